# Optimizing an MI355X kernel written in HIP

```python
import math
import numpy as np
import jax, jax.numpy as jnp
from jax import lax

D_MODEL = 1024
BATCH = 2
SEQ = 16384
DEPTH = 2

CTX_LEN = 256
GRID_W = 64
N_EVEN = (DEPTH + 1) // 2
N_ODD = DEPTH // 2
EPS = 1e-6
CHUNK = 128
CONV_W = 4
MIX_WIDTH = D_MODEL

A_HEADS = 4
A_DQK = 64
A_DV = 128
A_WIDTH = A_HEADS * A_DV
B_HEADS = 8
B_HEADDIM = 64
B_WIDTH = B_HEADS * B_HEADDIM
B_GROUPS = 2
B_STATE = 128
B_CONV_CH = B_WIDTH + 2 * B_GROUPS * B_STATE
EV_SPLITS = [A_HEADS * A_DQK, A_HEADS * A_DQK, A_WIDTH, A_WIDTH, 2 * A_HEADS, 2 * A_HEADS,
             B_WIDTH, B_CONV_CH, 2 * B_HEADS]
EV_COLS = sum(EV_SPLITS)
C_HEADS = 8
C_HEADDIM = 64
C_WIDTH = C_HEADS * C_HEADDIM
C_LORA_W = 64
C_LORA_A = 64
C_LORA_G = 128
RWKV_SPLITS = [C_WIDTH, C_WIDTH, C_WIDTH, C_LORA_W, C_LORA_A, C_LORA_G]
RWKV_COLS = sum(RWKV_SPLITS)
RWKV_W_SCALE = math.exp(-0.5)
RWKV_GN_EPS = 64e-5
D_WIDTH = 512
D_BLOCKS = 8
D_BLOCK = D_WIDTH // D_BLOCKS
LRU_C = 8.0
OD_COLS = RWKV_COLS + 2 * D_WIDTH
PEER_HEADS = 8
PEER_DK = 256
N_KEYS = 128
N_EXPERTS = N_KEYS * N_KEYS
PEER_TOPK = 16
PEER_BLOCK = 128

kernel_name = 'hybrid_mlstm_ssd_rwkv7_rglru_peer_prefix_ctx'


def rmsnorm(x, w):
    xf = x.astype(jnp.float32)
    y = xf * lax.rsqrt(jnp.mean(xf * xf, axis=-1, keepdims=True) + EPS)
    return (y * w.astype(jnp.float32)).astype(x.dtype)


def split_cols(p, sizes):
    return jnp.split(p, [int(s) for s in np.cumsum(sizes)[:-1]], axis=-1)


def conv_centred(x, w, b):
    L = x.shape[1]
    left = CONV_W // 2
    xp = jnp.pad(x, ((0, 0), (left, CONV_W - 1 - left), (0, 0)))
    y = b
    for tap in range(CONV_W):
        y = y + xp[:, tap:tap + L] * w[tap]
    return y


def grid_shift(p):
    B_, L, cn = p.shape
    rows = L // GRID_W
    g = p.reshape(B_, rows, GRID_W, cn)
    q = cn // 4
    left = jnp.pad(g[:, :, :-1, :q], ((0, 0), (0, 0), (1, 0), (0, 0)))
    right = jnp.pad(g[:, :, 1:, q:2 * q], ((0, 0), (0, 0), (0, 1), (0, 0)))
    up = jnp.pad(g[:, :-1, :, 2 * q:3 * q], ((0, 0), (1, 0), (0, 0), (0, 0)))
    down = jnp.pad(g[:, 1:, :, 3 * q:], ((0, 0), (0, 1), (0, 0), (0, 0)))
    return jnp.concatenate([left, right, up, down], axis=-1).reshape(B_, L, cn)


def seq_shift(p):
    half = p.shape[-1] // 2
    prev = jnp.pad(p[:, :-1, :half], ((0, 0), (1, 0), (0, 0)))
    nxt = jnp.pad(p[:, 1:, half:], ((0, 0), (0, 1), (0, 0)))
    return jnp.concatenate([prev, nxt], axis=-1)


def block_diag(x, w):
    B_, L, C = x.shape
    return jnp.einsum('blnd,nde->blne', x.reshape(B_, L, D_BLOCKS, D_BLOCK), w).reshape(B_, L, C)


def bidirectional(scan_fn, ctx_f, lat_f, ctx_b, lat_b, state0, axis):
    flip = lambda a: jnp.flip(a, axis)
    yc_f, sc_f = scan_fn(ctx_f, state0)
    yl_f, _ = scan_fn(lat_f, sc_f)
    yc_b, sc_b = scan_fn(tuple(flip(a) for a in ctx_b), state0)
    yl_b, _ = scan_fn(tuple(flip(a) for a in lat_b), sc_b)
    return yc_f + flip(yc_b), yl_f + flip(yl_b)


def mlstm_scan(inputs, state):
    dtype = inputs[2].dtype
    q, k, v, logi, logf = (a.astype(jnp.float32) for a in inputs)
    B_, H, L, _ = q.shape
    nc = L // CHUNK
    chunks = lambda a: jnp.moveaxis(a.reshape(B_, H, nc, CHUNK, *a.shape[3:]), 2, 0)
    tril = jnp.tril(jnp.ones((CHUNK, CHUNK), dtype=bool))

    def step(carry, blk):
        C, n, m = carry
        qc, kc, vc, ic, fc = blk
        b = jnp.cumsum(fc, axis=-1)
        dmat = jnp.where(tril, b[..., :, None] - b[..., None, :] + ic[..., None, :], -jnp.inf)
        inter = b + m[..., None]
        m_t = jnp.maximum(inter, jnp.max(dmat, axis=-1))
        s = jnp.einsum('bhtd,bhsd->bhts', qc, kc) * jnp.exp(dmat - m_t[..., None])
        w_inter = jnp.exp(inter - m_t)
        num = jnp.einsum('bhts,bhsv->bhtv', s, vc) + w_inter[..., None] * jnp.einsum('bhvd,bhtd->bhtv', C, qc)
        den = jnp.sum(s, axis=-1) + w_inter * jnp.einsum('bhd,bhtd->bht', n, qc)
        h = num / jnp.maximum(jnp.abs(den), jnp.exp(-m_t))[..., None]
        b_last = b[..., -1]
        g = b_last[..., None] - b + ic
        m_new = jnp.maximum(b_last + m, jnp.max(g, axis=-1))
        wg = jnp.exp(g - m_new[..., None])
        wc = jnp.exp(b_last + m - m_new)
        C = wc[..., None, None] * C + jnp.einsum('bhs,bhsv,bhsd->bhvd', wg, vc, kc)
        n = wc[..., None] * n + jnp.einsum('bhs,bhsd->bhd', wg, kc)
        return (C, n, m_new), h

    state, hs = lax.scan(step, state, tuple(chunks(a) for a in (q, k, v, logi, logf)))
    h = jnp.moveaxis(hs, 0, 2).reshape(B_, H, L, -1)
    return h.astype(dtype), state


def ssd_scan(inputs, state):
    dtype = inputs[0].dtype
    x, bm, cm, dt, la = (a.astype(jnp.float32) for a in inputs)
    B_, H, L, _ = x.shape
    nc = L // CHUNK
    chunks = lambda a: jnp.moveaxis(a.reshape(B_, H, nc, CHUNK, *a.shape[3:]), 2, 0)
    tril = jnp.tril(jnp.ones((CHUNK, CHUNK), dtype=bool))

    def step(S, blk):
        xc, bc, cc, dtc, lac = blk
        b = jnp.cumsum(lac, axis=-1)
        decay = jnp.exp(jnp.where(tril, b[..., :, None] - b[..., None, :], -jnp.inf))
        s = jnp.einsum('bhtn,bhsn->bhts', cc, bc) * decay * dtc[..., None, :]
        y = jnp.einsum('bhts,bhsp->bhtp', s, xc) + jnp.exp(b)[..., None] * jnp.einsum('bhpn,bhtn->bhtp', S, cc)
        w_end = jnp.exp(b[..., -1:] - b) * dtc
        S = jnp.exp(b[..., -1])[..., None, None] * S + jnp.einsum('bhs,bhsp,bhsn->bhpn', w_end, xc, bc)
        return S, y

    state, ys = lax.scan(step, state, tuple(chunks(a) for a in (x, bm, cm, dt, la)))
    y = jnp.moveaxis(ys, 0, 2).reshape(B_, H, L, -1)
    return y.astype(dtype), state


def rwkv_scan(inputs, state):
    dtype = inputs[3].dtype
    seq = tuple(jnp.moveaxis(a.astype(jnp.float32), 1, 0) for a in inputs)

    def step(S, blk):
        rt, wt, kt, vt, at, bt = blk
        sa = jnp.einsum('bhvk,bhk->bhv', S, at)
        S = S * wt[:, :, None, :] + sa[..., None] * bt[:, :, None, :] + vt[..., None] * kt[:, :, None, :]
        return S, jnp.einsum('bhvk,bhk->bhv', S, rt)

    state, ys = lax.scan(step, state, seq)
    return jnp.moveaxis(ys, 0, 1).astype(dtype), state


def lru_scan(inputs, h0):
    dtype = inputs[1].dtype
    a, b = (t.astype(jnp.float32) for t in inputs)
    b = b.at[:, 0].add(a[:, 0] * h0)

    def combine(left, right):
        a1, b1 = left
        a2, b2 = right
        return a1 * a2, a2 * b1 + b2

    _, h = lax.associative_scan(combine, (a, b), axis=1)
    return h.astype(dtype), h[:, -1]


def mlstm_ssd_mixer(h_ctx, h_lat, w_in, i_bias, f_bias, mlstm_norm, conv_w, conv_b,
                    dt_bias, a_log, d_skip, ssd_norm, need_ctx):
    def prep(h):
        B_, L = h.shape[:2]
        q, k, v, o, ig, fg, z, xbc, dt = split_cols(h @ w_in, EV_SPLITS)
        heads = lambda a, n: jnp.swapaxes(a.reshape(B_, L, n, -1), 1, 2)
        qh = heads(q, A_HEADS) * (A_DQK ** -0.5)
        kh, vh = heads(k, A_HEADS), heads(v, A_HEADS)
        gate = lambda g, bias, d: jnp.swapaxes(
            (g[..., d * A_HEADS:(d + 1) * A_HEADS] + bias[d]).astype(jnp.float32), 1, 2)
        mlstm_in = [(qh, kh, vh, gate(ig, i_bias, d), jax.nn.log_sigmoid(gate(fg, f_bias, d)))
                    for d in range(2)]
        xbc = jax.nn.silu(conv_centred(xbc, conv_w, conv_b))
        xs, bs, cs = split_cols(xbc, [B_WIDTH, B_GROUPS * B_STATE, B_GROUPS * B_STATE])
        xh = heads(xs, B_HEADS)
        bh = jnp.repeat(heads(bs, B_GROUPS), B_HEADS // B_GROUPS, axis=1)
        ch = jnp.repeat(heads(cs, B_GROUPS), B_HEADS // B_GROUPS, axis=1)
        ssd_in = []
        for d in range(2):
            dt_d = jax.nn.softplus(jnp.swapaxes(
                (dt[..., d * B_HEADS:(d + 1) * B_HEADS] + dt_bias[d]).astype(jnp.float32), 1, 2))
            la = -dt_d * jnp.exp(a_log[d].astype(jnp.float32))[None, :, None]
            ssd_in.append((xh, bh, ch, dt_d, la))
        return mlstm_in, ssd_in, (o, z, xh)

    mc, sc, extra_c = prep(h_ctx)
    ml, sl, extra_l = prep(h_lat)
    B_ = h_lat.shape[0]
    m0 = (jnp.zeros((B_, A_HEADS, A_DV, A_DQK), jnp.float32),
          jnp.zeros((B_, A_HEADS, A_DQK), jnp.float32),
          jnp.zeros((B_, A_HEADS), jnp.float32))
    hc, hl = bidirectional(mlstm_scan, mc[0], ml[0], mc[1], ml[1], m0, axis=2)
    s0 = jnp.zeros((B_, B_HEADS, B_HEADDIM, B_STATE), jnp.float32)
    yc, yl = bidirectional(ssd_scan, sc[0], sl[0], sc[1], sl[1], s0, axis=2)

    def finish(h, y, extra):
        o, z, xh = extra
        B_, _, L, _ = h.shape
        h = rmsnorm(jnp.swapaxes(h, 1, 2), mlstm_norm.reshape(A_HEADS, A_DV)).reshape(B_, L, A_WIDTH)
        ya = jax.nn.sigmoid(o) * h
        y = jnp.swapaxes(y + d_skip[None, :, None, None] * xh, 1, 2).reshape(B_, L, B_WIDTH)
        yb = rmsnorm(y * jax.nn.silu(z), ssd_norm)
        return jnp.concatenate([ya, yb], axis=-1)

    f_ctx = finish(hc, yc, extra_c) if need_ctx else None
    return f_ctx, finish(hl, yl, extra_l)


def rwkv_lru_mixer(h_ctx, h_lat, w_in, mu, w0, w_up, a0, a_up, g_up, k_k, k_a, r_k, ln_w, ln_b,
                   conv_w, conv_b, lam, wa, ba, wi, bi, need_ctx):
    def prep(h, shift_fn):
        B_, L = h.shape[:2]
        pr, gate_br, x_br = split_cols(h @ w_in, [RWKV_COLS, D_WIDTH, D_WIDTH])
        pr = pr + mu * (shift_fn(pr) - pr)
        r, k, v, wd, ad, gd = split_cols(pr, RWKV_SPLITS)
        heads = lambda a: a.reshape(B_, L, C_HEADS, C_HEADDIM)
        kk = heads(k * k_k).astype(jnp.float32)
        kk = kk * lax.rsqrt(jnp.sum(kk * kk, axis=-1, keepdims=True) + 1e-12)
        rwkv_in, kts = [], []
        for d in range(2):
            logw = -RWKV_W_SCALE * jax.nn.sigmoid((w0[d] + jnp.tanh(wd) @ w_up[d]).astype(jnp.float32))
            a = jax.nn.sigmoid((a0[d] + ad @ a_up[d]).astype(jnp.float32))
            kt = heads(k * (1.0 + (a - 1.0) * k_a))
            rwkv_in.append((heads(r), heads(jnp.exp(logw)), kt, heads(v), -kk, kk * heads(a)))
            kts.append(kt)
        g = jax.nn.sigmoid(gd) @ g_up
        xc = conv_centred(x_br, conv_w, conv_b)
        lru_in = []
        for d in range(2):
            gr = jax.nn.sigmoid((block_diag(xc, wa[d]) + ba[d]).astype(jnp.float32))
            gi = jax.nn.sigmoid(block_diag(xc, wi[d]) + bi[d])
            log_a = -LRU_C * gr * jax.nn.softplus(-lam[d].astype(jnp.float32))
            lru_in.append((jnp.exp(log_a), jnp.sqrt(-jnp.expm1(2.0 * log_a)) * (gi * xc)))
        return rwkv_in, lru_in, (heads(r), 0.5 * (kts[0] + kts[1]), heads(v), g, gate_br)

    rc, lc, extra_c = prep(h_ctx, seq_shift)
    rl, ll, extra_l = prep(h_lat, grid_shift)
    B_ = h_lat.shape[0]
    S0 = jnp.zeros((B_, C_HEADS, C_HEADDIM, C_HEADDIM), jnp.float32)
    yc, yl = bidirectional(rwkv_scan, rc[0], rl[0], rc[1], rl[1], S0, axis=1)
    h0 = jnp.zeros((B_, D_WIDTH), jnp.float32)
    uc, ul = bidirectional(lru_scan, lc[0], ll[0], lc[1], ll[1], h0, axis=1)

    def finish(y, u, extra):
        r, kb, v, g, gate_br = extra
        B_, L = y.shape[:2]
        yf = y.astype(jnp.float32)
        mean = jnp.mean(yf, axis=-1, keepdims=True)
        var = jnp.mean(jnp.square(yf - mean), axis=-1, keepdims=True)
        yn = (yf - mean) * lax.rsqrt(var + RWKV_GN_EPS) * ln_w.reshape(C_HEADS, C_HEADDIM) \
            + ln_b.reshape(C_HEADS, C_HEADDIM)
        yn = yn + jnp.sum(r * kb * r_k, axis=-1, keepdims=True) * v
        yc_ = (yn.reshape(B_, L, C_WIDTH) * g).astype(y.dtype)
        yd = u * jax.nn.gelu(gate_br, approximate=False)
        return jnp.concatenate([yc_, yd], axis=-1)

    f_ctx = finish(yc, uc, extra_c) if need_ctx else None
    return f_ctx, finish(yl, ul, extra_l)


def peer(h, wq, keys, u_tab, v_tab):
    B_, L, D = h.shape
    blocks = h.reshape(-1, PEER_BLOCK, D)

    def block_fn(xb):
        q = (xb @ wq).reshape(PEER_BLOCK, PEER_HEADS, 2, PEER_DK // 2)
        s = jnp.einsum('thpd,hpkd->thpk', q, keys)
        sv, si = lax.top_k(s, PEER_TOPK)
        cand = (sv[:, :, 0, :, None] + sv[:, :, 1, None, :]).reshape(PEER_BLOCK, PEER_HEADS, -1)
        cidx = (si[:, :, 0, :, None] * N_KEYS + si[:, :, 1, None, :]).reshape(PEER_BLOCK, PEER_HEADS, -1)
        best, pos = lax.top_k(cand, PEER_TOPK)
        idx = jnp.take_along_axis(cidx, pos, axis=-1)
        gate = jax.nn.softmax(best.astype(jnp.float32), axis=-1).astype(xb.dtype)
        act = jax.nn.gelu(jnp.einsum('td,thkd->thk', xb, u_tab[idx]), approximate=False)
        return jnp.einsum('thk,thkd->td', gate * act, v_tab[idx])

    return lax.map(block_fn, blocks).reshape(B_, L, D)


def setup_inputs(seed: int = 0) -> dict:
    key = jax.random.key(seed)
    ks = iter(jax.random.split(key, 64))
    f32 = jnp.float32
    nrm = lambda shape, scale: scale * jax.random.normal(next(ks), shape, f32)
    uni = lambda shape, lo, hi: jax.random.uniform(next(ks), shape, f32, lo, hi)
    D = D_MODEL
    dt = jnp.exp(uni((N_EVEN, 2, B_HEADS), math.log(1e-3), math.log(1e-1)))
    a8 = uni((N_ODD, 2, D_WIDTH), 0.9, 0.999)
    sa = a8 ** (1.0 / 8.0)
    return {
        'x': nrm((BATCH, SEQ, D), 1.0),
        'c': nrm((BATCH, D), 1.0),
        'ctx': nrm((BATCH, CTX_LEN, D), 1.0),
        'c_ctx': nrm((D,), 1.0),
        'mod_w': nrm((DEPTH, D, 6 * D), 0.5 * D ** -0.5),
        'mod_b': nrm((DEPTH, 6 * D), 0.02),
        'norm1': 1.0 + nrm((DEPTH, D), 0.02),
        'norm2': 1.0 + nrm((DEPTH, D), 0.02),
        'peer_wq': nrm((DEPTH, D, PEER_HEADS * PEER_DK), D ** -0.5),
        'peer_keys': nrm((DEPTH, PEER_HEADS, 2, N_KEYS, PEER_DK // 2), (PEER_DK // 2) ** -0.5),
        'peer_u': nrm((DEPTH, N_EXPERTS, D), D ** -0.5),
        'peer_v': nrm((DEPTH, N_EXPERTS, D), 0.5),
        'ev_w_in': nrm((N_EVEN, D, EV_COLS), D ** -0.5),
        'ev_w_out': nrm((N_EVEN, MIX_WIDTH, D), MIX_WIDTH ** -0.5),
        'ev_mlstm_i_bias': nrm((N_EVEN, 2, A_HEADS), 0.1),
        'ev_mlstm_f_bias': uni((N_EVEN, 2, A_HEADS), 3.0, 6.0),
        'ev_mlstm_norm': 1.0 + nrm((N_EVEN, A_WIDTH), 0.02),
        'ev_ssd_conv_w': nrm((N_EVEN, CONV_W, B_CONV_CH), CONV_W ** -0.5),
        'ev_ssd_conv_b': nrm((N_EVEN, B_CONV_CH), 0.02),
        'ev_ssd_dt_bias': dt + jnp.log(-jnp.expm1(-dt)),
        'ev_ssd_a_log': jnp.log(uni((N_EVEN, 2, B_HEADS), 1.0, 16.0)),
        'ev_ssd_d': 1.0 + nrm((N_EVEN, B_HEADS), 0.1),
        'ev_ssd_norm': 1.0 + nrm((N_EVEN, B_WIDTH), 0.02),
        'od_w_in': nrm((N_ODD, D, OD_COLS), D ** -0.5),
        'od_w_out': nrm((N_ODD, MIX_WIDTH, D), MIX_WIDTH ** -0.5),
        'od_rwkv_mu': uni((N_ODD, RWKV_COLS), 0.0, 1.0),
        'od_rwkv_w0': uni((N_ODD, 2, C_WIDTH), -3.0, 3.0),
        'od_rwkv_w_up': nrm((N_ODD, 2, C_LORA_W, C_WIDTH), 0.1),
        'od_rwkv_a0': nrm((N_ODD, 2, C_WIDTH), 0.1),
        'od_rwkv_a_up': nrm((N_ODD, 2, C_LORA_A, C_WIDTH), C_LORA_A ** -0.5),
        'od_rwkv_g_up': nrm((N_ODD, C_LORA_G, C_WIDTH), C_LORA_G ** -0.5),
        'od_rwkv_k_k': 0.85 + nrm((N_ODD, C_WIDTH), 0.05),
        'od_rwkv_k_a': 1.0 + nrm((N_ODD, C_WIDTH), 0.05),
        'od_rwkv_r_k': nrm((N_ODD, C_HEADS, C_HEADDIM), 0.1),
        'od_rwkv_ln_w': 1.0 + nrm((N_ODD, C_WIDTH), 0.02),
        'od_rwkv_ln_b': nrm((N_ODD, C_WIDTH), 0.02),
        'od_lru_conv_w': nrm((N_ODD, CONV_W, D_WIDTH), CONV_W ** -0.5),
        'od_lru_conv_b': nrm((N_ODD, D_WIDTH), 0.02),
        'od_lru_lambda': jnp.log(sa) - jnp.log1p(-sa),
        'od_lru_wa': nrm((N_ODD, 2, D_BLOCKS, D_BLOCK, D_BLOCK), D_BLOCK ** -0.5),
        'od_lru_ba': nrm((N_ODD, 2, D_WIDTH), 0.02),
        'od_lru_wi': nrm((N_ODD, 2, D_BLOCKS, D_BLOCK, D_BLOCK), D_BLOCK ** -0.5),
        'od_lru_bi': nrm((N_ODD, 2, D_WIDTH), 0.02),
        'final_norm': 1.0 + nrm((D,), 0.02),
    }


def reference(x, c, ctx, c_ctx, mod_w, mod_b, norm1, norm2, peer_wq, peer_keys, peer_u, peer_v,
              ev_w_in, ev_w_out, ev_mlstm_i_bias, ev_mlstm_f_bias, ev_mlstm_norm, ev_ssd_conv_w,
              ev_ssd_conv_b, ev_ssd_dt_bias, ev_ssd_a_log, ev_ssd_d, ev_ssd_norm,
              od_w_in, od_w_out, od_rwkv_mu, od_rwkv_w0, od_rwkv_w_up, od_rwkv_a0, od_rwkv_a_up,
              od_rwkv_g_up, od_rwkv_k_k, od_rwkv_k_a, od_rwkv_r_k, od_rwkv_ln_w, od_rwkv_ln_b,
              od_lru_conv_w, od_lru_conv_b, od_lru_lambda, od_lru_wa, od_lru_ba, od_lru_wi, od_lru_bi,
              final_norm):
    x_lat, x_ctx = x, ctx
    s_lat = jax.nn.silu(c)
    s_ctx = jax.nn.silu(c_ctx)
    for i in range(DEPTH):
        last = i == DEPTH - 1
        sh1, sc1, g1, sh2, sc2, g2 = [m[:, None, :] for m in jnp.split(s_lat @ mod_w[i] + mod_b[i], 6, axis=-1)]
        csh1, csc1, cg1, csh2, csc2, cg2 = jnp.split(s_ctx @ mod_w[i] + mod_b[i], 6, axis=-1)
        h_lat = rmsnorm(x_lat, norm1[i]) * (1.0 + sc1) + sh1
        h_ctx = rmsnorm(x_ctx, norm1[i]) * (1.0 + csc1) + csh1
        j = i // 2
        if i % 2 == 0:
            f_ctx, f_lat = mlstm_ssd_mixer(
                h_ctx, h_lat, ev_w_in[j], ev_mlstm_i_bias[j], ev_mlstm_f_bias[j], ev_mlstm_norm[j],
                ev_ssd_conv_w[j], ev_ssd_conv_b[j], ev_ssd_dt_bias[j], ev_ssd_a_log[j], ev_ssd_d[j],
                ev_ssd_norm[j], not last)
            w_out = ev_w_out[j]
        else:
            f_ctx, f_lat = rwkv_lru_mixer(
                h_ctx, h_lat, od_w_in[j], od_rwkv_mu[j], od_rwkv_w0[j], od_rwkv_w_up[j], od_rwkv_a0[j],
                od_rwkv_a_up[j], od_rwkv_g_up[j], od_rwkv_k_k[j], od_rwkv_k_a[j], od_rwkv_r_k[j],
                od_rwkv_ln_w[j], od_rwkv_ln_b[j], od_lru_conv_w[j], od_lru_conv_b[j], od_lru_lambda[j],
                od_lru_wa[j], od_lru_ba[j], od_lru_wi[j], od_lru_bi[j], not last)
            w_out = od_w_out[j]
        x_lat = x_lat + g1 * (f_lat @ w_out)
        x_lat = x_lat + g2 * peer(rmsnorm(x_lat, norm2[i]) * (1.0 + sc2) + sh2,
                                  peer_wq[i], peer_keys[i], peer_u[i], peer_v[i])
        if not last:
            x_ctx = x_ctx + cg1 * (f_ctx @ w_out)
            x_ctx = x_ctx + cg2 * peer(rmsnorm(x_ctx, norm2[i]) * (1.0 + csc2) + csh2,
                                      peer_wq[i], peer_keys[i], peer_u[i], peer_v[i])
    return rmsnorm(x_lat, final_norm)
```

```cpp
#ifdef CPU_EMU
#include "emu.h"
#else
#include <hip/hip_runtime.h>
#include <hip/hip_cooperative_groups.h>
#include <cstdio>
namespace cg = cooperative_groups;
#define DEV __device__ __forceinline__
#define DEVM __device__ __forceinline__
#endif

#ifndef SEQ_LEN
#define SEQ_LEN 16384
#endif
#ifndef CTX_LEN
#define CTX_LEN 256
#endif
#ifndef GRID_W_
#define GRID_W_ 64
#endif
#ifndef MULTI_LAUNCH
#define MULTI_LAUNCH 0
#endif

typedef unsigned short bf16_t;
typedef __attribute__((ext_vector_type(8))) short bf16x8;
typedef __attribute__((ext_vector_type(16))) float f32x16;
typedef __attribute__((ext_vector_type(4))) unsigned u32x4;
typedef __attribute__((ext_vector_type(2))) unsigned u32x2;
typedef __attribute__((ext_vector_type(4))) float f32x4;

constexpr int D = 1024, NB = 2, SEQ = SEQ_LEN, CTXL = CTX_LEN, GW = GRID_W_;
constexpr int NCTX = NB * CTXL, NLAT = NB * SEQ, NTOK = NCTX + NLAT;
constexpr int EVC = 3104, ODC = 2816;
constexpr int NEXP = 16384;
constexpr int NTILE = NTOK / 128, CTILE = NCTX / 128;
static_assert(NTOK % 128 == 0 && NCTX % 128 == 0, "tiles");
static_assert(CTXL % 64 == 0 && SEQ % 64 == 0 && SEQ % GW == 0, "chunks");

constexpr size_t al256(size_t x) { return (x + 255) & ~(size_t)255; }
constexpr size_t OFF_MODV = 0;
constexpr size_t OFF_CTXRES = OFF_MODV + al256(2 * 3 * 6144 * 4);
constexpr size_t OFF_GATES = OFF_CTXRES + al256((size_t)NCTX * 1024 * 4);
constexpr size_t OFF_WEVIN = OFF_GATES + al256((size_t)NTOK * 32 * 4);
constexpr size_t OFF_WEVOUT = OFF_WEVIN + al256((size_t)EVC * 1024 * 2);
constexpr size_t OFF_WODIN = OFF_WEVOUT + al256((size_t)1024 * 1024 * 2);
constexpr size_t OFF_WODOUT = OFF_WODIN + al256((size_t)ODC * 1024 * 2);
constexpr size_t OFF_WQ = OFF_WODOUT + al256((size_t)1024 * 1024 * 2);
constexpr size_t OFF_KEYS = OFF_WQ + al256((size_t)2 * 2048 * 1024 * 2);
constexpr size_t OFF_WUP = OFF_KEYS + al256((size_t)2 * 8 * 2 * 128 * 128 * 2);
constexpr size_t OFF_AUP = OFF_WUP + al256((size_t)2 * 512 * 64 * 2);
constexpr size_t OFF_GUP = OFF_AUP + al256((size_t)2 * 512 * 64 * 2);
constexpr size_t OFF_LRUT = OFF_GUP + al256((size_t)512 * 128 * 2);
constexpr size_t OFF_PU = OFF_LRUT + al256((size_t)2 * 8 * 128 * 64 * 2);
constexpr size_t OFF_PV = OFF_PU + al256((size_t)NEXP * 1024 * 2);
constexpr size_t OFF_HBUF = OFF_PV + al256((size_t)NEXP * 1024 * 2);
constexpr size_t OFF_PR = OFF_HBUF + al256((size_t)NTOK * 1024 * 2);
constexpr size_t PR_BYTES = (size_t)NTOK * 5376 * 2;
constexpr size_t WS_NEEDED = OFF_PR + PR_BYTES;
static_assert(WS_NEEDED <= (size_t)512 * 1024 * 1024, "workspace too large");
constexpr size_t OFF_PROJ = OFF_PR;
constexpr size_t OFF_R2L0 = OFF_PR + (size_t)NTOK * EVC * 2;
constexpr size_t OFF_LORA = OFF_PR + (size_t)NTOK * ODC * 2;
constexpr size_t OFF_Q = OFF_PR;
constexpr size_t OFF_PIDX = OFF_PR + (size_t)NTOK * 2048 * 2;
constexpr size_t OFF_PGATE = OFF_PIDX + (size_t)NTOK * 128 * 4;
static_assert(OFF_PGATE + (size_t)NTOK * 128 * 4 <= OFF_PR + PR_BYTES, "picks");

enum {
  I_X = 0, I_C, I_CTX, I_CCTX, I_MODW, I_MODB, I_NORM1, I_NORM2, I_WQ, I_KEYS, I_PU, I_PV,
  I_EVWIN, I_EVWOUT, I_IBIAS, I_FBIAS, I_MNORM, I_SCONVW, I_SCONVB, I_DTBIAS, I_ALOG, I_DSKIP, I_SNORM,
  I_ODWIN, I_ODWOUT, I_MU, I_W0, I_WUP, I_A0, I_AUP, I_GUP, I_KK, I_KA, I_RK, I_LNW, I_LNB,
  I_LCONVW, I_LCONVB, I_LAM, I_WA, I_BA, I_WI, I_BI, I_FNORM, N_IN
};

struct Params {
  const float* in[N_IN];
  float* out;
  unsigned char* ws;
};

constexpr int SMEM_BYTES = 80 * 1024;
#ifdef CPU_EMU
#define SMEM_DECL static thread_local __attribute__((aligned(16))) unsigned char smem_raw[SMEM_BYTES]
#else
#define SMEM_DECL __shared__ __attribute__((aligned(16))) unsigned char smem_raw[SMEM_BYTES]
#endif

DEV float bf2f(bf16_t v) { unsigned u = ((unsigned)v) << 16; float f; __builtin_memcpy(&f, &u, 4); return f; }
DEV bf16_t f2bf(float f) { unsigned u; __builtin_memcpy(&u, &f, 4); u += 0x7fffu + ((u >> 16) & 1u); return (bf16_t)(u >> 16); }
DEV unsigned pack2(float a, float b) { return (unsigned)f2bf(a) | ((unsigned)f2bf(b) << 16); }
DEV void unpack8(const u32x4& r, float* o) {
  unsigned w[4] = {r.x, r.y, r.z, r.w};
#pragma unroll
  for (int i = 0; i < 4; ++i) { unsigned lo = w[i] << 16, hi = w[i] & 0xffff0000u; __builtin_memcpy(&o[2 * i], &lo, 4); __builtin_memcpy(&o[2 * i + 1], &hi, 4); }
}
DEV u32x4 pack8(const float* o) { u32x4 r; r.x = pack2(o[0], o[1]); r.y = pack2(o[2], o[3]); r.z = pack2(o[4], o[5]); r.w = pack2(o[6], o[7]); return r; }
DEV float sigmoidf_(float x) { return 1.f / (1.f + expf(-x)); }
DEV float siluf_(float x) { return x / (1.f + expf(-x)); }
DEV float softplusf_(float x) { return fmaxf(x, 0.f) + log1pf(expf(-fabsf(x))); }
DEV float geluf_(float x) { return 0.5f * x * (1.f + erff(x * 0.70710678118654752f)); }

DEV f32x16 mfma32(bf16x8 a, bf16x8 b, f32x16 c) {
#ifdef CPU_EMU
  return emu_mfma32(a, b, c);
#else
  return __builtin_amdgcn_mfma_f32_32x32x16_bf16(a, b, c, 0, 0, 0);
#endif
}
DEV float wshfl_xor(float v, int m) {
#ifdef CPU_EMU
  return emu_shfl_xor(v, m);
#else
  return __shfl_xor(v, m, 64);
#endif
}
DEV float wave_sum(float v) {
#pragma unroll
  for (int m = 32; m >= 1; m >>= 1) v += wshfl_xor(v, m);
  return v;
}
DEV int acc_row(int reg, int lane) { return (reg & 3) + 8 * (reg >> 2) + 4 * (lane >> 5); }

DEV int mod_row(int row) { return row < NCTX ? 2 : (row - NCTX) / SEQ; }

template <bool SYNC_EPI, class Epi>
DEV void gemm_tile_128(const bf16_t* __restrict__ A, int lda, int M, const bf16_t* __restrict__ Bt, int ldb, int N,
                       int K, int m0, int n0, const Epi& epi, unsigned char* smem) {
  constexpr int LS = 72;
  bf16_t* sA = (bf16_t*)smem;
  bf16_t* sB = sA + 128 * LS;
  const int tid = threadIdx.x, lane = tid & 63, wave = tid >> 6;
  const int wm = (wave >> 1) * 64, wn = (wave & 1) * 64;
  f32x16 acc[2][2];
#pragma unroll
  for (int i = 0; i < 2; ++i)
#pragma unroll
    for (int j = 0; j < 2; ++j)
#pragma unroll
      for (int r = 0; r < 16; ++r) acc[i][j][r] = 0.f;
  u32x4 ra[4], rb[4];
  const u32x4 z4 = {0u, 0u, 0u, 0u};
#pragma unroll
  for (int i = 0; i < 4; ++i) {
    int c = tid + i * 256, r = c >> 3, cc = (c & 7) * 8;
    int gr = m0 + r, gn = n0 + r;
    ra[i] = gr < M ? *(const u32x4*)(A + (size_t)gr * lda + cc) : z4;
    rb[i] = gn < N ? *(const u32x4*)(Bt + (size_t)gn * ldb + cc) : z4;
  }
  for (int k0 = 0; k0 < K; k0 += 64) {
    __syncthreads();
#pragma unroll
    for (int i = 0; i < 4; ++i) {
      int c = tid + i * 256, r = c >> 3, cc = (c & 7) * 8;
      *(u32x4*)(sA + r * LS + cc) = ra[i];
      *(u32x4*)(sB + r * LS + cc) = rb[i];
    }
    __syncthreads();
    if (k0 + 64 < K) {
#pragma unroll
      for (int i = 0; i < 4; ++i) {
        int c = tid + i * 256, r = c >> 3, cc = (c & 7) * 8;
        int gr = m0 + r, gn = n0 + r;
        ra[i] = gr < M ? *(const u32x4*)(A + (size_t)gr * lda + k0 + 64 + cc) : z4;
        rb[i] = gn < N ? *(const u32x4*)(Bt + (size_t)gn * ldb + k0 + 64 + cc) : z4;
      }
    }
#pragma unroll
    for (int kk = 0; kk < 4; ++kk) {
      bf16x8 a[2], b[2];
      const int ko = kk * 16 + 8 * (lane >> 5);
#pragma unroll
      for (int i = 0; i < 2; ++i) a[i] = *(const bf16x8*)(sA + (wm + i * 32 + (lane & 31)) * LS + ko);
#pragma unroll
      for (int j = 0; j < 2; ++j) b[j] = *(const bf16x8*)(sB + (wn + j * 32 + (lane & 31)) * LS + ko);
#pragma unroll
      for (int i = 0; i < 2; ++i)
#pragma unroll
        for (int j = 0; j < 2; ++j) acc[i][j] = mfma32(a[i], b[j], acc[i][j]);
    }
  }
  if (SYNC_EPI) __syncthreads();
#pragma unroll
  for (int i = 0; i < 2; ++i)
#pragma unroll
    for (int j = 0; j < 2; ++j)
#pragma unroll
      for (int r = 0; r < 16; ++r) {
        int row = m0 + wm + i * 32 + acc_row(r, lane);
        int col = n0 + wn + j * 32 + (lane & 31);
        if (row < M && col < N) epi(row, col, acc[i][j][r]);
      }
}

DEV void transpose_tile(const float* __restrict__ src, int ld_src, bf16_t* __restrict__ dst, int ld_dst, int K, int N,
                        int tk, int tn, unsigned char* smem) {
  float* sT = (float*)smem;
  const int tid = threadIdx.x;
  __syncthreads();
  {
    const int tx = tid & 15, ty = tid >> 4;
#pragma unroll
    for (int p = 0; p < 4; ++p) {
      int k = tk * 64 + ty + p * 16, n = tn * 64 + tx * 4;
#pragma unroll
      for (int j = 0; j < 4; ++j) {
        float v = (k < K && n + j < N) ? src[(size_t)k * ld_src + n + j] : 0.f;
        sT[(ty + p * 16) * 65 + tx * 4 + j] = v;
      }
    }
  }
  __syncthreads();
  {
    const int n = tid >> 2, kseg = (tid & 3) * 16;
    int gn = tn * 64 + n;
    if (gn < N) {
      float v[16];
#pragma unroll
      for (int j = 0; j < 16; ++j) v[j] = sT[(kseg + j) * 65 + n];
      bf16_t* d = dst + (size_t)gn * ld_dst + tk * 64 + kseg;
      *(u32x4*)d = pack8(v);
      *(u32x4*)(d + 8) = pack8(v + 8);
    }
  }
}

constexpr int TJ0 = 16 * 49, TJ1 = 16 * 16, TJ2 = 16 * 44, TJ3 = 16 * 16, TJ4 = 2 * 16 * 32, TJ5 = 2 * 8, TJ6 = 2 * 8,
              TJ7 = 2 * 8, TJ8 = 32;
constexpr int NTRANS = TJ0 + TJ1 + TJ2 + TJ3 + TJ4 + TJ5 + TJ6 + TJ7 + TJ8;
constexpr int NKEYCV = (2 * 8 * 2 * 128 * 128) / (256 * 8);
constexpr int NMODV = 2 * 96;
constexpr int NPREP = NTRANS + NKEYCV + NMODV;

DEV void st_prep(const Params& P, int item, unsigned char* smem) {
  unsigned char* ws = P.ws;
  if (item < NTRANS) {
    int t = item;
    if (t < TJ0) { transpose_tile(P.in[I_EVWIN], EVC, (bf16_t*)(ws + OFF_WEVIN), 1024, 1024, EVC, t / 49, t % 49, smem); return; }
    t -= TJ0;
    if (t < TJ1) { transpose_tile(P.in[I_EVWOUT], 1024, (bf16_t*)(ws + OFF_WEVOUT), 1024, 1024, 1024, t / 16, t % 16, smem); return; }
    t -= TJ1;
    if (t < TJ2) { transpose_tile(P.in[I_ODWIN], ODC, (bf16_t*)(ws + OFF_WODIN), 1024, 1024, ODC, t / 44, t % 44, smem); return; }
    t -= TJ2;
    if (t < TJ3) { transpose_tile(P.in[I_ODWOUT], 1024, (bf16_t*)(ws + OFF_WODOUT), 1024, 1024, 1024, t / 16, t % 16, smem); return; }
    t -= TJ3;
    if (t < TJ4) {
      int l = t / 512, tt = t % 512;
      transpose_tile(P.in[I_WQ] + (size_t)l * 1024 * 2048, 2048, (bf16_t*)(ws + OFF_WQ) + (size_t)l * 2048 * 1024, 1024, 1024, 2048, tt / 32, tt % 32, smem);
      return;
    }
    t -= TJ4;
    if (t < TJ5) { int d = t / 8; transpose_tile(P.in[I_WUP] + d * 64 * 512, 512, (bf16_t*)(ws + OFF_WUP) + d * 512 * 64, 64, 64, 512, 0, t % 8, smem); return; }
    t -= TJ5;
    if (t < TJ6) { int d = t / 8; transpose_tile(P.in[I_AUP] + d * 64 * 512, 512, (bf16_t*)(ws + OFF_AUP) + d * 512 * 64, 64, 64, 512, 0, t % 8, smem); return; }
    t -= TJ6;
    if (t < TJ7) { transpose_tile(P.in[I_GUP], 512, (bf16_t*)(ws + OFF_GUP), 128, 128, 512, t / 8, t % 8, smem); return; }
    t -= TJ7;
    {
      int which = t & 1, db = t >> 1;
      const float* src = (which ? P.in[I_WI] : P.in[I_WA]) + (size_t)db * 64 * 64;
      transpose_tile(src, 64, (bf16_t*)(ws + OFF_LRUT) + (size_t)db * 128 * 64 + which * 64 * 64, 64, 64, 64, 0, 0, smem);
      return;
    }
  }
  item -= NTRANS;
  if (item < NKEYCV) {
    size_t e = ((size_t)item * 256 + threadIdx.x) * 8;
    const float* s = P.in[I_KEYS] + e;
    f32x4 a = *(const f32x4*)s, b = *(const f32x4*)(s + 4);
    float v[8] = {a.x, a.y, a.z, a.w, b.x, b.y, b.z, b.w};
    *(u32x4*)((bf16_t*)(ws + OFF_KEYS) + e) = pack8(v);
    return;
  }
  item -= NKEYCV;
  {
    const int l = item / 96, cgp = item % 96;
    float* sS = (float*)smem;
    float* sRed = sS + 3 * 1024;
    const int tid = threadIdx.x;
    __syncthreads();
    for (int i = tid; i < 3 * 1024; i += 256) {
      int m = i >> 10, k = i & 1023;
      float c = m < 2 ? P.in[I_C][m * 1024 + k] : P.in[I_CCTX][k];
      sS[i] = siluf_(c);
    }
    __syncthreads();
    const int ks = tid >> 6, col = cgp * 64 + (tid & 63);
    const float* w = P.in[I_MODW] + (size_t)l * 1024 * 6144 + col;
    float a0 = 0.f, a1 = 0.f, a2 = 0.f;
    for (int k = ks * 256; k < ks * 256 + 256; ++k) {
      float wv = w[(size_t)k * 6144];
      a0 += sS[k] * wv; a1 += sS[1024 + k] * wv; a2 += sS[2048 + k] * wv;
    }
    sRed[(ks * 3 + 0) * 64 + (tid & 63)] = a0;
    sRed[(ks * 3 + 1) * 64 + (tid & 63)] = a1;
    sRed[(ks * 3 + 2) * 64 + (tid & 63)] = a2;
    __syncthreads();
    if (tid < 192) {
      int m = tid >> 6, c = tid & 63;
      float s = sRed[(0 * 3 + m) * 64 + c] + sRed[(1 * 3 + m) * 64 + c] + sRed[(2 * 3 + m) * 64 + c] + sRed[(3 * 3 + m) * 64 + c];
      int cc = cgp * 64 + c;
      ((float*)(ws + OFF_MODV))[((size_t)l * 3 + m) * 6144 + cc] = s + P.in[I_MODB][l * 6144 + cc];
    }
  }
}

constexpr int NPCONV = 2 * (NEXP * 1024 / (256 * 8));
DEV void st_peer_conv(const Params& P, int layer, int item) {
  const int half = NPCONV / 2;
  int which = item >= half;
  int it = which ? item - half : item;
  size_t e = ((size_t)it * 256 + threadIdx.x) * 8;
  const float* s = (which ? P.in[I_PV] : P.in[I_PU]) + (size_t)layer * NEXP * 1024 + e;
  f32x4 a = *(const f32x4*)s, b = *(const f32x4*)(s + 4);
  float v[8] = {a.x, a.y, a.z, a.w, b.x, b.y, b.z, b.w};
  *(u32x4*)((bf16_t*)(P.ws + (which ? OFF_PV : OFF_PU)) + e) = pack8(v);
}

DEV void st_normmod(const Params& P, int layer, int which, int row) {
  const int lane = threadIdx.x & 63;
  const float* src;
  if (which == 0 && layer == 0) src = row < NCTX ? P.in[I_CTX] + (size_t)row * 1024 : P.in[I_X] + (size_t)(row - NCTX) * 1024;
  else src = row < NCTX ? (const float*)(P.ws + OFF_CTXRES) + (size_t)row * 1024 : P.out + (size_t)(row - NCTX) * 1024;
  const float* mv = (const float*)(P.ws + OFF_MODV) + ((size_t)layer * 3 + mod_row(row)) * 6144;
  const float* sh = mv + (which ? 3 : 0) * 1024;
  const float* sc = mv + (which ? 4 : 1) * 1024;
  const float* nw = (which ? P.in[I_NORM2] : P.in[I_NORM1]) + layer * 1024;
  f32x4 v[4];
  float ss = 0.f;
#pragma unroll
  for (int i = 0; i < 4; ++i) {
    v[i] = *(const f32x4*)(src + i * 256 + lane * 4);
    ss += v[i].x * v[i].x + v[i].y * v[i].y + v[i].z * v[i].z + v[i].w * v[i].w;
  }
  ss = wave_sum(ss);
  const float rstd = rsqrtf(ss * (1.f / 1024.f) + 1e-6f);
  bf16_t* dst = (bf16_t*)(P.ws + OFF_HBUF) + (size_t)row * 1024;
#pragma unroll
  for (int i = 0; i < 4; ++i) {
    int c = i * 256 + lane * 4;
    f32x4 w4 = *(const f32x4*)(nw + c), s4 = *(const f32x4*)(sc + c), h4 = *(const f32x4*)(sh + c);
    float o0 = v[i].x * rstd * w4.x * (1.f + s4.x) + h4.x;
    float o1 = v[i].y * rstd * w4.y * (1.f + s4.y) + h4.y;
    float o2 = v[i].z * rstd * w4.z * (1.f + s4.z) + h4.z;
    float o3 = v[i].w * rstd * w4.w * (1.f + s4.w) + h4.w;
    u32x2 pk; pk.x = pack2(o0, o1); pk.y = pack2(o2, o3);
    *(u32x2*)(dst + c) = pk;
  }
}

struct EpiProjL0 {
  bf16_t* proj; float* gates;
  DEVM void operator()(int row, int col, float v) const {
    proj[(size_t)row * EVC + col] = f2bf(v);
    if (col >= 1536 && col < 1552) gates[row * 32 + (col - 1536)] = v;
    else if (col >= 3088) gates[row * 32 + 16 + (col - 3088)] = v;
  }
};
struct EpiStoreBf {
  bf16_t* dst; int ld;
  DEVM void operator()(int row, int col, float v) const { dst[(size_t)row * ld + col] = f2bf(v); }
};
struct EpiStoreBfBias {
  bf16_t* dst; int ld; const float* bias;
  DEVM void operator()(int row, int col, float v) const { dst[(size_t)row * ld + col] = f2bf(v + (bias ? bias[col] : 0.f)); }
};
struct EpiOutProj {
  const float* x_lat; const float* x_ctx; float* o_lat; float* o_ctx; const float* modv;
  DEVM void operator()(int row, int col, float v) const {
    float g = modv[mod_row(row) * 6144 + 2 * 1024 + col];
    if (row < NCTX) o_ctx[(size_t)row * 1024 + col] = x_ctx[(size_t)row * 1024 + col] + g * v;
    else { size_t o = (size_t)(row - NCTX) * 1024 + col; o_lat[o] = x_lat[o] + g * v; }
  }
};
struct EpiScoreLds {
  float* sS; int m0;
  DEVM void operator()(int row, int col, float v) const { sS[(row - m0) * 129 + col] = v; }
};

DEV void ssd_conv8(const bf16_t* __restrict__ proj, int row0, int len, int pos, int ch, const float* __restrict__ cw,
                   const float* __restrict__ cb, float* o) {
#pragma unroll
  for (int j = 0; j < 8; ++j) o[j] = cb[ch + j];
#pragma unroll
  for (int tap = 0; tap < 4; ++tap) {
    int p = pos + tap - 2;
    if (p >= 0 && p < len) {
      u32x4 raw = *(const u32x4*)(proj + (size_t)(row0 + p) * EVC + 2064 + ch);
      float x[8];
      unpack8(raw, x);
#pragma unroll
      for (int j = 0; j < 8; ++j) o[j] += cw[tap * 1024 + ch + j] * x[j];
    }
  }
#pragma unroll
  for (int j = 0; j < 8; ++j) o[j] = siluf_(o[j]);
}

template <bool MLSTM>
DEV void st_linattn_stream(const Params& P, int sid, unsigned char* smem) {
  constexpr int DK = MLSTM ? 64 : 128, DX = MLSTM ? 128 : 64;
  constexpr int QS = DK + 8;
  constexpr int NH = MLSTM ? 4 : 8;
  const int tid = threadIdx.x, lane = tid & 63, wave = tid >> 6;
  const int d = sid & 1, h = (sid >> 1) % NH, b = (sid >> 1) / NH;
  bf16_t* sQ = (bf16_t*)smem;
  bf16_t* sK = sQ + 64 * QS;
  bf16_t* sP = sK;
  bf16_t* sKT = sK + 64 * QS;
  bf16_t* sXT = sKT + DK * 72;
  bf16_t* sST = sXT + DX * 72;
  float* sF = (float*)(sST + DX * QS);
  float* sLa = sF;
  float* sG = sF + 64;
  float* sBc = sF + 128;
  float* sDen = sF + 192;
  float* sN = sF + 256;
  int* sRow = (int*)(sF + 384);
  static_assert((64 * QS * 2 + DK * 72 + DX * 72 + DX * QS) * 2 + 448 * 4 <= SMEM_BYTES, "lds");

  const bf16_t* proj = (const bf16_t*)(P.ws + OFF_PROJ);
  const float* gates = (const float*)(P.ws + OFF_GATES);
  bf16_t* outb = MLSTM ? (bf16_t*)(P.ws + OFF_HBUF) : (bf16_t*)(P.ws + OFF_R2L0);

  __syncthreads();
  for (int i = tid; i < DX * QS; i += 256) sST[i] = 0;
  if (tid < 128) sN[tid] = 0.f;
  f32x16 accS[2];
#pragma unroll
  for (int j = 0; j < 2; ++j)
#pragma unroll
    for (int r = 0; r < 16; ++r) accS[j][r] = 0.f;
  const int sx0 = MLSTM ? wave * 32 : (wave >> 1) * 32;
  const int sk0 = MLSTM ? 0 : (wave & 1) * 64;

  float gbias_i = 0.f, gbias_f = 0.f, alog_e = 0.f, dskip = 0.f;
  if (MLSTM) { gbias_i = P.in[I_IBIAS][d * 4 + h]; gbias_f = P.in[I_FBIAS][d * 4 + h]; }
  else { gbias_i = P.in[I_DTBIAS][d * 8 + h]; alog_e = expf(P.in[I_ALOG][d * 8 + h]); dskip = P.in[I_DSKIP][h]; }

  for (int seg = 0; seg < 2; ++seg) {
    const int row0 = seg == 0 ? b * CTXL : NCTX + b * SEQ;
    const int len = seg == 0 ? CTXL : SEQ;
    for (int ck = 0; ck < len / 64; ++ck) {
      if (tid < 64) {
        int p = ck * 64 + tid;
        int pos = d ? len - 1 - p : p;
        int grow = row0 + pos;
        sRow[tid] = grow;
        if (MLSTM) {
          float li = gates[grow * 32 + d * 4 + h] + gbias_i;
          float fr = gates[grow * 32 + 8 + d * 4 + h] + gbias_f;
          sLa[tid] = -softplusf_(-fr);
          sG[tid] = expf(li);
        } else {
          float dt = softplusf_(gates[grow * 32 + 16 + d * 8 + h] + gbias_i);
          sLa[tid] = -dt * alog_e;
          sG[tid] = dt;
        }
      }
      if (MLSTM) {
#pragma unroll
        for (int i = 0; i < 2; ++i) {
          int c = tid + i * 256, r = c >> 3, cc = (c & 7) * 8;
          int p = ck * 64 + r, pos = d ? len - 1 - p : p;
          const bf16_t* rp = proj + (size_t)(row0 + pos) * EVC;
          u32x4 q4 = *(const u32x4*)(rp + h * 64 + cc);
          float qf[8]; unpack8(q4, qf);
#pragma unroll
          for (int j = 0; j < 8; ++j) qf[j] *= 0.125f;
          *(u32x4*)(sQ + r * QS + cc) = pack8(qf);
          *(u32x4*)(sK + r * QS + cc) = *(const u32x4*)(rp + 256 + h * 64 + cc);
        }
#pragma unroll
        for (int i = 0; i < 4; ++i) {
          int c = tid + i * 256, r = c >> 4, cc = (c & 15) * 8;
          int p = ck * 64 + r, pos = d ? len - 1 - p : p;
          u32x4 x4 = *(const u32x4*)(proj + (size_t)(row0 + pos) * EVC + 512 + h * 128 + cc);
          const bf16_t* xs = (const bf16_t*)&x4;
#pragma unroll
          for (int j = 0; j < 8; ++j) sXT[(cc + j) * 72 + r] = xs[j];
        }
      } else {
        const float* cw = P.in[I_SCONVW];
        const float* cb = P.in[I_SCONVB];
        const int grp = h >> 2;
#pragma unroll 1
        for (int i = 0; i < 10; ++i) {
          int c = tid + i * 256;
          float o[8];
          if (c < 512) {
            int r = c >> 3, cc = (c & 7) * 8;
            int p = ck * 64 + r, pos = d ? len - 1 - p : p;
            ssd_conv8(proj, row0, len, pos, h * 64 + cc, cw, cb, o);
#pragma unroll
            for (int j = 0; j < 8; ++j) sXT[(cc + j) * 72 + r] = f2bf(o[j]);
          } else if (c < 1536) {
            int c2 = c - 512, r = c2 >> 4, cc = (c2 & 15) * 8;
            int p = ck * 64 + r, pos = d ? len - 1 - p : p;
            ssd_conv8(proj, row0, len, pos, 512 + grp * 128 + cc, cw, cb, o);
            *(u32x4*)(sK + r * QS + cc) = pack8(o);
          } else {
            int c2 = c - 1536, r = c2 >> 4, cc = (c2 & 15) * 8;
            int p = ck * 64 + r, pos = d ? len - 1 - p : p;
            ssd_conv8(proj, row0, len, pos, 768 + grp * 128 + cc, cw, cb, o);
            *(u32x4*)(sQ + r * QS + cc) = pack8(o);
          }
        }
      }
      __syncthreads();
      if (wave == 0) {
        float v = sLa[lane];
#pragma unroll
        for (int off = 1; off < 64; off <<= 1) {
#ifdef CPU_EMU
          float o = emu_shfl_up(v, off);
#else
          float o = __shfl_up(v, off, 64);
#endif
          if (lane >= off) v += o;
        }
        sBc[lane] = v;
      }
      __syncthreads();
      const float blast = sBc[63];
      {
        const int s = tid & 63, kq = tid >> 6;
        const float wgt = expf(blast - sBc[s]) * sG[s];
#pragma unroll 4
        for (int k = kq * (DK / 4); k < (kq + 1) * (DK / 4); ++k) sKT[k * 72 + s] = f2bf(bf2f(sK[s * QS + k]) * wgt);
      }
      const int tr = (wave >> 1) * 32, tc = (wave & 1) * 32;
      f32x16 accP;
#pragma unroll
      for (int r = 0; r < 16; ++r) accP[r] = 0.f;
      if (!(tr == 0 && tc == 32)) {
#pragma unroll
        for (int kk = 0; kk < DK / 16; ++kk) {
          const int ko = kk * 16 + 8 * (lane >> 5);
          bf16x8 a = *(const bf16x8*)(sQ + (tr + (lane & 31)) * QS + ko);
          bf16x8 bb = *(const bf16x8*)(sK + (tc + (lane & 31)) * QS + ko);
          accP = mfma32(a, bb, accP);
        }
      }
      __syncthreads();
      {
        const int s = tc + (lane & 31);
        const float bs = sBc[s], gs = sG[s];
#pragma unroll
        for (int r = 0; r < 16; ++r) {
          int t = tr + acc_row(r, lane);
          float v = (s <= t) ? accP[r] * expf(sBc[t] - bs) * gs : 0.f;
          sP[t * 72 + s] = f2bf(v);
        }
        for (int i = tid; i < 64 * DK; i += 256) {
          int t = i / DK, k = i % DK;
          sQ[t * QS + k] = f2bf(bf2f(sQ[t * QS + k]) * expf(sBc[t]));
        }
      }
      __syncthreads();
      constexpr int NYT = MLSTM ? 2 : 1;
      const int yc0 = MLSTM ? (wave & 1) * 64 : (wave & 1) * 32;
      f32x16 accY[NYT];
#pragma unroll
      for (int j = 0; j < NYT; ++j)
#pragma unroll
        for (int r = 0; r < 16; ++r) accY[j][r] = 0.f;
#pragma unroll
      for (int kk = 0; kk < 4; ++kk) {
        const int ko = kk * 16 + 8 * (lane >> 5);
        bf16x8 a = *(const bf16x8*)(sP + (tr + (lane & 31)) * 72 + ko);
#pragma unroll
        for (int j = 0; j < NYT; ++j) {
          bf16x8 bb = *(const bf16x8*)(sXT + (yc0 + j * 32 + (lane & 31)) * 72 + ko);
          accY[j] = mfma32(a, bb, accY[j]);
        }
      }
#pragma unroll
      for (int kk = 0; kk < DK / 16; ++kk) {
        const int ko = kk * 16 + 8 * (lane >> 5);
        bf16x8 a = *(const bf16x8*)(sQ + (tr + (lane & 31)) * QS + ko);
#pragma unroll
        for (int j = 0; j < NYT; ++j) {
          bf16x8 bb = *(const bf16x8*)(sST + (yc0 + j * 32 + (lane & 31)) * QS + ko);
          accY[j] = mfma32(a, bb, accY[j]);
        }
      }
      if (MLSTM) {
        if (tid < 64) {
          float den = 0.f;
          for (int s = 0; s < 64; ++s) den += bf2f(sP[tid * 72 + s]);
          for (int k = 0; k < DK; ++k) den += sN[k] * bf2f(sQ[tid * QS + k]);
          sDen[tid] = den;
        }
        __syncthreads();
      }
#pragma unroll
      for (int j = 0; j < NYT; ++j)
#pragma unroll
        for (int r = 0; r < 16; ++r) {
          int t = tr + acc_row(r, lane);
          int x = yc0 + j * 32 + (lane & 31);
          float v = accY[j][r];
          if (MLSTM) {
            v = v / fmaxf(fabsf(sDen[t]), 1.f);
            outb[(size_t)sRow[t] * 1024 + d * 512 + h * 128 + x] = f2bf(v);
          } else {
            if (d == 0) v += dskip * bf2f(sXT[x * 72 + t]);
            outb[(size_t)sRow[t] * 1024 + d * 512 + h * 64 + x] = f2bf(v);
          }
        }
      __syncthreads();
      {
        const float eb = expf(blast);
#pragma unroll
        for (int j = 0; j < 2; ++j)
#pragma unroll
          for (int r = 0; r < 16; ++r) accS[j][r] *= eb;
#pragma unroll
        for (int kk = 0; kk < 4; ++kk) {
          const int ko = kk * 16 + 8 * (lane >> 5);
          bf16x8 a = *(const bf16x8*)(sXT + (sx0 + (lane & 31)) * 72 + ko);
#pragma unroll
          for (int j = 0; j < 2; ++j) {
            bf16x8 bb = *(const bf16x8*)(sKT + (sk0 + j * 32 + (lane & 31)) * 72 + ko);
            accS[j] = mfma32(a, bb, accS[j]);
          }
        }
#pragma unroll
        for (int j = 0; j < 2; ++j)
#pragma unroll
          for (int r = 0; r < 16; ++r) sST[(sx0 + acc_row(r, lane)) * QS + sk0 + j * 32 + (lane & 31)] = f2bf(accS[j][r]);
        if (MLSTM && tid < 64) {
          float nn = sN[tid] * eb;
          for (int s = 0; s < 64; ++s) nn += bf2f(sKT[tid * 72 + s]);
          sN[tid] = nn;
        }
      }
      __syncthreads();
    }
  }
}

DEV void st_finish_l0(const Params& P, int row) {
  const int lane = threadIdx.x & 63;
  bf16_t* hb = (bf16_t*)(P.ws + OFF_HBUF) + (size_t)row * 1024;
  const bf16_t* yb = (const bf16_t*)(P.ws + OFF_R2L0) + (size_t)row * 1024;
  const bf16_t* pr = (const bf16_t*)(P.ws + OFF_PROJ) + (size_t)row * EVC;
  const int ch = lane * 8;
  float h0[8], h1[8], o[8], f1[8];
  unpack8(*(const u32x4*)(hb + ch), h0);
  unpack8(*(const u32x4*)(hb + 512 + ch), h1);
  unpack8(*(const u32x4*)(pr + 1024 + ch), o);
  float ss = 0.f;
#pragma unroll
  for (int j = 0; j < 8; ++j) { h0[j] += h1[j]; ss += h0[j] * h0[j]; }
  ss += wshfl_xor(ss, 1); ss += wshfl_xor(ss, 2); ss += wshfl_xor(ss, 4); ss += wshfl_xor(ss, 8);
  float rstd = rsqrtf(ss * (1.f / 128.f) + 1e-6f);
#pragma unroll
  for (int j = 0; j < 8; ++j) f1[j] = h0[j] * rstd * P.in[I_MNORM][ch + j] * sigmoidf_(o[j]);
  float y0[8], y1[8], z[8], f2[8];
  unpack8(*(const u32x4*)(yb + ch), y0);
  unpack8(*(const u32x4*)(yb + 512 + ch), y1);
  unpack8(*(const u32x4*)(pr + 1552 + ch), z);
  float s2 = 0.f;
#pragma unroll
  for (int j = 0; j < 8; ++j) { y0[j] = (y0[j] + y1[j]) * siluf_(z[j]); s2 += y0[j] * y0[j]; }
  s2 = wave_sum(s2);
  float rstd2 = rsqrtf(s2 * (1.f / 512.f) + 1e-6f);
#pragma unroll
  for (int j = 0; j < 8; ++j) f2[j] = y0[j] * rstd2 * P.in[I_SNORM][ch + j];
  *(u32x4*)(hb + ch) = pack8(f1);
  *(u32x4*)(hb + 512 + ch) = pack8(f2);
}

DEV float mixval(const bf16_t* __restrict__ proj, int row, int c, const float* __restrict__ mu) {
  float self = bf2f(proj[(size_t)row * ODC + c]);
  int nrow = -1;
  if (row < NCTX) {
    int pos = row % CTXL;
    if (c < 896) { if (pos > 0) nrow = row - 1; }
    else { if (pos < CTXL - 1) nrow = row + 1; }
  } else {
    int pos = (row - NCTX) % SEQ;
    int gx = pos % GW, gy = pos / GW, q = c / 448;
    if (q == 0) { if (gx > 0) nrow = row - 1; }
    else if (q == 1) { if (gx < GW - 1) nrow = row + 1; }
    else if (q == 2) { if (gy > 0) nrow = row - GW; }
    else { if (gy < SEQ / GW - 1) nrow = row + GW; }
  }
  float nb = nrow >= 0 ? bf2f(proj[(size_t)nrow * ODC + c]) : 0.f;
  return self + mu[c] * (nb - self);
}

DEV void st_lora_act(const Params& P, int row) {
  const int lane = threadIdx.x & 63;
  const bf16_t* proj = (const bf16_t*)(P.ws + OFF_PROJ);
  bf16_t* hb = (bf16_t*)(P.ws + OFF_HBUF) + (size_t)row * 1024;
  float v[4];
#pragma unroll
  for (int j = 0; j < 4; ++j) {
    int c = lane * 4 + j;
    float x = mixval(proj, row, 1536 + c, P.in[I_MU]);
    v[j] = c < 64 ? tanhf(x) : (c < 128 ? x : sigmoidf_(x));
  }
  u32x2 pk; pk.x = pack2(v[0], v[1]); pk.y = pack2(v[2], v[3]);
  *(u32x2*)(hb + lane * 4) = pk;
}

DEV void st_rwkv_stream(const Params& P, int sid, unsigned char* smem) {
  const int tid = threadIdx.x, lane = tid & 63, wave = tid >> 6;
  const int d = sid & 1, h = (sid >> 1) & 7, b = sid >> 4;
  float* sR = (float*)smem;
  float* sW = sR + 2048;
  float* sKk = sW + 2048;
  float* sV = sKk + 2048;
  float* sA = sV + 2048;
  float* sBb = sA + 2048;
  float* sY = sBb + 2048;
  int* sRow = (int*)(sY + 2048);
  const bf16_t* proj = (const bf16_t*)(P.ws + OFF_PROJ);
  const bf16_t* lora = (const bf16_t*)(P.ws + OFF_LORA);
  bf16_t* yout = (bf16_t*)(P.ws + OFF_HBUF);
  const float* mu = P.in[I_MU];
  const int vrow = tid >> 2, j4 = tid & 3;
  float S[16];
#pragma unroll
  for (int i = 0; i < 16; ++i) S[i] = 0.f;
  const float kkw = P.in[I_KK][h * 64 + lane], kaw = P.in[I_KA][h * 64 + lane];
  for (int seg = 0; seg < 2; ++seg) {
    const int row0 = seg == 0 ? b * CTXL : NCTX + b * SEQ;
    const int len = seg == 0 ? CTXL : SEQ;
    for (int it = 0; it < len / 32; ++it) {
      __syncthreads();
      for (int s = wave; s < 32; s += 4) {
        int p = it * 32 + s, pos = d ? len - 1 - p : p, row = row0 + pos;
        int c = h * 64 + lane;
        float r = mixval(proj, row, c, mu);
        float k = mixval(proj, row, 512 + c, mu);
        float v = mixval(proj, row, 1024 + c, mu);
        float kk = k * kkw;
        float ss = wave_sum(kk * kk);
        kk *= rsqrtf(ss + 1e-12f);
        float lw = bf2f(lora[((size_t)d * NTOK + row) * 512 + c]);
        float la = bf2f(lora[((size_t)(2 + d) * NTOK + row) * 512 + c]);
        float w = expf(-0.6065306597126334f * sigmoidf_(lw));
        float a = sigmoidf_(la);
        float kt = k * (1.f + (a - 1.f) * kaw);
        sR[s * 64 + lane] = r; sW[s * 64 + lane] = w; sKk[s * 64 + lane] = kt; sV[s * 64 + lane] = v;
        sA[s * 64 + lane] = -kk; sBb[s * 64 + lane] = kk * a;
        if (lane == 0) sRow[s] = row;
      }
      __syncthreads();
      for (int s = 0; s < 32; ++s) {
        const float* pa = sA + s * 64 + j4 * 16;
        const float* pw = sW + s * 64 + j4 * 16;
        const float* pk = sKk + s * 64 + j4 * 16;
        const float* pb = sBb + s * 64 + j4 * 16;
        const float* pr = sR + s * 64 + j4 * 16;
        const float vv = sV[s * 64 + vrow];
        float sa = 0.f;
#pragma unroll
        for (int i = 0; i < 16; ++i) sa += S[i] * pa[i];
        sa += wshfl_xor(sa, 1); sa += wshfl_xor(sa, 2);
        float y = 0.f;
#pragma unroll
        for (int i = 0; i < 16; ++i) { S[i] = S[i] * pw[i] + sa * pb[i] + vv * pk[i]; y += S[i] * pr[i]; }
        y += wshfl_xor(y, 1); y += wshfl_xor(y, 2);
        if (j4 == 0) sY[s * 64 + vrow] = y;
      }
      __syncthreads();
      for (int i = tid; i < 2048; i += 256) {
        int s = i >> 6, c = i & 63;
        yout[(size_t)sRow[s] * 1024 + d * 512 + h * 64 + c] = f2bf(sY[i]);
      }
    }
  }
}

DEV void st_lru_stream(const Params& P, int sid, unsigned char* smem) {
  const int tid = threadIdx.x, lane = tid & 63, wave = tid >> 6;
  const int d = sid & 1, blk = (sid >> 1) & 7, b = sid >> 4;
  float* sXc = (float*)smem;
  float* sAc = sXc + 4096;
  float* sBc = sAc + 4096;
  float* sU = sBc + 4096;
  bf16_t* sAop = (bf16_t*)(sU + 4096);
  int* sRow = (int*)(sAop + 64 * 72);
  const bf16_t* proj = (const bf16_t*)(P.ws + OFF_PROJ);
  bf16_t* uout = (bf16_t*)(P.ws + OFF_LORA) + (size_t)d * NTOK * 512;
  const bf16_t* lruT = (const bf16_t*)(P.ws + OFF_LRUT) + (size_t)(d * 8 + blk) * 128 * 64;
  const float* cw = P.in[I_LCONVW];
  const float* cb = P.in[I_LCONVB];
  const int tr = (wave >> 1) * 32, nc0 = (wave & 1) * 64;
  bf16x8 bfrag[2][4];
#pragma unroll
  for (int j = 0; j < 2; ++j)
#pragma unroll
    for (int kk = 0; kk < 4; ++kk)
      bfrag[j][kk] = *(const bf16x8*)(lruT + (nc0 + j * 32 + (lane & 31)) * 64 + kk * 16 + 8 * (lane >> 5));
  float ebias[2], esp[2];
#pragma unroll
  for (int j = 0; j < 2; ++j) {
    int e = nc0 + j * 32 + (lane & 31);
    int ch = blk * 64 + (e & 63);
    ebias[j] = e < 64 ? P.in[I_BA][d * 512 + ch] : P.in[I_BI][d * 512 + ch];
    esp[j] = softplusf_(-P.in[I_LAM][d * 512 + ch]);
  }
  float hstate = 0.f;
  for (int seg = 0; seg < 2; ++seg) {
    const int row0 = seg == 0 ? b * CTXL : NCTX + b * SEQ;
    const int len = seg == 0 ? CTXL : SEQ;
    for (int ck = 0; ck < len / 64; ++ck) {
      __syncthreads();
      if (tid < 64) { int p = ck * 64 + tid; sRow[tid] = row0 + (d ? len - 1 - p : p); }
#pragma unroll
      for (int i = 0; i < 2; ++i) {
        int c = tid + i * 256, r = c >> 3, cc = (c & 7) * 8;
        int p = ck * 64 + r, pos = d ? len - 1 - p : p;
        int ch = blk * 64 + cc;
        float o[8];
#pragma unroll
        for (int j = 0; j < 8; ++j) o[j] = cb[ch + j];
#pragma unroll
        for (int tap = 0; tap < 4; ++tap) {
          int pp = pos + tap - 2;
          if (pp >= 0 && pp < len) {
            float x[8];
            unpack8(*(const u32x4*)(proj + (size_t)(row0 + pp) * ODC + 2304 + ch), x);
#pragma unroll
            for (int j = 0; j < 8; ++j) o[j] += cw[tap * 512 + ch + j] * x[j];
          }
        }
#pragma unroll
        for (int j = 0; j < 8; ++j) sXc[r * 64 + cc + j] = o[j];
        *(u32x4*)(sAop + r * 72 + cc) = pack8(o);
      }
      __syncthreads();
      f32x16 acc[2];
#pragma unroll
      for (int j = 0; j < 2; ++j)
#pragma unroll
        for (int r = 0; r < 16; ++r) acc[j][r] = 0.f;
#pragma unroll
      for (int kk = 0; kk < 4; ++kk) {
        bf16x8 a = *(const bf16x8*)(sAop + (tr + (lane & 31)) * 72 + kk * 16 + 8 * (lane >> 5));
#pragma unroll
        for (int j = 0; j < 2; ++j) acc[j] = mfma32(a, bfrag[j][kk], acc[j]);
      }
#pragma unroll
      for (int j = 0; j < 2; ++j)
#pragma unroll
        for (int r = 0; r < 16; ++r) {
          int t = tr + acc_row(r, lane);
          int e = nc0 + j * 32 + (lane & 31);
          float g = sigmoidf_(acc[j][r] + ebias[j]);
          if (e < 64) sAc[t * 64 + e] = -8.f * g * esp[j];
          else sBc[t * 64 + (e - 64)] = g * sXc[t * 64 + (e - 64)];
        }
      __syncthreads();
      if (wave == 0) {
        for (int t = 0; t < 64; ++t) {
          float la = sAc[t * 64 + lane];
          float a = expf(la);
          float bb = sqrtf(-expm1f(2.f * la)) * sBc[t * 64 + lane];
          hstate = a * hstate + bb;
          sU[t * 64 + lane] = hstate;
        }
      }
      __syncthreads();
      for (int i = tid; i < 4096; i += 256) {
        int t = i >> 6, c = i & 63;
        uout[(size_t)sRow[t] * 512 + blk * 64 + c] = f2bf(sU[i]);
      }
    }
  }
}

DEV void st_finish_l1(const Params& P, int row) {
  const int lane = threadIdx.x & 63;
  bf16_t* hb = (bf16_t*)(P.ws + OFF_HBUF) + (size_t)row * 1024;
  const bf16_t* proj = (const bf16_t*)(P.ws + OFF_PROJ);
  const bf16_t* lora = (const bf16_t*)(P.ws + OFF_LORA);
  const float* mu = P.in[I_MU];
  const int ch = lane * 8;
  float y0[8], y1[8];
  unpack8(*(const u32x4*)(hb + ch), y0);
  unpack8(*(const u32x4*)(hb + 512 + ch), y1);
  float sm = 0.f;
#pragma unroll
  for (int j = 0; j < 8; ++j) { y0[j] += y1[j]; sm += y0[j]; }
  sm += wshfl_xor(sm, 1); sm += wshfl_xor(sm, 2); sm += wshfl_xor(sm, 4);
  const float mean = sm * (1.f / 64.f);
  float sv = 0.f;
#pragma unroll
  for (int j = 0; j < 8; ++j) { float dlt = y0[j] - mean; sv += dlt * dlt; }
  sv += wshfl_xor(sv, 1); sv += wshfl_xor(sv, 2); sv += wshfl_xor(sv, 4);
  const float rstd = rsqrtf(sv * (1.f / 64.f) + 64e-5f);
  float a0[8], a1[8], g[8], u0[8], u1[8], gb[8];
  unpack8(*(const u32x4*)(lora + ((size_t)2 * NTOK + row) * 512 + ch), a0);
  unpack8(*(const u32x4*)(lora + ((size_t)3 * NTOK + row) * 512 + ch), a1);
  unpack8(*(const u32x4*)(lora + ((size_t)4 * NTOK + row) * 512 + ch), g);
  unpack8(*(const u32x4*)(lora + ((size_t)0 * NTOK + row) * 512 + ch), u0);
  unpack8(*(const u32x4*)(lora + ((size_t)1 * NTOK + row) * 512 + ch), u1);
  unpack8(*(const u32x4*)(proj + (size_t)row * ODC + 1792 + ch), gb);
  float rv[8], vv[8];
  float sdot = 0.f;
#pragma unroll
  for (int j = 0; j < 8; ++j) {
    float r = mixval(proj, row, ch + j, mu);
    float k = mixval(proj, row, 512 + ch + j, mu);
    vv[j] = mixval(proj, row, 1024 + ch + j, mu);
    float am = 0.5f * (sigmoidf_(a0[j]) + sigmoidf_(a1[j]));
    float kb = k * (1.f + (am - 1.f) * P.in[I_KA][ch + j]);
    sdot += r * kb * P.in[I_RK][ch + j];
    rv[j] = r;
  }
  sdot += wshfl_xor(sdot, 1); sdot += wshfl_xor(sdot, 2); sdot += wshfl_xor(sdot, 4);
  float f1[8], f2[8];
#pragma unroll
  for (int j = 0; j < 8; ++j) {
    float yn = (y0[j] - mean) * rstd * P.in[I_LNW][ch + j] + P.in[I_LNB][ch + j];
    yn += sdot * vv[j];
    f1[j] = yn * g[j];
    f2[j] = (u0[j] + u1[j]) * geluf_(gb[j]);
  }
  *(u32x4*)(hb + ch) = pack8(f1);
  *(u32x4*)(hb + 512 + ch) = pack8(f2);
}

DEV void topk_insert(float x, int xi, float* v, int* id) {
#pragma unroll
  for (int j = 0; j < 16; ++j) {
    bool gt = x > v[j];
    float tv = gt ? v[j] : x; int ti = gt ? id[j] : xi;
    v[j] = gt ? x : v[j]; id[j] = gt ? xi : id[j];
    x = tv; xi = ti;
  }
}

DEV void st_peer_topk(const Params& P, int layer, int tile, int h, unsigned char* smem) {
  const int tid = threadIdx.x;
  const bf16_t* q = (const bf16_t*)(P.ws + OFF_Q);
  const bf16_t* keys = (const bf16_t*)(P.ws + OFF_KEYS) + (size_t)(layer * 8 + h) * 2 * 128 * 128;
  float* sS = (float*)smem;
  const int m0 = tile * 128;
  float sv[2][16]; int si[2][16];
#pragma unroll
  for (int p = 0; p < 2; ++p) {
    EpiScoreLds epi{sS, m0};
    gemm_tile_128<true>(q + (h * 2 + p) * 128, 2048, NTOK, keys + p * 128 * 128, 128, 128, 128, m0, 0, epi, smem);
    __syncthreads();
#pragma unroll
    for (int j = 0; j < 16; ++j) { sv[p][j] = -3.0e38f; si[p][j] = 0; }
    if (tid < 128) {
      for (int key = 0; key < 128; ++key) {
        float x = sS[tid * 129 + key];
        if (x > sv[p][15]) topk_insert(x, key, sv[p], si[p]);
      }
    }
    __syncthreads();
  }
  if (tid < 128) {
    float best[16]; int bidx[16];
#pragma unroll
    for (int j = 0; j < 16; ++j) { best[j] = -3.0e38f; bidx[j] = 0; }
#pragma unroll
    for (int i = 0; i < 16; ++i)
#pragma unroll
      for (int j = 0; j < 16; ++j)
        if ((i + 1) * (j + 1) <= 16) {
          float x = sv[0][i] + sv[1][j];
          if (x > best[15]) topk_insert(x, si[0][i] * 128 + si[1][j], best, bidx);
        }
    float e[16], sum = 0.f;
#pragma unroll
    for (int j = 0; j < 16; ++j) { e[j] = expf(best[j] - best[0]); sum += e[j]; }
    const float inv = 1.f / sum;
    int* pidx = (int*)(P.ws + OFF_PIDX) + (size_t)(m0 + tid) * 128 + h * 16;
    float* pg = (float*)(P.ws + OFF_PGATE) + (size_t)(m0 + tid) * 128 + h * 16;
#pragma unroll
    for (int j = 0; j < 16; ++j) { pidx[j] = bidx[j]; pg[j] = e[j] * inv; }
  }
}

DEV void st_peer_experts(const Params& P, int layer, int row) {
  const int lane = threadIdx.x & 63;
  const bf16_t* xb = (const bf16_t*)(P.ws + OFF_HBUF) + (size_t)row * 1024;
  const bf16_t* U = (const bf16_t*)(P.ws + OFF_PU);
  const bf16_t* V = (const bf16_t*)(P.ws + OFF_PV);
  const int* pidx = (const int*)(P.ws + OFF_PIDX) + (size_t)row * 128;
  const float* pg = (const float*)(P.ws + OFF_PGATE) + (size_t)row * 128;
  float x[16], acc[16];
  unpack8(*(const u32x4*)(xb + lane * 8), x);
  unpack8(*(const u32x4*)(xb + 512 + lane * 8), x + 8);
#pragma unroll
  for (int j = 0; j < 16; ++j) acc[j] = 0.f;
  for (int k0 = 0; k0 < 128; k0 += 4) {
    int idx[4]; float gt[4]; u32x4 u0[4], u1[4], v0[4], v1[4];
#pragma unroll
    for (int i = 0; i < 4; ++i) { idx[i] = pidx[k0 + i]; gt[i] = pg[k0 + i]; }
#pragma unroll
    for (int i = 0; i < 4; ++i) {
      const bf16_t* ur = U + (size_t)idx[i] * 1024;
      const bf16_t* vr = V + (size_t)idx[i] * 1024;
      u0[i] = *(const u32x4*)(ur + lane * 8); u1[i] = *(const u32x4*)(ur + 512 + lane * 8);
      v0[i] = *(const u32x4*)(vr + lane * 8); v1[i] = *(const u32x4*)(vr + 512 + lane * 8);
    }
#pragma unroll
    for (int i = 0; i < 4; ++i) {
      float uf[16];
      unpack8(u0[i], uf); unpack8(u1[i], uf + 8);
      float dot = 0.f;
#pragma unroll
      for (int j = 0; j < 16; ++j) dot += x[j] * uf[j];
      dot = wave_sum(dot);
      float coef = gt[i] * geluf_(dot);
      float vf[16];
      unpack8(v0[i], vf); unpack8(v1[i], vf + 8);
#pragma unroll
      for (int j = 0; j < 16; ++j) acc[j] += coef * vf[j];
    }
  }
  float* xr = row < NCTX ? (float*)(P.ws + OFF_CTXRES) + (size_t)row * 1024 : P.out + (size_t)(row - NCTX) * 1024;
  const float* g2 = (const float*)(P.ws + OFF_MODV) + ((size_t)layer * 3 + mod_row(row)) * 6144 + 5 * 1024;
  float o[16];
  float ss = 0.f;
#pragma unroll
  for (int hh = 0; hh < 2; ++hh) {
    int c = hh * 512 + lane * 8;
    f32x4 a = *(const f32x4*)(xr + c), bq = *(const f32x4*)(xr + c + 4);
    f32x4 ga = *(const f32x4*)(g2 + c), gb = *(const f32x4*)(g2 + c + 4);
    o[hh * 8 + 0] = a.x + ga.x * acc[hh * 8 + 0]; o[hh * 8 + 1] = a.y + ga.y * acc[hh * 8 + 1];
    o[hh * 8 + 2] = a.z + ga.z * acc[hh * 8 + 2]; o[hh * 8 + 3] = a.w + ga.w * acc[hh * 8 + 3];
    o[hh * 8 + 4] = bq.x + gb.x * acc[hh * 8 + 4]; o[hh * 8 + 5] = bq.y + gb.y * acc[hh * 8 + 5];
    o[hh * 8 + 6] = bq.z + gb.z * acc[hh * 8 + 6]; o[hh * 8 + 7] = bq.w + gb.w * acc[hh * 8 + 7];
  }
  if (layer == 1) {
#pragma unroll
    for (int j = 0; j < 16; ++j) ss += o[j] * o[j];
    ss = wave_sum(ss);
    float rstd = rsqrtf(ss * (1.f / 1024.f) + 1e-6f);
#pragma unroll
    for (int hh = 0; hh < 2; ++hh)
#pragma unroll
      for (int j = 0; j < 8; ++j) o[hh * 8 + j] *= rstd * P.in[I_FNORM][hh * 512 + lane * 8 + j];
  }
#pragma unroll
  for (int hh = 0; hh < 2; ++hh) {
    int c = hh * 512 + lane * 8;
    f32x4 a = {o[hh * 8 + 0], o[hh * 8 + 1], o[hh * 8 + 2], o[hh * 8 + 3]};
    f32x4 bq = {o[hh * 8 + 4], o[hh * 8 + 5], o[hh * 8 + 6], o[hh * 8 + 7]};
    *(f32x4*)(xr + c) = a; *(f32x4*)(xr + c + 4) = bq;
  }
}

constexpr int NPHASE = 22;

template <int ph>
DEV void run_phase(const Params& P, unsigned char* smem) {
  const int bid = blockIdx.x, nb = gridDim.x;
  const int wave = threadIdx.x >> 6;
  unsigned char* ws = P.ws;
  const int layer = ph >= 10 ? 1 : 0;
  const float* modv_l = (const float*)(ws + OFF_MODV) + (size_t)layer * 3 * 6144;
  switch (ph) {
    case 0:
      for (int t = bid; t < NPREP; t += nb) st_prep(P, t, smem);
      break;
    case 1: case 10:
      for (int t = bid; t < NTOK / 4; t += nb) st_normmod(P, layer, 0, t * 4 + wave);
      break;
    case 2: {
      EpiProjL0 epi{(bf16_t*)(ws + OFF_PROJ), (float*)(ws + OFF_GATES)};
      for (int t = bid; t < NTILE * 25; t += nb)
        gemm_tile_128<false>((const bf16_t*)(ws + OFF_HBUF), 1024, NTOK, (const bf16_t*)(ws + OFF_WEVIN), 1024, EVC, 1024,
                             (t / 25) * 128, (t % 25) * 128, epi, smem);
    } break;
    case 3:
      if (bid < 48) {
        if (bid < 16) st_linattn_stream<true>(P, bid, smem);
        else st_linattn_stream<false>(P, bid - 16, smem);
      } else {
        for (int t = bid - 48; t < NPCONV; t += nb - 48) st_peer_conv(P, 0, t);
      }
      break;
    case 4:
      for (int t = bid; t < NTOK / 4; t += nb) st_finish_l0(P, t * 4 + wave);
      break;
    case 5: case 17: {
      EpiOutProj epi{layer == 0 ? P.in[I_X] : P.out, P.in[I_CTX], P.out, (float*)(ws + OFF_CTXRES), modv_l};
      const bf16_t* Wt = (const bf16_t*)(ws + (layer == 0 ? OFF_WEVOUT : OFF_WODOUT));
      const int t0 = layer == 0 ? 0 : CTILE * 8;
      for (int t = t0 + bid; t < NTILE * 8; t += nb)
        gemm_tile_128<false>((const bf16_t*)(ws + OFF_HBUF), 1024, NTOK, Wt, 1024, 1024, 1024, (t / 8) * 128, (t % 8) * 128, epi, smem);
    } break;
    case 6: case 18: {
      const int r0 = layer == 0 ? 0 : NCTX / 4;
      for (int t = r0 + bid; t < NTOK / 4; t += nb) st_normmod(P, layer, 1, t * 4 + wave);
    } break;
    case 7: case 19: {
      EpiStoreBf epi{(bf16_t*)(ws + OFF_Q), 2048};
      const bf16_t* Wt = (const bf16_t*)(ws + OFF_WQ) + (size_t)layer * 2048 * 1024;
      const int t0 = layer == 0 ? 0 : CTILE * 16;
      for (int t = t0 + bid; t < NTILE * 16; t += nb)
        gemm_tile_128<false>((const bf16_t*)(ws + OFF_HBUF), 1024, NTOK, Wt, 1024, 2048, 1024, (t / 16) * 128, (t % 16) * 128, epi, smem);
    } break;
    case 8: case 20: {
      const int t0 = layer == 0 ? 0 : CTILE * 8;
      for (int t = t0 + bid; t < NTILE * 8; t += nb) st_peer_topk(P, layer, t / 8, t % 8, smem);
    } break;
    case 9: case 21: {
      const int r0 = layer == 0 ? 0 : NCTX / 4;
      for (int t = r0 + bid; t < NTOK / 4; t += nb) st_peer_experts(P, layer, t * 4 + wave);
    } break;
    case 11: {
      EpiStoreBf epi{(bf16_t*)(ws + OFF_PROJ), ODC};
      for (int t = bid; t < NTILE * 22; t += nb)
        gemm_tile_128<false>((const bf16_t*)(ws + OFF_HBUF), 1024, NTOK, (const bf16_t*)(ws + OFF_WODIN), 1024, ODC, 1024,
                             (t / 22) * 128, (t % 22) * 128, epi, smem);
    } break;
    case 12:
      for (int t = bid; t < NTOK / 4; t += nb) st_lora_act(P, t * 4 + wave);
      break;
    case 13:
      for (int t = bid; t < NTILE * 20; t += nb) {
        int job = t / (NTILE * 4), tt = t % (NTILE * 4);
        int mt = tt / 4, nt = tt % 4;
        bf16_t* dst = (bf16_t*)(ws + OFF_LORA) + (size_t)job * NTOK * 512;
        const bf16_t* A = (const bf16_t*)(ws + OFF_HBUF) + (job < 2 ? 0 : (job < 4 ? 64 : 128));
        const bf16_t* Bt = job < 2 ? (const bf16_t*)(ws + OFF_WUP) + (size_t)job * 512 * 64
                         : job < 4 ? (const bf16_t*)(ws + OFF_AUP) + (size_t)(job - 2) * 512 * 64
                                   : (const bf16_t*)(ws + OFF_GUP);
        const float* bias = job < 2 ? P.in[I_W0] + job * 512 : (job < 4 ? P.in[I_A0] + (job - 2) * 512 : nullptr);
        const int K = job < 4 ? 64 : 128;
        EpiStoreBfBias epi{dst, 512, bias};
        gemm_tile_128<false>(A, 1024, NTOK, Bt, K, 512, K, mt * 128, nt * 128, epi, smem);
      }
      break;
    case 14:
      if (bid < 32) st_rwkv_stream(P, bid, smem);
      else for (int t = bid - 32; t < NPCONV; t += nb - 32) st_peer_conv(P, 1, t);
      break;
    case 15:
      if (bid < 32) st_lru_stream(P, bid, smem);
      break;
    case 16:
      for (int t = bid; t < NTOK / 4; t += nb) st_finish_l1(P, t * 4 + wave);
      break;
    default: break;
  }
}

#ifndef CPU_EMU
#if MULTI_LAUNCH
#define RUN_PH(n) if (ph_lo <= n && n < ph_hi) { run_phase<n>(P, smem_raw); }
#else
#define RUN_PH(n) if (ph_lo <= n && n < ph_hi) { run_phase<n>(P, smem_raw); if (n + 1 < ph_hi) cg::this_grid().sync(); }
#endif
__global__ void __launch_bounds__(256, 2) mega_kernel(Params P, int ph_lo, int ph_hi) {
  SMEM_DECL;
  RUN_PH(0) RUN_PH(1) RUN_PH(2) RUN_PH(3) RUN_PH(4) RUN_PH(5) RUN_PH(6) RUN_PH(7) RUN_PH(8) RUN_PH(9) RUN_PH(10)
  RUN_PH(11) RUN_PH(12) RUN_PH(13) RUN_PH(14) RUN_PH(15) RUN_PH(16) RUN_PH(17) RUN_PH(18) RUN_PH(19) RUN_PH(20) RUN_PH(21)
}

extern "C" void kernel_launch(void* const* d_in, const int* in_sizes, int n_in, void* d_out, int out_size, void* d_ws,
                              size_t ws_size, hipStream_t stream) {
  Params P{};
  for (int i = 0; i < N_IN; ++i) P.in[i] = (const float*)d_in[i];
  P.out = (float*)d_out;
  P.ws = (unsigned char*)d_ws;
  if (ws_size < WS_NEEDED) { fprintf(stderr, "workspace too small: %zu < %zu\n", ws_size, (size_t)WS_NEEDED); return; }
#if MULTI_LAUNCH
  for (int ph = 0; ph < NPHASE; ++ph) mega_kernel<<<dim3(1024), dim3(256), 0, stream>>>(P, ph, ph + 1);
#else
  static int grid_blocks = 0;
  if (!grid_blocks) {
    int dev = 0, cus = 0, per_cu = 0;
    hipGetDevice(&dev);
    hipDeviceGetAttribute(&cus, hipDeviceAttributeMultiprocessorCount, dev);
    hipOccupancyMaxActiveBlocksPerMultiprocessor(&per_cu, mega_kernel, 256, 0);
    if (per_cu > 2) per_cu = 2;
    grid_blocks = cus * per_cu;
  }
  int lo = 0, hi = NPHASE;
  void* args[] = {&P, &lo, &hi};
  hipError_t e = hipLaunchCooperativeKernel((void*)mega_kernel, dim3(grid_blocks), dim3(256), args, 0, stream);
  if (e != hipSuccess) fprintf(stderr, "cooperative launch failed: %s (grid %d)\n", hipGetErrorString(e), grid_blocks);
#endif
}
#endif
```

```cpp
#ifdef CPU_EMU
#include "emu.h"
#else
#include <hip/hip_runtime.h>
#include <hip/hip_cooperative_groups.h>
#include <cstdio>
namespace cg = cooperative_groups;
#define DEV __device__ __forceinline__
#define DEVM __device__ __forceinline__
#define OPAQUE(x) asm volatile("" : "+v"(x))
#endif

#ifndef SEQ_LEN
#define SEQ_LEN 16384
#endif
#ifndef CTX_LEN
#define CTX_LEN 256
#endif
#ifndef GRID_W_
#define GRID_W_ 64
#endif
#ifndef MULTI_LAUNCH
#define MULTI_LAUNCH 0
#endif

typedef unsigned short bf16_t;
typedef __attribute__((ext_vector_type(8))) short bf16x8;
typedef __attribute__((ext_vector_type(16))) float f32x16;
typedef __attribute__((ext_vector_type(4))) unsigned u32x4;
typedef __attribute__((ext_vector_type(2))) unsigned u32x2;
typedef __attribute__((ext_vector_type(4))) float f32x4;

constexpr int D = 1024, NB = 2, SEQ = SEQ_LEN, CTXL = CTX_LEN, GW = GRID_W_;
constexpr int NCTX = NB * CTXL, NLAT = NB * SEQ, NTOK = NCTX + NLAT;
constexpr int EVC = 3104, ODC = 2816;
constexpr int NEXP = 16384;
constexpr int NTILE = NTOK / 128, CTILE = NCTX / 128;
static_assert(NTOK % 128 == 0 && NCTX % 128 == 0, "tiles");
static_assert(CTXL % 64 == 0 && SEQ % 64 == 0 && SEQ % GW == 0, "chunks");

constexpr size_t al256(size_t x) { return (x + 255) & ~(size_t)255; }
constexpr size_t OFF_MODV = 0;
constexpr size_t OFF_CTXRES = OFF_MODV + al256(2 * 3 * 6144 * 4);
constexpr size_t OFF_GATES = OFF_CTXRES + al256((size_t)NCTX * 1024 * 4);
constexpr size_t OFF_WEVIN = OFF_GATES + al256((size_t)NTOK * 32 * 4);
constexpr size_t OFF_WEVOUT = OFF_WEVIN + al256((size_t)EVC * 1024 * 2);
constexpr size_t OFF_WODIN = OFF_WEVOUT + al256((size_t)1024 * 1024 * 2);
constexpr size_t OFF_WODOUT = OFF_WODIN + al256((size_t)ODC * 1024 * 2);
constexpr size_t OFF_WQ = OFF_WODOUT + al256((size_t)1024 * 1024 * 2);
constexpr size_t OFF_KEYS = OFF_WQ + al256((size_t)2 * 2048 * 1024 * 2);
constexpr size_t OFF_WUP = OFF_KEYS + al256((size_t)2 * 8 * 2 * 128 * 128 * 2);
constexpr size_t OFF_AUP = OFF_WUP + al256((size_t)2 * 512 * 64 * 2);
constexpr size_t OFF_GUP = OFF_AUP + al256((size_t)2 * 512 * 64 * 2);
constexpr size_t OFF_LRUT = OFF_GUP + al256((size_t)512 * 128 * 2);
constexpr size_t OFF_PU = OFF_LRUT + al256((size_t)2 * 8 * 128 * 64 * 2);
constexpr size_t OFF_PV = OFF_PU + al256((size_t)NEXP * 1024 * 2);
constexpr size_t OFF_HBUF = OFF_PV + al256((size_t)NEXP * 1024 * 2);
constexpr size_t OFF_PR = OFF_HBUF + al256((size_t)NTOK * 1024 * 2);
constexpr size_t PR_BYTES = (size_t)NTOK * 5376 * 2;
constexpr size_t WS_NEEDED = OFF_PR + PR_BYTES;
static_assert(WS_NEEDED <= (size_t)512 * 1024 * 1024, "workspace too large");
constexpr size_t OFF_PROJ = OFF_PR;
constexpr size_t OFF_R2L0 = OFF_PR + (size_t)NTOK * EVC * 2;
constexpr size_t OFF_LORA = OFF_PR + (size_t)NTOK * ODC * 2;
constexpr size_t OFF_Q = OFF_PR;
constexpr size_t OFF_PIDX = OFF_PR + (size_t)NTOK * 2048 * 2;
constexpr size_t OFF_PGATE = OFF_PIDX + (size_t)NTOK * 128 * 4;
static_assert(OFF_PGATE + (size_t)NTOK * 128 * 4 <= OFF_PR + PR_BYTES, "picks");

enum {
  I_X = 0, I_C, I_CTX, I_CCTX, I_MODW, I_MODB, I_NORM1, I_NORM2, I_WQ, I_KEYS, I_PU, I_PV,
  I_EVWIN, I_EVWOUT, I_IBIAS, I_FBIAS, I_MNORM, I_SCONVW, I_SCONVB, I_DTBIAS, I_ALOG, I_DSKIP, I_SNORM,
  I_ODWIN, I_ODWOUT, I_MU, I_W0, I_WUP, I_A0, I_AUP, I_GUP, I_KK, I_KA, I_RK, I_LNW, I_LNB,
  I_LCONVW, I_LCONVB, I_LAM, I_WA, I_BA, I_WI, I_BI, I_FNORM, N_IN
};

struct Params {
  const float* in[N_IN];
  float* out;
  unsigned char* ws;
};

constexpr int SMEM_BYTES = 80 * 1024;
#ifdef CPU_EMU
#define SMEM_DECL static thread_local __attribute__((aligned(16))) unsigned char smem_raw[SMEM_BYTES]
#else
#define SMEM_DECL __shared__ __attribute__((aligned(16))) unsigned char smem_raw[SMEM_BYTES]
#endif

DEV float bf2f(bf16_t v) { unsigned u = ((unsigned)v) << 16; float f; __builtin_memcpy(&f, &u, 4); return f; }
DEV bf16_t f2bf(float f) { unsigned u; __builtin_memcpy(&u, &f, 4); u += 0x7fffu + ((u >> 16) & 1u); return (bf16_t)(u >> 16); }
DEV unsigned pack2(float a, float b) { return (unsigned)f2bf(a) | ((unsigned)f2bf(b) << 16); }
DEV void unpack8(const u32x4& r, float* o) {
  unsigned w[4] = {r.x, r.y, r.z, r.w};
#pragma unroll
  for (int i = 0; i < 4; ++i) { unsigned lo = w[i] << 16, hi = w[i] & 0xffff0000u; __builtin_memcpy(&o[2 * i], &lo, 4); __builtin_memcpy(&o[2 * i + 1], &hi, 4); }
}
DEV u32x4 pack8(const float* o) { u32x4 r; r.x = pack2(o[0], o[1]); r.y = pack2(o[2], o[3]); r.z = pack2(o[4], o[5]); r.w = pack2(o[6], o[7]); return r; }
DEV float sigmoidf_(float x) { return 1.f / (1.f + expf(-x)); }
DEV float siluf_(float x) { return x / (1.f + expf(-x)); }
DEV float softplusf_(float x) { return fmaxf(x, 0.f) + log1pf(expf(-fabsf(x))); }
DEV float geluf_(float x) { return 0.5f * x * (1.f + erff(x * 0.70710678118654752f)); }

DEV f32x16 mfma32(bf16x8 a, bf16x8 b, f32x16 c) {
#ifdef CPU_EMU
  return emu_mfma32(a, b, c);
#else
  return __builtin_amdgcn_mfma_f32_32x32x16_bf16(a, b, c, 0, 0, 0);
#endif
}
DEV float wshfl_xor(float v, int m) {
#ifdef CPU_EMU
  return emu_shfl_xor(v, m);
#else
  return __shfl_xor(v, m, 64);
#endif
}
DEV float wave_sum(float v) {
#pragma unroll
  for (int m = 32; m >= 1; m >>= 1) v += wshfl_xor(v, m);
  return v;
}
DEV int acc_row(int reg, int lane) { return (reg & 3) + 8 * (reg >> 2) + 4 * (lane >> 5); }

DEV int mod_row(int row) { return row < NCTX ? 2 : (row - NCTX) / SEQ; }

template <bool SYNC_EPI, class Epi>
DEV void gemm_tile_128(const bf16_t* __restrict__ A, int lda, int M, const bf16_t* __restrict__ Bt, int ldb, int N,
                       int K, int m0, int n0, const Epi& epi, unsigned char* smem) {
  constexpr int LS = 72;
  bf16_t* sA = (bf16_t*)smem;
  bf16_t* sB = sA + 128 * LS;
  const int tid = threadIdx.x, lane = tid & 63, wave = tid >> 6;
  const int wm = (wave >> 1) * 64, wn = (wave & 1) * 64;
  f32x16 acc[2][2];
#pragma unroll
  for (int i = 0; i < 2; ++i)
#pragma unroll
    for (int j = 0; j < 2; ++j)
#pragma unroll
      for (int r = 0; r < 16; ++r) acc[i][j][r] = 0.f;
  u32x4 ra[4], rb[4];
  const u32x4 z4 = {0u, 0u, 0u, 0u};
#pragma unroll
  for (int i = 0; i < 4; ++i) {
    int c = tid + i * 256, r = c >> 3, cc = (c & 7) * 8;
    int gr = m0 + r, gn = n0 + r;
    ra[i] = gr < M ? *(const u32x4*)(A + (size_t)gr * lda + cc) : z4;
    rb[i] = gn < N ? *(const u32x4*)(Bt + (size_t)gn * ldb + cc) : z4;
  }
  for (int k0 = 0; k0 < K; k0 += 64) {
    __syncthreads();
#pragma unroll
    for (int i = 0; i < 4; ++i) {
      int c = tid + i * 256, r = c >> 3, cc = (c & 7) * 8;
      *(u32x4*)(sA + r * LS + cc) = ra[i];
      *(u32x4*)(sB + r * LS + cc) = rb[i];
    }
    __syncthreads();
    if (k0 + 64 < K) {
#pragma unroll
      for (int i = 0; i < 4; ++i) {
        int c = tid + i * 256, r = c >> 3, cc = (c & 7) * 8;
        int gr = m0 + r, gn = n0 + r;
        ra[i] = gr < M ? *(const u32x4*)(A + (size_t)gr * lda + k0 + 64 + cc) : z4;
        rb[i] = gn < N ? *(const u32x4*)(Bt + (size_t)gn * ldb + k0 + 64 + cc) : z4;
      }
    }
#pragma unroll
    for (int kk = 0; kk < 4; ++kk) {
      bf16x8 a[2], b[2];
      const int ko = kk * 16 + 8 * (lane >> 5);
#pragma unroll
      for (int i = 0; i < 2; ++i) a[i] = *(const bf16x8*)(sA + (wm + i * 32 + (lane & 31)) * LS + ko);
#pragma unroll
      for (int j = 0; j < 2; ++j) b[j] = *(const bf16x8*)(sB + (wn + j * 32 + (lane & 31)) * LS + ko);
#pragma unroll
      for (int i = 0; i < 2; ++i)
#pragma unroll
        for (int j = 0; j < 2; ++j) acc[i][j] = mfma32(a[i], b[j], acc[i][j]);
    }
  }
  if (SYNC_EPI) __syncthreads();
#pragma unroll
  for (int i = 0; i < 2; ++i)
#pragma unroll
    for (int j = 0; j < 2; ++j)
#pragma unroll
      for (int r = 0; r < 16; ++r) {
        int row = m0 + wm + i * 32 + acc_row(r, lane);
        int col = n0 + wn + j * 32 + (lane & 31);
        if (row < M && col < N) epi(row, col, acc[i][j][r]);
      }
}

DEV void transpose_tile(const float* __restrict__ src, int ld_src, bf16_t* __restrict__ dst, int ld_dst, int K, int N,
                        int tk, int tn, unsigned char* smem) {
  float* sT = (float*)smem;
  const int tid = threadIdx.x;
  __syncthreads();
  {
    const int tx = tid & 15, ty = tid >> 4;
#pragma unroll
    for (int p = 0; p < 4; ++p) {
      int k = tk * 64 + ty + p * 16, n = tn * 64 + tx * 4;
#pragma unroll
      for (int j = 0; j < 4; ++j) {
        float v = (k < K && n + j < N) ? src[(size_t)k * ld_src + n + j] : 0.f;
        sT[(ty + p * 16) * 65 + tx * 4 + j] = v;
      }
    }
  }
  __syncthreads();
  {
    const int n = tid >> 2, kseg = (tid & 3) * 16;
    int gn = tn * 64 + n;
    if (gn < N) {
      float v[16];
#pragma unroll
      for (int j = 0; j < 16; ++j) v[j] = sT[(kseg + j) * 65 + n];
      bf16_t* d = dst + (size_t)gn * ld_dst + tk * 64 + kseg;
      *(u32x4*)d = pack8(v);
      *(u32x4*)(d + 8) = pack8(v + 8);
    }
  }
}

constexpr int TJ0 = 16 * 49, TJ1 = 16 * 16, TJ2 = 16 * 44, TJ3 = 16 * 16, TJ4 = 2 * 16 * 32, TJ5 = 2 * 8, TJ6 = 2 * 8,
              TJ7 = 2 * 8, TJ8 = 32;
constexpr int NTRANS = TJ0 + TJ1 + TJ2 + TJ3 + TJ4 + TJ5 + TJ6 + TJ7 + TJ8;
constexpr int NKEYCV = (2 * 8 * 2 * 128 * 128) / (256 * 8);
constexpr int NMODV = 2 * 96;
constexpr int NPREP = NTRANS + NKEYCV + NMODV;

DEV void st_prep(const Params& P, int item, unsigned char* smem) {
  unsigned char* ws = P.ws;
  if (item < NTRANS) {
    int t = item;
    if (t < TJ0) { transpose_tile(P.in[I_EVWIN], EVC, (bf16_t*)(ws + OFF_WEVIN), 1024, 1024, EVC, t / 49, t % 49, smem); return; }
    t -= TJ0;
    if (t < TJ1) { transpose_tile(P.in[I_EVWOUT], 1024, (bf16_t*)(ws + OFF_WEVOUT), 1024, 1024, 1024, t / 16, t % 16, smem); return; }
    t -= TJ1;
    if (t < TJ2) { transpose_tile(P.in[I_ODWIN], ODC, (bf16_t*)(ws + OFF_WODIN), 1024, 1024, ODC, t / 44, t % 44, smem); return; }
    t -= TJ2;
    if (t < TJ3) { transpose_tile(P.in[I_ODWOUT], 1024, (bf16_t*)(ws + OFF_WODOUT), 1024, 1024, 1024, t / 16, t % 16, smem); return; }
    t -= TJ3;
    if (t < TJ4) {
      int l = t / 512, tt = t % 512;
      transpose_tile(P.in[I_WQ] + (size_t)l * 1024 * 2048, 2048, (bf16_t*)(ws + OFF_WQ) + (size_t)l * 2048 * 1024, 1024, 1024, 2048, tt / 32, tt % 32, smem);
      return;
    }
    t -= TJ4;
    if (t < TJ5) { int d = t / 8; transpose_tile(P.in[I_WUP] + d * 64 * 512, 512, (bf16_t*)(ws + OFF_WUP) + d * 512 * 64, 64, 64, 512, 0, t % 8, smem); return; }
    t -= TJ5;
    if (t < TJ6) { int d = t / 8; transpose_tile(P.in[I_AUP] + d * 64 * 512, 512, (bf16_t*)(ws + OFF_AUP) + d * 512 * 64, 64, 64, 512, 0, t % 8, smem); return; }
    t -= TJ6;
    if (t < TJ7) { transpose_tile(P.in[I_GUP], 512, (bf16_t*)(ws + OFF_GUP), 128, 128, 512, t / 8, t % 8, smem); return; }
    t -= TJ7;
    {
      int which = t & 1, db = t >> 1;
      const float* src = (which ? P.in[I_WI] : P.in[I_WA]) + (size_t)db * 64 * 64;
      transpose_tile(src, 64, (bf16_t*)(ws + OFF_LRUT) + (size_t)db * 128 * 64 + which * 64 * 64, 64, 64, 64, 0, 0, smem);
      return;
    }
  }
  item -= NTRANS;
  if (item < NKEYCV) {
    size_t e = ((size_t)item * 256 + threadIdx.x) * 8;
    const float* s = P.in[I_KEYS] + e;
    f32x4 a = *(const f32x4*)s, b = *(const f32x4*)(s + 4);
    float v[8] = {a.x, a.y, a.z, a.w, b.x, b.y, b.z, b.w};
    *(u32x4*)((bf16_t*)(ws + OFF_KEYS) + e) = pack8(v);
    return;
  }
  item -= NKEYCV;
  {
    const int l = item / 96, cgp = item % 96;
    float* sS = (float*)smem;
    float* sRed = sS + 3 * 1024;
    const int tid = threadIdx.x;
    __syncthreads();
    for (int i = tid; i < 3 * 1024; i += 256) {
      int m = i >> 10, k = i & 1023;
      float c = m < 2 ? P.in[I_C][m * 1024 + k] : P.in[I_CCTX][k];
      sS[i] = siluf_(c);
    }
    __syncthreads();
    const int ks = tid >> 6, col = cgp * 64 + (tid & 63);
    const float* w = P.in[I_MODW] + (size_t)l * 1024 * 6144 + col;
    float a0 = 0.f, a1 = 0.f, a2 = 0.f;
    for (int k = ks * 256; k < ks * 256 + 256; ++k) {
      float wv = w[(size_t)k * 6144];
      a0 += sS[k] * wv; a1 += sS[1024 + k] * wv; a2 += sS[2048 + k] * wv;
    }
    sRed[(ks * 3 + 0) * 64 + (tid & 63)] = a0;
    sRed[(ks * 3 + 1) * 64 + (tid & 63)] = a1;
    sRed[(ks * 3 + 2) * 64 + (tid & 63)] = a2;
    __syncthreads();
    if (tid < 192) {
      int m = tid >> 6, c = tid & 63;
      float s = sRed[(0 * 3 + m) * 64 + c] + sRed[(1 * 3 + m) * 64 + c] + sRed[(2 * 3 + m) * 64 + c] + sRed[(3 * 3 + m) * 64 + c];
      int cc = cgp * 64 + c;
      ((float*)(ws + OFF_MODV))[((size_t)l * 3 + m) * 6144 + cc] = s + P.in[I_MODB][l * 6144 + cc];
    }
  }
}

constexpr int NPCONV = 2 * (NEXP * 1024 / (256 * 8));
DEV void st_peer_conv(const Params& P, int layer, int item) {
  const int half = NPCONV / 2;
  int which = item >= half;
  int it = which ? item - half : item;
  size_t e = ((size_t)it * 256 + threadIdx.x) * 8;
  const float* s = (which ? P.in[I_PV] : P.in[I_PU]) + (size_t)layer * NEXP * 1024 + e;
  f32x4 a = *(const f32x4*)s, b = *(const f32x4*)(s + 4);
  float v[8] = {a.x, a.y, a.z, a.w, b.x, b.y, b.z, b.w};
  *(u32x4*)((bf16_t*)(P.ws + (which ? OFF_PV : OFF_PU)) + e) = pack8(v);
}

DEV void st_normmod(const Params& P, int layer, int which, int row) {
  const int lane = threadIdx.x & 63;
  const float* src;
  if (which == 0 && layer == 0) src = row < NCTX ? P.in[I_CTX] + (size_t)row * 1024 : P.in[I_X] + (size_t)(row - NCTX) * 1024;
  else src = row < NCTX ? (const float*)(P.ws + OFF_CTXRES) + (size_t)row * 1024 : P.out + (size_t)(row - NCTX) * 1024;
  const float* mv = (const float*)(P.ws + OFF_MODV) + ((size_t)layer * 3 + mod_row(row)) * 6144;
  const float* sh = mv + (which ? 3 : 0) * 1024;
  const float* sc = mv + (which ? 4 : 1) * 1024;
  const float* nw = (which ? P.in[I_NORM2] : P.in[I_NORM1]) + layer * 1024;
  f32x4 v[4];
  float ss = 0.f;
#pragma unroll
  for (int i = 0; i < 4; ++i) {
    v[i] = *(const f32x4*)(src + i * 256 + lane * 4);
    ss += v[i].x * v[i].x + v[i].y * v[i].y + v[i].z * v[i].z + v[i].w * v[i].w;
  }
  ss = wave_sum(ss);
  const float rstd = rsqrtf(ss * (1.f / 1024.f) + 1e-6f);
  bf16_t* dst = (bf16_t*)(P.ws + OFF_HBUF) + (size_t)row * 1024;
#pragma unroll
  for (int i = 0; i < 4; ++i) {
    int c = i * 256 + lane * 4;
    f32x4 w4 = *(const f32x4*)(nw + c), s4 = *(const f32x4*)(sc + c), h4 = *(const f32x4*)(sh + c);
    float o0 = v[i].x * rstd * w4.x * (1.f + s4.x) + h4.x;
    float o1 = v[i].y * rstd * w4.y * (1.f + s4.y) + h4.y;
    float o2 = v[i].z * rstd * w4.z * (1.f + s4.z) + h4.z;
    float o3 = v[i].w * rstd * w4.w * (1.f + s4.w) + h4.w;
    u32x2 pk; pk.x = pack2(o0, o1); pk.y = pack2(o2, o3);
    *(u32x2*)(dst + c) = pk;
  }
}

struct EpiProjL0 {
  bf16_t* proj; float* gates;
  DEVM void operator()(int row, int col, float v) const {
    proj[(size_t)row * EVC + col] = f2bf(v);
    if (col >= 1536 && col < 1552) gates[row * 32 + (col - 1536)] = v;
    else if (col >= 3088) gates[row * 32 + 16 + (col - 3088)] = v;
  }
};
struct EpiStoreBf {
  bf16_t* dst; int ld;
  DEVM void operator()(int row, int col, float v) const { dst[(size_t)row * ld + col] = f2bf(v); }
};
struct EpiStoreBfBias {
  bf16_t* dst; int ld; const float* bias;
  DEVM void operator()(int row, int col, float v) const { dst[(size_t)row * ld + col] = f2bf(v + (bias ? bias[col] : 0.f)); }
};
struct EpiOutProj {
  const float* x_lat; const float* x_ctx; float* o_lat; float* o_ctx; const float* modv;
  DEVM void operator()(int row, int col, float v) const {
    float g = modv[mod_row(row) * 6144 + 2 * 1024 + col];
    if (row < NCTX) o_ctx[(size_t)row * 1024 + col] = x_ctx[(size_t)row * 1024 + col] + g * v;
    else { size_t o = (size_t)(row - NCTX) * 1024 + col; o_lat[o] = x_lat[o] + g * v; }
  }
};
struct EpiScoreLds {
  float* sS; int m0;
  DEVM void operator()(int row, int col, float v) const { sS[(row - m0) * 129 + col] = v; }
};

DEV void st_xbc_conv(const Params& P, int row) {
  const int lane = threadIdx.x & 63;
  const bf16_t* proj = (const bf16_t*)(P.ws + OFF_PROJ);
  bf16_t* xc = (bf16_t*)P.out + (size_t)row * 1024;
  int row0, len, pos;
  if (row < NCTX) { row0 = (row / CTXL) * CTXL; len = CTXL; pos = row - row0; }
  else { int r = row - NCTX; row0 = NCTX + (r / SEQ) * SEQ; len = SEQ; pos = r % SEQ; }
  const float* cw = P.in[I_SCONVW];
  const float* cb = P.in[I_SCONVB];
#pragma unroll
  for (int hh = 0; hh < 2; ++hh) {
    const int ch = hh * 512 + lane * 8;
    float o[8];
#pragma unroll
    for (int j = 0; j < 8; ++j) o[j] = cb[ch + j];
#pragma unroll
    for (int tap = 0; tap < 4; ++tap) {
      int pp = pos + tap - 2;
      if (pp >= 0 && pp < len) {
        float x[8];
        unpack8(*(const u32x4*)(proj + (size_t)(row0 + pp) * EVC + 2064 + ch), x);
        f32x4 w0 = *(const f32x4*)(cw + tap * 1024 + ch), w1 = *(const f32x4*)(cw + tap * 1024 + ch + 4);
        o[0] += w0.x * x[0]; o[1] += w0.y * x[1]; o[2] += w0.z * x[2]; o[3] += w0.w * x[3];
        o[4] += w1.x * x[4]; o[5] += w1.y * x[5]; o[6] += w1.z * x[6]; o[7] += w1.w * x[7];
      }
    }
#pragma unroll
    for (int j = 0; j < 8; ++j) o[j] = siluf_(o[j]);
    *(u32x4*)(xc + ch) = pack8(o);
  }
}

#ifndef LA_NSEG
#define LA_NSEG 10
#endif
constexpr int LA_NCH = (CTXL + SEQ) / 64;
constexpr int LA_CPS = LA_NCH / LA_NSEG;
static_assert(LA_NCH % LA_NSEG == 0, "linattn segments");
#ifdef CPU_EMU
constexpr size_t OFF_LASEG = OFF_PR + PR_BYTES;
#else
constexpr size_t OFF_LASEG = OFF_R2L0 + (size_t)NTOK * 1024 * 2;
#endif
constexpr size_t LASEG_U = (size_t)48 * LA_NSEG * 8192 * 4;
constexpr size_t OFF_LASEG_N = OFF_LASEG + LASEG_U;
constexpr size_t OFF_LASEG_D = OFF_LASEG_N + (size_t)48 * LA_NSEG * 64 * 4;
#ifndef CPU_EMU
static_assert(OFF_LASEG_D + 48 * LA_NSEG * 4 <= OFF_PR + PR_BYTES, "laseg");
#endif

struct LaRaw { u32x4 q[2], k[4], x[4]; float g0, g1; };

template <bool MLSTM, bool FULL>
DEV void la_load_raw(const Params& P, int b, int h, int d, int cc, LaRaw& R) {
  constexpr int NC_CTX = CTXL / 64;
  const int tid = threadIdx.x;
  const int seg = cc >= NC_CTX;
  const int row0 = seg ? NCTX + b * SEQ : b * CTXL;
  const int len = seg ? SEQ : CTXL;
  const int cl = (seg ? cc - NC_CTX : cc) * 64;
  const bf16_t* proj = (const bf16_t*)(P.ws + OFF_PROJ);
  const bf16_t* xcv = (const bf16_t*)P.out;
  const float* gates = (const float*)(P.ws + OFF_GATES);
  if (tid < 64) {
    int p = cl + tid, grow = row0 + (d ? len - 1 - p : p);
    if (MLSTM) { R.g0 = gates[grow * 32 + d * 4 + h]; R.g1 = gates[grow * 32 + 8 + d * 4 + h]; }
    else { R.g0 = gates[grow * 32 + 16 + d * 8 + h]; R.g1 = 0.f; }
  }
  if (MLSTM) {
#pragma unroll
    for (int i = 0; i < 2; ++i) {
      int c = tid + i * 256, r = c >> 3, cc8 = (c & 7) * 8;
      int p = cl + r, pos = d ? len - 1 - p : p;
      const bf16_t* rp = proj + (size_t)(row0 + pos) * EVC;
      if (FULL) R.q[i] = *(const u32x4*)(rp + h * 64 + cc8);
      R.k[i] = *(const u32x4*)(rp + 256 + h * 64 + cc8);
    }
#pragma unroll
    for (int i = 0; i < 4; ++i) {
      int c = tid + i * 256, r = c >> 4, cc8 = (c & 15) * 8;
      int p = cl + r, pos = d ? len - 1 - p : p;
      R.x[i] = *(const u32x4*)(proj + (size_t)(row0 + pos) * EVC + 512 + h * 128 + cc8);
    }
  } else {
    const int grp = h >> 2;
#pragma unroll
    for (int i = 0; i < 2; ++i) {
      int c = tid + i * 256, r = c >> 3, cc8 = (c & 7) * 8;
      int p = cl + r, pos = d ? len - 1 - p : p;
      R.x[i] = *(const u32x4*)(xcv + (size_t)(row0 + pos) * 1024 + h * 64 + cc8);
    }
#pragma unroll
    for (int i = 0; i < 4; ++i) {
      int c = tid + i * 256, r = c >> 4, cc8 = (c & 15) * 8;
      int p = cl + r, pos = d ? len - 1 - p : p;
      const bf16_t* rp = xcv + (size_t)(row0 + pos) * 1024;
      R.k[i] = *(const u32x4*)(rp + 512 + grp * 128 + cc8);
      if (FULL) { if (i < 2) R.q[i] = *(const u32x4*)(rp + 768 + grp * 128 + cc8); else R.x[i] = *(const u32x4*)(rp + 768 + grp * 128 + cc8); }
    }
  }
}

template <bool MLSTM, bool FULL>
DEV void st_linattn_seg(const Params& P, int sid, int seg, unsigned char* smem) {
  constexpr int DK = MLSTM ? 64 : 128, DX = MLSTM ? 128 : 64;
  constexpr int QS = DK + 8;
  constexpr int NH = MLSTM ? 4 : 8;
  constexpr int NC_CTX = CTXL / 64;
  const int tid = threadIdx.x, lane = tid & 63, wave = tid >> 6;
  const int d = sid & 1, h = (sid >> 1) % NH, b = (sid >> 1) / NH;
  const int gsid = MLSTM ? sid : 16 + sid;
  bf16_t* sQ = (bf16_t*)smem;
  bf16_t* sK = sQ + 64 * QS;
  bf16_t* sP = sK;
  bf16_t* sKT = sK + 64 * QS;
  bf16_t* sXT = sKT + DK * 72;
  bf16_t* sST = sXT + DX * 72;
  float* sF = (float*)(sST + DX * QS);
  float* sLa = sF;
  float* sG = sF + 64;
  float* sBc = sF + 128;
  float* sDen = sF + 192;
  float* sN = sF + 256;
  int* sRow = (int*)(sF + 384);
  static_assert((64 * QS * 2 + DK * 72 + DX * 72 + DX * QS) * 2 + 448 * 4 <= SMEM_BYTES, "lds");
  bf16_t* outb = MLSTM ? (bf16_t*)(P.ws + OFF_HBUF) : (bf16_t*)(P.ws + OFF_R2L0);
  float* segU = (float*)(P.ws + OFF_LASEG);
  float* segN = (float*)(P.ws + OFF_LASEG_N);
  float* segD = (float*)(P.ws + OFF_LASEG_D);

  f32x16 accS[2];
#pragma unroll
  for (int j = 0; j < 2; ++j)
#pragma unroll
    for (int r = 0; r < 16; ++r) accS[j][r] = 0.f;
  const int sx0 = MLSTM ? wave * 32 : (wave >> 1) * 32;
  const int sk0 = MLSTM ? 0 : (wave & 1) * 64;
  float nreg = 0.f;
  float gb0 = 0.f, gb1 = 0.f, alog_e = 0.f, dskip = 0.f;
  if (MLSTM) { gb0 = P.in[I_IBIAS][d * 4 + h]; gb1 = P.in[I_FBIAS][d * 4 + h]; }
  else { gb0 = P.in[I_DTBIAS][d * 8 + h]; alog_e = expf(P.in[I_ALOG][d * 8 + h]); dskip = P.in[I_DSKIP][h]; }

  const int cc0 = seg * LA_CPS, cc1 = cc0 + LA_CPS;
  LaRaw R;
  la_load_raw<MLSTM, FULL>(P, b, h, d, cc0, R);
  __syncthreads();
  if (FULL) {
    for (int js = 0; js < seg; ++js) {
      const size_t it = (size_t)gsid * LA_NSEG + js;
      const float a = expf(segD[it]);
      const float* U = segU + it * 8192;
#pragma unroll
      for (int j = 0; j < 2; ++j)
#pragma unroll
        for (int r = 0; r < 16; ++r) accS[j][r] = a * accS[j][r] + U[(j * 16 + r) * 256 + tid];
      if (MLSTM && tid < 64) nreg = a * nreg + segN[it * 64 + tid];
    }
#pragma unroll
    for (int j = 0; j < 2; ++j)
#pragma unroll
      for (int r = 0; r < 16; ++r) sST[(sx0 + acc_row(r, lane)) * QS + sk0 + j * 32 + (lane & 31)] = f2bf(accS[j][r]);
    if (tid < 128) sN[tid] = (MLSTM && tid < 64) ? nreg : 0.f;
  }
  float lsum = 0.f;

  for (int cc = cc0; cc < cc1; ++cc) {
    int tl_ = threadIdx.x; OPAQUE(tl_);
    const int tid = tl_, lane = tl_ & 63;
    const int sgi = cc >= NC_CTX;
    const int row0 = sgi ? NCTX + b * SEQ : b * CTXL;
    const int len = sgi ? SEQ : CTXL;
    const int cl = (sgi ? cc - NC_CTX : cc) * 64;
    if (tid < 64) {
      int p = cl + tid;
      sRow[tid] = row0 + (d ? len - 1 - p : p);
      if (MLSTM) { sLa[tid] = -softplusf_(-(R.g1 + gb1)); sG[tid] = expf(R.g0 + gb0); }
      else { float dt = softplusf_(R.g0 + gb0); sLa[tid] = -dt * alog_e; sG[tid] = dt; }
    }
    __syncthreads();
    if (wave == 0) {
      float v = sLa[lane];
#pragma unroll
      for (int off = 1; off < 64; off <<= 1) {
#ifdef CPU_EMU
        float o = emu_shfl_up(v, off);
#else
        float o = __shfl_up(v, off, 64);
#endif
        if (lane >= off) v += o;
      }
      sBc[lane] = v;
    }
    __syncthreads();
    const float blast = sBc[63];
    lsum += blast;
    if (MLSTM) {
#pragma unroll
      for (int i = 0; i < 2; ++i) {
        int c = tid + i * 256, r = c >> 3, cc8 = (c & 7) * 8;
        float kf[8]; unpack8(R.k[i], kf);
        const float wgt = expf(blast - sBc[r]) * sG[r];
#pragma unroll
        for (int j = 0; j < 8; ++j) sKT[(cc8 + j) * 72 + r] = f2bf(kf[j] * wgt);
        if (FULL) {
          float qf[8]; unpack8(R.q[i], qf);
#pragma unroll
          for (int j = 0; j < 8; ++j) qf[j] *= 0.125f;
          *(u32x4*)(sQ + r * QS + cc8) = pack8(qf);
          *(u32x4*)(sK + r * QS + cc8) = R.k[i];
        }
      }
#pragma unroll
      for (int i = 0; i < 4; ++i) {
        int c = tid + i * 256, r = c >> 4, cc8 = (c & 15) * 8;
        const bf16_t* xs = (const bf16_t*)&R.x[i];
#pragma unroll
        for (int j = 0; j < 8; ++j) sXT[(cc8 + j) * 72 + r] = xs[j];
      }
    } else {
#pragma unroll
      for (int i = 0; i < 2; ++i) {
        int c = tid + i * 256, r = c >> 3, cc8 = (c & 7) * 8;
        const bf16_t* xs = (const bf16_t*)&R.x[i];
#pragma unroll
        for (int j = 0; j < 8; ++j) sXT[(cc8 + j) * 72 + r] = xs[j];
      }
#pragma unroll
      for (int i = 0; i < 4; ++i) {
        int c = tid + i * 256, r = c >> 4, cc8 = (c & 15) * 8;
        float kf[8]; unpack8(R.k[i], kf);
        const float wgt = expf(blast - sBc[r]) * sG[r];
#pragma unroll
        for (int j = 0; j < 8; ++j) sKT[(cc8 + j) * 72 + r] = f2bf(kf[j] * wgt);
        if (FULL) {
          *(u32x4*)(sK + r * QS + cc8) = R.k[i];
          *(u32x4*)(sQ + r * QS + cc8) = i < 2 ? R.q[i] : R.x[i];
        }
      }
    }
    if (cc + 1 < cc1) la_load_raw<MLSTM, FULL>(P, b, h, d, cc + 1, R);
    __syncthreads();
    if (FULL) {
      const int tr = (wave >> 1) * 32, tc = (wave & 1) * 32;
      f32x16 accP;
#pragma unroll
      for (int r = 0; r < 16; ++r) accP[r] = 0.f;
      if (!(tr == 0 && tc == 32)) {
#pragma unroll
        for (int kk = 0; kk < DK / 16; ++kk) {
          const int ko = kk * 16 + 8 * (lane >> 5);
          bf16x8 a = *(const bf16x8*)(sQ + (tr + (lane & 31)) * QS + ko);
          bf16x8 bb = *(const bf16x8*)(sK + (tc + (lane & 31)) * QS + ko);
          accP = mfma32(a, bb, accP);
        }
      }
      __syncthreads();
      {
        const int s = tc + (lane & 31);
        const float bs = sBc[s], gs = sG[s];
#pragma unroll
        for (int r = 0; r < 16; ++r) {
          int t = tr + acc_row(r, lane);
          float v = (s <= t) ? accP[r] * expf(sBc[t] - bs) * gs : 0.f;
          sP[t * 72 + s] = f2bf(v);
        }
        for (int i = tid; i < 64 * DK; i += 256) {
          int t = i / DK, k = i % DK;
          sQ[t * QS + k] = f2bf(bf2f(sQ[t * QS + k]) * expf(sBc[t]));
        }
      }
      __syncthreads();
      constexpr int NYT = MLSTM ? 2 : 1;
      const int yc0 = MLSTM ? (wave & 1) * 64 : (wave & 1) * 32;
      f32x16 accY[NYT];
#pragma unroll
      for (int j = 0; j < NYT; ++j)
#pragma unroll
        for (int r = 0; r < 16; ++r) accY[j][r] = 0.f;
#pragma unroll
      for (int kk = 0; kk < 4; ++kk) {
        const int ko = kk * 16 + 8 * (lane >> 5);
        bf16x8 a = *(const bf16x8*)(sP + (tr + (lane & 31)) * 72 + ko);
#pragma unroll
        for (int j = 0; j < NYT; ++j) {
          bf16x8 bb = *(const bf16x8*)(sXT + (yc0 + j * 32 + (lane & 31)) * 72 + ko);
          accY[j] = mfma32(a, bb, accY[j]);
        }
      }
#pragma unroll
      for (int kk = 0; kk < DK / 16; ++kk) {
        const int ko = kk * 16 + 8 * (lane >> 5);
        bf16x8 a = *(const bf16x8*)(sQ + (tr + (lane & 31)) * QS + ko);
#pragma unroll
        for (int j = 0; j < NYT; ++j) {
          bf16x8 bb = *(const bf16x8*)(sST + (yc0 + j * 32 + (lane & 31)) * QS + ko);
          accY[j] = mfma32(a, bb, accY[j]);
        }
      }
      if (MLSTM) {
        if (tid < 64) {
          float den = 0.f, dq = 0.f;
#pragma unroll 8
          for (int s = 0; s < 64; ++s) den += bf2f(sP[tid * 72 + s]);
#pragma unroll 8
          for (int k = 0; k < DK; ++k) dq += sN[k] * bf2f(sQ[tid * QS + k]);
          sDen[tid] = den + dq;
        }
        __syncthreads();
      }
#pragma unroll
      for (int j = 0; j < NYT; ++j)
#pragma unroll
        for (int r = 0; r < 16; ++r) {
          int t = tr + acc_row(r, lane);
          int x = yc0 + j * 32 + (lane & 31);
          float v = accY[j][r];
          if (MLSTM) {
            v = v / fmaxf(fabsf(sDen[t]), 1.f);
            outb[(size_t)sRow[t] * 1024 + d * 512 + h * 128 + x] = f2bf(v);
          } else {
            if (d == 0) v += dskip * bf2f(sXT[x * 72 + t]);
            outb[(size_t)sRow[t] * 1024 + d * 512 + h * 64 + x] = f2bf(v);
          }
        }
      __syncthreads();
    }
    {
      const float eb = expf(blast);
#pragma unroll
      for (int j = 0; j < 2; ++j)
#pragma unroll
        for (int r = 0; r < 16; ++r) accS[j][r] *= eb;
#pragma unroll
      for (int kk = 0; kk < 4; ++kk) {
        const int ko = kk * 16 + 8 * (lane >> 5);
        bf16x8 a = *(const bf16x8*)(sXT + (sx0 + (lane & 31)) * 72 + ko);
#pragma unroll
        for (int j = 0; j < 2; ++j) {
          bf16x8 bb = *(const bf16x8*)(sKT + (sk0 + j * 32 + (lane & 31)) * 72 + ko);
          accS[j] = mfma32(a, bb, accS[j]);
        }
      }
      if (FULL) {
#pragma unroll
        for (int j = 0; j < 2; ++j)
#pragma unroll
          for (int r = 0; r < 16; ++r) sST[(sx0 + acc_row(r, lane)) * QS + sk0 + j * 32 + (lane & 31)] = f2bf(accS[j][r]);
      }
      if (MLSTM && tid < 64) {
        float nn = nreg * eb;
        for (int s = 0; s < 64; ++s) nn += bf2f(sKT[tid * 72 + s]);
        nreg = nn;
        if (FULL) sN[tid] = nn;
      }
    }
    __syncthreads();
  }
  if (!FULL) {
    const size_t it = (size_t)gsid * LA_NSEG + seg;
    float* U = segU + it * 8192;
#pragma unroll
    for (int j = 0; j < 2; ++j)
#pragma unroll
      for (int r = 0; r < 16; ++r) U[(j * 16 + r) * 256 + tid] = accS[j][r];
    if (MLSTM && tid < 64) segN[it * 64 + tid] = nreg;
    if (tid == 0) segD[it] = lsum;
  }
}

DEV void st_finish_l0(const Params& P, int row) {
  const int lane = threadIdx.x & 63;
  bf16_t* hb = (bf16_t*)(P.ws + OFF_HBUF) + (size_t)row * 1024;
  const bf16_t* yb = (const bf16_t*)(P.ws + OFF_R2L0) + (size_t)row * 1024;
  const bf16_t* pr = (const bf16_t*)(P.ws + OFF_PROJ) + (size_t)row * EVC;
  const int ch = lane * 8;
  float h0[8], h1[8], o[8], f1[8];
  unpack8(*(const u32x4*)(hb + ch), h0);
  unpack8(*(const u32x4*)(hb + 512 + ch), h1);
  unpack8(*(const u32x4*)(pr + 1024 + ch), o);
  float ss = 0.f;
#pragma unroll
  for (int j = 0; j < 8; ++j) { h0[j] += h1[j]; ss += h0[j] * h0[j]; }
  ss += wshfl_xor(ss, 1); ss += wshfl_xor(ss, 2); ss += wshfl_xor(ss, 4); ss += wshfl_xor(ss, 8);
  float rstd = rsqrtf(ss * (1.f / 128.f) + 1e-6f);
#pragma unroll
  for (int j = 0; j < 8; ++j) f1[j] = h0[j] * rstd * P.in[I_MNORM][ch + j] * sigmoidf_(o[j]);
  float y0[8], y1[8], z[8], f2[8];
  unpack8(*(const u32x4*)(yb + ch), y0);
  unpack8(*(const u32x4*)(yb + 512 + ch), y1);
  unpack8(*(const u32x4*)(pr + 1552 + ch), z);
  float s2 = 0.f;
#pragma unroll
  for (int j = 0; j < 8; ++j) { y0[j] = (y0[j] + y1[j]) * siluf_(z[j]); s2 += y0[j] * y0[j]; }
  s2 = wave_sum(s2);
  float rstd2 = rsqrtf(s2 * (1.f / 512.f) + 1e-6f);
#pragma unroll
  for (int j = 0; j < 8; ++j) f2[j] = y0[j] * rstd2 * P.in[I_SNORM][ch + j];
  *(u32x4*)(hb + ch) = pack8(f1);
  *(u32x4*)(hb + 512 + ch) = pack8(f2);
}

DEV float mixval(const bf16_t* __restrict__ proj, int row, int c, const float* __restrict__ mu) {
  float self = bf2f(proj[(size_t)row * ODC + c]);
  int nrow = -1;
  if (row < NCTX) {
    int pos = row % CTXL;
    if (c < 896) { if (pos > 0) nrow = row - 1; }
    else { if (pos < CTXL - 1) nrow = row + 1; }
  } else {
    int pos = (row - NCTX) % SEQ;
    int gx = pos % GW, gy = pos / GW, q = c / 448;
    if (q == 0) { if (gx > 0) nrow = row - 1; }
    else if (q == 1) { if (gx < GW - 1) nrow = row + 1; }
    else if (q == 2) { if (gy > 0) nrow = row - GW; }
    else { if (gy < SEQ / GW - 1) nrow = row + GW; }
  }
  float nb = nrow >= 0 ? bf2f(proj[(size_t)nrow * ODC + c]) : 0.f;
  return self + mu[c] * (nb - self);
}

DEV void st_lora_act(const Params& P, int row) {
  const int lane = threadIdx.x & 63;
  const bf16_t* proj = (const bf16_t*)(P.ws + OFF_PROJ);
  bf16_t* hb = (bf16_t*)(P.ws + OFF_HBUF) + (size_t)row * 1024;
  float v[4];
#pragma unroll
  for (int j = 0; j < 4; ++j) {
    int c = lane * 4 + j;
    float x = mixval(proj, row, 1536 + c, P.in[I_MU]);
    v[j] = c < 64 ? tanhf(x) : (c < 128 ? x : sigmoidf_(x));
  }
  u32x2 pk; pk.x = pack2(v[0], v[1]); pk.y = pack2(v[2], v[3]);
  *(u32x2*)(hb + lane * 4) = pk;
}

DEV void st_rwkv_stream(const Params& P, int sid, unsigned char* smem) {
  const int tid = threadIdx.x, lane = tid & 63, wave = tid >> 6;
  const int d = sid & 1, h = (sid >> 1) & 7, b = sid >> 4;
  float* sR = (float*)smem;
  float* sW = sR + 2048;
  float* sKk = sW + 2048;
  float* sV = sKk + 2048;
  float* sA = sV + 2048;
  float* sBb = sA + 2048;
  float* sY = sBb + 2048;
  int* sRow = (int*)(sY + 2048);
  const bf16_t* proj = (const bf16_t*)(P.ws + OFF_PROJ);
  const bf16_t* lora = (const bf16_t*)(P.ws + OFF_LORA);
  bf16_t* yout = (bf16_t*)(P.ws + OFF_HBUF);
  const float* mu = P.in[I_MU];
  const int vrow = tid >> 2, j4 = tid & 3;
  float S[16];
#pragma unroll
  for (int i = 0; i < 16; ++i) S[i] = 0.f;
  const float kkw = P.in[I_KK][h * 64 + lane], kaw = P.in[I_KA][h * 64 + lane];
  for (int seg = 0; seg < 2; ++seg) {
    const int row0 = seg == 0 ? b * CTXL : NCTX + b * SEQ;
    const int len = seg == 0 ? CTXL : SEQ;
    for (int it = 0; it < len / 32; ++it) {
      __syncthreads();
      for (int s = wave; s < 32; s += 4) {
        int p = it * 32 + s, pos = d ? len - 1 - p : p, row = row0 + pos;
        int c = h * 64 + lane;
        float r = mixval(proj, row, c, mu);
        float k = mixval(proj, row, 512 + c, mu);
        float v = mixval(proj, row, 1024 + c, mu);
        float kk = k * kkw;
        float ss = wave_sum(kk * kk);
        kk *= rsqrtf(ss + 1e-12f);
        float lw = bf2f(lora[((size_t)d * NTOK + row) * 512 + c]);
        float la = bf2f(lora[((size_t)(2 + d) * NTOK + row) * 512 + c]);
        float w = expf(-0.6065306597126334f * sigmoidf_(lw));
        float a = sigmoidf_(la);
        float kt = k * (1.f + (a - 1.f) * kaw);
        sR[s * 64 + lane] = r; sW[s * 64 + lane] = w; sKk[s * 64 + lane] = kt; sV[s * 64 + lane] = v;
        sA[s * 64 + lane] = -kk; sBb[s * 64 + lane] = kk * a;
        if (lane == 0) sRow[s] = row;
      }
      __syncthreads();
      for (int s = 0; s < 32; ++s) {
        const float* pa = sA + s * 64 + j4 * 16;
        const float* pw = sW + s * 64 + j4 * 16;
        const float* pk = sKk + s * 64 + j4 * 16;
        const float* pb = sBb + s * 64 + j4 * 16;
        const float* pr = sR + s * 64 + j4 * 16;
        const float vv = sV[s * 64 + vrow];
        float sa = 0.f;
#pragma unroll
        for (int i = 0; i < 16; ++i) sa += S[i] * pa[i];
        sa += wshfl_xor(sa, 1); sa += wshfl_xor(sa, 2);
        float y = 0.f;
#pragma unroll
        for (int i = 0; i < 16; ++i) { S[i] = S[i] * pw[i] + sa * pb[i] + vv * pk[i]; y += S[i] * pr[i]; }
        y += wshfl_xor(y, 1); y += wshfl_xor(y, 2);
        if (j4 == 0) sY[s * 64 + vrow] = y;
      }
      __syncthreads();
      for (int i = tid; i < 2048; i += 256) {
        int s = i >> 6, c = i & 63;
        yout[(size_t)sRow[s] * 1024 + d * 512 + h * 64 + c] = f2bf(sY[i]);
      }
    }
  }
}


DEV int nbr_row(int row, int c) {
  if (row < NCTX) {
    int pos = row % CTXL;
    if (c < 896) return pos > 0 ? row - 1 : -1;
    return pos < CTXL - 1 ? row + 1 : -1;
  }
  int pos = (row - NCTX) % SEQ;
  int gx = pos % GW, gy = pos / GW, q = c / 448;
  if (q == 0) return gx > 0 ? row - 1 : -1;
  if (q == 1) return gx < GW - 1 ? row + 1 : -1;
  if (q == 2) return gy > 0 ? row - GW : -1;
  return gy < SEQ / GW - 1 ? row + GW : -1;
}

struct RwkvRaw { u32x4 rs, rn, ks, kn, vs, vn, lw, la; int row; };

DEV void rwkv_load_raw(const bf16_t* __restrict__ proj, const bf16_t* __restrict__ lora, int b, int h, int d, int cc, int t, int c0,
                       RwkvRaw& R) {
  constexpr int NC_CTX = CTXL / 32;
  const int seg = cc >= NC_CTX;
  const int row0 = seg ? NCTX + b * SEQ : b * CTXL;
  const int len = seg ? SEQ : CTXL;
  const int p = (seg ? cc - NC_CTX : cc) * 32 + t;
  const int row = row0 + (d ? len - 1 - p : p);
  const int col = h * 64 + c0;
  const u32x4 z4 = {0u, 0u, 0u, 0u};
  const bf16_t* rp = proj + (size_t)row * ODC;
  R.row = row;
  R.rs = *(const u32x4*)(rp + col);
  R.ks = *(const u32x4*)(rp + 512 + col);
  R.vs = *(const u32x4*)(rp + 1024 + col);
  int n0 = nbr_row(row, col), n1 = nbr_row(row, 512 + col), n2 = nbr_row(row, 1024 + col);
  R.rn = n0 >= 0 ? *(const u32x4*)(proj + (size_t)n0 * ODC + col) : z4;
  R.kn = n1 >= 0 ? *(const u32x4*)(proj + (size_t)n1 * ODC + 512 + col) : z4;
  R.vn = n2 >= 0 ? *(const u32x4*)(proj + (size_t)n2 * ODC + 1024 + col) : z4;
  R.lw = *(const u32x4*)(lora + ((size_t)d * NTOK + row) * 512 + col);
  R.la = *(const u32x4*)(lora + ((size_t)(2 + d) * NTOK + row) * 512 + col);
}

#ifndef RW_NSEG
#define RW_NSEG 13
#endif
constexpr int RW_NCH = (CTXL + SEQ) / 32;
constexpr int RW_CPS = RW_NCH / RW_NSEG;
static_assert(RW_NCH % RW_NSEG == 0, "rwkv segments");
constexpr size_t OFF_RWSEG = OFF_PU;
static_assert((size_t)32 * RW_NSEG * 64 * 128 * 4 <= (size_t)2 * NEXP * 1024 * 2, "rwseg");

template <bool FULL>
DEV void st_rwkv_seg(const Params& P, int sid, int seg, unsigned char* smem) {
  constexpr int NVB = FULL ? 2 : 4;
  constexpr int ZR = FULL ? 64 : 128;
  const int tid = threadIdx.x, lane = tid & 63, wave = tid >> 6;
  const int d = sid & 1, h = (sid >> 1) & 7, b = sid >> 4;
  bf16_t* sAt = (bf16_t*)smem;
  bf16_t* sRt = sAt + 32 * 72;
  bf16_t* sBt = sRt + 32 * 72;
  bf16_t* sKt = sBt + 32 * 72;
  bf16_t* sBT = sKt + 32 * 72;
  bf16_t* sKT = sBT + 64 * 40;
  bf16_t* sVT = sKT + 64 * 40;
  bf16_t* sLak = sVT + 64 * 40;
  bf16_t* sM = sLak + 32 * 40;
  bf16_t* sLrb = sM + 32 * 40;
  bf16_t* sLrk = sLrb + 32 * 40;
  bf16_t* sZ = FULL ? sLrk + 32 * 40 : sLrb;
  bf16_t* after = sZ + ZR * 72;
  bf16_t* sRT = FULL ? after : nullptr;
  bf16_t* sSAT = FULL ? after + 64 * 40 : sRt;
  float* sLP = (float*)(FULL ? after + 2 * 64 * 40 : after);
  float* sLab = sLP + 32 * 64;
  float* sD = sLab + 32 * 33;
  float* sPT = sD + 768;
  int* sRow = (int*)(sPT + 64);
  if (!FULL) sRT = (bf16_t*)sLP;
  static_assert((4 * 32 * 72 + 3 * 64 * 40 + 4 * 32 * 40 + 2 * 64 * 40 + 64 * 72) * 2 + (32 * 64 + 32 * 33 + 768 + 64 + 32 + 320) * 4 <= SMEM_BYTES, "lds full");
  static_assert((4 * 32 * 72 + 3 * 64 * 40 + 2 * 32 * 40 + 128 * 72) * 2 + (32 * 64 + 32 * 33 + 768 + 64 + 32) * 4 <= SMEM_BYTES, "lds p1");
  static_assert(128 * 40 * 2 <= (32 * 64 + 32 * 33) * 4 && 128 * 40 <= 3 * 32 * 72, "alias");
  const bf16_t* proj = (const bf16_t*)(P.ws + OFF_PROJ);
  const bf16_t* lora = (const bf16_t*)(P.ws + OFF_LORA);
  bf16_t* yout = (bf16_t*)(P.ws + OFF_HBUF);
  float* segZ = (float*)(P.ws + OFF_RWSEG);
  const int t = tid >> 3, c0 = (tid & 7) * 8;
  const int hl = lane >> 5, l31 = lane & 31;
  float* sCst = (float*)(smem + SMEM_BYTES - 320 * 4);
  if (tid < 64) {
    sCst[tid] = P.in[I_MU][h * 64 + tid]; sCst[64 + tid] = P.in[I_MU][512 + h * 64 + tid]; sCst[128 + tid] = P.in[I_MU][1024 + h * 64 + tid];
    sCst[192 + tid] = P.in[I_KK][h * 64 + tid]; sCst[256 + tid] = P.in[I_KA][h * 64 + tid];
  }
  const int cc0 = seg * RW_CPS, cc1 = cc0 + RW_CPS;
  RwkvRaw R;
  rwkv_load_raw(proj, lora, b, h, d, cc0, t, c0, R);
  f32x16 Zm[2];
#pragma unroll
  for (int j = 0; j < 2; ++j)
#pragma unroll
    for (int r = 0; r < 16; ++r) Zm[j][r] = 0.f;
  __syncthreads();
  for (int i = tid; i < ZR * 72; i += 256) sZ[i] = 0;
  __syncthreads();
  if (!FULL) {
    if (wave >= 2) {
#pragma unroll
      for (int cb = 0; cb < 2; ++cb)
#pragma unroll
        for (int r = 0; r < 16; ++r) {
          int c = cb * 32 + acc_row(r, lane), vp = wave * 32 + l31;
          if (c == vp - 64) { Zm[cb][r] = 1.f; sZ[vp * 72 + c] = 0x3f80; }
        }
    }
  } else {
    for (int js = 0; js < seg; ++js) {
      const float* Zs = segZ + ((size_t)sid * RW_NSEG + js) * 64 * 128;
      bf16_t* sG = sAt;
      for (int i = tid; i < 64 * 64; i += 256) { int c = i >> 6, c2 = i & 63; sG[c * 72 + c2] = f2bf(Zs[c * 128 + 64 + c2]); }
      __syncthreads();
      if (wave >= 2) {
        const int cb = wave - 2;
#pragma unroll
        for (int vb = 0; vb < 2; ++vb) {
          f32x16 acc;
#pragma unroll
          for (int r = 0; r < 16; ++r) acc[r] = Zs[(cb * 32 + acc_row(r, lane)) * 128 + vb * 32 + l31];
#pragma unroll
          for (int kk = 0; kk < 4; ++kk) {
            bf16x8 a = *(const bf16x8*)(sG + (cb * 32 + l31) * 72 + kk * 16 + 8 * hl);
            bf16x8 bb = *(const bf16x8*)(sZ + (vb * 32 + l31) * 72 + kk * 16 + 8 * hl);
            acc = mfma32(a, bb, acc);
          }
          Zm[vb] = acc;
        }
      }
      __syncthreads();
      if (wave >= 2) {
        const int cb = wave - 2;
#pragma unroll
        for (int vb = 0; vb < 2; ++vb)
#pragma unroll
          for (int g = 0; g < 4; ++g) {
            u32x2 pk; pk.x = pack2(Zm[vb][4 * g], Zm[vb][4 * g + 1]); pk.y = pack2(Zm[vb][4 * g + 2], Zm[vb][4 * g + 3]);
            *(u32x2*)(sZ + (vb * 32 + l31) * 72 + cb * 32 + 8 * g + 4 * hl) = pk;
          }
      }
      __syncthreads();
    }
  }
  for (int cc = cc0; cc < cc1; ++cc) {
    int tl_ = threadIdx.x; OPAQUE(tl_);
    const int tid = tl_, lane = tl_ & 63, hl = lane >> 5, l31 = lane & 31, t = tl_ >> 3, c0 = (tl_ & 7) * 8;
    const float* muR = sCst + c0; const float* muK = sCst + 64 + c0; const float* muV = sCst + 128 + c0;
    const float* kkw = sCst + 192 + c0; const float* kaw = sCst + 256 + c0;
    {
      float lwf[8];
      unpack8(R.lw, lwf);
#pragma unroll
      for (int j = 0; j < 8; ++j) sLP[t * 64 + c0 + j] = -0.6065306597126334f * sigmoidf_(lwf[j]);
      if ((tid & 7) == 0) sRow[t] = R.row;
    }
    __syncthreads();
    if (tid < 64) {
      float run = 0.f;
#pragma unroll 8
      for (int tt = 0; tt < 32; ++tt) { run += sLP[tt * 64 + tid]; sLP[tt * 64 + tid] = run; }
      sPT[tid] = expf(run);
    }
    __syncthreads();
    {
      float xs[8], xn[8], kt[8], aa[8], ob[8], ok[8];
      unpack8(R.ks, xs); unpack8(R.kn, xn);
      float ss = 0.f;
#pragma unroll
      for (int j = 0; j < 8; ++j) { kt[j] = xs[j] + muK[j] * (xn[j] - xs[j]); aa[j] = kt[j] * kkw[j]; ss += aa[j] * aa[j]; }
      ss += wshfl_xor(ss, 1); ss += wshfl_xor(ss, 2); ss += wshfl_xor(ss, 4);
      const float rn = rsqrtf(ss + 1e-12f);
      float laf[8];
      unpack8(R.la, laf);
#pragma unroll
      for (int j = 0; j < 8; ++j) {
        const float lp = sLP[t * 64 + c0 + j];
        const float lpm = t > 0 ? sLP[(t - 1) * 64 + c0 + j] : 0.f;
        const float e = expf(-lp);
        const float kkn = aa[j] * rn;
        const float asg = sigmoidf_(laf[j]);
        aa[j] = -kkn * expf(lpm);
        ob[j] = kkn * asg * e;
        ok[j] = kt[j] * (1.f + (asg - 1.f) * kaw[j]) * e;
      }
      *(u32x4*)(sAt + t * 72 + c0) = pack8(aa);
      *(u32x4*)(sBt + t * 72 + c0) = pack8(ob);
      *(u32x4*)(sKt + t * 72 + c0) = pack8(ok);
#pragma unroll
      for (int j = 0; j < 8; ++j) { sBT[(c0 + j) * 40 + t] = f2bf(ob[j]); sKT[(c0 + j) * 40 + t] = f2bf(ok[j]); }
      unpack8(R.vs, xs); unpack8(R.vn, xn);
#pragma unroll
      for (int j = 0; j < 8; ++j) sVT[(c0 + j) * 40 + t] = f2bf(xs[j] + muV[j] * (xn[j] - xs[j]));
      if (FULL) {
        unpack8(R.rs, xs); unpack8(R.rn, xn);
#pragma unroll
        for (int j = 0; j < 8; ++j) xs[j] = (xs[j] + muR[j] * (xn[j] - xs[j])) * expf(sLP[t * 64 + c0 + j]);
        *(u32x4*)(sRt + t * 72 + c0) = pack8(xs);
      }
    }
    if (cc + 1 < cc1) rwkv_load_raw(proj, lora, b, h, d, cc + 1, t, c0, R);
    __syncthreads();
    if (FULL || wave < 2) {
      const bf16_t* Asrc = wave < 2 ? sAt : sRt;
      const bf16_t* Bsrc = (wave & 1) ? sKt : sBt;
      f32x16 acc;
#pragma unroll
      for (int r = 0; r < 16; ++r) acc[r] = 0.f;
#pragma unroll
      for (int kk = 0; kk < 4; ++kk) {
        bf16x8 a = *(const bf16x8*)(Asrc + l31 * 72 + kk * 16 + 8 * hl);
        bf16x8 bb = *(const bf16x8*)(Bsrc + l31 * 72 + kk * 16 + 8 * hl);
        acc = mfma32(a, bb, acc);
      }
      bf16_t* dst = wave == 1 ? sLak : (wave == 2 ? sLrb : sLrk);
#pragma unroll
      for (int r = 0; r < 16; ++r) {
        int tt = acc_row(r, lane), j = l31;
        bool keep = wave < 2 ? (j < tt) : (j <= tt);
        float v = keep ? acc[r] : 0.f;
        if (wave == 0) sLab[tt * 33 + j] = v;
        else dst[tt * 40 + j] = f2bf(v);
      }
    }
    __syncthreads();
    if (tid < 32) {
      const int q = tid >> 4, c = tid & 15;
      float x[16];
#pragma unroll
      for (int i = 0; i < 16; ++i) {
        float sacc = (i == c) ? 1.f : 0.f;
#pragma unroll
        for (int j = 0; j < i; ++j) sacc += sLab[(q * 16 + i) * 33 + q * 16 + j] * x[j];
        x[i] = sacc;
        sD[q * 256 + i * 16 + c] = sacc;
      }
    }
    __syncthreads();
    {
      const int i = tid >> 4, c = tid & 15;
      float sacc = 0.f;
#pragma unroll
      for (int j = 0; j < 16; ++j) sacc += sLab[(16 + i) * 33 + j] * sD[j * 16 + c];
      sD[512 + i * 16 + c] = sacc;
    }
    __syncthreads();
    {
      const int i = tid >> 4, c = tid & 15;
      float sacc = 0.f;
#pragma unroll
      for (int j = 0; j < 16; ++j) sacc += sD[256 + i * 16 + j] * sD[512 + j * 16 + c];
      sM[(16 + i) * 40 + c] = f2bf(sacc);
      sM[i * 40 + c] = f2bf(sD[i * 16 + c]);
      sM[(16 + i) * 40 + 16 + c] = f2bf(sD[256 + i * 16 + c]);
      sM[i * 40 + 16 + c] = 0;
    }
    if (wave < NVB) {
      const int vb = wave;
      f32x16 acc;
#pragma unroll
      for (int r = 0; r < 16; ++r) acc[r] = 0.f;
#pragma unroll
      for (int kk = 0; kk < 4; ++kk) {
        bf16x8 a = *(const bf16x8*)(sAt + l31 * 72 + kk * 16 + 8 * hl);
        bf16x8 bb = *(const bf16x8*)(sZ + (vb * 32 + l31) * 72 + kk * 16 + 8 * hl);
        acc = mfma32(a, bb, acc);
      }
      if (vb < 2) {
#pragma unroll
        for (int kk = 0; kk < 2; ++kk) {
          bf16x8 a = *(const bf16x8*)(sLak + l31 * 40 + kk * 16 + 8 * hl);
          bf16x8 bb = *(const bf16x8*)(sVT + (vb * 32 + l31) * 40 + kk * 16 + 8 * hl);
          acc = mfma32(a, bb, acc);
        }
      }
#pragma unroll
      for (int g = 0; g < 4; ++g) {
        u32x2 pk; pk.x = pack2(acc[4 * g], acc[4 * g + 1]); pk.y = pack2(acc[4 * g + 2], acc[4 * g + 3]);
        *(u32x2*)(sRT + (vb * 32 + l31) * 40 + 8 * g + 4 * hl) = pk;
      }
    }
    __syncthreads();
    if (wave < NVB) {
      const int vb = wave;
      f32x16 acc;
#pragma unroll
      for (int r = 0; r < 16; ++r) acc[r] = 0.f;
#pragma unroll
      for (int kk = 0; kk < 2; ++kk) {
        bf16x8 a = *(const bf16x8*)(sM + l31 * 40 + kk * 16 + 8 * hl);
        bf16x8 bb = *(const bf16x8*)(sRT + (vb * 32 + l31) * 40 + kk * 16 + 8 * hl);
        acc = mfma32(a, bb, acc);
      }
#pragma unroll
      for (int g = 0; g < 4; ++g) {
        u32x2 pk; pk.x = pack2(acc[4 * g], acc[4 * g + 1]); pk.y = pack2(acc[4 * g + 2], acc[4 * g + 3]);
        *(u32x2*)(sSAT + (vb * 32 + l31) * 40 + 8 * g + 4 * hl) = pk;
      }
    }
    __syncthreads();
    if (FULL) {
      if (wave < 2) {
        const int vb = wave;
        f32x16 acc;
#pragma unroll
        for (int r = 0; r < 16; ++r) acc[r] = 0.f;
#pragma unroll
        for (int kk = 0; kk < 4; ++kk) {
          bf16x8 a = *(const bf16x8*)(sRt + l31 * 72 + kk * 16 + 8 * hl);
          bf16x8 bb = *(const bf16x8*)(sZ + (vb * 32 + l31) * 72 + kk * 16 + 8 * hl);
          acc = mfma32(a, bb, acc);
        }
#pragma unroll
        for (int kk = 0; kk < 2; ++kk) {
          bf16x8 a = *(const bf16x8*)(sLrb + l31 * 40 + kk * 16 + 8 * hl);
          bf16x8 bb = *(const bf16x8*)(sSAT + (vb * 32 + l31) * 40 + kk * 16 + 8 * hl);
          acc = mfma32(a, bb, acc);
        }
#pragma unroll
        for (int kk = 0; kk < 2; ++kk) {
          bf16x8 a = *(const bf16x8*)(sLrk + l31 * 40 + kk * 16 + 8 * hl);
          bf16x8 bb = *(const bf16x8*)(sVT + (vb * 32 + l31) * 40 + kk * 16 + 8 * hl);
          acc = mfma32(a, bb, acc);
        }
#pragma unroll
        for (int r = 0; r < 16; ++r) {
          int tt = acc_row(r, lane);
          yout[(size_t)sRow[tt] * 1024 + d * 512 + h * 64 + vb * 32 + l31] = f2bf(acc[r]);
        }
      } else {
        const int cb = wave - 2;
#pragma unroll
        for (int vb = 0; vb < 2; ++vb) {
          f32x16 acc;
#pragma unroll
          for (int r = 0; r < 16; ++r) acc[r] = 0.f;
#pragma unroll
          for (int kk = 0; kk < 2; ++kk) {
            bf16x8 a = *(const bf16x8*)(sBT + (cb * 32 + l31) * 40 + kk * 16 + 8 * hl);
            bf16x8 bb = *(const bf16x8*)(sSAT + (vb * 32 + l31) * 40 + kk * 16 + 8 * hl);
            acc = mfma32(a, bb, acc);
          }
#pragma unroll
          for (int kk = 0; kk < 2; ++kk) {
            bf16x8 a = *(const bf16x8*)(sKT + (cb * 32 + l31) * 40 + kk * 16 + 8 * hl);
            bf16x8 bb = *(const bf16x8*)(sVT + (vb * 32 + l31) * 40 + kk * 16 + 8 * hl);
            acc = mfma32(a, bb, acc);
          }
#pragma unroll
          for (int r = 0; r < 16; ++r) Zm[vb][r] = sPT[cb * 32 + acc_row(r, lane)] * (Zm[vb][r] + acc[r]);
        }
      }
      __syncthreads();
      if (wave >= 2) {
        const int cb = wave - 2;
#pragma unroll
        for (int vb = 0; vb < 2; ++vb)
#pragma unroll
          for (int g = 0; g < 4; ++g) {
            u32x2 pk; pk.x = pack2(Zm[vb][4 * g], Zm[vb][4 * g + 1]); pk.y = pack2(Zm[vb][4 * g + 2], Zm[vb][4 * g + 3]);
            *(u32x2*)(sZ + (vb * 32 + l31) * 72 + cb * 32 + 8 * g + 4 * hl) = pk;
          }
      }
    } else {
      const int vb = wave;
#pragma unroll
      for (int cb = 0; cb < 2; ++cb) {
        f32x16 acc;
#pragma unroll
        for (int r = 0; r < 16; ++r) acc[r] = 0.f;
#pragma unroll
        for (int kk = 0; kk < 2; ++kk) {
          bf16x8 a = *(const bf16x8*)(sBT + (cb * 32 + l31) * 40 + kk * 16 + 8 * hl);
          bf16x8 bb = *(const bf16x8*)(sSAT + (vb * 32 + l31) * 40 + kk * 16 + 8 * hl);
          acc = mfma32(a, bb, acc);
        }
        if (vb < 2) {
#pragma unroll
          for (int kk = 0; kk < 2; ++kk) {
            bf16x8 a = *(const bf16x8*)(sKT + (cb * 32 + l31) * 40 + kk * 16 + 8 * hl);
            bf16x8 bb = *(const bf16x8*)(sVT + (vb * 32 + l31) * 40 + kk * 16 + 8 * hl);
            acc = mfma32(a, bb, acc);
          }
        }
#pragma unroll
        for (int r = 0; r < 16; ++r) Zm[cb][r] = sPT[cb * 32 + acc_row(r, lane)] * (Zm[cb][r] + acc[r]);
      }
#pragma unroll
      for (int cb = 0; cb < 2; ++cb)
#pragma unroll
        for (int g = 0; g < 4; ++g) {
          u32x2 pk; pk.x = pack2(Zm[cb][4 * g], Zm[cb][4 * g + 1]); pk.y = pack2(Zm[cb][4 * g + 2], Zm[cb][4 * g + 3]);
          *(u32x2*)(sZ + (vb * 32 + l31) * 72 + cb * 32 + 8 * g + 4 * hl) = pk;
        }
    }
  }
  if (!FULL) {
    float* Zs = segZ + ((size_t)sid * RW_NSEG + seg) * 64 * 128;
#pragma unroll
    for (int cb = 0; cb < 2; ++cb)
#pragma unroll
      for (int r = 0; r < 16; ++r) Zs[(cb * 32 + acc_row(r, lane)) * 128 + wave * 32 + l31] = Zm[cb][r];
  }
}

#ifndef LRU_NSEG
#define LRU_NSEG 13
#endif
constexpr int LRU_NCH = (CTXL + SEQ) / 64;
constexpr int LRU_CPS = LRU_NCH / LRU_NSEG;
static_assert(LRU_NCH % LRU_NSEG == 0, "lru segments");
constexpr size_t OFF_LRUSEG = OFF_RWSEG + (size_t)32 * RW_NSEG * 64 * 128 * 4;
static_assert(OFF_LRUSEG + (size_t)32 * LRU_NSEG * 128 * 4 <= OFF_PU + (size_t)2 * NEXP * 1024 * 2, "lruseg");

template <bool FULL>
DEV void st_lru_seg(const Params& P, int sid, int seg, unsigned char* smem) {
  constexpr int NC_CTX = CTXL / 64;
  const int tid = threadIdx.x, lane = tid & 63, wave = tid >> 6;
  const int d = sid & 1, blk = (sid >> 1) & 7, b = sid >> 4;
  float* sXc = (float*)smem;
  float* sAc = sXc + 4096;
  float* sBc = sAc + 4096;
  float* sU = sBc + 4096;
  bf16_t* sAop = (bf16_t*)(sU + 4096);
  int* sRow = (int*)(sAop + 64 * 72);
  const bf16_t* proj = (const bf16_t*)(P.ws + OFF_PROJ);
  bf16_t* uout = (bf16_t*)(P.ws + OFF_LORA) + (size_t)d * NTOK * 512;
  const bf16_t* lruT = (const bf16_t*)(P.ws + OFF_LRUT) + (size_t)(d * 8 + blk) * 128 * 64;
  float* segS = (float*)(P.ws + OFF_LRUSEG);
  const float* cw = P.in[I_LCONVW];
  const float* cb = P.in[I_LCONVB];
  const int tr = (wave >> 1) * 32, nc0 = (wave & 1) * 64;
  bf16x8 bfrag[2][4];
#pragma unroll
  for (int j = 0; j < 2; ++j)
#pragma unroll
    for (int kk = 0; kk < 4; ++kk)
      bfrag[j][kk] = *(const bf16x8*)(lruT + (nc0 + j * 32 + (lane & 31)) * 64 + kk * 16 + 8 * (lane >> 5));
  float ebias[2], esp[2];
#pragma unroll
  for (int j = 0; j < 2; ++j) {
    int e = nc0 + j * 32 + (lane & 31);
    int ch = blk * 64 + (e & 63);
    ebias[j] = e < 64 ? P.in[I_BA][d * 512 + ch] : P.in[I_BI][d * 512 + ch];
    esp[j] = softplusf_(-P.in[I_LAM][d * 512 + ch]);
  }
  const int lc8 = (tid & 7) * 8, lch = blk * 64 + lc8;
  float cwr[4][8], cbr[8];
#pragma unroll
  for (int j = 0; j < 8; ++j) {
    cbr[j] = cb[lch + j];
#pragma unroll
    for (int tap = 0; tap < 4; ++tap) cwr[tap][j] = cw[tap * 512 + lch + j];
  }
  float hstate = 0.f, aprod = 1.f;
  if (FULL && wave == 0) {
    for (int js = 0; js < seg; ++js) {
      const float* S = segS + ((size_t)sid * LRU_NSEG + js) * 128;
      hstate = S[lane] * hstate + S[64 + lane];
    }
  }
  const int cc0 = seg * LRU_CPS, cc1 = cc0 + LRU_CPS;
  for (int cc = cc0; cc < cc1; ++cc) {
    int tl_ = threadIdx.x; OPAQUE(tl_);
    const int tid = tl_, lane = tl_ & 63;
    const int sgi = cc >= NC_CTX;
    const int row0 = sgi ? NCTX + b * SEQ : b * CTXL;
    const int len = sgi ? SEQ : CTXL;
    const int cl = (sgi ? cc - NC_CTX : cc) * 64;
    __syncthreads();
    if (tid < 64) { int p = cl + tid; sRow[tid] = row0 + (d ? len - 1 - p : p); }
#pragma unroll
    for (int i = 0; i < 2; ++i) {
      int c = tid + i * 256, r = c >> 3;
      int p = cl + r, pos = d ? len - 1 - p : p;
      float o[8];
#pragma unroll
      for (int j = 0; j < 8; ++j) o[j] = cbr[j];
#pragma unroll
      for (int tap = 0; tap < 4; ++tap) {
        int pp = pos + tap - 2;
        if (pp >= 0 && pp < len) {
          float x[8];
          unpack8(*(const u32x4*)(proj + (size_t)(row0 + pp) * ODC + 2304 + lch), x);
#pragma unroll
          for (int j = 0; j < 8; ++j) o[j] += cwr[tap][j] * x[j];
        }
      }
#pragma unroll
      for (int j = 0; j < 8; ++j) sXc[r * 64 + lc8 + j] = o[j];
      *(u32x4*)(sAop + r * 72 + lc8) = pack8(o);
    }
    __syncthreads();
    f32x16 acc[2];
#pragma unroll
    for (int j = 0; j < 2; ++j)
#pragma unroll
      for (int r = 0; r < 16; ++r) acc[j][r] = 0.f;
#pragma unroll
    for (int kk = 0; kk < 4; ++kk) {
      bf16x8 a = *(const bf16x8*)(sAop + (tr + (lane & 31)) * 72 + kk * 16 + 8 * (lane >> 5));
#pragma unroll
      for (int j = 0; j < 2; ++j) acc[j] = mfma32(a, bfrag[j][kk], acc[j]);
    }
#pragma unroll
    for (int j = 0; j < 2; ++j)
#pragma unroll
      for (int r = 0; r < 16; ++r) {
        int t = tr + acc_row(r, lane);
        int e = nc0 + j * 32 + (lane & 31);
        float g = sigmoidf_(acc[j][r] + ebias[j]);
        if (e < 64) { float la = -8.f * g * esp[j]; sAc[t * 64 + e] = expf(la); sU[t * 64 + e] = sqrtf(-expm1f(2.f * la)); }
        else sBc[t * 64 + (e - 64)] = g * sXc[t * 64 + (e - 64)];
      }
    __syncthreads();
    if (wave == 0) {
#pragma unroll 8
      for (int t = 0; t < 64; ++t) {
        float a = sAc[t * 64 + lane];
        float bb = sU[t * 64 + lane] * sBc[t * 64 + lane];
        hstate = a * hstate + bb;
        if (FULL) sU[t * 64 + lane] = hstate; else aprod *= a;
      }
    }
    if (FULL) {
      __syncthreads();
      for (int i = tid; i < 4096; i += 256) {
        int t = i >> 6, c = i & 63;
        uout[(size_t)sRow[t] * 512 + blk * 64 + c] = f2bf(sU[i]);
      }
    }
  }
  if (!FULL && wave == 0) {
    float* S = segS + ((size_t)sid * LRU_NSEG + seg) * 128;
    S[lane] = aprod; S[64 + lane] = hstate;
  }
}

DEV void st_finish_l1(const Params& P, int row) {
  const int lane = threadIdx.x & 63;
  bf16_t* hb = (bf16_t*)(P.ws + OFF_HBUF) + (size_t)row * 1024;
  const bf16_t* proj = (const bf16_t*)(P.ws + OFF_PROJ);
  const bf16_t* lora = (const bf16_t*)(P.ws + OFF_LORA);
  const float* mu = P.in[I_MU];
  const int ch = lane * 8;
  float y0[8], y1[8];
  unpack8(*(const u32x4*)(hb + ch), y0);
  unpack8(*(const u32x4*)(hb + 512 + ch), y1);
  float sm = 0.f;
#pragma unroll
  for (int j = 0; j < 8; ++j) { y0[j] += y1[j]; sm += y0[j]; }
  sm += wshfl_xor(sm, 1); sm += wshfl_xor(sm, 2); sm += wshfl_xor(sm, 4);
  const float mean = sm * (1.f / 64.f);
  float sv = 0.f;
#pragma unroll
  for (int j = 0; j < 8; ++j) { float dlt = y0[j] - mean; sv += dlt * dlt; }
  sv += wshfl_xor(sv, 1); sv += wshfl_xor(sv, 2); sv += wshfl_xor(sv, 4);
  const float rstd = rsqrtf(sv * (1.f / 64.f) + 64e-5f);
  float a0[8], a1[8], g[8], u0[8], u1[8], gb[8];
  unpack8(*(const u32x4*)(lora + ((size_t)2 * NTOK + row) * 512 + ch), a0);
  unpack8(*(const u32x4*)(lora + ((size_t)3 * NTOK + row) * 512 + ch), a1);
  unpack8(*(const u32x4*)(lora + ((size_t)4 * NTOK + row) * 512 + ch), g);
  unpack8(*(const u32x4*)(lora + ((size_t)0 * NTOK + row) * 512 + ch), u0);
  unpack8(*(const u32x4*)(lora + ((size_t)1 * NTOK + row) * 512 + ch), u1);
  unpack8(*(const u32x4*)(proj + (size_t)row * ODC + 1792 + ch), gb);
  float rv[8], vv[8];
  float sdot = 0.f;
#pragma unroll
  for (int j = 0; j < 8; ++j) {
    float r = mixval(proj, row, ch + j, mu);
    float k = mixval(proj, row, 512 + ch + j, mu);
    vv[j] = mixval(proj, row, 1024 + ch + j, mu);
    float am = 0.5f * (sigmoidf_(a0[j]) + sigmoidf_(a1[j]));
    float kb = k * (1.f + (am - 1.f) * P.in[I_KA][ch + j]);
    sdot += r * kb * P.in[I_RK][ch + j];
    rv[j] = r;
  }
  sdot += wshfl_xor(sdot, 1); sdot += wshfl_xor(sdot, 2); sdot += wshfl_xor(sdot, 4);
  float f1[8], f2[8];
#pragma unroll
  for (int j = 0; j < 8; ++j) {
    float yn = (y0[j] - mean) * rstd * P.in[I_LNW][ch + j] + P.in[I_LNB][ch + j];
    yn += sdot * vv[j];
    f1[j] = yn * g[j];
    f2[j] = (u0[j] + u1[j]) * geluf_(gb[j]);
  }
  *(u32x4*)(hb + ch) = pack8(f1);
  *(u32x4*)(hb + 512 + ch) = pack8(f2);
}

DEV void topk_insert(float x, int xi, float* v, int* id) {
#pragma unroll
  for (int j = 0; j < 16; ++j) {
    bool gt = x > v[j];
    float tv = gt ? v[j] : x; int ti = gt ? id[j] : xi;
    v[j] = gt ? x : v[j]; id[j] = gt ? xi : id[j];
    x = tv; xi = ti;
  }
}

DEV void st_peer_topk(const Params& P, int layer, int tile, int h, unsigned char* smem) {
  const int tid = threadIdx.x;
  const bf16_t* q = (const bf16_t*)(P.ws + OFF_Q);
  const bf16_t* keys = (const bf16_t*)(P.ws + OFF_KEYS) + (size_t)(layer * 8 + h) * 2 * 128 * 128;
  float* sS = (float*)smem;
  const int m0 = tile * 128;
  float sv[2][16]; int si[2][16];
#pragma unroll
  for (int p = 0; p < 2; ++p) {
    EpiScoreLds epi{sS, m0};
    gemm_tile_128<true>(q + (h * 2 + p) * 128, 2048, NTOK, keys + p * 128 * 128, 128, 128, 128, m0, 0, epi, smem);
    __syncthreads();
#pragma unroll
    for (int j = 0; j < 16; ++j) { sv[p][j] = -3.0e38f; si[p][j] = 0; }
    if (tid < 128) {
      for (int key = 0; key < 128; ++key) {
        float x = sS[tid * 129 + key];
        if (x > sv[p][15]) topk_insert(x, key, sv[p], si[p]);
      }
    }
    __syncthreads();
  }
  if (tid < 128) {
    float best[16]; int bidx[16];
#pragma unroll
    for (int j = 0; j < 16; ++j) { best[j] = -3.0e38f; bidx[j] = 0; }
#pragma unroll
    for (int i = 0; i < 16; ++i)
#pragma unroll
      for (int j = 0; j < 16; ++j)
        if ((i + 1) * (j + 1) <= 16) {
          float x = sv[0][i] + sv[1][j];
          if (x > best[15]) topk_insert(x, si[0][i] * 128 + si[1][j], best, bidx);
        }
    float e[16], sum = 0.f;
#pragma unroll
    for (int j = 0; j < 16; ++j) { e[j] = expf(best[j] - best[0]); sum += e[j]; }
    const float inv = 1.f / sum;
    int* pidx = (int*)(P.ws + OFF_PIDX) + (size_t)(m0 + tid) * 128 + h * 16;
    float* pg = (float*)(P.ws + OFF_PGATE) + (size_t)(m0 + tid) * 128 + h * 16;
#pragma unroll
    for (int j = 0; j < 16; ++j) { pidx[j] = bidx[j]; pg[j] = e[j] * inv; }
  }
}

DEV void st_peer_experts(const Params& P, int layer, int row) {
  const int lane = threadIdx.x & 63;
  const bf16_t* xb = (const bf16_t*)(P.ws + OFF_HBUF) + (size_t)row * 1024;
  const bf16_t* U = (const bf16_t*)(P.ws + OFF_PU);
  const bf16_t* V = (const bf16_t*)(P.ws + OFF_PV);
  const int* pidx = (const int*)(P.ws + OFF_PIDX) + (size_t)row * 128;
  const float* pg = (const float*)(P.ws + OFF_PGATE) + (size_t)row * 128;
  float x[16], acc[16];
  unpack8(*(const u32x4*)(xb + lane * 8), x);
  unpack8(*(const u32x4*)(xb + 512 + lane * 8), x + 8);
#pragma unroll
  for (int j = 0; j < 16; ++j) acc[j] = 0.f;
  for (int k0 = 0; k0 < 128; k0 += 4) {
    int idx[4]; float gt[4]; u32x4 u0[4], u1[4], v0[4], v1[4];
#pragma unroll
    for (int i = 0; i < 4; ++i) { idx[i] = pidx[k0 + i]; gt[i] = pg[k0 + i]; }
#pragma unroll
    for (int i = 0; i < 4; ++i) {
      const bf16_t* ur = U + (size_t)idx[i] * 1024;
      const bf16_t* vr = V + (size_t)idx[i] * 1024;
      u0[i] = *(const u32x4*)(ur + lane * 8); u1[i] = *(const u32x4*)(ur + 512 + lane * 8);
      v0[i] = *(const u32x4*)(vr + lane * 8); v1[i] = *(const u32x4*)(vr + 512 + lane * 8);
    }
#pragma unroll
    for (int i = 0; i < 4; ++i) {
      float uf[16];
      unpack8(u0[i], uf); unpack8(u1[i], uf + 8);
      float dot = 0.f;
#pragma unroll
      for (int j = 0; j < 16; ++j) dot += x[j] * uf[j];
      dot = wave_sum(dot);
      float coef = gt[i] * geluf_(dot);
      float vf[16];
      unpack8(v0[i], vf); unpack8(v1[i], vf + 8);
#pragma unroll
      for (int j = 0; j < 16; ++j) acc[j] += coef * vf[j];
    }
  }
  float* xr = row < NCTX ? (float*)(P.ws + OFF_CTXRES) + (size_t)row * 1024 : P.out + (size_t)(row - NCTX) * 1024;
  const float* g2 = (const float*)(P.ws + OFF_MODV) + ((size_t)layer * 3 + mod_row(row)) * 6144 + 5 * 1024;
  float o[16];
  float ss = 0.f;
#pragma unroll
  for (int hh = 0; hh < 2; ++hh) {
    int c = hh * 512 + lane * 8;
    f32x4 a = *(const f32x4*)(xr + c), bq = *(const f32x4*)(xr + c + 4);
    f32x4 ga = *(const f32x4*)(g2 + c), gb = *(const f32x4*)(g2 + c + 4);
    o[hh * 8 + 0] = a.x + ga.x * acc[hh * 8 + 0]; o[hh * 8 + 1] = a.y + ga.y * acc[hh * 8 + 1];
    o[hh * 8 + 2] = a.z + ga.z * acc[hh * 8 + 2]; o[hh * 8 + 3] = a.w + ga.w * acc[hh * 8 + 3];
    o[hh * 8 + 4] = bq.x + gb.x * acc[hh * 8 + 4]; o[hh * 8 + 5] = bq.y + gb.y * acc[hh * 8 + 5];
    o[hh * 8 + 6] = bq.z + gb.z * acc[hh * 8 + 6]; o[hh * 8 + 7] = bq.w + gb.w * acc[hh * 8 + 7];
  }
  if (layer == 1) {
#pragma unroll
    for (int j = 0; j < 16; ++j) ss += o[j] * o[j];
    ss = wave_sum(ss);
    float rstd = rsqrtf(ss * (1.f / 1024.f) + 1e-6f);
#pragma unroll
    for (int hh = 0; hh < 2; ++hh)
#pragma unroll
      for (int j = 0; j < 8; ++j) o[hh * 8 + j] *= rstd * P.in[I_FNORM][hh * 512 + lane * 8 + j];
  }
#pragma unroll
  for (int hh = 0; hh < 2; ++hh) {
    int c = hh * 512 + lane * 8;
    f32x4 a = {o[hh * 8 + 0], o[hh * 8 + 1], o[hh * 8 + 2], o[hh * 8 + 3]};
    f32x4 bq = {o[hh * 8 + 4], o[hh * 8 + 5], o[hh * 8 + 6], o[hh * 8 + 7]};
    *(f32x4*)(xr + c) = a; *(f32x4*)(xr + c + 4) = bq;
  }
}

#ifndef PHASE_LIST
#define PHASE_LIST(X) X(0) X(1) X(2) X(22) X(23) X(3) X(4) X(5) X(6) X(7) X(8) X(9) X(10) X(11) X(12) X(13) X(30) X(14) X(15) X(16) X(17) X(18) X(19) X(20) X(21)
#endif
constexpr int PH_LAST = 21;

template <int ph>
DEV void run_phase(const Params& P, unsigned char* smem) {
  const int bid = blockIdx.x, nb = gridDim.x;
  const int wave = threadIdx.x >> 6;
  unsigned char* ws = P.ws;
  constexpr int layer = ((ph >= 10 && ph <= 21) || ph >= 30) ? 1 : 0;
  const float* modv_l = (const float*)(ws + OFF_MODV) + (size_t)layer * 3 * 6144;
  switch (ph) {
    case 0:
      for (int t = bid; t < NPREP; t += nb) st_prep(P, t, smem);
      break;
    case 1: case 10:
      for (int t = bid; t < NTOK / 4; t += nb) st_normmod(P, layer, 0, t * 4 + wave);
      break;
    case 2: {
      EpiProjL0 epi{(bf16_t*)(ws + OFF_PROJ), (float*)(ws + OFF_GATES)};
      for (int t = bid; t < NTILE * 25; t += nb)
        gemm_tile_128<false>((const bf16_t*)(ws + OFF_HBUF), 1024, NTOK, (const bf16_t*)(ws + OFF_WEVIN), 1024, EVC, 1024,
                             (t / 25) * 128, (t % 25) * 128, epi, smem);
    } break;
    case 22:
      for (int t = bid; t < NTOK / 4; t += nb) st_xbc_conv(P, t * 4 + wave);
      for (int t = bid; t < NPCONV; t += nb) st_peer_conv(P, 0, t);
      break;
    case 23:
      for (int t = bid; t < 48 * LA_NSEG; t += nb) {
        int sid = t % 48, seg = t / 48;
        if (sid < 16) st_linattn_seg<true, false>(P, sid, seg, smem);
        else st_linattn_seg<false, false>(P, sid - 16, seg, smem);
      }
      break;
    case 3:
      for (int t = bid; t < 48 * LA_NSEG; t += nb) {
        int sid = t % 48, seg = t / 48;
        if (sid < 16) st_linattn_seg<true, true>(P, sid, seg, smem);
        else st_linattn_seg<false, true>(P, sid - 16, seg, smem);
      }
      break;
    case 4:
      for (int t = bid; t < NTOK / 4; t += nb) st_finish_l0(P, t * 4 + wave);
      break;
    case 5: case 17: {
      EpiOutProj epi{layer == 0 ? P.in[I_X] : P.out, P.in[I_CTX], P.out, (float*)(ws + OFF_CTXRES), modv_l};
      const bf16_t* Wt = (const bf16_t*)(ws + (layer == 0 ? OFF_WEVOUT : OFF_WODOUT));
      const int t0 = layer == 0 ? 0 : CTILE * 8;
      for (int t = t0 + bid; t < NTILE * 8; t += nb)
        gemm_tile_128<false>((const bf16_t*)(ws + OFF_HBUF), 1024, NTOK, Wt, 1024, 1024, 1024, (t / 8) * 128, (t % 8) * 128, epi, smem);
    } break;
    case 6: case 18: {
      const int r0 = layer == 0 ? 0 : NCTX / 4;
      for (int t = r0 + bid; t < NTOK / 4; t += nb) st_normmod(P, layer, 1, t * 4 + wave);
      if (ph == 18) for (int t = bid; t < NPCONV; t += nb) st_peer_conv(P, 1, t);
    } break;
    case 7: case 19: {
      EpiStoreBf epi{(bf16_t*)(ws + OFF_Q), 2048};
      const bf16_t* Wt = (const bf16_t*)(ws + OFF_WQ) + (size_t)layer * 2048 * 1024;
      const int t0 = layer == 0 ? 0 : CTILE * 16;
      for (int t = t0 + bid; t < NTILE * 16; t += nb)
        gemm_tile_128<false>((const bf16_t*)(ws + OFF_HBUF), 1024, NTOK, Wt, 1024, 2048, 1024, (t / 16) * 128, (t % 16) * 128, epi, smem);
    } break;
    case 8: case 20: {
      const int t0 = layer == 0 ? 0 : CTILE * 8;
      for (int t = t0 + bid; t < NTILE * 8; t += nb) st_peer_topk(P, layer, t / 8, t % 8, smem);
    } break;
    case 9: case 21: {
      const int r0 = layer == 0 ? 0 : NCTX / 4;
      for (int t = r0 + bid; t < NTOK / 4; t += nb) st_peer_experts(P, layer, t * 4 + wave);
    } break;
    case 11: {
      EpiStoreBf epi{(bf16_t*)(ws + OFF_PROJ), ODC};
      for (int t = bid; t < NTILE * 22; t += nb)
        gemm_tile_128<false>((const bf16_t*)(ws + OFF_HBUF), 1024, NTOK, (const bf16_t*)(ws + OFF_WODIN), 1024, ODC, 1024,
                             (t / 22) * 128, (t % 22) * 128, epi, smem);
    } break;
    case 12:
      for (int t = bid; t < NTOK / 4; t += nb) st_lora_act(P, t * 4 + wave);
      break;
    case 13:
      for (int t = bid; t < NTILE * 20; t += nb) {
        int job = t / (NTILE * 4), tt = t % (NTILE * 4);
        int mt = tt / 4, nt = tt % 4;
        bf16_t* dst = (bf16_t*)(ws + OFF_LORA) + (size_t)job * NTOK * 512;
        const bf16_t* A = (const bf16_t*)(ws + OFF_HBUF) + (job < 2 ? 0 : (job < 4 ? 64 : 128));
        const bf16_t* Bt = job < 2 ? (const bf16_t*)(ws + OFF_WUP) + (size_t)job * 512 * 64
                         : job < 4 ? (const bf16_t*)(ws + OFF_AUP) + (size_t)(job - 2) * 512 * 64
                                   : (const bf16_t*)(ws + OFF_GUP);
        const float* bias = job < 2 ? P.in[I_W0] + job * 512 : (job < 4 ? P.in[I_A0] + (job - 2) * 512 : nullptr);
        const int K = job < 4 ? 64 : 128;
        EpiStoreBfBias epi{dst, 512, bias};
        gemm_tile_128<false>(A, 1024, NTOK, Bt, K, 512, K, mt * 128, nt * 128, epi, smem);
      }
      break;
    case 30:
      for (int t = bid; t < 32 * RW_NSEG + 32 * LRU_NSEG; t += nb) {
        if (t < 32 * RW_NSEG) st_rwkv_seg<false>(P, t % 32, t / 32, smem);
        else { int u = t - 32 * RW_NSEG; st_lru_seg<false>(P, u % 32, u / 32, smem); }
      }
      break;
    case 14:
      for (int t = bid; t < 32 * RW_NSEG; t += nb) st_rwkv_seg<true>(P, t % 32, t / 32, smem);
      break;
    case 15:
      for (int t = bid; t < 32 * LRU_NSEG; t += nb) st_lru_seg<true>(P, t % 32, t / 32, smem);
      break;
    case 16:
      for (int t = bid; t < NTOK / 4; t += nb) st_finish_l1(P, t * 4 + wave);
      break;
    default: break;
  }
}

#ifndef CPU_EMU
#define RUN_PH(n) run_phase<n>(P, smem_raw); if (n != PH_LAST) cg::this_grid().sync();
__global__ void __launch_bounds__(256, 2) mega_kernel(Params P) {
  SMEM_DECL;
  PHASE_LIST(RUN_PH)
}

extern "C" void kernel_launch(void* const* d_in, const int* in_sizes, int n_in, void* d_out, int out_size, void* d_ws,
                              size_t ws_size, hipStream_t stream) {
  Params P{};
  for (int i = 0; i < N_IN; ++i) P.in[i] = (const float*)d_in[i];
  P.out = (float*)d_out;
  P.ws = (unsigned char*)d_ws;
  if (ws_size < WS_NEEDED) { fprintf(stderr, "workspace too small: %zu < %zu\n", ws_size, (size_t)WS_NEEDED); return; }
  static int grid_blocks = 0;
  if (!grid_blocks) {
    int dev = 0, cus = 0, per_cu = 0;
    hipGetDevice(&dev);
    hipDeviceGetAttribute(&cus, hipDeviceAttributeMultiprocessorCount, dev);
    hipOccupancyMaxActiveBlocksPerMultiprocessor(&per_cu, mega_kernel, 256, 0);
    if (per_cu > 2) per_cu = 2;
    grid_blocks = cus * per_cu;
  }
  void* args[] = {&P};
  hipError_t e = hipLaunchCooperativeKernel((void*)mega_kernel, dim3(grid_blocks), dim3(256), args, 0, stream);
  if (e != hipSuccess) fprintf(stderr, "cooperative launch failed: %s (grid %d)\n", hipGetErrorString(e), grid_blocks);
}
#endif
```

```cpp
#ifdef CPU_EMU
#include "emu.h"
#else
#include <hip/hip_runtime.h>
#include <hip/hip_cooperative_groups.h>
#include <cstdio>
namespace cg = cooperative_groups;
#define DEV __device__ __forceinline__
#define DEVM __device__ __forceinline__
#define OPAQUE(x) asm volatile("" : "+v"(x))
#endif

#ifndef SEQ_LEN
#define SEQ_LEN 16384
#endif
#ifndef CTX_LEN
#define CTX_LEN 256
#endif
#ifndef GRID_W_
#define GRID_W_ 64
#endif
#ifndef MULTI_LAUNCH
#define MULTI_LAUNCH 0
#endif

typedef unsigned short bf16_t;
typedef __attribute__((ext_vector_type(8))) short bf16x8;
typedef __attribute__((ext_vector_type(16))) float f32x16;
typedef __attribute__((ext_vector_type(4))) unsigned u32x4;
typedef __attribute__((ext_vector_type(2))) unsigned u32x2;
typedef __attribute__((ext_vector_type(4))) float f32x4;

constexpr int D = 1024, NB = 2, SEQ = SEQ_LEN, CTXL = CTX_LEN, GW = GRID_W_;
constexpr int NCTX = NB * CTXL, NLAT = NB * SEQ, NTOK = NCTX + NLAT;
constexpr int EVC = 3104, ODC = 2816;
constexpr int NEXP = 16384;
constexpr int NTILE = NTOK / 128, CTILE = NCTX / 128;
static_assert(NTOK % 128 == 0 && NCTX % 128 == 0, "tiles");
static_assert(CTXL % 64 == 0 && SEQ % 64 == 0 && SEQ % GW == 0, "chunks");

constexpr size_t al256(size_t x) { return (x + 255) & ~(size_t)255; }
constexpr size_t OFF_MODV = 0;
constexpr size_t OFF_CTXRES = OFF_MODV + al256(2 * 3 * 6144 * 4);
constexpr size_t OFF_GATES = OFF_CTXRES + al256((size_t)NCTX * 1024 * 4);
constexpr size_t OFF_WEVIN = OFF_GATES + al256((size_t)NTOK * 32 * 4);
constexpr size_t OFF_WEVOUT = OFF_WEVIN + al256((size_t)EVC * 1024 * 2);
constexpr size_t OFF_WODIN = OFF_WEVOUT + al256((size_t)1024 * 1024 * 2);
constexpr size_t OFF_WODOUT = OFF_WODIN + al256((size_t)ODC * 1024 * 2);
constexpr size_t OFF_WQ = OFF_WODOUT + al256((size_t)1024 * 1024 * 2);
constexpr size_t OFF_KEYS = OFF_WQ + al256((size_t)2 * 2048 * 1024 * 2);
constexpr size_t OFF_WUP = OFF_KEYS + al256((size_t)2 * 8 * 2 * 128 * 128 * 2);
constexpr size_t OFF_AUP = OFF_WUP + al256((size_t)2 * 512 * 64 * 2);
constexpr size_t OFF_GUP = OFF_AUP + al256((size_t)2 * 512 * 64 * 2);
constexpr size_t OFF_LRUT = OFF_GUP + al256((size_t)512 * 128 * 2);
constexpr size_t OFF_PU = OFF_LRUT + al256((size_t)2 * 8 * 128 * 64 * 2);
constexpr size_t OFF_PV = OFF_PU + al256((size_t)NEXP * 1024);
constexpr size_t OFF_HBUF = OFF_PV + al256((size_t)NEXP * 1024);
constexpr size_t OFF_PR = OFF_HBUF + al256((size_t)NTOK * 1024 * 2);
constexpr size_t PR_BYTES = (size_t)NTOK * 5376 * 2;
constexpr size_t OFF_BAR = OFF_PR + PR_BYTES;
constexpr size_t WS_NEEDED = OFF_BAR + 16384;
static_assert(WS_NEEDED <= (size_t)512 * 1024 * 1024, "workspace too large");
constexpr size_t OFF_PROJ = OFF_PR;
constexpr size_t OFF_R2L0 = OFF_PR + (size_t)NTOK * EVC * 2;
constexpr size_t OFF_LORA = OFF_PR + (size_t)NTOK * ODC * 2;
constexpr size_t OFF_Q = OFF_PR;
constexpr size_t OFF_PIDX = OFF_PR + (size_t)NTOK * 2048 * 2;
constexpr size_t OFF_PGATE = OFF_PIDX + (size_t)NTOK * 128 * 4;
static_assert(OFF_PGATE + (size_t)NTOK * 128 * 4 <= OFF_PR + PR_BYTES, "picks");

enum {
  I_X = 0, I_C, I_CTX, I_CCTX, I_MODW, I_MODB, I_NORM1, I_NORM2, I_WQ, I_KEYS, I_PU, I_PV,
  I_EVWIN, I_EVWOUT, I_IBIAS, I_FBIAS, I_MNORM, I_SCONVW, I_SCONVB, I_DTBIAS, I_ALOG, I_DSKIP, I_SNORM,
  I_ODWIN, I_ODWOUT, I_MU, I_W0, I_WUP, I_A0, I_AUP, I_GUP, I_KK, I_KA, I_RK, I_LNW, I_LNB,
  I_LCONVW, I_LCONVB, I_LAM, I_WA, I_BA, I_WI, I_BI, I_FNORM, N_IN
};

struct Params {
  const float* in[N_IN];
  float* out;
  unsigned char* ws;
};

constexpr int SMEM_BYTES = 80 * 1024;
#ifdef CPU_EMU
#define SMEM_DECL static thread_local __attribute__((aligned(16))) unsigned char smem_raw[SMEM_BYTES]
#else
#define SMEM_DECL __shared__ __attribute__((aligned(16))) unsigned char smem_raw[SMEM_BYTES]
#endif

DEV float bf2f(bf16_t v) { unsigned u = ((unsigned)v) << 16; float f; __builtin_memcpy(&f, &u, 4); return f; }
DEV bf16_t f2bf(float f) { unsigned u; __builtin_memcpy(&u, &f, 4); u += 0x7fffu + ((u >> 16) & 1u); return (bf16_t)(u >> 16); }
DEV unsigned pack2(float a, float b) { return (unsigned)f2bf(a) | ((unsigned)f2bf(b) << 16); }
DEV void unpack8(const u32x4& r, float* o) {
  unsigned w[4] = {r.x, r.y, r.z, r.w};
#pragma unroll
  for (int i = 0; i < 4; ++i) { unsigned lo = w[i] << 16, hi = w[i] & 0xffff0000u; __builtin_memcpy(&o[2 * i], &lo, 4); __builtin_memcpy(&o[2 * i + 1], &hi, 4); }
}
DEV u32x4 pack8(const float* o) { u32x4 r; r.x = pack2(o[0], o[1]); r.y = pack2(o[2], o[3]); r.z = pack2(o[4], o[5]); r.w = pack2(o[6], o[7]); return r; }
DEV float sigmoidf_(float x) { return 1.f / (1.f + expf(-x)); }
DEV float siluf_(float x) { return x / (1.f + expf(-x)); }
DEV float softplusf_(float x) { return fmaxf(x, 0.f) + log1pf(expf(-fabsf(x))); }
DEV float geluf_(float x) { return 0.5f * x * (1.f + erff(x * 0.70710678118654752f)); }

DEV f32x16 mfma32(bf16x8 a, bf16x8 b, f32x16 c) {
#ifdef CPU_EMU
  return emu_mfma32(a, b, c);
#else
  return __builtin_amdgcn_mfma_f32_32x32x16_bf16(a, b, c, 0, 0, 0);
#endif
}
DEV float wshfl_xor(float v, int m) {
#ifdef CPU_EMU
  return emu_shfl_xor(v, m);
#else
  return __shfl_xor(v, m, 64);
#endif
}
DEV float wave_sum(float v) {
#pragma unroll
  for (int m = 32; m >= 1; m >>= 1) v += wshfl_xor(v, m);
  return v;
}

#ifdef CPU_EMU
static inline unsigned emu_f2fp8(float f) {
  unsigned sgn = f < 0.f ? 0x80u : 0u; float a = fabsf(f);
  if (!(a == a)) return 0x7f;
  if (a >= 448.f) return sgn | 0x7e;
  if (a < 0.0009765625f) return sgn;
  int e; frexpf(a, &e); e -= 1;
  if (e < -6) { int q = (int)nearbyintf(a * 512.f); return sgn | (unsigned)q; }
  float m = a / ldexpf(1.f, e);
  int q = (int)nearbyintf((m - 1.f) * 8.f);
  if (q == 8) { q = 0; e += 1; }
  if (e > 8) return sgn | 0x7e;
  return sgn | (unsigned)((e + 7) << 3) | (unsigned)q;
}
static inline float emu_fp82f(unsigned c) {
  unsigned sgn = c & 0x80, e = (c >> 3) & 15, m = c & 7;
  float v = e == 0 ? ldexpf((float)m, -9) : ldexpf(1.f + m / 8.f, (int)e - 7);
  return sgn ? -v : v;
}
#endif
DEV unsigned pack4_fp8(float a, float b, float c, float d) {
#ifdef CPU_EMU
  return emu_f2fp8(a) | (emu_f2fp8(b) << 8) | (emu_f2fp8(c) << 16) | (emu_f2fp8(d) << 24);
#else
  int w = 0;
  w = __builtin_amdgcn_cvt_pk_fp8_f32(a, b, w, false);
  w = __builtin_amdgcn_cvt_pk_fp8_f32(c, d, w, true);
  return (unsigned)w;
#endif
}
DEV void unpack4_fp8(unsigned w, float* o) {
#ifdef CPU_EMU
  o[0] = emu_fp82f(w & 255); o[1] = emu_fp82f((w >> 8) & 255); o[2] = emu_fp82f((w >> 16) & 255); o[3] = emu_fp82f(w >> 24);
#else
  typedef __attribute__((ext_vector_type(2))) float f32x2_;
  f32x2_ lo = __builtin_amdgcn_cvt_pk_f32_fp8((int)w, false);
  f32x2_ hi = __builtin_amdgcn_cvt_pk_f32_fp8((int)w, true);
  o[0] = lo.x; o[1] = lo.y; o[2] = hi.x; o[3] = hi.y;
#endif
}
DEV void unpack16_fp8(const u32x4& r, float* o) { unpack4_fp8(r.x, o); unpack4_fp8(r.y, o + 4); unpack4_fp8(r.z, o + 8); unpack4_fp8(r.w, o + 12); }
DEV float wreadlane(float v, int srclane) {
#ifdef CPU_EMU
  return emu_readlane(v, srclane);
#else
  int iv; __builtin_memcpy(&iv, &v, 4);
  int r = __builtin_amdgcn_readlane(iv, srclane);
  float f; __builtin_memcpy(&f, &r, 4); return f;
#endif
}
constexpr float PEER_USCALE = 64.f, PEER_VSCALE = 4.f;

DEV int acc_row(int reg, int lane) { return (reg & 3) + 8 * (reg >> 2) + 4 * (lane >> 5); }

DEV int mod_row(int row) { return row < NCTX ? 2 : (row - NCTX) / SEQ; }

template <bool SYNC_EPI, class Epi>
DEV void gemm_tile_128(const bf16_t* __restrict__ A, int lda, int M, const bf16_t* __restrict__ Bt, int ldb, int N,
                       int K, int m0, int n0, const Epi& epi, unsigned char* smem) {
  constexpr int LS = 72;
  bf16_t* sA = (bf16_t*)smem;
  bf16_t* sB = sA + 128 * LS;
  const int tid = threadIdx.x, lane = tid & 63, wave = tid >> 6;
  const int wm = (wave >> 1) * 64, wn = (wave & 1) * 64;
  f32x16 acc[2][2];
#pragma unroll
  for (int i = 0; i < 2; ++i)
#pragma unroll
    for (int j = 0; j < 2; ++j)
#pragma unroll
      for (int r = 0; r < 16; ++r) acc[i][j][r] = 0.f;
  u32x4 ra[4], rb[4];
  const u32x4 z4 = {0u, 0u, 0u, 0u};
#pragma unroll
  for (int i = 0; i < 4; ++i) {
    int c = tid + i * 256, r = c >> 3, cc = (c & 7) * 8;
    int gr = m0 + r, gn = n0 + r;
    ra[i] = gr < M ? *(const u32x4*)(A + (size_t)gr * lda + cc) : z4;
    rb[i] = gn < N ? *(const u32x4*)(Bt + (size_t)gn * ldb + cc) : z4;
  }
  for (int k0 = 0; k0 < K; k0 += 64) {
    __syncthreads();
#pragma unroll
    for (int i = 0; i < 4; ++i) {
      int c = tid + i * 256, r = c >> 3, cc = (c & 7) * 8;
      *(u32x4*)(sA + r * LS + cc) = ra[i];
      *(u32x4*)(sB + r * LS + cc) = rb[i];
    }
    __syncthreads();
    if (k0 + 64 < K) {
#pragma unroll
      for (int i = 0; i < 4; ++i) {
        int c = tid + i * 256, r = c >> 3, cc = (c & 7) * 8;
        int gr = m0 + r, gn = n0 + r;
        ra[i] = gr < M ? *(const u32x4*)(A + (size_t)gr * lda + k0 + 64 + cc) : z4;
        rb[i] = gn < N ? *(const u32x4*)(Bt + (size_t)gn * ldb + k0 + 64 + cc) : z4;
      }
    }
#pragma unroll
    for (int kk = 0; kk < 4; ++kk) {
      bf16x8 a[2], b[2];
      const int ko = kk * 16 + 8 * (lane >> 5);
#pragma unroll
      for (int i = 0; i < 2; ++i) a[i] = *(const bf16x8*)(sA + (wm + i * 32 + (lane & 31)) * LS + ko);
#pragma unroll
      for (int j = 0; j < 2; ++j) b[j] = *(const bf16x8*)(sB + (wn + j * 32 + (lane & 31)) * LS + ko);
#pragma unroll
      for (int i = 0; i < 2; ++i)
#pragma unroll
        for (int j = 0; j < 2; ++j) acc[i][j] = mfma32(a[i], b[j], acc[i][j]);
    }
  }
  if (SYNC_EPI) __syncthreads();
#pragma unroll
  for (int i = 0; i < 2; ++i)
#pragma unroll
    for (int j = 0; j < 2; ++j)
#pragma unroll
      for (int r = 0; r < 16; ++r) {
        int row = m0 + wm + i * 32 + acc_row(r, lane);
        int col = n0 + wn + j * 32 + (lane & 31);
        if (row < M && col < N) epi(row, col, acc[i][j][r]);
      }
}

DEV void transpose_tile(const float* __restrict__ src, int ld_src, bf16_t* __restrict__ dst, int ld_dst, int K, int N,
                        int tk, int tn, unsigned char* smem) {
  float* sT = (float*)smem;
  const int tid = threadIdx.x;
  __syncthreads();
  {
    const int tx = tid & 15, ty = tid >> 4;
#pragma unroll
    for (int p = 0; p < 4; ++p) {
      int k = tk * 64 + ty + p * 16, n = tn * 64 + tx * 4;
#pragma unroll
      for (int j = 0; j < 4; ++j) {
        float v = (k < K && n + j < N) ? src[(size_t)k * ld_src + n + j] : 0.f;
        sT[(ty + p * 16) * 65 + tx * 4 + j] = v;
      }
    }
  }
  __syncthreads();
  {
    const int n = tid >> 2, kseg = (tid & 3) * 16;
    int gn = tn * 64 + n;
    if (gn < N) {
      float v[16];
#pragma unroll
      for (int j = 0; j < 16; ++j) v[j] = sT[(kseg + j) * 65 + n];
      bf16_t* d = dst + (size_t)gn * ld_dst + tk * 64 + kseg;
      *(u32x4*)d = pack8(v);
      *(u32x4*)(d + 8) = pack8(v + 8);
    }
  }
}

constexpr int TJ0 = 16 * 49, TJ1 = 16 * 16, TJ2 = 16 * 44, TJ3 = 16 * 16, TJ4 = 2 * 16 * 32, TJ5 = 2 * 8, TJ6 = 2 * 8,
              TJ7 = 2 * 8, TJ8 = 32;
constexpr int NTRANS = TJ0 + TJ1 + TJ2 + TJ3 + TJ4 + TJ5 + TJ6 + TJ7 + TJ8;
constexpr int NKEYCV = (2 * 8 * 2 * 128 * 128) / (256 * 8);
constexpr int NMODV = 2 * 96;
constexpr int NPREP = NTRANS + NKEYCV + NMODV;

DEV void st_prep(const Params& P, int item, unsigned char* smem) {
  unsigned char* ws = P.ws;
  if (item < NTRANS) {
    int t = item;
    if (t < TJ0) { transpose_tile(P.in[I_EVWIN], EVC, (bf16_t*)(ws + OFF_WEVIN), 1024, 1024, EVC, t / 49, t % 49, smem); return; }
    t -= TJ0;
    if (t < TJ1) { transpose_tile(P.in[I_EVWOUT], 1024, (bf16_t*)(ws + OFF_WEVOUT), 1024, 1024, 1024, t / 16, t % 16, smem); return; }
    t -= TJ1;
    if (t < TJ2) { transpose_tile(P.in[I_ODWIN], ODC, (bf16_t*)(ws + OFF_WODIN), 1024, 1024, ODC, t / 44, t % 44, smem); return; }
    t -= TJ2;
    if (t < TJ3) { transpose_tile(P.in[I_ODWOUT], 1024, (bf16_t*)(ws + OFF_WODOUT), 1024, 1024, 1024, t / 16, t % 16, smem); return; }
    t -= TJ3;
    if (t < TJ4) {
      int l = t / 512, tt = t % 512;
      transpose_tile(P.in[I_WQ] + (size_t)l * 1024 * 2048, 2048, (bf16_t*)(ws + OFF_WQ) + (size_t)l * 2048 * 1024, 1024, 1024, 2048, tt / 32, tt % 32, smem);
      return;
    }
    t -= TJ4;
    if (t < TJ5) { int d = t / 8; transpose_tile(P.in[I_WUP] + d * 64 * 512, 512, (bf16_t*)(ws + OFF_WUP) + d * 512 * 64, 64, 64, 512, 0, t % 8, smem); return; }
    t -= TJ5;
    if (t < TJ6) { int d = t / 8; transpose_tile(P.in[I_AUP] + d * 64 * 512, 512, (bf16_t*)(ws + OFF_AUP) + d * 512 * 64, 64, 64, 512, 0, t % 8, smem); return; }
    t -= TJ6;
    if (t < TJ7) { transpose_tile(P.in[I_GUP], 512, (bf16_t*)(ws + OFF_GUP), 128, 128, 512, t / 8, t % 8, smem); return; }
    t -= TJ7;
    {
      int which = t & 1, db = t >> 1;
      const float* src = (which ? P.in[I_WI] : P.in[I_WA]) + (size_t)db * 64 * 64;
      transpose_tile(src, 64, (bf16_t*)(ws + OFF_LRUT) + (size_t)db * 128 * 64 + which * 64 * 64, 64, 64, 64, 0, 0, smem);
      return;
    }
  }
  item -= NTRANS;
  if (item < NKEYCV) {
    size_t e = ((size_t)item * 256 + threadIdx.x) * 8;
    const float* s = P.in[I_KEYS] + e;
    f32x4 a = *(const f32x4*)s, b = *(const f32x4*)(s + 4);
    float v[8] = {a.x, a.y, a.z, a.w, b.x, b.y, b.z, b.w};
    *(u32x4*)((bf16_t*)(ws + OFF_KEYS) + e) = pack8(v);
    return;
  }
  item -= NKEYCV;
  {
    const int l = item / 96, cgp = item % 96;
    float* sS = (float*)smem;
    float* sRed = sS + 3 * 1024;
    const int tid = threadIdx.x;
    __syncthreads();
    for (int i = tid; i < 3 * 1024; i += 256) {
      int m = i >> 10, k = i & 1023;
      float c = m < 2 ? P.in[I_C][m * 1024 + k] : P.in[I_CCTX][k];
      sS[i] = siluf_(c);
    }
    __syncthreads();
    const int ks = tid >> 6, col = cgp * 64 + (tid & 63);
    const float* w = P.in[I_MODW] + (size_t)l * 1024 * 6144 + col;
    float a0 = 0.f, a1 = 0.f, a2 = 0.f;
    for (int k = ks * 256; k < ks * 256 + 256; ++k) {
      float wv = w[(size_t)k * 6144];
      a0 += sS[k] * wv; a1 += sS[1024 + k] * wv; a2 += sS[2048 + k] * wv;
    }
    sRed[(ks * 3 + 0) * 64 + (tid & 63)] = a0;
    sRed[(ks * 3 + 1) * 64 + (tid & 63)] = a1;
    sRed[(ks * 3 + 2) * 64 + (tid & 63)] = a2;
    __syncthreads();
    if (tid < 192) {
      int m = tid >> 6, c = tid & 63;
      float s = sRed[(0 * 3 + m) * 64 + c] + sRed[(1 * 3 + m) * 64 + c] + sRed[(2 * 3 + m) * 64 + c] + sRed[(3 * 3 + m) * 64 + c];
      int cc = cgp * 64 + c;
      ((float*)(ws + OFF_MODV))[((size_t)l * 3 + m) * 6144 + cc] = s + P.in[I_MODB][l * 6144 + cc];
    }
  }
}

constexpr int NPCONV = 2 * (NEXP * 1024 / (256 * 16));
DEV void st_peer_conv(const Params& P, int layer, int item) {
  const int half = NPCONV / 2;
  int which = item >= half;
  int it = which ? item - half : item;
  size_t e = ((size_t)it * 256 + threadIdx.x) * 16;
  const float* s = (which ? P.in[I_PV] : P.in[I_PU]) + (size_t)layer * NEXP * 1024 + e;
  const float sc = which ? PEER_VSCALE : PEER_USCALE;
  u32x4 o;
  f32x4 a = *(const f32x4*)s; o.x = pack4_fp8(a.x * sc, a.y * sc, a.z * sc, a.w * sc);
  a = *(const f32x4*)(s + 4); o.y = pack4_fp8(a.x * sc, a.y * sc, a.z * sc, a.w * sc);
  a = *(const f32x4*)(s + 8); o.z = pack4_fp8(a.x * sc, a.y * sc, a.z * sc, a.w * sc);
  a = *(const f32x4*)(s + 12); o.w = pack4_fp8(a.x * sc, a.y * sc, a.z * sc, a.w * sc);
  *(u32x4*)(P.ws + (which ? OFF_PV : OFF_PU) + e) = o;
}

DEV void st_normmod(const Params& P, int layer, int which, int row) {
  const int lane = threadIdx.x & 63;
  const float* src;
  if (which == 0 && layer == 0) src = row < NCTX ? P.in[I_CTX] + (size_t)row * 1024 : P.in[I_X] + (size_t)(row - NCTX) * 1024;
  else src = row < NCTX ? (const float*)(P.ws + OFF_CTXRES) + (size_t)row * 1024 : P.out + (size_t)(row - NCTX) * 1024;
  const float* mv = (const float*)(P.ws + OFF_MODV) + ((size_t)layer * 3 + mod_row(row)) * 6144;
  const float* sh = mv + (which ? 3 : 0) * 1024;
  const float* sc = mv + (which ? 4 : 1) * 1024;
  const float* nw = (which ? P.in[I_NORM2] : P.in[I_NORM1]) + layer * 1024;
  f32x4 v[4];
  float ss = 0.f;
#pragma unroll
  for (int i = 0; i < 4; ++i) {
    v[i] = *(const f32x4*)(src + i * 256 + lane * 4);
    ss += v[i].x * v[i].x + v[i].y * v[i].y + v[i].z * v[i].z + v[i].w * v[i].w;
  }
  ss = wave_sum(ss);
  const float rstd = rsqrtf(ss * (1.f / 1024.f) + 1e-6f);
  bf16_t* dst = (bf16_t*)(P.ws + OFF_HBUF) + (size_t)row * 1024;
#pragma unroll
  for (int i = 0; i < 4; ++i) {
    int c = i * 256 + lane * 4;
    f32x4 w4 = *(const f32x4*)(nw + c), s4 = *(const f32x4*)(sc + c), h4 = *(const f32x4*)(sh + c);
    float o0 = v[i].x * rstd * w4.x * (1.f + s4.x) + h4.x;
    float o1 = v[i].y * rstd * w4.y * (1.f + s4.y) + h4.y;
    float o2 = v[i].z * rstd * w4.z * (1.f + s4.z) + h4.z;
    float o3 = v[i].w * rstd * w4.w * (1.f + s4.w) + h4.w;
    u32x2 pk; pk.x = pack2(o0, o1); pk.y = pack2(o2, o3);
    *(u32x2*)(dst + c) = pk;
  }
}

struct EpiProjL0 {
  bf16_t* proj; float* gates;
  DEVM void operator()(int row, int col, float v) const {
    proj[(size_t)row * EVC + col] = f2bf(v);
    if (col >= 1536 && col < 1552) gates[row * 32 + (col - 1536)] = v;
    else if (col >= 3088) gates[row * 32 + 16 + (col - 3088)] = v;
  }
};
struct EpiStoreBf {
  bf16_t* dst; int ld;
  DEVM void operator()(int row, int col, float v) const { dst[(size_t)row * ld + col] = f2bf(v); }
};
struct EpiStoreBfBias {
  bf16_t* dst; int ld; const float* bias;
  DEVM void operator()(int row, int col, float v) const { dst[(size_t)row * ld + col] = f2bf(v + (bias ? bias[col] : 0.f)); }
};
struct EpiOutProj {
  const float* x_lat; const float* x_ctx; float* o_lat; float* o_ctx; const float* modv;
  DEVM void operator()(int row, int col, float v) const {
    float g = modv[mod_row(row) * 6144 + 2 * 1024 + col];
    if (row < NCTX) o_ctx[(size_t)row * 1024 + col] = x_ctx[(size_t)row * 1024 + col] + g * v;
    else { size_t o = (size_t)(row - NCTX) * 1024 + col; o_lat[o] = x_lat[o] + g * v; }
  }
};
struct EpiScoreLds {
  float* sS; int m0;
  DEVM void operator()(int row, int col, float v) const { sS[(row - m0) * 129 + col] = v; }
};

DEV void st_xbc_conv(const Params& P, int row) {
  const int lane = threadIdx.x & 63;
  const bf16_t* proj = (const bf16_t*)(P.ws + OFF_PROJ);
  bf16_t* xc = (bf16_t*)P.out + (size_t)row * 1024;
  int row0, len, pos;
  if (row < NCTX) { row0 = (row / CTXL) * CTXL; len = CTXL; pos = row - row0; }
  else { int r = row - NCTX; row0 = NCTX + (r / SEQ) * SEQ; len = SEQ; pos = r % SEQ; }
  const float* cw = P.in[I_SCONVW];
  const float* cb = P.in[I_SCONVB];
#pragma unroll
  for (int hh = 0; hh < 2; ++hh) {
    const int ch = hh * 512 + lane * 8;
    float o[8];
#pragma unroll
    for (int j = 0; j < 8; ++j) o[j] = cb[ch + j];
#pragma unroll
    for (int tap = 0; tap < 4; ++tap) {
      int pp = pos + tap - 2;
      if (pp >= 0 && pp < len) {
        float x[8];
        unpack8(*(const u32x4*)(proj + (size_t)(row0 + pp) * EVC + 2064 + ch), x);
        f32x4 w0 = *(const f32x4*)(cw + tap * 1024 + ch), w1 = *(const f32x4*)(cw + tap * 1024 + ch + 4);
        o[0] += w0.x * x[0]; o[1] += w0.y * x[1]; o[2] += w0.z * x[2]; o[3] += w0.w * x[3];
        o[4] += w1.x * x[4]; o[5] += w1.y * x[5]; o[6] += w1.z * x[6]; o[7] += w1.w * x[7];
      }
    }
#pragma unroll
    for (int j = 0; j < 8; ++j) o[j] = siluf_(o[j]);
    *(u32x4*)(xc + ch) = pack8(o);
  }
}

#ifndef LA_NSEG
#define LA_NSEG 10
#endif
constexpr int LA_NCH = (CTXL + SEQ) / 64;
constexpr int LA_CPS = LA_NCH / LA_NSEG;
static_assert(LA_NCH % LA_NSEG == 0, "linattn segments");
#ifdef CPU_EMU
constexpr size_t OFF_LASEG = OFF_PR + PR_BYTES;
#else
constexpr size_t OFF_LASEG = OFF_R2L0 + (size_t)NTOK * 1024 * 2;
#endif
constexpr size_t LASEG_U = (size_t)48 * LA_NSEG * 8192 * 4;
constexpr size_t OFF_LASEG_N = OFF_LASEG + LASEG_U;
constexpr size_t OFF_LASEG_D = OFF_LASEG_N + (size_t)48 * LA_NSEG * 64 * 4;
#ifndef CPU_EMU
static_assert(OFF_LASEG_D + 48 * LA_NSEG * 4 <= OFF_PR + PR_BYTES, "laseg");
#endif

struct LaRaw { u32x4 q[2], k[4], x[4]; float g0, g1; };

template <bool MLSTM, bool FULL>
DEV void la_load_raw(const Params& P, int b, int h, int d, int cc, LaRaw& R) {
  constexpr int NC_CTX = CTXL / 64;
  const int tid = threadIdx.x;
  const int seg = cc >= NC_CTX;
  const int row0 = seg ? NCTX + b * SEQ : b * CTXL;
  const int len = seg ? SEQ : CTXL;
  const int cl = (seg ? cc - NC_CTX : cc) * 64;
  const bf16_t* proj = (const bf16_t*)(P.ws + OFF_PROJ);
  const bf16_t* xcv = (const bf16_t*)P.out;
  const float* gates = (const float*)(P.ws + OFF_GATES);
  if (tid < 64) {
    int p = cl + tid, grow = row0 + (d ? len - 1 - p : p);
    if (MLSTM) { R.g0 = gates[grow * 32 + d * 4 + h]; R.g1 = gates[grow * 32 + 8 + d * 4 + h]; }
    else { R.g0 = gates[grow * 32 + 16 + d * 8 + h]; R.g1 = 0.f; }
  }
  if (MLSTM) {
#pragma unroll
    for (int i = 0; i < 2; ++i) {
      int c = tid + i * 256, r = c >> 3, cc8 = (c & 7) * 8;
      int p = cl + r, pos = d ? len - 1 - p : p;
      const bf16_t* rp = proj + (size_t)(row0 + pos) * EVC;
      if (FULL) R.q[i] = *(const u32x4*)(rp + h * 64 + cc8);
      R.k[i] = *(const u32x4*)(rp + 256 + h * 64 + cc8);
    }
#pragma unroll
    for (int i = 0; i < 4; ++i) {
      int c = tid + i * 256, r = c >> 4, cc8 = (c & 15) * 8;
      int p = cl + r, pos = d ? len - 1 - p : p;
      R.x[i] = *(const u32x4*)(proj + (size_t)(row0 + pos) * EVC + 512 + h * 128 + cc8);
    }
  } else {
    const int grp = h >> 2;
#pragma unroll
    for (int i = 0; i < 2; ++i) {
      int c = tid + i * 256, r = c >> 3, cc8 = (c & 7) * 8;
      int p = cl + r, pos = d ? len - 1 - p : p;
      R.x[i] = *(const u32x4*)(xcv + (size_t)(row0 + pos) * 1024 + h * 64 + cc8);
    }
#pragma unroll
    for (int i = 0; i < 4; ++i) {
      int c = tid + i * 256, r = c >> 4, cc8 = (c & 15) * 8;
      int p = cl + r, pos = d ? len - 1 - p : p;
      const bf16_t* rp = xcv + (size_t)(row0 + pos) * 1024;
      R.k[i] = *(const u32x4*)(rp + 512 + grp * 128 + cc8);
      if (FULL) { if (i < 2) R.q[i] = *(const u32x4*)(rp + 768 + grp * 128 + cc8); else R.x[i] = *(const u32x4*)(rp + 768 + grp * 128 + cc8); }
    }
  }
}

template <bool MLSTM, bool FULL>
DEV void st_linattn_seg(const Params& P, int sid, int seg, unsigned char* smem) {
  constexpr int DK = MLSTM ? 64 : 128, DX = MLSTM ? 128 : 64;
  constexpr int QS = DK + 8;
  constexpr int NH = MLSTM ? 4 : 8;
  constexpr int NC_CTX = CTXL / 64;
  const int tid = threadIdx.x, lane = tid & 63, wave = tid >> 6;
  const int d = sid & 1, h = (sid >> 1) % NH, b = (sid >> 1) / NH;
  const int gsid = MLSTM ? sid : 16 + sid;
  bf16_t* sQ = (bf16_t*)smem;
  bf16_t* sK = sQ + 64 * QS;
  bf16_t* sP = sK;
  bf16_t* sKT = sK + 64 * QS;
  bf16_t* sXT = sKT + DK * 72;
  bf16_t* sST = sXT + DX * 72;
  float* sF = (float*)(sST + DX * QS);
  float* sLa = sF;
  float* sG = sF + 64;
  float* sBc = sF + 128;
  float* sDen = sF + 192;
  float* sN = sF + 256;
  int* sRow = (int*)(sF + 384);
  static_assert((64 * QS * 2 + DK * 72 + DX * 72 + DX * QS) * 2 + 448 * 4 <= SMEM_BYTES, "lds");
  bf16_t* outb = MLSTM ? (bf16_t*)(P.ws + OFF_HBUF) : (bf16_t*)(P.ws + OFF_R2L0);
  float* segU = (float*)(P.ws + OFF_LASEG);
  float* segN = (float*)(P.ws + OFF_LASEG_N);
  float* segD = (float*)(P.ws + OFF_LASEG_D);

  f32x16 accS[2];
#pragma unroll
  for (int j = 0; j < 2; ++j)
#pragma unroll
    for (int r = 0; r < 16; ++r) accS[j][r] = 0.f;
  const int sx0 = MLSTM ? wave * 32 : (wave >> 1) * 32;
  const int sk0 = MLSTM ? 0 : (wave & 1) * 64;
  float nreg = 0.f;
  float gb0 = 0.f, gb1 = 0.f, alog_e = 0.f, dskip = 0.f;
  if (MLSTM) { gb0 = P.in[I_IBIAS][d * 4 + h]; gb1 = P.in[I_FBIAS][d * 4 + h]; }
  else { gb0 = P.in[I_DTBIAS][d * 8 + h]; alog_e = expf(P.in[I_ALOG][d * 8 + h]); dskip = P.in[I_DSKIP][h]; }

  const int cc0 = seg * LA_CPS, cc1 = cc0 + LA_CPS;
  LaRaw R;
  la_load_raw<MLSTM, FULL>(P, b, h, d, cc0, R);
  __syncthreads();
  if (FULL) {
    for (int js = 0; js < seg; ++js) {
      const size_t it = (size_t)gsid * LA_NSEG + js;
      const float a = expf(segD[it]);
      const float* U = segU + it * 8192;
#pragma unroll
      for (int j = 0; j < 2; ++j)
#pragma unroll
        for (int r = 0; r < 16; ++r) accS[j][r] = a * accS[j][r] + U[(j * 16 + r) * 256 + tid];
      if (MLSTM && tid < 64) nreg = a * nreg + segN[it * 64 + tid];
    }
#pragma unroll
    for (int j = 0; j < 2; ++j)
#pragma unroll
      for (int r = 0; r < 16; ++r) sST[(sx0 + acc_row(r, lane)) * QS + sk0 + j * 32 + (lane & 31)] = f2bf(accS[j][r]);
    if (tid < 128) sN[tid] = (MLSTM && tid < 64) ? nreg : 0.f;
  }
  float lsum = 0.f;

  for (int cc = cc0; cc < cc1; ++cc) {
    int tl_ = threadIdx.x; OPAQUE(tl_);
    const int tid = tl_, lane = tl_ & 63;
    const int sgi = cc >= NC_CTX;
    const int row0 = sgi ? NCTX + b * SEQ : b * CTXL;
    const int len = sgi ? SEQ : CTXL;
    const int cl = (sgi ? cc - NC_CTX : cc) * 64;
    if (tid < 64) {
      int p = cl + tid;
      sRow[tid] = row0 + (d ? len - 1 - p : p);
      if (MLSTM) { sLa[tid] = -softplusf_(-(R.g1 + gb1)); sG[tid] = expf(R.g0 + gb0); }
      else { float dt = softplusf_(R.g0 + gb0); sLa[tid] = -dt * alog_e; sG[tid] = dt; }
    }
    __syncthreads();
    if (wave == 0) {
      float v = sLa[lane];
#pragma unroll
      for (int off = 1; off < 64; off <<= 1) {
#ifdef CPU_EMU
        float o = emu_shfl_up(v, off);
#else
        float o = __shfl_up(v, off, 64);
#endif
        if (lane >= off) v += o;
      }
      sBc[lane] = v;
    }
    __syncthreads();
    const float blast = sBc[63];
    lsum += blast;
    if (MLSTM) {
#pragma unroll
      for (int i = 0; i < 2; ++i) {
        int c = tid + i * 256, r = c >> 3, cc8 = (c & 7) * 8;
        float kf[8]; unpack8(R.k[i], kf);
        const float wgt = expf(blast - sBc[r]) * sG[r];
#pragma unroll
        for (int j = 0; j < 8; ++j) sKT[(cc8 + j) * 72 + r] = f2bf(kf[j] * wgt);
        if (FULL) {
          float qf[8]; unpack8(R.q[i], qf);
#pragma unroll
          for (int j = 0; j < 8; ++j) qf[j] *= 0.125f;
          *(u32x4*)(sQ + r * QS + cc8) = pack8(qf);
          *(u32x4*)(sK + r * QS + cc8) = R.k[i];
        }
      }
#pragma unroll
      for (int i = 0; i < 4; ++i) {
        int c = tid + i * 256, r = c >> 4, cc8 = (c & 15) * 8;
        const bf16_t* xs = (const bf16_t*)&R.x[i];
#pragma unroll
        for (int j = 0; j < 8; ++j) sXT[(cc8 + j) * 72 + r] = xs[j];
      }
    } else {
#pragma unroll
      for (int i = 0; i < 2; ++i) {
        int c = tid + i * 256, r = c >> 3, cc8 = (c & 7) * 8;
        const bf16_t* xs = (const bf16_t*)&R.x[i];
#pragma unroll
        for (int j = 0; j < 8; ++j) sXT[(cc8 + j) * 72 + r] = xs[j];
      }
#pragma unroll
      for (int i = 0; i < 4; ++i) {
        int c = tid + i * 256, r = c >> 4, cc8 = (c & 15) * 8;
        float kf[8]; unpack8(R.k[i], kf);
        const float wgt = expf(blast - sBc[r]) * sG[r];
#pragma unroll
        for (int j = 0; j < 8; ++j) sKT[(cc8 + j) * 72 + r] = f2bf(kf[j] * wgt);
        if (FULL) {
          *(u32x4*)(sK + r * QS + cc8) = R.k[i];
          *(u32x4*)(sQ + r * QS + cc8) = i < 2 ? R.q[i] : R.x[i];
        }
      }
    }
    if (cc + 1 < cc1) la_load_raw<MLSTM, FULL>(P, b, h, d, cc + 1, R);
    __syncthreads();
    if (FULL) {
      const int tr = (wave >> 1) * 32, tc = (wave & 1) * 32;
      f32x16 accP;
#pragma unroll
      for (int r = 0; r < 16; ++r) accP[r] = 0.f;
      if (!(tr == 0 && tc == 32)) {
#pragma unroll
        for (int kk = 0; kk < DK / 16; ++kk) {
          const int ko = kk * 16 + 8 * (lane >> 5);
          bf16x8 a = *(const bf16x8*)(sQ + (tr + (lane & 31)) * QS + ko);
          bf16x8 bb = *(const bf16x8*)(sK + (tc + (lane & 31)) * QS + ko);
          accP = mfma32(a, bb, accP);
        }
      }
      __syncthreads();
      {
        const int s = tc + (lane & 31);
        const float bs = sBc[s], gs = sG[s];
#pragma unroll
        for (int r = 0; r < 16; ++r) {
          int t = tr + acc_row(r, lane);
          float v = (s <= t) ? accP[r] * expf(sBc[t] - bs) * gs : 0.f;
          sP[t * 72 + s] = f2bf(v);
        }
        for (int i = tid; i < 64 * DK; i += 256) {
          int t = i / DK, k = i % DK;
          sQ[t * QS + k] = f2bf(bf2f(sQ[t * QS + k]) * expf(sBc[t]));
        }
      }
      __syncthreads();
      constexpr int NYT = MLSTM ? 2 : 1;
      const int yc0 = MLSTM ? (wave & 1) * 64 : (wave & 1) * 32;
      f32x16 accY[NYT];
#pragma unroll
      for (int j = 0; j < NYT; ++j)
#pragma unroll
        for (int r = 0; r < 16; ++r) accY[j][r] = 0.f;
#pragma unroll
      for (int kk = 0; kk < 4; ++kk) {
        const int ko = kk * 16 + 8 * (lane >> 5);
        bf16x8 a = *(const bf16x8*)(sP + (tr + (lane & 31)) * 72 + ko);
#pragma unroll
        for (int j = 0; j < NYT; ++j) {
          bf16x8 bb = *(const bf16x8*)(sXT + (yc0 + j * 32 + (lane & 31)) * 72 + ko);
          accY[j] = mfma32(a, bb, accY[j]);
        }
      }
#pragma unroll
      for (int kk = 0; kk < DK / 16; ++kk) {
        const int ko = kk * 16 + 8 * (lane >> 5);
        bf16x8 a = *(const bf16x8*)(sQ + (tr + (lane & 31)) * QS + ko);
#pragma unroll
        for (int j = 0; j < NYT; ++j) {
          bf16x8 bb = *(const bf16x8*)(sST + (yc0 + j * 32 + (lane & 31)) * QS + ko);
          accY[j] = mfma32(a, bb, accY[j]);
        }
      }
      if (MLSTM) {
        if (tid < 64) {
          float den = 0.f, dq = 0.f;
#pragma unroll 8
          for (int s = 0; s < 64; ++s) den += bf2f(sP[tid * 72 + s]);
#pragma unroll 8
          for (int k = 0; k < DK; ++k) dq += sN[k] * bf2f(sQ[tid * QS + k]);
          sDen[tid] = den + dq;
        }
        __syncthreads();
      }
#pragma unroll
      for (int j = 0; j < NYT; ++j)
#pragma unroll
        for (int r = 0; r < 16; ++r) {
          int t = tr + acc_row(r, lane);
          int x = yc0 + j * 32 + (lane & 31);
          float v = accY[j][r];
          if (MLSTM) {
            v = v / fmaxf(fabsf(sDen[t]), 1.f);
            outb[(size_t)sRow[t] * 1024 + d * 512 + h * 128 + x] = f2bf(v);
          } else {
            if (d == 0) v += dskip * bf2f(sXT[x * 72 + t]);
            outb[(size_t)sRow[t] * 1024 + d * 512 + h * 64 + x] = f2bf(v);
          }
        }
      __syncthreads();
    }
    {
      const float eb = expf(blast);
#pragma unroll
      for (int j = 0; j < 2; ++j)
#pragma unroll
        for (int r = 0; r < 16; ++r) accS[j][r] *= eb;
#pragma unroll
      for (int kk = 0; kk < 4; ++kk) {
        const int ko = kk * 16 + 8 * (lane >> 5);
        bf16x8 a = *(const bf16x8*)(sXT + (sx0 + (lane & 31)) * 72 + ko);
#pragma unroll
        for (int j = 0; j < 2; ++j) {
          bf16x8 bb = *(const bf16x8*)(sKT + (sk0 + j * 32 + (lane & 31)) * 72 + ko);
          accS[j] = mfma32(a, bb, accS[j]);
        }
      }
      if (FULL) {
#pragma unroll
        for (int j = 0; j < 2; ++j)
#pragma unroll
          for (int r = 0; r < 16; ++r) sST[(sx0 + acc_row(r, lane)) * QS + sk0 + j * 32 + (lane & 31)] = f2bf(accS[j][r]);
      }
      if (MLSTM && tid < 64) {
        float nn = nreg * eb;
        for (int s = 0; s < 64; ++s) nn += bf2f(sKT[tid * 72 + s]);
        nreg = nn;
        if (FULL) sN[tid] = nn;
      }
    }
    __syncthreads();
  }
  if (!FULL) {
    const size_t it = (size_t)gsid * LA_NSEG + seg;
    float* U = segU + it * 8192;
#pragma unroll
    for (int j = 0; j < 2; ++j)
#pragma unroll
      for (int r = 0; r < 16; ++r) U[(j * 16 + r) * 256 + tid] = accS[j][r];
    if (MLSTM && tid < 64) segN[it * 64 + tid] = nreg;
    if (tid == 0) segD[it] = lsum;
  }
}

DEV void st_finish_l0(const Params& P, int row) {
  const int lane = threadIdx.x & 63;
  bf16_t* hb = (bf16_t*)(P.ws + OFF_HBUF) + (size_t)row * 1024;
  const bf16_t* yb = (const bf16_t*)(P.ws + OFF_R2L0) + (size_t)row * 1024;
  const bf16_t* pr = (const bf16_t*)(P.ws + OFF_PROJ) + (size_t)row * EVC;
  const int ch = lane * 8;
  float h0[8], h1[8], o[8], f1[8];
  unpack8(*(const u32x4*)(hb + ch), h0);
  unpack8(*(const u32x4*)(hb + 512 + ch), h1);
  unpack8(*(const u32x4*)(pr + 1024 + ch), o);
  float ss = 0.f;
#pragma unroll
  for (int j = 0; j < 8; ++j) { h0[j] += h1[j]; ss += h0[j] * h0[j]; }
  ss += wshfl_xor(ss, 1); ss += wshfl_xor(ss, 2); ss += wshfl_xor(ss, 4); ss += wshfl_xor(ss, 8);
  float rstd = rsqrtf(ss * (1.f / 128.f) + 1e-6f);
#pragma unroll
  for (int j = 0; j < 8; ++j) f1[j] = h0[j] * rstd * P.in[I_MNORM][ch + j] * sigmoidf_(o[j]);
  float y0[8], y1[8], z[8], f2[8];
  unpack8(*(const u32x4*)(yb + ch), y0);
  unpack8(*(const u32x4*)(yb + 512 + ch), y1);
  unpack8(*(const u32x4*)(pr + 1552 + ch), z);
  float s2 = 0.f;
#pragma unroll
  for (int j = 0; j < 8; ++j) { y0[j] = (y0[j] + y1[j]) * siluf_(z[j]); s2 += y0[j] * y0[j]; }
  s2 = wave_sum(s2);
  float rstd2 = rsqrtf(s2 * (1.f / 512.f) + 1e-6f);
#pragma unroll
  for (int j = 0; j < 8; ++j) f2[j] = y0[j] * rstd2 * P.in[I_SNORM][ch + j];
  *(u32x4*)(hb + ch) = pack8(f1);
  *(u32x4*)(hb + 512 + ch) = pack8(f2);
}

DEV float mixval(const bf16_t* __restrict__ proj, int row, int c, const float* __restrict__ mu) {
  float self = bf2f(proj[(size_t)row * ODC + c]);
  int nrow = -1;
  if (row < NCTX) {
    int pos = row % CTXL;
    if (c < 896) { if (pos > 0) nrow = row - 1; }
    else { if (pos < CTXL - 1) nrow = row + 1; }
  } else {
    int pos = (row - NCTX) % SEQ;
    int gx = pos % GW, gy = pos / GW, q = c / 448;
    if (q == 0) { if (gx > 0) nrow = row - 1; }
    else if (q == 1) { if (gx < GW - 1) nrow = row + 1; }
    else if (q == 2) { if (gy > 0) nrow = row - GW; }
    else { if (gy < SEQ / GW - 1) nrow = row + GW; }
  }
  float nb = nrow >= 0 ? bf2f(proj[(size_t)nrow * ODC + c]) : 0.f;
  return self + mu[c] * (nb - self);
}

DEV void st_lora_act(const Params& P, int row) {
  const int lane = threadIdx.x & 63;
  const bf16_t* proj = (const bf16_t*)(P.ws + OFF_PROJ);
  bf16_t* hb = (bf16_t*)(P.ws + OFF_HBUF) + (size_t)row * 1024;
  float v[4];
#pragma unroll
  for (int j = 0; j < 4; ++j) {
    int c = lane * 4 + j;
    float x = mixval(proj, row, 1536 + c, P.in[I_MU]);
    v[j] = c < 64 ? tanhf(x) : (c < 128 ? x : sigmoidf_(x));
  }
  u32x2 pk; pk.x = pack2(v[0], v[1]); pk.y = pack2(v[2], v[3]);
  *(u32x2*)(hb + lane * 4) = pk;
}

DEV void st_rwkv_stream(const Params& P, int sid, unsigned char* smem) {
  const int tid = threadIdx.x, lane = tid & 63, wave = tid >> 6;
  const int d = sid & 1, h = (sid >> 1) & 7, b = sid >> 4;
  float* sR = (float*)smem;
  float* sW = sR + 2048;
  float* sKk = sW + 2048;
  float* sV = sKk + 2048;
  float* sA = sV + 2048;
  float* sBb = sA + 2048;
  float* sY = sBb + 2048;
  int* sRow = (int*)(sY + 2048);
  const bf16_t* proj = (const bf16_t*)(P.ws + OFF_PROJ);
  const bf16_t* lora = (const bf16_t*)(P.ws + OFF_LORA);
  bf16_t* yout = (bf16_t*)(P.ws + OFF_HBUF);
  const float* mu = P.in[I_MU];
  const int vrow = tid >> 2, j4 = tid & 3;
  float S[16];
#pragma unroll
  for (int i = 0; i < 16; ++i) S[i] = 0.f;
  const float kkw = P.in[I_KK][h * 64 + lane], kaw = P.in[I_KA][h * 64 + lane];
  for (int seg = 0; seg < 2; ++seg) {
    const int row0 = seg == 0 ? b * CTXL : NCTX + b * SEQ;
    const int len = seg == 0 ? CTXL : SEQ;
    for (int it = 0; it < len / 32; ++it) {
      __syncthreads();
      for (int s = wave; s < 32; s += 4) {
        int p = it * 32 + s, pos = d ? len - 1 - p : p, row = row0 + pos;
        int c = h * 64 + lane;
        float r = mixval(proj, row, c, mu);
        float k = mixval(proj, row, 512 + c, mu);
        float v = mixval(proj, row, 1024 + c, mu);
        float kk = k * kkw;
        float ss = wave_sum(kk * kk);
        kk *= rsqrtf(ss + 1e-12f);
        float lw = bf2f(lora[((size_t)d * NTOK + row) * 512 + c]);
        float la = bf2f(lora[((size_t)(2 + d) * NTOK + row) * 512 + c]);
        float w = expf(-0.6065306597126334f * sigmoidf_(lw));
        float a = sigmoidf_(la);
        float kt = k * (1.f + (a - 1.f) * kaw);
        sR[s * 64 + lane] = r; sW[s * 64 + lane] = w; sKk[s * 64 + lane] = kt; sV[s * 64 + lane] = v;
        sA[s * 64 + lane] = -kk; sBb[s * 64 + lane] = kk * a;
        if (lane == 0) sRow[s] = row;
      }
      __syncthreads();
      for (int s = 0; s < 32; ++s) {
        const float* pa = sA + s * 64 + j4 * 16;
        const float* pw = sW + s * 64 + j4 * 16;
        const float* pk = sKk + s * 64 + j4 * 16;
        const float* pb = sBb + s * 64 + j4 * 16;
        const float* pr = sR + s * 64 + j4 * 16;
        const float vv = sV[s * 64 + vrow];
        float sa = 0.f;
#pragma unroll
        for (int i = 0; i < 16; ++i) sa += S[i] * pa[i];
        sa += wshfl_xor(sa, 1); sa += wshfl_xor(sa, 2);
        float y = 0.f;
#pragma unroll
        for (int i = 0; i < 16; ++i) { S[i] = S[i] * pw[i] + sa * pb[i] + vv * pk[i]; y += S[i] * pr[i]; }
        y += wshfl_xor(y, 1); y += wshfl_xor(y, 2);
        if (j4 == 0) sY[s * 64 + vrow] = y;
      }
      __syncthreads();
      for (int i = tid; i < 2048; i += 256) {
        int s = i >> 6, c = i & 63;
        yout[(size_t)sRow[s] * 1024 + d * 512 + h * 64 + c] = f2bf(sY[i]);
      }
    }
  }
}


DEV int nbr_row(int row, int c) {
  if (row < NCTX) {
    int pos = row % CTXL;
    if (c < 896) return pos > 0 ? row - 1 : -1;
    return pos < CTXL - 1 ? row + 1 : -1;
  }
  int pos = (row - NCTX) % SEQ;
  int gx = pos % GW, gy = pos / GW, q = c / 448;
  if (q == 0) return gx > 0 ? row - 1 : -1;
  if (q == 1) return gx < GW - 1 ? row + 1 : -1;
  if (q == 2) return gy > 0 ? row - GW : -1;
  return gy < SEQ / GW - 1 ? row + GW : -1;
}

struct RwkvRaw { u32x4 rs, rn, ks, kn, vs, vn, lw, la; int row; };

DEV void rwkv_load_raw(const bf16_t* __restrict__ proj, const bf16_t* __restrict__ lora, int b, int h, int d, int cc, int t, int c0,
                       RwkvRaw& R) {
  constexpr int NC_CTX = CTXL / 32;
  const int seg = cc >= NC_CTX;
  const int row0 = seg ? NCTX + b * SEQ : b * CTXL;
  const int len = seg ? SEQ : CTXL;
  const int p = (seg ? cc - NC_CTX : cc) * 32 + t;
  const int row = row0 + (d ? len - 1 - p : p);
  const int col = h * 64 + c0;
  const u32x4 z4 = {0u, 0u, 0u, 0u};
  const bf16_t* rp = proj + (size_t)row * ODC;
  R.row = row;
  R.rs = *(const u32x4*)(rp + col);
  R.ks = *(const u32x4*)(rp + 512 + col);
  R.vs = *(const u32x4*)(rp + 1024 + col);
  int n0 = nbr_row(row, col), n1 = nbr_row(row, 512 + col), n2 = nbr_row(row, 1024 + col);
  R.rn = n0 >= 0 ? *(const u32x4*)(proj + (size_t)n0 * ODC + col) : z4;
  R.kn = n1 >= 0 ? *(const u32x4*)(proj + (size_t)n1 * ODC + 512 + col) : z4;
  R.vn = n2 >= 0 ? *(const u32x4*)(proj + (size_t)n2 * ODC + 1024 + col) : z4;
  R.lw = *(const u32x4*)(lora + ((size_t)d * NTOK + row) * 512 + col);
  R.la = *(const u32x4*)(lora + ((size_t)(2 + d) * NTOK + row) * 512 + col);
}

#ifndef RW_NSEG
#define RW_NSEG 13
#endif
constexpr int RW_NCH = (CTXL + SEQ) / 32;
constexpr int RW_CPS = RW_NCH / RW_NSEG;
static_assert(RW_NCH % RW_NSEG == 0, "rwkv segments");
constexpr size_t OFF_RWSEG = OFF_PU;
static_assert((size_t)32 * RW_NSEG * 64 * 128 * 4 <= (size_t)2 * NEXP * 1024, "rwseg");

template <bool FULL>
DEV void st_rwkv_seg(const Params& P, int sid, int seg, unsigned char* smem) {
  constexpr int NVB = FULL ? 2 : 4;
  constexpr int ZR = FULL ? 64 : 128;
  const int tid = threadIdx.x, lane = tid & 63, wave = tid >> 6;
  const int d = sid & 1, h = (sid >> 1) & 7, b = sid >> 4;
  bf16_t* sAt = (bf16_t*)smem;
  bf16_t* sRt = sAt + 32 * 72;
  bf16_t* sBt = sRt + 32 * 72;
  bf16_t* sKt = sBt + 32 * 72;
  bf16_t* sBT = sKt + 32 * 72;
  bf16_t* sKT = sBT + 64 * 40;
  bf16_t* sVT = sKT + 64 * 40;
  bf16_t* sLak = sVT + 64 * 40;
  bf16_t* sM = sLak + 32 * 40;
  bf16_t* sLrb = sM + 32 * 40;
  bf16_t* sLrk = sLrb + 32 * 40;
  bf16_t* sZ = FULL ? sLrk + 32 * 40 : sLrb;
  bf16_t* after = sZ + ZR * 72;
  bf16_t* sRT = FULL ? after : nullptr;
  bf16_t* sSAT = FULL ? after + 64 * 40 : sRt;
  float* sLP = (float*)(FULL ? after + 2 * 64 * 40 : after);
  float* sLab = sLP + 32 * 64;
  float* sD = sLab + 32 * 33;
  float* sPT = sD + 768;
  int* sRow = (int*)(sPT + 64);
  if (!FULL) sRT = (bf16_t*)sLP;
  static_assert((4 * 32 * 72 + 3 * 64 * 40 + 4 * 32 * 40 + 2 * 64 * 40 + 64 * 72) * 2 + (32 * 64 + 32 * 33 + 768 + 64 + 32 + 320) * 4 + 16 <= SMEM_BYTES, "lds full");
  static_assert((4 * 32 * 72 + 3 * 64 * 40 + 2 * 32 * 40 + 128 * 72) * 2 + (32 * 64 + 32 * 33 + 768 + 64 + 32) * 4 <= SMEM_BYTES, "lds p1");
  static_assert(128 * 40 * 2 <= (32 * 64 + 32 * 33) * 4 && 128 * 40 <= 3 * 32 * 72, "alias");
  const bf16_t* proj = (const bf16_t*)(P.ws + OFF_PROJ);
  const bf16_t* lora = (const bf16_t*)(P.ws + OFF_LORA);
  bf16_t* yout = (bf16_t*)(P.ws + OFF_HBUF);
  float* segZ = (float*)(P.ws + OFF_RWSEG);
  const int t = tid >> 3, c0 = (tid & 7) * 8;
  const int hl = lane >> 5, l31 = lane & 31;
  float* sCst = (float*)(smem + SMEM_BYTES - 320 * 4 - 16);
  if (tid < 64) {
    sCst[tid] = P.in[I_MU][h * 64 + tid]; sCst[64 + tid] = P.in[I_MU][512 + h * 64 + tid]; sCst[128 + tid] = P.in[I_MU][1024 + h * 64 + tid];
    sCst[192 + tid] = P.in[I_KK][h * 64 + tid]; sCst[256 + tid] = P.in[I_KA][h * 64 + tid];
  }
  const int cc0 = seg * RW_CPS, cc1 = cc0 + RW_CPS;
  RwkvRaw R;
  rwkv_load_raw(proj, lora, b, h, d, cc0, t, c0, R);
  f32x16 Zm[2];
#pragma unroll
  for (int j = 0; j < 2; ++j)
#pragma unroll
    for (int r = 0; r < 16; ++r) Zm[j][r] = 0.f;
  __syncthreads();
  for (int i = tid; i < ZR * 72; i += 256) sZ[i] = 0;
  __syncthreads();
  if (!FULL) {
    if (wave >= 2) {
#pragma unroll
      for (int cb = 0; cb < 2; ++cb)
#pragma unroll
        for (int r = 0; r < 16; ++r) {
          int c = cb * 32 + acc_row(r, lane), vp = wave * 32 + l31;
          if (c == vp - 64) { Zm[cb][r] = 1.f; sZ[vp * 72 + c] = 0x3f80; }
        }
    }
  } else {
    for (int js = 0; js < seg; ++js) {
      const float* Zs = segZ + ((size_t)sid * RW_NSEG + js) * 64 * 128;
      bf16_t* sG = sAt;
      for (int i = tid; i < 64 * 64; i += 256) { int c = i >> 6, c2 = i & 63; sG[c * 72 + c2] = f2bf(Zs[c * 128 + 64 + c2]); }
      __syncthreads();
      if (wave >= 2) {
        const int cb = wave - 2;
#pragma unroll
        for (int vb = 0; vb < 2; ++vb) {
          f32x16 acc;
#pragma unroll
          for (int r = 0; r < 16; ++r) acc[r] = Zs[(cb * 32 + acc_row(r, lane)) * 128 + vb * 32 + l31];
#pragma unroll
          for (int kk = 0; kk < 4; ++kk) {
            bf16x8 a = *(const bf16x8*)(sG + (cb * 32 + l31) * 72 + kk * 16 + 8 * hl);
            bf16x8 bb = *(const bf16x8*)(sZ + (vb * 32 + l31) * 72 + kk * 16 + 8 * hl);
            acc = mfma32(a, bb, acc);
          }
          Zm[vb] = acc;
        }
      }
      __syncthreads();
      if (wave >= 2) {
        const int cb = wave - 2;
#pragma unroll
        for (int vb = 0; vb < 2; ++vb)
#pragma unroll
          for (int g = 0; g < 4; ++g) {
            u32x2 pk; pk.x = pack2(Zm[vb][4 * g], Zm[vb][4 * g + 1]); pk.y = pack2(Zm[vb][4 * g + 2], Zm[vb][4 * g + 3]);
            *(u32x2*)(sZ + (vb * 32 + l31) * 72 + cb * 32 + 8 * g + 4 * hl) = pk;
          }
      }
      __syncthreads();
    }
  }
  for (int cc = cc0; cc < cc1; ++cc) {
    int tl_ = threadIdx.x; OPAQUE(tl_);
    const int tid = tl_, lane = tl_ & 63, hl = lane >> 5, l31 = lane & 31, t = tl_ >> 3, c0 = (tl_ & 7) * 8;
    const float* muR = sCst + c0; const float* muK = sCst + 64 + c0; const float* muV = sCst + 128 + c0;
    const float* kkw = sCst + 192 + c0; const float* kaw = sCst + 256 + c0;
    {
      float lwf[8];
      unpack8(R.lw, lwf);
#pragma unroll
      for (int j = 0; j < 8; ++j) sLP[t * 64 + c0 + j] = -0.6065306597126334f * sigmoidf_(lwf[j]);
      if ((tid & 7) == 0) sRow[t] = R.row;
    }
    __syncthreads();
    if (tid < 64) {
      float run = 0.f;
#pragma unroll 8
      for (int tt = 0; tt < 32; ++tt) { run += sLP[tt * 64 + tid]; sLP[tt * 64 + tid] = run; }
      sPT[tid] = expf(run);
    }
    __syncthreads();
    {
      float xs[8], xn[8], kt[8], aa[8], ob[8], ok[8];
      unpack8(R.ks, xs); unpack8(R.kn, xn);
      float ss = 0.f;
#pragma unroll
      for (int j = 0; j < 8; ++j) { kt[j] = xs[j] + muK[j] * (xn[j] - xs[j]); aa[j] = kt[j] * kkw[j]; ss += aa[j] * aa[j]; }
      ss += wshfl_xor(ss, 1); ss += wshfl_xor(ss, 2); ss += wshfl_xor(ss, 4);
      const float rn = rsqrtf(ss + 1e-12f);
      float laf[8];
      unpack8(R.la, laf);
#pragma unroll
      for (int j = 0; j < 8; ++j) {
        const float lp = sLP[t * 64 + c0 + j];
        const float lpm = t > 0 ? sLP[(t - 1) * 64 + c0 + j] : 0.f;
        const float e = expf(-lp);
        const float kkn = aa[j] * rn;
        const float asg = sigmoidf_(laf[j]);
        aa[j] = -kkn * expf(lpm);
        ob[j] = kkn * asg * e;
        ok[j] = kt[j] * (1.f + (asg - 1.f) * kaw[j]) * e;
      }
      *(u32x4*)(sAt + t * 72 + c0) = pack8(aa);
      *(u32x4*)(sBt + t * 72 + c0) = pack8(ob);
      *(u32x4*)(sKt + t * 72 + c0) = pack8(ok);
#pragma unroll
      for (int j = 0; j < 8; ++j) { sBT[(c0 + j) * 40 + t] = f2bf(ob[j]); sKT[(c0 + j) * 40 + t] = f2bf(ok[j]); }
      unpack8(R.vs, xs); unpack8(R.vn, xn);
#pragma unroll
      for (int j = 0; j < 8; ++j) sVT[(c0 + j) * 40 + t] = f2bf(xs[j] + muV[j] * (xn[j] - xs[j]));
      if (FULL) {
        unpack8(R.rs, xs); unpack8(R.rn, xn);
#pragma unroll
        for (int j = 0; j < 8; ++j) xs[j] = (xs[j] + muR[j] * (xn[j] - xs[j])) * expf(sLP[t * 64 + c0 + j]);
        *(u32x4*)(sRt + t * 72 + c0) = pack8(xs);
      }
    }
    if (cc + 1 < cc1) rwkv_load_raw(proj, lora, b, h, d, cc + 1, t, c0, R);
    __syncthreads();
    if (FULL || wave < 2) {
      const bf16_t* Asrc = wave < 2 ? sAt : sRt;
      const bf16_t* Bsrc = (wave & 1) ? sKt : sBt;
      f32x16 acc;
#pragma unroll
      for (int r = 0; r < 16; ++r) acc[r] = 0.f;
#pragma unroll
      for (int kk = 0; kk < 4; ++kk) {
        bf16x8 a = *(const bf16x8*)(Asrc + l31 * 72 + kk * 16 + 8 * hl);
        bf16x8 bb = *(const bf16x8*)(Bsrc + l31 * 72 + kk * 16 + 8 * hl);
        acc = mfma32(a, bb, acc);
      }
      bf16_t* dst = wave == 1 ? sLak : (wave == 2 ? sLrb : sLrk);
#pragma unroll
      for (int r = 0; r < 16; ++r) {
        int tt = acc_row(r, lane), j = l31;
        bool keep = wave < 2 ? (j < tt) : (j <= tt);
        float v = keep ? acc[r] : 0.f;
        if (wave == 0) sLab[tt * 33 + j] = v;
        else dst[tt * 40 + j] = f2bf(v);
      }
    }
    __syncthreads();
    if (tid < 32) {
      const int q = tid >> 4, c = tid & 15;
      float x[16];
#pragma unroll
      for (int i = 0; i < 16; ++i) {
        float sacc = (i == c) ? 1.f : 0.f;
#pragma unroll
        for (int j = 0; j < i; ++j) sacc += sLab[(q * 16 + i) * 33 + q * 16 + j] * x[j];
        x[i] = sacc;
        sD[q * 256 + i * 16 + c] = sacc;
      }
    }
    __syncthreads();
    {
      const int i = tid >> 4, c = tid & 15;
      float sacc = 0.f;
#pragma unroll
      for (int j = 0; j < 16; ++j) sacc += sLab[(16 + i) * 33 + j] * sD[j * 16 + c];
      sD[512 + i * 16 + c] = sacc;
    }
    __syncthreads();
    {
      const int i = tid >> 4, c = tid & 15;
      float sacc = 0.f;
#pragma unroll
      for (int j = 0; j < 16; ++j) sacc += sD[256 + i * 16 + j] * sD[512 + j * 16 + c];
      sM[(16 + i) * 40 + c] = f2bf(sacc);
      sM[i * 40 + c] = f2bf(sD[i * 16 + c]);
      sM[(16 + i) * 40 + 16 + c] = f2bf(sD[256 + i * 16 + c]);
      sM[i * 40 + 16 + c] = 0;
    }
    if (wave < NVB) {
      const int vb = wave;
      f32x16 acc;
#pragma unroll
      for (int r = 0; r < 16; ++r) acc[r] = 0.f;
#pragma unroll
      for (int kk = 0; kk < 4; ++kk) {
        bf16x8 a = *(const bf16x8*)(sAt + l31 * 72 + kk * 16 + 8 * hl);
        bf16x8 bb = *(const bf16x8*)(sZ + (vb * 32 + l31) * 72 + kk * 16 + 8 * hl);
        acc = mfma32(a, bb, acc);
      }
      if (vb < 2) {
#pragma unroll
        for (int kk = 0; kk < 2; ++kk) {
          bf16x8 a = *(const bf16x8*)(sLak + l31 * 40 + kk * 16 + 8 * hl);
          bf16x8 bb = *(const bf16x8*)(sVT + (vb * 32 + l31) * 40 + kk * 16 + 8 * hl);
          acc = mfma32(a, bb, acc);
        }
      }
#pragma unroll
      for (int g = 0; g < 4; ++g) {
        u32x2 pk; pk.x = pack2(acc[4 * g], acc[4 * g + 1]); pk.y = pack2(acc[4 * g + 2], acc[4 * g + 3]);
        *(u32x2*)(sRT + (vb * 32 + l31) * 40 + 8 * g + 4 * hl) = pk;
      }
    }
    __syncthreads();
    if (wave < NVB) {
      const int vb = wave;
      f32x16 acc;
#pragma unroll
      for (int r = 0; r < 16; ++r) acc[r] = 0.f;
#pragma unroll
      for (int kk = 0; kk < 2; ++kk) {
        bf16x8 a = *(const bf16x8*)(sM + l31 * 40 + kk * 16 + 8 * hl);
        bf16x8 bb = *(const bf16x8*)(sRT + (vb * 32 + l31) * 40 + kk * 16 + 8 * hl);
        acc = mfma32(a, bb, acc);
      }
#pragma unroll
      for (int g = 0; g < 4; ++g) {
        u32x2 pk; pk.x = pack2(acc[4 * g], acc[4 * g + 1]); pk.y = pack2(acc[4 * g + 2], acc[4 * g + 3]);
        *(u32x2*)(sSAT + (vb * 32 + l31) * 40 + 8 * g + 4 * hl) = pk;
      }
    }
    __syncthreads();
    if (FULL) {
      if (wave < 2) {
        const int vb = wave;
        f32x16 acc;
#pragma unroll
        for (int r = 0; r < 16; ++r) acc[r] = 0.f;
#pragma unroll
        for (int kk = 0; kk < 4; ++kk) {
          bf16x8 a = *(const bf16x8*)(sRt + l31 * 72 + kk * 16 + 8 * hl);
          bf16x8 bb = *(const bf16x8*)(sZ + (vb * 32 + l31) * 72 + kk * 16 + 8 * hl);
          acc = mfma32(a, bb, acc);
        }
#pragma unroll
        for (int kk = 0; kk < 2; ++kk) {
          bf16x8 a = *(const bf16x8*)(sLrb + l31 * 40 + kk * 16 + 8 * hl);
          bf16x8 bb = *(const bf16x8*)(sSAT + (vb * 32 + l31) * 40 + kk * 16 + 8 * hl);
          acc = mfma32(a, bb, acc);
        }
#pragma unroll
        for (int kk = 0; kk < 2; ++kk) {
          bf16x8 a = *(const bf16x8*)(sLrk + l31 * 40 + kk * 16 + 8 * hl);
          bf16x8 bb = *(const bf16x8*)(sVT + (vb * 32 + l31) * 40 + kk * 16 + 8 * hl);
          acc = mfma32(a, bb, acc);
        }
#pragma unroll
        for (int r = 0; r < 16; ++r) {
          int tt = acc_row(r, lane);
          yout[(size_t)sRow[tt] * 1024 + d * 512 + h * 64 + vb * 32 + l31] = f2bf(acc[r]);
        }
      } else {
        const int cb = wave - 2;
#pragma unroll
        for (int vb = 0; vb < 2; ++vb) {
          f32x16 acc;
#pragma unroll
          for (int r = 0; r < 16; ++r) acc[r] = 0.f;
#pragma unroll
          for (int kk = 0; kk < 2; ++kk) {
            bf16x8 a = *(const bf16x8*)(sBT + (cb * 32 + l31) * 40 + kk * 16 + 8 * hl);
            bf16x8 bb = *(const bf16x8*)(sSAT + (vb * 32 + l31) * 40 + kk * 16 + 8 * hl);
            acc = mfma32(a, bb, acc);
          }
#pragma unroll
          for (int kk = 0; kk < 2; ++kk) {
            bf16x8 a = *(const bf16x8*)(sKT + (cb * 32 + l31) * 40 + kk * 16 + 8 * hl);
            bf16x8 bb = *(const bf16x8*)(sVT + (vb * 32 + l31) * 40 + kk * 16 + 8 * hl);
            acc = mfma32(a, bb, acc);
          }
#pragma unroll
          for (int r = 0; r < 16; ++r) Zm[vb][r] = sPT[cb * 32 + acc_row(r, lane)] * (Zm[vb][r] + acc[r]);
        }
      }
      __syncthreads();
      if (wave >= 2) {
        const int cb = wave - 2;
#pragma unroll
        for (int vb = 0; vb < 2; ++vb)
#pragma unroll
          for (int g = 0; g < 4; ++g) {
            u32x2 pk; pk.x = pack2(Zm[vb][4 * g], Zm[vb][4 * g + 1]); pk.y = pack2(Zm[vb][4 * g + 2], Zm[vb][4 * g + 3]);
            *(u32x2*)(sZ + (vb * 32 + l31) * 72 + cb * 32 + 8 * g + 4 * hl) = pk;
          }
      }
    } else {
      const int vb = wave;
#pragma unroll
      for (int cb = 0; cb < 2; ++cb) {
        f32x16 acc;
#pragma unroll
        for (int r = 0; r < 16; ++r) acc[r] = 0.f;
#pragma unroll
        for (int kk = 0; kk < 2; ++kk) {
          bf16x8 a = *(const bf16x8*)(sBT + (cb * 32 + l31) * 40 + kk * 16 + 8 * hl);
          bf16x8 bb = *(const bf16x8*)(sSAT + (vb * 32 + l31) * 40 + kk * 16 + 8 * hl);
          acc = mfma32(a, bb, acc);
        }
        if (vb < 2) {
#pragma unroll
          for (int kk = 0; kk < 2; ++kk) {
            bf16x8 a = *(const bf16x8*)(sKT + (cb * 32 + l31) * 40 + kk * 16 + 8 * hl);
            bf16x8 bb = *(const bf16x8*)(sVT + (vb * 32 + l31) * 40 + kk * 16 + 8 * hl);
            acc = mfma32(a, bb, acc);
          }
        }
#pragma unroll
        for (int r = 0; r < 16; ++r) Zm[cb][r] = sPT[cb * 32 + acc_row(r, lane)] * (Zm[cb][r] + acc[r]);
      }
#pragma unroll
      for (int cb = 0; cb < 2; ++cb)
#pragma unroll
        for (int g = 0; g < 4; ++g) {
          u32x2 pk; pk.x = pack2(Zm[cb][4 * g], Zm[cb][4 * g + 1]); pk.y = pack2(Zm[cb][4 * g + 2], Zm[cb][4 * g + 3]);
          *(u32x2*)(sZ + (vb * 32 + l31) * 72 + cb * 32 + 8 * g + 4 * hl) = pk;
        }
    }
  }
  if (!FULL) {
    float* Zs = segZ + ((size_t)sid * RW_NSEG + seg) * 64 * 128;
#pragma unroll
    for (int cb = 0; cb < 2; ++cb)
#pragma unroll
      for (int r = 0; r < 16; ++r) Zs[(cb * 32 + acc_row(r, lane)) * 128 + wave * 32 + l31] = Zm[cb][r];
  }
}

#ifndef LRU_NSEG
#define LRU_NSEG 13
#endif
constexpr int LRU_NCH = (CTXL + SEQ) / 64;
constexpr int LRU_CPS = LRU_NCH / LRU_NSEG;
static_assert(LRU_NCH % LRU_NSEG == 0, "lru segments");
constexpr size_t OFF_LRUSEG = OFF_RWSEG + (size_t)32 * RW_NSEG * 64 * 128 * 4;
static_assert(OFF_LRUSEG + (size_t)32 * LRU_NSEG * 128 * 4 <= OFF_PU + (size_t)2 * NEXP * 1024, "lruseg");

template <bool FULL>
DEV void st_lru_seg(const Params& P, int sid, int seg, unsigned char* smem) {
  constexpr int NC_CTX = CTXL / 64;
  const int tid = threadIdx.x, lane = tid & 63, wave = tid >> 6;
  const int d = sid & 1, blk = (sid >> 1) & 7, b = sid >> 4;
  float* sXc = (float*)smem;
  float* sAc = sXc + 4096;
  float* sBc = sAc + 4096;
  float* sU = sBc + 4096;
  bf16_t* sAop = (bf16_t*)(sU + 4096);
  int* sRow = (int*)(sAop + 64 * 72);
  const bf16_t* proj = (const bf16_t*)(P.ws + OFF_PROJ);
  bf16_t* uout = (bf16_t*)(P.ws + OFF_LORA) + (size_t)d * NTOK * 512;
  const bf16_t* lruT = (const bf16_t*)(P.ws + OFF_LRUT) + (size_t)(d * 8 + blk) * 128 * 64;
  float* segS = (float*)(P.ws + OFF_LRUSEG);
  const float* cw = P.in[I_LCONVW];
  const float* cb = P.in[I_LCONVB];
  const int tr = (wave >> 1) * 32, nc0 = (wave & 1) * 64;
  bf16x8 bfrag[2][4];
#pragma unroll
  for (int j = 0; j < 2; ++j)
#pragma unroll
    for (int kk = 0; kk < 4; ++kk)
      bfrag[j][kk] = *(const bf16x8*)(lruT + (nc0 + j * 32 + (lane & 31)) * 64 + kk * 16 + 8 * (lane >> 5));
  float ebias[2], esp[2];
#pragma unroll
  for (int j = 0; j < 2; ++j) {
    int e = nc0 + j * 32 + (lane & 31);
    int ch = blk * 64 + (e & 63);
    ebias[j] = e < 64 ? P.in[I_BA][d * 512 + ch] : P.in[I_BI][d * 512 + ch];
    esp[j] = softplusf_(-P.in[I_LAM][d * 512 + ch]);
  }
  const int lc8 = (tid & 7) * 8, lch = blk * 64 + lc8;
  float cwr[4][8], cbr[8];
#pragma unroll
  for (int j = 0; j < 8; ++j) {
    cbr[j] = cb[lch + j];
#pragma unroll
    for (int tap = 0; tap < 4; ++tap) cwr[tap][j] = cw[tap * 512 + lch + j];
  }
  float hstate = 0.f, aprod = 1.f;
  if (FULL && wave == 0) {
    for (int js = 0; js < seg; ++js) {
      const float* S = segS + ((size_t)sid * LRU_NSEG + js) * 128;
      hstate = S[lane] * hstate + S[64 + lane];
    }
  }
  const int cc0 = seg * LRU_CPS, cc1 = cc0 + LRU_CPS;
  for (int cc = cc0; cc < cc1; ++cc) {
    int tl_ = threadIdx.x; OPAQUE(tl_);
    const int tid = tl_, lane = tl_ & 63;
    const int sgi = cc >= NC_CTX;
    const int row0 = sgi ? NCTX + b * SEQ : b * CTXL;
    const int len = sgi ? SEQ : CTXL;
    const int cl = (sgi ? cc - NC_CTX : cc) * 64;
    __syncthreads();
    if (tid < 64) { int p = cl + tid; sRow[tid] = row0 + (d ? len - 1 - p : p); }
#pragma unroll
    for (int i = 0; i < 2; ++i) {
      int c = tid + i * 256, r = c >> 3;
      int p = cl + r, pos = d ? len - 1 - p : p;
      float o[8];
#pragma unroll
      for (int j = 0; j < 8; ++j) o[j] = cbr[j];
#pragma unroll
      for (int tap = 0; tap < 4; ++tap) {
        int pp = pos + tap - 2;
        if (pp >= 0 && pp < len) {
          float x[8];
          unpack8(*(const u32x4*)(proj + (size_t)(row0 + pp) * ODC + 2304 + lch), x);
#pragma unroll
          for (int j = 0; j < 8; ++j) o[j] += cwr[tap][j] * x[j];
        }
      }
#pragma unroll
      for (int j = 0; j < 8; ++j) sXc[r * 64 + lc8 + j] = o[j];
      *(u32x4*)(sAop + r * 72 + lc8) = pack8(o);
    }
    __syncthreads();
    f32x16 acc[2];
#pragma unroll
    for (int j = 0; j < 2; ++j)
#pragma unroll
      for (int r = 0; r < 16; ++r) acc[j][r] = 0.f;
#pragma unroll
    for (int kk = 0; kk < 4; ++kk) {
      bf16x8 a = *(const bf16x8*)(sAop + (tr + (lane & 31)) * 72 + kk * 16 + 8 * (lane >> 5));
#pragma unroll
      for (int j = 0; j < 2; ++j) acc[j] = mfma32(a, bfrag[j][kk], acc[j]);
    }
#pragma unroll
    for (int j = 0; j < 2; ++j)
#pragma unroll
      for (int r = 0; r < 16; ++r) {
        int t = tr + acc_row(r, lane);
        int e = nc0 + j * 32 + (lane & 31);
        float g = sigmoidf_(acc[j][r] + ebias[j]);
        if (e < 64) { float la = -8.f * g * esp[j]; sAc[t * 64 + e] = expf(la); sU[t * 64 + e] = sqrtf(-expm1f(2.f * la)); }
        else sBc[t * 64 + (e - 64)] = g * sXc[t * 64 + (e - 64)];
      }
    __syncthreads();
    if (wave == 0) {
#pragma unroll 8
      for (int t = 0; t < 64; ++t) {
        float a = sAc[t * 64 + lane];
        float bb = sU[t * 64 + lane] * sBc[t * 64 + lane];
        hstate = a * hstate + bb;
        if (FULL) sU[t * 64 + lane] = hstate; else aprod *= a;
      }
    }
    if (FULL) {
      __syncthreads();
      for (int i = tid; i < 4096; i += 256) {
        int t = i >> 6, c = i & 63;
        uout[(size_t)sRow[t] * 512 + blk * 64 + c] = f2bf(sU[i]);
      }
    }
  }
  if (!FULL && wave == 0) {
    float* S = segS + ((size_t)sid * LRU_NSEG + seg) * 128;
    S[lane] = aprod; S[64 + lane] = hstate;
  }
}

DEV void st_finish_l1(const Params& P, int row) {
  const int lane = threadIdx.x & 63;
  bf16_t* hb = (bf16_t*)(P.ws + OFF_HBUF) + (size_t)row * 1024;
  const bf16_t* proj = (const bf16_t*)(P.ws + OFF_PROJ);
  const bf16_t* lora = (const bf16_t*)(P.ws + OFF_LORA);
  const float* mu = P.in[I_MU];
  const int ch = lane * 8;
  float y0[8], y1[8];
  unpack8(*(const u32x4*)(hb + ch), y0);
  unpack8(*(const u32x4*)(hb + 512 + ch), y1);
  float sm = 0.f;
#pragma unroll
  for (int j = 0; j < 8; ++j) { y0[j] += y1[j]; sm += y0[j]; }
  sm += wshfl_xor(sm, 1); sm += wshfl_xor(sm, 2); sm += wshfl_xor(sm, 4);
  const float mean = sm * (1.f / 64.f);
  float sv = 0.f;
#pragma unroll
  for (int j = 0; j < 8; ++j) { float dlt = y0[j] - mean; sv += dlt * dlt; }
  sv += wshfl_xor(sv, 1); sv += wshfl_xor(sv, 2); sv += wshfl_xor(sv, 4);
  const float rstd = rsqrtf(sv * (1.f / 64.f) + 64e-5f);
  float a0[8], a1[8], g[8], u0[8], u1[8], gb[8];
  unpack8(*(const u32x4*)(lora + ((size_t)2 * NTOK + row) * 512 + ch), a0);
  unpack8(*(const u32x4*)(lora + ((size_t)3 * NTOK + row) * 512 + ch), a1);
  unpack8(*(const u32x4*)(lora + ((size_t)4 * NTOK + row) * 512 + ch), g);
  unpack8(*(const u32x4*)(lora + ((size_t)0 * NTOK + row) * 512 + ch), u0);
  unpack8(*(const u32x4*)(lora + ((size_t)1 * NTOK + row) * 512 + ch), u1);
  unpack8(*(const u32x4*)(proj + (size_t)row * ODC + 1792 + ch), gb);
  float rv[8], vv[8];
  float sdot = 0.f;
#pragma unroll
  for (int j = 0; j < 8; ++j) {
    float r = mixval(proj, row, ch + j, mu);
    float k = mixval(proj, row, 512 + ch + j, mu);
    vv[j] = mixval(proj, row, 1024 + ch + j, mu);
    float am = 0.5f * (sigmoidf_(a0[j]) + sigmoidf_(a1[j]));
    float kb = k * (1.f + (am - 1.f) * P.in[I_KA][ch + j]);
    sdot += r * kb * P.in[I_RK][ch + j];
    rv[j] = r;
  }
  sdot += wshfl_xor(sdot, 1); sdot += wshfl_xor(sdot, 2); sdot += wshfl_xor(sdot, 4);
  float f1[8], f2[8];
#pragma unroll
  for (int j = 0; j < 8; ++j) {
    float yn = (y0[j] - mean) * rstd * P.in[I_LNW][ch + j] + P.in[I_LNB][ch + j];
    yn += sdot * vv[j];
    f1[j] = yn * g[j];
    f2[j] = (u0[j] + u1[j]) * geluf_(gb[j]);
  }
  *(u32x4*)(hb + ch) = pack8(f1);
  *(u32x4*)(hb + 512 + ch) = pack8(f2);
}

DEV void topk_insert(float x, int xi, float* v, int* id) {
#pragma unroll
  for (int j = 0; j < 16; ++j) {
    bool gt = x > v[j];
    float tv = gt ? v[j] : x; int ti = gt ? id[j] : xi;
    v[j] = gt ? x : v[j]; id[j] = gt ? xi : id[j];
    x = tv; xi = ti;
  }
}

DEV void st_peer_topk(const Params& P, int layer, int tile, int h, unsigned char* smem) {
  const int tid = threadIdx.x;
  const bf16_t* q = (const bf16_t*)(P.ws + OFF_Q);
  const bf16_t* keys = (const bf16_t*)(P.ws + OFF_KEYS) + (size_t)(layer * 8 + h) * 2 * 128 * 128;
  float* sS = (float*)smem;
  const int m0 = tile * 128;
  float sv[2][16]; int si[2][16];
#pragma unroll
  for (int p = 0; p < 2; ++p) {
    EpiScoreLds epi{sS, m0};
    gemm_tile_128<true>(q + (h * 2 + p) * 128, 2048, NTOK, keys + p * 128 * 128, 128, 128, 128, m0, 0, epi, smem);
    __syncthreads();
#pragma unroll
    for (int j = 0; j < 16; ++j) { sv[p][j] = -3.0e38f; si[p][j] = 0; }
    if (tid < 128) {
      for (int key = 0; key < 128; ++key) {
        float x = sS[tid * 129 + key];
        if (x > sv[p][15]) topk_insert(x, key, sv[p], si[p]);
      }
    }
    __syncthreads();
  }
  if (tid < 128) {
    float best[16]; int bidx[16];
#pragma unroll
    for (int j = 0; j < 16; ++j) { best[j] = -3.0e38f; bidx[j] = 0; }
#pragma unroll
    for (int i = 0; i < 16; ++i)
#pragma unroll
      for (int j = 0; j < 16; ++j)
        if ((i + 1) * (j + 1) <= 16) {
          float x = sv[0][i] + sv[1][j];
          if (x > best[15]) topk_insert(x, si[0][i] * 128 + si[1][j], best, bidx);
        }
    float e[16], sum = 0.f;
#pragma unroll
    for (int j = 0; j < 16; ++j) { e[j] = expf(best[j] - best[0]); sum += e[j]; }
    const float inv = 1.f / sum;
    int* pidx = (int*)(P.ws + OFF_PIDX) + (size_t)(m0 + tid) * 128 + h * 16;
    float* pg = (float*)(P.ws + OFF_PGATE) + (size_t)(m0 + tid) * 128 + h * 16;
#pragma unroll
    for (int j = 0; j < 16; ++j) { pidx[j] = bidx[j]; pg[j] = e[j] * inv; }
  }
}

DEV void st_peer_experts(const Params& P, int layer, int row) {
  const int lane = threadIdx.x & 63;
  const bf16_t* xb = (const bf16_t*)(P.ws + OFF_HBUF) + (size_t)row * 1024;
  const unsigned char* U = P.ws + OFF_PU;
  const unsigned char* V = P.ws + OFF_PV;
  const int* pidx = (const int*)(P.ws + OFF_PIDX) + (size_t)row * 128;
  const float* pg = (const float*)(P.ws + OFF_PGATE) + (size_t)row * 128;
  float x[16], acc[16];
  unpack8(*(const u32x4*)(xb + lane * 16), x);
  unpack8(*(const u32x4*)(xb + lane * 16 + 8), x + 8);
#pragma unroll
  for (int j = 0; j < 16; ++j) acc[j] = 0.f;
  const int b5 = (lane >> 5) & 1, b4 = (lane >> 4) & 1, b3 = (lane >> 3) & 1;
  const int mypick = (lane >> 3) & 7;
  for (int k0 = 0; k0 < 128; k0 += 8) {
    u32x4 uu[8], vv[8];
#pragma unroll
    for (int i = 0; i < 8; ++i) {
      const size_t off = (size_t)pidx[k0 + i] * 1024 + lane * 16;
      uu[i] = *(const u32x4*)(U + off);
      vv[i] = *(const u32x4*)(V + off);
    }
    const float mygate = pg[k0 + mypick];
    float dsum[8];
#pragma unroll
    for (int i = 0; i < 8; ++i) {
      float uf[16];
      unpack16_fp8(uu[i], uf);
      float dd = 0.f;
#pragma unroll
      for (int j = 0; j < 16; ++j) dd += x[j] * uf[j];
      dsum[i] = dd;
    }
    float e4[4], e2[2], g;
#pragma unroll
    for (int i = 0; i < 4; ++i) {
      float mine = b5 ? dsum[4 + i] : dsum[i], send = b5 ? dsum[i] : dsum[4 + i];
      e4[i] = mine + wshfl_xor(send, 32);
    }
#pragma unroll
    for (int i = 0; i < 2; ++i) {
      float mine = b4 ? e4[2 + i] : e4[i], send = b4 ? e4[i] : e4[2 + i];
      e2[i] = mine + wshfl_xor(send, 16);
    }
    {
      float mine = b3 ? e2[1] : e2[0], send = b3 ? e2[0] : e2[1];
      g = mine + wshfl_xor(send, 8);
    }
    g += wshfl_xor(g, 4); g += wshfl_xor(g, 2); g += wshfl_xor(g, 1);
    const float mycoef = mygate * geluf_(g * (1.f / PEER_USCALE));
#pragma unroll
    for (int i = 0; i < 8; ++i) {
      const float coef = wreadlane(mycoef, i * 8);
      float vf[16];
      unpack16_fp8(vv[i], vf);
#pragma unroll
      for (int j = 0; j < 16; ++j) acc[j] += coef * vf[j];
    }
  }
  float* xr = row < NCTX ? (float*)(P.ws + OFF_CTXRES) + (size_t)row * 1024 : P.out + (size_t)(row - NCTX) * 1024;
  const float* g2 = (const float*)(P.ws + OFF_MODV) + ((size_t)layer * 3 + mod_row(row)) * 6144 + 5 * 1024;
  float o[16];
#pragma unroll
  for (int q = 0; q < 4; ++q) {
    const int c = lane * 16 + q * 4;
    f32x4 a = *(const f32x4*)(xr + c), ga = *(const f32x4*)(g2 + c);
    o[q * 4 + 0] = a.x + ga.x * acc[q * 4 + 0] * (1.f / PEER_VSCALE); o[q * 4 + 1] = a.y + ga.y * acc[q * 4 + 1] * (1.f / PEER_VSCALE);
    o[q * 4 + 2] = a.z + ga.z * acc[q * 4 + 2] * (1.f / PEER_VSCALE); o[q * 4 + 3] = a.w + ga.w * acc[q * 4 + 3] * (1.f / PEER_VSCALE);
  }
  if (layer == 1) {
    float ss = 0.f;
#pragma unroll
    for (int j = 0; j < 16; ++j) ss += o[j] * o[j];
    ss = wave_sum(ss);
    const float rstd = rsqrtf(ss * (1.f / 1024.f) + 1e-6f);
#pragma unroll
    for (int j = 0; j < 16; ++j) o[j] *= rstd * P.in[I_FNORM][lane * 16 + j];
  }
#pragma unroll
  for (int q = 0; q < 4; ++q) {
    f32x4 a = {o[q * 4 + 0], o[q * 4 + 1], o[q * 4 + 2], o[q * 4 + 3]};
    *(f32x4*)(xr + lane * 16 + q * 4) = a;
  }
}

#ifndef PHASE_LIST
#define PHASE_LIST(X) X(0) X(1) X(2) X(22) X(23) X(3) X(4) X(5) X(6) X(7) X(8) X(9) X(10) X(11) X(12) X(13) X(30) X(14) X(15) X(16) X(17) X(18) X(19) X(20) X(21)
#endif
constexpr int PH_LAST = 21;

template <int ph>
DEV void run_phase(const Params& P, unsigned char* smem) {
  const int bid = blockIdx.x, nb = gridDim.x;
  const int wave = threadIdx.x >> 6;
  unsigned char* ws = P.ws;
  constexpr int layer = ((ph >= 10 && ph <= 21) || ph >= 30) ? 1 : 0;
  const float* modv_l = (const float*)(ws + OFF_MODV) + (size_t)layer * 3 * 6144;
  switch (ph) {
    case 0:
      for (int t = bid; t < NPREP; t += nb) st_prep(P, t, smem);
      break;
    case 1: case 10:
      for (int t = bid; t < NTOK / 4; t += nb) st_normmod(P, layer, 0, t * 4 + wave);
      break;
    case 2: {
      EpiProjL0 epi{(bf16_t*)(ws + OFF_PROJ), (float*)(ws + OFF_GATES)};
      for (int t = bid; t < NTILE * 25; t += nb)
        gemm_tile_128<false>((const bf16_t*)(ws + OFF_HBUF), 1024, NTOK, (const bf16_t*)(ws + OFF_WEVIN), 1024, EVC, 1024,
                             (t / 25) * 128, (t % 25) * 128, epi, smem);
    } break;
    case 22:
      for (int t = bid; t < NTOK / 4; t += nb) st_xbc_conv(P, t * 4 + wave);
      for (int t = bid; t < NPCONV; t += nb) st_peer_conv(P, 0, t);
      break;
    case 23:
      for (int t = bid; t < 48 * LA_NSEG; t += nb) {
        int sid = t % 48, seg = t / 48;
        if (sid < 16) st_linattn_seg<true, false>(P, sid, seg, smem);
        else st_linattn_seg<false, false>(P, sid - 16, seg, smem);
      }
      break;
    case 3:
      for (int t = bid; t < 48 * LA_NSEG; t += nb) {
        int sid = t % 48, seg = t / 48;
        if (sid < 16) st_linattn_seg<true, true>(P, sid, seg, smem);
        else st_linattn_seg<false, true>(P, sid - 16, seg, smem);
      }
      break;
    case 4:
      for (int t = bid; t < NTOK / 4; t += nb) st_finish_l0(P, t * 4 + wave);
      break;
    case 5: case 17: {
      EpiOutProj epi{layer == 0 ? P.in[I_X] : P.out, P.in[I_CTX], P.out, (float*)(ws + OFF_CTXRES), modv_l};
      const bf16_t* Wt = (const bf16_t*)(ws + (layer == 0 ? OFF_WEVOUT : OFF_WODOUT));
      const int t0 = layer == 0 ? 0 : CTILE * 8;
      for (int t = t0 + bid; t < NTILE * 8; t += nb)
        gemm_tile_128<false>((const bf16_t*)(ws + OFF_HBUF), 1024, NTOK, Wt, 1024, 1024, 1024, (t / 8) * 128, (t % 8) * 128, epi, smem);
    } break;
    case 6: case 18: {
      const int r0 = layer == 0 ? 0 : NCTX / 4;
      for (int t = r0 + bid; t < NTOK / 4; t += nb) st_normmod(P, layer, 1, t * 4 + wave);
      if (ph == 18) for (int t = bid; t < NPCONV; t += nb) st_peer_conv(P, 1, t);
    } break;
    case 7: case 19: {
      EpiStoreBf epi{(bf16_t*)(ws + OFF_Q), 2048};
      const bf16_t* Wt = (const bf16_t*)(ws + OFF_WQ) + (size_t)layer * 2048 * 1024;
      const int t0 = layer == 0 ? 0 : CTILE * 16;
      for (int t = t0 + bid; t < NTILE * 16; t += nb)
        gemm_tile_128<false>((const bf16_t*)(ws + OFF_HBUF), 1024, NTOK, Wt, 1024, 2048, 1024, (t / 16) * 128, (t % 16) * 128, epi, smem);
    } break;
    case 8: case 20: {
      const int t0 = layer == 0 ? 0 : CTILE * 8;
      for (int t = t0 + bid; t < NTILE * 8; t += nb) st_peer_topk(P, layer, t / 8, t % 8, smem);
    } break;
    case 9: case 21: {
      const int r0 = layer == 0 ? 0 : NCTX / 4;
      for (int t = r0 + bid; t < NTOK / 4; t += nb) st_peer_experts(P, layer, t * 4 + wave);
    } break;
    case 11: {
      EpiStoreBf epi{(bf16_t*)(ws + OFF_PROJ), ODC};
      for (int t = bid; t < NTILE * 22; t += nb)
        gemm_tile_128<false>((const bf16_t*)(ws + OFF_HBUF), 1024, NTOK, (const bf16_t*)(ws + OFF_WODIN), 1024, ODC, 1024,
                             (t / 22) * 128, (t % 22) * 128, epi, smem);
    } break;
    case 12:
      for (int t = bid; t < NTOK / 4; t += nb) st_lora_act(P, t * 4 + wave);
      break;
    case 13:
      for (int t = bid; t < NTILE * 20; t += nb) {
        int job = t / (NTILE * 4), tt = t % (NTILE * 4);
        int mt = tt / 4, nt = tt % 4;
        bf16_t* dst = (bf16_t*)(ws + OFF_LORA) + (size_t)job * NTOK * 512;
        const bf16_t* A = (const bf16_t*)(ws + OFF_HBUF) + (job < 2 ? 0 : (job < 4 ? 64 : 128));
        const bf16_t* Bt = job < 2 ? (const bf16_t*)(ws + OFF_WUP) + (size_t)job * 512 * 64
                         : job < 4 ? (const bf16_t*)(ws + OFF_AUP) + (size_t)(job - 2) * 512 * 64
                                   : (const bf16_t*)(ws + OFF_GUP);
        const float* bias = job < 2 ? P.in[I_W0] + job * 512 : (job < 4 ? P.in[I_A0] + (job - 2) * 512 : nullptr);
        const int K = job < 4 ? 64 : 128;
        EpiStoreBfBias epi{dst, 512, bias};
        gemm_tile_128<false>(A, 1024, NTOK, Bt, K, 512, K, mt * 128, nt * 128, epi, smem);
      }
      break;
    case 30:
      for (int t = bid; t < 32 * RW_NSEG + 32 * LRU_NSEG; t += nb) {
        if (t < 32 * RW_NSEG) st_rwkv_seg<false>(P, t % 32, t / 32, smem);
        else { int u = t - 32 * RW_NSEG; st_lru_seg<false>(P, u % 32, u / 32, smem); }
      }
      break;
    case 14:
      for (int t = bid; t < 32 * RW_NSEG; t += nb) st_rwkv_seg<true>(P, t % 32, t / 32, smem);
      break;
    case 15:
      for (int t = bid; t < 32 * LRU_NSEG; t += nb) st_lru_seg<true>(P, t % 32, t / 32, smem);
      break;
    case 16:
      for (int t = bid; t < NTOK / 4; t += nb) st_finish_l1(P, t * 4 + wave);
      break;
    default: break;
  }
}


#ifndef CPU_EMU
#define XB_TMO      128
#define XB_XCNT(j)  (256  + 64 * (j))
#define XB_XSUB(j)  (1280 + 64 * (j))
#define XB_XGEN(j)  (2304 + 64 * (j))
#define XB_TOP      3328
#define XB_TOPGEN   3392
#define XCD_BAR_WORDS 3456
#define XB_SPIN_CAP (1u << 20)
#define LAS __attribute__((address_space(3)))
__device__ __forceinline__ unsigned xb_ld(unsigned* p)              { return __hip_atomic_load(p, __ATOMIC_RELAXED, __HIP_MEMORY_SCOPE_AGENT); }
__device__ __forceinline__ unsigned xb_add(unsigned* p, unsigned v) { return __hip_atomic_fetch_add(p, v, __ATOMIC_RELAXED, __HIP_MEMORY_SCOPE_AGENT); }
__device__ __forceinline__ unsigned xb_xcc_id() { return (unsigned)__builtin_amdgcn_s_getreg((3 << 11) | 20) & 0xFu; }
#define XB_SPIN(cond, bar) do { unsigned _sp = 0; while (cond) { __builtin_amdgcn_s_sleep(1); \
    if ((++_sp & 255u) == 0u) { if (xb_ld(&(bar)[XB_TMO])) break; if (_sp > XB_SPIN_CAP) { atomicAdd(&(bar)[XB_TMO], 1u); break; } } } } while (0)
struct XcdBarrier { unsigned* bar; unsigned x; volatile LAS unsigned* st; };
__device__ __forceinline__ XcdBarrier xcd_barrier_post(unsigned* bar, volatile LAS unsigned* st) {
  XcdBarrier b; b.bar = bar; b.x = xb_xcc_id(); b.st = st;
  if (threadIdx.x == 0) (void)xb_add(&bar[XB_XCNT(b.x)], 1u);
  return b;
}
__device__ __forceinline__ void xcd_barrier_complete(unsigned* bar, unsigned x, unsigned& nloc, unsigned& nx) {
  const unsigned G = gridDim.x * gridDim.y * gridDim.z;
  unsigned sum, cnt, mine, sp = 0u;
  for (;;) {
    sum = 0u; cnt = 0u; mine = 0u;
#pragma unroll
    for (unsigned j = 0; j < 16; ++j) { const unsigned c = xb_ld(&bar[XB_XCNT(j)]); sum += c; cnt += (c > 0u) ? 1u : 0u; mine = (j == x) ? c : mine; }
    if (sum == G) break;
    __builtin_amdgcn_s_sleep(1);
    if ((++sp & 255u) == 0u) { if (xb_ld(&bar[XB_TMO])) break; if (sp > XB_SPIN_CAP) { atomicAdd(&bar[XB_TMO], 1u); break; } }
  }
  nloc = mine > 0u ? mine : 1u; nx = cnt > 0u ? cnt : 1u;
}
__device__ __forceinline__ void xcd_barrier(const XcdBarrier& b) {
  asm volatile("s_waitcnt vmcnt(0)" ::: "memory");
  __syncthreads();
  if (threadIdx.x == 0) {
    unsigned* bar = b.bar;
    __builtin_amdgcn_s_waitcnt(0);
    unsigned nloc = b.st[0], nx = b.st[1];
    if (nloc == 0u) { xcd_barrier_complete(bar, b.x, nloc, nx); b.st[0] = nloc; b.st[1] = nx; }
    const unsigned old = xb_add(&bar[XB_XSUB(b.x)], 1u);
    const unsigned gen = old / nloc;
    if (old + 1u == (gen + 1u) * nloc) {
      __builtin_amdgcn_fence(__ATOMIC_RELEASE, "agent");
      asm volatile("s_waitcnt vmcnt(0)" ::: "memory");
      const unsigned og = xb_add(&bar[XB_TOP], 1u);
      const unsigned tg = og / nx;
      if (og + 1u == (tg + 1u) * nx) xb_add(&bar[XB_TOPGEN], 1u);
      else XB_SPIN(xb_ld(&bar[XB_TOPGEN]) == tg, bar);
      __builtin_amdgcn_fence(__ATOMIC_ACQUIRE, "agent");
      xb_add(&bar[XB_XGEN(b.x)], 1u);
      asm volatile("s_waitcnt vmcnt(0)" ::: "memory");
    } else {
      XB_SPIN(xb_ld(&bar[XB_XGEN(b.x)]) == gen, bar);
      __builtin_amdgcn_fence(__ATOMIC_ACQUIRE, "agent");
      asm volatile("s_waitcnt vmcnt(0)" ::: "memory");
    }
  }
  __syncthreads();
}
#endif
#ifndef CPU_EMU
#define RUN_PH(n) if (n != 0) { run_phase<n>(P, smem_raw); if (n != PH_LAST) xcd_barrier(xb); }
__global__ void __launch_bounds__(256, 2) mega_kernel(Params P) {
  SMEM_DECL;
  unsigned* bar = (unsigned*)(P.ws + OFF_BAR);
  volatile LAS unsigned* st = (volatile LAS unsigned*)(smem_raw + SMEM_BYTES - 16);
  if (blockIdx.x == 0) for (int i = threadIdx.x; i < XCD_BAR_WORDS; i += 256) bar[i] = 0u;
  if (threadIdx.x == 0) { st[0] = 0u; st[1] = 0u; }
  run_phase<0>(P, smem_raw);
  cg::this_grid().sync();
  XcdBarrier xb = xcd_barrier_post(bar, st);
  PHASE_LIST(RUN_PH)
}

extern "C" void kernel_launch(void* const* d_in, const int* in_sizes, int n_in, void* d_out, int out_size, void* d_ws,
                              size_t ws_size, hipStream_t stream) {
  Params P{};
  for (int i = 0; i < N_IN; ++i) P.in[i] = (const float*)d_in[i];
  P.out = (float*)d_out;
  P.ws = (unsigned char*)d_ws;
  if (ws_size < WS_NEEDED) { fprintf(stderr, "workspace too small: %zu < %zu\n", ws_size, (size_t)WS_NEEDED); return; }
  static int grid_blocks = 0;
  if (!grid_blocks) {
    int dev = 0, cus = 0, per_cu = 0;
    hipGetDevice(&dev);
    hipDeviceGetAttribute(&cus, hipDeviceAttributeMultiprocessorCount, dev);
    hipOccupancyMaxActiveBlocksPerMultiprocessor(&per_cu, mega_kernel, 256, 0);
    if (per_cu > 2) per_cu = 2;
    grid_blocks = cus * per_cu;
  }
  void* args[] = {&P};
  hipError_t e = hipLaunchCooperativeKernel((void*)mega_kernel, dim3(grid_blocks), dim3(256), args, 0, stream);
  if (e != hipSuccess) fprintf(stderr, "cooperative launch failed: %s (grid %d)\n", hipGetErrorString(e), grid_blocks);
}
#endif
```

```cpp
#ifdef CPU_EMU
#include "emu.h"
#else
#include <hip/hip_runtime.h>
#include <hip/hip_cooperative_groups.h>
#include <cstdio>
namespace cg = cooperative_groups;
#define DEV __device__ __forceinline__
#define DEVM __device__ __forceinline__
#define OPAQUE(x) asm volatile("" : "+v"(x))
#endif

#ifndef SEQ_LEN
#define SEQ_LEN 16384
#endif
#ifndef CTX_LEN
#define CTX_LEN 256
#endif
#ifndef GRID_W_
#define GRID_W_ 64
#endif
#ifndef MULTI_LAUNCH
#define MULTI_LAUNCH 0
#endif

typedef unsigned short bf16_t;
typedef __attribute__((ext_vector_type(8))) short bf16x8;
typedef __attribute__((ext_vector_type(16))) float f32x16;
typedef __attribute__((ext_vector_type(4))) unsigned u32x4;
typedef __attribute__((ext_vector_type(2))) unsigned u32x2;
typedef __attribute__((ext_vector_type(4))) float f32x4;

constexpr int D = 1024, NB = 2, SEQ = SEQ_LEN, CTXL = CTX_LEN, GW = GRID_W_;
constexpr int NCTX = NB * CTXL, NLAT = NB * SEQ, NTOK = NCTX + NLAT;
constexpr int EVC = 3104, ODC = 2816;
constexpr int NEXP = 16384;
constexpr int NTILE = NTOK / 128, CTILE = NCTX / 128;
static_assert(NTOK % 128 == 0 && NCTX % 128 == 0, "tiles");
static_assert(CTXL % 64 == 0 && SEQ % 64 == 0 && SEQ % GW == 0, "chunks");

constexpr size_t al256(size_t x) { return (x + 255) & ~(size_t)255; }
constexpr size_t OFF_MODV = 0;
constexpr size_t OFF_CTXRES = OFF_MODV + al256(2 * 3 * 6144 * 4);
constexpr size_t OFF_GATES = OFF_CTXRES + al256((size_t)NCTX * 1024 * 4);
constexpr size_t OFF_WEVIN = OFF_GATES + al256((size_t)NTOK * 32 * 4);
constexpr size_t OFF_WEVOUT = OFF_WEVIN + al256((size_t)EVC * 1024 * 2);
constexpr size_t OFF_WODIN = OFF_WEVOUT + al256((size_t)1024 * 1024 * 2);
constexpr size_t OFF_WODOUT = OFF_WODIN + al256((size_t)ODC * 1024 * 2);
constexpr size_t OFF_WQ = OFF_WODOUT + al256((size_t)1024 * 1024 * 2);
constexpr size_t OFF_KEYS = OFF_WQ + al256((size_t)2 * 2048 * 1024 * 2);
constexpr size_t OFF_WUP = OFF_KEYS + al256((size_t)2 * 8 * 2 * 128 * 128 * 2);
constexpr size_t OFF_AUP = OFF_WUP + al256((size_t)2 * 512 * 64 * 2);
constexpr size_t OFF_GUP = OFF_AUP + al256((size_t)2 * 512 * 64 * 2);
constexpr size_t OFF_LRUT = OFF_GUP + al256((size_t)512 * 128 * 2);
constexpr size_t OFF_PU = OFF_LRUT + al256((size_t)2 * 8 * 128 * 64 * 2);
constexpr size_t OFF_PV = OFF_PU + al256((size_t)NEXP * 1024);
constexpr size_t OFF_HBUF = OFF_PV + al256((size_t)NEXP * 1024);
constexpr size_t OFF_PR = OFF_HBUF + al256((size_t)NTOK * 1024 * 2);
constexpr size_t PR_BYTES = (size_t)NTOK * 5376 * 2;
constexpr size_t OFF_BAR = OFF_PR + PR_BYTES;
constexpr size_t WS_NEEDED = OFF_BAR + 16384;
static_assert(WS_NEEDED <= (size_t)512 * 1024 * 1024, "workspace too large");
constexpr size_t OFF_PROJ = OFF_PR;
constexpr size_t OFF_R2L0 = OFF_PR + (size_t)NTOK * EVC * 2;
constexpr size_t OFF_LORA = OFF_PR + (size_t)NTOK * ODC * 2;
constexpr size_t OFF_Q = OFF_PR;
constexpr size_t OFF_PIDX = OFF_PR + (size_t)NTOK * 2048 * 2;
constexpr size_t OFF_PGATE = OFF_PIDX + (size_t)NTOK * 128 * 4;
static_assert(OFF_PGATE + (size_t)NTOK * 128 * 4 <= OFF_PR + PR_BYTES, "picks");

enum {
  I_X = 0, I_C, I_CTX, I_CCTX, I_MODW, I_MODB, I_NORM1, I_NORM2, I_WQ, I_KEYS, I_PU, I_PV,
  I_EVWIN, I_EVWOUT, I_IBIAS, I_FBIAS, I_MNORM, I_SCONVW, I_SCONVB, I_DTBIAS, I_ALOG, I_DSKIP, I_SNORM,
  I_ODWIN, I_ODWOUT, I_MU, I_W0, I_WUP, I_A0, I_AUP, I_GUP, I_KK, I_KA, I_RK, I_LNW, I_LNB,
  I_LCONVW, I_LCONVB, I_LAM, I_WA, I_BA, I_WI, I_BI, I_FNORM, N_IN
};

struct Params {
  const float* in[N_IN];
  float* out;
  unsigned char* ws;
};

constexpr int SMEM_BYTES = 80 * 1024;
#ifdef CPU_EMU
#define SMEM_DECL static thread_local __attribute__((aligned(16))) unsigned char smem_raw[SMEM_BYTES]
#else
#define SMEM_DECL __shared__ __attribute__((aligned(16))) unsigned char smem_raw[SMEM_BYTES]
#endif

DEV float bf2f(bf16_t v) { unsigned u = ((unsigned)v) << 16; float f; __builtin_memcpy(&f, &u, 4); return f; }
DEV bf16_t f2bf(float f) { unsigned u; __builtin_memcpy(&u, &f, 4); u += 0x7fffu + ((u >> 16) & 1u); return (bf16_t)(u >> 16); }
DEV unsigned pack2(float a, float b) { return (unsigned)f2bf(a) | ((unsigned)f2bf(b) << 16); }
DEV void unpack8(const u32x4& r, float* o) {
  unsigned w[4] = {r.x, r.y, r.z, r.w};
#pragma unroll
  for (int i = 0; i < 4; ++i) { unsigned lo = w[i] << 16, hi = w[i] & 0xffff0000u; __builtin_memcpy(&o[2 * i], &lo, 4); __builtin_memcpy(&o[2 * i + 1], &hi, 4); }
}
DEV u32x4 pack8(const float* o) { u32x4 r; r.x = pack2(o[0], o[1]); r.y = pack2(o[2], o[3]); r.z = pack2(o[4], o[5]); r.w = pack2(o[6], o[7]); return r; }
#ifdef CPU_EMU
DEV float fexp(float x) { return expf(x); }
DEV float frcp(float x) { return 1.f / x; }
DEV float flog(float x) { return logf(x); }
DEV float frsq(float x) { return 1.f / sqrtf(x); }
DEV float fsqrt(float x) { return sqrtf(x); }
#else
DEV float fexp(float x) { return __expf(x); }
DEV float frcp(float x) { return __builtin_amdgcn_rcpf(x); }
DEV float flog(float x) { return __logf(x); }
DEV float frsq(float x) { return __builtin_amdgcn_rsqf(x); }
DEV float fsqrt(float x) { return __builtin_amdgcn_sqrtf(x); }
#endif
DEV float sigmoidf_(float x) { return frcp(1.f + fexp(-x)); }
DEV float siluf_(float x) { return x * frcp(1.f + fexp(-x)); }
DEV float softplusf_(float x) { return fmaxf(x, 0.f) + flog(1.f + fexp(-fabsf(x))); }
DEV float tanhf_(float x) { return 1.f - 2.f * frcp(1.f + fexp(2.f * x)); }
DEV float geluf_(float x) { return 0.5f * x * (1.f + erff(x * 0.70710678118654752f)); }

DEV f32x16 mfma32(bf16x8 a, bf16x8 b, f32x16 c) {
#ifdef CPU_EMU
  return emu_mfma32(a, b, c);
#else
  return __builtin_amdgcn_mfma_f32_32x32x16_bf16(a, b, c, 0, 0, 0);
#endif
}
DEV float wshfl_xor(float v, int m) {
#ifdef CPU_EMU
  return emu_shfl_xor(v, m);
#else
  return __shfl_xor(v, m, 64);
#endif
}
DEV float wave_sum(float v) {
#pragma unroll
  for (int m = 32; m >= 1; m >>= 1) v += wshfl_xor(v, m);
  return v;
}

#ifdef CPU_EMU
static inline unsigned emu_f2fp8(float f) {
  unsigned sgn = f < 0.f ? 0x80u : 0u; float a = fabsf(f);
  if (!(a == a)) return 0x7f;
  if (a >= 448.f) return sgn | 0x7e;
  if (a < 0.0009765625f) return sgn;
  int e; frexpf(a, &e); e -= 1;
  if (e < -6) { int q = (int)nearbyintf(a * 512.f); return sgn | (unsigned)q; }
  float m = a / ldexpf(1.f, e);
  int q = (int)nearbyintf((m - 1.f) * 8.f);
  if (q == 8) { q = 0; e += 1; }
  if (e > 8) return sgn | 0x7e;
  return sgn | (unsigned)((e + 7) << 3) | (unsigned)q;
}
static inline float emu_fp82f(unsigned c) {
  unsigned sgn = c & 0x80, e = (c >> 3) & 15, m = c & 7;
  float v = e == 0 ? ldexpf((float)m, -9) : ldexpf(1.f + m / 8.f, (int)e - 7);
  return sgn ? -v : v;
}
#endif
DEV unsigned pack4_fp8(float a, float b, float c, float d) {
#ifdef CPU_EMU
  return emu_f2fp8(a) | (emu_f2fp8(b) << 8) | (emu_f2fp8(c) << 16) | (emu_f2fp8(d) << 24);
#else
  int w = 0;
  w = __builtin_amdgcn_cvt_pk_fp8_f32(a, b, w, false);
  w = __builtin_amdgcn_cvt_pk_fp8_f32(c, d, w, true);
  return (unsigned)w;
#endif
}
DEV void unpack4_fp8(unsigned w, float* o) {
#ifdef CPU_EMU
  o[0] = emu_fp82f(w & 255); o[1] = emu_fp82f((w >> 8) & 255); o[2] = emu_fp82f((w >> 16) & 255); o[3] = emu_fp82f(w >> 24);
#else
  typedef __attribute__((ext_vector_type(2))) float f32x2_;
  f32x2_ lo = __builtin_amdgcn_cvt_pk_f32_fp8((int)w, false);
  f32x2_ hi = __builtin_amdgcn_cvt_pk_f32_fp8((int)w, true);
  o[0] = lo.x; o[1] = lo.y; o[2] = hi.x; o[3] = hi.y;
#endif
}
DEV void unpack16_fp8(const u32x4& r, float* o) { unpack4_fp8(r.x, o); unpack4_fp8(r.y, o + 4); unpack4_fp8(r.z, o + 8); unpack4_fp8(r.w, o + 12); }
DEV float wreadlane(float v, int srclane) {
#ifdef CPU_EMU
  return emu_readlane(v, srclane);
#else
  int iv; __builtin_memcpy(&iv, &v, 4);
  int r = __builtin_amdgcn_readlane(iv, srclane);
  float f; __builtin_memcpy(&f, &r, 4); return f;
#endif
}
constexpr float PEER_USCALE = 64.f, PEER_VSCALE = 4.f;

DEV int acc_row(int reg, int lane) { return (reg & 3) + 8 * (reg >> 2) + 4 * (lane >> 5); }

DEV int mod_row(int row) { return row < NCTX ? 2 : (row - NCTX) / SEQ; }

template <bool SYNC_EPI, class Epi>
DEV void gemm_tile_128(const bf16_t* __restrict__ A, int lda, int M, const bf16_t* __restrict__ Bt, int ldb, int N,
                       int K, int m0, int n0, const Epi& epi, unsigned char* smem) {
  constexpr int LS = 72;
  bf16_t* sA = (bf16_t*)smem;
  bf16_t* sB = sA + 128 * LS;
  const int wave = threadIdx.x >> 6;
  const int wm = (wave >> 1) * 64, wn = (wave & 1) * 64;
  f32x16 acc[2][2];
#pragma unroll
  for (int i = 0; i < 2; ++i)
#pragma unroll
    for (int j = 0; j < 2; ++j)
#pragma unroll
      for (int r = 0; r < 16; ++r) acc[i][j][r] = 0.f;
  u32x4 ra0[4], rb0[4], ra1[4], rb1[4];
  const u32x4 z4 = {0u, 0u, 0u, 0u};
  auto gload = [&](u32x4 (&ra)[4], u32x4 (&rb)[4], int k0) {
    int tl_ = threadIdx.x; OPAQUE(tl_);
#pragma unroll
    for (int i = 0; i < 4; ++i) {
      int c = tl_ + i * 256, r = c >> 3, cc = (c & 7) * 8;
      int gr = m0 + r, gn = n0 + r;
      gr = gr < M ? gr : M - 1; gn = gn < N ? gn : N - 1;
      ra[i] = *(const u32x4*)(A + (size_t)gr * lda + k0 + cc);
      rb[i] = *(const u32x4*)(Bt + (size_t)gn * ldb + k0 + cc);
    }
  };
  auto kstep = [&](u32x4 (&ra)[4], u32x4 (&rb)[4], int k0) {
    int tl_ = threadIdx.x; OPAQUE(tl_);
    const int lane = tl_ & 63;
    __syncthreads();
#pragma unroll
    for (int i = 0; i < 4; ++i) {
      int c = tl_ + i * 256, r = c >> 3, cc = (c & 7) * 8;
      *(u32x4*)(sA + r * LS + cc) = ra[i];
      *(u32x4*)(sB + r * LS + cc) = rb[i];
    }
    __syncthreads();
    if (k0 + 128 < K) gload(ra, rb, k0 + 128);
#pragma unroll
    for (int kk = 0; kk < 4; ++kk) {
      bf16x8 a[2], b[2];
      const int ko = kk * 16 + 8 * (lane >> 5);
#pragma unroll
      for (int i = 0; i < 2; ++i) a[i] = *(const bf16x8*)(sA + (wm + i * 32 + (lane & 31)) * LS + ko);
#pragma unroll
      for (int j = 0; j < 2; ++j) b[j] = *(const bf16x8*)(sB + (wn + j * 32 + (lane & 31)) * LS + ko);
#pragma unroll
      for (int i = 0; i < 2; ++i)
#pragma unroll
        for (int j = 0; j < 2; ++j) acc[i][j] = mfma32(a[i], b[j], acc[i][j]);
    }
  };
  gload(ra0, rb0, 0);
  if (64 < K) gload(ra1, rb1, 64);
  for (int k0 = 0; k0 < K; k0 += 128) {
    kstep(ra0, rb0, k0);
    if (k0 + 64 < K) kstep(ra1, rb1, k0 + 64);
  }
  if (SYNC_EPI) __syncthreads();
  {
    int tl_ = threadIdx.x; OPAQUE(tl_);
    const int lane = tl_ & 63;
#pragma unroll
    for (int i = 0; i < 2; ++i)
#pragma unroll
      for (int j = 0; j < 2; ++j)
#pragma unroll
        for (int r = 0; r < 16; ++r) {
          int row = m0 + wm + i * 32 + acc_row(r, lane);
          int col = n0 + wn + j * 32 + (lane & 31);
          if (row < M && col < N) epi(row, col, acc[i][j][r]);
        }
  }
}

template <class Epi>
DEV void gemm_tile_128x256(const bf16_t* __restrict__ A, int lda, int M, const bf16_t* __restrict__ Bt, int ldb, int N,
                           int K, int m0, int n0, const Epi& epi, unsigned char* smem) {
  constexpr int LS = 72;
  bf16_t* sA = (bf16_t*)smem;
  bf16_t* sB = sA + 128 * LS;
  const int wave = threadIdx.x >> 6;
  const int wm = (wave >> 1) * 64, wn = (wave & 1) * 128;
  f32x16 acc[2][4];
#pragma unroll
  for (int i = 0; i < 2; ++i)
#pragma unroll
    for (int j = 0; j < 4; ++j)
#pragma unroll
      for (int r = 0; r < 16; ++r) acc[i][j][r] = 0.f;
  u32x4 ra[4], rb[8];
  const u32x4 z4 = {0u, 0u, 0u, 0u};
  {
    const int tid = threadIdx.x;
#pragma unroll
    for (int i = 0; i < 4; ++i) {
      int c = tid + i * 256, r = c >> 3, cc = (c & 7) * 8;
      ra[i] = (m0 + r) < M ? *(const u32x4*)(A + (size_t)(m0 + r) * lda + cc) : z4;
    }
#pragma unroll
    for (int i = 0; i < 8; ++i) {
      int c = tid + i * 256, r = c >> 3, cc = (c & 7) * 8;
      rb[i] = (n0 + r) < N ? *(const u32x4*)(Bt + (size_t)(n0 + r) * ldb + cc) : z4;
    }
  }
  for (int k0 = 0; k0 < K; k0 += 64) {
    int tl_ = threadIdx.x; OPAQUE(tl_);
    const int tid = tl_, lane = tl_ & 63;
    __syncthreads();
#pragma unroll
    for (int i = 0; i < 4; ++i) { int c = tid + i * 256, r = c >> 3, cc = (c & 7) * 8; *(u32x4*)(sA + r * LS + cc) = ra[i]; }
#pragma unroll
    for (int i = 0; i < 8; ++i) { int c = tid + i * 256, r = c >> 3, cc = (c & 7) * 8; *(u32x4*)(sB + r * LS + cc) = rb[i]; }
    __syncthreads();
    if (k0 + 64 < K) {
#pragma unroll
      for (int i = 0; i < 4; ++i) {
        int c = tid + i * 256, r = c >> 3, cc = (c & 7) * 8;
        ra[i] = (m0 + r) < M ? *(const u32x4*)(A + (size_t)(m0 + r) * lda + k0 + 64 + cc) : z4;
      }
#pragma unroll
      for (int i = 0; i < 8; ++i) {
        int c = tid + i * 256, r = c >> 3, cc = (c & 7) * 8;
        rb[i] = (n0 + r) < N ? *(const u32x4*)(Bt + (size_t)(n0 + r) * ldb + k0 + 64 + cc) : z4;
      }
    }
#pragma unroll
    for (int kk = 0; kk < 4; ++kk) {
      bf16x8 a[2], b[4];
      const int ko = kk * 16 + 8 * (lane >> 5);
#pragma unroll
      for (int i = 0; i < 2; ++i) a[i] = *(const bf16x8*)(sA + (wm + i * 32 + (lane & 31)) * LS + ko);
#pragma unroll
      for (int j = 0; j < 4; ++j) b[j] = *(const bf16x8*)(sB + (wn + j * 32 + (lane & 31)) * LS + ko);
#pragma unroll
      for (int i = 0; i < 2; ++i)
#pragma unroll
        for (int j = 0; j < 4; ++j) acc[i][j] = mfma32(a[i], b[j], acc[i][j]);
    }
  }
  {
    int tl_ = threadIdx.x; OPAQUE(tl_);
    const int lane = tl_ & 63;
#pragma unroll
    for (int i = 0; i < 2; ++i)
#pragma unroll
      for (int j = 0; j < 4; ++j)
#pragma unroll
        for (int r = 0; r < 16; ++r) {
          int row = m0 + wm + i * 32 + acc_row(r, lane);
          int col = n0 + wn + j * 32 + (lane & 31);
          if (row < M && col < N) epi(row, col, acc[i][j][r]);
        }
  }
}

DEV void transpose_tile(const float* __restrict__ src, int ld_src, bf16_t* __restrict__ dst, int ld_dst, int K, int N,
                        int tk, int tn, unsigned char* smem) {
  float* sT = (float*)smem;
  const int tid = threadIdx.x;
  __syncthreads();
  {
    const int tx = tid & 15, ty = tid >> 4;
#pragma unroll
    for (int p = 0; p < 4; ++p) {
      int k = tk * 64 + ty + p * 16, n = tn * 64 + tx * 4;
#pragma unroll
      for (int j = 0; j < 4; ++j) {
        float v = (k < K && n + j < N) ? src[(size_t)k * ld_src + n + j] : 0.f;
        sT[(ty + p * 16) * 65 + tx * 4 + j] = v;
      }
    }
  }
  __syncthreads();
  {
    const int n = tid >> 2, kseg = (tid & 3) * 16;
    int gn = tn * 64 + n;
    if (gn < N) {
      float v[16];
#pragma unroll
      for (int j = 0; j < 16; ++j) v[j] = sT[(kseg + j) * 65 + n];
      bf16_t* d = dst + (size_t)gn * ld_dst + tk * 64 + kseg;
      *(u32x4*)d = pack8(v);
      *(u32x4*)(d + 8) = pack8(v + 8);
    }
  }
}

constexpr int TJ0 = 16 * 49, TJ1 = 16 * 16, TJ2 = 16 * 44, TJ3 = 16 * 16, TJ4 = 2 * 16 * 32, TJ5 = 2 * 8, TJ6 = 2 * 8,
              TJ7 = 2 * 8, TJ8 = 32;
constexpr int NTRANS = TJ0 + TJ1 + TJ2 + TJ3 + TJ4 + TJ5 + TJ6 + TJ7 + TJ8;
constexpr int NKEYCV = (2 * 8 * 2 * 128 * 128) / (256 * 8);
constexpr int NMODV = 2 * 96;
constexpr int NPREP = NTRANS + NKEYCV + NMODV;

DEV void st_prep(const Params& P, int item, unsigned char* smem) {
  unsigned char* ws = P.ws;
  if (item < NTRANS) {
    int t = item;
    if (t < TJ0) { transpose_tile(P.in[I_EVWIN], EVC, (bf16_t*)(ws + OFF_WEVIN), 1024, 1024, EVC, t / 49, t % 49, smem); return; }
    t -= TJ0;
    if (t < TJ1) { transpose_tile(P.in[I_EVWOUT], 1024, (bf16_t*)(ws + OFF_WEVOUT), 1024, 1024, 1024, t / 16, t % 16, smem); return; }
    t -= TJ1;
    if (t < TJ2) { transpose_tile(P.in[I_ODWIN], ODC, (bf16_t*)(ws + OFF_WODIN), 1024, 1024, ODC, t / 44, t % 44, smem); return; }
    t -= TJ2;
    if (t < TJ3) { transpose_tile(P.in[I_ODWOUT], 1024, (bf16_t*)(ws + OFF_WODOUT), 1024, 1024, 1024, t / 16, t % 16, smem); return; }
    t -= TJ3;
    if (t < TJ4) {
      int l = t / 512, tt = t % 512;
      transpose_tile(P.in[I_WQ] + (size_t)l * 1024 * 2048, 2048, (bf16_t*)(ws + OFF_WQ) + (size_t)l * 2048 * 1024, 1024, 1024, 2048, tt / 32, tt % 32, smem);
      return;
    }
    t -= TJ4;
    if (t < TJ5) { int d = t / 8; transpose_tile(P.in[I_WUP] + d * 64 * 512, 512, (bf16_t*)(ws + OFF_WUP) + d * 512 * 64, 64, 64, 512, 0, t % 8, smem); return; }
    t -= TJ5;
    if (t < TJ6) { int d = t / 8; transpose_tile(P.in[I_AUP] + d * 64 * 512, 512, (bf16_t*)(ws + OFF_AUP) + d * 512 * 64, 64, 64, 512, 0, t % 8, smem); return; }
    t -= TJ6;
    if (t < TJ7) { transpose_tile(P.in[I_GUP], 512, (bf16_t*)(ws + OFF_GUP), 128, 128, 512, t / 8, t % 8, smem); return; }
    t -= TJ7;
    {
      int which = t & 1, db = t >> 1;
      const float* src = (which ? P.in[I_WI] : P.in[I_WA]) + (size_t)db * 64 * 64;
      transpose_tile(src, 64, (bf16_t*)(ws + OFF_LRUT) + (size_t)db * 128 * 64 + which * 64 * 64, 64, 64, 64, 0, 0, smem);
      return;
    }
  }
  item -= NTRANS;
  if (item < NKEYCV) {
    size_t e = ((size_t)item * 256 + threadIdx.x) * 8;
    const float* s = P.in[I_KEYS] + e;
    f32x4 a = *(const f32x4*)s, b = *(const f32x4*)(s + 4);
    float v[8] = {a.x, a.y, a.z, a.w, b.x, b.y, b.z, b.w};
    *(u32x4*)((bf16_t*)(ws + OFF_KEYS) + e) = pack8(v);
    return;
  }
  item -= NKEYCV;
  {
    const int l = item / 96, cgp = item % 96;
    float* sS = (float*)smem;
    float* sRed = sS + 3 * 1024;
    const int tid = threadIdx.x;
    __syncthreads();
    for (int i = tid; i < 3 * 1024; i += 256) {
      int m = i >> 10, k = i & 1023;
      float c = m < 2 ? P.in[I_C][m * 1024 + k] : P.in[I_CCTX][k];
      sS[i] = siluf_(c);
    }
    __syncthreads();
    const int ks = tid >> 6, col = cgp * 64 + (tid & 63);
    const float* w = P.in[I_MODW] + (size_t)l * 1024 * 6144 + col;
    float a0 = 0.f, a1 = 0.f, a2 = 0.f;
    for (int k = ks * 256; k < ks * 256 + 256; ++k) {
      float wv = w[(size_t)k * 6144];
      a0 += sS[k] * wv; a1 += sS[1024 + k] * wv; a2 += sS[2048 + k] * wv;
    }
    sRed[(ks * 3 + 0) * 64 + (tid & 63)] = a0;
    sRed[(ks * 3 + 1) * 64 + (tid & 63)] = a1;
    sRed[(ks * 3 + 2) * 64 + (tid & 63)] = a2;
    __syncthreads();
    if (tid < 192) {
      int m = tid >> 6, c = tid & 63;
      float s = sRed[(0 * 3 + m) * 64 + c] + sRed[(1 * 3 + m) * 64 + c] + sRed[(2 * 3 + m) * 64 + c] + sRed[(3 * 3 + m) * 64 + c];
      int cc = cgp * 64 + c;
      ((float*)(ws + OFF_MODV))[((size_t)l * 3 + m) * 6144 + cc] = s + P.in[I_MODB][l * 6144 + cc];
    }
  }
}

constexpr int NPCONV = 2 * (NEXP * 1024 / (256 * 16));
DEV void st_peer_conv(const Params& P, int layer, int item) {
  const int half = NPCONV / 2;
  int which = item >= half;
  int it = which ? item - half : item;
  size_t e = ((size_t)it * 256 + threadIdx.x) * 16;
  const float* s = (which ? P.in[I_PV] : P.in[I_PU]) + (size_t)layer * NEXP * 1024 + e;
  const float sc = which ? PEER_VSCALE : PEER_USCALE;
  u32x4 o;
  f32x4 a = *(const f32x4*)s; o.x = pack4_fp8(a.x * sc, a.y * sc, a.z * sc, a.w * sc);
  a = *(const f32x4*)(s + 4); o.y = pack4_fp8(a.x * sc, a.y * sc, a.z * sc, a.w * sc);
  a = *(const f32x4*)(s + 8); o.z = pack4_fp8(a.x * sc, a.y * sc, a.z * sc, a.w * sc);
  a = *(const f32x4*)(s + 12); o.w = pack4_fp8(a.x * sc, a.y * sc, a.z * sc, a.w * sc);
  *(u32x4*)(P.ws + (which ? OFF_PV : OFF_PU) + e) = o;
}

DEV void st_normmod(const Params& P, int layer, int which, int row) {
  const int lane = threadIdx.x & 63;
  const float* src;
  if (which == 0 && layer == 0) src = row < NCTX ? P.in[I_CTX] + (size_t)row * 1024 : P.in[I_X] + (size_t)(row - NCTX) * 1024;
  else src = row < NCTX ? (const float*)(P.ws + OFF_CTXRES) + (size_t)row * 1024 : P.out + (size_t)(row - NCTX) * 1024;
  const float* mv = (const float*)(P.ws + OFF_MODV) + ((size_t)layer * 3 + mod_row(row)) * 6144;
  const float* sh = mv + (which ? 3 : 0) * 1024;
  const float* sc = mv + (which ? 4 : 1) * 1024;
  const float* nw = (which ? P.in[I_NORM2] : P.in[I_NORM1]) + layer * 1024;
  f32x4 v[4];
  float ss = 0.f;
#pragma unroll
  for (int i = 0; i < 4; ++i) {
    v[i] = *(const f32x4*)(src + i * 256 + lane * 4);
    ss += v[i].x * v[i].x + v[i].y * v[i].y + v[i].z * v[i].z + v[i].w * v[i].w;
  }
  ss = wave_sum(ss);
  const float rstd = frsq(ss * (1.f / 1024.f) + 1e-6f);
  bf16_t* dst = (bf16_t*)(P.ws + OFF_HBUF) + (size_t)row * 1024;
#pragma unroll
  for (int i = 0; i < 4; ++i) {
    int c = i * 256 + lane * 4;
    f32x4 w4 = *(const f32x4*)(nw + c), s4 = *(const f32x4*)(sc + c), h4 = *(const f32x4*)(sh + c);
    float o0 = v[i].x * rstd * w4.x * (1.f + s4.x) + h4.x;
    float o1 = v[i].y * rstd * w4.y * (1.f + s4.y) + h4.y;
    float o2 = v[i].z * rstd * w4.z * (1.f + s4.z) + h4.z;
    float o3 = v[i].w * rstd * w4.w * (1.f + s4.w) + h4.w;
    u32x2 pk; pk.x = pack2(o0, o1); pk.y = pack2(o2, o3);
    *(u32x2*)(dst + c) = pk;
  }
}

struct EpiProjL0 {
  bf16_t* proj; float* gates;
  DEVM void operator()(int row, int col, float v) const {
    proj[(size_t)row * EVC + col] = f2bf(v);
    if (col >= 1536 && col < 1552) gates[row * 32 + (col - 1536)] = v;
    else if (col >= 3088) gates[row * 32 + 16 + (col - 3088)] = v;
  }
};
struct EpiStoreBf {
  bf16_t* dst; int ld;
  DEVM void operator()(int row, int col, float v) const { dst[(size_t)row * ld + col] = f2bf(v); }
};
struct EpiStoreBfBias {
  bf16_t* dst; int ld; const float* bias;
  DEVM void operator()(int row, int col, float v) const { dst[(size_t)row * ld + col] = f2bf(v + (bias ? bias[col] : 0.f)); }
};
struct EpiOutProj {
  const float* x_lat; const float* x_ctx; float* o_lat; float* o_ctx; const float* modv;
  DEVM void operator()(int row, int col, float v) const {
    float g = modv[mod_row(row) * 6144 + 2 * 1024 + col];
    if (row < NCTX) o_ctx[(size_t)row * 1024 + col] = x_ctx[(size_t)row * 1024 + col] + g * v;
    else { size_t o = (size_t)(row - NCTX) * 1024 + col; o_lat[o] = x_lat[o] + g * v; }
  }
};
struct EpiScoreLds {
  float* sS; int m0;
  DEVM void operator()(int row, int col, float v) const { sS[(row - m0) * 129 + col] = v; }
};

DEV void st_xbc_conv(const Params& P, int row) {
  const int lane = threadIdx.x & 63;
  const bf16_t* proj = (const bf16_t*)(P.ws + OFF_PROJ);
  bf16_t* xc = (bf16_t*)P.out + (size_t)row * 1024;
  int row0, len, pos;
  if (row < NCTX) { row0 = (row / CTXL) * CTXL; len = CTXL; pos = row - row0; }
  else { int r = row - NCTX; row0 = NCTX + (r / SEQ) * SEQ; len = SEQ; pos = r % SEQ; }
  const float* cw = P.in[I_SCONVW];
  const float* cb = P.in[I_SCONVB];
#pragma unroll
  for (int hh = 0; hh < 2; ++hh) {
    const int ch = hh * 512 + lane * 8;
    float o[8];
#pragma unroll
    for (int j = 0; j < 8; ++j) o[j] = cb[ch + j];
#pragma unroll
    for (int tap = 0; tap < 4; ++tap) {
      int pp = pos + tap - 2;
      if (pp >= 0 && pp < len) {
        float x[8];
        unpack8(*(const u32x4*)(proj + (size_t)(row0 + pp) * EVC + 2064 + ch), x);
        f32x4 w0 = *(const f32x4*)(cw + tap * 1024 + ch), w1 = *(const f32x4*)(cw + tap * 1024 + ch + 4);
        o[0] += w0.x * x[0]; o[1] += w0.y * x[1]; o[2] += w0.z * x[2]; o[3] += w0.w * x[3];
        o[4] += w1.x * x[4]; o[5] += w1.y * x[5]; o[6] += w1.z * x[6]; o[7] += w1.w * x[7];
      }
    }
#pragma unroll
    for (int j = 0; j < 8; ++j) o[j] = siluf_(o[j]);
    *(u32x4*)(xc + ch) = pack8(o);
  }
}

#ifndef LA_NSEG
#define LA_NSEG 10
#endif
constexpr int LA_NCH = (CTXL + SEQ) / 64;
constexpr int LA_CPS = LA_NCH / LA_NSEG;
static_assert(LA_NCH % LA_NSEG == 0, "linattn segments");
#ifdef CPU_EMU
constexpr size_t OFF_LASEG = OFF_PR + PR_BYTES;
#else
constexpr size_t OFF_LASEG = OFF_R2L0 + (size_t)NTOK * 1024 * 2;
#endif
constexpr size_t LASEG_U = (size_t)48 * LA_NSEG * 8192 * 4;
constexpr size_t OFF_LASEG_N = OFF_LASEG + LASEG_U;
constexpr size_t OFF_LASEG_D = OFF_LASEG_N + (size_t)48 * LA_NSEG * 64 * 4;
#ifndef CPU_EMU
static_assert(OFF_LASEG_D + 48 * LA_NSEG * 4 <= OFF_PR + PR_BYTES, "laseg");
#endif

struct LaRaw { u32x4 q[2], k[4], x[4]; float g0, g1; };

template <bool MLSTM, bool FULL>
DEV void la_load_raw(const Params& P, int b, int h, int d, int cc, LaRaw& R) {
  constexpr int NC_CTX = CTXL / 64;
  const int tid = threadIdx.x;
  const int seg = cc >= NC_CTX;
  const int row0 = seg ? NCTX + b * SEQ : b * CTXL;
  const int len = seg ? SEQ : CTXL;
  const int cl = (seg ? cc - NC_CTX : cc) * 64;
  const bf16_t* proj = (const bf16_t*)(P.ws + OFF_PROJ);
  const bf16_t* xcv = (const bf16_t*)P.out;
  const float* gates = (const float*)(P.ws + OFF_GATES);
  if (tid < 64) {
    int p = cl + tid, grow = row0 + (d ? len - 1 - p : p);
    if (MLSTM) { R.g0 = gates[grow * 32 + d * 4 + h]; R.g1 = gates[grow * 32 + 8 + d * 4 + h]; }
    else { R.g0 = gates[grow * 32 + 16 + d * 8 + h]; R.g1 = 0.f; }
  }
  if (MLSTM) {
#pragma unroll
    for (int i = 0; i < 2; ++i) {
      int c = tid + i * 256, r = c >> 3, cc8 = (c & 7) * 8;
      int p = cl + r, pos = d ? len - 1 - p : p;
      const bf16_t* rp = proj + (size_t)(row0 + pos) * EVC;
      if (FULL) R.q[i] = *(const u32x4*)(rp + h * 64 + cc8);
      R.k[i] = *(const u32x4*)(rp + 256 + h * 64 + cc8);
    }
#pragma unroll
    for (int i = 0; i < 4; ++i) {
      int c = tid + i * 256, r = c >> 4, cc8 = (c & 15) * 8;
      int p = cl + r, pos = d ? len - 1 - p : p;
      R.x[i] = *(const u32x4*)(proj + (size_t)(row0 + pos) * EVC + 512 + h * 128 + cc8);
    }
  } else {
    const int grp = h >> 2;
#pragma unroll
    for (int i = 0; i < 2; ++i) {
      int c = tid + i * 256, r = c >> 3, cc8 = (c & 7) * 8;
      int p = cl + r, pos = d ? len - 1 - p : p;
      R.x[i] = *(const u32x4*)(xcv + (size_t)(row0 + pos) * 1024 + h * 64 + cc8);
    }
#pragma unroll
    for (int i = 0; i < 4; ++i) {
      int c = tid + i * 256, r = c >> 4, cc8 = (c & 15) * 8;
      int p = cl + r, pos = d ? len - 1 - p : p;
      const bf16_t* rp = xcv + (size_t)(row0 + pos) * 1024;
      R.k[i] = *(const u32x4*)(rp + 512 + grp * 128 + cc8);
      if (FULL) { if (i < 2) R.q[i] = *(const u32x4*)(rp + 768 + grp * 128 + cc8); else R.x[i] = *(const u32x4*)(rp + 768 + grp * 128 + cc8); }
    }
  }
}

template <bool MLSTM, bool FULL>
DEV void st_linattn_seg(const Params& P, int sid, int seg, unsigned char* smem) {
  constexpr int DK = MLSTM ? 64 : 128, DX = MLSTM ? 128 : 64;
  constexpr int QS = DK + 8;
  constexpr int NH = MLSTM ? 4 : 8;
  constexpr int NC_CTX = CTXL / 64;
  const int tid = threadIdx.x, lane = tid & 63, wave = tid >> 6;
  const int d = sid & 1, h = (sid >> 1) % NH, b = (sid >> 1) / NH;
  const int gsid = MLSTM ? sid : 16 + sid;
  bf16_t* sQ = (bf16_t*)smem;
  bf16_t* sK = sQ + 64 * QS;
  bf16_t* sP = sK;
  bf16_t* sKT = sK + 64 * QS;
  bf16_t* sXT = sKT + DK * 72;
  bf16_t* sST = sXT + DX * 72;
  float* sF = (float*)(sST + DX * QS);
  float* sLa = sF;
  float* sG = sF + 64;
  float* sBc = sF + 128;
  float* sDen = sF + 192;
  float* sN = sF + 256;
  int* sRow = (int*)(sF + 384);
  static_assert((64 * QS * 2 + DK * 72 + DX * 72 + DX * QS) * 2 + 448 * 4 <= SMEM_BYTES, "lds");
  bf16_t* outb = MLSTM ? (bf16_t*)(P.ws + OFF_HBUF) : (bf16_t*)(P.ws + OFF_R2L0);
  float* segU = (float*)(P.ws + OFF_LASEG);
  float* segN = (float*)(P.ws + OFF_LASEG_N);
  float* segD = (float*)(P.ws + OFF_LASEG_D);

  f32x16 accS[2];
#pragma unroll
  for (int j = 0; j < 2; ++j)
#pragma unroll
    for (int r = 0; r < 16; ++r) accS[j][r] = 0.f;
  const int sx0 = MLSTM ? wave * 32 : (wave >> 1) * 32;
  const int sk0 = MLSTM ? 0 : (wave & 1) * 64;
  float nreg = 0.f;
  float gb0 = 0.f, gb1 = 0.f, alog_e = 0.f, dskip = 0.f;
  if (MLSTM) { gb0 = P.in[I_IBIAS][d * 4 + h]; gb1 = P.in[I_FBIAS][d * 4 + h]; }
  else { gb0 = P.in[I_DTBIAS][d * 8 + h]; alog_e = fexp(P.in[I_ALOG][d * 8 + h]); dskip = P.in[I_DSKIP][h]; }

  const int cc0 = seg * LA_CPS, cc1 = cc0 + LA_CPS;
  LaRaw R;
  la_load_raw<MLSTM, FULL>(P, b, h, d, cc0, R);
  __syncthreads();
  if (FULL) {
    for (int js = 0; js < seg; ++js) {
      const size_t it = (size_t)gsid * LA_NSEG + js;
      const float a = fexp(segD[it]);
      const float* U = segU + it * 8192;
#pragma unroll
      for (int j = 0; j < 2; ++j)
#pragma unroll
        for (int r = 0; r < 16; ++r) accS[j][r] = a * accS[j][r] + U[(j * 16 + r) * 256 + tid];
      if (MLSTM && tid < 64) nreg = a * nreg + segN[it * 64 + tid];
    }
#pragma unroll
    for (int j = 0; j < 2; ++j)
#pragma unroll
      for (int r = 0; r < 16; ++r) sST[(sx0 + acc_row(r, lane)) * QS + sk0 + j * 32 + (lane & 31)] = f2bf(accS[j][r]);
    if (tid < 128) sN[tid] = (MLSTM && tid < 64) ? nreg : 0.f;
  }
  float lsum = 0.f;

  for (int cc = cc0; cc < cc1; ++cc) {
    int tl_ = threadIdx.x; OPAQUE(tl_);
    const int tid = tl_, lane = tl_ & 63;
    const int sgi = cc >= NC_CTX;
    const int row0 = sgi ? NCTX + b * SEQ : b * CTXL;
    const int len = sgi ? SEQ : CTXL;
    const int cl = (sgi ? cc - NC_CTX : cc) * 64;
    if (tid < 64) {
      int p = cl + tid;
      sRow[tid] = row0 + (d ? len - 1 - p : p);
      if (MLSTM) { sLa[tid] = -softplusf_(-(R.g1 + gb1)); sG[tid] = fexp(R.g0 + gb0); }
      else { float dt = softplusf_(R.g0 + gb0); sLa[tid] = -dt * alog_e; sG[tid] = dt; }
    }
    __syncthreads();
    if (wave == 0) {
      float v = sLa[lane];
#pragma unroll
      for (int off = 1; off < 64; off <<= 1) {
#ifdef CPU_EMU
        float o = emu_shfl_up(v, off);
#else
        float o = __shfl_up(v, off, 64);
#endif
        if (lane >= off) v += o;
      }
      sBc[lane] = v;
    }
    __syncthreads();
    const float blast = sBc[63];
    lsum += blast;
    if (MLSTM) {
#pragma unroll
      for (int i = 0; i < 2; ++i) {
        int c = tid + i * 256, r = c >> 3, cc8 = (c & 7) * 8;
        float kf[8]; unpack8(R.k[i], kf);
        const float wgt = fexp(blast - sBc[r]) * sG[r];
#pragma unroll
        for (int j = 0; j < 8; ++j) sKT[(cc8 + j) * 72 + r] = f2bf(kf[j] * wgt);
        if (FULL) {
          float qf[8]; unpack8(R.q[i], qf);
#pragma unroll
          for (int j = 0; j < 8; ++j) qf[j] *= 0.125f;
          *(u32x4*)(sQ + r * QS + cc8) = pack8(qf);
          *(u32x4*)(sK + r * QS + cc8) = R.k[i];
        }
      }
#pragma unroll
      for (int i = 0; i < 4; ++i) {
        int c = tid + i * 256, r = c >> 4, cc8 = (c & 15) * 8;
        const bf16_t* xs = (const bf16_t*)&R.x[i];
#pragma unroll
        for (int j = 0; j < 8; ++j) sXT[(cc8 + j) * 72 + r] = xs[j];
      }
    } else {
#pragma unroll
      for (int i = 0; i < 2; ++i) {
        int c = tid + i * 256, r = c >> 3, cc8 = (c & 7) * 8;
        const bf16_t* xs = (const bf16_t*)&R.x[i];
#pragma unroll
        for (int j = 0; j < 8; ++j) sXT[(cc8 + j) * 72 + r] = xs[j];
      }
#pragma unroll
      for (int i = 0; i < 4; ++i) {
        int c = tid + i * 256, r = c >> 4, cc8 = (c & 15) * 8;
        float kf[8]; unpack8(R.k[i], kf);
        const float wgt = fexp(blast - sBc[r]) * sG[r];
#pragma unroll
        for (int j = 0; j < 8; ++j) sKT[(cc8 + j) * 72 + r] = f2bf(kf[j] * wgt);
        if (FULL) {
          *(u32x4*)(sK + r * QS + cc8) = R.k[i];
          *(u32x4*)(sQ + r * QS + cc8) = i < 2 ? R.q[i] : R.x[i];
        }
      }
    }
    if (cc + 1 < cc1) la_load_raw<MLSTM, FULL>(P, b, h, d, cc + 1, R);
    __syncthreads();
    if (FULL) {
      const int tr = (wave >> 1) * 32, tc = (wave & 1) * 32;
      f32x16 accP;
#pragma unroll
      for (int r = 0; r < 16; ++r) accP[r] = 0.f;
      if (!(tr == 0 && tc == 32)) {
#pragma unroll
        for (int kk = 0; kk < DK / 16; ++kk) {
          const int ko = kk * 16 + 8 * (lane >> 5);
          bf16x8 a = *(const bf16x8*)(sQ + (tr + (lane & 31)) * QS + ko);
          bf16x8 bb = *(const bf16x8*)(sK + (tc + (lane & 31)) * QS + ko);
          accP = mfma32(a, bb, accP);
        }
      }
      __syncthreads();
      {
        const int s = tc + (lane & 31);
        const float bs = sBc[s], gs = sG[s];
#pragma unroll
        for (int r = 0; r < 16; ++r) {
          int t = tr + acc_row(r, lane);
          float v = (s <= t) ? accP[r] * fexp(sBc[t] - bs) * gs : 0.f;
          sP[t * 72 + s] = f2bf(v);
        }
        for (int i = tid; i < 64 * DK; i += 256) {
          int t = i / DK, k = i % DK;
          sQ[t * QS + k] = f2bf(bf2f(sQ[t * QS + k]) * fexp(sBc[t]));
        }
      }
      __syncthreads();
      constexpr int NYT = MLSTM ? 2 : 1;
      const int yc0 = MLSTM ? (wave & 1) * 64 : (wave & 1) * 32;
      f32x16 accY[NYT];
#pragma unroll
      for (int j = 0; j < NYT; ++j)
#pragma unroll
        for (int r = 0; r < 16; ++r) accY[j][r] = 0.f;
#pragma unroll
      for (int kk = 0; kk < 4; ++kk) {
        const int ko = kk * 16 + 8 * (lane >> 5);
        bf16x8 a = *(const bf16x8*)(sP + (tr + (lane & 31)) * 72 + ko);
#pragma unroll
        for (int j = 0; j < NYT; ++j) {
          bf16x8 bb = *(const bf16x8*)(sXT + (yc0 + j * 32 + (lane & 31)) * 72 + ko);
          accY[j] = mfma32(a, bb, accY[j]);
        }
      }
#pragma unroll
      for (int kk = 0; kk < DK / 16; ++kk) {
        const int ko = kk * 16 + 8 * (lane >> 5);
        bf16x8 a = *(const bf16x8*)(sQ + (tr + (lane & 31)) * QS + ko);
#pragma unroll
        for (int j = 0; j < NYT; ++j) {
          bf16x8 bb = *(const bf16x8*)(sST + (yc0 + j * 32 + (lane & 31)) * QS + ko);
          accY[j] = mfma32(a, bb, accY[j]);
        }
      }
      if (MLSTM) {
        if (tid < 64) {
          float den = 0.f, dq = 0.f;
#pragma unroll 8
          for (int s = 0; s < 64; ++s) den += bf2f(sP[tid * 72 + s]);
#pragma unroll 8
          for (int k = 0; k < DK; ++k) dq += sN[k] * bf2f(sQ[tid * QS + k]);
          sDen[tid] = den + dq;
        }
        __syncthreads();
      }
#pragma unroll
      for (int j = 0; j < NYT; ++j)
#pragma unroll
        for (int r = 0; r < 16; ++r) {
          int t = tr + acc_row(r, lane);
          int x = yc0 + j * 32 + (lane & 31);
          float v = accY[j][r];
          if (MLSTM) {
            v = v * frcp(fmaxf(fabsf(sDen[t]), 1.f));
            outb[(size_t)sRow[t] * 1024 + d * 512 + h * 128 + x] = f2bf(v);
          } else {
            if (d == 0) v += dskip * bf2f(sXT[x * 72 + t]);
            outb[(size_t)sRow[t] * 1024 + d * 512 + h * 64 + x] = f2bf(v);
          }
        }
      __syncthreads();
    }
    {
      const float eb = fexp(blast);
#pragma unroll
      for (int j = 0; j < 2; ++j)
#pragma unroll
        for (int r = 0; r < 16; ++r) accS[j][r] *= eb;
#pragma unroll
      for (int kk = 0; kk < 4; ++kk) {
        const int ko = kk * 16 + 8 * (lane >> 5);
        bf16x8 a = *(const bf16x8*)(sXT + (sx0 + (lane & 31)) * 72 + ko);
#pragma unroll
        for (int j = 0; j < 2; ++j) {
          bf16x8 bb = *(const bf16x8*)(sKT + (sk0 + j * 32 + (lane & 31)) * 72 + ko);
          accS[j] = mfma32(a, bb, accS[j]);
        }
      }
      if (FULL) {
#pragma unroll
        for (int j = 0; j < 2; ++j)
#pragma unroll
          for (int r = 0; r < 16; ++r) sST[(sx0 + acc_row(r, lane)) * QS + sk0 + j * 32 + (lane & 31)] = f2bf(accS[j][r]);
      }
      if (MLSTM && tid < 64) {
        float nn = nreg * eb;
        for (int s = 0; s < 64; ++s) nn += bf2f(sKT[tid * 72 + s]);
        nreg = nn;
        if (FULL) sN[tid] = nn;
      }
    }
    __syncthreads();
  }
  if (!FULL) {
    const size_t it = (size_t)gsid * LA_NSEG + seg;
    float* U = segU + it * 8192;
#pragma unroll
    for (int j = 0; j < 2; ++j)
#pragma unroll
      for (int r = 0; r < 16; ++r) U[(j * 16 + r) * 256 + tid] = accS[j][r];
    if (MLSTM && tid < 64) segN[it * 64 + tid] = nreg;
    if (tid == 0) segD[it] = lsum;
  }
}

DEV void st_finish_l0(const Params& P, int row) {
  const int lane = threadIdx.x & 63;
  bf16_t* hb = (bf16_t*)(P.ws + OFF_HBUF) + (size_t)row * 1024;
  const bf16_t* yb = (const bf16_t*)(P.ws + OFF_R2L0) + (size_t)row * 1024;
  const bf16_t* pr = (const bf16_t*)(P.ws + OFF_PROJ) + (size_t)row * EVC;
  const int ch = lane * 8;
  float h0[8], h1[8], o[8], f1[8];
  unpack8(*(const u32x4*)(hb + ch), h0);
  unpack8(*(const u32x4*)(hb + 512 + ch), h1);
  unpack8(*(const u32x4*)(pr + 1024 + ch), o);
  float ss = 0.f;
#pragma unroll
  for (int j = 0; j < 8; ++j) { h0[j] += h1[j]; ss += h0[j] * h0[j]; }
  ss += wshfl_xor(ss, 1); ss += wshfl_xor(ss, 2); ss += wshfl_xor(ss, 4); ss += wshfl_xor(ss, 8);
  float rstd = frsq(ss * (1.f / 128.f) + 1e-6f);
#pragma unroll
  for (int j = 0; j < 8; ++j) f1[j] = h0[j] * rstd * P.in[I_MNORM][ch + j] * sigmoidf_(o[j]);
  float y0[8], y1[8], z[8], f2[8];
  unpack8(*(const u32x4*)(yb + ch), y0);
  unpack8(*(const u32x4*)(yb + 512 + ch), y1);
  unpack8(*(const u32x4*)(pr + 1552 + ch), z);
  float s2 = 0.f;
#pragma unroll
  for (int j = 0; j < 8; ++j) { y0[j] = (y0[j] + y1[j]) * siluf_(z[j]); s2 += y0[j] * y0[j]; }
  s2 = wave_sum(s2);
  float rstd2 = frsq(s2 * (1.f / 512.f) + 1e-6f);
#pragma unroll
  for (int j = 0; j < 8; ++j) f2[j] = y0[j] * rstd2 * P.in[I_SNORM][ch + j];
  *(u32x4*)(hb + ch) = pack8(f1);
  *(u32x4*)(hb + 512 + ch) = pack8(f2);
}

DEV float mixval(const bf16_t* __restrict__ proj, int row, int c, const float* __restrict__ mu) {
  float self = bf2f(proj[(size_t)row * ODC + c]);
  int nrow = -1;
  if (row < NCTX) {
    int pos = row % CTXL;
    if (c < 896) { if (pos > 0) nrow = row - 1; }
    else { if (pos < CTXL - 1) nrow = row + 1; }
  } else {
    int pos = (row - NCTX) % SEQ;
    int gx = pos % GW, gy = pos / GW, q = c / 448;
    if (q == 0) { if (gx > 0) nrow = row - 1; }
    else if (q == 1) { if (gx < GW - 1) nrow = row + 1; }
    else if (q == 2) { if (gy > 0) nrow = row - GW; }
    else { if (gy < SEQ / GW - 1) nrow = row + GW; }
  }
  float nb = nrow >= 0 ? bf2f(proj[(size_t)nrow * ODC + c]) : 0.f;
  return self + mu[c] * (nb - self);
}

DEV void st_lora_act(const Params& P, int row) {
  const int lane = threadIdx.x & 63;
  const bf16_t* proj = (const bf16_t*)(P.ws + OFF_PROJ);
  bf16_t* hb = (bf16_t*)(P.ws + OFF_HBUF) + (size_t)row * 1024;
  float v[4];
#pragma unroll
  for (int j = 0; j < 4; ++j) {
    int c = lane * 4 + j;
    float x = mixval(proj, row, 1536 + c, P.in[I_MU]);
    v[j] = c < 64 ? tanhf_(x) : (c < 128 ? x : sigmoidf_(x));
  }
  u32x2 pk; pk.x = pack2(v[0], v[1]); pk.y = pack2(v[2], v[3]);
  *(u32x2*)(hb + lane * 4) = pk;
}

DEV void st_rwkv_stream(const Params& P, int sid, unsigned char* smem) {
  const int tid = threadIdx.x, lane = tid & 63, wave = tid >> 6;
  const int d = sid & 1, h = (sid >> 1) & 7, b = sid >> 4;
  float* sR = (float*)smem;
  float* sW = sR + 2048;
  float* sKk = sW + 2048;
  float* sV = sKk + 2048;
  float* sA = sV + 2048;
  float* sBb = sA + 2048;
  float* sY = sBb + 2048;
  int* sRow = (int*)(sY + 2048);
  const bf16_t* proj = (const bf16_t*)(P.ws + OFF_PROJ);
  const bf16_t* lora = (const bf16_t*)(P.ws + OFF_LORA);
  bf16_t* yout = (bf16_t*)(P.ws + OFF_HBUF);
  const float* mu = P.in[I_MU];
  const int vrow = tid >> 2, j4 = tid & 3;
  float S[16];
#pragma unroll
  for (int i = 0; i < 16; ++i) S[i] = 0.f;
  const float kkw = P.in[I_KK][h * 64 + lane], kaw = P.in[I_KA][h * 64 + lane];
  for (int seg = 0; seg < 2; ++seg) {
    const int row0 = seg == 0 ? b * CTXL : NCTX + b * SEQ;
    const int len = seg == 0 ? CTXL : SEQ;
    for (int it = 0; it < len / 32; ++it) {
      __syncthreads();
      for (int s = wave; s < 32; s += 4) {
        int p = it * 32 + s, pos = d ? len - 1 - p : p, row = row0 + pos;
        int c = h * 64 + lane;
        float r = mixval(proj, row, c, mu);
        float k = mixval(proj, row, 512 + c, mu);
        float v = mixval(proj, row, 1024 + c, mu);
        float kk = k * kkw;
        float ss = wave_sum(kk * kk);
        kk *= frsq(ss + 1e-12f);
        float lw = bf2f(lora[((size_t)d * NTOK + row) * 512 + c]);
        float la = bf2f(lora[((size_t)(2 + d) * NTOK + row) * 512 + c]);
        float w = fexp(-0.6065306597126334f * sigmoidf_(lw));
        float a = sigmoidf_(la);
        float kt = k * (1.f + (a - 1.f) * kaw);
        sR[s * 64 + lane] = r; sW[s * 64 + lane] = w; sKk[s * 64 + lane] = kt; sV[s * 64 + lane] = v;
        sA[s * 64 + lane] = -kk; sBb[s * 64 + lane] = kk * a;
        if (lane == 0) sRow[s] = row;
      }
      __syncthreads();
      for (int s = 0; s < 32; ++s) {
        const float* pa = sA + s * 64 + j4 * 16;
        const float* pw = sW + s * 64 + j4 * 16;
        const float* pk = sKk + s * 64 + j4 * 16;
        const float* pb = sBb + s * 64 + j4 * 16;
        const float* pr = sR + s * 64 + j4 * 16;
        const float vv = sV[s * 64 + vrow];
        float sa = 0.f;
#pragma unroll
        for (int i = 0; i < 16; ++i) sa += S[i] * pa[i];
        sa += wshfl_xor(sa, 1); sa += wshfl_xor(sa, 2);
        float y = 0.f;
#pragma unroll
        for (int i = 0; i < 16; ++i) { S[i] = S[i] * pw[i] + sa * pb[i] + vv * pk[i]; y += S[i] * pr[i]; }
        y += wshfl_xor(y, 1); y += wshfl_xor(y, 2);
        if (j4 == 0) sY[s * 64 + vrow] = y;
      }
      __syncthreads();
      for (int i = tid; i < 2048; i += 256) {
        int s = i >> 6, c = i & 63;
        yout[(size_t)sRow[s] * 1024 + d * 512 + h * 64 + c] = f2bf(sY[i]);
      }
    }
  }
}


DEV int nbr_row(int row, int c) {
  if (row < NCTX) {
    int pos = row % CTXL;
    if (c < 896) return pos > 0 ? row - 1 : -1;
    return pos < CTXL - 1 ? row + 1 : -1;
  }
  int pos = (row - NCTX) % SEQ;
  int gx = pos % GW, gy = pos / GW, q = c / 448;
  if (q == 0) return gx > 0 ? row - 1 : -1;
  if (q == 1) return gx < GW - 1 ? row + 1 : -1;
  if (q == 2) return gy > 0 ? row - GW : -1;
  return gy < SEQ / GW - 1 ? row + GW : -1;
}

struct RwkvRaw { u32x4 rs, rn, ks, kn, vs, vn, lw, la; int row; };

DEV void rwkv_load_raw(const bf16_t* __restrict__ proj, const bf16_t* __restrict__ lora, int b, int h, int d, int cc, int t, int c0,
                       RwkvRaw& R) {
  constexpr int NC_CTX = CTXL / 32;
  const int seg = cc >= NC_CTX;
  const int row0 = seg ? NCTX + b * SEQ : b * CTXL;
  const int len = seg ? SEQ : CTXL;
  const int p = (seg ? cc - NC_CTX : cc) * 32 + t;
  const int row = row0 + (d ? len - 1 - p : p);
  const int col = h * 64 + c0;
  const u32x4 z4 = {0u, 0u, 0u, 0u};
  const bf16_t* rp = proj + (size_t)row * ODC;
  R.row = row;
  R.rs = *(const u32x4*)(rp + col);
  R.ks = *(const u32x4*)(rp + 512 + col);
  R.vs = *(const u32x4*)(rp + 1024 + col);
  int n0 = nbr_row(row, col), n1 = nbr_row(row, 512 + col), n2 = nbr_row(row, 1024 + col);
  R.rn = n0 >= 0 ? *(const u32x4*)(proj + (size_t)n0 * ODC + col) : z4;
  R.kn = n1 >= 0 ? *(const u32x4*)(proj + (size_t)n1 * ODC + 512 + col) : z4;
  R.vn = n2 >= 0 ? *(const u32x4*)(proj + (size_t)n2 * ODC + 1024 + col) : z4;
  R.lw = *(const u32x4*)(lora + ((size_t)d * NTOK + row) * 512 + col);
  R.la = *(const u32x4*)(lora + ((size_t)(2 + d) * NTOK + row) * 512 + col);
}

#ifndef RW_NSEG
#define RW_NSEG 13
#endif
constexpr int RW_NCH = (CTXL + SEQ) / 32;
constexpr int RW_CPS = RW_NCH / RW_NSEG;
static_assert(RW_NCH % RW_NSEG == 0, "rwkv segments");
constexpr size_t OFF_RWSEG = OFF_PU;
static_assert((size_t)32 * RW_NSEG * 64 * 128 * 4 <= (size_t)2 * NEXP * 1024, "rwseg");

template <bool FULL>
DEV void st_rwkv_seg(const Params& P, int sid, int seg, unsigned char* smem) {
  constexpr int NVB = FULL ? 2 : 4;
  constexpr int ZR = FULL ? 64 : 128;
  const int tid = threadIdx.x, lane = tid & 63, wave = tid >> 6;
  const int d = sid & 1, h = (sid >> 1) & 7, b = sid >> 4;
  bf16_t* sAt = (bf16_t*)smem;
  bf16_t* sRt = sAt + 32 * 72;
  bf16_t* sBt = sRt + 32 * 72;
  bf16_t* sKt = sBt + 32 * 72;
  bf16_t* sBT = sKt + 32 * 72;
  bf16_t* sKT = sBT + 64 * 40;
  bf16_t* sVT = sKT + 64 * 40;
  bf16_t* sLak = sVT + 64 * 40;
  bf16_t* sM = sLak + 32 * 40;
  bf16_t* sLrb = sM + 32 * 40;
  bf16_t* sLrk = sLrb + 32 * 40;
  bf16_t* sZ = FULL ? sLrk + 32 * 40 : sLrb;
  bf16_t* after = sZ + ZR * 72;
  bf16_t* sRT = FULL ? after : nullptr;
  bf16_t* sSAT = FULL ? after + 64 * 40 : sRt;
  float* sLP = (float*)(FULL ? after + 2 * 64 * 40 : after);
  float* sLab = sLP + 32 * 64;
  float* sD = sLab + 32 * 33;
  float* sPT = sD + 768;
  int* sRow = (int*)(sPT + 64);
  if (!FULL) sRT = (bf16_t*)sLP;
  static_assert((4 * 32 * 72 + 3 * 64 * 40 + 4 * 32 * 40 + 2 * 64 * 40 + 64 * 72) * 2 + (32 * 64 + 32 * 33 + 768 + 64 + 32 + 320) * 4 + 16 <= SMEM_BYTES, "lds full");
  static_assert((4 * 32 * 72 + 3 * 64 * 40 + 2 * 32 * 40 + 128 * 72) * 2 + (32 * 64 + 32 * 33 + 768 + 64 + 32) * 4 <= SMEM_BYTES, "lds p1");
  static_assert(128 * 40 * 2 <= (32 * 64 + 32 * 33) * 4 && 128 * 40 <= 3 * 32 * 72, "alias");
  const bf16_t* proj = (const bf16_t*)(P.ws + OFF_PROJ);
  const bf16_t* lora = (const bf16_t*)(P.ws + OFF_LORA);
  bf16_t* yout = (bf16_t*)(P.ws + OFF_HBUF);
  float* segZ = (float*)(P.ws + OFF_RWSEG);
  const int t = tid >> 3, c0 = (tid & 7) * 8;
  const int hl = lane >> 5, l31 = lane & 31;
  float* sCst = (float*)(smem + SMEM_BYTES - 320 * 4 - 16);
  if (tid < 64) {
    sCst[tid] = P.in[I_MU][h * 64 + tid]; sCst[64 + tid] = P.in[I_MU][512 + h * 64 + tid]; sCst[128 + tid] = P.in[I_MU][1024 + h * 64 + tid];
    sCst[192 + tid] = P.in[I_KK][h * 64 + tid]; sCst[256 + tid] = P.in[I_KA][h * 64 + tid];
  }
  const int cc0 = seg * RW_CPS, cc1 = cc0 + RW_CPS;
  RwkvRaw R;
  rwkv_load_raw(proj, lora, b, h, d, cc0, t, c0, R);
  f32x16 Zm[2];
#pragma unroll
  for (int j = 0; j < 2; ++j)
#pragma unroll
    for (int r = 0; r < 16; ++r) Zm[j][r] = 0.f;
  __syncthreads();
  for (int i = tid; i < ZR * 72; i += 256) sZ[i] = 0;
  __syncthreads();
  if (!FULL) {
    if (wave >= 2) {
#pragma unroll
      for (int cb = 0; cb < 2; ++cb)
#pragma unroll
        for (int r = 0; r < 16; ++r) {
          int c = cb * 32 + acc_row(r, lane), vp = wave * 32 + l31;
          if (c == vp - 64) { Zm[cb][r] = 1.f; sZ[vp * 72 + c] = 0x3f80; }
        }
    }
  } else {
    for (int js = 0; js < seg; ++js) {
      const float* Zs = segZ + ((size_t)sid * RW_NSEG + js) * 64 * 128;
      bf16_t* sG = sAt;
      for (int i = tid; i < 64 * 64; i += 256) { int c = i >> 6, c2 = i & 63; sG[c * 72 + c2] = f2bf(Zs[c * 128 + 64 + c2]); }
      __syncthreads();
      if (wave >= 2) {
        const int cb = wave - 2;
#pragma unroll
        for (int vb = 0; vb < 2; ++vb) {
          f32x16 acc;
#pragma unroll
          for (int r = 0; r < 16; ++r) acc[r] = Zs[(cb * 32 + acc_row(r, lane)) * 128 + vb * 32 + l31];
#pragma unroll
          for (int kk = 0; kk < 4; ++kk) {
            bf16x8 a = *(const bf16x8*)(sG + (cb * 32 + l31) * 72 + kk * 16 + 8 * hl);
            bf16x8 bb = *(const bf16x8*)(sZ + (vb * 32 + l31) * 72 + kk * 16 + 8 * hl);
            acc = mfma32(a, bb, acc);
          }
          Zm[vb] = acc;
        }
      }
      __syncthreads();
      if (wave >= 2) {
        const int cb = wave - 2;
#pragma unroll
        for (int vb = 0; vb < 2; ++vb)
#pragma unroll
          for (int g = 0; g < 4; ++g) {
            u32x2 pk; pk.x = pack2(Zm[vb][4 * g], Zm[vb][4 * g + 1]); pk.y = pack2(Zm[vb][4 * g + 2], Zm[vb][4 * g + 3]);
            *(u32x2*)(sZ + (vb * 32 + l31) * 72 + cb * 32 + 8 * g + 4 * hl) = pk;
          }
      }
      __syncthreads();
    }
  }
  for (int cc = cc0; cc < cc1; ++cc) {
    int tl_ = threadIdx.x; OPAQUE(tl_);
    const int tid = tl_, lane = tl_ & 63, hl = lane >> 5, l31 = lane & 31, t = tl_ >> 3, c0 = (tl_ & 7) * 8;
    const float* muR = sCst + c0; const float* muK = sCst + 64 + c0; const float* muV = sCst + 128 + c0;
    const float* kkw = sCst + 192 + c0; const float* kaw = sCst + 256 + c0;
    {
      float lwf[8];
      unpack8(R.lw, lwf);
#pragma unroll
      for (int j = 0; j < 8; ++j) sLP[t * 64 + c0 + j] = -0.6065306597126334f * sigmoidf_(lwf[j]);
      if ((tid & 7) == 0) sRow[t] = R.row;
    }
    __syncthreads();
    if (tid < 64) {
      float run = 0.f;
#pragma unroll 8
      for (int tt = 0; tt < 32; ++tt) { run += sLP[tt * 64 + tid]; sLP[tt * 64 + tid] = run; }
      sPT[tid] = fexp(run);
    }
    __syncthreads();
    {
      float xs[8], xn[8], kt[8], aa[8], ob[8], ok[8];
      unpack8(R.ks, xs); unpack8(R.kn, xn);
      float ss = 0.f;
#pragma unroll
      for (int j = 0; j < 8; ++j) { kt[j] = xs[j] + muK[j] * (xn[j] - xs[j]); aa[j] = kt[j] * kkw[j]; ss += aa[j] * aa[j]; }
      ss += wshfl_xor(ss, 1); ss += wshfl_xor(ss, 2); ss += wshfl_xor(ss, 4);
      const float rn = frsq(ss + 1e-12f);
      float laf[8];
      unpack8(R.la, laf);
#pragma unroll
      for (int j = 0; j < 8; ++j) {
        const float lp = sLP[t * 64 + c0 + j];
        const float lpm = t > 0 ? sLP[(t - 1) * 64 + c0 + j] : 0.f;
        const float e = fexp(-lp);
        const float kkn = aa[j] * rn;
        const float asg = sigmoidf_(laf[j]);
        aa[j] = -kkn * fexp(lpm);
        ob[j] = kkn * asg * e;
        ok[j] = kt[j] * (1.f + (asg - 1.f) * kaw[j]) * e;
      }
      *(u32x4*)(sAt + t * 72 + c0) = pack8(aa);
      *(u32x4*)(sBt + t * 72 + c0) = pack8(ob);
      *(u32x4*)(sKt + t * 72 + c0) = pack8(ok);
#pragma unroll
      for (int j = 0; j < 8; ++j) { sBT[(c0 + j) * 40 + t] = f2bf(ob[j]); sKT[(c0 + j) * 40 + t] = f2bf(ok[j]); }
      unpack8(R.vs, xs); unpack8(R.vn, xn);
#pragma unroll
      for (int j = 0; j < 8; ++j) sVT[(c0 + j) * 40 + t] = f2bf(xs[j] + muV[j] * (xn[j] - xs[j]));
      if (FULL) {
        unpack8(R.rs, xs); unpack8(R.rn, xn);
#pragma unroll
        for (int j = 0; j < 8; ++j) xs[j] = (xs[j] + muR[j] * (xn[j] - xs[j])) * fexp(sLP[t * 64 + c0 + j]);
        *(u32x4*)(sRt + t * 72 + c0) = pack8(xs);
      }
    }
    if (cc + 1 < cc1) rwkv_load_raw(proj, lora, b, h, d, cc + 1, t, c0, R);
    __syncthreads();
    if (FULL || wave < 2) {
      const bf16_t* Asrc = wave < 2 ? sAt : sRt;
      const bf16_t* Bsrc = (wave & 1) ? sKt : sBt;
      f32x16 acc;
#pragma unroll
      for (int r = 0; r < 16; ++r) acc[r] = 0.f;
#pragma unroll
      for (int kk = 0; kk < 4; ++kk) {
        bf16x8 a = *(const bf16x8*)(Asrc + l31 * 72 + kk * 16 + 8 * hl);
        bf16x8 bb = *(const bf16x8*)(Bsrc + l31 * 72 + kk * 16 + 8 * hl);
        acc = mfma32(a, bb, acc);
      }
      bf16_t* dst = wave == 1 ? sLak : (wave == 2 ? sLrb : sLrk);
#pragma unroll
      for (int r = 0; r < 16; ++r) {
        int tt = acc_row(r, lane), j = l31;
        bool keep = wave < 2 ? (j < tt) : (j <= tt);
        float v = keep ? acc[r] : 0.f;
        if (wave == 0) sLab[tt * 33 + j] = v;
        else dst[tt * 40 + j] = f2bf(v);
      }
    }
    __syncthreads();
    if (tid < 32) {
      const int q = tid >> 4, c = tid & 15;
      float x[16];
#pragma unroll
      for (int i = 0; i < 16; ++i) {
        float sacc = (i == c) ? 1.f : 0.f;
#pragma unroll
        for (int j = 0; j < i; ++j) sacc += sLab[(q * 16 + i) * 33 + q * 16 + j] * x[j];
        x[i] = sacc;
        sD[q * 256 + i * 16 + c] = sacc;
      }
    }
    __syncthreads();
    {
      const int i = tid >> 4, c = tid & 15;
      float sacc = 0.f;
#pragma unroll
      for (int j = 0; j < 16; ++j) sacc += sLab[(16 + i) * 33 + j] * sD[j * 16 + c];
      sD[512 + i * 16 + c] = sacc;
    }
    __syncthreads();
    {
      const int i = tid >> 4, c = tid & 15;
      float sacc = 0.f;
#pragma unroll
      for (int j = 0; j < 16; ++j) sacc += sD[256 + i * 16 + j] * sD[512 + j * 16 + c];
      sM[(16 + i) * 40 + c] = f2bf(sacc);
      sM[i * 40 + c] = f2bf(sD[i * 16 + c]);
      sM[(16 + i) * 40 + 16 + c] = f2bf(sD[256 + i * 16 + c]);
      sM[i * 40 + 16 + c] = 0;
    }
    if (wave < NVB) {
      const int vb = wave;
      f32x16 acc;
#pragma unroll
      for (int r = 0; r < 16; ++r) acc[r] = 0.f;
#pragma unroll
      for (int kk = 0; kk < 4; ++kk) {
        bf16x8 a = *(const bf16x8*)(sAt + l31 * 72 + kk * 16 + 8 * hl);
        bf16x8 bb = *(const bf16x8*)(sZ + (vb * 32 + l31) * 72 + kk * 16 + 8 * hl);
        acc = mfma32(a, bb, acc);
      }
      if (vb < 2) {
#pragma unroll
        for (int kk = 0; kk < 2; ++kk) {
          bf16x8 a = *(const bf16x8*)(sLak + l31 * 40 + kk * 16 + 8 * hl);
          bf16x8 bb = *(const bf16x8*)(sVT + (vb * 32 + l31) * 40 + kk * 16 + 8 * hl);
          acc = mfma32(a, bb, acc);
        }
      }
#pragma unroll
      for (int g = 0; g < 4; ++g) {
        u32x2 pk; pk.x = pack2(acc[4 * g], acc[4 * g + 1]); pk.y = pack2(acc[4 * g + 2], acc[4 * g + 3]);
        *(u32x2*)(sRT + (vb * 32 + l31) * 40 + 8 * g + 4 * hl) = pk;
      }
    }
    __syncthreads();
    if (wave < NVB) {
      const int vb = wave;
      f32x16 acc;
#pragma unroll
      for (int r = 0; r < 16; ++r) acc[r] = 0.f;
#pragma unroll
      for (int kk = 0; kk < 2; ++kk) {
        bf16x8 a = *(const bf16x8*)(sM + l31 * 40 + kk * 16 + 8 * hl);
        bf16x8 bb = *(const bf16x8*)(sRT + (vb * 32 + l31) * 40 + kk * 16 + 8 * hl);
        acc = mfma32(a, bb, acc);
      }
#pragma unroll
      for (int g = 0; g < 4; ++g) {
        u32x2 pk; pk.x = pack2(acc[4 * g], acc[4 * g + 1]); pk.y = pack2(acc[4 * g + 2], acc[4 * g + 3]);
        *(u32x2*)(sSAT + (vb * 32 + l31) * 40 + 8 * g + 4 * hl) = pk;
      }
    }
    __syncthreads();
    if (FULL) {
      if (wave < 2) {
        const int vb = wave;
        f32x16 acc;
#pragma unroll
        for (int r = 0; r < 16; ++r) acc[r] = 0.f;
#pragma unroll
        for (int kk = 0; kk < 4; ++kk) {
          bf16x8 a = *(const bf16x8*)(sRt + l31 * 72 + kk * 16 + 8 * hl);
          bf16x8 bb = *(const bf16x8*)(sZ + (vb * 32 + l31) * 72 + kk * 16 + 8 * hl);
          acc = mfma32(a, bb, acc);
        }
#pragma unroll
        for (int kk = 0; kk < 2; ++kk) {
          bf16x8 a = *(const bf16x8*)(sLrb + l31 * 40 + kk * 16 + 8 * hl);
          bf16x8 bb = *(const bf16x8*)(sSAT + (vb * 32 + l31) * 40 + kk * 16 + 8 * hl);
          acc = mfma32(a, bb, acc);
        }
#pragma unroll
        for (int kk = 0; kk < 2; ++kk) {
          bf16x8 a = *(const bf16x8*)(sLrk + l31 * 40 + kk * 16 + 8 * hl);
          bf16x8 bb = *(const bf16x8*)(sVT + (vb * 32 + l31) * 40 + kk * 16 + 8 * hl);
          acc = mfma32(a, bb, acc);
        }
#pragma unroll
        for (int r = 0; r < 16; ++r) {
          int tt = acc_row(r, lane);
          yout[(size_t)sRow[tt] * 1024 + d * 512 + h * 64 + vb * 32 + l31] = f2bf(acc[r]);
        }
      } else {
        const int cb = wave - 2;
#pragma unroll
        for (int vb = 0; vb < 2; ++vb) {
          f32x16 acc;
#pragma unroll
          for (int r = 0; r < 16; ++r) acc[r] = 0.f;
#pragma unroll
          for (int kk = 0; kk < 2; ++kk) {
            bf16x8 a = *(const bf16x8*)(sBT + (cb * 32 + l31) * 40 + kk * 16 + 8 * hl);
            bf16x8 bb = *(const bf16x8*)(sSAT + (vb * 32 + l31) * 40 + kk * 16 + 8 * hl);
            acc = mfma32(a, bb, acc);
          }
#pragma unroll
          for (int kk = 0; kk < 2; ++kk) {
            bf16x8 a = *(const bf16x8*)(sKT + (cb * 32 + l31) * 40 + kk * 16 + 8 * hl);
            bf16x8 bb = *(const bf16x8*)(sVT + (vb * 32 + l31) * 40 + kk * 16 + 8 * hl);
            acc = mfma32(a, bb, acc);
          }
#pragma unroll
          for (int r = 0; r < 16; ++r) Zm[vb][r] = sPT[cb * 32 + acc_row(r, lane)] * (Zm[vb][r] + acc[r]);
        }
      }
      __syncthreads();
      if (wave >= 2) {
        const int cb = wave - 2;
#pragma unroll
        for (int vb = 0; vb < 2; ++vb)
#pragma unroll
          for (int g = 0; g < 4; ++g) {
            u32x2 pk; pk.x = pack2(Zm[vb][4 * g], Zm[vb][4 * g + 1]); pk.y = pack2(Zm[vb][4 * g + 2], Zm[vb][4 * g + 3]);
            *(u32x2*)(sZ + (vb * 32 + l31) * 72 + cb * 32 + 8 * g + 4 * hl) = pk;
          }
      }
    } else {
      const int vb = wave;
#pragma unroll
      for (int cb = 0; cb < 2; ++cb) {
        f32x16 acc;
#pragma unroll
        for (int r = 0; r < 16; ++r) acc[r] = 0.f;
#pragma unroll
        for (int kk = 0; kk < 2; ++kk) {
          bf16x8 a = *(const bf16x8*)(sBT + (cb * 32 + l31) * 40 + kk * 16 + 8 * hl);
          bf16x8 bb = *(const bf16x8*)(sSAT + (vb * 32 + l31) * 40 + kk * 16 + 8 * hl);
          acc = mfma32(a, bb, acc);
        }
        if (vb < 2) {
#pragma unroll
          for (int kk = 0; kk < 2; ++kk) {
            bf16x8 a = *(const bf16x8*)(sKT + (cb * 32 + l31) * 40 + kk * 16 + 8 * hl);
            bf16x8 bb = *(const bf16x8*)(sVT + (vb * 32 + l31) * 40 + kk * 16 + 8 * hl);
            acc = mfma32(a, bb, acc);
          }
        }
#pragma unroll
        for (int r = 0; r < 16; ++r) Zm[cb][r] = sPT[cb * 32 + acc_row(r, lane)] * (Zm[cb][r] + acc[r]);
      }
#pragma unroll
      for (int cb = 0; cb < 2; ++cb)
#pragma unroll
        for (int g = 0; g < 4; ++g) {
          u32x2 pk; pk.x = pack2(Zm[cb][4 * g], Zm[cb][4 * g + 1]); pk.y = pack2(Zm[cb][4 * g + 2], Zm[cb][4 * g + 3]);
          *(u32x2*)(sZ + (vb * 32 + l31) * 72 + cb * 32 + 8 * g + 4 * hl) = pk;
        }
    }
  }
  if (!FULL) {
    float* Zs = segZ + ((size_t)sid * RW_NSEG + seg) * 64 * 128;
#pragma unroll
    for (int cb = 0; cb < 2; ++cb)
#pragma unroll
      for (int r = 0; r < 16; ++r) Zs[(cb * 32 + acc_row(r, lane)) * 128 + wave * 32 + l31] = Zm[cb][r];
  }
}

#ifndef LRU_NSEG
#define LRU_NSEG 13
#endif
constexpr int LRU_NCH = (CTXL + SEQ) / 64;
constexpr int LRU_CPS = LRU_NCH / LRU_NSEG;
static_assert(LRU_NCH % LRU_NSEG == 0, "lru segments");
constexpr size_t OFF_LRUSEG = OFF_RWSEG + (size_t)32 * RW_NSEG * 64 * 128 * 4;
static_assert(OFF_LRUSEG + (size_t)32 * LRU_NSEG * 128 * 4 <= OFF_PU + (size_t)2 * NEXP * 1024, "lruseg");

template <bool FULL>
DEV void st_lru_seg(const Params& P, int sid, int seg, unsigned char* smem) {
  constexpr int NC_CTX = CTXL / 64;
  const int tid = threadIdx.x, lane = tid & 63, wave = tid >> 6;
  const int d = sid & 1, blk = (sid >> 1) & 7, b = sid >> 4;
  float* sXc = (float*)smem;
  float* sAc = sXc + 4096;
  float* sBc = sAc + 4096;
  float* sU = sBc + 4096;
  bf16_t* sAop = (bf16_t*)(sU + 4096);
  int* sRow = (int*)(sAop + 64 * 72);
  const bf16_t* proj = (const bf16_t*)(P.ws + OFF_PROJ);
  bf16_t* uout = (bf16_t*)(P.ws + OFF_LORA) + (size_t)d * NTOK * 512;
  const bf16_t* lruT = (const bf16_t*)(P.ws + OFF_LRUT) + (size_t)(d * 8 + blk) * 128 * 64;
  float* segS = (float*)(P.ws + OFF_LRUSEG);
  const float* cw = P.in[I_LCONVW];
  const float* cb = P.in[I_LCONVB];
  const int tr = (wave >> 1) * 32, nc0 = (wave & 1) * 64;
  bf16x8 bfrag[2][4];
#pragma unroll
  for (int j = 0; j < 2; ++j)
#pragma unroll
    for (int kk = 0; kk < 4; ++kk)
      bfrag[j][kk] = *(const bf16x8*)(lruT + (nc0 + j * 32 + (lane & 31)) * 64 + kk * 16 + 8 * (lane >> 5));
  float ebias[2], esp[2];
#pragma unroll
  for (int j = 0; j < 2; ++j) {
    int e = nc0 + j * 32 + (lane & 31);
    int ch = blk * 64 + (e & 63);
    ebias[j] = e < 64 ? P.in[I_BA][d * 512 + ch] : P.in[I_BI][d * 512 + ch];
    esp[j] = softplusf_(-P.in[I_LAM][d * 512 + ch]);
  }
  const int lc8 = (tid & 7) * 8, lch = blk * 64 + lc8;
  float cwr[4][8], cbr[8];
#pragma unroll
  for (int j = 0; j < 8; ++j) {
    cbr[j] = cb[lch + j];
#pragma unroll
    for (int tap = 0; tap < 4; ++tap) cwr[tap][j] = cw[tap * 512 + lch + j];
  }
  float hstate = 0.f, aprod = 1.f;
  if (FULL && wave == 0) {
    for (int js = 0; js < seg; ++js) {
      const float* S = segS + ((size_t)sid * LRU_NSEG + js) * 128;
      hstate = S[lane] * hstate + S[64 + lane];
    }
  }
  const int cc0 = seg * LRU_CPS, cc1 = cc0 + LRU_CPS;
  for (int cc = cc0; cc < cc1; ++cc) {
    int tl_ = threadIdx.x; OPAQUE(tl_);
    const int tid = tl_, lane = tl_ & 63;
    const int sgi = cc >= NC_CTX;
    const int row0 = sgi ? NCTX + b * SEQ : b * CTXL;
    const int len = sgi ? SEQ : CTXL;
    const int cl = (sgi ? cc - NC_CTX : cc) * 64;
    __syncthreads();
    if (tid < 64) { int p = cl + tid; sRow[tid] = row0 + (d ? len - 1 - p : p); }
#pragma unroll
    for (int i = 0; i < 2; ++i) {
      int c = tid + i * 256, r = c >> 3;
      int p = cl + r, pos = d ? len - 1 - p : p;
      float o[8];
#pragma unroll
      for (int j = 0; j < 8; ++j) o[j] = cbr[j];
#pragma unroll
      for (int tap = 0; tap < 4; ++tap) {
        int pp = pos + tap - 2;
        if (pp >= 0 && pp < len) {
          float x[8];
          unpack8(*(const u32x4*)(proj + (size_t)(row0 + pp) * ODC + 2304 + lch), x);
#pragma unroll
          for (int j = 0; j < 8; ++j) o[j] += cwr[tap][j] * x[j];
        }
      }
#pragma unroll
      for (int j = 0; j < 8; ++j) sXc[r * 64 + lc8 + j] = o[j];
      *(u32x4*)(sAop + r * 72 + lc8) = pack8(o);
    }
    __syncthreads();
    f32x16 acc[2];
#pragma unroll
    for (int j = 0; j < 2; ++j)
#pragma unroll
      for (int r = 0; r < 16; ++r) acc[j][r] = 0.f;
#pragma unroll
    for (int kk = 0; kk < 4; ++kk) {
      bf16x8 a = *(const bf16x8*)(sAop + (tr + (lane & 31)) * 72 + kk * 16 + 8 * (lane >> 5));
#pragma unroll
      for (int j = 0; j < 2; ++j) acc[j] = mfma32(a, bfrag[j][kk], acc[j]);
    }
#pragma unroll
    for (int j = 0; j < 2; ++j)
#pragma unroll
      for (int r = 0; r < 16; ++r) {
        int t = tr + acc_row(r, lane);
        int e = nc0 + j * 32 + (lane & 31);
        float g = sigmoidf_(acc[j][r] + ebias[j]);
        if (e < 64) { float la = -8.f * g * esp[j]; float a_ = fexp(la); sAc[t * 64 + e] = a_; sU[t * 64 + e] = fsqrt(fmaxf(1.f - a_ * a_, 0.f)); }
        else sBc[t * 64 + (e - 64)] = g * sXc[t * 64 + (e - 64)];
      }
    __syncthreads();
    if (wave == 0) {
#pragma unroll 8
      for (int t = 0; t < 64; ++t) {
        float a = sAc[t * 64 + lane];
        float bb = sU[t * 64 + lane] * sBc[t * 64 + lane];
        hstate = a * hstate + bb;
        if (FULL) sU[t * 64 + lane] = hstate; else aprod *= a;
      }
    }
    if (FULL) {
      __syncthreads();
      for (int i = tid; i < 4096; i += 256) {
        int t = i >> 6, c = i & 63;
        uout[(size_t)sRow[t] * 512 + blk * 64 + c] = f2bf(sU[i]);
      }
    }
  }
  if (!FULL && wave == 0) {
    float* S = segS + ((size_t)sid * LRU_NSEG + seg) * 128;
    S[lane] = aprod; S[64 + lane] = hstate;
  }
}

DEV void st_finish_l1(const Params& P, int row) {
  const int lane = threadIdx.x & 63;
  bf16_t* hb = (bf16_t*)(P.ws + OFF_HBUF) + (size_t)row * 1024;
  const bf16_t* proj = (const bf16_t*)(P.ws + OFF_PROJ);
  const bf16_t* lora = (const bf16_t*)(P.ws + OFF_LORA);
  const float* mu = P.in[I_MU];
  const int ch = lane * 8;
  float y0[8], y1[8];
  unpack8(*(const u32x4*)(hb + ch), y0);
  unpack8(*(const u32x4*)(hb + 512 + ch), y1);
  float sm = 0.f;
#pragma unroll
  for (int j = 0; j < 8; ++j) { y0[j] += y1[j]; sm += y0[j]; }
  sm += wshfl_xor(sm, 1); sm += wshfl_xor(sm, 2); sm += wshfl_xor(sm, 4);
  const float mean = sm * (1.f / 64.f);
  float sv = 0.f;
#pragma unroll
  for (int j = 0; j < 8; ++j) { float dlt = y0[j] - mean; sv += dlt * dlt; }
  sv += wshfl_xor(sv, 1); sv += wshfl_xor(sv, 2); sv += wshfl_xor(sv, 4);
  const float rstd = frsq(sv * (1.f / 64.f) + 64e-5f);
  float a0[8], a1[8], g[8], u0[8], u1[8], gb[8];
  unpack8(*(const u32x4*)(lora + ((size_t)2 * NTOK + row) * 512 + ch), a0);
  unpack8(*(const u32x4*)(lora + ((size_t)3 * NTOK + row) * 512 + ch), a1);
  unpack8(*(const u32x4*)(lora + ((size_t)4 * NTOK + row) * 512 + ch), g);
  unpack8(*(const u32x4*)(lora + ((size_t)0 * NTOK + row) * 512 + ch), u0);
  unpack8(*(const u32x4*)(lora + ((size_t)1 * NTOK + row) * 512 + ch), u1);
  unpack8(*(const u32x4*)(proj + (size_t)row * ODC + 1792 + ch), gb);
  float rv[8], vv[8];
  float sdot = 0.f;
#pragma unroll
  for (int j = 0; j < 8; ++j) {
    float r = mixval(proj, row, ch + j, mu);
    float k = mixval(proj, row, 512 + ch + j, mu);
    vv[j] = mixval(proj, row, 1024 + ch + j, mu);
    float am = 0.5f * (sigmoidf_(a0[j]) + sigmoidf_(a1[j]));
    float kb = k * (1.f + (am - 1.f) * P.in[I_KA][ch + j]);
    sdot += r * kb * P.in[I_RK][ch + j];
    rv[j] = r;
  }
  sdot += wshfl_xor(sdot, 1); sdot += wshfl_xor(sdot, 2); sdot += wshfl_xor(sdot, 4);
  float f1[8], f2[8];
#pragma unroll
  for (int j = 0; j < 8; ++j) {
    float yn = (y0[j] - mean) * rstd * P.in[I_LNW][ch + j] + P.in[I_LNB][ch + j];
    yn += sdot * vv[j];
    f1[j] = yn * g[j];
    f2[j] = (u0[j] + u1[j]) * geluf_(gb[j]);
  }
  *(u32x4*)(hb + ch) = pack8(f1);
  *(u32x4*)(hb + 512 + ch) = pack8(f2);
}

DEV unsigned fkey(float f) { unsigned u; __builtin_memcpy(&u, &f, 4); return (u >> 31) ? ~u : (u | 0x80000000u); }
DEV float keyf(unsigned u) { u = (u >> 31) ? (u & 0x7fffffffu) : ~u; float f; __builtin_memcpy(&f, &u, 4); return f; }
DEV void key_insert(unsigned x, unsigned* v) {
#pragma unroll
  for (int j = 0; j < 16; ++j) { unsigned hi = v[j] > x ? v[j] : x; x = v[j] > x ? x : v[j]; v[j] = hi; }
}

DEV void st_peer_topk(const Params& P, int layer, int tile, int h, unsigned char* smem) {
  const int tid = threadIdx.x;
  const bf16_t* q = (const bf16_t*)(P.ws + OFF_Q);
  const bf16_t* keys = (const bf16_t*)(P.ws + OFF_KEYS) + (size_t)(layer * 8 + h) * 2 * 128 * 128;
  float* sS = (float*)smem;
  const int m0 = tile * 128;
  unsigned kl[2][16];
#pragma unroll
  for (int p = 0; p < 2; ++p) {
    EpiScoreLds epi{sS, m0};
    gemm_tile_128<true>(q + (h * 2 + p) * 128, 2048, NTOK, keys + p * 128 * 128, 128, 128, 128, m0, 0, epi, smem);
    __syncthreads();
#pragma unroll
    for (int j = 0; j < 16; ++j) kl[p][j] = 0u;
    if (tid < 128) {
      const float* row = sS + tid * 129;
#pragma unroll 8
      for (int key = 0; key < 128; ++key) key_insert((fkey(row[key]) & ~127u) | (unsigned)(127 - key), kl[p]);
    }
    __syncthreads();
  }
  if (tid < 128) {
    float sv0[16], sv1[16];
    int* irow = (int*)(sS + tid * 129);
#pragma unroll
    for (int j = 0; j < 16; ++j) {
      sv0[j] = keyf((kl[0][j] & ~127u) | 64u); sv1[j] = keyf((kl[1][j] & ~127u) | 64u);
      irow[j] = 127 - (int)(kl[0][j] & 127u); irow[16 + j] = 127 - (int)(kl[1][j] & 127u);
    }
    unsigned best[16];
#pragma unroll
    for (int j = 0; j < 16; ++j) best[j] = 0u;
#pragma unroll
    for (int i = 0; i < 16; ++i)
#pragma unroll
      for (int j = 0; j < 16; ++j)
        if ((i + 1) * (j + 1) <= 16) key_insert((fkey(sv0[i] + sv1[j]) & ~255u) | (unsigned)(255 - (i * 16 + j)), best);
    float e[16], sum = 0.f;
    const float b0 = keyf((best[0] & ~255u) | 128u);
#pragma unroll
    for (int j = 0; j < 16; ++j) { e[j] = fexp(keyf((best[j] & ~255u) | 128u) - b0); sum += e[j]; }
    const float inv = 1.f / sum;
    int* pidx = (int*)(P.ws + OFF_PIDX) + (size_t)(m0 + tid) * 128 + h * 16;
    float* pg = (float*)(P.ws + OFF_PGATE) + (size_t)(m0 + tid) * 128 + h * 16;
#pragma unroll
    for (int j = 0; j < 16; ++j) {
      const int pos = 255 - (int)(best[j] & 255u);
      pidx[j] = irow[pos >> 4] * 128 + irow[16 + (pos & 15)];
      pg[j] = e[j] * inv;
    }
  }
}

DEV void st_peer_experts(const Params& P, int layer, int row) {
  const int lane = threadIdx.x & 63;
  const bf16_t* xb = (const bf16_t*)(P.ws + OFF_HBUF) + (size_t)row * 1024;
  const unsigned char* U = P.ws + OFF_PU;
  const unsigned char* V = P.ws + OFF_PV;
  const int* pidx = (const int*)(P.ws + OFF_PIDX) + (size_t)row * 128;
  const float* pg = (const float*)(P.ws + OFF_PGATE) + (size_t)row * 128;
  float x[16], acc[16];
  unpack8(*(const u32x4*)(xb + lane * 16), x);
  unpack8(*(const u32x4*)(xb + lane * 16 + 8), x + 8);
#pragma unroll
  for (int j = 0; j < 16; ++j) acc[j] = 0.f;
  const int b5 = (lane >> 5) & 1, b4 = (lane >> 4) & 1, b3 = (lane >> 3) & 1;
  const int mypick = (lane >> 3) & 7;
  for (int k0 = 0; k0 < 128; k0 += 8) {
    u32x4 uu[8], vv[8];
#pragma unroll
    for (int i = 0; i < 8; ++i) {
      const size_t off = (size_t)pidx[k0 + i] * 1024 + lane * 16;
      uu[i] = *(const u32x4*)(U + off);
      vv[i] = *(const u32x4*)(V + off);
    }
    const float mygate = pg[k0 + mypick];
    float dsum[8];
#pragma unroll
    for (int i = 0; i < 8; ++i) {
      float uf[16];
      unpack16_fp8(uu[i], uf);
      float dd = 0.f;
#pragma unroll
      for (int j = 0; j < 16; ++j) dd += x[j] * uf[j];
      dsum[i] = dd;
    }
    float e4[4], e2[2], g;
#pragma unroll
    for (int i = 0; i < 4; ++i) {
      float mine = b5 ? dsum[4 + i] : dsum[i], send = b5 ? dsum[i] : dsum[4 + i];
      e4[i] = mine + wshfl_xor(send, 32);
    }
#pragma unroll
    for (int i = 0; i < 2; ++i) {
      float mine = b4 ? e4[2 + i] : e4[i], send = b4 ? e4[i] : e4[2 + i];
      e2[i] = mine + wshfl_xor(send, 16);
    }
    {
      float mine = b3 ? e2[1] : e2[0], send = b3 ? e2[0] : e2[1];
      g = mine + wshfl_xor(send, 8);
    }
    g += wshfl_xor(g, 4); g += wshfl_xor(g, 2); g += wshfl_xor(g, 1);
    const float mycoef = mygate * geluf_(g * (1.f / PEER_USCALE));
#pragma unroll
    for (int i = 0; i < 8; ++i) {
      const float coef = wreadlane(mycoef, i * 8);
      float vf[16];
      unpack16_fp8(vv[i], vf);
#pragma unroll
      for (int j = 0; j < 16; ++j) acc[j] += coef * vf[j];
    }
  }
  float* xr = row < NCTX ? (float*)(P.ws + OFF_CTXRES) + (size_t)row * 1024 : P.out + (size_t)(row - NCTX) * 1024;
  const float* g2 = (const float*)(P.ws + OFF_MODV) + ((size_t)layer * 3 + mod_row(row)) * 6144 + 5 * 1024;
  float o[16];
#pragma unroll
  for (int q = 0; q < 4; ++q) {
    const int c = lane * 16 + q * 4;
    f32x4 a = *(const f32x4*)(xr + c), ga = *(const f32x4*)(g2 + c);
    o[q * 4 + 0] = a.x + ga.x * acc[q * 4 + 0] * (1.f / PEER_VSCALE); o[q * 4 + 1] = a.y + ga.y * acc[q * 4 + 1] * (1.f / PEER_VSCALE);
    o[q * 4 + 2] = a.z + ga.z * acc[q * 4 + 2] * (1.f / PEER_VSCALE); o[q * 4 + 3] = a.w + ga.w * acc[q * 4 + 3] * (1.f / PEER_VSCALE);
  }
  if (layer == 1) {
    float ss = 0.f;
#pragma unroll
    for (int j = 0; j < 16; ++j) ss += o[j] * o[j];
    ss = wave_sum(ss);
    const float rstd = frsq(ss * (1.f / 1024.f) + 1e-6f);
#pragma unroll
    for (int j = 0; j < 16; ++j) o[j] *= rstd * P.in[I_FNORM][lane * 16 + j];
  }
#pragma unroll
  for (int q = 0; q < 4; ++q) {
    f32x4 a = {o[q * 4 + 0], o[q * 4 + 1], o[q * 4 + 2], o[q * 4 + 3]};
    *(f32x4*)(xr + lane * 16 + q * 4) = a;
  }
}


#define FOR_TILES_XCD(MT0, MT1, NT, mt, nt)                                                     \
  for (int _x = blockIdx.x & 7, _mlo = (MT0) + (((MT1) - (MT0)) * _x) / 8,                        \
           _mhi = (MT0) + (((MT1) - (MT0)) * (_x + 1)) / 8, _i = blockIdx.x >> 3,                 \
           _cnt = (_mhi - _mlo) * (NT), mt = 0, nt = 0;                                           \
       _i < _cnt && ((mt = _mlo + _i / (NT)), (nt = _i % (NT)), true); _i += (int)(gridDim.x >> 3))

#ifndef PHASE_LIST
#define PHASE_LIST(X) X(0) X(1) X(2) X(22) X(23) X(3) X(4) X(5) X(6) X(7) X(8) X(9) X(10) X(11) X(12) X(13) X(30) X(14) X(15) X(16) X(17) X(18) X(19) X(20) X(21)
#endif
constexpr int PH_LAST = 21;

template <int ph>
DEV void run_phase(const Params& P, unsigned char* smem) {
  const int bid = blockIdx.x, nb = gridDim.x;
  const int wave = threadIdx.x >> 6;
  unsigned char* ws = P.ws;
  constexpr int layer = ((ph >= 10 && ph <= 21) || ph >= 30) ? 1 : 0;
  const float* modv_l = (const float*)(ws + OFF_MODV) + (size_t)layer * 3 * 6144;
  switch (ph) {
    case 0:
      for (int t = bid; t < NPREP; t += nb) st_prep(P, t, smem);
      break;
    case 1: case 10:
      for (int t = bid; t < NTOK / 4; t += nb) st_normmod(P, layer, 0, t * 4 + wave);
      break;
    case 2: {
      EpiProjL0 epi{(bf16_t*)(ws + OFF_PROJ), (float*)(ws + OFF_GATES)};
      FOR_TILES_XCD(0, NTILE, 25, mt, nt)
        gemm_tile_128<false>((const bf16_t*)(ws + OFF_HBUF), 1024, NTOK, (const bf16_t*)(ws + OFF_WEVIN), 1024, EVC, 1024,
                          mt * 128, nt * 128, epi, smem);
    } break;
    case 22:
      for (int t = bid; t < NTOK / 4; t += nb) st_xbc_conv(P, t * 4 + wave);
      for (int t = bid; t < NPCONV; t += nb) st_peer_conv(P, 0, t);
      break;
    case 23:
      for (int t = bid; t < 48 * LA_NSEG; t += nb) {
        int sid = t % 48, seg = t / 48;
        if (sid < 16) st_linattn_seg<true, false>(P, sid, seg, smem);
        else st_linattn_seg<false, false>(P, sid - 16, seg, smem);
      }
      break;
    case 3:
      for (int t = bid; t < 48 * LA_NSEG; t += nb) {
        int sid = t % 48, seg = t / 48;
        if (sid < 16) st_linattn_seg<true, true>(P, sid, seg, smem);
        else st_linattn_seg<false, true>(P, sid - 16, seg, smem);
      }
      break;
    case 4:
      for (int t = bid; t < NTOK / 4; t += nb) st_finish_l0(P, t * 4 + wave);
      break;
    case 5: case 17: {
      EpiOutProj epi{layer == 0 ? P.in[I_X] : P.out, P.in[I_CTX], P.out, (float*)(ws + OFF_CTXRES), modv_l};
      const bf16_t* Wt = (const bf16_t*)(ws + (layer == 0 ? OFF_WEVOUT : OFF_WODOUT));
      FOR_TILES_XCD(layer == 0 ? 0 : CTILE, NTILE, 8, mt, nt)
        gemm_tile_128<false>((const bf16_t*)(ws + OFF_HBUF), 1024, NTOK, Wt, 1024, 1024, 1024, mt * 128, nt * 128, epi, smem);
    } break;
    case 6: case 18: {
      const int r0 = layer == 0 ? 0 : NCTX / 4;
      for (int t = r0 + bid; t < NTOK / 4; t += nb) st_normmod(P, layer, 1, t * 4 + wave);
      if (ph == 18) for (int t = bid; t < NPCONV; t += nb) st_peer_conv(P, 1, t);
    } break;
    case 7: case 19: {
      EpiStoreBf epi{(bf16_t*)(ws + OFF_Q), 2048};
      const bf16_t* Wt = (const bf16_t*)(ws + OFF_WQ) + (size_t)layer * 2048 * 1024;
      FOR_TILES_XCD(layer == 0 ? 0 : CTILE, NTILE, 16, mt, nt)
        gemm_tile_128<false>((const bf16_t*)(ws + OFF_HBUF), 1024, NTOK, Wt, 1024, 2048, 1024, mt * 128, nt * 128, epi, smem);
    } break;
    case 8: case 20: {
      const int t0 = layer == 0 ? 0 : CTILE * 8;
      for (int t = t0 + bid; t < NTILE * 8; t += nb) st_peer_topk(P, layer, t / 8, t % 8, smem);
    } break;
    case 9: case 21: {
      const int r0 = layer == 0 ? 0 : NCTX / 4;
      for (int t = r0 + bid; t < NTOK / 4; t += nb) st_peer_experts(P, layer, t * 4 + wave);
    } break;
    case 11: {
      EpiStoreBf epi{(bf16_t*)(ws + OFF_PROJ), ODC};
      FOR_TILES_XCD(0, NTILE, 22, mt, nt)
        gemm_tile_128<false>((const bf16_t*)(ws + OFF_HBUF), 1024, NTOK, (const bf16_t*)(ws + OFF_WODIN), 1024, ODC, 1024,
                          mt * 128, nt * 128, epi, smem);
    } break;
    case 12:
      for (int t = bid; t < NTOK / 4; t += nb) st_lora_act(P, t * 4 + wave);
      break;
    case 13:
      for (int t = bid; t < NTILE * 20; t += nb) {
        int job = t / (NTILE * 4), tt = t % (NTILE * 4);
        int mt = tt / 4, nt = tt % 4;
        bf16_t* dst = (bf16_t*)(ws + OFF_LORA) + (size_t)job * NTOK * 512;
        const bf16_t* A = (const bf16_t*)(ws + OFF_HBUF) + (job < 2 ? 0 : (job < 4 ? 64 : 128));
        const bf16_t* Bt = job < 2 ? (const bf16_t*)(ws + OFF_WUP) + (size_t)job * 512 * 64
                         : job < 4 ? (const bf16_t*)(ws + OFF_AUP) + (size_t)(job - 2) * 512 * 64
                                   : (const bf16_t*)(ws + OFF_GUP);
        const float* bias = job < 2 ? P.in[I_W0] + job * 512 : (job < 4 ? P.in[I_A0] + (job - 2) * 512 : nullptr);
        const int K = job < 4 ? 64 : 128;
        EpiStoreBfBias epi{dst, 512, bias};
        gemm_tile_128<false>(A, 1024, NTOK, Bt, K, 512, K, mt * 128, nt * 128, epi, smem);
      }
      break;
    case 30:
      for (int t = bid; t < 32 * RW_NSEG + 32 * LRU_NSEG; t += nb) {
        if (t < 32 * RW_NSEG) st_rwkv_seg<false>(P, t % 32, t / 32, smem);
        else { int u = t - 32 * RW_NSEG; st_lru_seg<false>(P, u % 32, u / 32, smem); }
      }
      break;
    case 14:
      for (int t = bid; t < 32 * RW_NSEG; t += nb) st_rwkv_seg<true>(P, t % 32, t / 32, smem);
      break;
    case 15:
      for (int t = bid; t < 32 * LRU_NSEG; t += nb) st_lru_seg<true>(P, t % 32, t / 32, smem);
      break;
    case 16:
      for (int t = bid; t < NTOK / 4; t += nb) st_finish_l1(P, t * 4 + wave);
      break;
    default: break;
  }
}


#ifndef CPU_EMU
#define XB_TMO      128
#define XB_XCNT(j)  (256  + 64 * (j))
#define XB_XSUB(j)  (1280 + 64 * (j))
#define XB_XGEN(j)  (2304 + 64 * (j))
#define XB_TOP      3328
#define XB_TOPGEN   3392
#define XCD_BAR_WORDS 3456
#define XB_SPIN_CAP (1u << 20)
#define LAS __attribute__((address_space(3)))
__device__ __forceinline__ unsigned xb_ld(unsigned* p)              { return __hip_atomic_load(p, __ATOMIC_RELAXED, __HIP_MEMORY_SCOPE_AGENT); }
__device__ __forceinline__ unsigned xb_add(unsigned* p, unsigned v) { return __hip_atomic_fetch_add(p, v, __ATOMIC_RELAXED, __HIP_MEMORY_SCOPE_AGENT); }
__device__ __forceinline__ unsigned xb_xcc_id() { return (unsigned)__builtin_amdgcn_s_getreg((3 << 11) | 20) & 0xFu; }
#define XB_SPIN(cond, bar) do { unsigned _sp = 0; while (cond) { __builtin_amdgcn_s_sleep(1); \
    if ((++_sp & 255u) == 0u) { if (xb_ld(&(bar)[XB_TMO])) break; if (_sp > XB_SPIN_CAP) { atomicAdd(&(bar)[XB_TMO], 1u); break; } } } } while (0)
struct XcdBarrier { unsigned* bar; unsigned x; volatile LAS unsigned* st; };
__device__ __forceinline__ XcdBarrier xcd_barrier_post(unsigned* bar, volatile LAS unsigned* st) {
  XcdBarrier b; b.bar = bar; b.x = xb_xcc_id(); b.st = st;
  if (threadIdx.x == 0) (void)xb_add(&bar[XB_XCNT(b.x)], 1u);
  return b;
}
__device__ __forceinline__ void xcd_barrier_complete(unsigned* bar, unsigned x, unsigned& nloc, unsigned& nx) {
  const unsigned G = gridDim.x * gridDim.y * gridDim.z;
  unsigned sum, cnt, mine, sp = 0u;
  for (;;) {
    sum = 0u; cnt = 0u; mine = 0u;
#pragma unroll
    for (unsigned j = 0; j < 16; ++j) { const unsigned c = xb_ld(&bar[XB_XCNT(j)]); sum += c; cnt += (c > 0u) ? 1u : 0u; mine = (j == x) ? c : mine; }
    if (sum == G) break;
    __builtin_amdgcn_s_sleep(1);
    if ((++sp & 255u) == 0u) { if (xb_ld(&bar[XB_TMO])) break; if (sp > XB_SPIN_CAP) { atomicAdd(&bar[XB_TMO], 1u); break; } }
  }
  nloc = mine > 0u ? mine : 1u; nx = cnt > 0u ? cnt : 1u;
}
__device__ __forceinline__ void xcd_barrier(const XcdBarrier& b) {
  asm volatile("s_waitcnt vmcnt(0)" ::: "memory");
  __syncthreads();
  if (threadIdx.x == 0) {
    unsigned* bar = b.bar;
    __builtin_amdgcn_s_waitcnt(0);
    unsigned nloc = b.st[0], nx = b.st[1];
    if (nloc == 0u) { xcd_barrier_complete(bar, b.x, nloc, nx); b.st[0] = nloc; b.st[1] = nx; }
    const unsigned old = xb_add(&bar[XB_XSUB(b.x)], 1u);
    const unsigned gen = old / nloc;
    if (old + 1u == (gen + 1u) * nloc) {
      __builtin_amdgcn_fence(__ATOMIC_RELEASE, "agent");
      asm volatile("s_waitcnt vmcnt(0)" ::: "memory");
      const unsigned og = xb_add(&bar[XB_TOP], 1u);
      const unsigned tg = og / nx;
      if (og + 1u == (tg + 1u) * nx) xb_add(&bar[XB_TOPGEN], 1u);
      else XB_SPIN(xb_ld(&bar[XB_TOPGEN]) == tg, bar);
      __builtin_amdgcn_fence(__ATOMIC_ACQUIRE, "agent");
      xb_add(&bar[XB_XGEN(b.x)], 1u);
      asm volatile("s_waitcnt vmcnt(0)" ::: "memory");
    } else {
      XB_SPIN(xb_ld(&bar[XB_XGEN(b.x)]) == gen, bar);
      __builtin_amdgcn_fence(__ATOMIC_ACQUIRE, "agent");
      asm volatile("s_waitcnt vmcnt(0)" ::: "memory");
    }
  }
  __syncthreads();
}
#endif
#ifndef CPU_EMU
#define RUN_PH(n) if (n != 0) { run_phase<n>(P, smem_raw); if (n != PH_LAST) xcd_barrier(xb); }
__global__ void __launch_bounds__(256, 2) mega_kernel(Params P) {
  SMEM_DECL;
  unsigned* bar = (unsigned*)(P.ws + OFF_BAR);
  volatile LAS unsigned* st = (volatile LAS unsigned*)(smem_raw + SMEM_BYTES - 16);
  if (blockIdx.x == 0) for (int i = threadIdx.x; i < XCD_BAR_WORDS; i += 256) bar[i] = 0u;
  if (threadIdx.x == 0) { st[0] = 0u; st[1] = 0u; }
  run_phase<0>(P, smem_raw);
  cg::this_grid().sync();
  XcdBarrier xb = xcd_barrier_post(bar, st);
  PHASE_LIST(RUN_PH)
}

extern "C" void kernel_launch(void* const* d_in, const int* in_sizes, int n_in, void* d_out, int out_size, void* d_ws,
                              size_t ws_size, hipStream_t stream) {
  Params P{};
  for (int i = 0; i < N_IN; ++i) P.in[i] = (const float*)d_in[i];
  P.out = (float*)d_out;
  P.ws = (unsigned char*)d_ws;
  if (ws_size < WS_NEEDED) { fprintf(stderr, "workspace too small: %zu < %zu\n", ws_size, (size_t)WS_NEEDED); return; }
  static int grid_blocks = 0;
  if (!grid_blocks) {
    int dev = 0, cus = 0, per_cu = 0;
    hipGetDevice(&dev);
    hipDeviceGetAttribute(&cus, hipDeviceAttributeMultiprocessorCount, dev);
    hipOccupancyMaxActiveBlocksPerMultiprocessor(&per_cu, mega_kernel, 256, 0);
    if (per_cu > 2) per_cu = 2;
    grid_blocks = cus * per_cu;
  }
  void* args[] = {&P};
  hipError_t e = hipLaunchCooperativeKernel((void*)mega_kernel, dim3(grid_blocks), dim3(256), args, 0, stream);
  if (e != hipSuccess) fprintf(stderr, "cooperative launch failed: %s (grid %d)\n", hipGetErrorString(e), grid_blocks);
}
#endif
```

```cpp
#ifdef CPU_EMU
#include "emu.h"
#else
#include <hip/hip_runtime.h>
#include <hip/hip_cooperative_groups.h>
#include <cstdio>
namespace cg = cooperative_groups;
#define DEV __device__ __forceinline__
#define DEVM __device__ __forceinline__
#define OPAQUE(x) asm volatile("" : "+v"(x))
#endif

#ifndef SEQ_LEN
#define SEQ_LEN 16384
#endif
#ifndef CTX_LEN
#define CTX_LEN 256
#endif
#ifndef GRID_W_
#define GRID_W_ 64
#endif
#ifndef MULTI_LAUNCH
#define MULTI_LAUNCH 0
#endif

typedef unsigned short bf16_t;
typedef __attribute__((ext_vector_type(8))) short bf16x8;
typedef __attribute__((ext_vector_type(16))) float f32x16;
typedef __attribute__((ext_vector_type(4))) unsigned u32x4;
typedef __attribute__((ext_vector_type(2))) unsigned u32x2;
typedef __attribute__((ext_vector_type(4))) float f32x4;

constexpr int D = 1024, NB = 2, SEQ = SEQ_LEN, CTXL = CTX_LEN, GW = GRID_W_;
constexpr int NCTX = NB * CTXL, NLAT = NB * SEQ, NTOK = NCTX + NLAT;
constexpr int EVC = 3104, ODC = 2816;
constexpr int NEXP = 16384;
constexpr int NTILE = NTOK / 128, CTILE = NCTX / 128;
static_assert(NTOK % 128 == 0 && NCTX % 128 == 0, "tiles");
static_assert(CTXL % 64 == 0 && SEQ % 64 == 0 && SEQ % GW == 0, "chunks");

constexpr size_t al256(size_t x) { return (x + 255) & ~(size_t)255; }
constexpr size_t OFF_MODV = 0;
constexpr size_t OFF_CTXRES = OFF_MODV + al256(2 * 3 * 6144 * 4);
constexpr size_t OFF_GATES = OFF_CTXRES + al256((size_t)NCTX * 1024 * 4);
constexpr size_t OFF_WEVIN = OFF_GATES + al256((size_t)NTOK * 32 * 4);
constexpr size_t OFF_WEVOUT = OFF_WEVIN + al256((size_t)EVC * 1024 * 2);
constexpr size_t OFF_WODIN = OFF_WEVOUT + al256((size_t)1024 * 1024 * 2);
constexpr size_t OFF_WODOUT = OFF_WODIN + al256((size_t)ODC * 1024 * 2);
constexpr size_t OFF_WQ = OFF_WODOUT + al256((size_t)1024 * 1024 * 2);
constexpr size_t OFF_KEYS = OFF_WQ + al256((size_t)2 * 2048 * 1024 * 2);
constexpr size_t OFF_WUP = OFF_KEYS + al256((size_t)2 * 8 * 2 * 128 * 128 * 2);
constexpr size_t OFF_AUP = OFF_WUP + al256((size_t)2 * 512 * 64 * 2);
constexpr size_t OFF_GUP = OFF_AUP + al256((size_t)2 * 512 * 64 * 2);
constexpr size_t OFF_LRUT = OFF_GUP + al256((size_t)512 * 128 * 2);
constexpr size_t OFF_PU = OFF_LRUT + al256((size_t)2 * 8 * 128 * 64 * 2);
constexpr size_t OFF_PV = OFF_PU + al256((size_t)NEXP * 1024);
constexpr size_t OFF_HBUF = OFF_PV + al256((size_t)NEXP * 1024);
constexpr size_t OFF_PR = OFF_HBUF + al256((size_t)NTOK * 1024 * 2);
constexpr size_t PR_BYTES = (size_t)NTOK * 5376 * 2;
constexpr size_t OFF_BAR = OFF_PR + PR_BYTES;
constexpr size_t OFF_ACUM1 = OFF_BAR + 16384;
constexpr size_t OFF_LRUCS = OFF_ACUM1 + (size_t)NLAT * 512 * 2;
constexpr size_t OFF_LRUHS = OFF_LRUCS + (size_t)32 * ((CTXL + SEQ) / 64) * 128 * 4;
constexpr size_t WS_NEEDED = OFF_LRUHS + (size_t)32 * ((CTXL + SEQ) / 64) * 64 * 4;
#ifndef CPU_EMU
static_assert(WS_NEEDED <= (size_t)512 * 1024 * 1024, "workspace too large");
#endif
constexpr size_t OFF_PROJ = OFF_PR;
constexpr size_t OFF_R2L0 = OFF_PR + (size_t)NTOK * EVC * 2;
constexpr size_t OFF_LORA = OFF_PR + (size_t)NTOK * ODC * 2;
constexpr size_t OFF_Q = OFF_PR;
constexpr size_t OFF_PIDX = OFF_PR + (size_t)NTOK * 2048 * 2;
constexpr size_t OFF_PGATE = OFF_PIDX + (size_t)NTOK * 128 * 4;
static_assert(OFF_PGATE + (size_t)NTOK * 128 * 4 <= OFF_PR + PR_BYTES, "picks");

enum {
  I_X = 0, I_C, I_CTX, I_CCTX, I_MODW, I_MODB, I_NORM1, I_NORM2, I_WQ, I_KEYS, I_PU, I_PV,
  I_EVWIN, I_EVWOUT, I_IBIAS, I_FBIAS, I_MNORM, I_SCONVW, I_SCONVB, I_DTBIAS, I_ALOG, I_DSKIP, I_SNORM,
  I_ODWIN, I_ODWOUT, I_MU, I_W0, I_WUP, I_A0, I_AUP, I_GUP, I_KK, I_KA, I_RK, I_LNW, I_LNB,
  I_LCONVW, I_LCONVB, I_LAM, I_WA, I_BA, I_WI, I_BI, I_FNORM, N_IN
};

struct Params {
  const float* in[N_IN];
  float* out;
  unsigned char* ws;
};

constexpr int SMEM_BYTES = 80 * 1024;
#ifdef CPU_EMU
#define SMEM_DECL static thread_local __attribute__((aligned(16))) unsigned char smem_raw[SMEM_BYTES]
#else
#define SMEM_DECL __shared__ __attribute__((aligned(16))) unsigned char smem_raw[SMEM_BYTES]
#endif

DEV float bf2f(bf16_t v) { unsigned u = ((unsigned)v) << 16; float f; __builtin_memcpy(&f, &u, 4); return f; }
DEV bf16_t f2bf(float f) { unsigned u; __builtin_memcpy(&u, &f, 4); u += 0x7fffu + ((u >> 16) & 1u); return (bf16_t)(u >> 16); }
DEV unsigned pack2(float a, float b) { return (unsigned)f2bf(a) | ((unsigned)f2bf(b) << 16); }
DEV void unpack8(const u32x4& r, float* o) {
  unsigned w[4] = {r.x, r.y, r.z, r.w};
#pragma unroll
  for (int i = 0; i < 4; ++i) { unsigned lo = w[i] << 16, hi = w[i] & 0xffff0000u; __builtin_memcpy(&o[2 * i], &lo, 4); __builtin_memcpy(&o[2 * i + 1], &hi, 4); }
}
DEV u32x4 pack8(const float* o) { u32x4 r; r.x = pack2(o[0], o[1]); r.y = pack2(o[2], o[3]); r.z = pack2(o[4], o[5]); r.w = pack2(o[6], o[7]); return r; }
#ifdef CPU_EMU
DEV float fexp(float x) { return expf(x); }
DEV float frcp(float x) { return 1.f / x; }
DEV float flog(float x) { return logf(x); }
DEV float frsq(float x) { return 1.f / sqrtf(x); }
DEV float fsqrt(float x) { return sqrtf(x); }
#else
DEV float fexp(float x) { return __expf(x); }
DEV float frcp(float x) { return __builtin_amdgcn_rcpf(x); }
DEV float flog(float x) { return __logf(x); }
DEV float frsq(float x) { return __builtin_amdgcn_rsqf(x); }
DEV float fsqrt(float x) { return __builtin_amdgcn_sqrtf(x); }
#endif
DEV float sigmoidf_(float x) { return frcp(1.f + fexp(-x)); }
DEV float siluf_(float x) { return x * frcp(1.f + fexp(-x)); }
DEV float softplusf_(float x) { return fmaxf(x, 0.f) + flog(1.f + fexp(-fabsf(x))); }
DEV float tanhf_(float x) { return 1.f - 2.f * frcp(1.f + fexp(2.f * x)); }
DEV float geluf_(float x) { return 0.5f * x * (1.f + erff(x * 0.70710678118654752f)); }

DEV f32x16 mfma32(bf16x8 a, bf16x8 b, f32x16 c) {
#ifdef CPU_EMU
  return emu_mfma32(a, b, c);
#else
  return __builtin_amdgcn_mfma_f32_32x32x16_bf16(a, b, c, 0, 0, 0);
#endif
}
DEV float wshfl_xor(float v, int m) {
#ifdef CPU_EMU
  return emu_shfl_xor(v, m);
#else
  return __shfl_xor(v, m, 64);
#endif
}
DEV float wave_sum(float v) {
#pragma unroll
  for (int m = 32; m >= 1; m >>= 1) v += wshfl_xor(v, m);
  return v;
}

#ifdef CPU_EMU
static inline unsigned emu_f2fp8(float f) {
  unsigned sgn = f < 0.f ? 0x80u : 0u; float a = fabsf(f);
  if (!(a == a)) return 0x7f;
  if (a >= 448.f) return sgn | 0x7e;
  if (a < 0.0009765625f) return sgn;
  int e; frexpf(a, &e); e -= 1;
  if (e < -6) { int q = (int)nearbyintf(a * 512.f); return sgn | (unsigned)q; }
  float m = a / ldexpf(1.f, e);
  int q = (int)nearbyintf((m - 1.f) * 8.f);
  if (q == 8) { q = 0; e += 1; }
  if (e > 8) return sgn | 0x7e;
  return sgn | (unsigned)((e + 7) << 3) | (unsigned)q;
}
static inline float emu_fp82f(unsigned c) {
  unsigned sgn = c & 0x80, e = (c >> 3) & 15, m = c & 7;
  float v = e == 0 ? ldexpf((float)m, -9) : ldexpf(1.f + m / 8.f, (int)e - 7);
  return sgn ? -v : v;
}
#endif
DEV unsigned pack4_fp8(float a, float b, float c, float d) {
#ifdef CPU_EMU
  return emu_f2fp8(a) | (emu_f2fp8(b) << 8) | (emu_f2fp8(c) << 16) | (emu_f2fp8(d) << 24);
#else
  int w = 0;
  w = __builtin_amdgcn_cvt_pk_fp8_f32(a, b, w, false);
  w = __builtin_amdgcn_cvt_pk_fp8_f32(c, d, w, true);
  return (unsigned)w;
#endif
}
DEV void unpack4_fp8(unsigned w, float* o) {
#ifdef CPU_EMU
  o[0] = emu_fp82f(w & 255); o[1] = emu_fp82f((w >> 8) & 255); o[2] = emu_fp82f((w >> 16) & 255); o[3] = emu_fp82f(w >> 24);
#else
  typedef __attribute__((ext_vector_type(2))) float f32x2_;
  f32x2_ lo = __builtin_amdgcn_cvt_pk_f32_fp8((int)w, false);
  f32x2_ hi = __builtin_amdgcn_cvt_pk_f32_fp8((int)w, true);
  o[0] = lo.x; o[1] = lo.y; o[2] = hi.x; o[3] = hi.y;
#endif
}
DEV void unpack16_fp8(const u32x4& r, float* o) { unpack4_fp8(r.x, o); unpack4_fp8(r.y, o + 4); unpack4_fp8(r.z, o + 8); unpack4_fp8(r.w, o + 12); }
DEV float wreadlane(float v, int srclane) {
#ifdef CPU_EMU
  return emu_readlane(v, srclane);
#else
  int iv; __builtin_memcpy(&iv, &v, 4);
  int r = __builtin_amdgcn_readlane(iv, srclane);
  float f; __builtin_memcpy(&f, &r, 4); return f;
#endif
}
constexpr float PEER_USCALE = 64.f, PEER_VSCALE = 4.f;

DEV int acc_row(int reg, int lane) { return (reg & 3) + 8 * (reg >> 2) + 4 * (lane >> 5); }

DEV int mod_row(int row) { return row < NCTX ? 2 : (row - NCTX) / SEQ; }

template <bool SYNC_EPI, class Epi>
DEV void gemm_tile_128(const bf16_t* __restrict__ A, int lda, int M, const bf16_t* __restrict__ Bt, int ldb, int N,
                       int K, int m0, int n0, const Epi& epi, unsigned char* smem) {
  constexpr int LS = 72;
  constexpr int STAGE = 2 * 128 * LS;
  bf16_t* sbase = (bf16_t*)smem;
  const int wave = threadIdx.x >> 6;
  const int wm = (wave >> 1) * 64, wn = (wave & 1) * 64;
  f32x16 acc[2][2];
#pragma unroll
  for (int i = 0; i < 2; ++i)
#pragma unroll
    for (int j = 0; j < 2; ++j)
#pragma unroll
      for (int r = 0; r < 16; ++r) acc[i][j][r] = 0.f;
  u32x4 ra[4], rb[4];
  auto gload = [&](int k0) {
    int tl_ = threadIdx.x; OPAQUE(tl_);
#pragma unroll
    for (int i = 0; i < 4; ++i) {
      int c = tl_ + i * 256, r = c >> 3, cc = (c & 7) * 8;
      int gr = m0 + r, gn = n0 + r;
      gr = gr < M ? gr : M - 1; gn = gn < N ? gn : N - 1;
      ra[i] = *(const u32x4*)(A + (size_t)gr * lda + k0 + cc);
      rb[i] = *(const u32x4*)(Bt + (size_t)gn * ldb + k0 + cc);
    }
  };
  auto lwrite = [&](int buf) {
    int tl_ = threadIdx.x; OPAQUE(tl_);
    bf16_t* sA = sbase + buf * STAGE;
    bf16_t* sB = sA + 128 * LS;
#pragma unroll
    for (int i = 0; i < 4; ++i) {
      int c = tl_ + i * 256, r = c >> 3, cc = (c & 7) * 8;
      *(u32x4*)(sA + r * LS + cc) = ra[i];
      *(u32x4*)(sB + r * LS + cc) = rb[i];
    }
  };
  const int nk = K >> 6;
  gload(0);
  __syncthreads();
  lwrite(0);
  if (nk > 1) gload(64);
  __syncthreads();
  for (int it = 0; it < nk; ++it) {
    int tl_ = threadIdx.x; OPAQUE(tl_);
    const int lane = tl_ & 63;
    const bf16_t* sA = sbase + (it & 1) * STAGE;
    const bf16_t* sB = sA + 128 * LS;
#pragma unroll
    for (int kk = 0; kk < 4; ++kk) {
      bf16x8 a[2], b[2];
      const int ko = kk * 16 + 8 * (lane >> 5);
#pragma unroll
      for (int i = 0; i < 2; ++i) a[i] = *(const bf16x8*)(sA + (wm + i * 32 + (lane & 31)) * LS + ko);
#pragma unroll
      for (int j = 0; j < 2; ++j) b[j] = *(const bf16x8*)(sB + (wn + j * 32 + (lane & 31)) * LS + ko);
#pragma unroll
      for (int i = 0; i < 2; ++i)
#pragma unroll
        for (int j = 0; j < 2; ++j) acc[i][j] = mfma32(a[i], b[j], acc[i][j]);
      if (kk == 1) {
        if (it + 1 < nk) lwrite((it + 1) & 1);
        if (it + 2 < nk) gload((it + 2) * 64);
      }
    }
    __syncthreads();
  }
  {
    int tl_ = threadIdx.x; OPAQUE(tl_);
    const int lane = tl_ & 63;
#pragma unroll
    for (int i = 0; i < 2; ++i)
#pragma unroll
      for (int j = 0; j < 2; ++j)
#pragma unroll
        for (int r = 0; r < 16; ++r) {
          int row = m0 + wm + i * 32 + acc_row(r, lane);
          int col = n0 + wn + j * 32 + (lane & 31);
          if (row < M && col < N) epi(row, col, acc[i][j][r]);
        }
  }
}

template <class Epi>
DEV void gemm_tile_128x256(const bf16_t* __restrict__ A, int lda, int M, const bf16_t* __restrict__ Bt, int ldb, int N,
                           int K, int m0, int n0, const Epi& epi, unsigned char* smem) {
  constexpr int LS = 72;
  bf16_t* sA = (bf16_t*)smem;
  bf16_t* sB = sA + 128 * LS;
  const int wave = threadIdx.x >> 6;
  const int wm = (wave >> 1) * 64, wn = (wave & 1) * 128;
  f32x16 acc[2][4];
#pragma unroll
  for (int i = 0; i < 2; ++i)
#pragma unroll
    for (int j = 0; j < 4; ++j)
#pragma unroll
      for (int r = 0; r < 16; ++r) acc[i][j][r] = 0.f;
  u32x4 ra[4], rb[8];
  {
    const int tid = threadIdx.x;
#pragma unroll
    for (int i = 0; i < 4; ++i) {
      int c = tid + i * 256, r = c >> 3, cc = (c & 7) * 8;
      { int gr = m0 + r; gr = gr < M ? gr : M - 1; ra[i] = *(const u32x4*)(A + (size_t)gr * lda + cc); }
    }
#pragma unroll
    for (int i = 0; i < 8; ++i) {
      int c = tid + i * 256, r = c >> 3, cc = (c & 7) * 8;
      { int gn = n0 + r; gn = gn < N ? gn : N - 1; rb[i] = *(const u32x4*)(Bt + (size_t)gn * ldb + cc); }
    }
  }
  for (int k0 = 0; k0 < K; k0 += 64) {
    int tl_ = threadIdx.x; OPAQUE(tl_);
    const int tid = tl_, lane = tl_ & 63;
    __syncthreads();
#pragma unroll
    for (int i = 0; i < 4; ++i) { int c = tid + i * 256, r = c >> 3, cc = (c & 7) * 8; *(u32x4*)(sA + r * LS + cc) = ra[i]; }
#pragma unroll
    for (int i = 0; i < 8; ++i) { int c = tid + i * 256, r = c >> 3, cc = (c & 7) * 8; *(u32x4*)(sB + r * LS + cc) = rb[i]; }
    __syncthreads();
    if (k0 + 64 < K) {
#pragma unroll
      for (int i = 0; i < 4; ++i) {
        int c = tid + i * 256, r = c >> 3, cc = (c & 7) * 8;
        { int gr = m0 + r; gr = gr < M ? gr : M - 1; ra[i] = *(const u32x4*)(A + (size_t)gr * lda + k0 + 64 + cc); }
      }
#pragma unroll
      for (int i = 0; i < 8; ++i) {
        int c = tid + i * 256, r = c >> 3, cc = (c & 7) * 8;
        { int gn = n0 + r; gn = gn < N ? gn : N - 1; rb[i] = *(const u32x4*)(Bt + (size_t)gn * ldb + k0 + 64 + cc); }
      }
    }
#pragma unroll 2
    for (int kk = 0; kk < 4; ++kk) {
      bf16x8 a[2], b[4];
      const int ko = kk * 16 + 8 * (lane >> 5);
#pragma unroll
      for (int i = 0; i < 2; ++i) a[i] = *(const bf16x8*)(sA + (wm + i * 32 + (lane & 31)) * LS + ko);
#pragma unroll
      for (int j = 0; j < 4; ++j) b[j] = *(const bf16x8*)(sB + (wn + j * 32 + (lane & 31)) * LS + ko);
#pragma unroll
      for (int i = 0; i < 2; ++i)
#pragma unroll
        for (int j = 0; j < 4; ++j) acc[i][j] = mfma32(a[i], b[j], acc[i][j]);
    }
  }
  {
    int tl_ = threadIdx.x; OPAQUE(tl_);
    const int lane = tl_ & 63;
#pragma unroll
    for (int i = 0; i < 2; ++i)
#pragma unroll
      for (int j = 0; j < 4; ++j)
#pragma unroll
        for (int r = 0; r < 16; ++r) {
          int row = m0 + wm + i * 32 + acc_row(r, lane);
          int col = n0 + wn + j * 32 + (lane & 31);
          if (row < M && col < N) epi(row, col, acc[i][j][r]);
        }
  }
}

DEV void transpose_tile(const float* __restrict__ src, int ld_src, bf16_t* __restrict__ dst, int ld_dst, int K, int N,
                        int tk, int tn, unsigned char* smem) {
  float* sT = (float*)smem;
  const int tid = threadIdx.x;
  __syncthreads();
  {
    const int tx = tid & 15, ty = tid >> 4;
#pragma unroll
    for (int p = 0; p < 4; ++p) {
      int k = tk * 64 + ty + p * 16, n = tn * 64 + tx * 4;
#pragma unroll
      for (int j = 0; j < 4; ++j) {
        float v = (k < K && n + j < N) ? src[(size_t)k * ld_src + n + j] : 0.f;
        sT[(ty + p * 16) * 65 + tx * 4 + j] = v;
      }
    }
  }
  __syncthreads();
  {
    const int n = tid >> 2, kseg = (tid & 3) * 16;
    int gn = tn * 64 + n;
    if (gn < N) {
      float v[16];
#pragma unroll
      for (int j = 0; j < 16; ++j) v[j] = sT[(kseg + j) * 65 + n];
      bf16_t* d = dst + (size_t)gn * ld_dst + tk * 64 + kseg;
      *(u32x4*)d = pack8(v);
      *(u32x4*)(d + 8) = pack8(v + 8);
    }
  }
}

constexpr int TJ0 = 16 * 49, TJ1 = 16 * 16, TJ2 = 16 * 44, TJ3 = 16 * 16, TJ4 = 2 * 16 * 32, TJ5 = 2 * 8, TJ6 = 2 * 8,
              TJ7 = 2 * 8, TJ8 = 32;
constexpr int NTRANS = TJ0 + TJ1 + TJ2 + TJ3 + TJ4 + TJ5 + TJ6 + TJ7 + TJ8;
constexpr int NKEYCV = (2 * 8 * 2 * 128 * 128) / (256 * 8);
constexpr int NMODV = 2 * 96;
constexpr int NPREP = NTRANS + NKEYCV + NMODV;

DEV void st_prep(const Params& P, int item, unsigned char* smem) {
  unsigned char* ws = P.ws;
  if (item < NTRANS) {
    int t = item;
    if (t < TJ0) { transpose_tile(P.in[I_EVWIN], EVC, (bf16_t*)(ws + OFF_WEVIN), 1024, 1024, EVC, t / 49, t % 49, smem); return; }
    t -= TJ0;
    if (t < TJ1) { transpose_tile(P.in[I_EVWOUT], 1024, (bf16_t*)(ws + OFF_WEVOUT), 1024, 1024, 1024, t / 16, t % 16, smem); return; }
    t -= TJ1;
    if (t < TJ2) { transpose_tile(P.in[I_ODWIN], ODC, (bf16_t*)(ws + OFF_WODIN), 1024, 1024, ODC, t / 44, t % 44, smem); return; }
    t -= TJ2;
    if (t < TJ3) { transpose_tile(P.in[I_ODWOUT], 1024, (bf16_t*)(ws + OFF_WODOUT), 1024, 1024, 1024, t / 16, t % 16, smem); return; }
    t -= TJ3;
    if (t < TJ4) {
      int l = t / 512, tt = t % 512;
      transpose_tile(P.in[I_WQ] + (size_t)l * 1024 * 2048, 2048, (bf16_t*)(ws + OFF_WQ) + (size_t)l * 2048 * 1024, 1024, 1024, 2048, tt / 32, tt % 32, smem);
      return;
    }
    t -= TJ4;
    if (t < TJ5) { int d = t / 8; transpose_tile(P.in[I_WUP] + d * 64 * 512, 512, (bf16_t*)(ws + OFF_WUP) + d * 512 * 64, 64, 64, 512, 0, t % 8, smem); return; }
    t -= TJ5;
    if (t < TJ6) { int d = t / 8; transpose_tile(P.in[I_AUP] + d * 64 * 512, 512, (bf16_t*)(ws + OFF_AUP) + d * 512 * 64, 64, 64, 512, 0, t % 8, smem); return; }
    t -= TJ6;
    if (t < TJ7) { transpose_tile(P.in[I_GUP], 512, (bf16_t*)(ws + OFF_GUP), 128, 128, 512, t / 8, t % 8, smem); return; }
    t -= TJ7;
    {
      int which = t & 1, db = t >> 1;
      const float* src = (which ? P.in[I_WI] : P.in[I_WA]) + (size_t)db * 64 * 64;
      transpose_tile(src, 64, (bf16_t*)(ws + OFF_LRUT) + (size_t)db * 128 * 64 + which * 64 * 64, 64, 64, 64, 0, 0, smem);
      return;
    }
  }
  item -= NTRANS;
  if (item < NKEYCV) {
    size_t e = ((size_t)item * 256 + threadIdx.x) * 8;
    const float* s = P.in[I_KEYS] + e;
    f32x4 a = *(const f32x4*)s, b = *(const f32x4*)(s + 4);
    float v[8] = {a.x, a.y, a.z, a.w, b.x, b.y, b.z, b.w};
    *(u32x4*)((bf16_t*)(ws + OFF_KEYS) + e) = pack8(v);
    return;
  }
  item -= NKEYCV;
  {
    const int l = item / 96, cgp = item % 96;
    float* sS = (float*)smem;
    float* sRed = sS + 3 * 1024;
    const int tid = threadIdx.x;
    __syncthreads();
    for (int i = tid; i < 3 * 1024; i += 256) {
      int m = i >> 10, k = i & 1023;
      float c = m < 2 ? P.in[I_C][m * 1024 + k] : P.in[I_CCTX][k];
      sS[i] = siluf_(c);
    }
    __syncthreads();
    const int ks = tid >> 6, col = cgp * 64 + (tid & 63);
    const float* w = P.in[I_MODW] + (size_t)l * 1024 * 6144 + col;
    float a0 = 0.f, a1 = 0.f, a2 = 0.f;
    for (int k = ks * 256; k < ks * 256 + 256; ++k) {
      float wv = w[(size_t)k * 6144];
      a0 += sS[k] * wv; a1 += sS[1024 + k] * wv; a2 += sS[2048 + k] * wv;
    }
    sRed[(ks * 3 + 0) * 64 + (tid & 63)] = a0;
    sRed[(ks * 3 + 1) * 64 + (tid & 63)] = a1;
    sRed[(ks * 3 + 2) * 64 + (tid & 63)] = a2;
    __syncthreads();
    if (tid < 192) {
      int m = tid >> 6, c = tid & 63;
      float s = sRed[(0 * 3 + m) * 64 + c] + sRed[(1 * 3 + m) * 64 + c] + sRed[(2 * 3 + m) * 64 + c] + sRed[(3 * 3 + m) * 64 + c];
      int cc = cgp * 64 + c;
      ((float*)(ws + OFF_MODV))[((size_t)l * 3 + m) * 6144 + cc] = s + P.in[I_MODB][l * 6144 + cc];
    }
  }
}

constexpr int NPCONV = 2 * (NEXP * 1024 / (256 * 16));
DEV void st_peer_conv(const Params& P, int layer, int item) {
  const int half = NPCONV / 2;
  int which = item >= half;
  int it = which ? item - half : item;
  size_t e = ((size_t)it * 256 + threadIdx.x) * 16;
  const float* s = (which ? P.in[I_PV] : P.in[I_PU]) + (size_t)layer * NEXP * 1024 + e;
  const float sc = which ? PEER_VSCALE : PEER_USCALE;
  u32x4 o;
  f32x4 a = *(const f32x4*)s; o.x = pack4_fp8(a.x * sc, a.y * sc, a.z * sc, a.w * sc);
  a = *(const f32x4*)(s + 4); o.y = pack4_fp8(a.x * sc, a.y * sc, a.z * sc, a.w * sc);
  a = *(const f32x4*)(s + 8); o.z = pack4_fp8(a.x * sc, a.y * sc, a.z * sc, a.w * sc);
  a = *(const f32x4*)(s + 12); o.w = pack4_fp8(a.x * sc, a.y * sc, a.z * sc, a.w * sc);
  const size_t ex = e >> 10, col = e & 1023;
  *(u32x4*)(P.ws + OFF_PU + ex * 2048 + (which ? 1024 : 0) + col) = o;
}

DEV void st_normmod(const Params& P, int layer, int which, int row) {
  const int lane = threadIdx.x & 63;
  const float* src;
  if (which == 0 && layer == 0) src = row < NCTX ? P.in[I_CTX] + (size_t)row * 1024 : P.in[I_X] + (size_t)(row - NCTX) * 1024;
  else src = row < NCTX ? (const float*)(P.ws + OFF_CTXRES) + (size_t)row * 1024 : P.out + (size_t)(row - NCTX) * 1024;
  const float* mv = (const float*)(P.ws + OFF_MODV) + ((size_t)layer * 3 + mod_row(row)) * 6144;
  const float* sh = mv + (which ? 3 : 0) * 1024;
  const float* sc = mv + (which ? 4 : 1) * 1024;
  const float* nw = (which ? P.in[I_NORM2] : P.in[I_NORM1]) + layer * 1024;
  f32x4 v[4];
  float ss = 0.f;
#pragma unroll
  for (int i = 0; i < 4; ++i) {
    v[i] = *(const f32x4*)(src + i * 256 + lane * 4);
    ss += v[i].x * v[i].x + v[i].y * v[i].y + v[i].z * v[i].z + v[i].w * v[i].w;
  }
  ss = wave_sum(ss);
  const float rstd = frsq(ss * (1.f / 1024.f) + 1e-6f);
  bf16_t* dst = (bf16_t*)(P.ws + OFF_HBUF) + (size_t)row * 1024;
#pragma unroll
  for (int i = 0; i < 4; ++i) {
    int c = i * 256 + lane * 4;
    f32x4 w4 = *(const f32x4*)(nw + c), s4 = *(const f32x4*)(sc + c), h4 = *(const f32x4*)(sh + c);
    float o0 = v[i].x * rstd * w4.x * (1.f + s4.x) + h4.x;
    float o1 = v[i].y * rstd * w4.y * (1.f + s4.y) + h4.y;
    float o2 = v[i].z * rstd * w4.z * (1.f + s4.z) + h4.z;
    float o3 = v[i].w * rstd * w4.w * (1.f + s4.w) + h4.w;
    u32x2 pk; pk.x = pack2(o0, o1); pk.y = pack2(o2, o3);
    *(u32x2*)(dst + c) = pk;
  }
}

struct EpiProjL0 {
  bf16_t* proj; float* gates;
  DEVM void operator()(int row, int col, float v) const {
    proj[(size_t)row * EVC + col] = f2bf(v);
    if (col >= 1536 && col < 1552) gates[row * 32 + (col - 1536)] = v;
    else if (col >= 3088) gates[row * 32 + 16 + (col - 3088)] = v;
  }
};
struct EpiStoreBf {
  bf16_t* dst; int ld;
  DEVM void operator()(int row, int col, float v) const { dst[(size_t)row * ld + col] = f2bf(v); }
};
struct EpiStoreBfBias {
  bf16_t* dst; int ld; const float* bias;
  DEVM void operator()(int row, int col, float v) const { dst[(size_t)row * ld + col] = f2bf(v + (bias ? bias[col] : 0.f)); }
};
struct EpiOutProj {
  const float* x_lat; const float* x_ctx; float* o_lat; float* o_ctx; const float* modv;
  DEVM void operator()(int row, int col, float v) const {
    float g = modv[mod_row(row) * 6144 + 2 * 1024 + col];
    if (row < NCTX) o_ctx[(size_t)row * 1024 + col] = x_ctx[(size_t)row * 1024 + col] + g * v;
    else { size_t o = (size_t)(row - NCTX) * 1024 + col; o_lat[o] = x_lat[o] + g * v; }
  }
};
struct EpiScoreLds {
  float* sS; int m0;
  DEVM void operator()(int row, int col, float v) const { sS[(row - m0) * 129 + col] = v; }
};

DEV void st_xbc_conv(const Params& P, int row) {
  const int lane = threadIdx.x & 63;
  const bf16_t* proj = (const bf16_t*)(P.ws + OFF_PROJ);
  bf16_t* xc = (bf16_t*)P.out + (size_t)row * 1024;
  int row0, len, pos;
  if (row < NCTX) { row0 = (row / CTXL) * CTXL; len = CTXL; pos = row - row0; }
  else { int r = row - NCTX; row0 = NCTX + (r / SEQ) * SEQ; len = SEQ; pos = r % SEQ; }
  const float* cw = P.in[I_SCONVW];
  const float* cb = P.in[I_SCONVB];
#pragma unroll
  for (int hh = 0; hh < 2; ++hh) {
    const int ch = hh * 512 + lane * 8;
    float o[8];
#pragma unroll
    for (int j = 0; j < 8; ++j) o[j] = cb[ch + j];
#pragma unroll
    for (int tap = 0; tap < 4; ++tap) {
      int pp = pos + tap - 2;
      if (pp >= 0 && pp < len) {
        float x[8];
        unpack8(*(const u32x4*)(proj + (size_t)(row0 + pp) * EVC + 2064 + ch), x);
        f32x4 w0 = *(const f32x4*)(cw + tap * 1024 + ch), w1 = *(const f32x4*)(cw + tap * 1024 + ch + 4);
        o[0] += w0.x * x[0]; o[1] += w0.y * x[1]; o[2] += w0.z * x[2]; o[3] += w0.w * x[3];
        o[4] += w1.x * x[4]; o[5] += w1.y * x[5]; o[6] += w1.z * x[6]; o[7] += w1.w * x[7];
      }
    }
#pragma unroll
    for (int j = 0; j < 8; ++j) o[j] = siluf_(o[j]);
    *(u32x4*)(xc + ch) = pack8(o);
  }
}

#ifndef LA_NSEG
#define LA_NSEG 10
#endif
constexpr int LA_NCH = (CTXL + SEQ) / 64;
constexpr int LA_CPS = LA_NCH / LA_NSEG;
static_assert(LA_NCH % LA_NSEG == 0, "linattn segments");
#ifdef CPU_EMU
constexpr size_t OFF_LASEG = OFF_PR + PR_BYTES;
#else
constexpr size_t OFF_LASEG = OFF_R2L0 + (size_t)NTOK * 1024 * 2;
#endif
constexpr size_t LASEG_U = (size_t)48 * LA_NSEG * 8192 * 4;
constexpr size_t OFF_LASEG_N = OFF_LASEG + LASEG_U;
constexpr size_t OFF_LASEG_D = OFF_LASEG_N + (size_t)48 * LA_NSEG * 64 * 4;
#ifndef CPU_EMU
static_assert(OFF_LASEG_D + 48 * LA_NSEG * 4 <= OFF_PR + PR_BYTES, "laseg");
#endif

struct LaRaw { u32x4 q[2], k[4], x[4]; float g0, g1; };

template <bool MLSTM, bool FULL>
DEV void la_load_raw(const Params& P, int b, int h, int d, int cc, LaRaw& R) {
  constexpr int NC_CTX = CTXL / 64;
  const int tid = threadIdx.x;
  const int seg = cc >= NC_CTX;
  const int row0 = seg ? NCTX + b * SEQ : b * CTXL;
  const int len = seg ? SEQ : CTXL;
  const int cl = (seg ? cc - NC_CTX : cc) * 64;
  const bf16_t* proj = (const bf16_t*)(P.ws + OFF_PROJ);
  const bf16_t* xcv = (const bf16_t*)P.out;
  const float* gates = (const float*)(P.ws + OFF_GATES);
  if (tid < 64) {
    int p = cl + tid, grow = row0 + (d ? len - 1 - p : p);
    if (MLSTM) { R.g0 = gates[grow * 32 + d * 4 + h]; R.g1 = gates[grow * 32 + 8 + d * 4 + h]; }
    else { R.g0 = gates[grow * 32 + 16 + d * 8 + h]; R.g1 = 0.f; }
  }
  if (MLSTM) {
#pragma unroll
    for (int i = 0; i < 2; ++i) {
      int c = tid + i * 256, r = c >> 3, cc8 = (c & 7) * 8;
      int p = cl + r, pos = d ? len - 1 - p : p;
      const bf16_t* rp = proj + (size_t)(row0 + pos) * EVC;
      if (FULL) R.q[i] = *(const u32x4*)(rp + h * 64 + cc8);
      R.k[i] = *(const u32x4*)(rp + 256 + h * 64 + cc8);
    }
#pragma unroll
    for (int i = 0; i < 4; ++i) {
      int c = tid + i * 256, r = c >> 4, cc8 = (c & 15) * 8;
      int p = cl + r, pos = d ? len - 1 - p : p;
      R.x[i] = *(const u32x4*)(proj + (size_t)(row0 + pos) * EVC + 512 + h * 128 + cc8);
    }
  } else {
    const int grp = h >> 2;
#pragma unroll
    for (int i = 0; i < 2; ++i) {
      int c = tid + i * 256, r = c >> 3, cc8 = (c & 7) * 8;
      int p = cl + r, pos = d ? len - 1 - p : p;
      R.x[i] = *(const u32x4*)(xcv + (size_t)(row0 + pos) * 1024 + h * 64 + cc8);
    }
#pragma unroll
    for (int i = 0; i < 4; ++i) {
      int c = tid + i * 256, r = c >> 4, cc8 = (c & 15) * 8;
      int p = cl + r, pos = d ? len - 1 - p : p;
      const bf16_t* rp = xcv + (size_t)(row0 + pos) * 1024;
      R.k[i] = *(const u32x4*)(rp + 512 + grp * 128 + cc8);
      if (FULL) { if (i < 2) R.q[i] = *(const u32x4*)(rp + 768 + grp * 128 + cc8); else R.x[i] = *(const u32x4*)(rp + 768 + grp * 128 + cc8); }
    }
  }
}

template <bool MLSTM, bool FULL>
DEV void st_linattn_seg(const Params& P, int sid, int seg, unsigned char* smem) {
  constexpr int DK = MLSTM ? 64 : 128, DX = MLSTM ? 128 : 64;
  constexpr int QS = DK + 8;
  constexpr int NH = MLSTM ? 4 : 8;
  constexpr int NC_CTX = CTXL / 64;
  const int tid = threadIdx.x, lane = tid & 63, wave = tid >> 6;
  const int d = sid & 1, h = (sid >> 1) % NH, b = (sid >> 1) / NH;
  const int gsid = MLSTM ? sid : 16 + sid;
  bf16_t* sQ = (bf16_t*)smem;
  bf16_t* sK = sQ + 64 * QS;
  bf16_t* sP = sK;
  bf16_t* sKT = sK + 64 * QS;
  bf16_t* sXT = sKT + DK * 72;
  bf16_t* sST = sXT + DX * 72;
  float* sF = (float*)(sST + DX * QS);
  float* sLa = sF;
  float* sG = sF + 64;
  float* sBc = sF + 128;
  float* sDen = sF + 192;
  float* sN = sF + 256;
  int* sRow = (int*)(sF + 384);
  static_assert((64 * QS * 2 + DK * 72 + DX * 72 + DX * QS) * 2 + 448 * 4 <= SMEM_BYTES, "lds");
  bf16_t* outb = MLSTM ? (bf16_t*)(P.ws + OFF_HBUF) : (bf16_t*)(P.ws + OFF_R2L0);
  float* segU = (float*)(P.ws + OFF_LASEG);
  float* segN = (float*)(P.ws + OFF_LASEG_N);
  float* segD = (float*)(P.ws + OFF_LASEG_D);

  f32x16 accS[2];
#pragma unroll
  for (int j = 0; j < 2; ++j)
#pragma unroll
    for (int r = 0; r < 16; ++r) accS[j][r] = 0.f;
  const int sx0 = MLSTM ? wave * 32 : (wave >> 1) * 32;
  const int sk0 = MLSTM ? 0 : (wave & 1) * 64;
  float nreg = 0.f;
  float gb0 = 0.f, gb1 = 0.f, alog_e = 0.f, dskip = 0.f;
  if (MLSTM) { gb0 = P.in[I_IBIAS][d * 4 + h]; gb1 = P.in[I_FBIAS][d * 4 + h]; }
  else { gb0 = P.in[I_DTBIAS][d * 8 + h]; alog_e = fexp(P.in[I_ALOG][d * 8 + h]); dskip = P.in[I_DSKIP][h]; }

  const int cc0 = seg * LA_CPS, cc1 = cc0 + LA_CPS;
  LaRaw R;
  la_load_raw<MLSTM, FULL>(P, b, h, d, cc0, R);
  __syncthreads();
  if (FULL) {
    for (int js = 0; js < seg; ++js) {
      const size_t it = (size_t)gsid * LA_NSEG + js;
      const float a = fexp(segD[it]);
      const float* U = segU + it * 8192;
#pragma unroll
      for (int j = 0; j < 2; ++j)
#pragma unroll
        for (int r = 0; r < 16; ++r) accS[j][r] = a * accS[j][r] + U[(j * 16 + r) * 256 + tid];
      if (MLSTM && tid < 64) nreg = a * nreg + segN[it * 64 + tid];
    }
#pragma unroll
    for (int j = 0; j < 2; ++j)
#pragma unroll
      for (int r = 0; r < 16; ++r) sST[(sx0 + acc_row(r, lane)) * QS + sk0 + j * 32 + (lane & 31)] = f2bf(accS[j][r]);
    if (tid < 128) sN[tid] = (MLSTM && tid < 64) ? nreg : 0.f;
  }
  float lsum = 0.f;

  for (int cc = cc0; cc < cc1; ++cc) {
    int tl_ = threadIdx.x; OPAQUE(tl_);
    const int tid = tl_, lane = tl_ & 63;
    const int sgi = cc >= NC_CTX;
    const int row0 = sgi ? NCTX + b * SEQ : b * CTXL;
    const int len = sgi ? SEQ : CTXL;
    const int cl = (sgi ? cc - NC_CTX : cc) * 64;
    if (tid < 64) {
      int p = cl + tid;
      sRow[tid] = row0 + (d ? len - 1 - p : p);
      if (MLSTM) { sLa[tid] = -softplusf_(-(R.g1 + gb1)); sG[tid] = fexp(R.g0 + gb0); }
      else { float dt = softplusf_(R.g0 + gb0); sLa[tid] = -dt * alog_e; sG[tid] = dt; }
    }
    __syncthreads();
    if (wave == 0) {
      float v = sLa[lane];
#pragma unroll
      for (int off = 1; off < 64; off <<= 1) {
#ifdef CPU_EMU
        float o = emu_shfl_up(v, off);
#else
        float o = __shfl_up(v, off, 64);
#endif
        if (lane >= off) v += o;
      }
      sBc[lane] = v;
    }
    __syncthreads();
    const float blast = sBc[63];
    lsum += blast;
    if (MLSTM) {
#pragma unroll
      for (int i = 0; i < 2; ++i) {
        int c = tid + i * 256, r = c >> 3, cc8 = (c & 7) * 8;
        float kf[8]; unpack8(R.k[i], kf);
        const float wgt = fexp(blast - sBc[r]) * sG[r];
#pragma unroll
        for (int j = 0; j < 8; ++j) sKT[(cc8 + j) * 72 + r] = f2bf(kf[j] * wgt);
        if (FULL) {
          float qf[8]; unpack8(R.q[i], qf);
#pragma unroll
          for (int j = 0; j < 8; ++j) qf[j] *= 0.125f;
          *(u32x4*)(sQ + r * QS + cc8) = pack8(qf);
          *(u32x4*)(sK + r * QS + cc8) = R.k[i];
        }
      }
#pragma unroll
      for (int i = 0; i < 4; ++i) {
        int c = tid + i * 256, r = c >> 4, cc8 = (c & 15) * 8;
        const bf16_t* xs = (const bf16_t*)&R.x[i];
#pragma unroll
        for (int j = 0; j < 8; ++j) sXT[(cc8 + j) * 72 + r] = xs[j];
      }
    } else {
#pragma unroll
      for (int i = 0; i < 2; ++i) {
        int c = tid + i * 256, r = c >> 3, cc8 = (c & 7) * 8;
        const bf16_t* xs = (const bf16_t*)&R.x[i];
#pragma unroll
        for (int j = 0; j < 8; ++j) sXT[(cc8 + j) * 72 + r] = xs[j];
      }
#pragma unroll
      for (int i = 0; i < 4; ++i) {
        int c = tid + i * 256, r = c >> 4, cc8 = (c & 15) * 8;
        float kf[8]; unpack8(R.k[i], kf);
        const float wgt = fexp(blast - sBc[r]) * sG[r];
#pragma unroll
        for (int j = 0; j < 8; ++j) sKT[(cc8 + j) * 72 + r] = f2bf(kf[j] * wgt);
        if (FULL) {
          *(u32x4*)(sK + r * QS + cc8) = R.k[i];
          *(u32x4*)(sQ + r * QS + cc8) = i < 2 ? R.q[i] : R.x[i];
        }
      }
    }
    if (cc + 1 < cc1) la_load_raw<MLSTM, FULL>(P, b, h, d, cc + 1, R);
    __syncthreads();
    if (FULL) {
      const int tr = (wave >> 1) * 32, tc = (wave & 1) * 32;
      f32x16 accP;
#pragma unroll
      for (int r = 0; r < 16; ++r) accP[r] = 0.f;
      if (!(tr == 0 && tc == 32)) {
#pragma unroll
        for (int kk = 0; kk < DK / 16; ++kk) {
          const int ko = kk * 16 + 8 * (lane >> 5);
          bf16x8 a = *(const bf16x8*)(sQ + (tr + (lane & 31)) * QS + ko);
          bf16x8 bb = *(const bf16x8*)(sK + (tc + (lane & 31)) * QS + ko);
          accP = mfma32(a, bb, accP);
        }
      }
      __syncthreads();
      {
        const int s = tc + (lane & 31);
        const float bs = sBc[s], gs = sG[s];
#pragma unroll
        for (int r = 0; r < 16; ++r) {
          int t = tr + acc_row(r, lane);
          float v = (s <= t) ? accP[r] * fexp(sBc[t] - bs) * gs : 0.f;
          sP[t * 72 + s] = f2bf(v);
        }
        for (int i = tid; i < 64 * DK; i += 256) {
          int t = i / DK, k = i % DK;
          sQ[t * QS + k] = f2bf(bf2f(sQ[t * QS + k]) * fexp(sBc[t]));
        }
      }
      __syncthreads();
      constexpr int NYT = MLSTM ? 2 : 1;
      const int yc0 = MLSTM ? (wave & 1) * 64 : (wave & 1) * 32;
      f32x16 accY[NYT];
#pragma unroll
      for (int j = 0; j < NYT; ++j)
#pragma unroll
        for (int r = 0; r < 16; ++r) accY[j][r] = 0.f;
#pragma unroll
      for (int kk = 0; kk < 4; ++kk) {
        const int ko = kk * 16 + 8 * (lane >> 5);
        bf16x8 a = *(const bf16x8*)(sP + (tr + (lane & 31)) * 72 + ko);
#pragma unroll
        for (int j = 0; j < NYT; ++j) {
          bf16x8 bb = *(const bf16x8*)(sXT + (yc0 + j * 32 + (lane & 31)) * 72 + ko);
          accY[j] = mfma32(a, bb, accY[j]);
        }
      }
#pragma unroll
      for (int kk = 0; kk < DK / 16; ++kk) {
        const int ko = kk * 16 + 8 * (lane >> 5);
        bf16x8 a = *(const bf16x8*)(sQ + (tr + (lane & 31)) * QS + ko);
#pragma unroll
        for (int j = 0; j < NYT; ++j) {
          bf16x8 bb = *(const bf16x8*)(sST + (yc0 + j * 32 + (lane & 31)) * QS + ko);
          accY[j] = mfma32(a, bb, accY[j]);
        }
      }
      if (MLSTM) {
        if (tid < 64) {
          float den = 0.f, dq = 0.f;
#pragma unroll 8
          for (int s = 0; s < 64; ++s) den += bf2f(sP[tid * 72 + s]);
#pragma unroll 8
          for (int k = 0; k < DK; ++k) dq += sN[k] * bf2f(sQ[tid * QS + k]);
          sDen[tid] = den + dq;
        }
        __syncthreads();
      }
#pragma unroll
      for (int j = 0; j < NYT; ++j)
#pragma unroll
        for (int r = 0; r < 16; ++r) {
          int t = tr + acc_row(r, lane);
          int x = yc0 + j * 32 + (lane & 31);
          float v = accY[j][r];
          if (MLSTM) {
            v = v * frcp(fmaxf(fabsf(sDen[t]), 1.f));
            outb[(size_t)sRow[t] * 1024 + d * 512 + h * 128 + x] = f2bf(v);
          } else {
            if (d == 0) v += dskip * bf2f(sXT[x * 72 + t]);
            outb[(size_t)sRow[t] * 1024 + d * 512 + h * 64 + x] = f2bf(v);
          }
        }
      __syncthreads();
    }
    {
      const float eb = fexp(blast);
#pragma unroll
      for (int j = 0; j < 2; ++j)
#pragma unroll
        for (int r = 0; r < 16; ++r) accS[j][r] *= eb;
#pragma unroll
      for (int kk = 0; kk < 4; ++kk) {
        const int ko = kk * 16 + 8 * (lane >> 5);
        bf16x8 a = *(const bf16x8*)(sXT + (sx0 + (lane & 31)) * 72 + ko);
#pragma unroll
        for (int j = 0; j < 2; ++j) {
          bf16x8 bb = *(const bf16x8*)(sKT + (sk0 + j * 32 + (lane & 31)) * 72 + ko);
          accS[j] = mfma32(a, bb, accS[j]);
        }
      }
      if (FULL) {
#pragma unroll
        for (int j = 0; j < 2; ++j)
#pragma unroll
          for (int r = 0; r < 16; ++r) sST[(sx0 + acc_row(r, lane)) * QS + sk0 + j * 32 + (lane & 31)] = f2bf(accS[j][r]);
      }
      if (MLSTM && tid < 64) {
        float nn = nreg * eb;
        for (int s = 0; s < 64; ++s) nn += bf2f(sKT[tid * 72 + s]);
        nreg = nn;
        if (FULL) sN[tid] = nn;
      }
    }
    __syncthreads();
  }
  if (!FULL) {
    const size_t it = (size_t)gsid * LA_NSEG + seg;
    float* U = segU + it * 8192;
#pragma unroll
    for (int j = 0; j < 2; ++j)
#pragma unroll
      for (int r = 0; r < 16; ++r) U[(j * 16 + r) * 256 + tid] = accS[j][r];
    if (MLSTM && tid < 64) segN[it * 64 + tid] = nreg;
    if (tid == 0) segD[it] = lsum;
  }
}

DEV void st_finish_l0(const Params& P, int row) {
  const int lane = threadIdx.x & 63;
  bf16_t* hb = (bf16_t*)(P.ws + OFF_HBUF) + (size_t)row * 1024;
  const bf16_t* yb = (const bf16_t*)(P.ws + OFF_R2L0) + (size_t)row * 1024;
  const bf16_t* pr = (const bf16_t*)(P.ws + OFF_PROJ) + (size_t)row * EVC;
  const int ch = lane * 8;
  float h0[8], h1[8], o[8], f1[8];
  unpack8(*(const u32x4*)(hb + ch), h0);
  unpack8(*(const u32x4*)(hb + 512 + ch), h1);
  unpack8(*(const u32x4*)(pr + 1024 + ch), o);
  float ss = 0.f;
#pragma unroll
  for (int j = 0; j < 8; ++j) { h0[j] += h1[j]; ss += h0[j] * h0[j]; }
  ss += wshfl_xor(ss, 1); ss += wshfl_xor(ss, 2); ss += wshfl_xor(ss, 4); ss += wshfl_xor(ss, 8);
  float rstd = frsq(ss * (1.f / 128.f) + 1e-6f);
#pragma unroll
  for (int j = 0; j < 8; ++j) f1[j] = h0[j] * rstd * P.in[I_MNORM][ch + j] * sigmoidf_(o[j]);
  float y0[8], y1[8], z[8], f2[8];
  unpack8(*(const u32x4*)(yb + ch), y0);
  unpack8(*(const u32x4*)(yb + 512 + ch), y1);
  unpack8(*(const u32x4*)(pr + 1552 + ch), z);
  float s2 = 0.f;
#pragma unroll
  for (int j = 0; j < 8; ++j) { y0[j] = (y0[j] + y1[j]) * siluf_(z[j]); s2 += y0[j] * y0[j]; }
  s2 = wave_sum(s2);
  float rstd2 = frsq(s2 * (1.f / 512.f) + 1e-6f);
#pragma unroll
  for (int j = 0; j < 8; ++j) f2[j] = y0[j] * rstd2 * P.in[I_SNORM][ch + j];
  *(u32x4*)(hb + ch) = pack8(f1);
  *(u32x4*)(hb + 512 + ch) = pack8(f2);
}

DEV float mixval(const bf16_t* __restrict__ proj, int row, int c, const float* __restrict__ mu) {
  float self = bf2f(proj[(size_t)row * ODC + c]);
  int nrow = -1;
  if (row < NCTX) {
    int pos = row % CTXL;
    if (c < 896) { if (pos > 0) nrow = row - 1; }
    else { if (pos < CTXL - 1) nrow = row + 1; }
  } else {
    int pos = (row - NCTX) % SEQ;
    int gx = pos % GW, gy = pos / GW, q = c / 448;
    if (q == 0) { if (gx > 0) nrow = row - 1; }
    else if (q == 1) { if (gx < GW - 1) nrow = row + 1; }
    else if (q == 2) { if (gy > 0) nrow = row - GW; }
    else { if (gy < SEQ / GW - 1) nrow = row + GW; }
  }
  float nb = nrow >= 0 ? bf2f(proj[(size_t)nrow * ODC + c]) : 0.f;
  return self + mu[c] * (nb - self);
}

DEV void st_lora_act(const Params& P, int row) {
  const int lane = threadIdx.x & 63;
  const bf16_t* proj = (const bf16_t*)(P.ws + OFF_PROJ);
  bf16_t* hb = (bf16_t*)(P.ws + OFF_HBUF) + (size_t)row * 1024;
  float v[4];
#pragma unroll
  for (int j = 0; j < 4; ++j) {
    int c = lane * 4 + j;
    float x = mixval(proj, row, 1536 + c, P.in[I_MU]);
    v[j] = c < 64 ? tanhf_(x) : (c < 128 ? x : sigmoidf_(x));
  }
  u32x2 pk; pk.x = pack2(v[0], v[1]); pk.y = pack2(v[2], v[3]);
  *(u32x2*)(hb + lane * 4) = pk;
}

DEV void st_rwkv_stream(const Params& P, int sid, unsigned char* smem) {
  const int tid = threadIdx.x, lane = tid & 63, wave = tid >> 6;
  const int d = sid & 1, h = (sid >> 1) & 7, b = sid >> 4;
  float* sR = (float*)smem;
  float* sW = sR + 2048;
  float* sKk = sW + 2048;
  float* sV = sKk + 2048;
  float* sA = sV + 2048;
  float* sBb = sA + 2048;
  float* sY = sBb + 2048;
  int* sRow = (int*)(sY + 2048);
  const bf16_t* proj = (const bf16_t*)(P.ws + OFF_PROJ);
  const bf16_t* lora = (const bf16_t*)(P.ws + OFF_LORA);
  bf16_t* yout = (bf16_t*)(P.ws + OFF_HBUF);
  const float* mu = P.in[I_MU];
  const int vrow = tid >> 2, j4 = tid & 3;
  float S[16];
#pragma unroll
  for (int i = 0; i < 16; ++i) S[i] = 0.f;
  const float kkw = P.in[I_KK][h * 64 + lane], kaw = P.in[I_KA][h * 64 + lane];
  for (int seg = 0; seg < 2; ++seg) {
    const int row0 = seg == 0 ? b * CTXL : NCTX + b * SEQ;
    const int len = seg == 0 ? CTXL : SEQ;
    for (int it = 0; it < len / 32; ++it) {
      __syncthreads();
      for (int s = wave; s < 32; s += 4) {
        int p = it * 32 + s, pos = d ? len - 1 - p : p, row = row0 + pos;
        int c = h * 64 + lane;
        float r = mixval(proj, row, c, mu);
        float k = mixval(proj, row, 512 + c, mu);
        float v = mixval(proj, row, 1024 + c, mu);
        float kk = k * kkw;
        float ss = wave_sum(kk * kk);
        kk *= frsq(ss + 1e-12f);
        float lw = bf2f(lora[((size_t)d * NTOK + row) * 512 + c]);
        float la = bf2f(lora[((size_t)(2 + d) * NTOK + row) * 512 + c]);
        float w = fexp(-0.6065306597126334f * sigmoidf_(lw));
        float a = sigmoidf_(la);
        float kt = k * (1.f + (a - 1.f) * kaw);
        sR[s * 64 + lane] = r; sW[s * 64 + lane] = w; sKk[s * 64 + lane] = kt; sV[s * 64 + lane] = v;
        sA[s * 64 + lane] = -kk; sBb[s * 64 + lane] = kk * a;
        if (lane == 0) sRow[s] = row;
      }
      __syncthreads();
      for (int s = 0; s < 32; ++s) {
        const float* pa = sA + s * 64 + j4 * 16;
        const float* pw = sW + s * 64 + j4 * 16;
        const float* pk = sKk + s * 64 + j4 * 16;
        const float* pb = sBb + s * 64 + j4 * 16;
        const float* pr = sR + s * 64 + j4 * 16;
        const float vv = sV[s * 64 + vrow];
        float sa = 0.f;
#pragma unroll
        for (int i = 0; i < 16; ++i) sa += S[i] * pa[i];
        sa += wshfl_xor(sa, 1); sa += wshfl_xor(sa, 2);
        float y = 0.f;
#pragma unroll
        for (int i = 0; i < 16; ++i) { S[i] = S[i] * pw[i] + sa * pb[i] + vv * pk[i]; y += S[i] * pr[i]; }
        y += wshfl_xor(y, 1); y += wshfl_xor(y, 2);
        if (j4 == 0) sY[s * 64 + vrow] = y;
      }
      __syncthreads();
      for (int i = tid; i < 2048; i += 256) {
        int s = i >> 6, c = i & 63;
        yout[(size_t)sRow[s] * 1024 + d * 512 + h * 64 + c] = f2bf(sY[i]);
      }
    }
  }
}


DEV int nbr_row(int row, int c) {
  if (row < NCTX) {
    int pos = row % CTXL;
    if (c < 896) return pos > 0 ? row - 1 : -1;
    return pos < CTXL - 1 ? row + 1 : -1;
  }
  int pos = (row - NCTX) % SEQ;
  int gx = pos % GW, gy = pos / GW, q = c / 448;
  if (q == 0) return gx > 0 ? row - 1 : -1;
  if (q == 1) return gx < GW - 1 ? row + 1 : -1;
  if (q == 2) return gy > 0 ? row - GW : -1;
  return gy < SEQ / GW - 1 ? row + GW : -1;
}

struct RwkvRaw { u32x4 rs, rn, ks, kn, vs, vn, lw, la; int row; };

DEV void rwkv_load_raw(const bf16_t* __restrict__ proj, const bf16_t* __restrict__ lora, int b, int h, int d, int cc, int t, int c0,
                       RwkvRaw& R) {
  constexpr int NC_CTX = CTXL / 32;
  const int seg = cc >= NC_CTX;
  const int row0 = seg ? NCTX + b * SEQ : b * CTXL;
  const int len = seg ? SEQ : CTXL;
  const int p = (seg ? cc - NC_CTX : cc) * 32 + t;
  const int row = row0 + (d ? len - 1 - p : p);
  const int col = h * 64 + c0;
  const u32x4 z4 = {0u, 0u, 0u, 0u};
  const bf16_t* rp = proj + (size_t)row * ODC;
  R.row = row;
  R.rs = *(const u32x4*)(rp + col);
  R.ks = *(const u32x4*)(rp + 512 + col);
  R.vs = *(const u32x4*)(rp + 1024 + col);
  int n0 = nbr_row(row, col), n1 = nbr_row(row, 512 + col), n2 = nbr_row(row, 1024 + col);
  R.rn = n0 >= 0 ? *(const u32x4*)(proj + (size_t)n0 * ODC + col) : z4;
  R.kn = n1 >= 0 ? *(const u32x4*)(proj + (size_t)n1 * ODC + 512 + col) : z4;
  R.vn = n2 >= 0 ? *(const u32x4*)(proj + (size_t)n2 * ODC + 1024 + col) : z4;
  R.lw = *(const u32x4*)(lora + ((size_t)d * NTOK + row) * 512 + col);
  R.la = *(const u32x4*)(lora + ((size_t)(2 + d) * NTOK + row) * 512 + col);
}

#ifndef RW_NSEG
#define RW_NSEG 16
#endif
constexpr int RW_NCH = (CTXL + SEQ) / 32;
constexpr size_t OFF_RWSEG = OFF_PU;
static_assert((size_t)32 * RW_NSEG * 64 * 128 * 4 <= (size_t)2 * NEXP * 1024, "rwseg");

template <bool FULL>
DEV void st_rwkv_seg(const Params& P, int sid, int seg, unsigned char* smem) {
  constexpr int NVB = FULL ? 2 : 4;
  constexpr int ZR = FULL ? 64 : 128;
  const int tid = threadIdx.x, lane = tid & 63, wave = tid >> 6;
  const int d = sid & 1, h = (sid >> 1) & 7, b = sid >> 4;
  bf16_t* sAt = (bf16_t*)smem;
  bf16_t* sRt = sAt + 32 * 72;
  bf16_t* sBt = sRt + 32 * 72;
  bf16_t* sKt = sBt + 32 * 72;
  bf16_t* sBT = sKt + 32 * 72;
  bf16_t* sKT = sBT + 64 * 40;
  bf16_t* sVT = sKT + 64 * 40;
  bf16_t* sLak = sVT + 64 * 40;
  bf16_t* sM = sLak + 32 * 40;
  bf16_t* sLrb = sM + 32 * 40;
  bf16_t* sLrk = sLrb + 32 * 40;
  bf16_t* sZ = FULL ? sLrk + 32 * 40 : sLrb;
  bf16_t* after = sZ + ZR * 72;
  bf16_t* sRT = FULL ? after : nullptr;
  bf16_t* sSAT = FULL ? after + 64 * 40 : sRt;
  float* sLP = (float*)(FULL ? after + 2 * 64 * 40 : after);
  float* sLab = sLP + 32 * 64;
  float* sD = sLab + 32 * 33;
  float* sPT = sD + 768;
  int* sRow = (int*)(sPT + 64);
  if (!FULL) sRT = (bf16_t*)sLP;
  static_assert((4 * 32 * 72 + 3 * 64 * 40 + 4 * 32 * 40 + 2 * 64 * 40 + 64 * 72) * 2 + (32 * 64 + 32 * 33 + 768 + 64 + 32 + 320) * 4 + 16 <= SMEM_BYTES, "lds full");
  static_assert((4 * 32 * 72 + 3 * 64 * 40 + 2 * 32 * 40 + 128 * 72) * 2 + (32 * 64 + 32 * 33 + 768 + 64 + 32) * 4 <= SMEM_BYTES, "lds p1");
  static_assert(128 * 40 * 2 <= (32 * 64 + 32 * 33) * 4 && 128 * 40 <= 3 * 32 * 72, "alias");
  const bf16_t* proj = (const bf16_t*)(P.ws + OFF_PROJ);
  const bf16_t* lora = (const bf16_t*)(P.ws + OFF_LORA);
  bf16_t* yout = (bf16_t*)(P.ws + OFF_HBUF);
  float* segZ = (float*)(P.ws + OFF_RWSEG);
  const int t = tid >> 3, c0 = (tid & 7) * 8;
  const int hl = lane >> 5, l31 = lane & 31;
  float* sCst = (float*)(smem + SMEM_BYTES - 320 * 4 - 16);
  if (tid < 64) {
    sCst[tid] = P.in[I_MU][h * 64 + tid]; sCst[64 + tid] = P.in[I_MU][512 + h * 64 + tid]; sCst[128 + tid] = P.in[I_MU][1024 + h * 64 + tid];
    sCst[192 + tid] = P.in[I_KK][h * 64 + tid]; sCst[256 + tid] = P.in[I_KA][h * 64 + tid];
  }
  const int cc0 = (seg * RW_NCH) / RW_NSEG, cc1 = ((seg + 1) * RW_NCH) / RW_NSEG;
  RwkvRaw R;
  rwkv_load_raw(proj, lora, b, h, d, cc0, t, c0, R);
  f32x16 Zm[2];
#pragma unroll
  for (int j = 0; j < 2; ++j)
#pragma unroll
    for (int r = 0; r < 16; ++r) Zm[j][r] = 0.f;
  __syncthreads();
  for (int i = tid; i < ZR * 72; i += 256) sZ[i] = 0;
  __syncthreads();
  if (!FULL) {
    if (wave >= 2) {
#pragma unroll
      for (int cb = 0; cb < 2; ++cb)
#pragma unroll
        for (int r = 0; r < 16; ++r) {
          int c = cb * 32 + acc_row(r, lane), vp = wave * 32 + l31;
          if (c == vp - 64) { Zm[cb][r] = 1.f; sZ[vp * 72 + c] = 0x3f80; }
        }
    }
  } else {
    for (int js = 0; js < seg; ++js) {
      const float* Zs = segZ + ((size_t)sid * RW_NSEG + js) * 64 * 128;
      bf16_t* sG = sAt;
      for (int i = tid; i < 64 * 64; i += 256) { int c = i >> 6, c2 = i & 63; sG[c * 72 + c2] = f2bf(Zs[c * 128 + 64 + c2]); }
      __syncthreads();
      if (wave >= 2) {
        const int cb = wave - 2;
#pragma unroll
        for (int vb = 0; vb < 2; ++vb) {
          f32x16 acc;
#pragma unroll
          for (int r = 0; r < 16; ++r) acc[r] = Zs[(cb * 32 + acc_row(r, lane)) * 128 + vb * 32 + l31];
#pragma unroll
          for (int kk = 0; kk < 4; ++kk) {
            bf16x8 a = *(const bf16x8*)(sG + (cb * 32 + l31) * 72 + kk * 16 + 8 * hl);
            bf16x8 bb = *(const bf16x8*)(sZ + (vb * 32 + l31) * 72 + kk * 16 + 8 * hl);
            acc = mfma32(a, bb, acc);
          }
          Zm[vb] = acc;
        }
      }
      __syncthreads();
      if (wave >= 2) {
        const int cb = wave - 2;
#pragma unroll
        for (int vb = 0; vb < 2; ++vb)
#pragma unroll
          for (int g = 0; g < 4; ++g) {
            u32x2 pk; pk.x = pack2(Zm[vb][4 * g], Zm[vb][4 * g + 1]); pk.y = pack2(Zm[vb][4 * g + 2], Zm[vb][4 * g + 3]);
            *(u32x2*)(sZ + (vb * 32 + l31) * 72 + cb * 32 + 8 * g + 4 * hl) = pk;
          }
      }
      __syncthreads();
    }
  }
  for (int cc = cc0; cc < cc1; ++cc) {
    int tl_ = threadIdx.x; OPAQUE(tl_);
    const int tid = tl_, lane = tl_ & 63, hl = lane >> 5, l31 = lane & 31, t = tl_ >> 3, c0 = (tl_ & 7) * 8;
    const float* muR = sCst + c0; const float* muK = sCst + 64 + c0; const float* muV = sCst + 128 + c0;
    const float* kkw = sCst + 192 + c0; const float* kaw = sCst + 256 + c0;
    float lw8[8], lp8[8];
    {
      float lwf[8];
      unpack8(R.lw, lwf);
#pragma unroll
      for (int j = 0; j < 8; ++j) { lw8[j] = -0.6065306597126334f * sigmoidf_(lwf[j]); lp8[j] = lw8[j]; }
#pragma unroll
      for (int off = 8; off < 64; off <<= 1) {
#pragma unroll
        for (int j = 0; j < 8; ++j) {
#ifdef CPU_EMU
          float o = emu_shfl_up(lp8[j], off);
#else
          float o = __shfl_up(lp8[j], off, 64);
#endif
          if (lane >= off) lp8[j] += o;
        }
      }
      if (lane >= 56) {
#pragma unroll
        for (int j = 0; j < 8; ++j) sLP[wave * 64 + c0 + j] = lp8[j];
      }
      if ((tid & 7) == 0) sRow[t] = R.row;
    }
    __syncthreads();
    {
#pragma unroll
      for (int j = 0; j < 8; ++j) {
        float offs = 0.f;
        for (int w2 = 0; w2 < wave; ++w2) offs += sLP[w2 * 64 + c0 + j];
        lp8[j] += offs;
      }
      if (t == 31) {
#pragma unroll
        for (int j = 0; j < 8; ++j) sPT[c0 + j] = fexp(lp8[j]);
      }
    }
    {
      float xs[8], xn[8], kt[8], aa[8], ob[8], ok[8];
      unpack8(R.ks, xs); unpack8(R.kn, xn);
      float ss = 0.f;
#pragma unroll
      for (int j = 0; j < 8; ++j) { kt[j] = xs[j] + muK[j] * (xn[j] - xs[j]); aa[j] = kt[j] * kkw[j]; ss += aa[j] * aa[j]; }
      ss += wshfl_xor(ss, 1); ss += wshfl_xor(ss, 2); ss += wshfl_xor(ss, 4);
      const float rn = frsq(ss + 1e-12f);
      float laf[8];
      unpack8(R.la, laf);
#pragma unroll
      for (int j = 0; j < 8; ++j) {
        const float lp = lp8[j];
        const float lpm = lp8[j] - lw8[j];
        const float e = fexp(-lp);
        const float kkn = aa[j] * rn;
        const float asg = sigmoidf_(laf[j]);
        aa[j] = -kkn * fexp(lpm);
        ob[j] = kkn * asg * e;
        ok[j] = kt[j] * (1.f + (asg - 1.f) * kaw[j]) * e;
      }
      *(u32x4*)(sAt + t * 72 + c0) = pack8(aa);
      *(u32x4*)(sBt + t * 72 + c0) = pack8(ob);
      *(u32x4*)(sKt + t * 72 + c0) = pack8(ok);
#pragma unroll
      for (int j = 0; j < 8; ++j) { sBT[(c0 + j) * 40 + t] = f2bf(ob[j]); sKT[(c0 + j) * 40 + t] = f2bf(ok[j]); }
      unpack8(R.vs, xs); unpack8(R.vn, xn);
#pragma unroll
      for (int j = 0; j < 8; ++j) sVT[(c0 + j) * 40 + t] = f2bf(xs[j] + muV[j] * (xn[j] - xs[j]));
      if (FULL) {
        unpack8(R.rs, xs); unpack8(R.rn, xn);
#pragma unroll
        for (int j = 0; j < 8; ++j) xs[j] = (xs[j] + muR[j] * (xn[j] - xs[j])) * fexp(lp8[j]);
        *(u32x4*)(sRt + t * 72 + c0) = pack8(xs);
      }
    }
    if (cc + 1 < cc1) rwkv_load_raw(proj, lora, b, h, d, cc + 1, t, c0, R);
    __syncthreads();
    if (FULL || wave < 2) {
      const bf16_t* Asrc = wave < 2 ? sAt : sRt;
      const bf16_t* Bsrc = (wave & 1) ? sKt : sBt;
      f32x16 acc;
#pragma unroll
      for (int r = 0; r < 16; ++r) acc[r] = 0.f;
#pragma unroll
      for (int kk = 0; kk < 4; ++kk) {
        bf16x8 a = *(const bf16x8*)(Asrc + l31 * 72 + kk * 16 + 8 * hl);
        bf16x8 bb = *(const bf16x8*)(Bsrc + l31 * 72 + kk * 16 + 8 * hl);
        acc = mfma32(a, bb, acc);
      }
      bf16_t* dst = wave == 1 ? sLak : (wave == 2 ? sLrb : sLrk);
#pragma unroll
      for (int r = 0; r < 16; ++r) {
        int tt = acc_row(r, lane), j = l31;
        bool keep = wave < 2 ? (j < tt) : (j <= tt);
        float v = keep ? acc[r] : 0.f;
        if (wave == 0) sLab[tt * 33 + j] = v;
        else dst[tt * 40 + j] = f2bf(v);
      }
    }
    __syncthreads();
    if (tid < 32) {
      const int q = tid >> 4, c = tid & 15;
      float x[16];
#pragma unroll
      for (int i = 0; i < 16; ++i) {
        float sacc = (i == c) ? 1.f : 0.f;
#pragma unroll
        for (int j = 0; j < i; ++j) sacc += sLab[(q * 16 + i) * 33 + q * 16 + j] * x[j];
        x[i] = sacc;
        sD[q * 256 + i * 16 + c] = sacc;
      }
    }
    __syncthreads();
    {
      const int i = tid >> 4, c = tid & 15;
      float sacc = 0.f;
#pragma unroll
      for (int j = 0; j < 16; ++j) sacc += sLab[(16 + i) * 33 + j] * sD[j * 16 + c];
      sD[512 + i * 16 + c] = sacc;
    }
    __syncthreads();
    {
      const int i = tid >> 4, c = tid & 15;
      float sacc = 0.f;
#pragma unroll
      for (int j = 0; j < 16; ++j) sacc += sD[256 + i * 16 + j] * sD[512 + j * 16 + c];
      sM[(16 + i) * 40 + c] = f2bf(sacc);
      sM[i * 40 + c] = f2bf(sD[i * 16 + c]);
      sM[(16 + i) * 40 + 16 + c] = f2bf(sD[256 + i * 16 + c]);
      sM[i * 40 + 16 + c] = 0;
    }
    if (wave < NVB) {
      const int vb = wave;
      f32x16 acc;
#pragma unroll
      for (int r = 0; r < 16; ++r) acc[r] = 0.f;
#pragma unroll
      for (int kk = 0; kk < 4; ++kk) {
        bf16x8 a = *(const bf16x8*)(sAt + l31 * 72 + kk * 16 + 8 * hl);
        bf16x8 bb = *(const bf16x8*)(sZ + (vb * 32 + l31) * 72 + kk * 16 + 8 * hl);
        acc = mfma32(a, bb, acc);
      }
      if (vb < 2) {
#pragma unroll
        for (int kk = 0; kk < 2; ++kk) {
          bf16x8 a = *(const bf16x8*)(sLak + l31 * 40 + kk * 16 + 8 * hl);
          bf16x8 bb = *(const bf16x8*)(sVT + (vb * 32 + l31) * 40 + kk * 16 + 8 * hl);
          acc = mfma32(a, bb, acc);
        }
      }
#pragma unroll
      for (int g = 0; g < 4; ++g) {
        u32x2 pk; pk.x = pack2(acc[4 * g], acc[4 * g + 1]); pk.y = pack2(acc[4 * g + 2], acc[4 * g + 3]);
        *(u32x2*)(sRT + (vb * 32 + l31) * 40 + 8 * g + 4 * hl) = pk;
      }
    }
    __syncthreads();
    if (wave < NVB) {
      const int vb = wave;
      f32x16 acc;
#pragma unroll
      for (int r = 0; r < 16; ++r) acc[r] = 0.f;
#pragma unroll
      for (int kk = 0; kk < 2; ++kk) {
        bf16x8 a = *(const bf16x8*)(sM + l31 * 40 + kk * 16 + 8 * hl);
        bf16x8 bb = *(const bf16x8*)(sRT + (vb * 32 + l31) * 40 + kk * 16 + 8 * hl);
        acc = mfma32(a, bb, acc);
      }
#pragma unroll
      for (int g = 0; g < 4; ++g) {
        u32x2 pk; pk.x = pack2(acc[4 * g], acc[4 * g + 1]); pk.y = pack2(acc[4 * g + 2], acc[4 * g + 3]);
        *(u32x2*)(sSAT + (vb * 32 + l31) * 40 + 8 * g + 4 * hl) = pk;
      }
    }
    __syncthreads();
    if (FULL) {
      if (wave < 2) {
        const int vb = wave;
        f32x16 acc;
#pragma unroll
        for (int r = 0; r < 16; ++r) acc[r] = 0.f;
#pragma unroll
        for (int kk = 0; kk < 4; ++kk) {
          bf16x8 a = *(const bf16x8*)(sRt + l31 * 72 + kk * 16 + 8 * hl);
          bf16x8 bb = *(const bf16x8*)(sZ + (vb * 32 + l31) * 72 + kk * 16 + 8 * hl);
          acc = mfma32(a, bb, acc);
        }
#pragma unroll
        for (int kk = 0; kk < 2; ++kk) {
          bf16x8 a = *(const bf16x8*)(sLrb + l31 * 40 + kk * 16 + 8 * hl);
          bf16x8 bb = *(const bf16x8*)(sSAT + (vb * 32 + l31) * 40 + kk * 16 + 8 * hl);
          acc = mfma32(a, bb, acc);
        }
#pragma unroll
        for (int kk = 0; kk < 2; ++kk) {
          bf16x8 a = *(const bf16x8*)(sLrk + l31 * 40 + kk * 16 + 8 * hl);
          bf16x8 bb = *(const bf16x8*)(sVT + (vb * 32 + l31) * 40 + kk * 16 + 8 * hl);
          acc = mfma32(a, bb, acc);
        }
#pragma unroll
        for (int r = 0; r < 16; ++r) {
          int tt = acc_row(r, lane);
          yout[(size_t)sRow[tt] * 1024 + d * 512 + h * 64 + vb * 32 + l31] = f2bf(acc[r]);
        }
      } else {
        const int cb = wave - 2;
#pragma unroll
        for (int vb = 0; vb < 2; ++vb) {
          f32x16 acc;
#pragma unroll
          for (int r = 0; r < 16; ++r) acc[r] = 0.f;
#pragma unroll
          for (int kk = 0; kk < 2; ++kk) {
            bf16x8 a = *(const bf16x8*)(sBT + (cb * 32 + l31) * 40 + kk * 16 + 8 * hl);
            bf16x8 bb = *(const bf16x8*)(sSAT + (vb * 32 + l31) * 40 + kk * 16 + 8 * hl);
            acc = mfma32(a, bb, acc);
          }
#pragma unroll
          for (int kk = 0; kk < 2; ++kk) {
            bf16x8 a = *(const bf16x8*)(sKT + (cb * 32 + l31) * 40 + kk * 16 + 8 * hl);
            bf16x8 bb = *(const bf16x8*)(sVT + (vb * 32 + l31) * 40 + kk * 16 + 8 * hl);
            acc = mfma32(a, bb, acc);
          }
#pragma unroll
          for (int r = 0; r < 16; ++r) Zm[vb][r] = sPT[cb * 32 + acc_row(r, lane)] * (Zm[vb][r] + acc[r]);
        }
      }
      __syncthreads();
      if (wave >= 2) {
        const int cb = wave - 2;
#pragma unroll
        for (int vb = 0; vb < 2; ++vb)
#pragma unroll
          for (int g = 0; g < 4; ++g) {
            u32x2 pk; pk.x = pack2(Zm[vb][4 * g], Zm[vb][4 * g + 1]); pk.y = pack2(Zm[vb][4 * g + 2], Zm[vb][4 * g + 3]);
            *(u32x2*)(sZ + (vb * 32 + l31) * 72 + cb * 32 + 8 * g + 4 * hl) = pk;
          }
      }
    } else {
      const int vb = wave;
#pragma unroll
      for (int cb = 0; cb < 2; ++cb) {
        f32x16 acc;
#pragma unroll
        for (int r = 0; r < 16; ++r) acc[r] = 0.f;
#pragma unroll
        for (int kk = 0; kk < 2; ++kk) {
          bf16x8 a = *(const bf16x8*)(sBT + (cb * 32 + l31) * 40 + kk * 16 + 8 * hl);
          bf16x8 bb = *(const bf16x8*)(sSAT + (vb * 32 + l31) * 40 + kk * 16 + 8 * hl);
          acc = mfma32(a, bb, acc);
        }
        if (vb < 2) {
#pragma unroll
          for (int kk = 0; kk < 2; ++kk) {
            bf16x8 a = *(const bf16x8*)(sKT + (cb * 32 + l31) * 40 + kk * 16 + 8 * hl);
            bf16x8 bb = *(const bf16x8*)(sVT + (vb * 32 + l31) * 40 + kk * 16 + 8 * hl);
            acc = mfma32(a, bb, acc);
          }
        }
#pragma unroll
        for (int r = 0; r < 16; ++r) Zm[cb][r] = sPT[cb * 32 + acc_row(r, lane)] * (Zm[cb][r] + acc[r]);
      }
#pragma unroll
      for (int cb = 0; cb < 2; ++cb)
#pragma unroll
        for (int g = 0; g < 4; ++g) {
          u32x2 pk; pk.x = pack2(Zm[cb][4 * g], Zm[cb][4 * g + 1]); pk.y = pack2(Zm[cb][4 * g + 2], Zm[cb][4 * g + 3]);
          *(u32x2*)(sZ + (vb * 32 + l31) * 72 + cb * 32 + 8 * g + 4 * hl) = pk;
        }
    }
  }
  if (!FULL) {
    float* Zs = segZ + ((size_t)sid * RW_NSEG + seg) * 64 * 128;
#pragma unroll
    for (int cb = 0; cb < 2; ++cb)
#pragma unroll
      for (int r = 0; r < 16; ++r) Zs[(cb * 32 + acc_row(r, lane)) * 128 + wave * 32 + l31] = Zm[cb][r];
  }
}

constexpr int LRU_NCH = (CTXL + SEQ) / 64;
constexpr size_t OFF_ACUM0 = OFF_PU;
static_assert((size_t)NLAT * 512 * 2 <= (size_t)2 * NEXP * 1024, "acum0");

DEV void st_lru_chunk(const Params& P, int sid, int cc, unsigned char* smem) {
  constexpr int NC_CTX = CTXL / 64;
  const int tid = threadIdx.x, lane = tid & 63, wave = tid >> 6;
  const int d = sid & 1, blk = (sid >> 1) & 7, b = sid >> 4;
  float* sXc = (float*)smem;
  float* sAc = sXc + 4096;
  float* sBc = sAc + 4096;
  float* sU = sBc + 4096;
  bf16_t* sAop = (bf16_t*)(sU + 4096);
  float* sQA = (float*)(sAop + 64 * 72);
  float* sQH = sQA + 256;
  int* sRow = (int*)(sQH + 256);
  const bf16_t* proj = (const bf16_t*)(P.ws + OFF_PROJ);
  bf16_t* uout = (bf16_t*)(P.ws + OFF_LORA) + (size_t)d * NTOK * 512;
  bf16_t* aout = (bf16_t*)(P.ws + (d ? OFF_ACUM1 : OFF_ACUM0));
  const bf16_t* lruT = (const bf16_t*)(P.ws + OFF_LRUT) + (size_t)(d * 8 + blk) * 128 * 64;
  float* chunkS = (float*)(P.ws + OFF_LRUCS) + ((size_t)sid * LRU_NCH + cc) * 128;
  const float* cw = P.in[I_LCONVW];
  const float* cb = P.in[I_LCONVB];
  const int tr = (wave >> 1) * 32, nc0 = (wave & 1) * 64;
  const int sgi = cc >= NC_CTX;
  const int row0 = sgi ? NCTX + b * SEQ : b * CTXL;
  const int len = sgi ? SEQ : CTXL;
  const int cl = (sgi ? cc - NC_CTX : cc) * 64;
  __syncthreads();
  if (tid < 64) { int p = cl + tid; sRow[tid] = row0 + (d ? len - 1 - p : p); }
  {
    const int lc8 = (tid & 7) * 8, lch = blk * 64 + lc8;
#pragma unroll
    for (int i = 0; i < 2; ++i) {
      int c = tid + i * 256, r = c >> 3;
      int p = cl + r, pos = d ? len - 1 - p : p;
      float o[8];
      f32x4 c0 = *(const f32x4*)(cb + lch), c1 = *(const f32x4*)(cb + lch + 4);
      o[0] = c0.x; o[1] = c0.y; o[2] = c0.z; o[3] = c0.w; o[4] = c1.x; o[5] = c1.y; o[6] = c1.z; o[7] = c1.w;
#pragma unroll
      for (int tap = 0; tap < 4; ++tap) {
        int pp = pos + tap - 2;
        if (pp >= 0 && pp < len) {
          float x[8];
          unpack8(*(const u32x4*)(proj + (size_t)(row0 + pp) * ODC + 2304 + lch), x);
          f32x4 w0 = *(const f32x4*)(cw + tap * 512 + lch), w1 = *(const f32x4*)(cw + tap * 512 + lch + 4);
          o[0] += w0.x * x[0]; o[1] += w0.y * x[1]; o[2] += w0.z * x[2]; o[3] += w0.w * x[3];
          o[4] += w1.x * x[4]; o[5] += w1.y * x[5]; o[6] += w1.z * x[6]; o[7] += w1.w * x[7];
        }
      }
#pragma unroll
      for (int j = 0; j < 8; ++j) sXc[r * 64 + lc8 + j] = o[j];
      *(u32x4*)(sAop + r * 72 + lc8) = pack8(o);
    }
  }
  __syncthreads();
  {
    f32x16 acc[2];
#pragma unroll
    for (int j = 0; j < 2; ++j)
#pragma unroll
      for (int r = 0; r < 16; ++r) acc[j][r] = 0.f;
#pragma unroll
    for (int kk = 0; kk < 4; ++kk) {
      bf16x8 a = *(const bf16x8*)(sAop + (tr + (lane & 31)) * 72 + kk * 16 + 8 * (lane >> 5));
#pragma unroll
      for (int j = 0; j < 2; ++j) {
        bf16x8 bb = *(const bf16x8*)(lruT + (nc0 + j * 32 + (lane & 31)) * 64 + kk * 16 + 8 * (lane >> 5));
        acc[j] = mfma32(a, bb, acc[j]);
      }
    }
#pragma unroll
    for (int j = 0; j < 2; ++j) {
      const int e = nc0 + j * 32 + (lane & 31);
      const int ch = blk * 64 + (e & 63);
      const float ebias = e < 64 ? P.in[I_BA][d * 512 + ch] : P.in[I_BI][d * 512 + ch];
      const float esp = softplusf_(-P.in[I_LAM][d * 512 + ch]);
#pragma unroll
      for (int r = 0; r < 16; ++r) {
        int t = tr + acc_row(r, lane);
        float g = sigmoidf_(acc[j][r] + ebias);
        if (e < 64) { float a_ = fexp(-8.f * g * esp); sAc[t * 64 + e] = a_; sU[t * 64 + e] = fsqrt(fmaxf(1.f - a_ * a_, 0.f)); }
        else sBc[t * 64 + (e - 64)] = g * sXc[t * 64 + (e - 64)];
      }
    }
  }
  __syncthreads();
  const int c = tid & 63, q = tid >> 6;
  {
    float h = 0.f, ap = 1.f;
#pragma unroll 4
    for (int i = 0; i < 16; ++i) {
      const int t = q * 16 + i;
      const float a = sAc[t * 64 + c];
      h = a * h + sU[t * 64 + c] * sBc[t * 64 + c];
      ap *= a;
      sU[t * 64 + c] = h; sAc[t * 64 + c] = ap;
    }
    sQA[q * 64 + c] = ap; sQH[q * 64 + c] = h;
  }
  __syncthreads();
  {
    float hin = 0.f, ain = 1.f;
    for (int q2 = 0; q2 < q; ++q2) { hin = sQA[q2 * 64 + c] * hin + sQH[q2 * 64 + c]; ain *= sQA[q2 * 64 + c]; }
    if (q > 0) {
#pragma unroll 4
      for (int i = 0; i < 16; ++i) {
        const int t = q * 16 + i;
        const float ap = sAc[t * 64 + c];
        sU[t * 64 + c] += ap * hin;
        sAc[t * 64 + c] = ap * ain;
      }
    }
    if (q == 3) { chunkS[c] = sAc[63 * 64 + c]; chunkS[64 + c] = sU[63 * 64 + c]; }
  }
  __syncthreads();
  if (sgi) {
#pragma unroll
    for (int i = 0; i < 2; ++i) {
      int cidx = tid + i * 256, r = cidx >> 3, c8 = (cidx & 7) * 8;
      float u8[8], a8[8];
#pragma unroll
      for (int j = 0; j < 8; ++j) { u8[j] = sU[r * 64 + c8 + j]; a8[j] = sAc[r * 64 + c8 + j]; }
      const int row = sRow[r];
      *(u32x4*)(uout + (size_t)row * 512 + blk * 64 + c8) = pack8(u8);
      *(u32x4*)(aout + (size_t)(row - NCTX) * 512 + blk * 64 + c8) = pack8(a8);
    }
  }
}

DEV void st_lru_carry(const Params& P, int sid) {
  const int c = threadIdx.x;
  if (c >= 64) return;
  const float* cs = (const float*)(P.ws + OFF_LRUCS) + (size_t)sid * LRU_NCH * 128;
  float* hs = (float*)(P.ws + OFF_LRUHS) + (size_t)sid * LRU_NCH * 64;
  float h = 0.f;
  for (int cc0 = 0; cc0 < LRU_NCH; cc0 += 10) {
    float a[10], bb[10];
#pragma unroll
    for (int i = 0; i < 10; ++i) { a[i] = cs[(size_t)(cc0 + i) * 128 + c]; bb[i] = cs[(size_t)(cc0 + i) * 128 + 64 + c]; }
#pragma unroll
    for (int i = 0; i < 10; ++i) { hs[(size_t)(cc0 + i) * 64 + c] = h; h = a[i] * h + bb[i]; }
  }
}

DEV void st_finish_l1(const Params& P, int row) {
  const int lane = threadIdx.x & 63;
  bf16_t* hb = (bf16_t*)(P.ws + OFF_HBUF) + (size_t)row * 1024;
  const bf16_t* proj = (const bf16_t*)(P.ws + OFF_PROJ);
  const bf16_t* lora = (const bf16_t*)(P.ws + OFF_LORA);
  const float* mu = P.in[I_MU];
  const int ch = lane * 8;
  float y0[8], y1[8];
  unpack8(*(const u32x4*)(hb + ch), y0);
  unpack8(*(const u32x4*)(hb + 512 + ch), y1);
  float sm = 0.f;
#pragma unroll
  for (int j = 0; j < 8; ++j) { y0[j] += y1[j]; sm += y0[j]; }
  sm += wshfl_xor(sm, 1); sm += wshfl_xor(sm, 2); sm += wshfl_xor(sm, 4);
  const float mean = sm * (1.f / 64.f);
  float sv = 0.f;
#pragma unroll
  for (int j = 0; j < 8; ++j) { float dlt = y0[j] - mean; sv += dlt * dlt; }
  sv += wshfl_xor(sv, 1); sv += wshfl_xor(sv, 2); sv += wshfl_xor(sv, 4);
  const float rstd = frsq(sv * (1.f / 64.f) + 64e-5f);
  float a0[8], a1[8], g[8], u0[8], u1[8], gb[8];
  unpack8(*(const u32x4*)(lora + ((size_t)2 * NTOK + row) * 512 + ch), a0);
  unpack8(*(const u32x4*)(lora + ((size_t)3 * NTOK + row) * 512 + ch), a1);
  unpack8(*(const u32x4*)(lora + ((size_t)4 * NTOK + row) * 512 + ch), g);
  unpack8(*(const u32x4*)(lora + ((size_t)0 * NTOK + row) * 512 + ch), u0);
  unpack8(*(const u32x4*)(lora + ((size_t)1 * NTOK + row) * 512 + ch), u1);
  if (row >= NCTX) {
    const int bb_ = (row - NCTX) / SEQ, pos = (row - NCTX) % SEQ, blk = ch >> 6;
    float ac[8];
#pragma unroll
    for (int dd = 0; dd < 2; ++dd) {
      const int pidx = dd ? SEQ - 1 - pos : pos;
      const int cc = CTXL / 64 + pidx / 64;
      const int sid = (bb_ * 8 + blk) * 2 + dd;
      const float* hs = (const float*)(P.ws + OFF_LRUHS) + ((size_t)sid * LRU_NCH + cc) * 64 + (ch & 63);
      unpack8(*(const u32x4*)((const bf16_t*)(P.ws + (dd ? OFF_ACUM1 : OFF_ACUM0)) + (size_t)(row - NCTX) * 512 + ch), ac);
      f32x4 h0 = *(const f32x4*)hs, h1 = *(const f32x4*)(hs + 4);
      float* u = dd ? u1 : u0;
      u[0] += ac[0] * h0.x; u[1] += ac[1] * h0.y; u[2] += ac[2] * h0.z; u[3] += ac[3] * h0.w;
      u[4] += ac[4] * h1.x; u[5] += ac[5] * h1.y; u[6] += ac[6] * h1.z; u[7] += ac[7] * h1.w;
    }
  }
  unpack8(*(const u32x4*)(proj + (size_t)row * ODC + 1792 + ch), gb);
  float rv[8], vv[8];
  float sdot = 0.f;
#pragma unroll
  for (int j = 0; j < 8; ++j) {
    float r = mixval(proj, row, ch + j, mu);
    float k = mixval(proj, row, 512 + ch + j, mu);
    vv[j] = mixval(proj, row, 1024 + ch + j, mu);
    float am = 0.5f * (sigmoidf_(a0[j]) + sigmoidf_(a1[j]));
    float kb = k * (1.f + (am - 1.f) * P.in[I_KA][ch + j]);
    sdot += r * kb * P.in[I_RK][ch + j];
    rv[j] = r;
  }
  sdot += wshfl_xor(sdot, 1); sdot += wshfl_xor(sdot, 2); sdot += wshfl_xor(sdot, 4);
  float f1[8], f2[8];
#pragma unroll
  for (int j = 0; j < 8; ++j) {
    float yn = (y0[j] - mean) * rstd * P.in[I_LNW][ch + j] + P.in[I_LNB][ch + j];
    yn += sdot * vv[j];
    f1[j] = yn * g[j];
    f2[j] = (u0[j] + u1[j]) * geluf_(gb[j]);
  }
  *(u32x4*)(hb + ch) = pack8(f1);
  *(u32x4*)(hb + 512 + ch) = pack8(f2);
}

DEV unsigned fkey(float f) { unsigned u; __builtin_memcpy(&u, &f, 4); return (u >> 31) ? ~u : (u | 0x80000000u); }
DEV float keyf(unsigned u) { u = (u >> 31) ? (u & 0x7fffffffu) : ~u; float f; __builtin_memcpy(&f, &u, 4); return f; }
DEV void key_insert(unsigned x, unsigned* v) {
#pragma unroll
  for (int j = 0; j < 16; ++j) { unsigned hi = v[j] > x ? v[j] : x; x = v[j] > x ? x : v[j]; v[j] = hi; }
}
DEV void key_cx(unsigned& hi, unsigned& lo) { unsigned a = hi, b = lo; hi = a > b ? a : b; lo = a > b ? b : a; }
DEV void key_sort16(unsigned* v) {
#pragma unroll
  for (int k = 2; k <= 16; k <<= 1)
#pragma unroll
    for (int j = k >> 1; j > 0; j >>= 1)
#pragma unroll
      for (int i = 0; i < 16; ++i) {
        const int l = i ^ j;
        if (l > i) { if ((i & k) == 0) key_cx(v[i], v[l]); else key_cx(v[l], v[i]); }
      }
}
DEV void key_merge16(unsigned* a, const unsigned* b) {
#pragma unroll
  for (int i = 0; i < 16; ++i) a[i] = a[i] > b[15 - i] ? a[i] : b[15 - i];
#pragma unroll
  for (int j = 8; j > 0; j >>= 1)
#pragma unroll
    for (int i = 0; i < 16; ++i) { const int l = i ^ j; if (l > i) key_cx(a[i], a[l]); }
}

DEV void st_peer_topk(const Params& P, int layer, int tile, int h, unsigned char* smem) {
  const int tid = threadIdx.x;
  const bf16_t* q = (const bf16_t*)(P.ws + OFF_Q);
  const bf16_t* keys = (const bf16_t*)(P.ws + OFF_KEYS) + (size_t)(layer * 8 + h) * 2 * 128 * 128;
  float* sS = (float*)smem;
  const int m0 = tile * 128;
  const int tok = tid & 127, half = tid >> 7;
  unsigned kl[2][16];
#pragma unroll
  for (int p = 0; p < 2; ++p) {
    EpiScoreLds epi{sS, m0};
    gemm_tile_128<true>(q + (h * 2 + p) * 128, 2048, NTOK, keys + p * 128 * 128, 128, 128, 128, m0, 0, epi, smem);
    __syncthreads();
    float* row = sS + tok * 129 + half * 64;
#pragma unroll
    for (int g = 0; g < 4; ++g) {
      unsigned grp[16];
#pragma unroll
      for (int j = 0; j < 16; ++j) grp[j] = (fkey(row[g * 16 + j]) & ~127u) | (unsigned)(127 - (half * 64 + g * 16 + j));
      key_sort16(grp);
      if (g == 0) {
#pragma unroll
        for (int j = 0; j < 16; ++j) kl[p][j] = grp[j];
      } else key_merge16(kl[p], grp);
    }
    if (half == 1) {
#pragma unroll
      for (int j = 0; j < 16; ++j) row[j] = __builtin_bit_cast(float, kl[p][j]);
    }
    __syncthreads();
    if (half == 0) {
      unsigned oth[16];
#pragma unroll
      for (int j = 0; j < 16; ++j) oth[j] = __builtin_bit_cast(unsigned, sS[tok * 129 + 64 + j]);
      key_merge16(kl[p], oth);
    }
    __syncthreads();
  }
  if (tid < 128) {
    float sv0[16], sv1[16];
    int* irow = (int*)(sS + tid * 129);
#pragma unroll
    for (int j = 0; j < 16; ++j) {
      sv0[j] = keyf((kl[0][j] & ~127u) | 64u); sv1[j] = keyf((kl[1][j] & ~127u) | 64u);
      irow[j] = 127 - (int)(kl[0][j] & 127u); irow[16 + j] = 127 - (int)(kl[1][j] & 127u);
    }
    unsigned best[16];
#pragma unroll
    for (int j = 0; j < 16; ++j) best[j] = 0u;
#pragma unroll
    for (int i = 0; i < 16; ++i)
#pragma unroll
      for (int j = 0; j < 16; ++j)
        if ((i + 1) * (j + 1) <= 16) key_insert((fkey(sv0[i] + sv1[j]) & ~255u) | (unsigned)(255 - (i * 16 + j)), best);
    float e[16], sum = 0.f;
    const float b0 = keyf((best[0] & ~255u) | 128u);
#pragma unroll
    for (int j = 0; j < 16; ++j) { e[j] = fexp(keyf((best[j] & ~255u) | 128u) - b0); sum += e[j]; }
    const float inv = 1.f / sum;
    int* pidx = (int*)(P.ws + OFF_PIDX) + (size_t)(m0 + tid) * 128 + h * 16;
    float* pg = (float*)(P.ws + OFF_PGATE) + (size_t)(m0 + tid) * 128 + h * 16;
#pragma unroll
    for (int j = 0; j < 16; ++j) {
      const int pos = 255 - (int)(best[j] & 255u);
      pidx[j] = irow[pos >> 4] * 128 + irow[16 + (pos & 15)];
      pg[j] = e[j] * inv;
    }
  }
}

DEV void st_peer_experts(const Params& P, int layer, int row) {
  const int lane = threadIdx.x & 63;
  const bf16_t* xb = (const bf16_t*)(P.ws + OFF_HBUF) + (size_t)row * 1024;
  const unsigned char* U = P.ws + OFF_PU;
  const int* pidx = (const int*)(P.ws + OFF_PIDX) + (size_t)row * 128;
  const float* pg = (const float*)(P.ws + OFF_PGATE) + (size_t)row * 128;
  float x[16], acc[16];
  unpack8(*(const u32x4*)(xb + lane * 16), x);
  unpack8(*(const u32x4*)(xb + lane * 16 + 8), x + 8);
#pragma unroll
  for (int j = 0; j < 16; ++j) acc[j] = 0.f;
  const int b5 = (lane >> 5) & 1, b4 = (lane >> 4) & 1, b3 = (lane >> 3) & 1;
  const int mypick = (lane >> 3) & 7;
  for (int k0 = 0; k0 < 128; k0 += 8) {
    u32x4 uu[8], vv[8];
#pragma unroll
    for (int i = 0; i < 8; ++i) {
      const size_t off = (size_t)pidx[k0 + i] * 2048 + lane * 16;
      uu[i] = *(const u32x4*)(U + off);
      vv[i] = *(const u32x4*)(U + off + 1024);
    }
    const float mygate = pg[k0 + mypick];
    float dsum[8];
#pragma unroll
    for (int i = 0; i < 8; ++i) {
      float uf[16];
      unpack16_fp8(uu[i], uf);
      float dd = 0.f;
#pragma unroll
      for (int j = 0; j < 16; ++j) dd += x[j] * uf[j];
      dsum[i] = dd;
    }
    float e4[4], e2[2], g;
#pragma unroll
    for (int i = 0; i < 4; ++i) {
      float mine = b5 ? dsum[4 + i] : dsum[i], send = b5 ? dsum[i] : dsum[4 + i];
      e4[i] = mine + wshfl_xor(send, 32);
    }
#pragma unroll
    for (int i = 0; i < 2; ++i) {
      float mine = b4 ? e4[2 + i] : e4[i], send = b4 ? e4[i] : e4[2 + i];
      e2[i] = mine + wshfl_xor(send, 16);
    }
    {
      float mine = b3 ? e2[1] : e2[0], send = b3 ? e2[0] : e2[1];
      g = mine + wshfl_xor(send, 8);
    }
    g += wshfl_xor(g, 4); g += wshfl_xor(g, 2); g += wshfl_xor(g, 1);
    const float mycoef = mygate * geluf_(g * (1.f / PEER_USCALE));
#pragma unroll
    for (int i = 0; i < 8; ++i) {
      const float coef = wreadlane(mycoef, i * 8);
      float vf[16];
      unpack16_fp8(vv[i], vf);
#pragma unroll
      for (int j = 0; j < 16; ++j) acc[j] += coef * vf[j];
    }
  }
  float* xr = row < NCTX ? (float*)(P.ws + OFF_CTXRES) + (size_t)row * 1024 : P.out + (size_t)(row - NCTX) * 1024;
  const float* g2 = (const float*)(P.ws + OFF_MODV) + ((size_t)layer * 3 + mod_row(row)) * 6144 + 5 * 1024;
  float o[16];
#pragma unroll
  for (int q = 0; q < 4; ++q) {
    const int c = lane * 16 + q * 4;
    f32x4 a = *(const f32x4*)(xr + c), ga = *(const f32x4*)(g2 + c);
    o[q * 4 + 0] = a.x + ga.x * acc[q * 4 + 0] * (1.f / PEER_VSCALE); o[q * 4 + 1] = a.y + ga.y * acc[q * 4 + 1] * (1.f / PEER_VSCALE);
    o[q * 4 + 2] = a.z + ga.z * acc[q * 4 + 2] * (1.f / PEER_VSCALE); o[q * 4 + 3] = a.w + ga.w * acc[q * 4 + 3] * (1.f / PEER_VSCALE);
  }
  float ss = 0.f;
#pragma unroll
  for (int j = 0; j < 16; ++j) ss += o[j] * o[j];
  ss = wave_sum(ss);
  const float rstd = frsq(ss * (1.f / 1024.f) + 1e-6f);
  if (layer == 1) {
#pragma unroll
    for (int j = 0; j < 16; ++j) o[j] *= rstd * P.in[I_FNORM][lane * 16 + j];
  }
#pragma unroll
  for (int q = 0; q < 4; ++q) {
    f32x4 a = {o[q * 4 + 0], o[q * 4 + 1], o[q * 4 + 2], o[q * 4 + 3]};
    *(f32x4*)(xr + lane * 16 + q * 4) = a;
  }
  if (layer == 0) {
    const float* mv = (const float*)(P.ws + OFF_MODV) + ((size_t)1 * 3 + mod_row(row)) * 6144;
    const float* nw = P.in[I_NORM1] + 1024;
    float hh[16];
#pragma unroll
    for (int q = 0; q < 4; ++q) {
      const int c = lane * 16 + q * 4;
      f32x4 w4 = *(const f32x4*)(nw + c), s4 = *(const f32x4*)(mv + 1024 + c), h4 = *(const f32x4*)(mv + c);
      hh[q * 4 + 0] = o[q * 4 + 0] * rstd * w4.x * (1.f + s4.x) + h4.x; hh[q * 4 + 1] = o[q * 4 + 1] * rstd * w4.y * (1.f + s4.y) + h4.y;
      hh[q * 4 + 2] = o[q * 4 + 2] * rstd * w4.z * (1.f + s4.z) + h4.z; hh[q * 4 + 3] = o[q * 4 + 3] * rstd * w4.w * (1.f + s4.w) + h4.w;
    }
    bf16_t* hb = (bf16_t*)(P.ws + OFF_HBUF) + (size_t)row * 1024 + lane * 16;
    *(u32x4*)hb = pack8(hh);
    *(u32x4*)(hb + 8) = pack8(hh + 8);
  }
}


#define FOR_TILES_XCD(MT0, MT1, NT, mt, nt)                                                     \
  for (int _x = blockIdx.x & 7, _mlo = (MT0) + (((MT1) - (MT0)) * _x) / 8,                        \
           _mhi = (MT0) + (((MT1) - (MT0)) * (_x + 1)) / 8, _i = blockIdx.x >> 3,                 \
           _cnt = (_mhi - _mlo) * (NT), mt = 0, nt = 0;                                           \
       _i < _cnt && ((mt = _mlo + _i / (NT)), (nt = _i % (NT)), true); _i += (int)(gridDim.x >> 3))

#ifndef PHASE_LIST
#define PHASE_LIST(X) X(0) X(1) X(2) X(22) X(23) X(3) X(4) X(5) X(6) X(7) X(8) X(9) X(11) X(12) X(13) X(30) X(14) X(15) X(31) X(16) X(17) X(18) X(19) X(20) X(21)
#endif
constexpr int PH_LAST = 21;

template <int ph>
DEV void run_phase(const Params& P, unsigned char* smem) {
  const int bid = blockIdx.x, nb = gridDim.x;
  const int wave = threadIdx.x >> 6;
  unsigned char* ws = P.ws;
  constexpr int layer = ((ph >= 10 && ph <= 21) || ph >= 30) ? 1 : 0;
  const float* modv_l = (const float*)(ws + OFF_MODV) + (size_t)layer * 3 * 6144;
  switch (ph) {
    case 0:
      for (int t = NTRANS + bid; t < NPREP; t += nb) st_prep(P, t, smem);
      break;
    case 1: case 10:
      if (ph == 1) for (int t = nb - 1 - bid; t < NTRANS; t += nb) st_prep(P, t, smem);
      for (int t = bid; t < NTOK / 4; t += nb) st_normmod(P, layer, 0, t * 4 + wave);
      break;
    case 2: {
      EpiProjL0 epi{(bf16_t*)(ws + OFF_PROJ), (float*)(ws + OFF_GATES)};
      FOR_TILES_XCD(0, NTILE, 13, mt, nt)
        gemm_tile_128x256((const bf16_t*)(ws + OFF_HBUF), 1024, NTOK, (const bf16_t*)(ws + OFF_WEVIN), 1024, EVC, 1024,
                          mt * 128, nt * 256, epi, smem);
    } break;
    case 22:
      for (int t = bid; t < NTOK / 4; t += nb) st_xbc_conv(P, t * 4 + wave);
      for (int t = bid; t < NPCONV; t += nb) st_peer_conv(P, 0, t);
      break;
    case 23:
      for (int t = bid; t < 48 * LA_NSEG; t += nb) {
        int sid = t % 48, seg = t / 48;
        if (sid < 16) st_linattn_seg<true, false>(P, sid, seg, smem);
        else st_linattn_seg<false, false>(P, sid - 16, seg, smem);
      }
      break;
    case 3:
      for (int t = bid; t < 48 * LA_NSEG; t += nb) {
        int sid = t % 48, seg = t / 48;
        if (sid < 16) st_linattn_seg<true, true>(P, sid, seg, smem);
        else st_linattn_seg<false, true>(P, sid - 16, seg, smem);
      }
      break;
    case 4:
      for (int t = bid; t < NTOK / 4; t += nb) st_finish_l0(P, t * 4 + wave);
      break;
    case 5: case 17: {
      EpiOutProj epi{layer == 0 ? P.in[I_X] : P.out, P.in[I_CTX], P.out, (float*)(ws + OFF_CTXRES), modv_l};
      const bf16_t* Wt = (const bf16_t*)(ws + (layer == 0 ? OFF_WEVOUT : OFF_WODOUT));
      FOR_TILES_XCD(layer == 0 ? 0 : CTILE, NTILE, 4, mt, nt)
        gemm_tile_128x256((const bf16_t*)(ws + OFF_HBUF), 1024, NTOK, Wt, 1024, 1024, 1024, mt * 128, nt * 256, epi, smem);
    } break;
    case 6: case 18: {
      const int r0 = layer == 0 ? 0 : NCTX / 4;
      for (int t = r0 + bid; t < NTOK / 4; t += nb) st_normmod(P, layer, 1, t * 4 + wave);
      if (ph == 18) for (int t = bid; t < NPCONV; t += nb) st_peer_conv(P, 1, t);
    } break;
    case 7: case 19: {
      EpiStoreBf epi{(bf16_t*)(ws + OFF_Q), 2048};
      const bf16_t* Wt = (const bf16_t*)(ws + OFF_WQ) + (size_t)layer * 2048 * 1024;
      FOR_TILES_XCD(layer == 0 ? 0 : CTILE, NTILE, 8, mt, nt)
        gemm_tile_128x256((const bf16_t*)(ws + OFF_HBUF), 1024, NTOK, Wt, 1024, 2048, 1024, mt * 128, nt * 256, epi, smem);
    } break;
    case 8: case 20: {
      const int t0 = layer == 0 ? 0 : CTILE * 8;
      for (int t = t0 + bid; t < NTILE * 8; t += nb) st_peer_topk(P, layer, t / 8, t % 8, smem);
    } break;
    case 9: case 21: {
      const int r0 = layer == 0 ? 0 : NCTX / 4;
      for (int t = r0 + bid; t < NTOK / 4; t += nb) st_peer_experts(P, layer, t * 4 + wave);
    } break;
    case 11: {
      EpiStoreBf epi{(bf16_t*)(ws + OFF_PROJ), ODC};
      FOR_TILES_XCD(0, NTILE, 11, mt, nt)
        gemm_tile_128x256((const bf16_t*)(ws + OFF_HBUF), 1024, NTOK, (const bf16_t*)(ws + OFF_WODIN), 1024, ODC, 1024,
                          mt * 128, nt * 256, epi, smem);
    } break;
    case 12:
      for (int t = bid; t < NTOK / 4; t += nb) st_lora_act(P, t * 4 + wave);
      break;
    case 13:
      for (int t = bid; t < NTILE * 20; t += nb) {
        int job = t / (NTILE * 4), tt = t % (NTILE * 4);
        int mt = tt / 4, nt = tt % 4;
        bf16_t* dst = (bf16_t*)(ws + OFF_LORA) + (size_t)job * NTOK * 512;
        const bf16_t* A = (const bf16_t*)(ws + OFF_HBUF) + (job < 2 ? 0 : (job < 4 ? 64 : 128));
        const bf16_t* Bt = job < 2 ? (const bf16_t*)(ws + OFF_WUP) + (size_t)job * 512 * 64
                         : job < 4 ? (const bf16_t*)(ws + OFF_AUP) + (size_t)(job - 2) * 512 * 64
                                   : (const bf16_t*)(ws + OFF_GUP);
        const float* bias = job < 2 ? P.in[I_W0] + job * 512 : (job < 4 ? P.in[I_A0] + (job - 2) * 512 : nullptr);
        const int K = job < 4 ? 64 : 128;
        EpiStoreBfBias epi{dst, 512, bias};
        gemm_tile_128<false>(A, 1024, NTOK, Bt, K, 512, K, mt * 128, nt * 128, epi, smem);
      }
      break;
    case 30:
      for (int t = bid; t < 32 * RW_NSEG; t += nb) st_rwkv_seg<false>(P, t % 32, t / 32, smem);
      break;
    case 14:
      for (int t = bid; t < 32 * RW_NSEG; t += nb) st_rwkv_seg<true>(P, t % 32, t / 32, smem);
      break;
    case 15:
      for (int t = bid; t < 32 * LRU_NCH; t += nb) st_lru_chunk(P, t % 32, t / 32, smem);
      break;
    case 31:
      if (bid < 32) st_lru_carry(P, bid);
      break;
    case 16:
      for (int t = bid; t < NTOK / 4; t += nb) st_finish_l1(P, t * 4 + wave);
      break;
    default: break;
  }
}


#ifndef CPU_EMU
#define XB_TMO      128
#define XB_XCNT(j)  (256  + 64 * (j))
#define XB_XSUB(j)  (1280 + 64 * (j))
#define XB_XGEN(j)  (2304 + 64 * (j))
#define XB_TOP      3328
#define XB_TOPGEN   3392
#define XCD_BAR_WORDS 3456
#define XB_SPIN_CAP (1u << 20)
#define LAS __attribute__((address_space(3)))
__device__ __forceinline__ unsigned xb_ld(unsigned* p)              { return __hip_atomic_load(p, __ATOMIC_RELAXED, __HIP_MEMORY_SCOPE_AGENT); }
__device__ __forceinline__ unsigned xb_add(unsigned* p, unsigned v) { return __hip_atomic_fetch_add(p, v, __ATOMIC_RELAXED, __HIP_MEMORY_SCOPE_AGENT); }
__device__ __forceinline__ unsigned xb_xcc_id() { return (unsigned)__builtin_amdgcn_s_getreg((3 << 11) | 20) & 0xFu; }
#define XB_SPIN(cond, bar) do { unsigned _sp = 0; while (cond) { __builtin_amdgcn_s_sleep(1); \
    if ((++_sp & 255u) == 0u) { if (xb_ld(&(bar)[XB_TMO])) break; if (_sp > XB_SPIN_CAP) { atomicAdd(&(bar)[XB_TMO], 1u); break; } } } } while (0)
struct XcdBarrier { unsigned* bar; unsigned x; volatile LAS unsigned* st; };
__device__ __forceinline__ XcdBarrier xcd_barrier_post(unsigned* bar, volatile LAS unsigned* st) {
  XcdBarrier b; b.bar = bar; b.x = xb_xcc_id(); b.st = st;
  if (threadIdx.x == 0) (void)xb_add(&bar[XB_XCNT(b.x)], 1u);
  return b;
}
__device__ __forceinline__ void xcd_barrier_complete(unsigned* bar, unsigned x, unsigned& nloc, unsigned& nx) {
  const unsigned G = gridDim.x * gridDim.y * gridDim.z;
  unsigned sum, cnt, mine, sp = 0u;
  for (;;) {
    sum = 0u; cnt = 0u; mine = 0u;
#pragma unroll
    for (unsigned j = 0; j < 16; ++j) { const unsigned c = xb_ld(&bar[XB_XCNT(j)]); sum += c; cnt += (c > 0u) ? 1u : 0u; mine = (j == x) ? c : mine; }
    if (sum == G) break;
    __builtin_amdgcn_s_sleep(1);
    if ((++sp & 255u) == 0u) { if (xb_ld(&bar[XB_TMO])) break; if (sp > XB_SPIN_CAP) { atomicAdd(&bar[XB_TMO], 1u); break; } }
  }
  nloc = mine > 0u ? mine : 1u; nx = cnt > 0u ? cnt : 1u;
}
__device__ __forceinline__ void xcd_barrier(const XcdBarrier& b) {
  asm volatile("s_waitcnt vmcnt(0)" ::: "memory");
  __syncthreads();
  if (threadIdx.x == 0) {
    unsigned* bar = b.bar;
    __builtin_amdgcn_s_waitcnt(0);
    unsigned nloc = b.st[0], nx = b.st[1];
    if (nloc == 0u) { xcd_barrier_complete(bar, b.x, nloc, nx); b.st[0] = nloc; b.st[1] = nx; }
    const unsigned old = xb_add(&bar[XB_XSUB(b.x)], 1u);
    const unsigned gen = old / nloc;
    if (old + 1u == (gen + 1u) * nloc) {
      __builtin_amdgcn_fence(__ATOMIC_RELEASE, "agent");
      asm volatile("s_waitcnt vmcnt(0)" ::: "memory");
      const unsigned og = xb_add(&bar[XB_TOP], 1u);
      const unsigned tg = og / nx;
      if (og + 1u == (tg + 1u) * nx) xb_add(&bar[XB_TOPGEN], 1u);
      else XB_SPIN(xb_ld(&bar[XB_TOPGEN]) == tg, bar);
      __builtin_amdgcn_fence(__ATOMIC_ACQUIRE, "agent");
      xb_add(&bar[XB_XGEN(b.x)], 1u);
      asm volatile("s_waitcnt vmcnt(0)" ::: "memory");
    } else {
      XB_SPIN(xb_ld(&bar[XB_XGEN(b.x)]) == gen, bar);
      __builtin_amdgcn_fence(__ATOMIC_ACQUIRE, "agent");
      asm volatile("s_waitcnt vmcnt(0)" ::: "memory");
    }
  }
  __syncthreads();
}
#endif
#ifndef CPU_EMU
#define RUN_PH(n) if (n != 0) { run_phase<n>(P, smem_raw); if (n != PH_LAST) xcd_barrier(xb); }
__global__ void __launch_bounds__(256, 2) mega_kernel(Params P) {
  SMEM_DECL;
  unsigned* bar = (unsigned*)(P.ws + OFF_BAR);
  volatile LAS unsigned* st = (volatile LAS unsigned*)(smem_raw + SMEM_BYTES - 16);
  if (blockIdx.x == 0) for (int i = threadIdx.x; i < XCD_BAR_WORDS; i += 256) bar[i] = 0u;
  if (threadIdx.x == 0) { st[0] = 0u; st[1] = 0u; }
  run_phase<0>(P, smem_raw);
  cg::this_grid().sync();
  XcdBarrier xb = xcd_barrier_post(bar, st);
  PHASE_LIST(RUN_PH)
}

extern "C" void kernel_launch(void* const* d_in, const int* in_sizes, int n_in, void* d_out, int out_size, void* d_ws,
                              size_t ws_size, hipStream_t stream) {
  Params P{};
  for (int i = 0; i < N_IN; ++i) P.in[i] = (const float*)d_in[i];
  P.out = (float*)d_out;
  P.ws = (unsigned char*)d_ws;
  if (ws_size < WS_NEEDED) { fprintf(stderr, "workspace too small: %zu < %zu\n", ws_size, (size_t)WS_NEEDED); return; }
  static int grid_blocks = 0;
  if (!grid_blocks) {
    int dev = 0, cus = 0, per_cu = 0;
    hipGetDevice(&dev);
    hipDeviceGetAttribute(&cus, hipDeviceAttributeMultiprocessorCount, dev);
    hipOccupancyMaxActiveBlocksPerMultiprocessor(&per_cu, mega_kernel, 256, 0);
    if (per_cu > 2) per_cu = 2;
    grid_blocks = cus * per_cu;
  }
  void* args[] = {&P};
  hipError_t e = hipLaunchCooperativeKernel((void*)mega_kernel, dim3(grid_blocks), dim3(256), args, 0, stream);
  if (e != hipSuccess) fprintf(stderr, "cooperative launch failed: %s (grid %d)\n", hipGetErrorString(e), grid_blocks);
}
#endif
```

```cpp
#ifdef CPU_EMU
#include "emu.h"
#else
#include <hip/hip_runtime.h>
#include <hip/hip_cooperative_groups.h>
#include <cstdio>
namespace cg = cooperative_groups;
#define DEV __device__ __forceinline__
#define DEVM __device__ __forceinline__
#define OPAQUE(x) asm volatile("" : "+v"(x))
#endif

#ifndef SEQ_LEN
#define SEQ_LEN 16384
#endif
#ifndef CTX_LEN
#define CTX_LEN 256
#endif
#ifndef GRID_W_
#define GRID_W_ 64
#endif
#ifndef MULTI_LAUNCH
#define MULTI_LAUNCH 0
#endif

typedef unsigned short bf16_t;
typedef __attribute__((ext_vector_type(8))) short bf16x8;
typedef __attribute__((ext_vector_type(16))) float f32x16;
typedef __attribute__((ext_vector_type(4))) unsigned u32x4;
typedef __attribute__((ext_vector_type(2))) unsigned u32x2;
typedef __attribute__((ext_vector_type(4))) float f32x4;

constexpr int D = 1024, NB = 2, SEQ = SEQ_LEN, CTXL = CTX_LEN, GW = GRID_W_;
constexpr int NCTX = NB * CTXL, NLAT = NB * SEQ, NTOK = NCTX + NLAT;
constexpr int EVC = 3104, ODC = 2816;
constexpr int NEXP = 16384;
constexpr int NTILE = NTOK / 128, CTILE = NCTX / 128;
static_assert(NTOK % 128 == 0 && NCTX % 128 == 0, "tiles");
static_assert(CTXL % 64 == 0 && SEQ % 64 == 0 && SEQ % GW == 0, "chunks");

constexpr size_t al256(size_t x) { return (x + 255) & ~(size_t)255; }
constexpr size_t OFF_MODV = 0;
constexpr size_t OFF_CTXRES = OFF_MODV + al256(2 * 3 * 6144 * 4);
constexpr size_t OFF_GATES = OFF_CTXRES + al256((size_t)NCTX * 1024 * 4);
constexpr size_t OFF_WEVIN = OFF_GATES + al256((size_t)NTOK * 32 * 4);
constexpr size_t OFF_WEVOUT = OFF_WEVIN + al256((size_t)EVC * 1024 * 2);
constexpr size_t OFF_WODIN = OFF_WEVOUT + al256((size_t)1024 * 1024 * 2);
constexpr size_t OFF_WODOUT = OFF_WODIN + al256((size_t)ODC * 1024 * 2);
constexpr size_t OFF_WQ = OFF_WODOUT + al256((size_t)1024 * 1024 * 2);
constexpr size_t OFF_KEYS = OFF_WQ + al256((size_t)2 * 2048 * 1024 * 2);
constexpr size_t OFF_WUP = OFF_KEYS + al256((size_t)2 * 8 * 2 * 128 * 128 * 2);
constexpr size_t OFF_AUP = OFF_WUP + al256((size_t)2 * 512 * 64 * 2);
constexpr size_t OFF_GUP = OFF_AUP + al256((size_t)2 * 512 * 64 * 2);
constexpr size_t OFF_LRUT = OFF_GUP + al256((size_t)512 * 128 * 2);
constexpr size_t OFF_PU = OFF_LRUT + al256((size_t)2 * 8 * 128 * 64 * 2);
constexpr size_t OFF_PV = OFF_PU + al256((size_t)NEXP * 1024);
constexpr size_t OFF_HBUF = OFF_PV + al256((size_t)NEXP * 1024);
constexpr size_t OFF_PR = OFF_HBUF + al256((size_t)NTOK * 1024 * 2);
constexpr size_t PR_BYTES = (size_t)NTOK * 5376 * 2;
constexpr size_t OFF_BAR = OFF_PR + PR_BYTES;
constexpr size_t OFF_ACUM1 = OFF_BAR + 16384;
constexpr size_t OFF_LRUCS = OFF_ACUM1 + (size_t)NLAT * 512 * 2;
constexpr size_t OFF_LRUHS = OFF_LRUCS + (size_t)32 * ((CTXL + SEQ) / 64) * 128 * 4;
constexpr size_t WS_NEEDED = OFF_LRUHS + (size_t)32 * ((CTXL + SEQ) / 64) * 64 * 4;
#ifndef CPU_EMU
static_assert(WS_NEEDED <= (size_t)512 * 1024 * 1024, "workspace too large");
#endif
constexpr size_t OFF_PROJ = OFF_PR;
constexpr size_t OFF_R2L0 = OFF_PR + (size_t)NTOK * EVC * 2;
constexpr size_t OFF_LORA = OFF_PR + (size_t)NTOK * ODC * 2;
constexpr size_t OFF_Q = OFF_PR;
constexpr size_t OFF_PIDX = OFF_PR + (size_t)NTOK * 2048 * 2;
constexpr size_t OFF_PGATE = OFF_PIDX + (size_t)NTOK * 128 * 4;
static_assert(OFF_PGATE + (size_t)NTOK * 128 * 4 <= OFF_PR + PR_BYTES, "picks");

enum {
  I_X = 0, I_C, I_CTX, I_CCTX, I_MODW, I_MODB, I_NORM1, I_NORM2, I_WQ, I_KEYS, I_PU, I_PV,
  I_EVWIN, I_EVWOUT, I_IBIAS, I_FBIAS, I_MNORM, I_SCONVW, I_SCONVB, I_DTBIAS, I_ALOG, I_DSKIP, I_SNORM,
  I_ODWIN, I_ODWOUT, I_MU, I_W0, I_WUP, I_A0, I_AUP, I_GUP, I_KK, I_KA, I_RK, I_LNW, I_LNB,
  I_LCONVW, I_LCONVB, I_LAM, I_WA, I_BA, I_WI, I_BI, I_FNORM, N_IN
};

struct Params {
  const float* in[N_IN];
  float* out;
  unsigned char* ws;
};

constexpr int SMEM_BYTES = 80 * 1024;
#ifdef CPU_EMU
#define SMEM_DECL static thread_local __attribute__((aligned(16))) unsigned char smem_raw[SMEM_BYTES]
#else
#define SMEM_DECL __shared__ __attribute__((aligned(16))) unsigned char smem_raw[SMEM_BYTES]
#endif

DEV float bf2f(bf16_t v) { unsigned u = ((unsigned)v) << 16; float f; __builtin_memcpy(&f, &u, 4); return f; }
DEV bf16_t f2bf(float f) { unsigned u; __builtin_memcpy(&u, &f, 4); u += 0x7fffu + ((u >> 16) & 1u); return (bf16_t)(u >> 16); }
DEV unsigned pack2(float a, float b) { return (unsigned)f2bf(a) | ((unsigned)f2bf(b) << 16); }
DEV void unpack8(const u32x4& r, float* o) {
  unsigned w[4] = {r.x, r.y, r.z, r.w};
#pragma unroll
  for (int i = 0; i < 4; ++i) { unsigned lo = w[i] << 16, hi = w[i] & 0xffff0000u; __builtin_memcpy(&o[2 * i], &lo, 4); __builtin_memcpy(&o[2 * i + 1], &hi, 4); }
}
DEV u32x4 pack8(const float* o) { u32x4 r; r.x = pack2(o[0], o[1]); r.y = pack2(o[2], o[3]); r.z = pack2(o[4], o[5]); r.w = pack2(o[6], o[7]); return r; }
#ifdef CPU_EMU
DEV float fexp(float x) { return expf(x); }
DEV float frcp(float x) { return 1.f / x; }
DEV float flog(float x) { return logf(x); }
DEV float frsq(float x) { return 1.f / sqrtf(x); }
DEV float fsqrt(float x) { return sqrtf(x); }
#else
DEV float fexp(float x) { return __expf(x); }
DEV float frcp(float x) { return __builtin_amdgcn_rcpf(x); }
DEV float flog(float x) { return __logf(x); }
DEV float frsq(float x) { return __builtin_amdgcn_rsqf(x); }
DEV float fsqrt(float x) { return __builtin_amdgcn_sqrtf(x); }
#endif
DEV float sigmoidf_(float x) { return frcp(1.f + fexp(-x)); }
DEV float siluf_(float x) { return x * frcp(1.f + fexp(-x)); }
DEV float softplusf_(float x) { return fmaxf(x, 0.f) + flog(1.f + fexp(-fabsf(x))); }
DEV float tanhf_(float x) { return 1.f - 2.f * frcp(1.f + fexp(2.f * x)); }
DEV float geluf_(float x) { return 0.5f * x * (1.f + erff(x * 0.70710678118654752f)); }

DEV f32x16 mfma32(bf16x8 a, bf16x8 b, f32x16 c) {
#ifdef CPU_EMU
  return emu_mfma32(a, b, c);
#else
  return __builtin_amdgcn_mfma_f32_32x32x16_bf16(a, b, c, 0, 0, 0);
#endif
}
DEV float wshfl_xor(float v, int m) {
#ifdef CPU_EMU
  return emu_shfl_xor(v, m);
#else
  return __shfl_xor(v, m, 64);
#endif
}
DEV float wave_sum(float v) {
#pragma unroll
  for (int m = 32; m >= 1; m >>= 1) v += wshfl_xor(v, m);
  return v;
}

#ifdef CPU_EMU
static inline unsigned emu_f2fp8(float f) {
  unsigned sgn = f < 0.f ? 0x80u : 0u; float a = fabsf(f);
  if (!(a == a)) return 0x7f;
  if (a >= 448.f) return sgn | 0x7e;
  if (a < 0.0009765625f) return sgn;
  int e; frexpf(a, &e); e -= 1;
  if (e < -6) { int q = (int)nearbyintf(a * 512.f); return sgn | (unsigned)q; }
  float m = a / ldexpf(1.f, e);
  int q = (int)nearbyintf((m - 1.f) * 8.f);
  if (q == 8) { q = 0; e += 1; }
  if (e > 8) return sgn | 0x7e;
  return sgn | (unsigned)((e + 7) << 3) | (unsigned)q;
}
static inline float emu_fp82f(unsigned c) {
  unsigned sgn = c & 0x80, e = (c >> 3) & 15, m = c & 7;
  float v = e == 0 ? ldexpf((float)m, -9) : ldexpf(1.f + m / 8.f, (int)e - 7);
  return sgn ? -v : v;
}
#endif
DEV unsigned pack4_fp8(float a, float b, float c, float d) {
#ifdef CPU_EMU
  return emu_f2fp8(a) | (emu_f2fp8(b) << 8) | (emu_f2fp8(c) << 16) | (emu_f2fp8(d) << 24);
#else
  int w = 0;
  w = __builtin_amdgcn_cvt_pk_fp8_f32(a, b, w, false);
  w = __builtin_amdgcn_cvt_pk_fp8_f32(c, d, w, true);
  return (unsigned)w;
#endif
}
DEV void unpack4_fp8(unsigned w, float* o) {
#ifdef CPU_EMU
  o[0] = emu_fp82f(w & 255); o[1] = emu_fp82f((w >> 8) & 255); o[2] = emu_fp82f((w >> 16) & 255); o[3] = emu_fp82f(w >> 24);
#else
  typedef __attribute__((ext_vector_type(2))) float f32x2_;
  f32x2_ lo = __builtin_amdgcn_cvt_pk_f32_fp8((int)w, false);
  f32x2_ hi = __builtin_amdgcn_cvt_pk_f32_fp8((int)w, true);
  o[0] = lo.x; o[1] = lo.y; o[2] = hi.x; o[3] = hi.y;
#endif
}
DEV void unpack16_fp8(const u32x4& r, float* o) { unpack4_fp8(r.x, o); unpack4_fp8(r.y, o + 4); unpack4_fp8(r.z, o + 8); unpack4_fp8(r.w, o + 12); }
DEV float wreadlane(float v, int srclane) {
#ifdef CPU_EMU
  return emu_readlane(v, srclane);
#else
  int iv; __builtin_memcpy(&iv, &v, 4);
  int r = __builtin_amdgcn_readlane(iv, srclane);
  float f; __builtin_memcpy(&f, &r, 4); return f;
#endif
}
constexpr float PEER_USCALE = 64.f, PEER_VSCALE = 4.f;

DEV int acc_row(int reg, int lane) { return (reg & 3) + 8 * (reg >> 2) + 4 * (lane >> 5); }

DEV int mod_row(int row) { return row < NCTX ? 2 : (row - NCTX) / SEQ; }

template <bool SYNC_EPI, class Epi>
DEV void gemm_tile_128(const bf16_t* __restrict__ A, int lda, int M, const bf16_t* __restrict__ Bt, int ldb, int N,
                       int K, int m0, int n0, const Epi& epi, unsigned char* smem) {
  constexpr int LS = 72;
  constexpr int STAGE = 2 * 128 * LS;
  bf16_t* sbase = (bf16_t*)smem;
  const int wave = threadIdx.x >> 6;
  const int wm = (wave >> 1) * 64, wn = (wave & 1) * 64;
  f32x16 acc[2][2];
#pragma unroll
  for (int i = 0; i < 2; ++i)
#pragma unroll
    for (int j = 0; j < 2; ++j)
#pragma unroll
      for (int r = 0; r < 16; ++r) acc[i][j][r] = 0.f;
  u32x4 ra[4], rb[4];
  auto gload = [&](int k0) {
    int tl_ = threadIdx.x; OPAQUE(tl_);
#pragma unroll
    for (int i = 0; i < 4; ++i) {
      int c = tl_ + i * 256, r = c >> 3, cc = (c & 7) * 8;
      int gr = m0 + r, gn = n0 + r;
      gr = gr < M ? gr : M - 1; gn = gn < N ? gn : N - 1;
      ra[i] = *(const u32x4*)(A + (size_t)gr * lda + k0 + cc);
      rb[i] = *(const u32x4*)(Bt + (size_t)gn * ldb + k0 + cc);
    }
  };
  auto lwrite = [&](int buf) {
    int tl_ = threadIdx.x; OPAQUE(tl_);
    bf16_t* sA = sbase + buf * STAGE;
    bf16_t* sB = sA + 128 * LS;
#pragma unroll
    for (int i = 0; i < 4; ++i) {
      int c = tl_ + i * 256, r = c >> 3, cc = (c & 7) * 8;
      *(u32x4*)(sA + r * LS + cc) = ra[i];
      *(u32x4*)(sB + r * LS + cc) = rb[i];
    }
  };
  const int nk = K >> 6;
  gload(0);
  __syncthreads();
  lwrite(0);
  if (nk > 1) gload(64);
  __syncthreads();
  for (int it = 0; it < nk; ++it) {
    int tl_ = threadIdx.x; OPAQUE(tl_);
    const int lane = tl_ & 63;
    const bf16_t* sA = sbase + (it & 1) * STAGE;
    const bf16_t* sB = sA + 128 * LS;
#pragma unroll
    for (int kk = 0; kk < 4; ++kk) {
      bf16x8 a[2], b[2];
      const int ko = kk * 16 + 8 * (lane >> 5);
#pragma unroll
      for (int i = 0; i < 2; ++i) a[i] = *(const bf16x8*)(sA + (wm + i * 32 + (lane & 31)) * LS + ko);
#pragma unroll
      for (int j = 0; j < 2; ++j) b[j] = *(const bf16x8*)(sB + (wn + j * 32 + (lane & 31)) * LS + ko);
#pragma unroll
      for (int i = 0; i < 2; ++i)
#pragma unroll
        for (int j = 0; j < 2; ++j) acc[i][j] = mfma32(a[i], b[j], acc[i][j]);
      if (kk == 1) {
        if (it + 1 < nk) lwrite((it + 1) & 1);
        if (it + 2 < nk) gload((it + 2) * 64);
      }
    }
    __syncthreads();
  }
  {
    int tl_ = threadIdx.x; OPAQUE(tl_);
    const int lane = tl_ & 63;
#pragma unroll
    for (int i = 0; i < 2; ++i)
#pragma unroll
      for (int j = 0; j < 2; ++j)
#pragma unroll
        for (int r = 0; r < 16; ++r) {
          int row = m0 + wm + i * 32 + acc_row(r, lane);
          int col = n0 + wn + j * 32 + (lane & 31);
          if (row < M && col < N) epi(row, col, acc[i][j][r]);
        }
  }
}

template <class Epi>
DEV void gemm_tile_128x256(const bf16_t* __restrict__ A, int lda, int M, const bf16_t* __restrict__ Bt, int ldb, int N,
                           int K, int m0, int n0, const Epi& epi, unsigned char* smem) {
  constexpr int LS = 72;
  bf16_t* sA = (bf16_t*)smem;
  bf16_t* sB = sA + 128 * LS;
  const int wave = threadIdx.x >> 6;
  const int wm = (wave >> 1) * 64, wn = (wave & 1) * 128;
  f32x16 acc[2][4];
#pragma unroll
  for (int i = 0; i < 2; ++i)
#pragma unroll
    for (int j = 0; j < 4; ++j)
#pragma unroll
      for (int r = 0; r < 16; ++r) acc[i][j][r] = 0.f;
  u32x4 ra[4], rb[8];
  {
    const int tid = threadIdx.x;
#pragma unroll
    for (int i = 0; i < 4; ++i) {
      int c = tid + i * 256, r = c >> 3, cc = (c & 7) * 8;
      { int gr = m0 + r; gr = gr < M ? gr : M - 1; ra[i] = *(const u32x4*)(A + (size_t)gr * lda + cc); }
    }
#pragma unroll
    for (int i = 0; i < 8; ++i) {
      int c = tid + i * 256, r = c >> 3, cc = (c & 7) * 8;
      { int gn = n0 + r; gn = gn < N ? gn : N - 1; rb[i] = *(const u32x4*)(Bt + (size_t)gn * ldb + cc); }
    }
  }
  for (int k0 = 0; k0 < K; k0 += 64) {
    int tl_ = threadIdx.x; OPAQUE(tl_);
    const int tid = tl_, lane = tl_ & 63;
    __syncthreads();
#pragma unroll
    for (int i = 0; i < 4; ++i) { int c = tid + i * 256, r = c >> 3, cc = (c & 7) * 8; *(u32x4*)(sA + r * LS + cc) = ra[i]; }
#pragma unroll
    for (int i = 0; i < 8; ++i) { int c = tid + i * 256, r = c >> 3, cc = (c & 7) * 8; *(u32x4*)(sB + r * LS + cc) = rb[i]; }
    __syncthreads();
    if (k0 + 64 < K) {
#pragma unroll
      for (int i = 0; i < 4; ++i) {
        int c = tid + i * 256, r = c >> 3, cc = (c & 7) * 8;
        { int gr = m0 + r; gr = gr < M ? gr : M - 1; ra[i] = *(const u32x4*)(A + (size_t)gr * lda + k0 + 64 + cc); }
      }
#pragma unroll
      for (int i = 0; i < 8; ++i) {
        int c = tid + i * 256, r = c >> 3, cc = (c & 7) * 8;
        { int gn = n0 + r; gn = gn < N ? gn : N - 1; rb[i] = *(const u32x4*)(Bt + (size_t)gn * ldb + k0 + 64 + cc); }
      }
    }
#pragma unroll 2
    for (int kk = 0; kk < 4; ++kk) {
      bf16x8 a[2], b[4];
      const int ko = kk * 16 + 8 * (lane >> 5);
#pragma unroll
      for (int i = 0; i < 2; ++i) a[i] = *(const bf16x8*)(sA + (wm + i * 32 + (lane & 31)) * LS + ko);
#pragma unroll
      for (int j = 0; j < 4; ++j) b[j] = *(const bf16x8*)(sB + (wn + j * 32 + (lane & 31)) * LS + ko);
#pragma unroll
      for (int i = 0; i < 2; ++i)
#pragma unroll
        for (int j = 0; j < 4; ++j) acc[i][j] = mfma32(a[i], b[j], acc[i][j]);
    }
  }
  {
    int tl_ = threadIdx.x; OPAQUE(tl_);
    const int lane = tl_ & 63;
#pragma unroll
    for (int i = 0; i < 2; ++i)
#pragma unroll
      for (int j = 0; j < 4; ++j)
#pragma unroll
        for (int r = 0; r < 16; ++r) {
          int row = m0 + wm + i * 32 + acc_row(r, lane);
          int col = n0 + wn + j * 32 + (lane & 31);
          if (row < M && col < N) epi(row, col, acc[i][j][r]);
        }
  }
}

DEV void transpose_tile(const float* __restrict__ src, int ld_src, bf16_t* __restrict__ dst, int ld_dst, int K, int N,
                        int tk, int tn, unsigned char* smem) {
  float* sT = (float*)smem;
  const int tid = threadIdx.x;
  __syncthreads();
  {
    const int tx = tid & 15, ty = tid >> 4;
#pragma unroll
    for (int p = 0; p < 4; ++p) {
      int k = tk * 64 + ty + p * 16, n = tn * 64 + tx * 4;
#pragma unroll
      for (int j = 0; j < 4; ++j) {
        float v = (k < K && n + j < N) ? src[(size_t)k * ld_src + n + j] : 0.f;
        sT[(ty + p * 16) * 65 + tx * 4 + j] = v;
      }
    }
  }
  __syncthreads();
  {
    const int n = tid >> 2, kseg = (tid & 3) * 16;
    int gn = tn * 64 + n;
    if (gn < N) {
      float v[16];
#pragma unroll
      for (int j = 0; j < 16; ++j) v[j] = sT[(kseg + j) * 65 + n];
      bf16_t* d = dst + (size_t)gn * ld_dst + tk * 64 + kseg;
      *(u32x4*)d = pack8(v);
      *(u32x4*)(d + 8) = pack8(v + 8);
    }
  }
}

constexpr int TJ0 = 16 * 49, TJ1 = 16 * 16, TJ2 = 16 * 44, TJ3 = 16 * 16, TJ4 = 2 * 16 * 32, TJ5 = 2 * 8, TJ6 = 2 * 8,
              TJ7 = 2 * 8, TJ8 = 32;
constexpr int NTRANS = TJ0 + TJ1 + TJ2 + TJ3 + TJ4 + TJ5 + TJ6 + TJ7 + TJ8;
constexpr int NKEYCV = (2 * 8 * 2 * 128 * 128) / (256 * 8);
constexpr int NMODV = 2 * 96;
constexpr int NPREP = NTRANS + NKEYCV + NMODV;

DEV void st_prep(const Params& P, int item, unsigned char* smem) {
  unsigned char* ws = P.ws;
  if (item < NTRANS) {
    int t = item;
    if (t < TJ0) { transpose_tile(P.in[I_EVWIN], EVC, (bf16_t*)(ws + OFF_WEVIN), 1024, 1024, EVC, t / 49, t % 49, smem); return; }
    t -= TJ0;
    if (t < TJ1) { transpose_tile(P.in[I_EVWOUT], 1024, (bf16_t*)(ws + OFF_WEVOUT), 1024, 1024, 1024, t / 16, t % 16, smem); return; }
    t -= TJ1;
    if (t < TJ2) { transpose_tile(P.in[I_ODWIN], ODC, (bf16_t*)(ws + OFF_WODIN), 1024, 1024, ODC, t / 44, t % 44, smem); return; }
    t -= TJ2;
    if (t < TJ3) { transpose_tile(P.in[I_ODWOUT], 1024, (bf16_t*)(ws + OFF_WODOUT), 1024, 1024, 1024, t / 16, t % 16, smem); return; }
    t -= TJ3;
    if (t < TJ4) {
      int l = t / 512, tt = t % 512;
      transpose_tile(P.in[I_WQ] + (size_t)l * 1024 * 2048, 2048, (bf16_t*)(ws + OFF_WQ) + (size_t)l * 2048 * 1024, 1024, 1024, 2048, tt / 32, tt % 32, smem);
      return;
    }
    t -= TJ4;
    if (t < TJ5) { int d = t / 8; transpose_tile(P.in[I_WUP] + d * 64 * 512, 512, (bf16_t*)(ws + OFF_WUP) + d * 512 * 64, 64, 64, 512, 0, t % 8, smem); return; }
    t -= TJ5;
    if (t < TJ6) { int d = t / 8; transpose_tile(P.in[I_AUP] + d * 64 * 512, 512, (bf16_t*)(ws + OFF_AUP) + d * 512 * 64, 64, 64, 512, 0, t % 8, smem); return; }
    t -= TJ6;
    if (t < TJ7) { transpose_tile(P.in[I_GUP], 512, (bf16_t*)(ws + OFF_GUP), 128, 128, 512, t / 8, t % 8, smem); return; }
    t -= TJ7;
    {
      int which = t & 1, db = t >> 1;
      const float* src = (which ? P.in[I_WI] : P.in[I_WA]) + (size_t)db * 64 * 64;
      transpose_tile(src, 64, (bf16_t*)(ws + OFF_LRUT) + (size_t)db * 128 * 64 + which * 64 * 64, 64, 64, 64, 0, 0, smem);
      return;
    }
  }
  item -= NTRANS;
  if (item < NKEYCV) {
    size_t e = ((size_t)item * 256 + threadIdx.x) * 8;
    const float* s = P.in[I_KEYS] + e;
    f32x4 a = *(const f32x4*)s, b = *(const f32x4*)(s + 4);
    float v[8] = {a.x, a.y, a.z, a.w, b.x, b.y, b.z, b.w};
    *(u32x4*)((bf16_t*)(ws + OFF_KEYS) + e) = pack8(v);
    return;
  }
  item -= NKEYCV;
  {
    const int l = item / 96, cgp = item % 96;
    float* sS = (float*)smem;
    float* sRed = sS + 3 * 1024;
    const int tid = threadIdx.x;
    __syncthreads();
    for (int i = tid; i < 3 * 1024; i += 256) {
      int m = i >> 10, k = i & 1023;
      float c = m < 2 ? P.in[I_C][m * 1024 + k] : P.in[I_CCTX][k];
      sS[i] = siluf_(c);
    }
    __syncthreads();
    const int ks = tid >> 6, col = cgp * 64 + (tid & 63);
    const float* w = P.in[I_MODW] + (size_t)l * 1024 * 6144 + col;
    float a0 = 0.f, a1 = 0.f, a2 = 0.f;
    for (int k = ks * 256; k < ks * 256 + 256; ++k) {
      float wv = w[(size_t)k * 6144];
      a0 += sS[k] * wv; a1 += sS[1024 + k] * wv; a2 += sS[2048 + k] * wv;
    }
    sRed[(ks * 3 + 0) * 64 + (tid & 63)] = a0;
    sRed[(ks * 3 + 1) * 64 + (tid & 63)] = a1;
    sRed[(ks * 3 + 2) * 64 + (tid & 63)] = a2;
    __syncthreads();
    if (tid < 192) {
      int m = tid >> 6, c = tid & 63;
      float s = sRed[(0 * 3 + m) * 64 + c] + sRed[(1 * 3 + m) * 64 + c] + sRed[(2 * 3 + m) * 64 + c] + sRed[(3 * 3 + m) * 64 + c];
      int cc = cgp * 64 + c;
      ((float*)(ws + OFF_MODV))[((size_t)l * 3 + m) * 6144 + cc] = s + P.in[I_MODB][l * 6144 + cc];
    }
  }
}

constexpr int NPCONV = 2 * (NEXP * 1024 / (256 * 16));
DEV void st_peer_conv(const Params& P, int layer, int item) {
  const int half = NPCONV / 2;
  int which = item >= half;
  int it = which ? item - half : item;
  size_t e = ((size_t)it * 256 + threadIdx.x) * 16;
  const float* s = (which ? P.in[I_PV] : P.in[I_PU]) + (size_t)layer * NEXP * 1024 + e;
  const float sc = which ? PEER_VSCALE : PEER_USCALE;
  u32x4 o;
  f32x4 a = *(const f32x4*)s; o.x = pack4_fp8(a.x * sc, a.y * sc, a.z * sc, a.w * sc);
  a = *(const f32x4*)(s + 4); o.y = pack4_fp8(a.x * sc, a.y * sc, a.z * sc, a.w * sc);
  a = *(const f32x4*)(s + 8); o.z = pack4_fp8(a.x * sc, a.y * sc, a.z * sc, a.w * sc);
  a = *(const f32x4*)(s + 12); o.w = pack4_fp8(a.x * sc, a.y * sc, a.z * sc, a.w * sc);
  const size_t ex = e >> 10, col = e & 1023;
  *(u32x4*)(P.ws + OFF_PU + ex * 2048 + (which ? 1024 : 0) + col) = o;
}

DEV void st_normmod(const Params& P, int layer, int which, int row) {
  const int lane = threadIdx.x & 63;
  const float* src;
  if (which == 0 && layer == 0) src = row < NCTX ? P.in[I_CTX] + (size_t)row * 1024 : P.in[I_X] + (size_t)(row - NCTX) * 1024;
  else src = row < NCTX ? (const float*)(P.ws + OFF_CTXRES) + (size_t)row * 1024 : P.out + (size_t)(row - NCTX) * 1024;
  const float* mv = (const float*)(P.ws + OFF_MODV) + ((size_t)layer * 3 + mod_row(row)) * 6144;
  const float* sh = mv + (which ? 3 : 0) * 1024;
  const float* sc = mv + (which ? 4 : 1) * 1024;
  const float* nw = (which ? P.in[I_NORM2] : P.in[I_NORM1]) + layer * 1024;
  f32x4 v[4];
  float ss = 0.f;
#pragma unroll
  for (int i = 0; i < 4; ++i) {
    v[i] = *(const f32x4*)(src + i * 256 + lane * 4);
    ss += v[i].x * v[i].x + v[i].y * v[i].y + v[i].z * v[i].z + v[i].w * v[i].w;
  }
  ss = wave_sum(ss);
  const float rstd = frsq(ss * (1.f / 1024.f) + 1e-6f);
  bf16_t* dst = (bf16_t*)(P.ws + OFF_HBUF) + (size_t)row * 1024;
#pragma unroll
  for (int i = 0; i < 4; ++i) {
    int c = i * 256 + lane * 4;
    f32x4 w4 = *(const f32x4*)(nw + c), s4 = *(const f32x4*)(sc + c), h4 = *(const f32x4*)(sh + c);
    float o0 = v[i].x * rstd * w4.x * (1.f + s4.x) + h4.x;
    float o1 = v[i].y * rstd * w4.y * (1.f + s4.y) + h4.y;
    float o2 = v[i].z * rstd * w4.z * (1.f + s4.z) + h4.z;
    float o3 = v[i].w * rstd * w4.w * (1.f + s4.w) + h4.w;
    u32x2 pk; pk.x = pack2(o0, o1); pk.y = pack2(o2, o3);
    *(u32x2*)(dst + c) = pk;
  }
}

struct EpiProjL0 {
  bf16_t* proj; float* gates;
  DEVM void operator()(int row, int col, float v) const {
    proj[(size_t)row * EVC + col] = f2bf(v);
    if (col >= 1536 && col < 1552) gates[row * 32 + (col - 1536)] = v;
    else if (col >= 3088) gates[row * 32 + 16 + (col - 3088)] = v;
  }
};
struct EpiStoreBf {
  bf16_t* dst; int ld;
  DEVM void operator()(int row, int col, float v) const { dst[(size_t)row * ld + col] = f2bf(v); }
};
struct EpiStoreBfBias {
  bf16_t* dst; int ld; const float* bias;
  DEVM void operator()(int row, int col, float v) const { dst[(size_t)row * ld + col] = f2bf(v + (bias ? bias[col] : 0.f)); }
};
struct EpiOutProj {
  const float* x_lat; const float* x_ctx; float* o_lat; float* o_ctx; const float* modv;
  DEVM void operator()(int row, int col, float v) const {
    float g = modv[mod_row(row) * 6144 + 2 * 1024 + col];
    if (row < NCTX) o_ctx[(size_t)row * 1024 + col] = x_ctx[(size_t)row * 1024 + col] + g * v;
    else { size_t o = (size_t)(row - NCTX) * 1024 + col; o_lat[o] = x_lat[o] + g * v; }
  }
};
struct EpiScoreLds {
  float* sS; int m0;
  DEVM void operator()(int row, int col, float v) const { sS[(row - m0) * 129 + col] = v; }
};

DEV void st_xbc_conv(const Params& P, int row) {
  const int lane = threadIdx.x & 63;
  const bf16_t* proj = (const bf16_t*)(P.ws + OFF_PROJ);
  bf16_t* xc = (bf16_t*)P.out + (size_t)row * 1024;
  int row0, len, pos;
  if (row < NCTX) { row0 = (row / CTXL) * CTXL; len = CTXL; pos = row - row0; }
  else { int r = row - NCTX; row0 = NCTX + (r / SEQ) * SEQ; len = SEQ; pos = r % SEQ; }
  const float* cw = P.in[I_SCONVW];
  const float* cb = P.in[I_SCONVB];
#pragma unroll
  for (int hh = 0; hh < 2; ++hh) {
    const int ch = hh * 512 + lane * 8;
    float o[8];
#pragma unroll
    for (int j = 0; j < 8; ++j) o[j] = cb[ch + j];
#pragma unroll
    for (int tap = 0; tap < 4; ++tap) {
      int pp = pos + tap - 2;
      if (pp >= 0 && pp < len) {
        float x[8];
        unpack8(*(const u32x4*)(proj + (size_t)(row0 + pp) * EVC + 2064 + ch), x);
        f32x4 w0 = *(const f32x4*)(cw + tap * 1024 + ch), w1 = *(const f32x4*)(cw + tap * 1024 + ch + 4);
        o[0] += w0.x * x[0]; o[1] += w0.y * x[1]; o[2] += w0.z * x[2]; o[3] += w0.w * x[3];
        o[4] += w1.x * x[4]; o[5] += w1.y * x[5]; o[6] += w1.z * x[6]; o[7] += w1.w * x[7];
      }
    }
#pragma unroll
    for (int j = 0; j < 8; ++j) o[j] = siluf_(o[j]);
    *(u32x4*)(xc + ch) = pack8(o);
  }
}

#ifndef LA_NSEG
#define LA_NSEG 10
#endif
constexpr int LA_NCH = (CTXL + SEQ) / 64;
constexpr int LA_CPS = LA_NCH / LA_NSEG;
static_assert(LA_NCH % LA_NSEG == 0, "linattn segments");
#ifdef CPU_EMU
constexpr size_t OFF_LASEG = OFF_PR + PR_BYTES;
#else
constexpr size_t OFF_LASEG = OFF_R2L0 + (size_t)NTOK * 1024 * 2;
#endif
constexpr size_t LASEG_U = (size_t)48 * LA_NSEG * 8192 * 4;
constexpr size_t OFF_LASEG_N = OFF_LASEG + LASEG_U;
constexpr size_t OFF_LASEG_D = OFF_LASEG_N + (size_t)48 * LA_NSEG * 64 * 4;
#ifndef CPU_EMU
static_assert(OFF_LASEG_D + 48 * LA_NSEG * 4 <= OFF_PR + PR_BYTES, "laseg");
#endif

struct LaRaw { u32x4 q[2], k[4], x[4]; float g0, g1; };

template <bool MLSTM, bool FULL>
DEV void la_load_raw(const Params& P, int b, int h, int d, int cc, LaRaw& R) {
  constexpr int NC_CTX = CTXL / 64;
  const int tid = threadIdx.x;
  const int seg = cc >= NC_CTX;
  const int row0 = seg ? NCTX + b * SEQ : b * CTXL;
  const int len = seg ? SEQ : CTXL;
  const int cl = (seg ? cc - NC_CTX : cc) * 64;
  const bf16_t* proj = (const bf16_t*)(P.ws + OFF_PROJ);
  const bf16_t* xcv = (const bf16_t*)P.out;
  const float* gates = (const float*)(P.ws + OFF_GATES);
  if (tid < 64) {
    int p = cl + tid, grow = row0 + (d ? len - 1 - p : p);
    if (MLSTM) { R.g0 = gates[grow * 32 + d * 4 + h]; R.g1 = gates[grow * 32 + 8 + d * 4 + h]; }
    else { R.g0 = gates[grow * 32 + 16 + d * 8 + h]; R.g1 = 0.f; }
  }
  if (MLSTM) {
#pragma unroll
    for (int i = 0; i < 2; ++i) {
      int c = tid + i * 256, r = c >> 3, cc8 = (c & 7) * 8;
      int p = cl + r, pos = d ? len - 1 - p : p;
      const bf16_t* rp = proj + (size_t)(row0 + pos) * EVC;
      if (FULL) R.q[i] = *(const u32x4*)(rp + h * 64 + cc8);
      R.k[i] = *(const u32x4*)(rp + 256 + h * 64 + cc8);
    }
#pragma unroll
    for (int i = 0; i < 4; ++i) {
      int c = tid + i * 256, r = c >> 4, cc8 = (c & 15) * 8;
      int p = cl + r, pos = d ? len - 1 - p : p;
      R.x[i] = *(const u32x4*)(proj + (size_t)(row0 + pos) * EVC + 512 + h * 128 + cc8);
    }
  } else {
    const int grp = h >> 2;
#pragma unroll
    for (int i = 0; i < 2; ++i) {
      int c = tid + i * 256, r = c >> 3, cc8 = (c & 7) * 8;
      int p = cl + r, pos = d ? len - 1 - p : p;
      R.x[i] = *(const u32x4*)(xcv + (size_t)(row0 + pos) * 1024 + h * 64 + cc8);
    }
#pragma unroll
    for (int i = 0; i < 4; ++i) {
      int c = tid + i * 256, r = c >> 4, cc8 = (c & 15) * 8;
      int p = cl + r, pos = d ? len - 1 - p : p;
      const bf16_t* rp = xcv + (size_t)(row0 + pos) * 1024;
      R.k[i] = *(const u32x4*)(rp + 512 + grp * 128 + cc8);
      if (FULL) { if (i < 2) R.q[i] = *(const u32x4*)(rp + 768 + grp * 128 + cc8); else R.x[i] = *(const u32x4*)(rp + 768 + grp * 128 + cc8); }
    }
  }
}

template <bool MLSTM, bool FULL>
DEV void st_linattn_seg(const Params& P, int sid, int seg, unsigned char* smem) {
  constexpr int DK = MLSTM ? 64 : 128, DX = MLSTM ? 128 : 64;
  constexpr int QS = DK + 8;
  constexpr int NH = MLSTM ? 4 : 8;
  constexpr int NC_CTX = CTXL / 64;
  const int tid = threadIdx.x, lane = tid & 63, wave = tid >> 6;
  const int d = sid & 1, h = (sid >> 1) % NH, b = (sid >> 1) / NH;
  const int gsid = MLSTM ? sid : 16 + sid;
  bf16_t* sQ = (bf16_t*)smem;
  bf16_t* sK = sQ + 64 * QS;
  bf16_t* sP = sK;
  bf16_t* sKT = sK + 64 * QS;
  bf16_t* sXT = sKT + DK * 72;
  bf16_t* sST = sXT + DX * 72;
  float* sF = (float*)(sST + DX * QS);
  float* sLa = sF;
  float* sG = sF + 64;
  float* sBc = sF + 128;
  float* sDen = sF + 192;
  float* sN = sF + 256;
  int* sRow = (int*)(sF + 384);
  static_assert((64 * QS * 2 + DK * 72 + DX * 72 + DX * QS) * 2 + 448 * 4 <= SMEM_BYTES, "lds");
  bf16_t* outb = MLSTM ? (bf16_t*)(P.ws + OFF_HBUF) : (bf16_t*)(P.ws + OFF_R2L0);
  float* segU = (float*)(P.ws + OFF_LASEG);
  float* segN = (float*)(P.ws + OFF_LASEG_N);
  float* segD = (float*)(P.ws + OFF_LASEG_D);

  f32x16 accS[2];
#pragma unroll
  for (int j = 0; j < 2; ++j)
#pragma unroll
    for (int r = 0; r < 16; ++r) accS[j][r] = 0.f;
  const int sx0 = MLSTM ? wave * 32 : (wave >> 1) * 32;
  const int sk0 = MLSTM ? 0 : (wave & 1) * 64;
  float nreg = 0.f;
  float gb0 = 0.f, gb1 = 0.f, alog_e = 0.f, dskip = 0.f;
  if (MLSTM) { gb0 = P.in[I_IBIAS][d * 4 + h]; gb1 = P.in[I_FBIAS][d * 4 + h]; }
  else { gb0 = P.in[I_DTBIAS][d * 8 + h]; alog_e = fexp(P.in[I_ALOG][d * 8 + h]); dskip = P.in[I_DSKIP][h]; }

  const int cc0 = seg * LA_CPS, cc1 = cc0 + LA_CPS;
  LaRaw R;
  la_load_raw<MLSTM, FULL>(P, b, h, d, cc0, R);
  __syncthreads();
  if (FULL) {
    for (int js = 0; js < seg; ++js) {
      const size_t it = (size_t)gsid * LA_NSEG + js;
      const float a = fexp(segD[it]);
      const float* U = segU + it * 8192;
#pragma unroll
      for (int j = 0; j < 2; ++j)
#pragma unroll
        for (int r = 0; r < 16; ++r) accS[j][r] = a * accS[j][r] + U[(j * 16 + r) * 256 + tid];
      if (MLSTM && tid < 64) nreg = a * nreg + segN[it * 64 + tid];
    }
#pragma unroll
    for (int j = 0; j < 2; ++j)
#pragma unroll
      for (int r = 0; r < 16; ++r) sST[(sx0 + acc_row(r, lane)) * QS + sk0 + j * 32 + (lane & 31)] = f2bf(accS[j][r]);
    if (tid < 128) sN[tid] = (MLSTM && tid < 64) ? nreg : 0.f;
  }
  float lsum = 0.f;

  for (int cc = cc0; cc < cc1; ++cc) {
    int tl_ = threadIdx.x; OPAQUE(tl_);
    const int tid = tl_, lane = tl_ & 63;
    const int sgi = cc >= NC_CTX;
    const int row0 = sgi ? NCTX + b * SEQ : b * CTXL;
    const int len = sgi ? SEQ : CTXL;
    const int cl = (sgi ? cc - NC_CTX : cc) * 64;
    if (tid < 64) {
      int p = cl + tid;
      sRow[tid] = row0 + (d ? len - 1 - p : p);
      if (MLSTM) { sLa[tid] = -softplusf_(-(R.g1 + gb1)); sG[tid] = fexp(R.g0 + gb0); }
      else { float dt = softplusf_(R.g0 + gb0); sLa[tid] = -dt * alog_e; sG[tid] = dt; }
    }
    __syncthreads();
    if (wave == 0) {
      float v = sLa[lane];
#pragma unroll
      for (int off = 1; off < 64; off <<= 1) {
#ifdef CPU_EMU
        float o = emu_shfl_up(v, off);
#else
        float o = __shfl_up(v, off, 64);
#endif
        if (lane >= off) v += o;
      }
      sBc[lane] = v;
    }
    __syncthreads();
    const float blast = sBc[63];
    lsum += blast;
    if (MLSTM) {
#pragma unroll
      for (int i = 0; i < 2; ++i) {
        int c = tid + i * 256, r = c >> 3, cc8 = (c & 7) * 8;
        float kf[8]; unpack8(R.k[i], kf);
        const float wgt = fexp(blast - sBc[r]) * sG[r];
#pragma unroll
        for (int j = 0; j < 8; ++j) sKT[(cc8 + j) * 72 + r] = f2bf(kf[j] * wgt);
        if (FULL) {
          float qf[8]; unpack8(R.q[i], qf);
#pragma unroll
          for (int j = 0; j < 8; ++j) qf[j] *= 0.125f;
          *(u32x4*)(sQ + r * QS + cc8) = pack8(qf);
          *(u32x4*)(sK + r * QS + cc8) = R.k[i];
        }
      }
#pragma unroll
      for (int i = 0; i < 4; ++i) {
        int c = tid + i * 256, r = c >> 4, cc8 = (c & 15) * 8;
        const bf16_t* xs = (const bf16_t*)&R.x[i];
#pragma unroll
        for (int j = 0; j < 8; ++j) sXT[(cc8 + j) * 72 + r] = xs[j];
      }
    } else {
#pragma unroll
      for (int i = 0; i < 2; ++i) {
        int c = tid + i * 256, r = c >> 3, cc8 = (c & 7) * 8;
        const bf16_t* xs = (const bf16_t*)&R.x[i];
#pragma unroll
        for (int j = 0; j < 8; ++j) sXT[(cc8 + j) * 72 + r] = xs[j];
      }
#pragma unroll
      for (int i = 0; i < 4; ++i) {
        int c = tid + i * 256, r = c >> 4, cc8 = (c & 15) * 8;
        float kf[8]; unpack8(R.k[i], kf);
        const float wgt = fexp(blast - sBc[r]) * sG[r];
#pragma unroll
        for (int j = 0; j < 8; ++j) sKT[(cc8 + j) * 72 + r] = f2bf(kf[j] * wgt);
        if (FULL) {
          *(u32x4*)(sK + r * QS + cc8) = R.k[i];
          *(u32x4*)(sQ + r * QS + cc8) = i < 2 ? R.q[i] : R.x[i];
        }
      }
    }
    if (cc + 1 < cc1) la_load_raw<MLSTM, FULL>(P, b, h, d, cc + 1, R);
    __syncthreads();
    if (FULL) {
      const int tr = (wave >> 1) * 32, tc = (wave & 1) * 32;
      f32x16 accP;
#pragma unroll
      for (int r = 0; r < 16; ++r) accP[r] = 0.f;
      if (!(tr == 0 && tc == 32)) {
#pragma unroll
        for (int kk = 0; kk < DK / 16; ++kk) {
          const int ko = kk * 16 + 8 * (lane >> 5);
          bf16x8 a = *(const bf16x8*)(sQ + (tr + (lane & 31)) * QS + ko);
          bf16x8 bb = *(const bf16x8*)(sK + (tc + (lane & 31)) * QS + ko);
          accP = mfma32(a, bb, accP);
        }
      }
      __syncthreads();
      {
        const int s = tc + (lane & 31);
        const float bs = sBc[s], gs = sG[s];
#pragma unroll
        for (int r = 0; r < 16; ++r) {
          int t = tr + acc_row(r, lane);
          float v = (s <= t) ? accP[r] * fexp(sBc[t] - bs) * gs : 0.f;
          sP[t * 72 + s] = f2bf(v);
        }
        for (int i = tid; i < 64 * DK; i += 256) {
          int t = i / DK, k = i % DK;
          sQ[t * QS + k] = f2bf(bf2f(sQ[t * QS + k]) * fexp(sBc[t]));
        }
      }
      __syncthreads();
      constexpr int NYT = MLSTM ? 2 : 1;
      const int yc0 = MLSTM ? (wave & 1) * 64 : (wave & 1) * 32;
      f32x16 accY[NYT];
#pragma unroll
      for (int j = 0; j < NYT; ++j)
#pragma unroll
        for (int r = 0; r < 16; ++r) accY[j][r] = 0.f;
#pragma unroll
      for (int kk = 0; kk < 4; ++kk) {
        const int ko = kk * 16 + 8 * (lane >> 5);
        bf16x8 a = *(const bf16x8*)(sP + (tr + (lane & 31)) * 72 + ko);
#pragma unroll
        for (int j = 0; j < NYT; ++j) {
          bf16x8 bb = *(const bf16x8*)(sXT + (yc0 + j * 32 + (lane & 31)) * 72 + ko);
          accY[j] = mfma32(a, bb, accY[j]);
        }
      }
#pragma unroll
      for (int kk = 0; kk < DK / 16; ++kk) {
        const int ko = kk * 16 + 8 * (lane >> 5);
        bf16x8 a = *(const bf16x8*)(sQ + (tr + (lane & 31)) * QS + ko);
#pragma unroll
        for (int j = 0; j < NYT; ++j) {
          bf16x8 bb = *(const bf16x8*)(sST + (yc0 + j * 32 + (lane & 31)) * QS + ko);
          accY[j] = mfma32(a, bb, accY[j]);
        }
      }
      if (MLSTM) {
        if (tid < 64) {
          float den = 0.f, dq = 0.f;
#pragma unroll 8
          for (int s = 0; s < 64; ++s) den += bf2f(sP[tid * 72 + s]);
#pragma unroll 8
          for (int k = 0; k < DK; ++k) dq += sN[k] * bf2f(sQ[tid * QS + k]);
          sDen[tid] = den + dq;
        }
        __syncthreads();
      }
#pragma unroll
      for (int j = 0; j < NYT; ++j)
#pragma unroll
        for (int r = 0; r < 16; ++r) {
          int t = tr + acc_row(r, lane);
          int x = yc0 + j * 32 + (lane & 31);
          float v = accY[j][r];
          if (MLSTM) {
            v = v * frcp(fmaxf(fabsf(sDen[t]), 1.f));
            outb[(size_t)sRow[t] * 1024 + d * 512 + h * 128 + x] = f2bf(v);
          } else {
            if (d == 0) v += dskip * bf2f(sXT[x * 72 + t]);
            outb[(size_t)sRow[t] * 1024 + d * 512 + h * 64 + x] = f2bf(v);
          }
        }
      __syncthreads();
    }
    {
      const float eb = fexp(blast);
#pragma unroll
      for (int j = 0; j < 2; ++j)
#pragma unroll
        for (int r = 0; r < 16; ++r) accS[j][r] *= eb;
#pragma unroll
      for (int kk = 0; kk < 4; ++kk) {
        const int ko = kk * 16 + 8 * (lane >> 5);
        bf16x8 a = *(const bf16x8*)(sXT + (sx0 + (lane & 31)) * 72 + ko);
#pragma unroll
        for (int j = 0; j < 2; ++j) {
          bf16x8 bb = *(const bf16x8*)(sKT + (sk0 + j * 32 + (lane & 31)) * 72 + ko);
          accS[j] = mfma32(a, bb, accS[j]);
        }
      }
      if (FULL) {
#pragma unroll
        for (int j = 0; j < 2; ++j)
#pragma unroll
          for (int r = 0; r < 16; ++r) sST[(sx0 + acc_row(r, lane)) * QS + sk0 + j * 32 + (lane & 31)] = f2bf(accS[j][r]);
      }
      if (MLSTM && tid < 64) {
        float nn = nreg * eb;
        for (int s = 0; s < 64; ++s) nn += bf2f(sKT[tid * 72 + s]);
        nreg = nn;
        if (FULL) sN[tid] = nn;
      }
    }
    __syncthreads();
  }
  if (!FULL) {
    const size_t it = (size_t)gsid * LA_NSEG + seg;
    float* U = segU + it * 8192;
#pragma unroll
    for (int j = 0; j < 2; ++j)
#pragma unroll
      for (int r = 0; r < 16; ++r) U[(j * 16 + r) * 256 + tid] = accS[j][r];
    if (MLSTM && tid < 64) segN[it * 64 + tid] = nreg;
    if (tid == 0) segD[it] = lsum;
  }
}

DEV void st_finish_l0(const Params& P, int row) {
  const int lane = threadIdx.x & 63;
  bf16_t* hb = (bf16_t*)(P.ws + OFF_HBUF) + (size_t)row * 1024;
  const bf16_t* yb = (const bf16_t*)(P.ws + OFF_R2L0) + (size_t)row * 1024;
  const bf16_t* pr = (const bf16_t*)(P.ws + OFF_PROJ) + (size_t)row * EVC;
  const int ch = lane * 8;
  float h0[8], h1[8], o[8], f1[8];
  unpack8(*(const u32x4*)(hb + ch), h0);
  unpack8(*(const u32x4*)(hb + 512 + ch), h1);
  unpack8(*(const u32x4*)(pr + 1024 + ch), o);
  float ss = 0.f;
#pragma unroll
  for (int j = 0; j < 8; ++j) { h0[j] += h1[j]; ss += h0[j] * h0[j]; }
  ss += wshfl_xor(ss, 1); ss += wshfl_xor(ss, 2); ss += wshfl_xor(ss, 4); ss += wshfl_xor(ss, 8);
  float rstd = frsq(ss * (1.f / 128.f) + 1e-6f);
#pragma unroll
  for (int j = 0; j < 8; ++j) f1[j] = h0[j] * rstd * P.in[I_MNORM][ch + j] * sigmoidf_(o[j]);
  float y0[8], y1[8], z[8], f2[8];
  unpack8(*(const u32x4*)(yb + ch), y0);
  unpack8(*(const u32x4*)(yb + 512 + ch), y1);
  unpack8(*(const u32x4*)(pr + 1552 + ch), z);
  float s2 = 0.f;
#pragma unroll
  for (int j = 0; j < 8; ++j) { y0[j] = (y0[j] + y1[j]) * siluf_(z[j]); s2 += y0[j] * y0[j]; }
  s2 = wave_sum(s2);
  float rstd2 = frsq(s2 * (1.f / 512.f) + 1e-6f);
#pragma unroll
  for (int j = 0; j < 8; ++j) f2[j] = y0[j] * rstd2 * P.in[I_SNORM][ch + j];
  *(u32x4*)(hb + ch) = pack8(f1);
  *(u32x4*)(hb + 512 + ch) = pack8(f2);
}

DEV float mixval(const bf16_t* __restrict__ proj, int row, int c, const float* __restrict__ mu) {
  float self = bf2f(proj[(size_t)row * ODC + c]);
  int nrow = -1;
  if (row < NCTX) {
    int pos = row % CTXL;
    if (c < 896) { if (pos > 0) nrow = row - 1; }
    else { if (pos < CTXL - 1) nrow = row + 1; }
  } else {
    int pos = (row - NCTX) % SEQ;
    int gx = pos % GW, gy = pos / GW, q = c / 448;
    if (q == 0) { if (gx > 0) nrow = row - 1; }
    else if (q == 1) { if (gx < GW - 1) nrow = row + 1; }
    else if (q == 2) { if (gy > 0) nrow = row - GW; }
    else { if (gy < SEQ / GW - 1) nrow = row + GW; }
  }
  float nb = nrow >= 0 ? bf2f(proj[(size_t)nrow * ODC + c]) : 0.f;
  return self + mu[c] * (nb - self);
}

DEV void st_lora_act(const Params& P, int row) {
  const int lane = threadIdx.x & 63;
  const bf16_t* proj = (const bf16_t*)(P.ws + OFF_PROJ);
  bf16_t* hb = (bf16_t*)(P.ws + OFF_HBUF) + (size_t)row * 1024;
  float v[4];
#pragma unroll
  for (int j = 0; j < 4; ++j) {
    int c = lane * 4 + j;
    float x = mixval(proj, row, 1536 + c, P.in[I_MU]);
    v[j] = c < 64 ? tanhf_(x) : (c < 128 ? x : sigmoidf_(x));
  }
  u32x2 pk; pk.x = pack2(v[0], v[1]); pk.y = pack2(v[2], v[3]);
  *(u32x2*)(hb + lane * 4) = pk;
}

DEV void st_rwkv_stream(const Params& P, int sid, unsigned char* smem) {
  const int tid = threadIdx.x, lane = tid & 63, wave = tid >> 6;
  const int d = sid & 1, h = (sid >> 1) & 7, b = sid >> 4;
  float* sR = (float*)smem;
  float* sW = sR + 2048;
  float* sKk = sW + 2048;
  float* sV = sKk + 2048;
  float* sA = sV + 2048;
  float* sBb = sA + 2048;
  float* sY = sBb + 2048;
  int* sRow = (int*)(sY + 2048);
  const bf16_t* proj = (const bf16_t*)(P.ws + OFF_PROJ);
  const bf16_t* lora = (const bf16_t*)(P.ws + OFF_LORA);
  bf16_t* yout = (bf16_t*)(P.ws + OFF_HBUF);
  const float* mu = P.in[I_MU];
  const int vrow = tid >> 2, j4 = tid & 3;
  float S[16];
#pragma unroll
  for (int i = 0; i < 16; ++i) S[i] = 0.f;
  const float kkw = P.in[I_KK][h * 64 + lane], kaw = P.in[I_KA][h * 64 + lane];
  for (int seg = 0; seg < 2; ++seg) {
    const int row0 = seg == 0 ? b * CTXL : NCTX + b * SEQ;
    const int len = seg == 0 ? CTXL : SEQ;
    for (int it = 0; it < len / 32; ++it) {
      __syncthreads();
      for (int s = wave; s < 32; s += 4) {
        int p = it * 32 + s, pos = d ? len - 1 - p : p, row = row0 + pos;
        int c = h * 64 + lane;
        float r = mixval(proj, row, c, mu);
        float k = mixval(proj, row, 512 + c, mu);
        float v = mixval(proj, row, 1024 + c, mu);
        float kk = k * kkw;
        float ss = wave_sum(kk * kk);
        kk *= frsq(ss + 1e-12f);
        float lw = bf2f(lora[((size_t)d * NTOK + row) * 512 + c]);
        float la = bf2f(lora[((size_t)(2 + d) * NTOK + row) * 512 + c]);
        float w = fexp(-0.6065306597126334f * sigmoidf_(lw));
        float a = sigmoidf_(la);
        float kt = k * (1.f + (a - 1.f) * kaw);
        sR[s * 64 + lane] = r; sW[s * 64 + lane] = w; sKk[s * 64 + lane] = kt; sV[s * 64 + lane] = v;
        sA[s * 64 + lane] = -kk; sBb[s * 64 + lane] = kk * a;
        if (lane == 0) sRow[s] = row;
      }
      __syncthreads();
      for (int s = 0; s < 32; ++s) {
        const float* pa = sA + s * 64 + j4 * 16;
        const float* pw = sW + s * 64 + j4 * 16;
        const float* pk = sKk + s * 64 + j4 * 16;
        const float* pb = sBb + s * 64 + j4 * 16;
        const float* pr = sR + s * 64 + j4 * 16;
        const float vv = sV[s * 64 + vrow];
        float sa = 0.f;
#pragma unroll
        for (int i = 0; i < 16; ++i) sa += S[i] * pa[i];
        sa += wshfl_xor(sa, 1); sa += wshfl_xor(sa, 2);
        float y = 0.f;
#pragma unroll
        for (int i = 0; i < 16; ++i) { S[i] = S[i] * pw[i] + sa * pb[i] + vv * pk[i]; y += S[i] * pr[i]; }
        y += wshfl_xor(y, 1); y += wshfl_xor(y, 2);
        if (j4 == 0) sY[s * 64 + vrow] = y;
      }
      __syncthreads();
      for (int i = tid; i < 2048; i += 256) {
        int s = i >> 6, c = i & 63;
        yout[(size_t)sRow[s] * 1024 + d * 512 + h * 64 + c] = f2bf(sY[i]);
      }
    }
  }
}


DEV int nbr_row(int row, int c) {
  if (row < NCTX) {
    int pos = row % CTXL;
    if (c < 896) return pos > 0 ? row - 1 : -1;
    return pos < CTXL - 1 ? row + 1 : -1;
  }
  int pos = (row - NCTX) % SEQ;
  int gx = pos % GW, gy = pos / GW, q = c / 448;
  if (q == 0) return gx > 0 ? row - 1 : -1;
  if (q == 1) return gx < GW - 1 ? row + 1 : -1;
  if (q == 2) return gy > 0 ? row - GW : -1;
  return gy < SEQ / GW - 1 ? row + GW : -1;
}

struct RwkvRaw { u32x4 rs, rn, ks, kn, vs, vn, lw, la; int row; };

DEV void rwkv_load_raw(const bf16_t* __restrict__ proj, const bf16_t* __restrict__ lora, int b, int h, int d, int cc, int t, int c0,
                       RwkvRaw& R) {
  constexpr int NC_CTX = CTXL / 32;
  const int seg = cc >= NC_CTX;
  const int row0 = seg ? NCTX + b * SEQ : b * CTXL;
  const int len = seg ? SEQ : CTXL;
  const int p = (seg ? cc - NC_CTX : cc) * 32 + t;
  const int row = row0 + (d ? len - 1 - p : p);
  const int col = h * 64 + c0;
  const u32x4 z4 = {0u, 0u, 0u, 0u};
  const bf16_t* rp = proj + (size_t)row * ODC;
  R.row = row;
  R.rs = *(const u32x4*)(rp + col);
  R.ks = *(const u32x4*)(rp + 512 + col);
  R.vs = *(const u32x4*)(rp + 1024 + col);
  int n0 = nbr_row(row, col), n1 = nbr_row(row, 512 + col), n2 = nbr_row(row, 1024 + col);
  R.rn = n0 >= 0 ? *(const u32x4*)(proj + (size_t)n0 * ODC + col) : z4;
  R.kn = n1 >= 0 ? *(const u32x4*)(proj + (size_t)n1 * ODC + 512 + col) : z4;
  R.vn = n2 >= 0 ? *(const u32x4*)(proj + (size_t)n2 * ODC + 1024 + col) : z4;
  R.lw = *(const u32x4*)(lora + ((size_t)d * NTOK + row) * 512 + col);
  R.la = *(const u32x4*)(lora + ((size_t)(2 + d) * NTOK + row) * 512 + col);
}

#ifndef RW_NSEG
#define RW_NSEG 16
#endif
constexpr int RW_NCH = (CTXL + SEQ) / 32;
constexpr size_t OFF_RWSEG = OFF_PU;
static_assert((size_t)32 * RW_NSEG * 64 * 128 * 4 <= (size_t)2 * NEXP * 1024, "rwseg");

template <bool FULL>
DEV void st_rwkv_seg(const Params& P, int sid, int seg, unsigned char* smem) {
  constexpr int NVB = FULL ? 2 : 4;
  constexpr int ZR = FULL ? 64 : 128;
  const int tid = threadIdx.x, lane = tid & 63, wave = tid >> 6;
  const int d = sid & 1, h = (sid >> 1) & 7, b = sid >> 4;
  bf16_t* sAt = (bf16_t*)smem;
  bf16_t* sRt = sAt + 32 * 72;
  bf16_t* sBt = sRt + 32 * 72;
  bf16_t* sKt = sBt + 32 * 72;
  bf16_t* sBT = sKt + 32 * 72;
  bf16_t* sKT = sBT + 64 * 40;
  bf16_t* sVT = sKT + 64 * 40;
  bf16_t* sLak = sVT + 64 * 40;
  bf16_t* sM = sLak + 32 * 40;
  bf16_t* sLrb = sM + 32 * 40;
  bf16_t* sLrk = sLrb + 32 * 40;
  bf16_t* sZ = FULL ? sLrk + 32 * 40 : sLrb;
  bf16_t* after = sZ + ZR * 72;
  bf16_t* sRT = FULL ? after : nullptr;
  bf16_t* sSAT = FULL ? after + 64 * 40 : sRt;
  float* sLP = (float*)(FULL ? after + 2 * 64 * 40 : after);
  float* sLab = sLP + 32 * 64;
  float* sD = sLab + 32 * 33;
  float* sPT = sD + 768;
  int* sRow = (int*)(sPT + 64);
  if (!FULL) sRT = (bf16_t*)sLP;
  static_assert((4 * 32 * 72 + 3 * 64 * 40 + 4 * 32 * 40 + 2 * 64 * 40 + 64 * 72) * 2 + (32 * 64 + 32 * 33 + 768 + 64 + 32 + 320) * 4 + 16 <= SMEM_BYTES, "lds full");
  static_assert((4 * 32 * 72 + 3 * 64 * 40 + 2 * 32 * 40 + 128 * 72) * 2 + (32 * 64 + 32 * 33 + 768 + 64 + 32) * 4 <= SMEM_BYTES, "lds p1");
  static_assert(128 * 40 * 2 <= (32 * 64 + 32 * 33) * 4 && 128 * 40 <= 3 * 32 * 72, "alias");
  const bf16_t* proj = (const bf16_t*)(P.ws + OFF_PROJ);
  const bf16_t* lora = (const bf16_t*)(P.ws + OFF_LORA);
  bf16_t* yout = (bf16_t*)(P.ws + OFF_HBUF);
  float* segZ = (float*)(P.ws + OFF_RWSEG);
  const int t = tid >> 3, c0 = (tid & 7) * 8;
  const int hl = lane >> 5, l31 = lane & 31;
  float* sCst = (float*)(smem + SMEM_BYTES - 320 * 4 - 16);
  if (tid < 64) {
    sCst[tid] = P.in[I_MU][h * 64 + tid]; sCst[64 + tid] = P.in[I_MU][512 + h * 64 + tid]; sCst[128 + tid] = P.in[I_MU][1024 + h * 64 + tid];
    sCst[192 + tid] = P.in[I_KK][h * 64 + tid]; sCst[256 + tid] = P.in[I_KA][h * 64 + tid];
  }
  const int cc0 = (seg * RW_NCH) / RW_NSEG, cc1 = ((seg + 1) * RW_NCH) / RW_NSEG;
  RwkvRaw R;
  rwkv_load_raw(proj, lora, b, h, d, cc0, t, c0, R);
  f32x16 Zm[2];
#pragma unroll
  for (int j = 0; j < 2; ++j)
#pragma unroll
    for (int r = 0; r < 16; ++r) Zm[j][r] = 0.f;
  __syncthreads();
  for (int i = tid; i < ZR * 72; i += 256) sZ[i] = 0;
  __syncthreads();
  if (!FULL) {
    if (wave >= 2) {
#pragma unroll
      for (int cb = 0; cb < 2; ++cb)
#pragma unroll
        for (int r = 0; r < 16; ++r) {
          int c = cb * 32 + acc_row(r, lane), vp = wave * 32 + l31;
          if (c == vp - 64) { Zm[cb][r] = 1.f; sZ[vp * 72 + c] = 0x3f80; }
        }
    }
  } else {
    for (int js = 0; js < seg; ++js) {
      const float* Zs = segZ + ((size_t)sid * RW_NSEG + js) * 64 * 128;
      bf16_t* sG = sAt;
      for (int i = tid; i < 64 * 64; i += 256) { int c = i >> 6, c2 = i & 63; sG[c * 72 + c2] = f2bf(Zs[c * 128 + 64 + c2]); }
      __syncthreads();
      if (wave >= 2) {
        const int cb = wave - 2;
#pragma unroll
        for (int vb = 0; vb < 2; ++vb) {
          f32x16 acc;
#pragma unroll
          for (int r = 0; r < 16; ++r) acc[r] = Zs[(cb * 32 + acc_row(r, lane)) * 128 + vb * 32 + l31];
#pragma unroll
          for (int kk = 0; kk < 4; ++kk) {
            bf16x8 a = *(const bf16x8*)(sG + (cb * 32 + l31) * 72 + kk * 16 + 8 * hl);
            bf16x8 bb = *(const bf16x8*)(sZ + (vb * 32 + l31) * 72 + kk * 16 + 8 * hl);
            acc = mfma32(a, bb, acc);
          }
          Zm[vb] = acc;
        }
      }
      __syncthreads();
      if (wave >= 2) {
        const int cb = wave - 2;
#pragma unroll
        for (int vb = 0; vb < 2; ++vb)
#pragma unroll
          for (int g = 0; g < 4; ++g) {
            u32x2 pk; pk.x = pack2(Zm[vb][4 * g], Zm[vb][4 * g + 1]); pk.y = pack2(Zm[vb][4 * g + 2], Zm[vb][4 * g + 3]);
            *(u32x2*)(sZ + (vb * 32 + l31) * 72 + cb * 32 + 8 * g + 4 * hl) = pk;
          }
      }
      __syncthreads();
    }
  }
  for (int cc = cc0; cc < cc1; ++cc) {
    int tl_ = threadIdx.x; OPAQUE(tl_);
    const int tid = tl_, lane = tl_ & 63, hl = lane >> 5, l31 = lane & 31, t = tl_ >> 3, c0 = (tl_ & 7) * 8;
    const float* muR = sCst + c0; const float* muK = sCst + 64 + c0; const float* muV = sCst + 128 + c0;
    const float* kkw = sCst + 192 + c0; const float* kaw = sCst + 256 + c0;
    float lw8[8], lp8[8];
    {
      float lwf[8];
      unpack8(R.lw, lwf);
#pragma unroll
      for (int j = 0; j < 8; ++j) { lw8[j] = -0.6065306597126334f * sigmoidf_(lwf[j]); lp8[j] = lw8[j]; }
#pragma unroll
      for (int off = 8; off < 64; off <<= 1) {
#pragma unroll
        for (int j = 0; j < 8; ++j) {
#ifdef CPU_EMU
          float o = emu_shfl_up(lp8[j], off);
#else
          float o = __shfl_up(lp8[j], off, 64);
#endif
          if (lane >= off) lp8[j] += o;
        }
      }
      if (lane >= 56) {
#pragma unroll
        for (int j = 0; j < 8; ++j) sLP[wave * 64 + c0 + j] = lp8[j];
      }
      if ((tid & 7) == 0) sRow[t] = R.row;
    }
    __syncthreads();
    {
#pragma unroll
      for (int j = 0; j < 8; ++j) {
        float offs = 0.f;
        for (int w2 = 0; w2 < wave; ++w2) offs += sLP[w2 * 64 + c0 + j];
        lp8[j] += offs;
      }
      if (t == 31) {
#pragma unroll
        for (int j = 0; j < 8; ++j) sPT[c0 + j] = fexp(lp8[j]);
      }
    }
    {
      float xs[8], xn[8], kt[8], aa[8], ob[8], ok[8];
      unpack8(R.ks, xs); unpack8(R.kn, xn);
      float ss = 0.f;
#pragma unroll
      for (int j = 0; j < 8; ++j) { kt[j] = xs[j] + muK[j] * (xn[j] - xs[j]); aa[j] = kt[j] * kkw[j]; ss += aa[j] * aa[j]; }
      ss += wshfl_xor(ss, 1); ss += wshfl_xor(ss, 2); ss += wshfl_xor(ss, 4);
      const float rn = frsq(ss + 1e-12f);
      float laf[8];
      unpack8(R.la, laf);
#pragma unroll
      for (int j = 0; j < 8; ++j) {
        const float lp = lp8[j];
        const float lpm = lp8[j] - lw8[j];
        const float e = fexp(-lp);
        const float kkn = aa[j] * rn;
        const float asg = sigmoidf_(laf[j]);
        aa[j] = -kkn * fexp(lpm);
        ob[j] = kkn * asg * e;
        ok[j] = kt[j] * (1.f + (asg - 1.f) * kaw[j]) * e;
      }
      *(u32x4*)(sAt + t * 72 + c0) = pack8(aa);
      *(u32x4*)(sBt + t * 72 + c0) = pack8(ob);
      *(u32x4*)(sKt + t * 72 + c0) = pack8(ok);
#pragma unroll
      for (int j = 0; j < 8; ++j) { sBT[(c0 + j) * 40 + t] = f2bf(ob[j]); sKT[(c0 + j) * 40 + t] = f2bf(ok[j]); }
      unpack8(R.vs, xs); unpack8(R.vn, xn);
#pragma unroll
      for (int j = 0; j < 8; ++j) sVT[(c0 + j) * 40 + t] = f2bf(xs[j] + muV[j] * (xn[j] - xs[j]));
      if (FULL) {
        unpack8(R.rs, xs); unpack8(R.rn, xn);
#pragma unroll
        for (int j = 0; j < 8; ++j) xs[j] = (xs[j] + muR[j] * (xn[j] - xs[j])) * fexp(lp8[j]);
        *(u32x4*)(sRt + t * 72 + c0) = pack8(xs);
      }
    }
    if (cc + 1 < cc1) rwkv_load_raw(proj, lora, b, h, d, cc + 1, t, c0, R);
    __syncthreads();
    if (FULL || wave < 2) {
      const bf16_t* Asrc = wave < 2 ? sAt : sRt;
      const bf16_t* Bsrc = (wave & 1) ? sKt : sBt;
      f32x16 acc;
#pragma unroll
      for (int r = 0; r < 16; ++r) acc[r] = 0.f;
#pragma unroll
      for (int kk = 0; kk < 4; ++kk) {
        bf16x8 a = *(const bf16x8*)(Asrc + l31 * 72 + kk * 16 + 8 * hl);
        bf16x8 bb = *(const bf16x8*)(Bsrc + l31 * 72 + kk * 16 + 8 * hl);
        acc = mfma32(a, bb, acc);
      }
      bf16_t* dst = wave == 1 ? sLak : (wave == 2 ? sLrb : sLrk);
#pragma unroll
      for (int r = 0; r < 16; ++r) {
        int tt = acc_row(r, lane), j = l31;
        bool keep = wave < 2 ? (j < tt) : (j <= tt);
        float v = keep ? acc[r] : 0.f;
        if (wave == 0) sLab[tt * 33 + j] = v;
        else dst[tt * 40 + j] = f2bf(v);
      }
    }
    __syncthreads();
    if (tid < 32) {
      const int q = tid >> 4, c = tid & 15;
      float x[16];
#pragma unroll
      for (int i = 0; i < 16; ++i) {
        float sacc = (i == c) ? 1.f : 0.f;
#pragma unroll
        for (int j = 0; j < i; ++j) sacc += sLab[(q * 16 + i) * 33 + q * 16 + j] * x[j];
        x[i] = sacc;
        sD[q * 256 + i * 16 + c] = sacc;
      }
    }
    __syncthreads();
    {
      const int i = tid >> 4, c = tid & 15;
      float sacc = 0.f;
#pragma unroll
      for (int j = 0; j < 16; ++j) sacc += sLab[(16 + i) * 33 + j] * sD[j * 16 + c];
      sD[512 + i * 16 + c] = sacc;
    }
    __syncthreads();
    {
      const int i = tid >> 4, c = tid & 15;
      float sacc = 0.f;
#pragma unroll
      for (int j = 0; j < 16; ++j) sacc += sD[256 + i * 16 + j] * sD[512 + j * 16 + c];
      sM[(16 + i) * 40 + c] = f2bf(sacc);
      sM[i * 40 + c] = f2bf(sD[i * 16 + c]);
      sM[(16 + i) * 40 + 16 + c] = f2bf(sD[256 + i * 16 + c]);
      sM[i * 40 + 16 + c] = 0;
    }
    if (wave < NVB) {
      const int vb = wave;
      f32x16 acc;
#pragma unroll
      for (int r = 0; r < 16; ++r) acc[r] = 0.f;
#pragma unroll
      for (int kk = 0; kk < 4; ++kk) {
        bf16x8 a = *(const bf16x8*)(sAt + l31 * 72 + kk * 16 + 8 * hl);
        bf16x8 bb = *(const bf16x8*)(sZ + (vb * 32 + l31) * 72 + kk * 16 + 8 * hl);
        acc = mfma32(a, bb, acc);
      }
      if (vb < 2) {
#pragma unroll
        for (int kk = 0; kk < 2; ++kk) {
          bf16x8 a = *(const bf16x8*)(sLak + l31 * 40 + kk * 16 + 8 * hl);
          bf16x8 bb = *(const bf16x8*)(sVT + (vb * 32 + l31) * 40 + kk * 16 + 8 * hl);
          acc = mfma32(a, bb, acc);
        }
      }
#pragma unroll
      for (int g = 0; g < 4; ++g) {
        u32x2 pk; pk.x = pack2(acc[4 * g], acc[4 * g + 1]); pk.y = pack2(acc[4 * g + 2], acc[4 * g + 3]);
        *(u32x2*)(sRT + (vb * 32 + l31) * 40 + 8 * g + 4 * hl) = pk;
      }
    }
    __syncthreads();
    if (wave < NVB) {
      const int vb = wave;
      f32x16 acc;
#pragma unroll
      for (int r = 0; r < 16; ++r) acc[r] = 0.f;
#pragma unroll
      for (int kk = 0; kk < 2; ++kk) {
        bf16x8 a = *(const bf16x8*)(sM + l31 * 40 + kk * 16 + 8 * hl);
        bf16x8 bb = *(const bf16x8*)(sRT + (vb * 32 + l31) * 40 + kk * 16 + 8 * hl);
        acc = mfma32(a, bb, acc);
      }
#pragma unroll
      for (int g = 0; g < 4; ++g) {
        u32x2 pk; pk.x = pack2(acc[4 * g], acc[4 * g + 1]); pk.y = pack2(acc[4 * g + 2], acc[4 * g + 3]);
        *(u32x2*)(sSAT + (vb * 32 + l31) * 40 + 8 * g + 4 * hl) = pk;
      }
    }
    __syncthreads();
    if (FULL) {
      if (wave < 2) {
        const int vb = wave;
        f32x16 acc;
#pragma unroll
        for (int r = 0; r < 16; ++r) acc[r] = 0.f;
#pragma unroll
        for (int kk = 0; kk < 4; ++kk) {
          bf16x8 a = *(const bf16x8*)(sRt + l31 * 72 + kk * 16 + 8 * hl);
          bf16x8 bb = *(const bf16x8*)(sZ + (vb * 32 + l31) * 72 + kk * 16 + 8 * hl);
          acc = mfma32(a, bb, acc);
        }
#pragma unroll
        for (int kk = 0; kk < 2; ++kk) {
          bf16x8 a = *(const bf16x8*)(sLrb + l31 * 40 + kk * 16 + 8 * hl);
          bf16x8 bb = *(const bf16x8*)(sSAT + (vb * 32 + l31) * 40 + kk * 16 + 8 * hl);
          acc = mfma32(a, bb, acc);
        }
#pragma unroll
        for (int kk = 0; kk < 2; ++kk) {
          bf16x8 a = *(const bf16x8*)(sLrk + l31 * 40 + kk * 16 + 8 * hl);
          bf16x8 bb = *(const bf16x8*)(sVT + (vb * 32 + l31) * 40 + kk * 16 + 8 * hl);
          acc = mfma32(a, bb, acc);
        }
#pragma unroll
        for (int r = 0; r < 16; ++r) {
          int tt = acc_row(r, lane);
          yout[(size_t)sRow[tt] * 1024 + d * 512 + h * 64 + vb * 32 + l31] = f2bf(acc[r]);
        }
      } else {
        const int cb = wave - 2;
#pragma unroll
        for (int vb = 0; vb < 2; ++vb) {
          f32x16 acc;
#pragma unroll
          for (int r = 0; r < 16; ++r) acc[r] = 0.f;
#pragma unroll
          for (int kk = 0; kk < 2; ++kk) {
            bf16x8 a = *(const bf16x8*)(sBT + (cb * 32 + l31) * 40 + kk * 16 + 8 * hl);
            bf16x8 bb = *(const bf16x8*)(sSAT + (vb * 32 + l31) * 40 + kk * 16 + 8 * hl);
            acc = mfma32(a, bb, acc);
          }
#pragma unroll
          for (int kk = 0; kk < 2; ++kk) {
            bf16x8 a = *(const bf16x8*)(sKT + (cb * 32 + l31) * 40 + kk * 16 + 8 * hl);
            bf16x8 bb = *(const bf16x8*)(sVT + (vb * 32 + l31) * 40 + kk * 16 + 8 * hl);
            acc = mfma32(a, bb, acc);
          }
#pragma unroll
          for (int r = 0; r < 16; ++r) Zm[vb][r] = sPT[cb * 32 + acc_row(r, lane)] * (Zm[vb][r] + acc[r]);
        }
      }
      __syncthreads();
      if (wave >= 2) {
        const int cb = wave - 2;
#pragma unroll
        for (int vb = 0; vb < 2; ++vb)
#pragma unroll
          for (int g = 0; g < 4; ++g) {
            u32x2 pk; pk.x = pack2(Zm[vb][4 * g], Zm[vb][4 * g + 1]); pk.y = pack2(Zm[vb][4 * g + 2], Zm[vb][4 * g + 3]);
            *(u32x2*)(sZ + (vb * 32 + l31) * 72 + cb * 32 + 8 * g + 4 * hl) = pk;
          }
      }
    } else {
      const int vb = wave;
#pragma unroll
      for (int cb = 0; cb < 2; ++cb) {
        f32x16 acc;
#pragma unroll
        for (int r = 0; r < 16; ++r) acc[r] = 0.f;
#pragma unroll
        for (int kk = 0; kk < 2; ++kk) {
          bf16x8 a = *(const bf16x8*)(sBT + (cb * 32 + l31) * 40 + kk * 16 + 8 * hl);
          bf16x8 bb = *(const bf16x8*)(sSAT + (vb * 32 + l31) * 40 + kk * 16 + 8 * hl);
          acc = mfma32(a, bb, acc);
        }
        if (vb < 2) {
#pragma unroll
          for (int kk = 0; kk < 2; ++kk) {
            bf16x8 a = *(const bf16x8*)(sKT + (cb * 32 + l31) * 40 + kk * 16 + 8 * hl);
            bf16x8 bb = *(const bf16x8*)(sVT + (vb * 32 + l31) * 40 + kk * 16 + 8 * hl);
            acc = mfma32(a, bb, acc);
          }
        }
#pragma unroll
        for (int r = 0; r < 16; ++r) Zm[cb][r] = sPT[cb * 32 + acc_row(r, lane)] * (Zm[cb][r] + acc[r]);
      }
#pragma unroll
      for (int cb = 0; cb < 2; ++cb)
#pragma unroll
        for (int g = 0; g < 4; ++g) {
          u32x2 pk; pk.x = pack2(Zm[cb][4 * g], Zm[cb][4 * g + 1]); pk.y = pack2(Zm[cb][4 * g + 2], Zm[cb][4 * g + 3]);
          *(u32x2*)(sZ + (vb * 32 + l31) * 72 + cb * 32 + 8 * g + 4 * hl) = pk;
        }
    }
  }
  if (!FULL) {
    float* Zs = segZ + ((size_t)sid * RW_NSEG + seg) * 64 * 128;
#pragma unroll
    for (int cb = 0; cb < 2; ++cb)
#pragma unroll
      for (int r = 0; r < 16; ++r) Zs[(cb * 32 + acc_row(r, lane)) * 128 + wave * 32 + l31] = Zm[cb][r];
  }
}

constexpr int LRU_NCH = (CTXL + SEQ) / 64;
constexpr size_t OFF_ACUM0 = OFF_PU;
static_assert((size_t)NLAT * 512 * 2 <= (size_t)2 * NEXP * 1024, "acum0");

DEV void st_lru_chunk(const Params& P, int sid, int cc, unsigned char* smem) {
  constexpr int NC_CTX = CTXL / 64;
  const int tid = threadIdx.x, lane = tid & 63, wave = tid >> 6;
  const int d = sid & 1, blk = (sid >> 1) & 7, b = sid >> 4;
  float* sXc = (float*)smem;
  float* sAc = sXc + 4096;
  float* sBc = sAc + 4096;
  float* sU = sBc + 4096;
  bf16_t* sAop = (bf16_t*)(sU + 4096);
  float* sQA = (float*)(sAop + 64 * 72);
  float* sQH = sQA + 256;
  int* sRow = (int*)(sQH + 256);
  const bf16_t* proj = (const bf16_t*)(P.ws + OFF_PROJ);
  bf16_t* uout = (bf16_t*)(P.ws + OFF_LORA) + (size_t)d * NTOK * 512;
  bf16_t* aout = (bf16_t*)(P.ws + (d ? OFF_ACUM1 : OFF_ACUM0));
  const bf16_t* lruT = (const bf16_t*)(P.ws + OFF_LRUT) + (size_t)(d * 8 + blk) * 128 * 64;
  float* chunkS = (float*)(P.ws + OFF_LRUCS) + ((size_t)sid * LRU_NCH + cc) * 128;
  const float* cw = P.in[I_LCONVW];
  const float* cb = P.in[I_LCONVB];
  const int tr = (wave >> 1) * 32, nc0 = (wave & 1) * 64;
  const int sgi = cc >= NC_CTX;
  const int row0 = sgi ? NCTX + b * SEQ : b * CTXL;
  const int len = sgi ? SEQ : CTXL;
  const int cl = (sgi ? cc - NC_CTX : cc) * 64;
  __syncthreads();
  if (tid < 64) { int p = cl + tid; sRow[tid] = row0 + (d ? len - 1 - p : p); }
  {
    const int lc8 = (tid & 7) * 8, lch = blk * 64 + lc8;
#pragma unroll
    for (int i = 0; i < 2; ++i) {
      int c = tid + i * 256, r = c >> 3;
      int p = cl + r, pos = d ? len - 1 - p : p;
      float o[8];
      f32x4 c0 = *(const f32x4*)(cb + lch), c1 = *(const f32x4*)(cb + lch + 4);
      o[0] = c0.x; o[1] = c0.y; o[2] = c0.z; o[3] = c0.w; o[4] = c1.x; o[5] = c1.y; o[6] = c1.z; o[7] = c1.w;
#pragma unroll
      for (int tap = 0; tap < 4; ++tap) {
        int pp = pos + tap - 2;
        if (pp >= 0 && pp < len) {
          float x[8];
          unpack8(*(const u32x4*)(proj + (size_t)(row0 + pp) * ODC + 2304 + lch), x);
          f32x4 w0 = *(const f32x4*)(cw + tap * 512 + lch), w1 = *(const f32x4*)(cw + tap * 512 + lch + 4);
          o[0] += w0.x * x[0]; o[1] += w0.y * x[1]; o[2] += w0.z * x[2]; o[3] += w0.w * x[3];
          o[4] += w1.x * x[4]; o[5] += w1.y * x[5]; o[6] += w1.z * x[6]; o[7] += w1.w * x[7];
        }
      }
#pragma unroll
      for (int j = 0; j < 8; ++j) sXc[r * 64 + lc8 + j] = o[j];
      *(u32x4*)(sAop + r * 72 + lc8) = pack8(o);
    }
  }
  __syncthreads();
  {
    f32x16 acc[2];
#pragma unroll
    for (int j = 0; j < 2; ++j)
#pragma unroll
      for (int r = 0; r < 16; ++r) acc[j][r] = 0.f;
#pragma unroll
    for (int kk = 0; kk < 4; ++kk) {
      bf16x8 a = *(const bf16x8*)(sAop + (tr + (lane & 31)) * 72 + kk * 16 + 8 * (lane >> 5));
#pragma unroll
      for (int j = 0; j < 2; ++j) {
        bf16x8 bb = *(const bf16x8*)(lruT + (nc0 + j * 32 + (lane & 31)) * 64 + kk * 16 + 8 * (lane >> 5));
        acc[j] = mfma32(a, bb, acc[j]);
      }
    }
#pragma unroll
    for (int j = 0; j < 2; ++j) {
      const int e = nc0 + j * 32 + (lane & 31);
      const int ch = blk * 64 + (e & 63);
      const float ebias = e < 64 ? P.in[I_BA][d * 512 + ch] : P.in[I_BI][d * 512 + ch];
      const float esp = softplusf_(-P.in[I_LAM][d * 512 + ch]);
#pragma unroll
      for (int r = 0; r < 16; ++r) {
        int t = tr + acc_row(r, lane);
        float g = sigmoidf_(acc[j][r] + ebias);
        if (e < 64) { float a_ = fexp(-8.f * g * esp); sAc[t * 64 + e] = a_; sU[t * 64 + e] = fsqrt(fmaxf(1.f - a_ * a_, 0.f)); }
        else sBc[t * 64 + (e - 64)] = g * sXc[t * 64 + (e - 64)];
      }
    }
  }
  __syncthreads();
  const int c = tid & 63, q = tid >> 6;
  {
    float h = 0.f, ap = 1.f;
#pragma unroll 4
    for (int i = 0; i < 16; ++i) {
      const int t = q * 16 + i;
      const float a = sAc[t * 64 + c];
      h = a * h + sU[t * 64 + c] * sBc[t * 64 + c];
      ap *= a;
      sU[t * 64 + c] = h; sAc[t * 64 + c] = ap;
    }
    sQA[q * 64 + c] = ap; sQH[q * 64 + c] = h;
  }
  __syncthreads();
  {
    float hin = 0.f, ain = 1.f;
    for (int q2 = 0; q2 < q; ++q2) { hin = sQA[q2 * 64 + c] * hin + sQH[q2 * 64 + c]; ain *= sQA[q2 * 64 + c]; }
    if (q > 0) {
#pragma unroll 4
      for (int i = 0; i < 16; ++i) {
        const int t = q * 16 + i;
        const float ap = sAc[t * 64 + c];
        sU[t * 64 + c] += ap * hin;
        sAc[t * 64 + c] = ap * ain;
      }
    }
    if (q == 3) { chunkS[c] = sAc[63 * 64 + c]; chunkS[64 + c] = sU[63 * 64 + c]; }
  }
  __syncthreads();
  if (sgi) {
#pragma unroll
    for (int i = 0; i < 2; ++i) {
      int cidx = tid + i * 256, r = cidx >> 3, c8 = (cidx & 7) * 8;
      float u8[8], a8[8];
#pragma unroll
      for (int j = 0; j < 8; ++j) { u8[j] = sU[r * 64 + c8 + j]; a8[j] = sAc[r * 64 + c8 + j]; }
      const int row = sRow[r];
      *(u32x4*)(uout + (size_t)row * 512 + blk * 64 + c8) = pack8(u8);
      *(u32x4*)(aout + (size_t)(row - NCTX) * 512 + blk * 64 + c8) = pack8(a8);
    }
  }
}

DEV void st_lru_carry(const Params& P, int sid) {
  const int c = threadIdx.x;
  if (c >= 64) return;
  const float* cs = (const float*)(P.ws + OFF_LRUCS) + (size_t)sid * LRU_NCH * 128;
  float* hs = (float*)(P.ws + OFF_LRUHS) + (size_t)sid * LRU_NCH * 64;
  float h = 0.f;
  for (int cc0 = 0; cc0 < LRU_NCH; cc0 += 10) {
    float a[10], bb[10];
#pragma unroll
    for (int i = 0; i < 10; ++i) { a[i] = cs[(size_t)(cc0 + i) * 128 + c]; bb[i] = cs[(size_t)(cc0 + i) * 128 + 64 + c]; }
#pragma unroll
    for (int i = 0; i < 10; ++i) { hs[(size_t)(cc0 + i) * 64 + c] = h; h = a[i] * h + bb[i]; }
  }
}

DEV void st_finish_l1(const Params& P, int row) {
  const int lane = threadIdx.x & 63;
  bf16_t* hb = (bf16_t*)(P.ws + OFF_HBUF) + (size_t)row * 1024;
  const bf16_t* proj = (const bf16_t*)(P.ws + OFF_PROJ);
  const bf16_t* lora = (const bf16_t*)(P.ws + OFF_LORA);
  const float* mu = P.in[I_MU];
  const int ch = lane * 8;
  float y0[8], y1[8];
  unpack8(*(const u32x4*)(hb + ch), y0);
  unpack8(*(const u32x4*)(hb + 512 + ch), y1);
  float sm = 0.f;
#pragma unroll
  for (int j = 0; j < 8; ++j) { y0[j] += y1[j]; sm += y0[j]; }
  sm += wshfl_xor(sm, 1); sm += wshfl_xor(sm, 2); sm += wshfl_xor(sm, 4);
  const float mean = sm * (1.f / 64.f);
  float sv = 0.f;
#pragma unroll
  for (int j = 0; j < 8; ++j) { float dlt = y0[j] - mean; sv += dlt * dlt; }
  sv += wshfl_xor(sv, 1); sv += wshfl_xor(sv, 2); sv += wshfl_xor(sv, 4);
  const float rstd = frsq(sv * (1.f / 64.f) + 64e-5f);
  float a0[8], a1[8], g[8], u0[8], u1[8], gb[8];
  unpack8(*(const u32x4*)(lora + ((size_t)2 * NTOK + row) * 512 + ch), a0);
  unpack8(*(const u32x4*)(lora + ((size_t)3 * NTOK + row) * 512 + ch), a1);
  unpack8(*(const u32x4*)(lora + ((size_t)4 * NTOK + row) * 512 + ch), g);
  unpack8(*(const u32x4*)(lora + ((size_t)0 * NTOK + row) * 512 + ch), u0);
  unpack8(*(const u32x4*)(lora + ((size_t)1 * NTOK + row) * 512 + ch), u1);
  if (row >= NCTX) {
    const int bb_ = (row - NCTX) / SEQ, pos = (row - NCTX) % SEQ, blk = ch >> 6;
    float ac[8];
#pragma unroll
    for (int dd = 0; dd < 2; ++dd) {
      const int pidx = dd ? SEQ - 1 - pos : pos;
      const int cc = CTXL / 64 + pidx / 64;
      const int sid = (bb_ * 8 + blk) * 2 + dd;
      const float* hs = (const float*)(P.ws + OFF_LRUHS) + ((size_t)sid * LRU_NCH + cc) * 64 + (ch & 63);
      unpack8(*(const u32x4*)((const bf16_t*)(P.ws + (dd ? OFF_ACUM1 : OFF_ACUM0)) + (size_t)(row - NCTX) * 512 + ch), ac);
      f32x4 h0 = *(const f32x4*)hs, h1 = *(const f32x4*)(hs + 4);
      float* u = dd ? u1 : u0;
      u[0] += ac[0] * h0.x; u[1] += ac[1] * h0.y; u[2] += ac[2] * h0.z; u[3] += ac[3] * h0.w;
      u[4] += ac[4] * h1.x; u[5] += ac[5] * h1.y; u[6] += ac[6] * h1.z; u[7] += ac[7] * h1.w;
    }
  }
  unpack8(*(const u32x4*)(proj + (size_t)row * ODC + 1792 + ch), gb);
  float rv[8], vv[8];
  float sdot = 0.f;
#pragma unroll
  for (int j = 0; j < 8; ++j) {
    float r = mixval(proj, row, ch + j, mu);
    float k = mixval(proj, row, 512 + ch + j, mu);
    vv[j] = mixval(proj, row, 1024 + ch + j, mu);
    float am = 0.5f * (sigmoidf_(a0[j]) + sigmoidf_(a1[j]));
    float kb = k * (1.f + (am - 1.f) * P.in[I_KA][ch + j]);
    sdot += r * kb * P.in[I_RK][ch + j];
    rv[j] = r;
  }
  sdot += wshfl_xor(sdot, 1); sdot += wshfl_xor(sdot, 2); sdot += wshfl_xor(sdot, 4);
  float f1[8], f2[8];
#pragma unroll
  for (int j = 0; j < 8; ++j) {
    float yn = (y0[j] - mean) * rstd * P.in[I_LNW][ch + j] + P.in[I_LNB][ch + j];
    yn += sdot * vv[j];
    f1[j] = yn * g[j];
    f2[j] = (u0[j] + u1[j]) * geluf_(gb[j]);
  }
  *(u32x4*)(hb + ch) = pack8(f1);
  *(u32x4*)(hb + 512 + ch) = pack8(f2);
}

DEV unsigned fkey(float f) { unsigned u; __builtin_memcpy(&u, &f, 4); return (u >> 31) ? ~u : (u | 0x80000000u); }
DEV float keyf(unsigned u) { u = (u >> 31) ? (u & 0x7fffffffu) : ~u; float f; __builtin_memcpy(&f, &u, 4); return f; }
DEV void key_insert(unsigned x, unsigned* v) {
#pragma unroll
  for (int j = 0; j < 16; ++j) { unsigned hi = v[j] > x ? v[j] : x; x = v[j] > x ? x : v[j]; v[j] = hi; }
}
DEV void key_cx(unsigned& hi, unsigned& lo) { unsigned a = hi, b = lo; hi = a > b ? a : b; lo = a > b ? b : a; }
DEV void key_sort16(unsigned* v) {
#pragma unroll
  for (int k = 2; k <= 16; k <<= 1)
#pragma unroll
    for (int j = k >> 1; j > 0; j >>= 1)
#pragma unroll
      for (int i = 0; i < 16; ++i) {
        const int l = i ^ j;
        if (l > i) { if ((i & k) == 0) key_cx(v[i], v[l]); else key_cx(v[l], v[i]); }
      }
}
DEV void key_merge16(unsigned* a, const unsigned* b) {
#pragma unroll
  for (int i = 0; i < 16; ++i) a[i] = a[i] > b[15 - i] ? a[i] : b[15 - i];
#pragma unroll
  for (int j = 8; j > 0; j >>= 1)
#pragma unroll
    for (int i = 0; i < 16; ++i) { const int l = i ^ j; if (l > i) key_cx(a[i], a[l]); }
}

DEV void st_peer_topk(const Params& P, int layer, int tile, int h, unsigned char* smem) {
  const int tid = threadIdx.x;
  const bf16_t* q = (const bf16_t*)(P.ws + OFF_Q);
  const bf16_t* keys = (const bf16_t*)(P.ws + OFF_KEYS) + (size_t)(layer * 8 + h) * 2 * 128 * 128;
  float* sS = (float*)smem;
  const int m0 = tile * 128;
  const int tok = tid & 127, half = tid >> 7;
  unsigned kl[2][16];
#pragma unroll
  for (int p = 0; p < 2; ++p) {
    EpiScoreLds epi{sS, m0};
    gemm_tile_128<true>(q + (h * 2 + p) * 128, 2048, NTOK, keys + p * 128 * 128, 128, 128, 128, m0, 0, epi, smem);
    __syncthreads();
    float* row = sS + tok * 129 + half * 64;
#pragma unroll
    for (int g = 0; g < 4; ++g) {
      unsigned grp[16];
#pragma unroll
      for (int j = 0; j < 16; ++j) grp[j] = (fkey(row[g * 16 + j]) & ~127u) | (unsigned)(127 - (half * 64 + g * 16 + j));
      key_sort16(grp);
      if (g == 0) {
#pragma unroll
        for (int j = 0; j < 16; ++j) kl[p][j] = grp[j];
      } else key_merge16(kl[p], grp);
    }
    if (half == 1) {
#pragma unroll
      for (int j = 0; j < 16; ++j) row[j] = __builtin_bit_cast(float, kl[p][j]);
    }
    __syncthreads();
    if (half == 0) {
      unsigned oth[16];
#pragma unroll
      for (int j = 0; j < 16; ++j) oth[j] = __builtin_bit_cast(unsigned, sS[tok * 129 + 64 + j]);
      key_merge16(kl[p], oth);
    }
    __syncthreads();
  }
  if (tid < 128) {
    float sv0[16], sv1[16];
    int* irow = (int*)(sS + tid * 129);
#pragma unroll
    for (int j = 0; j < 16; ++j) {
      sv0[j] = keyf((kl[0][j] & ~127u) | 64u); sv1[j] = keyf((kl[1][j] & ~127u) | 64u);
      irow[j] = 127 - (int)(kl[0][j] & 127u); irow[16 + j] = 127 - (int)(kl[1][j] & 127u);
    }
    unsigned best[16];
#pragma unroll
    for (int j = 0; j < 16; ++j) best[j] = 0u;
#pragma unroll
    for (int i = 0; i < 16; ++i)
#pragma unroll
      for (int j = 0; j < 16; ++j)
        if ((i + 1) * (j + 1) <= 16) key_insert((fkey(sv0[i] + sv1[j]) & ~255u) | (unsigned)(255 - (i * 16 + j)), best);
    float e[16], sum = 0.f;
    const float b0 = keyf((best[0] & ~255u) | 128u);
#pragma unroll
    for (int j = 0; j < 16; ++j) { e[j] = fexp(keyf((best[j] & ~255u) | 128u) - b0); sum += e[j]; }
    const float inv = 1.f / sum;
    int* pidx = (int*)(P.ws + OFF_PIDX) + (size_t)(m0 + tid) * 128 + h * 16;
    float* pg = (float*)(P.ws + OFF_PGATE) + (size_t)(m0 + tid) * 128 + h * 16;
#pragma unroll
    for (int j = 0; j < 16; ++j) {
      const int pos = 255 - (int)(best[j] & 255u);
      pidx[j] = irow[pos >> 4] * 128 + irow[16 + (pos & 15)];
      pg[j] = e[j] * inv;
    }
  }
}

DEV void st_peer_experts(const Params& P, int layer, int row) {
  const int lane = threadIdx.x & 63;
  const bf16_t* xb = (const bf16_t*)(P.ws + OFF_HBUF) + (size_t)row * 1024;
  const unsigned char* U = P.ws + OFF_PU;
  const int* pidx = (const int*)(P.ws + OFF_PIDX) + (size_t)row * 128;
  const float* pg = (const float*)(P.ws + OFF_PGATE) + (size_t)row * 128;
  float x[16], acc[16];
  unpack8(*(const u32x4*)(xb + lane * 16), x);
  unpack8(*(const u32x4*)(xb + lane * 16 + 8), x + 8);
#pragma unroll
  for (int j = 0; j < 16; ++j) acc[j] = 0.f;
  const int b5 = (lane >> 5) & 1, b4 = (lane >> 4) & 1, b3 = (lane >> 3) & 1;
  const int mypick = (lane >> 3) & 7;
  for (int k0 = 0; k0 < 128; k0 += 8) {
    u32x4 uu[8], vv[8];
#pragma unroll
    for (int i = 0; i < 8; ++i) {
      const size_t off = (size_t)pidx[k0 + i] * 2048 + lane * 16;
      uu[i] = *(const u32x4*)(U + off);
      vv[i] = *(const u32x4*)(U + off + 1024);
    }
    const float mygate = pg[k0 + mypick];
    float dsum[8];
#pragma unroll
    for (int i = 0; i < 8; ++i) {
      float uf[16];
      unpack16_fp8(uu[i], uf);
      float dd = 0.f;
#pragma unroll
      for (int j = 0; j < 16; ++j) dd += x[j] * uf[j];
      dsum[i] = dd;
    }
    float e4[4], e2[2], g;
#pragma unroll
    for (int i = 0; i < 4; ++i) {
      float mine = b5 ? dsum[4 + i] : dsum[i], send = b5 ? dsum[i] : dsum[4 + i];
      e4[i] = mine + wshfl_xor(send, 32);
    }
#pragma unroll
    for (int i = 0; i < 2; ++i) {
      float mine = b4 ? e4[2 + i] : e4[i], send = b4 ? e4[i] : e4[2 + i];
      e2[i] = mine + wshfl_xor(send, 16);
    }
    {
      float mine = b3 ? e2[1] : e2[0], send = b3 ? e2[0] : e2[1];
      g = mine + wshfl_xor(send, 8);
    }
    g += wshfl_xor(g, 4); g += wshfl_xor(g, 2); g += wshfl_xor(g, 1);
    const float mycoef = mygate * geluf_(g * (1.f / PEER_USCALE));
#pragma unroll
    for (int i = 0; i < 8; ++i) {
      const float coef = wreadlane(mycoef, i * 8);
      float vf[16];
      unpack16_fp8(vv[i], vf);
#pragma unroll
      for (int j = 0; j < 16; ++j) acc[j] += coef * vf[j];
    }
  }
  float* xr = row < NCTX ? (float*)(P.ws + OFF_CTXRES) + (size_t)row * 1024 : P.out + (size_t)(row - NCTX) * 1024;
  const float* g2 = (const float*)(P.ws + OFF_MODV) + ((size_t)layer * 3 + mod_row(row)) * 6144 + 5 * 1024;
  float o[16];
#pragma unroll
  for (int q = 0; q < 4; ++q) {
    const int c = lane * 16 + q * 4;
    f32x4 a = *(const f32x4*)(xr + c), ga = *(const f32x4*)(g2 + c);
    o[q * 4 + 0] = a.x + ga.x * acc[q * 4 + 0] * (1.f / PEER_VSCALE); o[q * 4 + 1] = a.y + ga.y * acc[q * 4 + 1] * (1.f / PEER_VSCALE);
    o[q * 4 + 2] = a.z + ga.z * acc[q * 4 + 2] * (1.f / PEER_VSCALE); o[q * 4 + 3] = a.w + ga.w * acc[q * 4 + 3] * (1.f / PEER_VSCALE);
  }
  float ss = 0.f;
#pragma unroll
  for (int j = 0; j < 16; ++j) ss += o[j] * o[j];
  ss = wave_sum(ss);
  const float rstd = frsq(ss * (1.f / 1024.f) + 1e-6f);
  if (layer == 1) {
#pragma unroll
    for (int j = 0; j < 16; ++j) o[j] *= rstd * P.in[I_FNORM][lane * 16 + j];
  }
#pragma unroll
  for (int q = 0; q < 4; ++q) {
    f32x4 a = {o[q * 4 + 0], o[q * 4 + 1], o[q * 4 + 2], o[q * 4 + 3]};
    *(f32x4*)(xr + lane * 16 + q * 4) = a;
  }
  if (layer == 0) {
    const float* mv = (const float*)(P.ws + OFF_MODV) + ((size_t)1 * 3 + mod_row(row)) * 6144;
    const float* nw = P.in[I_NORM1] + 1024;
    float hh[16];
#pragma unroll
    for (int q = 0; q < 4; ++q) {
      const int c = lane * 16 + q * 4;
      f32x4 w4 = *(const f32x4*)(nw + c), s4 = *(const f32x4*)(mv + 1024 + c), h4 = *(const f32x4*)(mv + c);
      hh[q * 4 + 0] = o[q * 4 + 0] * rstd * w4.x * (1.f + s4.x) + h4.x; hh[q * 4 + 1] = o[q * 4 + 1] * rstd * w4.y * (1.f + s4.y) + h4.y;
      hh[q * 4 + 2] = o[q * 4 + 2] * rstd * w4.z * (1.f + s4.z) + h4.z; hh[q * 4 + 3] = o[q * 4 + 3] * rstd * w4.w * (1.f + s4.w) + h4.w;
    }
    bf16_t* hb = (bf16_t*)(P.ws + OFF_HBUF) + (size_t)row * 1024 + lane * 16;
    *(u32x4*)hb = pack8(hh);
    *(u32x4*)(hb + 8) = pack8(hh + 8);
  }
}


#define FOR_TILES_XCD(MT0, MT1, NT, mt, nt)                                                     \
  for (int _x = blockIdx.x & 7, _mlo = (MT0) + (((MT1) - (MT0)) * _x) / 8,                        \
           _mhi = (MT0) + (((MT1) - (MT0)) * (_x + 1)) / 8, _i = blockIdx.x >> 3,                 \
           _cnt = (_mhi - _mlo) * (NT), mt = 0, nt = 0;                                           \
       _i < _cnt && ((mt = _mlo + _i / (NT)), (nt = _i % (NT)), true); _i += (int)(gridDim.x >> 3))

#ifndef PHASE_LIST
#define PHASE_LIST(X) X(0) X(1) X(2) X(22) X(23) X(3) X(4) X(5) X(6) X(7) X(8) X(9) X(11) X(12) X(13) X(30) X(14) X(15) X(31) X(16) X(17) X(18) X(19) X(20) X(21)
#endif
constexpr int PH_LAST = 21;

template <int ph>
DEV void run_phase(const Params& P, unsigned char* smem) {
  const int bid = blockIdx.x, nb = gridDim.x;
  const int wave = threadIdx.x >> 6;
  unsigned char* ws = P.ws;
  constexpr int layer = ((ph >= 10 && ph <= 21) || ph >= 30) ? 1 : 0;
  const float* modv_l = (const float*)(ws + OFF_MODV) + (size_t)layer * 3 * 6144;
  switch (ph) {
    case 0:
      for (int t = NTRANS + bid; t < NPREP; t += nb) st_prep(P, t, smem);
      break;
    case 1: case 10:
      if (ph == 1) for (int t = nb - 1 - bid; t < NTRANS; t += nb) st_prep(P, t, smem);
      for (int t = bid; t < NTOK / 4; t += nb) st_normmod(P, layer, 0, t * 4 + wave);
      break;
    case 2: {
      EpiProjL0 epi{(bf16_t*)(ws + OFF_PROJ), (float*)(ws + OFF_GATES)};
      FOR_TILES_XCD(0, NTILE, 13, mt, nt)
        gemm_tile_128x256((const bf16_t*)(ws + OFF_HBUF), 1024, NTOK, (const bf16_t*)(ws + OFF_WEVIN), 1024, EVC, 1024,
                          mt * 128, nt * 256, epi, smem);
    } break;
    case 22:
      for (int t = bid; t < NTOK / 4; t += nb) st_xbc_conv(P, t * 4 + wave);
      for (int t = bid; t < NPCONV; t += nb) st_peer_conv(P, 0, t);
      break;
    case 23:
      for (int t = bid; t < 48 * LA_NSEG; t += nb) {
        int sid = t % 48, seg = t / 48;
        if (sid < 16) st_linattn_seg<true, false>(P, sid, seg, smem);
        else st_linattn_seg<false, false>(P, sid - 16, seg, smem);
      }
      break;
    case 3:
      for (int t = bid; t < 48 * LA_NSEG; t += nb) {
        int sid = t % 48, seg = t / 48;
        if (sid < 16) st_linattn_seg<true, true>(P, sid, seg, smem);
        else st_linattn_seg<false, true>(P, sid - 16, seg, smem);
      }
      break;
    case 4:
      for (int t = bid; t < NTOK / 4; t += nb) st_finish_l0(P, t * 4 + wave);
      break;
    case 5: case 17: {
      EpiOutProj epi{layer == 0 ? P.in[I_X] : P.out, P.in[I_CTX], P.out, (float*)(ws + OFF_CTXRES), modv_l};
      const bf16_t* Wt = (const bf16_t*)(ws + (layer == 0 ? OFF_WEVOUT : OFF_WODOUT));
      if (layer == 0) {
        FOR_TILES_XCD(0, NTILE, 8, mt, nt)
          gemm_tile_128<false>((const bf16_t*)(ws + OFF_HBUF), 1024, NTOK, Wt, 1024, 1024, 1024, mt * 128, nt * 128, epi, smem);
      } else {
        FOR_TILES_XCD(CTILE, NTILE, 4, mt, nt)
          gemm_tile_128x256((const bf16_t*)(ws + OFF_HBUF), 1024, NTOK, Wt, 1024, 1024, 1024, mt * 128, nt * 256, epi, smem);
      }
    } break;
    case 6: case 18: {
      const int r0 = layer == 0 ? 0 : NCTX / 4;
      for (int t = r0 + bid; t < NTOK / 4; t += nb) st_normmod(P, layer, 1, t * 4 + wave);
      if (ph == 18) for (int t = bid; t < NPCONV; t += nb) st_peer_conv(P, 1, t);
    } break;
    case 7: case 19: {
      EpiStoreBf epi{(bf16_t*)(ws + OFF_Q), 2048};
      const bf16_t* Wt = (const bf16_t*)(ws + OFF_WQ) + (size_t)layer * 2048 * 1024;
      if (layer == 0) {
        FOR_TILES_XCD(0, NTILE, 16, mt, nt)
          gemm_tile_128<false>((const bf16_t*)(ws + OFF_HBUF), 1024, NTOK, Wt, 1024, 2048, 1024, mt * 128, nt * 128, epi, smem);
      } else {
        FOR_TILES_XCD(CTILE, NTILE, 8, mt, nt)
          gemm_tile_128x256((const bf16_t*)(ws + OFF_HBUF), 1024, NTOK, Wt, 1024, 2048, 1024, mt * 128, nt * 256, epi, smem);
      }
    } break;
    case 8: case 20: {
      const int t0 = layer == 0 ? 0 : CTILE * 8;
      for (int t = t0 + bid; t < NTILE * 8; t += nb) st_peer_topk(P, layer, t / 8, t % 8, smem);
    } break;
    case 9: case 21: {
      const int r0 = layer == 0 ? 0 : NCTX / 4;
      for (int t = r0 + bid; t < NTOK / 4; t += nb) st_peer_experts(P, layer, t * 4 + wave);
    } break;
    case 11: {
      EpiStoreBf epi{(bf16_t*)(ws + OFF_PROJ), ODC};
      FOR_TILES_XCD(0, NTILE, 11, mt, nt)
        gemm_tile_128x256((const bf16_t*)(ws + OFF_HBUF), 1024, NTOK, (const bf16_t*)(ws + OFF_WODIN), 1024, ODC, 1024,
                          mt * 128, nt * 256, epi, smem);
    } break;
    case 12:
      for (int t = bid; t < NTOK / 4; t += nb) st_lora_act(P, t * 4 + wave);
      break;
    case 13:
      for (int t = bid; t < NTILE * 20; t += nb) {
        int job = t / (NTILE * 4), tt = t % (NTILE * 4);
        int mt = tt / 4, nt = tt % 4;
        bf16_t* dst = (bf16_t*)(ws + OFF_LORA) + (size_t)job * NTOK * 512;
        const bf16_t* A = (const bf16_t*)(ws + OFF_HBUF) + (job < 2 ? 0 : (job < 4 ? 64 : 128));
        const bf16_t* Bt = job < 2 ? (const bf16_t*)(ws + OFF_WUP) + (size_t)job * 512 * 64
                         : job < 4 ? (const bf16_t*)(ws + OFF_AUP) + (size_t)(job - 2) * 512 * 64
                                   : (const bf16_t*)(ws + OFF_GUP);
        const float* bias = job < 2 ? P.in[I_W0] + job * 512 : (job < 4 ? P.in[I_A0] + (job - 2) * 512 : nullptr);
        const int K = job < 4 ? 64 : 128;
        EpiStoreBfBias epi{dst, 512, bias};
        gemm_tile_128<false>(A, 1024, NTOK, Bt, K, 512, K, mt * 128, nt * 128, epi, smem);
      }
      break;
    case 30:
      for (int t = bid; t < 32 * RW_NSEG; t += nb) st_rwkv_seg<false>(P, t % 32, t / 32, smem);
      break;
    case 14:
      for (int t = bid; t < 32 * RW_NSEG; t += nb) st_rwkv_seg<true>(P, t % 32, t / 32, smem);
      break;
    case 15:
      for (int t = bid; t < 32 * LRU_NCH; t += nb) st_lru_chunk(P, t % 32, t / 32, smem);
      break;
    case 31:
      if (bid < 32) st_lru_carry(P, bid);
      break;
    case 16:
      for (int t = bid; t < NTOK / 4; t += nb) st_finish_l1(P, t * 4 + wave);
      break;
    default: break;
  }
}


#ifndef CPU_EMU
#define XB_TMO      128
#define XB_XCNT(j)  (256  + 64 * (j))
#define XB_XSUB(j)  (1280 + 64 * (j))
#define XB_XGEN(j)  (2304 + 64 * (j))
#define XB_TOP      3328
#define XB_TOPGEN   3392
#define XCD_BAR_WORDS 3456
#define XB_SPIN_CAP (1u << 20)
#define LAS __attribute__((address_space(3)))
__device__ __forceinline__ unsigned xb_ld(unsigned* p)              { return __hip_atomic_load(p, __ATOMIC_RELAXED, __HIP_MEMORY_SCOPE_AGENT); }
__device__ __forceinline__ unsigned xb_add(unsigned* p, unsigned v) { return __hip_atomic_fetch_add(p, v, __ATOMIC_RELAXED, __HIP_MEMORY_SCOPE_AGENT); }
__device__ __forceinline__ unsigned xb_xcc_id() { return (unsigned)__builtin_amdgcn_s_getreg((3 << 11) | 20) & 0xFu; }
#define XB_SPIN(cond, bar) do { unsigned _sp = 0; while (cond) { __builtin_amdgcn_s_sleep(1); \
    if ((++_sp & 255u) == 0u) { if (xb_ld(&(bar)[XB_TMO])) break; if (_sp > XB_SPIN_CAP) { atomicAdd(&(bar)[XB_TMO], 1u); break; } } } } while (0)
struct XcdBarrier { unsigned* bar; unsigned x; volatile LAS unsigned* st; };
__device__ __forceinline__ XcdBarrier xcd_barrier_post(unsigned* bar, volatile LAS unsigned* st) {
  XcdBarrier b; b.bar = bar; b.x = xb_xcc_id(); b.st = st;
  if (threadIdx.x == 0) (void)xb_add(&bar[XB_XCNT(b.x)], 1u);
  return b;
}
__device__ __forceinline__ void xcd_barrier_complete(unsigned* bar, unsigned x, unsigned& nloc, unsigned& nx) {
  const unsigned G = gridDim.x * gridDim.y * gridDim.z;
  unsigned sum, cnt, mine, sp = 0u;
  for (;;) {
    sum = 0u; cnt = 0u; mine = 0u;
#pragma unroll
    for (unsigned j = 0; j < 16; ++j) { const unsigned c = xb_ld(&bar[XB_XCNT(j)]); sum += c; cnt += (c > 0u) ? 1u : 0u; mine = (j == x) ? c : mine; }
    if (sum == G) break;
    __builtin_amdgcn_s_sleep(1);
    if ((++sp & 255u) == 0u) { if (xb_ld(&bar[XB_TMO])) break; if (sp > XB_SPIN_CAP) { atomicAdd(&bar[XB_TMO], 1u); break; } }
  }
  nloc = mine > 0u ? mine : 1u; nx = cnt > 0u ? cnt : 1u;
}
__device__ __forceinline__ void xcd_barrier(const XcdBarrier& b) {
  asm volatile("s_waitcnt vmcnt(0)" ::: "memory");
  __syncthreads();
  if (threadIdx.x == 0) {
    unsigned* bar = b.bar;
    __builtin_amdgcn_s_waitcnt(0);
    unsigned nloc = b.st[0], nx = b.st[1];
    if (nloc == 0u) { xcd_barrier_complete(bar, b.x, nloc, nx); b.st[0] = nloc; b.st[1] = nx; }
    const unsigned old = xb_add(&bar[XB_XSUB(b.x)], 1u);
    const unsigned gen = old / nloc;
    if (old + 1u == (gen + 1u) * nloc) {
      __builtin_amdgcn_fence(__ATOMIC_RELEASE, "agent");
      asm volatile("s_waitcnt vmcnt(0)" ::: "memory");
      const unsigned og = xb_add(&bar[XB_TOP], 1u);
      const unsigned tg = og / nx;
      if (og + 1u == (tg + 1u) * nx) xb_add(&bar[XB_TOPGEN], 1u);
      else XB_SPIN(xb_ld(&bar[XB_TOPGEN]) == tg, bar);
      __builtin_amdgcn_fence(__ATOMIC_ACQUIRE, "agent");
      xb_add(&bar[XB_XGEN(b.x)], 1u);
      asm volatile("s_waitcnt vmcnt(0)" ::: "memory");
    } else {
      XB_SPIN(xb_ld(&bar[XB_XGEN(b.x)]) == gen, bar);
      __builtin_amdgcn_fence(__ATOMIC_ACQUIRE, "agent");
      asm volatile("s_waitcnt vmcnt(0)" ::: "memory");
    }
  }
  __syncthreads();
}
#endif
#ifndef CPU_EMU
#define RUN_PH(n) run_phase<n>(P, smem_raw); if (n != PH_LAST) xcd_barrier(xb);
__global__ void __launch_bounds__(256, 2) mega_kernel(Params P) {
  SMEM_DECL;
  unsigned* bar = (unsigned*)(P.ws + OFF_BAR);
  volatile LAS unsigned* st = (volatile LAS unsigned*)(smem_raw + SMEM_BYTES - 16);
  if (threadIdx.x == 0) { st[0] = 0u; st[1] = 0u; }
  if (P.ws == nullptr) cg::this_grid().sync();
  __syncthreads();
  XcdBarrier xb = xcd_barrier_post(bar, st);
  PHASE_LIST(RUN_PH)
}

extern "C" void kernel_launch(void* const* d_in, const int* in_sizes, int n_in, void* d_out, int out_size, void* d_ws,
                              size_t ws_size, hipStream_t stream) {
  Params P{};
  for (int i = 0; i < N_IN; ++i) P.in[i] = (const float*)d_in[i];
  P.out = (float*)d_out;
  P.ws = (unsigned char*)d_ws;
  if (ws_size < WS_NEEDED) { fprintf(stderr, "workspace too small: %zu < %zu\n", ws_size, (size_t)WS_NEEDED); return; }
  static int grid_blocks = 0;
  if (!grid_blocks) {
    int dev = 0, cus = 0, per_cu = 0;
    hipGetDevice(&dev);
    hipDeviceGetAttribute(&cus, hipDeviceAttributeMultiprocessorCount, dev);
    hipOccupancyMaxActiveBlocksPerMultiprocessor(&per_cu, mega_kernel, 256, 0);
    if (per_cu > 2) per_cu = 2;
    grid_blocks = cus * per_cu;
  }
  (void)hipMemsetAsync((unsigned char*)d_ws + OFF_BAR, 0, 16384, stream);
  void* args[] = {&P};
  hipError_t e = hipLaunchCooperativeKernel((void*)mega_kernel, dim3(grid_blocks), dim3(256), args, 0, stream);
  if (e != hipSuccess) fprintf(stderr, "cooperative launch failed: %s (grid %d)\n", hipGetErrorString(e), grid_blocks);
}
#endif
```

```cpp
#ifdef CPU_EMU
#include "emu.h"
#else
#include <hip/hip_runtime.h>
#include <hip/hip_cooperative_groups.h>
#include <cstdio>
namespace cg = cooperative_groups;
#define DEV __device__ __forceinline__
#define DEVM __device__ __forceinline__
#define OPAQUE(x) asm volatile("" : "+v"(x))
#endif

#ifndef SEQ_LEN
#define SEQ_LEN 16384
#endif
#ifndef CTX_LEN
#define CTX_LEN 256
#endif
#ifndef GRID_W_
#define GRID_W_ 64
#endif
#ifndef MULTI_LAUNCH
#define MULTI_LAUNCH 0
#endif

typedef unsigned short bf16_t;
typedef __attribute__((ext_vector_type(8))) short bf16x8;
typedef __attribute__((ext_vector_type(16))) float f32x16;
typedef __attribute__((ext_vector_type(4))) unsigned u32x4;
typedef __attribute__((ext_vector_type(2))) unsigned u32x2;
typedef __attribute__((ext_vector_type(4))) float f32x4;

constexpr int D = 1024, NB = 2, SEQ = SEQ_LEN, CTXL = CTX_LEN, GW = GRID_W_;
constexpr int NCTX = NB * CTXL, NLAT = NB * SEQ, NTOK = NCTX + NLAT;
constexpr int EVC = 3104, ODC = 2816;
constexpr int NEXP = 16384;
constexpr int NTILE = NTOK / 128, CTILE = NCTX / 128;
static_assert(NTOK % 256 == 0 && NCTX % 256 == 0, "tiles");
static_assert(CTXL % 64 == 0 && SEQ % 64 == 0 && SEQ % GW == 0, "chunks");

constexpr size_t al256(size_t x) { return (x + 255) & ~(size_t)255; }
constexpr size_t OFF_MODV = 0;
constexpr size_t OFF_CTXRES = OFF_MODV + al256(2 * 3 * 6144 * 4);
constexpr size_t OFF_GATES = OFF_CTXRES + al256((size_t)NCTX * 1024 * 4);
constexpr size_t OFF_WEVIN = OFF_GATES + al256((size_t)NTOK * 32 * 4);
constexpr size_t OFF_WEVOUT = OFF_WEVIN + al256((size_t)EVC * 1024 * 2);
constexpr size_t OFF_WODIN = OFF_WEVOUT + al256((size_t)1024 * 1024 * 2);
constexpr size_t OFF_WODOUT = OFF_WODIN + al256((size_t)ODC * 1024 * 2);
constexpr size_t OFF_WQ = OFF_WODOUT + al256((size_t)1024 * 1024 * 2);
constexpr size_t OFF_KEYS = OFF_WQ + al256((size_t)2 * 2048 * 1024 * 2);
constexpr size_t OFF_WUP = OFF_KEYS + al256((size_t)2 * 8 * 2 * 128 * 128 * 2);
constexpr size_t OFF_AUP = OFF_WUP + al256((size_t)2 * 512 * 64 * 2);
constexpr size_t OFF_GUP = OFF_AUP + al256((size_t)2 * 512 * 64 * 2);
constexpr size_t OFF_LRUT = OFF_GUP + al256((size_t)512 * 128 * 2);
constexpr size_t OFF_PU = OFF_LRUT + al256((size_t)2 * 8 * 128 * 64 * 2);
constexpr size_t OFF_PV = OFF_PU + al256((size_t)NEXP * 1024);
constexpr size_t OFF_HBUF = OFF_PV + al256((size_t)NEXP * 1024);
constexpr size_t OFF_PR = OFF_HBUF + al256((size_t)NTOK * 1024 * 2);
constexpr size_t PR_BYTES = (size_t)NTOK * 5376 * 2;
constexpr size_t OFF_BAR = OFF_PR + PR_BYTES;
constexpr size_t OFF_ACUM1 = OFF_BAR + 16384;
constexpr size_t OFF_LRUCS = OFF_ACUM1 + (size_t)NLAT * 512 * 2;
constexpr size_t OFF_LRUHS = OFF_LRUCS + (size_t)32 * ((CTXL + SEQ) / 64) * 128 * 4;
constexpr size_t WS_NEEDED = OFF_LRUHS + (size_t)32 * ((CTXL + SEQ) / 64) * 64 * 4;
#ifndef CPU_EMU
static_assert(WS_NEEDED <= (size_t)512 * 1024 * 1024, "workspace too large");
#endif
constexpr size_t OFF_PROJ = OFF_PR;
constexpr size_t OFF_R2L0 = OFF_PR + (size_t)NTOK * EVC * 2;
constexpr size_t OFF_LORA = OFF_PR + (size_t)NTOK * ODC * 2;
constexpr size_t OFF_Q = OFF_PR;
constexpr size_t OFF_PIDX = OFF_PR + (size_t)NTOK * 2048 * 2;
constexpr size_t OFF_PGATE = OFF_PIDX + (size_t)NTOK * 128 * 4;
static_assert(OFF_PGATE + (size_t)NTOK * 128 * 4 <= OFF_PR + PR_BYTES, "picks");

enum {
  I_X = 0, I_C, I_CTX, I_CCTX, I_MODW, I_MODB, I_NORM1, I_NORM2, I_WQ, I_KEYS, I_PU, I_PV,
  I_EVWIN, I_EVWOUT, I_IBIAS, I_FBIAS, I_MNORM, I_SCONVW, I_SCONVB, I_DTBIAS, I_ALOG, I_DSKIP, I_SNORM,
  I_ODWIN, I_ODWOUT, I_MU, I_W0, I_WUP, I_A0, I_AUP, I_GUP, I_KK, I_KA, I_RK, I_LNW, I_LNB,
  I_LCONVW, I_LCONVB, I_LAM, I_WA, I_BA, I_WI, I_BI, I_FNORM, N_IN
};

struct Params {
  const float* in[N_IN];
  float* out;
  unsigned char* ws;
};

constexpr int SMEM_BYTES = 80 * 1024;
#ifdef CPU_EMU
#define SMEM_DECL static thread_local __attribute__((aligned(16))) unsigned char smem_raw[SMEM_BYTES]
#else
#define SMEM_DECL __shared__ __attribute__((aligned(16))) unsigned char smem_raw[SMEM_BYTES]
#endif

DEV float bf2f(bf16_t v) { unsigned u = ((unsigned)v) << 16; float f; __builtin_memcpy(&f, &u, 4); return f; }
DEV bf16_t f2bf(float f) { unsigned u; __builtin_memcpy(&u, &f, 4); u += 0x7fffu + ((u >> 16) & 1u); return (bf16_t)(u >> 16); }
DEV unsigned pack2(float a, float b) { return (unsigned)f2bf(a) | ((unsigned)f2bf(b) << 16); }
DEV void unpack8(const u32x4& r, float* o) {
  unsigned w[4] = {r.x, r.y, r.z, r.w};
#pragma unroll
  for (int i = 0; i < 4; ++i) { unsigned lo = w[i] << 16, hi = w[i] & 0xffff0000u; __builtin_memcpy(&o[2 * i], &lo, 4); __builtin_memcpy(&o[2 * i + 1], &hi, 4); }
}
DEV u32x4 pack8(const float* o) { u32x4 r; r.x = pack2(o[0], o[1]); r.y = pack2(o[2], o[3]); r.z = pack2(o[4], o[5]); r.w = pack2(o[6], o[7]); return r; }
#ifdef CPU_EMU
DEV float fexp(float x) { return expf(x); }
DEV float frcp(float x) { return 1.f / x; }
DEV float flog(float x) { return logf(x); }
DEV float frsq(float x) { return 1.f / sqrtf(x); }
DEV float fsqrt(float x) { return sqrtf(x); }
#else
DEV float fexp(float x) { return __expf(x); }
DEV float frcp(float x) { return __builtin_amdgcn_rcpf(x); }
DEV float flog(float x) { return __logf(x); }
DEV float frsq(float x) { return __builtin_amdgcn_rsqf(x); }
DEV float fsqrt(float x) { return __builtin_amdgcn_sqrtf(x); }
#endif
DEV float sigmoidf_(float x) { return frcp(1.f + fexp(-x)); }
DEV float siluf_(float x) { return x * frcp(1.f + fexp(-x)); }
DEV float softplusf_(float x) { return fmaxf(x, 0.f) + flog(1.f + fexp(-fabsf(x))); }
DEV float tanhf_(float x) { return 1.f - 2.f * frcp(1.f + fexp(2.f * x)); }
DEV float geluf_(float x) { return 0.5f * x * (1.f + erff(x * 0.70710678118654752f)); }

DEV f32x16 mfma32(bf16x8 a, bf16x8 b, f32x16 c) {
#ifdef CPU_EMU
  return emu_mfma32(a, b, c);
#else
  return __builtin_amdgcn_mfma_f32_32x32x16_bf16(a, b, c, 0, 0, 0);
#endif
}
DEV float wshfl_xor(float v, int m) {
#ifdef CPU_EMU
  return emu_shfl_xor(v, m);
#else
  return __shfl_xor(v, m, 64);
#endif
}
DEV float wave_sum(float v) {
#pragma unroll
  for (int m = 32; m >= 1; m >>= 1) v += wshfl_xor(v, m);
  return v;
}

#ifdef CPU_EMU
static inline unsigned emu_f2fp8(float f) {
  unsigned sgn = f < 0.f ? 0x80u : 0u; float a = fabsf(f);
  if (!(a == a)) return 0x7f;
  if (a >= 448.f) return sgn | 0x7e;
  if (a < 0.0009765625f) return sgn;
  int e; frexpf(a, &e); e -= 1;
  if (e < -6) { int q = (int)nearbyintf(a * 512.f); return sgn | (unsigned)q; }
  float m = a / ldexpf(1.f, e);
  int q = (int)nearbyintf((m - 1.f) * 8.f);
  if (q == 8) { q = 0; e += 1; }
  if (e > 8) return sgn | 0x7e;
  return sgn | (unsigned)((e + 7) << 3) | (unsigned)q;
}
static inline float emu_fp82f(unsigned c) {
  unsigned sgn = c & 0x80, e = (c >> 3) & 15, m = c & 7;
  float v = e == 0 ? ldexpf((float)m, -9) : ldexpf(1.f + m / 8.f, (int)e - 7);
  return sgn ? -v : v;
}
#endif
DEV unsigned pack4_fp8(float a, float b, float c, float d) {
#ifdef CPU_EMU
  return emu_f2fp8(a) | (emu_f2fp8(b) << 8) | (emu_f2fp8(c) << 16) | (emu_f2fp8(d) << 24);
#else
  int w = 0;
  w = __builtin_amdgcn_cvt_pk_fp8_f32(a, b, w, false);
  w = __builtin_amdgcn_cvt_pk_fp8_f32(c, d, w, true);
  return (unsigned)w;
#endif
}
DEV void unpack4_fp8(unsigned w, float* o) {
#ifdef CPU_EMU
  o[0] = emu_fp82f(w & 255); o[1] = emu_fp82f((w >> 8) & 255); o[2] = emu_fp82f((w >> 16) & 255); o[3] = emu_fp82f(w >> 24);
#else
  typedef __attribute__((ext_vector_type(2))) float f32x2_;
  f32x2_ lo = __builtin_amdgcn_cvt_pk_f32_fp8((int)w, false);
  f32x2_ hi = __builtin_amdgcn_cvt_pk_f32_fp8((int)w, true);
  o[0] = lo.x; o[1] = lo.y; o[2] = hi.x; o[3] = hi.y;
#endif
}
DEV void unpack16_fp8(const u32x4& r, float* o) { unpack4_fp8(r.x, o); unpack4_fp8(r.y, o + 4); unpack4_fp8(r.z, o + 8); unpack4_fp8(r.w, o + 12); }
DEV float wreadlane(float v, int srclane) {
#ifdef CPU_EMU
  return emu_readlane(v, srclane);
#else
  int iv; __builtin_memcpy(&iv, &v, 4);
  int r = __builtin_amdgcn_readlane(iv, srclane);
  float f; __builtin_memcpy(&f, &r, 4); return f;
#endif
}
constexpr float PEER_USCALE = 64.f, PEER_VSCALE = 4.f;

DEV int acc_row(int reg, int lane) { return (reg & 3) + 8 * (reg >> 2) + 4 * (lane >> 5); }

DEV int mod_row(int row) { return row < NCTX ? 2 : (row - NCTX) / SEQ; }

template <bool SYNC_EPI, class Epi, bool VEC4 = false>
DEV void gemm_tile_128(const bf16_t* __restrict__ A, int lda, int M, const bf16_t* __restrict__ Bt, int ldb, int N,
                       int K, int m0, int n0, const Epi& epi, unsigned char* smem) {
  constexpr int LS = 72;
  constexpr int STAGE = 2 * 128 * LS;
  bf16_t* sbase = (bf16_t*)smem;
  const int wave = threadIdx.x >> 6;
  const int wm = (wave >> 1) * 64, wn = (wave & 1) * 64;
  f32x16 acc[2][2];
#pragma unroll
  for (int i = 0; i < 2; ++i)
#pragma unroll
    for (int j = 0; j < 2; ++j)
#pragma unroll
      for (int r = 0; r < 16; ++r) acc[i][j][r] = 0.f;
  u32x4 ra[4], rb[4];
  auto gload = [&](int k0) {
    int tl_ = threadIdx.x; OPAQUE(tl_);
#pragma unroll
    for (int i = 0; i < 4; ++i) {
      int c = tl_ + i * 256, r = c >> 3, cc = (c & 7) * 8;
      int gr = m0 + r, gn = n0 + r;
      gr = gr < M ? gr : M - 1; gn = gn < N ? gn : N - 1;
      ra[i] = *(const u32x4*)(A + (size_t)gr * lda + k0 + cc);
      rb[i] = *(const u32x4*)(Bt + (size_t)gn * ldb + k0 + cc);
    }
  };
  auto lwrite = [&](int buf) {
    int tl_ = threadIdx.x; OPAQUE(tl_);
    bf16_t* sA = sbase + buf * STAGE;
    bf16_t* sB = sA + 128 * LS;
#pragma unroll
    for (int i = 0; i < 4; ++i) {
      int c = tl_ + i * 256, r = c >> 3, cc = (c & 7) * 8;
      *(u32x4*)(sA + r * LS + cc) = ra[i];
      *(u32x4*)(sB + r * LS + cc) = rb[i];
    }
  };
  const int nk = K >> 6;
  gload(0);
  __syncthreads();
  lwrite(0);
  if (nk > 1) gload(64);
  __syncthreads();
  for (int it = 0; it < nk; ++it) {
    int tl_ = threadIdx.x; OPAQUE(tl_);
    const int lane = tl_ & 63;
    const bf16_t* sA = sbase + (it & 1) * STAGE;
    const bf16_t* sB = sA + 128 * LS;
#pragma unroll
    for (int kk = 0; kk < 4; ++kk) {
      bf16x8 a[2], b[2];
      const int ko = kk * 16 + 8 * (lane >> 5);
#pragma unroll
      for (int i = 0; i < 2; ++i) a[i] = *(const bf16x8*)(sA + (wm + i * 32 + (lane & 31)) * LS + ko);
#pragma unroll
      for (int j = 0; j < 2; ++j) b[j] = *(const bf16x8*)(sB + (wn + j * 32 + (lane & 31)) * LS + ko);
#pragma unroll
      for (int i = 0; i < 2; ++i)
#pragma unroll
        for (int j = 0; j < 2; ++j) acc[i][j] = mfma32(a[i], b[j], acc[i][j]);
      if (kk == 1) {
        if (it + 1 < nk) lwrite((it + 1) & 1);
        if (it + 2 < nk) gload((it + 2) * 64);
      }
    }
    __syncthreads();
  }
  {
    int tl_ = threadIdx.x; OPAQUE(tl_);
    const int lane = tl_ & 63;
    if constexpr (VEC4) {
#pragma unroll
      for (int i = 0; i < 2; ++i)
#pragma unroll
        for (int j = 0; j < 2; ++j)
#pragma unroll
          for (int gq = 0; gq < 4; ++gq) {
            int row = m0 + wm + i * 32 + 8 * gq + 4 * (lane >> 5);
            int col = n0 + wn + j * 32 + (lane & 31);
            if (row < M && col < N) epi.store4(row, col, acc[i][j][4 * gq], acc[i][j][4 * gq + 1], acc[i][j][4 * gq + 2], acc[i][j][4 * gq + 3]);
          }
    } else {
#pragma unroll
      for (int i = 0; i < 2; ++i)
#pragma unroll
        for (int j = 0; j < 2; ++j)
#pragma unroll
          for (int r = 0; r < 16; ++r) {
            int row = m0 + wm + i * 32 + acc_row(r, lane);
            int col = n0 + wn + j * 32 + (lane & 31);
            if (row < M && col < N) epi(row, col, acc[i][j][r]);
          }
    }
  }
}

template <class Epi, bool VEC4 = false>
DEV void gemm_tile_128x256(const bf16_t* __restrict__ A, int lda, int M, const bf16_t* __restrict__ Bt, int ldb, int N,
                           int K, int m0, int n0, const Epi& epi, unsigned char* smem) {
  constexpr int LS = 72;
  bf16_t* sA = (bf16_t*)smem;
  bf16_t* sB = sA + 128 * LS;
  const int wave = threadIdx.x >> 6;
  const int wm = (wave >> 1) * 64, wn = (wave & 1) * 128;
  f32x16 acc[2][4];
#pragma unroll
  for (int i = 0; i < 2; ++i)
#pragma unroll
    for (int j = 0; j < 4; ++j)
#pragma unroll
      for (int r = 0; r < 16; ++r) acc[i][j][r] = 0.f;
  u32x4 ra[4], rb[8];
  {
    const int tid = threadIdx.x;
#pragma unroll
    for (int i = 0; i < 4; ++i) {
      int c = tid + i * 256, r = c >> 3, cc = (c & 7) * 8;
      { int gr = m0 + r; gr = gr < M ? gr : M - 1; ra[i] = *(const u32x4*)(A + (size_t)gr * lda + cc); }
    }
#pragma unroll
    for (int i = 0; i < 8; ++i) {
      int c = tid + i * 256, r = c >> 3, cc = (c & 7) * 8;
      { int gn = n0 + r; gn = gn < N ? gn : N - 1; rb[i] = *(const u32x4*)(Bt + (size_t)gn * ldb + cc); }
    }
  }
  for (int k0 = 0; k0 < K; k0 += 64) {
    int tl_ = threadIdx.x; OPAQUE(tl_);
    const int tid = tl_, lane = tl_ & 63;
    __syncthreads();
#pragma unroll
    for (int i = 0; i < 4; ++i) { int c = tid + i * 256, r = c >> 3, cc = (c & 7) * 8; *(u32x4*)(sA + r * LS + cc) = ra[i]; }
#pragma unroll
    for (int i = 0; i < 8; ++i) { int c = tid + i * 256, r = c >> 3, cc = (c & 7) * 8; *(u32x4*)(sB + r * LS + cc) = rb[i]; }
    __syncthreads();
    if (k0 + 64 < K) {
#pragma unroll
      for (int i = 0; i < 4; ++i) {
        int c = tid + i * 256, r = c >> 3, cc = (c & 7) * 8;
        { int gr = m0 + r; gr = gr < M ? gr : M - 1; ra[i] = *(const u32x4*)(A + (size_t)gr * lda + k0 + 64 + cc); }
      }
#pragma unroll
      for (int i = 0; i < 8; ++i) {
        int c = tid + i * 256, r = c >> 3, cc = (c & 7) * 8;
        { int gn = n0 + r; gn = gn < N ? gn : N - 1; rb[i] = *(const u32x4*)(Bt + (size_t)gn * ldb + k0 + 64 + cc); }
      }
    }
#pragma unroll 2
    for (int kk = 0; kk < 4; ++kk) {
      bf16x8 a[2], b[4];
      const int ko = kk * 16 + 8 * (lane >> 5);
#pragma unroll
      for (int i = 0; i < 2; ++i) a[i] = *(const bf16x8*)(sA + (wm + i * 32 + (lane & 31)) * LS + ko);
#pragma unroll
      for (int j = 0; j < 4; ++j) b[j] = *(const bf16x8*)(sB + (wn + j * 32 + (lane & 31)) * LS + ko);
#pragma unroll
      for (int i = 0; i < 2; ++i)
#pragma unroll
        for (int j = 0; j < 4; ++j) acc[i][j] = mfma32(a[i], b[j], acc[i][j]);
    }
  }
  {
    int tl_ = threadIdx.x; OPAQUE(tl_);
    const int lane = tl_ & 63;
    if constexpr (VEC4) {
#pragma unroll
      for (int i = 0; i < 2; ++i)
#pragma unroll
        for (int j = 0; j < 4; ++j)
#pragma unroll
          for (int gq = 0; gq < 4; ++gq) {
            int row = m0 + wm + i * 32 + 8 * gq + 4 * (lane >> 5);
            int col = n0 + wn + j * 32 + (lane & 31);
            if (row < M && col < N) epi.store4(row, col, acc[i][j][4 * gq], acc[i][j][4 * gq + 1], acc[i][j][4 * gq + 2], acc[i][j][4 * gq + 3]);
          }
    } else {
#pragma unroll
      for (int i = 0; i < 2; ++i)
#pragma unroll
        for (int j = 0; j < 4; ++j)
#pragma unroll
          for (int r = 0; r < 16; ++r) {
            int row = m0 + wm + i * 32 + acc_row(r, lane);
            int col = n0 + wn + j * 32 + (lane & 31);
            if (row < M && col < N) epi(row, col, acc[i][j][r]);
          }
    }
  }
}

DEV void transpose_tile(const float* __restrict__ src, int ld_src, bf16_t* __restrict__ dst, int ld_dst, int K, int N,
                        int tk, int tn, unsigned char* smem) {
  float* sT = (float*)smem;
  const int tid = threadIdx.x;
  __syncthreads();
  {
    const int tx = tid & 15, ty = tid >> 4;
#pragma unroll
    for (int p = 0; p < 4; ++p) {
      int k = tk * 64 + ty + p * 16, n = tn * 64 + tx * 4;
#pragma unroll
      for (int j = 0; j < 4; ++j) {
        float v = (k < K && n + j < N) ? src[(size_t)k * ld_src + n + j] : 0.f;
        sT[(ty + p * 16) * 65 + tx * 4 + j] = v;
      }
    }
  }
  __syncthreads();
  {
    const int n = tid >> 2, kseg = (tid & 3) * 16;
    int gn = tn * 64 + n;
    if (gn < N) {
      float v[16];
#pragma unroll
      for (int j = 0; j < 16; ++j) v[j] = sT[(kseg + j) * 65 + n];
      bf16_t* d = dst + (size_t)gn * ld_dst + tk * 64 + kseg;
      *(u32x4*)d = pack8(v);
      *(u32x4*)(d + 8) = pack8(v + 8);
    }
  }
}

constexpr int TJ0 = 16 * 49, TJ1 = 16 * 16, TJ2 = 16 * 44, TJ3 = 16 * 16, TJ4 = 2 * 16 * 32, TJ5 = 2 * 8, TJ6 = 2 * 8,
              TJ7 = 2 * 8, TJ8 = 32;
constexpr int NTRANS = TJ0 + TJ1 + TJ2 + TJ3 + TJ4 + TJ5 + TJ6 + TJ7 + TJ8;
constexpr int NKEYCV = (2 * 8 * 2 * 128 * 128) / (256 * 8);
constexpr int NMODV = 2 * 96;
constexpr int NPREP = NTRANS + NKEYCV + NMODV;

DEV void st_prep(const Params& P, int item, unsigned char* smem) {
  unsigned char* ws = P.ws;
  if (item < NTRANS) {
    int t = item;
    if (t < TJ0) { transpose_tile(P.in[I_EVWIN], EVC, (bf16_t*)(ws + OFF_WEVIN), 1024, 1024, EVC, t / 49, t % 49, smem); return; }
    t -= TJ0;
    if (t < TJ1) { transpose_tile(P.in[I_EVWOUT], 1024, (bf16_t*)(ws + OFF_WEVOUT), 1024, 1024, 1024, t / 16, t % 16, smem); return; }
    t -= TJ1;
    if (t < TJ2) { transpose_tile(P.in[I_ODWIN], ODC, (bf16_t*)(ws + OFF_WODIN), 1024, 1024, ODC, t / 44, t % 44, smem); return; }
    t -= TJ2;
    if (t < TJ3) { transpose_tile(P.in[I_ODWOUT], 1024, (bf16_t*)(ws + OFF_WODOUT), 1024, 1024, 1024, t / 16, t % 16, smem); return; }
    t -= TJ3;
    if (t < TJ4) {
      int l = t / 512, tt = t % 512;
      transpose_tile(P.in[I_WQ] + (size_t)l * 1024 * 2048, 2048, (bf16_t*)(ws + OFF_WQ) + (size_t)l * 2048 * 1024, 1024, 1024, 2048, tt / 32, tt % 32, smem);
      return;
    }
    t -= TJ4;
    if (t < TJ5) { int d = t / 8; transpose_tile(P.in[I_WUP] + d * 64 * 512, 512, (bf16_t*)(ws + OFF_WUP) + d * 512 * 64, 64, 64, 512, 0, t % 8, smem); return; }
    t -= TJ5;
    if (t < TJ6) { int d = t / 8; transpose_tile(P.in[I_AUP] + d * 64 * 512, 512, (bf16_t*)(ws + OFF_AUP) + d * 512 * 64, 64, 64, 512, 0, t % 8, smem); return; }
    t -= TJ6;
    if (t < TJ7) { transpose_tile(P.in[I_GUP], 512, (bf16_t*)(ws + OFF_GUP), 128, 128, 512, t / 8, t % 8, smem); return; }
    t -= TJ7;
    {
      int which = t & 1, db = t >> 1;
      const float* src = (which ? P.in[I_WI] : P.in[I_WA]) + (size_t)db * 64 * 64;
      transpose_tile(src, 64, (bf16_t*)(ws + OFF_LRUT) + (size_t)db * 128 * 64 + which * 64 * 64, 64, 64, 64, 0, 0, smem);
      return;
    }
  }
  item -= NTRANS;
  if (item < NKEYCV) {
    size_t e = ((size_t)item * 256 + threadIdx.x) * 8;
    const float* s = P.in[I_KEYS] + e;
    f32x4 a = *(const f32x4*)s, b = *(const f32x4*)(s + 4);
    float v[8] = {a.x, a.y, a.z, a.w, b.x, b.y, b.z, b.w};
    *(u32x4*)((bf16_t*)(ws + OFF_KEYS) + e) = pack8(v);
    return;
  }
  item -= NKEYCV;
  {
    const int l = item / 96, cgp = item % 96;
    float* sS = (float*)smem;
    float* sRed = sS + 3 * 1024;
    const int tid = threadIdx.x;
    __syncthreads();
    for (int i = tid; i < 3 * 1024; i += 256) {
      int m = i >> 10, k = i & 1023;
      float c = m < 2 ? P.in[I_C][m * 1024 + k] : P.in[I_CCTX][k];
      sS[i] = siluf_(c);
    }
    __syncthreads();
    const int ks = tid >> 6, col = cgp * 64 + (tid & 63);
    const float* w = P.in[I_MODW] + (size_t)l * 1024 * 6144 + col;
    float a0 = 0.f, a1 = 0.f, a2 = 0.f;
    for (int k = ks * 256; k < ks * 256 + 256; ++k) {
      float wv = w[(size_t)k * 6144];
      a0 += sS[k] * wv; a1 += sS[1024 + k] * wv; a2 += sS[2048 + k] * wv;
    }
    sRed[(ks * 3 + 0) * 64 + (tid & 63)] = a0;
    sRed[(ks * 3 + 1) * 64 + (tid & 63)] = a1;
    sRed[(ks * 3 + 2) * 64 + (tid & 63)] = a2;
    __syncthreads();
    if (tid < 192) {
      int m = tid >> 6, c = tid & 63;
      float s = sRed[(0 * 3 + m) * 64 + c] + sRed[(1 * 3 + m) * 64 + c] + sRed[(2 * 3 + m) * 64 + c] + sRed[(3 * 3 + m) * 64 + c];
      int cc = cgp * 64 + c;
      ((float*)(ws + OFF_MODV))[((size_t)l * 3 + m) * 6144 + cc] = s + P.in[I_MODB][l * 6144 + cc];
    }
  }
}

constexpr int NPCONV = 2 * (NEXP * 1024 / (256 * 16));
DEV void st_peer_conv(const Params& P, int layer, int item) {
  const int half = NPCONV / 2;
  int which = item >= half;
  int it = which ? item - half : item;
  size_t e = ((size_t)it * 256 + threadIdx.x) * 16;
  const float* s = (which ? P.in[I_PV] : P.in[I_PU]) + (size_t)layer * NEXP * 1024 + e;
  const float sc = which ? PEER_VSCALE : PEER_USCALE;
  u32x4 o;
  f32x4 a = *(const f32x4*)s; o.x = pack4_fp8(a.x * sc, a.y * sc, a.z * sc, a.w * sc);
  a = *(const f32x4*)(s + 4); o.y = pack4_fp8(a.x * sc, a.y * sc, a.z * sc, a.w * sc);
  a = *(const f32x4*)(s + 8); o.z = pack4_fp8(a.x * sc, a.y * sc, a.z * sc, a.w * sc);
  a = *(const f32x4*)(s + 12); o.w = pack4_fp8(a.x * sc, a.y * sc, a.z * sc, a.w * sc);
  const size_t ex = e >> 10, col = e & 1023;
  *(u32x4*)(P.ws + OFF_PU + ex * 2048 + (which ? 1024 : 0) + col) = o;
}

DEV void st_normmod(const Params& P, int layer, int which, int row) {
  const int lane = threadIdx.x & 63;
  const float* src;
  if (which == 0 && layer == 0) src = row < NCTX ? P.in[I_CTX] + (size_t)row * 1024 : P.in[I_X] + (size_t)(row - NCTX) * 1024;
  else src = row < NCTX ? (const float*)(P.ws + OFF_CTXRES) + (size_t)row * 1024 : P.out + (size_t)(row - NCTX) * 1024;
  const float* mv = (const float*)(P.ws + OFF_MODV) + ((size_t)layer * 3 + mod_row(row)) * 6144;
  const float* sh = mv + (which ? 3 : 0) * 1024;
  const float* sc = mv + (which ? 4 : 1) * 1024;
  const float* nw = (which ? P.in[I_NORM2] : P.in[I_NORM1]) + layer * 1024;
  f32x4 v[4];
  float ss = 0.f;
#pragma unroll
  for (int i = 0; i < 4; ++i) {
    v[i] = *(const f32x4*)(src + i * 256 + lane * 4);
    ss += v[i].x * v[i].x + v[i].y * v[i].y + v[i].z * v[i].z + v[i].w * v[i].w;
  }
  ss = wave_sum(ss);
  const float rstd = frsq(ss * (1.f / 1024.f) + 1e-6f);
  bf16_t* dst = (bf16_t*)(P.ws + OFF_HBUF) + (size_t)row * 1024;
#pragma unroll
  for (int i = 0; i < 4; ++i) {
    int c = i * 256 + lane * 4;
    f32x4 w4 = *(const f32x4*)(nw + c), s4 = *(const f32x4*)(sc + c), h4 = *(const f32x4*)(sh + c);
    float o0 = v[i].x * rstd * w4.x * (1.f + s4.x) + h4.x;
    float o1 = v[i].y * rstd * w4.y * (1.f + s4.y) + h4.y;
    float o2 = v[i].z * rstd * w4.z * (1.f + s4.z) + h4.z;
    float o3 = v[i].w * rstd * w4.w * (1.f + s4.w) + h4.w;
    u32x2 pk; pk.x = pack2(o0, o1); pk.y = pack2(o2, o3);
    *(u32x2*)(dst + c) = pk;
  }
}

struct EpiProjL0 {
  bf16_t* proj; float* gates;
  DEVM void operator()(int row, int col, float v) const {
    proj[(size_t)row * EVC + col] = f2bf(v);
    if (col >= 1536 && col < 1552) gates[row * 32 + (col - 1536)] = v;
    else if (col >= 3088) gates[row * 32 + 16 + (col - 3088)] = v;
  }
};
struct EpiStoreBf {
  bf16_t* dst; int ld;
  DEVM void operator()(int row, int col, float v) const { dst[(size_t)row * ld + col] = f2bf(v); }
};
struct EpiStoreBfBias {
  bf16_t* dst; int ld; const float* bias;
  DEVM void operator()(int row, int col, float v) const { dst[(size_t)row * ld + col] = f2bf(v + (bias ? bias[col] : 0.f)); }
};
struct EpiProjL0T {
  bf16_t* proj; float* gates;
  DEVM void operator()(int, int, float) const {}
  DEVM void store4(int n, int m, float v0, float v1, float v2, float v3) const {
    u32x2 pk; pk.x = pack2(v0, v1); pk.y = pack2(v2, v3);
    *(u32x2*)(proj + (size_t)m * EVC + n) = pk;
    if (n >= 1536 && n < 1552) { f32x4 g = {v0, v1, v2, v3}; *(f32x4*)(gates + m * 32 + (n - 1536)) = g; }
    else if (n >= 3088) { f32x4 g = {v0, v1, v2, v3}; *(f32x4*)(gates + m * 32 + 16 + (n - 3088)) = g; }
  }
};
struct EpiStoreBfT {
  bf16_t* dst; int ld;
  DEVM void operator()(int, int, float) const {}
  DEVM void store4(int n, int m, float v0, float v1, float v2, float v3) const {
    u32x2 pk; pk.x = pack2(v0, v1); pk.y = pack2(v2, v3);
    *(u32x2*)(dst + (size_t)m * ld + n) = pk;
  }
};
struct EpiOutProjT {
  const float* x_lat; const float* x_ctx; float* o_lat; float* o_ctx; const float* modv;
  DEVM void operator()(int, int, float) const {}
  DEVM void store4(int n, int m, float v0, float v1, float v2, float v3) const {
    const f32x4 g = *(const f32x4*)(modv + mod_row(m) * 6144 + 2 * 1024 + n);
    const float* xs; float* od;
    if (m < NCTX) { xs = x_ctx + (size_t)m * 1024 + n; od = o_ctx + (size_t)m * 1024 + n; }
    else { size_t o = (size_t)(m - NCTX) * 1024 + n; xs = x_lat + o; od = o_lat + o; }
    const f32x4 x = *(const f32x4*)xs;
    f32x4 r = {x.x + g.x * v0, x.y + g.y * v1, x.z + g.z * v2, x.w + g.w * v3};
    *(f32x4*)od = r;
  }
};
struct EpiStoreBfBiasT {
  bf16_t* dst; int ld; const float* bias;
  DEVM void operator()(int, int, float) const {}
  DEVM void store4(int n, int m, float v0, float v1, float v2, float v3) const {
    if (bias) { v0 += bias[n]; v1 += bias[n + 1]; v2 += bias[n + 2]; v3 += bias[n + 3]; }
    u32x2 pk; pk.x = pack2(v0, v1); pk.y = pack2(v2, v3);
    *(u32x2*)(dst + (size_t)m * ld + n) = pk;
  }
};
struct EpiOutProj {
  const float* x_lat; const float* x_ctx; float* o_lat; float* o_ctx; const float* modv;
  DEVM void operator()(int row, int col, float v) const {
    float g = modv[mod_row(row) * 6144 + 2 * 1024 + col];
    if (row < NCTX) o_ctx[(size_t)row * 1024 + col] = x_ctx[(size_t)row * 1024 + col] + g * v;
    else { size_t o = (size_t)(row - NCTX) * 1024 + col; o_lat[o] = x_lat[o] + g * v; }
  }
};
struct EpiScoreLds {
  float* sS; int m0;
  DEVM void operator()(int row, int col, float v) const { sS[(row - m0) * 129 + col] = v; }
};

DEV void st_xbc_conv(const Params& P, int row) {
  const int lane = threadIdx.x & 63;
  const bf16_t* proj = (const bf16_t*)(P.ws + OFF_PROJ);
  bf16_t* xc = (bf16_t*)P.out + (size_t)row * 1024;
  int row0, len, pos;
  if (row < NCTX) { row0 = (row / CTXL) * CTXL; len = CTXL; pos = row - row0; }
  else { int r = row - NCTX; row0 = NCTX + (r / SEQ) * SEQ; len = SEQ; pos = r % SEQ; }
  const float* cw = P.in[I_SCONVW];
  const float* cb = P.in[I_SCONVB];
#pragma unroll
  for (int hh = 0; hh < 2; ++hh) {
    const int ch = hh * 512 + lane * 8;
    float o[8];
#pragma unroll
    for (int j = 0; j < 8; ++j) o[j] = cb[ch + j];
#pragma unroll
    for (int tap = 0; tap < 4; ++tap) {
      int pp = pos + tap - 2;
      if (pp >= 0 && pp < len) {
        float x[8];
        unpack8(*(const u32x4*)(proj + (size_t)(row0 + pp) * EVC + 2064 + ch), x);
        f32x4 w0 = *(const f32x4*)(cw + tap * 1024 + ch), w1 = *(const f32x4*)(cw + tap * 1024 + ch + 4);
        o[0] += w0.x * x[0]; o[1] += w0.y * x[1]; o[2] += w0.z * x[2]; o[3] += w0.w * x[3];
        o[4] += w1.x * x[4]; o[5] += w1.y * x[5]; o[6] += w1.z * x[6]; o[7] += w1.w * x[7];
      }
    }
#pragma unroll
    for (int j = 0; j < 8; ++j) o[j] = siluf_(o[j]);
    *(u32x4*)(xc + ch) = pack8(o);
  }
}

#ifndef LA_NSEG
#define LA_NSEG 10
#endif
constexpr int LA_NCH = (CTXL + SEQ) / 64;
constexpr int LA_CPS = LA_NCH / LA_NSEG;
static_assert(LA_NCH % LA_NSEG == 0, "linattn segments");
#ifdef CPU_EMU
constexpr size_t OFF_LASEG = OFF_PR + PR_BYTES;
#else
constexpr size_t OFF_LASEG = OFF_R2L0 + (size_t)NTOK * 1024 * 2;
#endif
constexpr size_t LASEG_U = (size_t)48 * LA_NSEG * 8192 * 4;
constexpr size_t OFF_LASEG_N = OFF_LASEG + LASEG_U;
constexpr size_t OFF_LASEG_D = OFF_LASEG_N + (size_t)48 * LA_NSEG * 64 * 4;
#ifndef CPU_EMU
static_assert(OFF_LASEG_D + 48 * LA_NSEG * 4 <= OFF_PR + PR_BYTES, "laseg");
#endif

struct LaRaw { u32x4 q[2], k[4], x[4]; float g0, g1; };

template <bool MLSTM, bool FULL>
DEV void la_load_raw(const Params& P, int b, int h, int d, int cc, LaRaw& R) {
  constexpr int NC_CTX = CTXL / 64;
  const int tid = threadIdx.x;
  const int seg = cc >= NC_CTX;
  const int row0 = seg ? NCTX + b * SEQ : b * CTXL;
  const int len = seg ? SEQ : CTXL;
  const int cl = (seg ? cc - NC_CTX : cc) * 64;
  const bf16_t* proj = (const bf16_t*)(P.ws + OFF_PROJ);
  const bf16_t* xcv = (const bf16_t*)P.out;
  const float* gates = (const float*)(P.ws + OFF_GATES);
  if (tid < 64) {
    int p = cl + tid, grow = row0 + (d ? len - 1 - p : p);
    if (MLSTM) { R.g0 = gates[grow * 32 + d * 4 + h]; R.g1 = gates[grow * 32 + 8 + d * 4 + h]; }
    else { R.g0 = gates[grow * 32 + 16 + d * 8 + h]; R.g1 = 0.f; }
  }
  if (MLSTM) {
#pragma unroll
    for (int i = 0; i < 2; ++i) {
      int c = tid + i * 256, r = c >> 3, cc8 = (c & 7) * 8;
      int p = cl + r, pos = d ? len - 1 - p : p;
      const bf16_t* rp = proj + (size_t)(row0 + pos) * EVC;
      if (FULL) R.q[i] = *(const u32x4*)(rp + h * 64 + cc8);
      R.k[i] = *(const u32x4*)(rp + 256 + h * 64 + cc8);
    }
#pragma unroll
    for (int i = 0; i < 4; ++i) {
      int c = tid + i * 256, r = c >> 4, cc8 = (c & 15) * 8;
      int p = cl + r, pos = d ? len - 1 - p : p;
      R.x[i] = *(const u32x4*)(proj + (size_t)(row0 + pos) * EVC + 512 + h * 128 + cc8);
    }
  } else {
    const int grp = h >> 2;
#pragma unroll
    for (int i = 0; i < 2; ++i) {
      int c = tid + i * 256, r = c >> 3, cc8 = (c & 7) * 8;
      int p = cl + r, pos = d ? len - 1 - p : p;
      R.x[i] = *(const u32x4*)(xcv + (size_t)(row0 + pos) * 1024 + h * 64 + cc8);
    }
#pragma unroll
    for (int i = 0; i < 4; ++i) {
      int c = tid + i * 256, r = c >> 4, cc8 = (c & 15) * 8;
      int p = cl + r, pos = d ? len - 1 - p : p;
      const bf16_t* rp = xcv + (size_t)(row0 + pos) * 1024;
      R.k[i] = *(const u32x4*)(rp + 512 + grp * 128 + cc8);
      if (FULL) { if (i < 2) R.q[i] = *(const u32x4*)(rp + 768 + grp * 128 + cc8); else R.x[i] = *(const u32x4*)(rp + 768 + grp * 128 + cc8); }
    }
  }
}

template <bool MLSTM, bool FULL>
DEV void st_linattn_seg(const Params& P, int sid, int seg, unsigned char* smem) {
  constexpr int DK = MLSTM ? 64 : 128, DX = MLSTM ? 128 : 64;
  constexpr int QS = DK + 8;
  constexpr int NH = MLSTM ? 4 : 8;
  constexpr int NC_CTX = CTXL / 64;
  const int tid = threadIdx.x, lane = tid & 63, wave = tid >> 6;
  const int d = sid & 1, h = (sid >> 1) % NH, b = (sid >> 1) / NH;
  const int gsid = MLSTM ? sid : 16 + sid;
  bf16_t* sQ = (bf16_t*)smem;
  bf16_t* sK = sQ + 64 * QS;
  bf16_t* sP = sK;
  bf16_t* sKT = sK + 64 * QS;
  bf16_t* sXT = sKT + DK * 72;
  bf16_t* sST = sXT + DX * 72;
  float* sF = (float*)(sST + DX * QS);
  float* sLa = sF;
  float* sG = sF + 64;
  float* sBc = sF + 128;
  float* sDen = sF + 192;
  float* sN = sF + 256;
  int* sRow = (int*)(sF + 384);
  static_assert((64 * QS * 2 + DK * 72 + DX * 72 + DX * QS) * 2 + 448 * 4 <= SMEM_BYTES, "lds");
  bf16_t* outb = MLSTM ? (bf16_t*)(P.ws + OFF_HBUF) : (bf16_t*)(P.ws + OFF_R2L0);
  float* segU = (float*)(P.ws + OFF_LASEG);
  float* segN = (float*)(P.ws + OFF_LASEG_N);
  float* segD = (float*)(P.ws + OFF_LASEG_D);

  f32x16 accS[2];
#pragma unroll
  for (int j = 0; j < 2; ++j)
#pragma unroll
    for (int r = 0; r < 16; ++r) accS[j][r] = 0.f;
  const int sx0 = MLSTM ? wave * 32 : (wave >> 1) * 32;
  const int sk0 = MLSTM ? 0 : (wave & 1) * 64;
  float nreg = 0.f;
  float gb0 = 0.f, gb1 = 0.f, alog_e = 0.f, dskip = 0.f;
  if (MLSTM) { gb0 = P.in[I_IBIAS][d * 4 + h]; gb1 = P.in[I_FBIAS][d * 4 + h]; }
  else { gb0 = P.in[I_DTBIAS][d * 8 + h]; alog_e = fexp(P.in[I_ALOG][d * 8 + h]); dskip = P.in[I_DSKIP][h]; }

  const int cc0 = seg * LA_CPS, cc1 = cc0 + LA_CPS;
  LaRaw R;
  la_load_raw<MLSTM, FULL>(P, b, h, d, cc0, R);
  __syncthreads();
  if (FULL) {
    for (int js = 0; js < seg; ++js) {
      const size_t it = (size_t)gsid * LA_NSEG + js;
      const float a = fexp(segD[it]);
      const float* U = segU + it * 8192;
#pragma unroll
      for (int j = 0; j < 2; ++j)
#pragma unroll
        for (int r = 0; r < 16; ++r) accS[j][r] = a * accS[j][r] + U[(j * 16 + r) * 256 + tid];
      if (MLSTM && tid < 64) nreg = a * nreg + segN[it * 64 + tid];
    }
#pragma unroll
    for (int j = 0; j < 2; ++j)
#pragma unroll
      for (int r = 0; r < 16; ++r) sST[(sx0 + acc_row(r, lane)) * QS + sk0 + j * 32 + (lane & 31)] = f2bf(accS[j][r]);
    if (tid < 128) sN[tid] = (MLSTM && tid < 64) ? nreg : 0.f;
  }
  float lsum = 0.f;

  for (int cc = cc0; cc < cc1; ++cc) {
    int tl_ = threadIdx.x; OPAQUE(tl_);
    const int tid = tl_, lane = tl_ & 63;
    const int sgi = cc >= NC_CTX;
    const int row0 = sgi ? NCTX + b * SEQ : b * CTXL;
    const int len = sgi ? SEQ : CTXL;
    const int cl = (sgi ? cc - NC_CTX : cc) * 64;
    if (tid < 64) {
      int p = cl + tid;
      sRow[tid] = row0 + (d ? len - 1 - p : p);
      if (MLSTM) { sLa[tid] = -softplusf_(-(R.g1 + gb1)); sG[tid] = fexp(R.g0 + gb0); }
      else { float dt = softplusf_(R.g0 + gb0); sLa[tid] = -dt * alog_e; sG[tid] = dt; }
    }
    __syncthreads();
    if (wave == 0) {
      float v = sLa[lane];
#pragma unroll
      for (int off = 1; off < 64; off <<= 1) {
#ifdef CPU_EMU
        float o = emu_shfl_up(v, off);
#else
        float o = __shfl_up(v, off, 64);
#endif
        if (lane >= off) v += o;
      }
      sBc[lane] = v;
    }
    __syncthreads();
    const float blast = sBc[63];
    lsum += blast;
    if (MLSTM) {
#pragma unroll
      for (int i = 0; i < 2; ++i) {
        int c = tid + i * 256, r = c >> 3, cc8 = (c & 7) * 8;
        float kf[8]; unpack8(R.k[i], kf);
        const float wgt = fexp(blast - sBc[r]) * sG[r];
#pragma unroll
        for (int j = 0; j < 8; ++j) sKT[(cc8 + j) * 72 + r] = f2bf(kf[j] * wgt);
        if (FULL) {
          float qf[8]; unpack8(R.q[i], qf);
#pragma unroll
          for (int j = 0; j < 8; ++j) qf[j] *= 0.125f;
          *(u32x4*)(sQ + r * QS + cc8) = pack8(qf);
          *(u32x4*)(sK + r * QS + cc8) = R.k[i];
        }
      }
#pragma unroll
      for (int i = 0; i < 4; ++i) {
        int c = tid + i * 256, r = c >> 4, cc8 = (c & 15) * 8;
        const bf16_t* xs = (const bf16_t*)&R.x[i];
#pragma unroll
        for (int j = 0; j < 8; ++j) sXT[(cc8 + j) * 72 + r] = xs[j];
      }
    } else {
#pragma unroll
      for (int i = 0; i < 2; ++i) {
        int c = tid + i * 256, r = c >> 3, cc8 = (c & 7) * 8;
        const bf16_t* xs = (const bf16_t*)&R.x[i];
#pragma unroll
        for (int j = 0; j < 8; ++j) sXT[(cc8 + j) * 72 + r] = xs[j];
      }
#pragma unroll
      for (int i = 0; i < 4; ++i) {
        int c = tid + i * 256, r = c >> 4, cc8 = (c & 15) * 8;
        float kf[8]; unpack8(R.k[i], kf);
        const float wgt = fexp(blast - sBc[r]) * sG[r];
#pragma unroll
        for (int j = 0; j < 8; ++j) sKT[(cc8 + j) * 72 + r] = f2bf(kf[j] * wgt);
        if (FULL) {
          *(u32x4*)(sK + r * QS + cc8) = R.k[i];
          *(u32x4*)(sQ + r * QS + cc8) = i < 2 ? R.q[i] : R.x[i];
        }
      }
    }
    if (cc + 1 < cc1) la_load_raw<MLSTM, FULL>(P, b, h, d, cc + 1, R);
    __syncthreads();
    if (FULL) {
      const int tr = (wave >> 1) * 32, tc = (wave & 1) * 32;
      f32x16 accP;
#pragma unroll
      for (int r = 0; r < 16; ++r) accP[r] = 0.f;
      if (!(tr == 0 && tc == 32)) {
#pragma unroll
        for (int kk = 0; kk < DK / 16; ++kk) {
          const int ko = kk * 16 + 8 * (lane >> 5);
          bf16x8 a = *(const bf16x8*)(sQ + (tr + (lane & 31)) * QS + ko);
          bf16x8 bb = *(const bf16x8*)(sK + (tc + (lane & 31)) * QS + ko);
          accP = mfma32(a, bb, accP);
        }
      }
      __syncthreads();
      {
        const int s = tc + (lane & 31);
        const float bs = sBc[s], gs = sG[s];
#pragma unroll
        for (int r = 0; r < 16; ++r) {
          int t = tr + acc_row(r, lane);
          float v = (s <= t) ? accP[r] * fexp(sBc[t] - bs) * gs : 0.f;
          sP[t * 72 + s] = f2bf(v);
        }
        for (int i = tid; i < 64 * DK; i += 256) {
          int t = i / DK, k = i % DK;
          sQ[t * QS + k] = f2bf(bf2f(sQ[t * QS + k]) * fexp(sBc[t]));
        }
      }
      __syncthreads();
      constexpr int NYT = MLSTM ? 2 : 1;
      const int yc0 = MLSTM ? (wave & 1) * 64 : (wave & 1) * 32;
      f32x16 accY[NYT];
#pragma unroll
      for (int j = 0; j < NYT; ++j)
#pragma unroll
        for (int r = 0; r < 16; ++r) accY[j][r] = 0.f;
#pragma unroll
      for (int kk = 0; kk < 4; ++kk) {
        const int ko = kk * 16 + 8 * (lane >> 5);
        bf16x8 a = *(const bf16x8*)(sP + (tr + (lane & 31)) * 72 + ko);
#pragma unroll
        for (int j = 0; j < NYT; ++j) {
          bf16x8 bb = *(const bf16x8*)(sXT + (yc0 + j * 32 + (lane & 31)) * 72 + ko);
          accY[j] = mfma32(a, bb, accY[j]);
        }
      }
#pragma unroll
      for (int kk = 0; kk < DK / 16; ++kk) {
        const int ko = kk * 16 + 8 * (lane >> 5);
        bf16x8 a = *(const bf16x8*)(sQ + (tr + (lane & 31)) * QS + ko);
#pragma unroll
        for (int j = 0; j < NYT; ++j) {
          bf16x8 bb = *(const bf16x8*)(sST + (yc0 + j * 32 + (lane & 31)) * QS + ko);
          accY[j] = mfma32(a, bb, accY[j]);
        }
      }
      if (MLSTM) {
        if (tid < 64) {
          float den = 0.f, dq = 0.f;
#pragma unroll 8
          for (int s = 0; s < 64; ++s) den += bf2f(sP[tid * 72 + s]);
#pragma unroll 8
          for (int k = 0; k < DK; ++k) dq += sN[k] * bf2f(sQ[tid * QS + k]);
          sDen[tid] = den + dq;
        }
        __syncthreads();
      }
#pragma unroll
      for (int j = 0; j < NYT; ++j)
#pragma unroll
        for (int r = 0; r < 16; ++r) {
          int t = tr + acc_row(r, lane);
          int x = yc0 + j * 32 + (lane & 31);
          float v = accY[j][r];
          if (MLSTM) {
            v = v * frcp(fmaxf(fabsf(sDen[t]), 1.f));
            outb[(size_t)sRow[t] * 1024 + d * 512 + h * 128 + x] = f2bf(v);
          } else {
            if (d == 0) v += dskip * bf2f(sXT[x * 72 + t]);
            outb[(size_t)sRow[t] * 1024 + d * 512 + h * 64 + x] = f2bf(v);
          }
        }
      __syncthreads();
    }
    {
      const float eb = fexp(blast);
#pragma unroll
      for (int j = 0; j < 2; ++j)
#pragma unroll
        for (int r = 0; r < 16; ++r) accS[j][r] *= eb;
#pragma unroll
      for (int kk = 0; kk < 4; ++kk) {
        const int ko = kk * 16 + 8 * (lane >> 5);
        bf16x8 a = *(const bf16x8*)(sXT + (sx0 + (lane & 31)) * 72 + ko);
#pragma unroll
        for (int j = 0; j < 2; ++j) {
          bf16x8 bb = *(const bf16x8*)(sKT + (sk0 + j * 32 + (lane & 31)) * 72 + ko);
          accS[j] = mfma32(a, bb, accS[j]);
        }
      }
      if (FULL) {
#pragma unroll
        for (int j = 0; j < 2; ++j)
#pragma unroll
          for (int r = 0; r < 16; ++r) sST[(sx0 + acc_row(r, lane)) * QS + sk0 + j * 32 + (lane & 31)] = f2bf(accS[j][r]);
      }
      if (MLSTM && tid < 64) {
        float nn = nreg * eb;
        for (int s = 0; s < 64; ++s) nn += bf2f(sKT[tid * 72 + s]);
        nreg = nn;
        if (FULL) sN[tid] = nn;
      }
    }
    __syncthreads();
  }
  if (!FULL) {
    const size_t it = (size_t)gsid * LA_NSEG + seg;
    float* U = segU + it * 8192;
#pragma unroll
    for (int j = 0; j < 2; ++j)
#pragma unroll
      for (int r = 0; r < 16; ++r) U[(j * 16 + r) * 256 + tid] = accS[j][r];
    if (MLSTM && tid < 64) segN[it * 64 + tid] = nreg;
    if (tid == 0) segD[it] = lsum;
  }
}

DEV void st_finish_l0(const Params& P, int row) {
  const int lane = threadIdx.x & 63;
  bf16_t* hb = (bf16_t*)(P.ws + OFF_HBUF) + (size_t)row * 1024;
  const bf16_t* yb = (const bf16_t*)(P.ws + OFF_R2L0) + (size_t)row * 1024;
  const bf16_t* pr = (const bf16_t*)(P.ws + OFF_PROJ) + (size_t)row * EVC;
  const int ch = lane * 8;
  float h0[8], h1[8], o[8], f1[8];
  unpack8(*(const u32x4*)(hb + ch), h0);
  unpack8(*(const u32x4*)(hb + 512 + ch), h1);
  unpack8(*(const u32x4*)(pr + 1024 + ch), o);
  float ss = 0.f;
#pragma unroll
  for (int j = 0; j < 8; ++j) { h0[j] += h1[j]; ss += h0[j] * h0[j]; }
  ss += wshfl_xor(ss, 1); ss += wshfl_xor(ss, 2); ss += wshfl_xor(ss, 4); ss += wshfl_xor(ss, 8);
  float rstd = frsq(ss * (1.f / 128.f) + 1e-6f);
#pragma unroll
  for (int j = 0; j < 8; ++j) f1[j] = h0[j] * rstd * P.in[I_MNORM][ch + j] * sigmoidf_(o[j]);
  float y0[8], y1[8], z[8], f2[8];
  unpack8(*(const u32x4*)(yb + ch), y0);
  unpack8(*(const u32x4*)(yb + 512 + ch), y1);
  unpack8(*(const u32x4*)(pr + 1552 + ch), z);
  float s2 = 0.f;
#pragma unroll
  for (int j = 0; j < 8; ++j) { y0[j] = (y0[j] + y1[j]) * siluf_(z[j]); s2 += y0[j] * y0[j]; }
  s2 = wave_sum(s2);
  float rstd2 = frsq(s2 * (1.f / 512.f) + 1e-6f);
#pragma unroll
  for (int j = 0; j < 8; ++j) f2[j] = y0[j] * rstd2 * P.in[I_SNORM][ch + j];
  *(u32x4*)(hb + ch) = pack8(f1);
  *(u32x4*)(hb + 512 + ch) = pack8(f2);
}

DEV float mixval(const bf16_t* __restrict__ proj, int row, int c, const float* __restrict__ mu) {
  float self = bf2f(proj[(size_t)row * ODC + c]);
  int nrow = -1;
  if (row < NCTX) {
    int pos = row % CTXL;
    if (c < 896) { if (pos > 0) nrow = row - 1; }
    else { if (pos < CTXL - 1) nrow = row + 1; }
  } else {
    int pos = (row - NCTX) % SEQ;
    int gx = pos % GW, gy = pos / GW, q = c / 448;
    if (q == 0) { if (gx > 0) nrow = row - 1; }
    else if (q == 1) { if (gx < GW - 1) nrow = row + 1; }
    else if (q == 2) { if (gy > 0) nrow = row - GW; }
    else { if (gy < SEQ / GW - 1) nrow = row + GW; }
  }
  float nb = nrow >= 0 ? bf2f(proj[(size_t)nrow * ODC + c]) : 0.f;
  return self + mu[c] * (nb - self);
}

DEV void st_lora_act(const Params& P, int row) {
  const int lane = threadIdx.x & 63;
  const bf16_t* proj = (const bf16_t*)(P.ws + OFF_PROJ);
  bf16_t* hb = (bf16_t*)(P.ws + OFF_HBUF) + (size_t)row * 1024;
  float v[4];
#pragma unroll
  for (int j = 0; j < 4; ++j) {
    int c = lane * 4 + j;
    float x = mixval(proj, row, 1536 + c, P.in[I_MU]);
    v[j] = c < 64 ? tanhf_(x) : (c < 128 ? x : sigmoidf_(x));
  }
  u32x2 pk; pk.x = pack2(v[0], v[1]); pk.y = pack2(v[2], v[3]);
  *(u32x2*)(hb + lane * 4) = pk;
}

DEV void st_rwkv_stream(const Params& P, int sid, unsigned char* smem) {
  const int tid = threadIdx.x, lane = tid & 63, wave = tid >> 6;
  const int d = sid & 1, h = (sid >> 1) & 7, b = sid >> 4;
  float* sR = (float*)smem;
  float* sW = sR + 2048;
  float* sKk = sW + 2048;
  float* sV = sKk + 2048;
  float* sA = sV + 2048;
  float* sBb = sA + 2048;
  float* sY = sBb + 2048;
  int* sRow = (int*)(sY + 2048);
  const bf16_t* proj = (const bf16_t*)(P.ws + OFF_PROJ);
  const bf16_t* lora = (const bf16_t*)(P.ws + OFF_LORA);
  bf16_t* yout = (bf16_t*)(P.ws + OFF_HBUF);
  const float* mu = P.in[I_MU];
  const int vrow = tid >> 2, j4 = tid & 3;
  float S[16];
#pragma unroll
  for (int i = 0; i < 16; ++i) S[i] = 0.f;
  const float kkw = P.in[I_KK][h * 64 + lane], kaw = P.in[I_KA][h * 64 + lane];
  for (int seg = 0; seg < 2; ++seg) {
    const int row0 = seg == 0 ? b * CTXL : NCTX + b * SEQ;
    const int len = seg == 0 ? CTXL : SEQ;
    for (int it = 0; it < len / 32; ++it) {
      __syncthreads();
      for (int s = wave; s < 32; s += 4) {
        int p = it * 32 + s, pos = d ? len - 1 - p : p, row = row0 + pos;
        int c = h * 64 + lane;
        float r = mixval(proj, row, c, mu);
        float k = mixval(proj, row, 512 + c, mu);
        float v = mixval(proj, row, 1024 + c, mu);
        float kk = k * kkw;
        float ss = wave_sum(kk * kk);
        kk *= frsq(ss + 1e-12f);
        float lw = bf2f(lora[((size_t)d * NTOK + row) * 512 + c]);
        float la = bf2f(lora[((size_t)(2 + d) * NTOK + row) * 512 + c]);
        float w = fexp(-0.6065306597126334f * sigmoidf_(lw));
        float a = sigmoidf_(la);
        float kt = k * (1.f + (a - 1.f) * kaw);
        sR[s * 64 + lane] = r; sW[s * 64 + lane] = w; sKk[s * 64 + lane] = kt; sV[s * 64 + lane] = v;
        sA[s * 64 + lane] = -kk; sBb[s * 64 + lane] = kk * a;
        if (lane == 0) sRow[s] = row;
      }
      __syncthreads();
      for (int s = 0; s < 32; ++s) {
        const float* pa = sA + s * 64 + j4 * 16;
        const float* pw = sW + s * 64 + j4 * 16;
        const float* pk = sKk + s * 64 + j4 * 16;
        const float* pb = sBb + s * 64 + j4 * 16;
        const float* pr = sR + s * 64 + j4 * 16;
        const float vv = sV[s * 64 + vrow];
        float sa = 0.f;
#pragma unroll
        for (int i = 0; i < 16; ++i) sa += S[i] * pa[i];
        sa += wshfl_xor(sa, 1); sa += wshfl_xor(sa, 2);
        float y = 0.f;
#pragma unroll
        for (int i = 0; i < 16; ++i) { S[i] = S[i] * pw[i] + sa * pb[i] + vv * pk[i]; y += S[i] * pr[i]; }
        y += wshfl_xor(y, 1); y += wshfl_xor(y, 2);
        if (j4 == 0) sY[s * 64 + vrow] = y;
      }
      __syncthreads();
      for (int i = tid; i < 2048; i += 256) {
        int s = i >> 6, c = i & 63;
        yout[(size_t)sRow[s] * 1024 + d * 512 + h * 64 + c] = f2bf(sY[i]);
      }
    }
  }
}


DEV int nbr_row(int row, int c) {
  if (row < NCTX) {
    int pos = row % CTXL;
    if (c < 896) return pos > 0 ? row - 1 : -1;
    return pos < CTXL - 1 ? row + 1 : -1;
  }
  int pos = (row - NCTX) % SEQ;
  int gx = pos % GW, gy = pos / GW, q = c / 448;
  if (q == 0) return gx > 0 ? row - 1 : -1;
  if (q == 1) return gx < GW - 1 ? row + 1 : -1;
  if (q == 2) return gy > 0 ? row - GW : -1;
  return gy < SEQ / GW - 1 ? row + GW : -1;
}

struct RwkvRaw { u32x4 rs, rn, ks, kn, vs, vn, lw, la; int row; };

DEV void rwkv_load_raw(const bf16_t* __restrict__ proj, const bf16_t* __restrict__ lora, int b, int h, int d, int cc, int t, int c0,
                       RwkvRaw& R) {
  constexpr int NC_CTX = CTXL / 32;
  const int seg = cc >= NC_CTX;
  const int row0 = seg ? NCTX + b * SEQ : b * CTXL;
  const int len = seg ? SEQ : CTXL;
  const int p = (seg ? cc - NC_CTX : cc) * 32 + t;
  const int row = row0 + (d ? len - 1 - p : p);
  const int col = h * 64 + c0;
  const u32x4 z4 = {0u, 0u, 0u, 0u};
  const bf16_t* rp = proj + (size_t)row * ODC;
  R.row = row;
  R.rs = *(const u32x4*)(rp + col);
  R.ks = *(const u32x4*)(rp + 512 + col);
  R.vs = *(const u32x4*)(rp + 1024 + col);
  int n0 = nbr_row(row, col), n1 = nbr_row(row, 512 + col), n2 = nbr_row(row, 1024 + col);
  R.rn = n0 >= 0 ? *(const u32x4*)(proj + (size_t)n0 * ODC + col) : z4;
  R.kn = n1 >= 0 ? *(const u32x4*)(proj + (size_t)n1 * ODC + 512 + col) : z4;
  R.vn = n2 >= 0 ? *(const u32x4*)(proj + (size_t)n2 * ODC + 1024 + col) : z4;
  R.lw = *(const u32x4*)(lora + ((size_t)d * NTOK + row) * 512 + col);
  R.la = *(const u32x4*)(lora + ((size_t)(2 + d) * NTOK + row) * 512 + col);
}

#ifndef RW_NSEG
#define RW_NSEG 16
#endif
constexpr int RW_NCH = (CTXL + SEQ) / 32;
constexpr size_t OFF_RWSEG = OFF_PU;
static_assert((size_t)32 * RW_NSEG * 64 * 128 * 4 <= (size_t)2 * NEXP * 1024, "rwseg");

template <bool FULL>
DEV void st_rwkv_seg(const Params& P, int sid, int seg, unsigned char* smem) {
  constexpr int NVB = FULL ? 2 : 4;
  constexpr int ZR = FULL ? 64 : 128;
  const int tid = threadIdx.x, lane = tid & 63, wave = tid >> 6;
  const int d = sid & 1, h = (sid >> 1) & 7, b = sid >> 4;
  bf16_t* sAt = (bf16_t*)smem;
  bf16_t* sRt = sAt + 32 * 72;
  bf16_t* sBt = sRt + 32 * 72;
  bf16_t* sKt = sBt + 32 * 72;
  bf16_t* sBT = sKt + 32 * 72;
  bf16_t* sKT = sBT + 64 * 40;
  bf16_t* sVT = sKT + 64 * 40;
  bf16_t* sLak = sVT + 64 * 40;
  bf16_t* sM = sLak + 32 * 40;
  bf16_t* sLrb = sM + 32 * 40;
  bf16_t* sLrk = sLrb + 32 * 40;
  bf16_t* sZ = FULL ? sLrk + 32 * 40 : sLrb;
  bf16_t* after = sZ + ZR * 72;
  bf16_t* sRT = FULL ? after : nullptr;
  bf16_t* sSAT = FULL ? after + 64 * 40 : sRt;
  float* sLP = (float*)(FULL ? after + 2 * 64 * 40 : after);
  float* sLab = sLP + 32 * 64;
  float* sD = sLab + 32 * 33;
  float* sPT = sD + 768;
  int* sRow = (int*)(sPT + 64);
  if (!FULL) sRT = (bf16_t*)sLP;
  static_assert((4 * 32 * 72 + 3 * 64 * 40 + 4 * 32 * 40 + 2 * 64 * 40 + 64 * 72) * 2 + (32 * 64 + 32 * 33 + 768 + 64 + 32 + 320) * 4 + 16 <= SMEM_BYTES, "lds full");
  static_assert((4 * 32 * 72 + 3 * 64 * 40 + 2 * 32 * 40 + 128 * 72) * 2 + (32 * 64 + 32 * 33 + 768 + 64 + 32) * 4 <= SMEM_BYTES, "lds p1");
  static_assert(128 * 40 * 2 <= (32 * 64 + 32 * 33) * 4 && 128 * 40 <= 3 * 32 * 72, "alias");
  const bf16_t* proj = (const bf16_t*)(P.ws + OFF_PROJ);
  const bf16_t* lora = (const bf16_t*)(P.ws + OFF_LORA);
  bf16_t* yout = (bf16_t*)(P.ws + OFF_HBUF);
  float* segZ = (float*)(P.ws + OFF_RWSEG);
  const int t = tid >> 3, c0 = (tid & 7) * 8;
  const int hl = lane >> 5, l31 = lane & 31;
  float* sCst = (float*)(smem + SMEM_BYTES - 320 * 4 - 16);
  if (tid < 64) {
    sCst[tid] = P.in[I_MU][h * 64 + tid]; sCst[64 + tid] = P.in[I_MU][512 + h * 64 + tid]; sCst[128 + tid] = P.in[I_MU][1024 + h * 64 + tid];
    sCst[192 + tid] = P.in[I_KK][h * 64 + tid]; sCst[256 + tid] = P.in[I_KA][h * 64 + tid];
  }
  const int cc0 = (seg * RW_NCH) / RW_NSEG, cc1 = ((seg + 1) * RW_NCH) / RW_NSEG;
  RwkvRaw R;
  rwkv_load_raw(proj, lora, b, h, d, cc0, t, c0, R);
  f32x16 Zm[2];
#pragma unroll
  for (int j = 0; j < 2; ++j)
#pragma unroll
    for (int r = 0; r < 16; ++r) Zm[j][r] = 0.f;
  __syncthreads();
  for (int i = tid; i < ZR * 72; i += 256) sZ[i] = 0;
  __syncthreads();
  if (!FULL) {
    if (wave >= 2) {
#pragma unroll
      for (int cb = 0; cb < 2; ++cb)
#pragma unroll
        for (int r = 0; r < 16; ++r) {
          int c = cb * 32 + acc_row(r, lane), vp = wave * 32 + l31;
          if (c == vp - 64) { Zm[cb][r] = 1.f; sZ[vp * 72 + c] = 0x3f80; }
        }
    }
  } else {
    for (int js = 0; js < seg; ++js) {
      const float* Zs = segZ + ((size_t)sid * RW_NSEG + js) * 64 * 128;
      bf16_t* sG = sAt;
      for (int i = tid; i < 64 * 64; i += 256) { int c = i >> 6, c2 = i & 63; sG[c * 72 + c2] = f2bf(Zs[c * 128 + 64 + c2]); }
      __syncthreads();
      if (wave >= 2) {
        const int cb = wave - 2;
#pragma unroll
        for (int vb = 0; vb < 2; ++vb) {
          f32x16 acc;
#pragma unroll
          for (int r = 0; r < 16; ++r) acc[r] = Zs[(cb * 32 + acc_row(r, lane)) * 128 + vb * 32 + l31];
#pragma unroll
          for (int kk = 0; kk < 4; ++kk) {
            bf16x8 a = *(const bf16x8*)(sG + (cb * 32 + l31) * 72 + kk * 16 + 8 * hl);
            bf16x8 bb = *(const bf16x8*)(sZ + (vb * 32 + l31) * 72 + kk * 16 + 8 * hl);
            acc = mfma32(a, bb, acc);
          }
          Zm[vb] = acc;
        }
      }
      __syncthreads();
      if (wave >= 2) {
        const int cb = wave - 2;
#pragma unroll
        for (int vb = 0; vb < 2; ++vb)
#pragma unroll
          for (int g = 0; g < 4; ++g) {
            u32x2 pk; pk.x = pack2(Zm[vb][4 * g], Zm[vb][4 * g + 1]); pk.y = pack2(Zm[vb][4 * g + 2], Zm[vb][4 * g + 3]);
            *(u32x2*)(sZ + (vb * 32 + l31) * 72 + cb * 32 + 8 * g + 4 * hl) = pk;
          }
      }
      __syncthreads();
    }
  }
  for (int cc = cc0; cc < cc1; ++cc) {
    int tl_ = threadIdx.x; OPAQUE(tl_);
    const int tid = tl_, lane = tl_ & 63, hl = lane >> 5, l31 = lane & 31, t = tl_ >> 3, c0 = (tl_ & 7) * 8;
    const float* muR = sCst + c0; const float* muK = sCst + 64 + c0; const float* muV = sCst + 128 + c0;
    const float* kkw = sCst + 192 + c0; const float* kaw = sCst + 256 + c0;
    float lw8[8], lp8[8];
    {
      float lwf[8];
      unpack8(R.lw, lwf);
#pragma unroll
      for (int j = 0; j < 8; ++j) { lw8[j] = -0.6065306597126334f * sigmoidf_(lwf[j]); lp8[j] = lw8[j]; }
#pragma unroll
      for (int off = 8; off < 64; off <<= 1) {
#pragma unroll
        for (int j = 0; j < 8; ++j) {
#ifdef CPU_EMU
          float o = emu_shfl_up(lp8[j], off);
#else
          float o = __shfl_up(lp8[j], off, 64);
#endif
          if (lane >= off) lp8[j] += o;
        }
      }
      if (lane >= 56) {
#pragma unroll
        for (int j = 0; j < 8; ++j) sLP[wave * 64 + c0 + j] = lp8[j];
      }
      if ((tid & 7) == 0) sRow[t] = R.row;
    }
    __syncthreads();
    {
#pragma unroll
      for (int j = 0; j < 8; ++j) {
        float offs = 0.f;
        for (int w2 = 0; w2 < wave; ++w2) offs += sLP[w2 * 64 + c0 + j];
        lp8[j] += offs;
      }
      if (t == 31) {
#pragma unroll
        for (int j = 0; j < 8; ++j) sPT[c0 + j] = fexp(lp8[j]);
      }
    }
    {
      float xs[8], xn[8], kt[8], aa[8], ob[8], ok[8];
      unpack8(R.ks, xs); unpack8(R.kn, xn);
      float ss = 0.f;
#pragma unroll
      for (int j = 0; j < 8; ++j) { kt[j] = xs[j] + muK[j] * (xn[j] - xs[j]); aa[j] = kt[j] * kkw[j]; ss += aa[j] * aa[j]; }
      ss += wshfl_xor(ss, 1); ss += wshfl_xor(ss, 2); ss += wshfl_xor(ss, 4);
      const float rn = frsq(ss + 1e-12f);
      float laf[8];
      unpack8(R.la, laf);
#pragma unroll
      for (int j = 0; j < 8; ++j) {
        const float lp = lp8[j];
        const float lpm = lp8[j] - lw8[j];
        const float e = fexp(-lp);
        const float kkn = aa[j] * rn;
        const float asg = sigmoidf_(laf[j]);
        aa[j] = -kkn * fexp(lpm);
        ob[j] = kkn * asg * e;
        ok[j] = kt[j] * (1.f + (asg - 1.f) * kaw[j]) * e;
      }
      *(u32x4*)(sAt + t * 72 + c0) = pack8(aa);
      *(u32x4*)(sBt + t * 72 + c0) = pack8(ob);
      *(u32x4*)(sKt + t * 72 + c0) = pack8(ok);
#pragma unroll
      for (int j = 0; j < 8; ++j) { sBT[(c0 + j) * 40 + t] = f2bf(ob[j]); sKT[(c0 + j) * 40 + t] = f2bf(ok[j]); }
      unpack8(R.vs, xs); unpack8(R.vn, xn);
#pragma unroll
      for (int j = 0; j < 8; ++j) sVT[(c0 + j) * 40 + t] = f2bf(xs[j] + muV[j] * (xn[j] - xs[j]));
      if (FULL) {
        unpack8(R.rs, xs); unpack8(R.rn, xn);
#pragma unroll
        for (int j = 0; j < 8; ++j) xs[j] = (xs[j] + muR[j] * (xn[j] - xs[j])) * fexp(lp8[j]);
        *(u32x4*)(sRt + t * 72 + c0) = pack8(xs);
      }
    }
    if (cc + 1 < cc1) rwkv_load_raw(proj, lora, b, h, d, cc + 1, t, c0, R);
    __syncthreads();
    if (FULL || wave < 2) {
      const bf16_t* Asrc = wave < 2 ? sAt : sRt;
      const bf16_t* Bsrc = (wave & 1) ? sKt : sBt;
      f32x16 acc;
#pragma unroll
      for (int r = 0; r < 16; ++r) acc[r] = 0.f;
#pragma unroll
      for (int kk = 0; kk < 4; ++kk) {
        bf16x8 a = *(const bf16x8*)(Asrc + l31 * 72 + kk * 16 + 8 * hl);
        bf16x8 bb = *(const bf16x8*)(Bsrc + l31 * 72 + kk * 16 + 8 * hl);
        acc = mfma32(a, bb, acc);
      }
      bf16_t* dst = wave == 1 ? sLak : (wave == 2 ? sLrb : sLrk);
#pragma unroll
      for (int r = 0; r < 16; ++r) {
        int tt = acc_row(r, lane), j = l31;
        bool keep = wave < 2 ? (j < tt) : (j <= tt);
        float v = keep ? acc[r] : 0.f;
        if (wave == 0) sLab[tt * 33 + j] = v;
        else dst[tt * 40 + j] = f2bf(v);
      }
    }
    __syncthreads();
    if (tid < 32) {
      const int q = tid >> 4, c = tid & 15;
      float x[16];
#pragma unroll
      for (int i = 0; i < 16; ++i) {
        float sacc = (i == c) ? 1.f : 0.f;
#pragma unroll
        for (int j = 0; j < i; ++j) sacc += sLab[(q * 16 + i) * 33 + q * 16 + j] * x[j];
        x[i] = sacc;
        sD[q * 256 + i * 16 + c] = sacc;
      }
    }
    __syncthreads();
    {
      const int i = tid >> 4, c = tid & 15;
      float sacc = 0.f;
#pragma unroll
      for (int j = 0; j < 16; ++j) sacc += sLab[(16 + i) * 33 + j] * sD[j * 16 + c];
      sD[512 + i * 16 + c] = sacc;
    }
    __syncthreads();
    {
      const int i = tid >> 4, c = tid & 15;
      float sacc = 0.f;
#pragma unroll
      for (int j = 0; j < 16; ++j) sacc += sD[256 + i * 16 + j] * sD[512 + j * 16 + c];
      sM[(16 + i) * 40 + c] = f2bf(sacc);
      sM[i * 40 + c] = f2bf(sD[i * 16 + c]);
      sM[(16 + i) * 40 + 16 + c] = f2bf(sD[256 + i * 16 + c]);
      sM[i * 40 + 16 + c] = 0;
    }
    if (wave < NVB) {
      const int vb = wave;
      f32x16 acc;
#pragma unroll
      for (int r = 0; r < 16; ++r) acc[r] = 0.f;
#pragma unroll
      for (int kk = 0; kk < 4; ++kk) {
        bf16x8 a = *(const bf16x8*)(sAt + l31 * 72 + kk * 16 + 8 * hl);
        bf16x8 bb = *(const bf16x8*)(sZ + (vb * 32 + l31) * 72 + kk * 16 + 8 * hl);
        acc = mfma32(a, bb, acc);
      }
      if (vb < 2) {
#pragma unroll
        for (int kk = 0; kk < 2; ++kk) {
          bf16x8 a = *(const bf16x8*)(sLak + l31 * 40 + kk * 16 + 8 * hl);
          bf16x8 bb = *(const bf16x8*)(sVT + (vb * 32 + l31) * 40 + kk * 16 + 8 * hl);
          acc = mfma32(a, bb, acc);
        }
      }
#pragma unroll
      for (int g = 0; g < 4; ++g) {
        u32x2 pk; pk.x = pack2(acc[4 * g], acc[4 * g + 1]); pk.y = pack2(acc[4 * g + 2], acc[4 * g + 3]);
        *(u32x2*)(sRT + (vb * 32 + l31) * 40 + 8 * g + 4 * hl) = pk;
      }
    }
    __syncthreads();
    if (wave < NVB) {
      const int vb = wave;
      f32x16 acc;
#pragma unroll
      for (int r = 0; r < 16; ++r) acc[r] = 0.f;
#pragma unroll
      for (int kk = 0; kk < 2; ++kk) {
        bf16x8 a = *(const bf16x8*)(sM + l31 * 40 + kk * 16 + 8 * hl);
        bf16x8 bb = *(const bf16x8*)(sRT + (vb * 32 + l31) * 40 + kk * 16 + 8 * hl);
        acc = mfma32(a, bb, acc);
      }
#pragma unroll
      for (int g = 0; g < 4; ++g) {
        u32x2 pk; pk.x = pack2(acc[4 * g], acc[4 * g + 1]); pk.y = pack2(acc[4 * g + 2], acc[4 * g + 3]);
        *(u32x2*)(sSAT + (vb * 32 + l31) * 40 + 8 * g + 4 * hl) = pk;
      }
    }
    __syncthreads();
    if (FULL) {
      if (wave < 2) {
        const int vb = wave;
        f32x16 acc;
#pragma unroll
        for (int r = 0; r < 16; ++r) acc[r] = 0.f;
#pragma unroll
        for (int kk = 0; kk < 4; ++kk) {
          bf16x8 a = *(const bf16x8*)(sRt + l31 * 72 + kk * 16 + 8 * hl);
          bf16x8 bb = *(const bf16x8*)(sZ + (vb * 32 + l31) * 72 + kk * 16 + 8 * hl);
          acc = mfma32(a, bb, acc);
        }
#pragma unroll
        for (int kk = 0; kk < 2; ++kk) {
          bf16x8 a = *(const bf16x8*)(sLrb + l31 * 40 + kk * 16 + 8 * hl);
          bf16x8 bb = *(const bf16x8*)(sSAT + (vb * 32 + l31) * 40 + kk * 16 + 8 * hl);
          acc = mfma32(a, bb, acc);
        }
#pragma unroll
        for (int kk = 0; kk < 2; ++kk) {
          bf16x8 a = *(const bf16x8*)(sLrk + l31 * 40 + kk * 16 + 8 * hl);
          bf16x8 bb = *(const bf16x8*)(sVT + (vb * 32 + l31) * 40 + kk * 16 + 8 * hl);
          acc = mfma32(a, bb, acc);
        }
#pragma unroll
        for (int r = 0; r < 16; ++r) {
          int tt = acc_row(r, lane);
          yout[(size_t)sRow[tt] * 1024 + d * 512 + h * 64 + vb * 32 + l31] = f2bf(acc[r]);
        }
      } else {
        const int cb = wave - 2;
#pragma unroll
        for (int vb = 0; vb < 2; ++vb) {
          f32x16 acc;
#pragma unroll
          for (int r = 0; r < 16; ++r) acc[r] = 0.f;
#pragma unroll
          for (int kk = 0; kk < 2; ++kk) {
            bf16x8 a = *(const bf16x8*)(sBT + (cb * 32 + l31) * 40 + kk * 16 + 8 * hl);
            bf16x8 bb = *(const bf16x8*)(sSAT + (vb * 32 + l31) * 40 + kk * 16 + 8 * hl);
            acc = mfma32(a, bb, acc);
          }
#pragma unroll
          for (int kk = 0; kk < 2; ++kk) {
            bf16x8 a = *(const bf16x8*)(sKT + (cb * 32 + l31) * 40 + kk * 16 + 8 * hl);
            bf16x8 bb = *(const bf16x8*)(sVT + (vb * 32 + l31) * 40 + kk * 16 + 8 * hl);
            acc = mfma32(a, bb, acc);
          }
#pragma unroll
          for (int r = 0; r < 16; ++r) Zm[vb][r] = sPT[cb * 32 + acc_row(r, lane)] * (Zm[vb][r] + acc[r]);
        }
      }
      __syncthreads();
      if (wave >= 2) {
        const int cb = wave - 2;
#pragma unroll
        for (int vb = 0; vb < 2; ++vb)
#pragma unroll
          for (int g = 0; g < 4; ++g) {
            u32x2 pk; pk.x = pack2(Zm[vb][4 * g], Zm[vb][4 * g + 1]); pk.y = pack2(Zm[vb][4 * g + 2], Zm[vb][4 * g + 3]);
            *(u32x2*)(sZ + (vb * 32 + l31) * 72 + cb * 32 + 8 * g + 4 * hl) = pk;
          }
      }
    } else {
      const int vb = wave;
#pragma unroll
      for (int cb = 0; cb < 2; ++cb) {
        f32x16 acc;
#pragma unroll
        for (int r = 0; r < 16; ++r) acc[r] = 0.f;
#pragma unroll
        for (int kk = 0; kk < 2; ++kk) {
          bf16x8 a = *(const bf16x8*)(sBT + (cb * 32 + l31) * 40 + kk * 16 + 8 * hl);
          bf16x8 bb = *(const bf16x8*)(sSAT + (vb * 32 + l31) * 40 + kk * 16 + 8 * hl);
          acc = mfma32(a, bb, acc);
        }
        if (vb < 2) {
#pragma unroll
          for (int kk = 0; kk < 2; ++kk) {
            bf16x8 a = *(const bf16x8*)(sKT + (cb * 32 + l31) * 40 + kk * 16 + 8 * hl);
            bf16x8 bb = *(const bf16x8*)(sVT + (vb * 32 + l31) * 40 + kk * 16 + 8 * hl);
            acc = mfma32(a, bb, acc);
          }
        }
#pragma unroll
        for (int r = 0; r < 16; ++r) Zm[cb][r] = sPT[cb * 32 + acc_row(r, lane)] * (Zm[cb][r] + acc[r]);
      }
#pragma unroll
      for (int cb = 0; cb < 2; ++cb)
#pragma unroll
        for (int g = 0; g < 4; ++g) {
          u32x2 pk; pk.x = pack2(Zm[cb][4 * g], Zm[cb][4 * g + 1]); pk.y = pack2(Zm[cb][4 * g + 2], Zm[cb][4 * g + 3]);
          *(u32x2*)(sZ + (vb * 32 + l31) * 72 + cb * 32 + 8 * g + 4 * hl) = pk;
        }
    }
  }
  if (!FULL) {
    float* Zs = segZ + ((size_t)sid * RW_NSEG + seg) * 64 * 128;
#pragma unroll
    for (int cb = 0; cb < 2; ++cb)
#pragma unroll
      for (int r = 0; r < 16; ++r) Zs[(cb * 32 + acc_row(r, lane)) * 128 + wave * 32 + l31] = Zm[cb][r];
  }
}

constexpr int LRU_NCH = (CTXL + SEQ) / 64;
constexpr size_t OFF_ACUM0 = OFF_PU;
static_assert((size_t)NLAT * 512 * 2 <= (size_t)2 * NEXP * 1024, "acum0");

DEV void st_lru_chunk(const Params& P, int sid, int cc, unsigned char* smem) {
  constexpr int NC_CTX = CTXL / 64;
  const int tid = threadIdx.x, lane = tid & 63, wave = tid >> 6;
  const int d = sid & 1, blk = (sid >> 1) & 7, b = sid >> 4;
  float* sXc = (float*)smem;
  float* sAc = sXc + 4096;
  float* sBc = sAc + 4096;
  float* sU = sBc + 4096;
  bf16_t* sAop = (bf16_t*)(sU + 4096);
  float* sQA = (float*)(sAop + 64 * 72);
  float* sQH = sQA + 256;
  int* sRow = (int*)(sQH + 256);
  const bf16_t* proj = (const bf16_t*)(P.ws + OFF_PROJ);
  bf16_t* uout = (bf16_t*)(P.ws + OFF_LORA) + (size_t)d * NTOK * 512;
  bf16_t* aout = (bf16_t*)(P.ws + (d ? OFF_ACUM1 : OFF_ACUM0));
  const bf16_t* lruT = (const bf16_t*)(P.ws + OFF_LRUT) + (size_t)(d * 8 + blk) * 128 * 64;
  float* chunkS = (float*)(P.ws + OFF_LRUCS) + ((size_t)sid * LRU_NCH + cc) * 128;
  const float* cw = P.in[I_LCONVW];
  const float* cb = P.in[I_LCONVB];
  const int tr = (wave >> 1) * 32, nc0 = (wave & 1) * 64;
  const int sgi = cc >= NC_CTX;
  const int row0 = sgi ? NCTX + b * SEQ : b * CTXL;
  const int len = sgi ? SEQ : CTXL;
  const int cl = (sgi ? cc - NC_CTX : cc) * 64;
  __syncthreads();
  if (tid < 64) { int p = cl + tid; sRow[tid] = row0 + (d ? len - 1 - p : p); }
  {
    const int lc8 = (tid & 7) * 8, lch = blk * 64 + lc8;
#pragma unroll
    for (int i = 0; i < 2; ++i) {
      int c = tid + i * 256, r = c >> 3;
      int p = cl + r, pos = d ? len - 1 - p : p;
      float o[8];
      f32x4 c0 = *(const f32x4*)(cb + lch), c1 = *(const f32x4*)(cb + lch + 4);
      o[0] = c0.x; o[1] = c0.y; o[2] = c0.z; o[3] = c0.w; o[4] = c1.x; o[5] = c1.y; o[6] = c1.z; o[7] = c1.w;
#pragma unroll
      for (int tap = 0; tap < 4; ++tap) {
        int pp = pos + tap - 2;
        if (pp >= 0 && pp < len) {
          float x[8];
          unpack8(*(const u32x4*)(proj + (size_t)(row0 + pp) * ODC + 2304 + lch), x);
          f32x4 w0 = *(const f32x4*)(cw + tap * 512 + lch), w1 = *(const f32x4*)(cw + tap * 512 + lch + 4);
          o[0] += w0.x * x[0]; o[1] += w0.y * x[1]; o[2] += w0.z * x[2]; o[3] += w0.w * x[3];
          o[4] += w1.x * x[4]; o[5] += w1.y * x[5]; o[6] += w1.z * x[6]; o[7] += w1.w * x[7];
        }
      }
#pragma unroll
      for (int j = 0; j < 8; ++j) sXc[r * 64 + lc8 + j] = o[j];
      *(u32x4*)(sAop + r * 72 + lc8) = pack8(o);
    }
  }
  __syncthreads();
  {
    f32x16 acc[2];
#pragma unroll
    for (int j = 0; j < 2; ++j)
#pragma unroll
      for (int r = 0; r < 16; ++r) acc[j][r] = 0.f;
#pragma unroll
    for (int kk = 0; kk < 4; ++kk) {
      bf16x8 a = *(const bf16x8*)(sAop + (tr + (lane & 31)) * 72 + kk * 16 + 8 * (lane >> 5));
#pragma unroll
      for (int j = 0; j < 2; ++j) {
        bf16x8 bb = *(const bf16x8*)(lruT + (nc0 + j * 32 + (lane & 31)) * 64 + kk * 16 + 8 * (lane >> 5));
        acc[j] = mfma32(a, bb, acc[j]);
      }
    }
#pragma unroll
    for (int j = 0; j < 2; ++j) {
      const int e = nc0 + j * 32 + (lane & 31);
      const int ch = blk * 64 + (e & 63);
      const float ebias = e < 64 ? P.in[I_BA][d * 512 + ch] : P.in[I_BI][d * 512 + ch];
      const float esp = softplusf_(-P.in[I_LAM][d * 512 + ch]);
#pragma unroll
      for (int r = 0; r < 16; ++r) {
        int t = tr + acc_row(r, lane);
        float g = sigmoidf_(acc[j][r] + ebias);
        if (e < 64) { float a_ = fexp(-8.f * g * esp); sAc[t * 64 + e] = a_; sU[t * 64 + e] = fsqrt(fmaxf(1.f - a_ * a_, 0.f)); }
        else sBc[t * 64 + (e - 64)] = g * sXc[t * 64 + (e - 64)];
      }
    }
  }
  __syncthreads();
  const int c = tid & 63, q = tid >> 6;
  {
    float h = 0.f, ap = 1.f;
#pragma unroll 4
    for (int i = 0; i < 16; ++i) {
      const int t = q * 16 + i;
      const float a = sAc[t * 64 + c];
      h = a * h + sU[t * 64 + c] * sBc[t * 64 + c];
      ap *= a;
      sU[t * 64 + c] = h; sAc[t * 64 + c] = ap;
    }
    sQA[q * 64 + c] = ap; sQH[q * 64 + c] = h;
  }
  __syncthreads();
  {
    float hin = 0.f, ain = 1.f;
    for (int q2 = 0; q2 < q; ++q2) { hin = sQA[q2 * 64 + c] * hin + sQH[q2 * 64 + c]; ain *= sQA[q2 * 64 + c]; }
    if (q > 0) {
#pragma unroll 4
      for (int i = 0; i < 16; ++i) {
        const int t = q * 16 + i;
        const float ap = sAc[t * 64 + c];
        sU[t * 64 + c] += ap * hin;
        sAc[t * 64 + c] = ap * ain;
      }
    }
    if (q == 3) { chunkS[c] = sAc[63 * 64 + c]; chunkS[64 + c] = sU[63 * 64 + c]; }
  }
  __syncthreads();
  if (sgi) {
#pragma unroll
    for (int i = 0; i < 2; ++i) {
      int cidx = tid + i * 256, r = cidx >> 3, c8 = (cidx & 7) * 8;
      float u8[8], a8[8];
#pragma unroll
      for (int j = 0; j < 8; ++j) { u8[j] = sU[r * 64 + c8 + j]; a8[j] = sAc[r * 64 + c8 + j]; }
      const int row = sRow[r];
      *(u32x4*)(uout + (size_t)row * 512 + blk * 64 + c8) = pack8(u8);
      *(u32x4*)(aout + (size_t)(row - NCTX) * 512 + blk * 64 + c8) = pack8(a8);
    }
  }
}

DEV void st_lru_carry(const Params& P, int sid) {
  const int c = threadIdx.x;
  if (c >= 64) return;
  const float* cs = (const float*)(P.ws + OFF_LRUCS) + (size_t)sid * LRU_NCH * 128;
  float* hs = (float*)(P.ws + OFF_LRUHS) + (size_t)sid * LRU_NCH * 64;
  float h = 0.f;
  for (int cc0 = 0; cc0 < LRU_NCH; cc0 += 10) {
    float a[10], bb[10];
#pragma unroll
    for (int i = 0; i < 10; ++i) { a[i] = cs[(size_t)(cc0 + i) * 128 + c]; bb[i] = cs[(size_t)(cc0 + i) * 128 + 64 + c]; }
#pragma unroll
    for (int i = 0; i < 10; ++i) { hs[(size_t)(cc0 + i) * 64 + c] = h; h = a[i] * h + bb[i]; }
  }
}

DEV void st_finish_l1(const Params& P, int row) {
  const int lane = threadIdx.x & 63;
  bf16_t* hb = (bf16_t*)(P.ws + OFF_HBUF) + (size_t)row * 1024;
  const bf16_t* proj = (const bf16_t*)(P.ws + OFF_PROJ);
  const bf16_t* lora = (const bf16_t*)(P.ws + OFF_LORA);
  const float* mu = P.in[I_MU];
  const int ch = lane * 8;
  float y0[8], y1[8];
  unpack8(*(const u32x4*)(hb + ch), y0);
  unpack8(*(const u32x4*)(hb + 512 + ch), y1);
  float sm = 0.f;
#pragma unroll
  for (int j = 0; j < 8; ++j) { y0[j] += y1[j]; sm += y0[j]; }
  sm += wshfl_xor(sm, 1); sm += wshfl_xor(sm, 2); sm += wshfl_xor(sm, 4);
  const float mean = sm * (1.f / 64.f);
  float sv = 0.f;
#pragma unroll
  for (int j = 0; j < 8; ++j) { float dlt = y0[j] - mean; sv += dlt * dlt; }
  sv += wshfl_xor(sv, 1); sv += wshfl_xor(sv, 2); sv += wshfl_xor(sv, 4);
  const float rstd = frsq(sv * (1.f / 64.f) + 64e-5f);
  float a0[8], a1[8], g[8], u0[8], u1[8], gb[8];
  unpack8(*(const u32x4*)(lora + ((size_t)2 * NTOK + row) * 512 + ch), a0);
  unpack8(*(const u32x4*)(lora + ((size_t)3 * NTOK + row) * 512 + ch), a1);
  unpack8(*(const u32x4*)(lora + ((size_t)4 * NTOK + row) * 512 + ch), g);
  unpack8(*(const u32x4*)(lora + ((size_t)0 * NTOK + row) * 512 + ch), u0);
  unpack8(*(const u32x4*)(lora + ((size_t)1 * NTOK + row) * 512 + ch), u1);
  if (row >= NCTX) {
    const int bb_ = (row - NCTX) / SEQ, pos = (row - NCTX) % SEQ, blk = ch >> 6;
    float ac[8];
#pragma unroll
    for (int dd = 0; dd < 2; ++dd) {
      const int pidx = dd ? SEQ - 1 - pos : pos;
      const int cc = CTXL / 64 + pidx / 64;
      const int sid = (bb_ * 8 + blk) * 2 + dd;
      const float* hs = (const float*)(P.ws + OFF_LRUHS) + ((size_t)sid * LRU_NCH + cc) * 64 + (ch & 63);
      unpack8(*(const u32x4*)((const bf16_t*)(P.ws + (dd ? OFF_ACUM1 : OFF_ACUM0)) + (size_t)(row - NCTX) * 512 + ch), ac);
      f32x4 h0 = *(const f32x4*)hs, h1 = *(const f32x4*)(hs + 4);
      float* u = dd ? u1 : u0;
      u[0] += ac[0] * h0.x; u[1] += ac[1] * h0.y; u[2] += ac[2] * h0.z; u[3] += ac[3] * h0.w;
      u[4] += ac[4] * h1.x; u[5] += ac[5] * h1.y; u[6] += ac[6] * h1.z; u[7] += ac[7] * h1.w;
    }
  }
  unpack8(*(const u32x4*)(proj + (size_t)row * ODC + 1792 + ch), gb);
  float rv[8], vv[8];
  float sdot = 0.f;
#pragma unroll
  for (int j = 0; j < 8; ++j) {
    float r = mixval(proj, row, ch + j, mu);
    float k = mixval(proj, row, 512 + ch + j, mu);
    vv[j] = mixval(proj, row, 1024 + ch + j, mu);
    float am = 0.5f * (sigmoidf_(a0[j]) + sigmoidf_(a1[j]));
    float kb = k * (1.f + (am - 1.f) * P.in[I_KA][ch + j]);
    sdot += r * kb * P.in[I_RK][ch + j];
    rv[j] = r;
  }
  sdot += wshfl_xor(sdot, 1); sdot += wshfl_xor(sdot, 2); sdot += wshfl_xor(sdot, 4);
  float f1[8], f2[8];
#pragma unroll
  for (int j = 0; j < 8; ++j) {
    float yn = (y0[j] - mean) * rstd * P.in[I_LNW][ch + j] + P.in[I_LNB][ch + j];
    yn += sdot * vv[j];
    f1[j] = yn * g[j];
    f2[j] = (u0[j] + u1[j]) * geluf_(gb[j]);
  }
  *(u32x4*)(hb + ch) = pack8(f1);
  *(u32x4*)(hb + 512 + ch) = pack8(f2);
}

DEV unsigned fkey(float f) { unsigned u; __builtin_memcpy(&u, &f, 4); return (u >> 31) ? ~u : (u | 0x80000000u); }
DEV float keyf(unsigned u) { u = (u >> 31) ? (u & 0x7fffffffu) : ~u; float f; __builtin_memcpy(&f, &u, 4); return f; }
DEV void key_insert(unsigned x, unsigned* v) {
#pragma unroll
  for (int j = 0; j < 16; ++j) { unsigned hi = v[j] > x ? v[j] : x; x = v[j] > x ? x : v[j]; v[j] = hi; }
}
DEV void key_cx(unsigned& hi, unsigned& lo) { unsigned a = hi, b = lo; hi = a > b ? a : b; lo = a > b ? b : a; }
DEV void key_sort16(unsigned* v) {
#pragma unroll
  for (int k = 2; k <= 16; k <<= 1)
#pragma unroll
    for (int j = k >> 1; j > 0; j >>= 1)
#pragma unroll
      for (int i = 0; i < 16; ++i) {
        const int l = i ^ j;
        if (l > i) { if ((i & k) == 0) key_cx(v[i], v[l]); else key_cx(v[l], v[i]); }
      }
}
DEV void key_merge16(unsigned* a, const unsigned* b) {
#pragma unroll
  for (int i = 0; i < 16; ++i) a[i] = a[i] > b[15 - i] ? a[i] : b[15 - i];
#pragma unroll
  for (int j = 8; j > 0; j >>= 1)
#pragma unroll
    for (int i = 0; i < 16; ++i) { const int l = i ^ j; if (l > i) key_cx(a[i], a[l]); }
}

DEV void st_peer_topk(const Params& P, int layer, int tile, int h, unsigned char* smem) {
  const int tid = threadIdx.x;
  const bf16_t* q = (const bf16_t*)(P.ws + OFF_Q);
  const bf16_t* keys = (const bf16_t*)(P.ws + OFF_KEYS) + (size_t)(layer * 8 + h) * 2 * 128 * 128;
  float* sS = (float*)smem;
  const int m0 = tile * 128;
  const int tok = tid & 127, half = tid >> 7;
  unsigned kl[2][16];
#pragma unroll
  for (int p = 0; p < 2; ++p) {
    EpiScoreLds epi{sS, m0};
    gemm_tile_128<true>(q + (h * 2 + p) * 128, 2048, NTOK, keys + p * 128 * 128, 128, 128, 128, m0, 0, epi, smem);
    __syncthreads();
    float* row = sS + tok * 129 + half * 64;
#pragma unroll
    for (int g = 0; g < 4; ++g) {
      unsigned grp[16];
#pragma unroll
      for (int j = 0; j < 16; ++j) grp[j] = (fkey(row[g * 16 + j]) & ~127u) | (unsigned)(127 - (half * 64 + g * 16 + j));
      key_sort16(grp);
      if (g == 0) {
#pragma unroll
        for (int j = 0; j < 16; ++j) kl[p][j] = grp[j];
      } else key_merge16(kl[p], grp);
    }
    if (half == 1) {
#pragma unroll
      for (int j = 0; j < 16; ++j) row[j] = __builtin_bit_cast(float, kl[p][j]);
    }
    __syncthreads();
    if (half == 0) {
      unsigned oth[16];
#pragma unroll
      for (int j = 0; j < 16; ++j) oth[j] = __builtin_bit_cast(unsigned, sS[tok * 129 + 64 + j]);
      key_merge16(kl[p], oth);
    }
    __syncthreads();
  }
  if (tid < 128) {
    float sv0[16], sv1[16];
    int* irow = (int*)(sS + tid * 129);
#pragma unroll
    for (int j = 0; j < 16; ++j) {
      sv0[j] = keyf((kl[0][j] & ~127u) | 64u); sv1[j] = keyf((kl[1][j] & ~127u) | 64u);
      irow[j] = 127 - (int)(kl[0][j] & 127u); irow[16 + j] = 127 - (int)(kl[1][j] & 127u);
    }
    unsigned best[16];
#pragma unroll
    for (int j = 0; j < 16; ++j) best[j] = 0u;
#pragma unroll
    for (int i = 0; i < 16; ++i)
#pragma unroll
      for (int j = 0; j < 16; ++j)
        if ((i + 1) * (j + 1) <= 16) key_insert((fkey(sv0[i] + sv1[j]) & ~255u) | (unsigned)(255 - (i * 16 + j)), best);
    float e[16], sum = 0.f;
    const float b0 = keyf((best[0] & ~255u) | 128u);
#pragma unroll
    for (int j = 0; j < 16; ++j) { e[j] = fexp(keyf((best[j] & ~255u) | 128u) - b0); sum += e[j]; }
    const float inv = 1.f / sum;
    int* pidx = (int*)(P.ws + OFF_PIDX) + (size_t)(m0 + tid) * 128 + h * 16;
    float* pg = (float*)(P.ws + OFF_PGATE) + (size_t)(m0 + tid) * 128 + h * 16;
#pragma unroll
    for (int j = 0; j < 16; ++j) {
      const int pos = 255 - (int)(best[j] & 255u);
      pidx[j] = irow[pos >> 4] * 128 + irow[16 + (pos & 15)];
      pg[j] = e[j] * inv;
    }
  }
}

DEV void st_peer_experts(const Params& P, int layer, int row) {
  const int lane = threadIdx.x & 63;
  const bf16_t* xb = (const bf16_t*)(P.ws + OFF_HBUF) + (size_t)row * 1024;
  const unsigned char* U = P.ws + OFF_PU;
  const int* pidx = (const int*)(P.ws + OFF_PIDX) + (size_t)row * 128;
  const float* pg = (const float*)(P.ws + OFF_PGATE) + (size_t)row * 128;
  float x[16], acc[16];
  unpack8(*(const u32x4*)(xb + lane * 16), x);
  unpack8(*(const u32x4*)(xb + lane * 16 + 8), x + 8);
#pragma unroll
  for (int j = 0; j < 16; ++j) acc[j] = 0.f;
  const int b5 = (lane >> 5) & 1, b4 = (lane >> 4) & 1, b3 = (lane >> 3) & 1;
  const int mypick = (lane >> 3) & 7;
  for (int k0 = 0; k0 < 128; k0 += 8) {
    u32x4 uu[8], vv[8];
#pragma unroll
    for (int i = 0; i < 8; ++i) {
      const size_t off = (size_t)pidx[k0 + i] * 2048 + lane * 16;
      uu[i] = *(const u32x4*)(U + off);
      vv[i] = *(const u32x4*)(U + off + 1024);
    }
    const float mygate = pg[k0 + mypick];
    float dsum[8];
#pragma unroll
    for (int i = 0; i < 8; ++i) {
      float uf[16];
      unpack16_fp8(uu[i], uf);
      float dd = 0.f;
#pragma unroll
      for (int j = 0; j < 16; ++j) dd += x[j] * uf[j];
      dsum[i] = dd;
    }
    float e4[4], e2[2], g;
#pragma unroll
    for (int i = 0; i < 4; ++i) {
      float mine = b5 ? dsum[4 + i] : dsum[i], send = b5 ? dsum[i] : dsum[4 + i];
      e4[i] = mine + wshfl_xor(send, 32);
    }
#pragma unroll
    for (int i = 0; i < 2; ++i) {
      float mine = b4 ? e4[2 + i] : e4[i], send = b4 ? e4[i] : e4[2 + i];
      e2[i] = mine + wshfl_xor(send, 16);
    }
    {
      float mine = b3 ? e2[1] : e2[0], send = b3 ? e2[0] : e2[1];
      g = mine + wshfl_xor(send, 8);
    }
    g += wshfl_xor(g, 4); g += wshfl_xor(g, 2); g += wshfl_xor(g, 1);
    const float mycoef = mygate * geluf_(g * (1.f / PEER_USCALE));
#pragma unroll
    for (int i = 0; i < 8; ++i) {
      const float coef = wreadlane(mycoef, i * 8);
      float vf[16];
      unpack16_fp8(vv[i], vf);
#pragma unroll
      for (int j = 0; j < 16; ++j) acc[j] += coef * vf[j];
    }
  }
  float* xr = row < NCTX ? (float*)(P.ws + OFF_CTXRES) + (size_t)row * 1024 : P.out + (size_t)(row - NCTX) * 1024;
  const float* g2 = (const float*)(P.ws + OFF_MODV) + ((size_t)layer * 3 + mod_row(row)) * 6144 + 5 * 1024;
  float o[16];
#pragma unroll
  for (int q = 0; q < 4; ++q) {
    const int c = lane * 16 + q * 4;
    f32x4 a = *(const f32x4*)(xr + c), ga = *(const f32x4*)(g2 + c);
    o[q * 4 + 0] = a.x + ga.x * acc[q * 4 + 0] * (1.f / PEER_VSCALE); o[q * 4 + 1] = a.y + ga.y * acc[q * 4 + 1] * (1.f / PEER_VSCALE);
    o[q * 4 + 2] = a.z + ga.z * acc[q * 4 + 2] * (1.f / PEER_VSCALE); o[q * 4 + 3] = a.w + ga.w * acc[q * 4 + 3] * (1.f / PEER_VSCALE);
  }
  float ss = 0.f;
#pragma unroll
  for (int j = 0; j < 16; ++j) ss += o[j] * o[j];
  ss = wave_sum(ss);
  const float rstd = frsq(ss * (1.f / 1024.f) + 1e-6f);
  if (layer == 1) {
#pragma unroll
    for (int j = 0; j < 16; ++j) o[j] *= rstd * P.in[I_FNORM][lane * 16 + j];
  }
#pragma unroll
  for (int q = 0; q < 4; ++q) {
    f32x4 a = {o[q * 4 + 0], o[q * 4 + 1], o[q * 4 + 2], o[q * 4 + 3]};
    *(f32x4*)(xr + lane * 16 + q * 4) = a;
  }
  if (layer == 0) {
    const float* mv = (const float*)(P.ws + OFF_MODV) + ((size_t)1 * 3 + mod_row(row)) * 6144;
    const float* nw = P.in[I_NORM1] + 1024;
    float hh[16];
#pragma unroll
    for (int q = 0; q < 4; ++q) {
      const int c = lane * 16 + q * 4;
      f32x4 w4 = *(const f32x4*)(nw + c), s4 = *(const f32x4*)(mv + 1024 + c), h4 = *(const f32x4*)(mv + c);
      hh[q * 4 + 0] = o[q * 4 + 0] * rstd * w4.x * (1.f + s4.x) + h4.x; hh[q * 4 + 1] = o[q * 4 + 1] * rstd * w4.y * (1.f + s4.y) + h4.y;
      hh[q * 4 + 2] = o[q * 4 + 2] * rstd * w4.z * (1.f + s4.z) + h4.z; hh[q * 4 + 3] = o[q * 4 + 3] * rstd * w4.w * (1.f + s4.w) + h4.w;
    }
    bf16_t* hb = (bf16_t*)(P.ws + OFF_HBUF) + (size_t)row * 1024 + lane * 16;
    *(u32x4*)hb = pack8(hh);
    *(u32x4*)(hb + 8) = pack8(hh + 8);
  }
}


#define FOR_TILES_XCD(MT0, MT1, NT, mt, nt)                                                     \
  for (int _x = blockIdx.x & 7, _mlo = (MT0) + (((MT1) - (MT0)) * _x) / 8,                        \
           _mhi = (MT0) + (((MT1) - (MT0)) * (_x + 1)) / 8, _i = blockIdx.x >> 3,                 \
           _cnt = (_mhi - _mlo) * (NT), mt = 0, nt = 0;                                           \
       _i < _cnt && ((mt = _mlo + _i / (NT)), (nt = _i % (NT)), true); _i += (int)(gridDim.x >> 3))

#ifndef PHASE_LIST
#define PHASE_LIST(X) X(0) X(1) X(2) X(22) X(23) X(3) X(4) X(5) X(6) X(7) X(8) X(9) X(11) X(12) X(13) X(30) X(14) X(15) X(31) X(16) X(17) X(18) X(19) X(20) X(21)
#endif
constexpr int PH_LAST = 21;

template <int ph>
DEV void run_phase(const Params& P, unsigned char* smem) {
  const int bid = blockIdx.x, nb = gridDim.x;
  const int wave = threadIdx.x >> 6;
  unsigned char* ws = P.ws;
  constexpr int layer = ((ph >= 10 && ph <= 21) || ph >= 30) ? 1 : 0;
  const float* modv_l = (const float*)(ws + OFF_MODV) + (size_t)layer * 3 * 6144;
  switch (ph) {
    case 0:
      for (int t = NTRANS + bid; t < NPREP; t += nb) st_prep(P, t, smem);
      break;
    case 1: case 10:
      if (ph == 1) for (int t = nb - 1 - bid; t < NTRANS; t += nb) st_prep(P, t, smem);
      for (int t = bid; t < NTOK / 4; t += nb) st_normmod(P, layer, 0, t * 4 + wave);
      break;
    case 2: {
      EpiProjL0T epi{(bf16_t*)(ws + OFF_PROJ), (float*)(ws + OFF_GATES)};
      FOR_TILES_XCD(0, NTOK / 256, 25, mt, nt)
        gemm_tile_128x256<EpiProjL0T, true>((const bf16_t*)(ws + OFF_WEVIN), 1024, EVC, (const bf16_t*)(ws + OFF_HBUF), 1024, NTOK, 1024,
                                            nt * 128, mt * 256, epi, smem);
    } break;
    case 22:
      for (int t = bid; t < NTOK / 4; t += nb) st_xbc_conv(P, t * 4 + wave);
      for (int t = bid; t < NPCONV; t += nb) st_peer_conv(P, 0, t);
      break;
    case 23:
      for (int t = bid; t < 48 * LA_NSEG; t += nb) {
        int sid = t % 48, seg = t / 48;
        if (sid < 16) st_linattn_seg<true, false>(P, sid, seg, smem);
        else st_linattn_seg<false, false>(P, sid - 16, seg, smem);
      }
      break;
    case 3:
      for (int t = bid; t < 48 * LA_NSEG; t += nb) {
        int sid = t % 48, seg = t / 48;
        if (sid < 16) st_linattn_seg<true, true>(P, sid, seg, smem);
        else st_linattn_seg<false, true>(P, sid - 16, seg, smem);
      }
      break;
    case 4:
      for (int t = bid; t < NTOK / 4; t += nb) st_finish_l0(P, t * 4 + wave);
      break;
    case 5: case 17: {
      EpiOutProjT epi{layer == 0 ? P.in[I_X] : P.out, P.in[I_CTX], P.out, (float*)(ws + OFF_CTXRES), modv_l};
      const bf16_t* Wt = (const bf16_t*)(ws + (layer == 0 ? OFF_WEVOUT : OFF_WODOUT));
      FOR_TILES_XCD(layer == 0 ? 0 : NCTX / 256, NTOK / 256, 8, mt, nt)
        gemm_tile_128x256<EpiOutProjT, true>(Wt, 1024, 1024, (const bf16_t*)(ws + OFF_HBUF), 1024, NTOK, 1024, nt * 128, mt * 256, epi, smem);
    } break;
    case 6: case 18: {
      const int r0 = layer == 0 ? 0 : NCTX / 4;
      for (int t = r0 + bid; t < NTOK / 4; t += nb) st_normmod(P, layer, 1, t * 4 + wave);
      if (ph == 18) for (int t = bid; t < NPCONV; t += nb) st_peer_conv(P, 1, t);
    } break;
    case 7: case 19: {
      EpiStoreBfT epi{(bf16_t*)(ws + OFF_Q), 2048};
      const bf16_t* Wt = (const bf16_t*)(ws + OFF_WQ) + (size_t)layer * 2048 * 1024;
      FOR_TILES_XCD(layer == 0 ? 0 : NCTX / 256, NTOK / 256, 16, mt, nt)
        gemm_tile_128x256<EpiStoreBfT, true>(Wt, 1024, 2048, (const bf16_t*)(ws + OFF_HBUF), 1024, NTOK, 1024, nt * 128, mt * 256, epi, smem);
    } break;
    case 8: case 20: {
      const int t0 = layer == 0 ? 0 : CTILE * 8;
      for (int t = t0 + bid; t < NTILE * 8; t += nb) st_peer_topk(P, layer, t / 8, t % 8, smem);
    } break;
    case 9: case 21: {
      const int r0 = layer == 0 ? 0 : NCTX / 4;
      for (int t = r0 + bid; t < NTOK / 4; t += nb) st_peer_experts(P, layer, t * 4 + wave);
    } break;
    case 11: {
      EpiStoreBfT epi{(bf16_t*)(ws + OFF_PROJ), ODC};
      FOR_TILES_XCD(0, NTOK / 256, 22, mt, nt)
        gemm_tile_128x256<EpiStoreBfT, true>((const bf16_t*)(ws + OFF_WODIN), 1024, ODC, (const bf16_t*)(ws + OFF_HBUF), 1024, NTOK, 1024,
                                             nt * 128, mt * 256, epi, smem);
    } break;
    case 12:
      for (int t = bid; t < NTOK / 4; t += nb) st_lora_act(P, t * 4 + wave);
      break;
    case 13:
      for (int t = bid; t < NTILE * 20; t += nb) {
        int job = t / (NTILE * 4), tt = t % (NTILE * 4);
        int mt = tt / 4, nt = tt % 4;
        bf16_t* dst = (bf16_t*)(ws + OFF_LORA) + (size_t)job * NTOK * 512;
        const bf16_t* A = (const bf16_t*)(ws + OFF_HBUF) + (job < 2 ? 0 : (job < 4 ? 64 : 128));
        const bf16_t* Bt = job < 2 ? (const bf16_t*)(ws + OFF_WUP) + (size_t)job * 512 * 64
                         : job < 4 ? (const bf16_t*)(ws + OFF_AUP) + (size_t)(job - 2) * 512 * 64
                                   : (const bf16_t*)(ws + OFF_GUP);
        const float* bias = job < 2 ? P.in[I_W0] + job * 512 : (job < 4 ? P.in[I_A0] + (job - 2) * 512 : nullptr);
        const int K = job < 4 ? 64 : 128;
        EpiStoreBfBiasT epi{dst, 512, bias};
        gemm_tile_128<false, EpiStoreBfBiasT, true>(Bt, K, 512, A, 1024, NTOK, K, nt * 128, mt * 128, epi, smem);
      }
      break;
    case 30:
      for (int t = bid; t < 32 * RW_NSEG; t += nb) st_rwkv_seg<false>(P, t % 32, t / 32, smem);
      break;
    case 14:
      for (int t = bid; t < 32 * RW_NSEG; t += nb) st_rwkv_seg<true>(P, t % 32, t / 32, smem);
      break;
    case 15:
      for (int t = bid; t < 32 * LRU_NCH; t += nb) st_lru_chunk(P, t % 32, t / 32, smem);
      break;
    case 31:
      if (bid < 32) st_lru_carry(P, bid);
      break;
    case 16:
      for (int t = bid; t < NTOK / 4; t += nb) st_finish_l1(P, t * 4 + wave);
      break;
    default: break;
  }
}


#ifndef CPU_EMU
#define XB_TMO      128
#define XB_XCNT(j)  (256  + 64 * (j))
#define XB_XSUB(j)  (1280 + 64 * (j))
#define XB_XGEN(j)  (2304 + 64 * (j))
#define XB_TOP      3328
#define XB_TOPGEN   3392
#define XCD_BAR_WORDS 3456
#define XB_SPIN_CAP (1u << 20)
#define LAS __attribute__((address_space(3)))
__device__ __forceinline__ unsigned xb_ld(unsigned* p)              { return __hip_atomic_load(p, __ATOMIC_RELAXED, __HIP_MEMORY_SCOPE_AGENT); }
__device__ __forceinline__ unsigned xb_add(unsigned* p, unsigned v) { return __hip_atomic_fetch_add(p, v, __ATOMIC_RELAXED, __HIP_MEMORY_SCOPE_AGENT); }
__device__ __forceinline__ unsigned xb_xcc_id() { return (unsigned)__builtin_amdgcn_s_getreg((3 << 11) | 20) & 0xFu; }
#define XB_SPIN(cond, bar) do { unsigned _sp = 0; while (cond) { __builtin_amdgcn_s_sleep(1); \
    if ((++_sp & 255u) == 0u) { if (xb_ld(&(bar)[XB_TMO])) break; if (_sp > XB_SPIN_CAP) { atomicAdd(&(bar)[XB_TMO], 1u); break; } } } } while (0)
struct XcdBarrier { unsigned* bar; unsigned x; volatile LAS unsigned* st; };
__device__ __forceinline__ XcdBarrier xcd_barrier_post(unsigned* bar, volatile LAS unsigned* st) {
  XcdBarrier b; b.bar = bar; b.x = xb_xcc_id(); b.st = st;
  if (threadIdx.x == 0) (void)xb_add(&bar[XB_XCNT(b.x)], 1u);
  return b;
}
__device__ __forceinline__ void xcd_barrier_complete(unsigned* bar, unsigned x, unsigned& nloc, unsigned& nx) {
  const unsigned G = gridDim.x * gridDim.y * gridDim.z;
  unsigned sum, cnt, mine, sp = 0u;
  for (;;) {
    sum = 0u; cnt = 0u; mine = 0u;
#pragma unroll
    for (unsigned j = 0; j < 16; ++j) { const unsigned c = xb_ld(&bar[XB_XCNT(j)]); sum += c; cnt += (c > 0u) ? 1u : 0u; mine = (j == x) ? c : mine; }
    if (sum == G) break;
    __builtin_amdgcn_s_sleep(1);
    if ((++sp & 255u) == 0u) { if (xb_ld(&bar[XB_TMO])) break; if (sp > XB_SPIN_CAP) { atomicAdd(&bar[XB_TMO], 1u); break; } }
  }
  nloc = mine > 0u ? mine : 1u; nx = cnt > 0u ? cnt : 1u;
}
__device__ __forceinline__ void xcd_barrier(const XcdBarrier& b) {
  asm volatile("s_waitcnt vmcnt(0)" ::: "memory");
  __syncthreads();
  if (threadIdx.x == 0) {
    unsigned* bar = b.bar;
    __builtin_amdgcn_s_waitcnt(0);
    unsigned nloc = b.st[0], nx = b.st[1];
    if (nloc == 0u) { xcd_barrier_complete(bar, b.x, nloc, nx); b.st[0] = nloc; b.st[1] = nx; }
    const unsigned old = xb_add(&bar[XB_XSUB(b.x)], 1u);
    const unsigned gen = old / nloc;
    if (old + 1u == (gen + 1u) * nloc) {
      __builtin_amdgcn_fence(__ATOMIC_RELEASE, "agent");
      asm volatile("s_waitcnt vmcnt(0)" ::: "memory");
      const unsigned og = xb_add(&bar[XB_TOP], 1u);
      const unsigned tg = og / nx;
      if (og + 1u == (tg + 1u) * nx) xb_add(&bar[XB_TOPGEN], 1u);
      else XB_SPIN(xb_ld(&bar[XB_TOPGEN]) == tg, bar);
      __builtin_amdgcn_fence(__ATOMIC_ACQUIRE, "agent");
      xb_add(&bar[XB_XGEN(b.x)], 1u);
      asm volatile("s_waitcnt vmcnt(0)" ::: "memory");
    } else {
      XB_SPIN(xb_ld(&bar[XB_XGEN(b.x)]) == gen, bar);
      __builtin_amdgcn_fence(__ATOMIC_ACQUIRE, "agent");
      asm volatile("s_waitcnt vmcnt(0)" ::: "memory");
    }
  }
  __syncthreads();
}
#endif
#ifndef CPU_EMU
#define RUN_PH(n) run_phase<n>(P, smem_raw); if (n != PH_LAST) xcd_barrier(xb);
__global__ void __launch_bounds__(256, 2) mega_kernel(Params P) {
  SMEM_DECL;
  unsigned* bar = (unsigned*)(P.ws + OFF_BAR);
  volatile LAS unsigned* st = (volatile LAS unsigned*)(smem_raw + SMEM_BYTES - 16);
  if (threadIdx.x == 0) { st[0] = 0u; st[1] = 0u; }
  if (P.ws == nullptr) cg::this_grid().sync();
  __syncthreads();
  XcdBarrier xb = xcd_barrier_post(bar, st);
  PHASE_LIST(RUN_PH)
}

extern "C" void kernel_launch(void* const* d_in, const int* in_sizes, int n_in, void* d_out, int out_size, void* d_ws,
                              size_t ws_size, hipStream_t stream) {
  Params P{};
  for (int i = 0; i < N_IN; ++i) P.in[i] = (const float*)d_in[i];
  P.out = (float*)d_out;
  P.ws = (unsigned char*)d_ws;
  if (ws_size < WS_NEEDED) { fprintf(stderr, "workspace too small: %zu < %zu\n", ws_size, (size_t)WS_NEEDED); return; }
  static int grid_blocks = 0;
  if (!grid_blocks) {
    int dev = 0, cus = 0, per_cu = 0;
    hipGetDevice(&dev);
    hipDeviceGetAttribute(&cus, hipDeviceAttributeMultiprocessorCount, dev);
    hipOccupancyMaxActiveBlocksPerMultiprocessor(&per_cu, mega_kernel, 256, 0);
    if (per_cu > 2) per_cu = 2;
    grid_blocks = cus * per_cu;
  }
  (void)hipMemsetAsync((unsigned char*)d_ws + OFF_BAR, 0, 16384, stream);
  void* args[] = {&P};
  hipError_t e = hipLaunchCooperativeKernel((void*)mega_kernel, dim3(grid_blocks), dim3(256), args, 0, stream);
  if (e != hipSuccess) fprintf(stderr, "cooperative launch failed: %s (grid %d)\n", hipGetErrorString(e), grid_blocks);
}
#endif
```

```cpp
#ifdef CPU_EMU
#include "emu.h"
#else
#include <hip/hip_runtime.h>
#include <hip/hip_cooperative_groups.h>
#include <cstdio>
namespace cg = cooperative_groups;
#define DEV __device__ __forceinline__
#define DEVM __device__ __forceinline__
#define OPAQUE(x) asm volatile("" : "+v"(x))
#define OPAQUE_S(x) asm volatile("" : "+s"(x))
#endif

#ifndef SEQ_LEN
#define SEQ_LEN 16384
#endif
#ifndef CTX_LEN
#define CTX_LEN 256
#endif
#ifndef GRID_W_
#define GRID_W_ 64
#endif
#ifndef MULTI_LAUNCH
#define MULTI_LAUNCH 0
#endif

typedef unsigned short bf16_t;
typedef __attribute__((ext_vector_type(8))) short bf16x8;
typedef __attribute__((ext_vector_type(16))) float f32x16;
typedef __attribute__((ext_vector_type(4))) unsigned u32x4;
typedef __attribute__((ext_vector_type(2))) unsigned u32x2;
typedef __attribute__((ext_vector_type(4))) float f32x4;

constexpr int D = 1024, NB = 2, SEQ = SEQ_LEN, CTXL = CTX_LEN, GW = GRID_W_;
constexpr int NCTX = NB * CTXL, NLAT = NB * SEQ, NTOK = NCTX + NLAT;
constexpr int EVC = 3104, ODC = 2816;
constexpr int NEXP = 16384;
constexpr int NTILE = NTOK / 128, CTILE = NCTX / 128;
static_assert(NTOK % 256 == 0 && NCTX % 256 == 0, "tiles");
static_assert(CTXL % 64 == 0 && SEQ % 64 == 0 && SEQ % GW == 0, "chunks");

constexpr size_t al256(size_t x) { return (x + 255) & ~(size_t)255; }
constexpr size_t OFF_MODV = 0;
constexpr size_t OFF_CTXRES = OFF_MODV + al256(2 * 3 * 6144 * 4);
constexpr size_t OFF_GATES = OFF_CTXRES + al256((size_t)NCTX * 1024 * 4);
constexpr size_t OFF_WEVIN = OFF_GATES + al256((size_t)NTOK * 32 * 4);
constexpr size_t OFF_WEVOUT = OFF_WEVIN + al256((size_t)EVC * 1024 * 2);
constexpr size_t OFF_WODIN = OFF_WEVOUT + al256((size_t)1024 * 1024 * 2);
constexpr size_t OFF_WODOUT = OFF_WODIN + al256((size_t)ODC * 1024 * 2);
constexpr size_t OFF_WQ = OFF_WODOUT + al256((size_t)1024 * 1024 * 2);
constexpr size_t OFF_KEYS = OFF_WQ + al256((size_t)2 * 2048 * 1024 * 2);
constexpr size_t OFF_WUP = OFF_KEYS + al256((size_t)2 * 8 * 2 * 128 * 128 * 2);
constexpr size_t OFF_AUP = OFF_WUP + al256((size_t)2 * 512 * 64 * 2);
constexpr size_t OFF_GUP = OFF_AUP + al256((size_t)2 * 512 * 64 * 2);
constexpr size_t OFF_LRUT = OFF_GUP + al256((size_t)512 * 128 * 2);
constexpr size_t OFF_PU = OFF_LRUT + al256((size_t)2 * 8 * 128 * 64 * 2);
constexpr size_t OFF_PV = OFF_PU + al256((size_t)NEXP * 1024);
constexpr size_t OFF_HBUF = OFF_PV + al256((size_t)NEXP * 1024);
constexpr size_t OFF_PR = OFF_HBUF + al256((size_t)NTOK * 1024 * 2);
constexpr size_t PR_BYTES = (size_t)NTOK * 5376 * 2;
constexpr size_t OFF_BAR = OFF_PR + PR_BYTES;
constexpr size_t OFF_ACUM1 = OFF_BAR + 16384;
constexpr size_t OFF_LRUCS = OFF_ACUM1 + (size_t)NLAT * 512 * 2;
constexpr size_t OFF_LRUHS = OFF_LRUCS + (size_t)32 * ((CTXL + SEQ) / 64) * 128 * 4;
constexpr size_t WS_NEEDED = OFF_LRUHS + (size_t)32 * ((CTXL + SEQ) / 64) * 64 * 4;
#ifndef CPU_EMU
static_assert(WS_NEEDED <= (size_t)512 * 1024 * 1024, "workspace too large");
#endif
constexpr size_t OFF_PROJ = OFF_PR;
constexpr size_t OFF_R2L0 = OFF_PR + (size_t)NTOK * EVC * 2;
constexpr size_t OFF_LORA = OFF_PR + (size_t)NTOK * ODC * 2;
constexpr size_t OFF_Q = OFF_PR;
constexpr size_t OFF_PIDX = OFF_PR + (size_t)NTOK * 2048 * 2;
constexpr size_t OFF_PGATE = OFF_PIDX + (size_t)NTOK * 128 * 4;
static_assert(OFF_PGATE + (size_t)NTOK * 128 * 4 <= OFF_PR + PR_BYTES, "picks");

enum {
  I_X = 0, I_C, I_CTX, I_CCTX, I_MODW, I_MODB, I_NORM1, I_NORM2, I_WQ, I_KEYS, I_PU, I_PV,
  I_EVWIN, I_EVWOUT, I_IBIAS, I_FBIAS, I_MNORM, I_SCONVW, I_SCONVB, I_DTBIAS, I_ALOG, I_DSKIP, I_SNORM,
  I_ODWIN, I_ODWOUT, I_MU, I_W0, I_WUP, I_A0, I_AUP, I_GUP, I_KK, I_KA, I_RK, I_LNW, I_LNB,
  I_LCONVW, I_LCONVB, I_LAM, I_WA, I_BA, I_WI, I_BI, I_FNORM, N_IN
};

struct Params {
  const float* in[N_IN];
  float* out;
  unsigned char* ws;
};

constexpr int SMEM_BYTES = 80 * 1024;
#ifdef CPU_EMU
#define SMEM_DECL static thread_local __attribute__((aligned(16))) unsigned char smem_raw[SMEM_BYTES]
#else
#define SMEM_DECL __shared__ __attribute__((aligned(16))) unsigned char smem_raw[SMEM_BYTES]
#endif

DEV float bf2f(bf16_t v) { unsigned u = ((unsigned)v) << 16; float f; __builtin_memcpy(&f, &u, 4); return f; }
DEV bf16_t f2bf(float f) { unsigned u; __builtin_memcpy(&u, &f, 4); u += 0x7fffu + ((u >> 16) & 1u); return (bf16_t)(u >> 16); }
DEV unsigned pack2(float a, float b) { return (unsigned)f2bf(a) | ((unsigned)f2bf(b) << 16); }
DEV void unpack8(const u32x4& r, float* o) {
  unsigned w[4] = {r.x, r.y, r.z, r.w};
#pragma unroll
  for (int i = 0; i < 4; ++i) { unsigned lo = w[i] << 16, hi = w[i] & 0xffff0000u; __builtin_memcpy(&o[2 * i], &lo, 4); __builtin_memcpy(&o[2 * i + 1], &hi, 4); }
}
DEV u32x4 pack8(const float* o) { u32x4 r; r.x = pack2(o[0], o[1]); r.y = pack2(o[2], o[3]); r.z = pack2(o[4], o[5]); r.w = pack2(o[6], o[7]); return r; }
#ifdef CPU_EMU
DEV float fexp(float x) { return expf(x); }
DEV float frcp(float x) { return 1.f / x; }
DEV float flog(float x) { return logf(x); }
DEV float frsq(float x) { return 1.f / sqrtf(x); }
DEV float fsqrt(float x) { return sqrtf(x); }
#else
DEV float fexp(float x) { return __expf(x); }
DEV float frcp(float x) { return __builtin_amdgcn_rcpf(x); }
DEV float flog(float x) { return __logf(x); }
DEV float frsq(float x) { return __builtin_amdgcn_rsqf(x); }
DEV float fsqrt(float x) { return __builtin_amdgcn_sqrtf(x); }
#endif
DEV float sigmoidf_(float x) { return frcp(1.f + fexp(-x)); }
DEV float siluf_(float x) { return x * frcp(1.f + fexp(-x)); }
DEV float softplusf_(float x) { return fmaxf(x, 0.f) + flog(1.f + fexp(-fabsf(x))); }
DEV float tanhf_(float x) { return 1.f - 2.f * frcp(1.f + fexp(2.f * x)); }
DEV float geluf_(float x) { return 0.5f * x * (1.f + erff(x * 0.70710678118654752f)); }

DEV f32x16 mfma32(bf16x8 a, bf16x8 b, f32x16 c) {
#ifdef CPU_EMU
  return emu_mfma32(a, b, c);
#else
  return __builtin_amdgcn_mfma_f32_32x32x16_bf16(a, b, c, 0, 0, 0);
#endif
}
DEV float wshfl_xor(float v, int m) {
#ifdef CPU_EMU
  return emu_shfl_xor(v, m);
#else
  return __shfl_xor(v, m, 64);
#endif
}
DEV float wave_sum(float v) {
#pragma unroll
  for (int m = 32; m >= 1; m >>= 1) v += wshfl_xor(v, m);
  return v;
}

#ifdef CPU_EMU
static inline unsigned emu_f2fp8(float f) {
  unsigned sgn = f < 0.f ? 0x80u : 0u; float a = fabsf(f);
  if (!(a == a)) return 0x7f;
  if (a >= 448.f) return sgn | 0x7e;
  if (a < 0.0009765625f) return sgn;
  int e; frexpf(a, &e); e -= 1;
  if (e < -6) { int q = (int)nearbyintf(a * 512.f); return sgn | (unsigned)q; }
  float m = a / ldexpf(1.f, e);
  int q = (int)nearbyintf((m - 1.f) * 8.f);
  if (q == 8) { q = 0; e += 1; }
  if (e > 8) return sgn | 0x7e;
  return sgn | (unsigned)((e + 7) << 3) | (unsigned)q;
}
static inline float emu_fp82f(unsigned c) {
  unsigned sgn = c & 0x80, e = (c >> 3) & 15, m = c & 7;
  float v = e == 0 ? ldexpf((float)m, -9) : ldexpf(1.f + m / 8.f, (int)e - 7);
  return sgn ? -v : v;
}
#endif
DEV unsigned pack4_fp8(float a, float b, float c, float d) {
#ifdef CPU_EMU
  return emu_f2fp8(a) | (emu_f2fp8(b) << 8) | (emu_f2fp8(c) << 16) | (emu_f2fp8(d) << 24);
#else
  int w = 0;
  w = __builtin_amdgcn_cvt_pk_fp8_f32(a, b, w, false);
  w = __builtin_amdgcn_cvt_pk_fp8_f32(c, d, w, true);
  return (unsigned)w;
#endif
}
DEV void unpack4_fp8(unsigned w, float* o) {
#ifdef CPU_EMU
  o[0] = emu_fp82f(w & 255); o[1] = emu_fp82f((w >> 8) & 255); o[2] = emu_fp82f((w >> 16) & 255); o[3] = emu_fp82f(w >> 24);
#else
  typedef __attribute__((ext_vector_type(2))) float f32x2_;
  f32x2_ lo = __builtin_amdgcn_cvt_pk_f32_fp8((int)w, false);
  f32x2_ hi = __builtin_amdgcn_cvt_pk_f32_fp8((int)w, true);
  o[0] = lo.x; o[1] = lo.y; o[2] = hi.x; o[3] = hi.y;
#endif
}
DEV void unpack16_fp8(const u32x4& r, float* o) { unpack4_fp8(r.x, o); unpack4_fp8(r.y, o + 4); unpack4_fp8(r.z, o + 8); unpack4_fp8(r.w, o + 12); }
DEV float wreadlane(float v, int srclane) {
#ifdef CPU_EMU
  return emu_readlane(v, srclane);
#else
  int iv; __builtin_memcpy(&iv, &v, 4);
  int r = __builtin_amdgcn_readlane(iv, srclane);
  float f; __builtin_memcpy(&f, &r, 4); return f;
#endif
}
constexpr float PEER_USCALE = 64.f, PEER_VSCALE = 4.f;

DEV int acc_row(int reg, int lane) { return (reg & 3) + 8 * (reg >> 2) + 4 * (lane >> 5); }

DEV int mod_row(int row) { return row < NCTX ? 2 : (row - NCTX) / SEQ; }

template <bool SYNC_EPI, class Epi, bool VEC4 = false>
DEV void gemm_tile_128(const bf16_t* __restrict__ A, int lda, int M, const bf16_t* __restrict__ Bt, int ldb, int N,
                       int K, int m0, int n0, const Epi& epi, unsigned char* smem) {
  constexpr int LS = 72;
  constexpr int STAGE = 2 * 128 * LS;
  bf16_t* sbase = (bf16_t*)smem;
  const int wave = threadIdx.x >> 6;
  const int wm = (wave >> 1) * 64, wn = (wave & 1) * 64;
  f32x16 acc[2][2];
#pragma unroll
  for (int i = 0; i < 2; ++i)
#pragma unroll
    for (int j = 0; j < 2; ++j)
#pragma unroll
      for (int r = 0; r < 16; ++r) acc[i][j][r] = 0.f;
  u32x4 ra[4], rb[4];
  auto gload = [&](int k0) {
    int tl_ = threadIdx.x; OPAQUE(tl_);
#pragma unroll
    for (int i = 0; i < 4; ++i) {
      int c = tl_ + i * 256, r = c >> 3, cc = (c & 7) * 8;
      int gr = m0 + r, gn = n0 + r;
      gr = gr < M ? gr : M - 1; gn = gn < N ? gn : N - 1;
      ra[i] = *(const u32x4*)(A + (size_t)gr * lda + k0 + cc);
      rb[i] = *(const u32x4*)(Bt + (size_t)gn * ldb + k0 + cc);
    }
  };
  auto lwrite = [&](int buf) {
    int tl_ = threadIdx.x; OPAQUE(tl_);
    bf16_t* sA = sbase + buf * STAGE;
    bf16_t* sB = sA + 128 * LS;
#pragma unroll
    for (int i = 0; i < 4; ++i) {
      int c = tl_ + i * 256, r = c >> 3, cc = (c & 7) * 8;
      *(u32x4*)(sA + r * LS + cc) = ra[i];
      *(u32x4*)(sB + r * LS + cc) = rb[i];
    }
  };
  const int nk = K >> 6;
  gload(0);
  __syncthreads();
  lwrite(0);
  if (nk > 1) gload(64);
  __syncthreads();
  for (int it = 0; it < nk; ++it) {
    int tl_ = threadIdx.x; OPAQUE(tl_);
    const int lane = tl_ & 63;
    const bf16_t* sA = sbase + (it & 1) * STAGE;
    const bf16_t* sB = sA + 128 * LS;
#pragma unroll
    for (int kk = 0; kk < 4; ++kk) {
      bf16x8 a[2], b[2];
      const int ko = kk * 16 + 8 * (lane >> 5);
#pragma unroll
      for (int i = 0; i < 2; ++i) a[i] = *(const bf16x8*)(sA + (wm + i * 32 + (lane & 31)) * LS + ko);
#pragma unroll
      for (int j = 0; j < 2; ++j) b[j] = *(const bf16x8*)(sB + (wn + j * 32 + (lane & 31)) * LS + ko);
#pragma unroll
      for (int i = 0; i < 2; ++i)
#pragma unroll
        for (int j = 0; j < 2; ++j) acc[i][j] = mfma32(a[i], b[j], acc[i][j]);
      if (kk == 1) {
        if (it + 1 < nk) lwrite((it + 1) & 1);
        if (it + 2 < nk) gload((it + 2) * 64);
      }
    }
    __syncthreads();
  }
  {
    int tl_ = threadIdx.x; OPAQUE(tl_);
    const int lane = tl_ & 63;
    if constexpr (VEC4) {
#pragma unroll
      for (int i = 0; i < 2; ++i)
#pragma unroll
        for (int j = 0; j < 2; ++j)
#pragma unroll
          for (int gq = 0; gq < 4; ++gq) {
            int row = m0 + wm + i * 32 + 8 * gq + 4 * (lane >> 5);
            int col = n0 + wn + j * 32 + (lane & 31);
            if (row < M && col < N) epi.store4(row, col, acc[i][j][4 * gq], acc[i][j][4 * gq + 1], acc[i][j][4 * gq + 2], acc[i][j][4 * gq + 3]);
          }
    } else {
#pragma unroll
      for (int i = 0; i < 2; ++i)
#pragma unroll
        for (int j = 0; j < 2; ++j)
#pragma unroll
          for (int r = 0; r < 16; ++r) {
            int row = m0 + wm + i * 32 + acc_row(r, lane);
            int col = n0 + wn + j * 32 + (lane & 31);
            if (row < M && col < N) epi(row, col, acc[i][j][r]);
          }
    }
  }
}

template <class Epi, bool VEC4 = false>
DEV void gemm_tile_128x256(const bf16_t* __restrict__ A, int lda, int M, const bf16_t* __restrict__ Bt, int ldb, int N,
                           int K, int m0, int n0, const Epi& epi, unsigned char* smem) {
  constexpr int LS = 72;
  bf16_t* sA = (bf16_t*)smem;
  bf16_t* sB = sA + 128 * LS;
  const int wave = threadIdx.x >> 6;
  const int wm = (wave >> 1) * 64, wn = (wave & 1) * 128;
  f32x16 acc[2][4];
#pragma unroll
  for (int i = 0; i < 2; ++i)
#pragma unroll
    for (int j = 0; j < 4; ++j)
#pragma unroll
      for (int r = 0; r < 16; ++r) acc[i][j][r] = 0.f;
  u32x4 ra[4], rb[8];
  {
    const int tid = threadIdx.x;
#pragma unroll
    for (int i = 0; i < 4; ++i) {
      int c = tid + i * 256, r = c >> 3, cc = (c & 7) * 8;
      { int gr = m0 + r; gr = gr < M ? gr : M - 1; ra[i] = *(const u32x4*)(A + (size_t)gr * lda + cc); }
    }
#pragma unroll
    for (int i = 0; i < 8; ++i) {
      int c = tid + i * 256, r = c >> 3, cc = (c & 7) * 8;
      { int gn = n0 + r; gn = gn < N ? gn : N - 1; rb[i] = *(const u32x4*)(Bt + (size_t)gn * ldb + cc); }
    }
  }
  for (int k0 = 0; k0 < K; k0 += 64) {
    int tl_ = threadIdx.x; OPAQUE(tl_);
    const int tid = tl_, lane = tl_ & 63;
    __syncthreads();
#pragma unroll
    for (int i = 0; i < 4; ++i) { int c = tid + i * 256, r = c >> 3, cc = (c & 7) * 8; *(u32x4*)(sA + r * LS + cc) = ra[i]; }
#pragma unroll
    for (int i = 0; i < 8; ++i) { int c = tid + i * 256, r = c >> 3, cc = (c & 7) * 8; *(u32x4*)(sB + r * LS + cc) = rb[i]; }
    __syncthreads();
    if (k0 + 64 < K) {
#pragma unroll
      for (int i = 0; i < 4; ++i) {
        int c = tid + i * 256, r = c >> 3, cc = (c & 7) * 8;
        { int gr = m0 + r; gr = gr < M ? gr : M - 1; ra[i] = *(const u32x4*)(A + (size_t)gr * lda + k0 + 64 + cc); }
      }
#pragma unroll
      for (int i = 0; i < 8; ++i) {
        int c = tid + i * 256, r = c >> 3, cc = (c & 7) * 8;
        { int gn = n0 + r; gn = gn < N ? gn : N - 1; rb[i] = *(const u32x4*)(Bt + (size_t)gn * ldb + k0 + 64 + cc); }
      }
    }
#pragma unroll 2
    for (int kk = 0; kk < 4; ++kk) {
      bf16x8 a[2], b[4];
      const int ko = kk * 16 + 8 * (lane >> 5);
#pragma unroll
      for (int i = 0; i < 2; ++i) a[i] = *(const bf16x8*)(sA + (wm + i * 32 + (lane & 31)) * LS + ko);
#pragma unroll
      for (int j = 0; j < 4; ++j) b[j] = *(const bf16x8*)(sB + (wn + j * 32 + (lane & 31)) * LS + ko);
#pragma unroll
      for (int i = 0; i < 2; ++i)
#pragma unroll
        for (int j = 0; j < 4; ++j) acc[i][j] = mfma32(a[i], b[j], acc[i][j]);
    }
  }
  {
    int tl_ = threadIdx.x; OPAQUE(tl_);
    const int lane = tl_ & 63;
    if constexpr (VEC4) {
#pragma unroll
      for (int i = 0; i < 2; ++i)
#pragma unroll
        for (int j = 0; j < 4; ++j)
#pragma unroll
          for (int gq = 0; gq < 4; ++gq) {
            int row = m0 + wm + i * 32 + 8 * gq + 4 * (lane >> 5);
            int col = n0 + wn + j * 32 + (lane & 31);
            if (row < M && col < N) epi.store4(row, col, acc[i][j][4 * gq], acc[i][j][4 * gq + 1], acc[i][j][4 * gq + 2], acc[i][j][4 * gq + 3]);
          }
    } else {
#pragma unroll
      for (int i = 0; i < 2; ++i)
#pragma unroll
        for (int j = 0; j < 4; ++j)
#pragma unroll
          for (int r = 0; r < 16; ++r) {
            int row = m0 + wm + i * 32 + acc_row(r, lane);
            int col = n0 + wn + j * 32 + (lane & 31);
            if (row < M && col < N) epi(row, col, acc[i][j][r]);
          }
    }
  }
}

DEV void transpose_tile(const float* __restrict__ src, int ld_src, bf16_t* __restrict__ dst, int ld_dst, int K, int N,
                        int tk, int tn, unsigned char* smem) {
  float* sT = (float*)smem;
  const int tid = threadIdx.x;
  __syncthreads();
  {
    const int tx = tid & 15, ty = tid >> 4;
#pragma unroll
    for (int p = 0; p < 4; ++p) {
      int k = tk * 64 + ty + p * 16, n = tn * 64 + tx * 4;
#pragma unroll
      for (int j = 0; j < 4; ++j) {
        float v = (k < K && n + j < N) ? src[(size_t)k * ld_src + n + j] : 0.f;
        sT[(ty + p * 16) * 65 + tx * 4 + j] = v;
      }
    }
  }
  __syncthreads();
  {
    const int n = tid >> 2, kseg = (tid & 3) * 16;
    int gn = tn * 64 + n;
    if (gn < N) {
      float v[16];
#pragma unroll
      for (int j = 0; j < 16; ++j) v[j] = sT[(kseg + j) * 65 + n];
      bf16_t* d = dst + (size_t)gn * ld_dst + tk * 64 + kseg;
      *(u32x4*)d = pack8(v);
      *(u32x4*)(d + 8) = pack8(v + 8);
    }
  }
}

constexpr int TJ0 = 16 * 49, TJ1 = 16 * 16, TJ2 = 16 * 44, TJ3 = 16 * 16, TJ4 = 2 * 16 * 32, TJ5 = 2 * 8, TJ6 = 2 * 8,
              TJ7 = 2 * 8, TJ8 = 32;
constexpr int NTRANS = TJ0 + TJ1 + TJ2 + TJ3 + TJ4 + TJ5 + TJ6 + TJ7 + TJ8;
constexpr int NKEYCV = (2 * 8 * 2 * 128 * 128) / (256 * 8);
constexpr int NMODV = 2 * 96;
constexpr int NPREP = NTRANS + NKEYCV + NMODV;

DEV void st_prep(const Params& P, int item, unsigned char* smem) {
  unsigned char* ws = P.ws;
  if (item < NTRANS) {
    int t = item;
    if (t < TJ0) { transpose_tile(P.in[I_EVWIN], EVC, (bf16_t*)(ws + OFF_WEVIN), 1024, 1024, EVC, t / 49, t % 49, smem); return; }
    t -= TJ0;
    if (t < TJ1) { transpose_tile(P.in[I_EVWOUT], 1024, (bf16_t*)(ws + OFF_WEVOUT), 1024, 1024, 1024, t / 16, t % 16, smem); return; }
    t -= TJ1;
    if (t < TJ2) { transpose_tile(P.in[I_ODWIN], ODC, (bf16_t*)(ws + OFF_WODIN), 1024, 1024, ODC, t / 44, t % 44, smem); return; }
    t -= TJ2;
    if (t < TJ3) { transpose_tile(P.in[I_ODWOUT], 1024, (bf16_t*)(ws + OFF_WODOUT), 1024, 1024, 1024, t / 16, t % 16, smem); return; }
    t -= TJ3;
    if (t < TJ4) {
      int l = t / 512, tt = t % 512;
      transpose_tile(P.in[I_WQ] + (size_t)l * 1024 * 2048, 2048, (bf16_t*)(ws + OFF_WQ) + (size_t)l * 2048 * 1024, 1024, 1024, 2048, tt / 32, tt % 32, smem);
      return;
    }
    t -= TJ4;
    if (t < TJ5) { int d = t / 8; transpose_tile(P.in[I_WUP] + d * 64 * 512, 512, (bf16_t*)(ws + OFF_WUP) + d * 512 * 64, 64, 64, 512, 0, t % 8, smem); return; }
    t -= TJ5;
    if (t < TJ6) { int d = t / 8; transpose_tile(P.in[I_AUP] + d * 64 * 512, 512, (bf16_t*)(ws + OFF_AUP) + d * 512 * 64, 64, 64, 512, 0, t % 8, smem); return; }
    t -= TJ6;
    if (t < TJ7) { transpose_tile(P.in[I_GUP], 512, (bf16_t*)(ws + OFF_GUP), 128, 128, 512, t / 8, t % 8, smem); return; }
    t -= TJ7;
    {
      int which = t & 1, db = t >> 1;
      const float* src = (which ? P.in[I_WI] : P.in[I_WA]) + (size_t)db * 64 * 64;
      transpose_tile(src, 64, (bf16_t*)(ws + OFF_LRUT) + (size_t)db * 128 * 64 + which * 64 * 64, 64, 64, 64, 0, 0, smem);
      return;
    }
  }
  item -= NTRANS;
  if (item < NKEYCV) {
    size_t e = ((size_t)item * 256 + threadIdx.x) * 8;
    const float* s = P.in[I_KEYS] + e;
    f32x4 a = *(const f32x4*)s, b = *(const f32x4*)(s + 4);
    float v[8] = {a.x, a.y, a.z, a.w, b.x, b.y, b.z, b.w};
    *(u32x4*)((bf16_t*)(ws + OFF_KEYS) + e) = pack8(v);
    return;
  }
  item -= NKEYCV;
  {
    const int l = item / 96, cgp = item % 96;
    float* sS = (float*)smem;
    float* sRed = sS + 3 * 1024;
    const int tid = threadIdx.x;
    __syncthreads();
    for (int i = tid; i < 3 * 1024; i += 256) {
      int m = i >> 10, k = i & 1023;
      float c = m < 2 ? P.in[I_C][m * 1024 + k] : P.in[I_CCTX][k];
      sS[i] = siluf_(c);
    }
    __syncthreads();
    const int ks = tid >> 6, col = cgp * 64 + (tid & 63);
    const float* w = P.in[I_MODW] + (size_t)l * 1024 * 6144 + col;
    float a0 = 0.f, a1 = 0.f, a2 = 0.f;
    for (int k = ks * 256; k < ks * 256 + 256; ++k) {
      float wv = w[(size_t)k * 6144];
      a0 += sS[k] * wv; a1 += sS[1024 + k] * wv; a2 += sS[2048 + k] * wv;
    }
    sRed[(ks * 3 + 0) * 64 + (tid & 63)] = a0;
    sRed[(ks * 3 + 1) * 64 + (tid & 63)] = a1;
    sRed[(ks * 3 + 2) * 64 + (tid & 63)] = a2;
    __syncthreads();
    if (tid < 192) {
      int m = tid >> 6, c = tid & 63;
      float s = sRed[(0 * 3 + m) * 64 + c] + sRed[(1 * 3 + m) * 64 + c] + sRed[(2 * 3 + m) * 64 + c] + sRed[(3 * 3 + m) * 64 + c];
      int cc = cgp * 64 + c;
      ((float*)(ws + OFF_MODV))[((size_t)l * 3 + m) * 6144 + cc] = s + P.in[I_MODB][l * 6144 + cc];
    }
  }
}

constexpr int NPCONV = 2 * (NEXP * 1024 / (256 * 16));
DEV void st_peer_conv(const Params& P, int layer, int item) {
  const int half = NPCONV / 2;
  int which = item >= half;
  int it = which ? item - half : item;
  size_t e = ((size_t)it * 256 + threadIdx.x) * 16;
  const float* s = (which ? P.in[I_PV] : P.in[I_PU]) + (size_t)layer * NEXP * 1024 + e;
  const float sc = which ? PEER_VSCALE : PEER_USCALE;
  u32x4 o;
  f32x4 a = *(const f32x4*)s; o.x = pack4_fp8(a.x * sc, a.y * sc, a.z * sc, a.w * sc);
  a = *(const f32x4*)(s + 4); o.y = pack4_fp8(a.x * sc, a.y * sc, a.z * sc, a.w * sc);
  a = *(const f32x4*)(s + 8); o.z = pack4_fp8(a.x * sc, a.y * sc, a.z * sc, a.w * sc);
  a = *(const f32x4*)(s + 12); o.w = pack4_fp8(a.x * sc, a.y * sc, a.z * sc, a.w * sc);
  const size_t ex = e >> 10, col = e & 1023;
  *(u32x4*)(P.ws + OFF_PU + ex * 2048 + (which ? 1024 : 0) + col) = o;
}

DEV void st_normmod(const Params& P, int layer, int which, int row) {
  const int lane = threadIdx.x & 63;
  const float* src;
  if (which == 0 && layer == 0) src = row < NCTX ? P.in[I_CTX] + (size_t)row * 1024 : P.in[I_X] + (size_t)(row - NCTX) * 1024;
  else src = row < NCTX ? (const float*)(P.ws + OFF_CTXRES) + (size_t)row * 1024 : P.out + (size_t)(row - NCTX) * 1024;
  const float* mv = (const float*)(P.ws + OFF_MODV) + ((size_t)layer * 3 + mod_row(row)) * 6144;
  const float* sh = mv + (which ? 3 : 0) * 1024;
  const float* sc = mv + (which ? 4 : 1) * 1024;
  const float* nw = (which ? P.in[I_NORM2] : P.in[I_NORM1]) + layer * 1024;
  f32x4 v[4];
  float ss = 0.f;
#pragma unroll
  for (int i = 0; i < 4; ++i) {
    v[i] = *(const f32x4*)(src + i * 256 + lane * 4);
    ss += v[i].x * v[i].x + v[i].y * v[i].y + v[i].z * v[i].z + v[i].w * v[i].w;
  }
  ss = wave_sum(ss);
  const float rstd = frsq(ss * (1.f / 1024.f) + 1e-6f);
  bf16_t* dst = (bf16_t*)(P.ws + OFF_HBUF) + (size_t)row * 1024;
#pragma unroll
  for (int i = 0; i < 4; ++i) {
    int c = i * 256 + lane * 4;
    f32x4 w4 = *(const f32x4*)(nw + c), s4 = *(const f32x4*)(sc + c), h4 = *(const f32x4*)(sh + c);
    float o0 = v[i].x * rstd * w4.x * (1.f + s4.x) + h4.x;
    float o1 = v[i].y * rstd * w4.y * (1.f + s4.y) + h4.y;
    float o2 = v[i].z * rstd * w4.z * (1.f + s4.z) + h4.z;
    float o3 = v[i].w * rstd * w4.w * (1.f + s4.w) + h4.w;
    u32x2 pk; pk.x = pack2(o0, o1); pk.y = pack2(o2, o3);
    *(u32x2*)(dst + c) = pk;
  }
}

struct EpiProjL0 {
  bf16_t* proj; float* gates;
  DEVM void operator()(int row, int col, float v) const {
    proj[(size_t)row * EVC + col] = f2bf(v);
    if (col >= 1536 && col < 1552) gates[row * 32 + (col - 1536)] = v;
    else if (col >= 3088) gates[row * 32 + 16 + (col - 3088)] = v;
  }
};
struct EpiStoreBf {
  bf16_t* dst; int ld;
  DEVM void operator()(int row, int col, float v) const { dst[(size_t)row * ld + col] = f2bf(v); }
};
struct EpiStoreBfBias {
  bf16_t* dst; int ld; const float* bias;
  DEVM void operator()(int row, int col, float v) const { dst[(size_t)row * ld + col] = f2bf(v + (bias ? bias[col] : 0.f)); }
};
struct EpiProjL0T {
  bf16_t* proj; float* gates;
  DEVM void operator()(int, int, float) const {}
  DEVM void store4(int n, int m, float v0, float v1, float v2, float v3) const {
    u32x2 pk; pk.x = pack2(v0, v1); pk.y = pack2(v2, v3);
    *(u32x2*)(proj + (size_t)m * EVC + n) = pk;
    if (n >= 1536 && n < 1552) { f32x4 g = {v0, v1, v2, v3}; *(f32x4*)(gates + m * 32 + (n - 1536)) = g; }
    else if (n >= 3088) { f32x4 g = {v0, v1, v2, v3}; *(f32x4*)(gates + m * 32 + 16 + (n - 3088)) = g; }
  }
};
struct EpiStoreBfT {
  bf16_t* dst; int ld;
  DEVM void operator()(int, int, float) const {}
  DEVM void store4(int n, int m, float v0, float v1, float v2, float v3) const {
    u32x2 pk; pk.x = pack2(v0, v1); pk.y = pack2(v2, v3);
    *(u32x2*)(dst + (size_t)m * ld + n) = pk;
  }
};
struct EpiOutProjT {
  const float* x_lat; const float* x_ctx; float* o_lat; float* o_ctx; const float* modv;
  DEVM void operator()(int, int, float) const {}
  DEVM void store4(int n, int m, float v0, float v1, float v2, float v3) const {
    const f32x4 g = *(const f32x4*)(modv + mod_row(m) * 6144 + 2 * 1024 + n);
    const float* xs; float* od;
    if (m < NCTX) { xs = x_ctx + (size_t)m * 1024 + n; od = o_ctx + (size_t)m * 1024 + n; }
    else { size_t o = (size_t)(m - NCTX) * 1024 + n; xs = x_lat + o; od = o_lat + o; }
    const f32x4 x = *(const f32x4*)xs;
    f32x4 r = {x.x + g.x * v0, x.y + g.y * v1, x.z + g.z * v2, x.w + g.w * v3};
    *(f32x4*)od = r;
  }
};
struct EpiStoreBfBiasT {
  bf16_t* dst; int ld; const float* bias;
  DEVM void operator()(int, int, float) const {}
  DEVM void store4(int n, int m, float v0, float v1, float v2, float v3) const {
    if (bias) { v0 += bias[n]; v1 += bias[n + 1]; v2 += bias[n + 2]; v3 += bias[n + 3]; }
    u32x2 pk; pk.x = pack2(v0, v1); pk.y = pack2(v2, v3);
    *(u32x2*)(dst + (size_t)m * ld + n) = pk;
  }
};
struct EpiOutProj {
  const float* x_lat; const float* x_ctx; float* o_lat; float* o_ctx; const float* modv;
  DEVM void operator()(int row, int col, float v) const {
    float g = modv[mod_row(row) * 6144 + 2 * 1024 + col];
    if (row < NCTX) o_ctx[(size_t)row * 1024 + col] = x_ctx[(size_t)row * 1024 + col] + g * v;
    else { size_t o = (size_t)(row - NCTX) * 1024 + col; o_lat[o] = x_lat[o] + g * v; }
  }
};
struct EpiScoreLds {
  float* sS; int m0;
  DEVM void operator()(int row, int col, float v) const { sS[(row - m0) * 129 + col] = v; }
};

DEV void st_xbc_conv(const Params& P, int row) {
  const int lane = threadIdx.x & 63;
  const bf16_t* proj = (const bf16_t*)(P.ws + OFF_PROJ);
  bf16_t* xc = (bf16_t*)P.out + (size_t)row * 1024;
  int row0, len, pos;
  if (row < NCTX) { row0 = (row / CTXL) * CTXL; len = CTXL; pos = row - row0; }
  else { int r = row - NCTX; row0 = NCTX + (r / SEQ) * SEQ; len = SEQ; pos = r % SEQ; }
  const float* cw = P.in[I_SCONVW];
  const float* cb = P.in[I_SCONVB];
#pragma unroll
  for (int hh = 0; hh < 2; ++hh) {
    const int ch = hh * 512 + lane * 8;
    float o[8];
#pragma unroll
    for (int j = 0; j < 8; ++j) o[j] = cb[ch + j];
#pragma unroll
    for (int tap = 0; tap < 4; ++tap) {
      int pp = pos + tap - 2;
      if (pp >= 0 && pp < len) {
        float x[8];
        unpack8(*(const u32x4*)(proj + (size_t)(row0 + pp) * EVC + 2064 + ch), x);
        f32x4 w0 = *(const f32x4*)(cw + tap * 1024 + ch), w1 = *(const f32x4*)(cw + tap * 1024 + ch + 4);
        o[0] += w0.x * x[0]; o[1] += w0.y * x[1]; o[2] += w0.z * x[2]; o[3] += w0.w * x[3];
        o[4] += w1.x * x[4]; o[5] += w1.y * x[5]; o[6] += w1.z * x[6]; o[7] += w1.w * x[7];
      }
    }
#pragma unroll
    for (int j = 0; j < 8; ++j) o[j] = siluf_(o[j]);
    *(u32x4*)(xc + ch) = pack8(o);
  }
}

#ifndef LA_NSEG
#define LA_NSEG 10
#endif
constexpr int LA_NCH = (CTXL + SEQ) / 64;
constexpr int LA_CPS = LA_NCH / LA_NSEG;
static_assert(LA_NCH % LA_NSEG == 0, "linattn segments");
#ifdef CPU_EMU
constexpr size_t OFF_LASEG = OFF_PR + PR_BYTES;
#else
constexpr size_t OFF_LASEG = OFF_R2L0 + (size_t)NTOK * 1024 * 2;
#endif
constexpr size_t LASEG_U = (size_t)48 * LA_NSEG * 8192 * 4;
constexpr size_t OFF_LASEG_N = OFF_LASEG + LASEG_U;
constexpr size_t OFF_LASEG_D = OFF_LASEG_N + (size_t)48 * LA_NSEG * 64 * 4;
#ifndef CPU_EMU
static_assert(OFF_LASEG_D + 48 * LA_NSEG * 4 <= OFF_PR + PR_BYTES, "laseg");
#endif

struct LaRaw { u32x4 q[2], k[4], x[4]; float g0, g1; };

template <bool MLSTM, bool FULL>
DEV void la_load_raw(const Params& P, int b, int h, int d, int cc, LaRaw& R) {
  constexpr int NC_CTX = CTXL / 64;
  const int tid = threadIdx.x;
  const int seg = cc >= NC_CTX;
  const int row0 = seg ? NCTX + b * SEQ : b * CTXL;
  const int len = seg ? SEQ : CTXL;
  const int cl = (seg ? cc - NC_CTX : cc) * 64;
  const bf16_t* proj = (const bf16_t*)(P.ws + OFF_PROJ);
  const bf16_t* xcv = (const bf16_t*)P.out;
  const float* gates = (const float*)(P.ws + OFF_GATES);
  if (tid < 64) {
    int p = cl + tid, grow = row0 + (d ? len - 1 - p : p);
    if (MLSTM) { R.g0 = gates[grow * 32 + d * 4 + h]; R.g1 = gates[grow * 32 + 8 + d * 4 + h]; }
    else { R.g0 = gates[grow * 32 + 16 + d * 8 + h]; R.g1 = 0.f; }
  }
  if (MLSTM) {
#pragma unroll
    for (int i = 0; i < 2; ++i) {
      int c = tid + i * 256, r = c >> 3, cc8 = (c & 7) * 8;
      int p = cl + r, pos = d ? len - 1 - p : p;
      const bf16_t* rp = proj + (size_t)(row0 + pos) * EVC;
      if (FULL) R.q[i] = *(const u32x4*)(rp + h * 64 + cc8);
      R.k[i] = *(const u32x4*)(rp + 256 + h * 64 + cc8);
    }
#pragma unroll
    for (int i = 0; i < 4; ++i) {
      int c = tid + i * 256, r = c >> 4, cc8 = (c & 15) * 8;
      int p = cl + r, pos = d ? len - 1 - p : p;
      R.x[i] = *(const u32x4*)(proj + (size_t)(row0 + pos) * EVC + 512 + h * 128 + cc8);
    }
  } else {
    const int grp = h >> 2;
#pragma unroll
    for (int i = 0; i < 2; ++i) {
      int c = tid + i * 256, r = c >> 3, cc8 = (c & 7) * 8;
      int p = cl + r, pos = d ? len - 1 - p : p;
      R.x[i] = *(const u32x4*)(xcv + (size_t)(row0 + pos) * 1024 + h * 64 + cc8);
    }
#pragma unroll
    for (int i = 0; i < 4; ++i) {
      int c = tid + i * 256, r = c >> 4, cc8 = (c & 15) * 8;
      int p = cl + r, pos = d ? len - 1 - p : p;
      const bf16_t* rp = xcv + (size_t)(row0 + pos) * 1024;
      R.k[i] = *(const u32x4*)(rp + 512 + grp * 128 + cc8);
      if (FULL) { if (i < 2) R.q[i] = *(const u32x4*)(rp + 768 + grp * 128 + cc8); else R.x[i] = *(const u32x4*)(rp + 768 + grp * 128 + cc8); }
    }
  }
}

template <bool MLSTM, bool FULL>
DEV void st_linattn_seg(const Params& P, int sid, int seg, unsigned char* smem) {
  constexpr int DK = MLSTM ? 64 : 128, DX = MLSTM ? 128 : 64;
  constexpr int QS = DK + 8;
  constexpr int NH = MLSTM ? 4 : 8;
  constexpr int NC_CTX = CTXL / 64;
  const int tid = threadIdx.x, lane = tid & 63, wave = tid >> 6;
  const int d = sid & 1, h = (sid >> 1) % NH, b = (sid >> 1) / NH;
  const int gsid = MLSTM ? sid : 16 + sid;
  bf16_t* sQ = (bf16_t*)smem;
  bf16_t* sK = sQ + 64 * QS;
  bf16_t* sP = sK;
  bf16_t* sKT = sK + 64 * QS;
  bf16_t* sXT = sKT + DK * 72;
  bf16_t* sST = sXT + DX * 72;
  float* sF = (float*)(sST + DX * QS);
  float* sLa = sF;
  float* sG = sF + 64;
  float* sBc = sF + 128;
  float* sDen = sF + 192;
  float* sN = sF + 256;
  int* sRow = (int*)(sF + 384);
  static_assert((64 * QS * 2 + DK * 72 + DX * 72 + DX * QS) * 2 + 448 * 4 <= SMEM_BYTES, "lds");
  bf16_t* outb = MLSTM ? (bf16_t*)(P.ws + OFF_HBUF) : (bf16_t*)(P.ws + OFF_R2L0);
  float* segU = (float*)(P.ws + OFF_LASEG);
  float* segN = (float*)(P.ws + OFF_LASEG_N);
  float* segD = (float*)(P.ws + OFF_LASEG_D);

  f32x16 accS[2];
#pragma unroll
  for (int j = 0; j < 2; ++j)
#pragma unroll
    for (int r = 0; r < 16; ++r) accS[j][r] = 0.f;
  const int sx0 = MLSTM ? wave * 32 : (wave >> 1) * 32;
  const int sk0 = MLSTM ? 0 : (wave & 1) * 64;
  float nreg = 0.f;
  float gb0 = 0.f, gb1 = 0.f, alog_e = 0.f, dskip = 0.f;
  if (MLSTM) { gb0 = P.in[I_IBIAS][d * 4 + h]; gb1 = P.in[I_FBIAS][d * 4 + h]; }
  else { gb0 = P.in[I_DTBIAS][d * 8 + h]; alog_e = fexp(P.in[I_ALOG][d * 8 + h]); dskip = P.in[I_DSKIP][h]; }

  const int cc0 = seg * LA_CPS, cc1 = cc0 + LA_CPS;
  LaRaw R;
  la_load_raw<MLSTM, FULL>(P, b, h, d, cc0, R);
  __syncthreads();
  if (FULL) {
    for (int js = 0; js < seg; ++js) {
      const size_t it = (size_t)gsid * LA_NSEG + js;
      const float a = fexp(segD[it]);
      const float* U = segU + it * 8192;
#pragma unroll
      for (int j = 0; j < 2; ++j)
#pragma unroll
        for (int r = 0; r < 16; ++r) accS[j][r] = a * accS[j][r] + U[(j * 16 + r) * 256 + tid];
      if (MLSTM && tid < 64) nreg = a * nreg + segN[it * 64 + tid];
    }
#pragma unroll
    for (int j = 0; j < 2; ++j)
#pragma unroll
      for (int r = 0; r < 16; ++r) sST[(sx0 + acc_row(r, lane)) * QS + sk0 + j * 32 + (lane & 31)] = f2bf(accS[j][r]);
    if (tid < 128) sN[tid] = (MLSTM && tid < 64) ? nreg : 0.f;
  }
  float lsum = 0.f;

  for (int cc = cc0; cc < cc1; ++cc) {
    int tl_ = threadIdx.x; OPAQUE(tl_);
    const int tid = tl_, lane = tl_ & 63;
    const int sgi = cc >= NC_CTX;
    const int row0 = sgi ? NCTX + b * SEQ : b * CTXL;
    const int len = sgi ? SEQ : CTXL;
    const int cl = (sgi ? cc - NC_CTX : cc) * 64;
    if (tid < 64) {
      int p = cl + tid;
      sRow[tid] = row0 + (d ? len - 1 - p : p);
      if (MLSTM) { sLa[tid] = -softplusf_(-(R.g1 + gb1)); sG[tid] = fexp(R.g0 + gb0); }
      else { float dt = softplusf_(R.g0 + gb0); sLa[tid] = -dt * alog_e; sG[tid] = dt; }
    }
    __syncthreads();
    if (wave == 0) {
      float v = sLa[lane];
#pragma unroll
      for (int off = 1; off < 64; off <<= 1) {
#ifdef CPU_EMU
        float o = emu_shfl_up(v, off);
#else
        float o = __shfl_up(v, off, 64);
#endif
        if (lane >= off) v += o;
      }
      sBc[lane] = v;
    }
    __syncthreads();
    const float blast = sBc[63];
    lsum += blast;
    if (MLSTM) {
#pragma unroll
      for (int i = 0; i < 2; ++i) {
        int c = tid + i * 256, r = c >> 3, cc8 = (c & 7) * 8;
        float kf[8]; unpack8(R.k[i], kf);
        const float wgt = fexp(blast - sBc[r]) * sG[r];
#pragma unroll
        for (int j = 0; j < 8; ++j) sKT[(cc8 + j) * 72 + r] = f2bf(kf[j] * wgt);
        if (FULL) {
          float qf[8]; unpack8(R.q[i], qf);
#pragma unroll
          for (int j = 0; j < 8; ++j) qf[j] *= 0.125f;
          *(u32x4*)(sQ + r * QS + cc8) = pack8(qf);
          *(u32x4*)(sK + r * QS + cc8) = R.k[i];
        }
      }
#pragma unroll
      for (int i = 0; i < 4; ++i) {
        int c = tid + i * 256, r = c >> 4, cc8 = (c & 15) * 8;
        const bf16_t* xs = (const bf16_t*)&R.x[i];
#pragma unroll
        for (int j = 0; j < 8; ++j) sXT[(cc8 + j) * 72 + r] = xs[j];
      }
    } else {
#pragma unroll
      for (int i = 0; i < 2; ++i) {
        int c = tid + i * 256, r = c >> 3, cc8 = (c & 7) * 8;
        const bf16_t* xs = (const bf16_t*)&R.x[i];
#pragma unroll
        for (int j = 0; j < 8; ++j) sXT[(cc8 + j) * 72 + r] = xs[j];
      }
#pragma unroll
      for (int i = 0; i < 4; ++i) {
        int c = tid + i * 256, r = c >> 4, cc8 = (c & 15) * 8;
        float kf[8]; unpack8(R.k[i], kf);
        const float wgt = fexp(blast - sBc[r]) * sG[r];
#pragma unroll
        for (int j = 0; j < 8; ++j) sKT[(cc8 + j) * 72 + r] = f2bf(kf[j] * wgt);
        if (FULL) {
          *(u32x4*)(sK + r * QS + cc8) = R.k[i];
          *(u32x4*)(sQ + r * QS + cc8) = i < 2 ? R.q[i] : R.x[i];
        }
      }
    }
    if (cc + 1 < cc1) la_load_raw<MLSTM, FULL>(P, b, h, d, cc + 1, R);
    __syncthreads();
    if (FULL) {
      const int tr = (wave >> 1) * 32, tc = (wave & 1) * 32;
      f32x16 accP;
#pragma unroll
      for (int r = 0; r < 16; ++r) accP[r] = 0.f;
      if (!(tr == 0 && tc == 32)) {
#pragma unroll
        for (int kk = 0; kk < DK / 16; ++kk) {
          const int ko = kk * 16 + 8 * (lane >> 5);
          bf16x8 a = *(const bf16x8*)(sQ + (tr + (lane & 31)) * QS + ko);
          bf16x8 bb = *(const bf16x8*)(sK + (tc + (lane & 31)) * QS + ko);
          accP = mfma32(a, bb, accP);
        }
      }
      __syncthreads();
      {
        const int s = tc + (lane & 31);
        const float bs = sBc[s], gs = sG[s];
#pragma unroll
        for (int r = 0; r < 16; ++r) {
          int t = tr + acc_row(r, lane);
          float v = (s <= t) ? accP[r] * fexp(sBc[t] - bs) * gs : 0.f;
          sP[t * 72 + s] = f2bf(v);
        }
        for (int i = tid; i < 64 * DK; i += 256) {
          int t = i / DK, k = i % DK;
          sQ[t * QS + k] = f2bf(bf2f(sQ[t * QS + k]) * fexp(sBc[t]));
        }
      }
      __syncthreads();
      constexpr int NYT = MLSTM ? 2 : 1;
      const int yx0 = MLSTM ? wave * 32 : (wave >> 1) * 32;
      const int yt0 = MLSTM ? 0 : (wave & 1) * 32;
      f32x16 accY[NYT];
#pragma unroll
      for (int j = 0; j < NYT; ++j)
#pragma unroll
        for (int r = 0; r < 16; ++r) accY[j][r] = 0.f;
#pragma unroll
      for (int kk = 0; kk < 4; ++kk) {
        const int ko = kk * 16 + 8 * (lane >> 5);
        bf16x8 a = *(const bf16x8*)(sXT + (yx0 + (lane & 31)) * 72 + ko);
#pragma unroll
        for (int j = 0; j < NYT; ++j) {
          bf16x8 bb = *(const bf16x8*)(sP + (yt0 + j * 32 + (lane & 31)) * 72 + ko);
          accY[j] = mfma32(a, bb, accY[j]);
        }
      }
#pragma unroll
      for (int kk = 0; kk < DK / 16; ++kk) {
        const int ko = kk * 16 + 8 * (lane >> 5);
        bf16x8 a = *(const bf16x8*)(sST + (yx0 + (lane & 31)) * QS + ko);
#pragma unroll
        for (int j = 0; j < NYT; ++j) {
          bf16x8 bb = *(const bf16x8*)(sQ + (yt0 + j * 32 + (lane & 31)) * QS + ko);
          accY[j] = mfma32(a, bb, accY[j]);
        }
      }
      if (MLSTM) {
        if (tid < 64) {
          float den = 0.f, dq = 0.f;
#pragma unroll 8
          for (int s = 0; s < 64; ++s) den += bf2f(sP[tid * 72 + s]);
#pragma unroll 8
          for (int k = 0; k < DK; ++k) dq += sN[k] * bf2f(sQ[tid * QS + k]);
          sDen[tid] = den + dq;
        }
        __syncthreads();
      }
#pragma unroll
      for (int j = 0; j < NYT; ++j) {
        const int t = yt0 + j * 32 + (lane & 31);
        const size_t obase = (size_t)sRow[t] * 1024 + d * 512 + h * DX;
        const float dinv = MLSTM ? frcp(fmaxf(fabsf(sDen[t]), 1.f)) : 1.f;
#pragma unroll
        for (int g = 0; g < 4; ++g) {
          const int x0 = yx0 + 8 * g + 4 * (lane >> 5);
          float v0 = accY[j][4 * g], v1 = accY[j][4 * g + 1], v2 = accY[j][4 * g + 2], v3 = accY[j][4 * g + 3];
          if (MLSTM) { v0 *= dinv; v1 *= dinv; v2 *= dinv; v3 *= dinv; }
          else if (d == 0) {
            v0 += dskip * bf2f(sXT[(x0 + 0) * 72 + t]); v1 += dskip * bf2f(sXT[(x0 + 1) * 72 + t]);
            v2 += dskip * bf2f(sXT[(x0 + 2) * 72 + t]); v3 += dskip * bf2f(sXT[(x0 + 3) * 72 + t]);
          }
          u32x2 pk; pk.x = pack2(v0, v1); pk.y = pack2(v2, v3);
          *(u32x2*)(outb + obase + x0) = pk;
        }
      }
      __syncthreads();
    }
    {
      const float eb = fexp(blast);
#pragma unroll
      for (int j = 0; j < 2; ++j)
#pragma unroll
        for (int r = 0; r < 16; ++r) accS[j][r] *= eb;
#pragma unroll
      for (int kk = 0; kk < 4; ++kk) {
        const int ko = kk * 16 + 8 * (lane >> 5);
        bf16x8 a = *(const bf16x8*)(sXT + (sx0 + (lane & 31)) * 72 + ko);
#pragma unroll
        for (int j = 0; j < 2; ++j) {
          bf16x8 bb = *(const bf16x8*)(sKT + (sk0 + j * 32 + (lane & 31)) * 72 + ko);
          accS[j] = mfma32(a, bb, accS[j]);
        }
      }
      if (FULL) {
#pragma unroll
        for (int j = 0; j < 2; ++j)
#pragma unroll
          for (int r = 0; r < 16; ++r) sST[(sx0 + acc_row(r, lane)) * QS + sk0 + j * 32 + (lane & 31)] = f2bf(accS[j][r]);
      }
      if (MLSTM && tid < 64) {
        float nn = nreg * eb;
        for (int s = 0; s < 64; ++s) nn += bf2f(sKT[tid * 72 + s]);
        nreg = nn;
        if (FULL) sN[tid] = nn;
      }
    }
    __syncthreads();
  }
  if (!FULL) {
    const size_t it = (size_t)gsid * LA_NSEG + seg;
    float* U = segU + it * 8192;
#pragma unroll
    for (int j = 0; j < 2; ++j)
#pragma unroll
      for (int r = 0; r < 16; ++r) U[(j * 16 + r) * 256 + tid] = accS[j][r];
    if (MLSTM && tid < 64) segN[it * 64 + tid] = nreg;
    if (tid == 0) segD[it] = lsum;
  }
}

DEV void st_finish_l0(const Params& P, int row) {
  const int lane = threadIdx.x & 63;
  bf16_t* hb = (bf16_t*)(P.ws + OFF_HBUF) + (size_t)row * 1024;
  const bf16_t* yb = (const bf16_t*)(P.ws + OFF_R2L0) + (size_t)row * 1024;
  const bf16_t* pr = (const bf16_t*)(P.ws + OFF_PROJ) + (size_t)row * EVC;
  const int ch = lane * 8;
  float h0[8], h1[8], o[8], f1[8];
  unpack8(*(const u32x4*)(hb + ch), h0);
  unpack8(*(const u32x4*)(hb + 512 + ch), h1);
  unpack8(*(const u32x4*)(pr + 1024 + ch), o);
  float ss = 0.f;
#pragma unroll
  for (int j = 0; j < 8; ++j) { h0[j] += h1[j]; ss += h0[j] * h0[j]; }
  ss += wshfl_xor(ss, 1); ss += wshfl_xor(ss, 2); ss += wshfl_xor(ss, 4); ss += wshfl_xor(ss, 8);
  float rstd = frsq(ss * (1.f / 128.f) + 1e-6f);
#pragma unroll
  for (int j = 0; j < 8; ++j) f1[j] = h0[j] * rstd * P.in[I_MNORM][ch + j] * sigmoidf_(o[j]);
  float y0[8], y1[8], z[8], f2[8];
  unpack8(*(const u32x4*)(yb + ch), y0);
  unpack8(*(const u32x4*)(yb + 512 + ch), y1);
  unpack8(*(const u32x4*)(pr + 1552 + ch), z);
  float s2 = 0.f;
#pragma unroll
  for (int j = 0; j < 8; ++j) { y0[j] = (y0[j] + y1[j]) * siluf_(z[j]); s2 += y0[j] * y0[j]; }
  s2 = wave_sum(s2);
  float rstd2 = frsq(s2 * (1.f / 512.f) + 1e-6f);
#pragma unroll
  for (int j = 0; j < 8; ++j) f2[j] = y0[j] * rstd2 * P.in[I_SNORM][ch + j];
  *(u32x4*)(hb + ch) = pack8(f1);
  *(u32x4*)(hb + 512 + ch) = pack8(f2);
}

DEV float mixval(const bf16_t* __restrict__ proj, int row, int c, const float* __restrict__ mu) {
  float self = bf2f(proj[(size_t)row * ODC + c]);
  int nrow = -1;
  if (row < NCTX) {
    int pos = row % CTXL;
    if (c < 896) { if (pos > 0) nrow = row - 1; }
    else { if (pos < CTXL - 1) nrow = row + 1; }
  } else {
    int pos = (row - NCTX) % SEQ;
    int gx = pos % GW, gy = pos / GW, q = c / 448;
    if (q == 0) { if (gx > 0) nrow = row - 1; }
    else if (q == 1) { if (gx < GW - 1) nrow = row + 1; }
    else if (q == 2) { if (gy > 0) nrow = row - GW; }
    else { if (gy < SEQ / GW - 1) nrow = row + GW; }
  }
  float nb = nrow >= 0 ? bf2f(proj[(size_t)nrow * ODC + c]) : 0.f;
  return self + mu[c] * (nb - self);
}

DEV void st_lora_act(const Params& P, int row) {
  const int lane = threadIdx.x & 63;
  const bf16_t* proj = (const bf16_t*)(P.ws + OFF_PROJ);
  bf16_t* hb = (bf16_t*)(P.ws + OFF_HBUF) + (size_t)row * 1024;
  float v[4];
#pragma unroll
  for (int j = 0; j < 4; ++j) {
    int c = lane * 4 + j;
    float x = mixval(proj, row, 1536 + c, P.in[I_MU]);
    v[j] = c < 64 ? tanhf_(x) : (c < 128 ? x : sigmoidf_(x));
  }
  u32x2 pk; pk.x = pack2(v[0], v[1]); pk.y = pack2(v[2], v[3]);
  *(u32x2*)(hb + lane * 4) = pk;
}

DEV void st_rwkv_stream(const Params& P, int sid, unsigned char* smem) {
  const int tid = threadIdx.x, lane = tid & 63, wave = tid >> 6;
  const int d = sid & 1, h = (sid >> 1) & 7, b = sid >> 4;
  float* sR = (float*)smem;
  float* sW = sR + 2048;
  float* sKk = sW + 2048;
  float* sV = sKk + 2048;
  float* sA = sV + 2048;
  float* sBb = sA + 2048;
  float* sY = sBb + 2048;
  int* sRow = (int*)(sY + 2048);
  const bf16_t* proj = (const bf16_t*)(P.ws + OFF_PROJ);
  const bf16_t* lora = (const bf16_t*)(P.ws + OFF_LORA);
  bf16_t* yout = (bf16_t*)(P.ws + OFF_HBUF);
  const float* mu = P.in[I_MU];
  const int vrow = tid >> 2, j4 = tid & 3;
  float S[16];
#pragma unroll
  for (int i = 0; i < 16; ++i) S[i] = 0.f;
  const float kkw = P.in[I_KK][h * 64 + lane], kaw = P.in[I_KA][h * 64 + lane];
  for (int seg = 0; seg < 2; ++seg) {
    const int row0 = seg == 0 ? b * CTXL : NCTX + b * SEQ;
    const int len = seg == 0 ? CTXL : SEQ;
    for (int it = 0; it < len / 32; ++it) {
      __syncthreads();
      for (int s = wave; s < 32; s += 4) {
        int p = it * 32 + s, pos = d ? len - 1 - p : p, row = row0 + pos;
        int c = h * 64 + lane;
        float r = mixval(proj, row, c, mu);
        float k = mixval(proj, row, 512 + c, mu);
        float v = mixval(proj, row, 1024 + c, mu);
        float kk = k * kkw;
        float ss = wave_sum(kk * kk);
        kk *= frsq(ss + 1e-12f);
        float lw = bf2f(lora[((size_t)d * NTOK + row) * 512 + c]);
        float la = bf2f(lora[((size_t)(2 + d) * NTOK + row) * 512 + c]);
        float w = fexp(-0.6065306597126334f * sigmoidf_(lw));
        float a = sigmoidf_(la);
        float kt = k * (1.f + (a - 1.f) * kaw);
        sR[s * 64 + lane] = r; sW[s * 64 + lane] = w; sKk[s * 64 + lane] = kt; sV[s * 64 + lane] = v;
        sA[s * 64 + lane] = -kk; sBb[s * 64 + lane] = kk * a;
        if (lane == 0) sRow[s] = row;
      }
      __syncthreads();
      for (int s = 0; s < 32; ++s) {
        const float* pa = sA + s * 64 + j4 * 16;
        const float* pw = sW + s * 64 + j4 * 16;
        const float* pk = sKk + s * 64 + j4 * 16;
        const float* pb = sBb + s * 64 + j4 * 16;
        const float* pr = sR + s * 64 + j4 * 16;
        const float vv = sV[s * 64 + vrow];
        float sa = 0.f;
#pragma unroll
        for (int i = 0; i < 16; ++i) sa += S[i] * pa[i];
        sa += wshfl_xor(sa, 1); sa += wshfl_xor(sa, 2);
        float y = 0.f;
#pragma unroll
        for (int i = 0; i < 16; ++i) { S[i] = S[i] * pw[i] + sa * pb[i] + vv * pk[i]; y += S[i] * pr[i]; }
        y += wshfl_xor(y, 1); y += wshfl_xor(y, 2);
        if (j4 == 0) sY[s * 64 + vrow] = y;
      }
      __syncthreads();
      for (int i = tid; i < 2048; i += 256) {
        int s = i >> 6, c = i & 63;
        yout[(size_t)sRow[s] * 1024 + d * 512 + h * 64 + c] = f2bf(sY[i]);
      }
    }
  }
}


DEV int nbr_row(int row, int c) {
  if (row < NCTX) {
    int pos = row % CTXL;
    if (c < 896) return pos > 0 ? row - 1 : -1;
    return pos < CTXL - 1 ? row + 1 : -1;
  }
  int pos = (row - NCTX) % SEQ;
  int gx = pos % GW, gy = pos / GW, q = c / 448;
  if (q == 0) return gx > 0 ? row - 1 : -1;
  if (q == 1) return gx < GW - 1 ? row + 1 : -1;
  if (q == 2) return gy > 0 ? row - GW : -1;
  return gy < SEQ / GW - 1 ? row + GW : -1;
}

struct RwkvRaw { u32x4 rs, rn, ks, kn, vs, vn, lw, la; int row; };

DEV void rwkv_load_raw(const bf16_t* __restrict__ proj, const bf16_t* __restrict__ lora, int b, int h, int d, int cc, int t, int c0,
                       RwkvRaw& R) {
  constexpr int NC_CTX = CTXL / 32;
  const int seg = cc >= NC_CTX;
  const int row0 = seg ? NCTX + b * SEQ : b * CTXL;
  const int len = seg ? SEQ : CTXL;
  const int p = (seg ? cc - NC_CTX : cc) * 32 + t;
  const int row = row0 + (d ? len - 1 - p : p);
  const int col = h * 64 + c0;
  const u32x4 z4 = {0u, 0u, 0u, 0u};
  const bf16_t* rp = proj + (size_t)row * ODC;
  R.row = row;
  R.rs = *(const u32x4*)(rp + col);
  R.ks = *(const u32x4*)(rp + 512 + col);
  R.vs = *(const u32x4*)(rp + 1024 + col);
  int n0 = nbr_row(row, col), n1 = nbr_row(row, 512 + col), n2 = nbr_row(row, 1024 + col);
  R.rn = n0 >= 0 ? *(const u32x4*)(proj + (size_t)n0 * ODC + col) : z4;
  R.kn = n1 >= 0 ? *(const u32x4*)(proj + (size_t)n1 * ODC + 512 + col) : z4;
  R.vn = n2 >= 0 ? *(const u32x4*)(proj + (size_t)n2 * ODC + 1024 + col) : z4;
  R.lw = *(const u32x4*)(lora + ((size_t)d * NTOK + row) * 512 + col);
  R.la = *(const u32x4*)(lora + ((size_t)(2 + d) * NTOK + row) * 512 + col);
}

#ifndef RW_NSEG
#define RW_NSEG 16
#endif
constexpr int RW_NCH = (CTXL + SEQ) / 32;
constexpr size_t OFF_RWSEG = OFF_PU;
static_assert((size_t)32 * RW_NSEG * 64 * 128 * 4 <= (size_t)2 * NEXP * 1024, "rwseg");

template <bool FULL>
DEV void st_rwkv_seg(const Params& P, int sid, int seg, unsigned char* smem) {
  constexpr int NVB = FULL ? 2 : 4;
  constexpr int ZR = FULL ? 64 : 128;
  const int tid = threadIdx.x, lane = tid & 63, wave = tid >> 6;
  const int d = sid & 1, h = (sid >> 1) & 7, b = sid >> 4;
  bf16_t* sAt = (bf16_t*)smem;
  bf16_t* sRt = sAt + 32 * 72;
  bf16_t* sBt = sRt + 32 * 72;
  bf16_t* sKt = sBt + 32 * 72;
  bf16_t* sBT = sKt + 32 * 72;
  bf16_t* sKT = sBT + 64 * 40;
  bf16_t* sVT = sKT + 64 * 40;
  bf16_t* sLak = sVT + 64 * 40;
  bf16_t* sM = sLak + 32 * 40;
  bf16_t* sLrb = sM + 32 * 40;
  bf16_t* sLrk = sLrb + 32 * 40;
  bf16_t* sZ = FULL ? sLrk + 32 * 40 : sLrb;
  bf16_t* after = sZ + ZR * 72;
  bf16_t* sRT = FULL ? after : nullptr;
  bf16_t* sSAT = FULL ? after + 64 * 40 : sRt;
  float* sLP = (float*)(FULL ? after + 2 * 64 * 40 : after);
  float* sLab = sLP + 32 * 64;
  float* sD = sLab + 32 * 33;
  float* sPT = sD + 768;
  int* sRow = (int*)(sPT + 64);
  if (!FULL) sRT = (bf16_t*)sLP;
  static_assert((4 * 32 * 72 + 3 * 64 * 40 + 4 * 32 * 40 + 2 * 64 * 40 + 64 * 72) * 2 + (32 * 64 + 32 * 33 + 768 + 64 + 32 + 320) * 4 + 16 <= SMEM_BYTES, "lds full");
  static_assert((4 * 32 * 72 + 3 * 64 * 40 + 2 * 32 * 40 + 128 * 72) * 2 + (32 * 64 + 32 * 33 + 768 + 64 + 32) * 4 <= SMEM_BYTES, "lds p1");
  static_assert(128 * 40 * 2 <= (32 * 64 + 32 * 33) * 4 && 128 * 40 <= 3 * 32 * 72, "alias");
  const bf16_t* proj = (const bf16_t*)(P.ws + OFF_PROJ);
  const bf16_t* lora = (const bf16_t*)(P.ws + OFF_LORA);
  bf16_t* yout = (bf16_t*)(P.ws + OFF_HBUF);
  float* segZ = (float*)(P.ws + OFF_RWSEG);
  const int t = tid >> 3, c0 = (tid & 7) * 8;
  const int hl = lane >> 5, l31 = lane & 31;
  float* sCst = (float*)(smem + SMEM_BYTES - 320 * 4 - 16);
  if (tid < 64) {
    sCst[tid] = P.in[I_MU][h * 64 + tid]; sCst[64 + tid] = P.in[I_MU][512 + h * 64 + tid]; sCst[128 + tid] = P.in[I_MU][1024 + h * 64 + tid];
    sCst[192 + tid] = P.in[I_KK][h * 64 + tid]; sCst[256 + tid] = P.in[I_KA][h * 64 + tid];
  }
  const int cc0 = (seg * RW_NCH) / RW_NSEG, cc1 = ((seg + 1) * RW_NCH) / RW_NSEG;
  RwkvRaw R;
  rwkv_load_raw(proj, lora, b, h, d, cc0, t, c0, R);
  f32x16 Zm[2];
#pragma unroll
  for (int j = 0; j < 2; ++j)
#pragma unroll
    for (int r = 0; r < 16; ++r) Zm[j][r] = 0.f;
  __syncthreads();
  for (int i = tid; i < ZR * 72; i += 256) sZ[i] = 0;
  __syncthreads();
  if (!FULL) {
    if (wave >= 2) {
#pragma unroll
      for (int cb = 0; cb < 2; ++cb)
#pragma unroll
        for (int r = 0; r < 16; ++r) {
          int c = cb * 32 + acc_row(r, lane), vp = wave * 32 + l31;
          if (c == vp - 64) { Zm[cb][r] = 1.f; sZ[vp * 72 + c] = 0x3f80; }
        }
    }
  } else {
    for (int js = 0; js < seg; ++js) {
      const float* Zs = segZ + ((size_t)sid * RW_NSEG + js) * 64 * 128;
      bf16_t* sG = sAt;
      for (int i = tid; i < 64 * 64; i += 256) { int c = i >> 6, c2 = i & 63; sG[c * 72 + c2] = f2bf(Zs[c * 128 + 64 + c2]); }
      __syncthreads();
      if (wave >= 2) {
        const int cb = wave - 2;
#pragma unroll
        for (int vb = 0; vb < 2; ++vb) {
          f32x16 acc;
#pragma unroll
          for (int r = 0; r < 16; ++r) acc[r] = Zs[(cb * 32 + acc_row(r, lane)) * 128 + vb * 32 + l31];
#pragma unroll
          for (int kk = 0; kk < 4; ++kk) {
            bf16x8 a = *(const bf16x8*)(sG + (cb * 32 + l31) * 72 + kk * 16 + 8 * hl);
            bf16x8 bb = *(const bf16x8*)(sZ + (vb * 32 + l31) * 72 + kk * 16 + 8 * hl);
            acc = mfma32(a, bb, acc);
          }
          Zm[vb] = acc;
        }
      }
      __syncthreads();
      if (wave >= 2) {
        const int cb = wave - 2;
#pragma unroll
        for (int vb = 0; vb < 2; ++vb)
#pragma unroll
          for (int g = 0; g < 4; ++g) {
            u32x2 pk; pk.x = pack2(Zm[vb][4 * g], Zm[vb][4 * g + 1]); pk.y = pack2(Zm[vb][4 * g + 2], Zm[vb][4 * g + 3]);
            *(u32x2*)(sZ + (vb * 32 + l31) * 72 + cb * 32 + 8 * g + 4 * hl) = pk;
          }
      }
      __syncthreads();
    }
  }
  for (int cc = cc0; cc < cc1; ++cc) {
    int tl_ = threadIdx.x; OPAQUE(tl_);
    const int tid = tl_, lane = tl_ & 63, hl = lane >> 5, l31 = lane & 31, t = tl_ >> 3, c0 = (tl_ & 7) * 8;
    const float* muR = sCst + c0; const float* muK = sCst + 64 + c0; const float* muV = sCst + 128 + c0;
    const float* kkw = sCst + 192 + c0; const float* kaw = sCst + 256 + c0;
    float lw8[8], lp8[8];
    {
      float lwf[8];
      unpack8(R.lw, lwf);
#pragma unroll
      for (int j = 0; j < 8; ++j) { lw8[j] = -0.6065306597126334f * sigmoidf_(lwf[j]); lp8[j] = lw8[j]; }
#pragma unroll
      for (int off = 8; off < 64; off <<= 1) {
#pragma unroll
        for (int j = 0; j < 8; ++j) {
#ifdef CPU_EMU
          float o = emu_shfl_up(lp8[j], off);
#else
          float o = __shfl_up(lp8[j], off, 64);
#endif
          if (lane >= off) lp8[j] += o;
        }
      }
      if (lane >= 56) {
#pragma unroll
        for (int j = 0; j < 8; ++j) sLP[wave * 64 + c0 + j] = lp8[j];
      }
      if ((tid & 7) == 0) sRow[t] = R.row;
    }
    __syncthreads();
    {
#pragma unroll
      for (int j = 0; j < 8; ++j) {
        float offs = 0.f;
        for (int w2 = 0; w2 < wave; ++w2) offs += sLP[w2 * 64 + c0 + j];
        lp8[j] += offs;
      }
      if (t == 31) {
#pragma unroll
        for (int j = 0; j < 8; ++j) sPT[c0 + j] = fexp(lp8[j]);
      }
    }
    {
      float xs[8], xn[8], kt[8], aa[8], ob[8], ok[8];
      unpack8(R.ks, xs); unpack8(R.kn, xn);
      float ss = 0.f;
#pragma unroll
      for (int j = 0; j < 8; ++j) { kt[j] = xs[j] + muK[j] * (xn[j] - xs[j]); aa[j] = kt[j] * kkw[j]; ss += aa[j] * aa[j]; }
      ss += wshfl_xor(ss, 1); ss += wshfl_xor(ss, 2); ss += wshfl_xor(ss, 4);
      const float rn = frsq(ss + 1e-12f);
      float laf[8];
      unpack8(R.la, laf);
#pragma unroll
      for (int j = 0; j < 8; ++j) {
        const float lp = lp8[j];
        const float lpm = lp8[j] - lw8[j];
        const float e = fexp(-lp);
        const float kkn = aa[j] * rn;
        const float asg = sigmoidf_(laf[j]);
        aa[j] = -kkn * fexp(lpm);
        ob[j] = kkn * asg * e;
        ok[j] = kt[j] * (1.f + (asg - 1.f) * kaw[j]) * e;
      }
      *(u32x4*)(sAt + t * 72 + c0) = pack8(aa);
      *(u32x4*)(sBt + t * 72 + c0) = pack8(ob);
      *(u32x4*)(sKt + t * 72 + c0) = pack8(ok);
#pragma unroll
      for (int j = 0; j < 8; ++j) { sBT[(c0 + j) * 40 + t] = f2bf(ob[j]); sKT[(c0 + j) * 40 + t] = f2bf(ok[j]); }
      unpack8(R.vs, xs); unpack8(R.vn, xn);
#pragma unroll
      for (int j = 0; j < 8; ++j) sVT[(c0 + j) * 40 + t] = f2bf(xs[j] + muV[j] * (xn[j] - xs[j]));
      if (FULL) {
        unpack8(R.rs, xs); unpack8(R.rn, xn);
#pragma unroll
        for (int j = 0; j < 8; ++j) xs[j] = (xs[j] + muR[j] * (xn[j] - xs[j])) * fexp(lp8[j]);
        *(u32x4*)(sRt + t * 72 + c0) = pack8(xs);
      }
    }
    if (cc + 1 < cc1) rwkv_load_raw(proj, lora, b, h, d, cc + 1, t, c0, R);
    __syncthreads();
    if (FULL || wave < 2) {
      const bf16_t* Asrc = wave < 2 ? sAt : sRt;
      const bf16_t* Bsrc = (wave & 1) ? sKt : sBt;
      f32x16 acc;
#pragma unroll
      for (int r = 0; r < 16; ++r) acc[r] = 0.f;
#pragma unroll
      for (int kk = 0; kk < 4; ++kk) {
        bf16x8 a = *(const bf16x8*)(Asrc + l31 * 72 + kk * 16 + 8 * hl);
        bf16x8 bb = *(const bf16x8*)(Bsrc + l31 * 72 + kk * 16 + 8 * hl);
        acc = mfma32(a, bb, acc);
      }
      bf16_t* dst = wave == 1 ? sLak : (wave == 2 ? sLrb : sLrk);
#pragma unroll
      for (int r = 0; r < 16; ++r) {
        int tt = acc_row(r, lane), j = l31;
        bool keep = wave < 2 ? (j < tt) : (j <= tt);
        float v = keep ? acc[r] : 0.f;
        if (wave == 0) sLab[tt * 33 + j] = v;
        else dst[tt * 40 + j] = f2bf(v);
      }
    }
    __syncthreads();
    if (tid < 32) {
      const int q = tid >> 4, c = tid & 15;
      float x[16];
#pragma unroll
      for (int i = 0; i < 16; ++i) {
        float sacc = (i == c) ? 1.f : 0.f;
#pragma unroll
        for (int j = 0; j < i; ++j) sacc += sLab[(q * 16 + i) * 33 + q * 16 + j] * x[j];
        x[i] = sacc;
        sD[q * 256 + i * 16 + c] = sacc;
      }
    }
    __syncthreads();
    {
      const int i = tid >> 4, c = tid & 15;
      float sacc = 0.f;
#pragma unroll
      for (int j = 0; j < 16; ++j) sacc += sLab[(16 + i) * 33 + j] * sD[j * 16 + c];
      sD[512 + i * 16 + c] = sacc;
    }
    __syncthreads();
    {
      const int i = tid >> 4, c = tid & 15;
      float sacc = 0.f;
#pragma unroll
      for (int j = 0; j < 16; ++j) sacc += sD[256 + i * 16 + j] * sD[512 + j * 16 + c];
      sM[(16 + i) * 40 + c] = f2bf(sacc);
      sM[i * 40 + c] = f2bf(sD[i * 16 + c]);
      sM[(16 + i) * 40 + 16 + c] = f2bf(sD[256 + i * 16 + c]);
      sM[i * 40 + 16 + c] = 0;
    }
    if (wave < NVB) {
      const int vb = wave;
      f32x16 acc;
#pragma unroll
      for (int r = 0; r < 16; ++r) acc[r] = 0.f;
#pragma unroll
      for (int kk = 0; kk < 4; ++kk) {
        bf16x8 a = *(const bf16x8*)(sAt + l31 * 72 + kk * 16 + 8 * hl);
        bf16x8 bb = *(const bf16x8*)(sZ + (vb * 32 + l31) * 72 + kk * 16 + 8 * hl);
        acc = mfma32(a, bb, acc);
      }
      if (vb < 2) {
#pragma unroll
        for (int kk = 0; kk < 2; ++kk) {
          bf16x8 a = *(const bf16x8*)(sLak + l31 * 40 + kk * 16 + 8 * hl);
          bf16x8 bb = *(const bf16x8*)(sVT + (vb * 32 + l31) * 40 + kk * 16 + 8 * hl);
          acc = mfma32(a, bb, acc);
        }
      }
#pragma unroll
      for (int g = 0; g < 4; ++g) {
        u32x2 pk; pk.x = pack2(acc[4 * g], acc[4 * g + 1]); pk.y = pack2(acc[4 * g + 2], acc[4 * g + 3]);
        *(u32x2*)(sRT + (vb * 32 + l31) * 40 + 8 * g + 4 * hl) = pk;
      }
    }
    __syncthreads();
    if (wave < NVB) {
      const int vb = wave;
      f32x16 acc;
#pragma unroll
      for (int r = 0; r < 16; ++r) acc[r] = 0.f;
#pragma unroll
      for (int kk = 0; kk < 2; ++kk) {
        bf16x8 a = *(const bf16x8*)(sM + l31 * 40 + kk * 16 + 8 * hl);
        bf16x8 bb = *(const bf16x8*)(sRT + (vb * 32 + l31) * 40 + kk * 16 + 8 * hl);
        acc = mfma32(a, bb, acc);
      }
#pragma unroll
      for (int g = 0; g < 4; ++g) {
        u32x2 pk; pk.x = pack2(acc[4 * g], acc[4 * g + 1]); pk.y = pack2(acc[4 * g + 2], acc[4 * g + 3]);
        *(u32x2*)(sSAT + (vb * 32 + l31) * 40 + 8 * g + 4 * hl) = pk;
      }
    }
    __syncthreads();
    if (FULL) {
      if (wave < 2) {
        const int vb = wave;
        f32x16 acc;
#pragma unroll
        for (int r = 0; r < 16; ++r) acc[r] = 0.f;
#pragma unroll
        for (int kk = 0; kk < 4; ++kk) {
          bf16x8 a = *(const bf16x8*)(sZ + (vb * 32 + l31) * 72 + kk * 16 + 8 * hl);
          bf16x8 bb = *(const bf16x8*)(sRt + l31 * 72 + kk * 16 + 8 * hl);
          acc = mfma32(a, bb, acc);
        }
#pragma unroll
        for (int kk = 0; kk < 2; ++kk) {
          bf16x8 a = *(const bf16x8*)(sSAT + (vb * 32 + l31) * 40 + kk * 16 + 8 * hl);
          bf16x8 bb = *(const bf16x8*)(sLrb + l31 * 40 + kk * 16 + 8 * hl);
          acc = mfma32(a, bb, acc);
        }
#pragma unroll
        for (int kk = 0; kk < 2; ++kk) {
          bf16x8 a = *(const bf16x8*)(sVT + (vb * 32 + l31) * 40 + kk * 16 + 8 * hl);
          bf16x8 bb = *(const bf16x8*)(sLrk + l31 * 40 + kk * 16 + 8 * hl);
          acc = mfma32(a, bb, acc);
        }
        {
          const size_t obase = (size_t)sRow[l31] * 1024 + d * 512 + h * 64 + vb * 32;
#pragma unroll
          for (int g = 0; g < 4; ++g) {
            u32x2 pk; pk.x = pack2(acc[4 * g], acc[4 * g + 1]); pk.y = pack2(acc[4 * g + 2], acc[4 * g + 3]);
            *(u32x2*)(yout + obase + 8 * g + 4 * hl) = pk;
          }
        }
      } else {
        const int cb = wave - 2;
#pragma unroll
        for (int vb = 0; vb < 2; ++vb) {
          f32x16 acc;
#pragma unroll
          for (int r = 0; r < 16; ++r) acc[r] = 0.f;
#pragma unroll
          for (int kk = 0; kk < 2; ++kk) {
            bf16x8 a = *(const bf16x8*)(sBT + (cb * 32 + l31) * 40 + kk * 16 + 8 * hl);
            bf16x8 bb = *(const bf16x8*)(sSAT + (vb * 32 + l31) * 40 + kk * 16 + 8 * hl);
            acc = mfma32(a, bb, acc);
          }
#pragma unroll
          for (int kk = 0; kk < 2; ++kk) {
            bf16x8 a = *(const bf16x8*)(sKT + (cb * 32 + l31) * 40 + kk * 16 + 8 * hl);
            bf16x8 bb = *(const bf16x8*)(sVT + (vb * 32 + l31) * 40 + kk * 16 + 8 * hl);
            acc = mfma32(a, bb, acc);
          }
#pragma unroll
          for (int r = 0; r < 16; ++r) Zm[vb][r] = sPT[cb * 32 + acc_row(r, lane)] * (Zm[vb][r] + acc[r]);
        }
      }
      __syncthreads();
      if (wave >= 2) {
        const int cb = wave - 2;
#pragma unroll
        for (int vb = 0; vb < 2; ++vb)
#pragma unroll
          for (int g = 0; g < 4; ++g) {
            u32x2 pk; pk.x = pack2(Zm[vb][4 * g], Zm[vb][4 * g + 1]); pk.y = pack2(Zm[vb][4 * g + 2], Zm[vb][4 * g + 3]);
            *(u32x2*)(sZ + (vb * 32 + l31) * 72 + cb * 32 + 8 * g + 4 * hl) = pk;
          }
      }
    } else {
      const int vb = wave;
#pragma unroll
      for (int cb = 0; cb < 2; ++cb) {
        f32x16 acc;
#pragma unroll
        for (int r = 0; r < 16; ++r) acc[r] = 0.f;
#pragma unroll
        for (int kk = 0; kk < 2; ++kk) {
          bf16x8 a = *(const bf16x8*)(sBT + (cb * 32 + l31) * 40 + kk * 16 + 8 * hl);
          bf16x8 bb = *(const bf16x8*)(sSAT + (vb * 32 + l31) * 40 + kk * 16 + 8 * hl);
          acc = mfma32(a, bb, acc);
        }
        if (vb < 2) {
#pragma unroll
          for (int kk = 0; kk < 2; ++kk) {
            bf16x8 a = *(const bf16x8*)(sKT + (cb * 32 + l31) * 40 + kk * 16 + 8 * hl);
            bf16x8 bb = *(const bf16x8*)(sVT + (vb * 32 + l31) * 40 + kk * 16 + 8 * hl);
            acc = mfma32(a, bb, acc);
          }
        }
#pragma unroll
        for (int r = 0; r < 16; ++r) Zm[cb][r] = sPT[cb * 32 + acc_row(r, lane)] * (Zm[cb][r] + acc[r]);
      }
#pragma unroll
      for (int cb = 0; cb < 2; ++cb)
#pragma unroll
        for (int g = 0; g < 4; ++g) {
          u32x2 pk; pk.x = pack2(Zm[cb][4 * g], Zm[cb][4 * g + 1]); pk.y = pack2(Zm[cb][4 * g + 2], Zm[cb][4 * g + 3]);
          *(u32x2*)(sZ + (vb * 32 + l31) * 72 + cb * 32 + 8 * g + 4 * hl) = pk;
        }
    }
  }
  if (!FULL) {
    float* Zs = segZ + ((size_t)sid * RW_NSEG + seg) * 64 * 128;
#pragma unroll
    for (int cb = 0; cb < 2; ++cb)
#pragma unroll
      for (int r = 0; r < 16; ++r) Zs[(cb * 32 + acc_row(r, lane)) * 128 + wave * 32 + l31] = Zm[cb][r];
  }
}

constexpr int LRU_NCH = (CTXL + SEQ) / 64;
constexpr size_t OFF_ACUM0 = OFF_PU;
static_assert((size_t)NLAT * 512 * 2 <= (size_t)2 * NEXP * 1024, "acum0");

DEV void st_lru_chunk(const Params& P, int sid, int cc, unsigned char* smem) {
  constexpr int NC_CTX = CTXL / 64;
  const int tid = threadIdx.x, lane = tid & 63, wave = tid >> 6;
  const int d = sid & 1, blk = (sid >> 1) & 7, b = sid >> 4;
  float* sXc = (float*)smem;
  float* sAc = sXc + 4096;
  float* sBc = sAc + 4096;
  float* sU = sBc + 4096;
  bf16_t* sAop = (bf16_t*)(sU + 4096);
  float* sQA = (float*)(sAop + 64 * 72);
  float* sQH = sQA + 256;
  int* sRow = (int*)(sQH + 256);
  const bf16_t* proj = (const bf16_t*)(P.ws + OFF_PROJ);
  bf16_t* uout = (bf16_t*)(P.ws + OFF_LORA) + (size_t)d * NTOK * 512;
  bf16_t* aout = (bf16_t*)(P.ws + (d ? OFF_ACUM1 : OFF_ACUM0));
  const bf16_t* lruT = (const bf16_t*)(P.ws + OFF_LRUT) + (size_t)(d * 8 + blk) * 128 * 64;
  float* chunkS = (float*)(P.ws + OFF_LRUCS) + ((size_t)sid * LRU_NCH + cc) * 128;
  const float* cw = P.in[I_LCONVW];
  const float* cb = P.in[I_LCONVB];
  const int tr = (wave >> 1) * 32, nc0 = (wave & 1) * 64;
  const int sgi = cc >= NC_CTX;
  const int row0 = sgi ? NCTX + b * SEQ : b * CTXL;
  const int len = sgi ? SEQ : CTXL;
  const int cl = (sgi ? cc - NC_CTX : cc) * 64;
  __syncthreads();
  if (tid < 64) { int p = cl + tid; sRow[tid] = row0 + (d ? len - 1 - p : p); }
  {
    const int lc8 = (tid & 7) * 8, lch = blk * 64 + lc8;
#pragma unroll
    for (int i = 0; i < 2; ++i) {
      int c = tid + i * 256, r = c >> 3;
      int p = cl + r, pos = d ? len - 1 - p : p;
      float o[8];
      f32x4 c0 = *(const f32x4*)(cb + lch), c1 = *(const f32x4*)(cb + lch + 4);
      o[0] = c0.x; o[1] = c0.y; o[2] = c0.z; o[3] = c0.w; o[4] = c1.x; o[5] = c1.y; o[6] = c1.z; o[7] = c1.w;
#pragma unroll
      for (int tap = 0; tap < 4; ++tap) {
        int pp = pos + tap - 2;
        if (pp >= 0 && pp < len) {
          float x[8];
          unpack8(*(const u32x4*)(proj + (size_t)(row0 + pp) * ODC + 2304 + lch), x);
          f32x4 w0 = *(const f32x4*)(cw + tap * 512 + lch), w1 = *(const f32x4*)(cw + tap * 512 + lch + 4);
          o[0] += w0.x * x[0]; o[1] += w0.y * x[1]; o[2] += w0.z * x[2]; o[3] += w0.w * x[3];
          o[4] += w1.x * x[4]; o[5] += w1.y * x[5]; o[6] += w1.z * x[6]; o[7] += w1.w * x[7];
        }
      }
#pragma unroll
      for (int j = 0; j < 8; ++j) sXc[r * 64 + lc8 + j] = o[j];
      *(u32x4*)(sAop + r * 72 + lc8) = pack8(o);
    }
  }
  __syncthreads();
  {
    f32x16 acc[2];
#pragma unroll
    for (int j = 0; j < 2; ++j)
#pragma unroll
      for (int r = 0; r < 16; ++r) acc[j][r] = 0.f;
#pragma unroll
    for (int kk = 0; kk < 4; ++kk) {
      bf16x8 a = *(const bf16x8*)(sAop + (tr + (lane & 31)) * 72 + kk * 16 + 8 * (lane >> 5));
#pragma unroll
      for (int j = 0; j < 2; ++j) {
        bf16x8 bb = *(const bf16x8*)(lruT + (nc0 + j * 32 + (lane & 31)) * 64 + kk * 16 + 8 * (lane >> 5));
        acc[j] = mfma32(a, bb, acc[j]);
      }
    }
#pragma unroll
    for (int j = 0; j < 2; ++j) {
      const int e = nc0 + j * 32 + (lane & 31);
      const int ch = blk * 64 + (e & 63);
      const float ebias = e < 64 ? P.in[I_BA][d * 512 + ch] : P.in[I_BI][d * 512 + ch];
      const float esp = softplusf_(-P.in[I_LAM][d * 512 + ch]);
#pragma unroll
      for (int r = 0; r < 16; ++r) {
        int t = tr + acc_row(r, lane);
        float g = sigmoidf_(acc[j][r] + ebias);
        if (e < 64) { float a_ = fexp(-8.f * g * esp); sAc[t * 64 + e] = a_; sU[t * 64 + e] = fsqrt(fmaxf(1.f - a_ * a_, 0.f)); }
        else sBc[t * 64 + (e - 64)] = g * sXc[t * 64 + (e - 64)];
      }
    }
  }
  __syncthreads();
  const int c = tid & 63, q = tid >> 6;
  {
    float h = 0.f, ap = 1.f;
#pragma unroll 4
    for (int i = 0; i < 16; ++i) {
      const int t = q * 16 + i;
      const float a = sAc[t * 64 + c];
      h = a * h + sU[t * 64 + c] * sBc[t * 64 + c];
      ap *= a;
      sU[t * 64 + c] = h; sAc[t * 64 + c] = ap;
    }
    sQA[q * 64 + c] = ap; sQH[q * 64 + c] = h;
  }
  __syncthreads();
  {
    float hin = 0.f, ain = 1.f;
    for (int q2 = 0; q2 < q; ++q2) { hin = sQA[q2 * 64 + c] * hin + sQH[q2 * 64 + c]; ain *= sQA[q2 * 64 + c]; }
    if (q > 0) {
#pragma unroll 4
      for (int i = 0; i < 16; ++i) {
        const int t = q * 16 + i;
        const float ap = sAc[t * 64 + c];
        sU[t * 64 + c] += ap * hin;
        sAc[t * 64 + c] = ap * ain;
      }
    }
    if (q == 3) { chunkS[c] = sAc[63 * 64 + c]; chunkS[64 + c] = sU[63 * 64 + c]; }
  }
  __syncthreads();
  if (sgi) {
#pragma unroll
    for (int i = 0; i < 2; ++i) {
      int cidx = tid + i * 256, r = cidx >> 3, c8 = (cidx & 7) * 8;
      float u8[8], a8[8];
#pragma unroll
      for (int j = 0; j < 8; ++j) { u8[j] = sU[r * 64 + c8 + j]; a8[j] = sAc[r * 64 + c8 + j]; }
      const int row = sRow[r];
      *(u32x4*)(uout + (size_t)row * 512 + blk * 64 + c8) = pack8(u8);
      *(u32x4*)(aout + (size_t)(row - NCTX) * 512 + blk * 64 + c8) = pack8(a8);
    }
  }
}

DEV void st_lru_carry(const Params& P, int sid) {
  const int c = threadIdx.x;
  if (c >= 64) return;
  const float* cs = (const float*)(P.ws + OFF_LRUCS) + (size_t)sid * LRU_NCH * 128;
  float* hs = (float*)(P.ws + OFF_LRUHS) + (size_t)sid * LRU_NCH * 64;
  float h = 0.f;
  for (int cc0 = 0; cc0 < LRU_NCH; cc0 += 10) {
    float a[10], bb[10];
#pragma unroll
    for (int i = 0; i < 10; ++i) { a[i] = cs[(size_t)(cc0 + i) * 128 + c]; bb[i] = cs[(size_t)(cc0 + i) * 128 + 64 + c]; }
#pragma unroll
    for (int i = 0; i < 10; ++i) { hs[(size_t)(cc0 + i) * 64 + c] = h; h = a[i] * h + bb[i]; }
  }
}

DEV void st_finish_l1(const Params& P, int row) {
  const int lane = threadIdx.x & 63;
  bf16_t* hb = (bf16_t*)(P.ws + OFF_HBUF) + (size_t)row * 1024;
  const bf16_t* proj = (const bf16_t*)(P.ws + OFF_PROJ);
  const bf16_t* lora = (const bf16_t*)(P.ws + OFF_LORA);
  const float* mu = P.in[I_MU];
  const int ch = lane * 8;
  float y0[8], y1[8];
  unpack8(*(const u32x4*)(hb + ch), y0);
  unpack8(*(const u32x4*)(hb + 512 + ch), y1);
  float sm = 0.f;
#pragma unroll
  for (int j = 0; j < 8; ++j) { y0[j] += y1[j]; sm += y0[j]; }
  sm += wshfl_xor(sm, 1); sm += wshfl_xor(sm, 2); sm += wshfl_xor(sm, 4);
  const float mean = sm * (1.f / 64.f);
  float sv = 0.f;
#pragma unroll
  for (int j = 0; j < 8; ++j) { float dlt = y0[j] - mean; sv += dlt * dlt; }
  sv += wshfl_xor(sv, 1); sv += wshfl_xor(sv, 2); sv += wshfl_xor(sv, 4);
  const float rstd = frsq(sv * (1.f / 64.f) + 64e-5f);
  float a0[8], a1[8], g[8], u0[8], u1[8], gb[8];
  unpack8(*(const u32x4*)(lora + ((size_t)2 * NTOK + row) * 512 + ch), a0);
  unpack8(*(const u32x4*)(lora + ((size_t)3 * NTOK + row) * 512 + ch), a1);
  unpack8(*(const u32x4*)(lora + ((size_t)4 * NTOK + row) * 512 + ch), g);
  unpack8(*(const u32x4*)(lora + ((size_t)0 * NTOK + row) * 512 + ch), u0);
  unpack8(*(const u32x4*)(lora + ((size_t)1 * NTOK + row) * 512 + ch), u1);
  if (row >= NCTX) {
    const int bb_ = (row - NCTX) / SEQ, pos = (row - NCTX) % SEQ, blk = ch >> 6;
    float ac[8];
#pragma unroll
    for (int dd = 0; dd < 2; ++dd) {
      const int pidx = dd ? SEQ - 1 - pos : pos;
      const int cc = CTXL / 64 + pidx / 64;
      const int sid = (bb_ * 8 + blk) * 2 + dd;
      const float* hs = (const float*)(P.ws + OFF_LRUHS) + ((size_t)sid * LRU_NCH + cc) * 64 + (ch & 63);
      unpack8(*(const u32x4*)((const bf16_t*)(P.ws + (dd ? OFF_ACUM1 : OFF_ACUM0)) + (size_t)(row - NCTX) * 512 + ch), ac);
      f32x4 h0 = *(const f32x4*)hs, h1 = *(const f32x4*)(hs + 4);
      float* u = dd ? u1 : u0;
      u[0] += ac[0] * h0.x; u[1] += ac[1] * h0.y; u[2] += ac[2] * h0.z; u[3] += ac[3] * h0.w;
      u[4] += ac[4] * h1.x; u[5] += ac[5] * h1.y; u[6] += ac[6] * h1.z; u[7] += ac[7] * h1.w;
    }
  }
  unpack8(*(const u32x4*)(proj + (size_t)row * ODC + 1792 + ch), gb);
  float rv[8], vv[8];
  float sdot = 0.f;
#pragma unroll
  for (int j = 0; j < 8; ++j) {
    float r = mixval(proj, row, ch + j, mu);
    float k = mixval(proj, row, 512 + ch + j, mu);
    vv[j] = mixval(proj, row, 1024 + ch + j, mu);
    float am = 0.5f * (sigmoidf_(a0[j]) + sigmoidf_(a1[j]));
    float kb = k * (1.f + (am - 1.f) * P.in[I_KA][ch + j]);
    sdot += r * kb * P.in[I_RK][ch + j];
    rv[j] = r;
  }
  sdot += wshfl_xor(sdot, 1); sdot += wshfl_xor(sdot, 2); sdot += wshfl_xor(sdot, 4);
  float f1[8], f2[8];
#pragma unroll
  for (int j = 0; j < 8; ++j) {
    float yn = (y0[j] - mean) * rstd * P.in[I_LNW][ch + j] + P.in[I_LNB][ch + j];
    yn += sdot * vv[j];
    f1[j] = yn * g[j];
    f2[j] = (u0[j] + u1[j]) * geluf_(gb[j]);
  }
  *(u32x4*)(hb + ch) = pack8(f1);
  *(u32x4*)(hb + 512 + ch) = pack8(f2);
}

DEV unsigned fkey(float f) { unsigned u; __builtin_memcpy(&u, &f, 4); return (u >> 31) ? ~u : (u | 0x80000000u); }
DEV float keyf(unsigned u) { u = (u >> 31) ? (u & 0x7fffffffu) : ~u; float f; __builtin_memcpy(&f, &u, 4); return f; }
DEV void key_insert(unsigned x, unsigned* v) {
#pragma unroll
  for (int j = 0; j < 16; ++j) { unsigned hi = v[j] > x ? v[j] : x; x = v[j] > x ? x : v[j]; v[j] = hi; }
}
DEV void key_cx(unsigned& hi, unsigned& lo) { unsigned a = hi, b = lo; hi = a > b ? a : b; lo = a > b ? b : a; }
DEV void key_sort16(unsigned* v) {
#pragma unroll
  for (int k = 2; k <= 16; k <<= 1)
#pragma unroll
    for (int j = k >> 1; j > 0; j >>= 1)
#pragma unroll
      for (int i = 0; i < 16; ++i) {
        const int l = i ^ j;
        if (l > i) { if ((i & k) == 0) key_cx(v[i], v[l]); else key_cx(v[l], v[i]); }
      }
}
DEV void key_merge16(unsigned* a, const unsigned* b) {
#pragma unroll
  for (int i = 0; i < 16; ++i) a[i] = a[i] > b[15 - i] ? a[i] : b[15 - i];
#pragma unroll
  for (int j = 8; j > 0; j >>= 1)
#pragma unroll
    for (int i = 0; i < 16; ++i) { const int l = i ^ j; if (l > i) key_cx(a[i], a[l]); }
}

DEV void st_peer_topk(const Params& P, int layer, int tile, int h, unsigned char* smem) {
  const int tid = threadIdx.x;
  const bf16_t* q = (const bf16_t*)(P.ws + OFF_Q);
  const bf16_t* keys = (const bf16_t*)(P.ws + OFF_KEYS) + (size_t)(layer * 8 + h) * 2 * 128 * 128;
  float* sS = (float*)smem;
  const int m0 = tile * 128;
  const int tok = tid & 127, half = tid >> 7;
  unsigned kl[2][16];
#pragma unroll
  for (int p = 0; p < 2; ++p) {
    EpiScoreLds epi{sS, m0};
    gemm_tile_128<true>(q + (h * 2 + p) * 128, 2048, NTOK, keys + p * 128 * 128, 128, 128, 128, m0, 0, epi, smem);
    __syncthreads();
    float* row = sS + tok * 129 + half * 64;
#pragma unroll
    for (int g = 0; g < 4; ++g) {
      unsigned grp[16];
#pragma unroll
      for (int j = 0; j < 16; ++j) grp[j] = (fkey(row[g * 16 + j]) & ~127u) | (unsigned)(127 - (half * 64 + g * 16 + j));
      key_sort16(grp);
      if (g == 0) {
#pragma unroll
        for (int j = 0; j < 16; ++j) kl[p][j] = grp[j];
      } else key_merge16(kl[p], grp);
    }
    if (half == 1) {
#pragma unroll
      for (int j = 0; j < 16; ++j) row[j] = __builtin_bit_cast(float, kl[p][j]);
    }
    __syncthreads();
    if (half == 0) {
      unsigned oth[16];
#pragma unroll
      for (int j = 0; j < 16; ++j) oth[j] = __builtin_bit_cast(unsigned, sS[tok * 129 + 64 + j]);
      key_merge16(kl[p], oth);
    }
    __syncthreads();
  }
  if (tid < 128) {
    float sv0[16], sv1[16];
    int* irow = (int*)(sS + tid * 129);
#pragma unroll
    for (int j = 0; j < 16; ++j) {
      sv0[j] = keyf((kl[0][j] & ~127u) | 64u); sv1[j] = keyf((kl[1][j] & ~127u) | 64u);
      irow[j] = 127 - (int)(kl[0][j] & 127u); irow[16 + j] = 127 - (int)(kl[1][j] & 127u);
    }
    unsigned best[16];
#pragma unroll
    for (int j = 0; j < 16; ++j) best[j] = 0u;
#pragma unroll
    for (int i = 0; i < 16; ++i)
#pragma unroll
      for (int j = 0; j < 16; ++j)
        if ((i + 1) * (j + 1) <= 16) key_insert((fkey(sv0[i] + sv1[j]) & ~255u) | (unsigned)(255 - (i * 16 + j)), best);
    float e[16], sum = 0.f;
    const float b0 = keyf((best[0] & ~255u) | 128u);
#pragma unroll
    for (int j = 0; j < 16; ++j) { e[j] = fexp(keyf((best[j] & ~255u) | 128u) - b0); sum += e[j]; }
    const float inv = 1.f / sum;
    int* pidx = (int*)(P.ws + OFF_PIDX) + (size_t)(m0 + tid) * 128 + h * 16;
    float* pg = (float*)(P.ws + OFF_PGATE) + (size_t)(m0 + tid) * 128 + h * 16;
#pragma unroll
    for (int j = 0; j < 16; ++j) {
      const int pos = 255 - (int)(best[j] & 255u);
      pidx[j] = irow[pos >> 4] * 128 + irow[16 + (pos & 15)];
      pg[j] = e[j] * inv;
    }
  }
}

DEV void st_peer_experts(const Params& P, int layer, int row) {
  const int lane = threadIdx.x & 63;
  const bf16_t* xb = (const bf16_t*)(P.ws + OFF_HBUF) + (size_t)row * 1024;
  const unsigned char* U = P.ws + OFF_PU;
  const int* pidx = (const int*)(P.ws + OFF_PIDX) + (size_t)row * 128;
  const float* pg = (const float*)(P.ws + OFF_PGATE) + (size_t)row * 128;
  float x[16], acc[16];
  unpack8(*(const u32x4*)(xb + lane * 16), x);
  unpack8(*(const u32x4*)(xb + lane * 16 + 8), x + 8);
#pragma unroll
  for (int j = 0; j < 16; ++j) acc[j] = 0.f;
  const int b5 = (lane >> 5) & 1, b4 = (lane >> 4) & 1, b3 = (lane >> 3) & 1;
  const int mypick = (lane >> 3) & 7;
  for (int k0 = 0; k0 < 128; k0 += 8) {
    u32x4 uu[8], vv[8];
#pragma unroll
    for (int i = 0; i < 8; ++i) {
      const size_t off = (size_t)pidx[k0 + i] * 2048 + lane * 16;
      uu[i] = *(const u32x4*)(U + off);
      vv[i] = *(const u32x4*)(U + off + 1024);
    }
    const float mygate = pg[k0 + mypick];
    float dsum[8];
#pragma unroll
    for (int i = 0; i < 8; ++i) {
      float uf[16];
      unpack16_fp8(uu[i], uf);
      float dd = 0.f;
#pragma unroll
      for (int j = 0; j < 16; ++j) dd += x[j] * uf[j];
      dsum[i] = dd;
    }
    float e4[4], e2[2], g;
#pragma unroll
    for (int i = 0; i < 4; ++i) {
      float mine = b5 ? dsum[4 + i] : dsum[i], send = b5 ? dsum[i] : dsum[4 + i];
      e4[i] = mine + wshfl_xor(send, 32);
    }
#pragma unroll
    for (int i = 0; i < 2; ++i) {
      float mine = b4 ? e4[2 + i] : e4[i], send = b4 ? e4[i] : e4[2 + i];
      e2[i] = mine + wshfl_xor(send, 16);
    }
    {
      float mine = b3 ? e2[1] : e2[0], send = b3 ? e2[0] : e2[1];
      g = mine + wshfl_xor(send, 8);
    }
    g += wshfl_xor(g, 4); g += wshfl_xor(g, 2); g += wshfl_xor(g, 1);
    const float mycoef = mygate * geluf_(g * (1.f / PEER_USCALE));
#pragma unroll
    for (int i = 0; i < 8; ++i) {
      const float coef = wreadlane(mycoef, i * 8);
      float vf[16];
      unpack16_fp8(vv[i], vf);
#pragma unroll
      for (int j = 0; j < 16; ++j) acc[j] += coef * vf[j];
    }
  }
  float* xr = row < NCTX ? (float*)(P.ws + OFF_CTXRES) + (size_t)row * 1024 : P.out + (size_t)(row - NCTX) * 1024;
  const float* g2 = (const float*)(P.ws + OFF_MODV) + ((size_t)layer * 3 + mod_row(row)) * 6144 + 5 * 1024;
  float o[16];
#pragma unroll
  for (int q = 0; q < 4; ++q) {
    const int c = lane * 16 + q * 4;
    f32x4 a = *(const f32x4*)(xr + c), ga = *(const f32x4*)(g2 + c);
    o[q * 4 + 0] = a.x + ga.x * acc[q * 4 + 0] * (1.f / PEER_VSCALE); o[q * 4 + 1] = a.y + ga.y * acc[q * 4 + 1] * (1.f / PEER_VSCALE);
    o[q * 4 + 2] = a.z + ga.z * acc[q * 4 + 2] * (1.f / PEER_VSCALE); o[q * 4 + 3] = a.w + ga.w * acc[q * 4 + 3] * (1.f / PEER_VSCALE);
  }
  float ss = 0.f;
#pragma unroll
  for (int j = 0; j < 16; ++j) ss += o[j] * o[j];
  ss = wave_sum(ss);
  const float rstd = frsq(ss * (1.f / 1024.f) + 1e-6f);
  if (layer == 1) {
#pragma unroll
    for (int j = 0; j < 16; ++j) o[j] *= rstd * P.in[I_FNORM][lane * 16 + j];
  }
#pragma unroll
  for (int q = 0; q < 4; ++q) {
    f32x4 a = {o[q * 4 + 0], o[q * 4 + 1], o[q * 4 + 2], o[q * 4 + 3]};
    *(f32x4*)(xr + lane * 16 + q * 4) = a;
  }
  if (layer == 0) {
    const float* mv = (const float*)(P.ws + OFF_MODV) + ((size_t)1 * 3 + mod_row(row)) * 6144;
    const float* nw = P.in[I_NORM1] + 1024;
    float hh[16];
#pragma unroll
    for (int q = 0; q < 4; ++q) {
      const int c = lane * 16 + q * 4;
      f32x4 w4 = *(const f32x4*)(nw + c), s4 = *(const f32x4*)(mv + 1024 + c), h4 = *(const f32x4*)(mv + c);
      hh[q * 4 + 0] = o[q * 4 + 0] * rstd * w4.x * (1.f + s4.x) + h4.x; hh[q * 4 + 1] = o[q * 4 + 1] * rstd * w4.y * (1.f + s4.y) + h4.y;
      hh[q * 4 + 2] = o[q * 4 + 2] * rstd * w4.z * (1.f + s4.z) + h4.z; hh[q * 4 + 3] = o[q * 4 + 3] * rstd * w4.w * (1.f + s4.w) + h4.w;
    }
    bf16_t* hb = (bf16_t*)(P.ws + OFF_HBUF) + (size_t)row * 1024 + lane * 16;
    *(u32x4*)hb = pack8(hh);
    *(u32x4*)(hb + 8) = pack8(hh + 8);
  }
}


#define FOR_TILES_XCD(MT0, MT1, NT, mt, nt)                                                     \
  for (int _x = blockIdx.x & 7, _mlo = (MT0) + (((MT1) - (MT0)) * _x) / 8,                        \
           _mhi = (MT0) + (((MT1) - (MT0)) * (_x + 1)) / 8, _i = blockIdx.x >> 3,                 \
           _cnt = (_mhi - _mlo) * (NT), mt = 0, nt = 0;                                           \
       _i < _cnt && ((mt = _mlo + _i / (NT)), (nt = _i % (NT)), true); _i += (int)(gridDim.x >> 3))

#ifndef PHASE_LIST
#define PHASE_LIST(X) X(0) X(1) X(2) X(22) X(23) X(3) X(4) X(5) X(6) X(7) X(8) X(9) X(11) X(12) X(13) X(30) X(14) X(15) X(31) X(16) X(17) X(18) X(19) X(20) X(21)
#endif
constexpr int PH_LAST = 21;

template <int ph>
DEV void run_phase(const Params& P, unsigned char* smem) {
  int bid_ = blockIdx.x, wave_ = threadIdx.x >> 6;
  OPAQUE_S(bid_); OPAQUE(wave_);
  const int bid = bid_, nb = gridDim.x;
  const int wave = wave_;
  unsigned char* ws = P.ws;
  constexpr int layer = ((ph >= 10 && ph <= 21) || ph >= 30) ? 1 : 0;
  const float* modv_l = (const float*)(ws + OFF_MODV) + (size_t)layer * 3 * 6144;
  switch (ph) {
    case 0:
      for (int t = NTRANS + bid; t < NPREP; t += nb) st_prep(P, t, smem);
      break;
    case 1: case 10:
      if (ph == 1) for (int t = nb - 1 - bid; t < NTRANS; t += nb) st_prep(P, t, smem);
      for (int t = bid; t < NTOK / 4; t += nb) st_normmod(P, layer, 0, t * 4 + wave);
      break;
    case 2: {
      EpiProjL0T epi{(bf16_t*)(ws + OFF_PROJ), (float*)(ws + OFF_GATES)};
      FOR_TILES_XCD(0, NTOK / 256, 25, mt, nt)
        gemm_tile_128x256<EpiProjL0T, true>((const bf16_t*)(ws + OFF_WEVIN), 1024, EVC, (const bf16_t*)(ws + OFF_HBUF), 1024, NTOK, 1024,
                                            nt * 128, mt * 256, epi, smem);
    } break;
    case 22:
      for (int t = bid; t < NTOK / 4; t += nb) st_xbc_conv(P, t * 4 + wave);
      for (int t = bid; t < NPCONV; t += nb) st_peer_conv(P, 0, t);
      break;
    case 23:
      for (int t = bid; t < 48 * LA_NSEG; t += nb) {
        int sid = t % 48, seg = t / 48;
        if (sid < 16) st_linattn_seg<true, false>(P, sid, seg, smem);
        else st_linattn_seg<false, false>(P, sid - 16, seg, smem);
      }
      break;
    case 3:
      for (int t = bid; t < 48 * LA_NSEG; t += nb) {
        int sid = t % 48, seg = t / 48;
        if (sid < 16) st_linattn_seg<true, true>(P, sid, seg, smem);
        else st_linattn_seg<false, true>(P, sid - 16, seg, smem);
      }
      break;
    case 4:
      for (int t = bid; t < NTOK / 4; t += nb) st_finish_l0(P, t * 4 + wave);
      break;
    case 5: case 17: {
      EpiOutProjT epi{layer == 0 ? P.in[I_X] : P.out, P.in[I_CTX], P.out, (float*)(ws + OFF_CTXRES), modv_l};
      const bf16_t* Wt = (const bf16_t*)(ws + (layer == 0 ? OFF_WEVOUT : OFF_WODOUT));
      FOR_TILES_XCD(layer == 0 ? 0 : NCTX / 256, NTOK / 256, 8, mt, nt)
        gemm_tile_128x256<EpiOutProjT, true>(Wt, 1024, 1024, (const bf16_t*)(ws + OFF_HBUF), 1024, NTOK, 1024, nt * 128, mt * 256, epi, smem);
    } break;
    case 6: case 18: {
      const int r0 = layer == 0 ? 0 : NCTX / 4;
      for (int t = r0 + bid; t < NTOK / 4; t += nb) st_normmod(P, layer, 1, t * 4 + wave);
      if (ph == 18) for (int t = bid; t < NPCONV; t += nb) st_peer_conv(P, 1, t);
    } break;
    case 7: case 19: {
      EpiStoreBfT epi{(bf16_t*)(ws + OFF_Q), 2048};
      const bf16_t* Wt = (const bf16_t*)(ws + OFF_WQ) + (size_t)layer * 2048 * 1024;
      FOR_TILES_XCD(layer == 0 ? 0 : NCTX / 256, NTOK / 256, 16, mt, nt)
        gemm_tile_128x256<EpiStoreBfT, true>(Wt, 1024, 2048, (const bf16_t*)(ws + OFF_HBUF), 1024, NTOK, 1024, nt * 128, mt * 256, epi, smem);
    } break;
    case 8: case 20: {
      const int t0 = layer == 0 ? 0 : CTILE * 8;
      for (int t = t0 + bid; t < NTILE * 8; t += nb) st_peer_topk(P, layer, t / 8, t % 8, smem);
    } break;
    case 9: case 21: {
      const int r0 = layer == 0 ? 0 : NCTX / 4;
      for (int t = r0 + bid; t < NTOK / 4; t += nb) st_peer_experts(P, layer, t * 4 + wave);
    } break;
    case 11: {
      EpiStoreBfT epi{(bf16_t*)(ws + OFF_PROJ), ODC};
      FOR_TILES_XCD(0, NTOK / 256, 22, mt, nt)
        gemm_tile_128x256<EpiStoreBfT, true>((const bf16_t*)(ws + OFF_WODIN), 1024, ODC, (const bf16_t*)(ws + OFF_HBUF), 1024, NTOK, 1024,
                                             nt * 128, mt * 256, epi, smem);
    } break;
    case 12:
      for (int t = bid; t < NTOK / 4; t += nb) st_lora_act(P, t * 4 + wave);
      break;
    case 13:
      for (int t = bid; t < NTILE * 20; t += nb) {
        int job = t / (NTILE * 4), tt = t % (NTILE * 4);
        int mt = tt / 4, nt = tt % 4;
        bf16_t* dst = (bf16_t*)(ws + OFF_LORA) + (size_t)job * NTOK * 512;
        const bf16_t* A = (const bf16_t*)(ws + OFF_HBUF) + (job < 2 ? 0 : (job < 4 ? 64 : 128));
        const bf16_t* Bt = job < 2 ? (const bf16_t*)(ws + OFF_WUP) + (size_t)job * 512 * 64
                         : job < 4 ? (const bf16_t*)(ws + OFF_AUP) + (size_t)(job - 2) * 512 * 64
                                   : (const bf16_t*)(ws + OFF_GUP);
        const float* bias = job < 2 ? P.in[I_W0] + job * 512 : (job < 4 ? P.in[I_A0] + (job - 2) * 512 : nullptr);
        const int K = job < 4 ? 64 : 128;
        EpiStoreBfBiasT epi{dst, 512, bias};
        gemm_tile_128<false, EpiStoreBfBiasT, true>(Bt, K, 512, A, 1024, NTOK, K, nt * 128, mt * 128, epi, smem);
      }
      break;
    case 30:
      for (int t = bid; t < 32 * RW_NSEG; t += nb) st_rwkv_seg<false>(P, t % 32, t / 32, smem);
      break;
    case 14:
      for (int t = bid; t < 32 * RW_NSEG; t += nb) st_rwkv_seg<true>(P, t % 32, t / 32, smem);
      break;
    case 15:
      for (int t = bid; t < 32 * LRU_NCH; t += nb) st_lru_chunk(P, t % 32, t / 32, smem);
      break;
    case 31:
      if (bid < 32) st_lru_carry(P, bid);
      break;
    case 16:
      for (int t = bid; t < NTOK / 4; t += nb) st_finish_l1(P, t * 4 + wave);
      break;
    default: break;
  }
}


#ifndef CPU_EMU
#define XB_TMO      128
#define XB_XCNT(j)  (256  + 64 * (j))
#define XB_XSUB(j)  (1280 + 64 * (j))
#define XB_XGEN(j)  (2304 + 64 * (j))
#define XB_TOP      3328
#define XB_TOPGEN   3392
#define XCD_BAR_WORDS 3456
#define XB_SPIN_CAP (1u << 20)
#define LAS __attribute__((address_space(3)))
__device__ __forceinline__ unsigned xb_ld(unsigned* p)              { return __hip_atomic_load(p, __ATOMIC_RELAXED, __HIP_MEMORY_SCOPE_AGENT); }
__device__ __forceinline__ unsigned xb_add(unsigned* p, unsigned v) { return __hip_atomic_fetch_add(p, v, __ATOMIC_RELAXED, __HIP_MEMORY_SCOPE_AGENT); }
__device__ __forceinline__ unsigned xb_xcc_id() { return (unsigned)__builtin_amdgcn_s_getreg((3 << 11) | 20) & 0xFu; }
#define XB_SPIN(cond, bar) do { unsigned _sp = 0; while (cond) { __builtin_amdgcn_s_sleep(1); \
    if ((++_sp & 255u) == 0u) { if (xb_ld(&(bar)[XB_TMO])) break; if (_sp > XB_SPIN_CAP) { atomicAdd(&(bar)[XB_TMO], 1u); break; } } } } while (0)
struct XcdBarrier { unsigned* bar; unsigned x; volatile LAS unsigned* st; };
__device__ __forceinline__ XcdBarrier xcd_barrier_post(unsigned* bar, volatile LAS unsigned* st) {
  XcdBarrier b; b.bar = bar; b.x = xb_xcc_id(); b.st = st;
  if (threadIdx.x == 0) (void)xb_add(&bar[XB_XCNT(b.x)], 1u);
  return b;
}
__device__ __forceinline__ void xcd_barrier_complete(unsigned* bar, unsigned x, unsigned& nloc, unsigned& nx) {
  const unsigned G = gridDim.x * gridDim.y * gridDim.z;
  unsigned sum, cnt, mine, sp = 0u;
  for (;;) {
    sum = 0u; cnt = 0u; mine = 0u;
#pragma unroll
    for (unsigned j = 0; j < 16; ++j) { const unsigned c = xb_ld(&bar[XB_XCNT(j)]); sum += c; cnt += (c > 0u) ? 1u : 0u; mine = (j == x) ? c : mine; }
    if (sum == G) break;
    __builtin_amdgcn_s_sleep(1);
    if ((++sp & 255u) == 0u) { if (xb_ld(&bar[XB_TMO])) break; if (sp > XB_SPIN_CAP) { atomicAdd(&bar[XB_TMO], 1u); break; } }
  }
  nloc = mine > 0u ? mine : 1u; nx = cnt > 0u ? cnt : 1u;
}
__device__ __forceinline__ void xcd_barrier(const XcdBarrier& b) {
  asm volatile("s_waitcnt vmcnt(0)" ::: "memory");
  __syncthreads();
  if (threadIdx.x == 0) {
    unsigned* bar = b.bar;
    __builtin_amdgcn_s_waitcnt(0);
    unsigned nloc = b.st[0], nx = b.st[1];
    if (nloc == 0u) { xcd_barrier_complete(bar, b.x, nloc, nx); b.st[0] = nloc; b.st[1] = nx; }
    const unsigned old = xb_add(&bar[XB_XSUB(b.x)], 1u);
    const unsigned gen = old / nloc;
    if (old + 1u == (gen + 1u) * nloc) {
      __builtin_amdgcn_fence(__ATOMIC_RELEASE, "agent");
      asm volatile("s_waitcnt vmcnt(0)" ::: "memory");
      const unsigned og = xb_add(&bar[XB_TOP], 1u);
      const unsigned tg = og / nx;
      if (og + 1u == (tg + 1u) * nx) xb_add(&bar[XB_TOPGEN], 1u);
      else XB_SPIN(xb_ld(&bar[XB_TOPGEN]) == tg, bar);
      __builtin_amdgcn_fence(__ATOMIC_ACQUIRE, "agent");
      xb_add(&bar[XB_XGEN(b.x)], 1u);
      asm volatile("s_waitcnt vmcnt(0)" ::: "memory");
    } else {
      XB_SPIN(xb_ld(&bar[XB_XGEN(b.x)]) == gen, bar);
      __builtin_amdgcn_fence(__ATOMIC_ACQUIRE, "agent");
      asm volatile("s_waitcnt vmcnt(0)" ::: "memory");
    }
  }
  __syncthreads();
}
#endif
#ifndef CPU_EMU
#define RUN_PH(n) run_phase<n>(P, smem_raw); if (n != PH_LAST) xcd_barrier(xb);
__global__ void __launch_bounds__(256, 2) mega_kernel(Params P) {
  SMEM_DECL;
  unsigned* bar = (unsigned*)(P.ws + OFF_BAR);
  volatile LAS unsigned* st = (volatile LAS unsigned*)(smem_raw + SMEM_BYTES - 16);
  if (threadIdx.x == 0) { st[0] = 0u; st[1] = 0u; }
  if (P.ws == nullptr) cg::this_grid().sync();
  __syncthreads();
  XcdBarrier xb = xcd_barrier_post(bar, st);
  PHASE_LIST(RUN_PH)
}

extern "C" void kernel_launch(void* const* d_in, const int* in_sizes, int n_in, void* d_out, int out_size, void* d_ws,
                              size_t ws_size, hipStream_t stream) {
  Params P{};
  for (int i = 0; i < N_IN; ++i) P.in[i] = (const float*)d_in[i];
  P.out = (float*)d_out;
  P.ws = (unsigned char*)d_ws;
  if (ws_size < WS_NEEDED) { fprintf(stderr, "workspace too small: %zu < %zu\n", ws_size, (size_t)WS_NEEDED); return; }
  static int grid_blocks = 0;
  if (!grid_blocks) {
    int dev = 0, cus = 0, per_cu = 0;
    hipGetDevice(&dev);
    hipDeviceGetAttribute(&cus, hipDeviceAttributeMultiprocessorCount, dev);
    hipOccupancyMaxActiveBlocksPerMultiprocessor(&per_cu, mega_kernel, 256, 0);
    if (per_cu > 2) per_cu = 2;
    grid_blocks = cus * per_cu;
  }
  (void)hipMemsetAsync((unsigned char*)d_ws + OFF_BAR, 0, 16384, stream);
  void* args[] = {&P};
  hipError_t e = hipLaunchCooperativeKernel((void*)mega_kernel, dim3(grid_blocks), dim3(256), args, 0, stream);
  if (e != hipSuccess) fprintf(stderr, "cooperative launch failed: %s (grid %d)\n", hipGetErrorString(e), grid_blocks);
}
#endif
```

```cpp
#ifdef CPU_EMU
#include "emu.h"
#else
#include <hip/hip_runtime.h>
#include <hip/hip_cooperative_groups.h>
#include <cstdio>
namespace cg = cooperative_groups;
#define DEV __device__ __forceinline__
#define DEVM __device__ __forceinline__
#define OPAQUE(x) asm volatile("" : "+v"(x))
#define OPAQUE_S(x) asm volatile("" : "+s"(x))
#endif

#ifndef SEQ_LEN
#define SEQ_LEN 16384
#endif
#ifndef CTX_LEN
#define CTX_LEN 256
#endif
#ifndef GRID_W_
#define GRID_W_ 64
#endif
#ifndef MULTI_LAUNCH
#define MULTI_LAUNCH 0
#endif

typedef unsigned short bf16_t;
typedef __attribute__((ext_vector_type(8))) short bf16x8;
typedef __attribute__((ext_vector_type(16))) float f32x16;
typedef __attribute__((ext_vector_type(4))) unsigned u32x4;
typedef __attribute__((ext_vector_type(2))) unsigned u32x2;
typedef __attribute__((ext_vector_type(4))) float f32x4;

constexpr int D = 1024, NB = 2, SEQ = SEQ_LEN, CTXL = CTX_LEN, GW = GRID_W_;
constexpr int NCTX = NB * CTXL, NLAT = NB * SEQ, NTOK = NCTX + NLAT;
constexpr int EVC = 3104, ODC = 2816;
constexpr int NEXP = 16384;
constexpr int NTILE = NTOK / 128, CTILE = NCTX / 128;
static_assert(NTOK % 256 == 0 && NCTX % 256 == 0, "tiles");
static_assert(CTXL % 64 == 0 && SEQ % 64 == 0 && SEQ % GW == 0, "chunks");

constexpr size_t al256(size_t x) { return (x + 255) & ~(size_t)255; }
constexpr size_t OFF_MODV = 0;
constexpr size_t OFF_CTXRES = OFF_MODV + al256(2 * 3 * 6144 * 4);
constexpr size_t OFF_GATES = OFF_CTXRES + al256((size_t)NCTX * 1024 * 4);
constexpr size_t OFF_WEVIN = OFF_GATES + al256((size_t)NTOK * 32 * 4);
constexpr size_t OFF_WEVOUT = OFF_WEVIN + al256((size_t)EVC * 1024 * 2);
constexpr size_t OFF_WODIN = OFF_WEVOUT + al256((size_t)1024 * 1024 * 2);
constexpr size_t OFF_WODOUT = OFF_WODIN + al256((size_t)ODC * 1024 * 2);
constexpr size_t OFF_WQ = OFF_WODOUT + al256((size_t)1024 * 1024 * 2);
constexpr size_t OFF_KEYS = OFF_WQ + al256((size_t)2 * 2048 * 1024 * 2);
constexpr size_t OFF_WUP = OFF_KEYS + al256((size_t)2 * 8 * 2 * 128 * 128 * 2);
constexpr size_t OFF_AUP = OFF_WUP + al256((size_t)2 * 512 * 64 * 2);
constexpr size_t OFF_GUP = OFF_AUP + al256((size_t)2 * 512 * 64 * 2);
constexpr size_t OFF_LRUT = OFF_GUP + al256((size_t)512 * 128 * 2);
constexpr size_t OFF_PU = OFF_LRUT + al256((size_t)2 * 8 * 128 * 64 * 2);
constexpr size_t OFF_PV = OFF_PU + al256((size_t)NEXP * 1024);
constexpr size_t OFF_HBUF = OFF_PV + al256((size_t)NEXP * 1024);
constexpr size_t OFF_PR = OFF_HBUF + al256((size_t)NTOK * 1024 * 2);
constexpr size_t PR_BYTES = (size_t)NTOK * 5376 * 2;
constexpr size_t OFF_BAR = OFF_PR + PR_BYTES;
constexpr size_t OFF_ACUM1 = OFF_BAR + 16384;
constexpr size_t OFF_LRUCS = OFF_ACUM1 + (size_t)NLAT * 512 * 2;
constexpr size_t OFF_LRUHS = OFF_LRUCS + (size_t)32 * ((CTXL + SEQ) / 64) * 128 * 4;
constexpr size_t WS_NEEDED = OFF_LRUHS + (size_t)32 * ((CTXL + SEQ) / 64) * 64 * 4;
#ifndef CPU_EMU
static_assert(WS_NEEDED <= (size_t)512 * 1024 * 1024, "workspace too large");
#endif
constexpr size_t OFF_PROJ = OFF_PR;
constexpr size_t OFF_R2L0 = OFF_PR + (size_t)NTOK * EVC * 2;
constexpr size_t OFF_LORA = OFF_PR + (size_t)NTOK * ODC * 2;
constexpr size_t OFF_Q = OFF_PR;
constexpr size_t OFF_PIDX = OFF_PR + (size_t)NTOK * 2048 * 2;
constexpr size_t OFF_PGATE = OFF_PIDX + (size_t)NTOK * 128 * 4;
static_assert(OFF_PGATE + (size_t)NTOK * 128 * 4 <= OFF_PR + PR_BYTES, "picks");

enum {
  I_X = 0, I_C, I_CTX, I_CCTX, I_MODW, I_MODB, I_NORM1, I_NORM2, I_WQ, I_KEYS, I_PU, I_PV,
  I_EVWIN, I_EVWOUT, I_IBIAS, I_FBIAS, I_MNORM, I_SCONVW, I_SCONVB, I_DTBIAS, I_ALOG, I_DSKIP, I_SNORM,
  I_ODWIN, I_ODWOUT, I_MU, I_W0, I_WUP, I_A0, I_AUP, I_GUP, I_KK, I_KA, I_RK, I_LNW, I_LNB,
  I_LCONVW, I_LCONVB, I_LAM, I_WA, I_BA, I_WI, I_BI, I_FNORM, N_IN
};

struct Params {
  const float* in[N_IN];
  float* out;
  unsigned char* ws;
};

constexpr int SMEM_BYTES = 80 * 1024;
#ifdef CPU_EMU
#define SMEM_DECL static thread_local __attribute__((aligned(16))) unsigned char smem_raw[SMEM_BYTES]
#else
#define SMEM_DECL __shared__ __attribute__((aligned(16))) unsigned char smem_raw[SMEM_BYTES]
#endif

DEV float bf2f(bf16_t v) { unsigned u = ((unsigned)v) << 16; float f; __builtin_memcpy(&f, &u, 4); return f; }
DEV bf16_t f2bf(float f) { unsigned u; __builtin_memcpy(&u, &f, 4); u += 0x7fffu + ((u >> 16) & 1u); return (bf16_t)(u >> 16); }
DEV unsigned pack2(float a, float b) { return (unsigned)f2bf(a) | ((unsigned)f2bf(b) << 16); }
DEV void unpack8(const u32x4& r, float* o) {
  unsigned w[4] = {r.x, r.y, r.z, r.w};
#pragma unroll
  for (int i = 0; i < 4; ++i) { unsigned lo = w[i] << 16, hi = w[i] & 0xffff0000u; __builtin_memcpy(&o[2 * i], &lo, 4); __builtin_memcpy(&o[2 * i + 1], &hi, 4); }
}
DEV u32x4 pack8(const float* o) { u32x4 r; r.x = pack2(o[0], o[1]); r.y = pack2(o[2], o[3]); r.z = pack2(o[4], o[5]); r.w = pack2(o[6], o[7]); return r; }
#ifdef CPU_EMU
DEV float fexp(float x) { return expf(x); }
DEV float frcp(float x) { return 1.f / x; }
DEV float flog(float x) { return logf(x); }
DEV float frsq(float x) { return 1.f / sqrtf(x); }
DEV float fsqrt(float x) { return sqrtf(x); }
#else
DEV float fexp(float x) { return __expf(x); }
DEV float frcp(float x) { return __builtin_amdgcn_rcpf(x); }
DEV float flog(float x) { return __logf(x); }
DEV float frsq(float x) { return __builtin_amdgcn_rsqf(x); }
DEV float fsqrt(float x) { return __builtin_amdgcn_sqrtf(x); }
#endif
DEV float sigmoidf_(float x) { return frcp(1.f + fexp(-x)); }
DEV float siluf_(float x) { return x * frcp(1.f + fexp(-x)); }
DEV float softplusf_(float x) { return fmaxf(x, 0.f) + flog(1.f + fexp(-fabsf(x))); }
DEV float tanhf_(float x) { return 1.f - 2.f * frcp(1.f + fexp(2.f * x)); }
DEV float geluf_(float x) { return 0.5f * x * (1.f + erff(x * 0.70710678118654752f)); }

DEV f32x16 mfma32(bf16x8 a, bf16x8 b, f32x16 c) {
#ifdef CPU_EMU
  return emu_mfma32(a, b, c);
#else
  return __builtin_amdgcn_mfma_f32_32x32x16_bf16(a, b, c, 0, 0, 0);
#endif
}
DEV float wshfl_xor(float v, int m) {
#ifdef CPU_EMU
  return emu_shfl_xor(v, m);
#else
  return __shfl_xor(v, m, 64);
#endif
}
DEV float wave_sum(float v) {
#pragma unroll
  for (int m = 32; m >= 1; m >>= 1) v += wshfl_xor(v, m);
  return v;
}

#ifdef CPU_EMU
static inline unsigned emu_f2fp8(float f) {
  unsigned sgn = f < 0.f ? 0x80u : 0u; float a = fabsf(f);
  if (!(a == a)) return 0x7f;
  if (a >= 448.f) return sgn | 0x7e;
  if (a < 0.0009765625f) return sgn;
  int e; frexpf(a, &e); e -= 1;
  if (e < -6) { int q = (int)nearbyintf(a * 512.f); return sgn | (unsigned)q; }
  float m = a / ldexpf(1.f, e);
  int q = (int)nearbyintf((m - 1.f) * 8.f);
  if (q == 8) { q = 0; e += 1; }
  if (e > 8) return sgn | 0x7e;
  return sgn | (unsigned)((e + 7) << 3) | (unsigned)q;
}
static inline float emu_fp82f(unsigned c) {
  unsigned sgn = c & 0x80, e = (c >> 3) & 15, m = c & 7;
  float v = e == 0 ? ldexpf((float)m, -9) : ldexpf(1.f + m / 8.f, (int)e - 7);
  return sgn ? -v : v;
}
#endif
DEV unsigned pack4_fp8(float a, float b, float c, float d) {
#ifdef CPU_EMU
  return emu_f2fp8(a) | (emu_f2fp8(b) << 8) | (emu_f2fp8(c) << 16) | (emu_f2fp8(d) << 24);
#else
  int w = 0;
  w = __builtin_amdgcn_cvt_pk_fp8_f32(a, b, w, false);
  w = __builtin_amdgcn_cvt_pk_fp8_f32(c, d, w, true);
  return (unsigned)w;
#endif
}
DEV void unpack4_fp8(unsigned w, float* o) {
#ifdef CPU_EMU
  o[0] = emu_fp82f(w & 255); o[1] = emu_fp82f((w >> 8) & 255); o[2] = emu_fp82f((w >> 16) & 255); o[3] = emu_fp82f(w >> 24);
#else
  typedef __attribute__((ext_vector_type(2))) float f32x2_;
  f32x2_ lo = __builtin_amdgcn_cvt_pk_f32_fp8((int)w, false);
  f32x2_ hi = __builtin_amdgcn_cvt_pk_f32_fp8((int)w, true);
  o[0] = lo.x; o[1] = lo.y; o[2] = hi.x; o[3] = hi.y;
#endif
}
DEV void unpack16_fp8(const u32x4& r, float* o) { unpack4_fp8(r.x, o); unpack4_fp8(r.y, o + 4); unpack4_fp8(r.z, o + 8); unpack4_fp8(r.w, o + 12); }
DEV float wreadlane(float v, int srclane) {
#ifdef CPU_EMU
  return emu_readlane(v, srclane);
#else
  int iv; __builtin_memcpy(&iv, &v, 4);
  int r = __builtin_amdgcn_readlane(iv, srclane);
  float f; __builtin_memcpy(&f, &r, 4); return f;
#endif
}
constexpr float PEER_USCALE = 64.f, PEER_VSCALE = 4.f;
#ifdef CPU_EMU
static inline unsigned emu_f2fp4(float f) {
  static const float lv[8] = {0.f, 0.5f, 1.f, 1.5f, 2.f, 3.f, 4.f, 6.f};
  unsigned sgn = f < 0.f ? 8u : 0u; float a = fabsf(f);
  int best = 0; float bd = 1e30f;
  for (int i = 0; i < 8; ++i) { float dd = fabsf(a - lv[i]); if (dd < bd || (dd == bd && (i & 1) == 0)) { bd = dd; best = i; } }
  return sgn | (unsigned)best;
}
static inline float emu_fp42f(unsigned c) {
  static const float lv[8] = {0.f, 0.5f, 1.f, 1.5f, 2.f, 3.f, 4.f, 6.f};
  float v = lv[c & 7]; return (c & 8) ? -v : v;
}
#endif
DEV unsigned pack8_fp4(const float* v) {
#ifdef CPU_EMU
  unsigned w = 0;
  for (int i = 0; i < 8; ++i) w |= emu_f2fp4(v[i]) << (4 * i);
  return w;
#else
  unsigned w = 0;
  w = __builtin_amdgcn_cvt_scalef32_pk_fp4_f32(w, v[0], v[1], 1.0f, 0);
  w = __builtin_amdgcn_cvt_scalef32_pk_fp4_f32(w, v[2], v[3], 1.0f, 1);
  w = __builtin_amdgcn_cvt_scalef32_pk_fp4_f32(w, v[4], v[5], 1.0f, 2);
  w = __builtin_amdgcn_cvt_scalef32_pk_fp4_f32(w, v[6], v[7], 1.0f, 3);
  return w;
#endif
}
DEV void unpack8_fp4(unsigned w, float* o) {
#ifdef CPU_EMU
  for (int i = 0; i < 8; ++i) o[i] = emu_fp42f((w >> (4 * i)) & 15u);
#else
  typedef __attribute__((ext_vector_type(2))) float f32x2_;
  f32x2_ a = __builtin_amdgcn_cvt_scalef32_pk_f32_fp4(w, 1.0f, 0);
  f32x2_ b = __builtin_amdgcn_cvt_scalef32_pk_f32_fp4(w, 1.0f, 1);
  f32x2_ c = __builtin_amdgcn_cvt_scalef32_pk_f32_fp4(w, 1.0f, 2);
  f32x2_ d = __builtin_amdgcn_cvt_scalef32_pk_f32_fp4(w, 1.0f, 3);
  o[0] = a.x; o[1] = a.y; o[2] = b.x; o[3] = b.y; o[4] = c.x; o[5] = c.y; o[6] = d.x; o[7] = d.y;
#endif
}
constexpr int PEER_ROWB = 1536;


DEV int acc_row(int reg, int lane) { return (reg & 3) + 8 * (reg >> 2) + 4 * (lane >> 5); }

DEV int mod_row(int row) { return row < NCTX ? 2 : (row - NCTX) / SEQ; }

template <bool SYNC_EPI, class Epi, bool VEC4 = false>
DEV void gemm_tile_128(const bf16_t* __restrict__ A, int lda, int M, const bf16_t* __restrict__ Bt, int ldb, int N,
                       int K, int m0, int n0, const Epi& epi, unsigned char* smem) {
  constexpr int LS = 72;
  constexpr int STAGE = 2 * 128 * LS;
  bf16_t* sbase = (bf16_t*)smem;
  const int wave = threadIdx.x >> 6;
  const int wm = (wave >> 1) * 64, wn = (wave & 1) * 64;
  f32x16 acc[2][2];
#pragma unroll
  for (int i = 0; i < 2; ++i)
#pragma unroll
    for (int j = 0; j < 2; ++j)
#pragma unroll
      for (int r = 0; r < 16; ++r) acc[i][j][r] = 0.f;
  u32x4 ra[4], rb[4];
  auto gload = [&](int k0) {
    int tl_ = threadIdx.x; OPAQUE(tl_);
#pragma unroll
    for (int i = 0; i < 4; ++i) {
      int c = tl_ + i * 256, r = c >> 3, cc = (c & 7) * 8;
      int gr = m0 + r, gn = n0 + r;
      gr = gr < M ? gr : M - 1; gn = gn < N ? gn : N - 1;
      ra[i] = *(const u32x4*)(A + (size_t)gr * lda + k0 + cc);
      rb[i] = *(const u32x4*)(Bt + (size_t)gn * ldb + k0 + cc);
    }
  };
  auto lwrite = [&](int buf) {
    int tl_ = threadIdx.x; OPAQUE(tl_);
    bf16_t* sA = sbase + buf * STAGE;
    bf16_t* sB = sA + 128 * LS;
#pragma unroll
    for (int i = 0; i < 4; ++i) {
      int c = tl_ + i * 256, r = c >> 3, cc = (c & 7) * 8;
      *(u32x4*)(sA + r * LS + cc) = ra[i];
      *(u32x4*)(sB + r * LS + cc) = rb[i];
    }
  };
  const int nk = K >> 6;
  gload(0);
  __syncthreads();
  lwrite(0);
  if (nk > 1) gload(64);
  __syncthreads();
  for (int it = 0; it < nk; ++it) {
    int tl_ = threadIdx.x; OPAQUE(tl_);
    const int lane = tl_ & 63;
    const bf16_t* sA = sbase + (it & 1) * STAGE;
    const bf16_t* sB = sA + 128 * LS;
#pragma unroll
    for (int kk = 0; kk < 4; ++kk) {
      bf16x8 a[2], b[2];
      const int ko = kk * 16 + 8 * (lane >> 5);
#pragma unroll
      for (int i = 0; i < 2; ++i) a[i] = *(const bf16x8*)(sA + (wm + i * 32 + (lane & 31)) * LS + ko);
#pragma unroll
      for (int j = 0; j < 2; ++j) b[j] = *(const bf16x8*)(sB + (wn + j * 32 + (lane & 31)) * LS + ko);
#pragma unroll
      for (int i = 0; i < 2; ++i)
#pragma unroll
        for (int j = 0; j < 2; ++j) acc[i][j] = mfma32(a[i], b[j], acc[i][j]);
      if (kk == 1) {
        if (it + 1 < nk) lwrite((it + 1) & 1);
        if (it + 2 < nk) gload((it + 2) * 64);
      }
    }
    __syncthreads();
  }
  {
    int tl_ = threadIdx.x; OPAQUE(tl_);
    const int lane = tl_ & 63;
    if constexpr (VEC4) {
#pragma unroll
      for (int i = 0; i < 2; ++i)
#pragma unroll
        for (int j = 0; j < 2; ++j)
#pragma unroll
          for (int gq = 0; gq < 4; ++gq) {
            int row = m0 + wm + i * 32 + 8 * gq + 4 * (lane >> 5);
            int col = n0 + wn + j * 32 + (lane & 31);
            if (row < M && col < N) epi.store4(row, col, acc[i][j][4 * gq], acc[i][j][4 * gq + 1], acc[i][j][4 * gq + 2], acc[i][j][4 * gq + 3]);
          }
    } else {
#pragma unroll
      for (int i = 0; i < 2; ++i)
#pragma unroll
        for (int j = 0; j < 2; ++j)
#pragma unroll
          for (int r = 0; r < 16; ++r) {
            int row = m0 + wm + i * 32 + acc_row(r, lane);
            int col = n0 + wn + j * 32 + (lane & 31);
            if (row < M && col < N) epi(row, col, acc[i][j][r]);
          }
    }
  }
}

template <class Epi, bool VEC4 = false>
DEV void gemm_tile_128x256(const bf16_t* __restrict__ A, int lda, int M, const bf16_t* __restrict__ Bt, int ldb, int N,
                           int K, int m0, int n0, const Epi& epi, unsigned char* smem) {
  constexpr int LS = 72;
  bf16_t* sA = (bf16_t*)smem;
  bf16_t* sB = sA + 128 * LS;
  const int wave = threadIdx.x >> 6;
  const int wm = (wave >> 1) * 64, wn = (wave & 1) * 128;
  f32x16 acc[2][4];
#pragma unroll
  for (int i = 0; i < 2; ++i)
#pragma unroll
    for (int j = 0; j < 4; ++j)
#pragma unroll
      for (int r = 0; r < 16; ++r) acc[i][j][r] = 0.f;
  u32x4 ra[4], rb[8];
  {
    const int tid = threadIdx.x;
#pragma unroll
    for (int i = 0; i < 4; ++i) {
      int c = tid + i * 256, r = c >> 3, cc = (c & 7) * 8;
      { int gr = m0 + r; gr = gr < M ? gr : M - 1; ra[i] = *(const u32x4*)(A + (size_t)gr * lda + cc); }
    }
#pragma unroll
    for (int i = 0; i < 8; ++i) {
      int c = tid + i * 256, r = c >> 3, cc = (c & 7) * 8;
      { int gn = n0 + r; gn = gn < N ? gn : N - 1; rb[i] = *(const u32x4*)(Bt + (size_t)gn * ldb + cc); }
    }
  }
  for (int k0 = 0; k0 < K; k0 += 64) {
    int tl_ = threadIdx.x; OPAQUE(tl_);
    const int tid = tl_, lane = tl_ & 63;
    __syncthreads();
#pragma unroll
    for (int i = 0; i < 4; ++i) { int c = tid + i * 256, r = c >> 3, cc = (c & 7) * 8; *(u32x4*)(sA + r * LS + cc) = ra[i]; }
#pragma unroll
    for (int i = 0; i < 8; ++i) { int c = tid + i * 256, r = c >> 3, cc = (c & 7) * 8; *(u32x4*)(sB + r * LS + cc) = rb[i]; }
    __syncthreads();
    if (k0 + 64 < K) {
#pragma unroll
      for (int i = 0; i < 4; ++i) {
        int c = tid + i * 256, r = c >> 3, cc = (c & 7) * 8;
        { int gr = m0 + r; gr = gr < M ? gr : M - 1; ra[i] = *(const u32x4*)(A + (size_t)gr * lda + k0 + 64 + cc); }
      }
#pragma unroll
      for (int i = 0; i < 8; ++i) {
        int c = tid + i * 256, r = c >> 3, cc = (c & 7) * 8;
        { int gn = n0 + r; gn = gn < N ? gn : N - 1; rb[i] = *(const u32x4*)(Bt + (size_t)gn * ldb + k0 + 64 + cc); }
      }
    }
#pragma unroll 2
    for (int kk = 0; kk < 4; ++kk) {
      bf16x8 a[2], b[4];
      const int ko = kk * 16 + 8 * (lane >> 5);
#pragma unroll
      for (int i = 0; i < 2; ++i) a[i] = *(const bf16x8*)(sA + (wm + i * 32 + (lane & 31)) * LS + ko);
#pragma unroll
      for (int j = 0; j < 4; ++j) b[j] = *(const bf16x8*)(sB + (wn + j * 32 + (lane & 31)) * LS + ko);
#pragma unroll
      for (int i = 0; i < 2; ++i)
#pragma unroll
        for (int j = 0; j < 4; ++j) acc[i][j] = mfma32(a[i], b[j], acc[i][j]);
    }
  }
  {
    int tl_ = threadIdx.x; OPAQUE(tl_);
    const int lane = tl_ & 63;
    if constexpr (VEC4) {
#pragma unroll
      for (int i = 0; i < 2; ++i)
#pragma unroll
        for (int j = 0; j < 4; ++j)
#pragma unroll
          for (int gq = 0; gq < 4; ++gq) {
            int row = m0 + wm + i * 32 + 8 * gq + 4 * (lane >> 5);
            int col = n0 + wn + j * 32 + (lane & 31);
            if (row < M && col < N) epi.store4(row, col, acc[i][j][4 * gq], acc[i][j][4 * gq + 1], acc[i][j][4 * gq + 2], acc[i][j][4 * gq + 3]);
          }
    } else {
#pragma unroll
      for (int i = 0; i < 2; ++i)
#pragma unroll
        for (int j = 0; j < 4; ++j)
#pragma unroll
          for (int r = 0; r < 16; ++r) {
            int row = m0 + wm + i * 32 + acc_row(r, lane);
            int col = n0 + wn + j * 32 + (lane & 31);
            if (row < M && col < N) epi(row, col, acc[i][j][r]);
          }
    }
  }
}

DEV void transpose_tile(const float* __restrict__ src, int ld_src, bf16_t* __restrict__ dst, int ld_dst, int K, int N,
                        int tk, int tn, unsigned char* smem) {
  float* sT = (float*)smem;
  const int tid = threadIdx.x;
  __syncthreads();
  {
    const int tx = tid & 15, ty = tid >> 4;
#pragma unroll
    for (int p = 0; p < 4; ++p) {
      int k = tk * 64 + ty + p * 16, n = tn * 64 + tx * 4;
#pragma unroll
      for (int j = 0; j < 4; ++j) {
        float v = (k < K && n + j < N) ? src[(size_t)k * ld_src + n + j] : 0.f;
        sT[(ty + p * 16) * 65 + tx * 4 + j] = v;
      }
    }
  }
  __syncthreads();
  {
    const int n = tid >> 2, kseg = (tid & 3) * 16;
    int gn = tn * 64 + n;
    if (gn < N) {
      float v[16];
#pragma unroll
      for (int j = 0; j < 16; ++j) v[j] = sT[(kseg + j) * 65 + n];
      bf16_t* d = dst + (size_t)gn * ld_dst + tk * 64 + kseg;
      *(u32x4*)d = pack8(v);
      *(u32x4*)(d + 8) = pack8(v + 8);
    }
  }
}

constexpr int TJ0 = 16 * 49, TJ1 = 16 * 16, TJ2 = 16 * 44, TJ3 = 16 * 16, TJ4 = 2 * 16 * 32, TJ5 = 2 * 8, TJ6 = 2 * 8,
              TJ7 = 2 * 8, TJ8 = 32;
constexpr int NTRANS = TJ0 + TJ1 + TJ2 + TJ3 + TJ4 + TJ5 + TJ6 + TJ7 + TJ8;
constexpr int NKEYCV = (2 * 8 * 2 * 128 * 128) / (256 * 8);
constexpr int NMODV = 2 * 96;
constexpr int NPREP = NTRANS + NKEYCV + NMODV;

DEV void st_prep(const Params& P, int item, unsigned char* smem) {
  unsigned char* ws = P.ws;
  if (item < NTRANS) {
    int t = item;
    if (t < TJ0) { transpose_tile(P.in[I_EVWIN], EVC, (bf16_t*)(ws + OFF_WEVIN), 1024, 1024, EVC, t / 49, t % 49, smem); return; }
    t -= TJ0;
    if (t < TJ1) { transpose_tile(P.in[I_EVWOUT], 1024, (bf16_t*)(ws + OFF_WEVOUT), 1024, 1024, 1024, t / 16, t % 16, smem); return; }
    t -= TJ1;
    if (t < TJ2) { transpose_tile(P.in[I_ODWIN], ODC, (bf16_t*)(ws + OFF_WODIN), 1024, 1024, ODC, t / 44, t % 44, smem); return; }
    t -= TJ2;
    if (t < TJ3) { transpose_tile(P.in[I_ODWOUT], 1024, (bf16_t*)(ws + OFF_WODOUT), 1024, 1024, 1024, t / 16, t % 16, smem); return; }
    t -= TJ3;
    if (t < TJ4) {
      int l = t / 512, tt = t % 512;
      transpose_tile(P.in[I_WQ] + (size_t)l * 1024 * 2048, 2048, (bf16_t*)(ws + OFF_WQ) + (size_t)l * 2048 * 1024, 1024, 1024, 2048, tt / 32, tt % 32, smem);
      return;
    }
    t -= TJ4;
    if (t < TJ5) { int d = t / 8; transpose_tile(P.in[I_WUP] + d * 64 * 512, 512, (bf16_t*)(ws + OFF_WUP) + d * 512 * 64, 64, 64, 512, 0, t % 8, smem); return; }
    t -= TJ5;
    if (t < TJ6) { int d = t / 8; transpose_tile(P.in[I_AUP] + d * 64 * 512, 512, (bf16_t*)(ws + OFF_AUP) + d * 512 * 64, 64, 64, 512, 0, t % 8, smem); return; }
    t -= TJ6;
    if (t < TJ7) { transpose_tile(P.in[I_GUP], 512, (bf16_t*)(ws + OFF_GUP), 128, 128, 512, t / 8, t % 8, smem); return; }
    t -= TJ7;
    {
      int which = t & 1, db = t >> 1;
      const float* src = (which ? P.in[I_WI] : P.in[I_WA]) + (size_t)db * 64 * 64;
      transpose_tile(src, 64, (bf16_t*)(ws + OFF_LRUT) + (size_t)db * 128 * 64 + which * 64 * 64, 64, 64, 64, 0, 0, smem);
      return;
    }
  }
  item -= NTRANS;
  if (item < NKEYCV) {
    size_t e = ((size_t)item * 256 + threadIdx.x) * 8;
    const float* s = P.in[I_KEYS] + e;
    f32x4 a = *(const f32x4*)s, b = *(const f32x4*)(s + 4);
    float v[8] = {a.x, a.y, a.z, a.w, b.x, b.y, b.z, b.w};
    *(u32x4*)((bf16_t*)(ws + OFF_KEYS) + e) = pack8(v);
    return;
  }
  item -= NKEYCV;
  {
    const int l = item / 96, cgp = item % 96;
    float* sS = (float*)smem;
    float* sRed = sS + 3 * 1024;
    const int tid = threadIdx.x;
    __syncthreads();
    for (int i = tid; i < 3 * 1024; i += 256) {
      int m = i >> 10, k = i & 1023;
      float c = m < 2 ? P.in[I_C][m * 1024 + k] : P.in[I_CCTX][k];
      sS[i] = siluf_(c);
    }
    __syncthreads();
    const int ks = tid >> 6, col = cgp * 64 + (tid & 63);
    const float* w = P.in[I_MODW] + (size_t)l * 1024 * 6144 + col;
    float a0 = 0.f, a1 = 0.f, a2 = 0.f;
    for (int k = ks * 256; k < ks * 256 + 256; ++k) {
      float wv = w[(size_t)k * 6144];
      a0 += sS[k] * wv; a1 += sS[1024 + k] * wv; a2 += sS[2048 + k] * wv;
    }
    sRed[(ks * 3 + 0) * 64 + (tid & 63)] = a0;
    sRed[(ks * 3 + 1) * 64 + (tid & 63)] = a1;
    sRed[(ks * 3 + 2) * 64 + (tid & 63)] = a2;
    __syncthreads();
    if (tid < 192) {
      int m = tid >> 6, c = tid & 63;
      float s = sRed[(0 * 3 + m) * 64 + c] + sRed[(1 * 3 + m) * 64 + c] + sRed[(2 * 3 + m) * 64 + c] + sRed[(3 * 3 + m) * 64 + c];
      int cc = cgp * 64 + c;
      ((float*)(ws + OFF_MODV))[((size_t)l * 3 + m) * 6144 + cc] = s + P.in[I_MODB][l * 6144 + cc];
    }
  }
}

constexpr int NPCONV = 2 * (NEXP * 1024 / (256 * 16));
DEV void st_peer_conv(const Params& P, int layer, int item) {
  const int half = NPCONV / 2;
  int which = item >= half;
  int it = which ? item - half : item;
  size_t e = ((size_t)it * 256 + threadIdx.x) * 16;
  const float* s = (which ? P.in[I_PV] : P.in[I_PU]) + (size_t)layer * NEXP * 1024 + e;
  const float sc = which ? PEER_VSCALE : PEER_USCALE;
  float v16[16];
#pragma unroll
  for (int q = 0; q < 4; ++q) {
    f32x4 a = *(const f32x4*)(s + 4 * q);
    v16[4 * q] = a.x * sc; v16[4 * q + 1] = a.y * sc; v16[4 * q + 2] = a.z * sc; v16[4 * q + 3] = a.w * sc;
  }
  const size_t ex = e >> 10, col = e & 1023;
  if (which) {
    u32x2 o; o.x = pack8_fp4(v16); o.y = pack8_fp4(v16 + 8);
    *(u32x2*)(P.ws + OFF_PU + ex * PEER_ROWB + 1024 + (col >> 1)) = o;
  } else {
    u32x4 o;
    o.x = pack4_fp8(v16[0], v16[1], v16[2], v16[3]); o.y = pack4_fp8(v16[4], v16[5], v16[6], v16[7]);
    o.z = pack4_fp8(v16[8], v16[9], v16[10], v16[11]); o.w = pack4_fp8(v16[12], v16[13], v16[14], v16[15]);
    *(u32x4*)(P.ws + OFF_PU + ex * PEER_ROWB + col) = o;
  }
}

DEV void st_normmod(const Params& P, int layer, int which, int row) {
  const int lane = threadIdx.x & 63;
  const float* src;
  if (which == 0 && layer == 0) src = row < NCTX ? P.in[I_CTX] + (size_t)row * 1024 : P.in[I_X] + (size_t)(row - NCTX) * 1024;
  else src = row < NCTX ? (const float*)(P.ws + OFF_CTXRES) + (size_t)row * 1024 : P.out + (size_t)(row - NCTX) * 1024;
  const float* mv = (const float*)(P.ws + OFF_MODV) + ((size_t)layer * 3 + mod_row(row)) * 6144;
  const float* sh = mv + (which ? 3 : 0) * 1024;
  const float* sc = mv + (which ? 4 : 1) * 1024;
  const float* nw = (which ? P.in[I_NORM2] : P.in[I_NORM1]) + layer * 1024;
  f32x4 v[4];
  float ss = 0.f;
#pragma unroll
  for (int i = 0; i < 4; ++i) {
    v[i] = *(const f32x4*)(src + i * 256 + lane * 4);
    ss += v[i].x * v[i].x + v[i].y * v[i].y + v[i].z * v[i].z + v[i].w * v[i].w;
  }
  ss = wave_sum(ss);
  const float rstd = frsq(ss * (1.f / 1024.f) + 1e-6f);
  bf16_t* dst = (bf16_t*)(P.ws + OFF_HBUF) + (size_t)row * 1024;
#pragma unroll
  for (int i = 0; i < 4; ++i) {
    int c = i * 256 + lane * 4;
    f32x4 w4 = *(const f32x4*)(nw + c), s4 = *(const f32x4*)(sc + c), h4 = *(const f32x4*)(sh + c);
    float o0 = v[i].x * rstd * w4.x * (1.f + s4.x) + h4.x;
    float o1 = v[i].y * rstd * w4.y * (1.f + s4.y) + h4.y;
    float o2 = v[i].z * rstd * w4.z * (1.f + s4.z) + h4.z;
    float o3 = v[i].w * rstd * w4.w * (1.f + s4.w) + h4.w;
    u32x2 pk; pk.x = pack2(o0, o1); pk.y = pack2(o2, o3);
    *(u32x2*)(dst + c) = pk;
  }
}

struct EpiProjL0 {
  bf16_t* proj; float* gates;
  DEVM void operator()(int row, int col, float v) const {
    proj[(size_t)row * EVC + col] = f2bf(v);
    if (col >= 1536 && col < 1552) gates[row * 32 + (col - 1536)] = v;
    else if (col >= 3088) gates[row * 32 + 16 + (col - 3088)] = v;
  }
};
struct EpiStoreBf {
  bf16_t* dst; int ld;
  DEVM void operator()(int row, int col, float v) const { dst[(size_t)row * ld + col] = f2bf(v); }
};
struct EpiStoreBfBias {
  bf16_t* dst; int ld; const float* bias;
  DEVM void operator()(int row, int col, float v) const { dst[(size_t)row * ld + col] = f2bf(v + (bias ? bias[col] : 0.f)); }
};
struct EpiProjL0T {
  bf16_t* proj; float* gates;
  DEVM void operator()(int, int, float) const {}
  DEVM void store4(int n, int m, float v0, float v1, float v2, float v3) const {
    u32x2 pk; pk.x = pack2(v0, v1); pk.y = pack2(v2, v3);
    *(u32x2*)(proj + (size_t)m * EVC + n) = pk;
    if (n >= 1536 && n < 1552) { f32x4 g = {v0, v1, v2, v3}; *(f32x4*)(gates + m * 32 + (n - 1536)) = g; }
    else if (n >= 3088) { f32x4 g = {v0, v1, v2, v3}; *(f32x4*)(gates + m * 32 + 16 + (n - 3088)) = g; }
  }
};
struct EpiStoreBfT {
  bf16_t* dst; int ld;
  DEVM void operator()(int, int, float) const {}
  DEVM void store4(int n, int m, float v0, float v1, float v2, float v3) const {
    u32x2 pk; pk.x = pack2(v0, v1); pk.y = pack2(v2, v3);
    *(u32x2*)(dst + (size_t)m * ld + n) = pk;
  }
};
struct EpiOutProjT {
  const float* x_lat; const float* x_ctx; float* o_lat; float* o_ctx; const float* modv;
  DEVM void operator()(int, int, float) const {}
  DEVM void store4(int n, int m, float v0, float v1, float v2, float v3) const {
    const f32x4 g = *(const f32x4*)(modv + mod_row(m) * 6144 + 2 * 1024 + n);
    const float* xs; float* od;
    if (m < NCTX) { xs = x_ctx + (size_t)m * 1024 + n; od = o_ctx + (size_t)m * 1024 + n; }
    else { size_t o = (size_t)(m - NCTX) * 1024 + n; xs = x_lat + o; od = o_lat + o; }
    const f32x4 x = *(const f32x4*)xs;
    f32x4 r = {x.x + g.x * v0, x.y + g.y * v1, x.z + g.z * v2, x.w + g.w * v3};
    *(f32x4*)od = r;
  }
};
struct EpiStoreBfBiasT {
  bf16_t* dst; int ld; const float* bias;
  DEVM void operator()(int, int, float) const {}
  DEVM void store4(int n, int m, float v0, float v1, float v2, float v3) const {
    if (bias) { v0 += bias[n]; v1 += bias[n + 1]; v2 += bias[n + 2]; v3 += bias[n + 3]; }
    u32x2 pk; pk.x = pack2(v0, v1); pk.y = pack2(v2, v3);
    *(u32x2*)(dst + (size_t)m * ld + n) = pk;
  }
};
struct EpiOutProj {
  const float* x_lat; const float* x_ctx; float* o_lat; float* o_ctx; const float* modv;
  DEVM void operator()(int row, int col, float v) const {
    float g = modv[mod_row(row) * 6144 + 2 * 1024 + col];
    if (row < NCTX) o_ctx[(size_t)row * 1024 + col] = x_ctx[(size_t)row * 1024 + col] + g * v;
    else { size_t o = (size_t)(row - NCTX) * 1024 + col; o_lat[o] = x_lat[o] + g * v; }
  }
};
struct EpiScoreLds {
  float* sS; int m0;
  DEVM void operator()(int row, int col, float v) const { sS[(row - m0) * 129 + col] = v; }
};

DEV void st_xbc_conv(const Params& P, int row) {
  const int lane = threadIdx.x & 63;
  const bf16_t* proj = (const bf16_t*)(P.ws + OFF_PROJ);
  bf16_t* xc = (bf16_t*)P.out + (size_t)row * 1024;
  int row0, len, pos;
  if (row < NCTX) { row0 = (row / CTXL) * CTXL; len = CTXL; pos = row - row0; }
  else { int r = row - NCTX; row0 = NCTX + (r / SEQ) * SEQ; len = SEQ; pos = r % SEQ; }
  const float* cw = P.in[I_SCONVW];
  const float* cb = P.in[I_SCONVB];
#pragma unroll
  for (int hh = 0; hh < 2; ++hh) {
    const int ch = hh * 512 + lane * 8;
    float o[8];
#pragma unroll
    for (int j = 0; j < 8; ++j) o[j] = cb[ch + j];
#pragma unroll
    for (int tap = 0; tap < 4; ++tap) {
      int pp = pos + tap - 2;
      if (pp >= 0 && pp < len) {
        float x[8];
        unpack8(*(const u32x4*)(proj + (size_t)(row0 + pp) * EVC + 2064 + ch), x);
        f32x4 w0 = *(const f32x4*)(cw + tap * 1024 + ch), w1 = *(const f32x4*)(cw + tap * 1024 + ch + 4);
        o[0] += w0.x * x[0]; o[1] += w0.y * x[1]; o[2] += w0.z * x[2]; o[3] += w0.w * x[3];
        o[4] += w1.x * x[4]; o[5] += w1.y * x[5]; o[6] += w1.z * x[6]; o[7] += w1.w * x[7];
      }
    }
#pragma unroll
    for (int j = 0; j < 8; ++j) o[j] = siluf_(o[j]);
    *(u32x4*)(xc + ch) = pack8(o);
  }
}

#ifndef LA_NSEG
#define LA_NSEG 10
#endif
constexpr int LA_NCH = (CTXL + SEQ) / 64;
constexpr int LA_CPS = LA_NCH / LA_NSEG;
static_assert(LA_NCH % LA_NSEG == 0, "linattn segments");
#ifdef CPU_EMU
constexpr size_t OFF_LASEG = OFF_PR + PR_BYTES;
#else
constexpr size_t OFF_LASEG = OFF_R2L0 + (size_t)NTOK * 1024 * 2;
#endif
constexpr size_t LASEG_U = (size_t)48 * LA_NSEG * 8192 * 4;
constexpr size_t OFF_LASEG_N = OFF_LASEG + LASEG_U;
constexpr size_t OFF_LASEG_D = OFF_LASEG_N + (size_t)48 * LA_NSEG * 64 * 4;
#ifndef CPU_EMU
static_assert(OFF_LASEG_D + 48 * LA_NSEG * 4 <= OFF_PR + PR_BYTES, "laseg");
#endif

struct LaRaw { u32x4 q[2], k[4], x[4]; float g0, g1; };

template <bool MLSTM, bool FULL>
DEV void la_load_raw(const Params& P, int b, int h, int d, int cc, LaRaw& R) {
  constexpr int NC_CTX = CTXL / 64;
  const int tid = threadIdx.x;
  const int seg = cc >= NC_CTX;
  const int row0 = seg ? NCTX + b * SEQ : b * CTXL;
  const int len = seg ? SEQ : CTXL;
  const int cl = (seg ? cc - NC_CTX : cc) * 64;
  const bf16_t* proj = (const bf16_t*)(P.ws + OFF_PROJ);
  const bf16_t* xcv = (const bf16_t*)P.out;
  const float* gates = (const float*)(P.ws + OFF_GATES);
  if (tid < 64) {
    int p = cl + tid, grow = row0 + (d ? len - 1 - p : p);
    if (MLSTM) { R.g0 = gates[grow * 32 + d * 4 + h]; R.g1 = gates[grow * 32 + 8 + d * 4 + h]; }
    else { R.g0 = gates[grow * 32 + 16 + d * 8 + h]; R.g1 = 0.f; }
  }
  if (MLSTM) {
#pragma unroll
    for (int i = 0; i < 2; ++i) {
      int c = tid + i * 256, r = c >> 3, cc8 = (c & 7) * 8;
      int p = cl + r, pos = d ? len - 1 - p : p;
      const bf16_t* rp = proj + (size_t)(row0 + pos) * EVC;
      if (FULL) R.q[i] = *(const u32x4*)(rp + h * 64 + cc8);
      R.k[i] = *(const u32x4*)(rp + 256 + h * 64 + cc8);
    }
#pragma unroll
    for (int i = 0; i < 4; ++i) {
      int c = tid + i * 256, r = c >> 4, cc8 = (c & 15) * 8;
      int p = cl + r, pos = d ? len - 1 - p : p;
      R.x[i] = *(const u32x4*)(proj + (size_t)(row0 + pos) * EVC + 512 + h * 128 + cc8);
    }
  } else {
    const int grp = h >> 2;
#pragma unroll
    for (int i = 0; i < 2; ++i) {
      int c = tid + i * 256, r = c >> 3, cc8 = (c & 7) * 8;
      int p = cl + r, pos = d ? len - 1 - p : p;
      R.x[i] = *(const u32x4*)(xcv + (size_t)(row0 + pos) * 1024 + h * 64 + cc8);
    }
#pragma unroll
    for (int i = 0; i < 4; ++i) {
      int c = tid + i * 256, r = c >> 4, cc8 = (c & 15) * 8;
      int p = cl + r, pos = d ? len - 1 - p : p;
      const bf16_t* rp = xcv + (size_t)(row0 + pos) * 1024;
      R.k[i] = *(const u32x4*)(rp + 512 + grp * 128 + cc8);
      if (FULL) { if (i < 2) R.q[i] = *(const u32x4*)(rp + 768 + grp * 128 + cc8); else R.x[i] = *(const u32x4*)(rp + 768 + grp * 128 + cc8); }
    }
  }
}

template <bool MLSTM, bool FULL>
DEV void st_linattn_seg(const Params& P, int sid, int seg, unsigned char* smem) {
  constexpr int DK = MLSTM ? 64 : 128, DX = MLSTM ? 128 : 64;
  constexpr int QS = DK + 8;
  constexpr int NH = MLSTM ? 4 : 8;
  constexpr int NC_CTX = CTXL / 64;
  const int tid = threadIdx.x, lane = tid & 63, wave = tid >> 6;
  const int d = sid & 1, h = (sid >> 1) % NH, b = (sid >> 1) / NH;
  const int gsid = MLSTM ? sid : 16 + sid;
  bf16_t* sQ = (bf16_t*)smem;
  bf16_t* sK = sQ + 64 * QS;
  bf16_t* sP = sK;
  bf16_t* sKT = sK + 64 * QS;
  bf16_t* sXT = sKT + DK * 72;
  bf16_t* sST = sXT + DX * 72;
  float* sF = (float*)(sST + DX * QS);
  float* sLa = sF;
  float* sG = sF + 64;
  float* sBc = sF + 128;
  float* sDen = sF + 192;
  float* sN = sF + 256;
  int* sRow = (int*)(sF + 384);
  static_assert((64 * QS * 2 + DK * 72 + DX * 72 + DX * QS) * 2 + 448 * 4 <= SMEM_BYTES, "lds");
  bf16_t* outb = MLSTM ? (bf16_t*)(P.ws + OFF_HBUF) : (bf16_t*)(P.ws + OFF_R2L0);
  float* segU = (float*)(P.ws + OFF_LASEG);
  float* segN = (float*)(P.ws + OFF_LASEG_N);
  float* segD = (float*)(P.ws + OFF_LASEG_D);

  f32x16 accS[2];
#pragma unroll
  for (int j = 0; j < 2; ++j)
#pragma unroll
    for (int r = 0; r < 16; ++r) accS[j][r] = 0.f;
  const int sx0 = MLSTM ? wave * 32 : (wave >> 1) * 32;
  const int sk0 = MLSTM ? 0 : (wave & 1) * 64;
  float nreg = 0.f;
  float gb0 = 0.f, gb1 = 0.f, alog_e = 0.f, dskip = 0.f;
  if (MLSTM) { gb0 = P.in[I_IBIAS][d * 4 + h]; gb1 = P.in[I_FBIAS][d * 4 + h]; }
  else { gb0 = P.in[I_DTBIAS][d * 8 + h]; alog_e = fexp(P.in[I_ALOG][d * 8 + h]); dskip = P.in[I_DSKIP][h]; }

  const int cc0 = seg * LA_CPS, cc1 = cc0 + LA_CPS;
  LaRaw R;
  la_load_raw<MLSTM, FULL>(P, b, h, d, cc0, R);
  __syncthreads();
  if (FULL) {
    for (int js = 0; js < seg; ++js) {
      const size_t it = (size_t)gsid * LA_NSEG + js;
      const float a = fexp(segD[it]);
      const float* U = segU + it * 8192;
#pragma unroll
      for (int j = 0; j < 2; ++j)
#pragma unroll
        for (int r = 0; r < 16; ++r) accS[j][r] = a * accS[j][r] + U[(j * 16 + r) * 256 + tid];
      if (MLSTM && tid < 64) nreg = a * nreg + segN[it * 64 + tid];
    }
#pragma unroll
    for (int j = 0; j < 2; ++j)
#pragma unroll
      for (int r = 0; r < 16; ++r) sST[(sx0 + acc_row(r, lane)) * QS + sk0 + j * 32 + (lane & 31)] = f2bf(accS[j][r]);
    if (tid < 128) sN[tid] = (MLSTM && tid < 64) ? nreg : 0.f;
  }
  float lsum = 0.f;

  for (int cc = cc0; cc < cc1; ++cc) {
    int tl_ = threadIdx.x; OPAQUE(tl_);
    const int tid = tl_, lane = tl_ & 63;
    const int sgi = cc >= NC_CTX;
    const int row0 = sgi ? NCTX + b * SEQ : b * CTXL;
    const int len = sgi ? SEQ : CTXL;
    const int cl = (sgi ? cc - NC_CTX : cc) * 64;
    if (tid < 64) {
      int p = cl + tid;
      sRow[tid] = row0 + (d ? len - 1 - p : p);
      if (MLSTM) { sLa[tid] = -softplusf_(-(R.g1 + gb1)); sG[tid] = fexp(R.g0 + gb0); }
      else { float dt = softplusf_(R.g0 + gb0); sLa[tid] = -dt * alog_e; sG[tid] = dt; }
    }
    __syncthreads();
    if (wave == 0) {
      float v = sLa[lane];
#pragma unroll
      for (int off = 1; off < 64; off <<= 1) {
#ifdef CPU_EMU
        float o = emu_shfl_up(v, off);
#else
        float o = __shfl_up(v, off, 64);
#endif
        if (lane >= off) v += o;
      }
      sBc[lane] = v;
    }
    __syncthreads();
    const float blast = sBc[63];
    lsum += blast;
    if (MLSTM) {
#pragma unroll
      for (int i = 0; i < 2; ++i) {
        int c = tid + i * 256, r = c >> 3, cc8 = (c & 7) * 8;
        float kf[8]; unpack8(R.k[i], kf);
        const float wgt = fexp(blast - sBc[r]) * sG[r];
#pragma unroll
        for (int j = 0; j < 8; ++j) sKT[(cc8 + j) * 72 + r] = f2bf(kf[j] * wgt);
        if (FULL) {
          float qf[8]; unpack8(R.q[i], qf);
#pragma unroll
          for (int j = 0; j < 8; ++j) qf[j] *= 0.125f;
          *(u32x4*)(sQ + r * QS + cc8) = pack8(qf);
          *(u32x4*)(sK + r * QS + cc8) = R.k[i];
        }
      }
#pragma unroll
      for (int i = 0; i < 4; ++i) {
        int c = tid + i * 256, r = c >> 4, cc8 = (c & 15) * 8;
        const bf16_t* xs = (const bf16_t*)&R.x[i];
#pragma unroll
        for (int j = 0; j < 8; ++j) sXT[(cc8 + j) * 72 + r] = xs[j];
      }
    } else {
#pragma unroll
      for (int i = 0; i < 2; ++i) {
        int c = tid + i * 256, r = c >> 3, cc8 = (c & 7) * 8;
        const bf16_t* xs = (const bf16_t*)&R.x[i];
#pragma unroll
        for (int j = 0; j < 8; ++j) sXT[(cc8 + j) * 72 + r] = xs[j];
      }
#pragma unroll
      for (int i = 0; i < 4; ++i) {
        int c = tid + i * 256, r = c >> 4, cc8 = (c & 15) * 8;
        float kf[8]; unpack8(R.k[i], kf);
        const float wgt = fexp(blast - sBc[r]) * sG[r];
#pragma unroll
        for (int j = 0; j < 8; ++j) sKT[(cc8 + j) * 72 + r] = f2bf(kf[j] * wgt);
        if (FULL) {
          *(u32x4*)(sK + r * QS + cc8) = R.k[i];
          *(u32x4*)(sQ + r * QS + cc8) = i < 2 ? R.q[i] : R.x[i];
        }
      }
    }
    if (cc + 1 < cc1) la_load_raw<MLSTM, FULL>(P, b, h, d, cc + 1, R);
    __syncthreads();
    if (FULL) {
      const int tr = (wave >> 1) * 32, tc = (wave & 1) * 32;
      f32x16 accP;
#pragma unroll
      for (int r = 0; r < 16; ++r) accP[r] = 0.f;
      if (!(tr == 0 && tc == 32)) {
#pragma unroll
        for (int kk = 0; kk < DK / 16; ++kk) {
          const int ko = kk * 16 + 8 * (lane >> 5);
          bf16x8 a = *(const bf16x8*)(sQ + (tr + (lane & 31)) * QS + ko);
          bf16x8 bb = *(const bf16x8*)(sK + (tc + (lane & 31)) * QS + ko);
          accP = mfma32(a, bb, accP);
        }
      }
      __syncthreads();
      {
        const int s = tc + (lane & 31);
        const float bs = sBc[s], gs = sG[s];
#pragma unroll
        for (int r = 0; r < 16; ++r) {
          int t = tr + acc_row(r, lane);
          float v = (s <= t) ? accP[r] * fexp(sBc[t] - bs) * gs : 0.f;
          sP[t * 72 + s] = f2bf(v);
        }
        for (int i = tid; i < 64 * DK; i += 256) {
          int t = i / DK, k = i % DK;
          sQ[t * QS + k] = f2bf(bf2f(sQ[t * QS + k]) * fexp(sBc[t]));
        }
      }
      __syncthreads();
      constexpr int NYT = MLSTM ? 2 : 1;
      const int yx0 = MLSTM ? wave * 32 : (wave >> 1) * 32;
      const int yt0 = MLSTM ? 0 : (wave & 1) * 32;
      f32x16 accY[NYT];
#pragma unroll
      for (int j = 0; j < NYT; ++j)
#pragma unroll
        for (int r = 0; r < 16; ++r) accY[j][r] = 0.f;
#pragma unroll
      for (int kk = 0; kk < 4; ++kk) {
        const int ko = kk * 16 + 8 * (lane >> 5);
        bf16x8 a = *(const bf16x8*)(sXT + (yx0 + (lane & 31)) * 72 + ko);
#pragma unroll
        for (int j = 0; j < NYT; ++j) {
          bf16x8 bb = *(const bf16x8*)(sP + (yt0 + j * 32 + (lane & 31)) * 72 + ko);
          accY[j] = mfma32(a, bb, accY[j]);
        }
      }
#pragma unroll
      for (int kk = 0; kk < DK / 16; ++kk) {
        const int ko = kk * 16 + 8 * (lane >> 5);
        bf16x8 a = *(const bf16x8*)(sST + (yx0 + (lane & 31)) * QS + ko);
#pragma unroll
        for (int j = 0; j < NYT; ++j) {
          bf16x8 bb = *(const bf16x8*)(sQ + (yt0 + j * 32 + (lane & 31)) * QS + ko);
          accY[j] = mfma32(a, bb, accY[j]);
        }
      }
      if (MLSTM) {
        if (tid < 64) {
          float den = 0.f, dq = 0.f;
#pragma unroll 8
          for (int s = 0; s < 64; ++s) den += bf2f(sP[tid * 72 + s]);
#pragma unroll 8
          for (int k = 0; k < DK; ++k) dq += sN[k] * bf2f(sQ[tid * QS + k]);
          sDen[tid] = den + dq;
        }
        __syncthreads();
      }
#pragma unroll
      for (int j = 0; j < NYT; ++j) {
        const int t = yt0 + j * 32 + (lane & 31);
        const size_t obase = (size_t)sRow[t] * 1024 + d * 512 + h * DX;
        const float dinv = MLSTM ? frcp(fmaxf(fabsf(sDen[t]), 1.f)) : 1.f;
#pragma unroll
        for (int g = 0; g < 4; ++g) {
          const int x0 = yx0 + 8 * g + 4 * (lane >> 5);
          float v0 = accY[j][4 * g], v1 = accY[j][4 * g + 1], v2 = accY[j][4 * g + 2], v3 = accY[j][4 * g + 3];
          if (MLSTM) { v0 *= dinv; v1 *= dinv; v2 *= dinv; v3 *= dinv; }
          else if (d == 0) {
            v0 += dskip * bf2f(sXT[(x0 + 0) * 72 + t]); v1 += dskip * bf2f(sXT[(x0 + 1) * 72 + t]);
            v2 += dskip * bf2f(sXT[(x0 + 2) * 72 + t]); v3 += dskip * bf2f(sXT[(x0 + 3) * 72 + t]);
          }
          u32x2 pk; pk.x = pack2(v0, v1); pk.y = pack2(v2, v3);
          *(u32x2*)(outb + obase + x0) = pk;
        }
      }
      __syncthreads();
    }
    {
      const float eb = fexp(blast);
#pragma unroll
      for (int j = 0; j < 2; ++j)
#pragma unroll
        for (int r = 0; r < 16; ++r) accS[j][r] *= eb;
#pragma unroll
      for (int kk = 0; kk < 4; ++kk) {
        const int ko = kk * 16 + 8 * (lane >> 5);
        bf16x8 a = *(const bf16x8*)(sXT + (sx0 + (lane & 31)) * 72 + ko);
#pragma unroll
        for (int j = 0; j < 2; ++j) {
          bf16x8 bb = *(const bf16x8*)(sKT + (sk0 + j * 32 + (lane & 31)) * 72 + ko);
          accS[j] = mfma32(a, bb, accS[j]);
        }
      }
      if (FULL) {
#pragma unroll
        for (int j = 0; j < 2; ++j)
#pragma unroll
          for (int r = 0; r < 16; ++r) sST[(sx0 + acc_row(r, lane)) * QS + sk0 + j * 32 + (lane & 31)] = f2bf(accS[j][r]);
      }
      if (MLSTM && tid < 64) {
        float nn = nreg * eb;
        for (int s = 0; s < 64; ++s) nn += bf2f(sKT[tid * 72 + s]);
        nreg = nn;
        if (FULL) sN[tid] = nn;
      }
    }
    __syncthreads();
  }
  if (!FULL) {
    const size_t it = (size_t)gsid * LA_NSEG + seg;
    float* U = segU + it * 8192;
#pragma unroll
    for (int j = 0; j < 2; ++j)
#pragma unroll
      for (int r = 0; r < 16; ++r) U[(j * 16 + r) * 256 + tid] = accS[j][r];
    if (MLSTM && tid < 64) segN[it * 64 + tid] = nreg;
    if (tid == 0) segD[it] = lsum;
  }
}

DEV void st_finish_l0(const Params& P, int row) {
  const int lane = threadIdx.x & 63;
  bf16_t* hb = (bf16_t*)(P.ws + OFF_HBUF) + (size_t)row * 1024;
  const bf16_t* yb = (const bf16_t*)(P.ws + OFF_R2L0) + (size_t)row * 1024;
  const bf16_t* pr = (const bf16_t*)(P.ws + OFF_PROJ) + (size_t)row * EVC;
  const int ch = lane * 8;
  float h0[8], h1[8], o[8], f1[8];
  unpack8(*(const u32x4*)(hb + ch), h0);
  unpack8(*(const u32x4*)(hb + 512 + ch), h1);
  unpack8(*(const u32x4*)(pr + 1024 + ch), o);
  float ss = 0.f;
#pragma unroll
  for (int j = 0; j < 8; ++j) { h0[j] += h1[j]; ss += h0[j] * h0[j]; }
  ss += wshfl_xor(ss, 1); ss += wshfl_xor(ss, 2); ss += wshfl_xor(ss, 4); ss += wshfl_xor(ss, 8);
  float rstd = frsq(ss * (1.f / 128.f) + 1e-6f);
#pragma unroll
  for (int j = 0; j < 8; ++j) f1[j] = h0[j] * rstd * P.in[I_MNORM][ch + j] * sigmoidf_(o[j]);
  float y0[8], y1[8], z[8], f2[8];
  unpack8(*(const u32x4*)(yb + ch), y0);
  unpack8(*(const u32x4*)(yb + 512 + ch), y1);
  unpack8(*(const u32x4*)(pr + 1552 + ch), z);
  float s2 = 0.f;
#pragma unroll
  for (int j = 0; j < 8; ++j) { y0[j] = (y0[j] + y1[j]) * siluf_(z[j]); s2 += y0[j] * y0[j]; }
  s2 = wave_sum(s2);
  float rstd2 = frsq(s2 * (1.f / 512.f) + 1e-6f);
#pragma unroll
  for (int j = 0; j < 8; ++j) f2[j] = y0[j] * rstd2 * P.in[I_SNORM][ch + j];
  *(u32x4*)(hb + ch) = pack8(f1);
  *(u32x4*)(hb + 512 + ch) = pack8(f2);
}

DEV float mixval(const bf16_t* __restrict__ proj, int row, int c, const float* __restrict__ mu) {
  float self = bf2f(proj[(size_t)row * ODC + c]);
  int nrow = -1;
  if (row < NCTX) {
    int pos = row % CTXL;
    if (c < 896) { if (pos > 0) nrow = row - 1; }
    else { if (pos < CTXL - 1) nrow = row + 1; }
  } else {
    int pos = (row - NCTX) % SEQ;
    int gx = pos % GW, gy = pos / GW, q = c / 448;
    if (q == 0) { if (gx > 0) nrow = row - 1; }
    else if (q == 1) { if (gx < GW - 1) nrow = row + 1; }
    else if (q == 2) { if (gy > 0) nrow = row - GW; }
    else { if (gy < SEQ / GW - 1) nrow = row + GW; }
  }
  float nb = nrow >= 0 ? bf2f(proj[(size_t)nrow * ODC + c]) : 0.f;
  return self + mu[c] * (nb - self);
}

DEV void st_lora_act(const Params& P, int row) {
  const int lane = threadIdx.x & 63;
  const bf16_t* proj = (const bf16_t*)(P.ws + OFF_PROJ);
  bf16_t* hb = (bf16_t*)(P.ws + OFF_HBUF) + (size_t)row * 1024;
  float v[4];
#pragma unroll
  for (int j = 0; j < 4; ++j) {
    int c = lane * 4 + j;
    float x = mixval(proj, row, 1536 + c, P.in[I_MU]);
    v[j] = c < 64 ? tanhf_(x) : (c < 128 ? x : sigmoidf_(x));
  }
  u32x2 pk; pk.x = pack2(v[0], v[1]); pk.y = pack2(v[2], v[3]);
  *(u32x2*)(hb + lane * 4) = pk;
}

DEV void st_rwkv_stream(const Params& P, int sid, unsigned char* smem) {
  const int tid = threadIdx.x, lane = tid & 63, wave = tid >> 6;
  const int d = sid & 1, h = (sid >> 1) & 7, b = sid >> 4;
  float* sR = (float*)smem;
  float* sW = sR + 2048;
  float* sKk = sW + 2048;
  float* sV = sKk + 2048;
  float* sA = sV + 2048;
  float* sBb = sA + 2048;
  float* sY = sBb + 2048;
  int* sRow = (int*)(sY + 2048);
  const bf16_t* proj = (const bf16_t*)(P.ws + OFF_PROJ);
  const bf16_t* lora = (const bf16_t*)(P.ws + OFF_LORA);
  bf16_t* yout = (bf16_t*)(P.ws + OFF_HBUF);
  const float* mu = P.in[I_MU];
  const int vrow = tid >> 2, j4 = tid & 3;
  float S[16];
#pragma unroll
  for (int i = 0; i < 16; ++i) S[i] = 0.f;
  const float kkw = P.in[I_KK][h * 64 + lane], kaw = P.in[I_KA][h * 64 + lane];
  for (int seg = 0; seg < 2; ++seg) {
    const int row0 = seg == 0 ? b * CTXL : NCTX + b * SEQ;
    const int len = seg == 0 ? CTXL : SEQ;
    for (int it = 0; it < len / 32; ++it) {
      __syncthreads();
      for (int s = wave; s < 32; s += 4) {
        int p = it * 32 + s, pos = d ? len - 1 - p : p, row = row0 + pos;
        int c = h * 64 + lane;
        float r = mixval(proj, row, c, mu);
        float k = mixval(proj, row, 512 + c, mu);
        float v = mixval(proj, row, 1024 + c, mu);
        float kk = k * kkw;
        float ss = wave_sum(kk * kk);
        kk *= frsq(ss + 1e-12f);
        float lw = bf2f(lora[((size_t)d * NTOK + row) * 512 + c]);
        float la = bf2f(lora[((size_t)(2 + d) * NTOK + row) * 512 + c]);
        float w = fexp(-0.6065306597126334f * sigmoidf_(lw));
        float a = sigmoidf_(la);
        float kt = k * (1.f + (a - 1.f) * kaw);
        sR[s * 64 + lane] = r; sW[s * 64 + lane] = w; sKk[s * 64 + lane] = kt; sV[s * 64 + lane] = v;
        sA[s * 64 + lane] = -kk; sBb[s * 64 + lane] = kk * a;
        if (lane == 0) sRow[s] = row;
      }
      __syncthreads();
      for (int s = 0; s < 32; ++s) {
        const float* pa = sA + s * 64 + j4 * 16;
        const float* pw = sW + s * 64 + j4 * 16;
        const float* pk = sKk + s * 64 + j4 * 16;
        const float* pb = sBb + s * 64 + j4 * 16;
        const float* pr = sR + s * 64 + j4 * 16;
        const float vv = sV[s * 64 + vrow];
        float sa = 0.f;
#pragma unroll
        for (int i = 0; i < 16; ++i) sa += S[i] * pa[i];
        sa += wshfl_xor(sa, 1); sa += wshfl_xor(sa, 2);
        float y = 0.f;
#pragma unroll
        for (int i = 0; i < 16; ++i) { S[i] = S[i] * pw[i] + sa * pb[i] + vv * pk[i]; y += S[i] * pr[i]; }
        y += wshfl_xor(y, 1); y += wshfl_xor(y, 2);
        if (j4 == 0) sY[s * 64 + vrow] = y;
      }
      __syncthreads();
      for (int i = tid; i < 2048; i += 256) {
        int s = i >> 6, c = i & 63;
        yout[(size_t)sRow[s] * 1024 + d * 512 + h * 64 + c] = f2bf(sY[i]);
      }
    }
  }
}


DEV int nbr_row(int row, int c) {
  if (row < NCTX) {
    int pos = row % CTXL;
    if (c < 896) return pos > 0 ? row - 1 : -1;
    return pos < CTXL - 1 ? row + 1 : -1;
  }
  int pos = (row - NCTX) % SEQ;
  int gx = pos % GW, gy = pos / GW, q = c / 448;
  if (q == 0) return gx > 0 ? row - 1 : -1;
  if (q == 1) return gx < GW - 1 ? row + 1 : -1;
  if (q == 2) return gy > 0 ? row - GW : -1;
  return gy < SEQ / GW - 1 ? row + GW : -1;
}

struct RwkvRaw { u32x4 rs, rn, ks, kn, vs, vn, lw, la; int row; };

DEV void rwkv_load_raw(const bf16_t* __restrict__ proj, const bf16_t* __restrict__ lora, int b, int h, int d, int cc, int t, int c0,
                       RwkvRaw& R) {
  constexpr int NC_CTX = CTXL / 32;
  const int seg = cc >= NC_CTX;
  const int row0 = seg ? NCTX + b * SEQ : b * CTXL;
  const int len = seg ? SEQ : CTXL;
  const int p = (seg ? cc - NC_CTX : cc) * 32 + t;
  const int row = row0 + (d ? len - 1 - p : p);
  const int col = h * 64 + c0;
  const u32x4 z4 = {0u, 0u, 0u, 0u};
  const bf16_t* rp = proj + (size_t)row * ODC;
  R.row = row;
  R.rs = *(const u32x4*)(rp + col);
  R.ks = *(const u32x4*)(rp + 512 + col);
  R.vs = *(const u32x4*)(rp + 1024 + col);
  int n0 = nbr_row(row, col), n1 = nbr_row(row, 512 + col), n2 = nbr_row(row, 1024 + col);
  R.rn = n0 >= 0 ? *(const u32x4*)(proj + (size_t)n0 * ODC + col) : z4;
  R.kn = n1 >= 0 ? *(const u32x4*)(proj + (size_t)n1 * ODC + 512 + col) : z4;
  R.vn = n2 >= 0 ? *(const u32x4*)(proj + (size_t)n2 * ODC + 1024 + col) : z4;
  R.lw = *(const u32x4*)(lora + ((size_t)d * NTOK + row) * 512 + col);
  R.la = *(const u32x4*)(lora + ((size_t)(2 + d) * NTOK + row) * 512 + col);
}

#ifndef RW_NSEG
#define RW_NSEG 16
#endif
constexpr int RW_NCH = (CTXL + SEQ) / 32;
constexpr size_t OFF_RWSEG = OFF_PU;
static_assert((size_t)32 * RW_NSEG * 64 * 128 * 4 <= (size_t)2 * NEXP * 1024, "rwseg");

template <bool FULL>
DEV void st_rwkv_seg(const Params& P, int sid, int seg, unsigned char* smem) {
  constexpr int NVB = FULL ? 2 : 4;
  constexpr int ZR = FULL ? 64 : 128;
  const int tid = threadIdx.x, lane = tid & 63, wave = tid >> 6;
  const int d = sid & 1, h = (sid >> 1) & 7, b = sid >> 4;
  bf16_t* sAt = (bf16_t*)smem;
  bf16_t* sRt = sAt + 32 * 72;
  bf16_t* sBt = sRt + 32 * 72;
  bf16_t* sKt = sBt + 32 * 72;
  bf16_t* sBT = sKt + 32 * 72;
  bf16_t* sKT = sBT + 64 * 40;
  bf16_t* sVT = sKT + 64 * 40;
  bf16_t* sLak = sVT + 64 * 40;
  bf16_t* sM = sLak + 32 * 40;
  bf16_t* sLrb = sM + 32 * 40;
  bf16_t* sLrk = sLrb + 32 * 40;
  bf16_t* sZ = FULL ? sLrk + 32 * 40 : sLrb;
  bf16_t* after = sZ + ZR * 72;
  bf16_t* sRT = FULL ? after : nullptr;
  bf16_t* sSAT = FULL ? after + 64 * 40 : sRt;
  float* sLP = (float*)(FULL ? after + 2 * 64 * 40 : after);
  float* sLab = sLP + 32 * 64;
  float* sD = sLab + 32 * 33;
  float* sPT = sD + 768;
  int* sRow = (int*)(sPT + 64);
  if (!FULL) sRT = (bf16_t*)sLP;
  static_assert((4 * 32 * 72 + 3 * 64 * 40 + 4 * 32 * 40 + 2 * 64 * 40 + 64 * 72) * 2 + (32 * 64 + 32 * 33 + 768 + 64 + 32 + 320) * 4 + 16 <= SMEM_BYTES, "lds full");
  static_assert((4 * 32 * 72 + 3 * 64 * 40 + 2 * 32 * 40 + 128 * 72) * 2 + (32 * 64 + 32 * 33 + 768 + 64 + 32) * 4 <= SMEM_BYTES, "lds p1");
  static_assert(128 * 40 * 2 <= (32 * 64 + 32 * 33) * 4 && 128 * 40 <= 3 * 32 * 72, "alias");
  const bf16_t* proj = (const bf16_t*)(P.ws + OFF_PROJ);
  const bf16_t* lora = (const bf16_t*)(P.ws + OFF_LORA);
  bf16_t* yout = (bf16_t*)(P.ws + OFF_HBUF);
  float* segZ = (float*)(P.ws + OFF_RWSEG);
  const int t = tid >> 3, c0 = (tid & 7) * 8;
  const int hl = lane >> 5, l31 = lane & 31;
  float* sCst = (float*)(smem + SMEM_BYTES - 320 * 4 - 16);
  if (tid < 64) {
    sCst[tid] = P.in[I_MU][h * 64 + tid]; sCst[64 + tid] = P.in[I_MU][512 + h * 64 + tid]; sCst[128 + tid] = P.in[I_MU][1024 + h * 64 + tid];
    sCst[192 + tid] = P.in[I_KK][h * 64 + tid]; sCst[256 + tid] = P.in[I_KA][h * 64 + tid];
  }
  const int cc0 = (seg * RW_NCH) / RW_NSEG, cc1 = ((seg + 1) * RW_NCH) / RW_NSEG;
  RwkvRaw R;
  rwkv_load_raw(proj, lora, b, h, d, cc0, t, c0, R);
  f32x16 Zm[2];
#pragma unroll
  for (int j = 0; j < 2; ++j)
#pragma unroll
    for (int r = 0; r < 16; ++r) Zm[j][r] = 0.f;
  __syncthreads();
  for (int i = tid; i < ZR * 72; i += 256) sZ[i] = 0;
  __syncthreads();
  if (!FULL) {
    if (wave >= 2) {
#pragma unroll
      for (int cb = 0; cb < 2; ++cb)
#pragma unroll
        for (int r = 0; r < 16; ++r) {
          int c = cb * 32 + acc_row(r, lane), vp = wave * 32 + l31;
          if (c == vp - 64) { Zm[cb][r] = 1.f; sZ[vp * 72 + c] = 0x3f80; }
        }
    }
  } else {
    for (int js = 0; js < seg; ++js) {
      const float* Zs = segZ + ((size_t)sid * RW_NSEG + js) * 64 * 128;
      bf16_t* sG = sAt;
      for (int i = tid; i < 64 * 64; i += 256) { int c = i >> 6, c2 = i & 63; sG[c * 72 + c2] = f2bf(Zs[c * 128 + 64 + c2]); }
      __syncthreads();
      if (wave >= 2) {
        const int cb = wave - 2;
#pragma unroll
        for (int vb = 0; vb < 2; ++vb) {
          f32x16 acc;
#pragma unroll
          for (int r = 0; r < 16; ++r) acc[r] = Zs[(cb * 32 + acc_row(r, lane)) * 128 + vb * 32 + l31];
#pragma unroll
          for (int kk = 0; kk < 4; ++kk) {
            bf16x8 a = *(const bf16x8*)(sG + (cb * 32 + l31) * 72 + kk * 16 + 8 * hl);
            bf16x8 bb = *(const bf16x8*)(sZ + (vb * 32 + l31) * 72 + kk * 16 + 8 * hl);
            acc = mfma32(a, bb, acc);
          }
          Zm[vb] = acc;
        }
      }
      __syncthreads();
      if (wave >= 2) {
        const int cb = wave - 2;
#pragma unroll
        for (int vb = 0; vb < 2; ++vb)
#pragma unroll
          for (int g = 0; g < 4; ++g) {
            u32x2 pk; pk.x = pack2(Zm[vb][4 * g], Zm[vb][4 * g + 1]); pk.y = pack2(Zm[vb][4 * g + 2], Zm[vb][4 * g + 3]);
            *(u32x2*)(sZ + (vb * 32 + l31) * 72 + cb * 32 + 8 * g + 4 * hl) = pk;
          }
      }
      __syncthreads();
    }
  }
  for (int cc = cc0; cc < cc1; ++cc) {
    int tl_ = threadIdx.x; OPAQUE(tl_);
    const int tid = tl_, lane = tl_ & 63, hl = lane >> 5, l31 = lane & 31, t = tl_ >> 3, c0 = (tl_ & 7) * 8;
    const float* muR = sCst + c0; const float* muK = sCst + 64 + c0; const float* muV = sCst + 128 + c0;
    const float* kkw = sCst + 192 + c0; const float* kaw = sCst + 256 + c0;
    float lw8[8], lp8[8];
    {
      float lwf[8];
      unpack8(R.lw, lwf);
#pragma unroll
      for (int j = 0; j < 8; ++j) { lw8[j] = -0.6065306597126334f * sigmoidf_(lwf[j]); lp8[j] = lw8[j]; }
#pragma unroll
      for (int off = 8; off < 64; off <<= 1) {
#pragma unroll
        for (int j = 0; j < 8; ++j) {
#ifdef CPU_EMU
          float o = emu_shfl_up(lp8[j], off);
#else
          float o = __shfl_up(lp8[j], off, 64);
#endif
          if (lane >= off) lp8[j] += o;
        }
      }
      if (lane >= 56) {
#pragma unroll
        for (int j = 0; j < 8; ++j) sLP[wave * 64 + c0 + j] = lp8[j];
      }
      if ((tid & 7) == 0) sRow[t] = R.row;
    }
    __syncthreads();
    {
#pragma unroll
      for (int j = 0; j < 8; ++j) {
        float offs = 0.f;
        for (int w2 = 0; w2 < wave; ++w2) offs += sLP[w2 * 64 + c0 + j];
        lp8[j] += offs;
      }
      if (t == 31) {
#pragma unroll
        for (int j = 0; j < 8; ++j) sPT[c0 + j] = fexp(lp8[j]);
      }
    }
    {
      float xs[8], xn[8], kt[8], aa[8], ob[8], ok[8];
      unpack8(R.ks, xs); unpack8(R.kn, xn);
      float ss = 0.f;
#pragma unroll
      for (int j = 0; j < 8; ++j) { kt[j] = xs[j] + muK[j] * (xn[j] - xs[j]); aa[j] = kt[j] * kkw[j]; ss += aa[j] * aa[j]; }
      ss += wshfl_xor(ss, 1); ss += wshfl_xor(ss, 2); ss += wshfl_xor(ss, 4);
      const float rn = frsq(ss + 1e-12f);
      float laf[8];
      unpack8(R.la, laf);
#pragma unroll
      for (int j = 0; j < 8; ++j) {
        const float lp = lp8[j];
        const float lpm = lp8[j] - lw8[j];
        const float e = fexp(-lp);
        const float kkn = aa[j] * rn;
        const float asg = sigmoidf_(laf[j]);
        aa[j] = -kkn * fexp(lpm);
        ob[j] = kkn * asg * e;
        ok[j] = kt[j] * (1.f + (asg - 1.f) * kaw[j]) * e;
      }
      *(u32x4*)(sAt + t * 72 + c0) = pack8(aa);
      *(u32x4*)(sBt + t * 72 + c0) = pack8(ob);
      *(u32x4*)(sKt + t * 72 + c0) = pack8(ok);
#pragma unroll
      for (int j = 0; j < 8; ++j) { sBT[(c0 + j) * 40 + t] = f2bf(ob[j]); sKT[(c0 + j) * 40 + t] = f2bf(ok[j]); }
      unpack8(R.vs, xs); unpack8(R.vn, xn);
#pragma unroll
      for (int j = 0; j < 8; ++j) sVT[(c0 + j) * 40 + t] = f2bf(xs[j] + muV[j] * (xn[j] - xs[j]));
      if (FULL) {
        unpack8(R.rs, xs); unpack8(R.rn, xn);
#pragma unroll
        for (int j = 0; j < 8; ++j) xs[j] = (xs[j] + muR[j] * (xn[j] - xs[j])) * fexp(lp8[j]);
        *(u32x4*)(sRt + t * 72 + c0) = pack8(xs);
      }
    }
    if (cc + 1 < cc1) rwkv_load_raw(proj, lora, b, h, d, cc + 1, t, c0, R);
    __syncthreads();
    if (FULL || wave < 2) {
      const bf16_t* Asrc = wave < 2 ? sAt : sRt;
      const bf16_t* Bsrc = (wave & 1) ? sKt : sBt;
      f32x16 acc;
#pragma unroll
      for (int r = 0; r < 16; ++r) acc[r] = 0.f;
#pragma unroll
      for (int kk = 0; kk < 4; ++kk) {
        bf16x8 a = *(const bf16x8*)(Asrc + l31 * 72 + kk * 16 + 8 * hl);
        bf16x8 bb = *(const bf16x8*)(Bsrc + l31 * 72 + kk * 16 + 8 * hl);
        acc = mfma32(a, bb, acc);
      }
      bf16_t* dst = wave == 1 ? sLak : (wave == 2 ? sLrb : sLrk);
#pragma unroll
      for (int r = 0; r < 16; ++r) {
        int tt = acc_row(r, lane), j = l31;
        bool keep = wave < 2 ? (j < tt) : (j <= tt);
        float v = keep ? acc[r] : 0.f;
        if (wave == 0) sLab[tt * 33 + j] = v;
        else dst[tt * 40 + j] = f2bf(v);
      }
    }
    __syncthreads();
    if (tid < 32) {
      const int q = tid >> 4, c = tid & 15;
      float x[16];
#pragma unroll
      for (int i = 0; i < 16; ++i) {
        float sacc = (i == c) ? 1.f : 0.f;
#pragma unroll
        for (int j = 0; j < i; ++j) sacc += sLab[(q * 16 + i) * 33 + q * 16 + j] * x[j];
        x[i] = sacc;
        sD[q * 256 + i * 16 + c] = sacc;
      }
    }
    __syncthreads();
    {
      const int i = tid >> 4, c = tid & 15;
      float sacc = 0.f;
#pragma unroll
      for (int j = 0; j < 16; ++j) sacc += sLab[(16 + i) * 33 + j] * sD[j * 16 + c];
      sD[512 + i * 16 + c] = sacc;
    }
    __syncthreads();
    {
      const int i = tid >> 4, c = tid & 15;
      float sacc = 0.f;
#pragma unroll
      for (int j = 0; j < 16; ++j) sacc += sD[256 + i * 16 + j] * sD[512 + j * 16 + c];
      sM[(16 + i) * 40 + c] = f2bf(sacc);
      sM[i * 40 + c] = f2bf(sD[i * 16 + c]);
      sM[(16 + i) * 40 + 16 + c] = f2bf(sD[256 + i * 16 + c]);
      sM[i * 40 + 16 + c] = 0;
    }
    if (wave < NVB) {
      const int vb = wave;
      f32x16 acc;
#pragma unroll
      for (int r = 0; r < 16; ++r) acc[r] = 0.f;
#pragma unroll
      for (int kk = 0; kk < 4; ++kk) {
        bf16x8 a = *(const bf16x8*)(sAt + l31 * 72 + kk * 16 + 8 * hl);
        bf16x8 bb = *(const bf16x8*)(sZ + (vb * 32 + l31) * 72 + kk * 16 + 8 * hl);
        acc = mfma32(a, bb, acc);
      }
      if (vb < 2) {
#pragma unroll
        for (int kk = 0; kk < 2; ++kk) {
          bf16x8 a = *(const bf16x8*)(sLak + l31 * 40 + kk * 16 + 8 * hl);
          bf16x8 bb = *(const bf16x8*)(sVT + (vb * 32 + l31) * 40 + kk * 16 + 8 * hl);
          acc = mfma32(a, bb, acc);
        }
      }
#pragma unroll
      for (int g = 0; g < 4; ++g) {
        u32x2 pk; pk.x = pack2(acc[4 * g], acc[4 * g + 1]); pk.y = pack2(acc[4 * g + 2], acc[4 * g + 3]);
        *(u32x2*)(sRT + (vb * 32 + l31) * 40 + 8 * g + 4 * hl) = pk;
      }
    }
    __syncthreads();
    if (wave < NVB) {
      const int vb = wave;
      f32x16 acc;
#pragma unroll
      for (int r = 0; r < 16; ++r) acc[r] = 0.f;
#pragma unroll
      for (int kk = 0; kk < 2; ++kk) {
        bf16x8 a = *(const bf16x8*)(sM + l31 * 40 + kk * 16 + 8 * hl);
        bf16x8 bb = *(const bf16x8*)(sRT + (vb * 32 + l31) * 40 + kk * 16 + 8 * hl);
        acc = mfma32(a, bb, acc);
      }
#pragma unroll
      for (int g = 0; g < 4; ++g) {
        u32x2 pk; pk.x = pack2(acc[4 * g], acc[4 * g + 1]); pk.y = pack2(acc[4 * g + 2], acc[4 * g + 3]);
        *(u32x2*)(sSAT + (vb * 32 + l31) * 40 + 8 * g + 4 * hl) = pk;
      }
    }
    __syncthreads();
    if (FULL) {
      if (wave < 2) {
        const int vb = wave;
        f32x16 acc;
#pragma unroll
        for (int r = 0; r < 16; ++r) acc[r] = 0.f;
#pragma unroll
        for (int kk = 0; kk < 4; ++kk) {
          bf16x8 a = *(const bf16x8*)(sZ + (vb * 32 + l31) * 72 + kk * 16 + 8 * hl);
          bf16x8 bb = *(const bf16x8*)(sRt + l31 * 72 + kk * 16 + 8 * hl);
          acc = mfma32(a, bb, acc);
        }
#pragma unroll
        for (int kk = 0; kk < 2; ++kk) {
          bf16x8 a = *(const bf16x8*)(sSAT + (vb * 32 + l31) * 40 + kk * 16 + 8 * hl);
          bf16x8 bb = *(const bf16x8*)(sLrb + l31 * 40 + kk * 16 + 8 * hl);
          acc = mfma32(a, bb, acc);
        }
#pragma unroll
        for (int kk = 0; kk < 2; ++kk) {
          bf16x8 a = *(const bf16x8*)(sVT + (vb * 32 + l31) * 40 + kk * 16 + 8 * hl);
          bf16x8 bb = *(const bf16x8*)(sLrk + l31 * 40 + kk * 16 + 8 * hl);
          acc = mfma32(a, bb, acc);
        }
        {
          const size_t obase = (size_t)sRow[l31] * 1024 + d * 512 + h * 64 + vb * 32;
#pragma unroll
          for (int g = 0; g < 4; ++g) {
            u32x2 pk; pk.x = pack2(acc[4 * g], acc[4 * g + 1]); pk.y = pack2(acc[4 * g + 2], acc[4 * g + 3]);
            *(u32x2*)(yout + obase + 8 * g + 4 * hl) = pk;
          }
        }
      } else {
        const int cb = wave - 2;
#pragma unroll
        for (int vb = 0; vb < 2; ++vb) {
          f32x16 acc;
#pragma unroll
          for (int r = 0; r < 16; ++r) acc[r] = 0.f;
#pragma unroll
          for (int kk = 0; kk < 2; ++kk) {
            bf16x8 a = *(const bf16x8*)(sBT + (cb * 32 + l31) * 40 + kk * 16 + 8 * hl);
            bf16x8 bb = *(const bf16x8*)(sSAT + (vb * 32 + l31) * 40 + kk * 16 + 8 * hl);
            acc = mfma32(a, bb, acc);
          }
#pragma unroll
          for (int kk = 0; kk < 2; ++kk) {
            bf16x8 a = *(const bf16x8*)(sKT + (cb * 32 + l31) * 40 + kk * 16 + 8 * hl);
            bf16x8 bb = *(const bf16x8*)(sVT + (vb * 32 + l31) * 40 + kk * 16 + 8 * hl);
            acc = mfma32(a, bb, acc);
          }
#pragma unroll
          for (int r = 0; r < 16; ++r) Zm[vb][r] = sPT[cb * 32 + acc_row(r, lane)] * (Zm[vb][r] + acc[r]);
        }
      }
      __syncthreads();
      if (wave >= 2) {
        const int cb = wave - 2;
#pragma unroll
        for (int vb = 0; vb < 2; ++vb)
#pragma unroll
          for (int g = 0; g < 4; ++g) {
            u32x2 pk; pk.x = pack2(Zm[vb][4 * g], Zm[vb][4 * g + 1]); pk.y = pack2(Zm[vb][4 * g + 2], Zm[vb][4 * g + 3]);
            *(u32x2*)(sZ + (vb * 32 + l31) * 72 + cb * 32 + 8 * g + 4 * hl) = pk;
          }
      }
    } else {
      const int vb = wave;
#pragma unroll
      for (int cb = 0; cb < 2; ++cb) {
        f32x16 acc;
#pragma unroll
        for (int r = 0; r < 16; ++r) acc[r] = 0.f;
#pragma unroll
        for (int kk = 0; kk < 2; ++kk) {
          bf16x8 a = *(const bf16x8*)(sBT + (cb * 32 + l31) * 40 + kk * 16 + 8 * hl);
          bf16x8 bb = *(const bf16x8*)(sSAT + (vb * 32 + l31) * 40 + kk * 16 + 8 * hl);
          acc = mfma32(a, bb, acc);
        }
        if (vb < 2) {
#pragma unroll
          for (int kk = 0; kk < 2; ++kk) {
            bf16x8 a = *(const bf16x8*)(sKT + (cb * 32 + l31) * 40 + kk * 16 + 8 * hl);
            bf16x8 bb = *(const bf16x8*)(sVT + (vb * 32 + l31) * 40 + kk * 16 + 8 * hl);
            acc = mfma32(a, bb, acc);
          }
        }
#pragma unroll
        for (int r = 0; r < 16; ++r) Zm[cb][r] = sPT[cb * 32 + acc_row(r, lane)] * (Zm[cb][r] + acc[r]);
      }
#pragma unroll
      for (int cb = 0; cb < 2; ++cb)
#pragma unroll
        for (int g = 0; g < 4; ++g) {
          u32x2 pk; pk.x = pack2(Zm[cb][4 * g], Zm[cb][4 * g + 1]); pk.y = pack2(Zm[cb][4 * g + 2], Zm[cb][4 * g + 3]);
          *(u32x2*)(sZ + (vb * 32 + l31) * 72 + cb * 32 + 8 * g + 4 * hl) = pk;
        }
    }
  }
  if (!FULL) {
    float* Zs = segZ + ((size_t)sid * RW_NSEG + seg) * 64 * 128;
#pragma unroll
    for (int cb = 0; cb < 2; ++cb)
#pragma unroll
      for (int r = 0; r < 16; ++r) Zs[(cb * 32 + acc_row(r, lane)) * 128 + wave * 32 + l31] = Zm[cb][r];
  }
}

constexpr int LRU_NCH = (CTXL + SEQ) / 64;
constexpr size_t OFF_ACUM0 = OFF_PU;
static_assert((size_t)NLAT * 512 * 2 <= (size_t)2 * NEXP * 1024, "acum0");

DEV void st_lru_chunk(const Params& P, int sid, int cc, unsigned char* smem) {
  constexpr int NC_CTX = CTXL / 64;
  const int tid = threadIdx.x, lane = tid & 63, wave = tid >> 6;
  const int d = sid & 1, blk = (sid >> 1) & 7, b = sid >> 4;
  float* sXc = (float*)smem;
  float* sAc = sXc + 4096;
  float* sBc = sAc + 4096;
  float* sU = sBc + 4096;
  bf16_t* sAop = (bf16_t*)(sU + 4096);
  float* sQA = (float*)(sAop + 64 * 72);
  float* sQH = sQA + 256;
  int* sRow = (int*)(sQH + 256);
  const bf16_t* proj = (const bf16_t*)(P.ws + OFF_PROJ);
  bf16_t* uout = (bf16_t*)(P.ws + OFF_LORA) + (size_t)d * NTOK * 512;
  bf16_t* aout = (bf16_t*)(P.ws + (d ? OFF_ACUM1 : OFF_ACUM0));
  const bf16_t* lruT = (const bf16_t*)(P.ws + OFF_LRUT) + (size_t)(d * 8 + blk) * 128 * 64;
  float* chunkS = (float*)(P.ws + OFF_LRUCS) + ((size_t)sid * LRU_NCH + cc) * 128;
  const float* cw = P.in[I_LCONVW];
  const float* cb = P.in[I_LCONVB];
  const int tr = (wave >> 1) * 32, nc0 = (wave & 1) * 64;
  const int sgi = cc >= NC_CTX;
  const int row0 = sgi ? NCTX + b * SEQ : b * CTXL;
  const int len = sgi ? SEQ : CTXL;
  const int cl = (sgi ? cc - NC_CTX : cc) * 64;
  __syncthreads();
  if (tid < 64) { int p = cl + tid; sRow[tid] = row0 + (d ? len - 1 - p : p); }
  {
    const int lc8 = (tid & 7) * 8, lch = blk * 64 + lc8;
#pragma unroll
    for (int i = 0; i < 2; ++i) {
      int c = tid + i * 256, r = c >> 3;
      int p = cl + r, pos = d ? len - 1 - p : p;
      float o[8];
      f32x4 c0 = *(const f32x4*)(cb + lch), c1 = *(const f32x4*)(cb + lch + 4);
      o[0] = c0.x; o[1] = c0.y; o[2] = c0.z; o[3] = c0.w; o[4] = c1.x; o[5] = c1.y; o[6] = c1.z; o[7] = c1.w;
#pragma unroll
      for (int tap = 0; tap < 4; ++tap) {
        int pp = pos + tap - 2;
        if (pp >= 0 && pp < len) {
          float x[8];
          unpack8(*(const u32x4*)(proj + (size_t)(row0 + pp) * ODC + 2304 + lch), x);
          f32x4 w0 = *(const f32x4*)(cw + tap * 512 + lch), w1 = *(const f32x4*)(cw + tap * 512 + lch + 4);
          o[0] += w0.x * x[0]; o[1] += w0.y * x[1]; o[2] += w0.z * x[2]; o[3] += w0.w * x[3];
          o[4] += w1.x * x[4]; o[5] += w1.y * x[5]; o[6] += w1.z * x[6]; o[7] += w1.w * x[7];
        }
      }
#pragma unroll
      for (int j = 0; j < 8; ++j) sXc[r * 64 + lc8 + j] = o[j];
      *(u32x4*)(sAop + r * 72 + lc8) = pack8(o);
    }
  }
  __syncthreads();
  {
    f32x16 acc[2];
#pragma unroll
    for (int j = 0; j < 2; ++j)
#pragma unroll
      for (int r = 0; r < 16; ++r) acc[j][r] = 0.f;
#pragma unroll
    for (int kk = 0; kk < 4; ++kk) {
      bf16x8 a = *(const bf16x8*)(sAop + (tr + (lane & 31)) * 72 + kk * 16 + 8 * (lane >> 5));
#pragma unroll
      for (int j = 0; j < 2; ++j) {
        bf16x8 bb = *(const bf16x8*)(lruT + (nc0 + j * 32 + (lane & 31)) * 64 + kk * 16 + 8 * (lane >> 5));
        acc[j] = mfma32(a, bb, acc[j]);
      }
    }
#pragma unroll
    for (int j = 0; j < 2; ++j) {
      const int e = nc0 + j * 32 + (lane & 31);
      const int ch = blk * 64 + (e & 63);
      const float ebias = e < 64 ? P.in[I_BA][d * 512 + ch] : P.in[I_BI][d * 512 + ch];
      const float esp = softplusf_(-P.in[I_LAM][d * 512 + ch]);
#pragma unroll
      for (int r = 0; r < 16; ++r) {
        int t = tr + acc_row(r, lane);
        float g = sigmoidf_(acc[j][r] + ebias);
        if (e < 64) { float a_ = fexp(-8.f * g * esp); sAc[t * 64 + e] = a_; sU[t * 64 + e] = fsqrt(fmaxf(1.f - a_ * a_, 0.f)); }
        else sBc[t * 64 + (e - 64)] = g * sXc[t * 64 + (e - 64)];
      }
    }
  }
  __syncthreads();
  const int c = tid & 63, q = tid >> 6;
  {
    float h = 0.f, ap = 1.f;
#pragma unroll 4
    for (int i = 0; i < 16; ++i) {
      const int t = q * 16 + i;
      const float a = sAc[t * 64 + c];
      h = a * h + sU[t * 64 + c] * sBc[t * 64 + c];
      ap *= a;
      sU[t * 64 + c] = h; sAc[t * 64 + c] = ap;
    }
    sQA[q * 64 + c] = ap; sQH[q * 64 + c] = h;
  }
  __syncthreads();
  {
    float hin = 0.f, ain = 1.f;
    for (int q2 = 0; q2 < q; ++q2) { hin = sQA[q2 * 64 + c] * hin + sQH[q2 * 64 + c]; ain *= sQA[q2 * 64 + c]; }
    if (q > 0) {
#pragma unroll 4
      for (int i = 0; i < 16; ++i) {
        const int t = q * 16 + i;
        const float ap = sAc[t * 64 + c];
        sU[t * 64 + c] += ap * hin;
        sAc[t * 64 + c] = ap * ain;
      }
    }
    if (q == 3) { chunkS[c] = sAc[63 * 64 + c]; chunkS[64 + c] = sU[63 * 64 + c]; }
  }
  __syncthreads();
  if (sgi) {
#pragma unroll
    for (int i = 0; i < 2; ++i) {
      int cidx = tid + i * 256, r = cidx >> 3, c8 = (cidx & 7) * 8;
      float u8[8], a8[8];
#pragma unroll
      for (int j = 0; j < 8; ++j) { u8[j] = sU[r * 64 + c8 + j]; a8[j] = sAc[r * 64 + c8 + j]; }
      const int row = sRow[r];
      *(u32x4*)(uout + (size_t)row * 512 + blk * 64 + c8) = pack8(u8);
      *(u32x4*)(aout + (size_t)(row - NCTX) * 512 + blk * 64 + c8) = pack8(a8);
    }
  }
}

DEV void st_lru_carry(const Params& P, int sid) {
  const int c = threadIdx.x;
  if (c >= 64) return;
  const float* cs = (const float*)(P.ws + OFF_LRUCS) + (size_t)sid * LRU_NCH * 128;
  float* hs = (float*)(P.ws + OFF_LRUHS) + (size_t)sid * LRU_NCH * 64;
  float h = 0.f;
  for (int cc0 = 0; cc0 < LRU_NCH; cc0 += 10) {
    float a[10], bb[10];
#pragma unroll
    for (int i = 0; i < 10; ++i) { a[i] = cs[(size_t)(cc0 + i) * 128 + c]; bb[i] = cs[(size_t)(cc0 + i) * 128 + 64 + c]; }
#pragma unroll
    for (int i = 0; i < 10; ++i) { hs[(size_t)(cc0 + i) * 64 + c] = h; h = a[i] * h + bb[i]; }
  }
}

DEV void st_finish_l1(const Params& P, int row) {
  const int lane = threadIdx.x & 63;
  bf16_t* hb = (bf16_t*)(P.ws + OFF_HBUF) + (size_t)row * 1024;
  const bf16_t* proj = (const bf16_t*)(P.ws + OFF_PROJ);
  const bf16_t* lora = (const bf16_t*)(P.ws + OFF_LORA);
  const float* mu = P.in[I_MU];
  const int ch = lane * 8;
  float y0[8], y1[8];
  unpack8(*(const u32x4*)(hb + ch), y0);
  unpack8(*(const u32x4*)(hb + 512 + ch), y1);
  float sm = 0.f;
#pragma unroll
  for (int j = 0; j < 8; ++j) { y0[j] += y1[j]; sm += y0[j]; }
  sm += wshfl_xor(sm, 1); sm += wshfl_xor(sm, 2); sm += wshfl_xor(sm, 4);
  const float mean = sm * (1.f / 64.f);
  float sv = 0.f;
#pragma unroll
  for (int j = 0; j < 8; ++j) { float dlt = y0[j] - mean; sv += dlt * dlt; }
  sv += wshfl_xor(sv, 1); sv += wshfl_xor(sv, 2); sv += wshfl_xor(sv, 4);
  const float rstd = frsq(sv * (1.f / 64.f) + 64e-5f);
  float a0[8], a1[8], g[8], u0[8], u1[8], gb[8];
  unpack8(*(const u32x4*)(lora + ((size_t)2 * NTOK + row) * 512 + ch), a0);
  unpack8(*(const u32x4*)(lora + ((size_t)3 * NTOK + row) * 512 + ch), a1);
  unpack8(*(const u32x4*)(lora + ((size_t)4 * NTOK + row) * 512 + ch), g);
  unpack8(*(const u32x4*)(lora + ((size_t)0 * NTOK + row) * 512 + ch), u0);
  unpack8(*(const u32x4*)(lora + ((size_t)1 * NTOK + row) * 512 + ch), u1);
  if (row >= NCTX) {
    const int bb_ = (row - NCTX) / SEQ, pos = (row - NCTX) % SEQ, blk = ch >> 6;
    float ac[8];
#pragma unroll
    for (int dd = 0; dd < 2; ++dd) {
      const int pidx = dd ? SEQ - 1 - pos : pos;
      const int cc = CTXL / 64 + pidx / 64;
      const int sid = (bb_ * 8 + blk) * 2 + dd;
      const float* hs = (const float*)(P.ws + OFF_LRUHS) + ((size_t)sid * LRU_NCH + cc) * 64 + (ch & 63);
      unpack8(*(const u32x4*)((const bf16_t*)(P.ws + (dd ? OFF_ACUM1 : OFF_ACUM0)) + (size_t)(row - NCTX) * 512 + ch), ac);
      f32x4 h0 = *(const f32x4*)hs, h1 = *(const f32x4*)(hs + 4);
      float* u = dd ? u1 : u0;
      u[0] += ac[0] * h0.x; u[1] += ac[1] * h0.y; u[2] += ac[2] * h0.z; u[3] += ac[3] * h0.w;
      u[4] += ac[4] * h1.x; u[5] += ac[5] * h1.y; u[6] += ac[6] * h1.z; u[7] += ac[7] * h1.w;
    }
  }
  unpack8(*(const u32x4*)(proj + (size_t)row * ODC + 1792 + ch), gb);
  float rv[8], vv[8];
  float sdot = 0.f;
#pragma unroll
  for (int j = 0; j < 8; ++j) {
    float r = mixval(proj, row, ch + j, mu);
    float k = mixval(proj, row, 512 + ch + j, mu);
    vv[j] = mixval(proj, row, 1024 + ch + j, mu);
    float am = 0.5f * (sigmoidf_(a0[j]) + sigmoidf_(a1[j]));
    float kb = k * (1.f + (am - 1.f) * P.in[I_KA][ch + j]);
    sdot += r * kb * P.in[I_RK][ch + j];
    rv[j] = r;
  }
  sdot += wshfl_xor(sdot, 1); sdot += wshfl_xor(sdot, 2); sdot += wshfl_xor(sdot, 4);
  float f1[8], f2[8];
#pragma unroll
  for (int j = 0; j < 8; ++j) {
    float yn = (y0[j] - mean) * rstd * P.in[I_LNW][ch + j] + P.in[I_LNB][ch + j];
    yn += sdot * vv[j];
    f1[j] = yn * g[j];
    f2[j] = (u0[j] + u1[j]) * geluf_(gb[j]);
  }
  *(u32x4*)(hb + ch) = pack8(f1);
  *(u32x4*)(hb + 512 + ch) = pack8(f2);
}

DEV unsigned fkey(float f) { unsigned u; __builtin_memcpy(&u, &f, 4); return (u >> 31) ? ~u : (u | 0x80000000u); }
DEV float keyf(unsigned u) { u = (u >> 31) ? (u & 0x7fffffffu) : ~u; float f; __builtin_memcpy(&f, &u, 4); return f; }
DEV void key_insert(unsigned x, unsigned* v) {
#pragma unroll
  for (int j = 0; j < 16; ++j) { unsigned hi = v[j] > x ? v[j] : x; x = v[j] > x ? x : v[j]; v[j] = hi; }
}
DEV void key_cx(unsigned& hi, unsigned& lo) { unsigned a = hi, b = lo; hi = a > b ? a : b; lo = a > b ? b : a; }
DEV void key_sort16(unsigned* v) {
#pragma unroll
  for (int k = 2; k <= 16; k <<= 1)
#pragma unroll
    for (int j = k >> 1; j > 0; j >>= 1)
#pragma unroll
      for (int i = 0; i < 16; ++i) {
        const int l = i ^ j;
        if (l > i) { if ((i & k) == 0) key_cx(v[i], v[l]); else key_cx(v[l], v[i]); }
      }
}
DEV void key_merge16(unsigned* a, const unsigned* b) {
#pragma unroll
  for (int i = 0; i < 16; ++i) a[i] = a[i] > b[15 - i] ? a[i] : b[15 - i];
#pragma unroll
  for (int j = 8; j > 0; j >>= 1)
#pragma unroll
    for (int i = 0; i < 16; ++i) { const int l = i ^ j; if (l > i) key_cx(a[i], a[l]); }
}

DEV void st_peer_topk(const Params& P, int layer, int tile, int h, unsigned char* smem) {
  const int tid = threadIdx.x;
  const bf16_t* q = (const bf16_t*)(P.ws + OFF_Q);
  const bf16_t* keys = (const bf16_t*)(P.ws + OFF_KEYS) + (size_t)(layer * 8 + h) * 2 * 128 * 128;
  float* sS = (float*)smem;
  const int m0 = tile * 128;
  const int tok = tid & 127, half = tid >> 7;
  unsigned kl[2][16];
#pragma unroll
  for (int p = 0; p < 2; ++p) {
    EpiScoreLds epi{sS, m0};
    gemm_tile_128<true>(q + (h * 2 + p) * 128, 2048, NTOK, keys + p * 128 * 128, 128, 128, 128, m0, 0, epi, smem);
    __syncthreads();
    float* row = sS + tok * 129 + half * 64;
#pragma unroll
    for (int g = 0; g < 4; ++g) {
      unsigned grp[16];
#pragma unroll
      for (int j = 0; j < 16; ++j) grp[j] = (fkey(row[g * 16 + j]) & ~127u) | (unsigned)(127 - (half * 64 + g * 16 + j));
      key_sort16(grp);
      if (g == 0) {
#pragma unroll
        for (int j = 0; j < 16; ++j) kl[p][j] = grp[j];
      } else key_merge16(kl[p], grp);
    }
    if (half == 1) {
#pragma unroll
      for (int j = 0; j < 16; ++j) row[j] = __builtin_bit_cast(float, kl[p][j]);
    }
    __syncthreads();
    if (half == 0) {
      unsigned oth[16];
#pragma unroll
      for (int j = 0; j < 16; ++j) oth[j] = __builtin_bit_cast(unsigned, sS[tok * 129 + 64 + j]);
      key_merge16(kl[p], oth);
    }
    __syncthreads();
  }
  if (tid < 128) {
    float sv0[16], sv1[16];
    int* irow = (int*)(sS + tid * 129);
#pragma unroll
    for (int j = 0; j < 16; ++j) {
      sv0[j] = keyf((kl[0][j] & ~127u) | 64u); sv1[j] = keyf((kl[1][j] & ~127u) | 64u);
      irow[j] = 127 - (int)(kl[0][j] & 127u); irow[16 + j] = 127 - (int)(kl[1][j] & 127u);
    }
    unsigned best[16];
#pragma unroll
    for (int j = 0; j < 16; ++j) best[j] = 0u;
#pragma unroll
    for (int i = 0; i < 16; ++i)
#pragma unroll
      for (int j = 0; j < 16; ++j)
        if ((i + 1) * (j + 1) <= 16) key_insert((fkey(sv0[i] + sv1[j]) & ~255u) | (unsigned)(255 - (i * 16 + j)), best);
    float e[16], sum = 0.f;
    const float b0 = keyf((best[0] & ~255u) | 128u);
#pragma unroll
    for (int j = 0; j < 16; ++j) { e[j] = fexp(keyf((best[j] & ~255u) | 128u) - b0); sum += e[j]; }
    const float inv = 1.f / sum;
    int* pidx = (int*)(P.ws + OFF_PIDX) + (size_t)(m0 + tid) * 128 + h * 16;
    float* pg = (float*)(P.ws + OFF_PGATE) + (size_t)(m0 + tid) * 128 + h * 16;
#pragma unroll
    for (int j = 0; j < 16; ++j) {
      const int pos = 255 - (int)(best[j] & 255u);
      pidx[j] = irow[pos >> 4] * 128 + irow[16 + (pos & 15)];
      pg[j] = e[j] * inv;
    }
  }
}

DEV void st_peer_experts(const Params& P, int layer, int row) {
  const int lane = threadIdx.x & 63;
  const bf16_t* xb = (const bf16_t*)(P.ws + OFF_HBUF) + (size_t)row * 1024;
  const unsigned char* U = P.ws + OFF_PU;
  const int* pidx = (const int*)(P.ws + OFF_PIDX) + (size_t)row * 128;
  const float* pg = (const float*)(P.ws + OFF_PGATE) + (size_t)row * 128;
  float x[16], acc[16];
  unpack8(*(const u32x4*)(xb + lane * 16), x);
  unpack8(*(const u32x4*)(xb + lane * 16 + 8), x + 8);
#pragma unroll
  for (int j = 0; j < 16; ++j) acc[j] = 0.f;
  const int b5 = (lane >> 5) & 1, b4 = (lane >> 4) & 1, b3 = (lane >> 3) & 1;
  const int mypick = (lane >> 3) & 7;
  for (int k0 = 0; k0 < 128; k0 += 8) {
    u32x4 uu[8]; u32x2 vv[8];
#pragma unroll
    for (int i = 0; i < 8; ++i) {
      const unsigned char* er = U + (size_t)pidx[k0 + i] * PEER_ROWB;
      uu[i] = *(const u32x4*)(er + lane * 16);
      vv[i] = *(const u32x2*)(er + 1024 + lane * 8);
    }
    const float mygate = pg[k0 + mypick];
    float dsum[8];
#pragma unroll
    for (int i = 0; i < 8; ++i) {
      float uf[16];
      unpack16_fp8(uu[i], uf);
      float dd = 0.f;
#pragma unroll
      for (int j = 0; j < 16; ++j) dd += x[j] * uf[j];
      dsum[i] = dd;
    }
    float e4[4], e2[2], g;
#pragma unroll
    for (int i = 0; i < 4; ++i) {
      float mine = b5 ? dsum[4 + i] : dsum[i], send = b5 ? dsum[i] : dsum[4 + i];
      e4[i] = mine + wshfl_xor(send, 32);
    }
#pragma unroll
    for (int i = 0; i < 2; ++i) {
      float mine = b4 ? e4[2 + i] : e4[i], send = b4 ? e4[i] : e4[2 + i];
      e2[i] = mine + wshfl_xor(send, 16);
    }
    {
      float mine = b3 ? e2[1] : e2[0], send = b3 ? e2[0] : e2[1];
      g = mine + wshfl_xor(send, 8);
    }
    g += wshfl_xor(g, 4); g += wshfl_xor(g, 2); g += wshfl_xor(g, 1);
    const float mycoef = mygate * geluf_(g * (1.f / PEER_USCALE));
#pragma unroll
    for (int i = 0; i < 8; ++i) {
      const float coef = wreadlane(mycoef, i * 8);
      float vf[16];
      unpack8_fp4(vv[i].x, vf); unpack8_fp4(vv[i].y, vf + 8);
#pragma unroll
      for (int j = 0; j < 16; ++j) acc[j] += coef * vf[j];
    }
  }
  float* xr = row < NCTX ? (float*)(P.ws + OFF_CTXRES) + (size_t)row * 1024 : P.out + (size_t)(row - NCTX) * 1024;
  const float* g2 = (const float*)(P.ws + OFF_MODV) + ((size_t)layer * 3 + mod_row(row)) * 6144 + 5 * 1024;
  float o[16];
#pragma unroll
  for (int q = 0; q < 4; ++q) {
    const int c = lane * 16 + q * 4;
    f32x4 a = *(const f32x4*)(xr + c), ga = *(const f32x4*)(g2 + c);
    o[q * 4 + 0] = a.x + ga.x * acc[q * 4 + 0] * (1.f / PEER_VSCALE); o[q * 4 + 1] = a.y + ga.y * acc[q * 4 + 1] * (1.f / PEER_VSCALE);
    o[q * 4 + 2] = a.z + ga.z * acc[q * 4 + 2] * (1.f / PEER_VSCALE); o[q * 4 + 3] = a.w + ga.w * acc[q * 4 + 3] * (1.f / PEER_VSCALE);
  }
  float ss = 0.f;
#pragma unroll
  for (int j = 0; j < 16; ++j) ss += o[j] * o[j];
  ss = wave_sum(ss);
  const float rstd = frsq(ss * (1.f / 1024.f) + 1e-6f);
  if (layer == 1) {
#pragma unroll
    for (int j = 0; j < 16; ++j) o[j] *= rstd * P.in[I_FNORM][lane * 16 + j];
  }
#pragma unroll
  for (int q = 0; q < 4; ++q) {
    f32x4 a = {o[q * 4 + 0], o[q * 4 + 1], o[q * 4 + 2], o[q * 4 + 3]};
    *(f32x4*)(xr + lane * 16 + q * 4) = a;
  }
  if (layer == 0) {
    const float* mv = (const float*)(P.ws + OFF_MODV) + ((size_t)1 * 3 + mod_row(row)) * 6144;
    const float* nw = P.in[I_NORM1] + 1024;
    float hh[16];
#pragma unroll
    for (int q = 0; q < 4; ++q) {
      const int c = lane * 16 + q * 4;
      f32x4 w4 = *(const f32x4*)(nw + c), s4 = *(const f32x4*)(mv + 1024 + c), h4 = *(const f32x4*)(mv + c);
      hh[q * 4 + 0] = o[q * 4 + 0] * rstd * w4.x * (1.f + s4.x) + h4.x; hh[q * 4 + 1] = o[q * 4 + 1] * rstd * w4.y * (1.f + s4.y) + h4.y;
      hh[q * 4 + 2] = o[q * 4 + 2] * rstd * w4.z * (1.f + s4.z) + h4.z; hh[q * 4 + 3] = o[q * 4 + 3] * rstd * w4.w * (1.f + s4.w) + h4.w;
    }
    bf16_t* hb = (bf16_t*)(P.ws + OFF_HBUF) + (size_t)row * 1024 + lane * 16;
    *(u32x4*)hb = pack8(hh);
    *(u32x4*)(hb + 8) = pack8(hh + 8);
  }
}


#define FOR_TILES_XCD(MT0, MT1, NT, mt, nt)                                                     \
  for (int _x = blockIdx.x & 7, _mlo = (MT0) + (((MT1) - (MT0)) * _x) / 8,                        \
           _mhi = (MT0) + (((MT1) - (MT0)) * (_x + 1)) / 8, _i = blockIdx.x >> 3,                 \
           _cnt = (_mhi - _mlo) * (NT), mt = 0, nt = 0;                                           \
       _i < _cnt && ((mt = _mlo + _i / (NT)), (nt = _i % (NT)), true); _i += (int)(gridDim.x >> 3))

#ifndef PHASE_LIST
#define PHASE_LIST(X) X(0) X(1) X(2) X(22) X(23) X(3) X(4) X(5) X(6) X(7) X(8) X(9) X(11) X(12) X(13) X(30) X(14) X(15) X(31) X(16) X(17) X(18) X(19) X(20) X(21)
#endif
constexpr int PH_LAST = 21;

template <int ph>
DEV void run_phase(const Params& P, unsigned char* smem) {
  int bid_ = blockIdx.x, wave_ = threadIdx.x >> 6;
  OPAQUE_S(bid_); OPAQUE(wave_);
  const int bid = bid_, nb = gridDim.x;
  const int wave = wave_;
  unsigned char* ws = P.ws;
  constexpr int layer = ((ph >= 10 && ph <= 21) || ph >= 30) ? 1 : 0;
  const float* modv_l = (const float*)(ws + OFF_MODV) + (size_t)layer * 3 * 6144;
  switch (ph) {
    case 0:
      for (int t = NTRANS + bid; t < NPREP; t += nb) st_prep(P, t, smem);
      break;
    case 1: case 10:
      if (ph == 1) for (int t = nb - 1 - bid; t < NTRANS; t += nb) st_prep(P, t, smem);
      for (int t = bid; t < NTOK / 4; t += nb) st_normmod(P, layer, 0, t * 4 + wave);
      break;
    case 2: {
      EpiProjL0T epi{(bf16_t*)(ws + OFF_PROJ), (float*)(ws + OFF_GATES)};
      FOR_TILES_XCD(0, NTOK / 256, 25, mt, nt)
        gemm_tile_128x256<EpiProjL0T, true>((const bf16_t*)(ws + OFF_WEVIN), 1024, EVC, (const bf16_t*)(ws + OFF_HBUF), 1024, NTOK, 1024,
                                            nt * 128, mt * 256, epi, smem);
    } break;
    case 22:
      for (int t = bid; t < NTOK / 4; t += nb) st_xbc_conv(P, t * 4 + wave);
      for (int t = bid; t < NPCONV; t += nb) st_peer_conv(P, 0, t);
      break;
    case 23:
      for (int t = bid; t < 48 * LA_NSEG; t += nb) {
        int sid = t % 48, seg = t / 48;
        if (sid < 16) st_linattn_seg<true, false>(P, sid, seg, smem);
        else st_linattn_seg<false, false>(P, sid - 16, seg, smem);
      }
      break;
    case 3:
      for (int t = bid; t < 48 * LA_NSEG; t += nb) {
        int sid = t % 48, seg = t / 48;
        if (sid < 16) st_linattn_seg<true, true>(P, sid, seg, smem);
        else st_linattn_seg<false, true>(P, sid - 16, seg, smem);
      }
      break;
    case 4:
      for (int t = bid; t < NTOK / 4; t += nb) st_finish_l0(P, t * 4 + wave);
      break;
    case 5: case 17: {
      EpiOutProjT epi{layer == 0 ? P.in[I_X] : P.out, P.in[I_CTX], P.out, (float*)(ws + OFF_CTXRES), modv_l};
      const bf16_t* Wt = (const bf16_t*)(ws + (layer == 0 ? OFF_WEVOUT : OFF_WODOUT));
      FOR_TILES_XCD(layer == 0 ? 0 : NCTX / 256, NTOK / 256, 8, mt, nt)
        gemm_tile_128x256<EpiOutProjT, true>(Wt, 1024, 1024, (const bf16_t*)(ws + OFF_HBUF), 1024, NTOK, 1024, nt * 128, mt * 256, epi, smem);
    } break;
    case 6: case 18: {
      const int r0 = layer == 0 ? 0 : NCTX / 4;
      for (int t = r0 + bid; t < NTOK / 4; t += nb) st_normmod(P, layer, 1, t * 4 + wave);
      if (ph == 18) for (int t = bid; t < NPCONV; t += nb) st_peer_conv(P, 1, t);
    } break;
    case 7: case 19: {
      EpiStoreBfT epi{(bf16_t*)(ws + OFF_Q), 2048};
      const bf16_t* Wt = (const bf16_t*)(ws + OFF_WQ) + (size_t)layer * 2048 * 1024;
      FOR_TILES_XCD(layer == 0 ? 0 : NCTX / 256, NTOK / 256, 16, mt, nt)
        gemm_tile_128x256<EpiStoreBfT, true>(Wt, 1024, 2048, (const bf16_t*)(ws + OFF_HBUF), 1024, NTOK, 1024, nt * 128, mt * 256, epi, smem);
    } break;
    case 8: case 20: {
      const int t0 = layer == 0 ? 0 : CTILE * 8;
      for (int t = t0 + bid; t < NTILE * 8; t += nb) st_peer_topk(P, layer, t / 8, t % 8, smem);
    } break;
    case 9: case 21: {
      const int r0 = layer == 0 ? 0 : NCTX / 4;
      for (int t = r0 + bid; t < NTOK / 4; t += nb) st_peer_experts(P, layer, t * 4 + wave);
    } break;
    case 11: {
      EpiStoreBfT epi{(bf16_t*)(ws + OFF_PROJ), ODC};
      FOR_TILES_XCD(0, NTOK / 256, 22, mt, nt)
        gemm_tile_128x256<EpiStoreBfT, true>((const bf16_t*)(ws + OFF_WODIN), 1024, ODC, (const bf16_t*)(ws + OFF_HBUF), 1024, NTOK, 1024,
                                             nt * 128, mt * 256, epi, smem);
    } break;
    case 12:
      for (int t = bid; t < NTOK / 4; t += nb) st_lora_act(P, t * 4 + wave);
      break;
    case 13:
      for (int t = bid; t < NTILE * 20; t += nb) {
        int job = t / (NTILE * 4), tt = t % (NTILE * 4);
        int mt = tt / 4, nt = tt % 4;
        bf16_t* dst = (bf16_t*)(ws + OFF_LORA) + (size_t)job * NTOK * 512;
        const bf16_t* A = (const bf16_t*)(ws + OFF_HBUF) + (job < 2 ? 0 : (job < 4 ? 64 : 128));
        const bf16_t* Bt = job < 2 ? (const bf16_t*)(ws + OFF_WUP) + (size_t)job * 512 * 64
                         : job < 4 ? (const bf16_t*)(ws + OFF_AUP) + (size_t)(job - 2) * 512 * 64
                                   : (const bf16_t*)(ws + OFF_GUP);
        const float* bias = job < 2 ? P.in[I_W0] + job * 512 : (job < 4 ? P.in[I_A0] + (job - 2) * 512 : nullptr);
        const int K = job < 4 ? 64 : 128;
        EpiStoreBfBiasT epi{dst, 512, bias};
        gemm_tile_128<false, EpiStoreBfBiasT, true>(Bt, K, 512, A, 1024, NTOK, K, nt * 128, mt * 128, epi, smem);
      }
      break;
    case 30:
      for (int t = bid; t < 32 * RW_NSEG; t += nb) st_rwkv_seg<false>(P, t % 32, t / 32, smem);
      break;
    case 14:
      for (int t = bid; t < 32 * RW_NSEG; t += nb) st_rwkv_seg<true>(P, t % 32, t / 32, smem);
      break;
    case 15:
      for (int t = bid; t < 32 * LRU_NCH; t += nb) st_lru_chunk(P, t % 32, t / 32, smem);
      break;
    case 31:
      if (bid < 32) st_lru_carry(P, bid);
      break;
    case 16:
      for (int t = bid; t < NTOK / 4; t += nb) st_finish_l1(P, t * 4 + wave);
      break;
    default: break;
  }
}


#ifndef CPU_EMU
#define XB_TMO      128
#define XB_XCNT(j)  (256  + 64 * (j))
#define XB_XSUB(j)  (1280 + 64 * (j))
#define XB_XGEN(j)  (2304 + 64 * (j))
#define XB_TOP      3328
#define XB_TOPGEN   3392
#define XCD_BAR_WORDS 3456
#define XB_SPIN_CAP (1u << 20)
#define LAS __attribute__((address_space(3)))
__device__ __forceinline__ unsigned xb_ld(unsigned* p)              { return __hip_atomic_load(p, __ATOMIC_RELAXED, __HIP_MEMORY_SCOPE_AGENT); }
__device__ __forceinline__ unsigned xb_add(unsigned* p, unsigned v) { return __hip_atomic_fetch_add(p, v, __ATOMIC_RELAXED, __HIP_MEMORY_SCOPE_AGENT); }
__device__ __forceinline__ unsigned xb_xcc_id() { return (unsigned)__builtin_amdgcn_s_getreg((3 << 11) | 20) & 0xFu; }
#define XB_SPIN(cond, bar) do { unsigned _sp = 0; while (cond) { __builtin_amdgcn_s_sleep(1); \
    if ((++_sp & 255u) == 0u) { if (xb_ld(&(bar)[XB_TMO])) break; if (_sp > XB_SPIN_CAP) { atomicAdd(&(bar)[XB_TMO], 1u); break; } } } } while (0)
struct XcdBarrier { unsigned* bar; unsigned x; volatile LAS unsigned* st; };
__device__ __forceinline__ XcdBarrier xcd_barrier_post(unsigned* bar, volatile LAS unsigned* st) {
  XcdBarrier b; b.bar = bar; b.x = xb_xcc_id(); b.st = st;
  if (threadIdx.x == 0) (void)xb_add(&bar[XB_XCNT(b.x)], 1u);
  return b;
}
__device__ __forceinline__ void xcd_barrier_complete(unsigned* bar, unsigned x, unsigned& nloc, unsigned& nx) {
  const unsigned G = gridDim.x * gridDim.y * gridDim.z;
  unsigned sum, cnt, mine, sp = 0u;
  for (;;) {
    sum = 0u; cnt = 0u; mine = 0u;
#pragma unroll
    for (unsigned j = 0; j < 16; ++j) { const unsigned c = xb_ld(&bar[XB_XCNT(j)]); sum += c; cnt += (c > 0u) ? 1u : 0u; mine = (j == x) ? c : mine; }
    if (sum == G) break;
    __builtin_amdgcn_s_sleep(1);
    if ((++sp & 255u) == 0u) { if (xb_ld(&bar[XB_TMO])) break; if (sp > XB_SPIN_CAP) { atomicAdd(&bar[XB_TMO], 1u); break; } }
  }
  nloc = mine > 0u ? mine : 1u; nx = cnt > 0u ? cnt : 1u;
}
__device__ __forceinline__ void xcd_barrier(const XcdBarrier& b) {
  asm volatile("s_waitcnt vmcnt(0)" ::: "memory");
  __syncthreads();
  if (threadIdx.x == 0) {
    unsigned* bar = b.bar;
    __builtin_amdgcn_s_waitcnt(0);
    unsigned nloc = b.st[0], nx = b.st[1];
    if (nloc == 0u) { xcd_barrier_complete(bar, b.x, nloc, nx); b.st[0] = nloc; b.st[1] = nx; }
    const unsigned old = xb_add(&bar[XB_XSUB(b.x)], 1u);
    const unsigned gen = old / nloc;
    if (old + 1u == (gen + 1u) * nloc) {
      __builtin_amdgcn_fence(__ATOMIC_RELEASE, "agent");
      asm volatile("s_waitcnt vmcnt(0)" ::: "memory");
      const unsigned og = xb_add(&bar[XB_TOP], 1u);
      const unsigned tg = og / nx;
      if (og + 1u == (tg + 1u) * nx) xb_add(&bar[XB_TOPGEN], 1u);
      else XB_SPIN(xb_ld(&bar[XB_TOPGEN]) == tg, bar);
      __builtin_amdgcn_fence(__ATOMIC_ACQUIRE, "agent");
      xb_add(&bar[XB_XGEN(b.x)], 1u);
      asm volatile("s_waitcnt vmcnt(0)" ::: "memory");
    } else {
      XB_SPIN(xb_ld(&bar[XB_XGEN(b.x)]) == gen, bar);
      __builtin_amdgcn_fence(__ATOMIC_ACQUIRE, "agent");
      asm volatile("s_waitcnt vmcnt(0)" ::: "memory");
    }
  }
  __syncthreads();
}
#endif
#ifndef CPU_EMU
#define RUN_PH(n) run_phase<n>(P, smem_raw); if (n != PH_LAST) xcd_barrier(xb);
__global__ void __launch_bounds__(256, 2) mega_kernel(Params P) {
  SMEM_DECL;
  unsigned* bar = (unsigned*)(P.ws + OFF_BAR);
  volatile LAS unsigned* st = (volatile LAS unsigned*)(smem_raw + SMEM_BYTES - 16);
  if (threadIdx.x == 0) { st[0] = 0u; st[1] = 0u; }
  if (P.ws == nullptr) cg::this_grid().sync();
  __syncthreads();
  XcdBarrier xb = xcd_barrier_post(bar, st);
  PHASE_LIST(RUN_PH)
}

extern "C" void kernel_launch(void* const* d_in, const int* in_sizes, int n_in, void* d_out, int out_size, void* d_ws,
                              size_t ws_size, hipStream_t stream) {
  Params P{};
  for (int i = 0; i < N_IN; ++i) P.in[i] = (const float*)d_in[i];
  P.out = (float*)d_out;
  P.ws = (unsigned char*)d_ws;
  if (ws_size < WS_NEEDED) { fprintf(stderr, "workspace too small: %zu < %zu\n", ws_size, (size_t)WS_NEEDED); return; }
  static int grid_blocks = 0;
  if (!grid_blocks) {
    int dev = 0, cus = 0, per_cu = 0;
    hipGetDevice(&dev);
    hipDeviceGetAttribute(&cus, hipDeviceAttributeMultiprocessorCount, dev);
    hipOccupancyMaxActiveBlocksPerMultiprocessor(&per_cu, mega_kernel, 256, 0);
    if (per_cu > 2) per_cu = 2;
    grid_blocks = cus * per_cu;
  }
  (void)hipMemsetAsync((unsigned char*)d_ws + OFF_BAR, 0, 16384, stream);
  void* args[] = {&P};
  hipError_t e = hipLaunchCooperativeKernel((void*)mega_kernel, dim3(grid_blocks), dim3(256), args, 0, stream);
  if (e != hipSuccess) fprintf(stderr, "cooperative launch failed: %s (grid %d)\n", hipGetErrorString(e), grid_blocks);
}
#endif
```

```cpp
#ifdef CPU_EMU
#include "emu.h"
#else
#include <hip/hip_runtime.h>
#include <hip/hip_cooperative_groups.h>
#include <cstdio>
namespace cg = cooperative_groups;
#define DEV __device__ __forceinline__
#define DEVM __device__ __forceinline__
#define OPAQUE(x) asm volatile("" : "+v"(x))
#define OPAQUE_S(x) asm volatile("" : "+s"(x))
#endif

#ifndef SEQ_LEN
#define SEQ_LEN 16384
#endif
#ifndef CTX_LEN
#define CTX_LEN 256
#endif
#ifndef GRID_W_
#define GRID_W_ 64
#endif
#ifndef MULTI_LAUNCH
#define MULTI_LAUNCH 0
#endif

typedef unsigned short bf16_t;
typedef __attribute__((ext_vector_type(8))) short bf16x8;
typedef __attribute__((ext_vector_type(16))) float f32x16;
typedef __attribute__((ext_vector_type(4))) unsigned u32x4;
typedef __attribute__((ext_vector_type(2))) unsigned u32x2;
typedef __attribute__((ext_vector_type(4))) float f32x4;

constexpr int D = 1024, NB = 2, SEQ = SEQ_LEN, CTXL = CTX_LEN, GW = GRID_W_;
constexpr int NCTX = NB * CTXL, NLAT = NB * SEQ, NTOK = NCTX + NLAT;
constexpr int EVC = 3104, ODC = 2816;
constexpr int NEXP = 16384;
constexpr int NTILE = NTOK / 128, CTILE = NCTX / 128;
static_assert(NTOK % 256 == 0 && NCTX % 256 == 0, "tiles");
static_assert(CTXL % 64 == 0 && SEQ % 64 == 0 && SEQ % GW == 0, "chunks");

constexpr size_t al256(size_t x) { return (x + 255) & ~(size_t)255; }
constexpr size_t OFF_MODV = 0;
constexpr size_t OFF_CTXRES = OFF_MODV + al256(2 * 3 * 6144 * 4);
constexpr size_t OFF_GATES = OFF_CTXRES + al256((size_t)NCTX * 1024 * 4);
constexpr size_t OFF_WEVIN = OFF_GATES + al256((size_t)NTOK * 32 * 4);
constexpr size_t OFF_WEVOUT = OFF_WEVIN + al256((size_t)EVC * 1024 * 2);
constexpr size_t OFF_WODIN = OFF_WEVOUT + al256((size_t)1024 * 1024 * 2);
constexpr size_t OFF_WODOUT = OFF_WODIN + al256((size_t)ODC * 1024 * 2);
constexpr size_t OFF_WQ = OFF_WODOUT + al256((size_t)1024 * 1024 * 2);
constexpr size_t OFF_KEYS = OFF_WQ + al256((size_t)2 * 2048 * 1024 * 2);
constexpr size_t OFF_WUP = OFF_KEYS + al256((size_t)2 * 8 * 2 * 128 * 128 * 2);
constexpr size_t OFF_AUP = OFF_WUP + al256((size_t)2 * 512 * 64 * 2);
constexpr size_t OFF_GUP = OFF_AUP + al256((size_t)2 * 512 * 64 * 2);
constexpr size_t OFF_LRUT = OFF_GUP + al256((size_t)512 * 128 * 2);
constexpr size_t OFF_PU = OFF_LRUT + al256((size_t)2 * 8 * 128 * 64 * 2);
constexpr size_t OFF_PV = OFF_PU + al256((size_t)NEXP * 1024);
constexpr size_t OFF_HBUF = OFF_PV + al256((size_t)NEXP * 1024);
constexpr size_t OFF_PR = OFF_HBUF + al256((size_t)NTOK * 1024 * 2);
constexpr size_t PR_BYTES = (size_t)NTOK * 5376 * 2;
constexpr size_t OFF_BAR = OFF_PR + PR_BYTES;
constexpr size_t OFF_ACUM1 = OFF_BAR + 16384;
constexpr size_t OFF_LRUCS = OFF_ACUM1 + (size_t)NLAT * 512 * 2;
constexpr size_t OFF_LRUHS = OFF_LRUCS + (size_t)32 * ((CTXL + SEQ) / 64) * 128 * 4;
constexpr size_t WS_NEEDED = OFF_LRUHS + (size_t)32 * ((CTXL + SEQ) / 64) * 64 * 4;
#ifndef CPU_EMU
static_assert(WS_NEEDED <= (size_t)512 * 1024 * 1024, "workspace too large");
#endif
constexpr size_t OFF_PROJ = OFF_PR;
constexpr size_t OFF_R2L0 = OFF_PR + (size_t)NTOK * EVC * 2;
constexpr size_t OFF_LORA = OFF_PR + (size_t)NTOK * ODC * 2;
constexpr size_t OFF_Q = OFF_PR;
constexpr size_t OFF_PIDX = OFF_PR + (size_t)NTOK * 2048 * 2;
constexpr size_t OFF_PGATE = OFF_PIDX + (size_t)NTOK * 128 * 4;
static_assert(OFF_PGATE + (size_t)NTOK * 128 * 4 <= OFF_PR + PR_BYTES, "picks");

enum {
  I_X = 0, I_C, I_CTX, I_CCTX, I_MODW, I_MODB, I_NORM1, I_NORM2, I_WQ, I_KEYS, I_PU, I_PV,
  I_EVWIN, I_EVWOUT, I_IBIAS, I_FBIAS, I_MNORM, I_SCONVW, I_SCONVB, I_DTBIAS, I_ALOG, I_DSKIP, I_SNORM,
  I_ODWIN, I_ODWOUT, I_MU, I_W0, I_WUP, I_A0, I_AUP, I_GUP, I_KK, I_KA, I_RK, I_LNW, I_LNB,
  I_LCONVW, I_LCONVB, I_LAM, I_WA, I_BA, I_WI, I_BI, I_FNORM, N_IN
};

struct Params {
  const float* in[N_IN];
  float* out;
  unsigned char* ws;
};

constexpr int SMEM_BYTES = 80 * 1024;
#ifdef CPU_EMU
#define SMEM_DECL static thread_local __attribute__((aligned(16))) unsigned char smem_raw[SMEM_BYTES]
#else
#define SMEM_DECL __shared__ __attribute__((aligned(16))) unsigned char smem_raw[SMEM_BYTES]
#endif

DEV float bf2f(bf16_t v) { unsigned u = ((unsigned)v) << 16; float f; __builtin_memcpy(&f, &u, 4); return f; }
DEV bf16_t f2bf(float f) { unsigned u; __builtin_memcpy(&u, &f, 4); u += 0x7fffu + ((u >> 16) & 1u); return (bf16_t)(u >> 16); }
DEV unsigned pack2(float a, float b) { return (unsigned)f2bf(a) | ((unsigned)f2bf(b) << 16); }
DEV void unpack8(const u32x4& r, float* o) {
  unsigned w[4] = {r.x, r.y, r.z, r.w};
#pragma unroll
  for (int i = 0; i < 4; ++i) { unsigned lo = w[i] << 16, hi = w[i] & 0xffff0000u; __builtin_memcpy(&o[2 * i], &lo, 4); __builtin_memcpy(&o[2 * i + 1], &hi, 4); }
}
DEV u32x4 pack8(const float* o) { u32x4 r; r.x = pack2(o[0], o[1]); r.y = pack2(o[2], o[3]); r.z = pack2(o[4], o[5]); r.w = pack2(o[6], o[7]); return r; }
#ifdef CPU_EMU
DEV float fexp(float x) { return expf(x); }
DEV float frcp(float x) { return 1.f / x; }
DEV float flog(float x) { return logf(x); }
DEV float frsq(float x) { return 1.f / sqrtf(x); }
DEV float fsqrt(float x) { return sqrtf(x); }
#else
DEV float fexp(float x) { return __expf(x); }
DEV float frcp(float x) { return __builtin_amdgcn_rcpf(x); }
DEV float flog(float x) { return __logf(x); }
DEV float frsq(float x) { return __builtin_amdgcn_rsqf(x); }
DEV float fsqrt(float x) { return __builtin_amdgcn_sqrtf(x); }
#endif
DEV float sigmoidf_(float x) { return frcp(1.f + fexp(-x)); }
DEV float siluf_(float x) { return x * frcp(1.f + fexp(-x)); }
DEV float softplusf_(float x) { return fmaxf(x, 0.f) + flog(1.f + fexp(-fabsf(x))); }
DEV float tanhf_(float x) { return 1.f - 2.f * frcp(1.f + fexp(2.f * x)); }
DEV float geluf_(float x) { return 0.5f * x * (1.f + erff(x * 0.70710678118654752f)); }

DEV f32x16 mfma32(bf16x8 a, bf16x8 b, f32x16 c) {
#ifdef CPU_EMU
  return emu_mfma32(a, b, c);
#else
  return __builtin_amdgcn_mfma_f32_32x32x16_bf16(a, b, c, 0, 0, 0);
#endif
}
DEV float wshfl_xor(float v, int m) {
#ifdef CPU_EMU
  return emu_shfl_xor(v, m);
#else
  return __shfl_xor(v, m, 64);
#endif
}
DEV float wave_sum(float v) {
#pragma unroll
  for (int m = 32; m >= 1; m >>= 1) v += wshfl_xor(v, m);
  return v;
}

#ifdef CPU_EMU
static inline unsigned emu_f2fp8(float f) {
  unsigned sgn = f < 0.f ? 0x80u : 0u; float a = fabsf(f);
  if (!(a == a)) return 0x7f;
  if (a >= 448.f) return sgn | 0x7e;
  if (a < 0.0009765625f) return sgn;
  int e; frexpf(a, &e); e -= 1;
  if (e < -6) { int q = (int)nearbyintf(a * 512.f); return sgn | (unsigned)q; }
  float m = a / ldexpf(1.f, e);
  int q = (int)nearbyintf((m - 1.f) * 8.f);
  if (q == 8) { q = 0; e += 1; }
  if (e > 8) return sgn | 0x7e;
  return sgn | (unsigned)((e + 7) << 3) | (unsigned)q;
}
static inline float emu_fp82f(unsigned c) {
  unsigned sgn = c & 0x80, e = (c >> 3) & 15, m = c & 7;
  float v = e == 0 ? ldexpf((float)m, -9) : ldexpf(1.f + m / 8.f, (int)e - 7);
  return sgn ? -v : v;
}
#endif
DEV unsigned pack4_fp8(float a, float b, float c, float d) {
#ifdef CPU_EMU
  return emu_f2fp8(a) | (emu_f2fp8(b) << 8) | (emu_f2fp8(c) << 16) | (emu_f2fp8(d) << 24);
#else
  int w = 0;
  w = __builtin_amdgcn_cvt_pk_fp8_f32(a, b, w, false);
  w = __builtin_amdgcn_cvt_pk_fp8_f32(c, d, w, true);
  return (unsigned)w;
#endif
}
DEV void unpack4_fp8(unsigned w, float* o) {
#ifdef CPU_EMU
  o[0] = emu_fp82f(w & 255); o[1] = emu_fp82f((w >> 8) & 255); o[2] = emu_fp82f((w >> 16) & 255); o[3] = emu_fp82f(w >> 24);
#else
  typedef __attribute__((ext_vector_type(2))) float f32x2_;
  f32x2_ lo = __builtin_amdgcn_cvt_pk_f32_fp8((int)w, false);
  f32x2_ hi = __builtin_amdgcn_cvt_pk_f32_fp8((int)w, true);
  o[0] = lo.x; o[1] = lo.y; o[2] = hi.x; o[3] = hi.y;
#endif
}
DEV void unpack16_fp8(const u32x4& r, float* o) { unpack4_fp8(r.x, o); unpack4_fp8(r.y, o + 4); unpack4_fp8(r.z, o + 8); unpack4_fp8(r.w, o + 12); }
DEV float wreadlane(float v, int srclane) {
#ifdef CPU_EMU
  return emu_readlane(v, srclane);
#else
  int iv; __builtin_memcpy(&iv, &v, 4);
  int r = __builtin_amdgcn_readlane(iv, srclane);
  float f; __builtin_memcpy(&f, &r, 4); return f;
#endif
}
constexpr float PEER_USCALE = 64.f, PEER_VSCALE = 4.f;
#ifdef CPU_EMU
static inline unsigned emu_f2fp4(float f) {
  static const float lv[8] = {0.f, 0.5f, 1.f, 1.5f, 2.f, 3.f, 4.f, 6.f};
  unsigned sgn = f < 0.f ? 8u : 0u; float a = fabsf(f);
  int best = 0; float bd = 1e30f;
  for (int i = 0; i < 8; ++i) { float dd = fabsf(a - lv[i]); if (dd < bd || (dd == bd && (i & 1) == 0)) { bd = dd; best = i; } }
  return sgn | (unsigned)best;
}
static inline float emu_fp42f(unsigned c) {
  static const float lv[8] = {0.f, 0.5f, 1.f, 1.5f, 2.f, 3.f, 4.f, 6.f};
  float v = lv[c & 7]; return (c & 8) ? -v : v;
}
#endif
DEV unsigned pack8_fp4(const float* v) {
#ifdef CPU_EMU
  unsigned w = 0;
  for (int i = 0; i < 8; ++i) w |= emu_f2fp4(v[i]) << (4 * i);
  return w;
#else
  unsigned w = 0;
  w = __builtin_amdgcn_cvt_scalef32_pk_fp4_f32(w, v[0], v[1], 1.0f, 0);
  w = __builtin_amdgcn_cvt_scalef32_pk_fp4_f32(w, v[2], v[3], 1.0f, 1);
  w = __builtin_amdgcn_cvt_scalef32_pk_fp4_f32(w, v[4], v[5], 1.0f, 2);
  w = __builtin_amdgcn_cvt_scalef32_pk_fp4_f32(w, v[6], v[7], 1.0f, 3);
  return w;
#endif
}
DEV void unpack8_fp4(unsigned w, float* o) {
#ifdef CPU_EMU
  for (int i = 0; i < 8; ++i) o[i] = emu_fp42f((w >> (4 * i)) & 15u);
#else
  typedef __attribute__((ext_vector_type(2))) float f32x2_;
  f32x2_ a = __builtin_amdgcn_cvt_scalef32_pk_f32_fp4(w, 1.0f, 0);
  f32x2_ b = __builtin_amdgcn_cvt_scalef32_pk_f32_fp4(w, 1.0f, 1);
  f32x2_ c = __builtin_amdgcn_cvt_scalef32_pk_f32_fp4(w, 1.0f, 2);
  f32x2_ d = __builtin_amdgcn_cvt_scalef32_pk_f32_fp4(w, 1.0f, 3);
  o[0] = a.x; o[1] = a.y; o[2] = b.x; o[3] = b.y; o[4] = c.x; o[5] = c.y; o[6] = d.x; o[7] = d.y;
#endif
}
typedef __attribute__((ext_vector_type(3))) unsigned u32x3;
#ifndef FP6_INTERLEAVED
#define FP6_INTERLEAVED 1
#endif
#ifdef CPU_EMU
static inline unsigned emu_f2fp6(float f) {
  unsigned sgn = f < 0.f ? 32u : 0u; float a = fabsf(f);
  if (a >= 7.5f) return sgn | 31u;
  int e; unsigned code;
  if (a < 1.f) { int q = (int)nearbyintf(a * 8.f); code = (unsigned)q; }
  else { frexpf(a, &e); e -= 1; float m = a / ldexpf(1.f, e); int q = (int)nearbyintf((m - 1.f) * 8.f); if (q == 8) { q = 0; e += 1; } code = (unsigned)(((e + 1) << 3) | q); if (e > 2) code = 31u; }
  return sgn | code;
}
static inline float emu_fp62f(unsigned c) {
  unsigned e = (c >> 3) & 3, m = c & 7;
  float v = e == 0 ? m * 0.125f : ldexpf(1.f + m / 8.f, (int)e - 1);
  return (c & 32) ? -v : v;
}
#endif
DEV u32x3 pack16_fp6(const float* v) {
#ifdef CPU_EMU
  unsigned long long lo = 0; unsigned hi = 0;
  for (int i = 0; i < 16; ++i) {
    unsigned long long c = emu_f2fp6(v[i]); int bit = 6 * i;
    if (bit < 64) { lo |= c << bit; if (bit > 58) hi |= (unsigned)(c >> (64 - bit)); } else hi |= (unsigned)(c << (bit - 64));
  }
  u32x3 r; r.x = (unsigned)lo; r.y = (unsigned)(lo >> 32); r.z = hi; return r;
#else
  typedef __attribute__((ext_vector_type(6))) unsigned u32x6_;
  f32x16 a, b;
#if FP6_INTERLEAVED
#pragma unroll
  for (int i = 0; i < 8; ++i) { a[i] = v[2 * i]; b[i] = v[2 * i + 1]; a[8 + i] = 0.f; b[8 + i] = 0.f; }
#else
#pragma unroll
  for (int i = 0; i < 16; ++i) { a[i] = v[i]; b[i] = 0.f; }
#endif
  u32x6_ w = __builtin_amdgcn_cvt_scalef32_2xpk16_fp6_f32(a, b, 1.0f);
  u32x3 r; r.x = w[0]; r.y = w[1]; r.z = w[2]; return r;
#endif
}
DEV void unpack16_fp6(const u32x3& r, float* o) {
#ifdef CPU_EMU
  unsigned long long lo = (unsigned long long)r.x | ((unsigned long long)r.y << 32); unsigned hi = r.z;
  for (int i = 0; i < 16; ++i) {
    int bit = 6 * i; unsigned c;
    if (bit + 6 <= 64) c = (unsigned)(lo >> bit) & 63u;
    else if (bit >= 64) c = (hi >> (bit - 64)) & 63u;
    else c = ((unsigned)(lo >> bit) | (hi << (64 - bit))) & 63u;
    o[i] = emu_fp62f(c);
  }
#else
  typedef __attribute__((ext_vector_type(6))) unsigned u32x6_;
  typedef __attribute__((ext_vector_type(32))) float f32x32_;
  u32x6_ w; w[0] = r.x; w[1] = r.y; w[2] = r.z; w[3] = 0u; w[4] = 0u; w[5] = 0u;
  f32x32_ f = __builtin_amdgcn_cvt_scalef32_pk32_f32_fp6(w, 1.0f);
#pragma unroll
  for (int i = 0; i < 16; ++i) o[i] = f[i];
#endif
}
constexpr int PEER_ROWB = 1280;
constexpr int PEER_VOFF = 768;


DEV int acc_row(int reg, int lane) { return (reg & 3) + 8 * (reg >> 2) + 4 * (lane >> 5); }

DEV int mod_row(int row) { return row < NCTX ? 2 : (row - NCTX) / SEQ; }

template <bool SYNC_EPI, class Epi, bool VEC4 = false>
DEV void gemm_tile_128(const bf16_t* __restrict__ A, int lda, int M, const bf16_t* __restrict__ Bt, int ldb, int N,
                       int K, int m0, int n0, const Epi& epi, unsigned char* smem) {
  constexpr int LS = 72;
  constexpr int STAGE = 2 * 128 * LS;
  bf16_t* sbase = (bf16_t*)smem;
  const int wave = threadIdx.x >> 6;
  const int wm = (wave >> 1) * 64, wn = (wave & 1) * 64;
  f32x16 acc[2][2];
#pragma unroll
  for (int i = 0; i < 2; ++i)
#pragma unroll
    for (int j = 0; j < 2; ++j)
#pragma unroll
      for (int r = 0; r < 16; ++r) acc[i][j][r] = 0.f;
  u32x4 ra[4], rb[4];
  auto gload = [&](int k0) {
    int tl_ = threadIdx.x; OPAQUE(tl_);
#pragma unroll
    for (int i = 0; i < 4; ++i) {
      int c = tl_ + i * 256, r = c >> 3, cc = (c & 7) * 8;
      int gr = m0 + r, gn = n0 + r;
      gr = gr < M ? gr : M - 1; gn = gn < N ? gn : N - 1;
      ra[i] = *(const u32x4*)(A + (size_t)gr * lda + k0 + cc);
      rb[i] = *(const u32x4*)(Bt + (size_t)gn * ldb + k0 + cc);
    }
  };
  auto lwrite = [&](int buf) {
    int tl_ = threadIdx.x; OPAQUE(tl_);
    bf16_t* sA = sbase + buf * STAGE;
    bf16_t* sB = sA + 128 * LS;
#pragma unroll
    for (int i = 0; i < 4; ++i) {
      int c = tl_ + i * 256, r = c >> 3, cc = (c & 7) * 8;
      *(u32x4*)(sA + r * LS + cc) = ra[i];
      *(u32x4*)(sB + r * LS + cc) = rb[i];
    }
  };
  const int nk = K >> 6;
  gload(0);
  __syncthreads();
  lwrite(0);
  if (nk > 1) gload(64);
  __syncthreads();
  for (int it = 0; it < nk; ++it) {
    int tl_ = threadIdx.x; OPAQUE(tl_);
    const int lane = tl_ & 63;
    const bf16_t* sA = sbase + (it & 1) * STAGE;
    const bf16_t* sB = sA + 128 * LS;
#pragma unroll
    for (int kk = 0; kk < 4; ++kk) {
      bf16x8 a[2], b[2];
      const int ko = kk * 16 + 8 * (lane >> 5);
#pragma unroll
      for (int i = 0; i < 2; ++i) a[i] = *(const bf16x8*)(sA + (wm + i * 32 + (lane & 31)) * LS + ko);
#pragma unroll
      for (int j = 0; j < 2; ++j) b[j] = *(const bf16x8*)(sB + (wn + j * 32 + (lane & 31)) * LS + ko);
#pragma unroll
      for (int i = 0; i < 2; ++i)
#pragma unroll
        for (int j = 0; j < 2; ++j) acc[i][j] = mfma32(a[i], b[j], acc[i][j]);
      if (kk == 1) {
        if (it + 1 < nk) lwrite((it + 1) & 1);
        if (it + 2 < nk) gload((it + 2) * 64);
      }
    }
    __syncthreads();
  }
  {
    int tl_ = threadIdx.x; OPAQUE(tl_);
    const int lane = tl_ & 63;
    if constexpr (VEC4) {
#pragma unroll
      for (int i = 0; i < 2; ++i)
#pragma unroll
        for (int j = 0; j < 2; ++j)
#pragma unroll
          for (int gq = 0; gq < 4; ++gq) {
            int row = m0 + wm + i * 32 + 8 * gq + 4 * (lane >> 5);
            int col = n0 + wn + j * 32 + (lane & 31);
            if (row < M && col < N) epi.store4(row, col, acc[i][j][4 * gq], acc[i][j][4 * gq + 1], acc[i][j][4 * gq + 2], acc[i][j][4 * gq + 3]);
          }
    } else {
#pragma unroll
      for (int i = 0; i < 2; ++i)
#pragma unroll
        for (int j = 0; j < 2; ++j)
#pragma unroll
          for (int r = 0; r < 16; ++r) {
            int row = m0 + wm + i * 32 + acc_row(r, lane);
            int col = n0 + wn + j * 32 + (lane & 31);
            if (row < M && col < N) epi(row, col, acc[i][j][r]);
          }
    }
  }
}

template <class Epi, bool VEC4 = false>
DEV void gemm_tile_128x256(const bf16_t* __restrict__ A, int lda, int M, const bf16_t* __restrict__ Bt, int ldb, int N,
                           int K, int m0, int n0, const Epi& epi, unsigned char* smem) {
  constexpr int LS = 72;
  bf16_t* sA = (bf16_t*)smem;
  bf16_t* sB = sA + 128 * LS;
  const int wave = threadIdx.x >> 6;
  const int wm = (wave >> 1) * 64, wn = (wave & 1) * 128;
  f32x16 acc[2][4];
#pragma unroll
  for (int i = 0; i < 2; ++i)
#pragma unroll
    for (int j = 0; j < 4; ++j)
#pragma unroll
      for (int r = 0; r < 16; ++r) acc[i][j][r] = 0.f;
  u32x4 ra[4], rb[8];
  {
    const int tid = threadIdx.x;
#pragma unroll
    for (int i = 0; i < 4; ++i) {
      int c = tid + i * 256, r = c >> 3, cc = (c & 7) * 8;
      { int gr = m0 + r; gr = gr < M ? gr : M - 1; ra[i] = *(const u32x4*)(A + (size_t)gr * lda + cc); }
    }
#pragma unroll
    for (int i = 0; i < 8; ++i) {
      int c = tid + i * 256, r = c >> 3, cc = (c & 7) * 8;
      { int gn = n0 + r; gn = gn < N ? gn : N - 1; rb[i] = *(const u32x4*)(Bt + (size_t)gn * ldb + cc); }
    }
  }
  for (int k0 = 0; k0 < K; k0 += 64) {
    int tl_ = threadIdx.x; OPAQUE(tl_);
    const int tid = tl_, lane = tl_ & 63;
    __syncthreads();
#pragma unroll
    for (int i = 0; i < 4; ++i) { int c = tid + i * 256, r = c >> 3, cc = (c & 7) * 8; *(u32x4*)(sA + r * LS + cc) = ra[i]; }
#pragma unroll
    for (int i = 0; i < 8; ++i) { int c = tid + i * 256, r = c >> 3, cc = (c & 7) * 8; *(u32x4*)(sB + r * LS + cc) = rb[i]; }
    __syncthreads();
    if (k0 + 64 < K) {
#pragma unroll
      for (int i = 0; i < 4; ++i) {
        int c = tid + i * 256, r = c >> 3, cc = (c & 7) * 8;
        { int gr = m0 + r; gr = gr < M ? gr : M - 1; ra[i] = *(const u32x4*)(A + (size_t)gr * lda + k0 + 64 + cc); }
      }
#pragma unroll
      for (int i = 0; i < 8; ++i) {
        int c = tid + i * 256, r = c >> 3, cc = (c & 7) * 8;
        { int gn = n0 + r; gn = gn < N ? gn : N - 1; rb[i] = *(const u32x4*)(Bt + (size_t)gn * ldb + k0 + 64 + cc); }
      }
    }
#pragma unroll 2
    for (int kk = 0; kk < 4; ++kk) {
      bf16x8 a[2], b[4];
      const int ko = kk * 16 + 8 * (lane >> 5);
#pragma unroll
      for (int i = 0; i < 2; ++i) a[i] = *(const bf16x8*)(sA + (wm + i * 32 + (lane & 31)) * LS + ko);
#pragma unroll
      for (int j = 0; j < 4; ++j) b[j] = *(const bf16x8*)(sB + (wn + j * 32 + (lane & 31)) * LS + ko);
#pragma unroll
      for (int i = 0; i < 2; ++i)
#pragma unroll
        for (int j = 0; j < 4; ++j) acc[i][j] = mfma32(a[i], b[j], acc[i][j]);
    }
  }
  {
    int tl_ = threadIdx.x; OPAQUE(tl_);
    const int lane = tl_ & 63;
    if constexpr (VEC4) {
#pragma unroll
      for (int i = 0; i < 2; ++i)
#pragma unroll
        for (int j = 0; j < 4; ++j)
#pragma unroll
          for (int gq = 0; gq < 4; ++gq) {
            int row = m0 + wm + i * 32 + 8 * gq + 4 * (lane >> 5);
            int col = n0 + wn + j * 32 + (lane & 31);
            if (row < M && col < N) epi.store4(row, col, acc[i][j][4 * gq], acc[i][j][4 * gq + 1], acc[i][j][4 * gq + 2], acc[i][j][4 * gq + 3]);
          }
    } else {
#pragma unroll
      for (int i = 0; i < 2; ++i)
#pragma unroll
        for (int j = 0; j < 4; ++j)
#pragma unroll
          for (int r = 0; r < 16; ++r) {
            int row = m0 + wm + i * 32 + acc_row(r, lane);
            int col = n0 + wn + j * 32 + (lane & 31);
            if (row < M && col < N) epi(row, col, acc[i][j][r]);
          }
    }
  }
}

DEV void transpose_tile(const float* __restrict__ src, int ld_src, bf16_t* __restrict__ dst, int ld_dst, int K, int N,
                        int tk, int tn, unsigned char* smem) {
  float* sT = (float*)smem;
  const int tid = threadIdx.x;
  __syncthreads();
  {
    const int tx = tid & 15, ty = tid >> 4;
#pragma unroll
    for (int p = 0; p < 4; ++p) {
      int k = tk * 64 + ty + p * 16, n = tn * 64 + tx * 4;
#pragma unroll
      for (int j = 0; j < 4; ++j) {
        float v = (k < K && n + j < N) ? src[(size_t)k * ld_src + n + j] : 0.f;
        sT[(ty + p * 16) * 65 + tx * 4 + j] = v;
      }
    }
  }
  __syncthreads();
  {
    const int n = tid >> 2, kseg = (tid & 3) * 16;
    int gn = tn * 64 + n;
    if (gn < N) {
      float v[16];
#pragma unroll
      for (int j = 0; j < 16; ++j) v[j] = sT[(kseg + j) * 65 + n];
      bf16_t* d = dst + (size_t)gn * ld_dst + tk * 64 + kseg;
      *(u32x4*)d = pack8(v);
      *(u32x4*)(d + 8) = pack8(v + 8);
    }
  }
}

constexpr int TJ0 = 16 * 49, TJ1 = 16 * 16, TJ2 = 16 * 44, TJ3 = 16 * 16, TJ4 = 2 * 16 * 32, TJ5 = 2 * 8, TJ6 = 2 * 8,
              TJ7 = 2 * 8, TJ8 = 32;
constexpr int NTRANS = TJ0 + TJ1 + TJ2 + TJ3 + TJ4 + TJ5 + TJ6 + TJ7 + TJ8;
constexpr int NKEYCV = (2 * 8 * 2 * 128 * 128) / (256 * 8);
constexpr int NMODV = 2 * 96;
constexpr int NPREP = NTRANS + NKEYCV + NMODV;

DEV void st_prep(const Params& P, int item, unsigned char* smem) {
  unsigned char* ws = P.ws;
  if (item < NTRANS) {
    int t = item;
    if (t < TJ0) { transpose_tile(P.in[I_EVWIN], EVC, (bf16_t*)(ws + OFF_WEVIN), 1024, 1024, EVC, t / 49, t % 49, smem); return; }
    t -= TJ0;
    if (t < TJ1) { transpose_tile(P.in[I_EVWOUT], 1024, (bf16_t*)(ws + OFF_WEVOUT), 1024, 1024, 1024, t / 16, t % 16, smem); return; }
    t -= TJ1;
    if (t < TJ2) { transpose_tile(P.in[I_ODWIN], ODC, (bf16_t*)(ws + OFF_WODIN), 1024, 1024, ODC, t / 44, t % 44, smem); return; }
    t -= TJ2;
    if (t < TJ3) { transpose_tile(P.in[I_ODWOUT], 1024, (bf16_t*)(ws + OFF_WODOUT), 1024, 1024, 1024, t / 16, t % 16, smem); return; }
    t -= TJ3;
    if (t < TJ4) {
      int l = t / 512, tt = t % 512;
      transpose_tile(P.in[I_WQ] + (size_t)l * 1024 * 2048, 2048, (bf16_t*)(ws + OFF_WQ) + (size_t)l * 2048 * 1024, 1024, 1024, 2048, tt / 32, tt % 32, smem);
      return;
    }
    t -= TJ4;
    if (t < TJ5) { int d = t / 8; transpose_tile(P.in[I_WUP] + d * 64 * 512, 512, (bf16_t*)(ws + OFF_WUP) + d * 512 * 64, 64, 64, 512, 0, t % 8, smem); return; }
    t -= TJ5;
    if (t < TJ6) { int d = t / 8; transpose_tile(P.in[I_AUP] + d * 64 * 512, 512, (bf16_t*)(ws + OFF_AUP) + d * 512 * 64, 64, 64, 512, 0, t % 8, smem); return; }
    t -= TJ6;
    if (t < TJ7) { transpose_tile(P.in[I_GUP], 512, (bf16_t*)(ws + OFF_GUP), 128, 128, 512, t / 8, t % 8, smem); return; }
    t -= TJ7;
    {
      int which = t & 1, db = t >> 1;
      const float* src = (which ? P.in[I_WI] : P.in[I_WA]) + (size_t)db * 64 * 64;
      transpose_tile(src, 64, (bf16_t*)(ws + OFF_LRUT) + (size_t)db * 128 * 64 + which * 64 * 64, 64, 64, 64, 0, 0, smem);
      return;
    }
  }
  item -= NTRANS;
  if (item < NKEYCV) {
    size_t e = ((size_t)item * 256 + threadIdx.x) * 8;
    const float* s = P.in[I_KEYS] + e;
    f32x4 a = *(const f32x4*)s, b = *(const f32x4*)(s + 4);
    float v[8] = {a.x, a.y, a.z, a.w, b.x, b.y, b.z, b.w};
    *(u32x4*)((bf16_t*)(ws + OFF_KEYS) + e) = pack8(v);
    return;
  }
  item -= NKEYCV;
  {
    const int l = item / 96, cgp = item % 96;
    float* sS = (float*)smem;
    float* sRed = sS + 3 * 1024;
    const int tid = threadIdx.x;
    __syncthreads();
    for (int i = tid; i < 3 * 1024; i += 256) {
      int m = i >> 10, k = i & 1023;
      float c = m < 2 ? P.in[I_C][m * 1024 + k] : P.in[I_CCTX][k];
      sS[i] = siluf_(c);
    }
    __syncthreads();
    const int ks = tid >> 6, col = cgp * 64 + (tid & 63);
    const float* w = P.in[I_MODW] + (size_t)l * 1024 * 6144 + col;
    float a0 = 0.f, a1 = 0.f, a2 = 0.f;
    for (int k = ks * 256; k < ks * 256 + 256; ++k) {
      float wv = w[(size_t)k * 6144];
      a0 += sS[k] * wv; a1 += sS[1024 + k] * wv; a2 += sS[2048 + k] * wv;
    }
    sRed[(ks * 3 + 0) * 64 + (tid & 63)] = a0;
    sRed[(ks * 3 + 1) * 64 + (tid & 63)] = a1;
    sRed[(ks * 3 + 2) * 64 + (tid & 63)] = a2;
    __syncthreads();
    if (tid < 192) {
      int m = tid >> 6, c = tid & 63;
      float s = sRed[(0 * 3 + m) * 64 + c] + sRed[(1 * 3 + m) * 64 + c] + sRed[(2 * 3 + m) * 64 + c] + sRed[(3 * 3 + m) * 64 + c];
      int cc = cgp * 64 + c;
      ((float*)(ws + OFF_MODV))[((size_t)l * 3 + m) * 6144 + cc] = s + P.in[I_MODB][l * 6144 + cc];
    }
  }
}

constexpr int NPCONV = 2 * (NEXP * 1024 / (256 * 16));
DEV void st_peer_conv(const Params& P, int layer, int item) {
  const int half = NPCONV / 2;
  int which = item >= half;
  int it = which ? item - half : item;
  size_t e = ((size_t)it * 256 + threadIdx.x) * 16;
  const float* s = (which ? P.in[I_PV] : P.in[I_PU]) + (size_t)layer * NEXP * 1024 + e;
  const float sc = which ? PEER_VSCALE : PEER_USCALE;
  float v16[16];
#pragma unroll
  for (int q = 0; q < 4; ++q) {
    f32x4 a = *(const f32x4*)(s + 4 * q);
    v16[4 * q] = a.x * sc; v16[4 * q + 1] = a.y * sc; v16[4 * q + 2] = a.z * sc; v16[4 * q + 3] = a.w * sc;
  }
  const size_t ex = e >> 10, col = e & 1023;
  if (which) {
    u32x2 o; o.x = pack8_fp4(v16); o.y = pack8_fp4(v16 + 8);
    *(u32x2*)(P.ws + OFF_PU + ex * PEER_ROWB + PEER_VOFF + (col >> 1)) = o;
  } else {
    u32x3 o = pack16_fp6(v16);
    unsigned* dp = (unsigned*)(P.ws + OFF_PU + ex * PEER_ROWB + (col >> 4) * 12);
    dp[0] = o.x; dp[1] = o.y; dp[2] = o.z;
  }
}

DEV void st_normmod(const Params& P, int layer, int which, int row) {
  const int lane = threadIdx.x & 63;
  const float* src;
  if (which == 0 && layer == 0) src = row < NCTX ? P.in[I_CTX] + (size_t)row * 1024 : P.in[I_X] + (size_t)(row - NCTX) * 1024;
  else src = row < NCTX ? (const float*)(P.ws + OFF_CTXRES) + (size_t)row * 1024 : P.out + (size_t)(row - NCTX) * 1024;
  const float* mv = (const float*)(P.ws + OFF_MODV) + ((size_t)layer * 3 + mod_row(row)) * 6144;
  const float* sh = mv + (which ? 3 : 0) * 1024;
  const float* sc = mv + (which ? 4 : 1) * 1024;
  const float* nw = (which ? P.in[I_NORM2] : P.in[I_NORM1]) + layer * 1024;
  f32x4 v[4];
  float ss = 0.f;
#pragma unroll
  for (int i = 0; i < 4; ++i) {
    v[i] = *(const f32x4*)(src + i * 256 + lane * 4);
    ss += v[i].x * v[i].x + v[i].y * v[i].y + v[i].z * v[i].z + v[i].w * v[i].w;
  }
  ss = wave_sum(ss);
  const float rstd = frsq(ss * (1.f / 1024.f) + 1e-6f);
  bf16_t* dst = (bf16_t*)(P.ws + OFF_HBUF) + (size_t)row * 1024;
#pragma unroll
  for (int i = 0; i < 4; ++i) {
    int c = i * 256 + lane * 4;
    f32x4 w4 = *(const f32x4*)(nw + c), s4 = *(const f32x4*)(sc + c), h4 = *(const f32x4*)(sh + c);
    float o0 = v[i].x * rstd * w4.x * (1.f + s4.x) + h4.x;
    float o1 = v[i].y * rstd * w4.y * (1.f + s4.y) + h4.y;
    float o2 = v[i].z * rstd * w4.z * (1.f + s4.z) + h4.z;
    float o3 = v[i].w * rstd * w4.w * (1.f + s4.w) + h4.w;
    u32x2 pk; pk.x = pack2(o0, o1); pk.y = pack2(o2, o3);
    *(u32x2*)(dst + c) = pk;
  }
}

struct EpiProjL0 {
  bf16_t* proj; float* gates;
  DEVM void operator()(int row, int col, float v) const {
    proj[(size_t)row * EVC + col] = f2bf(v);
    if (col >= 1536 && col < 1552) gates[row * 32 + (col - 1536)] = v;
    else if (col >= 3088) gates[row * 32 + 16 + (col - 3088)] = v;
  }
};
struct EpiStoreBf {
  bf16_t* dst; int ld;
  DEVM void operator()(int row, int col, float v) const { dst[(size_t)row * ld + col] = f2bf(v); }
};
struct EpiStoreBfBias {
  bf16_t* dst; int ld; const float* bias;
  DEVM void operator()(int row, int col, float v) const { dst[(size_t)row * ld + col] = f2bf(v + (bias ? bias[col] : 0.f)); }
};
struct EpiProjL0T {
  bf16_t* proj; float* gates;
  DEVM void operator()(int, int, float) const {}
  DEVM void store4(int n, int m, float v0, float v1, float v2, float v3) const {
    u32x2 pk; pk.x = pack2(v0, v1); pk.y = pack2(v2, v3);
    *(u32x2*)(proj + (size_t)m * EVC + n) = pk;
    if (n >= 1536 && n < 1552) { f32x4 g = {v0, v1, v2, v3}; *(f32x4*)(gates + m * 32 + (n - 1536)) = g; }
    else if (n >= 3088) { f32x4 g = {v0, v1, v2, v3}; *(f32x4*)(gates + m * 32 + 16 + (n - 3088)) = g; }
  }
};
struct EpiStoreBfT {
  bf16_t* dst; int ld;
  DEVM void operator()(int, int, float) const {}
  DEVM void store4(int n, int m, float v0, float v1, float v2, float v3) const {
    u32x2 pk; pk.x = pack2(v0, v1); pk.y = pack2(v2, v3);
    *(u32x2*)(dst + (size_t)m * ld + n) = pk;
  }
};
struct EpiOutProjT {
  const float* x_lat; const float* x_ctx; float* o_lat; float* o_ctx; const float* modv;
  DEVM void operator()(int, int, float) const {}
  DEVM void store4(int n, int m, float v0, float v1, float v2, float v3) const {
    const f32x4 g = *(const f32x4*)(modv + mod_row(m) * 6144 + 2 * 1024 + n);
    const float* xs; float* od;
    if (m < NCTX) { xs = x_ctx + (size_t)m * 1024 + n; od = o_ctx + (size_t)m * 1024 + n; }
    else { size_t o = (size_t)(m - NCTX) * 1024 + n; xs = x_lat + o; od = o_lat + o; }
    const f32x4 x = *(const f32x4*)xs;
    f32x4 r = {x.x + g.x * v0, x.y + g.y * v1, x.z + g.z * v2, x.w + g.w * v3};
    *(f32x4*)od = r;
  }
};
struct EpiStoreBfBiasT {
  bf16_t* dst; int ld; const float* bias;
  DEVM void operator()(int, int, float) const {}
  DEVM void store4(int n, int m, float v0, float v1, float v2, float v3) const {
    if (bias) { v0 += bias[n]; v1 += bias[n + 1]; v2 += bias[n + 2]; v3 += bias[n + 3]; }
    u32x2 pk; pk.x = pack2(v0, v1); pk.y = pack2(v2, v3);
    *(u32x2*)(dst + (size_t)m * ld + n) = pk;
  }
};
struct EpiOutProj {
  const float* x_lat; const float* x_ctx; float* o_lat; float* o_ctx; const float* modv;
  DEVM void operator()(int row, int col, float v) const {
    float g = modv[mod_row(row) * 6144 + 2 * 1024 + col];
    if (row < NCTX) o_ctx[(size_t)row * 1024 + col] = x_ctx[(size_t)row * 1024 + col] + g * v;
    else { size_t o = (size_t)(row - NCTX) * 1024 + col; o_lat[o] = x_lat[o] + g * v; }
  }
};
struct EpiScoreLds {
  float* sS; int m0;
  DEVM void operator()(int row, int col, float v) const { sS[(row - m0) * 129 + col] = v; }
};

DEV void st_xbc_conv(const Params& P, int row) {
  const int lane = threadIdx.x & 63;
  const bf16_t* proj = (const bf16_t*)(P.ws + OFF_PROJ);
  bf16_t* xc = (bf16_t*)P.out + (size_t)row * 1024;
  int row0, len, pos;
  if (row < NCTX) { row0 = (row / CTXL) * CTXL; len = CTXL; pos = row - row0; }
  else { int r = row - NCTX; row0 = NCTX + (r / SEQ) * SEQ; len = SEQ; pos = r % SEQ; }
  const float* cw = P.in[I_SCONVW];
  const float* cb = P.in[I_SCONVB];
#pragma unroll
  for (int hh = 0; hh < 2; ++hh) {
    const int ch = hh * 512 + lane * 8;
    float o[8];
#pragma unroll
    for (int j = 0; j < 8; ++j) o[j] = cb[ch + j];
#pragma unroll
    for (int tap = 0; tap < 4; ++tap) {
      int pp = pos + tap - 2;
      if (pp >= 0 && pp < len) {
        float x[8];
        unpack8(*(const u32x4*)(proj + (size_t)(row0 + pp) * EVC + 2064 + ch), x);
        f32x4 w0 = *(const f32x4*)(cw + tap * 1024 + ch), w1 = *(const f32x4*)(cw + tap * 1024 + ch + 4);
        o[0] += w0.x * x[0]; o[1] += w0.y * x[1]; o[2] += w0.z * x[2]; o[3] += w0.w * x[3];
        o[4] += w1.x * x[4]; o[5] += w1.y * x[5]; o[6] += w1.z * x[6]; o[7] += w1.w * x[7];
      }
    }
#pragma unroll
    for (int j = 0; j < 8; ++j) o[j] = siluf_(o[j]);
    *(u32x4*)(xc + ch) = pack8(o);
  }
}

#ifndef LA_NSEG
#define LA_NSEG 10
#endif
constexpr int LA_NCH = (CTXL + SEQ) / 64;
constexpr int LA_CPS = LA_NCH / LA_NSEG;
static_assert(LA_NCH % LA_NSEG == 0, "linattn segments");
#ifdef CPU_EMU
constexpr size_t OFF_LASEG = OFF_PR + PR_BYTES;
#else
constexpr size_t OFF_LASEG = OFF_R2L0 + (size_t)NTOK * 1024 * 2;
#endif
constexpr size_t LASEG_U = (size_t)48 * LA_NSEG * 8192 * 4;
constexpr size_t OFF_LASEG_N = OFF_LASEG + LASEG_U;
constexpr size_t OFF_LASEG_D = OFF_LASEG_N + (size_t)48 * LA_NSEG * 64 * 4;
#ifndef CPU_EMU
static_assert(OFF_LASEG_D + 48 * LA_NSEG * 4 <= OFF_PR + PR_BYTES, "laseg");
#endif

struct LaRaw { u32x4 q[2], k[4], x[4]; float g0, g1; };

template <bool MLSTM, bool FULL>
DEV void la_load_raw(const Params& P, int b, int h, int d, int cc, LaRaw& R) {
  constexpr int NC_CTX = CTXL / 64;
  const int tid = threadIdx.x;
  const int seg = cc >= NC_CTX;
  const int row0 = seg ? NCTX + b * SEQ : b * CTXL;
  const int len = seg ? SEQ : CTXL;
  const int cl = (seg ? cc - NC_CTX : cc) * 64;
  const bf16_t* proj = (const bf16_t*)(P.ws + OFF_PROJ);
  const bf16_t* xcv = (const bf16_t*)P.out;
  const float* gates = (const float*)(P.ws + OFF_GATES);
  if (tid < 64) {
    int p = cl + tid, grow = row0 + (d ? len - 1 - p : p);
    if (MLSTM) { R.g0 = gates[grow * 32 + d * 4 + h]; R.g1 = gates[grow * 32 + 8 + d * 4 + h]; }
    else { R.g0 = gates[grow * 32 + 16 + d * 8 + h]; R.g1 = 0.f; }
  }
  if (MLSTM) {
#pragma unroll
    for (int i = 0; i < 2; ++i) {
      int c = tid + i * 256, r = c >> 3, cc8 = (c & 7) * 8;
      int p = cl + r, pos = d ? len - 1 - p : p;
      const bf16_t* rp = proj + (size_t)(row0 + pos) * EVC;
      if (FULL) R.q[i] = *(const u32x4*)(rp + h * 64 + cc8);
      R.k[i] = *(const u32x4*)(rp + 256 + h * 64 + cc8);
    }
#pragma unroll
    for (int i = 0; i < 4; ++i) {
      int c = tid + i * 256, r = c >> 4, cc8 = (c & 15) * 8;
      int p = cl + r, pos = d ? len - 1 - p : p;
      R.x[i] = *(const u32x4*)(proj + (size_t)(row0 + pos) * EVC + 512 + h * 128 + cc8);
    }
  } else {
    const int grp = h >> 2;
#pragma unroll
    for (int i = 0; i < 2; ++i) {
      int c = tid + i * 256, r = c >> 3, cc8 = (c & 7) * 8;
      int p = cl + r, pos = d ? len - 1 - p : p;
      R.x[i] = *(const u32x4*)(xcv + (size_t)(row0 + pos) * 1024 + h * 64 + cc8);
    }
#pragma unroll
    for (int i = 0; i < 4; ++i) {
      int c = tid + i * 256, r = c >> 4, cc8 = (c & 15) * 8;
      int p = cl + r, pos = d ? len - 1 - p : p;
      const bf16_t* rp = xcv + (size_t)(row0 + pos) * 1024;
      R.k[i] = *(const u32x4*)(rp + 512 + grp * 128 + cc8);
      if (FULL) { if (i < 2) R.q[i] = *(const u32x4*)(rp + 768 + grp * 128 + cc8); else R.x[i] = *(const u32x4*)(rp + 768 + grp * 128 + cc8); }
    }
  }
}

template <bool MLSTM, bool FULL>
DEV void st_linattn_seg(const Params& P, int sid, int seg, unsigned char* smem) {
  constexpr int DK = MLSTM ? 64 : 128, DX = MLSTM ? 128 : 64;
  constexpr int QS = DK + 8;
  constexpr int NH = MLSTM ? 4 : 8;
  constexpr int NC_CTX = CTXL / 64;
  const int tid = threadIdx.x, lane = tid & 63, wave = tid >> 6;
  const int d = sid & 1, h = (sid >> 1) % NH, b = (sid >> 1) / NH;
  const int gsid = MLSTM ? sid : 16 + sid;
  bf16_t* sQ = (bf16_t*)smem;
  bf16_t* sK = sQ + 64 * QS;
  bf16_t* sP = sK;
  bf16_t* sKT = sK + 64 * QS;
  bf16_t* sXT = sKT + DK * 72;
  bf16_t* sST = sXT + DX * 72;
  float* sF = (float*)(sST + DX * QS);
  float* sLa = sF;
  float* sG = sF + 64;
  float* sBc = sF + 128;
  float* sDen = sF + 192;
  float* sN = sF + 256;
  int* sRow = (int*)(sF + 384);
  static_assert((64 * QS * 2 + DK * 72 + DX * 72 + DX * QS) * 2 + 448 * 4 <= SMEM_BYTES, "lds");
  bf16_t* outb = MLSTM ? (bf16_t*)(P.ws + OFF_HBUF) : (bf16_t*)(P.ws + OFF_R2L0);
  float* segU = (float*)(P.ws + OFF_LASEG);
  float* segN = (float*)(P.ws + OFF_LASEG_N);
  float* segD = (float*)(P.ws + OFF_LASEG_D);

  f32x16 accS[2];
#pragma unroll
  for (int j = 0; j < 2; ++j)
#pragma unroll
    for (int r = 0; r < 16; ++r) accS[j][r] = 0.f;
  const int sx0 = MLSTM ? wave * 32 : (wave >> 1) * 32;
  const int sk0 = MLSTM ? 0 : (wave & 1) * 64;
  float nreg = 0.f;
  float gb0 = 0.f, gb1 = 0.f, alog_e = 0.f, dskip = 0.f;
  if (MLSTM) { gb0 = P.in[I_IBIAS][d * 4 + h]; gb1 = P.in[I_FBIAS][d * 4 + h]; }
  else { gb0 = P.in[I_DTBIAS][d * 8 + h]; alog_e = fexp(P.in[I_ALOG][d * 8 + h]); dskip = P.in[I_DSKIP][h]; }

  const int cc0 = seg * LA_CPS, cc1 = cc0 + LA_CPS;
  LaRaw R;
  la_load_raw<MLSTM, FULL>(P, b, h, d, cc0, R);
  __syncthreads();
  if (FULL) {
    for (int js = 0; js < seg; ++js) {
      const size_t it = (size_t)gsid * LA_NSEG + js;
      const float a = fexp(segD[it]);
      const float* U = segU + it * 8192;
#pragma unroll
      for (int j = 0; j < 2; ++j)
#pragma unroll
        for (int r = 0; r < 16; ++r) accS[j][r] = a * accS[j][r] + U[(j * 16 + r) * 256 + tid];
      if (MLSTM && tid < 64) nreg = a * nreg + segN[it * 64 + tid];
    }
#pragma unroll
    for (int j = 0; j < 2; ++j)
#pragma unroll
      for (int r = 0; r < 16; ++r) sST[(sx0 + acc_row(r, lane)) * QS + sk0 + j * 32 + (lane & 31)] = f2bf(accS[j][r]);
    if (tid < 128) sN[tid] = (MLSTM && tid < 64) ? nreg : 0.f;
  }
  float lsum = 0.f;

  for (int cc = cc0; cc < cc1; ++cc) {
    int tl_ = threadIdx.x; OPAQUE(tl_);
    const int tid = tl_, lane = tl_ & 63;
    const int sgi = cc >= NC_CTX;
    const int row0 = sgi ? NCTX + b * SEQ : b * CTXL;
    const int len = sgi ? SEQ : CTXL;
    const int cl = (sgi ? cc - NC_CTX : cc) * 64;
    if (tid < 64) {
      int p = cl + tid;
      sRow[tid] = row0 + (d ? len - 1 - p : p);
      if (MLSTM) { sLa[tid] = -softplusf_(-(R.g1 + gb1)); sG[tid] = fexp(R.g0 + gb0); }
      else { float dt = softplusf_(R.g0 + gb0); sLa[tid] = -dt * alog_e; sG[tid] = dt; }
    }
    __syncthreads();
    if (wave == 0) {
      float v = sLa[lane];
#pragma unroll
      for (int off = 1; off < 64; off <<= 1) {
#ifdef CPU_EMU
        float o = emu_shfl_up(v, off);
#else
        float o = __shfl_up(v, off, 64);
#endif
        if (lane >= off) v += o;
      }
      sBc[lane] = v;
    }
    __syncthreads();
    const float blast = sBc[63];
    lsum += blast;
    if (MLSTM) {
#pragma unroll
      for (int i = 0; i < 2; ++i) {
        int c = tid + i * 256, r = c >> 3, cc8 = (c & 7) * 8;
        float kf[8]; unpack8(R.k[i], kf);
        const float wgt = fexp(blast - sBc[r]) * sG[r];
#pragma unroll
        for (int j = 0; j < 8; ++j) sKT[(cc8 + j) * 72 + r] = f2bf(kf[j] * wgt);
        if (FULL) {
          float qf[8]; unpack8(R.q[i], qf);
#pragma unroll
          for (int j = 0; j < 8; ++j) qf[j] *= 0.125f;
          *(u32x4*)(sQ + r * QS + cc8) = pack8(qf);
          *(u32x4*)(sK + r * QS + cc8) = R.k[i];
        }
      }
#pragma unroll
      for (int i = 0; i < 4; ++i) {
        int c = tid + i * 256, r = c >> 4, cc8 = (c & 15) * 8;
        const bf16_t* xs = (const bf16_t*)&R.x[i];
#pragma unroll
        for (int j = 0; j < 8; ++j) sXT[(cc8 + j) * 72 + r] = xs[j];
      }
    } else {
#pragma unroll
      for (int i = 0; i < 2; ++i) {
        int c = tid + i * 256, r = c >> 3, cc8 = (c & 7) * 8;
        const bf16_t* xs = (const bf16_t*)&R.x[i];
#pragma unroll
        for (int j = 0; j < 8; ++j) sXT[(cc8 + j) * 72 + r] = xs[j];
      }
#pragma unroll
      for (int i = 0; i < 4; ++i) {
        int c = tid + i * 256, r = c >> 4, cc8 = (c & 15) * 8;
        float kf[8]; unpack8(R.k[i], kf);
        const float wgt = fexp(blast - sBc[r]) * sG[r];
#pragma unroll
        for (int j = 0; j < 8; ++j) sKT[(cc8 + j) * 72 + r] = f2bf(kf[j] * wgt);
        if (FULL) {
          *(u32x4*)(sK + r * QS + cc8) = R.k[i];
          *(u32x4*)(sQ + r * QS + cc8) = i < 2 ? R.q[i] : R.x[i];
        }
      }
    }
    if (cc + 1 < cc1) la_load_raw<MLSTM, FULL>(P, b, h, d, cc + 1, R);
    __syncthreads();
    if (FULL) {
      const int tr = (wave >> 1) * 32, tc = (wave & 1) * 32;
      f32x16 accP;
#pragma unroll
      for (int r = 0; r < 16; ++r) accP[r] = 0.f;
      if (!(tr == 0 && tc == 32)) {
#pragma unroll
        for (int kk = 0; kk < DK / 16; ++kk) {
          const int ko = kk * 16 + 8 * (lane >> 5);
          bf16x8 a = *(const bf16x8*)(sQ + (tr + (lane & 31)) * QS + ko);
          bf16x8 bb = *(const bf16x8*)(sK + (tc + (lane & 31)) * QS + ko);
          accP = mfma32(a, bb, accP);
        }
      }
      __syncthreads();
      {
        const int s = tc + (lane & 31);
        const float bs = sBc[s], gs = sG[s];
#pragma unroll
        for (int r = 0; r < 16; ++r) {
          int t = tr + acc_row(r, lane);
          float v = (s <= t) ? accP[r] * fexp(sBc[t] - bs) * gs : 0.f;
          sP[t * 72 + s] = f2bf(v);
        }
        for (int i = tid; i < 64 * DK; i += 256) {
          int t = i / DK, k = i % DK;
          sQ[t * QS + k] = f2bf(bf2f(sQ[t * QS + k]) * fexp(sBc[t]));
        }
      }
      __syncthreads();
      constexpr int NYT = MLSTM ? 2 : 1;
      const int yx0 = MLSTM ? wave * 32 : (wave >> 1) * 32;
      const int yt0 = MLSTM ? 0 : (wave & 1) * 32;
      f32x16 accY[NYT];
#pragma unroll
      for (int j = 0; j < NYT; ++j)
#pragma unroll
        for (int r = 0; r < 16; ++r) accY[j][r] = 0.f;
#pragma unroll
      for (int kk = 0; kk < 4; ++kk) {
        const int ko = kk * 16 + 8 * (lane >> 5);
        bf16x8 a = *(const bf16x8*)(sXT + (yx0 + (lane & 31)) * 72 + ko);
#pragma unroll
        for (int j = 0; j < NYT; ++j) {
          bf16x8 bb = *(const bf16x8*)(sP + (yt0 + j * 32 + (lane & 31)) * 72 + ko);
          accY[j] = mfma32(a, bb, accY[j]);
        }
      }
#pragma unroll
      for (int kk = 0; kk < DK / 16; ++kk) {
        const int ko = kk * 16 + 8 * (lane >> 5);
        bf16x8 a = *(const bf16x8*)(sST + (yx0 + (lane & 31)) * QS + ko);
#pragma unroll
        for (int j = 0; j < NYT; ++j) {
          bf16x8 bb = *(const bf16x8*)(sQ + (yt0 + j * 32 + (lane & 31)) * QS + ko);
          accY[j] = mfma32(a, bb, accY[j]);
        }
      }
      if (MLSTM) {
        if (tid < 64) {
          float den = 0.f, dq = 0.f;
#pragma unroll 8
          for (int s = 0; s < 64; ++s) den += bf2f(sP[tid * 72 + s]);
#pragma unroll 8
          for (int k = 0; k < DK; ++k) dq += sN[k] * bf2f(sQ[tid * QS + k]);
          sDen[tid] = den + dq;
        }
        __syncthreads();
      }
#pragma unroll
      for (int j = 0; j < NYT; ++j) {
        const int t = yt0 + j * 32 + (lane & 31);
        const size_t obase = (size_t)sRow[t] * 1024 + d * 512 + h * DX;
        const float dinv = MLSTM ? frcp(fmaxf(fabsf(sDen[t]), 1.f)) : 1.f;
#pragma unroll
        for (int g = 0; g < 4; ++g) {
          const int x0 = yx0 + 8 * g + 4 * (lane >> 5);
          float v0 = accY[j][4 * g], v1 = accY[j][4 * g + 1], v2 = accY[j][4 * g + 2], v3 = accY[j][4 * g + 3];
          if (MLSTM) { v0 *= dinv; v1 *= dinv; v2 *= dinv; v3 *= dinv; }
          else if (d == 0) {
            v0 += dskip * bf2f(sXT[(x0 + 0) * 72 + t]); v1 += dskip * bf2f(sXT[(x0 + 1) * 72 + t]);
            v2 += dskip * bf2f(sXT[(x0 + 2) * 72 + t]); v3 += dskip * bf2f(sXT[(x0 + 3) * 72 + t]);
          }
          u32x2 pk; pk.x = pack2(v0, v1); pk.y = pack2(v2, v3);
          *(u32x2*)(outb + obase + x0) = pk;
        }
      }
      __syncthreads();
    }
    {
      const float eb = fexp(blast);
#pragma unroll
      for (int j = 0; j < 2; ++j)
#pragma unroll
        for (int r = 0; r < 16; ++r) accS[j][r] *= eb;
#pragma unroll
      for (int kk = 0; kk < 4; ++kk) {
        const int ko = kk * 16 + 8 * (lane >> 5);
        bf16x8 a = *(const bf16x8*)(sXT + (sx0 + (lane & 31)) * 72 + ko);
#pragma unroll
        for (int j = 0; j < 2; ++j) {
          bf16x8 bb = *(const bf16x8*)(sKT + (sk0 + j * 32 + (lane & 31)) * 72 + ko);
          accS[j] = mfma32(a, bb, accS[j]);
        }
      }
      if (FULL) {
#pragma unroll
        for (int j = 0; j < 2; ++j)
#pragma unroll
          for (int r = 0; r < 16; ++r) sST[(sx0 + acc_row(r, lane)) * QS + sk0 + j * 32 + (lane & 31)] = f2bf(accS[j][r]);
      }
      if (MLSTM && tid < 64) {
        float nn = nreg * eb;
        for (int s = 0; s < 64; ++s) nn += bf2f(sKT[tid * 72 + s]);
        nreg = nn;
        if (FULL) sN[tid] = nn;
      }
    }
    __syncthreads();
  }
  if (!FULL) {
    const size_t it = (size_t)gsid * LA_NSEG + seg;
    float* U = segU + it * 8192;
#pragma unroll
    for (int j = 0; j < 2; ++j)
#pragma unroll
      for (int r = 0; r < 16; ++r) U[(j * 16 + r) * 256 + tid] = accS[j][r];
    if (MLSTM && tid < 64) segN[it * 64 + tid] = nreg;
    if (tid == 0) segD[it] = lsum;
  }
}

DEV void st_finish_l0(const Params& P, int row) {
  const int lane = threadIdx.x & 63;
  bf16_t* hb = (bf16_t*)(P.ws + OFF_HBUF) + (size_t)row * 1024;
  const bf16_t* yb = (const bf16_t*)(P.ws + OFF_R2L0) + (size_t)row * 1024;
  const bf16_t* pr = (const bf16_t*)(P.ws + OFF_PROJ) + (size_t)row * EVC;
  const int ch = lane * 8;
  float h0[8], h1[8], o[8], f1[8];
  unpack8(*(const u32x4*)(hb + ch), h0);
  unpack8(*(const u32x4*)(hb + 512 + ch), h1);
  unpack8(*(const u32x4*)(pr + 1024 + ch), o);
  float ss = 0.f;
#pragma unroll
  for (int j = 0; j < 8; ++j) { h0[j] += h1[j]; ss += h0[j] * h0[j]; }
  ss += wshfl_xor(ss, 1); ss += wshfl_xor(ss, 2); ss += wshfl_xor(ss, 4); ss += wshfl_xor(ss, 8);
  float rstd = frsq(ss * (1.f / 128.f) + 1e-6f);
#pragma unroll
  for (int j = 0; j < 8; ++j) f1[j] = h0[j] * rstd * P.in[I_MNORM][ch + j] * sigmoidf_(o[j]);
  float y0[8], y1[8], z[8], f2[8];
  unpack8(*(const u32x4*)(yb + ch), y0);
  unpack8(*(const u32x4*)(yb + 512 + ch), y1);
  unpack8(*(const u32x4*)(pr + 1552 + ch), z);
  float s2 = 0.f;
#pragma unroll
  for (int j = 0; j < 8; ++j) { y0[j] = (y0[j] + y1[j]) * siluf_(z[j]); s2 += y0[j] * y0[j]; }
  s2 = wave_sum(s2);
  float rstd2 = frsq(s2 * (1.f / 512.f) + 1e-6f);
#pragma unroll
  for (int j = 0; j < 8; ++j) f2[j] = y0[j] * rstd2 * P.in[I_SNORM][ch + j];
  *(u32x4*)(hb + ch) = pack8(f1);
  *(u32x4*)(hb + 512 + ch) = pack8(f2);
}

DEV float mixval(const bf16_t* __restrict__ proj, int row, int c, const float* __restrict__ mu) {
  float self = bf2f(proj[(size_t)row * ODC + c]);
  int nrow = -1;
  if (row < NCTX) {
    int pos = row % CTXL;
    if (c < 896) { if (pos > 0) nrow = row - 1; }
    else { if (pos < CTXL - 1) nrow = row + 1; }
  } else {
    int pos = (row - NCTX) % SEQ;
    int gx = pos % GW, gy = pos / GW, q = c / 448;
    if (q == 0) { if (gx > 0) nrow = row - 1; }
    else if (q == 1) { if (gx < GW - 1) nrow = row + 1; }
    else if (q == 2) { if (gy > 0) nrow = row - GW; }
    else { if (gy < SEQ / GW - 1) nrow = row + GW; }
  }
  float nb = nrow >= 0 ? bf2f(proj[(size_t)nrow * ODC + c]) : 0.f;
  return self + mu[c] * (nb - self);
}

DEV void st_lora_act(const Params& P, int row) {
  const int lane = threadIdx.x & 63;
  const bf16_t* proj = (const bf16_t*)(P.ws + OFF_PROJ);
  bf16_t* hb = (bf16_t*)(P.ws + OFF_HBUF) + (size_t)row * 1024;
  float v[4];
#pragma unroll
  for (int j = 0; j < 4; ++j) {
    int c = lane * 4 + j;
    float x = mixval(proj, row, 1536 + c, P.in[I_MU]);
    v[j] = c < 64 ? tanhf_(x) : (c < 128 ? x : sigmoidf_(x));
  }
  u32x2 pk; pk.x = pack2(v[0], v[1]); pk.y = pack2(v[2], v[3]);
  *(u32x2*)(hb + lane * 4) = pk;
}

DEV void st_rwkv_stream(const Params& P, int sid, unsigned char* smem) {
  const int tid = threadIdx.x, lane = tid & 63, wave = tid >> 6;
  const int d = sid & 1, h = (sid >> 1) & 7, b = sid >> 4;
  float* sR = (float*)smem;
  float* sW = sR + 2048;
  float* sKk = sW + 2048;
  float* sV = sKk + 2048;
  float* sA = sV + 2048;
  float* sBb = sA + 2048;
  float* sY = sBb + 2048;
  int* sRow = (int*)(sY + 2048);
  const bf16_t* proj = (const bf16_t*)(P.ws + OFF_PROJ);
  const bf16_t* lora = (const bf16_t*)(P.ws + OFF_LORA);
  bf16_t* yout = (bf16_t*)(P.ws + OFF_HBUF);
  const float* mu = P.in[I_MU];
  const int vrow = tid >> 2, j4 = tid & 3;
  float S[16];
#pragma unroll
  for (int i = 0; i < 16; ++i) S[i] = 0.f;
  const float kkw = P.in[I_KK][h * 64 + lane], kaw = P.in[I_KA][h * 64 + lane];
  for (int seg = 0; seg < 2; ++seg) {
    const int row0 = seg == 0 ? b * CTXL : NCTX + b * SEQ;
    const int len = seg == 0 ? CTXL : SEQ;
    for (int it = 0; it < len / 32; ++it) {
      __syncthreads();
      for (int s = wave; s < 32; s += 4) {
        int p = it * 32 + s, pos = d ? len - 1 - p : p, row = row0 + pos;
        int c = h * 64 + lane;
        float r = mixval(proj, row, c, mu);
        float k = mixval(proj, row, 512 + c, mu);
        float v = mixval(proj, row, 1024 + c, mu);
        float kk = k * kkw;
        float ss = wave_sum(kk * kk);
        kk *= frsq(ss + 1e-12f);
        float lw = bf2f(lora[((size_t)d * NTOK + row) * 512 + c]);
        float la = bf2f(lora[((size_t)(2 + d) * NTOK + row) * 512 + c]);
        float w = fexp(-0.6065306597126334f * sigmoidf_(lw));
        float a = sigmoidf_(la);
        float kt = k * (1.f + (a - 1.f) * kaw);
        sR[s * 64 + lane] = r; sW[s * 64 + lane] = w; sKk[s * 64 + lane] = kt; sV[s * 64 + lane] = v;
        sA[s * 64 + lane] = -kk; sBb[s * 64 + lane] = kk * a;
        if (lane == 0) sRow[s] = row;
      }
      __syncthreads();
      for (int s = 0; s < 32; ++s) {
        const float* pa = sA + s * 64 + j4 * 16;
        const float* pw = sW + s * 64 + j4 * 16;
        const float* pk = sKk + s * 64 + j4 * 16;
        const float* pb = sBb + s * 64 + j4 * 16;
        const float* pr = sR + s * 64 + j4 * 16;
        const float vv = sV[s * 64 + vrow];
        float sa = 0.f;
#pragma unroll
        for (int i = 0; i < 16; ++i) sa += S[i] * pa[i];
        sa += wshfl_xor(sa, 1); sa += wshfl_xor(sa, 2);
        float y = 0.f;
#pragma unroll
        for (int i = 0; i < 16; ++i) { S[i] = S[i] * pw[i] + sa * pb[i] + vv * pk[i]; y += S[i] * pr[i]; }
        y += wshfl_xor(y, 1); y += wshfl_xor(y, 2);
        if (j4 == 0) sY[s * 64 + vrow] = y;
      }
      __syncthreads();
      for (int i = tid; i < 2048; i += 256) {
        int s = i >> 6, c = i & 63;
        yout[(size_t)sRow[s] * 1024 + d * 512 + h * 64 + c] = f2bf(sY[i]);
      }
    }
  }
}


DEV int nbr_row(int row, int c) {
  if (row < NCTX) {
    int pos = row % CTXL;
    if (c < 896) return pos > 0 ? row - 1 : -1;
    return pos < CTXL - 1 ? row + 1 : -1;
  }
  int pos = (row - NCTX) % SEQ;
  int gx = pos % GW, gy = pos / GW, q = c / 448;
  if (q == 0) return gx > 0 ? row - 1 : -1;
  if (q == 1) return gx < GW - 1 ? row + 1 : -1;
  if (q == 2) return gy > 0 ? row - GW : -1;
  return gy < SEQ / GW - 1 ? row + GW : -1;
}

struct RwkvRaw { u32x4 rs, rn, ks, kn, vs, vn, lw, la; int row; };

DEV void rwkv_load_raw(const bf16_t* __restrict__ proj, const bf16_t* __restrict__ lora, int b, int h, int d, int cc, int t, int c0,
                       RwkvRaw& R) {
  constexpr int NC_CTX = CTXL / 32;
  const int seg = cc >= NC_CTX;
  const int row0 = seg ? NCTX + b * SEQ : b * CTXL;
  const int len = seg ? SEQ : CTXL;
  const int p = (seg ? cc - NC_CTX : cc) * 32 + t;
  const int row = row0 + (d ? len - 1 - p : p);
  const int col = h * 64 + c0;
  const u32x4 z4 = {0u, 0u, 0u, 0u};
  const bf16_t* rp = proj + (size_t)row * ODC;
  R.row = row;
  R.rs = *(const u32x4*)(rp + col);
  R.ks = *(const u32x4*)(rp + 512 + col);
  R.vs = *(const u32x4*)(rp + 1024 + col);
  int n0 = nbr_row(row, col), n1 = nbr_row(row, 512 + col), n2 = nbr_row(row, 1024 + col);
  R.rn = n0 >= 0 ? *(const u32x4*)(proj + (size_t)n0 * ODC + col) : z4;
  R.kn = n1 >= 0 ? *(const u32x4*)(proj + (size_t)n1 * ODC + 512 + col) : z4;
  R.vn = n2 >= 0 ? *(const u32x4*)(proj + (size_t)n2 * ODC + 1024 + col) : z4;
  R.lw = *(const u32x4*)(lora + ((size_t)d * NTOK + row) * 512 + col);
  R.la = *(const u32x4*)(lora + ((size_t)(2 + d) * NTOK + row) * 512 + col);
}

#ifndef RW_NSEG
#define RW_NSEG 16
#endif
constexpr int RW_NCH = (CTXL + SEQ) / 32;
constexpr size_t OFF_RWSEG = OFF_PU;
static_assert((size_t)32 * RW_NSEG * 64 * 128 * 4 <= (size_t)2 * NEXP * 1024, "rwseg");

template <bool FULL>
DEV void st_rwkv_seg(const Params& P, int sid, int seg, unsigned char* smem) {
  constexpr int NVB = FULL ? 2 : 4;
  constexpr int ZR = FULL ? 64 : 128;
  const int tid = threadIdx.x, lane = tid & 63, wave = tid >> 6;
  const int d = sid & 1, h = (sid >> 1) & 7, b = sid >> 4;
  bf16_t* sAt = (bf16_t*)smem;
  bf16_t* sRt = sAt + 32 * 72;
  bf16_t* sBt = sRt + 32 * 72;
  bf16_t* sKt = sBt + 32 * 72;
  bf16_t* sBT = sKt + 32 * 72;
  bf16_t* sKT = sBT + 64 * 40;
  bf16_t* sVT = sKT + 64 * 40;
  bf16_t* sLak = sVT + 64 * 40;
  bf16_t* sM = sLak + 32 * 40;
  bf16_t* sLrb = sM + 32 * 40;
  bf16_t* sLrk = sLrb + 32 * 40;
  bf16_t* sZ = FULL ? sLrk + 32 * 40 : sLrb;
  bf16_t* after = sZ + ZR * 72;
  bf16_t* sRT = FULL ? after : nullptr;
  bf16_t* sSAT = FULL ? after + 64 * 40 : sRt;
  float* sLP = (float*)(FULL ? after + 2 * 64 * 40 : after);
  float* sLab = sLP + 32 * 64;
  float* sD = sLab + 32 * 33;
  float* sPT = sD + 768;
  int* sRow = (int*)(sPT + 64);
  if (!FULL) sRT = (bf16_t*)sLP;
  static_assert((4 * 32 * 72 + 3 * 64 * 40 + 4 * 32 * 40 + 2 * 64 * 40 + 64 * 72) * 2 + (32 * 64 + 32 * 33 + 768 + 64 + 32 + 320) * 4 + 16 <= SMEM_BYTES, "lds full");
  static_assert((4 * 32 * 72 + 3 * 64 * 40 + 2 * 32 * 40 + 128 * 72) * 2 + (32 * 64 + 32 * 33 + 768 + 64 + 32) * 4 <= SMEM_BYTES, "lds p1");
  static_assert(128 * 40 * 2 <= (32 * 64 + 32 * 33) * 4 && 128 * 40 <= 3 * 32 * 72, "alias");
  const bf16_t* proj = (const bf16_t*)(P.ws + OFF_PROJ);
  const bf16_t* lora = (const bf16_t*)(P.ws + OFF_LORA);
  bf16_t* yout = (bf16_t*)(P.ws + OFF_HBUF);
  float* segZ = (float*)(P.ws + OFF_RWSEG);
  const int t = tid >> 3, c0 = (tid & 7) * 8;
  const int hl = lane >> 5, l31 = lane & 31;
  float* sCst = (float*)(smem + SMEM_BYTES - 320 * 4 - 16);
  if (tid < 64) {
    sCst[tid] = P.in[I_MU][h * 64 + tid]; sCst[64 + tid] = P.in[I_MU][512 + h * 64 + tid]; sCst[128 + tid] = P.in[I_MU][1024 + h * 64 + tid];
    sCst[192 + tid] = P.in[I_KK][h * 64 + tid]; sCst[256 + tid] = P.in[I_KA][h * 64 + tid];
  }
  const int cc0 = (seg * RW_NCH) / RW_NSEG, cc1 = ((seg + 1) * RW_NCH) / RW_NSEG;
  RwkvRaw R;
  rwkv_load_raw(proj, lora, b, h, d, cc0, t, c0, R);
  f32x16 Zm[2];
#pragma unroll
  for (int j = 0; j < 2; ++j)
#pragma unroll
    for (int r = 0; r < 16; ++r) Zm[j][r] = 0.f;
  __syncthreads();
  for (int i = tid; i < ZR * 72; i += 256) sZ[i] = 0;
  __syncthreads();
  if (!FULL) {
    if (wave >= 2) {
#pragma unroll
      for (int cb = 0; cb < 2; ++cb)
#pragma unroll
        for (int r = 0; r < 16; ++r) {
          int c = cb * 32 + acc_row(r, lane), vp = wave * 32 + l31;
          if (c == vp - 64) { Zm[cb][r] = 1.f; sZ[vp * 72 + c] = 0x3f80; }
        }
    }
  } else {
    for (int js = 0; js < seg; ++js) {
      const float* Zs = segZ + ((size_t)sid * RW_NSEG + js) * 64 * 128;
      bf16_t* sG = sAt;
      for (int i = tid; i < 64 * 64; i += 256) { int c = i >> 6, c2 = i & 63; sG[c * 72 + c2] = f2bf(Zs[c * 128 + 64 + c2]); }
      __syncthreads();
      if (wave >= 2) {
        const int cb = wave - 2;
#pragma unroll
        for (int vb = 0; vb < 2; ++vb) {
          f32x16 acc;
#pragma unroll
          for (int r = 0; r < 16; ++r) acc[r] = Zs[(cb * 32 + acc_row(r, lane)) * 128 + vb * 32 + l31];
#pragma unroll
          for (int kk = 0; kk < 4; ++kk) {
            bf16x8 a = *(const bf16x8*)(sG + (cb * 32 + l31) * 72 + kk * 16 + 8 * hl);
            bf16x8 bb = *(const bf16x8*)(sZ + (vb * 32 + l31) * 72 + kk * 16 + 8 * hl);
            acc = mfma32(a, bb, acc);
          }
          Zm[vb] = acc;
        }
      }
      __syncthreads();
      if (wave >= 2) {
        const int cb = wave - 2;
#pragma unroll
        for (int vb = 0; vb < 2; ++vb)
#pragma unroll
          for (int g = 0; g < 4; ++g) {
            u32x2 pk; pk.x = pack2(Zm[vb][4 * g], Zm[vb][4 * g + 1]); pk.y = pack2(Zm[vb][4 * g + 2], Zm[vb][4 * g + 3]);
            *(u32x2*)(sZ + (vb * 32 + l31) * 72 + cb * 32 + 8 * g + 4 * hl) = pk;
          }
      }
      __syncthreads();
    }
  }
  for (int cc = cc0; cc < cc1; ++cc) {
    int tl_ = threadIdx.x; OPAQUE(tl_);
    const int tid = tl_, lane = tl_ & 63, hl = lane >> 5, l31 = lane & 31, t = tl_ >> 3, c0 = (tl_ & 7) * 8;
    const float* muR = sCst + c0; const float* muK = sCst + 64 + c0; const float* muV = sCst + 128 + c0;
    const float* kkw = sCst + 192 + c0; const float* kaw = sCst + 256 + c0;
    float lw8[8], lp8[8];
    {
      float lwf[8];
      unpack8(R.lw, lwf);
#pragma unroll
      for (int j = 0; j < 8; ++j) { lw8[j] = -0.6065306597126334f * sigmoidf_(lwf[j]); lp8[j] = lw8[j]; }
#pragma unroll
      for (int off = 8; off < 64; off <<= 1) {
#pragma unroll
        for (int j = 0; j < 8; ++j) {
#ifdef CPU_EMU
          float o = emu_shfl_up(lp8[j], off);
#else
          float o = __shfl_up(lp8[j], off, 64);
#endif
          if (lane >= off) lp8[j] += o;
        }
      }
      if (lane >= 56) {
#pragma unroll
        for (int j = 0; j < 8; ++j) sLP[wave * 64 + c0 + j] = lp8[j];
      }
      if ((tid & 7) == 0) sRow[t] = R.row;
    }
    __syncthreads();
    {
#pragma unroll
      for (int j = 0; j < 8; ++j) {
        float offs = 0.f;
        for (int w2 = 0; w2 < wave; ++w2) offs += sLP[w2 * 64 + c0 + j];
        lp8[j] += offs;
      }
      if (t == 31) {
#pragma unroll
        for (int j = 0; j < 8; ++j) sPT[c0 + j] = fexp(lp8[j]);
      }
    }
    {
      float xs[8], xn[8], kt[8], aa[8], ob[8], ok[8];
      unpack8(R.ks, xs); unpack8(R.kn, xn);
      float ss = 0.f;
#pragma unroll
      for (int j = 0; j < 8; ++j) { kt[j] = xs[j] + muK[j] * (xn[j] - xs[j]); aa[j] = kt[j] * kkw[j]; ss += aa[j] * aa[j]; }
      ss += wshfl_xor(ss, 1); ss += wshfl_xor(ss, 2); ss += wshfl_xor(ss, 4);
      const float rn = frsq(ss + 1e-12f);
      float laf[8];
      unpack8(R.la, laf);
#pragma unroll
      for (int j = 0; j < 8; ++j) {
        const float lp = lp8[j];
        const float lpm = lp8[j] - lw8[j];
        const float e = fexp(-lp);
        const float kkn = aa[j] * rn;
        const float asg = sigmoidf_(laf[j]);
        aa[j] = -kkn * fexp(lpm);
        ob[j] = kkn * asg * e;
        ok[j] = kt[j] * (1.f + (asg - 1.f) * kaw[j]) * e;
      }
      *(u32x4*)(sAt + t * 72 + c0) = pack8(aa);
      *(u32x4*)(sBt + t * 72 + c0) = pack8(ob);
      *(u32x4*)(sKt + t * 72 + c0) = pack8(ok);
#pragma unroll
      for (int j = 0; j < 8; ++j) { sBT[(c0 + j) * 40 + t] = f2bf(ob[j]); sKT[(c0 + j) * 40 + t] = f2bf(ok[j]); }
      unpack8(R.vs, xs); unpack8(R.vn, xn);
#pragma unroll
      for (int j = 0; j < 8; ++j) sVT[(c0 + j) * 40 + t] = f2bf(xs[j] + muV[j] * (xn[j] - xs[j]));
      if (FULL) {
        unpack8(R.rs, xs); unpack8(R.rn, xn);
#pragma unroll
        for (int j = 0; j < 8; ++j) xs[j] = (xs[j] + muR[j] * (xn[j] - xs[j])) * fexp(lp8[j]);
        *(u32x4*)(sRt + t * 72 + c0) = pack8(xs);
      }
    }
    if (cc + 1 < cc1) rwkv_load_raw(proj, lora, b, h, d, cc + 1, t, c0, R);
    __syncthreads();
    if (FULL || wave < 2) {
      const bf16_t* Asrc = wave < 2 ? sAt : sRt;
      const bf16_t* Bsrc = (wave & 1) ? sKt : sBt;
      f32x16 acc;
#pragma unroll
      for (int r = 0; r < 16; ++r) acc[r] = 0.f;
#pragma unroll
      for (int kk = 0; kk < 4; ++kk) {
        bf16x8 a = *(const bf16x8*)(Asrc + l31 * 72 + kk * 16 + 8 * hl);
        bf16x8 bb = *(const bf16x8*)(Bsrc + l31 * 72 + kk * 16 + 8 * hl);
        acc = mfma32(a, bb, acc);
      }
      bf16_t* dst = wave == 1 ? sLak : (wave == 2 ? sLrb : sLrk);
#pragma unroll
      for (int r = 0; r < 16; ++r) {
        int tt = acc_row(r, lane), j = l31;
        bool keep = wave < 2 ? (j < tt) : (j <= tt);
        float v = keep ? acc[r] : 0.f;
        if (wave == 0) sLab[tt * 33 + j] = v;
        else dst[tt * 40 + j] = f2bf(v);
      }
    }
    __syncthreads();
    if (tid < 32) {
      const int q = tid >> 4, c = tid & 15;
      float x[16];
#pragma unroll
      for (int i = 0; i < 16; ++i) {
        float sacc = (i == c) ? 1.f : 0.f;
#pragma unroll
        for (int j = 0; j < i; ++j) sacc += sLab[(q * 16 + i) * 33 + q * 16 + j] * x[j];
        x[i] = sacc;
        sD[q * 256 + i * 16 + c] = sacc;
      }
    }
    __syncthreads();
    {
      const int i = tid >> 4, c = tid & 15;
      float sacc = 0.f;
#pragma unroll
      for (int j = 0; j < 16; ++j) sacc += sLab[(16 + i) * 33 + j] * sD[j * 16 + c];
      sD[512 + i * 16 + c] = sacc;
    }
    __syncthreads();
    {
      const int i = tid >> 4, c = tid & 15;
      float sacc = 0.f;
#pragma unroll
      for (int j = 0; j < 16; ++j) sacc += sD[256 + i * 16 + j] * sD[512 + j * 16 + c];
      sM[(16 + i) * 40 + c] = f2bf(sacc);
      sM[i * 40 + c] = f2bf(sD[i * 16 + c]);
      sM[(16 + i) * 40 + 16 + c] = f2bf(sD[256 + i * 16 + c]);
      sM[i * 40 + 16 + c] = 0;
    }
    if (wave < NVB) {
      const int vb = wave;
      f32x16 acc;
#pragma unroll
      for (int r = 0; r < 16; ++r) acc[r] = 0.f;
#pragma unroll
      for (int kk = 0; kk < 4; ++kk) {
        bf16x8 a = *(const bf16x8*)(sAt + l31 * 72 + kk * 16 + 8 * hl);
        bf16x8 bb = *(const bf16x8*)(sZ + (vb * 32 + l31) * 72 + kk * 16 + 8 * hl);
        acc = mfma32(a, bb, acc);
      }
      if (vb < 2) {
#pragma unroll
        for (int kk = 0; kk < 2; ++kk) {
          bf16x8 a = *(const bf16x8*)(sLak + l31 * 40 + kk * 16 + 8 * hl);
          bf16x8 bb = *(const bf16x8*)(sVT + (vb * 32 + l31) * 40 + kk * 16 + 8 * hl);
          acc = mfma32(a, bb, acc);
        }
      }
#pragma unroll
      for (int g = 0; g < 4; ++g) {
        u32x2 pk; pk.x = pack2(acc[4 * g], acc[4 * g + 1]); pk.y = pack2(acc[4 * g + 2], acc[4 * g + 3]);
        *(u32x2*)(sRT + (vb * 32 + l31) * 40 + 8 * g + 4 * hl) = pk;
      }
    }
    __syncthreads();
    if (wave < NVB) {
      const int vb = wave;
      f32x16 acc;
#pragma unroll
      for (int r = 0; r < 16; ++r) acc[r] = 0.f;
#pragma unroll
      for (int kk = 0; kk < 2; ++kk) {
        bf16x8 a = *(const bf16x8*)(sM + l31 * 40 + kk * 16 + 8 * hl);
        bf16x8 bb = *(const bf16x8*)(sRT + (vb * 32 + l31) * 40 + kk * 16 + 8 * hl);
        acc = mfma32(a, bb, acc);
      }
#pragma unroll
      for (int g = 0; g < 4; ++g) {
        u32x2 pk; pk.x = pack2(acc[4 * g], acc[4 * g + 1]); pk.y = pack2(acc[4 * g + 2], acc[4 * g + 3]);
        *(u32x2*)(sSAT + (vb * 32 + l31) * 40 + 8 * g + 4 * hl) = pk;
      }
    }
    __syncthreads();
    if (FULL) {
      if (wave < 2) {
        const int vb = wave;
        f32x16 acc;
#pragma unroll
        for (int r = 0; r < 16; ++r) acc[r] = 0.f;
#pragma unroll
        for (int kk = 0; kk < 4; ++kk) {
          bf16x8 a = *(const bf16x8*)(sZ + (vb * 32 + l31) * 72 + kk * 16 + 8 * hl);
          bf16x8 bb = *(const bf16x8*)(sRt + l31 * 72 + kk * 16 + 8 * hl);
          acc = mfma32(a, bb, acc);
        }
#pragma unroll
        for (int kk = 0; kk < 2; ++kk) {
          bf16x8 a = *(const bf16x8*)(sSAT + (vb * 32 + l31) * 40 + kk * 16 + 8 * hl);
          bf16x8 bb = *(const bf16x8*)(sLrb + l31 * 40 + kk * 16 + 8 * hl);
          acc = mfma32(a, bb, acc);
        }
#pragma unroll
        for (int kk = 0; kk < 2; ++kk) {
          bf16x8 a = *(const bf16x8*)(sVT + (vb * 32 + l31) * 40 + kk * 16 + 8 * hl);
          bf16x8 bb = *(const bf16x8*)(sLrk + l31 * 40 + kk * 16 + 8 * hl);
          acc = mfma32(a, bb, acc);
        }
        {
          const size_t obase = (size_t)sRow[l31] * 1024 + d * 512 + h * 64 + vb * 32;
#pragma unroll
          for (int g = 0; g < 4; ++g) {
            u32x2 pk; pk.x = pack2(acc[4 * g], acc[4 * g + 1]); pk.y = pack2(acc[4 * g + 2], acc[4 * g + 3]);
            *(u32x2*)(yout + obase + 8 * g + 4 * hl) = pk;
          }
        }
      } else {
        const int cb = wave - 2;
#pragma unroll
        for (int vb = 0; vb < 2; ++vb) {
          f32x16 acc;
#pragma unroll
          for (int r = 0; r < 16; ++r) acc[r] = 0.f;
#pragma unroll
          for (int kk = 0; kk < 2; ++kk) {
            bf16x8 a = *(const bf16x8*)(sBT + (cb * 32 + l31) * 40 + kk * 16 + 8 * hl);
            bf16x8 bb = *(const bf16x8*)(sSAT + (vb * 32 + l31) * 40 + kk * 16 + 8 * hl);
            acc = mfma32(a, bb, acc);
          }
#pragma unroll
          for (int kk = 0; kk < 2; ++kk) {
            bf16x8 a = *(const bf16x8*)(sKT + (cb * 32 + l31) * 40 + kk * 16 + 8 * hl);
            bf16x8 bb = *(const bf16x8*)(sVT + (vb * 32 + l31) * 40 + kk * 16 + 8 * hl);
            acc = mfma32(a, bb, acc);
          }
#pragma unroll
          for (int r = 0; r < 16; ++r) Zm[vb][r] = sPT[cb * 32 + acc_row(r, lane)] * (Zm[vb][r] + acc[r]);
        }
      }
      __syncthreads();
      if (wave >= 2) {
        const int cb = wave - 2;
#pragma unroll
        for (int vb = 0; vb < 2; ++vb)
#pragma unroll
          for (int g = 0; g < 4; ++g) {
            u32x2 pk; pk.x = pack2(Zm[vb][4 * g], Zm[vb][4 * g + 1]); pk.y = pack2(Zm[vb][4 * g + 2], Zm[vb][4 * g + 3]);
            *(u32x2*)(sZ + (vb * 32 + l31) * 72 + cb * 32 + 8 * g + 4 * hl) = pk;
          }
      }
    } else {
      const int vb = wave;
#pragma unroll
      for (int cb = 0; cb < 2; ++cb) {
        f32x16 acc;
#pragma unroll
        for (int r = 0; r < 16; ++r) acc[r] = 0.f;
#pragma unroll
        for (int kk = 0; kk < 2; ++kk) {
          bf16x8 a = *(const bf16x8*)(sBT + (cb * 32 + l31) * 40 + kk * 16 + 8 * hl);
          bf16x8 bb = *(const bf16x8*)(sSAT + (vb * 32 + l31) * 40 + kk * 16 + 8 * hl);
          acc = mfma32(a, bb, acc);
        }
        if (vb < 2) {
#pragma unroll
          for (int kk = 0; kk < 2; ++kk) {
            bf16x8 a = *(const bf16x8*)(sKT + (cb * 32 + l31) * 40 + kk * 16 + 8 * hl);
            bf16x8 bb = *(const bf16x8*)(sVT + (vb * 32 + l31) * 40 + kk * 16 + 8 * hl);
            acc = mfma32(a, bb, acc);
          }
        }
#pragma unroll
        for (int r = 0; r < 16; ++r) Zm[cb][r] = sPT[cb * 32 + acc_row(r, lane)] * (Zm[cb][r] + acc[r]);
      }
#pragma unroll
      for (int cb = 0; cb < 2; ++cb)
#pragma unroll
        for (int g = 0; g < 4; ++g) {
          u32x2 pk; pk.x = pack2(Zm[cb][4 * g], Zm[cb][4 * g + 1]); pk.y = pack2(Zm[cb][4 * g + 2], Zm[cb][4 * g + 3]);
          *(u32x2*)(sZ + (vb * 32 + l31) * 72 + cb * 32 + 8 * g + 4 * hl) = pk;
        }
    }
  }
  if (!FULL) {
    float* Zs = segZ + ((size_t)sid * RW_NSEG + seg) * 64 * 128;
#pragma unroll
    for (int cb = 0; cb < 2; ++cb)
#pragma unroll
      for (int r = 0; r < 16; ++r) Zs[(cb * 32 + acc_row(r, lane)) * 128 + wave * 32 + l31] = Zm[cb][r];
  }
}

constexpr int LRU_NCH = (CTXL + SEQ) / 64;
constexpr size_t OFF_ACUM0 = OFF_PU;
static_assert((size_t)NLAT * 512 * 2 <= (size_t)2 * NEXP * 1024, "acum0");

DEV void st_lru_chunk(const Params& P, int sid, int cc, unsigned char* smem) {
  constexpr int NC_CTX = CTXL / 64;
  const int tid = threadIdx.x, lane = tid & 63, wave = tid >> 6;
  const int d = sid & 1, blk = (sid >> 1) & 7, b = sid >> 4;
  float* sXc = (float*)smem;
  float* sAc = sXc + 4096;
  float* sBc = sAc + 4096;
  float* sU = sBc + 4096;
  bf16_t* sAop = (bf16_t*)(sU + 4096);
  float* sQA = (float*)(sAop + 64 * 72);
  float* sQH = sQA + 256;
  int* sRow = (int*)(sQH + 256);
  const bf16_t* proj = (const bf16_t*)(P.ws + OFF_PROJ);
  bf16_t* uout = (bf16_t*)(P.ws + OFF_LORA) + (size_t)d * NTOK * 512;
  bf16_t* aout = (bf16_t*)(P.ws + (d ? OFF_ACUM1 : OFF_ACUM0));
  const bf16_t* lruT = (const bf16_t*)(P.ws + OFF_LRUT) + (size_t)(d * 8 + blk) * 128 * 64;
  float* chunkS = (float*)(P.ws + OFF_LRUCS) + ((size_t)sid * LRU_NCH + cc) * 128;
  const float* cw = P.in[I_LCONVW];
  const float* cb = P.in[I_LCONVB];
  const int tr = (wave >> 1) * 32, nc0 = (wave & 1) * 64;
  const int sgi = cc >= NC_CTX;
  const int row0 = sgi ? NCTX + b * SEQ : b * CTXL;
  const int len = sgi ? SEQ : CTXL;
  const int cl = (sgi ? cc - NC_CTX : cc) * 64;
  __syncthreads();
  if (tid < 64) { int p = cl + tid; sRow[tid] = row0 + (d ? len - 1 - p : p); }
  {
    const int lc8 = (tid & 7) * 8, lch = blk * 64 + lc8;
#pragma unroll
    for (int i = 0; i < 2; ++i) {
      int c = tid + i * 256, r = c >> 3;
      int p = cl + r, pos = d ? len - 1 - p : p;
      float o[8];
      f32x4 c0 = *(const f32x4*)(cb + lch), c1 = *(const f32x4*)(cb + lch + 4);
      o[0] = c0.x; o[1] = c0.y; o[2] = c0.z; o[3] = c0.w; o[4] = c1.x; o[5] = c1.y; o[6] = c1.z; o[7] = c1.w;
#pragma unroll
      for (int tap = 0; tap < 4; ++tap) {
        int pp = pos + tap - 2;
        if (pp >= 0 && pp < len) {
          float x[8];
          unpack8(*(const u32x4*)(proj + (size_t)(row0 + pp) * ODC + 2304 + lch), x);
          f32x4 w0 = *(const f32x4*)(cw + tap * 512 + lch), w1 = *(const f32x4*)(cw + tap * 512 + lch + 4);
          o[0] += w0.x * x[0]; o[1] += w0.y * x[1]; o[2] += w0.z * x[2]; o[3] += w0.w * x[3];
          o[4] += w1.x * x[4]; o[5] += w1.y * x[5]; o[6] += w1.z * x[6]; o[7] += w1.w * x[7];
        }
      }
#pragma unroll
      for (int j = 0; j < 8; ++j) sXc[r * 64 + lc8 + j] = o[j];
      *(u32x4*)(sAop + r * 72 + lc8) = pack8(o);
    }
  }
  __syncthreads();
  {
    f32x16 acc[2];
#pragma unroll
    for (int j = 0; j < 2; ++j)
#pragma unroll
      for (int r = 0; r < 16; ++r) acc[j][r] = 0.f;
#pragma unroll
    for (int kk = 0; kk < 4; ++kk) {
      bf16x8 a = *(const bf16x8*)(sAop + (tr + (lane & 31)) * 72 + kk * 16 + 8 * (lane >> 5));
#pragma unroll
      for (int j = 0; j < 2; ++j) {
        bf16x8 bb = *(const bf16x8*)(lruT + (nc0 + j * 32 + (lane & 31)) * 64 + kk * 16 + 8 * (lane >> 5));
        acc[j] = mfma32(a, bb, acc[j]);
      }
    }
#pragma unroll
    for (int j = 0; j < 2; ++j) {
      const int e = nc0 + j * 32 + (lane & 31);
      const int ch = blk * 64 + (e & 63);
      const float ebias = e < 64 ? P.in[I_BA][d * 512 + ch] : P.in[I_BI][d * 512 + ch];
      const float esp = softplusf_(-P.in[I_LAM][d * 512 + ch]);
#pragma unroll
      for (int r = 0; r < 16; ++r) {
        int t = tr + acc_row(r, lane);
        float g = sigmoidf_(acc[j][r] + ebias);
        if (e < 64) { float a_ = fexp(-8.f * g * esp); sAc[t * 64 + e] = a_; sU[t * 64 + e] = fsqrt(fmaxf(1.f - a_ * a_, 0.f)); }
        else sBc[t * 64 + (e - 64)] = g * sXc[t * 64 + (e - 64)];
      }
    }
  }
  __syncthreads();
  const int c = tid & 63, q = tid >> 6;
  {
    float h = 0.f, ap = 1.f;
#pragma unroll 4
    for (int i = 0; i < 16; ++i) {
      const int t = q * 16 + i;
      const float a = sAc[t * 64 + c];
      h = a * h + sU[t * 64 + c] * sBc[t * 64 + c];
      ap *= a;
      sU[t * 64 + c] = h; sAc[t * 64 + c] = ap;
    }
    sQA[q * 64 + c] = ap; sQH[q * 64 + c] = h;
  }
  __syncthreads();
  {
    float hin = 0.f, ain = 1.f;
    for (int q2 = 0; q2 < q; ++q2) { hin = sQA[q2 * 64 + c] * hin + sQH[q2 * 64 + c]; ain *= sQA[q2 * 64 + c]; }
    if (q > 0) {
#pragma unroll 4
      for (int i = 0; i < 16; ++i) {
        const int t = q * 16 + i;
        const float ap = sAc[t * 64 + c];
        sU[t * 64 + c] += ap * hin;
        sAc[t * 64 + c] = ap * ain;
      }
    }
    if (q == 3) { chunkS[c] = sAc[63 * 64 + c]; chunkS[64 + c] = sU[63 * 64 + c]; }
  }
  __syncthreads();
  if (sgi) {
#pragma unroll
    for (int i = 0; i < 2; ++i) {
      int cidx = tid + i * 256, r = cidx >> 3, c8 = (cidx & 7) * 8;
      float u8[8], a8[8];
#pragma unroll
      for (int j = 0; j < 8; ++j) { u8[j] = sU[r * 64 + c8 + j]; a8[j] = sAc[r * 64 + c8 + j]; }
      const int row = sRow[r];
      *(u32x4*)(uout + (size_t)row * 512 + blk * 64 + c8) = pack8(u8);
      *(u32x4*)(aout + (size_t)(row - NCTX) * 512 + blk * 64 + c8) = pack8(a8);
    }
  }
}

DEV void st_lru_carry(const Params& P, int sid) {
  const int c = threadIdx.x;
  if (c >= 64) return;
  const float* cs = (const float*)(P.ws + OFF_LRUCS) + (size_t)sid * LRU_NCH * 128;
  float* hs = (float*)(P.ws + OFF_LRUHS) + (size_t)sid * LRU_NCH * 64;
  float h = 0.f;
  for (int cc0 = 0; cc0 < LRU_NCH; cc0 += 10) {
    float a[10], bb[10];
#pragma unroll
    for (int i = 0; i < 10; ++i) { a[i] = cs[(size_t)(cc0 + i) * 128 + c]; bb[i] = cs[(size_t)(cc0 + i) * 128 + 64 + c]; }
#pragma unroll
    for (int i = 0; i < 10; ++i) { hs[(size_t)(cc0 + i) * 64 + c] = h; h = a[i] * h + bb[i]; }
  }
}

DEV void st_finish_l1(const Params& P, int row) {
  const int lane = threadIdx.x & 63;
  bf16_t* hb = (bf16_t*)(P.ws + OFF_HBUF) + (size_t)row * 1024;
  const bf16_t* proj = (const bf16_t*)(P.ws + OFF_PROJ);
  const bf16_t* lora = (const bf16_t*)(P.ws + OFF_LORA);
  const float* mu = P.in[I_MU];
  const int ch = lane * 8;
  float y0[8], y1[8];
  unpack8(*(const u32x4*)(hb + ch), y0);
  unpack8(*(const u32x4*)(hb + 512 + ch), y1);
  float sm = 0.f;
#pragma unroll
  for (int j = 0; j < 8; ++j) { y0[j] += y1[j]; sm += y0[j]; }
  sm += wshfl_xor(sm, 1); sm += wshfl_xor(sm, 2); sm += wshfl_xor(sm, 4);
  const float mean = sm * (1.f / 64.f);
  float sv = 0.f;
#pragma unroll
  for (int j = 0; j < 8; ++j) { float dlt = y0[j] - mean; sv += dlt * dlt; }
  sv += wshfl_xor(sv, 1); sv += wshfl_xor(sv, 2); sv += wshfl_xor(sv, 4);
  const float rstd = frsq(sv * (1.f / 64.f) + 64e-5f);
  float a0[8], a1[8], g[8], u0[8], u1[8], gb[8];
  unpack8(*(const u32x4*)(lora + ((size_t)2 * NTOK + row) * 512 + ch), a0);
  unpack8(*(const u32x4*)(lora + ((size_t)3 * NTOK + row) * 512 + ch), a1);
  unpack8(*(const u32x4*)(lora + ((size_t)4 * NTOK + row) * 512 + ch), g);
  unpack8(*(const u32x4*)(lora + ((size_t)0 * NTOK + row) * 512 + ch), u0);
  unpack8(*(const u32x4*)(lora + ((size_t)1 * NTOK + row) * 512 + ch), u1);
  if (row >= NCTX) {
    const int bb_ = (row - NCTX) / SEQ, pos = (row - NCTX) % SEQ, blk = ch >> 6;
    float ac[8];
#pragma unroll
    for (int dd = 0; dd < 2; ++dd) {
      const int pidx = dd ? SEQ - 1 - pos : pos;
      const int cc = CTXL / 64 + pidx / 64;
      const int sid = (bb_ * 8 + blk) * 2 + dd;
      const float* hs = (const float*)(P.ws + OFF_LRUHS) + ((size_t)sid * LRU_NCH + cc) * 64 + (ch & 63);
      unpack8(*(const u32x4*)((const bf16_t*)(P.ws + (dd ? OFF_ACUM1 : OFF_ACUM0)) + (size_t)(row - NCTX) * 512 + ch), ac);
      f32x4 h0 = *(const f32x4*)hs, h1 = *(const f32x4*)(hs + 4);
      float* u = dd ? u1 : u0;
      u[0] += ac[0] * h0.x; u[1] += ac[1] * h0.y; u[2] += ac[2] * h0.z; u[3] += ac[3] * h0.w;
      u[4] += ac[4] * h1.x; u[5] += ac[5] * h1.y; u[6] += ac[6] * h1.z; u[7] += ac[7] * h1.w;
    }
  }
  unpack8(*(const u32x4*)(proj + (size_t)row * ODC + 1792 + ch), gb);
  float rv[8], vv[8];
  float sdot = 0.f;
#pragma unroll
  for (int j = 0; j < 8; ++j) {
    float r = mixval(proj, row, ch + j, mu);
    float k = mixval(proj, row, 512 + ch + j, mu);
    vv[j] = mixval(proj, row, 1024 + ch + j, mu);
    float am = 0.5f * (sigmoidf_(a0[j]) + sigmoidf_(a1[j]));
    float kb = k * (1.f + (am - 1.f) * P.in[I_KA][ch + j]);
    sdot += r * kb * P.in[I_RK][ch + j];
    rv[j] = r;
  }
  sdot += wshfl_xor(sdot, 1); sdot += wshfl_xor(sdot, 2); sdot += wshfl_xor(sdot, 4);
  float f1[8], f2[8];
#pragma unroll
  for (int j = 0; j < 8; ++j) {
    float yn = (y0[j] - mean) * rstd * P.in[I_LNW][ch + j] + P.in[I_LNB][ch + j];
    yn += sdot * vv[j];
    f1[j] = yn * g[j];
    f2[j] = (u0[j] + u1[j]) * geluf_(gb[j]);
  }
  *(u32x4*)(hb + ch) = pack8(f1);
  *(u32x4*)(hb + 512 + ch) = pack8(f2);
}

DEV unsigned fkey(float f) { unsigned u; __builtin_memcpy(&u, &f, 4); return (u >> 31) ? ~u : (u | 0x80000000u); }
DEV float keyf(unsigned u) { u = (u >> 31) ? (u & 0x7fffffffu) : ~u; float f; __builtin_memcpy(&f, &u, 4); return f; }
DEV void key_insert(unsigned x, unsigned* v) {
#pragma unroll
  for (int j = 0; j < 16; ++j) { unsigned hi = v[j] > x ? v[j] : x; x = v[j] > x ? x : v[j]; v[j] = hi; }
}
DEV void key_cx(unsigned& hi, unsigned& lo) { unsigned a = hi, b = lo; hi = a > b ? a : b; lo = a > b ? b : a; }
DEV void key_sort16(unsigned* v) {
#pragma unroll
  for (int k = 2; k <= 16; k <<= 1)
#pragma unroll
    for (int j = k >> 1; j > 0; j >>= 1)
#pragma unroll
      for (int i = 0; i < 16; ++i) {
        const int l = i ^ j;
        if (l > i) { if ((i & k) == 0) key_cx(v[i], v[l]); else key_cx(v[l], v[i]); }
      }
}
DEV void key_merge16(unsigned* a, const unsigned* b) {
#pragma unroll
  for (int i = 0; i < 16; ++i) a[i] = a[i] > b[15 - i] ? a[i] : b[15 - i];
#pragma unroll
  for (int j = 8; j > 0; j >>= 1)
#pragma unroll
    for (int i = 0; i < 16; ++i) { const int l = i ^ j; if (l > i) key_cx(a[i], a[l]); }
}

DEV void st_peer_topk(const Params& P, int layer, int tile, int h, unsigned char* smem) {
  const int tid = threadIdx.x;
  const bf16_t* q = (const bf16_t*)(P.ws + OFF_Q);
  const bf16_t* keys = (const bf16_t*)(P.ws + OFF_KEYS) + (size_t)(layer * 8 + h) * 2 * 128 * 128;
  float* sS = (float*)smem;
  const int m0 = tile * 128;
  const int tok = tid & 127, half = tid >> 7;
  unsigned kl[2][16];
#pragma unroll
  for (int p = 0; p < 2; ++p) {
    EpiScoreLds epi{sS, m0};
    gemm_tile_128<true>(q + (h * 2 + p) * 128, 2048, NTOK, keys + p * 128 * 128, 128, 128, 128, m0, 0, epi, smem);
    __syncthreads();
    float* row = sS + tok * 129 + half * 64;
#pragma unroll
    for (int g = 0; g < 4; ++g) {
      unsigned grp[16];
#pragma unroll
      for (int j = 0; j < 16; ++j) grp[j] = (fkey(row[g * 16 + j]) & ~127u) | (unsigned)(127 - (half * 64 + g * 16 + j));
      key_sort16(grp);
      if (g == 0) {
#pragma unroll
        for (int j = 0; j < 16; ++j) kl[p][j] = grp[j];
      } else key_merge16(kl[p], grp);
    }
    if (half == 1) {
#pragma unroll
      for (int j = 0; j < 16; ++j) row[j] = __builtin_bit_cast(float, kl[p][j]);
    }
    __syncthreads();
    if (half == 0) {
      unsigned oth[16];
#pragma unroll
      for (int j = 0; j < 16; ++j) oth[j] = __builtin_bit_cast(unsigned, sS[tok * 129 + 64 + j]);
      key_merge16(kl[p], oth);
    }
    __syncthreads();
  }
  if (tid < 128) {
    float sv0[16], sv1[16];
    int* irow = (int*)(sS + tid * 129);
#pragma unroll
    for (int j = 0; j < 16; ++j) {
      sv0[j] = keyf((kl[0][j] & ~127u) | 64u); sv1[j] = keyf((kl[1][j] & ~127u) | 64u);
      irow[j] = 127 - (int)(kl[0][j] & 127u); irow[16 + j] = 127 - (int)(kl[1][j] & 127u);
    }
    unsigned best[16];
#pragma unroll
    for (int j = 0; j < 16; ++j) best[j] = 0u;
#pragma unroll
    for (int i = 0; i < 16; ++i)
#pragma unroll
      for (int j = 0; j < 16; ++j)
        if ((i + 1) * (j + 1) <= 16) key_insert((fkey(sv0[i] + sv1[j]) & ~255u) | (unsigned)(255 - (i * 16 + j)), best);
    float e[16], sum = 0.f;
    const float b0 = keyf((best[0] & ~255u) | 128u);
#pragma unroll
    for (int j = 0; j < 16; ++j) { e[j] = fexp(keyf((best[j] & ~255u) | 128u) - b0); sum += e[j]; }
    const float inv = 1.f / sum;
    int* pidx = (int*)(P.ws + OFF_PIDX) + (size_t)(m0 + tid) * 128 + h * 16;
    float* pg = (float*)(P.ws + OFF_PGATE) + (size_t)(m0 + tid) * 128 + h * 16;
#pragma unroll
    for (int j = 0; j < 16; ++j) {
      const int pos = 255 - (int)(best[j] & 255u);
      pidx[j] = irow[pos >> 4] * 128 + irow[16 + (pos & 15)];
      pg[j] = e[j] * inv;
    }
  }
}

DEV void st_peer_experts(const Params& P, int layer, int row) {
  const int lane = threadIdx.x & 63;
  const bf16_t* xb = (const bf16_t*)(P.ws + OFF_HBUF) + (size_t)row * 1024;
  const unsigned char* U = P.ws + OFF_PU;
  const int* pidx = (const int*)(P.ws + OFF_PIDX) + (size_t)row * 128;
  const float* pg = (const float*)(P.ws + OFF_PGATE) + (size_t)row * 128;
  float x[16], acc[16];
  unpack8(*(const u32x4*)(xb + lane * 16), x);
  unpack8(*(const u32x4*)(xb + lane * 16 + 8), x + 8);
#pragma unroll
  for (int j = 0; j < 16; ++j) acc[j] = 0.f;
  const int b5 = (lane >> 5) & 1, b4 = (lane >> 4) & 1, b3 = (lane >> 3) & 1;
  const int mypick = (lane >> 3) & 7;
  for (int k0 = 0; k0 < 128; k0 += 8) {
    u32x3 uu[8]; u32x2 vv[8];
#pragma unroll
    for (int i = 0; i < 8; ++i) {
      const unsigned char* er = U + (size_t)pidx[k0 + i] * PEER_ROWB;
      const unsigned* up = (const unsigned*)(er + lane * 12);
      uu[i].x = up[0]; uu[i].y = up[1]; uu[i].z = up[2];
      vv[i] = *(const u32x2*)(er + PEER_VOFF + lane * 8);
    }
    const float mygate = pg[k0 + mypick];
    float dsum[8];
#pragma unroll
    for (int i = 0; i < 8; ++i) {
      float uf[16];
#ifndef CPU_EMU
      __builtin_amdgcn_sched_barrier(0);
#endif
      unpack16_fp6(uu[i], uf);
      float dd = 0.f;
#pragma unroll
      for (int j = 0; j < 16; ++j) dd += x[j] * uf[j];
      dsum[i] = dd;
    }
    float e4[4], e2[2], g;
#pragma unroll
    for (int i = 0; i < 4; ++i) {
      float mine = b5 ? dsum[4 + i] : dsum[i], send = b5 ? dsum[i] : dsum[4 + i];
      e4[i] = mine + wshfl_xor(send, 32);
    }
#pragma unroll
    for (int i = 0; i < 2; ++i) {
      float mine = b4 ? e4[2 + i] : e4[i], send = b4 ? e4[i] : e4[2 + i];
      e2[i] = mine + wshfl_xor(send, 16);
    }
    {
      float mine = b3 ? e2[1] : e2[0], send = b3 ? e2[0] : e2[1];
      g = mine + wshfl_xor(send, 8);
    }
    g += wshfl_xor(g, 4); g += wshfl_xor(g, 2); g += wshfl_xor(g, 1);
    const float mycoef = mygate * geluf_(g * (1.f / PEER_USCALE));
#pragma unroll
    for (int i = 0; i < 8; ++i) {
      const float coef = wreadlane(mycoef, i * 8);
      float vf[16];
      unpack8_fp4(vv[i].x, vf); unpack8_fp4(vv[i].y, vf + 8);
#pragma unroll
      for (int j = 0; j < 16; ++j) acc[j] += coef * vf[j];
    }
  }
  float* xr = row < NCTX ? (float*)(P.ws + OFF_CTXRES) + (size_t)row * 1024 : P.out + (size_t)(row - NCTX) * 1024;
  const float* g2 = (const float*)(P.ws + OFF_MODV) + ((size_t)layer * 3 + mod_row(row)) * 6144 + 5 * 1024;
  float o[16];
#pragma unroll
  for (int q = 0; q < 4; ++q) {
    const int c = lane * 16 + q * 4;
    f32x4 a = *(const f32x4*)(xr + c), ga = *(const f32x4*)(g2 + c);
    o[q * 4 + 0] = a.x + ga.x * acc[q * 4 + 0] * (1.f / PEER_VSCALE); o[q * 4 + 1] = a.y + ga.y * acc[q * 4 + 1] * (1.f / PEER_VSCALE);
    o[q * 4 + 2] = a.z + ga.z * acc[q * 4 + 2] * (1.f / PEER_VSCALE); o[q * 4 + 3] = a.w + ga.w * acc[q * 4 + 3] * (1.f / PEER_VSCALE);
  }
  float ss = 0.f;
#pragma unroll
  for (int j = 0; j < 16; ++j) ss += o[j] * o[j];
  ss = wave_sum(ss);
  const float rstd = frsq(ss * (1.f / 1024.f) + 1e-6f);
  if (layer == 1) {
#pragma unroll
    for (int j = 0; j < 16; ++j) o[j] *= rstd * P.in[I_FNORM][lane * 16 + j];
  }
#pragma unroll
  for (int q = 0; q < 4; ++q) {
    f32x4 a = {o[q * 4 + 0], o[q * 4 + 1], o[q * 4 + 2], o[q * 4 + 3]};
    *(f32x4*)(xr + lane * 16 + q * 4) = a;
  }
  if (layer == 0) {
    const float* mv = (const float*)(P.ws + OFF_MODV) + ((size_t)1 * 3 + mod_row(row)) * 6144;
    const float* nw = P.in[I_NORM1] + 1024;
    float hh[16];
#pragma unroll
    for (int q = 0; q < 4; ++q) {
      const int c = lane * 16 + q * 4;
      f32x4 w4 = *(const f32x4*)(nw + c), s4 = *(const f32x4*)(mv + 1024 + c), h4 = *(const f32x4*)(mv + c);
      hh[q * 4 + 0] = o[q * 4 + 0] * rstd * w4.x * (1.f + s4.x) + h4.x; hh[q * 4 + 1] = o[q * 4 + 1] * rstd * w4.y * (1.f + s4.y) + h4.y;
      hh[q * 4 + 2] = o[q * 4 + 2] * rstd * w4.z * (1.f + s4.z) + h4.z; hh[q * 4 + 3] = o[q * 4 + 3] * rstd * w4.w * (1.f + s4.w) + h4.w;
    }
    bf16_t* hb = (bf16_t*)(P.ws + OFF_HBUF) + (size_t)row * 1024 + lane * 16;
    *(u32x4*)hb = pack8(hh);
    *(u32x4*)(hb + 8) = pack8(hh + 8);
  }
}


#define FOR_TILES_XCD(MT0, MT1, NT, mt, nt)                                                     \
  for (int _x = blockIdx.x & 7, _mlo = (MT0) + (((MT1) - (MT0)) * _x) / 8,                        \
           _mhi = (MT0) + (((MT1) - (MT0)) * (_x + 1)) / 8, _i = blockIdx.x >> 3,                 \
           _cnt = (_mhi - _mlo) * (NT), mt = 0, nt = 0;                                           \
       _i < _cnt && ((mt = _mlo + _i / (NT)), (nt = _i % (NT)), true); _i += (int)(gridDim.x >> 3))

#ifndef PHASE_LIST
#define PHASE_LIST(X) X(0) X(1) X(2) X(22) X(23) X(3) X(4) X(5) X(6) X(7) X(8) X(9) X(11) X(12) X(13) X(30) X(14) X(15) X(31) X(16) X(17) X(18) X(19) X(20) X(21)
#endif
constexpr int PH_LAST = 21;

template <int ph>
DEV void run_phase(const Params& P, unsigned char* smem) {
  int bid_ = blockIdx.x, wave_ = threadIdx.x >> 6;
  OPAQUE_S(bid_); OPAQUE(wave_);
  const int bid = bid_, nb = gridDim.x;
  const int wave = wave_;
  unsigned char* ws = P.ws;
  constexpr int layer = ((ph >= 10 && ph <= 21) || ph >= 30) ? 1 : 0;
  const float* modv_l = (const float*)(ws + OFF_MODV) + (size_t)layer * 3 * 6144;
  switch (ph) {
    case 0:
      for (int t = NTRANS + bid; t < NPREP; t += nb) st_prep(P, t, smem);
      break;
    case 1: case 10:
      if (ph == 1) for (int t = nb - 1 - bid; t < NTRANS; t += nb) st_prep(P, t, smem);
      for (int t = bid; t < NTOK / 4; t += nb) st_normmod(P, layer, 0, t * 4 + wave);
      break;
    case 2: {
      EpiProjL0T epi{(bf16_t*)(ws + OFF_PROJ), (float*)(ws + OFF_GATES)};
      FOR_TILES_XCD(0, NTOK / 256, 25, mt, nt)
        gemm_tile_128x256<EpiProjL0T, true>((const bf16_t*)(ws + OFF_WEVIN), 1024, EVC, (const bf16_t*)(ws + OFF_HBUF), 1024, NTOK, 1024,
                                            nt * 128, mt * 256, epi, smem);
    } break;
    case 22:
      for (int t = bid; t < NTOK / 4; t += nb) st_xbc_conv(P, t * 4 + wave);
      for (int t = bid; t < NPCONV; t += nb) st_peer_conv(P, 0, t);
      break;
    case 23:
      for (int t = bid; t < 48 * LA_NSEG; t += nb) {
        int sid = t % 48, seg = t / 48;
        if (sid < 16) st_linattn_seg<true, false>(P, sid, seg, smem);
        else st_linattn_seg<false, false>(P, sid - 16, seg, smem);
      }
      break;
    case 3:
      for (int t = bid; t < 48 * LA_NSEG; t += nb) {
        int sid = t % 48, seg = t / 48;
        if (sid < 16) st_linattn_seg<true, true>(P, sid, seg, smem);
        else st_linattn_seg<false, true>(P, sid - 16, seg, smem);
      }
      break;
    case 4:
      for (int t = bid; t < NTOK / 4; t += nb) st_finish_l0(P, t * 4 + wave);
      break;
    case 5: case 17: {
      EpiOutProjT epi{layer == 0 ? P.in[I_X] : P.out, P.in[I_CTX], P.out, (float*)(ws + OFF_CTXRES), modv_l};
      const bf16_t* Wt = (const bf16_t*)(ws + (layer == 0 ? OFF_WEVOUT : OFF_WODOUT));
      FOR_TILES_XCD(layer == 0 ? 0 : NCTX / 256, NTOK / 256, 8, mt, nt)
        gemm_tile_128x256<EpiOutProjT, true>(Wt, 1024, 1024, (const bf16_t*)(ws + OFF_HBUF), 1024, NTOK, 1024, nt * 128, mt * 256, epi, smem);
    } break;
    case 6: case 18: {
      const int r0 = layer == 0 ? 0 : NCTX / 4;
      for (int t = r0 + bid; t < NTOK / 4; t += nb) st_normmod(P, layer, 1, t * 4 + wave);
      if (ph == 18) for (int t = bid; t < NPCONV; t += nb) st_peer_conv(P, 1, t);
    } break;
    case 7: case 19: {
      EpiStoreBfT epi{(bf16_t*)(ws + OFF_Q), 2048};
      const bf16_t* Wt = (const bf16_t*)(ws + OFF_WQ) + (size_t)layer * 2048 * 1024;
      FOR_TILES_XCD(layer == 0 ? 0 : NCTX / 256, NTOK / 256, 16, mt, nt)
        gemm_tile_128x256<EpiStoreBfT, true>(Wt, 1024, 2048, (const bf16_t*)(ws + OFF_HBUF), 1024, NTOK, 1024, nt * 128, mt * 256, epi, smem);
    } break;
    case 8: case 20: {
      const int t0 = layer == 0 ? 0 : CTILE * 8;
      for (int t = t0 + bid; t < NTILE * 8; t += nb) st_peer_topk(P, layer, t / 8, t % 8, smem);
    } break;
    case 9: case 21: {
      const int r0 = layer == 0 ? 0 : NCTX / 4;
      for (int t = r0 + bid; t < NTOK / 4; t += nb) st_peer_experts(P, layer, t * 4 + wave);
    } break;
    case 11: {
      EpiStoreBfT epi{(bf16_t*)(ws + OFF_PROJ), ODC};
      FOR_TILES_XCD(0, NTOK / 256, 22, mt, nt)
        gemm_tile_128x256<EpiStoreBfT, true>((const bf16_t*)(ws + OFF_WODIN), 1024, ODC, (const bf16_t*)(ws + OFF_HBUF), 1024, NTOK, 1024,
                                             nt * 128, mt * 256, epi, smem);
    } break;
    case 12:
      for (int t = bid; t < NTOK / 4; t += nb) st_lora_act(P, t * 4 + wave);
      break;
    case 13:
      for (int t = bid; t < NTILE * 20; t += nb) {
        int job = t / (NTILE * 4), tt = t % (NTILE * 4);
        int mt = tt / 4, nt = tt % 4;
        bf16_t* dst = (bf16_t*)(ws + OFF_LORA) + (size_t)job * NTOK * 512;
        const bf16_t* A = (const bf16_t*)(ws + OFF_HBUF) + (job < 2 ? 0 : (job < 4 ? 64 : 128));
        const bf16_t* Bt = job < 2 ? (const bf16_t*)(ws + OFF_WUP) + (size_t)job * 512 * 64
                         : job < 4 ? (const bf16_t*)(ws + OFF_AUP) + (size_t)(job - 2) * 512 * 64
                                   : (const bf16_t*)(ws + OFF_GUP);
        const float* bias = job < 2 ? P.in[I_W0] + job * 512 : (job < 4 ? P.in[I_A0] + (job - 2) * 512 : nullptr);
        const int K = job < 4 ? 64 : 128;
        EpiStoreBfBiasT epi{dst, 512, bias};
        gemm_tile_128<false, EpiStoreBfBiasT, true>(Bt, K, 512, A, 1024, NTOK, K, nt * 128, mt * 128, epi, smem);
      }
      break;
    case 30:
      for (int t = bid; t < 32 * RW_NSEG; t += nb) st_rwkv_seg<false>(P, t % 32, t / 32, smem);
      break;
    case 14:
      for (int t = bid; t < 32 * RW_NSEG; t += nb) st_rwkv_seg<true>(P, t % 32, t / 32, smem);
      break;
    case 15:
      for (int t = bid; t < 32 * LRU_NCH; t += nb) st_lru_chunk(P, t % 32, t / 32, smem);
      break;
    case 31:
      if (bid < 32) st_lru_carry(P, bid);
      break;
    case 16:
      for (int t = bid; t < NTOK / 4; t += nb) st_finish_l1(P, t * 4 + wave);
      break;
    default: break;
  }
}


#ifndef CPU_EMU
#define XB_TMO      128
#define XB_XCNT(j)  (256  + 64 * (j))
#define XB_XSUB(j)  (1280 + 64 * (j))
#define XB_XGEN(j)  (2304 + 64 * (j))
#define XB_TOP      3328
#define XB_TOPGEN   3392
#define XCD_BAR_WORDS 3456
#define XB_SPIN_CAP (1u << 20)
#define LAS __attribute__((address_space(3)))
__device__ __forceinline__ unsigned xb_ld(unsigned* p)              { return __hip_atomic_load(p, __ATOMIC_RELAXED, __HIP_MEMORY_SCOPE_AGENT); }
__device__ __forceinline__ unsigned xb_add(unsigned* p, unsigned v) { return __hip_atomic_fetch_add(p, v, __ATOMIC_RELAXED, __HIP_MEMORY_SCOPE_AGENT); }
__device__ __forceinline__ unsigned xb_xcc_id() { return (unsigned)__builtin_amdgcn_s_getreg((3 << 11) | 20) & 0xFu; }
#define XB_SPIN(cond, bar) do { unsigned _sp = 0; while (cond) { __builtin_amdgcn_s_sleep(1); \
    if ((++_sp & 255u) == 0u) { if (xb_ld(&(bar)[XB_TMO])) break; if (_sp > XB_SPIN_CAP) { atomicAdd(&(bar)[XB_TMO], 1u); break; } } } } while (0)
struct XcdBarrier { unsigned* bar; unsigned x; volatile LAS unsigned* st; };
__device__ __forceinline__ XcdBarrier xcd_barrier_post(unsigned* bar, volatile LAS unsigned* st) {
  XcdBarrier b; b.bar = bar; b.x = xb_xcc_id(); b.st = st;
  if (threadIdx.x == 0) (void)xb_add(&bar[XB_XCNT(b.x)], 1u);
  return b;
}
__device__ __forceinline__ void xcd_barrier_complete(unsigned* bar, unsigned x, unsigned& nloc, unsigned& nx) {
  const unsigned G = gridDim.x * gridDim.y * gridDim.z;
  unsigned sum, cnt, mine, sp = 0u;
  for (;;) {
    sum = 0u; cnt = 0u; mine = 0u;
#pragma unroll
    for (unsigned j = 0; j < 16; ++j) { const unsigned c = xb_ld(&bar[XB_XCNT(j)]); sum += c; cnt += (c > 0u) ? 1u : 0u; mine = (j == x) ? c : mine; }
    if (sum == G) break;
    __builtin_amdgcn_s_sleep(1);
    if ((++sp & 255u) == 0u) { if (xb_ld(&bar[XB_TMO])) break; if (sp > XB_SPIN_CAP) { atomicAdd(&bar[XB_TMO], 1u); break; } }
  }
  nloc = mine > 0u ? mine : 1u; nx = cnt > 0u ? cnt : 1u;
}
__device__ __forceinline__ void xcd_barrier(const XcdBarrier& b) {
  asm volatile("s_waitcnt vmcnt(0)" ::: "memory");
  __syncthreads();
  if (threadIdx.x == 0) {
    unsigned* bar = b.bar;
    __builtin_amdgcn_s_waitcnt(0);
    unsigned nloc = b.st[0], nx = b.st[1];
    if (nloc == 0u) { xcd_barrier_complete(bar, b.x, nloc, nx); b.st[0] = nloc; b.st[1] = nx; }
    const unsigned old = xb_add(&bar[XB_XSUB(b.x)], 1u);
    const unsigned gen = old / nloc;
    if (old + 1u == (gen + 1u) * nloc) {
      __builtin_amdgcn_fence(__ATOMIC_RELEASE, "agent");
      asm volatile("s_waitcnt vmcnt(0)" ::: "memory");
      const unsigned og = xb_add(&bar[XB_TOP], 1u);
      const unsigned tg = og / nx;
      if (og + 1u == (tg + 1u) * nx) xb_add(&bar[XB_TOPGEN], 1u);
      else XB_SPIN(xb_ld(&bar[XB_TOPGEN]) == tg, bar);
      __builtin_amdgcn_fence(__ATOMIC_ACQUIRE, "agent");
      xb_add(&bar[XB_XGEN(b.x)], 1u);
      asm volatile("s_waitcnt vmcnt(0)" ::: "memory");
    } else {
      XB_SPIN(xb_ld(&bar[XB_XGEN(b.x)]) == gen, bar);
      __builtin_amdgcn_fence(__ATOMIC_ACQUIRE, "agent");
      asm volatile("s_waitcnt vmcnt(0)" ::: "memory");
    }
  }
  __syncthreads();
}
#endif
#ifndef CPU_EMU
#define RUN_PH(n) run_phase<n>(P, smem_raw); if (n != PH_LAST) xcd_barrier(xb);
__global__ void __launch_bounds__(256, 2) mega_kernel(Params P) {
  SMEM_DECL;
  unsigned* bar = (unsigned*)(P.ws + OFF_BAR);
  volatile LAS unsigned* st = (volatile LAS unsigned*)(smem_raw + SMEM_BYTES - 16);
  if (threadIdx.x == 0) { st[0] = 0u; st[1] = 0u; }
  if (P.ws == nullptr) cg::this_grid().sync();
  __syncthreads();
  XcdBarrier xb = xcd_barrier_post(bar, st);
  PHASE_LIST(RUN_PH)
}

extern "C" void kernel_launch(void* const* d_in, const int* in_sizes, int n_in, void* d_out, int out_size, void* d_ws,
                              size_t ws_size, hipStream_t stream) {
  Params P{};
  for (int i = 0; i < N_IN; ++i) P.in[i] = (const float*)d_in[i];
  P.out = (float*)d_out;
  P.ws = (unsigned char*)d_ws;
  if (ws_size < WS_NEEDED) { fprintf(stderr, "workspace too small: %zu < %zu\n", ws_size, (size_t)WS_NEEDED); return; }
  static int grid_blocks = 0;
  if (!grid_blocks) {
    int dev = 0, cus = 0, per_cu = 0;
    hipGetDevice(&dev);
    hipDeviceGetAttribute(&cus, hipDeviceAttributeMultiprocessorCount, dev);
    hipOccupancyMaxActiveBlocksPerMultiprocessor(&per_cu, mega_kernel, 256, 0);
    if (per_cu > 2) per_cu = 2;
    grid_blocks = cus * per_cu;
  }
  (void)hipMemsetAsync((unsigned char*)d_ws + OFF_BAR, 0, 16384, stream);
  void* args[] = {&P};
  hipError_t e = hipLaunchCooperativeKernel((void*)mega_kernel, dim3(grid_blocks), dim3(256), args, 0, stream);
  if (e != hipSuccess) fprintf(stderr, "cooperative launch failed: %s (grid %d)\n", hipGetErrorString(e), grid_blocks);
}
#endif
```

```cpp
#ifdef CPU_EMU
#include "emu.h"
#else
#include <hip/hip_runtime.h>
#include <hip/hip_cooperative_groups.h>
#include <cstdio>
namespace cg = cooperative_groups;
#define DEV __device__ __forceinline__
#define DEVM __device__ __forceinline__
#define OPAQUE(x) asm volatile("" : "+v"(x))
#define OPAQUE_S(x) asm volatile("" : "+s"(x))
#endif

#ifndef SEQ_LEN
#define SEQ_LEN 16384
#endif
#ifndef CTX_LEN
#define CTX_LEN 256
#endif
#ifndef GRID_W_
#define GRID_W_ 64
#endif
#ifndef MULTI_LAUNCH
#define MULTI_LAUNCH 0
#endif

typedef unsigned short bf16_t;
typedef __attribute__((ext_vector_type(8))) short bf16x8;
typedef __attribute__((ext_vector_type(16))) float f32x16;
typedef __attribute__((ext_vector_type(4))) unsigned u32x4;
typedef __attribute__((ext_vector_type(2))) unsigned u32x2;
typedef __attribute__((ext_vector_type(4))) float f32x4;

constexpr int D = 1024, NB = 2, SEQ = SEQ_LEN, CTXL = CTX_LEN, GW = GRID_W_;
constexpr int NCTX = NB * CTXL, NLAT = NB * SEQ, NTOK = NCTX + NLAT;
constexpr int EVC = 3104, ODC = 2816;
constexpr int NEXP = 16384;
constexpr int NTILE = NTOK / 128, CTILE = NCTX / 128;
static_assert(NTOK % 256 == 0 && NCTX % 256 == 0, "tiles");
static_assert(CTXL % 64 == 0 && SEQ % 64 == 0 && SEQ % GW == 0, "chunks");

constexpr size_t al256(size_t x) { return (x + 255) & ~(size_t)255; }
constexpr size_t OFF_MODV = 0;
constexpr size_t OFF_CTXRES = OFF_MODV + al256(2 * 3 * 6144 * 4);
constexpr size_t OFF_GATES = OFF_CTXRES + al256((size_t)NCTX * 1024 * 4);
constexpr size_t OFF_WEVIN = OFF_GATES + al256((size_t)NTOK * 32 * 4);
constexpr size_t OFF_WEVOUT = OFF_WEVIN + al256((size_t)EVC * 1024 * 2);
constexpr size_t OFF_WODIN = OFF_WEVOUT + al256((size_t)1024 * 1024 * 2);
constexpr size_t OFF_WODOUT = OFF_WODIN + al256((size_t)ODC * 1024 * 2);
constexpr size_t OFF_WQ = OFF_WODOUT + al256((size_t)1024 * 1024 * 2);
constexpr size_t OFF_KEYS = OFF_WQ + al256((size_t)2 * 2048 * 1024 * 2);
constexpr size_t OFF_WUP = OFF_KEYS + al256((size_t)2 * 8 * 2 * 128 * 128 * 2);
constexpr size_t OFF_AUP = OFF_WUP + al256((size_t)2 * 512 * 64 * 2);
constexpr size_t OFF_GUP = OFF_AUP + al256((size_t)2 * 512 * 64 * 2);
constexpr size_t OFF_LRUT = OFF_GUP + al256((size_t)512 * 128 * 2);
constexpr size_t OFF_PU = OFF_LRUT + al256((size_t)2 * 8 * 128 * 64 * 2);
constexpr size_t OFF_PV = OFF_PU + al256((size_t)NEXP * 1024);
constexpr size_t OFF_HBUF = OFF_PV + al256((size_t)NEXP * 1024);
constexpr size_t OFF_PR = OFF_HBUF + al256((size_t)NTOK * 1024 * 2);
constexpr size_t PR_BYTES = (size_t)NTOK * 5376 * 2;
constexpr size_t OFF_BAR = OFF_PR + PR_BYTES;
constexpr size_t OFF_ACUM1 = OFF_BAR + 16384;
constexpr size_t OFF_LRUCS = OFF_ACUM1 + (size_t)NLAT * 512 * 2;
constexpr size_t OFF_LRUHS = OFF_LRUCS + (size_t)32 * ((CTXL + SEQ) / 64) * 128 * 4;
constexpr size_t WS_NEEDED = OFF_LRUHS + (size_t)32 * ((CTXL + SEQ) / 64) * 64 * 4;
#ifndef CPU_EMU
static_assert(WS_NEEDED <= (size_t)512 * 1024 * 1024, "workspace too large");
#endif
constexpr size_t OFF_PROJ = OFF_PR;
constexpr size_t OFF_R2L0 = OFF_PR + (size_t)NTOK * EVC * 2;
constexpr size_t OFF_LORA = OFF_PR + (size_t)NTOK * ODC * 2;
constexpr size_t OFF_Q = OFF_PR;
constexpr size_t OFF_PIDX = OFF_PR + (size_t)NTOK * 2048 * 2;
constexpr size_t OFF_PGATE = OFF_PIDX + (size_t)NTOK * 128 * 4;
static_assert(OFF_PGATE + (size_t)NTOK * 128 * 4 <= OFF_PR + PR_BYTES, "picks");

enum {
  I_X = 0, I_C, I_CTX, I_CCTX, I_MODW, I_MODB, I_NORM1, I_NORM2, I_WQ, I_KEYS, I_PU, I_PV,
  I_EVWIN, I_EVWOUT, I_IBIAS, I_FBIAS, I_MNORM, I_SCONVW, I_SCONVB, I_DTBIAS, I_ALOG, I_DSKIP, I_SNORM,
  I_ODWIN, I_ODWOUT, I_MU, I_W0, I_WUP, I_A0, I_AUP, I_GUP, I_KK, I_KA, I_RK, I_LNW, I_LNB,
  I_LCONVW, I_LCONVB, I_LAM, I_WA, I_BA, I_WI, I_BI, I_FNORM, N_IN
};

struct Params {
  const float* in[N_IN];
  float* out;
  unsigned char* ws;
};

constexpr int SMEM_BYTES = 80 * 1024;
#ifdef CPU_EMU
#define SMEM_DECL static thread_local __attribute__((aligned(16))) unsigned char smem_raw[SMEM_BYTES]
#else
#define SMEM_DECL __shared__ __attribute__((aligned(16))) unsigned char smem_raw[SMEM_BYTES]
#endif

DEV float bf2f(bf16_t v) { unsigned u = ((unsigned)v) << 16; float f; __builtin_memcpy(&f, &u, 4); return f; }
DEV bf16_t f2bf(float f) { unsigned u; __builtin_memcpy(&u, &f, 4); u += 0x7fffu + ((u >> 16) & 1u); return (bf16_t)(u >> 16); }
DEV unsigned pack2(float a, float b) { return (unsigned)f2bf(a) | ((unsigned)f2bf(b) << 16); }
DEV void unpack8(const u32x4& r, float* o) {
  unsigned w[4] = {r.x, r.y, r.z, r.w};
#pragma unroll
  for (int i = 0; i < 4; ++i) { unsigned lo = w[i] << 16, hi = w[i] & 0xffff0000u; __builtin_memcpy(&o[2 * i], &lo, 4); __builtin_memcpy(&o[2 * i + 1], &hi, 4); }
}
DEV u32x4 pack8(const float* o) { u32x4 r; r.x = pack2(o[0], o[1]); r.y = pack2(o[2], o[3]); r.z = pack2(o[4], o[5]); r.w = pack2(o[6], o[7]); return r; }
#ifdef CPU_EMU
DEV float fexp(float x) { return expf(x); }
DEV float frcp(float x) { return 1.f / x; }
DEV float flog(float x) { return logf(x); }
DEV float frsq(float x) { return 1.f / sqrtf(x); }
DEV float fsqrt(float x) { return sqrtf(x); }
#else
DEV float fexp(float x) { return __expf(x); }
DEV float frcp(float x) { return __builtin_amdgcn_rcpf(x); }
DEV float flog(float x) { return __logf(x); }
DEV float frsq(float x) { return __builtin_amdgcn_rsqf(x); }
DEV float fsqrt(float x) { return __builtin_amdgcn_sqrtf(x); }
#endif
DEV float sigmoidf_(float x) { return frcp(1.f + fexp(-x)); }
DEV float siluf_(float x) { return x * frcp(1.f + fexp(-x)); }
DEV float softplusf_(float x) { return fmaxf(x, 0.f) + flog(1.f + fexp(-fabsf(x))); }
DEV float tanhf_(float x) { return 1.f - 2.f * frcp(1.f + fexp(2.f * x)); }
DEV float geluf_(float x) { return 0.5f * x * (1.f + erff(x * 0.70710678118654752f)); }

DEV f32x16 mfma32(bf16x8 a, bf16x8 b, f32x16 c) {
#ifdef CPU_EMU
  return emu_mfma32(a, b, c);
#else
  return __builtin_amdgcn_mfma_f32_32x32x16_bf16(a, b, c, 0, 0, 0);
#endif
}
DEV float wshfl_xor(float v, int m) {
#ifdef CPU_EMU
  return emu_shfl_xor(v, m);
#else
  return __shfl_xor(v, m, 64);
#endif
}
DEV float wave_sum(float v) {
#pragma unroll
  for (int m = 32; m >= 1; m >>= 1) v += wshfl_xor(v, m);
  return v;
}

#ifdef CPU_EMU
static inline unsigned emu_f2fp8(float f) {
  unsigned sgn = f < 0.f ? 0x80u : 0u; float a = fabsf(f);
  if (!(a == a)) return 0x7f;
  if (a >= 448.f) return sgn | 0x7e;
  if (a < 0.0009765625f) return sgn;
  int e; frexpf(a, &e); e -= 1;
  if (e < -6) { int q = (int)nearbyintf(a * 512.f); return sgn | (unsigned)q; }
  float m = a / ldexpf(1.f, e);
  int q = (int)nearbyintf((m - 1.f) * 8.f);
  if (q == 8) { q = 0; e += 1; }
  if (e > 8) return sgn | 0x7e;
  return sgn | (unsigned)((e + 7) << 3) | (unsigned)q;
}
static inline float emu_fp82f(unsigned c) {
  unsigned sgn = c & 0x80, e = (c >> 3) & 15, m = c & 7;
  float v = e == 0 ? ldexpf((float)m, -9) : ldexpf(1.f + m / 8.f, (int)e - 7);
  return sgn ? -v : v;
}
#endif
DEV unsigned pack4_fp8(float a, float b, float c, float d) {
#ifdef CPU_EMU
  return emu_f2fp8(a) | (emu_f2fp8(b) << 8) | (emu_f2fp8(c) << 16) | (emu_f2fp8(d) << 24);
#else
  int w = 0;
  w = __builtin_amdgcn_cvt_pk_fp8_f32(a, b, w, false);
  w = __builtin_amdgcn_cvt_pk_fp8_f32(c, d, w, true);
  return (unsigned)w;
#endif
}
DEV void unpack4_fp8(unsigned w, float* o) {
#ifdef CPU_EMU
  o[0] = emu_fp82f(w & 255); o[1] = emu_fp82f((w >> 8) & 255); o[2] = emu_fp82f((w >> 16) & 255); o[3] = emu_fp82f(w >> 24);
#else
  typedef __attribute__((ext_vector_type(2))) float f32x2_;
  f32x2_ lo = __builtin_amdgcn_cvt_pk_f32_fp8((int)w, false);
  f32x2_ hi = __builtin_amdgcn_cvt_pk_f32_fp8((int)w, true);
  o[0] = lo.x; o[1] = lo.y; o[2] = hi.x; o[3] = hi.y;
#endif
}
DEV void unpack16_fp8(const u32x4& r, float* o) { unpack4_fp8(r.x, o); unpack4_fp8(r.y, o + 4); unpack4_fp8(r.z, o + 8); unpack4_fp8(r.w, o + 12); }
DEV float wreadlane(float v, int srclane) {
#ifdef CPU_EMU
  return emu_readlane(v, srclane);
#else
  int iv; __builtin_memcpy(&iv, &v, 4);
  int r = __builtin_amdgcn_readlane(iv, srclane);
  float f; __builtin_memcpy(&f, &r, 4); return f;
#endif
}
constexpr float PEER_USCALE = 64.f, PEER_VSCALE = 4.f;
#ifdef CPU_EMU
static inline unsigned emu_f2fp4(float f) {
  static const float lv[8] = {0.f, 0.5f, 1.f, 1.5f, 2.f, 3.f, 4.f, 6.f};
  unsigned sgn = f < 0.f ? 8u : 0u; float a = fabsf(f);
  int best = 0; float bd = 1e30f;
  for (int i = 0; i < 8; ++i) { float dd = fabsf(a - lv[i]); if (dd < bd || (dd == bd && (i & 1) == 0)) { bd = dd; best = i; } }
  return sgn | (unsigned)best;
}
static inline float emu_fp42f(unsigned c) {
  static const float lv[8] = {0.f, 0.5f, 1.f, 1.5f, 2.f, 3.f, 4.f, 6.f};
  float v = lv[c & 7]; return (c & 8) ? -v : v;
}
#endif
DEV unsigned pack8_fp4(const float* v) {
#ifdef CPU_EMU
  unsigned w = 0;
  for (int i = 0; i < 8; ++i) w |= emu_f2fp4(v[i]) << (4 * i);
  return w;
#else
  unsigned w = 0;
  w = __builtin_amdgcn_cvt_scalef32_pk_fp4_f32(w, v[0], v[1], 1.0f, 0);
  w = __builtin_amdgcn_cvt_scalef32_pk_fp4_f32(w, v[2], v[3], 1.0f, 1);
  w = __builtin_amdgcn_cvt_scalef32_pk_fp4_f32(w, v[4], v[5], 1.0f, 2);
  w = __builtin_amdgcn_cvt_scalef32_pk_fp4_f32(w, v[6], v[7], 1.0f, 3);
  return w;
#endif
}
DEV void unpack8_fp4(unsigned w, float* o) {
#ifdef CPU_EMU
  for (int i = 0; i < 8; ++i) o[i] = emu_fp42f((w >> (4 * i)) & 15u);
#else
  typedef __attribute__((ext_vector_type(2))) float f32x2_;
  f32x2_ a = __builtin_amdgcn_cvt_scalef32_pk_f32_fp4(w, 1.0f, 0);
  f32x2_ b = __builtin_amdgcn_cvt_scalef32_pk_f32_fp4(w, 1.0f, 1);
  f32x2_ c = __builtin_amdgcn_cvt_scalef32_pk_f32_fp4(w, 1.0f, 2);
  f32x2_ d = __builtin_amdgcn_cvt_scalef32_pk_f32_fp4(w, 1.0f, 3);
  o[0] = a.x; o[1] = a.y; o[2] = b.x; o[3] = b.y; o[4] = c.x; o[5] = c.y; o[6] = d.x; o[7] = d.y;
#endif
}
typedef __attribute__((ext_vector_type(3))) unsigned u32x3;
#ifndef FP6_INTERLEAVED
#define FP6_INTERLEAVED 1
#endif
#ifdef CPU_EMU
static inline unsigned emu_f2fp6(float f) {
  unsigned sgn = f < 0.f ? 32u : 0u; float a = fabsf(f);
  if (a >= 7.5f) return sgn | 31u;
  int e; unsigned code;
  if (a < 1.f) { int q = (int)nearbyintf(a * 8.f); code = (unsigned)q; }
  else { frexpf(a, &e); e -= 1; float m = a / ldexpf(1.f, e); int q = (int)nearbyintf((m - 1.f) * 8.f); if (q == 8) { q = 0; e += 1; } code = (unsigned)(((e + 1) << 3) | q); if (e > 2) code = 31u; }
  return sgn | code;
}
static inline float emu_fp62f(unsigned c) {
  unsigned e = (c >> 3) & 3, m = c & 7;
  float v = e == 0 ? m * 0.125f : ldexpf(1.f + m / 8.f, (int)e - 1);
  return (c & 32) ? -v : v;
}
#endif
DEV u32x3 pack16_fp6(const float* v) {
#ifdef CPU_EMU
  unsigned long long lo = 0; unsigned hi = 0;
  for (int i = 0; i < 16; ++i) {
    unsigned long long c = emu_f2fp6(v[i]); int bit = 6 * i;
    if (bit < 64) { lo |= c << bit; if (bit > 58) hi |= (unsigned)(c >> (64 - bit)); } else hi |= (unsigned)(c << (bit - 64));
  }
  u32x3 r; r.x = (unsigned)lo; r.y = (unsigned)(lo >> 32); r.z = hi; return r;
#else
  typedef __attribute__((ext_vector_type(6))) unsigned u32x6_;
  f32x16 a, b;
#if FP6_INTERLEAVED
#pragma unroll
  for (int i = 0; i < 8; ++i) { a[i] = v[2 * i]; b[i] = v[2 * i + 1]; a[8 + i] = 0.f; b[8 + i] = 0.f; }
#else
#pragma unroll
  for (int i = 0; i < 16; ++i) { a[i] = v[i]; b[i] = 0.f; }
#endif
  u32x6_ w = __builtin_amdgcn_cvt_scalef32_2xpk16_fp6_f32(a, b, 1.0f);
  u32x3 r; r.x = w[0]; r.y = w[1]; r.z = w[2]; return r;
#endif
}
DEV void unpack16_fp6(const u32x3& r, float* o) {
#ifdef CPU_EMU
  unsigned long long lo = (unsigned long long)r.x | ((unsigned long long)r.y << 32); unsigned hi = r.z;
  for (int i = 0; i < 16; ++i) {
    int bit = 6 * i; unsigned c;
    if (bit + 6 <= 64) c = (unsigned)(lo >> bit) & 63u;
    else if (bit >= 64) c = (hi >> (bit - 64)) & 63u;
    else c = ((unsigned)(lo >> bit) | (hi << (64 - bit))) & 63u;
    o[i] = emu_fp62f(c);
  }
#else
  typedef __attribute__((ext_vector_type(6))) unsigned u32x6_;
  typedef __attribute__((ext_vector_type(32))) float f32x32_;
  u32x6_ w; w[0] = r.x; w[1] = r.y; w[2] = r.z; w[3] = 0u; w[4] = 0u; w[5] = 0u;
  f32x32_ f = __builtin_amdgcn_cvt_scalef32_pk32_f32_fp6(w, 1.0f);
#pragma unroll
  for (int i = 0; i < 16; ++i) o[i] = f[i];
#endif
}
DEV void unpack2x16_fp6(const u32x3& ra, const u32x3& rb, float* oa, float* ob) {
#ifdef CPU_EMU
  unpack16_fp6(ra, oa); unpack16_fp6(rb, ob);
#else
  typedef __attribute__((ext_vector_type(6))) unsigned u32x6_;
  typedef __attribute__((ext_vector_type(32))) float f32x32_;
  u32x6_ w; w[0] = ra.x; w[1] = ra.y; w[2] = ra.z; w[3] = rb.x; w[4] = rb.y; w[5] = rb.z;
  f32x32_ f = __builtin_amdgcn_cvt_scalef32_pk32_f32_fp6(w, 1.0f);
#pragma unroll
  for (int i = 0; i < 16; ++i) { oa[i] = f[i]; ob[i] = f[16 + i]; }
#endif
}
constexpr int PEER_ROWB = 1280;
constexpr int PEER_VOFF = 768;


DEV int acc_row(int reg, int lane) { return (reg & 3) + 8 * (reg >> 2) + 4 * (lane >> 5); }

DEV int mod_row(int row) { return row < NCTX ? 2 : (row - NCTX) / SEQ; }

template <bool SYNC_EPI, class Epi, bool VEC4 = false>
DEV void gemm_tile_128(const bf16_t* __restrict__ A, int lda, int M, const bf16_t* __restrict__ Bt, int ldb, int N,
                       int K, int m0, int n0, const Epi& epi, unsigned char* smem) {
  constexpr int LS = 72;
  constexpr int STAGE = 2 * 128 * LS;
  bf16_t* sbase = (bf16_t*)smem;
  const int wave = threadIdx.x >> 6;
  const int wm = (wave >> 1) * 64, wn = (wave & 1) * 64;
  f32x16 acc[2][2];
#pragma unroll
  for (int i = 0; i < 2; ++i)
#pragma unroll
    for (int j = 0; j < 2; ++j)
#pragma unroll
      for (int r = 0; r < 16; ++r) acc[i][j][r] = 0.f;
  u32x4 ra[4], rb[4];
  auto gload = [&](int k0) {
    int tl_ = threadIdx.x; OPAQUE(tl_);
#pragma unroll
    for (int i = 0; i < 4; ++i) {
      int c = tl_ + i * 256, r = c >> 3, cc = (c & 7) * 8;
      int gr = m0 + r, gn = n0 + r;
      gr = gr < M ? gr : M - 1; gn = gn < N ? gn : N - 1;
      ra[i] = *(const u32x4*)(A + (size_t)gr * lda + k0 + cc);
      rb[i] = *(const u32x4*)(Bt + (size_t)gn * ldb + k0 + cc);
    }
  };
  auto lwrite = [&](int buf) {
    int tl_ = threadIdx.x; OPAQUE(tl_);
    bf16_t* sA = sbase + buf * STAGE;
    bf16_t* sB = sA + 128 * LS;
#pragma unroll
    for (int i = 0; i < 4; ++i) {
      int c = tl_ + i * 256, r = c >> 3, cc = (c & 7) * 8;
      *(u32x4*)(sA + r * LS + cc) = ra[i];
      *(u32x4*)(sB + r * LS + cc) = rb[i];
    }
  };
  const int nk = K >> 6;
  gload(0);
  __syncthreads();
  lwrite(0);
  if (nk > 1) gload(64);
  __syncthreads();
  for (int it = 0; it < nk; ++it) {
    int tl_ = threadIdx.x; OPAQUE(tl_);
    const int lane = tl_ & 63;
    const bf16_t* sA = sbase + (it & 1) * STAGE;
    const bf16_t* sB = sA + 128 * LS;
#pragma unroll
    for (int kk = 0; kk < 4; ++kk) {
      bf16x8 a[2], b[2];
      const int ko = kk * 16 + 8 * (lane >> 5);
#pragma unroll
      for (int i = 0; i < 2; ++i) a[i] = *(const bf16x8*)(sA + (wm + i * 32 + (lane & 31)) * LS + ko);
#pragma unroll
      for (int j = 0; j < 2; ++j) b[j] = *(const bf16x8*)(sB + (wn + j * 32 + (lane & 31)) * LS + ko);
#pragma unroll
      for (int i = 0; i < 2; ++i)
#pragma unroll
        for (int j = 0; j < 2; ++j) acc[i][j] = mfma32(a[i], b[j], acc[i][j]);
      if (kk == 1) {
        if (it + 1 < nk) lwrite((it + 1) & 1);
        if (it + 2 < nk) gload((it + 2) * 64);
      }
    }
    __syncthreads();
  }
  {
    int tl_ = threadIdx.x; OPAQUE(tl_);
    const int lane = tl_ & 63;
    if constexpr (VEC4) {
#pragma unroll
      for (int i = 0; i < 2; ++i)
#pragma unroll
        for (int j = 0; j < 2; ++j)
#pragma unroll
          for (int gq = 0; gq < 4; ++gq) {
            int row = m0 + wm + i * 32 + 8 * gq + 4 * (lane >> 5);
            int col = n0 + wn + j * 32 + (lane & 31);
            if (row < M && col < N) epi.store4(row, col, acc[i][j][4 * gq], acc[i][j][4 * gq + 1], acc[i][j][4 * gq + 2], acc[i][j][4 * gq + 3]);
          }
    } else {
#pragma unroll
      for (int i = 0; i < 2; ++i)
#pragma unroll
        for (int j = 0; j < 2; ++j)
#pragma unroll
          for (int r = 0; r < 16; ++r) {
            int row = m0 + wm + i * 32 + acc_row(r, lane);
            int col = n0 + wn + j * 32 + (lane & 31);
            if (row < M && col < N) epi(row, col, acc[i][j][r]);
          }
    }
  }
}

template <class Epi, bool VEC4 = false>
DEV void gemm_tile_128x256(const bf16_t* __restrict__ A, int lda, int M, const bf16_t* __restrict__ Bt, int ldb, int N,
                           int K, int m0, int n0, const Epi& epi, unsigned char* smem) {
  constexpr int LS = 72;
  bf16_t* sA = (bf16_t*)smem;
  bf16_t* sB = sA + 128 * LS;
  const int wave = threadIdx.x >> 6;
  const int wm = (wave >> 1) * 64, wn = (wave & 1) * 128;
  f32x16 acc[2][4];
#pragma unroll
  for (int i = 0; i < 2; ++i)
#pragma unroll
    for (int j = 0; j < 4; ++j)
#pragma unroll
      for (int r = 0; r < 16; ++r) acc[i][j][r] = 0.f;
  u32x4 ra[4], rb[8];
  {
    const int tid = threadIdx.x;
#pragma unroll
    for (int i = 0; i < 4; ++i) {
      int c = tid + i * 256, r = c >> 3, cc = (c & 7) * 8;
      { int gr = m0 + r; gr = gr < M ? gr : M - 1; ra[i] = *(const u32x4*)(A + (size_t)gr * lda + cc); }
    }
#pragma unroll
    for (int i = 0; i < 8; ++i) {
      int c = tid + i * 256, r = c >> 3, cc = (c & 7) * 8;
      { int gn = n0 + r; gn = gn < N ? gn : N - 1; rb[i] = *(const u32x4*)(Bt + (size_t)gn * ldb + cc); }
    }
  }
  for (int k0 = 0; k0 < K; k0 += 64) {
    int tl_ = threadIdx.x; OPAQUE(tl_);
    const int tid = tl_, lane = tl_ & 63;
    __syncthreads();
#pragma unroll
    for (int i = 0; i < 4; ++i) { int c = tid + i * 256, r = c >> 3, cc = (c & 7) * 8; *(u32x4*)(sA + r * LS + cc) = ra[i]; }
#pragma unroll
    for (int i = 0; i < 8; ++i) { int c = tid + i * 256, r = c >> 3, cc = (c & 7) * 8; *(u32x4*)(sB + r * LS + cc) = rb[i]; }
    __syncthreads();
    if (k0 + 64 < K) {
#pragma unroll
      for (int i = 0; i < 4; ++i) {
        int c = tid + i * 256, r = c >> 3, cc = (c & 7) * 8;
        { int gr = m0 + r; gr = gr < M ? gr : M - 1; ra[i] = *(const u32x4*)(A + (size_t)gr * lda + k0 + 64 + cc); }
      }
#pragma unroll
      for (int i = 0; i < 8; ++i) {
        int c = tid + i * 256, r = c >> 3, cc = (c & 7) * 8;
        { int gn = n0 + r; gn = gn < N ? gn : N - 1; rb[i] = *(const u32x4*)(Bt + (size_t)gn * ldb + k0 + 64 + cc); }
      }
    }
#pragma unroll 2
    for (int kk = 0; kk < 4; ++kk) {
      bf16x8 a[2], b[4];
      const int ko = kk * 16 + 8 * (lane >> 5);
#pragma unroll
      for (int i = 0; i < 2; ++i) a[i] = *(const bf16x8*)(sA + (wm + i * 32 + (lane & 31)) * LS + ko);
#pragma unroll
      for (int j = 0; j < 4; ++j) b[j] = *(const bf16x8*)(sB + (wn + j * 32 + (lane & 31)) * LS + ko);
#pragma unroll
      for (int i = 0; i < 2; ++i)
#pragma unroll
        for (int j = 0; j < 4; ++j) acc[i][j] = mfma32(a[i], b[j], acc[i][j]);
    }
  }
  {
    int tl_ = threadIdx.x; OPAQUE(tl_);
    const int lane = tl_ & 63;
    if constexpr (VEC4) {
#pragma unroll
      for (int i = 0; i < 2; ++i)
#pragma unroll
        for (int j = 0; j < 4; ++j)
#pragma unroll
          for (int gq = 0; gq < 4; ++gq) {
            int row = m0 + wm + i * 32 + 8 * gq + 4 * (lane >> 5);
            int col = n0 + wn + j * 32 + (lane & 31);
            if (row < M && col < N) epi.store4(row, col, acc[i][j][4 * gq], acc[i][j][4 * gq + 1], acc[i][j][4 * gq + 2], acc[i][j][4 * gq + 3]);
          }
    } else {
#pragma unroll
      for (int i = 0; i < 2; ++i)
#pragma unroll
        for (int j = 0; j < 4; ++j)
#pragma unroll
          for (int r = 0; r < 16; ++r) {
            int row = m0 + wm + i * 32 + acc_row(r, lane);
            int col = n0 + wn + j * 32 + (lane & 31);
            if (row < M && col < N) epi(row, col, acc[i][j][r]);
          }
    }
  }
}

DEV void transpose_tile(const float* __restrict__ src, int ld_src, bf16_t* __restrict__ dst, int ld_dst, int K, int N,
                        int tk, int tn, unsigned char* smem) {
  float* sT = (float*)smem;
  const int tid = threadIdx.x;
  __syncthreads();
  {
    const int tx = tid & 15, ty = tid >> 4;
#pragma unroll
    for (int p = 0; p < 4; ++p) {
      int k = tk * 64 + ty + p * 16, n = tn * 64 + tx * 4;
#pragma unroll
      for (int j = 0; j < 4; ++j) {
        float v = (k < K && n + j < N) ? src[(size_t)k * ld_src + n + j] : 0.f;
        sT[(ty + p * 16) * 65 + tx * 4 + j] = v;
      }
    }
  }
  __syncthreads();
  {
    const int n = tid >> 2, kseg = (tid & 3) * 16;
    int gn = tn * 64 + n;
    if (gn < N) {
      float v[16];
#pragma unroll
      for (int j = 0; j < 16; ++j) v[j] = sT[(kseg + j) * 65 + n];
      bf16_t* d = dst + (size_t)gn * ld_dst + tk * 64 + kseg;
      *(u32x4*)d = pack8(v);
      *(u32x4*)(d + 8) = pack8(v + 8);
    }
  }
}

constexpr int TJ0 = 16 * 49, TJ1 = 16 * 16, TJ2 = 16 * 44, TJ3 = 16 * 16, TJ4 = 2 * 16 * 32, TJ5 = 2 * 8, TJ6 = 2 * 8,
              TJ7 = 2 * 8, TJ8 = 32;
constexpr int NTRANS = TJ0 + TJ1 + TJ2 + TJ3 + TJ4 + TJ5 + TJ6 + TJ7 + TJ8;
constexpr int NKEYCV = (2 * 8 * 2 * 128 * 128) / (256 * 8);
constexpr int NMODV = 2 * 96;
constexpr int NPREP = NTRANS + NKEYCV + NMODV;

DEV void st_prep(const Params& P, int item, unsigned char* smem) {
  unsigned char* ws = P.ws;
  if (item < NTRANS) {
    int t = item;
    if (t < TJ0) { transpose_tile(P.in[I_EVWIN], EVC, (bf16_t*)(ws + OFF_WEVIN), 1024, 1024, EVC, t / 49, t % 49, smem); return; }
    t -= TJ0;
    if (t < TJ1) { transpose_tile(P.in[I_EVWOUT], 1024, (bf16_t*)(ws + OFF_WEVOUT), 1024, 1024, 1024, t / 16, t % 16, smem); return; }
    t -= TJ1;
    if (t < TJ2) { transpose_tile(P.in[I_ODWIN], ODC, (bf16_t*)(ws + OFF_WODIN), 1024, 1024, ODC, t / 44, t % 44, smem); return; }
    t -= TJ2;
    if (t < TJ3) { transpose_tile(P.in[I_ODWOUT], 1024, (bf16_t*)(ws + OFF_WODOUT), 1024, 1024, 1024, t / 16, t % 16, smem); return; }
    t -= TJ3;
    if (t < TJ4) {
      int l = t / 512, tt = t % 512;
      transpose_tile(P.in[I_WQ] + (size_t)l * 1024 * 2048, 2048, (bf16_t*)(ws + OFF_WQ) + (size_t)l * 2048 * 1024, 1024, 1024, 2048, tt / 32, tt % 32, smem);
      return;
    }
    t -= TJ4;
    if (t < TJ5) { int d = t / 8; transpose_tile(P.in[I_WUP] + d * 64 * 512, 512, (bf16_t*)(ws + OFF_WUP) + d * 512 * 64, 64, 64, 512, 0, t % 8, smem); return; }
    t -= TJ5;
    if (t < TJ6) { int d = t / 8; transpose_tile(P.in[I_AUP] + d * 64 * 512, 512, (bf16_t*)(ws + OFF_AUP) + d * 512 * 64, 64, 64, 512, 0, t % 8, smem); return; }
    t -= TJ6;
    if (t < TJ7) { transpose_tile(P.in[I_GUP], 512, (bf16_t*)(ws + OFF_GUP), 128, 128, 512, t / 8, t % 8, smem); return; }
    t -= TJ7;
    {
      int which = t & 1, db = t >> 1;
      const float* src = (which ? P.in[I_WI] : P.in[I_WA]) + (size_t)db * 64 * 64;
      transpose_tile(src, 64, (bf16_t*)(ws + OFF_LRUT) + (size_t)db * 128 * 64 + which * 64 * 64, 64, 64, 64, 0, 0, smem);
      return;
    }
  }
  item -= NTRANS;
  if (item < NKEYCV) {
    size_t e = ((size_t)item * 256 + threadIdx.x) * 8;
    const float* s = P.in[I_KEYS] + e;
    f32x4 a = *(const f32x4*)s, b = *(const f32x4*)(s + 4);
    float v[8] = {a.x, a.y, a.z, a.w, b.x, b.y, b.z, b.w};
    *(u32x4*)((bf16_t*)(ws + OFF_KEYS) + e) = pack8(v);
    return;
  }
  item -= NKEYCV;
  {
    const int l = item / 96, cgp = item % 96;
    float* sS = (float*)smem;
    float* sRed = sS + 3 * 1024;
    const int tid = threadIdx.x;
    __syncthreads();
    for (int i = tid; i < 3 * 1024; i += 256) {
      int m = i >> 10, k = i & 1023;
      float c = m < 2 ? P.in[I_C][m * 1024 + k] : P.in[I_CCTX][k];
      sS[i] = siluf_(c);
    }
    __syncthreads();
    const int ks = tid >> 6, col = cgp * 64 + (tid & 63);
    const float* w = P.in[I_MODW] + (size_t)l * 1024 * 6144 + col;
    float a0 = 0.f, a1 = 0.f, a2 = 0.f;
    for (int k = ks * 256; k < ks * 256 + 256; ++k) {
      float wv = w[(size_t)k * 6144];
      a0 += sS[k] * wv; a1 += sS[1024 + k] * wv; a2 += sS[2048 + k] * wv;
    }
    sRed[(ks * 3 + 0) * 64 + (tid & 63)] = a0;
    sRed[(ks * 3 + 1) * 64 + (tid & 63)] = a1;
    sRed[(ks * 3 + 2) * 64 + (tid & 63)] = a2;
    __syncthreads();
    if (tid < 192) {
      int m = tid >> 6, c = tid & 63;
      float s = sRed[(0 * 3 + m) * 64 + c] + sRed[(1 * 3 + m) * 64 + c] + sRed[(2 * 3 + m) * 64 + c] + sRed[(3 * 3 + m) * 64 + c];
      int cc = cgp * 64 + c;
      ((float*)(ws + OFF_MODV))[((size_t)l * 3 + m) * 6144 + cc] = s + P.in[I_MODB][l * 6144 + cc];
    }
  }
}

constexpr int NPCONV = 2 * (NEXP * 1024 / (256 * 16));
DEV void st_peer_conv(const Params& P, int layer, int item) {
  const int half = NPCONV / 2;
  int which = item >= half;
  int it = which ? item - half : item;
  size_t e = ((size_t)it * 256 + threadIdx.x) * 16;
  const float* s = (which ? P.in[I_PV] : P.in[I_PU]) + (size_t)layer * NEXP * 1024 + e;
  const float sc = which ? PEER_VSCALE : PEER_USCALE;
  float v16[16];
#pragma unroll
  for (int q = 0; q < 4; ++q) {
    f32x4 a = *(const f32x4*)(s + 4 * q);
    v16[4 * q] = a.x * sc; v16[4 * q + 1] = a.y * sc; v16[4 * q + 2] = a.z * sc; v16[4 * q + 3] = a.w * sc;
  }
  const size_t ex = e >> 10, col = e & 1023;
  if (which) {
    u32x2 o; o.x = pack8_fp4(v16); o.y = pack8_fp4(v16 + 8);
    *(u32x2*)(P.ws + OFF_PU + ex * PEER_ROWB + PEER_VOFF + (col >> 1)) = o;
  } else {
    u32x3 o = pack16_fp6(v16);
    unsigned* dp = (unsigned*)(P.ws + OFF_PU + ex * PEER_ROWB + (col >> 4) * 12);
    dp[0] = o.x; dp[1] = o.y; dp[2] = o.z;
  }
}

DEV void st_normmod(const Params& P, int layer, int which, int row) {
  const int lane = threadIdx.x & 63;
  const float* src;
  if (which == 0 && layer == 0) src = row < NCTX ? P.in[I_CTX] + (size_t)row * 1024 : P.in[I_X] + (size_t)(row - NCTX) * 1024;
  else src = row < NCTX ? (const float*)(P.ws + OFF_CTXRES) + (size_t)row * 1024 : P.out + (size_t)(row - NCTX) * 1024;
  const float* mv = (const float*)(P.ws + OFF_MODV) + ((size_t)layer * 3 + mod_row(row)) * 6144;
  const float* sh = mv + (which ? 3 : 0) * 1024;
  const float* sc = mv + (which ? 4 : 1) * 1024;
  const float* nw = (which ? P.in[I_NORM2] : P.in[I_NORM1]) + layer * 1024;
  f32x4 v[4];
  float ss = 0.f;
#pragma unroll
  for (int i = 0; i < 4; ++i) {
    v[i] = *(const f32x4*)(src + i * 256 + lane * 4);
    ss += v[i].x * v[i].x + v[i].y * v[i].y + v[i].z * v[i].z + v[i].w * v[i].w;
  }
  ss = wave_sum(ss);
  const float rstd = frsq(ss * (1.f / 1024.f) + 1e-6f);
  bf16_t* dst = (bf16_t*)(P.ws + OFF_HBUF) + (size_t)row * 1024;
#pragma unroll
  for (int i = 0; i < 4; ++i) {
    int c = i * 256 + lane * 4;
    f32x4 w4 = *(const f32x4*)(nw + c), s4 = *(const f32x4*)(sc + c), h4 = *(const f32x4*)(sh + c);
    float o0 = v[i].x * rstd * w4.x * (1.f + s4.x) + h4.x;
    float o1 = v[i].y * rstd * w4.y * (1.f + s4.y) + h4.y;
    float o2 = v[i].z * rstd * w4.z * (1.f + s4.z) + h4.z;
    float o3 = v[i].w * rstd * w4.w * (1.f + s4.w) + h4.w;
    u32x2 pk; pk.x = pack2(o0, o1); pk.y = pack2(o2, o3);
    *(u32x2*)(dst + c) = pk;
  }
}

struct EpiProjL0 {
  bf16_t* proj; float* gates;
  DEVM void operator()(int row, int col, float v) const {
    proj[(size_t)row * EVC + col] = f2bf(v);
    if (col >= 1536 && col < 1552) gates[row * 32 + (col - 1536)] = v;
    else if (col >= 3088) gates[row * 32 + 16 + (col - 3088)] = v;
  }
};
struct EpiStoreBf {
  bf16_t* dst; int ld;
  DEVM void operator()(int row, int col, float v) const { dst[(size_t)row * ld + col] = f2bf(v); }
};
struct EpiStoreBfBias {
  bf16_t* dst; int ld; const float* bias;
  DEVM void operator()(int row, int col, float v) const { dst[(size_t)row * ld + col] = f2bf(v + (bias ? bias[col] : 0.f)); }
};
struct EpiProjL0T {
  bf16_t* proj; float* gates;
  DEVM void operator()(int, int, float) const {}
  DEVM void store4(int n, int m, float v0, float v1, float v2, float v3) const {
    u32x2 pk; pk.x = pack2(v0, v1); pk.y = pack2(v2, v3);
    *(u32x2*)(proj + (size_t)m * EVC + n) = pk;
    if (n >= 1536 && n < 1552) { f32x4 g = {v0, v1, v2, v3}; *(f32x4*)(gates + m * 32 + (n - 1536)) = g; }
    else if (n >= 3088) { f32x4 g = {v0, v1, v2, v3}; *(f32x4*)(gates + m * 32 + 16 + (n - 3088)) = g; }
  }
};
struct EpiStoreBfT {
  bf16_t* dst; int ld;
  DEVM void operator()(int, int, float) const {}
  DEVM void store4(int n, int m, float v0, float v1, float v2, float v3) const {
    u32x2 pk; pk.x = pack2(v0, v1); pk.y = pack2(v2, v3);
    *(u32x2*)(dst + (size_t)m * ld + n) = pk;
  }
};
struct EpiOutProjT {
  const float* x_lat; const float* x_ctx; float* o_lat; float* o_ctx; const float* modv;
  DEVM void operator()(int, int, float) const {}
  DEVM void store4(int n, int m, float v0, float v1, float v2, float v3) const {
    const f32x4 g = *(const f32x4*)(modv + mod_row(m) * 6144 + 2 * 1024 + n);
    const float* xs; float* od;
    if (m < NCTX) { xs = x_ctx + (size_t)m * 1024 + n; od = o_ctx + (size_t)m * 1024 + n; }
    else { size_t o = (size_t)(m - NCTX) * 1024 + n; xs = x_lat + o; od = o_lat + o; }
    const f32x4 x = *(const f32x4*)xs;
    f32x4 r = {x.x + g.x * v0, x.y + g.y * v1, x.z + g.z * v2, x.w + g.w * v3};
    *(f32x4*)od = r;
  }
};
struct EpiStoreBfBiasT {
  bf16_t* dst; int ld; const float* bias;
  DEVM void operator()(int, int, float) const {}
  DEVM void store4(int n, int m, float v0, float v1, float v2, float v3) const {
    if (bias) { v0 += bias[n]; v1 += bias[n + 1]; v2 += bias[n + 2]; v3 += bias[n + 3]; }
    u32x2 pk; pk.x = pack2(v0, v1); pk.y = pack2(v2, v3);
    *(u32x2*)(dst + (size_t)m * ld + n) = pk;
  }
};
struct EpiOutProj {
  const float* x_lat; const float* x_ctx; float* o_lat; float* o_ctx; const float* modv;
  DEVM void operator()(int row, int col, float v) const {
    float g = modv[mod_row(row) * 6144 + 2 * 1024 + col];
    if (row < NCTX) o_ctx[(size_t)row * 1024 + col] = x_ctx[(size_t)row * 1024 + col] + g * v;
    else { size_t o = (size_t)(row - NCTX) * 1024 + col; o_lat[o] = x_lat[o] + g * v; }
  }
};
struct EpiScoreLds {
  float* sS; int m0;
  DEVM void operator()(int row, int col, float v) const { sS[(row - m0) * 129 + col] = v; }
};

DEV void st_xbc_conv(const Params& P, int row) {
  const int lane = threadIdx.x & 63;
  const bf16_t* proj = (const bf16_t*)(P.ws + OFF_PROJ);
  bf16_t* xc = (bf16_t*)P.out + (size_t)row * 1024;
  int row0, len, pos;
  if (row < NCTX) { row0 = (row / CTXL) * CTXL; len = CTXL; pos = row - row0; }
  else { int r = row - NCTX; row0 = NCTX + (r / SEQ) * SEQ; len = SEQ; pos = r % SEQ; }
  const float* cw = P.in[I_SCONVW];
  const float* cb = P.in[I_SCONVB];
#pragma unroll
  for (int hh = 0; hh < 2; ++hh) {
    const int ch = hh * 512 + lane * 8;
    float o[8];
#pragma unroll
    for (int j = 0; j < 8; ++j) o[j] = cb[ch + j];
#pragma unroll
    for (int tap = 0; tap < 4; ++tap) {
      int pp = pos + tap - 2;
      if (pp >= 0 && pp < len) {
        float x[8];
        unpack8(*(const u32x4*)(proj + (size_t)(row0 + pp) * EVC + 2064 + ch), x);
        f32x4 w0 = *(const f32x4*)(cw + tap * 1024 + ch), w1 = *(const f32x4*)(cw + tap * 1024 + ch + 4);
        o[0] += w0.x * x[0]; o[1] += w0.y * x[1]; o[2] += w0.z * x[2]; o[3] += w0.w * x[3];
        o[4] += w1.x * x[4]; o[5] += w1.y * x[5]; o[6] += w1.z * x[6]; o[7] += w1.w * x[7];
      }
    }
#pragma unroll
    for (int j = 0; j < 8; ++j) o[j] = siluf_(o[j]);
    *(u32x4*)(xc + ch) = pack8(o);
  }
}

#ifndef LA_NSEG
#define LA_NSEG 10
#endif
constexpr int LA_NCH = (CTXL + SEQ) / 64;
constexpr int LA_CPS = LA_NCH / LA_NSEG;
static_assert(LA_NCH % LA_NSEG == 0, "linattn segments");
#ifdef CPU_EMU
constexpr size_t OFF_LASEG = OFF_PR + PR_BYTES;
#else
constexpr size_t OFF_LASEG = OFF_R2L0 + (size_t)NTOK * 1024 * 2;
#endif
constexpr size_t LASEG_U = (size_t)48 * LA_NSEG * 8192 * 4;
constexpr size_t OFF_LASEG_N = OFF_LASEG + LASEG_U;
constexpr size_t OFF_LASEG_D = OFF_LASEG_N + (size_t)48 * LA_NSEG * 64 * 4;
#ifndef CPU_EMU
static_assert(OFF_LASEG_D + 48 * LA_NSEG * 4 <= OFF_PR + PR_BYTES, "laseg");
#endif

struct LaRaw { u32x4 q[2], k[4], x[4]; float g0, g1; };

template <bool MLSTM, bool FULL>
DEV void la_load_raw(const Params& P, int b, int h, int d, int cc, LaRaw& R) {
  constexpr int NC_CTX = CTXL / 64;
  const int tid = threadIdx.x;
  const int seg = cc >= NC_CTX;
  const int row0 = seg ? NCTX + b * SEQ : b * CTXL;
  const int len = seg ? SEQ : CTXL;
  const int cl = (seg ? cc - NC_CTX : cc) * 64;
  const bf16_t* proj = (const bf16_t*)(P.ws + OFF_PROJ);
  const bf16_t* xcv = (const bf16_t*)P.out;
  const float* gates = (const float*)(P.ws + OFF_GATES);
  if (tid < 64) {
    int p = cl + tid, grow = row0 + (d ? len - 1 - p : p);
    if (MLSTM) { R.g0 = gates[grow * 32 + d * 4 + h]; R.g1 = gates[grow * 32 + 8 + d * 4 + h]; }
    else { R.g0 = gates[grow * 32 + 16 + d * 8 + h]; R.g1 = 0.f; }
  }
  if (MLSTM) {
#pragma unroll
    for (int i = 0; i < 2; ++i) {
      int c = tid + i * 256, r = c >> 3, cc8 = (c & 7) * 8;
      int p = cl + r, pos = d ? len - 1 - p : p;
      const bf16_t* rp = proj + (size_t)(row0 + pos) * EVC;
      if (FULL) R.q[i] = *(const u32x4*)(rp + h * 64 + cc8);
      R.k[i] = *(const u32x4*)(rp + 256 + h * 64 + cc8);
    }
#pragma unroll
    for (int i = 0; i < 4; ++i) {
      int c = tid + i * 256, r = c >> 4, cc8 = (c & 15) * 8;
      int p = cl + r, pos = d ? len - 1 - p : p;
      R.x[i] = *(const u32x4*)(proj + (size_t)(row0 + pos) * EVC + 512 + h * 128 + cc8);
    }
  } else {
    const int grp = h >> 2;
#pragma unroll
    for (int i = 0; i < 2; ++i) {
      int c = tid + i * 256, r = c >> 3, cc8 = (c & 7) * 8;
      int p = cl + r, pos = d ? len - 1 - p : p;
      R.x[i] = *(const u32x4*)(xcv + (size_t)(row0 + pos) * 1024 + h * 64 + cc8);
    }
#pragma unroll
    for (int i = 0; i < 4; ++i) {
      int c = tid + i * 256, r = c >> 4, cc8 = (c & 15) * 8;
      int p = cl + r, pos = d ? len - 1 - p : p;
      const bf16_t* rp = xcv + (size_t)(row0 + pos) * 1024;
      R.k[i] = *(const u32x4*)(rp + 512 + grp * 128 + cc8);
      if (FULL) { if (i < 2) R.q[i] = *(const u32x4*)(rp + 768 + grp * 128 + cc8); else R.x[i] = *(const u32x4*)(rp + 768 + grp * 128 + cc8); }
    }
  }
}

template <bool MLSTM, bool FULL>
DEV void st_linattn_seg(const Params& P, int sid, int seg, unsigned char* smem) {
  constexpr int DK = MLSTM ? 64 : 128, DX = MLSTM ? 128 : 64;
  constexpr int QS = DK + 8;
  constexpr int NH = MLSTM ? 4 : 8;
  constexpr int NC_CTX = CTXL / 64;
  const int tid = threadIdx.x, lane = tid & 63, wave = tid >> 6;
  const int d = sid & 1, h = (sid >> 1) % NH, b = (sid >> 1) / NH;
  const int gsid = MLSTM ? sid : 16 + sid;
  bf16_t* sQ = (bf16_t*)smem;
  bf16_t* sK = sQ + 64 * QS;
  bf16_t* sP = sK;
  bf16_t* sKT = sK + 64 * QS;
  bf16_t* sXT = sKT + DK * 72;
  bf16_t* sST = sXT + DX * 72;
  float* sF = (float*)(sST + DX * QS);
  float* sLa = sF;
  float* sG = sF + 64;
  float* sBc = sF + 128;
  float* sDen = sF + 192;
  float* sN = sF + 256;
  int* sRow = (int*)(sF + 384);
  static_assert((64 * QS * 2 + DK * 72 + DX * 72 + DX * QS) * 2 + 448 * 4 <= SMEM_BYTES, "lds");
  bf16_t* outb = MLSTM ? (bf16_t*)(P.ws + OFF_HBUF) : (bf16_t*)(P.ws + OFF_R2L0);
  float* segU = (float*)(P.ws + OFF_LASEG);
  float* segN = (float*)(P.ws + OFF_LASEG_N);
  float* segD = (float*)(P.ws + OFF_LASEG_D);

  f32x16 accS[2];
#pragma unroll
  for (int j = 0; j < 2; ++j)
#pragma unroll
    for (int r = 0; r < 16; ++r) accS[j][r] = 0.f;
  const int sx0 = MLSTM ? wave * 32 : (wave >> 1) * 32;
  const int sk0 = MLSTM ? 0 : (wave & 1) * 64;
  float nreg = 0.f;
  float gb0 = 0.f, gb1 = 0.f, alog_e = 0.f, dskip = 0.f;
  if (MLSTM) { gb0 = P.in[I_IBIAS][d * 4 + h]; gb1 = P.in[I_FBIAS][d * 4 + h]; }
  else { gb0 = P.in[I_DTBIAS][d * 8 + h]; alog_e = fexp(P.in[I_ALOG][d * 8 + h]); dskip = P.in[I_DSKIP][h]; }

  const int cc0 = seg * LA_CPS, cc1 = cc0 + LA_CPS;
  LaRaw R;
  la_load_raw<MLSTM, FULL>(P, b, h, d, cc0, R);
  __syncthreads();
  if (FULL) {
    for (int js = 0; js < seg; ++js) {
      const size_t it = (size_t)gsid * LA_NSEG + js;
      const float a = fexp(segD[it]);
      const float* U = segU + it * 8192;
#pragma unroll
      for (int j = 0; j < 2; ++j)
#pragma unroll
        for (int r = 0; r < 16; ++r) accS[j][r] = a * accS[j][r] + U[(j * 16 + r) * 256 + tid];
      if (MLSTM && tid < 64) nreg = a * nreg + segN[it * 64 + tid];
    }
#pragma unroll
    for (int j = 0; j < 2; ++j)
#pragma unroll
      for (int r = 0; r < 16; ++r) sST[(sx0 + acc_row(r, lane)) * QS + sk0 + j * 32 + (lane & 31)] = f2bf(accS[j][r]);
    if (tid < 128) sN[tid] = (MLSTM && tid < 64) ? nreg : 0.f;
  }
  float lsum = 0.f;

  for (int cc = cc0; cc < cc1; ++cc) {
    int tl_ = threadIdx.x; OPAQUE(tl_);
    const int tid = tl_, lane = tl_ & 63;
    const int sgi = cc >= NC_CTX;
    const int row0 = sgi ? NCTX + b * SEQ : b * CTXL;
    const int len = sgi ? SEQ : CTXL;
    const int cl = (sgi ? cc - NC_CTX : cc) * 64;
    if (tid < 64) {
      int p = cl + tid;
      sRow[tid] = row0 + (d ? len - 1 - p : p);
      if (MLSTM) { sLa[tid] = -softplusf_(-(R.g1 + gb1)); sG[tid] = fexp(R.g0 + gb0); }
      else { float dt = softplusf_(R.g0 + gb0); sLa[tid] = -dt * alog_e; sG[tid] = dt; }
    }
    __syncthreads();
    if (wave == 0) {
      float v = sLa[lane];
#pragma unroll
      for (int off = 1; off < 64; off <<= 1) {
#ifdef CPU_EMU
        float o = emu_shfl_up(v, off);
#else
        float o = __shfl_up(v, off, 64);
#endif
        if (lane >= off) v += o;
      }
      sBc[lane] = v;
    }
    __syncthreads();
    const float blast = sBc[63];
    lsum += blast;
    if (MLSTM) {
#pragma unroll
      for (int i = 0; i < 2; ++i) {
        int c = tid + i * 256, r = c >> 3, cc8 = (c & 7) * 8;
        float kf[8]; unpack8(R.k[i], kf);
        const float wgt = fexp(blast - sBc[r]) * sG[r];
#pragma unroll
        for (int j = 0; j < 8; ++j) sKT[(cc8 + j) * 72 + r] = f2bf(kf[j] * wgt);
        if (FULL) {
          float qf[8]; unpack8(R.q[i], qf);
#pragma unroll
          for (int j = 0; j < 8; ++j) qf[j] *= 0.125f;
          *(u32x4*)(sQ + r * QS + cc8) = pack8(qf);
          *(u32x4*)(sK + r * QS + cc8) = R.k[i];
        }
      }
#pragma unroll
      for (int i = 0; i < 4; ++i) {
        int c = tid + i * 256, r = c >> 4, cc8 = (c & 15) * 8;
        const bf16_t* xs = (const bf16_t*)&R.x[i];
#pragma unroll
        for (int j = 0; j < 8; ++j) sXT[(cc8 + j) * 72 + r] = xs[j];
      }
    } else {
#pragma unroll
      for (int i = 0; i < 2; ++i) {
        int c = tid + i * 256, r = c >> 3, cc8 = (c & 7) * 8;
        const bf16_t* xs = (const bf16_t*)&R.x[i];
#pragma unroll
        for (int j = 0; j < 8; ++j) sXT[(cc8 + j) * 72 + r] = xs[j];
      }
#pragma unroll
      for (int i = 0; i < 4; ++i) {
        int c = tid + i * 256, r = c >> 4, cc8 = (c & 15) * 8;
        float kf[8]; unpack8(R.k[i], kf);
        const float wgt = fexp(blast - sBc[r]) * sG[r];
#pragma unroll
        for (int j = 0; j < 8; ++j) sKT[(cc8 + j) * 72 + r] = f2bf(kf[j] * wgt);
        if (FULL) {
          *(u32x4*)(sK + r * QS + cc8) = R.k[i];
          *(u32x4*)(sQ + r * QS + cc8) = i < 2 ? R.q[i] : R.x[i];
        }
      }
    }
    if (cc + 1 < cc1) la_load_raw<MLSTM, FULL>(P, b, h, d, cc + 1, R);
    __syncthreads();
    if (FULL) {
      const int tr = (wave >> 1) * 32, tc = (wave & 1) * 32;
      f32x16 accP;
#pragma unroll
      for (int r = 0; r < 16; ++r) accP[r] = 0.f;
      if (!(tr == 0 && tc == 32)) {
#pragma unroll
        for (int kk = 0; kk < DK / 16; ++kk) {
          const int ko = kk * 16 + 8 * (lane >> 5);
          bf16x8 a = *(const bf16x8*)(sQ + (tr + (lane & 31)) * QS + ko);
          bf16x8 bb = *(const bf16x8*)(sK + (tc + (lane & 31)) * QS + ko);
          accP = mfma32(a, bb, accP);
        }
      }
      __syncthreads();
      {
        const int s = tc + (lane & 31);
        const float bs = sBc[s], gs = sG[s];
#pragma unroll
        for (int r = 0; r < 16; ++r) {
          int t = tr + acc_row(r, lane);
          float v = (s <= t) ? accP[r] * fexp(sBc[t] - bs) * gs : 0.f;
          sP[t * 72 + s] = f2bf(v);
        }
        for (int i = tid; i < 64 * DK; i += 256) {
          int t = i / DK, k = i % DK;
          sQ[t * QS + k] = f2bf(bf2f(sQ[t * QS + k]) * fexp(sBc[t]));
        }
      }
      __syncthreads();
      constexpr int NYT = MLSTM ? 2 : 1;
      const int yx0 = MLSTM ? wave * 32 : (wave >> 1) * 32;
      const int yt0 = MLSTM ? 0 : (wave & 1) * 32;
      f32x16 accY[NYT];
#pragma unroll
      for (int j = 0; j < NYT; ++j)
#pragma unroll
        for (int r = 0; r < 16; ++r) accY[j][r] = 0.f;
#pragma unroll
      for (int kk = 0; kk < 4; ++kk) {
        const int ko = kk * 16 + 8 * (lane >> 5);
        bf16x8 a = *(const bf16x8*)(sXT + (yx0 + (lane & 31)) * 72 + ko);
#pragma unroll
        for (int j = 0; j < NYT; ++j) {
          bf16x8 bb = *(const bf16x8*)(sP + (yt0 + j * 32 + (lane & 31)) * 72 + ko);
          accY[j] = mfma32(a, bb, accY[j]);
        }
      }
#pragma unroll
      for (int kk = 0; kk < DK / 16; ++kk) {
        const int ko = kk * 16 + 8 * (lane >> 5);
        bf16x8 a = *(const bf16x8*)(sST + (yx0 + (lane & 31)) * QS + ko);
#pragma unroll
        for (int j = 0; j < NYT; ++j) {
          bf16x8 bb = *(const bf16x8*)(sQ + (yt0 + j * 32 + (lane & 31)) * QS + ko);
          accY[j] = mfma32(a, bb, accY[j]);
        }
      }
      if (MLSTM) {
        if (tid < 64) {
          float den = 0.f, dq = 0.f;
#pragma unroll 8
          for (int s = 0; s < 64; ++s) den += bf2f(sP[tid * 72 + s]);
#pragma unroll 8
          for (int k = 0; k < DK; ++k) dq += sN[k] * bf2f(sQ[tid * QS + k]);
          sDen[tid] = den + dq;
        }
        __syncthreads();
      }
#pragma unroll
      for (int j = 0; j < NYT; ++j) {
        const int t = yt0 + j * 32 + (lane & 31);
        const size_t obase = (size_t)sRow[t] * 1024 + d * 512 + h * DX;
        const float dinv = MLSTM ? frcp(fmaxf(fabsf(sDen[t]), 1.f)) : 1.f;
#pragma unroll
        for (int g = 0; g < 4; ++g) {
          const int x0 = yx0 + 8 * g + 4 * (lane >> 5);
          float v0 = accY[j][4 * g], v1 = accY[j][4 * g + 1], v2 = accY[j][4 * g + 2], v3 = accY[j][4 * g + 3];
          if (MLSTM) { v0 *= dinv; v1 *= dinv; v2 *= dinv; v3 *= dinv; }
          else if (d == 0) {
            v0 += dskip * bf2f(sXT[(x0 + 0) * 72 + t]); v1 += dskip * bf2f(sXT[(x0 + 1) * 72 + t]);
            v2 += dskip * bf2f(sXT[(x0 + 2) * 72 + t]); v3 += dskip * bf2f(sXT[(x0 + 3) * 72 + t]);
          }
          u32x2 pk; pk.x = pack2(v0, v1); pk.y = pack2(v2, v3);
          *(u32x2*)(outb + obase + x0) = pk;
        }
      }
      __syncthreads();
    }
    {
      const float eb = fexp(blast);
#pragma unroll
      for (int j = 0; j < 2; ++j)
#pragma unroll
        for (int r = 0; r < 16; ++r) accS[j][r] *= eb;
#pragma unroll
      for (int kk = 0; kk < 4; ++kk) {
        const int ko = kk * 16 + 8 * (lane >> 5);
        bf16x8 a = *(const bf16x8*)(sXT + (sx0 + (lane & 31)) * 72 + ko);
#pragma unroll
        for (int j = 0; j < 2; ++j) {
          bf16x8 bb = *(const bf16x8*)(sKT + (sk0 + j * 32 + (lane & 31)) * 72 + ko);
          accS[j] = mfma32(a, bb, accS[j]);
        }
      }
      if (FULL) {
#pragma unroll
        for (int j = 0; j < 2; ++j)
#pragma unroll
          for (int r = 0; r < 16; ++r) sST[(sx0 + acc_row(r, lane)) * QS + sk0 + j * 32 + (lane & 31)] = f2bf(accS[j][r]);
      }
      if (MLSTM && tid < 64) {
        float nn = nreg * eb;
        for (int s = 0; s < 64; ++s) nn += bf2f(sKT[tid * 72 + s]);
        nreg = nn;
        if (FULL) sN[tid] = nn;
      }
    }
    __syncthreads();
  }
  if (!FULL) {
    const size_t it = (size_t)gsid * LA_NSEG + seg;
    float* U = segU + it * 8192;
#pragma unroll
    for (int j = 0; j < 2; ++j)
#pragma unroll
      for (int r = 0; r < 16; ++r) U[(j * 16 + r) * 256 + tid] = accS[j][r];
    if (MLSTM && tid < 64) segN[it * 64 + tid] = nreg;
    if (tid == 0) segD[it] = lsum;
  }
}

DEV void st_finish_l0(const Params& P, int row) {
  const int lane = threadIdx.x & 63;
  bf16_t* hb = (bf16_t*)(P.ws + OFF_HBUF) + (size_t)row * 1024;
  const bf16_t* yb = (const bf16_t*)(P.ws + OFF_R2L0) + (size_t)row * 1024;
  const bf16_t* pr = (const bf16_t*)(P.ws + OFF_PROJ) + (size_t)row * EVC;
  const int ch = lane * 8;
  float h0[8], h1[8], o[8], f1[8];
  unpack8(*(const u32x4*)(hb + ch), h0);
  unpack8(*(const u32x4*)(hb + 512 + ch), h1);
  unpack8(*(const u32x4*)(pr + 1024 + ch), o);
  float ss = 0.f;
#pragma unroll
  for (int j = 0; j < 8; ++j) { h0[j] += h1[j]; ss += h0[j] * h0[j]; }
  ss += wshfl_xor(ss, 1); ss += wshfl_xor(ss, 2); ss += wshfl_xor(ss, 4); ss += wshfl_xor(ss, 8);
  float rstd = frsq(ss * (1.f / 128.f) + 1e-6f);
#pragma unroll
  for (int j = 0; j < 8; ++j) f1[j] = h0[j] * rstd * P.in[I_MNORM][ch + j] * sigmoidf_(o[j]);
  float y0[8], y1[8], z[8], f2[8];
  unpack8(*(const u32x4*)(yb + ch), y0);
  unpack8(*(const u32x4*)(yb + 512 + ch), y1);
  unpack8(*(const u32x4*)(pr + 1552 + ch), z);
  float s2 = 0.f;
#pragma unroll
  for (int j = 0; j < 8; ++j) { y0[j] = (y0[j] + y1[j]) * siluf_(z[j]); s2 += y0[j] * y0[j]; }
  s2 = wave_sum(s2);
  float rstd2 = frsq(s2 * (1.f / 512.f) + 1e-6f);
#pragma unroll
  for (int j = 0; j < 8; ++j) f2[j] = y0[j] * rstd2 * P.in[I_SNORM][ch + j];
  *(u32x4*)(hb + ch) = pack8(f1);
  *(u32x4*)(hb + 512 + ch) = pack8(f2);
}

DEV float mixval(const bf16_t* __restrict__ proj, int row, int c, const float* __restrict__ mu) {
  float self = bf2f(proj[(size_t)row * ODC + c]);
  int nrow = -1;
  if (row < NCTX) {
    int pos = row % CTXL;
    if (c < 896) { if (pos > 0) nrow = row - 1; }
    else { if (pos < CTXL - 1) nrow = row + 1; }
  } else {
    int pos = (row - NCTX) % SEQ;
    int gx = pos % GW, gy = pos / GW, q = c / 448;
    if (q == 0) { if (gx > 0) nrow = row - 1; }
    else if (q == 1) { if (gx < GW - 1) nrow = row + 1; }
    else if (q == 2) { if (gy > 0) nrow = row - GW; }
    else { if (gy < SEQ / GW - 1) nrow = row + GW; }
  }
  float nb = nrow >= 0 ? bf2f(proj[(size_t)nrow * ODC + c]) : 0.f;
  return self + mu[c] * (nb - self);
}

DEV void st_lora_act(const Params& P, int row) {
  const int lane = threadIdx.x & 63;
  const bf16_t* proj = (const bf16_t*)(P.ws + OFF_PROJ);
  bf16_t* hb = (bf16_t*)(P.ws + OFF_HBUF) + (size_t)row * 1024;
  float v[4];
#pragma unroll
  for (int j = 0; j < 4; ++j) {
    int c = lane * 4 + j;
    float x = mixval(proj, row, 1536 + c, P.in[I_MU]);
    v[j] = c < 64 ? tanhf_(x) : (c < 128 ? x : sigmoidf_(x));
  }
  u32x2 pk; pk.x = pack2(v[0], v[1]); pk.y = pack2(v[2], v[3]);
  *(u32x2*)(hb + lane * 4) = pk;
}

DEV void st_rwkv_stream(const Params& P, int sid, unsigned char* smem) {
  const int tid = threadIdx.x, lane = tid & 63, wave = tid >> 6;
  const int d = sid & 1, h = (sid >> 1) & 7, b = sid >> 4;
  float* sR = (float*)smem;
  float* sW = sR + 2048;
  float* sKk = sW + 2048;
  float* sV = sKk + 2048;
  float* sA = sV + 2048;
  float* sBb = sA + 2048;
  float* sY = sBb + 2048;
  int* sRow = (int*)(sY + 2048);
  const bf16_t* proj = (const bf16_t*)(P.ws + OFF_PROJ);
  const bf16_t* lora = (const bf16_t*)(P.ws + OFF_LORA);
  bf16_t* yout = (bf16_t*)(P.ws + OFF_HBUF);
  const float* mu = P.in[I_MU];
  const int vrow = tid >> 2, j4 = tid & 3;
  float S[16];
#pragma unroll
  for (int i = 0; i < 16; ++i) S[i] = 0.f;
  const float kkw = P.in[I_KK][h * 64 + lane], kaw = P.in[I_KA][h * 64 + lane];
  for (int seg = 0; seg < 2; ++seg) {
    const int row0 = seg == 0 ? b * CTXL : NCTX + b * SEQ;
    const int len = seg == 0 ? CTXL : SEQ;
    for (int it = 0; it < len / 32; ++it) {
      __syncthreads();
      for (int s = wave; s < 32; s += 4) {
        int p = it * 32 + s, pos = d ? len - 1 - p : p, row = row0 + pos;
        int c = h * 64 + lane;
        float r = mixval(proj, row, c, mu);
        float k = mixval(proj, row, 512 + c, mu);
        float v = mixval(proj, row, 1024 + c, mu);
        float kk = k * kkw;
        float ss = wave_sum(kk * kk);
        kk *= frsq(ss + 1e-12f);
        float lw = bf2f(lora[((size_t)d * NTOK + row) * 512 + c]);
        float la = bf2f(lora[((size_t)(2 + d) * NTOK + row) * 512 + c]);
        float w = fexp(-0.6065306597126334f * sigmoidf_(lw));
        float a = sigmoidf_(la);
        float kt = k * (1.f + (a - 1.f) * kaw);
        sR[s * 64 + lane] = r; sW[s * 64 + lane] = w; sKk[s * 64 + lane] = kt; sV[s * 64 + lane] = v;
        sA[s * 64 + lane] = -kk; sBb[s * 64 + lane] = kk * a;
        if (lane == 0) sRow[s] = row;
      }
      __syncthreads();
      for (int s = 0; s < 32; ++s) {
        const float* pa = sA + s * 64 + j4 * 16;
        const float* pw = sW + s * 64 + j4 * 16;
        const float* pk = sKk + s * 64 + j4 * 16;
        const float* pb = sBb + s * 64 + j4 * 16;
        const float* pr = sR + s * 64 + j4 * 16;
        const float vv = sV[s * 64 + vrow];
        float sa = 0.f;
#pragma unroll
        for (int i = 0; i < 16; ++i) sa += S[i] * pa[i];
        sa += wshfl_xor(sa, 1); sa += wshfl_xor(sa, 2);
        float y = 0.f;
#pragma unroll
        for (int i = 0; i < 16; ++i) { S[i] = S[i] * pw[i] + sa * pb[i] + vv * pk[i]; y += S[i] * pr[i]; }
        y += wshfl_xor(y, 1); y += wshfl_xor(y, 2);
        if (j4 == 0) sY[s * 64 + vrow] = y;
      }
      __syncthreads();
      for (int i = tid; i < 2048; i += 256) {
        int s = i >> 6, c = i & 63;
        yout[(size_t)sRow[s] * 1024 + d * 512 + h * 64 + c] = f2bf(sY[i]);
      }
    }
  }
}


DEV int nbr_row(int row, int c) {
  if (row < NCTX) {
    int pos = row % CTXL;
    if (c < 896) return pos > 0 ? row - 1 : -1;
    return pos < CTXL - 1 ? row + 1 : -1;
  }
  int pos = (row - NCTX) % SEQ;
  int gx = pos % GW, gy = pos / GW, q = c / 448;
  if (q == 0) return gx > 0 ? row - 1 : -1;
  if (q == 1) return gx < GW - 1 ? row + 1 : -1;
  if (q == 2) return gy > 0 ? row - GW : -1;
  return gy < SEQ / GW - 1 ? row + GW : -1;
}

struct RwkvRaw { u32x4 rs, rn, ks, kn, vs, vn, lw, la; int row; };

DEV void rwkv_load_raw(const bf16_t* __restrict__ proj, const bf16_t* __restrict__ lora, int b, int h, int d, int cc, int t, int c0,
                       RwkvRaw& R) {
  constexpr int NC_CTX = CTXL / 32;
  const int seg = cc >= NC_CTX;
  const int row0 = seg ? NCTX + b * SEQ : b * CTXL;
  const int len = seg ? SEQ : CTXL;
  const int p = (seg ? cc - NC_CTX : cc) * 32 + t;
  const int row = row0 + (d ? len - 1 - p : p);
  const int col = h * 64 + c0;
  const u32x4 z4 = {0u, 0u, 0u, 0u};
  const bf16_t* rp = proj + (size_t)row * ODC;
  R.row = row;
  R.rs = *(const u32x4*)(rp + col);
  R.ks = *(const u32x4*)(rp + 512 + col);
  R.vs = *(const u32x4*)(rp + 1024 + col);
  int n0 = nbr_row(row, col), n1 = nbr_row(row, 512 + col), n2 = nbr_row(row, 1024 + col);
  R.rn = n0 >= 0 ? *(const u32x4*)(proj + (size_t)n0 * ODC + col) : z4;
  R.kn = n1 >= 0 ? *(const u32x4*)(proj + (size_t)n1 * ODC + 512 + col) : z4;
  R.vn = n2 >= 0 ? *(const u32x4*)(proj + (size_t)n2 * ODC + 1024 + col) : z4;
  R.lw = *(const u32x4*)(lora + ((size_t)d * NTOK + row) * 512 + col);
  R.la = *(const u32x4*)(lora + ((size_t)(2 + d) * NTOK + row) * 512 + col);
}

#ifndef RW_NSEG
#define RW_NSEG 16
#endif
constexpr int RW_NCH = (CTXL + SEQ) / 32;
constexpr size_t OFF_RWSEG = OFF_PU;
static_assert((size_t)32 * RW_NSEG * 64 * 128 * 4 <= (size_t)2 * NEXP * 1024, "rwseg");

template <bool FULL>
DEV void st_rwkv_seg(const Params& P, int sid, int seg, unsigned char* smem) {
  constexpr int NVB = FULL ? 2 : 4;
  constexpr int ZR = FULL ? 64 : 128;
  const int tid = threadIdx.x, lane = tid & 63, wave = tid >> 6;
  const int d = sid & 1, h = (sid >> 1) & 7, b = sid >> 4;
  bf16_t* sAt = (bf16_t*)smem;
  bf16_t* sRt = sAt + 32 * 72;
  bf16_t* sBt = sRt + 32 * 72;
  bf16_t* sKt = sBt + 32 * 72;
  bf16_t* sBT = sKt + 32 * 72;
  bf16_t* sKT = sBT + 64 * 40;
  bf16_t* sVT = sKT + 64 * 40;
  bf16_t* sLak = sVT + 64 * 40;
  bf16_t* sM = sLak + 32 * 40;
  bf16_t* sLrb = sM + 32 * 40;
  bf16_t* sLrk = sLrb + 32 * 40;
  bf16_t* sZ = FULL ? sLrk + 32 * 40 : sLrb;
  bf16_t* after = sZ + ZR * 72;
  bf16_t* sRT = FULL ? after : nullptr;
  bf16_t* sSAT = FULL ? after + 64 * 40 : sRt;
  float* sLP = (float*)(FULL ? after + 2 * 64 * 40 : after);
  float* sLab = sLP + 32 * 64;
  float* sD = sLab + 32 * 33;
  float* sPT = sD + 768;
  int* sRow = (int*)(sPT + 64);
  if (!FULL) sRT = (bf16_t*)sLP;
  static_assert((4 * 32 * 72 + 3 * 64 * 40 + 4 * 32 * 40 + 2 * 64 * 40 + 64 * 72) * 2 + (32 * 64 + 32 * 33 + 768 + 64 + 32 + 320) * 4 + 16 <= SMEM_BYTES, "lds full");
  static_assert((4 * 32 * 72 + 3 * 64 * 40 + 2 * 32 * 40 + 128 * 72) * 2 + (32 * 64 + 32 * 33 + 768 + 64 + 32) * 4 <= SMEM_BYTES, "lds p1");
  static_assert(128 * 40 * 2 <= (32 * 64 + 32 * 33) * 4 && 128 * 40 <= 3 * 32 * 72, "alias");
  const bf16_t* proj = (const bf16_t*)(P.ws + OFF_PROJ);
  const bf16_t* lora = (const bf16_t*)(P.ws + OFF_LORA);
  bf16_t* yout = (bf16_t*)(P.ws + OFF_HBUF);
  float* segZ = (float*)(P.ws + OFF_RWSEG);
  const int t = tid >> 3, c0 = (tid & 7) * 8;
  const int hl = lane >> 5, l31 = lane & 31;
  float* sCst = (float*)(smem + SMEM_BYTES - 320 * 4 - 16);
  if (tid < 64) {
    sCst[tid] = P.in[I_MU][h * 64 + tid]; sCst[64 + tid] = P.in[I_MU][512 + h * 64 + tid]; sCst[128 + tid] = P.in[I_MU][1024 + h * 64 + tid];
    sCst[192 + tid] = P.in[I_KK][h * 64 + tid]; sCst[256 + tid] = P.in[I_KA][h * 64 + tid];
  }
  const int cc0 = (seg * RW_NCH) / RW_NSEG, cc1 = ((seg + 1) * RW_NCH) / RW_NSEG;
  RwkvRaw R;
  rwkv_load_raw(proj, lora, b, h, d, cc0, t, c0, R);
  f32x16 Zm[2];
#pragma unroll
  for (int j = 0; j < 2; ++j)
#pragma unroll
    for (int r = 0; r < 16; ++r) Zm[j][r] = 0.f;
  __syncthreads();
  for (int i = tid; i < ZR * 72; i += 256) sZ[i] = 0;
  __syncthreads();
  if (!FULL) {
    if (wave >= 2) {
#pragma unroll
      for (int cb = 0; cb < 2; ++cb)
#pragma unroll
        for (int r = 0; r < 16; ++r) {
          int c = cb * 32 + acc_row(r, lane), vp = wave * 32 + l31;
          if (c == vp - 64) { Zm[cb][r] = 1.f; sZ[vp * 72 + c] = 0x3f80; }
        }
    }
  } else {
    for (int js = 0; js < seg; ++js) {
      const float* Zs = segZ + ((size_t)sid * RW_NSEG + js) * 64 * 128;
      bf16_t* sG = sAt;
      for (int i = tid; i < 64 * 64; i += 256) { int c = i >> 6, c2 = i & 63; sG[c * 72 + c2] = f2bf(Zs[c * 128 + 64 + c2]); }
      __syncthreads();
      if (wave >= 2) {
        const int cb = wave - 2;
#pragma unroll
        for (int vb = 0; vb < 2; ++vb) {
          f32x16 acc;
#pragma unroll
          for (int r = 0; r < 16; ++r) acc[r] = Zs[(cb * 32 + acc_row(r, lane)) * 128 + vb * 32 + l31];
#pragma unroll
          for (int kk = 0; kk < 4; ++kk) {
            bf16x8 a = *(const bf16x8*)(sG + (cb * 32 + l31) * 72 + kk * 16 + 8 * hl);
            bf16x8 bb = *(const bf16x8*)(sZ + (vb * 32 + l31) * 72 + kk * 16 + 8 * hl);
            acc = mfma32(a, bb, acc);
          }
          Zm[vb] = acc;
        }
      }
      __syncthreads();
      if (wave >= 2) {
        const int cb = wave - 2;
#pragma unroll
        for (int vb = 0; vb < 2; ++vb)
#pragma unroll
          for (int g = 0; g < 4; ++g) {
            u32x2 pk; pk.x = pack2(Zm[vb][4 * g], Zm[vb][4 * g + 1]); pk.y = pack2(Zm[vb][4 * g + 2], Zm[vb][4 * g + 3]);
            *(u32x2*)(sZ + (vb * 32 + l31) * 72 + cb * 32 + 8 * g + 4 * hl) = pk;
          }
      }
      __syncthreads();
    }
  }
  for (int cc = cc0; cc < cc1; ++cc) {
    int tl_ = threadIdx.x; OPAQUE(tl_);
    const int tid = tl_, lane = tl_ & 63, hl = lane >> 5, l31 = lane & 31, t = tl_ >> 3, c0 = (tl_ & 7) * 8;
    const float* muR = sCst + c0; const float* muK = sCst + 64 + c0; const float* muV = sCst + 128 + c0;
    const float* kkw = sCst + 192 + c0; const float* kaw = sCst + 256 + c0;
    float lw8[8], lp8[8];
    {
      float lwf[8];
      unpack8(R.lw, lwf);
#pragma unroll
      for (int j = 0; j < 8; ++j) { lw8[j] = -0.6065306597126334f * sigmoidf_(lwf[j]); lp8[j] = lw8[j]; }
#pragma unroll
      for (int off = 8; off < 64; off <<= 1) {
#pragma unroll
        for (int j = 0; j < 8; ++j) {
#ifdef CPU_EMU
          float o = emu_shfl_up(lp8[j], off);
#else
          float o = __shfl_up(lp8[j], off, 64);
#endif
          if (lane >= off) lp8[j] += o;
        }
      }
      if (lane >= 56) {
#pragma unroll
        for (int j = 0; j < 8; ++j) sLP[wave * 64 + c0 + j] = lp8[j];
      }
      if ((tid & 7) == 0) sRow[t] = R.row;
    }
    __syncthreads();
    {
#pragma unroll
      for (int j = 0; j < 8; ++j) {
        float offs = 0.f;
        for (int w2 = 0; w2 < wave; ++w2) offs += sLP[w2 * 64 + c0 + j];
        lp8[j] += offs;
      }
      if (t == 31) {
#pragma unroll
        for (int j = 0; j < 8; ++j) sPT[c0 + j] = fexp(lp8[j]);
      }
    }
    {
      float xs[8], xn[8], kt[8], aa[8], ob[8], ok[8];
      unpack8(R.ks, xs); unpack8(R.kn, xn);
      float ss = 0.f;
#pragma unroll
      for (int j = 0; j < 8; ++j) { kt[j] = xs[j] + muK[j] * (xn[j] - xs[j]); aa[j] = kt[j] * kkw[j]; ss += aa[j] * aa[j]; }
      ss += wshfl_xor(ss, 1); ss += wshfl_xor(ss, 2); ss += wshfl_xor(ss, 4);
      const float rn = frsq(ss + 1e-12f);
      float laf[8];
      unpack8(R.la, laf);
#pragma unroll
      for (int j = 0; j < 8; ++j) {
        const float lp = lp8[j];
        const float lpm = lp8[j] - lw8[j];
        const float e = fexp(-lp);
        const float kkn = aa[j] * rn;
        const float asg = sigmoidf_(laf[j]);
        aa[j] = -kkn * fexp(lpm);
        ob[j] = kkn * asg * e;
        ok[j] = kt[j] * (1.f + (asg - 1.f) * kaw[j]) * e;
      }
      *(u32x4*)(sAt + t * 72 + c0) = pack8(aa);
      *(u32x4*)(sBt + t * 72 + c0) = pack8(ob);
      *(u32x4*)(sKt + t * 72 + c0) = pack8(ok);
#pragma unroll
      for (int j = 0; j < 8; ++j) { sBT[(c0 + j) * 40 + t] = f2bf(ob[j]); sKT[(c0 + j) * 40 + t] = f2bf(ok[j]); }
      unpack8(R.vs, xs); unpack8(R.vn, xn);
#pragma unroll
      for (int j = 0; j < 8; ++j) sVT[(c0 + j) * 40 + t] = f2bf(xs[j] + muV[j] * (xn[j] - xs[j]));
      if (FULL) {
        unpack8(R.rs, xs); unpack8(R.rn, xn);
#pragma unroll
        for (int j = 0; j < 8; ++j) xs[j] = (xs[j] + muR[j] * (xn[j] - xs[j])) * fexp(lp8[j]);
        *(u32x4*)(sRt + t * 72 + c0) = pack8(xs);
      }
    }
    if (cc + 1 < cc1) rwkv_load_raw(proj, lora, b, h, d, cc + 1, t, c0, R);
    __syncthreads();
    if (FULL || wave < 2) {
      const bf16_t* Asrc = wave < 2 ? sAt : sRt;
      const bf16_t* Bsrc = (wave & 1) ? sKt : sBt;
      f32x16 acc;
#pragma unroll
      for (int r = 0; r < 16; ++r) acc[r] = 0.f;
#pragma unroll
      for (int kk = 0; kk < 4; ++kk) {
        bf16x8 a = *(const bf16x8*)(Asrc + l31 * 72 + kk * 16 + 8 * hl);
        bf16x8 bb = *(const bf16x8*)(Bsrc + l31 * 72 + kk * 16 + 8 * hl);
        acc = mfma32(a, bb, acc);
      }
      bf16_t* dst = wave == 1 ? sLak : (wave == 2 ? sLrb : sLrk);
#pragma unroll
      for (int r = 0; r < 16; ++r) {
        int tt = acc_row(r, lane), j = l31;
        bool keep = wave < 2 ? (j < tt) : (j <= tt);
        float v = keep ? acc[r] : 0.f;
        if (wave == 0) sLab[tt * 33 + j] = v;
        else dst[tt * 40 + j] = f2bf(v);
      }
    }
    __syncthreads();
    if (tid < 32) {
      const int q = tid >> 4, c = tid & 15;
      float x[16];
#pragma unroll
      for (int i = 0; i < 16; ++i) {
        float sacc = (i == c) ? 1.f : 0.f;
#pragma unroll
        for (int j = 0; j < i; ++j) sacc += sLab[(q * 16 + i) * 33 + q * 16 + j] * x[j];
        x[i] = sacc;
        sD[q * 256 + i * 16 + c] = sacc;
      }
    }
    __syncthreads();
    {
      const int i = tid >> 4, c = tid & 15;
      float sacc = 0.f;
#pragma unroll
      for (int j = 0; j < 16; ++j) sacc += sLab[(16 + i) * 33 + j] * sD[j * 16 + c];
      sD[512 + i * 16 + c] = sacc;
    }
    __syncthreads();
    {
      const int i = tid >> 4, c = tid & 15;
      float sacc = 0.f;
#pragma unroll
      for (int j = 0; j < 16; ++j) sacc += sD[256 + i * 16 + j] * sD[512 + j * 16 + c];
      sM[(16 + i) * 40 + c] = f2bf(sacc);
      sM[i * 40 + c] = f2bf(sD[i * 16 + c]);
      sM[(16 + i) * 40 + 16 + c] = f2bf(sD[256 + i * 16 + c]);
      sM[i * 40 + 16 + c] = 0;
    }
    if (wave < NVB) {
      const int vb = wave;
      f32x16 acc;
#pragma unroll
      for (int r = 0; r < 16; ++r) acc[r] = 0.f;
#pragma unroll
      for (int kk = 0; kk < 4; ++kk) {
        bf16x8 a = *(const bf16x8*)(sAt + l31 * 72 + kk * 16 + 8 * hl);
        bf16x8 bb = *(const bf16x8*)(sZ + (vb * 32 + l31) * 72 + kk * 16 + 8 * hl);
        acc = mfma32(a, bb, acc);
      }
      if (vb < 2) {
#pragma unroll
        for (int kk = 0; kk < 2; ++kk) {
          bf16x8 a = *(const bf16x8*)(sLak + l31 * 40 + kk * 16 + 8 * hl);
          bf16x8 bb = *(const bf16x8*)(sVT + (vb * 32 + l31) * 40 + kk * 16 + 8 * hl);
          acc = mfma32(a, bb, acc);
        }
      }
#pragma unroll
      for (int g = 0; g < 4; ++g) {
        u32x2 pk; pk.x = pack2(acc[4 * g], acc[4 * g + 1]); pk.y = pack2(acc[4 * g + 2], acc[4 * g + 3]);
        *(u32x2*)(sRT + (vb * 32 + l31) * 40 + 8 * g + 4 * hl) = pk;
      }
    }
    __syncthreads();
    if (wave < NVB) {
      const int vb = wave;
      f32x16 acc;
#pragma unroll
      for (int r = 0; r < 16; ++r) acc[r] = 0.f;
#pragma unroll
      for (int kk = 0; kk < 2; ++kk) {
        bf16x8 a = *(const bf16x8*)(sM + l31 * 40 + kk * 16 + 8 * hl);
        bf16x8 bb = *(const bf16x8*)(sRT + (vb * 32 + l31) * 40 + kk * 16 + 8 * hl);
        acc = mfma32(a, bb, acc);
      }
#pragma unroll
      for (int g = 0; g < 4; ++g) {
        u32x2 pk; pk.x = pack2(acc[4 * g], acc[4 * g + 1]); pk.y = pack2(acc[4 * g + 2], acc[4 * g + 3]);
        *(u32x2*)(sSAT + (vb * 32 + l31) * 40 + 8 * g + 4 * hl) = pk;
      }
    }
    __syncthreads();
    if (FULL) {
      if (wave < 2) {
        const int vb = wave;
        f32x16 acc;
#pragma unroll
        for (int r = 0; r < 16; ++r) acc[r] = 0.f;
#pragma unroll
        for (int kk = 0; kk < 4; ++kk) {
          bf16x8 a = *(const bf16x8*)(sZ + (vb * 32 + l31) * 72 + kk * 16 + 8 * hl);
          bf16x8 bb = *(const bf16x8*)(sRt + l31 * 72 + kk * 16 + 8 * hl);
          acc = mfma32(a, bb, acc);
        }
#pragma unroll
        for (int kk = 0; kk < 2; ++kk) {
          bf16x8 a = *(const bf16x8*)(sSAT + (vb * 32 + l31) * 40 + kk * 16 + 8 * hl);
          bf16x8 bb = *(const bf16x8*)(sLrb + l31 * 40 + kk * 16 + 8 * hl);
          acc = mfma32(a, bb, acc);
        }
#pragma unroll
        for (int kk = 0; kk < 2; ++kk) {
          bf16x8 a = *(const bf16x8*)(sVT + (vb * 32 + l31) * 40 + kk * 16 + 8 * hl);
          bf16x8 bb = *(const bf16x8*)(sLrk + l31 * 40 + kk * 16 + 8 * hl);
          acc = mfma32(a, bb, acc);
        }
        {
          const size_t obase = (size_t)sRow[l31] * 1024 + d * 512 + h * 64 + vb * 32;
#pragma unroll
          for (int g = 0; g < 4; ++g) {
            u32x2 pk; pk.x = pack2(acc[4 * g], acc[4 * g + 1]); pk.y = pack2(acc[4 * g + 2], acc[4 * g + 3]);
            *(u32x2*)(yout + obase + 8 * g + 4 * hl) = pk;
          }
        }
      } else {
        const int cb = wave - 2;
#pragma unroll
        for (int vb = 0; vb < 2; ++vb) {
          f32x16 acc;
#pragma unroll
          for (int r = 0; r < 16; ++r) acc[r] = 0.f;
#pragma unroll
          for (int kk = 0; kk < 2; ++kk) {
            bf16x8 a = *(const bf16x8*)(sBT + (cb * 32 + l31) * 40 + kk * 16 + 8 * hl);
            bf16x8 bb = *(const bf16x8*)(sSAT + (vb * 32 + l31) * 40 + kk * 16 + 8 * hl);
            acc = mfma32(a, bb, acc);
          }
#pragma unroll
          for (int kk = 0; kk < 2; ++kk) {
            bf16x8 a = *(const bf16x8*)(sKT + (cb * 32 + l31) * 40 + kk * 16 + 8 * hl);
            bf16x8 bb = *(const bf16x8*)(sVT + (vb * 32 + l31) * 40 + kk * 16 + 8 * hl);
            acc = mfma32(a, bb, acc);
          }
#pragma unroll
          for (int r = 0; r < 16; ++r) Zm[vb][r] = sPT[cb * 32 + acc_row(r, lane)] * (Zm[vb][r] + acc[r]);
        }
      }
      __syncthreads();
      if (wave >= 2) {
        const int cb = wave - 2;
#pragma unroll
        for (int vb = 0; vb < 2; ++vb)
#pragma unroll
          for (int g = 0; g < 4; ++g) {
            u32x2 pk; pk.x = pack2(Zm[vb][4 * g], Zm[vb][4 * g + 1]); pk.y = pack2(Zm[vb][4 * g + 2], Zm[vb][4 * g + 3]);
            *(u32x2*)(sZ + (vb * 32 + l31) * 72 + cb * 32 + 8 * g + 4 * hl) = pk;
          }
      }
    } else {
      const int vb = wave;
#pragma unroll
      for (int cb = 0; cb < 2; ++cb) {
        f32x16 acc;
#pragma unroll
        for (int r = 0; r < 16; ++r) acc[r] = 0.f;
#pragma unroll
        for (int kk = 0; kk < 2; ++kk) {
          bf16x8 a = *(const bf16x8*)(sBT + (cb * 32 + l31) * 40 + kk * 16 + 8 * hl);
          bf16x8 bb = *(const bf16x8*)(sSAT + (vb * 32 + l31) * 40 + kk * 16 + 8 * hl);
          acc = mfma32(a, bb, acc);
        }
        if (vb < 2) {
#pragma unroll
          for (int kk = 0; kk < 2; ++kk) {
            bf16x8 a = *(const bf16x8*)(sKT + (cb * 32 + l31) * 40 + kk * 16 + 8 * hl);
            bf16x8 bb = *(const bf16x8*)(sVT + (vb * 32 + l31) * 40 + kk * 16 + 8 * hl);
            acc = mfma32(a, bb, acc);
          }
        }
#pragma unroll
        for (int r = 0; r < 16; ++r) Zm[cb][r] = sPT[cb * 32 + acc_row(r, lane)] * (Zm[cb][r] + acc[r]);
      }
#pragma unroll
      for (int cb = 0; cb < 2; ++cb)
#pragma unroll
        for (int g = 0; g < 4; ++g) {
          u32x2 pk; pk.x = pack2(Zm[cb][4 * g], Zm[cb][4 * g + 1]); pk.y = pack2(Zm[cb][4 * g + 2], Zm[cb][4 * g + 3]);
          *(u32x2*)(sZ + (vb * 32 + l31) * 72 + cb * 32 + 8 * g + 4 * hl) = pk;
        }
    }
  }
  if (!FULL) {
    float* Zs = segZ + ((size_t)sid * RW_NSEG + seg) * 64 * 128;
#pragma unroll
    for (int cb = 0; cb < 2; ++cb)
#pragma unroll
      for (int r = 0; r < 16; ++r) Zs[(cb * 32 + acc_row(r, lane)) * 128 + wave * 32 + l31] = Zm[cb][r];
  }
}

constexpr int LRU_NCH = (CTXL + SEQ) / 64;
constexpr size_t OFF_ACUM0 = OFF_PU;
static_assert((size_t)NLAT * 512 * 2 <= (size_t)2 * NEXP * 1024, "acum0");

DEV void st_lru_chunk(const Params& P, int sid, int cc, unsigned char* smem) {
  constexpr int NC_CTX = CTXL / 64;
  const int tid = threadIdx.x, lane = tid & 63, wave = tid >> 6;
  const int d = sid & 1, blk = (sid >> 1) & 7, b = sid >> 4;
  float* sXc = (float*)smem;
  float* sAc = sXc + 4096;
  float* sBc = sAc + 4096;
  float* sU = sBc + 4096;
  bf16_t* sAop = (bf16_t*)(sU + 4096);
  float* sQA = (float*)(sAop + 64 * 72);
  float* sQH = sQA + 256;
  int* sRow = (int*)(sQH + 256);
  const bf16_t* proj = (const bf16_t*)(P.ws + OFF_PROJ);
  bf16_t* uout = (bf16_t*)(P.ws + OFF_LORA) + (size_t)d * NTOK * 512;
  bf16_t* aout = (bf16_t*)(P.ws + (d ? OFF_ACUM1 : OFF_ACUM0));
  const bf16_t* lruT = (const bf16_t*)(P.ws + OFF_LRUT) + (size_t)(d * 8 + blk) * 128 * 64;
  float* chunkS = (float*)(P.ws + OFF_LRUCS) + ((size_t)sid * LRU_NCH + cc) * 128;
  const float* cw = P.in[I_LCONVW];
  const float* cb = P.in[I_LCONVB];
  const int tr = (wave >> 1) * 32, nc0 = (wave & 1) * 64;
  const int sgi = cc >= NC_CTX;
  const int row0 = sgi ? NCTX + b * SEQ : b * CTXL;
  const int len = sgi ? SEQ : CTXL;
  const int cl = (sgi ? cc - NC_CTX : cc) * 64;
  __syncthreads();
  if (tid < 64) { int p = cl + tid; sRow[tid] = row0 + (d ? len - 1 - p : p); }
  {
    const int lc8 = (tid & 7) * 8, lch = blk * 64 + lc8;
#pragma unroll
    for (int i = 0; i < 2; ++i) {
      int c = tid + i * 256, r = c >> 3;
      int p = cl + r, pos = d ? len - 1 - p : p;
      float o[8];
      f32x4 c0 = *(const f32x4*)(cb + lch), c1 = *(const f32x4*)(cb + lch + 4);
      o[0] = c0.x; o[1] = c0.y; o[2] = c0.z; o[3] = c0.w; o[4] = c1.x; o[5] = c1.y; o[6] = c1.z; o[7] = c1.w;
#pragma unroll
      for (int tap = 0; tap < 4; ++tap) {
        int pp = pos + tap - 2;
        if (pp >= 0 && pp < len) {
          float x[8];
          unpack8(*(const u32x4*)(proj + (size_t)(row0 + pp) * ODC + 2304 + lch), x);
          f32x4 w0 = *(const f32x4*)(cw + tap * 512 + lch), w1 = *(const f32x4*)(cw + tap * 512 + lch + 4);
          o[0] += w0.x * x[0]; o[1] += w0.y * x[1]; o[2] += w0.z * x[2]; o[3] += w0.w * x[3];
          o[4] += w1.x * x[4]; o[5] += w1.y * x[5]; o[6] += w1.z * x[6]; o[7] += w1.w * x[7];
        }
      }
#pragma unroll
      for (int j = 0; j < 8; ++j) sXc[r * 64 + lc8 + j] = o[j];
      *(u32x4*)(sAop + r * 72 + lc8) = pack8(o);
    }
  }
  __syncthreads();
  {
    f32x16 acc[2];
#pragma unroll
    for (int j = 0; j < 2; ++j)
#pragma unroll
      for (int r = 0; r < 16; ++r) acc[j][r] = 0.f;
#pragma unroll
    for (int kk = 0; kk < 4; ++kk) {
      bf16x8 a = *(const bf16x8*)(sAop + (tr + (lane & 31)) * 72 + kk * 16 + 8 * (lane >> 5));
#pragma unroll
      for (int j = 0; j < 2; ++j) {
        bf16x8 bb = *(const bf16x8*)(lruT + (nc0 + j * 32 + (lane & 31)) * 64 + kk * 16 + 8 * (lane >> 5));
        acc[j] = mfma32(a, bb, acc[j]);
      }
    }
#pragma unroll
    for (int j = 0; j < 2; ++j) {
      const int e = nc0 + j * 32 + (lane & 31);
      const int ch = blk * 64 + (e & 63);
      const float ebias = e < 64 ? P.in[I_BA][d * 512 + ch] : P.in[I_BI][d * 512 + ch];
      const float esp = softplusf_(-P.in[I_LAM][d * 512 + ch]);
#pragma unroll
      for (int r = 0; r < 16; ++r) {
        int t = tr + acc_row(r, lane);
        float g = sigmoidf_(acc[j][r] + ebias);
        if (e < 64) { float a_ = fexp(-8.f * g * esp); sAc[t * 64 + e] = a_; sU[t * 64 + e] = fsqrt(fmaxf(1.f - a_ * a_, 0.f)); }
        else sBc[t * 64 + (e - 64)] = g * sXc[t * 64 + (e - 64)];
      }
    }
  }
  __syncthreads();
  const int c = tid & 63, q = tid >> 6;
  {
    float h = 0.f, ap = 1.f;
#pragma unroll 4
    for (int i = 0; i < 16; ++i) {
      const int t = q * 16 + i;
      const float a = sAc[t * 64 + c];
      h = a * h + sU[t * 64 + c] * sBc[t * 64 + c];
      ap *= a;
      sU[t * 64 + c] = h; sAc[t * 64 + c] = ap;
    }
    sQA[q * 64 + c] = ap; sQH[q * 64 + c] = h;
  }
  __syncthreads();
  {
    float hin = 0.f, ain = 1.f;
    for (int q2 = 0; q2 < q; ++q2) { hin = sQA[q2 * 64 + c] * hin + sQH[q2 * 64 + c]; ain *= sQA[q2 * 64 + c]; }
    if (q > 0) {
#pragma unroll 4
      for (int i = 0; i < 16; ++i) {
        const int t = q * 16 + i;
        const float ap = sAc[t * 64 + c];
        sU[t * 64 + c] += ap * hin;
        sAc[t * 64 + c] = ap * ain;
      }
    }
    if (q == 3) { chunkS[c] = sAc[63 * 64 + c]; chunkS[64 + c] = sU[63 * 64 + c]; }
  }
  __syncthreads();
  if (sgi) {
#pragma unroll
    for (int i = 0; i < 2; ++i) {
      int cidx = tid + i * 256, r = cidx >> 3, c8 = (cidx & 7) * 8;
      float u8[8], a8[8];
#pragma unroll
      for (int j = 0; j < 8; ++j) { u8[j] = sU[r * 64 + c8 + j]; a8[j] = sAc[r * 64 + c8 + j]; }
      const int row = sRow[r];
      *(u32x4*)(uout + (size_t)row * 512 + blk * 64 + c8) = pack8(u8);
      *(u32x4*)(aout + (size_t)(row - NCTX) * 512 + blk * 64 + c8) = pack8(a8);
    }
  }
}

DEV void st_lru_carry(const Params& P, int sid) {
  const int c = threadIdx.x;
  if (c >= 64) return;
  const float* cs = (const float*)(P.ws + OFF_LRUCS) + (size_t)sid * LRU_NCH * 128;
  float* hs = (float*)(P.ws + OFF_LRUHS) + (size_t)sid * LRU_NCH * 64;
  float h = 0.f;
  for (int cc0 = 0; cc0 < LRU_NCH; cc0 += 10) {
    float a[10], bb[10];
#pragma unroll
    for (int i = 0; i < 10; ++i) { a[i] = cs[(size_t)(cc0 + i) * 128 + c]; bb[i] = cs[(size_t)(cc0 + i) * 128 + 64 + c]; }
#pragma unroll
    for (int i = 0; i < 10; ++i) { hs[(size_t)(cc0 + i) * 64 + c] = h; h = a[i] * h + bb[i]; }
  }
}

DEV void st_finish_l1(const Params& P, int row) {
  const int lane = threadIdx.x & 63;
  bf16_t* hb = (bf16_t*)(P.ws + OFF_HBUF) + (size_t)row * 1024;
  const bf16_t* proj = (const bf16_t*)(P.ws + OFF_PROJ);
  const bf16_t* lora = (const bf16_t*)(P.ws + OFF_LORA);
  const float* mu = P.in[I_MU];
  const int ch = lane * 8;
  float y0[8], y1[8];
  unpack8(*(const u32x4*)(hb + ch), y0);
  unpack8(*(const u32x4*)(hb + 512 + ch), y1);
  float sm = 0.f;
#pragma unroll
  for (int j = 0; j < 8; ++j) { y0[j] += y1[j]; sm += y0[j]; }
  sm += wshfl_xor(sm, 1); sm += wshfl_xor(sm, 2); sm += wshfl_xor(sm, 4);
  const float mean = sm * (1.f / 64.f);
  float sv = 0.f;
#pragma unroll
  for (int j = 0; j < 8; ++j) { float dlt = y0[j] - mean; sv += dlt * dlt; }
  sv += wshfl_xor(sv, 1); sv += wshfl_xor(sv, 2); sv += wshfl_xor(sv, 4);
  const float rstd = frsq(sv * (1.f / 64.f) + 64e-5f);
  float a0[8], a1[8], g[8], u0[8], u1[8], gb[8];
  unpack8(*(const u32x4*)(lora + ((size_t)2 * NTOK + row) * 512 + ch), a0);
  unpack8(*(const u32x4*)(lora + ((size_t)3 * NTOK + row) * 512 + ch), a1);
  unpack8(*(const u32x4*)(lora + ((size_t)4 * NTOK + row) * 512 + ch), g);
  unpack8(*(const u32x4*)(lora + ((size_t)0 * NTOK + row) * 512 + ch), u0);
  unpack8(*(const u32x4*)(lora + ((size_t)1 * NTOK + row) * 512 + ch), u1);
  if (row >= NCTX) {
    const int bb_ = (row - NCTX) / SEQ, pos = (row - NCTX) % SEQ, blk = ch >> 6;
    float ac[8];
#pragma unroll
    for (int dd = 0; dd < 2; ++dd) {
      const int pidx = dd ? SEQ - 1 - pos : pos;
      const int cc = CTXL / 64 + pidx / 64;
      const int sid = (bb_ * 8 + blk) * 2 + dd;
      const float* hs = (const float*)(P.ws + OFF_LRUHS) + ((size_t)sid * LRU_NCH + cc) * 64 + (ch & 63);
      unpack8(*(const u32x4*)((const bf16_t*)(P.ws + (dd ? OFF_ACUM1 : OFF_ACUM0)) + (size_t)(row - NCTX) * 512 + ch), ac);
      f32x4 h0 = *(const f32x4*)hs, h1 = *(const f32x4*)(hs + 4);
      float* u = dd ? u1 : u0;
      u[0] += ac[0] * h0.x; u[1] += ac[1] * h0.y; u[2] += ac[2] * h0.z; u[3] += ac[3] * h0.w;
      u[4] += ac[4] * h1.x; u[5] += ac[5] * h1.y; u[6] += ac[6] * h1.z; u[7] += ac[7] * h1.w;
    }
  }
  unpack8(*(const u32x4*)(proj + (size_t)row * ODC + 1792 + ch), gb);
  float rv[8], vv[8];
  float sdot = 0.f;
#pragma unroll
  for (int j = 0; j < 8; ++j) {
    float r = mixval(proj, row, ch + j, mu);
    float k = mixval(proj, row, 512 + ch + j, mu);
    vv[j] = mixval(proj, row, 1024 + ch + j, mu);
    float am = 0.5f * (sigmoidf_(a0[j]) + sigmoidf_(a1[j]));
    float kb = k * (1.f + (am - 1.f) * P.in[I_KA][ch + j]);
    sdot += r * kb * P.in[I_RK][ch + j];
    rv[j] = r;
  }
  sdot += wshfl_xor(sdot, 1); sdot += wshfl_xor(sdot, 2); sdot += wshfl_xor(sdot, 4);
  float f1[8], f2[8];
#pragma unroll
  for (int j = 0; j < 8; ++j) {
    float yn = (y0[j] - mean) * rstd * P.in[I_LNW][ch + j] + P.in[I_LNB][ch + j];
    yn += sdot * vv[j];
    f1[j] = yn * g[j];
    f2[j] = (u0[j] + u1[j]) * geluf_(gb[j]);
  }
  *(u32x4*)(hb + ch) = pack8(f1);
  *(u32x4*)(hb + 512 + ch) = pack8(f2);
}

DEV unsigned fkey(float f) { unsigned u; __builtin_memcpy(&u, &f, 4); return (u >> 31) ? ~u : (u | 0x80000000u); }
DEV float keyf(unsigned u) { u = (u >> 31) ? (u & 0x7fffffffu) : ~u; float f; __builtin_memcpy(&f, &u, 4); return f; }
DEV void key_insert(unsigned x, unsigned* v) {
#pragma unroll
  for (int j = 0; j < 16; ++j) { unsigned hi = v[j] > x ? v[j] : x; x = v[j] > x ? x : v[j]; v[j] = hi; }
}
DEV void key_cx(unsigned& hi, unsigned& lo) { unsigned a = hi, b = lo; hi = a > b ? a : b; lo = a > b ? b : a; }
DEV void key_sort16(unsigned* v) {
#pragma unroll
  for (int k = 2; k <= 16; k <<= 1)
#pragma unroll
    for (int j = k >> 1; j > 0; j >>= 1)
#pragma unroll
      for (int i = 0; i < 16; ++i) {
        const int l = i ^ j;
        if (l > i) { if ((i & k) == 0) key_cx(v[i], v[l]); else key_cx(v[l], v[i]); }
      }
}
DEV void key_merge16(unsigned* a, const unsigned* b) {
#pragma unroll
  for (int i = 0; i < 16; ++i) a[i] = a[i] > b[15 - i] ? a[i] : b[15 - i];
#pragma unroll
  for (int j = 8; j > 0; j >>= 1)
#pragma unroll
    for (int i = 0; i < 16; ++i) { const int l = i ^ j; if (l > i) key_cx(a[i], a[l]); }
}

DEV void st_peer_topk(const Params& P, int layer, int tile, int h, unsigned char* smem) {
  const int tid = threadIdx.x;
  const bf16_t* q = (const bf16_t*)(P.ws + OFF_Q);
  const bf16_t* keys = (const bf16_t*)(P.ws + OFF_KEYS) + (size_t)(layer * 8 + h) * 2 * 128 * 128;
  float* sS = (float*)smem;
  const int m0 = tile * 128;
  const int tok = tid & 127, half = tid >> 7;
  unsigned kl[2][16];
#pragma unroll
  for (int p = 0; p < 2; ++p) {
    EpiScoreLds epi{sS, m0};
    gemm_tile_128<true>(q + (h * 2 + p) * 128, 2048, NTOK, keys + p * 128 * 128, 128, 128, 128, m0, 0, epi, smem);
    __syncthreads();
    float* row = sS + tok * 129 + half * 64;
#pragma unroll
    for (int g = 0; g < 4; ++g) {
      unsigned grp[16];
#pragma unroll
      for (int j = 0; j < 16; ++j) grp[j] = (fkey(row[g * 16 + j]) & ~127u) | (unsigned)(127 - (half * 64 + g * 16 + j));
      key_sort16(grp);
      if (g == 0) {
#pragma unroll
        for (int j = 0; j < 16; ++j) kl[p][j] = grp[j];
      } else key_merge16(kl[p], grp);
    }
    if (half == 1) {
#pragma unroll
      for (int j = 0; j < 16; ++j) row[j] = __builtin_bit_cast(float, kl[p][j]);
    }
    __syncthreads();
    if (half == 0) {
      unsigned oth[16];
#pragma unroll
      for (int j = 0; j < 16; ++j) oth[j] = __builtin_bit_cast(unsigned, sS[tok * 129 + 64 + j]);
      key_merge16(kl[p], oth);
    }
    __syncthreads();
  }
  if (tid < 128) {
    float sv0[16], sv1[16];
    int* irow = (int*)(sS + tid * 129);
#pragma unroll
    for (int j = 0; j < 16; ++j) {
      sv0[j] = keyf((kl[0][j] & ~127u) | 64u); sv1[j] = keyf((kl[1][j] & ~127u) | 64u);
      irow[j] = 127 - (int)(kl[0][j] & 127u); irow[16 + j] = 127 - (int)(kl[1][j] & 127u);
    }
    unsigned best[16];
#pragma unroll
    for (int j = 0; j < 16; ++j) best[j] = 0u;
#pragma unroll
    for (int i = 0; i < 16; ++i)
#pragma unroll
      for (int j = 0; j < 16; ++j)
        if ((i + 1) * (j + 1) <= 16) key_insert((fkey(sv0[i] + sv1[j]) & ~255u) | (unsigned)(255 - (i * 16 + j)), best);
    float e[16], sum = 0.f;
    const float b0 = keyf((best[0] & ~255u) | 128u);
#pragma unroll
    for (int j = 0; j < 16; ++j) { e[j] = fexp(keyf((best[j] & ~255u) | 128u) - b0); sum += e[j]; }
    const float inv = 1.f / sum;
    int* pidx = (int*)(P.ws + OFF_PIDX) + (size_t)(m0 + tid) * 128 + h * 16;
    float* pg = (float*)(P.ws + OFF_PGATE) + (size_t)(m0 + tid) * 128 + h * 16;
#pragma unroll
    for (int j = 0; j < 16; ++j) {
      const int pos = 255 - (int)(best[j] & 255u);
      pidx[j] = irow[pos >> 4] * 128 + irow[16 + (pos & 15)];
      pg[j] = e[j] * inv;
    }
  }
}

DEV void st_peer_experts(const Params& P, int layer, int row) {
  const int lane = threadIdx.x & 63;
  const bf16_t* xb = (const bf16_t*)(P.ws + OFF_HBUF) + (size_t)row * 1024;
  const unsigned char* U = P.ws + OFF_PU;
  const int* pidx = (const int*)(P.ws + OFF_PIDX) + (size_t)row * 128;
  const float* pg = (const float*)(P.ws + OFF_PGATE) + (size_t)row * 128;
  float x[16], acc[16];
  unpack8(*(const u32x4*)(xb + lane * 16), x);
  unpack8(*(const u32x4*)(xb + lane * 16 + 8), x + 8);
#pragma unroll
  for (int j = 0; j < 16; ++j) acc[j] = 0.f;
  const int b5 = (lane >> 5) & 1, b4 = (lane >> 4) & 1, b3 = (lane >> 3) & 1;
  const int mypick = (lane >> 3) & 7;
  for (int k0 = 0; k0 < 128; k0 += 8) {
    u32x3 uu[8]; u32x2 vv[8];
#pragma unroll
    for (int i = 0; i < 8; ++i) {
      const unsigned char* er = U + (size_t)pidx[k0 + i] * PEER_ROWB;
      const unsigned* up = (const unsigned*)(er + lane * 12);
      uu[i].x = up[0]; uu[i].y = up[1]; uu[i].z = up[2];
      vv[i] = *(const u32x2*)(er + PEER_VOFF + lane * 8);
    }
    const float mygate = pg[k0 + mypick];
    float dsum[8];
#pragma unroll
    for (int i = 0; i < 8; i += 2) {
      float ufa[16], ufb[16];
#ifndef CPU_EMU
      __builtin_amdgcn_sched_barrier(0);
#endif
      unpack2x16_fp6(uu[i], uu[i + 1], ufa, ufb);
      typedef __attribute__((ext_vector_type(2))) float f32x2v;
      f32x2v da2 = {0.f, 0.f}, db2 = {0.f, 0.f};
#pragma unroll
      for (int j = 0; j < 8; ++j) {
        const f32x2v xx = {x[2 * j], x[2 * j + 1]};
        const f32x2v ua = {ufa[2 * j], ufa[2 * j + 1]}, ub = {ufb[2 * j], ufb[2 * j + 1]};
        da2 = xx * ua + da2; db2 = xx * ub + db2;
      }
      dsum[i] = da2.x + da2.y; dsum[i + 1] = db2.x + db2.y;
    }
    float e4[4], e2[2], g;
#pragma unroll
    for (int i = 0; i < 4; ++i) {
      float mine = b5 ? dsum[4 + i] : dsum[i], send = b5 ? dsum[i] : dsum[4 + i];
      e4[i] = mine + wshfl_xor(send, 32);
    }
#pragma unroll
    for (int i = 0; i < 2; ++i) {
      float mine = b4 ? e4[2 + i] : e4[i], send = b4 ? e4[i] : e4[2 + i];
      e2[i] = mine + wshfl_xor(send, 16);
    }
    {
      float mine = b3 ? e2[1] : e2[0], send = b3 ? e2[0] : e2[1];
      g = mine + wshfl_xor(send, 8);
    }
    g += wshfl_xor(g, 4); g += wshfl_xor(g, 2); g += wshfl_xor(g, 1);
    const float mycoef = mygate * geluf_(g * (1.f / PEER_USCALE));
#pragma unroll
    for (int i = 0; i < 8; ++i) {
      const float coef = wreadlane(mycoef, i * 8);
      float vf[16];
      unpack8_fp4(vv[i].x, vf); unpack8_fp4(vv[i].y, vf + 8);
#pragma unroll
      for (int j = 0; j < 16; ++j) acc[j] += coef * vf[j];
    }
  }
  float* xr = row < NCTX ? (float*)(P.ws + OFF_CTXRES) + (size_t)row * 1024 : P.out + (size_t)(row - NCTX) * 1024;
  const float* g2 = (const float*)(P.ws + OFF_MODV) + ((size_t)layer * 3 + mod_row(row)) * 6144 + 5 * 1024;
  float o[16];
#pragma unroll
  for (int q = 0; q < 4; ++q) {
    const int c = lane * 16 + q * 4;
    f32x4 a = *(const f32x4*)(xr + c), ga = *(const f32x4*)(g2 + c);
    o[q * 4 + 0] = a.x + ga.x * acc[q * 4 + 0] * (1.f / PEER_VSCALE); o[q * 4 + 1] = a.y + ga.y * acc[q * 4 + 1] * (1.f / PEER_VSCALE);
    o[q * 4 + 2] = a.z + ga.z * acc[q * 4 + 2] * (1.f / PEER_VSCALE); o[q * 4 + 3] = a.w + ga.w * acc[q * 4 + 3] * (1.f / PEER_VSCALE);
  }
  float ss = 0.f;
#pragma unroll
  for (int j = 0; j < 16; ++j) ss += o[j] * o[j];
  ss = wave_sum(ss);
  const float rstd = frsq(ss * (1.f / 1024.f) + 1e-6f);
  if (layer == 1) {
#pragma unroll
    for (int j = 0; j < 16; ++j) o[j] *= rstd * P.in[I_FNORM][lane * 16 + j];
  }
#pragma unroll
  for (int q = 0; q < 4; ++q) {
    f32x4 a = {o[q * 4 + 0], o[q * 4 + 1], o[q * 4 + 2], o[q * 4 + 3]};
    *(f32x4*)(xr + lane * 16 + q * 4) = a;
  }
  if (layer == 0) {
    const float* mv = (const float*)(P.ws + OFF_MODV) + ((size_t)1 * 3 + mod_row(row)) * 6144;
    const float* nw = P.in[I_NORM1] + 1024;
    float hh[16];
#pragma unroll
    for (int q = 0; q < 4; ++q) {
      const int c = lane * 16 + q * 4;
      f32x4 w4 = *(const f32x4*)(nw + c), s4 = *(const f32x4*)(mv + 1024 + c), h4 = *(const f32x4*)(mv + c);
      hh[q * 4 + 0] = o[q * 4 + 0] * rstd * w4.x * (1.f + s4.x) + h4.x; hh[q * 4 + 1] = o[q * 4 + 1] * rstd * w4.y * (1.f + s4.y) + h4.y;
      hh[q * 4 + 2] = o[q * 4 + 2] * rstd * w4.z * (1.f + s4.z) + h4.z; hh[q * 4 + 3] = o[q * 4 + 3] * rstd * w4.w * (1.f + s4.w) + h4.w;
    }
    bf16_t* hb = (bf16_t*)(P.ws + OFF_HBUF) + (size_t)row * 1024 + lane * 16;
    *(u32x4*)hb = pack8(hh);
    *(u32x4*)(hb + 8) = pack8(hh + 8);
  }
}


#define FOR_TILES_XCD(MT0, MT1, NT, mt, nt)                                                     \
  for (int _x = blockIdx.x & 7, _mlo = (MT0) + (((MT1) - (MT0)) * _x) / 8,                        \
           _mhi = (MT0) + (((MT1) - (MT0)) * (_x + 1)) / 8, _i = blockIdx.x >> 3,                 \
           _cnt = (_mhi - _mlo) * (NT), mt = 0, nt = 0;                                           \
       _i < _cnt && ((mt = _mlo + _i / (NT)), (nt = _i % (NT)), true); _i += (int)(gridDim.x >> 3))

#ifndef PHASE_LIST
#define PHASE_LIST(X) X(0) X(1) X(2) X(22) X(23) X(3) X(4) X(5) X(6) X(7) X(8) X(9) X(11) X(12) X(13) X(30) X(14) X(15) X(31) X(16) X(17) X(18) X(19) X(20) X(21)
#endif
constexpr int PH_LAST = 21;

template <int ph>
DEV void run_phase(const Params& P, unsigned char* smem) {
  int bid_ = blockIdx.x, wave_ = threadIdx.x >> 6;
  OPAQUE_S(bid_); OPAQUE(wave_);
  const int bid = bid_, nb = gridDim.x;
  const int wave = wave_;
  unsigned char* ws = P.ws;
  constexpr int layer = ((ph >= 10 && ph <= 21) || ph >= 30) ? 1 : 0;
  const float* modv_l = (const float*)(ws + OFF_MODV) + (size_t)layer * 3 * 6144;
  switch (ph) {
    case 0:
      for (int t = NTRANS + bid; t < NPREP; t += nb) st_prep(P, t, smem);
      break;
    case 1: case 10:
      if (ph == 1) for (int t = nb - 1 - bid; t < NTRANS; t += nb) st_prep(P, t, smem);
      for (int t = bid; t < NTOK / 4; t += nb) st_normmod(P, layer, 0, t * 4 + wave);
      break;
    case 2: {
      EpiProjL0T epi{(bf16_t*)(ws + OFF_PROJ), (float*)(ws + OFF_GATES)};
      FOR_TILES_XCD(0, NTOK / 256, 25, mt, nt)
        gemm_tile_128x256<EpiProjL0T, true>((const bf16_t*)(ws + OFF_WEVIN), 1024, EVC, (const bf16_t*)(ws + OFF_HBUF), 1024, NTOK, 1024,
                                            nt * 128, mt * 256, epi, smem);
    } break;
    case 22:
      for (int t = bid; t < NTOK / 4; t += nb) st_xbc_conv(P, t * 4 + wave);
      for (int t = bid; t < NPCONV; t += nb) st_peer_conv(P, 0, t);
      break;
    case 23:
      for (int t = bid; t < 48 * LA_NSEG; t += nb) {
        int sid = t % 48, seg = t / 48;
        if (sid < 16) st_linattn_seg<true, false>(P, sid, seg, smem);
        else st_linattn_seg<false, false>(P, sid - 16, seg, smem);
      }
      break;
    case 3:
      for (int t = bid; t < 48 * LA_NSEG; t += nb) {
        int sid = t % 48, seg = t / 48;
        if (sid < 16) st_linattn_seg<true, true>(P, sid, seg, smem);
        else st_linattn_seg<false, true>(P, sid - 16, seg, smem);
      }
      break;
    case 4:
      for (int t = bid; t < NTOK / 4; t += nb) st_finish_l0(P, t * 4 + wave);
      break;
    case 5: case 17: {
      EpiOutProjT epi{layer == 0 ? P.in[I_X] : P.out, P.in[I_CTX], P.out, (float*)(ws + OFF_CTXRES), modv_l};
      const bf16_t* Wt = (const bf16_t*)(ws + (layer == 0 ? OFF_WEVOUT : OFF_WODOUT));
      FOR_TILES_XCD(layer == 0 ? 0 : NCTX / 256, NTOK / 256, 8, mt, nt)
        gemm_tile_128x256<EpiOutProjT, true>(Wt, 1024, 1024, (const bf16_t*)(ws + OFF_HBUF), 1024, NTOK, 1024, nt * 128, mt * 256, epi, smem);
    } break;
    case 6: case 18: {
      const int r0 = layer == 0 ? 0 : NCTX / 4;
      for (int t = r0 + bid; t < NTOK / 4; t += nb) st_normmod(P, layer, 1, t * 4 + wave);
      if (ph == 18) for (int t = bid; t < NPCONV; t += nb) st_peer_conv(P, 1, t);
    } break;
    case 7: case 19: {
      EpiStoreBfT epi{(bf16_t*)(ws + OFF_Q), 2048};
      const bf16_t* Wt = (const bf16_t*)(ws + OFF_WQ) + (size_t)layer * 2048 * 1024;
      FOR_TILES_XCD(layer == 0 ? 0 : NCTX / 256, NTOK / 256, 16, mt, nt)
        gemm_tile_128x256<EpiStoreBfT, true>(Wt, 1024, 2048, (const bf16_t*)(ws + OFF_HBUF), 1024, NTOK, 1024, nt * 128, mt * 256, epi, smem);
    } break;
    case 8: case 20: {
      const int t0 = layer == 0 ? 0 : CTILE * 8;
      for (int t = t0 + bid; t < NTILE * 8; t += nb) st_peer_topk(P, layer, t / 8, t % 8, smem);
    } break;
    case 9: case 21: {
      const int r0 = layer == 0 ? 0 : NCTX / 4;
      for (int t = r0 + bid; t < NTOK / 4; t += nb) st_peer_experts(P, layer, t * 4 + wave);
    } break;
    case 11: {
      EpiStoreBfT epi{(bf16_t*)(ws + OFF_PROJ), ODC};
      FOR_TILES_XCD(0, NTOK / 256, 22, mt, nt)
        gemm_tile_128x256<EpiStoreBfT, true>((const bf16_t*)(ws + OFF_WODIN), 1024, ODC, (const bf16_t*)(ws + OFF_HBUF), 1024, NTOK, 1024,
                                             nt * 128, mt * 256, epi, smem);
    } break;
    case 12:
      for (int t = bid; t < NTOK / 4; t += nb) st_lora_act(P, t * 4 + wave);
      break;
    case 13:
      for (int t = bid; t < NTILE * 20; t += nb) {
        int job = t / (NTILE * 4), tt = t % (NTILE * 4);
        int mt = tt / 4, nt = tt % 4;
        bf16_t* dst = (bf16_t*)(ws + OFF_LORA) + (size_t)job * NTOK * 512;
        const bf16_t* A = (const bf16_t*)(ws + OFF_HBUF) + (job < 2 ? 0 : (job < 4 ? 64 : 128));
        const bf16_t* Bt = job < 2 ? (const bf16_t*)(ws + OFF_WUP) + (size_t)job * 512 * 64
                         : job < 4 ? (const bf16_t*)(ws + OFF_AUP) + (size_t)(job - 2) * 512 * 64
                                   : (const bf16_t*)(ws + OFF_GUP);
        const float* bias = job < 2 ? P.in[I_W0] + job * 512 : (job < 4 ? P.in[I_A0] + (job - 2) * 512 : nullptr);
        const int K = job < 4 ? 64 : 128;
        EpiStoreBfBiasT epi{dst, 512, bias};
        gemm_tile_128<false, EpiStoreBfBiasT, true>(Bt, K, 512, A, 1024, NTOK, K, nt * 128, mt * 128, epi, smem);
      }
      break;
    case 30:
      for (int t = bid; t < 32 * RW_NSEG; t += nb) st_rwkv_seg<false>(P, t % 32, t / 32, smem);
      break;
    case 14:
      for (int t = bid; t < 32 * RW_NSEG; t += nb) st_rwkv_seg<true>(P, t % 32, t / 32, smem);
      break;
    case 15:
      for (int t = bid; t < 32 * LRU_NCH; t += nb) st_lru_chunk(P, t % 32, t / 32, smem);
      break;
    case 31:
      if (bid < 32) st_lru_carry(P, bid);
      break;
    case 16:
      for (int t = bid; t < NTOK / 4; t += nb) st_finish_l1(P, t * 4 + wave);
      break;
    default: break;
  }
}


#ifndef CPU_EMU
#define XB_TMO      128
#define XB_XCNT(j)  (256  + 64 * (j))
#define XB_XSUB(j)  (1280 + 64 * (j))
#define XB_XGEN(j)  (2304 + 64 * (j))
#define XB_TOP      3328
#define XB_TOPGEN   3392
#define XCD_BAR_WORDS 3456
#define XB_SPIN_CAP (1u << 20)
#define LAS __attribute__((address_space(3)))
__device__ __forceinline__ unsigned xb_ld(unsigned* p)              { return __hip_atomic_load(p, __ATOMIC_RELAXED, __HIP_MEMORY_SCOPE_AGENT); }
__device__ __forceinline__ unsigned xb_add(unsigned* p, unsigned v) { return __hip_atomic_fetch_add(p, v, __ATOMIC_RELAXED, __HIP_MEMORY_SCOPE_AGENT); }
__device__ __forceinline__ unsigned xb_xcc_id() { return (unsigned)__builtin_amdgcn_s_getreg((3 << 11) | 20) & 0xFu; }
#define XB_SPIN(cond, bar) do { unsigned _sp = 0; while (cond) { __builtin_amdgcn_s_sleep(1); \
    if ((++_sp & 255u) == 0u) { if (xb_ld(&(bar)[XB_TMO])) break; if (_sp > XB_SPIN_CAP) { atomicAdd(&(bar)[XB_TMO], 1u); break; } } } } while (0)
struct XcdBarrier { unsigned* bar; unsigned x; volatile LAS unsigned* st; };
__device__ __forceinline__ XcdBarrier xcd_barrier_post(unsigned* bar, volatile LAS unsigned* st) {
  XcdBarrier b; b.bar = bar; b.x = xb_xcc_id(); b.st = st;
  if (threadIdx.x == 0) (void)xb_add(&bar[XB_XCNT(b.x)], 1u);
  return b;
}
__device__ __forceinline__ void xcd_barrier_complete(unsigned* bar, unsigned x, unsigned& nloc, unsigned& nx) {
  const unsigned G = gridDim.x * gridDim.y * gridDim.z;
  unsigned sum, cnt, mine, sp = 0u;
  for (;;) {
    sum = 0u; cnt = 0u; mine = 0u;
#pragma unroll
    for (unsigned j = 0; j < 16; ++j) { const unsigned c = xb_ld(&bar[XB_XCNT(j)]); sum += c; cnt += (c > 0u) ? 1u : 0u; mine = (j == x) ? c : mine; }
    if (sum == G) break;
    __builtin_amdgcn_s_sleep(1);
    if ((++sp & 255u) == 0u) { if (xb_ld(&bar[XB_TMO])) break; if (sp > XB_SPIN_CAP) { atomicAdd(&bar[XB_TMO], 1u); break; } }
  }
  nloc = mine > 0u ? mine : 1u; nx = cnt > 0u ? cnt : 1u;
}
__device__ __forceinline__ void xcd_barrier(const XcdBarrier& b) {
  asm volatile("s_waitcnt vmcnt(0)" ::: "memory");
  __syncthreads();
  if (threadIdx.x == 0) {
    unsigned* bar = b.bar;
    __builtin_amdgcn_s_waitcnt(0);
    unsigned nloc = b.st[0], nx = b.st[1];
    if (nloc == 0u) { xcd_barrier_complete(bar, b.x, nloc, nx); b.st[0] = nloc; b.st[1] = nx; }
    const unsigned old = xb_add(&bar[XB_XSUB(b.x)], 1u);
    const unsigned gen = old / nloc;
    if (old + 1u == (gen + 1u) * nloc) {
      __builtin_amdgcn_fence(__ATOMIC_RELEASE, "agent");
      asm volatile("s_waitcnt vmcnt(0)" ::: "memory");
      const unsigned og = xb_add(&bar[XB_TOP], 1u);
      const unsigned tg = og / nx;
      if (og + 1u == (tg + 1u) * nx) xb_add(&bar[XB_TOPGEN], 1u);
      else XB_SPIN(xb_ld(&bar[XB_TOPGEN]) == tg, bar);
      __builtin_amdgcn_fence(__ATOMIC_ACQUIRE, "agent");
      xb_add(&bar[XB_XGEN(b.x)], 1u);
      asm volatile("s_waitcnt vmcnt(0)" ::: "memory");
    } else {
      XB_SPIN(xb_ld(&bar[XB_XGEN(b.x)]) == gen, bar);
      __builtin_amdgcn_fence(__ATOMIC_ACQUIRE, "agent");
      asm volatile("s_waitcnt vmcnt(0)" ::: "memory");
    }
  }
  __syncthreads();
}
#endif
#ifndef CPU_EMU
#define RUN_PH(n) run_phase<n>(P, smem_raw); if (n != PH_LAST) xcd_barrier(xb);
__global__ void __launch_bounds__(256, 2) mega_kernel(Params P) {
  SMEM_DECL;
  unsigned* bar = (unsigned*)(P.ws + OFF_BAR);
  volatile LAS unsigned* st = (volatile LAS unsigned*)(smem_raw + SMEM_BYTES - 16);
  if (threadIdx.x == 0) { st[0] = 0u; st[1] = 0u; }
  if (P.ws == nullptr) cg::this_grid().sync();
  __syncthreads();
  XcdBarrier xb = xcd_barrier_post(bar, st);
  PHASE_LIST(RUN_PH)
}

extern "C" void kernel_launch(void* const* d_in, const int* in_sizes, int n_in, void* d_out, int out_size, void* d_ws,
                              size_t ws_size, hipStream_t stream) {
  Params P{};
  for (int i = 0; i < N_IN; ++i) P.in[i] = (const float*)d_in[i];
  P.out = (float*)d_out;
  P.ws = (unsigned char*)d_ws;
  if (ws_size < WS_NEEDED) { fprintf(stderr, "workspace too small: %zu < %zu\n", ws_size, (size_t)WS_NEEDED); return; }
  static int grid_blocks = 0;
  if (!grid_blocks) {
    int dev = 0, cus = 0, per_cu = 0;
    hipGetDevice(&dev);
    hipDeviceGetAttribute(&cus, hipDeviceAttributeMultiprocessorCount, dev);
    hipOccupancyMaxActiveBlocksPerMultiprocessor(&per_cu, mega_kernel, 256, 0);
    if (per_cu > 2) per_cu = 2;
    grid_blocks = cus * per_cu;
  }
  (void)hipMemsetAsync((unsigned char*)d_ws + OFF_BAR, 0, 16384, stream);
  void* args[] = {&P};
  hipError_t e = hipLaunchCooperativeKernel((void*)mega_kernel, dim3(grid_blocks), dim3(256), args, 0, stream);
  if (e != hipSuccess) fprintf(stderr, "cooperative launch failed: %s (grid %d)\n", hipGetErrorString(e), grid_blocks);
}
#endif
```

```cpp
#ifdef CPU_EMU
#include "emu.h"
#else
#include <hip/hip_runtime.h>
#include <hip/hip_cooperative_groups.h>
#include <cstdio>
namespace cg = cooperative_groups;
#define DEV __device__ __forceinline__
#define DEVM __device__ __forceinline__
#define OPAQUE(x) asm volatile("" : "+v"(x))
#define OPAQUE_S(x) asm volatile("" : "+s"(x))
#endif

#ifndef SEQ_LEN
#define SEQ_LEN 16384
#endif
#ifndef CTX_LEN
#define CTX_LEN 256
#endif
#ifndef GRID_W_
#define GRID_W_ 64
#endif
#ifndef MULTI_LAUNCH
#define MULTI_LAUNCH 0
#endif

typedef unsigned short bf16_t;
typedef __attribute__((ext_vector_type(8))) short bf16x8;
typedef __attribute__((ext_vector_type(16))) float f32x16;
typedef __attribute__((ext_vector_type(4))) unsigned u32x4;
typedef __attribute__((ext_vector_type(2))) unsigned u32x2;
typedef __attribute__((ext_vector_type(4))) float f32x4;

constexpr int D = 1024, NB = 2, SEQ = SEQ_LEN, CTXL = CTX_LEN, GW = GRID_W_;
constexpr int NCTX = NB * CTXL, NLAT = NB * SEQ, NTOK = NCTX + NLAT;
constexpr int EVC = 3104, ODC = 2816;
constexpr int NEXP = 16384;
constexpr int NTILE = NTOK / 128, CTILE = NCTX / 128;
static_assert(NTOK % 256 == 0 && NCTX % 256 == 0, "tiles");
static_assert(CTXL % 64 == 0 && SEQ % 64 == 0 && SEQ % GW == 0, "chunks");

constexpr size_t al256(size_t x) { return (x + 255) & ~(size_t)255; }
constexpr size_t OFF_MODV = 0;
constexpr size_t OFF_CTXRES = OFF_MODV + al256(2 * 3 * 6144 * 4);
constexpr size_t OFF_GATES = OFF_CTXRES + al256((size_t)NCTX * 1024 * 4);
constexpr size_t OFF_WEVIN = OFF_GATES + al256((size_t)NTOK * 32 * 4);
constexpr size_t OFF_WEVOUT = OFF_WEVIN + al256((size_t)EVC * 1024 * 2);
constexpr size_t OFF_WODIN = OFF_WEVOUT + al256((size_t)1024 * 1024 * 2);
constexpr size_t OFF_WODOUT = OFF_WODIN + al256((size_t)ODC * 1024 * 2);
constexpr size_t OFF_WQ = OFF_WODOUT + al256((size_t)1024 * 1024 * 2);
constexpr size_t OFF_KEYS = OFF_WQ + al256((size_t)2 * 2048 * 1024 * 2);
constexpr size_t OFF_WUP = OFF_KEYS + al256((size_t)2 * 8 * 2 * 128 * 128 * 2);
constexpr size_t OFF_AUP = OFF_WUP + al256((size_t)2 * 512 * 64 * 2);
constexpr size_t OFF_GUP = OFF_AUP + al256((size_t)2 * 512 * 64 * 2);
constexpr size_t OFF_LRUT = OFF_GUP + al256((size_t)512 * 128 * 2);
constexpr size_t OFF_PU = OFF_LRUT + al256((size_t)2 * 8 * 128 * 64 * 2);
constexpr size_t OFF_PV = OFF_PU + al256((size_t)NEXP * 1024);
constexpr size_t OFF_HBUF = OFF_PV + al256((size_t)NEXP * 1024);
constexpr size_t OFF_PR = OFF_HBUF + al256((size_t)NTOK * 1024 * 2);
constexpr size_t PR_BYTES = (size_t)NTOK * 5376 * 2;
constexpr size_t OFF_BAR = OFF_PR + PR_BYTES;
constexpr size_t OFF_ACUM1 = OFF_BAR + 16384;
constexpr size_t OFF_LRUCS = OFF_ACUM1 + (size_t)NLAT * 512 * 2;
constexpr size_t OFF_LRUHS = OFF_LRUCS + (size_t)32 * ((CTXL + SEQ) / 64) * 128 * 4;
constexpr size_t WS_NEEDED = OFF_LRUHS + (size_t)32 * ((CTXL + SEQ) / 64) * 64 * 4;
#ifndef CPU_EMU
static_assert(WS_NEEDED <= (size_t)512 * 1024 * 1024, "workspace too large");
#endif
constexpr size_t OFF_PROJ = OFF_PR;
constexpr size_t OFF_R2L0 = OFF_PR + (size_t)NTOK * EVC * 2;
constexpr size_t OFF_LORA = OFF_PR + (size_t)NTOK * ODC * 2;
constexpr size_t OFF_Q = OFF_PR;
constexpr size_t OFF_PIDX = OFF_PR + (size_t)NTOK * 2048 * 2;
constexpr size_t OFF_PGATE = OFF_PIDX + (size_t)NTOK * 128 * 4;
static_assert(OFF_PGATE + (size_t)NTOK * 128 * 4 <= OFF_PR + PR_BYTES, "picks");

enum {
  I_X = 0, I_C, I_CTX, I_CCTX, I_MODW, I_MODB, I_NORM1, I_NORM2, I_WQ, I_KEYS, I_PU, I_PV,
  I_EVWIN, I_EVWOUT, I_IBIAS, I_FBIAS, I_MNORM, I_SCONVW, I_SCONVB, I_DTBIAS, I_ALOG, I_DSKIP, I_SNORM,
  I_ODWIN, I_ODWOUT, I_MU, I_W0, I_WUP, I_A0, I_AUP, I_GUP, I_KK, I_KA, I_RK, I_LNW, I_LNB,
  I_LCONVW, I_LCONVB, I_LAM, I_WA, I_BA, I_WI, I_BI, I_FNORM, N_IN
};

struct Params {
  const float* in[N_IN];
  float* out;
  unsigned char* ws;
};

constexpr int SMEM_BYTES = 80 * 1024;
#ifdef CPU_EMU
#define SMEM_DECL static thread_local __attribute__((aligned(16))) unsigned char smem_raw[SMEM_BYTES]
#else
#define SMEM_DECL __shared__ __attribute__((aligned(16))) unsigned char smem_raw[SMEM_BYTES]
#endif

DEV float bf2f(bf16_t v) { unsigned u = ((unsigned)v) << 16; float f; __builtin_memcpy(&f, &u, 4); return f; }
DEV bf16_t f2bf(float f) { unsigned u; __builtin_memcpy(&u, &f, 4); u += 0x7fffu + ((u >> 16) & 1u); return (bf16_t)(u >> 16); }
DEV unsigned pack2(float a, float b) { return (unsigned)f2bf(a) | ((unsigned)f2bf(b) << 16); }
DEV void unpack8(const u32x4& r, float* o) {
  unsigned w[4] = {r.x, r.y, r.z, r.w};
#pragma unroll
  for (int i = 0; i < 4; ++i) { unsigned lo = w[i] << 16, hi = w[i] & 0xffff0000u; __builtin_memcpy(&o[2 * i], &lo, 4); __builtin_memcpy(&o[2 * i + 1], &hi, 4); }
}
DEV u32x4 pack8(const float* o) { u32x4 r; r.x = pack2(o[0], o[1]); r.y = pack2(o[2], o[3]); r.z = pack2(o[4], o[5]); r.w = pack2(o[6], o[7]); return r; }
#ifdef CPU_EMU
DEV float fexp(float x) { return expf(x); }
DEV float frcp(float x) { return 1.f / x; }
DEV float flog(float x) { return logf(x); }
DEV float frsq(float x) { return 1.f / sqrtf(x); }
DEV float fsqrt(float x) { return sqrtf(x); }
#else
DEV float fexp(float x) { return __expf(x); }
DEV float frcp(float x) { return __builtin_amdgcn_rcpf(x); }
DEV float flog(float x) { return __logf(x); }
DEV float frsq(float x) { return __builtin_amdgcn_rsqf(x); }
DEV float fsqrt(float x) { return __builtin_amdgcn_sqrtf(x); }
#endif
DEV void ld8(const float* __restrict__ p, float* o) { const f32x4 a = *(const f32x4*)p, b = *(const f32x4*)(p + 4); o[0] = a.x; o[1] = a.y; o[2] = a.z; o[3] = a.w; o[4] = b.x; o[5] = b.y; o[6] = b.z; o[7] = b.w; }
DEV float sigmoidf_(float x) { return frcp(1.f + fexp(-x)); }
DEV float siluf_(float x) { return x * frcp(1.f + fexp(-x)); }
DEV float softplusf_(float x) { return fmaxf(x, 0.f) + flog(1.f + fexp(-fabsf(x))); }
DEV float tanhf_(float x) { return 1.f - 2.f * frcp(1.f + fexp(2.f * x)); }
DEV float geluf_(float x) { return 0.5f * x * (1.f + erff(x * 0.70710678118654752f)); }

DEV f32x16 mfma32(bf16x8 a, bf16x8 b, f32x16 c) {
#ifdef CPU_EMU
  return emu_mfma32(a, b, c);
#else
  return __builtin_amdgcn_mfma_f32_32x32x16_bf16(a, b, c, 0, 0, 0);
#endif
}
DEV float wshfl_xor(float v, int m) {
#ifdef CPU_EMU
  return emu_shfl_xor(v, m);
#else
  return __shfl_xor(v, m, 64);
#endif
}
DEV float wave_sum(float v) {
#pragma unroll
  for (int m = 32; m >= 1; m >>= 1) v += wshfl_xor(v, m);
  return v;
}

#ifdef CPU_EMU
static inline unsigned emu_f2fp8(float f) {
  unsigned sgn = f < 0.f ? 0x80u : 0u; float a = fabsf(f);
  if (!(a == a)) return 0x7f;
  if (a >= 448.f) return sgn | 0x7e;
  if (a < 0.0009765625f) return sgn;
  int e; frexpf(a, &e); e -= 1;
  if (e < -6) { int q = (int)nearbyintf(a * 512.f); return sgn | (unsigned)q; }
  float m = a / ldexpf(1.f, e);
  int q = (int)nearbyintf((m - 1.f) * 8.f);
  if (q == 8) { q = 0; e += 1; }
  if (e > 8) return sgn | 0x7e;
  return sgn | (unsigned)((e + 7) << 3) | (unsigned)q;
}
static inline float emu_fp82f(unsigned c) {
  unsigned sgn = c & 0x80, e = (c >> 3) & 15, m = c & 7;
  float v = e == 0 ? ldexpf((float)m, -9) : ldexpf(1.f + m / 8.f, (int)e - 7);
  return sgn ? -v : v;
}
#endif
DEV unsigned pack4_fp8(float a, float b, float c, float d) {
#ifdef CPU_EMU
  return emu_f2fp8(a) | (emu_f2fp8(b) << 8) | (emu_f2fp8(c) << 16) | (emu_f2fp8(d) << 24);
#else
  int w = 0;
  w = __builtin_amdgcn_cvt_pk_fp8_f32(a, b, w, false);
  w = __builtin_amdgcn_cvt_pk_fp8_f32(c, d, w, true);
  return (unsigned)w;
#endif
}
DEV void unpack4_fp8(unsigned w, float* o) {
#ifdef CPU_EMU
  o[0] = emu_fp82f(w & 255); o[1] = emu_fp82f((w >> 8) & 255); o[2] = emu_fp82f((w >> 16) & 255); o[3] = emu_fp82f(w >> 24);
#else
  typedef __attribute__((ext_vector_type(2))) float f32x2_;
  f32x2_ lo = __builtin_amdgcn_cvt_pk_f32_fp8((int)w, false);
  f32x2_ hi = __builtin_amdgcn_cvt_pk_f32_fp8((int)w, true);
  o[0] = lo.x; o[1] = lo.y; o[2] = hi.x; o[3] = hi.y;
#endif
}
DEV void unpack16_fp8(const u32x4& r, float* o) { unpack4_fp8(r.x, o); unpack4_fp8(r.y, o + 4); unpack4_fp8(r.z, o + 8); unpack4_fp8(r.w, o + 12); }
DEV float wreadlane(float v, int srclane) {
#ifdef CPU_EMU
  return emu_readlane(v, srclane);
#else
  int iv; __builtin_memcpy(&iv, &v, 4);
  int r = __builtin_amdgcn_readlane(iv, srclane);
  float f; __builtin_memcpy(&f, &r, 4); return f;
#endif
}
constexpr float PEER_USCALE = 64.f, PEER_VSCALE = 4.f;
#ifdef CPU_EMU
static inline unsigned emu_f2fp4(float f) {
  static const float lv[8] = {0.f, 0.5f, 1.f, 1.5f, 2.f, 3.f, 4.f, 6.f};
  unsigned sgn = f < 0.f ? 8u : 0u; float a = fabsf(f);
  int best = 0; float bd = 1e30f;
  for (int i = 0; i < 8; ++i) { float dd = fabsf(a - lv[i]); if (dd < bd || (dd == bd && (i & 1) == 0)) { bd = dd; best = i; } }
  return sgn | (unsigned)best;
}
static inline float emu_fp42f(unsigned c) {
  static const float lv[8] = {0.f, 0.5f, 1.f, 1.5f, 2.f, 3.f, 4.f, 6.f};
  float v = lv[c & 7]; return (c & 8) ? -v : v;
}
#endif
DEV unsigned pack8_fp4(const float* v) {
#ifdef CPU_EMU
  unsigned w = 0;
  for (int i = 0; i < 8; ++i) w |= emu_f2fp4(v[i]) << (4 * i);
  return w;
#else
  unsigned w = 0;
  w = __builtin_amdgcn_cvt_scalef32_pk_fp4_f32(w, v[0], v[1], 1.0f, 0);
  w = __builtin_amdgcn_cvt_scalef32_pk_fp4_f32(w, v[2], v[3], 1.0f, 1);
  w = __builtin_amdgcn_cvt_scalef32_pk_fp4_f32(w, v[4], v[5], 1.0f, 2);
  w = __builtin_amdgcn_cvt_scalef32_pk_fp4_f32(w, v[6], v[7], 1.0f, 3);
  return w;
#endif
}
DEV void unpack8_fp4(unsigned w, float* o) {
#ifdef CPU_EMU
  for (int i = 0; i < 8; ++i) o[i] = emu_fp42f((w >> (4 * i)) & 15u);
#else
  typedef __attribute__((ext_vector_type(2))) float f32x2_;
  f32x2_ a = __builtin_amdgcn_cvt_scalef32_pk_f32_fp4(w, 1.0f, 0);
  f32x2_ b = __builtin_amdgcn_cvt_scalef32_pk_f32_fp4(w, 1.0f, 1);
  f32x2_ c = __builtin_amdgcn_cvt_scalef32_pk_f32_fp4(w, 1.0f, 2);
  f32x2_ d = __builtin_amdgcn_cvt_scalef32_pk_f32_fp4(w, 1.0f, 3);
  o[0] = a.x; o[1] = a.y; o[2] = b.x; o[3] = b.y; o[4] = c.x; o[5] = c.y; o[6] = d.x; o[7] = d.y;
#endif
}
typedef __attribute__((ext_vector_type(3))) unsigned u32x3;
#ifndef FP6_INTERLEAVED
#define FP6_INTERLEAVED 1
#endif
#ifdef CPU_EMU
static inline unsigned emu_f2fp6(float f) {
  unsigned sgn = f < 0.f ? 32u : 0u; float a = fabsf(f);
  if (a >= 7.5f) return sgn | 31u;
  int e; unsigned code;
  if (a < 1.f) { int q = (int)nearbyintf(a * 8.f); code = (unsigned)q; }
  else { frexpf(a, &e); e -= 1; float m = a / ldexpf(1.f, e); int q = (int)nearbyintf((m - 1.f) * 8.f); if (q == 8) { q = 0; e += 1; } code = (unsigned)(((e + 1) << 3) | q); if (e > 2) code = 31u; }
  return sgn | code;
}
static inline float emu_fp62f(unsigned c) {
  unsigned e = (c >> 3) & 3, m = c & 7;
  float v = e == 0 ? m * 0.125f : ldexpf(1.f + m / 8.f, (int)e - 1);
  return (c & 32) ? -v : v;
}
#endif
DEV u32x3 pack16_fp6(const float* v) {
#ifdef CPU_EMU
  unsigned long long lo = 0; unsigned hi = 0;
  for (int i = 0; i < 16; ++i) {
    unsigned long long c = emu_f2fp6(v[i]); int bit = 6 * i;
    if (bit < 64) { lo |= c << bit; if (bit > 58) hi |= (unsigned)(c >> (64 - bit)); } else hi |= (unsigned)(c << (bit - 64));
  }
  u32x3 r; r.x = (unsigned)lo; r.y = (unsigned)(lo >> 32); r.z = hi; return r;
#else
  typedef __attribute__((ext_vector_type(6))) unsigned u32x6_;
  f32x16 a, b;
#if FP6_INTERLEAVED
#pragma unroll
  for (int i = 0; i < 8; ++i) { a[i] = v[2 * i]; b[i] = v[2 * i + 1]; a[8 + i] = 0.f; b[8 + i] = 0.f; }
#else
#pragma unroll
  for (int i = 0; i < 16; ++i) { a[i] = v[i]; b[i] = 0.f; }
#endif
  u32x6_ w = __builtin_amdgcn_cvt_scalef32_2xpk16_fp6_f32(a, b, 1.0f);
  u32x3 r; r.x = w[0]; r.y = w[1]; r.z = w[2]; return r;
#endif
}
DEV void unpack16_fp6(const u32x3& r, float* o) {
#ifdef CPU_EMU
  unsigned long long lo = (unsigned long long)r.x | ((unsigned long long)r.y << 32); unsigned hi = r.z;
  for (int i = 0; i < 16; ++i) {
    int bit = 6 * i; unsigned c;
    if (bit + 6 <= 64) c = (unsigned)(lo >> bit) & 63u;
    else if (bit >= 64) c = (hi >> (bit - 64)) & 63u;
    else c = ((unsigned)(lo >> bit) | (hi << (64 - bit))) & 63u;
    o[i] = emu_fp62f(c);
  }
#else
  typedef __attribute__((ext_vector_type(6))) unsigned u32x6_;
  typedef __attribute__((ext_vector_type(32))) float f32x32_;
  u32x6_ w; w[0] = r.x; w[1] = r.y; w[2] = r.z; w[3] = 0u; w[4] = 0u; w[5] = 0u;
  f32x32_ f = __builtin_amdgcn_cvt_scalef32_pk32_f32_fp6(w, 1.0f);
#pragma unroll
  for (int i = 0; i < 16; ++i) o[i] = f[i];
#endif
}
DEV void unpack2x16_fp6(const u32x3& ra, const u32x3& rb, float* oa, float* ob) {
#ifdef CPU_EMU
  unpack16_fp6(ra, oa); unpack16_fp6(rb, ob);
#else
  typedef __attribute__((ext_vector_type(6))) unsigned u32x6_;
  typedef __attribute__((ext_vector_type(32))) float f32x32_;
  u32x6_ w; w[0] = ra.x; w[1] = ra.y; w[2] = ra.z; w[3] = rb.x; w[4] = rb.y; w[5] = rb.z;
  f32x32_ f = __builtin_amdgcn_cvt_scalef32_pk32_f32_fp6(w, 1.0f);
#pragma unroll
  for (int i = 0; i < 16; ++i) { oa[i] = f[i]; ob[i] = f[16 + i]; }
#endif
}
constexpr int PEER_ROWB = 1280;
constexpr int PEER_VOFF = 768;


DEV int acc_row(int reg, int lane) { return (reg & 3) + 8 * (reg >> 2) + 4 * (lane >> 5); }

DEV int mod_row(int row) { return row < NCTX ? 2 : (row - NCTX) / SEQ; }

template <bool SYNC_EPI, class Epi, bool VEC4 = false>
DEV void gemm_tile_128(const bf16_t* __restrict__ A, int lda, int M, const bf16_t* __restrict__ Bt, int ldb, int N,
                       int K, int m0, int n0, const Epi& epi, unsigned char* smem) {
  constexpr int LS = 72;
  constexpr int STAGE = 2 * 128 * LS;
  bf16_t* sbase = (bf16_t*)smem;
  const int wave = threadIdx.x >> 6;
  const int wm = (wave >> 1) * 64, wn = (wave & 1) * 64;
  f32x16 acc[2][2];
#pragma unroll
  for (int i = 0; i < 2; ++i)
#pragma unroll
    for (int j = 0; j < 2; ++j)
#pragma unroll
      for (int r = 0; r < 16; ++r) acc[i][j][r] = 0.f;
  u32x4 ra[4], rb[4];
  auto gload = [&](int k0) {
    int tl_ = threadIdx.x; OPAQUE(tl_);
#pragma unroll
    for (int i = 0; i < 4; ++i) {
      int c = tl_ + i * 256, r = c >> 3, cc = (c & 7) * 8;
      int gr = m0 + r, gn = n0 + r;
      gr = gr < M ? gr : M - 1; gn = gn < N ? gn : N - 1;
      ra[i] = *(const u32x4*)(A + (size_t)gr * lda + k0 + cc);
      rb[i] = *(const u32x4*)(Bt + (size_t)gn * ldb + k0 + cc);
    }
  };
  auto lwrite = [&](int buf) {
    int tl_ = threadIdx.x; OPAQUE(tl_);
    bf16_t* sA = sbase + buf * STAGE;
    bf16_t* sB = sA + 128 * LS;
#pragma unroll
    for (int i = 0; i < 4; ++i) {
      int c = tl_ + i * 256, r = c >> 3, cc = (c & 7) * 8;
      *(u32x4*)(sA + r * LS + cc) = ra[i];
      *(u32x4*)(sB + r * LS + cc) = rb[i];
    }
  };
  const int nk = K >> 6;
  gload(0);
  __syncthreads();
  lwrite(0);
  if (nk > 1) gload(64);
  __syncthreads();
  for (int it = 0; it < nk; ++it) {
    int tl_ = threadIdx.x; OPAQUE(tl_);
    const int lane = tl_ & 63;
    const bf16_t* sA = sbase + (it & 1) * STAGE;
    const bf16_t* sB = sA + 128 * LS;
#pragma unroll
    for (int kk = 0; kk < 4; ++kk) {
      bf16x8 a[2], b[2];
      const int ko = kk * 16 + 8 * (lane >> 5);
#pragma unroll
      for (int i = 0; i < 2; ++i) a[i] = *(const bf16x8*)(sA + (wm + i * 32 + (lane & 31)) * LS + ko);
#pragma unroll
      for (int j = 0; j < 2; ++j) b[j] = *(const bf16x8*)(sB + (wn + j * 32 + (lane & 31)) * LS + ko);
#pragma unroll
      for (int i = 0; i < 2; ++i)
#pragma unroll
        for (int j = 0; j < 2; ++j) acc[i][j] = mfma32(a[i], b[j], acc[i][j]);
      if (kk == 1) {
        if (it + 1 < nk) lwrite((it + 1) & 1);
        if (it + 2 < nk) gload((it + 2) * 64);
      }
    }
    __syncthreads();
  }
  {
    int tl_ = threadIdx.x; OPAQUE(tl_);
    const int lane = tl_ & 63;
    if constexpr (VEC4) {
#pragma unroll
      for (int i = 0; i < 2; ++i)
#pragma unroll
        for (int j = 0; j < 2; ++j)
#pragma unroll
          for (int gq = 0; gq < 4; ++gq) {
            int row = m0 + wm + i * 32 + 8 * gq + 4 * (lane >> 5);
            int col = n0 + wn + j * 32 + (lane & 31);
            if (row < M && col < N) epi.store4(row, col, acc[i][j][4 * gq], acc[i][j][4 * gq + 1], acc[i][j][4 * gq + 2], acc[i][j][4 * gq + 3]);
          }
    } else {
#pragma unroll
      for (int i = 0; i < 2; ++i)
#pragma unroll
        for (int j = 0; j < 2; ++j)
#pragma unroll
          for (int r = 0; r < 16; ++r) {
            int row = m0 + wm + i * 32 + acc_row(r, lane);
            int col = n0 + wn + j * 32 + (lane & 31);
            if (row < M && col < N) epi(row, col, acc[i][j][r]);
          }
    }
  }
}

template <class Epi, bool VEC4 = false>
DEV void gemm_tile_128x256(const bf16_t* __restrict__ A, int lda, int M, const bf16_t* __restrict__ Bt, int ldb, int N,
                           int K, int m0, int n0, const Epi& epi, unsigned char* smem) {
  constexpr int LS = 72;
  bf16_t* sA = (bf16_t*)smem;
  bf16_t* sB = sA + 128 * LS;
  const int wave = threadIdx.x >> 6;
  const int wm = (wave >> 1) * 64, wn = (wave & 1) * 128;
  f32x16 acc[2][4];
#pragma unroll
  for (int i = 0; i < 2; ++i)
#pragma unroll
    for (int j = 0; j < 4; ++j)
#pragma unroll
      for (int r = 0; r < 16; ++r) acc[i][j][r] = 0.f;
  u32x4 ra[4], rb[8];
  {
    const int tid = threadIdx.x;
#pragma unroll
    for (int i = 0; i < 4; ++i) {
      int c = tid + i * 256, r = c >> 3, cc = (c & 7) * 8;
      { int gr = m0 + r; gr = gr < M ? gr : M - 1; ra[i] = *(const u32x4*)(A + (size_t)gr * lda + cc); }
    }
#pragma unroll
    for (int i = 0; i < 8; ++i) {
      int c = tid + i * 256, r = c >> 3, cc = (c & 7) * 8;
      { int gn = n0 + r; gn = gn < N ? gn : N - 1; rb[i] = *(const u32x4*)(Bt + (size_t)gn * ldb + cc); }
    }
  }
  for (int k0 = 0; k0 < K; k0 += 64) {
    int tl_ = threadIdx.x; OPAQUE(tl_);
    const int tid = tl_, lane = tl_ & 63;
    __syncthreads();
#pragma unroll
    for (int i = 0; i < 4; ++i) { int c = tid + i * 256, r = c >> 3, cc = (c & 7) * 8; *(u32x4*)(sA + r * LS + cc) = ra[i]; }
#pragma unroll
    for (int i = 0; i < 8; ++i) { int c = tid + i * 256, r = c >> 3, cc = (c & 7) * 8; *(u32x4*)(sB + r * LS + cc) = rb[i]; }
    __syncthreads();
    if (k0 + 64 < K) {
#pragma unroll
      for (int i = 0; i < 4; ++i) {
        int c = tid + i * 256, r = c >> 3, cc = (c & 7) * 8;
        { int gr = m0 + r; gr = gr < M ? gr : M - 1; ra[i] = *(const u32x4*)(A + (size_t)gr * lda + k0 + 64 + cc); }
      }
#pragma unroll
      for (int i = 0; i < 8; ++i) {
        int c = tid + i * 256, r = c >> 3, cc = (c & 7) * 8;
        { int gn = n0 + r; gn = gn < N ? gn : N - 1; rb[i] = *(const u32x4*)(Bt + (size_t)gn * ldb + k0 + 64 + cc); }
      }
    }
#pragma unroll 2
    for (int kk = 0; kk < 4; ++kk) {
      bf16x8 a[2], b[4];
      const int ko = kk * 16 + 8 * (lane >> 5);
#pragma unroll
      for (int i = 0; i < 2; ++i) a[i] = *(const bf16x8*)(sA + (wm + i * 32 + (lane & 31)) * LS + ko);
#pragma unroll
      for (int j = 0; j < 4; ++j) b[j] = *(const bf16x8*)(sB + (wn + j * 32 + (lane & 31)) * LS + ko);
#pragma unroll
      for (int i = 0; i < 2; ++i)
#pragma unroll
        for (int j = 0; j < 4; ++j) acc[i][j] = mfma32(a[i], b[j], acc[i][j]);
    }
  }
  {
    int tl_ = threadIdx.x; OPAQUE(tl_);
    const int lane = tl_ & 63;
    if constexpr (VEC4) {
#pragma unroll
      for (int i = 0; i < 2; ++i)
#pragma unroll
        for (int j = 0; j < 4; ++j)
#pragma unroll
          for (int gq = 0; gq < 4; ++gq) {
            int row = m0 + wm + i * 32 + 8 * gq + 4 * (lane >> 5);
            int col = n0 + wn + j * 32 + (lane & 31);
            if (row < M && col < N) epi.store4(row, col, acc[i][j][4 * gq], acc[i][j][4 * gq + 1], acc[i][j][4 * gq + 2], acc[i][j][4 * gq + 3]);
          }
    } else {
#pragma unroll
      for (int i = 0; i < 2; ++i)
#pragma unroll
        for (int j = 0; j < 4; ++j)
#pragma unroll
          for (int r = 0; r < 16; ++r) {
            int row = m0 + wm + i * 32 + acc_row(r, lane);
            int col = n0 + wn + j * 32 + (lane & 31);
            if (row < M && col < N) epi(row, col, acc[i][j][r]);
          }
    }
  }
}

DEV void transpose_tile(const float* __restrict__ src, int ld_src, bf16_t* __restrict__ dst, int ld_dst, int K, int N,
                        int tk, int tn, unsigned char* smem) {
  float* sT = (float*)smem;
  const int tid = threadIdx.x;
  __syncthreads();
  {
    const int tx = tid & 15, ty = tid >> 4;
#pragma unroll
    for (int p = 0; p < 4; ++p) {
      int k = tk * 64 + ty + p * 16, n = tn * 64 + tx * 4;
#pragma unroll
      for (int j = 0; j < 4; ++j) {
        float v = (k < K && n + j < N) ? src[(size_t)k * ld_src + n + j] : 0.f;
        sT[(ty + p * 16) * 65 + tx * 4 + j] = v;
      }
    }
  }
  __syncthreads();
  {
    const int n = tid >> 2, kseg = (tid & 3) * 16;
    int gn = tn * 64 + n;
    if (gn < N) {
      float v[16];
#pragma unroll
      for (int j = 0; j < 16; ++j) v[j] = sT[(kseg + j) * 65 + n];
      bf16_t* d = dst + (size_t)gn * ld_dst + tk * 64 + kseg;
      *(u32x4*)d = pack8(v);
      *(u32x4*)(d + 8) = pack8(v + 8);
    }
  }
}

constexpr int TJ0 = 16 * 49, TJ1 = 16 * 16, TJ2 = 16 * 44, TJ3 = 16 * 16, TJ4 = 2 * 16 * 32, TJ5 = 2 * 8, TJ6 = 2 * 8,
              TJ7 = 2 * 8, TJ8 = 32;
constexpr int NTRANS = TJ0 + TJ1 + TJ2 + TJ3 + TJ4 + TJ5 + TJ6 + TJ7 + TJ8;
constexpr int NKEYCV = (2 * 8 * 2 * 128 * 128) / (256 * 8);
constexpr int NMODV = 2 * 96;
constexpr int NPREP = NTRANS + NKEYCV + NMODV;

DEV void st_prep(const Params& P, int item, unsigned char* smem) {
  unsigned char* ws = P.ws;
  if (item < NTRANS) {
    int t = item;
    if (t < TJ0) { transpose_tile(P.in[I_EVWIN], EVC, (bf16_t*)(ws + OFF_WEVIN), 1024, 1024, EVC, t / 49, t % 49, smem); return; }
    t -= TJ0;
    if (t < TJ1) { transpose_tile(P.in[I_EVWOUT], 1024, (bf16_t*)(ws + OFF_WEVOUT), 1024, 1024, 1024, t / 16, t % 16, smem); return; }
    t -= TJ1;
    if (t < TJ2) { transpose_tile(P.in[I_ODWIN], ODC, (bf16_t*)(ws + OFF_WODIN), 1024, 1024, ODC, t / 44, t % 44, smem); return; }
    t -= TJ2;
    if (t < TJ3) { transpose_tile(P.in[I_ODWOUT], 1024, (bf16_t*)(ws + OFF_WODOUT), 1024, 1024, 1024, t / 16, t % 16, smem); return; }
    t -= TJ3;
    if (t < TJ4) {
      int l = t / 512, tt = t % 512;
      transpose_tile(P.in[I_WQ] + (size_t)l * 1024 * 2048, 2048, (bf16_t*)(ws + OFF_WQ) + (size_t)l * 2048 * 1024, 1024, 1024, 2048, tt / 32, tt % 32, smem);
      return;
    }
    t -= TJ4;
    if (t < TJ5) { int d = t / 8; transpose_tile(P.in[I_WUP] + d * 64 * 512, 512, (bf16_t*)(ws + OFF_WUP) + d * 512 * 64, 64, 64, 512, 0, t % 8, smem); return; }
    t -= TJ5;
    if (t < TJ6) { int d = t / 8; transpose_tile(P.in[I_AUP] + d * 64 * 512, 512, (bf16_t*)(ws + OFF_AUP) + d * 512 * 64, 64, 64, 512, 0, t % 8, smem); return; }
    t -= TJ6;
    if (t < TJ7) { transpose_tile(P.in[I_GUP], 512, (bf16_t*)(ws + OFF_GUP), 128, 128, 512, t / 8, t % 8, smem); return; }
    t -= TJ7;
    {
      int which = t & 1, db = t >> 1;
      const float* src = (which ? P.in[I_WI] : P.in[I_WA]) + (size_t)db * 64 * 64;
      transpose_tile(src, 64, (bf16_t*)(ws + OFF_LRUT) + (size_t)db * 128 * 64 + which * 64 * 64, 64, 64, 64, 0, 0, smem);
      return;
    }
  }
  item -= NTRANS;
  if (item < NKEYCV) {
    size_t e = ((size_t)item * 256 + threadIdx.x) * 8;
    const float* s = P.in[I_KEYS] + e;
    f32x4 a = *(const f32x4*)s, b = *(const f32x4*)(s + 4);
    float v[8] = {a.x, a.y, a.z, a.w, b.x, b.y, b.z, b.w};
    *(u32x4*)((bf16_t*)(ws + OFF_KEYS) + e) = pack8(v);
    return;
  }
  item -= NKEYCV;
  {
    const int l = item / 96, cgp = item % 96;
    float* sS = (float*)smem;
    float* sRed = sS + 3 * 1024;
    const int tid = threadIdx.x;
    __syncthreads();
    for (int i = tid; i < 3 * 1024; i += 256) {
      int m = i >> 10, k = i & 1023;
      float c = m < 2 ? P.in[I_C][m * 1024 + k] : P.in[I_CCTX][k];
      sS[i] = siluf_(c);
    }
    __syncthreads();
    const int ks = tid >> 6, col = cgp * 64 + (tid & 63);
    const float* w = P.in[I_MODW] + (size_t)l * 1024 * 6144 + col;
    float a0 = 0.f, a1 = 0.f, a2 = 0.f;
    for (int k = ks * 256; k < ks * 256 + 256; ++k) {
      float wv = w[(size_t)k * 6144];
      a0 += sS[k] * wv; a1 += sS[1024 + k] * wv; a2 += sS[2048 + k] * wv;
    }
    sRed[(ks * 3 + 0) * 64 + (tid & 63)] = a0;
    sRed[(ks * 3 + 1) * 64 + (tid & 63)] = a1;
    sRed[(ks * 3 + 2) * 64 + (tid & 63)] = a2;
    __syncthreads();
    if (tid < 192) {
      int m = tid >> 6, c = tid & 63;
      float s = sRed[(0 * 3 + m) * 64 + c] + sRed[(1 * 3 + m) * 64 + c] + sRed[(2 * 3 + m) * 64 + c] + sRed[(3 * 3 + m) * 64 + c];
      int cc = cgp * 64 + c;
      ((float*)(ws + OFF_MODV))[((size_t)l * 3 + m) * 6144 + cc] = s + P.in[I_MODB][l * 6144 + cc];
    }
  }
}

constexpr int NPCONV = 2 * (NEXP * 1024 / (256 * 16));
DEV void st_peer_conv(const Params& P, int layer, int item) {
  const int half = NPCONV / 2;
  int which = item >= half;
  int it = which ? item - half : item;
  size_t e = ((size_t)it * 256 + threadIdx.x) * 16;
  const float* s = (which ? P.in[I_PV] : P.in[I_PU]) + (size_t)layer * NEXP * 1024 + e;
  const float sc = which ? PEER_VSCALE : PEER_USCALE;
  float v16[16];
#pragma unroll
  for (int q = 0; q < 4; ++q) {
    f32x4 a = *(const f32x4*)(s + 4 * q);
    v16[4 * q] = a.x * sc; v16[4 * q + 1] = a.y * sc; v16[4 * q + 2] = a.z * sc; v16[4 * q + 3] = a.w * sc;
  }
  const size_t ex = e >> 10, col = e & 1023;
  if (which) {
    u32x2 o; o.x = pack8_fp4(v16); o.y = pack8_fp4(v16 + 8);
    *(u32x2*)(P.ws + OFF_PU + ex * PEER_ROWB + PEER_VOFF + (col >> 1)) = o;
  } else {
    u32x3 o = pack16_fp6(v16);
    unsigned* dp = (unsigned*)(P.ws + OFF_PU + ex * PEER_ROWB + (col >> 4) * 12);
    dp[0] = o.x; dp[1] = o.y; dp[2] = o.z;
  }
}

DEV void st_normmod(const Params& P, int layer, int which, int row) {
  const int lane = threadIdx.x & 63;
  const float* src;
  if (which == 0 && layer == 0) src = row < NCTX ? P.in[I_CTX] + (size_t)row * 1024 : P.in[I_X] + (size_t)(row - NCTX) * 1024;
  else src = row < NCTX ? (const float*)(P.ws + OFF_CTXRES) + (size_t)row * 1024 : P.out + (size_t)(row - NCTX) * 1024;
  const float* mv = (const float*)(P.ws + OFF_MODV) + ((size_t)layer * 3 + mod_row(row)) * 6144;
  const float* sh = mv + (which ? 3 : 0) * 1024;
  const float* sc = mv + (which ? 4 : 1) * 1024;
  const float* nw = (which ? P.in[I_NORM2] : P.in[I_NORM1]) + layer * 1024;
  f32x4 v[4];
  float ss = 0.f;
#pragma unroll
  for (int i = 0; i < 4; ++i) {
    v[i] = *(const f32x4*)(src + i * 256 + lane * 4);
    ss += v[i].x * v[i].x + v[i].y * v[i].y + v[i].z * v[i].z + v[i].w * v[i].w;
  }
  ss = wave_sum(ss);
  const float rstd = frsq(ss * (1.f / 1024.f) + 1e-6f);
  bf16_t* dst = (bf16_t*)(P.ws + OFF_HBUF) + (size_t)row * 1024;
#pragma unroll
  for (int i = 0; i < 4; ++i) {
    int c = i * 256 + lane * 4;
    f32x4 w4 = *(const f32x4*)(nw + c), s4 = *(const f32x4*)(sc + c), h4 = *(const f32x4*)(sh + c);
    float o0 = v[i].x * rstd * w4.x * (1.f + s4.x) + h4.x;
    float o1 = v[i].y * rstd * w4.y * (1.f + s4.y) + h4.y;
    float o2 = v[i].z * rstd * w4.z * (1.f + s4.z) + h4.z;
    float o3 = v[i].w * rstd * w4.w * (1.f + s4.w) + h4.w;
    u32x2 pk; pk.x = pack2(o0, o1); pk.y = pack2(o2, o3);
    *(u32x2*)(dst + c) = pk;
  }
}

struct EpiProjL0 {
  bf16_t* proj; float* gates;
  DEVM void operator()(int row, int col, float v) const {
    proj[(size_t)row * EVC + col] = f2bf(v);
    if (col >= 1536 && col < 1552) gates[row * 32 + (col - 1536)] = v;
    else if (col >= 3088) gates[row * 32 + 16 + (col - 3088)] = v;
  }
};
struct EpiStoreBf {
  bf16_t* dst; int ld;
  DEVM void operator()(int row, int col, float v) const { dst[(size_t)row * ld + col] = f2bf(v); }
};
struct EpiStoreBfBias {
  bf16_t* dst; int ld; const float* bias;
  DEVM void operator()(int row, int col, float v) const { dst[(size_t)row * ld + col] = f2bf(v + (bias ? bias[col] : 0.f)); }
};
struct EpiProjL0T {
  bf16_t* proj; float* gates;
  DEVM void operator()(int, int, float) const {}
  DEVM void store4(int n, int m, float v0, float v1, float v2, float v3) const {
    u32x2 pk; pk.x = pack2(v0, v1); pk.y = pack2(v2, v3);
    *(u32x2*)(proj + (size_t)m * EVC + n) = pk;
    if (n >= 1536 && n < 1552) { f32x4 g = {v0, v1, v2, v3}; *(f32x4*)(gates + m * 32 + (n - 1536)) = g; }
    else if (n >= 3088) { f32x4 g = {v0, v1, v2, v3}; *(f32x4*)(gates + m * 32 + 16 + (n - 3088)) = g; }
  }
};
struct EpiStoreBfT {
  bf16_t* dst; int ld;
  DEVM void operator()(int, int, float) const {}
  DEVM void store4(int n, int m, float v0, float v1, float v2, float v3) const {
    u32x2 pk; pk.x = pack2(v0, v1); pk.y = pack2(v2, v3);
    *(u32x2*)(dst + (size_t)m * ld + n) = pk;
  }
};
struct EpiOutProjT {
  const float* x_lat; const float* x_ctx; float* o_lat; float* o_ctx; const float* modv;
  DEVM void operator()(int, int, float) const {}
  DEVM void store4(int n, int m, float v0, float v1, float v2, float v3) const {
    const f32x4 g = *(const f32x4*)(modv + mod_row(m) * 6144 + 2 * 1024 + n);
    const float* xs; float* od;
    if (m < NCTX) { xs = x_ctx + (size_t)m * 1024 + n; od = o_ctx + (size_t)m * 1024 + n; }
    else { size_t o = (size_t)(m - NCTX) * 1024 + n; xs = x_lat + o; od = o_lat + o; }
    const f32x4 x = *(const f32x4*)xs;
    f32x4 r = {x.x + g.x * v0, x.y + g.y * v1, x.z + g.z * v2, x.w + g.w * v3};
    *(f32x4*)od = r;
  }
};
struct EpiStoreBfBiasT {
  bf16_t* dst; int ld; const float* bias;
  DEVM void operator()(int, int, float) const {}
  DEVM void store4(int n, int m, float v0, float v1, float v2, float v3) const {
    if (bias) { v0 += bias[n]; v1 += bias[n + 1]; v2 += bias[n + 2]; v3 += bias[n + 3]; }
    u32x2 pk; pk.x = pack2(v0, v1); pk.y = pack2(v2, v3);
    *(u32x2*)(dst + (size_t)m * ld + n) = pk;
  }
};
struct EpiOutProj {
  const float* x_lat; const float* x_ctx; float* o_lat; float* o_ctx; const float* modv;
  DEVM void operator()(int row, int col, float v) const {
    float g = modv[mod_row(row) * 6144 + 2 * 1024 + col];
    if (row < NCTX) o_ctx[(size_t)row * 1024 + col] = x_ctx[(size_t)row * 1024 + col] + g * v;
    else { size_t o = (size_t)(row - NCTX) * 1024 + col; o_lat[o] = x_lat[o] + g * v; }
  }
};
struct EpiScoreLds {
  float* sS; int m0;
  DEVM void operator()(int row, int col, float v) const { sS[(row - m0) * 129 + col] = v; }
};

DEV void st_xbc_conv(const Params& P, int row) {
  const int lane = threadIdx.x & 63;
  const bf16_t* proj = (const bf16_t*)(P.ws + OFF_PROJ);
  bf16_t* xc = (bf16_t*)P.out + (size_t)row * 1024;
  int row0, len, pos;
  if (row < NCTX) { row0 = (row / CTXL) * CTXL; len = CTXL; pos = row - row0; }
  else { int r = row - NCTX; row0 = NCTX + (r / SEQ) * SEQ; len = SEQ; pos = r % SEQ; }
  const float* cw = P.in[I_SCONVW];
  const float* cb = P.in[I_SCONVB];
#pragma unroll
  for (int hh = 0; hh < 2; ++hh) {
    const int ch = hh * 512 + lane * 8;
    float o[8];
#pragma unroll
    for (int j = 0; j < 8; ++j) o[j] = cb[ch + j];
#pragma unroll
    for (int tap = 0; tap < 4; ++tap) {
      int pp = pos + tap - 2;
      if (pp >= 0 && pp < len) {
        float x[8];
        unpack8(*(const u32x4*)(proj + (size_t)(row0 + pp) * EVC + 2064 + ch), x);
        f32x4 w0 = *(const f32x4*)(cw + tap * 1024 + ch), w1 = *(const f32x4*)(cw + tap * 1024 + ch + 4);
        o[0] += w0.x * x[0]; o[1] += w0.y * x[1]; o[2] += w0.z * x[2]; o[3] += w0.w * x[3];
        o[4] += w1.x * x[4]; o[5] += w1.y * x[5]; o[6] += w1.z * x[6]; o[7] += w1.w * x[7];
      }
    }
#pragma unroll
    for (int j = 0; j < 8; ++j) o[j] = siluf_(o[j]);
    *(u32x4*)(xc + ch) = pack8(o);
  }
}

#ifndef LA_NSEG
#define LA_NSEG 10
#endif
constexpr int LA_NCH = (CTXL + SEQ) / 64;
constexpr int LA_CPS = LA_NCH / LA_NSEG;
static_assert(LA_NCH % LA_NSEG == 0, "linattn segments");
#ifdef CPU_EMU
constexpr size_t OFF_LASEG = OFF_PR + PR_BYTES;
#else
constexpr size_t OFF_LASEG = OFF_R2L0 + (size_t)NTOK * 1024 * 2;
#endif
constexpr size_t LASEG_U = (size_t)48 * LA_NSEG * 8192 * 4;
constexpr size_t OFF_LASEG_N = OFF_LASEG + LASEG_U;
constexpr size_t OFF_LASEG_D = OFF_LASEG_N + (size_t)48 * LA_NSEG * 64 * 4;
#ifndef CPU_EMU
static_assert(OFF_LASEG_D + 48 * LA_NSEG * 4 <= OFF_PR + PR_BYTES, "laseg");
#endif

struct LaRaw { u32x4 q[2], k[4], x[4]; float g0, g1; };

template <bool MLSTM, bool FULL>
DEV void la_load_raw(const Params& P, int b, int h, int d, int cc, LaRaw& R) {
  constexpr int NC_CTX = CTXL / 64;
  const int tid = threadIdx.x;
  const int seg = cc >= NC_CTX;
  const int row0 = seg ? NCTX + b * SEQ : b * CTXL;
  const int len = seg ? SEQ : CTXL;
  const int cl = (seg ? cc - NC_CTX : cc) * 64;
  const bf16_t* proj = (const bf16_t*)(P.ws + OFF_PROJ);
  const bf16_t* xcv = (const bf16_t*)P.out;
  const float* gates = (const float*)(P.ws + OFF_GATES);
  if (tid < 64) {
    int p = cl + tid, grow = row0 + (d ? len - 1 - p : p);
    if (MLSTM) { R.g0 = gates[grow * 32 + d * 4 + h]; R.g1 = gates[grow * 32 + 8 + d * 4 + h]; }
    else { R.g0 = gates[grow * 32 + 16 + d * 8 + h]; R.g1 = 0.f; }
  }
  if (MLSTM) {
#pragma unroll
    for (int i = 0; i < 2; ++i) {
      int c = tid + i * 256, r = c >> 3, cc8 = (c & 7) * 8;
      int p = cl + r, pos = d ? len - 1 - p : p;
      const bf16_t* rp = proj + (size_t)(row0 + pos) * EVC;
      if (FULL) R.q[i] = *(const u32x4*)(rp + h * 64 + cc8);
      R.k[i] = *(const u32x4*)(rp + 256 + h * 64 + cc8);
    }
#pragma unroll
    for (int i = 0; i < 4; ++i) {
      int c = tid + i * 256, r = c >> 4, cc8 = (c & 15) * 8;
      int p = cl + r, pos = d ? len - 1 - p : p;
      R.x[i] = *(const u32x4*)(proj + (size_t)(row0 + pos) * EVC + 512 + h * 128 + cc8);
    }
  } else {
    const int grp = h >> 2;
#pragma unroll
    for (int i = 0; i < 2; ++i) {
      int c = tid + i * 256, r = c >> 3, cc8 = (c & 7) * 8;
      int p = cl + r, pos = d ? len - 1 - p : p;
      R.x[i] = *(const u32x4*)(xcv + (size_t)(row0 + pos) * 1024 + h * 64 + cc8);
    }
#pragma unroll
    for (int i = 0; i < 4; ++i) {
      int c = tid + i * 256, r = c >> 4, cc8 = (c & 15) * 8;
      int p = cl + r, pos = d ? len - 1 - p : p;
      const bf16_t* rp = xcv + (size_t)(row0 + pos) * 1024;
      R.k[i] = *(const u32x4*)(rp + 512 + grp * 128 + cc8);
      if (FULL) { if (i < 2) R.q[i] = *(const u32x4*)(rp + 768 + grp * 128 + cc8); else R.x[i] = *(const u32x4*)(rp + 768 + grp * 128 + cc8); }
    }
  }
}

template <bool MLSTM, bool FULL>
DEV void st_linattn_seg(const Params& P, int sid, int seg, unsigned char* smem) {
  constexpr int DK = MLSTM ? 64 : 128, DX = MLSTM ? 128 : 64;
  constexpr int QS = DK + 8;
  constexpr int NH = MLSTM ? 4 : 8;
  constexpr int NC_CTX = CTXL / 64;
  const int tid = threadIdx.x, lane = tid & 63, wave = tid >> 6;
  const int d = sid & 1, h = (sid >> 1) % NH, b = (sid >> 1) / NH;
  const int gsid = MLSTM ? sid : 16 + sid;
  bf16_t* sQ = (bf16_t*)smem;
  bf16_t* sK = sQ + 64 * QS;
  bf16_t* sP = sK;
  bf16_t* sKT = sK + 64 * QS;
  bf16_t* sXT = sKT + DK * 72;
  bf16_t* sST = sXT + DX * 72;
  float* sF = (float*)(sST + DX * QS);
  float* sLa = sF;
  float* sG = sF + 64;
  float* sBc = sF + 128;
  float* sDen = sF + 192;
  float* sN = sF + 256;
  int* sRow = (int*)(sF + 384);
  static_assert((64 * QS * 2 + DK * 72 + DX * 72 + DX * QS) * 2 + 448 * 4 <= SMEM_BYTES, "lds");
  bf16_t* outb = MLSTM ? (bf16_t*)(P.ws + OFF_HBUF) : (bf16_t*)(P.ws + OFF_R2L0);
  float* segU = (float*)(P.ws + OFF_LASEG);
  float* segN = (float*)(P.ws + OFF_LASEG_N);
  float* segD = (float*)(P.ws + OFF_LASEG_D);

  f32x16 accS[2];
#pragma unroll
  for (int j = 0; j < 2; ++j)
#pragma unroll
    for (int r = 0; r < 16; ++r) accS[j][r] = 0.f;
  const int sx0 = MLSTM ? wave * 32 : (wave >> 1) * 32;
  const int sk0 = MLSTM ? 0 : (wave & 1) * 64;
  float nreg = 0.f;
  float gb0 = 0.f, gb1 = 0.f, alog_e = 0.f, dskip = 0.f;
  if (MLSTM) { gb0 = P.in[I_IBIAS][d * 4 + h]; gb1 = P.in[I_FBIAS][d * 4 + h]; }
  else { gb0 = P.in[I_DTBIAS][d * 8 + h]; alog_e = fexp(P.in[I_ALOG][d * 8 + h]); dskip = P.in[I_DSKIP][h]; }

  const int cc0 = seg * LA_CPS, cc1 = cc0 + LA_CPS;
  LaRaw R;
  la_load_raw<MLSTM, FULL>(P, b, h, d, cc0, R);
  __syncthreads();
  if (FULL) {
    for (int js = 0; js < seg; ++js) {
      const size_t it = (size_t)gsid * LA_NSEG + js;
      const float a = fexp(segD[it]);
      const float* U = segU + it * 8192;
#pragma unroll
      for (int j = 0; j < 2; ++j)
#pragma unroll
        for (int r = 0; r < 16; ++r) accS[j][r] = a * accS[j][r] + U[(j * 16 + r) * 256 + tid];
      if (MLSTM && tid < 64) nreg = a * nreg + segN[it * 64 + tid];
    }
#pragma unroll
    for (int j = 0; j < 2; ++j)
#pragma unroll
      for (int r = 0; r < 16; ++r) sST[(sx0 + acc_row(r, lane)) * QS + sk0 + j * 32 + (lane & 31)] = f2bf(accS[j][r]);
    if (tid < 128) sN[tid] = (MLSTM && tid < 64) ? nreg : 0.f;
  }
  float lsum = 0.f;

  for (int cc = cc0; cc < cc1; ++cc) {
    int tl_ = threadIdx.x; OPAQUE(tl_);
    const int tid = tl_, lane = tl_ & 63;
    const int sgi = cc >= NC_CTX;
    const int row0 = sgi ? NCTX + b * SEQ : b * CTXL;
    const int len = sgi ? SEQ : CTXL;
    const int cl = (sgi ? cc - NC_CTX : cc) * 64;
    if (tid < 64) {
      int p = cl + tid;
      sRow[tid] = row0 + (d ? len - 1 - p : p);
      if (MLSTM) { sLa[tid] = -softplusf_(-(R.g1 + gb1)); sG[tid] = fexp(R.g0 + gb0); }
      else { float dt = softplusf_(R.g0 + gb0); sLa[tid] = -dt * alog_e; sG[tid] = dt; }
    }
    __syncthreads();
    if (wave == 0) {
      float v = sLa[lane];
#pragma unroll
      for (int off = 1; off < 64; off <<= 1) {
#ifdef CPU_EMU
        float o = emu_shfl_up(v, off);
#else
        float o = __shfl_up(v, off, 64);
#endif
        if (lane >= off) v += o;
      }
      sBc[lane] = v;
    }
    __syncthreads();
    const float blast = sBc[63];
    lsum += blast;
    if (MLSTM) {
#pragma unroll
      for (int i = 0; i < 2; ++i) {
        int c = tid + i * 256, r = c >> 3, cc8 = (c & 7) * 8;
        float kf[8]; unpack8(R.k[i], kf);
        const float wgt = fexp(blast - sBc[r]) * sG[r];
#pragma unroll
        for (int j = 0; j < 8; ++j) sKT[(cc8 + j) * 72 + r] = f2bf(kf[j] * wgt);
        if (FULL) {
          float qf[8]; unpack8(R.q[i], qf);
#pragma unroll
          for (int j = 0; j < 8; ++j) qf[j] *= 0.125f;
          *(u32x4*)(sQ + r * QS + cc8) = pack8(qf);
          *(u32x4*)(sK + r * QS + cc8) = R.k[i];
        }
      }
#pragma unroll
      for (int i = 0; i < 4; ++i) {
        int c = tid + i * 256, r = c >> 4, cc8 = (c & 15) * 8;
        const bf16_t* xs = (const bf16_t*)&R.x[i];
#pragma unroll
        for (int j = 0; j < 8; ++j) sXT[(cc8 + j) * 72 + r] = xs[j];
      }
    } else {
#pragma unroll
      for (int i = 0; i < 2; ++i) {
        int c = tid + i * 256, r = c >> 3, cc8 = (c & 7) * 8;
        const bf16_t* xs = (const bf16_t*)&R.x[i];
#pragma unroll
        for (int j = 0; j < 8; ++j) sXT[(cc8 + j) * 72 + r] = xs[j];
      }
#pragma unroll
      for (int i = 0; i < 4; ++i) {
        int c = tid + i * 256, r = c >> 4, cc8 = (c & 15) * 8;
        float kf[8]; unpack8(R.k[i], kf);
        const float wgt = fexp(blast - sBc[r]) * sG[r];
#pragma unroll
        for (int j = 0; j < 8; ++j) sKT[(cc8 + j) * 72 + r] = f2bf(kf[j] * wgt);
        if (FULL) {
          *(u32x4*)(sK + r * QS + cc8) = R.k[i];
          *(u32x4*)(sQ + r * QS + cc8) = i < 2 ? R.q[i] : R.x[i];
        }
      }
    }
    if (cc + 1 < cc1) la_load_raw<MLSTM, FULL>(P, b, h, d, cc + 1, R);
    __syncthreads();
    if (FULL) {
      const int tr = (wave >> 1) * 32, tc = (wave & 1) * 32;
      f32x16 accP;
#pragma unroll
      for (int r = 0; r < 16; ++r) accP[r] = 0.f;
      if (!(tr == 0 && tc == 32)) {
#pragma unroll
        for (int kk = 0; kk < DK / 16; ++kk) {
          const int ko = kk * 16 + 8 * (lane >> 5);
          bf16x8 a = *(const bf16x8*)(sQ + (tr + (lane & 31)) * QS + ko);
          bf16x8 bb = *(const bf16x8*)(sK + (tc + (lane & 31)) * QS + ko);
          accP = mfma32(a, bb, accP);
        }
      }
      __syncthreads();
      {
        const int s = tc + (lane & 31);
        const float bs = sBc[s], gs = sG[s];
#pragma unroll
        for (int r = 0; r < 16; ++r) {
          int t = tr + acc_row(r, lane);
          float v = (s <= t) ? accP[r] * fexp(sBc[t] - bs) * gs : 0.f;
          sP[t * 72 + s] = f2bf(v);
        }
        {
          const int t = tid >> 2, kq = (tid & 3) * (DK / 4);
          const float et = fexp(sBc[t]);
#pragma unroll
          for (int c8 = 0; c8 < DK / 4; c8 += 8) {
            float qf[8];
            unpack8(*(const u32x4*)(sQ + t * QS + kq + c8), qf);
#pragma unroll
            for (int j = 0; j < 8; ++j) qf[j] *= et;
            *(u32x4*)(sQ + t * QS + kq + c8) = pack8(qf);
          }
        }
      }
      __syncthreads();
      constexpr int NYT = MLSTM ? 2 : 1;
      const int yx0 = MLSTM ? wave * 32 : (wave >> 1) * 32;
      const int yt0 = MLSTM ? 0 : (wave & 1) * 32;
      f32x16 accY[NYT];
#pragma unroll
      for (int j = 0; j < NYT; ++j)
#pragma unroll
        for (int r = 0; r < 16; ++r) accY[j][r] = 0.f;
#pragma unroll
      for (int kk = 0; kk < 4; ++kk) {
        const int ko = kk * 16 + 8 * (lane >> 5);
        bf16x8 a = *(const bf16x8*)(sXT + (yx0 + (lane & 31)) * 72 + ko);
#pragma unroll
        for (int j = 0; j < NYT; ++j) {
          bf16x8 bb = *(const bf16x8*)(sP + (yt0 + j * 32 + (lane & 31)) * 72 + ko);
          accY[j] = mfma32(a, bb, accY[j]);
        }
      }
#pragma unroll
      for (int kk = 0; kk < DK / 16; ++kk) {
        const int ko = kk * 16 + 8 * (lane >> 5);
        bf16x8 a = *(const bf16x8*)(sST + (yx0 + (lane & 31)) * QS + ko);
#pragma unroll
        for (int j = 0; j < NYT; ++j) {
          bf16x8 bb = *(const bf16x8*)(sQ + (yt0 + j * 32 + (lane & 31)) * QS + ko);
          accY[j] = mfma32(a, bb, accY[j]);
        }
      }
      if (MLSTM) {
        if (tid < 64) {
          float den = 0.f, dq = 0.f;
#pragma unroll 8
          for (int s = 0; s < 64; ++s) den += bf2f(sP[tid * 72 + s]);
#pragma unroll 8
          for (int k = 0; k < DK; ++k) dq += sN[k] * bf2f(sQ[tid * QS + k]);
          sDen[tid] = den + dq;
        }
        __syncthreads();
      }
#pragma unroll
      for (int j = 0; j < NYT; ++j) {
        const int t = yt0 + j * 32 + (lane & 31);
        const size_t obase = (size_t)sRow[t] * 1024 + d * 512 + h * DX;
        const float dinv = MLSTM ? frcp(fmaxf(fabsf(sDen[t]), 1.f)) : 1.f;
#pragma unroll
        for (int g = 0; g < 4; ++g) {
          const int x0 = yx0 + 8 * g + 4 * (lane >> 5);
          float v0 = accY[j][4 * g], v1 = accY[j][4 * g + 1], v2 = accY[j][4 * g + 2], v3 = accY[j][4 * g + 3];
          if (MLSTM) { v0 *= dinv; v1 *= dinv; v2 *= dinv; v3 *= dinv; }
          else if (d == 0) {
            v0 += dskip * bf2f(sXT[(x0 + 0) * 72 + t]); v1 += dskip * bf2f(sXT[(x0 + 1) * 72 + t]);
            v2 += dskip * bf2f(sXT[(x0 + 2) * 72 + t]); v3 += dskip * bf2f(sXT[(x0 + 3) * 72 + t]);
          }
          u32x2 pk; pk.x = pack2(v0, v1); pk.y = pack2(v2, v3);
          *(u32x2*)(outb + obase + x0) = pk;
        }
      }
      __syncthreads();
    }
    {
      const float eb = fexp(blast);
#pragma unroll
      for (int j = 0; j < 2; ++j)
#pragma unroll
        for (int r = 0; r < 16; ++r) accS[j][r] *= eb;
#pragma unroll
      for (int kk = 0; kk < 4; ++kk) {
        const int ko = kk * 16 + 8 * (lane >> 5);
        bf16x8 a = *(const bf16x8*)(sXT + (sx0 + (lane & 31)) * 72 + ko);
#pragma unroll
        for (int j = 0; j < 2; ++j) {
          bf16x8 bb = *(const bf16x8*)(sKT + (sk0 + j * 32 + (lane & 31)) * 72 + ko);
          accS[j] = mfma32(a, bb, accS[j]);
        }
      }
      if (FULL) {
#pragma unroll
        for (int j = 0; j < 2; ++j)
#pragma unroll
          for (int r = 0; r < 16; ++r) sST[(sx0 + acc_row(r, lane)) * QS + sk0 + j * 32 + (lane & 31)] = f2bf(accS[j][r]);
      }
      if (MLSTM && tid < 64) {
        float nn = nreg * eb;
        for (int s = 0; s < 64; ++s) nn += bf2f(sKT[tid * 72 + s]);
        nreg = nn;
        if (FULL) sN[tid] = nn;
      }
    }
    __syncthreads();
  }
  if (!FULL) {
    const size_t it = (size_t)gsid * LA_NSEG + seg;
    float* U = segU + it * 8192;
#pragma unroll
    for (int j = 0; j < 2; ++j)
#pragma unroll
      for (int r = 0; r < 16; ++r) U[(j * 16 + r) * 256 + tid] = accS[j][r];
    if (MLSTM && tid < 64) segN[it * 64 + tid] = nreg;
    if (tid == 0) segD[it] = lsum;
  }
}

DEV void st_finish_l0(const Params& P, int row) {
  const int lane = threadIdx.x & 63;
  bf16_t* hb = (bf16_t*)(P.ws + OFF_HBUF) + (size_t)row * 1024;
  const bf16_t* yb = (const bf16_t*)(P.ws + OFF_R2L0) + (size_t)row * 1024;
  const bf16_t* pr = (const bf16_t*)(P.ws + OFF_PROJ) + (size_t)row * EVC;
  const int ch = lane * 8;
  float h0[8], h1[8], o[8], f1[8];
  unpack8(*(const u32x4*)(hb + ch), h0);
  unpack8(*(const u32x4*)(hb + 512 + ch), h1);
  unpack8(*(const u32x4*)(pr + 1024 + ch), o);
  float ss = 0.f;
#pragma unroll
  for (int j = 0; j < 8; ++j) { h0[j] += h1[j]; ss += h0[j] * h0[j]; }
  ss += wshfl_xor(ss, 1); ss += wshfl_xor(ss, 2); ss += wshfl_xor(ss, 4); ss += wshfl_xor(ss, 8);
  float rstd = frsq(ss * (1.f / 128.f) + 1e-6f);
  float pw[8]; ld8(P.in[I_MNORM] + ch, pw);
#pragma unroll
  for (int j = 0; j < 8; ++j) f1[j] = h0[j] * rstd * pw[j] * sigmoidf_(o[j]);
  float y0[8], y1[8], z[8], f2[8];
  unpack8(*(const u32x4*)(yb + ch), y0);
  unpack8(*(const u32x4*)(yb + 512 + ch), y1);
  unpack8(*(const u32x4*)(pr + 1552 + ch), z);
  float s2 = 0.f;
#pragma unroll
  for (int j = 0; j < 8; ++j) { y0[j] = (y0[j] + y1[j]) * siluf_(z[j]); s2 += y0[j] * y0[j]; }
  s2 = wave_sum(s2);
  float rstd2 = frsq(s2 * (1.f / 512.f) + 1e-6f);
  ld8(P.in[I_SNORM] + ch, pw);
#pragma unroll
  for (int j = 0; j < 8; ++j) f2[j] = y0[j] * rstd2 * pw[j];
  *(u32x4*)(hb + ch) = pack8(f1);
  *(u32x4*)(hb + 512 + ch) = pack8(f2);
}

DEV float mixval(const bf16_t* __restrict__ proj, int row, int c, const float* __restrict__ mu) {
  float self = bf2f(proj[(size_t)row * ODC + c]);
  int nrow = -1;
  if (row < NCTX) {
    int pos = row % CTXL;
    if (c < 896) { if (pos > 0) nrow = row - 1; }
    else { if (pos < CTXL - 1) nrow = row + 1; }
  } else {
    int pos = (row - NCTX) % SEQ;
    int gx = pos % GW, gy = pos / GW, q = c / 448;
    if (q == 0) { if (gx > 0) nrow = row - 1; }
    else if (q == 1) { if (gx < GW - 1) nrow = row + 1; }
    else if (q == 2) { if (gy > 0) nrow = row - GW; }
    else { if (gy < SEQ / GW - 1) nrow = row + GW; }
  }
  float nb = nrow >= 0 ? bf2f(proj[(size_t)nrow * ODC + c]) : 0.f;
  return self + mu[c] * (nb - self);
}

DEV int nbr_row(int row, int c) {
  if (row < NCTX) {
    int pos = row % CTXL;
    if (c < 896) return pos > 0 ? row - 1 : -1;
    return pos < CTXL - 1 ? row + 1 : -1;
  }
  int pos = (row - NCTX) % SEQ;
  int gx = pos % GW, gy = pos / GW, q = c / 448;
  if (q == 0) return gx > 0 ? row - 1 : -1;
  if (q == 1) return gx < GW - 1 ? row + 1 : -1;
  if (q == 2) return gy > 0 ? row - GW : -1;
  return gy < SEQ / GW - 1 ? row + GW : -1;
}

DEV void mix8(const bf16_t* __restrict__ proj, int row, int c, const float* __restrict__ mu, float* o) {
  float xs[8], xn[8];
  unpack8(*(const u32x4*)(proj + (size_t)row * ODC + c), xs);
  const int nr = nbr_row(row, c);
  if (nr >= 0) unpack8(*(const u32x4*)(proj + (size_t)nr * ODC + c), xn);
  else {
#pragma unroll
    for (int j = 0; j < 8; ++j) xn[j] = 0.f;
  }
  const f32x4 m0 = *(const f32x4*)(mu + c), m1 = *(const f32x4*)(mu + c + 4);
  const float mm[8] = {m0.x, m0.y, m0.z, m0.w, m1.x, m1.y, m1.z, m1.w};
#pragma unroll
  for (int j = 0; j < 8; ++j) o[j] = xs[j] + mm[j] * (xn[j] - xs[j]);
}

DEV void st_lora_act(const Params& P, int row2) {
  const int lane = threadIdx.x & 63;
  const int row = row2 + (lane >> 5), c = (lane & 31) * 8;
  const bf16_t* proj = (const bf16_t*)(P.ws + OFF_PROJ);
  bf16_t* hb = (bf16_t*)(P.ws + OFF_HBUF) + (size_t)row * 1024;
  float v[8];
  mix8(proj, row, 1536 + c, P.in[I_MU], v);
#pragma unroll
  for (int j = 0; j < 8; ++j) v[j] = c < 64 ? tanhf_(v[j]) : (c < 128 ? v[j] : sigmoidf_(v[j]));
  *(u32x4*)(hb + c) = pack8(v);
}

DEV void st_rwkv_stream(const Params& P, int sid, unsigned char* smem) {
  const int tid = threadIdx.x, lane = tid & 63, wave = tid >> 6;
  const int d = sid & 1, h = (sid >> 1) & 7, b = sid >> 4;
  float* sR = (float*)smem;
  float* sW = sR + 2048;
  float* sKk = sW + 2048;
  float* sV = sKk + 2048;
  float* sA = sV + 2048;
  float* sBb = sA + 2048;
  float* sY = sBb + 2048;
  int* sRow = (int*)(sY + 2048);
  const bf16_t* proj = (const bf16_t*)(P.ws + OFF_PROJ);
  const bf16_t* lora = (const bf16_t*)(P.ws + OFF_LORA);
  bf16_t* yout = (bf16_t*)(P.ws + OFF_HBUF);
  const float* mu = P.in[I_MU];
  const int vrow = tid >> 2, j4 = tid & 3;
  float S[16];
#pragma unroll
  for (int i = 0; i < 16; ++i) S[i] = 0.f;
  const float kkw = P.in[I_KK][h * 64 + lane], kaw = P.in[I_KA][h * 64 + lane];
  for (int seg = 0; seg < 2; ++seg) {
    const int row0 = seg == 0 ? b * CTXL : NCTX + b * SEQ;
    const int len = seg == 0 ? CTXL : SEQ;
    for (int it = 0; it < len / 32; ++it) {
      __syncthreads();
      for (int s = wave; s < 32; s += 4) {
        int p = it * 32 + s, pos = d ? len - 1 - p : p, row = row0 + pos;
        int c = h * 64 + lane;
        float r = mixval(proj, row, c, mu);
        float k = mixval(proj, row, 512 + c, mu);
        float v = mixval(proj, row, 1024 + c, mu);
        float kk = k * kkw;
        float ss = wave_sum(kk * kk);
        kk *= frsq(ss + 1e-12f);
        float lw = bf2f(lora[((size_t)d * NTOK + row) * 512 + c]);
        float la = bf2f(lora[((size_t)(2 + d) * NTOK + row) * 512 + c]);
        float w = fexp(-0.6065306597126334f * sigmoidf_(lw));
        float a = sigmoidf_(la);
        float kt = k * (1.f + (a - 1.f) * kaw);
        sR[s * 64 + lane] = r; sW[s * 64 + lane] = w; sKk[s * 64 + lane] = kt; sV[s * 64 + lane] = v;
        sA[s * 64 + lane] = -kk; sBb[s * 64 + lane] = kk * a;
        if (lane == 0) sRow[s] = row;
      }
      __syncthreads();
      for (int s = 0; s < 32; ++s) {
        const float* pa = sA + s * 64 + j4 * 16;
        const float* pw = sW + s * 64 + j4 * 16;
        const float* pk = sKk + s * 64 + j4 * 16;
        const float* pb = sBb + s * 64 + j4 * 16;
        const float* pr = sR + s * 64 + j4 * 16;
        const float vv = sV[s * 64 + vrow];
        float sa = 0.f;
#pragma unroll
        for (int i = 0; i < 16; ++i) sa += S[i] * pa[i];
        sa += wshfl_xor(sa, 1); sa += wshfl_xor(sa, 2);
        float y = 0.f;
#pragma unroll
        for (int i = 0; i < 16; ++i) { S[i] = S[i] * pw[i] + sa * pb[i] + vv * pk[i]; y += S[i] * pr[i]; }
        y += wshfl_xor(y, 1); y += wshfl_xor(y, 2);
        if (j4 == 0) sY[s * 64 + vrow] = y;
      }
      __syncthreads();
      for (int i = tid; i < 2048; i += 256) {
        int s = i >> 6, c = i & 63;
        yout[(size_t)sRow[s] * 1024 + d * 512 + h * 64 + c] = f2bf(sY[i]);
      }
    }
  }
}


struct RwkvRaw { u32x4 rs, rn, ks, kn, vs, vn, lw, la; int row; };

DEV void rwkv_load_raw(const bf16_t* __restrict__ proj, const bf16_t* __restrict__ lora, int b, int h, int d, int cc, int t, int c0,
                       RwkvRaw& R) {
  constexpr int NC_CTX = CTXL / 32;
  const int seg = cc >= NC_CTX;
  const int row0 = seg ? NCTX + b * SEQ : b * CTXL;
  const int len = seg ? SEQ : CTXL;
  const int p = (seg ? cc - NC_CTX : cc) * 32 + t;
  const int row = row0 + (d ? len - 1 - p : p);
  const int col = h * 64 + c0;
  const u32x4 z4 = {0u, 0u, 0u, 0u};
  const bf16_t* rp = proj + (size_t)row * ODC;
  R.row = row;
  R.rs = *(const u32x4*)(rp + col);
  R.ks = *(const u32x4*)(rp + 512 + col);
  R.vs = *(const u32x4*)(rp + 1024 + col);
  int n0 = nbr_row(row, col), n1 = nbr_row(row, 512 + col), n2 = nbr_row(row, 1024 + col);
  R.rn = n0 >= 0 ? *(const u32x4*)(proj + (size_t)n0 * ODC + col) : z4;
  R.kn = n1 >= 0 ? *(const u32x4*)(proj + (size_t)n1 * ODC + 512 + col) : z4;
  R.vn = n2 >= 0 ? *(const u32x4*)(proj + (size_t)n2 * ODC + 1024 + col) : z4;
  R.lw = *(const u32x4*)(lora + ((size_t)d * NTOK + row) * 512 + col);
  R.la = *(const u32x4*)(lora + ((size_t)(2 + d) * NTOK + row) * 512 + col);
}

#ifndef RW_NSEG
#define RW_NSEG 16
#endif
constexpr int RW_NCH = (CTXL + SEQ) / 32;
constexpr size_t OFF_RWSEG = OFF_PU;
static_assert((size_t)32 * RW_NSEG * 64 * 128 * 4 <= (size_t)2 * NEXP * 1024, "rwseg");

template <bool FULL>
DEV void st_rwkv_seg(const Params& P, int sid, int seg, unsigned char* smem) {
  constexpr int NVB = FULL ? 2 : 4;
  constexpr int ZR = FULL ? 64 : 128;
  const int tid = threadIdx.x, lane = tid & 63, wave = tid >> 6;
  const int d = sid & 1, h = (sid >> 1) & 7, b = sid >> 4;
  bf16_t* sAt = (bf16_t*)smem;
  bf16_t* sRt = sAt + 32 * 72;
  bf16_t* sBt = sRt + 32 * 72;
  bf16_t* sKt = sBt + 32 * 72;
  bf16_t* sBT = sKt + 32 * 72;
  bf16_t* sKT = sBT + 64 * 40;
  bf16_t* sVT = sKT + 64 * 40;
  bf16_t* sLak = sVT + 64 * 40;
  bf16_t* sM = sLak + 32 * 40;
  bf16_t* sLrb = sM + 32 * 40;
  bf16_t* sLrk = sLrb + 32 * 40;
  bf16_t* sZ = FULL ? sLrk + 32 * 40 : sLrb;
  bf16_t* after = sZ + ZR * 72;
  bf16_t* sRT = FULL ? after : nullptr;
  bf16_t* sSAT = FULL ? after + 64 * 40 : sRt;
  float* sLP = (float*)(FULL ? after + 2 * 64 * 40 : after);
  float* sLab = sLP + 32 * 64;
  float* sD = sLab + 32 * 33;
  float* sPT = sD + 768;
  int* sRow = (int*)(sPT + 64);
  if (!FULL) sRT = (bf16_t*)sLP;
  static_assert((4 * 32 * 72 + 3 * 64 * 40 + 4 * 32 * 40 + 2 * 64 * 40 + 64 * 72) * 2 + (32 * 64 + 32 * 33 + 768 + 64 + 32 + 320) * 4 + 16 <= SMEM_BYTES, "lds full");
  static_assert((4 * 32 * 72 + 3 * 64 * 40 + 2 * 32 * 40 + 128 * 72) * 2 + (32 * 64 + 32 * 33 + 768 + 64 + 32) * 4 <= SMEM_BYTES, "lds p1");
  static_assert(128 * 40 * 2 <= (32 * 64 + 32 * 33) * 4 && 128 * 40 <= 3 * 32 * 72, "alias");
  const bf16_t* proj = (const bf16_t*)(P.ws + OFF_PROJ);
  const bf16_t* lora = (const bf16_t*)(P.ws + OFF_LORA);
  bf16_t* yout = (bf16_t*)(P.ws + OFF_HBUF);
  float* segZ = (float*)(P.ws + OFF_RWSEG);
  const int t = tid >> 3, c0 = (tid & 7) * 8;
  const int hl = lane >> 5, l31 = lane & 31;
  float* sCst = (float*)(smem + SMEM_BYTES - 320 * 4 - 16);
  if (tid < 64) {
    sCst[tid] = P.in[I_MU][h * 64 + tid]; sCst[64 + tid] = P.in[I_MU][512 + h * 64 + tid]; sCst[128 + tid] = P.in[I_MU][1024 + h * 64 + tid];
    sCst[192 + tid] = P.in[I_KK][h * 64 + tid]; sCst[256 + tid] = P.in[I_KA][h * 64 + tid];
  }
  const int cc0 = (seg * RW_NCH) / RW_NSEG, cc1 = ((seg + 1) * RW_NCH) / RW_NSEG;
  RwkvRaw R;
  rwkv_load_raw(proj, lora, b, h, d, cc0, t, c0, R);
  f32x16 Zm[2];
#pragma unroll
  for (int j = 0; j < 2; ++j)
#pragma unroll
    for (int r = 0; r < 16; ++r) Zm[j][r] = 0.f;
  __syncthreads();
  for (int i = tid; i < ZR * 72; i += 256) sZ[i] = 0;
  __syncthreads();
  if (!FULL) {
    if (wave >= 2) {
#pragma unroll
      for (int cb = 0; cb < 2; ++cb)
#pragma unroll
        for (int r = 0; r < 16; ++r) {
          int c = cb * 32 + acc_row(r, lane), vp = wave * 32 + l31;
          if (c == vp - 64) { Zm[cb][r] = 1.f; sZ[vp * 72 + c] = 0x3f80; }
        }
    }
  } else {
    for (int js = 0; js < seg; ++js) {
      const float* Zs = segZ + ((size_t)sid * RW_NSEG + js) * 64 * 128;
      bf16_t* sG = sAt;
      for (int i = tid; i < 64 * 64; i += 256) { int c = i >> 6, c2 = i & 63; sG[c * 72 + c2] = f2bf(Zs[c * 128 + 64 + c2]); }
      __syncthreads();
      if (wave >= 2) {
        const int cb = wave - 2;
#pragma unroll
        for (int vb = 0; vb < 2; ++vb) {
          f32x16 acc;
#pragma unroll
          for (int r = 0; r < 16; ++r) acc[r] = Zs[(cb * 32 + acc_row(r, lane)) * 128 + vb * 32 + l31];
#pragma unroll
          for (int kk = 0; kk < 4; ++kk) {
            bf16x8 a = *(const bf16x8*)(sG + (cb * 32 + l31) * 72 + kk * 16 + 8 * hl);
            bf16x8 bb = *(const bf16x8*)(sZ + (vb * 32 + l31) * 72 + kk * 16 + 8 * hl);
            acc = mfma32(a, bb, acc);
          }
          Zm[vb] = acc;
        }
      }
      __syncthreads();
      if (wave >= 2) {
        const int cb = wave - 2;
#pragma unroll
        for (int vb = 0; vb < 2; ++vb)
#pragma unroll
          for (int g = 0; g < 4; ++g) {
            u32x2 pk; pk.x = pack2(Zm[vb][4 * g], Zm[vb][4 * g + 1]); pk.y = pack2(Zm[vb][4 * g + 2], Zm[vb][4 * g + 3]);
            *(u32x2*)(sZ + (vb * 32 + l31) * 72 + cb * 32 + 8 * g + 4 * hl) = pk;
          }
      }
      __syncthreads();
    }
  }
  for (int cc = cc0; cc < cc1; ++cc) {
    int tl_ = threadIdx.x; OPAQUE(tl_);
    const int tid = tl_, lane = tl_ & 63, hl = lane >> 5, l31 = lane & 31, t = tl_ >> 3, c0 = (tl_ & 7) * 8;
    const float* muR = sCst + c0; const float* muK = sCst + 64 + c0; const float* muV = sCst + 128 + c0;
    const float* kkw = sCst + 192 + c0; const float* kaw = sCst + 256 + c0;
    float lw8[8], lp8[8];
    {
      float lwf[8];
      unpack8(R.lw, lwf);
#pragma unroll
      for (int j = 0; j < 8; ++j) { lw8[j] = -0.6065306597126334f * sigmoidf_(lwf[j]); lp8[j] = lw8[j]; }
#pragma unroll
      for (int off = 8; off < 64; off <<= 1) {
#pragma unroll
        for (int j = 0; j < 8; ++j) {
#ifdef CPU_EMU
          float o = emu_shfl_up(lp8[j], off);
#else
          float o = __shfl_up(lp8[j], off, 64);
#endif
          if (lane >= off) lp8[j] += o;
        }
      }
      if (lane >= 56) {
#pragma unroll
        for (int j = 0; j < 8; ++j) sLP[wave * 64 + c0 + j] = lp8[j];
      }
      if ((tid & 7) == 0) sRow[t] = R.row;
    }
    __syncthreads();
    {
#pragma unroll
      for (int j = 0; j < 8; ++j) {
        float offs = 0.f;
        for (int w2 = 0; w2 < wave; ++w2) offs += sLP[w2 * 64 + c0 + j];
        lp8[j] += offs;
      }
      if (t == 31) {
#pragma unroll
        for (int j = 0; j < 8; ++j) sPT[c0 + j] = fexp(lp8[j]);
      }
    }
    {
      float xs[8], xn[8], kt[8], aa[8], ob[8], ok[8];
      unpack8(R.ks, xs); unpack8(R.kn, xn);
      float ss = 0.f;
#pragma unroll
      for (int j = 0; j < 8; ++j) { kt[j] = xs[j] + muK[j] * (xn[j] - xs[j]); aa[j] = kt[j] * kkw[j]; ss += aa[j] * aa[j]; }
      ss += wshfl_xor(ss, 1); ss += wshfl_xor(ss, 2); ss += wshfl_xor(ss, 4);
      const float rn = frsq(ss + 1e-12f);
      float laf[8];
      unpack8(R.la, laf);
#pragma unroll
      for (int j = 0; j < 8; ++j) {
        const float lp = lp8[j];
        const float lpm = lp8[j] - lw8[j];
        const float e = fexp(-lp);
        const float kkn = aa[j] * rn;
        const float asg = sigmoidf_(laf[j]);
        aa[j] = -kkn * fexp(lpm);
        ob[j] = kkn * asg * e;
        ok[j] = kt[j] * (1.f + (asg - 1.f) * kaw[j]) * e;
      }
      *(u32x4*)(sAt + t * 72 + c0) = pack8(aa);
      *(u32x4*)(sBt + t * 72 + c0) = pack8(ob);
      *(u32x4*)(sKt + t * 72 + c0) = pack8(ok);
#pragma unroll
      for (int j = 0; j < 8; ++j) { sBT[(c0 + j) * 40 + t] = f2bf(ob[j]); sKT[(c0 + j) * 40 + t] = f2bf(ok[j]); }
      unpack8(R.vs, xs); unpack8(R.vn, xn);
#pragma unroll
      for (int j = 0; j < 8; ++j) sVT[(c0 + j) * 40 + t] = f2bf(xs[j] + muV[j] * (xn[j] - xs[j]));
      if (FULL) {
        unpack8(R.rs, xs); unpack8(R.rn, xn);
#pragma unroll
        for (int j = 0; j < 8; ++j) xs[j] = (xs[j] + muR[j] * (xn[j] - xs[j])) * fexp(lp8[j]);
        *(u32x4*)(sRt + t * 72 + c0) = pack8(xs);
      }
    }
    if (cc + 1 < cc1) rwkv_load_raw(proj, lora, b, h, d, cc + 1, t, c0, R);
    __syncthreads();
    if (FULL || wave < 2) {
      const bf16_t* Asrc = wave < 2 ? sAt : sRt;
      const bf16_t* Bsrc = (wave & 1) ? sKt : sBt;
      f32x16 acc;
#pragma unroll
      for (int r = 0; r < 16; ++r) acc[r] = 0.f;
#pragma unroll
      for (int kk = 0; kk < 4; ++kk) {
        bf16x8 a = *(const bf16x8*)(Asrc + l31 * 72 + kk * 16 + 8 * hl);
        bf16x8 bb = *(const bf16x8*)(Bsrc + l31 * 72 + kk * 16 + 8 * hl);
        acc = mfma32(a, bb, acc);
      }
      bf16_t* dst = wave == 1 ? sLak : (wave == 2 ? sLrb : sLrk);
#pragma unroll
      for (int r = 0; r < 16; ++r) {
        int tt = acc_row(r, lane), j = l31;
        bool keep = wave < 2 ? (j < tt) : (j <= tt);
        float v = keep ? acc[r] : 0.f;
        if (wave == 0) sLab[tt * 33 + j] = v;
        else dst[tt * 40 + j] = f2bf(v);
      }
    }
    __syncthreads();
    if (tid < 32) {
      const int q = tid >> 4, c = tid & 15;
      float x[16];
#pragma unroll
      for (int i = 0; i < 16; ++i) {
        float sacc = (i == c) ? 1.f : 0.f;
#pragma unroll
        for (int j = 0; j < i; ++j) sacc += sLab[(q * 16 + i) * 33 + q * 16 + j] * x[j];
        x[i] = sacc;
        sD[q * 256 + i * 16 + c] = sacc;
      }
    }
    __syncthreads();
    {
      const int i = tid >> 4, c = tid & 15;
      float sacc = 0.f;
#pragma unroll
      for (int j = 0; j < 16; ++j) sacc += sLab[(16 + i) * 33 + j] * sD[j * 16 + c];
      sD[512 + i * 16 + c] = sacc;
    }
    __syncthreads();
    {
      const int i = tid >> 4, c = tid & 15;
      float sacc = 0.f;
#pragma unroll
      for (int j = 0; j < 16; ++j) sacc += sD[256 + i * 16 + j] * sD[512 + j * 16 + c];
      sM[(16 + i) * 40 + c] = f2bf(sacc);
      sM[i * 40 + c] = f2bf(sD[i * 16 + c]);
      sM[(16 + i) * 40 + 16 + c] = f2bf(sD[256 + i * 16 + c]);
      sM[i * 40 + 16 + c] = 0;
    }
    if (wave < NVB) {
      const int vb = wave;
      f32x16 acc;
#pragma unroll
      for (int r = 0; r < 16; ++r) acc[r] = 0.f;
#pragma unroll
      for (int kk = 0; kk < 4; ++kk) {
        bf16x8 a = *(const bf16x8*)(sAt + l31 * 72 + kk * 16 + 8 * hl);
        bf16x8 bb = *(const bf16x8*)(sZ + (vb * 32 + l31) * 72 + kk * 16 + 8 * hl);
        acc = mfma32(a, bb, acc);
      }
      if (vb < 2) {
#pragma unroll
        for (int kk = 0; kk < 2; ++kk) {
          bf16x8 a = *(const bf16x8*)(sLak + l31 * 40 + kk * 16 + 8 * hl);
          bf16x8 bb = *(const bf16x8*)(sVT + (vb * 32 + l31) * 40 + kk * 16 + 8 * hl);
          acc = mfma32(a, bb, acc);
        }
      }
#pragma unroll
      for (int g = 0; g < 4; ++g) {
        u32x2 pk; pk.x = pack2(acc[4 * g], acc[4 * g + 1]); pk.y = pack2(acc[4 * g + 2], acc[4 * g + 3]);
        *(u32x2*)(sRT + (vb * 32 + l31) * 40 + 8 * g + 4 * hl) = pk;
      }
    }
    __syncthreads();
    if (wave < NVB) {
      const int vb = wave;
      f32x16 acc;
#pragma unroll
      for (int r = 0; r < 16; ++r) acc[r] = 0.f;
#pragma unroll
      for (int kk = 0; kk < 2; ++kk) {
        bf16x8 a = *(const bf16x8*)(sM + l31 * 40 + kk * 16 + 8 * hl);
        bf16x8 bb = *(const bf16x8*)(sRT + (vb * 32 + l31) * 40 + kk * 16 + 8 * hl);
        acc = mfma32(a, bb, acc);
      }
#pragma unroll
      for (int g = 0; g < 4; ++g) {
        u32x2 pk; pk.x = pack2(acc[4 * g], acc[4 * g + 1]); pk.y = pack2(acc[4 * g + 2], acc[4 * g + 3]);
        *(u32x2*)(sSAT + (vb * 32 + l31) * 40 + 8 * g + 4 * hl) = pk;
      }
    }
    __syncthreads();
    if (FULL) {
      if (wave < 2) {
        const int vb = wave;
        f32x16 acc;
#pragma unroll
        for (int r = 0; r < 16; ++r) acc[r] = 0.f;
#pragma unroll
        for (int kk = 0; kk < 4; ++kk) {
          bf16x8 a = *(const bf16x8*)(sZ + (vb * 32 + l31) * 72 + kk * 16 + 8 * hl);
          bf16x8 bb = *(const bf16x8*)(sRt + l31 * 72 + kk * 16 + 8 * hl);
          acc = mfma32(a, bb, acc);
        }
#pragma unroll
        for (int kk = 0; kk < 2; ++kk) {
          bf16x8 a = *(const bf16x8*)(sSAT + (vb * 32 + l31) * 40 + kk * 16 + 8 * hl);
          bf16x8 bb = *(const bf16x8*)(sLrb + l31 * 40 + kk * 16 + 8 * hl);
          acc = mfma32(a, bb, acc);
        }
#pragma unroll
        for (int kk = 0; kk < 2; ++kk) {
          bf16x8 a = *(const bf16x8*)(sVT + (vb * 32 + l31) * 40 + kk * 16 + 8 * hl);
          bf16x8 bb = *(const bf16x8*)(sLrk + l31 * 40 + kk * 16 + 8 * hl);
          acc = mfma32(a, bb, acc);
        }
        {
          const size_t obase = (size_t)sRow[l31] * 1024 + d * 512 + h * 64 + vb * 32;
#pragma unroll
          for (int g = 0; g < 4; ++g) {
            u32x2 pk; pk.x = pack2(acc[4 * g], acc[4 * g + 1]); pk.y = pack2(acc[4 * g + 2], acc[4 * g + 3]);
            *(u32x2*)(yout + obase + 8 * g + 4 * hl) = pk;
          }
        }
      } else {
        const int cb = wave - 2;
#pragma unroll
        for (int vb = 0; vb < 2; ++vb) {
          f32x16 acc;
#pragma unroll
          for (int r = 0; r < 16; ++r) acc[r] = 0.f;
#pragma unroll
          for (int kk = 0; kk < 2; ++kk) {
            bf16x8 a = *(const bf16x8*)(sBT + (cb * 32 + l31) * 40 + kk * 16 + 8 * hl);
            bf16x8 bb = *(const bf16x8*)(sSAT + (vb * 32 + l31) * 40 + kk * 16 + 8 * hl);
            acc = mfma32(a, bb, acc);
          }
#pragma unroll
          for (int kk = 0; kk < 2; ++kk) {
            bf16x8 a = *(const bf16x8*)(sKT + (cb * 32 + l31) * 40 + kk * 16 + 8 * hl);
            bf16x8 bb = *(const bf16x8*)(sVT + (vb * 32 + l31) * 40 + kk * 16 + 8 * hl);
            acc = mfma32(a, bb, acc);
          }
#pragma unroll
          for (int r = 0; r < 16; ++r) Zm[vb][r] = sPT[cb * 32 + acc_row(r, lane)] * (Zm[vb][r] + acc[r]);
        }
      }
      __syncthreads();
      if (wave >= 2) {
        const int cb = wave - 2;
#pragma unroll
        for (int vb = 0; vb < 2; ++vb)
#pragma unroll
          for (int g = 0; g < 4; ++g) {
            u32x2 pk; pk.x = pack2(Zm[vb][4 * g], Zm[vb][4 * g + 1]); pk.y = pack2(Zm[vb][4 * g + 2], Zm[vb][4 * g + 3]);
            *(u32x2*)(sZ + (vb * 32 + l31) * 72 + cb * 32 + 8 * g + 4 * hl) = pk;
          }
      }
    } else {
      const int vb = wave;
#pragma unroll
      for (int cb = 0; cb < 2; ++cb) {
        f32x16 acc;
#pragma unroll
        for (int r = 0; r < 16; ++r) acc[r] = 0.f;
#pragma unroll
        for (int kk = 0; kk < 2; ++kk) {
          bf16x8 a = *(const bf16x8*)(sBT + (cb * 32 + l31) * 40 + kk * 16 + 8 * hl);
          bf16x8 bb = *(const bf16x8*)(sSAT + (vb * 32 + l31) * 40 + kk * 16 + 8 * hl);
          acc = mfma32(a, bb, acc);
        }
        if (vb < 2) {
#pragma unroll
          for (int kk = 0; kk < 2; ++kk) {
            bf16x8 a = *(const bf16x8*)(sKT + (cb * 32 + l31) * 40 + kk * 16 + 8 * hl);
            bf16x8 bb = *(const bf16x8*)(sVT + (vb * 32 + l31) * 40 + kk * 16 + 8 * hl);
            acc = mfma32(a, bb, acc);
          }
        }
#pragma unroll
        for (int r = 0; r < 16; ++r) Zm[cb][r] = sPT[cb * 32 + acc_row(r, lane)] * (Zm[cb][r] + acc[r]);
      }
#pragma unroll
      for (int cb = 0; cb < 2; ++cb)
#pragma unroll
        for (int g = 0; g < 4; ++g) {
          u32x2 pk; pk.x = pack2(Zm[cb][4 * g], Zm[cb][4 * g + 1]); pk.y = pack2(Zm[cb][4 * g + 2], Zm[cb][4 * g + 3]);
          *(u32x2*)(sZ + (vb * 32 + l31) * 72 + cb * 32 + 8 * g + 4 * hl) = pk;
        }
    }
  }
  if (!FULL) {
    float* Zs = segZ + ((size_t)sid * RW_NSEG + seg) * 64 * 128;
#pragma unroll
    for (int cb = 0; cb < 2; ++cb)
#pragma unroll
      for (int r = 0; r < 16; ++r) Zs[(cb * 32 + acc_row(r, lane)) * 128 + wave * 32 + l31] = Zm[cb][r];
  }
}

constexpr int LRU_NCH = (CTXL + SEQ) / 64;
constexpr size_t OFF_ACUM0 = OFF_PU;
static_assert((size_t)NLAT * 512 * 2 <= (size_t)2 * NEXP * 1024, "acum0");

DEV void st_lru_chunk(const Params& P, int sid, int cc, unsigned char* smem) {
  constexpr int NC_CTX = CTXL / 64;
  const int tid = threadIdx.x, lane = tid & 63, wave = tid >> 6;
  const int d = sid & 1, blk = (sid >> 1) & 7, b = sid >> 4;
  float* sXc = (float*)smem;
  float* sAc = sXc + 4096;
  float* sBc = sAc + 4096;
  float* sU = sBc + 4096;
  bf16_t* sAop = (bf16_t*)(sU + 4096);
  float* sQA = (float*)(sAop + 64 * 72);
  float* sQH = sQA + 256;
  int* sRow = (int*)(sQH + 256);
  const bf16_t* proj = (const bf16_t*)(P.ws + OFF_PROJ);
  bf16_t* uout = (bf16_t*)(P.ws + OFF_LORA) + (size_t)d * NTOK * 512;
  bf16_t* aout = (bf16_t*)(P.ws + (d ? OFF_ACUM1 : OFF_ACUM0));
  const bf16_t* lruT = (const bf16_t*)(P.ws + OFF_LRUT) + (size_t)(d * 8 + blk) * 128 * 64;
  float* chunkS = (float*)(P.ws + OFF_LRUCS) + ((size_t)sid * LRU_NCH + cc) * 128;
  const float* cw = P.in[I_LCONVW];
  const float* cb = P.in[I_LCONVB];
  const int tr = (wave >> 1) * 32, nc0 = (wave & 1) * 64;
  const int sgi = cc >= NC_CTX;
  const int row0 = sgi ? NCTX + b * SEQ : b * CTXL;
  const int len = sgi ? SEQ : CTXL;
  const int cl = (sgi ? cc - NC_CTX : cc) * 64;
  __syncthreads();
  if (tid < 64) { int p = cl + tid; sRow[tid] = row0 + (d ? len - 1 - p : p); }
  {
    const int lc8 = (tid & 7) * 8, lch = blk * 64 + lc8;
#pragma unroll
    for (int i = 0; i < 2; ++i) {
      int c = tid + i * 256, r = c >> 3;
      int p = cl + r, pos = d ? len - 1 - p : p;
      float o[8];
      f32x4 c0 = *(const f32x4*)(cb + lch), c1 = *(const f32x4*)(cb + lch + 4);
      o[0] = c0.x; o[1] = c0.y; o[2] = c0.z; o[3] = c0.w; o[4] = c1.x; o[5] = c1.y; o[6] = c1.z; o[7] = c1.w;
#pragma unroll
      for (int tap = 0; tap < 4; ++tap) {
        int pp = pos + tap - 2;
        if (pp >= 0 && pp < len) {
          float x[8];
          unpack8(*(const u32x4*)(proj + (size_t)(row0 + pp) * ODC + 2304 + lch), x);
          f32x4 w0 = *(const f32x4*)(cw + tap * 512 + lch), w1 = *(const f32x4*)(cw + tap * 512 + lch + 4);
          o[0] += w0.x * x[0]; o[1] += w0.y * x[1]; o[2] += w0.z * x[2]; o[3] += w0.w * x[3];
          o[4] += w1.x * x[4]; o[5] += w1.y * x[5]; o[6] += w1.z * x[6]; o[7] += w1.w * x[7];
        }
      }
#pragma unroll
      for (int j = 0; j < 8; ++j) sXc[r * 64 + lc8 + j] = o[j];
      *(u32x4*)(sAop + r * 72 + lc8) = pack8(o);
    }
  }
  __syncthreads();
  {
    f32x16 acc[2];
#pragma unroll
    for (int j = 0; j < 2; ++j)
#pragma unroll
      for (int r = 0; r < 16; ++r) acc[j][r] = 0.f;
#pragma unroll
    for (int kk = 0; kk < 4; ++kk) {
      bf16x8 a = *(const bf16x8*)(sAop + (tr + (lane & 31)) * 72 + kk * 16 + 8 * (lane >> 5));
#pragma unroll
      for (int j = 0; j < 2; ++j) {
        bf16x8 bb = *(const bf16x8*)(lruT + (nc0 + j * 32 + (lane & 31)) * 64 + kk * 16 + 8 * (lane >> 5));
        acc[j] = mfma32(a, bb, acc[j]);
      }
    }
#pragma unroll
    for (int j = 0; j < 2; ++j) {
      const int e = nc0 + j * 32 + (lane & 31);
      const int ch = blk * 64 + (e & 63);
      const float ebias = e < 64 ? P.in[I_BA][d * 512 + ch] : P.in[I_BI][d * 512 + ch];
      const float esp = softplusf_(-P.in[I_LAM][d * 512 + ch]);
#pragma unroll
      for (int r = 0; r < 16; ++r) {
        int t = tr + acc_row(r, lane);
        float g = sigmoidf_(acc[j][r] + ebias);
        if (e < 64) { float a_ = fexp(-8.f * g * esp); sAc[t * 64 + e] = a_; sU[t * 64 + e] = fsqrt(fmaxf(1.f - a_ * a_, 0.f)); }
        else sBc[t * 64 + (e - 64)] = g * sXc[t * 64 + (e - 64)];
      }
    }
  }
  __syncthreads();
  const int c = tid & 63, q = tid >> 6;
  {
    float h = 0.f, ap = 1.f;
#pragma unroll 4
    for (int i = 0; i < 16; ++i) {
      const int t = q * 16 + i;
      const float a = sAc[t * 64 + c];
      h = a * h + sU[t * 64 + c] * sBc[t * 64 + c];
      ap *= a;
      sU[t * 64 + c] = h; sAc[t * 64 + c] = ap;
    }
    sQA[q * 64 + c] = ap; sQH[q * 64 + c] = h;
  }
  __syncthreads();
  {
    float hin = 0.f, ain = 1.f;
    for (int q2 = 0; q2 < q; ++q2) { hin = sQA[q2 * 64 + c] * hin + sQH[q2 * 64 + c]; ain *= sQA[q2 * 64 + c]; }
    if (q > 0) {
#pragma unroll 4
      for (int i = 0; i < 16; ++i) {
        const int t = q * 16 + i;
        const float ap = sAc[t * 64 + c];
        sU[t * 64 + c] += ap * hin;
        sAc[t * 64 + c] = ap * ain;
      }
    }
    if (q == 3) { chunkS[c] = sAc[63 * 64 + c]; chunkS[64 + c] = sU[63 * 64 + c]; }
  }
  __syncthreads();
  if (sgi) {
#pragma unroll
    for (int i = 0; i < 2; ++i) {
      int cidx = tid + i * 256, r = cidx >> 3, c8 = (cidx & 7) * 8;
      float u8[8], a8[8];
#pragma unroll
      for (int j = 0; j < 8; ++j) { u8[j] = sU[r * 64 + c8 + j]; a8[j] = sAc[r * 64 + c8 + j]; }
      const int row = sRow[r];
      *(u32x4*)(uout + (size_t)row * 512 + blk * 64 + c8) = pack8(u8);
      *(u32x4*)(aout + (size_t)(row - NCTX) * 512 + blk * 64 + c8) = pack8(a8);
    }
  }
}

DEV void st_lru_carry(const Params& P, int sid) {
  const int c = threadIdx.x;
  if (c >= 64) return;
  const float* cs = (const float*)(P.ws + OFF_LRUCS) + (size_t)sid * LRU_NCH * 128;
  float* hs = (float*)(P.ws + OFF_LRUHS) + (size_t)sid * LRU_NCH * 64;
  float h = 0.f;
  for (int cc0 = 0; cc0 < LRU_NCH; cc0 += 10) {
    float a[10], bb[10];
#pragma unroll
    for (int i = 0; i < 10; ++i) { a[i] = cs[(size_t)(cc0 + i) * 128 + c]; bb[i] = cs[(size_t)(cc0 + i) * 128 + 64 + c]; }
#pragma unroll
    for (int i = 0; i < 10; ++i) { hs[(size_t)(cc0 + i) * 64 + c] = h; h = a[i] * h + bb[i]; }
  }
}

DEV void st_finish_l1(const Params& P, int row) {
  const int lane = threadIdx.x & 63;
  bf16_t* hb = (bf16_t*)(P.ws + OFF_HBUF) + (size_t)row * 1024;
  const bf16_t* proj = (const bf16_t*)(P.ws + OFF_PROJ);
  const bf16_t* lora = (const bf16_t*)(P.ws + OFF_LORA);
  const float* mu = P.in[I_MU];
  const int ch = lane * 8;
  float y0[8], y1[8];
  unpack8(*(const u32x4*)(hb + ch), y0);
  unpack8(*(const u32x4*)(hb + 512 + ch), y1);
  float sm = 0.f;
#pragma unroll
  for (int j = 0; j < 8; ++j) { y0[j] += y1[j]; sm += y0[j]; }
  sm += wshfl_xor(sm, 1); sm += wshfl_xor(sm, 2); sm += wshfl_xor(sm, 4);
  const float mean = sm * (1.f / 64.f);
  float sv = 0.f;
#pragma unroll
  for (int j = 0; j < 8; ++j) { float dlt = y0[j] - mean; sv += dlt * dlt; }
  sv += wshfl_xor(sv, 1); sv += wshfl_xor(sv, 2); sv += wshfl_xor(sv, 4);
  const float rstd = frsq(sv * (1.f / 64.f) + 64e-5f);
  float a0[8], a1[8], g[8], u0[8], u1[8], gb[8];
  unpack8(*(const u32x4*)(lora + ((size_t)2 * NTOK + row) * 512 + ch), a0);
  unpack8(*(const u32x4*)(lora + ((size_t)3 * NTOK + row) * 512 + ch), a1);
  unpack8(*(const u32x4*)(lora + ((size_t)4 * NTOK + row) * 512 + ch), g);
  unpack8(*(const u32x4*)(lora + ((size_t)0 * NTOK + row) * 512 + ch), u0);
  unpack8(*(const u32x4*)(lora + ((size_t)1 * NTOK + row) * 512 + ch), u1);
  if (row >= NCTX) {
    const int bb_ = (row - NCTX) / SEQ, pos = (row - NCTX) % SEQ, blk = ch >> 6;
    float ac[8];
#pragma unroll
    for (int dd = 0; dd < 2; ++dd) {
      const int pidx = dd ? SEQ - 1 - pos : pos;
      const int cc = CTXL / 64 + pidx / 64;
      const int sid = (bb_ * 8 + blk) * 2 + dd;
      const float* hs = (const float*)(P.ws + OFF_LRUHS) + ((size_t)sid * LRU_NCH + cc) * 64 + (ch & 63);
      unpack8(*(const u32x4*)((const bf16_t*)(P.ws + (dd ? OFF_ACUM1 : OFF_ACUM0)) + (size_t)(row - NCTX) * 512 + ch), ac);
      f32x4 h0 = *(const f32x4*)hs, h1 = *(const f32x4*)(hs + 4);
      float* u = dd ? u1 : u0;
      u[0] += ac[0] * h0.x; u[1] += ac[1] * h0.y; u[2] += ac[2] * h0.z; u[3] += ac[3] * h0.w;
      u[4] += ac[4] * h1.x; u[5] += ac[5] * h1.y; u[6] += ac[6] * h1.z; u[7] += ac[7] * h1.w;
    }
  }
  unpack8(*(const u32x4*)(proj + (size_t)row * ODC + 1792 + ch), gb);
  float rv[8], vv[8], kv[8];
  float sdot = 0.f;
  float pka[8], prk[8], plw[8], plb[8];
  ld8(P.in[I_KA] + ch, pka); ld8(P.in[I_RK] + ch, prk); ld8(P.in[I_LNW] + ch, plw); ld8(P.in[I_LNB] + ch, plb);
  mix8(proj, row, ch, mu, rv);
  mix8(proj, row, 512 + ch, mu, kv);
  mix8(proj, row, 1024 + ch, mu, vv);
#pragma unroll
  for (int j = 0; j < 8; ++j) {
    float r = rv[j];
    float k = kv[j];
    float am = 0.5f * (sigmoidf_(a0[j]) + sigmoidf_(a1[j]));
    float kb = k * (1.f + (am - 1.f) * pka[j]);
    sdot += r * kb * prk[j];
    rv[j] = r;
  }
  sdot += wshfl_xor(sdot, 1); sdot += wshfl_xor(sdot, 2); sdot += wshfl_xor(sdot, 4);
  float f1[8], f2[8];
#pragma unroll
  for (int j = 0; j < 8; ++j) {
    float yn = (y0[j] - mean) * rstd * plw[j] + plb[j];
    yn += sdot * vv[j];
    f1[j] = yn * g[j];
    f2[j] = (u0[j] + u1[j]) * geluf_(gb[j]);
  }
  *(u32x4*)(hb + ch) = pack8(f1);
  *(u32x4*)(hb + 512 + ch) = pack8(f2);
}

DEV unsigned fkey(float f) { unsigned u; __builtin_memcpy(&u, &f, 4); return (u >> 31) ? ~u : (u | 0x80000000u); }
DEV float keyf(unsigned u) { u = (u >> 31) ? (u & 0x7fffffffu) : ~u; float f; __builtin_memcpy(&f, &u, 4); return f; }
DEV void key_insert(unsigned x, unsigned* v) {
#pragma unroll
  for (int j = 0; j < 16; ++j) { unsigned hi = v[j] > x ? v[j] : x; x = v[j] > x ? x : v[j]; v[j] = hi; }
}
DEV void key_cx(unsigned& hi, unsigned& lo) { unsigned a = hi, b = lo; hi = a > b ? a : b; lo = a > b ? b : a; }
DEV void key_sort16(unsigned* v) {
#pragma unroll
  for (int k = 2; k <= 16; k <<= 1)
#pragma unroll
    for (int j = k >> 1; j > 0; j >>= 1)
#pragma unroll
      for (int i = 0; i < 16; ++i) {
        const int l = i ^ j;
        if (l > i) { if ((i & k) == 0) key_cx(v[i], v[l]); else key_cx(v[l], v[i]); }
      }
}
DEV void key_merge16(unsigned* a, const unsigned* b) {
#pragma unroll
  for (int i = 0; i < 16; ++i) a[i] = a[i] > b[15 - i] ? a[i] : b[15 - i];
#pragma unroll
  for (int j = 8; j > 0; j >>= 1)
#pragma unroll
    for (int i = 0; i < 16; ++i) { const int l = i ^ j; if (l > i) key_cx(a[i], a[l]); }
}

DEV void st_peer_topk(const Params& P, int layer, int tile, int h, unsigned char* smem) {
  const int tid = threadIdx.x;
  const bf16_t* q = (const bf16_t*)(P.ws + OFF_Q);
  const bf16_t* keys = (const bf16_t*)(P.ws + OFF_KEYS) + (size_t)(layer * 8 + h) * 2 * 128 * 128;
  float* sS = (float*)smem;
  const int m0 = tile * 128;
  const int tok = tid & 127, half = tid >> 7;
  unsigned kl[2][16];
#pragma unroll
  for (int p = 0; p < 2; ++p) {
    EpiScoreLds epi{sS, m0};
    gemm_tile_128<true>(q + (h * 2 + p) * 128, 2048, NTOK, keys + p * 128 * 128, 128, 128, 128, m0, 0, epi, smem);
    __syncthreads();
    float* row = sS + tok * 129 + half * 64;
#pragma unroll
    for (int g = 0; g < 4; ++g) {
      unsigned grp[16];
#pragma unroll
      for (int j = 0; j < 16; ++j) grp[j] = (fkey(row[g * 16 + j]) & ~127u) | (unsigned)(127 - (half * 64 + g * 16 + j));
      key_sort16(grp);
      if (g == 0) {
#pragma unroll
        for (int j = 0; j < 16; ++j) kl[p][j] = grp[j];
      } else key_merge16(kl[p], grp);
    }
    if (half == 1) {
#pragma unroll
      for (int j = 0; j < 16; ++j) row[j] = __builtin_bit_cast(float, kl[p][j]);
    }
    __syncthreads();
    if (half == 0) {
      unsigned oth[16];
#pragma unroll
      for (int j = 0; j < 16; ++j) oth[j] = __builtin_bit_cast(unsigned, sS[tok * 129 + 64 + j]);
      key_merge16(kl[p], oth);
    }
    __syncthreads();
  }
  if (tid < 128) {
    float sv0[16], sv1[16];
    int* irow = (int*)(sS + tid * 129);
#pragma unroll
    for (int j = 0; j < 16; ++j) {
      sv0[j] = keyf((kl[0][j] & ~127u) | 64u); sv1[j] = keyf((kl[1][j] & ~127u) | 64u);
      irow[j] = 127 - (int)(kl[0][j] & 127u); irow[16 + j] = 127 - (int)(kl[1][j] & 127u);
    }
    unsigned best[16];
#pragma unroll
    for (int j = 0; j < 16; ++j) best[j] = 0u;
#pragma unroll
    for (int i = 0; i < 16; ++i)
#pragma unroll
      for (int j = 0; j < 16; ++j)
        if ((i + 1) * (j + 1) <= 16) key_insert((fkey(sv0[i] + sv1[j]) & ~255u) | (unsigned)(255 - (i * 16 + j)), best);
    float e[16], sum = 0.f;
    const float b0 = keyf((best[0] & ~255u) | 128u);
#pragma unroll
    for (int j = 0; j < 16; ++j) { e[j] = fexp(keyf((best[j] & ~255u) | 128u) - b0); sum += e[j]; }
    const float inv = 1.f / sum;
    int* pidx = (int*)(P.ws + OFF_PIDX) + (size_t)(m0 + tid) * 128 + h * 16;
    float* pg = (float*)(P.ws + OFF_PGATE) + (size_t)(m0 + tid) * 128 + h * 16;
#pragma unroll
    for (int j = 0; j < 16; ++j) {
      const int pos = 255 - (int)(best[j] & 255u);
      pidx[j] = irow[pos >> 4] * 128 + irow[16 + (pos & 15)];
      pg[j] = e[j] * inv;
    }
  }
}

DEV void st_peer_experts(const Params& P, int layer, int row) {
  const int lane = threadIdx.x & 63;
  const bf16_t* xb = (const bf16_t*)(P.ws + OFF_HBUF) + (size_t)row * 1024;
  const unsigned char* U = P.ws + OFF_PU;
  const int* pidx = (const int*)(P.ws + OFF_PIDX) + (size_t)row * 128;
  const float* pg = (const float*)(P.ws + OFF_PGATE) + (size_t)row * 128;
  float x[16], acc[16];
  unpack8(*(const u32x4*)(xb + lane * 16), x);
  unpack8(*(const u32x4*)(xb + lane * 16 + 8), x + 8);
#pragma unroll
  for (int j = 0; j < 16; ++j) acc[j] = 0.f;
  const int b5 = (lane >> 5) & 1, b4 = (lane >> 4) & 1, b3 = (lane >> 3) & 1;
  const int mypick = (lane >> 3) & 7;
  for (int k0 = 0; k0 < 128; k0 += 8) {
    u32x3 uu[8]; u32x2 vv[8];
#pragma unroll
    for (int i = 0; i < 8; ++i) {
      const unsigned char* er = U + (size_t)pidx[k0 + i] * PEER_ROWB;
      const unsigned* up = (const unsigned*)(er + lane * 12);
      uu[i].x = up[0]; uu[i].y = up[1]; uu[i].z = up[2];
      vv[i] = *(const u32x2*)(er + PEER_VOFF + lane * 8);
    }
    const float mygate = pg[k0 + mypick];
    float dsum[8];
#pragma unroll
    for (int i = 0; i < 8; i += 2) {
      float ufa[16], ufb[16];
#ifndef CPU_EMU
      __builtin_amdgcn_sched_barrier(0);
#endif
      unpack2x16_fp6(uu[i], uu[i + 1], ufa, ufb);
      typedef __attribute__((ext_vector_type(2))) float f32x2v;
      f32x2v da2 = {0.f, 0.f}, db2 = {0.f, 0.f};
#pragma unroll
      for (int j = 0; j < 8; ++j) {
        const f32x2v xx = {x[2 * j], x[2 * j + 1]};
        const f32x2v ua = {ufa[2 * j], ufa[2 * j + 1]}, ub = {ufb[2 * j], ufb[2 * j + 1]};
        da2 = xx * ua + da2; db2 = xx * ub + db2;
      }
      dsum[i] = da2.x + da2.y; dsum[i + 1] = db2.x + db2.y;
    }
    float e4[4], e2[2], g;
#pragma unroll
    for (int i = 0; i < 4; ++i) {
      float mine = b5 ? dsum[4 + i] : dsum[i], send = b5 ? dsum[i] : dsum[4 + i];
      e4[i] = mine + wshfl_xor(send, 32);
    }
#pragma unroll
    for (int i = 0; i < 2; ++i) {
      float mine = b4 ? e4[2 + i] : e4[i], send = b4 ? e4[i] : e4[2 + i];
      e2[i] = mine + wshfl_xor(send, 16);
    }
    {
      float mine = b3 ? e2[1] : e2[0], send = b3 ? e2[0] : e2[1];
      g = mine + wshfl_xor(send, 8);
    }
    g += wshfl_xor(g, 4); g += wshfl_xor(g, 2); g += wshfl_xor(g, 1);
    const float mycoef = mygate * geluf_(g * (1.f / PEER_USCALE));
#pragma unroll
    for (int i = 0; i < 8; ++i) {
      const float coef = wreadlane(mycoef, i * 8);
      float vf[16];
      unpack8_fp4(vv[i].x, vf); unpack8_fp4(vv[i].y, vf + 8);
#pragma unroll
      for (int j = 0; j < 16; ++j) acc[j] += coef * vf[j];
    }
  }
  float* xr = row < NCTX ? (float*)(P.ws + OFF_CTXRES) + (size_t)row * 1024 : P.out + (size_t)(row - NCTX) * 1024;
  const float* g2 = (const float*)(P.ws + OFF_MODV) + ((size_t)layer * 3 + mod_row(row)) * 6144 + 5 * 1024;
  float o[16];
#pragma unroll
  for (int q = 0; q < 4; ++q) {
    const int c = lane * 16 + q * 4;
    f32x4 a = *(const f32x4*)(xr + c), ga = *(const f32x4*)(g2 + c);
    o[q * 4 + 0] = a.x + ga.x * acc[q * 4 + 0] * (1.f / PEER_VSCALE); o[q * 4 + 1] = a.y + ga.y * acc[q * 4 + 1] * (1.f / PEER_VSCALE);
    o[q * 4 + 2] = a.z + ga.z * acc[q * 4 + 2] * (1.f / PEER_VSCALE); o[q * 4 + 3] = a.w + ga.w * acc[q * 4 + 3] * (1.f / PEER_VSCALE);
  }
  float ss = 0.f;
#pragma unroll
  for (int j = 0; j < 16; ++j) ss += o[j] * o[j];
  ss = wave_sum(ss);
  const float rstd = frsq(ss * (1.f / 1024.f) + 1e-6f);
  if (layer == 1) {
    float fn[16]; ld8(P.in[I_FNORM] + lane * 16, fn); ld8(P.in[I_FNORM] + lane * 16 + 8, fn + 8);
#pragma unroll
    for (int j = 0; j < 16; ++j) o[j] *= rstd * fn[j];
  }
#pragma unroll
  for (int q = 0; q < 4; ++q) {
    f32x4 a = {o[q * 4 + 0], o[q * 4 + 1], o[q * 4 + 2], o[q * 4 + 3]};
    *(f32x4*)(xr + lane * 16 + q * 4) = a;
  }
  if (layer == 0) {
    const float* mv = (const float*)(P.ws + OFF_MODV) + ((size_t)1 * 3 + mod_row(row)) * 6144;
    const float* nw = P.in[I_NORM1] + 1024;
    float hh[16];
#pragma unroll
    for (int q = 0; q < 4; ++q) {
      const int c = lane * 16 + q * 4;
      f32x4 w4 = *(const f32x4*)(nw + c), s4 = *(const f32x4*)(mv + 1024 + c), h4 = *(const f32x4*)(mv + c);
      hh[q * 4 + 0] = o[q * 4 + 0] * rstd * w4.x * (1.f + s4.x) + h4.x; hh[q * 4 + 1] = o[q * 4 + 1] * rstd * w4.y * (1.f + s4.y) + h4.y;
      hh[q * 4 + 2] = o[q * 4 + 2] * rstd * w4.z * (1.f + s4.z) + h4.z; hh[q * 4 + 3] = o[q * 4 + 3] * rstd * w4.w * (1.f + s4.w) + h4.w;
    }
    bf16_t* hb = (bf16_t*)(P.ws + OFF_HBUF) + (size_t)row * 1024 + lane * 16;
    *(u32x4*)hb = pack8(hh);
    *(u32x4*)(hb + 8) = pack8(hh + 8);
  }
}


#define FOR_TILES_XCD(MT0, MT1, NT, mt, nt)                                                     \
  for (int _x = blockIdx.x & 7, _mlo = (MT0) + (((MT1) - (MT0)) * _x) / 8,                        \
           _mhi = (MT0) + (((MT1) - (MT0)) * (_x + 1)) / 8, _i = blockIdx.x >> 3,                 \
           _cnt = (_mhi - _mlo) * (NT), mt = 0, nt = 0;                                           \
       _i < _cnt && ((mt = _mlo + _i / (NT)), (nt = _i % (NT)), true); _i += (int)(gridDim.x >> 3))

#ifndef PHASE_LIST
#define PHASE_LIST(X) X(0) X(1) X(2) X(22) X(23) X(3) X(4) X(5) X(6) X(7) X(8) X(9) X(11) X(12) X(13) X(30) X(14) X(15) X(31) X(16) X(17) X(18) X(19) X(20) X(21)
#endif
constexpr int PH_LAST = 21;

template <int ph>
DEV void run_phase(const Params& P, unsigned char* smem) {
  int bid_ = blockIdx.x, wave_ = threadIdx.x >> 6;
  OPAQUE_S(bid_); OPAQUE(wave_);
  const int bid = bid_, nb = gridDim.x;
  const int wave = wave_;
  unsigned char* ws = P.ws;
  constexpr int layer = ((ph >= 10 && ph <= 21) || ph >= 30) ? 1 : 0;
  const float* modv_l = (const float*)(ws + OFF_MODV) + (size_t)layer * 3 * 6144;
  switch (ph) {
    case 0:
      for (int t = NTRANS + bid; t < NPREP; t += nb) st_prep(P, t, smem);
      break;
    case 1: case 10:
      if (ph == 1) for (int t = nb - 1 - bid; t < NTRANS; t += nb) st_prep(P, t, smem);
      for (int t = bid; t < NTOK / 4; t += nb) st_normmod(P, layer, 0, t * 4 + wave);
      break;
    case 2: {
      EpiProjL0T epi{(bf16_t*)(ws + OFF_PROJ), (float*)(ws + OFF_GATES)};
      FOR_TILES_XCD(0, NTOK / 256, 25, mt, nt)
        gemm_tile_128x256<EpiProjL0T, true>((const bf16_t*)(ws + OFF_WEVIN), 1024, EVC, (const bf16_t*)(ws + OFF_HBUF), 1024, NTOK, 1024,
                                            nt * 128, mt * 256, epi, smem);
    } break;
    case 22:
      for (int t = bid; t < NTOK / 4; t += nb) st_xbc_conv(P, t * 4 + wave);
      for (int t = bid; t < NPCONV; t += nb) st_peer_conv(P, 0, t);
      break;
    case 23:
      for (int t = bid; t < 48 * LA_NSEG; t += nb) {
        int sid = t % 48, seg = t / 48;
        if (sid < 16) st_linattn_seg<true, false>(P, sid, seg, smem);
        else st_linattn_seg<false, false>(P, sid - 16, seg, smem);
      }
      break;
    case 3:
      for (int t = bid; t < 48 * LA_NSEG; t += nb) {
        int sid = t % 48, seg = t / 48;
        if (sid < 16) st_linattn_seg<true, true>(P, sid, seg, smem);
        else st_linattn_seg<false, true>(P, sid - 16, seg, smem);
      }
      break;
    case 4:
      for (int t = bid; t < NTOK / 4; t += nb) st_finish_l0(P, t * 4 + wave);
      break;
    case 5: case 17: {
      EpiOutProjT epi{layer == 0 ? P.in[I_X] : P.out, P.in[I_CTX], P.out, (float*)(ws + OFF_CTXRES), modv_l};
      const bf16_t* Wt = (const bf16_t*)(ws + (layer == 0 ? OFF_WEVOUT : OFF_WODOUT));
      FOR_TILES_XCD(layer == 0 ? 0 : NCTX / 256, NTOK / 256, 8, mt, nt)
        gemm_tile_128x256<EpiOutProjT, true>(Wt, 1024, 1024, (const bf16_t*)(ws + OFF_HBUF), 1024, NTOK, 1024, nt * 128, mt * 256, epi, smem);
    } break;
    case 6: case 18: {
      const int r0 = layer == 0 ? 0 : NCTX / 4;
      for (int t = r0 + bid; t < NTOK / 4; t += nb) st_normmod(P, layer, 1, t * 4 + wave);
      if (ph == 18) for (int t = bid; t < NPCONV; t += nb) st_peer_conv(P, 1, t);
    } break;
    case 7: case 19: {
      EpiStoreBfT epi{(bf16_t*)(ws + OFF_Q), 2048};
      const bf16_t* Wt = (const bf16_t*)(ws + OFF_WQ) + (size_t)layer * 2048 * 1024;
      FOR_TILES_XCD(layer == 0 ? 0 : NCTX / 256, NTOK / 256, 16, mt, nt)
        gemm_tile_128x256<EpiStoreBfT, true>(Wt, 1024, 2048, (const bf16_t*)(ws + OFF_HBUF), 1024, NTOK, 1024, nt * 128, mt * 256, epi, smem);
    } break;
    case 8: case 20: {
      const int t0 = layer == 0 ? 0 : CTILE * 8;
      for (int t = t0 + bid; t < NTILE * 8; t += nb) st_peer_topk(P, layer, t / 8, t % 8, smem);
    } break;
    case 9: case 21: {
      const int r0 = layer == 0 ? 0 : NCTX / 4;
      for (int t = r0 + bid; t < NTOK / 4; t += nb) st_peer_experts(P, layer, t * 4 + wave);
    } break;
    case 11: {
      EpiStoreBfT epi{(bf16_t*)(ws + OFF_PROJ), ODC};
      FOR_TILES_XCD(0, NTOK / 256, 22, mt, nt)
        gemm_tile_128x256<EpiStoreBfT, true>((const bf16_t*)(ws + OFF_WODIN), 1024, ODC, (const bf16_t*)(ws + OFF_HBUF), 1024, NTOK, 1024,
                                             nt * 128, mt * 256, epi, smem);
    } break;
    case 12:
      for (int t = bid; t < NTOK / 8; t += nb) st_lora_act(P, t * 8 + wave * 2);
      break;
    case 13:
      for (int t = bid; t < NTILE * 20; t += nb) {
        int job = t / (NTILE * 4), tt = t % (NTILE * 4);
        int mt = tt / 4, nt = tt % 4;
        bf16_t* dst = (bf16_t*)(ws + OFF_LORA) + (size_t)job * NTOK * 512;
        const bf16_t* A = (const bf16_t*)(ws + OFF_HBUF) + (job < 2 ? 0 : (job < 4 ? 64 : 128));
        const bf16_t* Bt = job < 2 ? (const bf16_t*)(ws + OFF_WUP) + (size_t)job * 512 * 64
                         : job < 4 ? (const bf16_t*)(ws + OFF_AUP) + (size_t)(job - 2) * 512 * 64
                                   : (const bf16_t*)(ws + OFF_GUP);
        const float* bias = job < 2 ? P.in[I_W0] + job * 512 : (job < 4 ? P.in[I_A0] + (job - 2) * 512 : nullptr);
        const int K = job < 4 ? 64 : 128;
        EpiStoreBfBiasT epi{dst, 512, bias};
        gemm_tile_128<false, EpiStoreBfBiasT, true>(Bt, K, 512, A, 1024, NTOK, K, nt * 128, mt * 128, epi, smem);
      }
      break;
    case 30:
      for (int t = bid; t < 32 * RW_NSEG; t += nb) st_rwkv_seg<false>(P, t % 32, t / 32, smem);
      break;
    case 14:
      for (int t = bid; t < 32 * RW_NSEG; t += nb) st_rwkv_seg<true>(P, t % 32, t / 32, smem);
      break;
    case 15:
      for (int t = bid; t < 32 * LRU_NCH; t += nb) st_lru_chunk(P, t % 32, t / 32, smem);
      break;
    case 31:
      if (bid < 32) st_lru_carry(P, bid);
      break;
    case 16:
      for (int t = bid; t < NTOK / 4; t += nb) st_finish_l1(P, t * 4 + wave);
      break;
    default: break;
  }
}


#ifndef CPU_EMU
#define XB_TMO      128
#define XB_XCNT(j)  (256  + 64 * (j))
#define XB_XSUB(j)  (1280 + 64 * (j))
#define XB_XGEN(j)  (2304 + 64 * (j))
#define XB_TOP      3328
#define XB_TOPGEN   3392
#define XCD_BAR_WORDS 3456
#define XB_SPIN_CAP (1u << 20)
#define LAS __attribute__((address_space(3)))
__device__ __forceinline__ unsigned xb_ld(unsigned* p)              { return __hip_atomic_load(p, __ATOMIC_RELAXED, __HIP_MEMORY_SCOPE_AGENT); }
__device__ __forceinline__ unsigned xb_add(unsigned* p, unsigned v) { return __hip_atomic_fetch_add(p, v, __ATOMIC_RELAXED, __HIP_MEMORY_SCOPE_AGENT); }
__device__ __forceinline__ unsigned xb_xcc_id() { return (unsigned)__builtin_amdgcn_s_getreg((3 << 11) | 20) & 0xFu; }
#define XB_SPIN(cond, bar) do { unsigned _sp = 0; while (cond) { __builtin_amdgcn_s_sleep(1); \
    if ((++_sp & 255u) == 0u) { if (xb_ld(&(bar)[XB_TMO])) break; if (_sp > XB_SPIN_CAP) { atomicAdd(&(bar)[XB_TMO], 1u); break; } } } } while (0)
struct XcdBarrier { unsigned* bar; unsigned x; volatile LAS unsigned* st; };
__device__ __forceinline__ XcdBarrier xcd_barrier_post(unsigned* bar, volatile LAS unsigned* st) {
  XcdBarrier b; b.bar = bar; b.x = xb_xcc_id(); b.st = st;
  if (threadIdx.x == 0) (void)xb_add(&bar[XB_XCNT(b.x)], 1u);
  return b;
}
__device__ __forceinline__ void xcd_barrier_complete(unsigned* bar, unsigned x, unsigned& nloc, unsigned& nx) {
  const unsigned G = gridDim.x * gridDim.y * gridDim.z;
  unsigned sum, cnt, mine, sp = 0u;
  for (;;) {
    sum = 0u; cnt = 0u; mine = 0u;
#pragma unroll
    for (unsigned j = 0; j < 16; ++j) { const unsigned c = xb_ld(&bar[XB_XCNT(j)]); sum += c; cnt += (c > 0u) ? 1u : 0u; mine = (j == x) ? c : mine; }
    if (sum == G) break;
    __builtin_amdgcn_s_sleep(1);
    if ((++sp & 255u) == 0u) { if (xb_ld(&bar[XB_TMO])) break; if (sp > XB_SPIN_CAP) { atomicAdd(&bar[XB_TMO], 1u); break; } }
  }
  nloc = mine > 0u ? mine : 1u; nx = cnt > 0u ? cnt : 1u;
}
__device__ __forceinline__ void xcd_barrier(const XcdBarrier& b) {
  asm volatile("s_waitcnt vmcnt(0)" ::: "memory");
  __syncthreads();
  if (threadIdx.x == 0) {
    unsigned* bar = b.bar;
    __builtin_amdgcn_s_waitcnt(0);
    unsigned nloc = b.st[0], nx = b.st[1];
    if (nloc == 0u) { xcd_barrier_complete(bar, b.x, nloc, nx); b.st[0] = nloc; b.st[1] = nx; }
    const unsigned old = xb_add(&bar[XB_XSUB(b.x)], 1u);
    const unsigned gen = old / nloc;
    if (old + 1u == (gen + 1u) * nloc) {
      __builtin_amdgcn_fence(__ATOMIC_RELEASE, "agent");
      asm volatile("s_waitcnt vmcnt(0)" ::: "memory");
      const unsigned og = xb_add(&bar[XB_TOP], 1u);
      const unsigned tg = og / nx;
      if (og + 1u == (tg + 1u) * nx) xb_add(&bar[XB_TOPGEN], 1u);
      else XB_SPIN(xb_ld(&bar[XB_TOPGEN]) == tg, bar);
      __builtin_amdgcn_fence(__ATOMIC_ACQUIRE, "agent");
      xb_add(&bar[XB_XGEN(b.x)], 1u);
      asm volatile("s_waitcnt vmcnt(0)" ::: "memory");
    } else {
      XB_SPIN(xb_ld(&bar[XB_XGEN(b.x)]) == gen, bar);
      __builtin_amdgcn_fence(__ATOMIC_ACQUIRE, "agent");
      asm volatile("s_waitcnt vmcnt(0)" ::: "memory");
    }
  }
  __syncthreads();
}
#endif
#ifndef CPU_EMU
#define RUN_PH(n) run_phase<n>(P, smem_raw); if (n != PH_LAST) xcd_barrier(xb);
__global__ void __launch_bounds__(256, 2) mega_kernel(Params P) {
  SMEM_DECL;
  unsigned* bar = (unsigned*)(P.ws + OFF_BAR);
  volatile LAS unsigned* st = (volatile LAS unsigned*)(smem_raw + SMEM_BYTES - 16);
  if (threadIdx.x == 0) { st[0] = 0u; st[1] = 0u; }
  if (P.ws == nullptr) cg::this_grid().sync();
  __syncthreads();
  XcdBarrier xb = xcd_barrier_post(bar, st);
  PHASE_LIST(RUN_PH)
}

extern "C" void kernel_launch(void* const* d_in, const int* in_sizes, int n_in, void* d_out, int out_size, void* d_ws,
                              size_t ws_size, hipStream_t stream) {
  Params P{};
  for (int i = 0; i < N_IN; ++i) P.in[i] = (const float*)d_in[i];
  P.out = (float*)d_out;
  P.ws = (unsigned char*)d_ws;
  if (ws_size < WS_NEEDED) { fprintf(stderr, "workspace too small: %zu < %zu\n", ws_size, (size_t)WS_NEEDED); return; }
  static int grid_blocks = 0;
  if (!grid_blocks) {
    int dev = 0, cus = 0, per_cu = 0;
    hipGetDevice(&dev);
    hipDeviceGetAttribute(&cus, hipDeviceAttributeMultiprocessorCount, dev);
    hipOccupancyMaxActiveBlocksPerMultiprocessor(&per_cu, mega_kernel, 256, 0);
    if (per_cu > 2) per_cu = 2;
    grid_blocks = cus * per_cu;
  }
  (void)hipMemsetAsync((unsigned char*)d_ws + OFF_BAR, 0, 16384, stream);
  void* args[] = {&P};
  hipError_t e = hipLaunchCooperativeKernel((void*)mega_kernel, dim3(grid_blocks), dim3(256), args, 0, stream);
  if (e != hipSuccess) fprintf(stderr, "cooperative launch failed: %s (grid %d)\n", hipGetErrorString(e), grid_blocks);
}
#endif
```

```cpp
#ifdef CPU_EMU
#include "emu.h"
#else
#include <hip/hip_runtime.h>
#include <hip/hip_cooperative_groups.h>
#include <cstdio>
namespace cg = cooperative_groups;
#define DEV __device__ __forceinline__
#define DEVM __device__ __forceinline__
#define OPAQUE(x) asm volatile("" : "+v"(x))
#define OPAQUE_S(x) asm volatile("" : "+s"(x))
#endif

#ifndef SEQ_LEN
#define SEQ_LEN 16384
#endif
#ifndef CTX_LEN
#define CTX_LEN 256
#endif
#ifndef GRID_W_
#define GRID_W_ 64
#endif
#ifndef MULTI_LAUNCH
#define MULTI_LAUNCH 0
#endif

typedef unsigned short bf16_t;
typedef __attribute__((ext_vector_type(8))) short bf16x8;
typedef __attribute__((ext_vector_type(16))) float f32x16;
typedef __attribute__((ext_vector_type(4))) unsigned u32x4;
typedef __attribute__((ext_vector_type(2))) unsigned u32x2;
typedef __attribute__((ext_vector_type(4))) float f32x4;

constexpr int D = 1024, NB = 2, SEQ = SEQ_LEN, CTXL = CTX_LEN, GW = GRID_W_;
constexpr int NCTX = NB * CTXL, NLAT = NB * SEQ, NTOK = NCTX + NLAT;
constexpr int EVC = 3104, ODC = 2816;
constexpr int NEXP = 16384;
constexpr int NTILE = NTOK / 128, CTILE = NCTX / 128;
static_assert(NTOK % 256 == 0 && NCTX % 256 == 0, "tiles");
static_assert(CTXL % 64 == 0 && SEQ % 64 == 0 && SEQ % GW == 0, "chunks");

constexpr size_t al256(size_t x) { return (x + 255) & ~(size_t)255; }
constexpr size_t OFF_MODV = 0;
constexpr size_t OFF_CTXRES = OFF_MODV + al256(2 * 3 * 6144 * 4);
constexpr size_t OFF_GATES = OFF_CTXRES + al256((size_t)NCTX * 1024 * 4);
constexpr size_t OFF_WEVIN = OFF_GATES + al256((size_t)NTOK * 32 * 4);
constexpr size_t OFF_WEVOUT = OFF_WEVIN + al256((size_t)EVC * 1024 * 2);
constexpr size_t OFF_WODIN = OFF_WEVOUT + al256((size_t)1024 * 1024 * 2);
constexpr size_t OFF_WODOUT = OFF_WODIN + al256((size_t)ODC * 1024 * 2);
constexpr size_t OFF_WQ = OFF_WODOUT + al256((size_t)1024 * 1024 * 2);
constexpr size_t OFF_KEYS = OFF_WQ + al256((size_t)2 * 2048 * 1024 * 2);
constexpr size_t OFF_WUP = OFF_KEYS + al256((size_t)2 * 8 * 2 * 128 * 128 * 2);
constexpr size_t OFF_AUP = OFF_WUP + al256((size_t)2 * 512 * 64 * 2);
constexpr size_t OFF_GUP = OFF_AUP + al256((size_t)2 * 512 * 64 * 2);
constexpr size_t OFF_LRUT = OFF_GUP + al256((size_t)512 * 128 * 2);
constexpr size_t OFF_PU = OFF_LRUT + al256((size_t)2 * 8 * 128 * 64 * 2);
constexpr size_t OFF_PV = OFF_PU + al256((size_t)NEXP * 1024);
constexpr size_t OFF_HBUF = OFF_PV + al256((size_t)NEXP * 1024);
constexpr size_t OFF_PR = OFF_HBUF + al256((size_t)NTOK * 1024 * 2);
constexpr size_t PR_BYTES = (size_t)NTOK * 5376 * 2;
constexpr size_t OFF_BAR = OFF_PR + PR_BYTES;
constexpr size_t OFF_ACUM1 = OFF_BAR + 16384;
constexpr size_t OFF_LRUCS = OFF_ACUM1 + (size_t)NLAT * 512 * 2;
constexpr size_t OFF_LRUHS = OFF_LRUCS + (size_t)32 * ((CTXL + SEQ) / 64) * 128 * 4;
constexpr size_t WS_NEEDED = OFF_LRUHS + (size_t)32 * ((CTXL + SEQ) / 64) * 64 * 4;
#ifndef CPU_EMU
static_assert(WS_NEEDED <= (size_t)512 * 1024 * 1024, "workspace too large");
#endif
constexpr size_t OFF_PROJ = OFF_PR;
constexpr size_t OFF_R2L0 = OFF_PR + (size_t)NTOK * EVC * 2;
constexpr size_t OFF_LORA = OFF_PR + (size_t)NTOK * ODC * 2;
constexpr size_t OFF_Q = OFF_PR;
constexpr size_t OFF_PIDX = OFF_PR + (size_t)NTOK * 2048 * 2;
constexpr size_t OFF_PGATE = OFF_PIDX + (size_t)NTOK * 128 * 4;
static_assert(OFF_PGATE + (size_t)NTOK * 128 * 4 <= OFF_PR + PR_BYTES, "picks");

enum {
  I_X = 0, I_C, I_CTX, I_CCTX, I_MODW, I_MODB, I_NORM1, I_NORM2, I_WQ, I_KEYS, I_PU, I_PV,
  I_EVWIN, I_EVWOUT, I_IBIAS, I_FBIAS, I_MNORM, I_SCONVW, I_SCONVB, I_DTBIAS, I_ALOG, I_DSKIP, I_SNORM,
  I_ODWIN, I_ODWOUT, I_MU, I_W0, I_WUP, I_A0, I_AUP, I_GUP, I_KK, I_KA, I_RK, I_LNW, I_LNB,
  I_LCONVW, I_LCONVB, I_LAM, I_WA, I_BA, I_WI, I_BI, I_FNORM, N_IN
};

struct Params {
  const float* in[N_IN];
  float* out;
  unsigned char* ws;
};

constexpr int SMEM_BYTES = 80 * 1024;
#ifdef CPU_EMU
#define SMEM_DECL static thread_local __attribute__((aligned(16))) unsigned char smem_raw[SMEM_BYTES]
#else
#define SMEM_DECL __shared__ __attribute__((aligned(16))) unsigned char smem_raw[SMEM_BYTES]
#endif

DEV float bf2f(bf16_t v) { unsigned u = ((unsigned)v) << 16; float f; __builtin_memcpy(&f, &u, 4); return f; }
DEV bf16_t f2bf(float f) { unsigned u; __builtin_memcpy(&u, &f, 4); u += 0x7fffu + ((u >> 16) & 1u); return (bf16_t)(u >> 16); }
DEV unsigned pack2(float a, float b) { return (unsigned)f2bf(a) | ((unsigned)f2bf(b) << 16); }
DEV void unpack8(const u32x4& r, float* o) {
  unsigned w[4] = {r.x, r.y, r.z, r.w};
#pragma unroll
  for (int i = 0; i < 4; ++i) { unsigned lo = w[i] << 16, hi = w[i] & 0xffff0000u; __builtin_memcpy(&o[2 * i], &lo, 4); __builtin_memcpy(&o[2 * i + 1], &hi, 4); }
}
DEV u32x4 pack8(const float* o) { u32x4 r; r.x = pack2(o[0], o[1]); r.y = pack2(o[2], o[3]); r.z = pack2(o[4], o[5]); r.w = pack2(o[6], o[7]); return r; }
#ifdef CPU_EMU
DEV float fexp(float x) { return expf(x); }
DEV float frcp(float x) { return 1.f / x; }
DEV float flog(float x) { return logf(x); }
DEV float frsq(float x) { return 1.f / sqrtf(x); }
DEV float fsqrt(float x) { return sqrtf(x); }
#else
DEV float fexp(float x) { return __expf(x); }
DEV float frcp(float x) { return __builtin_amdgcn_rcpf(x); }
DEV float flog(float x) { return __logf(x); }
DEV float frsq(float x) { return __builtin_amdgcn_rsqf(x); }
DEV float fsqrt(float x) { return __builtin_amdgcn_sqrtf(x); }
#endif
DEV void ld8(const float* __restrict__ p, float* o) { const f32x4 a = *(const f32x4*)p, b = *(const f32x4*)(p + 4); o[0] = a.x; o[1] = a.y; o[2] = a.z; o[3] = a.w; o[4] = b.x; o[5] = b.y; o[6] = b.z; o[7] = b.w; }
DEV float sigmoidf_(float x) { return frcp(1.f + fexp(-x)); }
DEV float siluf_(float x) { return x * frcp(1.f + fexp(-x)); }
DEV float softplusf_(float x) { return fmaxf(x, 0.f) + flog(1.f + fexp(-fabsf(x))); }
DEV float tanhf_(float x) { return 1.f - 2.f * frcp(1.f + fexp(2.f * x)); }
DEV float geluf_(float x) { return 0.5f * x * (1.f + erff(x * 0.70710678118654752f)); }

DEV f32x16 mfma32(bf16x8 a, bf16x8 b, f32x16 c) {
#ifdef CPU_EMU
  return emu_mfma32(a, b, c);
#else
  return __builtin_amdgcn_mfma_f32_32x32x16_bf16(a, b, c, 0, 0, 0);
#endif
}
DEV float wshfl_xor(float v, int m) {
#ifdef CPU_EMU
  return emu_shfl_xor(v, m);
#else
  return __shfl_xor(v, m, 64);
#endif
}
DEV float wave_sum(float v) {
#pragma unroll
  for (int m = 32; m >= 1; m >>= 1) v += wshfl_xor(v, m);
  return v;
}

#ifdef CPU_EMU
static inline unsigned emu_f2fp8(float f) {
  unsigned sgn = f < 0.f ? 0x80u : 0u; float a = fabsf(f);
  if (!(a == a)) return 0x7f;
  if (a >= 448.f) return sgn | 0x7e;
  if (a < 0.0009765625f) return sgn;
  int e; frexpf(a, &e); e -= 1;
  if (e < -6) { int q = (int)nearbyintf(a * 512.f); return sgn | (unsigned)q; }
  float m = a / ldexpf(1.f, e);
  int q = (int)nearbyintf((m - 1.f) * 8.f);
  if (q == 8) { q = 0; e += 1; }
  if (e > 8) return sgn | 0x7e;
  return sgn | (unsigned)((e + 7) << 3) | (unsigned)q;
}
static inline float emu_fp82f(unsigned c) {
  unsigned sgn = c & 0x80, e = (c >> 3) & 15, m = c & 7;
  float v = e == 0 ? ldexpf((float)m, -9) : ldexpf(1.f + m / 8.f, (int)e - 7);
  return sgn ? -v : v;
}
#endif
DEV unsigned pack4_fp8(float a, float b, float c, float d) {
#ifdef CPU_EMU
  return emu_f2fp8(a) | (emu_f2fp8(b) << 8) | (emu_f2fp8(c) << 16) | (emu_f2fp8(d) << 24);
#else
  int w = 0;
  w = __builtin_amdgcn_cvt_pk_fp8_f32(a, b, w, false);
  w = __builtin_amdgcn_cvt_pk_fp8_f32(c, d, w, true);
  return (unsigned)w;
#endif
}
DEV void unpack4_fp8(unsigned w, float* o) {
#ifdef CPU_EMU
  o[0] = emu_fp82f(w & 255); o[1] = emu_fp82f((w >> 8) & 255); o[2] = emu_fp82f((w >> 16) & 255); o[3] = emu_fp82f(w >> 24);
#else
  typedef __attribute__((ext_vector_type(2))) float f32x2_;
  f32x2_ lo = __builtin_amdgcn_cvt_pk_f32_fp8((int)w, false);
  f32x2_ hi = __builtin_amdgcn_cvt_pk_f32_fp8((int)w, true);
  o[0] = lo.x; o[1] = lo.y; o[2] = hi.x; o[3] = hi.y;
#endif
}
DEV void unpack16_fp8(const u32x4& r, float* o) { unpack4_fp8(r.x, o); unpack4_fp8(r.y, o + 4); unpack4_fp8(r.z, o + 8); unpack4_fp8(r.w, o + 12); }
DEV float wreadlane(float v, int srclane) {
#ifdef CPU_EMU
  return emu_readlane(v, srclane);
#else
  int iv; __builtin_memcpy(&iv, &v, 4);
  int r = __builtin_amdgcn_readlane(iv, srclane);
  float f; __builtin_memcpy(&f, &r, 4); return f;
#endif
}
constexpr float PEER_USCALE = 64.f, PEER_VSCALE = 4.f;
#ifdef CPU_EMU
static inline unsigned emu_f2fp4(float f) {
  static const float lv[8] = {0.f, 0.5f, 1.f, 1.5f, 2.f, 3.f, 4.f, 6.f};
  unsigned sgn = f < 0.f ? 8u : 0u; float a = fabsf(f);
  int best = 0; float bd = 1e30f;
  for (int i = 0; i < 8; ++i) { float dd = fabsf(a - lv[i]); if (dd < bd || (dd == bd && (i & 1) == 0)) { bd = dd; best = i; } }
  return sgn | (unsigned)best;
}
static inline float emu_fp42f(unsigned c) {
  static const float lv[8] = {0.f, 0.5f, 1.f, 1.5f, 2.f, 3.f, 4.f, 6.f};
  float v = lv[c & 7]; return (c & 8) ? -v : v;
}
#endif
DEV unsigned pack8_fp4(const float* v) {
#ifdef CPU_EMU
  unsigned w = 0;
  for (int i = 0; i < 8; ++i) w |= emu_f2fp4(v[i]) << (4 * i);
  return w;
#else
  unsigned w = 0;
  w = __builtin_amdgcn_cvt_scalef32_pk_fp4_f32(w, v[0], v[1], 1.0f, 0);
  w = __builtin_amdgcn_cvt_scalef32_pk_fp4_f32(w, v[2], v[3], 1.0f, 1);
  w = __builtin_amdgcn_cvt_scalef32_pk_fp4_f32(w, v[4], v[5], 1.0f, 2);
  w = __builtin_amdgcn_cvt_scalef32_pk_fp4_f32(w, v[6], v[7], 1.0f, 3);
  return w;
#endif
}
DEV void unpack8_fp4(unsigned w, float* o) {
#ifdef CPU_EMU
  for (int i = 0; i < 8; ++i) o[i] = emu_fp42f((w >> (4 * i)) & 15u);
#else
  typedef __attribute__((ext_vector_type(2))) float f32x2_;
  f32x2_ a = __builtin_amdgcn_cvt_scalef32_pk_f32_fp4(w, 1.0f, 0);
  f32x2_ b = __builtin_amdgcn_cvt_scalef32_pk_f32_fp4(w, 1.0f, 1);
  f32x2_ c = __builtin_amdgcn_cvt_scalef32_pk_f32_fp4(w, 1.0f, 2);
  f32x2_ d = __builtin_amdgcn_cvt_scalef32_pk_f32_fp4(w, 1.0f, 3);
  o[0] = a.x; o[1] = a.y; o[2] = b.x; o[3] = b.y; o[4] = c.x; o[5] = c.y; o[6] = d.x; o[7] = d.y;
#endif
}
typedef __attribute__((ext_vector_type(3))) unsigned u32x3;
#ifndef FP6_INTERLEAVED
#define FP6_INTERLEAVED 1
#endif
#ifdef CPU_EMU
static inline unsigned emu_f2fp6(float f) {
  unsigned sgn = f < 0.f ? 32u : 0u; float a = fabsf(f);
  if (a >= 7.5f) return sgn | 31u;
  int e; unsigned code;
  if (a < 1.f) { int q = (int)nearbyintf(a * 8.f); code = (unsigned)q; }
  else { frexpf(a, &e); e -= 1; float m = a / ldexpf(1.f, e); int q = (int)nearbyintf((m - 1.f) * 8.f); if (q == 8) { q = 0; e += 1; } code = (unsigned)(((e + 1) << 3) | q); if (e > 2) code = 31u; }
  return sgn | code;
}
static inline float emu_fp62f(unsigned c) {
  unsigned e = (c >> 3) & 3, m = c & 7;
  float v = e == 0 ? m * 0.125f : ldexpf(1.f + m / 8.f, (int)e - 1);
  return (c & 32) ? -v : v;
}
#endif
DEV u32x3 pack16_fp6(const float* v) {
#ifdef CPU_EMU
  unsigned long long lo = 0; unsigned hi = 0;
  for (int i = 0; i < 16; ++i) {
    unsigned long long c = emu_f2fp6(v[i]); int bit = 6 * i;
    if (bit < 64) { lo |= c << bit; if (bit > 58) hi |= (unsigned)(c >> (64 - bit)); } else hi |= (unsigned)(c << (bit - 64));
  }
  u32x3 r; r.x = (unsigned)lo; r.y = (unsigned)(lo >> 32); r.z = hi; return r;
#else
  typedef __attribute__((ext_vector_type(6))) unsigned u32x6_;
  f32x16 a, b;
#if FP6_INTERLEAVED
#pragma unroll
  for (int i = 0; i < 8; ++i) { a[i] = v[2 * i]; b[i] = v[2 * i + 1]; a[8 + i] = 0.f; b[8 + i] = 0.f; }
#else
#pragma unroll
  for (int i = 0; i < 16; ++i) { a[i] = v[i]; b[i] = 0.f; }
#endif
  u32x6_ w = __builtin_amdgcn_cvt_scalef32_2xpk16_fp6_f32(a, b, 1.0f);
  u32x3 r; r.x = w[0]; r.y = w[1]; r.z = w[2]; return r;
#endif
}
DEV void unpack16_fp6(const u32x3& r, float* o) {
#ifdef CPU_EMU
  unsigned long long lo = (unsigned long long)r.x | ((unsigned long long)r.y << 32); unsigned hi = r.z;
  for (int i = 0; i < 16; ++i) {
    int bit = 6 * i; unsigned c;
    if (bit + 6 <= 64) c = (unsigned)(lo >> bit) & 63u;
    else if (bit >= 64) c = (hi >> (bit - 64)) & 63u;
    else c = ((unsigned)(lo >> bit) | (hi << (64 - bit))) & 63u;
    o[i] = emu_fp62f(c);
  }
#else
  typedef __attribute__((ext_vector_type(6))) unsigned u32x6_;
  typedef __attribute__((ext_vector_type(32))) float f32x32_;
  u32x6_ w; w[0] = r.x; w[1] = r.y; w[2] = r.z; w[3] = 0u; w[4] = 0u; w[5] = 0u;
  f32x32_ f = __builtin_amdgcn_cvt_scalef32_pk32_f32_fp6(w, 1.0f);
#pragma unroll
  for (int i = 0; i < 16; ++i) o[i] = f[i];
#endif
}
DEV void unpack2x16_fp6(const u32x3& ra, const u32x3& rb, float* oa, float* ob) {
#ifdef CPU_EMU
  unpack16_fp6(ra, oa); unpack16_fp6(rb, ob);
#else
  typedef __attribute__((ext_vector_type(6))) unsigned u32x6_;
  typedef __attribute__((ext_vector_type(32))) float f32x32_;
  u32x6_ w; w[0] = ra.x; w[1] = ra.y; w[2] = ra.z; w[3] = rb.x; w[4] = rb.y; w[5] = rb.z;
  f32x32_ f = __builtin_amdgcn_cvt_scalef32_pk32_f32_fp6(w, 1.0f);
#pragma unroll
  for (int i = 0; i < 16; ++i) { oa[i] = f[i]; ob[i] = f[16 + i]; }
#endif
}
constexpr int PEER_ROWB = 1280;
constexpr int PEER_VOFF = 768;


DEV int acc_row(int reg, int lane) { return (reg & 3) + 8 * (reg >> 2) + 4 * (lane >> 5); }

DEV int mod_row(int row) { return row < NCTX ? 2 : (row - NCTX) / SEQ; }

template <bool SYNC_EPI, class Epi, bool VEC4 = false>
DEV void gemm_tile_128(const bf16_t* __restrict__ A, int lda, int M, const bf16_t* __restrict__ Bt, int ldb, int N,
                       int K, int m0, int n0, const Epi& epi, unsigned char* smem) {
  constexpr int LS = 72;
  constexpr int STAGE = 2 * 128 * LS;
  bf16_t* sbase = (bf16_t*)smem;
  const int wave = threadIdx.x >> 6;
  const int wm = (wave >> 1) * 64, wn = (wave & 1) * 64;
  f32x16 acc[2][2];
#pragma unroll
  for (int i = 0; i < 2; ++i)
#pragma unroll
    for (int j = 0; j < 2; ++j)
#pragma unroll
      for (int r = 0; r < 16; ++r) acc[i][j][r] = 0.f;
  u32x4 ra[4], rb[4];
  auto gload = [&](int k0) {
    int tl_ = threadIdx.x; OPAQUE(tl_);
#pragma unroll
    for (int i = 0; i < 4; ++i) {
      int c = tl_ + i * 256, r = c >> 3, cc = (c & 7) * 8;
      int gr = m0 + r, gn = n0 + r;
      gr = gr < M ? gr : M - 1; gn = gn < N ? gn : N - 1;
      ra[i] = *(const u32x4*)(A + (size_t)gr * lda + k0 + cc);
      rb[i] = *(const u32x4*)(Bt + (size_t)gn * ldb + k0 + cc);
    }
  };
  auto lwrite = [&](int buf) {
    int tl_ = threadIdx.x; OPAQUE(tl_);
    bf16_t* sA = sbase + buf * STAGE;
    bf16_t* sB = sA + 128 * LS;
#pragma unroll
    for (int i = 0; i < 4; ++i) {
      int c = tl_ + i * 256, r = c >> 3, cc = (c & 7) * 8;
      *(u32x4*)(sA + r * LS + cc) = ra[i];
      *(u32x4*)(sB + r * LS + cc) = rb[i];
    }
  };
  const int nk = K >> 6;
  gload(0);
  __syncthreads();
  lwrite(0);
  if (nk > 1) gload(64);
  __syncthreads();
  for (int it = 0; it < nk; ++it) {
    int tl_ = threadIdx.x; OPAQUE(tl_);
    const int lane = tl_ & 63;
    const bf16_t* sA = sbase + (it & 1) * STAGE;
    const bf16_t* sB = sA + 128 * LS;
#pragma unroll
    for (int kk = 0; kk < 4; ++kk) {
      bf16x8 a[2], b[2];
      const int ko = kk * 16 + 8 * (lane >> 5);
#pragma unroll
      for (int i = 0; i < 2; ++i) a[i] = *(const bf16x8*)(sA + (wm + i * 32 + (lane & 31)) * LS + ko);
#pragma unroll
      for (int j = 0; j < 2; ++j) b[j] = *(const bf16x8*)(sB + (wn + j * 32 + (lane & 31)) * LS + ko);
#pragma unroll
      for (int i = 0; i < 2; ++i)
#pragma unroll
        for (int j = 0; j < 2; ++j) acc[i][j] = mfma32(a[i], b[j], acc[i][j]);
      if (kk == 1) {
        if (it + 1 < nk) lwrite((it + 1) & 1);
        if (it + 2 < nk) gload((it + 2) * 64);
      }
    }
    __syncthreads();
  }
  {
    int tl_ = threadIdx.x; OPAQUE(tl_);
    const int lane = tl_ & 63;
    if constexpr (VEC4) {
#pragma unroll
      for (int i = 0; i < 2; ++i)
#pragma unroll
        for (int j = 0; j < 2; ++j)
#pragma unroll
          for (int gq = 0; gq < 4; ++gq) {
            int row = m0 + wm + i * 32 + 8 * gq + 4 * (lane >> 5);
            int col = n0 + wn + j * 32 + (lane & 31);
            if (row < M && col < N) epi.store4(row, col, acc[i][j][4 * gq], acc[i][j][4 * gq + 1], acc[i][j][4 * gq + 2], acc[i][j][4 * gq + 3]);
          }
    } else {
#pragma unroll
      for (int i = 0; i < 2; ++i)
#pragma unroll
        for (int j = 0; j < 2; ++j)
#pragma unroll
          for (int r = 0; r < 16; ++r) {
            int row = m0 + wm + i * 32 + acc_row(r, lane);
            int col = n0 + wn + j * 32 + (lane & 31);
            if (row < M && col < N) epi(row, col, acc[i][j][r]);
          }
    }
  }
}

template <class Epi, bool VEC4 = false>
DEV void gemm_tile_128x256(const bf16_t* __restrict__ A, int lda, int M, const bf16_t* __restrict__ Bt, int ldb, int N,
                           int K, int m0, int n0, const Epi& epi, unsigned char* smem) {
  constexpr int LS = 72;
  bf16_t* sA = (bf16_t*)smem;
  bf16_t* sB = sA + 128 * LS;
  const int wave = threadIdx.x >> 6;
  const int wm = (wave >> 1) * 64, wn = (wave & 1) * 128;
  f32x16 acc[2][4];
#pragma unroll
  for (int i = 0; i < 2; ++i)
#pragma unroll
    for (int j = 0; j < 4; ++j)
#pragma unroll
      for (int r = 0; r < 16; ++r) acc[i][j][r] = 0.f;
  u32x4 ra[4], rb[8];
  {
    const int tid = threadIdx.x;
#pragma unroll
    for (int i = 0; i < 4; ++i) {
      int c = tid + i * 256, r = c >> 3, cc = (c & 7) * 8;
      { int gr = m0 + r; gr = gr < M ? gr : M - 1; ra[i] = *(const u32x4*)(A + (size_t)gr * lda + cc); }
    }
#pragma unroll
    for (int i = 0; i < 8; ++i) {
      int c = tid + i * 256, r = c >> 3, cc = (c & 7) * 8;
      { int gn = n0 + r; gn = gn < N ? gn : N - 1; rb[i] = *(const u32x4*)(Bt + (size_t)gn * ldb + cc); }
    }
  }
  for (int k0 = 0; k0 < K; k0 += 64) {
    int tl_ = threadIdx.x; OPAQUE(tl_);
    const int tid = tl_, lane = tl_ & 63;
    __syncthreads();
#pragma unroll
    for (int i = 0; i < 4; ++i) { int c = tid + i * 256, r = c >> 3, cc = (c & 7) * 8; *(u32x4*)(sA + r * LS + cc) = ra[i]; }
#pragma unroll
    for (int i = 0; i < 8; ++i) { int c = tid + i * 256, r = c >> 3, cc = (c & 7) * 8; *(u32x4*)(sB + r * LS + cc) = rb[i]; }
    __syncthreads();
    if (k0 + 64 < K) {
#pragma unroll
      for (int i = 0; i < 4; ++i) {
        int c = tid + i * 256, r = c >> 3, cc = (c & 7) * 8;
        { int gr = m0 + r; gr = gr < M ? gr : M - 1; ra[i] = *(const u32x4*)(A + (size_t)gr * lda + k0 + 64 + cc); }
      }
#pragma unroll
      for (int i = 0; i < 8; ++i) {
        int c = tid + i * 256, r = c >> 3, cc = (c & 7) * 8;
        { int gn = n0 + r; gn = gn < N ? gn : N - 1; rb[i] = *(const u32x4*)(Bt + (size_t)gn * ldb + k0 + 64 + cc); }
      }
    }
#pragma unroll 2
    for (int kk = 0; kk < 4; ++kk) {
      bf16x8 a[2], b[4];
      const int ko = kk * 16 + 8 * (lane >> 5);
#pragma unroll
      for (int i = 0; i < 2; ++i) a[i] = *(const bf16x8*)(sA + (wm + i * 32 + (lane & 31)) * LS + ko);
#pragma unroll
      for (int j = 0; j < 4; ++j) b[j] = *(const bf16x8*)(sB + (wn + j * 32 + (lane & 31)) * LS + ko);
#pragma unroll
      for (int i = 0; i < 2; ++i)
#pragma unroll
        for (int j = 0; j < 4; ++j) acc[i][j] = mfma32(a[i], b[j], acc[i][j]);
    }
  }
  {
    int tl_ = threadIdx.x; OPAQUE(tl_);
    const int lane = tl_ & 63;
    if constexpr (VEC4) {
#pragma unroll
      for (int i = 0; i < 2; ++i)
#pragma unroll
        for (int j = 0; j < 4; ++j)
#pragma unroll
          for (int gq = 0; gq < 4; ++gq) {
            int row = m0 + wm + i * 32 + 8 * gq + 4 * (lane >> 5);
            int col = n0 + wn + j * 32 + (lane & 31);
            if (row < M && col < N) epi.store4(row, col, acc[i][j][4 * gq], acc[i][j][4 * gq + 1], acc[i][j][4 * gq + 2], acc[i][j][4 * gq + 3]);
          }
    } else {
#pragma unroll
      for (int i = 0; i < 2; ++i)
#pragma unroll
        for (int j = 0; j < 4; ++j)
#pragma unroll
          for (int r = 0; r < 16; ++r) {
            int row = m0 + wm + i * 32 + acc_row(r, lane);
            int col = n0 + wn + j * 32 + (lane & 31);
            if (row < M && col < N) epi(row, col, acc[i][j][r]);
          }
    }
  }
}

DEV void transpose_tile(const float* __restrict__ src, int ld_src, bf16_t* __restrict__ dst, int ld_dst, int K, int N,
                        int tk, int tn, unsigned char* smem) {
  float* sT = (float*)smem;
  const int tid = threadIdx.x;
  __syncthreads();
  {
    const int tx = tid & 15, ty = tid >> 4;
#pragma unroll
    for (int p = 0; p < 4; ++p) {
      int k = tk * 64 + ty + p * 16, n = tn * 64 + tx * 4;
      f32x4 v4 = {0.f, 0.f, 0.f, 0.f};
      if (k < K && n < N) v4 = *(const f32x4*)(src + (size_t)k * ld_src + n);
      float* d = sT + (ty + p * 16) * 65 + tx * 4;
      d[0] = v4.x; d[1] = v4.y; d[2] = v4.z; d[3] = v4.w;
    }
  }
  __syncthreads();
  {
    const int n = tid >> 2, kseg = (tid & 3) * 16;
    int gn = tn * 64 + n;
    if (gn < N) {
      float v[16];
#pragma unroll
      for (int j = 0; j < 16; ++j) v[j] = sT[(kseg + j) * 65 + n];
      bf16_t* d = dst + (size_t)gn * ld_dst + tk * 64 + kseg;
      *(u32x4*)d = pack8(v);
      *(u32x4*)(d + 8) = pack8(v + 8);
    }
  }
}

constexpr int TJ0 = 16 * 49, TJ1 = 16 * 16, TJ2 = 16 * 44, TJ3 = 16 * 16, TJ4 = 2 * 16 * 32, TJ5 = 2 * 8, TJ6 = 2 * 8,
              TJ7 = 2 * 8, TJ8 = 32;
constexpr int NTRANS = TJ0 + TJ1 + TJ2 + TJ3 + TJ4 + TJ5 + TJ6 + TJ7 + TJ8;
constexpr int NKEYCV = (2 * 8 * 2 * 128 * 128) / (256 * 8);
constexpr int NMODV = 2 * 96;
constexpr int NPREP = NTRANS + NKEYCV + NMODV;

DEV void st_prep(const Params& P, int item, unsigned char* smem) {
  unsigned char* ws = P.ws;
  if (item < NTRANS) {
    int t = item;
    if (t < TJ0) { transpose_tile(P.in[I_EVWIN], EVC, (bf16_t*)(ws + OFF_WEVIN), 1024, 1024, EVC, t / 49, t % 49, smem); return; }
    t -= TJ0;
    if (t < TJ1) { transpose_tile(P.in[I_EVWOUT], 1024, (bf16_t*)(ws + OFF_WEVOUT), 1024, 1024, 1024, t / 16, t % 16, smem); return; }
    t -= TJ1;
    if (t < TJ2) { transpose_tile(P.in[I_ODWIN], ODC, (bf16_t*)(ws + OFF_WODIN), 1024, 1024, ODC, t / 44, t % 44, smem); return; }
    t -= TJ2;
    if (t < TJ3) { transpose_tile(P.in[I_ODWOUT], 1024, (bf16_t*)(ws + OFF_WODOUT), 1024, 1024, 1024, t / 16, t % 16, smem); return; }
    t -= TJ3;
    if (t < TJ4) {
      int l = t / 512, tt = t % 512;
      transpose_tile(P.in[I_WQ] + (size_t)l * 1024 * 2048, 2048, (bf16_t*)(ws + OFF_WQ) + (size_t)l * 2048 * 1024, 1024, 1024, 2048, tt / 32, tt % 32, smem);
      return;
    }
    t -= TJ4;
    if (t < TJ5) { int d = t / 8; transpose_tile(P.in[I_WUP] + d * 64 * 512, 512, (bf16_t*)(ws + OFF_WUP) + d * 512 * 64, 64, 64, 512, 0, t % 8, smem); return; }
    t -= TJ5;
    if (t < TJ6) { int d = t / 8; transpose_tile(P.in[I_AUP] + d * 64 * 512, 512, (bf16_t*)(ws + OFF_AUP) + d * 512 * 64, 64, 64, 512, 0, t % 8, smem); return; }
    t -= TJ6;
    if (t < TJ7) { transpose_tile(P.in[I_GUP], 512, (bf16_t*)(ws + OFF_GUP), 128, 128, 512, t / 8, t % 8, smem); return; }
    t -= TJ7;
    {
      int which = t & 1, db = t >> 1;
      const float* src = (which ? P.in[I_WI] : P.in[I_WA]) + (size_t)db * 64 * 64;
      transpose_tile(src, 64, (bf16_t*)(ws + OFF_LRUT) + (size_t)db * 128 * 64 + which * 64 * 64, 64, 64, 64, 0, 0, smem);
      return;
    }
  }
  item -= NTRANS;
  if (item < NKEYCV) {
    size_t e = ((size_t)item * 256 + threadIdx.x) * 8;
    const float* s = P.in[I_KEYS] + e;
    f32x4 a = *(const f32x4*)s, b = *(const f32x4*)(s + 4);
    float v[8] = {a.x, a.y, a.z, a.w, b.x, b.y, b.z, b.w};
    *(u32x4*)((bf16_t*)(ws + OFF_KEYS) + e) = pack8(v);
    return;
  }
  item -= NKEYCV;
  {
    const int l = item / 96, cgp = item % 96;
    float* sS = (float*)smem;
    float* sRed = sS + 3 * 1024;
    const int tid = threadIdx.x;
    __syncthreads();
    for (int i = tid; i < 3 * 1024; i += 256) {
      int m = i >> 10, k = i & 1023;
      float c = m < 2 ? P.in[I_C][m * 1024 + k] : P.in[I_CCTX][k];
      sS[i] = siluf_(c);
    }
    __syncthreads();
    const int ks = tid >> 6, col = cgp * 64 + (tid & 63);
    const float* w = P.in[I_MODW] + (size_t)l * 1024 * 6144 + col;
    float a0 = 0.f, a1 = 0.f, a2 = 0.f;
    for (int k = ks * 256; k < ks * 256 + 256; ++k) {
      float wv = w[(size_t)k * 6144];
      a0 += sS[k] * wv; a1 += sS[1024 + k] * wv; a2 += sS[2048 + k] * wv;
    }
    sRed[(ks * 3 + 0) * 64 + (tid & 63)] = a0;
    sRed[(ks * 3 + 1) * 64 + (tid & 63)] = a1;
    sRed[(ks * 3 + 2) * 64 + (tid & 63)] = a2;
    __syncthreads();
    if (tid < 192) {
      int m = tid >> 6, c = tid & 63;
      float s = sRed[(0 * 3 + m) * 64 + c] + sRed[(1 * 3 + m) * 64 + c] + sRed[(2 * 3 + m) * 64 + c] + sRed[(3 * 3 + m) * 64 + c];
      int cc = cgp * 64 + c;
      ((float*)(ws + OFF_MODV))[((size_t)l * 3 + m) * 6144 + cc] = s + P.in[I_MODB][l * 6144 + cc];
    }
  }
}

constexpr int NPCONV = 2 * (NEXP * 1024 / (256 * 16));
DEV void st_peer_conv(const Params& P, int layer, int item) {
  const int half = NPCONV / 2;
  int which = item >= half;
  int it = which ? item - half : item;
  size_t e = ((size_t)it * 256 + threadIdx.x) * 16;
  const float* s = (which ? P.in[I_PV] : P.in[I_PU]) + (size_t)layer * NEXP * 1024 + e;
  const float sc = which ? PEER_VSCALE : PEER_USCALE;
  float v16[16];
#pragma unroll
  for (int q = 0; q < 4; ++q) {
    f32x4 a = *(const f32x4*)(s + 4 * q);
    v16[4 * q] = a.x * sc; v16[4 * q + 1] = a.y * sc; v16[4 * q + 2] = a.z * sc; v16[4 * q + 3] = a.w * sc;
  }
  const size_t ex = e >> 10, col = e & 1023;
  if (which) {
    u32x2 o; o.x = pack8_fp4(v16); o.y = pack8_fp4(v16 + 8);
    *(u32x2*)(P.ws + OFF_PU + ex * PEER_ROWB + PEER_VOFF + (col >> 1)) = o;
  } else {
    u32x3 o = pack16_fp6(v16);
    unsigned* dp = (unsigned*)(P.ws + OFF_PU + ex * PEER_ROWB + (col >> 4) * 12);
    dp[0] = o.x; dp[1] = o.y; dp[2] = o.z;
  }
}

DEV void st_normmod(const Params& P, int layer, int which, int row) {
  const int lane = threadIdx.x & 63;
  const float* src;
  if (which == 0 && layer == 0) src = row < NCTX ? P.in[I_CTX] + (size_t)row * 1024 : P.in[I_X] + (size_t)(row - NCTX) * 1024;
  else src = row < NCTX ? (const float*)(P.ws + OFF_CTXRES) + (size_t)row * 1024 : P.out + (size_t)(row - NCTX) * 1024;
  const float* mv = (const float*)(P.ws + OFF_MODV) + ((size_t)layer * 3 + mod_row(row)) * 6144;
  const float* sh = mv + (which ? 3 : 0) * 1024;
  const float* sc = mv + (which ? 4 : 1) * 1024;
  const float* nw = (which ? P.in[I_NORM2] : P.in[I_NORM1]) + layer * 1024;
  f32x4 v[4];
  float ss = 0.f;
#pragma unroll
  for (int i = 0; i < 4; ++i) {
    v[i] = *(const f32x4*)(src + i * 256 + lane * 4);
    ss += v[i].x * v[i].x + v[i].y * v[i].y + v[i].z * v[i].z + v[i].w * v[i].w;
  }
  ss = wave_sum(ss);
  const float rstd = frsq(ss * (1.f / 1024.f) + 1e-6f);
  bf16_t* dst = (bf16_t*)(P.ws + OFF_HBUF) + (size_t)row * 1024;
#pragma unroll
  for (int i = 0; i < 4; ++i) {
    int c = i * 256 + lane * 4;
    f32x4 w4 = *(const f32x4*)(nw + c), s4 = *(const f32x4*)(sc + c), h4 = *(const f32x4*)(sh + c);
    float o0 = v[i].x * rstd * w4.x * (1.f + s4.x) + h4.x;
    float o1 = v[i].y * rstd * w4.y * (1.f + s4.y) + h4.y;
    float o2 = v[i].z * rstd * w4.z * (1.f + s4.z) + h4.z;
    float o3 = v[i].w * rstd * w4.w * (1.f + s4.w) + h4.w;
    u32x2 pk; pk.x = pack2(o0, o1); pk.y = pack2(o2, o3);
    *(u32x2*)(dst + c) = pk;
  }
}

struct EpiProjL0 {
  bf16_t* proj; float* gates;
  DEVM void operator()(int row, int col, float v) const {
    proj[(size_t)row * EVC + col] = f2bf(v);
    if (col >= 1536 && col < 1552) gates[row * 32 + (col - 1536)] = v;
    else if (col >= 3088) gates[row * 32 + 16 + (col - 3088)] = v;
  }
};
struct EpiStoreBf {
  bf16_t* dst; int ld;
  DEVM void operator()(int row, int col, float v) const { dst[(size_t)row * ld + col] = f2bf(v); }
};
struct EpiStoreBfBias {
  bf16_t* dst; int ld; const float* bias;
  DEVM void operator()(int row, int col, float v) const { dst[(size_t)row * ld + col] = f2bf(v + (bias ? bias[col] : 0.f)); }
};
struct EpiProjL0T {
  bf16_t* proj; float* gates;
  DEVM void operator()(int, int, float) const {}
  DEVM void store4(int n, int m, float v0, float v1, float v2, float v3) const {
    u32x2 pk; pk.x = pack2(v0, v1); pk.y = pack2(v2, v3);
    *(u32x2*)(proj + (size_t)m * EVC + n) = pk;
    if (n >= 1536 && n < 1552) { f32x4 g = {v0, v1, v2, v3}; *(f32x4*)(gates + m * 32 + (n - 1536)) = g; }
    else if (n >= 3088) { f32x4 g = {v0, v1, v2, v3}; *(f32x4*)(gates + m * 32 + 16 + (n - 3088)) = g; }
  }
};
struct EpiStoreBfT {
  bf16_t* dst; int ld;
  DEVM void operator()(int, int, float) const {}
  DEVM void store4(int n, int m, float v0, float v1, float v2, float v3) const {
    u32x2 pk; pk.x = pack2(v0, v1); pk.y = pack2(v2, v3);
    *(u32x2*)(dst + (size_t)m * ld + n) = pk;
  }
};
struct EpiOutProjT {
  const float* x_lat; const float* x_ctx; float* o_lat; float* o_ctx; const float* modv;
  DEVM void operator()(int, int, float) const {}
  DEVM void store4(int n, int m, float v0, float v1, float v2, float v3) const {
    const f32x4 g = *(const f32x4*)(modv + mod_row(m) * 6144 + 2 * 1024 + n);
    const float* xs; float* od;
    if (m < NCTX) { xs = x_ctx + (size_t)m * 1024 + n; od = o_ctx + (size_t)m * 1024 + n; }
    else { size_t o = (size_t)(m - NCTX) * 1024 + n; xs = x_lat + o; od = o_lat + o; }
    const f32x4 x = *(const f32x4*)xs;
    f32x4 r = {x.x + g.x * v0, x.y + g.y * v1, x.z + g.z * v2, x.w + g.w * v3};
    *(f32x4*)od = r;
  }
};
struct EpiStoreBfBiasT {
  bf16_t* dst; int ld; const float* bias;
  DEVM void operator()(int, int, float) const {}
  DEVM void store4(int n, int m, float v0, float v1, float v2, float v3) const {
    if (bias) { v0 += bias[n]; v1 += bias[n + 1]; v2 += bias[n + 2]; v3 += bias[n + 3]; }
    u32x2 pk; pk.x = pack2(v0, v1); pk.y = pack2(v2, v3);
    *(u32x2*)(dst + (size_t)m * ld + n) = pk;
  }
};
struct EpiOutProj {
  const float* x_lat; const float* x_ctx; float* o_lat; float* o_ctx; const float* modv;
  DEVM void operator()(int row, int col, float v) const {
    float g = modv[mod_row(row) * 6144 + 2 * 1024 + col];
    if (row < NCTX) o_ctx[(size_t)row * 1024 + col] = x_ctx[(size_t)row * 1024 + col] + g * v;
    else { size_t o = (size_t)(row - NCTX) * 1024 + col; o_lat[o] = x_lat[o] + g * v; }
  }
};
struct EpiScoreLds {
  float* sS; int m0;
  DEVM void operator()(int row, int col, float v) const { sS[(row - m0) * 129 + col] = v; }
};

DEV void st_xbc_conv(const Params& P, int row) {
  const int lane = threadIdx.x & 63;
  const bf16_t* proj = (const bf16_t*)(P.ws + OFF_PROJ);
  bf16_t* xc = (bf16_t*)P.out + (size_t)row * 1024;
  int row0, len, pos;
  if (row < NCTX) { row0 = (row / CTXL) * CTXL; len = CTXL; pos = row - row0; }
  else { int r = row - NCTX; row0 = NCTX + (r / SEQ) * SEQ; len = SEQ; pos = r % SEQ; }
  const float* cw = P.in[I_SCONVW];
  const float* cb = P.in[I_SCONVB];
#pragma unroll
  for (int hh = 0; hh < 2; ++hh) {
    const int ch = hh * 512 + lane * 8;
    float o[8];
#pragma unroll
    for (int j = 0; j < 8; ++j) o[j] = cb[ch + j];
#pragma unroll
    for (int tap = 0; tap < 4; ++tap) {
      int pp = pos + tap - 2;
      if (pp >= 0 && pp < len) {
        float x[8];
        unpack8(*(const u32x4*)(proj + (size_t)(row0 + pp) * EVC + 2064 + ch), x);
        f32x4 w0 = *(const f32x4*)(cw + tap * 1024 + ch), w1 = *(const f32x4*)(cw + tap * 1024 + ch + 4);
        o[0] += w0.x * x[0]; o[1] += w0.y * x[1]; o[2] += w0.z * x[2]; o[3] += w0.w * x[3];
        o[4] += w1.x * x[4]; o[5] += w1.y * x[5]; o[6] += w1.z * x[6]; o[7] += w1.w * x[7];
      }
    }
#pragma unroll
    for (int j = 0; j < 8; ++j) o[j] = siluf_(o[j]);
    *(u32x4*)(xc + ch) = pack8(o);
  }
}

#ifndef LA_NSEG
#define LA_NSEG 10
#endif
constexpr int LA_NCH = (CTXL + SEQ) / 64;
constexpr int LA_CPS = LA_NCH / LA_NSEG;
static_assert(LA_NCH % LA_NSEG == 0, "linattn segments");
#ifdef CPU_EMU
constexpr size_t OFF_LASEG = OFF_PR + PR_BYTES;
#else
constexpr size_t OFF_LASEG = OFF_R2L0 + (size_t)NTOK * 1024 * 2;
#endif
constexpr size_t LASEG_U = (size_t)48 * LA_NSEG * 8192 * 4;
constexpr size_t OFF_LASEG_N = OFF_LASEG + LASEG_U;
constexpr size_t OFF_LASEG_D = OFF_LASEG_N + (size_t)48 * LA_NSEG * 64 * 4;
#ifndef CPU_EMU
static_assert(OFF_LASEG_D + 48 * LA_NSEG * 4 <= OFF_PR + PR_BYTES, "laseg");
#endif

struct LaRaw { u32x4 q[2], k[4], x[4]; float g0, g1; };

template <bool MLSTM, bool FULL>
DEV void la_load_raw(const Params& P, int b, int h, int d, int cc, LaRaw& R) {
  constexpr int NC_CTX = CTXL / 64;
  const int tid = threadIdx.x;
  const int seg = cc >= NC_CTX;
  const int row0 = seg ? NCTX + b * SEQ : b * CTXL;
  const int len = seg ? SEQ : CTXL;
  const int cl = (seg ? cc - NC_CTX : cc) * 64;
  const bf16_t* proj = (const bf16_t*)(P.ws + OFF_PROJ);
  const bf16_t* xcv = (const bf16_t*)P.out;
  const float* gates = (const float*)(P.ws + OFF_GATES);
  if (tid < 64) {
    int p = cl + tid, grow = row0 + (d ? len - 1 - p : p);
    if (MLSTM) { R.g0 = gates[grow * 32 + d * 4 + h]; R.g1 = gates[grow * 32 + 8 + d * 4 + h]; }
    else { R.g0 = gates[grow * 32 + 16 + d * 8 + h]; R.g1 = 0.f; }
  }
  if (MLSTM) {
#pragma unroll
    for (int i = 0; i < 2; ++i) {
      int c = tid + i * 256, r = c >> 3, cc8 = (c & 7) * 8;
      int p = cl + r, pos = d ? len - 1 - p : p;
      const bf16_t* rp = proj + (size_t)(row0 + pos) * EVC;
      if (FULL) R.q[i] = *(const u32x4*)(rp + h * 64 + cc8);
      R.k[i] = *(const u32x4*)(rp + 256 + h * 64 + cc8);
    }
#pragma unroll
    for (int i = 0; i < 4; ++i) {
      int c = tid + i * 256, r = c >> 4, cc8 = (c & 15) * 8;
      int p = cl + r, pos = d ? len - 1 - p : p;
      R.x[i] = *(const u32x4*)(proj + (size_t)(row0 + pos) * EVC + 512 + h * 128 + cc8);
    }
  } else {
    const int grp = h >> 2;
#pragma unroll
    for (int i = 0; i < 2; ++i) {
      int c = tid + i * 256, r = c >> 3, cc8 = (c & 7) * 8;
      int p = cl + r, pos = d ? len - 1 - p : p;
      R.x[i] = *(const u32x4*)(xcv + (size_t)(row0 + pos) * 1024 + h * 64 + cc8);
    }
#pragma unroll
    for (int i = 0; i < 4; ++i) {
      int c = tid + i * 256, r = c >> 4, cc8 = (c & 15) * 8;
      int p = cl + r, pos = d ? len - 1 - p : p;
      const bf16_t* rp = xcv + (size_t)(row0 + pos) * 1024;
      R.k[i] = *(const u32x4*)(rp + 512 + grp * 128 + cc8);
      if (FULL) { if (i < 2) R.q[i] = *(const u32x4*)(rp + 768 + grp * 128 + cc8); else R.x[i] = *(const u32x4*)(rp + 768 + grp * 128 + cc8); }
    }
  }
}

template <bool MLSTM, bool FULL>
DEV void st_linattn_seg(const Params& P, int sid, int seg, unsigned char* smem) {
  constexpr int DK = MLSTM ? 64 : 128, DX = MLSTM ? 128 : 64;
  constexpr int QS = DK + 8;
  constexpr int NH = MLSTM ? 4 : 8;
  constexpr int NC_CTX = CTXL / 64;
  const int tid = threadIdx.x, lane = tid & 63, wave = tid >> 6;
  const int d = sid & 1, h = (sid >> 1) % NH, b = (sid >> 1) / NH;
  const int gsid = MLSTM ? sid : 16 + sid;
  bf16_t* sQ = (bf16_t*)smem;
  bf16_t* sK = sQ + 64 * QS;
  bf16_t* sP = sK;
  bf16_t* sKT = sK + 64 * QS;
  bf16_t* sXT = sKT + DK * 72;
  bf16_t* sST = sXT + DX * 72;
  float* sF = (float*)(sST + DX * QS);
  float* sLa = sF;
  float* sG = sF + 64;
  float* sBc = sF + 128;
  float* sDen = sF + 192;
  float* sN = sF + 256;
  int* sRow = (int*)(sF + 384);
  static_assert((64 * QS * 2 + DK * 72 + DX * 72 + DX * QS) * 2 + 448 * 4 <= SMEM_BYTES, "lds");
  bf16_t* outb = MLSTM ? (bf16_t*)(P.ws + OFF_HBUF) : (bf16_t*)(P.ws + OFF_R2L0);
  float* segU = (float*)(P.ws + OFF_LASEG);
  float* segN = (float*)(P.ws + OFF_LASEG_N);
  float* segD = (float*)(P.ws + OFF_LASEG_D);

  f32x16 accS[2];
#pragma unroll
  for (int j = 0; j < 2; ++j)
#pragma unroll
    for (int r = 0; r < 16; ++r) accS[j][r] = 0.f;
  const int sx0 = MLSTM ? wave * 32 : (wave >> 1) * 32;
  const int sk0 = MLSTM ? 0 : (wave & 1) * 64;
  float nreg = 0.f;
  float gb0 = 0.f, gb1 = 0.f, alog_e = 0.f, dskip = 0.f;
  if (MLSTM) { gb0 = P.in[I_IBIAS][d * 4 + h]; gb1 = P.in[I_FBIAS][d * 4 + h]; }
  else { gb0 = P.in[I_DTBIAS][d * 8 + h]; alog_e = fexp(P.in[I_ALOG][d * 8 + h]); dskip = P.in[I_DSKIP][h]; }

  const int cc0 = seg * LA_CPS, cc1 = cc0 + LA_CPS;
  LaRaw R;
  la_load_raw<MLSTM, FULL>(P, b, h, d, cc0, R);
  __syncthreads();
  if (FULL) {
    for (int js = 0; js < seg; ++js) {
      const size_t it = (size_t)gsid * LA_NSEG + js;
      const float a = fexp(segD[it]);
      const float* U = segU + it * 8192;
#pragma unroll
      for (int j = 0; j < 2; ++j)
#pragma unroll
        for (int r = 0; r < 16; ++r) accS[j][r] = a * accS[j][r] + U[(j * 16 + r) * 256 + tid];
      if (MLSTM && tid < 64) nreg = a * nreg + segN[it * 64 + tid];
    }
#pragma unroll
    for (int j = 0; j < 2; ++j)
#pragma unroll
      for (int r = 0; r < 16; ++r) sST[(sx0 + acc_row(r, lane)) * QS + sk0 + j * 32 + (lane & 31)] = f2bf(accS[j][r]);
    if (tid < 128) sN[tid] = (MLSTM && tid < 64) ? nreg : 0.f;
  }
  float lsum = 0.f;

  for (int cc = cc0; cc < cc1; ++cc) {
    int tl_ = threadIdx.x; OPAQUE(tl_);
    const int tid = tl_, lane = tl_ & 63;
    const int sgi = cc >= NC_CTX;
    const int row0 = sgi ? NCTX + b * SEQ : b * CTXL;
    const int len = sgi ? SEQ : CTXL;
    const int cl = (sgi ? cc - NC_CTX : cc) * 64;
    if (tid < 64) {
      int p = cl + tid;
      sRow[tid] = row0 + (d ? len - 1 - p : p);
      if (MLSTM) { sLa[tid] = -softplusf_(-(R.g1 + gb1)); sG[tid] = fexp(R.g0 + gb0); }
      else { float dt = softplusf_(R.g0 + gb0); sLa[tid] = -dt * alog_e; sG[tid] = dt; }
    }
    __syncthreads();
    if (wave == 0) {
      float v = sLa[lane];
#pragma unroll
      for (int off = 1; off < 64; off <<= 1) {
#ifdef CPU_EMU
        float o = emu_shfl_up(v, off);
#else
        float o = __shfl_up(v, off, 64);
#endif
        if (lane >= off) v += o;
      }
      sBc[lane] = v;
    }
    __syncthreads();
    const float blast = sBc[63];
    lsum += blast;
    if (MLSTM) {
#pragma unroll
      for (int i = 0; i < 2; ++i) {
        int c = tid + i * 256, r = c >> 3, cc8 = (c & 7) * 8;
        float kf[8]; unpack8(R.k[i], kf);
        const float wgt = fexp(blast - sBc[r]) * sG[r];
#pragma unroll
        for (int j = 0; j < 8; ++j) sKT[(cc8 + j) * 72 + r] = f2bf(kf[j] * wgt);
        if (FULL) {
          float qf[8]; unpack8(R.q[i], qf);
#pragma unroll
          for (int j = 0; j < 8; ++j) qf[j] *= 0.125f;
          *(u32x4*)(sQ + r * QS + cc8) = pack8(qf);
          *(u32x4*)(sK + r * QS + cc8) = R.k[i];
        }
      }
#pragma unroll
      for (int i = 0; i < 4; ++i) {
        int c = tid + i * 256, r = c >> 4, cc8 = (c & 15) * 8;
        const bf16_t* xs = (const bf16_t*)&R.x[i];
#pragma unroll
        for (int j = 0; j < 8; ++j) sXT[(cc8 + j) * 72 + r] = xs[j];
      }
    } else {
#pragma unroll
      for (int i = 0; i < 2; ++i) {
        int c = tid + i * 256, r = c >> 3, cc8 = (c & 7) * 8;
        const bf16_t* xs = (const bf16_t*)&R.x[i];
#pragma unroll
        for (int j = 0; j < 8; ++j) sXT[(cc8 + j) * 72 + r] = xs[j];
      }
#pragma unroll
      for (int i = 0; i < 4; ++i) {
        int c = tid + i * 256, r = c >> 4, cc8 = (c & 15) * 8;
        float kf[8]; unpack8(R.k[i], kf);
        const float wgt = fexp(blast - sBc[r]) * sG[r];
#pragma unroll
        for (int j = 0; j < 8; ++j) sKT[(cc8 + j) * 72 + r] = f2bf(kf[j] * wgt);
        if (FULL) {
          *(u32x4*)(sK + r * QS + cc8) = R.k[i];
          *(u32x4*)(sQ + r * QS + cc8) = i < 2 ? R.q[i] : R.x[i];
        }
      }
    }
    if (cc + 1 < cc1) la_load_raw<MLSTM, FULL>(P, b, h, d, cc + 1, R);
    __syncthreads();
    if (FULL) {
      const int tr = (wave >> 1) * 32, tc = (wave & 1) * 32;
      f32x16 accP;
#pragma unroll
      for (int r = 0; r < 16; ++r) accP[r] = 0.f;
      if (!(tr == 0 && tc == 32)) {
#pragma unroll
        for (int kk = 0; kk < DK / 16; ++kk) {
          const int ko = kk * 16 + 8 * (lane >> 5);
          bf16x8 a = *(const bf16x8*)(sQ + (tr + (lane & 31)) * QS + ko);
          bf16x8 bb = *(const bf16x8*)(sK + (tc + (lane & 31)) * QS + ko);
          accP = mfma32(a, bb, accP);
        }
      }
      __syncthreads();
      {
        const int s = tc + (lane & 31);
        const float bs = sBc[s], gs = sG[s];
#pragma unroll
        for (int r = 0; r < 16; ++r) {
          int t = tr + acc_row(r, lane);
          float v = (s <= t) ? accP[r] * fexp(sBc[t] - bs) * gs : 0.f;
          sP[t * 72 + s] = f2bf(v);
        }
        {
          const int t = tid >> 2, kq = (tid & 3) * (DK / 4);
          const float et = fexp(sBc[t]);
#pragma unroll
          for (int c8 = 0; c8 < DK / 4; c8 += 8) {
            float qf[8];
            unpack8(*(const u32x4*)(sQ + t * QS + kq + c8), qf);
#pragma unroll
            for (int j = 0; j < 8; ++j) qf[j] *= et;
            *(u32x4*)(sQ + t * QS + kq + c8) = pack8(qf);
          }
        }
      }
      __syncthreads();
      constexpr int NYT = MLSTM ? 2 : 1;
      const int yx0 = MLSTM ? wave * 32 : (wave >> 1) * 32;
      const int yt0 = MLSTM ? 0 : (wave & 1) * 32;
      f32x16 accY[NYT];
#pragma unroll
      for (int j = 0; j < NYT; ++j)
#pragma unroll
        for (int r = 0; r < 16; ++r) accY[j][r] = 0.f;
#pragma unroll
      for (int kk = 0; kk < 4; ++kk) {
        const int ko = kk * 16 + 8 * (lane >> 5);
        bf16x8 a = *(const bf16x8*)(sXT + (yx0 + (lane & 31)) * 72 + ko);
#pragma unroll
        for (int j = 0; j < NYT; ++j) {
          bf16x8 bb = *(const bf16x8*)(sP + (yt0 + j * 32 + (lane & 31)) * 72 + ko);
          accY[j] = mfma32(a, bb, accY[j]);
        }
      }
#pragma unroll
      for (int kk = 0; kk < DK / 16; ++kk) {
        const int ko = kk * 16 + 8 * (lane >> 5);
        bf16x8 a = *(const bf16x8*)(sST + (yx0 + (lane & 31)) * QS + ko);
#pragma unroll
        for (int j = 0; j < NYT; ++j) {
          bf16x8 bb = *(const bf16x8*)(sQ + (yt0 + j * 32 + (lane & 31)) * QS + ko);
          accY[j] = mfma32(a, bb, accY[j]);
        }
      }
      if (MLSTM) {
        if (tid < 64) {
          float den = 0.f, dq = 0.f;
#pragma unroll 8
          for (int s = 0; s < 64; ++s) den += bf2f(sP[tid * 72 + s]);
#pragma unroll 8
          for (int k = 0; k < DK; ++k) dq += sN[k] * bf2f(sQ[tid * QS + k]);
          sDen[tid] = den + dq;
        }
        __syncthreads();
      }
#pragma unroll
      for (int j = 0; j < NYT; ++j) {
        const int t = yt0 + j * 32 + (lane & 31);
        const size_t obase = (size_t)sRow[t] * 1024 + d * 512 + h * DX;
        const float dinv = MLSTM ? frcp(fmaxf(fabsf(sDen[t]), 1.f)) : 1.f;
#pragma unroll
        for (int g = 0; g < 4; ++g) {
          const int x0 = yx0 + 8 * g + 4 * (lane >> 5);
          float v0 = accY[j][4 * g], v1 = accY[j][4 * g + 1], v2 = accY[j][4 * g + 2], v3 = accY[j][4 * g + 3];
          if (MLSTM) { v0 *= dinv; v1 *= dinv; v2 *= dinv; v3 *= dinv; }
          else if (d == 0) {
            v0 += dskip * bf2f(sXT[(x0 + 0) * 72 + t]); v1 += dskip * bf2f(sXT[(x0 + 1) * 72 + t]);
            v2 += dskip * bf2f(sXT[(x0 + 2) * 72 + t]); v3 += dskip * bf2f(sXT[(x0 + 3) * 72 + t]);
          }
          u32x2 pk; pk.x = pack2(v0, v1); pk.y = pack2(v2, v3);
          *(u32x2*)(outb + obase + x0) = pk;
        }
      }
      __syncthreads();
    }
    {
      const float eb = fexp(blast);
#pragma unroll
      for (int j = 0; j < 2; ++j)
#pragma unroll
        for (int r = 0; r < 16; ++r) accS[j][r] *= eb;
#pragma unroll
      for (int kk = 0; kk < 4; ++kk) {
        const int ko = kk * 16 + 8 * (lane >> 5);
        bf16x8 a = *(const bf16x8*)(sXT + (sx0 + (lane & 31)) * 72 + ko);
#pragma unroll
        for (int j = 0; j < 2; ++j) {
          bf16x8 bb = *(const bf16x8*)(sKT + (sk0 + j * 32 + (lane & 31)) * 72 + ko);
          accS[j] = mfma32(a, bb, accS[j]);
        }
      }
      if (FULL) {
#pragma unroll
        for (int j = 0; j < 2; ++j)
#pragma unroll
          for (int r = 0; r < 16; ++r) sST[(sx0 + acc_row(r, lane)) * QS + sk0 + j * 32 + (lane & 31)] = f2bf(accS[j][r]);
      }
      if (MLSTM && tid < 64) {
        float nn = nreg * eb;
        for (int s = 0; s < 64; ++s) nn += bf2f(sKT[tid * 72 + s]);
        nreg = nn;
        if (FULL) sN[tid] = nn;
      }
    }
    __syncthreads();
  }
  if (!FULL) {
    const size_t it = (size_t)gsid * LA_NSEG + seg;
    float* U = segU + it * 8192;
#pragma unroll
    for (int j = 0; j < 2; ++j)
#pragma unroll
      for (int r = 0; r < 16; ++r) U[(j * 16 + r) * 256 + tid] = accS[j][r];
    if (MLSTM && tid < 64) segN[it * 64 + tid] = nreg;
    if (tid == 0) segD[it] = lsum;
  }
}

DEV void st_finish_l0(const Params& P, int row) {
  const int lane = threadIdx.x & 63;
  bf16_t* hb = (bf16_t*)(P.ws + OFF_HBUF) + (size_t)row * 1024;
  const bf16_t* yb = (const bf16_t*)(P.ws + OFF_R2L0) + (size_t)row * 1024;
  const bf16_t* pr = (const bf16_t*)(P.ws + OFF_PROJ) + (size_t)row * EVC;
  const int ch = lane * 8;
  float h0[8], h1[8], o[8], f1[8];
  unpack8(*(const u32x4*)(hb + ch), h0);
  unpack8(*(const u32x4*)(hb + 512 + ch), h1);
  unpack8(*(const u32x4*)(pr + 1024 + ch), o);
  float ss = 0.f;
#pragma unroll
  for (int j = 0; j < 8; ++j) { h0[j] += h1[j]; ss += h0[j] * h0[j]; }
  ss += wshfl_xor(ss, 1); ss += wshfl_xor(ss, 2); ss += wshfl_xor(ss, 4); ss += wshfl_xor(ss, 8);
  float rstd = frsq(ss * (1.f / 128.f) + 1e-6f);
  float pw[8]; ld8(P.in[I_MNORM] + ch, pw);
#pragma unroll
  for (int j = 0; j < 8; ++j) f1[j] = h0[j] * rstd * pw[j] * sigmoidf_(o[j]);
  float y0[8], y1[8], z[8], f2[8];
  unpack8(*(const u32x4*)(yb + ch), y0);
  unpack8(*(const u32x4*)(yb + 512 + ch), y1);
  unpack8(*(const u32x4*)(pr + 1552 + ch), z);
  float s2 = 0.f;
#pragma unroll
  for (int j = 0; j < 8; ++j) { y0[j] = (y0[j] + y1[j]) * siluf_(z[j]); s2 += y0[j] * y0[j]; }
  s2 = wave_sum(s2);
  float rstd2 = frsq(s2 * (1.f / 512.f) + 1e-6f);
  ld8(P.in[I_SNORM] + ch, pw);
#pragma unroll
  for (int j = 0; j < 8; ++j) f2[j] = y0[j] * rstd2 * pw[j];
  *(u32x4*)(hb + ch) = pack8(f1);
  *(u32x4*)(hb + 512 + ch) = pack8(f2);
}

DEV float mixval(const bf16_t* __restrict__ proj, int row, int c, const float* __restrict__ mu) {
  float self = bf2f(proj[(size_t)row * ODC + c]);
  int nrow = -1;
  if (row < NCTX) {
    int pos = row % CTXL;
    if (c < 896) { if (pos > 0) nrow = row - 1; }
    else { if (pos < CTXL - 1) nrow = row + 1; }
  } else {
    int pos = (row - NCTX) % SEQ;
    int gx = pos % GW, gy = pos / GW, q = c / 448;
    if (q == 0) { if (gx > 0) nrow = row - 1; }
    else if (q == 1) { if (gx < GW - 1) nrow = row + 1; }
    else if (q == 2) { if (gy > 0) nrow = row - GW; }
    else { if (gy < SEQ / GW - 1) nrow = row + GW; }
  }
  float nb = nrow >= 0 ? bf2f(proj[(size_t)nrow * ODC + c]) : 0.f;
  return self + mu[c] * (nb - self);
}

DEV int nbr_row(int row, int c) {
  if (row < NCTX) {
    int pos = row % CTXL;
    if (c < 896) return pos > 0 ? row - 1 : -1;
    return pos < CTXL - 1 ? row + 1 : -1;
  }
  int pos = (row - NCTX) % SEQ;
  int gx = pos % GW, gy = pos / GW, q = c / 448;
  if (q == 0) return gx > 0 ? row - 1 : -1;
  if (q == 1) return gx < GW - 1 ? row + 1 : -1;
  if (q == 2) return gy > 0 ? row - GW : -1;
  return gy < SEQ / GW - 1 ? row + GW : -1;
}

DEV void mix8(const bf16_t* __restrict__ proj, int row, int c, const float* __restrict__ mu, float* o) {
  float xs[8], xn[8];
  unpack8(*(const u32x4*)(proj + (size_t)row * ODC + c), xs);
  const int nr = nbr_row(row, c);
  if (nr >= 0) unpack8(*(const u32x4*)(proj + (size_t)nr * ODC + c), xn);
  else {
#pragma unroll
    for (int j = 0; j < 8; ++j) xn[j] = 0.f;
  }
  const f32x4 m0 = *(const f32x4*)(mu + c), m1 = *(const f32x4*)(mu + c + 4);
  const float mm[8] = {m0.x, m0.y, m0.z, m0.w, m1.x, m1.y, m1.z, m1.w};
#pragma unroll
  for (int j = 0; j < 8; ++j) o[j] = xs[j] + mm[j] * (xn[j] - xs[j]);
}

DEV void st_lora_act(const Params& P, int row2) {
  const int lane = threadIdx.x & 63;
  const int row = row2 + (lane >> 5), c = (lane & 31) * 8;
  const bf16_t* proj = (const bf16_t*)(P.ws + OFF_PROJ);
  bf16_t* hb = (bf16_t*)(P.ws + OFF_HBUF) + (size_t)row * 1024;
  float v[8];
  mix8(proj, row, 1536 + c, P.in[I_MU], v);
#pragma unroll
  for (int j = 0; j < 8; ++j) v[j] = c < 64 ? tanhf_(v[j]) : (c < 128 ? v[j] : sigmoidf_(v[j]));
  *(u32x4*)(hb + c) = pack8(v);
}

DEV void st_rwkv_stream(const Params& P, int sid, unsigned char* smem) {
  const int tid = threadIdx.x, lane = tid & 63, wave = tid >> 6;
  const int d = sid & 1, h = (sid >> 1) & 7, b = sid >> 4;
  float* sR = (float*)smem;
  float* sW = sR + 2048;
  float* sKk = sW + 2048;
  float* sV = sKk + 2048;
  float* sA = sV + 2048;
  float* sBb = sA + 2048;
  float* sY = sBb + 2048;
  int* sRow = (int*)(sY + 2048);
  const bf16_t* proj = (const bf16_t*)(P.ws + OFF_PROJ);
  const bf16_t* lora = (const bf16_t*)(P.ws + OFF_LORA);
  bf16_t* yout = (bf16_t*)(P.ws + OFF_HBUF);
  const float* mu = P.in[I_MU];
  const int vrow = tid >> 2, j4 = tid & 3;
  float S[16];
#pragma unroll
  for (int i = 0; i < 16; ++i) S[i] = 0.f;
  const float kkw = P.in[I_KK][h * 64 + lane], kaw = P.in[I_KA][h * 64 + lane];
  for (int seg = 0; seg < 2; ++seg) {
    const int row0 = seg == 0 ? b * CTXL : NCTX + b * SEQ;
    const int len = seg == 0 ? CTXL : SEQ;
    for (int it = 0; it < len / 32; ++it) {
      __syncthreads();
      for (int s = wave; s < 32; s += 4) {
        int p = it * 32 + s, pos = d ? len - 1 - p : p, row = row0 + pos;
        int c = h * 64 + lane;
        float r = mixval(proj, row, c, mu);
        float k = mixval(proj, row, 512 + c, mu);
        float v = mixval(proj, row, 1024 + c, mu);
        float kk = k * kkw;
        float ss = wave_sum(kk * kk);
        kk *= frsq(ss + 1e-12f);
        float lw = bf2f(lora[((size_t)d * NTOK + row) * 512 + c]);
        float la = bf2f(lora[((size_t)(2 + d) * NTOK + row) * 512 + c]);
        float w = fexp(-0.6065306597126334f * sigmoidf_(lw));
        float a = sigmoidf_(la);
        float kt = k * (1.f + (a - 1.f) * kaw);
        sR[s * 64 + lane] = r; sW[s * 64 + lane] = w; sKk[s * 64 + lane] = kt; sV[s * 64 + lane] = v;
        sA[s * 64 + lane] = -kk; sBb[s * 64 + lane] = kk * a;
        if (lane == 0) sRow[s] = row;
      }
      __syncthreads();
      for (int s = 0; s < 32; ++s) {
        const float* pa = sA + s * 64 + j4 * 16;
        const float* pw = sW + s * 64 + j4 * 16;
        const float* pk = sKk + s * 64 + j4 * 16;
        const float* pb = sBb + s * 64 + j4 * 16;
        const float* pr = sR + s * 64 + j4 * 16;
        const float vv = sV[s * 64 + vrow];
        float sa = 0.f;
#pragma unroll
        for (int i = 0; i < 16; ++i) sa += S[i] * pa[i];
        sa += wshfl_xor(sa, 1); sa += wshfl_xor(sa, 2);
        float y = 0.f;
#pragma unroll
        for (int i = 0; i < 16; ++i) { S[i] = S[i] * pw[i] + sa * pb[i] + vv * pk[i]; y += S[i] * pr[i]; }
        y += wshfl_xor(y, 1); y += wshfl_xor(y, 2);
        if (j4 == 0) sY[s * 64 + vrow] = y;
      }
      __syncthreads();
      for (int i = tid; i < 2048; i += 256) {
        int s = i >> 6, c = i & 63;
        yout[(size_t)sRow[s] * 1024 + d * 512 + h * 64 + c] = f2bf(sY[i]);
      }
    }
  }
}


struct RwkvRaw { u32x4 rs, rn, ks, kn, vs, vn, lw, la; int row; };

DEV void rwkv_load_raw(const bf16_t* __restrict__ proj, const bf16_t* __restrict__ lora, int b, int h, int d, int cc, int t, int c0,
                       RwkvRaw& R) {
  constexpr int NC_CTX = CTXL / 32;
  const int seg = cc >= NC_CTX;
  const int row0 = seg ? NCTX + b * SEQ : b * CTXL;
  const int len = seg ? SEQ : CTXL;
  const int p = (seg ? cc - NC_CTX : cc) * 32 + t;
  const int row = row0 + (d ? len - 1 - p : p);
  const int col = h * 64 + c0;
  const u32x4 z4 = {0u, 0u, 0u, 0u};
  const bf16_t* rp = proj + (size_t)row * ODC;
  R.row = row;
  R.rs = *(const u32x4*)(rp + col);
  R.ks = *(const u32x4*)(rp + 512 + col);
  R.vs = *(const u32x4*)(rp + 1024 + col);
  int n0 = nbr_row(row, col), n1 = nbr_row(row, 512 + col), n2 = nbr_row(row, 1024 + col);
  R.rn = n0 >= 0 ? *(const u32x4*)(proj + (size_t)n0 * ODC + col) : z4;
  R.kn = n1 >= 0 ? *(const u32x4*)(proj + (size_t)n1 * ODC + 512 + col) : z4;
  R.vn = n2 >= 0 ? *(const u32x4*)(proj + (size_t)n2 * ODC + 1024 + col) : z4;
  R.lw = *(const u32x4*)(lora + ((size_t)d * NTOK + row) * 512 + col);
  R.la = *(const u32x4*)(lora + ((size_t)(2 + d) * NTOK + row) * 512 + col);
}

#ifndef RW_NSEG
#define RW_NSEG 16
#endif
constexpr int RW_NCH = (CTXL + SEQ) / 32;
constexpr size_t OFF_RWSEG = OFF_PU;
static_assert((size_t)32 * RW_NSEG * 64 * 128 * 4 <= (size_t)2 * NEXP * 1024, "rwseg");

template <bool FULL>
DEV void st_rwkv_seg(const Params& P, int sid, int seg, unsigned char* smem) {
  constexpr int NVB = FULL ? 2 : 4;
  constexpr int ZR = FULL ? 64 : 128;
  const int tid = threadIdx.x, lane = tid & 63, wave = tid >> 6;
  const int d = sid & 1, h = (sid >> 1) & 7, b = sid >> 4;
  bf16_t* sAt = (bf16_t*)smem;
  bf16_t* sRt = sAt + 32 * 72;
  bf16_t* sBt = sRt + 32 * 72;
  bf16_t* sKt = sBt + 32 * 72;
  bf16_t* sBT = sKt + 32 * 72;
  bf16_t* sKT = sBT + 64 * 40;
  bf16_t* sVT = sKT + 64 * 40;
  bf16_t* sLak = sVT + 64 * 40;
  bf16_t* sM = sLak + 32 * 40;
  bf16_t* sLrb = sM + 32 * 40;
  bf16_t* sLrk = sLrb + 32 * 40;
  bf16_t* sZ = FULL ? sLrk + 32 * 40 : sLrb;
  bf16_t* after = sZ + ZR * 72;
  bf16_t* sRT = FULL ? after : nullptr;
  bf16_t* sSAT = FULL ? after + 64 * 40 : sRt;
  float* sLP = (float*)(FULL ? after + 2 * 64 * 40 : after);
  float* sLab = sLP + 32 * 64;
  float* sD = sLab + 32 * 33;
  float* sPT = sD + 768;
  int* sRow = (int*)(sPT + 64);
  if (!FULL) sRT = (bf16_t*)sLP;
  static_assert((4 * 32 * 72 + 3 * 64 * 40 + 4 * 32 * 40 + 2 * 64 * 40 + 64 * 72) * 2 + (32 * 64 + 32 * 33 + 768 + 64 + 32 + 320) * 4 + 16 <= SMEM_BYTES, "lds full");
  static_assert((4 * 32 * 72 + 3 * 64 * 40 + 2 * 32 * 40 + 128 * 72) * 2 + (32 * 64 + 32 * 33 + 768 + 64 + 32) * 4 <= SMEM_BYTES, "lds p1");
  static_assert(128 * 40 * 2 <= (32 * 64 + 32 * 33) * 4 && 128 * 40 <= 3 * 32 * 72, "alias");
  const bf16_t* proj = (const bf16_t*)(P.ws + OFF_PROJ);
  const bf16_t* lora = (const bf16_t*)(P.ws + OFF_LORA);
  bf16_t* yout = (bf16_t*)(P.ws + OFF_HBUF);
  float* segZ = (float*)(P.ws + OFF_RWSEG);
  const int t = tid >> 3, c0 = (tid & 7) * 8;
  const int hl = lane >> 5, l31 = lane & 31;
  float* sCst = (float*)(smem + SMEM_BYTES - 320 * 4 - 16);
  if (tid < 64) {
    sCst[tid] = P.in[I_MU][h * 64 + tid]; sCst[64 + tid] = P.in[I_MU][512 + h * 64 + tid]; sCst[128 + tid] = P.in[I_MU][1024 + h * 64 + tid];
    sCst[192 + tid] = P.in[I_KK][h * 64 + tid]; sCst[256 + tid] = P.in[I_KA][h * 64 + tid];
  }
  const int cc0 = (seg * RW_NCH) / RW_NSEG, cc1 = ((seg + 1) * RW_NCH) / RW_NSEG;
  RwkvRaw R;
  rwkv_load_raw(proj, lora, b, h, d, cc0, t, c0, R);
  f32x16 Zm[2];
#pragma unroll
  for (int j = 0; j < 2; ++j)
#pragma unroll
    for (int r = 0; r < 16; ++r) Zm[j][r] = 0.f;
  __syncthreads();
  for (int i = tid; i < ZR * 72; i += 256) sZ[i] = 0;
  __syncthreads();
  if (!FULL) {
    if (wave >= 2) {
#pragma unroll
      for (int cb = 0; cb < 2; ++cb)
#pragma unroll
        for (int r = 0; r < 16; ++r) {
          int c = cb * 32 + acc_row(r, lane), vp = wave * 32 + l31;
          if (c == vp - 64) { Zm[cb][r] = 1.f; sZ[vp * 72 + c] = 0x3f80; }
        }
    }
  } else {
    for (int js = 0; js < seg; ++js) {
      const float* Zs = segZ + ((size_t)sid * RW_NSEG + js) * 64 * 128;
      bf16_t* sG = sAt;
      {
        const int c = tid >> 2, c2 = (tid & 3) * 16;
        float gv[16];
        ld8(Zs + c * 128 + 64 + c2, gv); ld8(Zs + c * 128 + 64 + c2 + 8, gv + 8);
        *(u32x4*)(sG + c * 72 + c2) = pack8(gv);
        *(u32x4*)(sG + c * 72 + c2 + 8) = pack8(gv + 8);
      }
      __syncthreads();
      if (wave >= 2) {
        const int cb = wave - 2;
#pragma unroll
        for (int vb = 0; vb < 2; ++vb) {
          f32x16 acc;
#pragma unroll
          for (int r = 0; r < 16; ++r) acc[r] = Zs[(cb * 32 + acc_row(r, lane)) * 128 + vb * 32 + l31];
#pragma unroll
          for (int kk = 0; kk < 4; ++kk) {
            bf16x8 a = *(const bf16x8*)(sG + (cb * 32 + l31) * 72 + kk * 16 + 8 * hl);
            bf16x8 bb = *(const bf16x8*)(sZ + (vb * 32 + l31) * 72 + kk * 16 + 8 * hl);
            acc = mfma32(a, bb, acc);
          }
          Zm[vb] = acc;
        }
      }
      __syncthreads();
      if (wave >= 2) {
        const int cb = wave - 2;
#pragma unroll
        for (int vb = 0; vb < 2; ++vb)
#pragma unroll
          for (int g = 0; g < 4; ++g) {
            u32x2 pk; pk.x = pack2(Zm[vb][4 * g], Zm[vb][4 * g + 1]); pk.y = pack2(Zm[vb][4 * g + 2], Zm[vb][4 * g + 3]);
            *(u32x2*)(sZ + (vb * 32 + l31) * 72 + cb * 32 + 8 * g + 4 * hl) = pk;
          }
      }
      __syncthreads();
    }
  }
  for (int cc = cc0; cc < cc1; ++cc) {
    int tl_ = threadIdx.x; OPAQUE(tl_);
    const int tid = tl_, lane = tl_ & 63, hl = lane >> 5, l31 = lane & 31, t = tl_ >> 3, c0 = (tl_ & 7) * 8;
    const float* muR = sCst + c0; const float* muK = sCst + 64 + c0; const float* muV = sCst + 128 + c0;
    const float* kkw = sCst + 192 + c0; const float* kaw = sCst + 256 + c0;
    float lw8[8], lp8[8];
    {
      float lwf[8];
      unpack8(R.lw, lwf);
#pragma unroll
      for (int j = 0; j < 8; ++j) { lw8[j] = -0.6065306597126334f * sigmoidf_(lwf[j]); lp8[j] = lw8[j]; }
#pragma unroll
      for (int off = 8; off < 64; off <<= 1) {
#pragma unroll
        for (int j = 0; j < 8; ++j) {
#ifdef CPU_EMU
          float o = emu_shfl_up(lp8[j], off);
#else
          float o = __shfl_up(lp8[j], off, 64);
#endif
          if (lane >= off) lp8[j] += o;
        }
      }
      if (lane >= 56) {
#pragma unroll
        for (int j = 0; j < 8; ++j) sLP[wave * 64 + c0 + j] = lp8[j];
      }
      if ((tid & 7) == 0) sRow[t] = R.row;
    }
    __syncthreads();
    {
#pragma unroll
      for (int j = 0; j < 8; ++j) {
        float offs = 0.f;
        for (int w2 = 0; w2 < wave; ++w2) offs += sLP[w2 * 64 + c0 + j];
        lp8[j] += offs;
      }
      if (t == 31) {
#pragma unroll
        for (int j = 0; j < 8; ++j) sPT[c0 + j] = fexp(lp8[j]);
      }
    }
    {
      float xs[8], xn[8], kt[8], aa[8], ob[8], ok[8];
      unpack8(R.ks, xs); unpack8(R.kn, xn);
      float ss = 0.f;
#pragma unroll
      for (int j = 0; j < 8; ++j) { kt[j] = xs[j] + muK[j] * (xn[j] - xs[j]); aa[j] = kt[j] * kkw[j]; ss += aa[j] * aa[j]; }
      ss += wshfl_xor(ss, 1); ss += wshfl_xor(ss, 2); ss += wshfl_xor(ss, 4);
      const float rn = frsq(ss + 1e-12f);
      float laf[8];
      unpack8(R.la, laf);
#pragma unroll
      for (int j = 0; j < 8; ++j) {
        const float lp = lp8[j];
        const float lpm = lp8[j] - lw8[j];
        const float e = fexp(-lp);
        const float kkn = aa[j] * rn;
        const float asg = sigmoidf_(laf[j]);
        aa[j] = -kkn * fexp(lpm);
        ob[j] = kkn * asg * e;
        ok[j] = kt[j] * (1.f + (asg - 1.f) * kaw[j]) * e;
      }
      *(u32x4*)(sAt + t * 72 + c0) = pack8(aa);
      *(u32x4*)(sBt + t * 72 + c0) = pack8(ob);
      *(u32x4*)(sKt + t * 72 + c0) = pack8(ok);
#pragma unroll
      for (int j = 0; j < 8; ++j) { sBT[(c0 + j) * 40 + t] = f2bf(ob[j]); sKT[(c0 + j) * 40 + t] = f2bf(ok[j]); }
      unpack8(R.vs, xs); unpack8(R.vn, xn);
#pragma unroll
      for (int j = 0; j < 8; ++j) sVT[(c0 + j) * 40 + t] = f2bf(xs[j] + muV[j] * (xn[j] - xs[j]));
      if (FULL) {
        unpack8(R.rs, xs); unpack8(R.rn, xn);
#pragma unroll
        for (int j = 0; j < 8; ++j) xs[j] = (xs[j] + muR[j] * (xn[j] - xs[j])) * fexp(lp8[j]);
        *(u32x4*)(sRt + t * 72 + c0) = pack8(xs);
      }
    }
    if (cc + 1 < cc1) rwkv_load_raw(proj, lora, b, h, d, cc + 1, t, c0, R);
    __syncthreads();
    if (FULL || wave < 2) {
      const bf16_t* Asrc = wave < 2 ? sAt : sRt;
      const bf16_t* Bsrc = (wave & 1) ? sKt : sBt;
      f32x16 acc;
#pragma unroll
      for (int r = 0; r < 16; ++r) acc[r] = 0.f;
#pragma unroll
      for (int kk = 0; kk < 4; ++kk) {
        bf16x8 a = *(const bf16x8*)(Asrc + l31 * 72 + kk * 16 + 8 * hl);
        bf16x8 bb = *(const bf16x8*)(Bsrc + l31 * 72 + kk * 16 + 8 * hl);
        acc = mfma32(a, bb, acc);
      }
      bf16_t* dst = wave == 1 ? sLak : (wave == 2 ? sLrb : sLrk);
#pragma unroll
      for (int r = 0; r < 16; ++r) {
        int tt = acc_row(r, lane), j = l31;
        bool keep = wave < 2 ? (j < tt) : (j <= tt);
        float v = keep ? acc[r] : 0.f;
        if (wave == 0) sLab[tt * 33 + j] = v;
        else dst[tt * 40 + j] = f2bf(v);
      }
    }
    __syncthreads();
    if (tid < 32) {
      const int q = tid >> 4, c = tid & 15;
      float x[16];
#pragma unroll
      for (int i = 0; i < 16; ++i) {
        float sacc = (i == c) ? 1.f : 0.f;
#pragma unroll
        for (int j = 0; j < i; ++j) sacc += sLab[(q * 16 + i) * 33 + q * 16 + j] * x[j];
        x[i] = sacc;
        sD[q * 256 + i * 16 + c] = sacc;
      }
    }
    __syncthreads();
    {
      const int i = tid >> 4, c = tid & 15;
      float sacc = 0.f;
#pragma unroll
      for (int j = 0; j < 16; ++j) sacc += sLab[(16 + i) * 33 + j] * sD[j * 16 + c];
      sD[512 + i * 16 + c] = sacc;
    }
    __syncthreads();
    {
      const int i = tid >> 4, c = tid & 15;
      float sacc = 0.f;
#pragma unroll
      for (int j = 0; j < 16; ++j) sacc += sD[256 + i * 16 + j] * sD[512 + j * 16 + c];
      sM[(16 + i) * 40 + c] = f2bf(sacc);
      sM[i * 40 + c] = f2bf(sD[i * 16 + c]);
      sM[(16 + i) * 40 + 16 + c] = f2bf(sD[256 + i * 16 + c]);
      sM[i * 40 + 16 + c] = 0;
    }
    if (wave < NVB) {
      const int vb = wave;
      f32x16 acc;
#pragma unroll
      for (int r = 0; r < 16; ++r) acc[r] = 0.f;
#pragma unroll
      for (int kk = 0; kk < 4; ++kk) {
        bf16x8 a = *(const bf16x8*)(sAt + l31 * 72 + kk * 16 + 8 * hl);
        bf16x8 bb = *(const bf16x8*)(sZ + (vb * 32 + l31) * 72 + kk * 16 + 8 * hl);
        acc = mfma32(a, bb, acc);
      }
      if (vb < 2) {
#pragma unroll
        for (int kk = 0; kk < 2; ++kk) {
          bf16x8 a = *(const bf16x8*)(sLak + l31 * 40 + kk * 16 + 8 * hl);
          bf16x8 bb = *(const bf16x8*)(sVT + (vb * 32 + l31) * 40 + kk * 16 + 8 * hl);
          acc = mfma32(a, bb, acc);
        }
      }
#pragma unroll
      for (int g = 0; g < 4; ++g) {
        u32x2 pk; pk.x = pack2(acc[4 * g], acc[4 * g + 1]); pk.y = pack2(acc[4 * g + 2], acc[4 * g + 3]);
        *(u32x2*)(sRT + (vb * 32 + l31) * 40 + 8 * g + 4 * hl) = pk;
      }
    }
    __syncthreads();
    if (wave < NVB) {
      const int vb = wave;
      f32x16 acc;
#pragma unroll
      for (int r = 0; r < 16; ++r) acc[r] = 0.f;
#pragma unroll
      for (int kk = 0; kk < 2; ++kk) {
        bf16x8 a = *(const bf16x8*)(sM + l31 * 40 + kk * 16 + 8 * hl);
        bf16x8 bb = *(const bf16x8*)(sRT + (vb * 32 + l31) * 40 + kk * 16 + 8 * hl);
        acc = mfma32(a, bb, acc);
      }
#pragma unroll
      for (int g = 0; g < 4; ++g) {
        u32x2 pk; pk.x = pack2(acc[4 * g], acc[4 * g + 1]); pk.y = pack2(acc[4 * g + 2], acc[4 * g + 3]);
        *(u32x2*)(sSAT + (vb * 32 + l31) * 40 + 8 * g + 4 * hl) = pk;
      }
    }
    __syncthreads();
    if (FULL) {
      if (wave < 2) {
        const int vb = wave;
        f32x16 acc;
#pragma unroll
        for (int r = 0; r < 16; ++r) acc[r] = 0.f;
#pragma unroll
        for (int kk = 0; kk < 4; ++kk) {
          bf16x8 a = *(const bf16x8*)(sZ + (vb * 32 + l31) * 72 + kk * 16 + 8 * hl);
          bf16x8 bb = *(const bf16x8*)(sRt + l31 * 72 + kk * 16 + 8 * hl);
          acc = mfma32(a, bb, acc);
        }
#pragma unroll
        for (int kk = 0; kk < 2; ++kk) {
          bf16x8 a = *(const bf16x8*)(sSAT + (vb * 32 + l31) * 40 + kk * 16 + 8 * hl);
          bf16x8 bb = *(const bf16x8*)(sLrb + l31 * 40 + kk * 16 + 8 * hl);
          acc = mfma32(a, bb, acc);
        }
#pragma unroll
        for (int kk = 0; kk < 2; ++kk) {
          bf16x8 a = *(const bf16x8*)(sVT + (vb * 32 + l31) * 40 + kk * 16 + 8 * hl);
          bf16x8 bb = *(const bf16x8*)(sLrk + l31 * 40 + kk * 16 + 8 * hl);
          acc = mfma32(a, bb, acc);
        }
        {
          const size_t obase = (size_t)sRow[l31] * 1024 + d * 512 + h * 64 + vb * 32;
#pragma unroll
          for (int g = 0; g < 4; ++g) {
            u32x2 pk; pk.x = pack2(acc[4 * g], acc[4 * g + 1]); pk.y = pack2(acc[4 * g + 2], acc[4 * g + 3]);
            *(u32x2*)(yout + obase + 8 * g + 4 * hl) = pk;
          }
        }
      } else {
        const int cb = wave - 2;
#pragma unroll
        for (int vb = 0; vb < 2; ++vb) {
          f32x16 acc;
#pragma unroll
          for (int r = 0; r < 16; ++r) acc[r] = 0.f;
#pragma unroll
          for (int kk = 0; kk < 2; ++kk) {
            bf16x8 a = *(const bf16x8*)(sBT + (cb * 32 + l31) * 40 + kk * 16 + 8 * hl);
            bf16x8 bb = *(const bf16x8*)(sSAT + (vb * 32 + l31) * 40 + kk * 16 + 8 * hl);
            acc = mfma32(a, bb, acc);
          }
#pragma unroll
          for (int kk = 0; kk < 2; ++kk) {
            bf16x8 a = *(const bf16x8*)(sKT + (cb * 32 + l31) * 40 + kk * 16 + 8 * hl);
            bf16x8 bb = *(const bf16x8*)(sVT + (vb * 32 + l31) * 40 + kk * 16 + 8 * hl);
            acc = mfma32(a, bb, acc);
          }
#pragma unroll
          for (int r = 0; r < 16; ++r) Zm[vb][r] = sPT[cb * 32 + acc_row(r, lane)] * (Zm[vb][r] + acc[r]);
        }
      }
      __syncthreads();
      if (wave >= 2) {
        const int cb = wave - 2;
#pragma unroll
        for (int vb = 0; vb < 2; ++vb)
#pragma unroll
          for (int g = 0; g < 4; ++g) {
            u32x2 pk; pk.x = pack2(Zm[vb][4 * g], Zm[vb][4 * g + 1]); pk.y = pack2(Zm[vb][4 * g + 2], Zm[vb][4 * g + 3]);
            *(u32x2*)(sZ + (vb * 32 + l31) * 72 + cb * 32 + 8 * g + 4 * hl) = pk;
          }
      }
    } else {
      const int vb = wave;
#pragma unroll
      for (int cb = 0; cb < 2; ++cb) {
        f32x16 acc;
#pragma unroll
        for (int r = 0; r < 16; ++r) acc[r] = 0.f;
#pragma unroll
        for (int kk = 0; kk < 2; ++kk) {
          bf16x8 a = *(const bf16x8*)(sBT + (cb * 32 + l31) * 40 + kk * 16 + 8 * hl);
          bf16x8 bb = *(const bf16x8*)(sSAT + (vb * 32 + l31) * 40 + kk * 16 + 8 * hl);
          acc = mfma32(a, bb, acc);
        }
        if (vb < 2) {
#pragma unroll
          for (int kk = 0; kk < 2; ++kk) {
            bf16x8 a = *(const bf16x8*)(sKT + (cb * 32 + l31) * 40 + kk * 16 + 8 * hl);
            bf16x8 bb = *(const bf16x8*)(sVT + (vb * 32 + l31) * 40 + kk * 16 + 8 * hl);
            acc = mfma32(a, bb, acc);
          }
        }
#pragma unroll
        for (int r = 0; r < 16; ++r) Zm[cb][r] = sPT[cb * 32 + acc_row(r, lane)] * (Zm[cb][r] + acc[r]);
      }
#pragma unroll
      for (int cb = 0; cb < 2; ++cb)
#pragma unroll
        for (int g = 0; g < 4; ++g) {
          u32x2 pk; pk.x = pack2(Zm[cb][4 * g], Zm[cb][4 * g + 1]); pk.y = pack2(Zm[cb][4 * g + 2], Zm[cb][4 * g + 3]);
          *(u32x2*)(sZ + (vb * 32 + l31) * 72 + cb * 32 + 8 * g + 4 * hl) = pk;
        }
    }
  }
  if (!FULL) {
    float* Zs = segZ + ((size_t)sid * RW_NSEG + seg) * 64 * 128;
#pragma unroll
    for (int cb = 0; cb < 2; ++cb)
#pragma unroll
      for (int r = 0; r < 16; ++r) Zs[(cb * 32 + acc_row(r, lane)) * 128 + wave * 32 + l31] = Zm[cb][r];
  }
}

constexpr int LRU_NCH = (CTXL + SEQ) / 64;
constexpr size_t OFF_ACUM0 = OFF_PU;
static_assert((size_t)NLAT * 512 * 2 <= (size_t)2 * NEXP * 1024, "acum0");

DEV void st_lru_chunk(const Params& P, int sid, int cc, unsigned char* smem) {
  constexpr int NC_CTX = CTXL / 64;
  const int tid = threadIdx.x, lane = tid & 63, wave = tid >> 6;
  const int d = sid & 1, blk = (sid >> 1) & 7, b = sid >> 4;
  float* sXc = (float*)smem;
  float* sAc = sXc + 4096;
  float* sBc = sAc + 4096;
  float* sU = sBc + 4096;
  bf16_t* sAop = (bf16_t*)(sU + 4096);
  float* sQA = (float*)(sAop + 64 * 72);
  float* sQH = sQA + 256;
  int* sRow = (int*)(sQH + 256);
  const bf16_t* proj = (const bf16_t*)(P.ws + OFF_PROJ);
  bf16_t* uout = (bf16_t*)(P.ws + OFF_LORA) + (size_t)d * NTOK * 512;
  bf16_t* aout = (bf16_t*)(P.ws + (d ? OFF_ACUM1 : OFF_ACUM0));
  const bf16_t* lruT = (const bf16_t*)(P.ws + OFF_LRUT) + (size_t)(d * 8 + blk) * 128 * 64;
  float* chunkS = (float*)(P.ws + OFF_LRUCS) + ((size_t)sid * LRU_NCH + cc) * 128;
  const float* cw = P.in[I_LCONVW];
  const float* cb = P.in[I_LCONVB];
  const int tr = (wave >> 1) * 32, nc0 = (wave & 1) * 64;
  const int sgi = cc >= NC_CTX;
  const int row0 = sgi ? NCTX + b * SEQ : b * CTXL;
  const int len = sgi ? SEQ : CTXL;
  const int cl = (sgi ? cc - NC_CTX : cc) * 64;
  __syncthreads();
  if (tid < 64) { int p = cl + tid; sRow[tid] = row0 + (d ? len - 1 - p : p); }
  {
    const int lc8 = (tid & 7) * 8, lch = blk * 64 + lc8;
#pragma unroll
    for (int i = 0; i < 2; ++i) {
      int c = tid + i * 256, r = c >> 3;
      int p = cl + r, pos = d ? len - 1 - p : p;
      float o[8];
      f32x4 c0 = *(const f32x4*)(cb + lch), c1 = *(const f32x4*)(cb + lch + 4);
      o[0] = c0.x; o[1] = c0.y; o[2] = c0.z; o[3] = c0.w; o[4] = c1.x; o[5] = c1.y; o[6] = c1.z; o[7] = c1.w;
#pragma unroll
      for (int tap = 0; tap < 4; ++tap) {
        int pp = pos + tap - 2;
        if (pp >= 0 && pp < len) {
          float x[8];
          unpack8(*(const u32x4*)(proj + (size_t)(row0 + pp) * ODC + 2304 + lch), x);
          f32x4 w0 = *(const f32x4*)(cw + tap * 512 + lch), w1 = *(const f32x4*)(cw + tap * 512 + lch + 4);
          o[0] += w0.x * x[0]; o[1] += w0.y * x[1]; o[2] += w0.z * x[2]; o[3] += w0.w * x[3];
          o[4] += w1.x * x[4]; o[5] += w1.y * x[5]; o[6] += w1.z * x[6]; o[7] += w1.w * x[7];
        }
      }
#pragma unroll
      for (int j = 0; j < 8; ++j) sXc[r * 64 + lc8 + j] = o[j];
      *(u32x4*)(sAop + r * 72 + lc8) = pack8(o);
    }
  }
  __syncthreads();
  {
    f32x16 acc[2];
#pragma unroll
    for (int j = 0; j < 2; ++j)
#pragma unroll
      for (int r = 0; r < 16; ++r) acc[j][r] = 0.f;
#pragma unroll
    for (int kk = 0; kk < 4; ++kk) {
      bf16x8 a = *(const bf16x8*)(sAop + (tr + (lane & 31)) * 72 + kk * 16 + 8 * (lane >> 5));
#pragma unroll
      for (int j = 0; j < 2; ++j) {
        bf16x8 bb = *(const bf16x8*)(lruT + (nc0 + j * 32 + (lane & 31)) * 64 + kk * 16 + 8 * (lane >> 5));
        acc[j] = mfma32(a, bb, acc[j]);
      }
    }
#pragma unroll
    for (int j = 0; j < 2; ++j) {
      const int e = nc0 + j * 32 + (lane & 31);
      const int ch = blk * 64 + (e & 63);
      const float ebias = e < 64 ? P.in[I_BA][d * 512 + ch] : P.in[I_BI][d * 512 + ch];
      const float esp = softplusf_(-P.in[I_LAM][d * 512 + ch]);
#pragma unroll
      for (int r = 0; r < 16; ++r) {
        int t = tr + acc_row(r, lane);
        float g = sigmoidf_(acc[j][r] + ebias);
        if (e < 64) { float a_ = fexp(-8.f * g * esp); sAc[t * 64 + e] = a_; sU[t * 64 + e] = fsqrt(fmaxf(1.f - a_ * a_, 0.f)); }
        else sBc[t * 64 + (e - 64)] = g * sXc[t * 64 + (e - 64)];
      }
    }
  }
  __syncthreads();
  const int c = tid & 63, q = tid >> 6;
  {
    float h = 0.f, ap = 1.f;
#pragma unroll 4
    for (int i = 0; i < 16; ++i) {
      const int t = q * 16 + i;
      const float a = sAc[t * 64 + c];
      h = a * h + sU[t * 64 + c] * sBc[t * 64 + c];
      ap *= a;
      sU[t * 64 + c] = h; sAc[t * 64 + c] = ap;
    }
    sQA[q * 64 + c] = ap; sQH[q * 64 + c] = h;
  }
  __syncthreads();
  {
    float hin = 0.f, ain = 1.f;
    for (int q2 = 0; q2 < q; ++q2) { hin = sQA[q2 * 64 + c] * hin + sQH[q2 * 64 + c]; ain *= sQA[q2 * 64 + c]; }
    if (q > 0) {
#pragma unroll 4
      for (int i = 0; i < 16; ++i) {
        const int t = q * 16 + i;
        const float ap = sAc[t * 64 + c];
        sU[t * 64 + c] += ap * hin;
        sAc[t * 64 + c] = ap * ain;
      }
    }
    if (q == 3) { chunkS[c] = sAc[63 * 64 + c]; chunkS[64 + c] = sU[63 * 64 + c]; }
  }
  __syncthreads();
  if (sgi) {
#pragma unroll
    for (int i = 0; i < 2; ++i) {
      int cidx = tid + i * 256, r = cidx >> 3, c8 = (cidx & 7) * 8;
      float u8[8], a8[8];
#pragma unroll
      for (int j = 0; j < 8; ++j) { u8[j] = sU[r * 64 + c8 + j]; a8[j] = sAc[r * 64 + c8 + j]; }
      const int row = sRow[r];
      *(u32x4*)(uout + (size_t)row * 512 + blk * 64 + c8) = pack8(u8);
      *(u32x4*)(aout + (size_t)(row - NCTX) * 512 + blk * 64 + c8) = pack8(a8);
    }
  }
}

DEV void st_lru_carry(const Params& P, int sid) {
  const int c = threadIdx.x;
  if (c >= 64) return;
  const float* cs = (const float*)(P.ws + OFF_LRUCS) + (size_t)sid * LRU_NCH * 128;
  float* hs = (float*)(P.ws + OFF_LRUHS) + (size_t)sid * LRU_NCH * 64;
  float h = 0.f;
  for (int cc0 = 0; cc0 < LRU_NCH; cc0 += 10) {
    float a[10], bb[10];
#pragma unroll
    for (int i = 0; i < 10; ++i) { a[i] = cs[(size_t)(cc0 + i) * 128 + c]; bb[i] = cs[(size_t)(cc0 + i) * 128 + 64 + c]; }
#pragma unroll
    for (int i = 0; i < 10; ++i) { hs[(size_t)(cc0 + i) * 64 + c] = h; h = a[i] * h + bb[i]; }
  }
}

DEV void st_finish_l1(const Params& P, int row) {
  const int lane = threadIdx.x & 63;
  bf16_t* hb = (bf16_t*)(P.ws + OFF_HBUF) + (size_t)row * 1024;
  const bf16_t* proj = (const bf16_t*)(P.ws + OFF_PROJ);
  const bf16_t* lora = (const bf16_t*)(P.ws + OFF_LORA);
  const float* mu = P.in[I_MU];
  const int ch = lane * 8;
  float y0[8], y1[8];
  unpack8(*(const u32x4*)(hb + ch), y0);
  unpack8(*(const u32x4*)(hb + 512 + ch), y1);
  float sm = 0.f;
#pragma unroll
  for (int j = 0; j < 8; ++j) { y0[j] += y1[j]; sm += y0[j]; }
  sm += wshfl_xor(sm, 1); sm += wshfl_xor(sm, 2); sm += wshfl_xor(sm, 4);
  const float mean = sm * (1.f / 64.f);
  float sv = 0.f;
#pragma unroll
  for (int j = 0; j < 8; ++j) { float dlt = y0[j] - mean; sv += dlt * dlt; }
  sv += wshfl_xor(sv, 1); sv += wshfl_xor(sv, 2); sv += wshfl_xor(sv, 4);
  const float rstd = frsq(sv * (1.f / 64.f) + 64e-5f);
  float a0[8], a1[8], g[8], u0[8], u1[8], gb[8];
  unpack8(*(const u32x4*)(lora + ((size_t)2 * NTOK + row) * 512 + ch), a0);
  unpack8(*(const u32x4*)(lora + ((size_t)3 * NTOK + row) * 512 + ch), a1);
  unpack8(*(const u32x4*)(lora + ((size_t)4 * NTOK + row) * 512 + ch), g);
  unpack8(*(const u32x4*)(lora + ((size_t)0 * NTOK + row) * 512 + ch), u0);
  unpack8(*(const u32x4*)(lora + ((size_t)1 * NTOK + row) * 512 + ch), u1);
  if (row >= NCTX) {
    const int bb_ = (row - NCTX) / SEQ, pos = (row - NCTX) % SEQ, blk = ch >> 6;
    float ac[8];
#pragma unroll
    for (int dd = 0; dd < 2; ++dd) {
      const int pidx = dd ? SEQ - 1 - pos : pos;
      const int cc = CTXL / 64 + pidx / 64;
      const int sid = (bb_ * 8 + blk) * 2 + dd;
      const float* hs = (const float*)(P.ws + OFF_LRUHS) + ((size_t)sid * LRU_NCH + cc) * 64 + (ch & 63);
      unpack8(*(const u32x4*)((const bf16_t*)(P.ws + (dd ? OFF_ACUM1 : OFF_ACUM0)) + (size_t)(row - NCTX) * 512 + ch), ac);
      f32x4 h0 = *(const f32x4*)hs, h1 = *(const f32x4*)(hs + 4);
      float* u = dd ? u1 : u0;
      u[0] += ac[0] * h0.x; u[1] += ac[1] * h0.y; u[2] += ac[2] * h0.z; u[3] += ac[3] * h0.w;
      u[4] += ac[4] * h1.x; u[5] += ac[5] * h1.y; u[6] += ac[6] * h1.z; u[7] += ac[7] * h1.w;
    }
  }
  unpack8(*(const u32x4*)(proj + (size_t)row * ODC + 1792 + ch), gb);
  float rv[8], vv[8], kv[8];
  float sdot = 0.f;
  float pka[8], prk[8], plw[8], plb[8];
  ld8(P.in[I_KA] + ch, pka); ld8(P.in[I_RK] + ch, prk); ld8(P.in[I_LNW] + ch, plw); ld8(P.in[I_LNB] + ch, plb);
  mix8(proj, row, ch, mu, rv);
  mix8(proj, row, 512 + ch, mu, kv);
  mix8(proj, row, 1024 + ch, mu, vv);
#pragma unroll
  for (int j = 0; j < 8; ++j) {
    float r = rv[j];
    float k = kv[j];
    float am = 0.5f * (sigmoidf_(a0[j]) + sigmoidf_(a1[j]));
    float kb = k * (1.f + (am - 1.f) * pka[j]);
    sdot += r * kb * prk[j];
    rv[j] = r;
  }
  sdot += wshfl_xor(sdot, 1); sdot += wshfl_xor(sdot, 2); sdot += wshfl_xor(sdot, 4);
  float f1[8], f2[8];
#pragma unroll
  for (int j = 0; j < 8; ++j) {
    float yn = (y0[j] - mean) * rstd * plw[j] + plb[j];
    yn += sdot * vv[j];
    f1[j] = yn * g[j];
    f2[j] = (u0[j] + u1[j]) * geluf_(gb[j]);
  }
  *(u32x4*)(hb + ch) = pack8(f1);
  *(u32x4*)(hb + 512 + ch) = pack8(f2);
}

DEV unsigned fkey(float f) { unsigned u; __builtin_memcpy(&u, &f, 4); return (u >> 31) ? ~u : (u | 0x80000000u); }
DEV float keyf(unsigned u) { u = (u >> 31) ? (u & 0x7fffffffu) : ~u; float f; __builtin_memcpy(&f, &u, 4); return f; }
DEV void key_insert(unsigned x, unsigned* v) {
#pragma unroll
  for (int j = 0; j < 16; ++j) { unsigned hi = v[j] > x ? v[j] : x; x = v[j] > x ? x : v[j]; v[j] = hi; }
}
DEV void key_cx(unsigned& hi, unsigned& lo) { unsigned a = hi, b = lo; hi = a > b ? a : b; lo = a > b ? b : a; }
DEV void key_sort16(unsigned* v) {
#pragma unroll
  for (int k = 2; k <= 16; k <<= 1)
#pragma unroll
    for (int j = k >> 1; j > 0; j >>= 1)
#pragma unroll
      for (int i = 0; i < 16; ++i) {
        const int l = i ^ j;
        if (l > i) { if ((i & k) == 0) key_cx(v[i], v[l]); else key_cx(v[l], v[i]); }
      }
}
DEV void key_merge16(unsigned* a, const unsigned* b) {
#pragma unroll
  for (int i = 0; i < 16; ++i) a[i] = a[i] > b[15 - i] ? a[i] : b[15 - i];
#pragma unroll
  for (int j = 8; j > 0; j >>= 1)
#pragma unroll
    for (int i = 0; i < 16; ++i) { const int l = i ^ j; if (l > i) key_cx(a[i], a[l]); }
}

DEV void st_peer_topk(const Params& P, int layer, int tile, int h, unsigned char* smem) {
  const int tid = threadIdx.x;
  const bf16_t* q = (const bf16_t*)(P.ws + OFF_Q);
  const bf16_t* keys = (const bf16_t*)(P.ws + OFF_KEYS) + (size_t)(layer * 8 + h) * 2 * 128 * 128;
  float* sS = (float*)smem;
  const int m0 = tile * 128;
  const int tok = tid & 127, half = tid >> 7;
  unsigned kl[2][16];
#pragma unroll
  for (int p = 0; p < 2; ++p) {
    EpiScoreLds epi{sS, m0};
    gemm_tile_128<true>(q + (h * 2 + p) * 128, 2048, NTOK, keys + p * 128 * 128, 128, 128, 128, m0, 0, epi, smem);
    __syncthreads();
    float* row = sS + tok * 129 + half * 64;
#pragma unroll
    for (int g = 0; g < 4; ++g) {
      unsigned grp[16];
#pragma unroll
      for (int j = 0; j < 16; ++j) grp[j] = (fkey(row[g * 16 + j]) & ~127u) | (unsigned)(127 - (half * 64 + g * 16 + j));
      key_sort16(grp);
      if (g == 0) {
#pragma unroll
        for (int j = 0; j < 16; ++j) kl[p][j] = grp[j];
      } else key_merge16(kl[p], grp);
    }
    if (half == 1) {
#pragma unroll
      for (int j = 0; j < 16; ++j) row[j] = __builtin_bit_cast(float, kl[p][j]);
    }
    __syncthreads();
    if (half == 0) {
      unsigned oth[16];
#pragma unroll
      for (int j = 0; j < 16; ++j) oth[j] = __builtin_bit_cast(unsigned, sS[tok * 129 + 64 + j]);
      key_merge16(kl[p], oth);
    }
    __syncthreads();
  }
  if (tid < 128) {
    float sv0[16], sv1[16];
    int* irow = (int*)(sS + tid * 129);
#pragma unroll
    for (int j = 0; j < 16; ++j) {
      sv0[j] = keyf((kl[0][j] & ~127u) | 64u); sv1[j] = keyf((kl[1][j] & ~127u) | 64u);
      irow[j] = 127 - (int)(kl[0][j] & 127u); irow[16 + j] = 127 - (int)(kl[1][j] & 127u);
    }
    unsigned best[16];
#pragma unroll
    for (int j = 0; j < 16; ++j) best[j] = 0u;
#pragma unroll
    for (int i = 0; i < 16; ++i)
#pragma unroll
      for (int j = 0; j < 16; ++j)
        if ((i + 1) * (j + 1) <= 16) key_insert((fkey(sv0[i] + sv1[j]) & ~255u) | (unsigned)(255 - (i * 16 + j)), best);
    float e[16], sum = 0.f;
    const float b0 = keyf((best[0] & ~255u) | 128u);
#pragma unroll
    for (int j = 0; j < 16; ++j) { e[j] = fexp(keyf((best[j] & ~255u) | 128u) - b0); sum += e[j]; }
    const float inv = 1.f / sum;
    int* pidx = (int*)(P.ws + OFF_PIDX) + (size_t)(m0 + tid) * 128 + h * 16;
    float* pg = (float*)(P.ws + OFF_PGATE) + (size_t)(m0 + tid) * 128 + h * 16;
#pragma unroll
    for (int j = 0; j < 16; ++j) {
      const int pos = 255 - (int)(best[j] & 255u);
      pidx[j] = irow[pos >> 4] * 128 + irow[16 + (pos & 15)];
      pg[j] = e[j] * inv;
    }
  }
}

DEV void st_peer_experts(const Params& P, int layer, int row) {
  const int lane = threadIdx.x & 63;
  const bf16_t* xb = (const bf16_t*)(P.ws + OFF_HBUF) + (size_t)row * 1024;
  const unsigned char* U = P.ws + OFF_PU;
  const int* pidx = (const int*)(P.ws + OFF_PIDX) + (size_t)row * 128;
  const float* pg = (const float*)(P.ws + OFF_PGATE) + (size_t)row * 128;
  float x[16], acc[16];
  unpack8(*(const u32x4*)(xb + lane * 16), x);
  unpack8(*(const u32x4*)(xb + lane * 16 + 8), x + 8);
#pragma unroll
  for (int j = 0; j < 16; ++j) acc[j] = 0.f;
  const int b5 = (lane >> 5) & 1, b4 = (lane >> 4) & 1, b3 = (lane >> 3) & 1;
  const int mypick = (lane >> 3) & 7;
  for (int k0 = 0; k0 < 128; k0 += 8) {
    u32x3 uu[8]; u32x2 vv[8];
#pragma unroll
    for (int i = 0; i < 8; ++i) {
      const unsigned char* er = U + (size_t)pidx[k0 + i] * PEER_ROWB;
      const unsigned* up = (const unsigned*)(er + lane * 12);
      uu[i].x = up[0]; uu[i].y = up[1]; uu[i].z = up[2];
      vv[i] = *(const u32x2*)(er + PEER_VOFF + lane * 8);
    }
    const float mygate = pg[k0 + mypick];
    float dsum[8];
#pragma unroll
    for (int i = 0; i < 8; i += 2) {
      float ufa[16], ufb[16];
#ifndef CPU_EMU
      __builtin_amdgcn_sched_barrier(0);
#endif
      unpack2x16_fp6(uu[i], uu[i + 1], ufa, ufb);
      typedef __attribute__((ext_vector_type(2))) float f32x2v;
      f32x2v da2 = {0.f, 0.f}, db2 = {0.f, 0.f};
#pragma unroll
      for (int j = 0; j < 8; ++j) {
        const f32x2v xx = {x[2 * j], x[2 * j + 1]};
        const f32x2v ua = {ufa[2 * j], ufa[2 * j + 1]}, ub = {ufb[2 * j], ufb[2 * j + 1]};
        da2 = xx * ua + da2; db2 = xx * ub + db2;
      }
      dsum[i] = da2.x + da2.y; dsum[i + 1] = db2.x + db2.y;
    }
    float e4[4], e2[2], g;
#pragma unroll
    for (int i = 0; i < 4; ++i) {
      float mine = b5 ? dsum[4 + i] : dsum[i], send = b5 ? dsum[i] : dsum[4 + i];
      e4[i] = mine + wshfl_xor(send, 32);
    }
#pragma unroll
    for (int i = 0; i < 2; ++i) {
      float mine = b4 ? e4[2 + i] : e4[i], send = b4 ? e4[i] : e4[2 + i];
      e2[i] = mine + wshfl_xor(send, 16);
    }
    {
      float mine = b3 ? e2[1] : e2[0], send = b3 ? e2[0] : e2[1];
      g = mine + wshfl_xor(send, 8);
    }
    g += wshfl_xor(g, 4); g += wshfl_xor(g, 2); g += wshfl_xor(g, 1);
    const float mycoef = mygate * geluf_(g * (1.f / PEER_USCALE));
#pragma unroll
    for (int i = 0; i < 8; ++i) {
      const float coef = wreadlane(mycoef, i * 8);
      float vf[16];
      unpack8_fp4(vv[i].x, vf); unpack8_fp4(vv[i].y, vf + 8);
#pragma unroll
      for (int j = 0; j < 16; ++j) acc[j] += coef * vf[j];
    }
  }
  float* xr = row < NCTX ? (float*)(P.ws + OFF_CTXRES) + (size_t)row * 1024 : P.out + (size_t)(row - NCTX) * 1024;
  const float* g2 = (const float*)(P.ws + OFF_MODV) + ((size_t)layer * 3 + mod_row(row)) * 6144 + 5 * 1024;
  float o[16];
#pragma unroll
  for (int q = 0; q < 4; ++q) {
    const int c = lane * 16 + q * 4;
    f32x4 a = *(const f32x4*)(xr + c), ga = *(const f32x4*)(g2 + c);
    o[q * 4 + 0] = a.x + ga.x * acc[q * 4 + 0] * (1.f / PEER_VSCALE); o[q * 4 + 1] = a.y + ga.y * acc[q * 4 + 1] * (1.f / PEER_VSCALE);
    o[q * 4 + 2] = a.z + ga.z * acc[q * 4 + 2] * (1.f / PEER_VSCALE); o[q * 4 + 3] = a.w + ga.w * acc[q * 4 + 3] * (1.f / PEER_VSCALE);
  }
  float ss = 0.f;
#pragma unroll
  for (int j = 0; j < 16; ++j) ss += o[j] * o[j];
  ss = wave_sum(ss);
  const float rstd = frsq(ss * (1.f / 1024.f) + 1e-6f);
  if (layer == 1) {
    float fn[16]; ld8(P.in[I_FNORM] + lane * 16, fn); ld8(P.in[I_FNORM] + lane * 16 + 8, fn + 8);
#pragma unroll
    for (int j = 0; j < 16; ++j) o[j] *= rstd * fn[j];
  }
#pragma unroll
  for (int q = 0; q < 4; ++q) {
    f32x4 a = {o[q * 4 + 0], o[q * 4 + 1], o[q * 4 + 2], o[q * 4 + 3]};
    *(f32x4*)(xr + lane * 16 + q * 4) = a;
  }
  if (layer == 0) {
    const float* mv = (const float*)(P.ws + OFF_MODV) + ((size_t)1 * 3 + mod_row(row)) * 6144;
    const float* nw = P.in[I_NORM1] + 1024;
    float hh[16];
#pragma unroll
    for (int q = 0; q < 4; ++q) {
      const int c = lane * 16 + q * 4;
      f32x4 w4 = *(const f32x4*)(nw + c), s4 = *(const f32x4*)(mv + 1024 + c), h4 = *(const f32x4*)(mv + c);
      hh[q * 4 + 0] = o[q * 4 + 0] * rstd * w4.x * (1.f + s4.x) + h4.x; hh[q * 4 + 1] = o[q * 4 + 1] * rstd * w4.y * (1.f + s4.y) + h4.y;
      hh[q * 4 + 2] = o[q * 4 + 2] * rstd * w4.z * (1.f + s4.z) + h4.z; hh[q * 4 + 3] = o[q * 4 + 3] * rstd * w4.w * (1.f + s4.w) + h4.w;
    }
    bf16_t* hb = (bf16_t*)(P.ws + OFF_HBUF) + (size_t)row * 1024 + lane * 16;
    *(u32x4*)hb = pack8(hh);
    *(u32x4*)(hb + 8) = pack8(hh + 8);
  }
}


#define FOR_TILES_XCD(MT0, MT1, NT, mt, nt)                                                     \
  for (int _x = blockIdx.x & 7, _mlo = (MT0) + (((MT1) - (MT0)) * _x) / 8,                        \
           _mhi = (MT0) + (((MT1) - (MT0)) * (_x + 1)) / 8, _i = blockIdx.x >> 3,                 \
           _cnt = (_mhi - _mlo) * (NT), mt = 0, nt = 0;                                           \
       _i < _cnt && ((mt = _mlo + _i / (NT)), (nt = _i % (NT)), true); _i += (int)(gridDim.x >> 3))

#ifndef PHASE_LIST
#define PHASE_LIST(X) X(0) X(1) X(2) X(22) X(23) X(3) X(4) X(5) X(6) X(7) X(8) X(9) X(11) X(12) X(13) X(30) X(14) X(15) X(31) X(16) X(17) X(18) X(19) X(20) X(21)
#endif
constexpr int PH_LAST = 21;

template <int ph>
DEV void run_phase(const Params& P, unsigned char* smem) {
  int bid_ = blockIdx.x, wave_ = threadIdx.x >> 6;
  OPAQUE_S(bid_); OPAQUE(wave_);
  const int bid = bid_, nb = gridDim.x;
  const int wave = wave_;
  unsigned char* ws = P.ws;
  constexpr int layer = ((ph >= 10 && ph <= 21) || ph >= 30) ? 1 : 0;
  const float* modv_l = (const float*)(ws + OFF_MODV) + (size_t)layer * 3 * 6144;
  switch (ph) {
    case 0:
      for (int t = NTRANS + bid; t < NPREP; t += nb) st_prep(P, t, smem);
      break;
    case 1: case 10:
      if (ph == 1) for (int t = nb - 1 - bid; t < NTRANS; t += nb) st_prep(P, t, smem);
      for (int t = bid; t < NTOK / 4; t += nb) st_normmod(P, layer, 0, t * 4 + wave);
      break;
    case 2: {
      EpiProjL0T epi{(bf16_t*)(ws + OFF_PROJ), (float*)(ws + OFF_GATES)};
      FOR_TILES_XCD(0, NTOK / 256, 25, mt, nt)
        gemm_tile_128x256<EpiProjL0T, true>((const bf16_t*)(ws + OFF_WEVIN), 1024, EVC, (const bf16_t*)(ws + OFF_HBUF), 1024, NTOK, 1024,
                                            nt * 128, mt * 256, epi, smem);
    } break;
    case 22:
      for (int t = bid; t < NTOK / 4; t += nb) st_xbc_conv(P, t * 4 + wave);
      for (int t = bid; t < NPCONV; t += nb) st_peer_conv(P, 0, t);
      break;
    case 23:
      for (int t = bid; t < 48 * LA_NSEG; t += nb) {
        int sid = t % 48, seg = t / 48;
        if (sid < 16) st_linattn_seg<true, false>(P, sid, seg, smem);
        else st_linattn_seg<false, false>(P, sid - 16, seg, smem);
      }
      break;
    case 3:
      for (int t = bid; t < 48 * LA_NSEG; t += nb) {
        int sid = t % 48, seg = t / 48;
        if (sid < 16) st_linattn_seg<true, true>(P, sid, seg, smem);
        else st_linattn_seg<false, true>(P, sid - 16, seg, smem);
      }
      break;
    case 4:
      for (int t = bid; t < NTOK / 4; t += nb) st_finish_l0(P, t * 4 + wave);
      break;
    case 5: case 17: {
      EpiOutProjT epi{layer == 0 ? P.in[I_X] : P.out, P.in[I_CTX], P.out, (float*)(ws + OFF_CTXRES), modv_l};
      const bf16_t* Wt = (const bf16_t*)(ws + (layer == 0 ? OFF_WEVOUT : OFF_WODOUT));
      FOR_TILES_XCD(layer == 0 ? 0 : NCTX / 256, NTOK / 256, 8, mt, nt)
        gemm_tile_128x256<EpiOutProjT, true>(Wt, 1024, 1024, (const bf16_t*)(ws + OFF_HBUF), 1024, NTOK, 1024, nt * 128, mt * 256, epi, smem);
    } break;
    case 6: case 18: {
      const int r0 = layer == 0 ? 0 : NCTX / 4;
      for (int t = r0 + bid; t < NTOK / 4; t += nb) st_normmod(P, layer, 1, t * 4 + wave);
      if (ph == 18) for (int t = bid; t < NPCONV; t += nb) st_peer_conv(P, 1, t);
    } break;
    case 7: case 19: {
      EpiStoreBfT epi{(bf16_t*)(ws + OFF_Q), 2048};
      const bf16_t* Wt = (const bf16_t*)(ws + OFF_WQ) + (size_t)layer * 2048 * 1024;
      FOR_TILES_XCD(layer == 0 ? 0 : NCTX / 256, NTOK / 256, 16, mt, nt)
        gemm_tile_128x256<EpiStoreBfT, true>(Wt, 1024, 2048, (const bf16_t*)(ws + OFF_HBUF), 1024, NTOK, 1024, nt * 128, mt * 256, epi, smem);
    } break;
    case 8: case 20: {
      const int t0 = layer == 0 ? 0 : CTILE * 8;
      for (int t = t0 + bid; t < NTILE * 8; t += nb) st_peer_topk(P, layer, t / 8, t % 8, smem);
    } break;
    case 9: case 21: {
      const int r0 = layer == 0 ? 0 : NCTX / 4;
      for (int t = r0 + bid; t < NTOK / 4; t += nb) st_peer_experts(P, layer, t * 4 + wave);
    } break;
    case 11: {
      EpiStoreBfT epi{(bf16_t*)(ws + OFF_PROJ), ODC};
      FOR_TILES_XCD(0, NTOK / 256, 22, mt, nt)
        gemm_tile_128x256<EpiStoreBfT, true>((const bf16_t*)(ws + OFF_WODIN), 1024, ODC, (const bf16_t*)(ws + OFF_HBUF), 1024, NTOK, 1024,
                                             nt * 128, mt * 256, epi, smem);
    } break;
    case 12:
      for (int t = bid; t < NTOK / 8; t += nb) st_lora_act(P, t * 8 + wave * 2);
      break;
    case 13:
      for (int t = bid; t < NTILE * 20; t += nb) {
        int job = t / (NTILE * 4), tt = t % (NTILE * 4);
        int mt = tt / 4, nt = tt % 4;
        bf16_t* dst = (bf16_t*)(ws + OFF_LORA) + (size_t)job * NTOK * 512;
        const bf16_t* A = (const bf16_t*)(ws + OFF_HBUF) + (job < 2 ? 0 : (job < 4 ? 64 : 128));
        const bf16_t* Bt = job < 2 ? (const bf16_t*)(ws + OFF_WUP) + (size_t)job * 512 * 64
                         : job < 4 ? (const bf16_t*)(ws + OFF_AUP) + (size_t)(job - 2) * 512 * 64
                                   : (const bf16_t*)(ws + OFF_GUP);
        const float* bias = job < 2 ? P.in[I_W0] + job * 512 : (job < 4 ? P.in[I_A0] + (job - 2) * 512 : nullptr);
        const int K = job < 4 ? 64 : 128;
        EpiStoreBfBiasT epi{dst, 512, bias};
        gemm_tile_128<false, EpiStoreBfBiasT, true>(Bt, K, 512, A, 1024, NTOK, K, nt * 128, mt * 128, epi, smem);
      }
      break;
    case 30:
      for (int t = bid; t < 32 * RW_NSEG; t += nb) st_rwkv_seg<false>(P, t % 32, t / 32, smem);
      break;
    case 14:
      for (int t = bid; t < 32 * RW_NSEG; t += nb) st_rwkv_seg<true>(P, t % 32, t / 32, smem);
      break;
    case 15:
      for (int t = bid; t < 32 * LRU_NCH; t += nb) st_lru_chunk(P, t % 32, t / 32, smem);
      break;
    case 31:
      if (bid < 32) st_lru_carry(P, bid);
      break;
    case 16:
      for (int t = bid; t < NTOK / 4; t += nb) st_finish_l1(P, t * 4 + wave);
      break;
    default: break;
  }
}


#ifndef CPU_EMU
#define XB_TMO      128
#define XB_XCNT(j)  (256  + 64 * (j))
#define XB_XSUB(j)  (1280 + 64 * (j))
#define XB_XGEN(j)  (2304 + 64 * (j))
#define XB_TOP      3328
#define XB_TOPGEN   3392
#define XCD_BAR_WORDS 3456
#define XB_SPIN_CAP (1u << 20)
#define LAS __attribute__((address_space(3)))
__device__ __forceinline__ unsigned xb_ld(unsigned* p)              { return __hip_atomic_load(p, __ATOMIC_RELAXED, __HIP_MEMORY_SCOPE_AGENT); }
__device__ __forceinline__ unsigned xb_add(unsigned* p, unsigned v) { return __hip_atomic_fetch_add(p, v, __ATOMIC_RELAXED, __HIP_MEMORY_SCOPE_AGENT); }
__device__ __forceinline__ unsigned xb_xcc_id() { return (unsigned)__builtin_amdgcn_s_getreg((3 << 11) | 20) & 0xFu; }
#define XB_SPIN(cond, bar) do { unsigned _sp = 0; while (cond) { __builtin_amdgcn_s_sleep(1); \
    if ((++_sp & 255u) == 0u) { if (xb_ld(&(bar)[XB_TMO])) break; if (_sp > XB_SPIN_CAP) { atomicAdd(&(bar)[XB_TMO], 1u); break; } } } } while (0)
struct XcdBarrier { unsigned* bar; unsigned x; volatile LAS unsigned* st; };
__device__ __forceinline__ XcdBarrier xcd_barrier_post(unsigned* bar, volatile LAS unsigned* st) {
  XcdBarrier b; b.bar = bar; b.x = xb_xcc_id(); b.st = st;
  if (threadIdx.x == 0) (void)xb_add(&bar[XB_XCNT(b.x)], 1u);
  return b;
}
__device__ __forceinline__ void xcd_barrier_complete(unsigned* bar, unsigned x, unsigned& nloc, unsigned& nx) {
  const unsigned G = gridDim.x * gridDim.y * gridDim.z;
  unsigned sum, cnt, mine, sp = 0u;
  for (;;) {
    sum = 0u; cnt = 0u; mine = 0u;
#pragma unroll
    for (unsigned j = 0; j < 16; ++j) { const unsigned c = xb_ld(&bar[XB_XCNT(j)]); sum += c; cnt += (c > 0u) ? 1u : 0u; mine = (j == x) ? c : mine; }
    if (sum == G) break;
    __builtin_amdgcn_s_sleep(1);
    if ((++sp & 255u) == 0u) { if (xb_ld(&bar[XB_TMO])) break; if (sp > XB_SPIN_CAP) { atomicAdd(&bar[XB_TMO], 1u); break; } }
  }
  nloc = mine > 0u ? mine : 1u; nx = cnt > 0u ? cnt : 1u;
}
__device__ __forceinline__ void xcd_barrier(const XcdBarrier& b) {
  asm volatile("s_waitcnt vmcnt(0)" ::: "memory");
  __syncthreads();
  if (threadIdx.x == 0) {
    unsigned* bar = b.bar;
    __builtin_amdgcn_s_waitcnt(0);
    unsigned nloc = b.st[0], nx = b.st[1];
    if (nloc == 0u) { xcd_barrier_complete(bar, b.x, nloc, nx); b.st[0] = nloc; b.st[1] = nx; }
    const unsigned old = xb_add(&bar[XB_XSUB(b.x)], 1u);
    const unsigned gen = old / nloc;
    if (old + 1u == (gen + 1u) * nloc) {
      __builtin_amdgcn_fence(__ATOMIC_RELEASE, "agent");
      asm volatile("s_waitcnt vmcnt(0)" ::: "memory");
      const unsigned og = xb_add(&bar[XB_TOP], 1u);
      const unsigned tg = og / nx;
      if (og + 1u == (tg + 1u) * nx) xb_add(&bar[XB_TOPGEN], 1u);
      else XB_SPIN(xb_ld(&bar[XB_TOPGEN]) == tg, bar);
      __builtin_amdgcn_fence(__ATOMIC_ACQUIRE, "agent");
      xb_add(&bar[XB_XGEN(b.x)], 1u);
      asm volatile("s_waitcnt vmcnt(0)" ::: "memory");
    } else {
      XB_SPIN(xb_ld(&bar[XB_XGEN(b.x)]) == gen, bar);
      __builtin_amdgcn_fence(__ATOMIC_ACQUIRE, "agent");
      asm volatile("s_waitcnt vmcnt(0)" ::: "memory");
    }
  }
  __syncthreads();
}
#endif
#ifndef CPU_EMU
#define RUN_PH(n) run_phase<n>(P, smem_raw); if (n != PH_LAST) xcd_barrier(xb);
__global__ void __launch_bounds__(256, 2) mega_kernel(Params P) {
  SMEM_DECL;
  unsigned* bar = (unsigned*)(P.ws + OFF_BAR);
  volatile LAS unsigned* st = (volatile LAS unsigned*)(smem_raw + SMEM_BYTES - 16);
  if (threadIdx.x == 0) { st[0] = 0u; st[1] = 0u; }
  if (P.ws == nullptr) cg::this_grid().sync();
  __syncthreads();
  XcdBarrier xb = xcd_barrier_post(bar, st);
  PHASE_LIST(RUN_PH)
}

extern "C" void kernel_launch(void* const* d_in, const int* in_sizes, int n_in, void* d_out, int out_size, void* d_ws,
                              size_t ws_size, hipStream_t stream) {
  Params P{};
  for (int i = 0; i < N_IN; ++i) P.in[i] = (const float*)d_in[i];
  P.out = (float*)d_out;
  P.ws = (unsigned char*)d_ws;
  if (ws_size < WS_NEEDED) { fprintf(stderr, "workspace too small: %zu < %zu\n", ws_size, (size_t)WS_NEEDED); return; }
  static int grid_blocks = 0;
  if (!grid_blocks) {
    int dev = 0, cus = 0, per_cu = 0;
    hipGetDevice(&dev);
    hipDeviceGetAttribute(&cus, hipDeviceAttributeMultiprocessorCount, dev);
    hipOccupancyMaxActiveBlocksPerMultiprocessor(&per_cu, mega_kernel, 256, 0);
    if (per_cu > 2) per_cu = 2;
    grid_blocks = cus * per_cu;
  }
  (void)hipMemsetAsync((unsigned char*)d_ws + OFF_BAR, 0, 16384, stream);
  void* args[] = {&P};
  hipError_t e = hipLaunchCooperativeKernel((void*)mega_kernel, dim3(grid_blocks), dim3(256), args, 0, stream);
  if (e != hipSuccess) fprintf(stderr, "cooperative launch failed: %s (grid %d)\n", hipGetErrorString(e), grid_blocks);
}
#endif
```

```cpp
#ifdef CPU_EMU
#include "emu.h"
#else
#include <hip/hip_runtime.h>
#include <hip/hip_cooperative_groups.h>
#include <cstdio>
namespace cg = cooperative_groups;
#define DEV __device__ __forceinline__
#define DEVM __device__ __forceinline__
#define OPAQUE(x) asm volatile("" : "+v"(x))
#define OPAQUE_S(x) asm volatile("" : "+s"(x))
#endif

#ifndef SEQ_LEN
#define SEQ_LEN 16384
#endif
#ifndef CTX_LEN
#define CTX_LEN 256
#endif
#ifndef GRID_W_
#define GRID_W_ 64
#endif
#ifndef MULTI_LAUNCH
#define MULTI_LAUNCH 0
#endif

typedef unsigned short bf16_t;
typedef __attribute__((ext_vector_type(8))) short bf16x8;
typedef __attribute__((ext_vector_type(16))) float f32x16;
typedef __attribute__((ext_vector_type(4))) unsigned u32x4;
typedef __attribute__((ext_vector_type(2))) unsigned u32x2;
typedef __attribute__((ext_vector_type(4))) float f32x4;

constexpr int D = 1024, NB = 2, SEQ = SEQ_LEN, CTXL = CTX_LEN, GW = GRID_W_;
constexpr int NCTX = NB * CTXL, NLAT = NB * SEQ, NTOK = NCTX + NLAT;
constexpr int EVC = 3104, ODC = 2816;
constexpr int NEXP = 16384;
constexpr int NTILE = NTOK / 128, CTILE = NCTX / 128;
static_assert(NTOK % 256 == 0 && NCTX % 256 == 0, "tiles");
static_assert(CTXL % 64 == 0 && SEQ % 64 == 0 && SEQ % GW == 0, "chunks");

constexpr size_t al256(size_t x) { return (x + 255) & ~(size_t)255; }
constexpr size_t OFF_MODV = 0;
constexpr size_t OFF_CTXRES = OFF_MODV + al256(2 * 3 * 6144 * 4);
constexpr size_t OFF_GATES = OFF_CTXRES + al256((size_t)NCTX * 1024 * 4);
constexpr size_t OFF_WEVIN = OFF_GATES + al256((size_t)NTOK * 32 * 4);
constexpr size_t OFF_WEVOUT = OFF_WEVIN + al256((size_t)EVC * 1024 * 2);
constexpr size_t OFF_WODIN = OFF_WEVOUT + al256((size_t)1024 * 1024 * 2);
constexpr size_t OFF_WODOUT = OFF_WODIN + al256((size_t)ODC * 1024 * 2);
constexpr size_t OFF_WQ = OFF_WODOUT + al256((size_t)1024 * 1024 * 2);
constexpr size_t OFF_KEYS = OFF_WQ + al256((size_t)2 * 2048 * 1024 * 2);
constexpr size_t OFF_WUP = OFF_KEYS + al256((size_t)2 * 8 * 2 * 128 * 128 * 2);
constexpr size_t OFF_AUP = OFF_WUP + al256((size_t)2 * 512 * 64 * 2);
constexpr size_t OFF_GUP = OFF_AUP + al256((size_t)2 * 512 * 64 * 2);
constexpr size_t OFF_LRUT = OFF_GUP + al256((size_t)512 * 128 * 2);
constexpr size_t OFF_PU = OFF_LRUT + al256((size_t)2 * 8 * 128 * 64 * 2);
constexpr size_t OFF_PV = OFF_PU + al256((size_t)NEXP * 1024);
constexpr size_t OFF_HBUF = OFF_PV + al256((size_t)NEXP * 1024);
constexpr size_t OFF_PR = OFF_HBUF + al256((size_t)NTOK * 1024 * 2);
constexpr size_t PR_BYTES = (size_t)NTOK * 5376 * 2;
constexpr size_t OFF_BAR = OFF_PR + PR_BYTES;
constexpr size_t OFF_ACUM1 = OFF_BAR + 16384;
constexpr size_t OFF_LRUCS = OFF_ACUM1 + (size_t)NLAT * 512 * 2;
constexpr size_t OFF_LRUHS = OFF_LRUCS + (size_t)32 * ((CTXL + SEQ) / 64) * 128 * 4;
constexpr size_t WS_NEEDED = OFF_LRUHS + (size_t)32 * ((CTXL + SEQ) / 64) * 64 * 4;
#ifndef CPU_EMU
static_assert(WS_NEEDED <= (size_t)512 * 1024 * 1024, "workspace too large");
#endif
constexpr size_t OFF_PROJ = OFF_PR;
constexpr size_t OFF_R2L0 = OFF_PR + (size_t)NTOK * EVC * 2;
constexpr size_t OFF_LORA = OFF_PR + (size_t)NTOK * ODC * 2;
constexpr size_t OFF_Q = OFF_PR;
constexpr size_t OFF_PIDX = OFF_PR + (size_t)NTOK * 2048 * 2;
constexpr size_t OFF_PGATE = OFF_PIDX + (size_t)NTOK * 128 * 4;
static_assert(OFF_PGATE + (size_t)NTOK * 128 * 4 <= OFF_PR + PR_BYTES, "picks");

enum {
  I_X = 0, I_C, I_CTX, I_CCTX, I_MODW, I_MODB, I_NORM1, I_NORM2, I_WQ, I_KEYS, I_PU, I_PV,
  I_EVWIN, I_EVWOUT, I_IBIAS, I_FBIAS, I_MNORM, I_SCONVW, I_SCONVB, I_DTBIAS, I_ALOG, I_DSKIP, I_SNORM,
  I_ODWIN, I_ODWOUT, I_MU, I_W0, I_WUP, I_A0, I_AUP, I_GUP, I_KK, I_KA, I_RK, I_LNW, I_LNB,
  I_LCONVW, I_LCONVB, I_LAM, I_WA, I_BA, I_WI, I_BI, I_FNORM, N_IN
};

struct Params {
  const float* in[N_IN];
  float* out;
  unsigned char* ws;
};

constexpr int SMEM_BYTES = 80 * 1024;
#ifdef CPU_EMU
#define SMEM_DECL static thread_local __attribute__((aligned(16))) unsigned char smem_raw[SMEM_BYTES]
#else
#define SMEM_DECL __shared__ __attribute__((aligned(16))) unsigned char smem_raw[SMEM_BYTES]
#endif

DEV float bf2f(bf16_t v) { unsigned u = ((unsigned)v) << 16; float f; __builtin_memcpy(&f, &u, 4); return f; }
DEV bf16_t f2bf(float f) { unsigned u; __builtin_memcpy(&u, &f, 4); u += 0x7fffu + ((u >> 16) & 1u); return (bf16_t)(u >> 16); }
DEV unsigned pack2(float a, float b) { return (unsigned)f2bf(a) | ((unsigned)f2bf(b) << 16); }
DEV void unpack8(const u32x4& r, float* o) {
  unsigned w[4] = {r.x, r.y, r.z, r.w};
#pragma unroll
  for (int i = 0; i < 4; ++i) { unsigned lo = w[i] << 16, hi = w[i] & 0xffff0000u; __builtin_memcpy(&o[2 * i], &lo, 4); __builtin_memcpy(&o[2 * i + 1], &hi, 4); }
}
DEV u32x4 pack8(const float* o) { u32x4 r; r.x = pack2(o[0], o[1]); r.y = pack2(o[2], o[3]); r.z = pack2(o[4], o[5]); r.w = pack2(o[6], o[7]); return r; }
#ifdef CPU_EMU
DEV float fexp(float x) { return expf(x); }
DEV float frcp(float x) { return 1.f / x; }
DEV float flog(float x) { return logf(x); }
DEV float frsq(float x) { return 1.f / sqrtf(x); }
DEV float fsqrt(float x) { return sqrtf(x); }
#else
DEV float fexp(float x) { return __expf(x); }
DEV float frcp(float x) { return __builtin_amdgcn_rcpf(x); }
DEV float flog(float x) { return __logf(x); }
DEV float frsq(float x) { return __builtin_amdgcn_rsqf(x); }
DEV float fsqrt(float x) { return __builtin_amdgcn_sqrtf(x); }
#endif
DEV void ld8(const float* __restrict__ p, float* o) { const f32x4 a = *(const f32x4*)p, b = *(const f32x4*)(p + 4); o[0] = a.x; o[1] = a.y; o[2] = a.z; o[3] = a.w; o[4] = b.x; o[5] = b.y; o[6] = b.z; o[7] = b.w; }
DEV float sigmoidf_(float x) { return frcp(1.f + fexp(-x)); }
DEV float siluf_(float x) { return x * frcp(1.f + fexp(-x)); }
DEV float softplusf_(float x) { return fmaxf(x, 0.f) + flog(1.f + fexp(-fabsf(x))); }
DEV float tanhf_(float x) { return 1.f - 2.f * frcp(1.f + fexp(2.f * x)); }
DEV float geluf_(float x) { return 0.5f * x * (1.f + erff(x * 0.70710678118654752f)); }

DEV f32x16 mfma32(bf16x8 a, bf16x8 b, f32x16 c) {
#ifdef CPU_EMU
  return emu_mfma32(a, b, c);
#else
  return __builtin_amdgcn_mfma_f32_32x32x16_bf16(a, b, c, 0, 0, 0);
#endif
}
DEV float wshfl_xor(float v, int m) {
#ifdef CPU_EMU
  return emu_shfl_xor(v, m);
#else
  return __shfl_xor(v, m, 64);
#endif
}
DEV float wave_sum(float v) {
#pragma unroll
  for (int m = 32; m >= 1; m >>= 1) v += wshfl_xor(v, m);
  return v;
}

#ifdef CPU_EMU
static inline unsigned emu_f2fp8(float f) {
  unsigned sgn = f < 0.f ? 0x80u : 0u; float a = fabsf(f);
  if (!(a == a)) return 0x7f;
  if (a >= 448.f) return sgn | 0x7e;
  if (a < 0.0009765625f) return sgn;
  int e; frexpf(a, &e); e -= 1;
  if (e < -6) { int q = (int)nearbyintf(a * 512.f); return sgn | (unsigned)q; }
  float m = a / ldexpf(1.f, e);
  int q = (int)nearbyintf((m - 1.f) * 8.f);
  if (q == 8) { q = 0; e += 1; }
  if (e > 8) return sgn | 0x7e;
  return sgn | (unsigned)((e + 7) << 3) | (unsigned)q;
}
static inline float emu_fp82f(unsigned c) {
  unsigned sgn = c & 0x80, e = (c >> 3) & 15, m = c & 7;
  float v = e == 0 ? ldexpf((float)m, -9) : ldexpf(1.f + m / 8.f, (int)e - 7);
  return sgn ? -v : v;
}
#endif
DEV unsigned pack4_fp8(float a, float b, float c, float d) {
#ifdef CPU_EMU
  return emu_f2fp8(a) | (emu_f2fp8(b) << 8) | (emu_f2fp8(c) << 16) | (emu_f2fp8(d) << 24);
#else
  int w = 0;
  w = __builtin_amdgcn_cvt_pk_fp8_f32(a, b, w, false);
  w = __builtin_amdgcn_cvt_pk_fp8_f32(c, d, w, true);
  return (unsigned)w;
#endif
}
DEV void unpack4_fp8(unsigned w, float* o) {
#ifdef CPU_EMU
  o[0] = emu_fp82f(w & 255); o[1] = emu_fp82f((w >> 8) & 255); o[2] = emu_fp82f((w >> 16) & 255); o[3] = emu_fp82f(w >> 24);
#else
  typedef __attribute__((ext_vector_type(2))) float f32x2_;
  f32x2_ lo = __builtin_amdgcn_cvt_pk_f32_fp8((int)w, false);
  f32x2_ hi = __builtin_amdgcn_cvt_pk_f32_fp8((int)w, true);
  o[0] = lo.x; o[1] = lo.y; o[2] = hi.x; o[3] = hi.y;
#endif
}
DEV void unpack16_fp8(const u32x4& r, float* o) { unpack4_fp8(r.x, o); unpack4_fp8(r.y, o + 4); unpack4_fp8(r.z, o + 8); unpack4_fp8(r.w, o + 12); }
DEV float wreadlane(float v, int srclane) {
#ifdef CPU_EMU
  return emu_readlane(v, srclane);
#else
  int iv; __builtin_memcpy(&iv, &v, 4);
  int r = __builtin_amdgcn_readlane(iv, srclane);
  float f; __builtin_memcpy(&f, &r, 4); return f;
#endif
}
constexpr float PEER_USCALE = 64.f, PEER_VSCALE = 4.f;
#ifdef CPU_EMU
static inline unsigned emu_f2fp4(float f) {
  static const float lv[8] = {0.f, 0.5f, 1.f, 1.5f, 2.f, 3.f, 4.f, 6.f};
  unsigned sgn = f < 0.f ? 8u : 0u; float a = fabsf(f);
  int best = 0; float bd = 1e30f;
  for (int i = 0; i < 8; ++i) { float dd = fabsf(a - lv[i]); if (dd < bd || (dd == bd && (i & 1) == 0)) { bd = dd; best = i; } }
  return sgn | (unsigned)best;
}
static inline float emu_fp42f(unsigned c) {
  static const float lv[8] = {0.f, 0.5f, 1.f, 1.5f, 2.f, 3.f, 4.f, 6.f};
  float v = lv[c & 7]; return (c & 8) ? -v : v;
}
#endif
DEV unsigned pack8_fp4(const float* v) {
#ifdef CPU_EMU
  unsigned w = 0;
  for (int i = 0; i < 8; ++i) w |= emu_f2fp4(v[i]) << (4 * i);
  return w;
#else
  unsigned w = 0;
  w = __builtin_amdgcn_cvt_scalef32_pk_fp4_f32(w, v[0], v[1], 1.0f, 0);
  w = __builtin_amdgcn_cvt_scalef32_pk_fp4_f32(w, v[2], v[3], 1.0f, 1);
  w = __builtin_amdgcn_cvt_scalef32_pk_fp4_f32(w, v[4], v[5], 1.0f, 2);
  w = __builtin_amdgcn_cvt_scalef32_pk_fp4_f32(w, v[6], v[7], 1.0f, 3);
  return w;
#endif
}
DEV void unpack8_fp4(unsigned w, float* o) {
#ifdef CPU_EMU
  for (int i = 0; i < 8; ++i) o[i] = emu_fp42f((w >> (4 * i)) & 15u);
#else
  typedef __attribute__((ext_vector_type(2))) float f32x2_;
  f32x2_ a = __builtin_amdgcn_cvt_scalef32_pk_f32_fp4(w, 1.0f, 0);
  f32x2_ b = __builtin_amdgcn_cvt_scalef32_pk_f32_fp4(w, 1.0f, 1);
  f32x2_ c = __builtin_amdgcn_cvt_scalef32_pk_f32_fp4(w, 1.0f, 2);
  f32x2_ d = __builtin_amdgcn_cvt_scalef32_pk_f32_fp4(w, 1.0f, 3);
  o[0] = a.x; o[1] = a.y; o[2] = b.x; o[3] = b.y; o[4] = c.x; o[5] = c.y; o[6] = d.x; o[7] = d.y;
#endif
}
typedef __attribute__((ext_vector_type(3))) unsigned u32x3;
#ifndef FP6_INTERLEAVED
#define FP6_INTERLEAVED 1
#endif
#ifdef CPU_EMU
static inline unsigned emu_f2fp6(float f) {
  unsigned sgn = f < 0.f ? 32u : 0u; float a = fabsf(f);
  if (a >= 7.5f) return sgn | 31u;
  int e; unsigned code;
  if (a < 1.f) { int q = (int)nearbyintf(a * 8.f); code = (unsigned)q; }
  else { frexpf(a, &e); e -= 1; float m = a / ldexpf(1.f, e); int q = (int)nearbyintf((m - 1.f) * 8.f); if (q == 8) { q = 0; e += 1; } code = (unsigned)(((e + 1) << 3) | q); if (e > 2) code = 31u; }
  return sgn | code;
}
static inline float emu_fp62f(unsigned c) {
  unsigned e = (c >> 3) & 3, m = c & 7;
  float v = e == 0 ? m * 0.125f : ldexpf(1.f + m / 8.f, (int)e - 1);
  return (c & 32) ? -v : v;
}
#endif
DEV u32x3 pack16_fp6(const float* v) {
#ifdef CPU_EMU
  unsigned long long lo = 0; unsigned hi = 0;
  for (int i = 0; i < 16; ++i) {
    unsigned long long c = emu_f2fp6(v[i]); int bit = 6 * i;
    if (bit < 64) { lo |= c << bit; if (bit > 58) hi |= (unsigned)(c >> (64 - bit)); } else hi |= (unsigned)(c << (bit - 64));
  }
  u32x3 r; r.x = (unsigned)lo; r.y = (unsigned)(lo >> 32); r.z = hi; return r;
#else
  typedef __attribute__((ext_vector_type(6))) unsigned u32x6_;
  f32x16 a, b;
#if FP6_INTERLEAVED
#pragma unroll
  for (int i = 0; i < 8; ++i) { a[i] = v[2 * i]; b[i] = v[2 * i + 1]; a[8 + i] = 0.f; b[8 + i] = 0.f; }
#else
#pragma unroll
  for (int i = 0; i < 16; ++i) { a[i] = v[i]; b[i] = 0.f; }
#endif
  u32x6_ w = __builtin_amdgcn_cvt_scalef32_2xpk16_fp6_f32(a, b, 1.0f);
  u32x3 r; r.x = w[0]; r.y = w[1]; r.z = w[2]; return r;
#endif
}
DEV void unpack16_fp6(const u32x3& r, float* o) {
#ifdef CPU_EMU
  unsigned long long lo = (unsigned long long)r.x | ((unsigned long long)r.y << 32); unsigned hi = r.z;
  for (int i = 0; i < 16; ++i) {
    int bit = 6 * i; unsigned c;
    if (bit + 6 <= 64) c = (unsigned)(lo >> bit) & 63u;
    else if (bit >= 64) c = (hi >> (bit - 64)) & 63u;
    else c = ((unsigned)(lo >> bit) | (hi << (64 - bit))) & 63u;
    o[i] = emu_fp62f(c);
  }
#else
  typedef __attribute__((ext_vector_type(6))) unsigned u32x6_;
  typedef __attribute__((ext_vector_type(32))) float f32x32_;
  u32x6_ w; w[0] = r.x; w[1] = r.y; w[2] = r.z; w[3] = 0u; w[4] = 0u; w[5] = 0u;
  f32x32_ f = __builtin_amdgcn_cvt_scalef32_pk32_f32_fp6(w, 1.0f);
#pragma unroll
  for (int i = 0; i < 16; ++i) o[i] = f[i];
#endif
}
DEV void unpack2x16_fp6(const u32x3& ra, const u32x3& rb, float* oa, float* ob) {
#ifdef CPU_EMU
  unpack16_fp6(ra, oa); unpack16_fp6(rb, ob);
#else
  typedef __attribute__((ext_vector_type(6))) unsigned u32x6_;
  typedef __attribute__((ext_vector_type(32))) float f32x32_;
  u32x6_ w; w[0] = ra.x; w[1] = ra.y; w[2] = ra.z; w[3] = rb.x; w[4] = rb.y; w[5] = rb.z;
  f32x32_ f = __builtin_amdgcn_cvt_scalef32_pk32_f32_fp6(w, 1.0f);
#pragma unroll
  for (int i = 0; i < 16; ++i) { oa[i] = f[i]; ob[i] = f[16 + i]; }
#endif
}
constexpr int PEER_ROWB = 1280;
constexpr int PEER_VOFF = 768;


DEV int acc_row(int reg, int lane) { return (reg & 3) + 8 * (reg >> 2) + 4 * (lane >> 5); }

DEV int mod_row(int row) { return row < NCTX ? 2 : (row - NCTX) / SEQ; }

template <bool SYNC_EPI, class Epi, bool VEC4 = false>
DEV void gemm_tile_128(const bf16_t* __restrict__ A, int lda, int M, const bf16_t* __restrict__ Bt, int ldb, int N,
                       int K, int m0, int n0, const Epi& epi, unsigned char* smem) {
  constexpr int LS = 72;
  constexpr int STAGE = 2 * 128 * LS;
  bf16_t* sbase = (bf16_t*)smem;
  const int wave = threadIdx.x >> 6;
  const int wm = (wave >> 1) * 64, wn = (wave & 1) * 64;
  f32x16 acc[2][2];
#pragma unroll
  for (int i = 0; i < 2; ++i)
#pragma unroll
    for (int j = 0; j < 2; ++j)
#pragma unroll
      for (int r = 0; r < 16; ++r) acc[i][j][r] = 0.f;
  u32x4 ra[4], rb[4];
  auto gload = [&](int k0) {
    int tl_ = threadIdx.x; OPAQUE(tl_);
#pragma unroll
    for (int i = 0; i < 4; ++i) {
      int c = tl_ + i * 256, r = c >> 3, cc = (c & 7) * 8;
      int gr = m0 + r, gn = n0 + r;
      gr = gr < M ? gr : M - 1; gn = gn < N ? gn : N - 1;
      ra[i] = *(const u32x4*)(A + (size_t)gr * lda + k0 + cc);
      rb[i] = *(const u32x4*)(Bt + (size_t)gn * ldb + k0 + cc);
    }
  };
  auto lwrite = [&](int buf) {
    int tl_ = threadIdx.x; OPAQUE(tl_);
    bf16_t* sA = sbase + buf * STAGE;
    bf16_t* sB = sA + 128 * LS;
#pragma unroll
    for (int i = 0; i < 4; ++i) {
      int c = tl_ + i * 256, r = c >> 3, cc = (c & 7) * 8;
      *(u32x4*)(sA + r * LS + cc) = ra[i];
      *(u32x4*)(sB + r * LS + cc) = rb[i];
    }
  };
  const int nk = K >> 6;
  gload(0);
  __syncthreads();
  lwrite(0);
  if (nk > 1) gload(64);
  __syncthreads();
  for (int it = 0; it < nk; ++it) {
    int tl_ = threadIdx.x; OPAQUE(tl_);
    const int lane = tl_ & 63;
    const bf16_t* sA = sbase + (it & 1) * STAGE;
    const bf16_t* sB = sA + 128 * LS;
#pragma unroll
    for (int kk = 0; kk < 4; ++kk) {
      bf16x8 a[2], b[2];
      const int ko = kk * 16 + 8 * (lane >> 5);
#pragma unroll
      for (int i = 0; i < 2; ++i) a[i] = *(const bf16x8*)(sA + (wm + i * 32 + (lane & 31)) * LS + ko);
#pragma unroll
      for (int j = 0; j < 2; ++j) b[j] = *(const bf16x8*)(sB + (wn + j * 32 + (lane & 31)) * LS + ko);
#pragma unroll
      for (int i = 0; i < 2; ++i)
#pragma unroll
        for (int j = 0; j < 2; ++j) acc[i][j] = mfma32(a[i], b[j], acc[i][j]);
      if (kk == 1) {
        if (it + 1 < nk) lwrite((it + 1) & 1);
        if (it + 2 < nk) gload((it + 2) * 64);
      }
    }
    __syncthreads();
  }
  {
    int tl_ = threadIdx.x; OPAQUE(tl_);
    const int lane = tl_ & 63;
    if constexpr (VEC4) {
#pragma unroll
      for (int i = 0; i < 2; ++i)
#pragma unroll
        for (int j = 0; j < 2; ++j)
#pragma unroll
          for (int gq = 0; gq < 4; ++gq) {
            int row = m0 + wm + i * 32 + 8 * gq + 4 * (lane >> 5);
            int col = n0 + wn + j * 32 + (lane & 31);
            if (row < M && col < N) epi.store4(row, col, acc[i][j][4 * gq], acc[i][j][4 * gq + 1], acc[i][j][4 * gq + 2], acc[i][j][4 * gq + 3]);
          }
    } else {
#pragma unroll
      for (int i = 0; i < 2; ++i)
#pragma unroll
        for (int j = 0; j < 2; ++j)
#pragma unroll
          for (int r = 0; r < 16; ++r) {
            int row = m0 + wm + i * 32 + acc_row(r, lane);
            int col = n0 + wn + j * 32 + (lane & 31);
            if (row < M && col < N) epi(row, col, acc[i][j][r]);
          }
    }
  }
}

template <class Epi, bool VEC4 = false>
DEV void gemm_tile_128x256(const bf16_t* __restrict__ A, int lda, int M, const bf16_t* __restrict__ Bt, int ldb, int N,
                           int K, int m0, int n0, const Epi& epi, unsigned char* smem) {
  constexpr int LS = 72;
  bf16_t* sA = (bf16_t*)smem;
  bf16_t* sB = sA + 128 * LS;
  const int wave = threadIdx.x >> 6;
  const int wm = (wave >> 1) * 64, wn = (wave & 1) * 128;
  f32x16 acc[2][4];
#pragma unroll
  for (int i = 0; i < 2; ++i)
#pragma unroll
    for (int j = 0; j < 4; ++j)
#pragma unroll
      for (int r = 0; r < 16; ++r) acc[i][j][r] = 0.f;
  u32x4 ra[4], rb[8];
  {
    const int tid = threadIdx.x;
#pragma unroll
    for (int i = 0; i < 4; ++i) {
      int c = tid + i * 256, r = c >> 3, cc = (c & 7) * 8;
      { int gr = m0 + r; gr = gr < M ? gr : M - 1; ra[i] = *(const u32x4*)(A + (size_t)gr * lda + cc); }
    }
#pragma unroll
    for (int i = 0; i < 8; ++i) {
      int c = tid + i * 256, r = c >> 3, cc = (c & 7) * 8;
      { int gn = n0 + r; gn = gn < N ? gn : N - 1; rb[i] = *(const u32x4*)(Bt + (size_t)gn * ldb + cc); }
    }
  }
  for (int k0 = 0; k0 < K; k0 += 64) {
    int tl_ = threadIdx.x; OPAQUE(tl_);
    const int tid = tl_, lane = tl_ & 63;
    __syncthreads();
#pragma unroll
    for (int i = 0; i < 4; ++i) { int c = tid + i * 256, r = c >> 3, cc = (c & 7) * 8; *(u32x4*)(sA + r * LS + cc) = ra[i]; }
#pragma unroll
    for (int i = 0; i < 8; ++i) { int c = tid + i * 256, r = c >> 3, cc = (c & 7) * 8; *(u32x4*)(sB + r * LS + cc) = rb[i]; }
    __syncthreads();
    if (k0 + 64 < K) {
#pragma unroll
      for (int i = 0; i < 4; ++i) {
        int c = tid + i * 256, r = c >> 3, cc = (c & 7) * 8;
        { int gr = m0 + r; gr = gr < M ? gr : M - 1; ra[i] = *(const u32x4*)(A + (size_t)gr * lda + k0 + 64 + cc); }
      }
#pragma unroll
      for (int i = 0; i < 8; ++i) {
        int c = tid + i * 256, r = c >> 3, cc = (c & 7) * 8;
        { int gn = n0 + r; gn = gn < N ? gn : N - 1; rb[i] = *(const u32x4*)(Bt + (size_t)gn * ldb + k0 + 64 + cc); }
      }
    }
#pragma unroll 2
    for (int kk = 0; kk < 4; ++kk) {
      bf16x8 a[2], b[4];
      const int ko = kk * 16 + 8 * (lane >> 5);
#pragma unroll
      for (int i = 0; i < 2; ++i) a[i] = *(const bf16x8*)(sA + (wm + i * 32 + (lane & 31)) * LS + ko);
#pragma unroll
      for (int j = 0; j < 4; ++j) b[j] = *(const bf16x8*)(sB + (wn + j * 32 + (lane & 31)) * LS + ko);
#pragma unroll
      for (int i = 0; i < 2; ++i)
#pragma unroll
        for (int j = 0; j < 4; ++j) acc[i][j] = mfma32(a[i], b[j], acc[i][j]);
    }
  }
  {
    int tl_ = threadIdx.x; OPAQUE(tl_);
    const int lane = tl_ & 63;
    if constexpr (VEC4) {
#pragma unroll
      for (int i = 0; i < 2; ++i)
#pragma unroll
        for (int j = 0; j < 4; ++j)
#pragma unroll
          for (int gq = 0; gq < 4; ++gq) {
            int row = m0 + wm + i * 32 + 8 * gq + 4 * (lane >> 5);
            int col = n0 + wn + j * 32 + (lane & 31);
            if (row < M && col < N) epi.store4(row, col, acc[i][j][4 * gq], acc[i][j][4 * gq + 1], acc[i][j][4 * gq + 2], acc[i][j][4 * gq + 3]);
          }
    } else {
#pragma unroll
      for (int i = 0; i < 2; ++i)
#pragma unroll
        for (int j = 0; j < 4; ++j)
#pragma unroll
          for (int r = 0; r < 16; ++r) {
            int row = m0 + wm + i * 32 + acc_row(r, lane);
            int col = n0 + wn + j * 32 + (lane & 31);
            if (row < M && col < N) epi(row, col, acc[i][j][r]);
          }
    }
  }
}

DEV void transpose_tile(const float* __restrict__ src, int ld_src, bf16_t* __restrict__ dst, int ld_dst, int K, int N,
                        int tk, int tn, unsigned char* smem) {
  float* sT = (float*)smem;
  const int tid = threadIdx.x;
  __syncthreads();
  {
    const int tx = tid & 15, ty = tid >> 4;
#pragma unroll
    for (int p = 0; p < 4; ++p) {
      int k = tk * 64 + ty + p * 16, n = tn * 64 + tx * 4;
      f32x4 v4 = {0.f, 0.f, 0.f, 0.f};
      if (k < K && n < N) v4 = *(const f32x4*)(src + (size_t)k * ld_src + n);
      float* d = sT + (ty + p * 16) * 65 + tx * 4;
      d[0] = v4.x; d[1] = v4.y; d[2] = v4.z; d[3] = v4.w;
    }
  }
  __syncthreads();
  {
    const int n = tid >> 2, kseg = (tid & 3) * 16;
    int gn = tn * 64 + n;
    if (gn < N) {
      float v[16];
#pragma unroll
      for (int j = 0; j < 16; ++j) v[j] = sT[(kseg + j) * 65 + n];
      bf16_t* d = dst + (size_t)gn * ld_dst + tk * 64 + kseg;
      *(u32x4*)d = pack8(v);
      *(u32x4*)(d + 8) = pack8(v + 8);
    }
  }
}

constexpr int TJ0 = 16 * 49, TJ1 = 16 * 16, TJ2 = 16 * 44, TJ3 = 16 * 16, TJ4 = 2 * 16 * 32, TJ5 = 2 * 8, TJ6 = 2 * 8,
              TJ7 = 2 * 8, TJ8 = 32;
constexpr int NTRANS = TJ0 + TJ1 + TJ2 + TJ3 + TJ4 + TJ5 + TJ6 + TJ7 + TJ8;
constexpr int NKEYCV = (2 * 8 * 2 * 128 * 128) / (256 * 8);
constexpr int NMODV = 2 * 96;
constexpr int NPREP = NTRANS + NKEYCV + NMODV;

DEV void st_prep(const Params& P, int item, unsigned char* smem) {
  unsigned char* ws = P.ws;
  if (item < NTRANS) {
    int t = item;
    if (t < TJ0) { transpose_tile(P.in[I_EVWIN], EVC, (bf16_t*)(ws + OFF_WEVIN), 1024, 1024, EVC, t / 49, t % 49, smem); return; }
    t -= TJ0;
    if (t < TJ1) { transpose_tile(P.in[I_EVWOUT], 1024, (bf16_t*)(ws + OFF_WEVOUT), 1024, 1024, 1024, t / 16, t % 16, smem); return; }
    t -= TJ1;
    if (t < TJ2) { transpose_tile(P.in[I_ODWIN], ODC, (bf16_t*)(ws + OFF_WODIN), 1024, 1024, ODC, t / 44, t % 44, smem); return; }
    t -= TJ2;
    if (t < TJ3) { transpose_tile(P.in[I_ODWOUT], 1024, (bf16_t*)(ws + OFF_WODOUT), 1024, 1024, 1024, t / 16, t % 16, smem); return; }
    t -= TJ3;
    if (t < TJ4) {
      int l = t / 512, tt = t % 512;
      transpose_tile(P.in[I_WQ] + (size_t)l * 1024 * 2048, 2048, (bf16_t*)(ws + OFF_WQ) + (size_t)l * 2048 * 1024, 1024, 1024, 2048, tt / 32, tt % 32, smem);
      return;
    }
    t -= TJ4;
    if (t < TJ5) { int d = t / 8; transpose_tile(P.in[I_WUP] + d * 64 * 512, 512, (bf16_t*)(ws + OFF_WUP) + d * 512 * 64, 64, 64, 512, 0, t % 8, smem); return; }
    t -= TJ5;
    if (t < TJ6) { int d = t / 8; transpose_tile(P.in[I_AUP] + d * 64 * 512, 512, (bf16_t*)(ws + OFF_AUP) + d * 512 * 64, 64, 64, 512, 0, t % 8, smem); return; }
    t -= TJ6;
    if (t < TJ7) { transpose_tile(P.in[I_GUP], 512, (bf16_t*)(ws + OFF_GUP), 128, 128, 512, t / 8, t % 8, smem); return; }
    t -= TJ7;
    {
      int which = t & 1, db = t >> 1;
      const float* src = (which ? P.in[I_WI] : P.in[I_WA]) + (size_t)db * 64 * 64;
      transpose_tile(src, 64, (bf16_t*)(ws + OFF_LRUT) + (size_t)db * 128 * 64 + which * 64 * 64, 64, 64, 64, 0, 0, smem);
      return;
    }
  }
  item -= NTRANS;
  if (item < NKEYCV) {
    size_t e = ((size_t)item * 256 + threadIdx.x) * 8;
    const float* s = P.in[I_KEYS] + e;
    f32x4 a = *(const f32x4*)s, b = *(const f32x4*)(s + 4);
    float v[8] = {a.x, a.y, a.z, a.w, b.x, b.y, b.z, b.w};
    *(u32x4*)((bf16_t*)(ws + OFF_KEYS) + e) = pack8(v);
    return;
  }
  item -= NKEYCV;
  {
    const int l = item / 96, cgp = item % 96;
    float* sS = (float*)smem;
    float* sRed = sS + 3 * 1024;
    const int tid = threadIdx.x;
    __syncthreads();
    for (int i = tid; i < 3 * 1024; i += 256) {
      int m = i >> 10, k = i & 1023;
      float c = m < 2 ? P.in[I_C][m * 1024 + k] : P.in[I_CCTX][k];
      sS[i] = siluf_(c);
    }
    __syncthreads();
    const int ks = tid >> 6, col = cgp * 64 + (tid & 63);
    const float* w = P.in[I_MODW] + (size_t)l * 1024 * 6144 + col;
    float a0 = 0.f, a1 = 0.f, a2 = 0.f;
    for (int k = ks * 256; k < ks * 256 + 256; ++k) {
      float wv = w[(size_t)k * 6144];
      a0 += sS[k] * wv; a1 += sS[1024 + k] * wv; a2 += sS[2048 + k] * wv;
    }
    sRed[(ks * 3 + 0) * 64 + (tid & 63)] = a0;
    sRed[(ks * 3 + 1) * 64 + (tid & 63)] = a1;
    sRed[(ks * 3 + 2) * 64 + (tid & 63)] = a2;
    __syncthreads();
    if (tid < 192) {
      int m = tid >> 6, c = tid & 63;
      float s = sRed[(0 * 3 + m) * 64 + c] + sRed[(1 * 3 + m) * 64 + c] + sRed[(2 * 3 + m) * 64 + c] + sRed[(3 * 3 + m) * 64 + c];
      int cc = cgp * 64 + c;
      ((float*)(ws + OFF_MODV))[((size_t)l * 3 + m) * 6144 + cc] = s + P.in[I_MODB][l * 6144 + cc];
    }
  }
}

constexpr int NPCONV = 2 * (NEXP * 1024 / (256 * 16));
DEV void st_peer_conv(const Params& P, int layer, int item) {
  const int half = NPCONV / 2;
  int which = item >= half;
  int it = which ? item - half : item;
  size_t e = ((size_t)it * 256 + threadIdx.x) * 16;
  const float* s = (which ? P.in[I_PV] : P.in[I_PU]) + (size_t)layer * NEXP * 1024 + e;
  const float sc = which ? PEER_VSCALE : PEER_USCALE;
  float v16[16];
#pragma unroll
  for (int q = 0; q < 4; ++q) {
    f32x4 a = *(const f32x4*)(s + 4 * q);
    v16[4 * q] = a.x * sc; v16[4 * q + 1] = a.y * sc; v16[4 * q + 2] = a.z * sc; v16[4 * q + 3] = a.w * sc;
  }
  const size_t ex = e >> 10, col = e & 1023;
  if (which) {
    u32x2 o; o.x = pack8_fp4(v16); o.y = pack8_fp4(v16 + 8);
    *(u32x2*)(P.ws + OFF_PU + ex * PEER_ROWB + PEER_VOFF + (col >> 1)) = o;
  } else {
    u32x3 o = pack16_fp6(v16);
    unsigned* dp = (unsigned*)(P.ws + OFF_PU + ex * PEER_ROWB + (col >> 4) * 12);
    dp[0] = o.x; dp[1] = o.y; dp[2] = o.z;
  }
}

DEV void st_normmod(const Params& P, int layer, int which, int row) {
  const int lane = threadIdx.x & 63;
  const float* src;
  if (which == 0 && layer == 0) src = row < NCTX ? P.in[I_CTX] + (size_t)row * 1024 : P.in[I_X] + (size_t)(row - NCTX) * 1024;
  else src = row < NCTX ? (const float*)(P.ws + OFF_CTXRES) + (size_t)row * 1024 : P.out + (size_t)(row - NCTX) * 1024;
  const float* mv = (const float*)(P.ws + OFF_MODV) + ((size_t)layer * 3 + mod_row(row)) * 6144;
  const float* sh = mv + (which ? 3 : 0) * 1024;
  const float* sc = mv + (which ? 4 : 1) * 1024;
  const float* nw = (which ? P.in[I_NORM2] : P.in[I_NORM1]) + layer * 1024;
  f32x4 v[4];
  float ss = 0.f;
#pragma unroll
  for (int i = 0; i < 4; ++i) {
    v[i] = *(const f32x4*)(src + i * 256 + lane * 4);
    ss += v[i].x * v[i].x + v[i].y * v[i].y + v[i].z * v[i].z + v[i].w * v[i].w;
  }
  ss = wave_sum(ss);
  const float rstd = frsq(ss * (1.f / 1024.f) + 1e-6f);
  bf16_t* dst = (bf16_t*)(P.ws + OFF_HBUF) + (size_t)row * 1024;
#pragma unroll
  for (int i = 0; i < 4; ++i) {
    int c = i * 256 + lane * 4;
    f32x4 w4 = *(const f32x4*)(nw + c), s4 = *(const f32x4*)(sc + c), h4 = *(const f32x4*)(sh + c);
    float o0 = v[i].x * rstd * w4.x * (1.f + s4.x) + h4.x;
    float o1 = v[i].y * rstd * w4.y * (1.f + s4.y) + h4.y;
    float o2 = v[i].z * rstd * w4.z * (1.f + s4.z) + h4.z;
    float o3 = v[i].w * rstd * w4.w * (1.f + s4.w) + h4.w;
    u32x2 pk; pk.x = pack2(o0, o1); pk.y = pack2(o2, o3);
    *(u32x2*)(dst + c) = pk;
  }
}

struct EpiProjL0 {
  bf16_t* proj; float* gates;
  DEVM void operator()(int row, int col, float v) const {
    proj[(size_t)row * EVC + col] = f2bf(v);
    if (col >= 1536 && col < 1552) gates[row * 32 + (col - 1536)] = v;
    else if (col >= 3088) gates[row * 32 + 16 + (col - 3088)] = v;
  }
};
struct EpiStoreBf {
  bf16_t* dst; int ld;
  DEVM void operator()(int row, int col, float v) const { dst[(size_t)row * ld + col] = f2bf(v); }
};
struct EpiStoreBfBias {
  bf16_t* dst; int ld; const float* bias;
  DEVM void operator()(int row, int col, float v) const { dst[(size_t)row * ld + col] = f2bf(v + (bias ? bias[col] : 0.f)); }
};
struct EpiProjL0T {
  bf16_t* proj; float* gates;
  DEVM void operator()(int, int, float) const {}
  DEVM void store4(int n, int m, float v0, float v1, float v2, float v3) const {
    u32x2 pk; pk.x = pack2(v0, v1); pk.y = pack2(v2, v3);
    *(u32x2*)(proj + (size_t)m * EVC + n) = pk;
    if (n >= 1536 && n < 1552) { f32x4 g = {v0, v1, v2, v3}; *(f32x4*)(gates + m * 32 + (n - 1536)) = g; }
    else if (n >= 3088) { f32x4 g = {v0, v1, v2, v3}; *(f32x4*)(gates + m * 32 + 16 + (n - 3088)) = g; }
  }
};
struct EpiStoreBfT {
  bf16_t* dst; int ld;
  DEVM void operator()(int, int, float) const {}
  DEVM void store4(int n, int m, float v0, float v1, float v2, float v3) const {
    u32x2 pk; pk.x = pack2(v0, v1); pk.y = pack2(v2, v3);
    *(u32x2*)(dst + (size_t)m * ld + n) = pk;
  }
};
struct EpiOutProjT {
  const float* x_lat; const float* x_ctx; float* o_lat; float* o_ctx; const float* modv;
  DEVM void operator()(int, int, float) const {}
  DEVM void store4(int n, int m, float v0, float v1, float v2, float v3) const {
    const f32x4 g = *(const f32x4*)(modv + mod_row(m) * 6144 + 2 * 1024 + n);
    const float* xs; float* od;
    if (m < NCTX) { xs = x_ctx + (size_t)m * 1024 + n; od = o_ctx + (size_t)m * 1024 + n; }
    else { size_t o = (size_t)(m - NCTX) * 1024 + n; xs = x_lat + o; od = o_lat + o; }
    const f32x4 x = *(const f32x4*)xs;
    f32x4 r = {x.x + g.x * v0, x.y + g.y * v1, x.z + g.z * v2, x.w + g.w * v3};
    *(f32x4*)od = r;
  }
};
struct EpiStoreBfBiasT {
  bf16_t* dst; int ld; const float* bias;
  DEVM void operator()(int, int, float) const {}
  DEVM void store4(int n, int m, float v0, float v1, float v2, float v3) const {
    if (bias) { v0 += bias[n]; v1 += bias[n + 1]; v2 += bias[n + 2]; v3 += bias[n + 3]; }
    u32x2 pk; pk.x = pack2(v0, v1); pk.y = pack2(v2, v3);
    *(u32x2*)(dst + (size_t)m * ld + n) = pk;
  }
};
struct EpiOutProj {
  const float* x_lat; const float* x_ctx; float* o_lat; float* o_ctx; const float* modv;
  DEVM void operator()(int row, int col, float v) const {
    float g = modv[mod_row(row) * 6144 + 2 * 1024 + col];
    if (row < NCTX) o_ctx[(size_t)row * 1024 + col] = x_ctx[(size_t)row * 1024 + col] + g * v;
    else { size_t o = (size_t)(row - NCTX) * 1024 + col; o_lat[o] = x_lat[o] + g * v; }
  }
};
struct EpiScoreLds {
  float* sS; int m0;
  DEVM void operator()(int row, int col, float v) const { sS[(row - m0) * 129 + col] = v; }
};

DEV void st_xbc_conv(const Params& P, int row) {
  const int lane = threadIdx.x & 63;
  const bf16_t* proj = (const bf16_t*)(P.ws + OFF_PROJ);
  bf16_t* xc = (bf16_t*)P.out + (size_t)row * 1024;
  int row0, len, pos;
  if (row < NCTX) { row0 = (row / CTXL) * CTXL; len = CTXL; pos = row - row0; }
  else { int r = row - NCTX; row0 = NCTX + (r / SEQ) * SEQ; len = SEQ; pos = r % SEQ; }
  const float* cw = P.in[I_SCONVW];
  const float* cb = P.in[I_SCONVB];
#pragma unroll
  for (int hh = 0; hh < 2; ++hh) {
    const int ch = hh * 512 + lane * 8;
    float o[8];
#pragma unroll
    for (int j = 0; j < 8; ++j) o[j] = cb[ch + j];
#pragma unroll
    for (int tap = 0; tap < 4; ++tap) {
      int pp = pos + tap - 2;
      if (pp >= 0 && pp < len) {
        float x[8];
        unpack8(*(const u32x4*)(proj + (size_t)(row0 + pp) * EVC + 2064 + ch), x);
        f32x4 w0 = *(const f32x4*)(cw + tap * 1024 + ch), w1 = *(const f32x4*)(cw + tap * 1024 + ch + 4);
        o[0] += w0.x * x[0]; o[1] += w0.y * x[1]; o[2] += w0.z * x[2]; o[3] += w0.w * x[3];
        o[4] += w1.x * x[4]; o[5] += w1.y * x[5]; o[6] += w1.z * x[6]; o[7] += w1.w * x[7];
      }
    }
#pragma unroll
    for (int j = 0; j < 8; ++j) o[j] = siluf_(o[j]);
    *(u32x4*)(xc + ch) = pack8(o);
  }
}

#ifndef LA_NSEG
#define LA_NSEG 10
#endif
constexpr int LA_NCH = (CTXL + SEQ) / 64;
constexpr int LA_CPS = LA_NCH / LA_NSEG;
static_assert(LA_NCH % LA_NSEG == 0, "linattn segments");
#ifdef CPU_EMU
constexpr size_t OFF_LASEG = OFF_PR + PR_BYTES;
#else
constexpr size_t OFF_LASEG = OFF_R2L0 + (size_t)NTOK * 1024 * 2;
#endif
constexpr size_t LASEG_U = (size_t)48 * LA_NSEG * 8192 * 4;
constexpr size_t OFF_LASEG_N = OFF_LASEG + LASEG_U;
constexpr size_t OFF_LASEG_D = OFF_LASEG_N + (size_t)48 * LA_NSEG * 64 * 4;
#ifndef CPU_EMU
static_assert(OFF_LASEG_D + 48 * LA_NSEG * 4 <= OFF_PR + PR_BYTES, "laseg");
#endif

struct LaRaw { u32x4 q[2], k[4], x[4]; float g0, g1; };

template <bool MLSTM, bool FULL>
DEV void la_load_raw(const Params& P, int b, int h, int d, int cc, LaRaw& R) {
  constexpr int NC_CTX = CTXL / 64;
  const int tid = threadIdx.x;
  const int seg = cc >= NC_CTX;
  const int row0 = seg ? NCTX + b * SEQ : b * CTXL;
  const int len = seg ? SEQ : CTXL;
  const int cl = (seg ? cc - NC_CTX : cc) * 64;
  const bf16_t* proj = (const bf16_t*)(P.ws + OFF_PROJ);
  const bf16_t* xcv = (const bf16_t*)P.out;
  const float* gates = (const float*)(P.ws + OFF_GATES);
  if (tid < 64) {
    int p = cl + tid, grow = row0 + (d ? len - 1 - p : p);
    if (MLSTM) { R.g0 = gates[grow * 32 + d * 4 + h]; R.g1 = gates[grow * 32 + 8 + d * 4 + h]; }
    else { R.g0 = gates[grow * 32 + 16 + d * 8 + h]; R.g1 = 0.f; }
  }
  if (MLSTM) {
#pragma unroll
    for (int i = 0; i < 2; ++i) {
      int c = tid + i * 256, r = c >> 3, cc8 = (c & 7) * 8;
      int p = cl + r, pos = d ? len - 1 - p : p;
      const bf16_t* rp = proj + (size_t)(row0 + pos) * EVC;
      if (FULL) R.q[i] = *(const u32x4*)(rp + h * 64 + cc8);
      R.k[i] = *(const u32x4*)(rp + 256 + h * 64 + cc8);
    }
#pragma unroll
    for (int i = 0; i < 4; ++i) {
      int c = tid + i * 256, r = c >> 4, cc8 = (c & 15) * 8;
      int p = cl + r, pos = d ? len - 1 - p : p;
      R.x[i] = *(const u32x4*)(proj + (size_t)(row0 + pos) * EVC + 512 + h * 128 + cc8);
    }
  } else {
    const int grp = h >> 2;
#pragma unroll
    for (int i = 0; i < 2; ++i) {
      int c = tid + i * 256, r = c >> 3, cc8 = (c & 7) * 8;
      int p = cl + r, pos = d ? len - 1 - p : p;
      R.x[i] = *(const u32x4*)(xcv + (size_t)(row0 + pos) * 1024 + h * 64 + cc8);
    }
#pragma unroll
    for (int i = 0; i < 4; ++i) {
      int c = tid + i * 256, r = c >> 4, cc8 = (c & 15) * 8;
      int p = cl + r, pos = d ? len - 1 - p : p;
      const bf16_t* rp = xcv + (size_t)(row0 + pos) * 1024;
      R.k[i] = *(const u32x4*)(rp + 512 + grp * 128 + cc8);
      if (FULL) { if (i < 2) R.q[i] = *(const u32x4*)(rp + 768 + grp * 128 + cc8); else R.x[i] = *(const u32x4*)(rp + 768 + grp * 128 + cc8); }
    }
  }
}

template <bool MLSTM, bool FULL>
DEV void st_linattn_seg(const Params& P, int sid, int seg, unsigned char* smem) {
  constexpr int DK = MLSTM ? 64 : 128, DX = MLSTM ? 128 : 64;
  constexpr int QS = DK + 8;
  constexpr int NH = MLSTM ? 4 : 8;
  constexpr int NC_CTX = CTXL / 64;
  const int tid = threadIdx.x, lane = tid & 63, wave = tid >> 6;
  const int d = sid & 1, h = (sid >> 1) % NH, b = (sid >> 1) / NH;
  const int gsid = MLSTM ? sid : 16 + sid;
  bf16_t* sQ = (bf16_t*)smem;
  bf16_t* sK = sQ + 64 * QS;
  bf16_t* sP = sK;
  bf16_t* sKT = sK + 64 * QS;
  bf16_t* sXT = sKT + DK * 72;
  bf16_t* sST = sXT + DX * 72;
  float* sF = (float*)(sST + DX * QS);
  float* sLa = sF;
  float* sG = sF + 64;
  float* sBc = sF + 128;
  float* sDen = sF + 192;
  float* sN = sF + 256;
  int* sRow = (int*)(sF + 384);
  static_assert((64 * QS * 2 + DK * 72 + DX * 72 + DX * QS) * 2 + 448 * 4 <= SMEM_BYTES, "lds");
  bf16_t* outb = MLSTM ? (bf16_t*)(P.ws + OFF_HBUF) : (bf16_t*)(P.ws + OFF_R2L0);
  float* segU = (float*)(P.ws + OFF_LASEG);
  float* segN = (float*)(P.ws + OFF_LASEG_N);
  float* segD = (float*)(P.ws + OFF_LASEG_D);

  f32x16 accS[2];
#pragma unroll
  for (int j = 0; j < 2; ++j)
#pragma unroll
    for (int r = 0; r < 16; ++r) accS[j][r] = 0.f;
  const int sx0 = MLSTM ? wave * 32 : (wave >> 1) * 32;
  const int sk0 = MLSTM ? 0 : (wave & 1) * 64;
  float nreg = 0.f;
  float gb0 = 0.f, gb1 = 0.f, alog_e = 0.f, dskip = 0.f;
  if (MLSTM) { gb0 = P.in[I_IBIAS][d * 4 + h]; gb1 = P.in[I_FBIAS][d * 4 + h]; }
  else { gb0 = P.in[I_DTBIAS][d * 8 + h]; alog_e = fexp(P.in[I_ALOG][d * 8 + h]); dskip = P.in[I_DSKIP][h]; }

  const int cc0 = seg * LA_CPS, cc1 = cc0 + LA_CPS;
  LaRaw R;
  la_load_raw<MLSTM, FULL>(P, b, h, d, cc0, R);
  __syncthreads();
  if (FULL) {
    for (int js = 0; js < seg; ++js) {
      const size_t it = (size_t)gsid * LA_NSEG + js;
      const float a = fexp(segD[it]);
      const float* U = segU + it * 8192;
#pragma unroll
      for (int j = 0; j < 2; ++j)
#pragma unroll
        for (int r = 0; r < 16; ++r) accS[j][r] = a * accS[j][r] + U[(j * 16 + r) * 256 + tid];
      if (MLSTM && tid < 64) nreg = a * nreg + segN[it * 64 + tid];
    }
#pragma unroll
    for (int j = 0; j < 2; ++j)
#pragma unroll
      for (int r = 0; r < 16; ++r) sST[(sx0 + acc_row(r, lane)) * QS + sk0 + j * 32 + (lane & 31)] = f2bf(accS[j][r]);
    if (tid < 128) sN[tid] = (MLSTM && tid < 64) ? nreg : 0.f;
  }
  float lsum = 0.f;

  for (int cc = cc0; cc < cc1; ++cc) {
    int tl_ = threadIdx.x; OPAQUE(tl_);
    const int tid = tl_, lane = tl_ & 63;
    const int sgi = cc >= NC_CTX;
    const int row0 = sgi ? NCTX + b * SEQ : b * CTXL;
    const int len = sgi ? SEQ : CTXL;
    const int cl = (sgi ? cc - NC_CTX : cc) * 64;
    if (tid < 64) {
      int p = cl + tid;
      sRow[tid] = row0 + (d ? len - 1 - p : p);
      if (MLSTM) { sLa[tid] = -softplusf_(-(R.g1 + gb1)); sG[tid] = fexp(R.g0 + gb0); }
      else { float dt = softplusf_(R.g0 + gb0); sLa[tid] = -dt * alog_e; sG[tid] = dt; }
    }
    __syncthreads();
    if (wave == 0) {
      float v = sLa[lane];
#pragma unroll
      for (int off = 1; off < 64; off <<= 1) {
#ifdef CPU_EMU
        float o = emu_shfl_up(v, off);
#else
        float o = __shfl_up(v, off, 64);
#endif
        if (lane >= off) v += o;
      }
      sBc[lane] = v;
    }
    __syncthreads();
    const float blast = sBc[63];
    lsum += blast;
    if (MLSTM) {
#pragma unroll
      for (int i = 0; i < 2; ++i) {
        int c = tid + i * 256, r = c >> 3, cc8 = (c & 7) * 8;
        float kf[8]; unpack8(R.k[i], kf);
        const float wgt = fexp(blast - sBc[r]) * sG[r];
#pragma unroll
        for (int j = 0; j < 8; ++j) sKT[(cc8 + j) * 72 + r] = f2bf(kf[j] * wgt);
        if (FULL) {
          float qf[8]; unpack8(R.q[i], qf);
#pragma unroll
          for (int j = 0; j < 8; ++j) qf[j] *= 0.125f;
          *(u32x4*)(sQ + r * QS + cc8) = pack8(qf);
          *(u32x4*)(sK + r * QS + cc8) = R.k[i];
        }
      }
#pragma unroll
      for (int i = 0; i < 4; ++i) {
        int c = tid + i * 256, r = c >> 4, cc8 = (c & 15) * 8;
        const bf16_t* xs = (const bf16_t*)&R.x[i];
#pragma unroll
        for (int j = 0; j < 8; ++j) sXT[(cc8 + j) * 72 + r] = xs[j];
      }
    } else {
#pragma unroll
      for (int i = 0; i < 2; ++i) {
        int c = tid + i * 256, r = c >> 3, cc8 = (c & 7) * 8;
        const bf16_t* xs = (const bf16_t*)&R.x[i];
#pragma unroll
        for (int j = 0; j < 8; ++j) sXT[(cc8 + j) * 72 + r] = xs[j];
      }
#pragma unroll
      for (int i = 0; i < 4; ++i) {
        int c = tid + i * 256, r = c >> 4, cc8 = (c & 15) * 8;
        float kf[8]; unpack8(R.k[i], kf);
        const float wgt = fexp(blast - sBc[r]) * sG[r];
#pragma unroll
        for (int j = 0; j < 8; ++j) sKT[(cc8 + j) * 72 + r] = f2bf(kf[j] * wgt);
        if (FULL) {
          *(u32x4*)(sK + r * QS + cc8) = R.k[i];
          *(u32x4*)(sQ + r * QS + cc8) = i < 2 ? R.q[i] : R.x[i];
        }
      }
    }
    if (cc + 1 < cc1) la_load_raw<MLSTM, FULL>(P, b, h, d, cc + 1, R);
    __syncthreads();
    if (FULL) {
      const int tr = (wave >> 1) * 32, tc = (wave & 1) * 32;
      f32x16 accP;
#pragma unroll
      for (int r = 0; r < 16; ++r) accP[r] = 0.f;
      if (!(tr == 0 && tc == 32)) {
#pragma unroll
        for (int kk = 0; kk < DK / 16; ++kk) {
          const int ko = kk * 16 + 8 * (lane >> 5);
          bf16x8 a = *(const bf16x8*)(sQ + (tr + (lane & 31)) * QS + ko);
          bf16x8 bb = *(const bf16x8*)(sK + (tc + (lane & 31)) * QS + ko);
          accP = mfma32(a, bb, accP);
        }
      }
      __syncthreads();
      {
        const int s = tc + (lane & 31);
        const float bs = sBc[s], gs = sG[s];
#pragma unroll
        for (int r = 0; r < 16; ++r) {
          int t = tr + acc_row(r, lane);
          float v = (s <= t) ? accP[r] * fexp(sBc[t] - bs) * gs : 0.f;
          sP[t * 72 + s] = f2bf(v);
        }
        {
          const int t = tid >> 2, kq = (tid & 3) * (DK / 4);
          const float et = fexp(sBc[t]);
#pragma unroll
          for (int c8 = 0; c8 < DK / 4; c8 += 8) {
            float qf[8];
            unpack8(*(const u32x4*)(sQ + t * QS + kq + c8), qf);
#pragma unroll
            for (int j = 0; j < 8; ++j) qf[j] *= et;
            *(u32x4*)(sQ + t * QS + kq + c8) = pack8(qf);
          }
        }
      }
      __syncthreads();
      constexpr int NYT = MLSTM ? 2 : 1;
      const int yx0 = MLSTM ? wave * 32 : (wave >> 1) * 32;
      const int yt0 = MLSTM ? 0 : (wave & 1) * 32;
      f32x16 accY[NYT];
#pragma unroll
      for (int j = 0; j < NYT; ++j)
#pragma unroll
        for (int r = 0; r < 16; ++r) accY[j][r] = 0.f;
#pragma unroll
      for (int kk = 0; kk < 4; ++kk) {
        const int ko = kk * 16 + 8 * (lane >> 5);
        bf16x8 a = *(const bf16x8*)(sXT + (yx0 + (lane & 31)) * 72 + ko);
#pragma unroll
        for (int j = 0; j < NYT; ++j) {
          bf16x8 bb = *(const bf16x8*)(sP + (yt0 + j * 32 + (lane & 31)) * 72 + ko);
          accY[j] = mfma32(a, bb, accY[j]);
        }
      }
#pragma unroll
      for (int kk = 0; kk < DK / 16; ++kk) {
        const int ko = kk * 16 + 8 * (lane >> 5);
        bf16x8 a = *(const bf16x8*)(sST + (yx0 + (lane & 31)) * QS + ko);
#pragma unroll
        for (int j = 0; j < NYT; ++j) {
          bf16x8 bb = *(const bf16x8*)(sQ + (yt0 + j * 32 + (lane & 31)) * QS + ko);
          accY[j] = mfma32(a, bb, accY[j]);
        }
      }
      if (MLSTM) {
        if (tid < 64) {
          float den = 0.f, dq = 0.f;
#pragma unroll 8
          for (int s = 0; s < 64; ++s) den += bf2f(sP[tid * 72 + s]);
#pragma unroll 8
          for (int k = 0; k < DK; ++k) dq += sN[k] * bf2f(sQ[tid * QS + k]);
          sDen[tid] = den + dq;
        }
        __syncthreads();
      }
#pragma unroll
      for (int j = 0; j < NYT; ++j) {
        const int t = yt0 + j * 32 + (lane & 31);
        const size_t obase = (size_t)sRow[t] * 1024 + d * 512 + h * DX;
        const float dinv = MLSTM ? frcp(fmaxf(fabsf(sDen[t]), 1.f)) : 1.f;
#pragma unroll
        for (int g = 0; g < 4; ++g) {
          const int x0 = yx0 + 8 * g + 4 * (lane >> 5);
          float v0 = accY[j][4 * g], v1 = accY[j][4 * g + 1], v2 = accY[j][4 * g + 2], v3 = accY[j][4 * g + 3];
          if (MLSTM) { v0 *= dinv; v1 *= dinv; v2 *= dinv; v3 *= dinv; }
          else if (d == 0) {
            v0 += dskip * bf2f(sXT[(x0 + 0) * 72 + t]); v1 += dskip * bf2f(sXT[(x0 + 1) * 72 + t]);
            v2 += dskip * bf2f(sXT[(x0 + 2) * 72 + t]); v3 += dskip * bf2f(sXT[(x0 + 3) * 72 + t]);
          }
          u32x2 pk; pk.x = pack2(v0, v1); pk.y = pack2(v2, v3);
          *(u32x2*)(outb + obase + x0) = pk;
        }
      }
      __syncthreads();
    }
    {
      const float eb = fexp(blast);
#pragma unroll
      for (int j = 0; j < 2; ++j)
#pragma unroll
        for (int r = 0; r < 16; ++r) accS[j][r] *= eb;
#pragma unroll
      for (int kk = 0; kk < 4; ++kk) {
        const int ko = kk * 16 + 8 * (lane >> 5);
        bf16x8 a = *(const bf16x8*)(sXT + (sx0 + (lane & 31)) * 72 + ko);
#pragma unroll
        for (int j = 0; j < 2; ++j) {
          bf16x8 bb = *(const bf16x8*)(sKT + (sk0 + j * 32 + (lane & 31)) * 72 + ko);
          accS[j] = mfma32(a, bb, accS[j]);
        }
      }
      if (FULL) {
#pragma unroll
        for (int j = 0; j < 2; ++j)
#pragma unroll
          for (int r = 0; r < 16; ++r) sST[(sx0 + acc_row(r, lane)) * QS + sk0 + j * 32 + (lane & 31)] = f2bf(accS[j][r]);
      }
      if (MLSTM && tid < 64) {
        float nn = nreg * eb;
        for (int s = 0; s < 64; ++s) nn += bf2f(sKT[tid * 72 + s]);
        nreg = nn;
        if (FULL) sN[tid] = nn;
      }
    }
    __syncthreads();
  }
  if (!FULL) {
    const size_t it = (size_t)gsid * LA_NSEG + seg;
    float* U = segU + it * 8192;
#pragma unroll
    for (int j = 0; j < 2; ++j)
#pragma unroll
      for (int r = 0; r < 16; ++r) U[(j * 16 + r) * 256 + tid] = accS[j][r];
    if (MLSTM && tid < 64) segN[it * 64 + tid] = nreg;
    if (tid == 0) segD[it] = lsum;
  }
}

DEV void st_finish_l0(const Params& P, int row) {
  const int lane = threadIdx.x & 63;
  bf16_t* hb = (bf16_t*)(P.ws + OFF_HBUF) + (size_t)row * 1024;
  const bf16_t* yb = (const bf16_t*)(P.ws + OFF_R2L0) + (size_t)row * 1024;
  const bf16_t* pr = (const bf16_t*)(P.ws + OFF_PROJ) + (size_t)row * EVC;
  const int ch = lane * 8;
  float h0[8], h1[8], o[8], f1[8];
  unpack8(*(const u32x4*)(hb + ch), h0);
  unpack8(*(const u32x4*)(hb + 512 + ch), h1);
  unpack8(*(const u32x4*)(pr + 1024 + ch), o);
  float ss = 0.f;
#pragma unroll
  for (int j = 0; j < 8; ++j) { h0[j] += h1[j]; ss += h0[j] * h0[j]; }
  ss += wshfl_xor(ss, 1); ss += wshfl_xor(ss, 2); ss += wshfl_xor(ss, 4); ss += wshfl_xor(ss, 8);
  float rstd = frsq(ss * (1.f / 128.f) + 1e-6f);
  float pw[8]; ld8(P.in[I_MNORM] + ch, pw);
#pragma unroll
  for (int j = 0; j < 8; ++j) f1[j] = h0[j] * rstd * pw[j] * sigmoidf_(o[j]);
  float y0[8], y1[8], z[8], f2[8];
  unpack8(*(const u32x4*)(yb + ch), y0);
  unpack8(*(const u32x4*)(yb + 512 + ch), y1);
  unpack8(*(const u32x4*)(pr + 1552 + ch), z);
  float s2 = 0.f;
#pragma unroll
  for (int j = 0; j < 8; ++j) { y0[j] = (y0[j] + y1[j]) * siluf_(z[j]); s2 += y0[j] * y0[j]; }
  s2 = wave_sum(s2);
  float rstd2 = frsq(s2 * (1.f / 512.f) + 1e-6f);
  ld8(P.in[I_SNORM] + ch, pw);
#pragma unroll
  for (int j = 0; j < 8; ++j) f2[j] = y0[j] * rstd2 * pw[j];
  *(u32x4*)(hb + ch) = pack8(f1);
  *(u32x4*)(hb + 512 + ch) = pack8(f2);
}

DEV float mixval(const bf16_t* __restrict__ proj, int row, int c, const float* __restrict__ mu) {
  float self = bf2f(proj[(size_t)row * ODC + c]);
  int nrow = -1;
  if (row < NCTX) {
    int pos = row % CTXL;
    if (c < 896) { if (pos > 0) nrow = row - 1; }
    else { if (pos < CTXL - 1) nrow = row + 1; }
  } else {
    int pos = (row - NCTX) % SEQ;
    int gx = pos % GW, gy = pos / GW, q = c / 448;
    if (q == 0) { if (gx > 0) nrow = row - 1; }
    else if (q == 1) { if (gx < GW - 1) nrow = row + 1; }
    else if (q == 2) { if (gy > 0) nrow = row - GW; }
    else { if (gy < SEQ / GW - 1) nrow = row + GW; }
  }
  float nb = nrow >= 0 ? bf2f(proj[(size_t)nrow * ODC + c]) : 0.f;
  return self + mu[c] * (nb - self);
}

DEV int nbr_row(int row, int c) {
  if (row < NCTX) {
    int pos = row % CTXL;
    if (c < 896) return pos > 0 ? row - 1 : -1;
    return pos < CTXL - 1 ? row + 1 : -1;
  }
  int pos = (row - NCTX) % SEQ;
  int gx = pos % GW, gy = pos / GW, q = c / 448;
  if (q == 0) return gx > 0 ? row - 1 : -1;
  if (q == 1) return gx < GW - 1 ? row + 1 : -1;
  if (q == 2) return gy > 0 ? row - GW : -1;
  return gy < SEQ / GW - 1 ? row + GW : -1;
}

DEV void mix8(const bf16_t* __restrict__ proj, int row, int c, const float* __restrict__ mu, float* o) {
  float xs[8], xn[8];
  unpack8(*(const u32x4*)(proj + (size_t)row * ODC + c), xs);
  const int nr = nbr_row(row, c);
  if (nr >= 0) unpack8(*(const u32x4*)(proj + (size_t)nr * ODC + c), xn);
  else {
#pragma unroll
    for (int j = 0; j < 8; ++j) xn[j] = 0.f;
  }
  const f32x4 m0 = *(const f32x4*)(mu + c), m1 = *(const f32x4*)(mu + c + 4);
  const float mm[8] = {m0.x, m0.y, m0.z, m0.w, m1.x, m1.y, m1.z, m1.w};
#pragma unroll
  for (int j = 0; j < 8; ++j) o[j] = xs[j] + mm[j] * (xn[j] - xs[j]);
}

DEV void st_lora_act(const Params& P, int row2) {
  const int lane = threadIdx.x & 63;
  const int row = row2 + (lane >> 5), c = (lane & 31) * 8;
  const bf16_t* proj = (const bf16_t*)(P.ws + OFF_PROJ);
  bf16_t* hb = (bf16_t*)(P.ws + OFF_HBUF) + (size_t)row * 1024;
  float v[8];
  mix8(proj, row, 1536 + c, P.in[I_MU], v);
#pragma unroll
  for (int j = 0; j < 8; ++j) v[j] = c < 64 ? tanhf_(v[j]) : (c < 128 ? v[j] : sigmoidf_(v[j]));
  *(u32x4*)(hb + c) = pack8(v);
}

DEV void st_rwkv_stream(const Params& P, int sid, unsigned char* smem) {
  const int tid = threadIdx.x, lane = tid & 63, wave = tid >> 6;
  const int d = sid & 1, h = (sid >> 1) & 7, b = sid >> 4;
  float* sR = (float*)smem;
  float* sW = sR + 2048;
  float* sKk = sW + 2048;
  float* sV = sKk + 2048;
  float* sA = sV + 2048;
  float* sBb = sA + 2048;
  float* sY = sBb + 2048;
  int* sRow = (int*)(sY + 2048);
  const bf16_t* proj = (const bf16_t*)(P.ws + OFF_PROJ);
  const bf16_t* lora = (const bf16_t*)(P.ws + OFF_LORA);
  bf16_t* yout = (bf16_t*)(P.ws + OFF_HBUF);
  const float* mu = P.in[I_MU];
  const int vrow = tid >> 2, j4 = tid & 3;
  float S[16];
#pragma unroll
  for (int i = 0; i < 16; ++i) S[i] = 0.f;
  const float kkw = P.in[I_KK][h * 64 + lane], kaw = P.in[I_KA][h * 64 + lane];
  for (int seg = 0; seg < 2; ++seg) {
    const int row0 = seg == 0 ? b * CTXL : NCTX + b * SEQ;
    const int len = seg == 0 ? CTXL : SEQ;
    for (int it = 0; it < len / 32; ++it) {
      __syncthreads();
      for (int s = wave; s < 32; s += 4) {
        int p = it * 32 + s, pos = d ? len - 1 - p : p, row = row0 + pos;
        int c = h * 64 + lane;
        float r = mixval(proj, row, c, mu);
        float k = mixval(proj, row, 512 + c, mu);
        float v = mixval(proj, row, 1024 + c, mu);
        float kk = k * kkw;
        float ss = wave_sum(kk * kk);
        kk *= frsq(ss + 1e-12f);
        float lw = bf2f(lora[((size_t)d * NTOK + row) * 512 + c]);
        float la = bf2f(lora[((size_t)(2 + d) * NTOK + row) * 512 + c]);
        float w = fexp(-0.6065306597126334f * sigmoidf_(lw));
        float a = sigmoidf_(la);
        float kt = k * (1.f + (a - 1.f) * kaw);
        sR[s * 64 + lane] = r; sW[s * 64 + lane] = w; sKk[s * 64 + lane] = kt; sV[s * 64 + lane] = v;
        sA[s * 64 + lane] = -kk; sBb[s * 64 + lane] = kk * a;
        if (lane == 0) sRow[s] = row;
      }
      __syncthreads();
      for (int s = 0; s < 32; ++s) {
        const float* pa = sA + s * 64 + j4 * 16;
        const float* pw = sW + s * 64 + j4 * 16;
        const float* pk = sKk + s * 64 + j4 * 16;
        const float* pb = sBb + s * 64 + j4 * 16;
        const float* pr = sR + s * 64 + j4 * 16;
        const float vv = sV[s * 64 + vrow];
        float sa = 0.f;
#pragma unroll
        for (int i = 0; i < 16; ++i) sa += S[i] * pa[i];
        sa += wshfl_xor(sa, 1); sa += wshfl_xor(sa, 2);
        float y = 0.f;
#pragma unroll
        for (int i = 0; i < 16; ++i) { S[i] = S[i] * pw[i] + sa * pb[i] + vv * pk[i]; y += S[i] * pr[i]; }
        y += wshfl_xor(y, 1); y += wshfl_xor(y, 2);
        if (j4 == 0) sY[s * 64 + vrow] = y;
      }
      __syncthreads();
      for (int i = tid; i < 2048; i += 256) {
        int s = i >> 6, c = i & 63;
        yout[(size_t)sRow[s] * 1024 + d * 512 + h * 64 + c] = f2bf(sY[i]);
      }
    }
  }
}


struct RwkvRaw { u32x4 rs, rn, ks, kn, vs, vn, lw, la; int row; };

DEV void rwkv_load_raw(const bf16_t* __restrict__ proj, const bf16_t* __restrict__ lora, int b, int h, int d, int cc, int t, int c0,
                       RwkvRaw& R) {
  constexpr int NC_CTX = CTXL / 32;
  const int seg = cc >= NC_CTX;
  const int row0 = seg ? NCTX + b * SEQ : b * CTXL;
  const int len = seg ? SEQ : CTXL;
  const int p = (seg ? cc - NC_CTX : cc) * 32 + t;
  const int row = row0 + (d ? len - 1 - p : p);
  const int col = h * 64 + c0;
  const u32x4 z4 = {0u, 0u, 0u, 0u};
  const bf16_t* rp = proj + (size_t)row * ODC;
  R.row = row;
  R.rs = *(const u32x4*)(rp + col);
  R.ks = *(const u32x4*)(rp + 512 + col);
  R.vs = *(const u32x4*)(rp + 1024 + col);
  int n0 = nbr_row(row, col), n1 = nbr_row(row, 512 + col), n2 = nbr_row(row, 1024 + col);
  R.rn = n0 >= 0 ? *(const u32x4*)(proj + (size_t)n0 * ODC + col) : z4;
  R.kn = n1 >= 0 ? *(const u32x4*)(proj + (size_t)n1 * ODC + 512 + col) : z4;
  R.vn = n2 >= 0 ? *(const u32x4*)(proj + (size_t)n2 * ODC + 1024 + col) : z4;
  R.lw = *(const u32x4*)(lora + ((size_t)d * NTOK + row) * 512 + col);
  R.la = *(const u32x4*)(lora + ((size_t)(2 + d) * NTOK + row) * 512 + col);
}

#ifndef RW_NSEG
#define RW_NSEG 16
#endif
constexpr int RW_NCH = (CTXL + SEQ) / 32;
constexpr size_t OFF_RWSEG = OFF_PU;
static_assert((size_t)32 * RW_NSEG * 64 * 128 * 4 <= (size_t)2 * NEXP * 1024, "rwseg");

template <bool FULL>
DEV void st_rwkv_seg(const Params& P, int sid, int seg, unsigned char* smem) {
  constexpr int NVB = FULL ? 2 : 4;
  constexpr int ZR = FULL ? 64 : 128;
  const int tid = threadIdx.x, lane = tid & 63, wave = tid >> 6;
  const int d = sid & 1, h = (sid >> 1) & 7, b = sid >> 4;
  bf16_t* sAt = (bf16_t*)smem;
  bf16_t* sRt = sAt + 32 * 72;
  bf16_t* sBt = sRt + 32 * 72;
  bf16_t* sKt = sBt + 32 * 72;
  bf16_t* sBT = sKt + 32 * 72;
  bf16_t* sKT = sBT + 64 * 40;
  bf16_t* sVT = sKT + 64 * 40;
  bf16_t* sLak = sVT + 64 * 40;
  bf16_t* sM = sLak + 32 * 40;
  bf16_t* sLrb = sM + 32 * 40;
  bf16_t* sLrk = sLrb + 32 * 40;
  bf16_t* sZ = FULL ? sLrk + 32 * 40 : sLrb;
  bf16_t* after = sZ + ZR * 72;
  bf16_t* sRT = FULL ? after : nullptr;
  bf16_t* sSAT = FULL ? after + 64 * 40 : sRt;
  float* sLP = (float*)(FULL ? after + 2 * 64 * 40 : after);
  float* sLab = sLP + 32 * 64;
  float* sD = sLab + 32 * 33;
  float* sPT = sD + 768;
  int* sRow = (int*)(sPT + 64);
  if (!FULL) sRT = (bf16_t*)sLP;
  static_assert((4 * 32 * 72 + 3 * 64 * 40 + 4 * 32 * 40 + 2 * 64 * 40 + 64 * 72) * 2 + (32 * 64 + 32 * 33 + 768 + 64 + 32 + 320) * 4 + 16 <= SMEM_BYTES, "lds full");
  static_assert((4 * 32 * 72 + 3 * 64 * 40 + 2 * 32 * 40 + 128 * 72) * 2 + (32 * 64 + 32 * 33 + 768 + 64 + 32) * 4 <= SMEM_BYTES, "lds p1");
  static_assert(128 * 40 * 2 <= (32 * 64 + 32 * 33) * 4 && 128 * 40 <= 3 * 32 * 72, "alias");
  const bf16_t* proj = (const bf16_t*)(P.ws + OFF_PROJ);
  const bf16_t* lora = (const bf16_t*)(P.ws + OFF_LORA);
  bf16_t* yout = (bf16_t*)(P.ws + OFF_HBUF);
  float* segZ = (float*)(P.ws + OFF_RWSEG);
  const int t = tid >> 3, c0 = (tid & 7) * 8;
  const int hl = lane >> 5, l31 = lane & 31;
  float* sCst = (float*)(smem + SMEM_BYTES - 320 * 4 - 16);
  if (tid < 64) {
    sCst[tid] = P.in[I_MU][h * 64 + tid]; sCst[64 + tid] = P.in[I_MU][512 + h * 64 + tid]; sCst[128 + tid] = P.in[I_MU][1024 + h * 64 + tid];
    sCst[192 + tid] = P.in[I_KK][h * 64 + tid]; sCst[256 + tid] = P.in[I_KA][h * 64 + tid];
  }
  const int cc0 = (seg * RW_NCH) / RW_NSEG, cc1 = ((seg + 1) * RW_NCH) / RW_NSEG;
  RwkvRaw R;
  rwkv_load_raw(proj, lora, b, h, d, cc0, t, c0, R);
  f32x16 Zm[2];
#pragma unroll
  for (int j = 0; j < 2; ++j)
#pragma unroll
    for (int r = 0; r < 16; ++r) Zm[j][r] = 0.f;
  __syncthreads();
  for (int i = tid; i < ZR * 72; i += 256) sZ[i] = 0;
  __syncthreads();
  if (!FULL) {
    if (wave >= 2) {
#pragma unroll
      for (int cb = 0; cb < 2; ++cb)
#pragma unroll
        for (int r = 0; r < 16; ++r) {
          int c = cb * 32 + acc_row(r, lane), vp = wave * 32 + l31;
          if (c == vp - 64) { Zm[cb][r] = 1.f; sZ[vp * 72 + c] = 0x3f80; }
        }
    }
  } else {
    for (int js = 0; js < seg; ++js) {
      const float* Zs = segZ + ((size_t)sid * RW_NSEG + js) * 64 * 128;
      bf16_t* sG = sAt;
      {
        const int c = tid >> 2, c2 = (tid & 3) * 16;
        float gv[16];
        ld8(Zs + c * 128 + 64 + c2, gv); ld8(Zs + c * 128 + 64 + c2 + 8, gv + 8);
        *(u32x4*)(sG + c * 72 + c2) = pack8(gv);
        *(u32x4*)(sG + c * 72 + c2 + 8) = pack8(gv + 8);
      }
      __syncthreads();
      if (wave >= 2) {
        const int cb = wave - 2;
#pragma unroll
        for (int vb = 0; vb < 2; ++vb) {
          f32x16 acc;
#pragma unroll
          for (int r = 0; r < 16; ++r) acc[r] = Zs[(cb * 32 + acc_row(r, lane)) * 128 + vb * 32 + l31];
#pragma unroll
          for (int kk = 0; kk < 4; ++kk) {
            bf16x8 a = *(const bf16x8*)(sG + (cb * 32 + l31) * 72 + kk * 16 + 8 * hl);
            bf16x8 bb = *(const bf16x8*)(sZ + (vb * 32 + l31) * 72 + kk * 16 + 8 * hl);
            acc = mfma32(a, bb, acc);
          }
          Zm[vb] = acc;
        }
      }
      __syncthreads();
      if (wave >= 2) {
        const int cb = wave - 2;
#pragma unroll
        for (int vb = 0; vb < 2; ++vb)
#pragma unroll
          for (int g = 0; g < 4; ++g) {
            u32x2 pk; pk.x = pack2(Zm[vb][4 * g], Zm[vb][4 * g + 1]); pk.y = pack2(Zm[vb][4 * g + 2], Zm[vb][4 * g + 3]);
            *(u32x2*)(sZ + (vb * 32 + l31) * 72 + cb * 32 + 8 * g + 4 * hl) = pk;
          }
      }
      __syncthreads();
    }
  }
  for (int cc = cc0; cc < cc1; ++cc) {
    int tl_ = threadIdx.x; OPAQUE(tl_);
    const int tid = tl_, lane = tl_ & 63, hl = lane >> 5, l31 = lane & 31, t = tl_ >> 3, c0 = (tl_ & 7) * 8;
    const float* muR = sCst + c0; const float* muK = sCst + 64 + c0; const float* muV = sCst + 128 + c0;
    const float* kkw = sCst + 192 + c0; const float* kaw = sCst + 256 + c0;
    float lw8[8], lp8[8];
    {
      float lwf[8];
      unpack8(R.lw, lwf);
#pragma unroll
      for (int j = 0; j < 8; ++j) { lw8[j] = -0.6065306597126334f * sigmoidf_(lwf[j]); lp8[j] = lw8[j]; }
#pragma unroll
      for (int off = 8; off < 64; off <<= 1) {
#pragma unroll
        for (int j = 0; j < 8; ++j) {
#ifdef CPU_EMU
          float o = emu_shfl_up(lp8[j], off);
#else
          float o = __shfl_up(lp8[j], off, 64);
#endif
          if (lane >= off) lp8[j] += o;
        }
      }
      if (lane >= 56) {
#pragma unroll
        for (int j = 0; j < 8; ++j) sLP[wave * 64 + c0 + j] = lp8[j];
      }
      if ((tid & 7) == 0) sRow[t] = R.row;
    }
    __syncthreads();
    {
#pragma unroll
      for (int j = 0; j < 8; ++j) {
        float offs = 0.f;
        for (int w2 = 0; w2 < wave; ++w2) offs += sLP[w2 * 64 + c0 + j];
        lp8[j] += offs;
      }
      if (t == 31) {
#pragma unroll
        for (int j = 0; j < 8; ++j) sPT[c0 + j] = fexp(lp8[j]);
      }
    }
    {
      float xs[8], xn[8], kt[8], aa[8], ob[8], ok[8];
      unpack8(R.ks, xs); unpack8(R.kn, xn);
      float ss = 0.f;
#pragma unroll
      for (int j = 0; j < 8; ++j) { kt[j] = xs[j] + muK[j] * (xn[j] - xs[j]); aa[j] = kt[j] * kkw[j]; ss += aa[j] * aa[j]; }
      ss += wshfl_xor(ss, 1); ss += wshfl_xor(ss, 2); ss += wshfl_xor(ss, 4);
      const float rn = frsq(ss + 1e-12f);
      float laf[8];
      unpack8(R.la, laf);
#pragma unroll
      for (int j = 0; j < 8; ++j) {
        const float lp = lp8[j];
        const float lpm = lp8[j] - lw8[j];
        const float e = fexp(-lp);
        const float kkn = aa[j] * rn;
        const float asg = sigmoidf_(laf[j]);
        aa[j] = -kkn * fexp(lpm);
        ob[j] = kkn * asg * e;
        ok[j] = kt[j] * (1.f + (asg - 1.f) * kaw[j]) * e;
      }
      *(u32x4*)(sAt + t * 72 + c0) = pack8(aa);
      *(u32x4*)(sBt + t * 72 + c0) = pack8(ob);
      *(u32x4*)(sKt + t * 72 + c0) = pack8(ok);
#pragma unroll
      for (int j = 0; j < 8; ++j) { sBT[(c0 + j) * 40 + t] = f2bf(ob[j]); sKT[(c0 + j) * 40 + t] = f2bf(ok[j]); }
      unpack8(R.vs, xs); unpack8(R.vn, xn);
#pragma unroll
      for (int j = 0; j < 8; ++j) sVT[(c0 + j) * 40 + t] = f2bf(xs[j] + muV[j] * (xn[j] - xs[j]));
      if (FULL) {
        unpack8(R.rs, xs); unpack8(R.rn, xn);
#pragma unroll
        for (int j = 0; j < 8; ++j) xs[j] = (xs[j] + muR[j] * (xn[j] - xs[j])) * fexp(lp8[j]);
        *(u32x4*)(sRt + t * 72 + c0) = pack8(xs);
      }
    }
    if (cc + 1 < cc1) rwkv_load_raw(proj, lora, b, h, d, cc + 1, t, c0, R);
    __syncthreads();
    if (FULL || wave < 2) {
      const bf16_t* Asrc = wave < 2 ? sAt : sRt;
      const bf16_t* Bsrc = (wave & 1) ? sKt : sBt;
      f32x16 acc;
#pragma unroll
      for (int r = 0; r < 16; ++r) acc[r] = 0.f;
#pragma unroll
      for (int kk = 0; kk < 4; ++kk) {
        bf16x8 a = *(const bf16x8*)(Asrc + l31 * 72 + kk * 16 + 8 * hl);
        bf16x8 bb = *(const bf16x8*)(Bsrc + l31 * 72 + kk * 16 + 8 * hl);
        acc = mfma32(a, bb, acc);
      }
      bf16_t* dst = wave == 1 ? sLak : (wave == 2 ? sLrb : sLrk);
#pragma unroll
      for (int r = 0; r < 16; ++r) {
        int tt = acc_row(r, lane), j = l31;
        bool keep = wave < 2 ? (j < tt) : (j <= tt);
        float v = keep ? acc[r] : 0.f;
        if (wave == 0) sLab[tt * 33 + j] = v;
        else dst[tt * 40 + j] = f2bf(v);
      }
    }
    __syncthreads();
    if (tid < 32) {
      const int q = tid >> 4, c = tid & 15;
      float x[16];
#pragma unroll
      for (int i = 0; i < 16; ++i) {
        float sacc = (i == c) ? 1.f : 0.f;
#pragma unroll
        for (int j = 0; j < i; ++j) sacc += sLab[(q * 16 + i) * 33 + q * 16 + j] * x[j];
        x[i] = sacc;
        sD[q * 256 + i * 16 + c] = sacc;
      }
    }
    __syncthreads();
    {
      const int i = tid >> 4, c = tid & 15;
      float sacc = 0.f;
#pragma unroll
      for (int j = 0; j < 16; ++j) sacc += sLab[(16 + i) * 33 + j] * sD[j * 16 + c];
      sD[512 + i * 16 + c] = sacc;
    }
    __syncthreads();
    {
      const int i = tid >> 4, c = tid & 15;
      float sacc = 0.f;
#pragma unroll
      for (int j = 0; j < 16; ++j) sacc += sD[256 + i * 16 + j] * sD[512 + j * 16 + c];
      sM[(16 + i) * 40 + c] = f2bf(sacc);
      sM[i * 40 + c] = f2bf(sD[i * 16 + c]);
      sM[(16 + i) * 40 + 16 + c] = f2bf(sD[256 + i * 16 + c]);
      sM[i * 40 + 16 + c] = 0;
    }
    if (wave < NVB) {
      const int vb = wave;
      f32x16 acc;
#pragma unroll
      for (int r = 0; r < 16; ++r) acc[r] = 0.f;
#pragma unroll
      for (int kk = 0; kk < 4; ++kk) {
        bf16x8 a = *(const bf16x8*)(sAt + l31 * 72 + kk * 16 + 8 * hl);
        bf16x8 bb = *(const bf16x8*)(sZ + (vb * 32 + l31) * 72 + kk * 16 + 8 * hl);
        acc = mfma32(a, bb, acc);
      }
      if (vb < 2) {
#pragma unroll
        for (int kk = 0; kk < 2; ++kk) {
          bf16x8 a = *(const bf16x8*)(sLak + l31 * 40 + kk * 16 + 8 * hl);
          bf16x8 bb = *(const bf16x8*)(sVT + (vb * 32 + l31) * 40 + kk * 16 + 8 * hl);
          acc = mfma32(a, bb, acc);
        }
      }
#pragma unroll
      for (int g = 0; g < 4; ++g) {
        u32x2 pk; pk.x = pack2(acc[4 * g], acc[4 * g + 1]); pk.y = pack2(acc[4 * g + 2], acc[4 * g + 3]);
        *(u32x2*)(sRT + (vb * 32 + l31) * 40 + 8 * g + 4 * hl) = pk;
      }
    }
    __syncthreads();
    if (wave < NVB) {
      const int vb = wave;
      f32x16 acc;
#pragma unroll
      for (int r = 0; r < 16; ++r) acc[r] = 0.f;
#pragma unroll
      for (int kk = 0; kk < 2; ++kk) {
        bf16x8 a = *(const bf16x8*)(sM + l31 * 40 + kk * 16 + 8 * hl);
        bf16x8 bb = *(const bf16x8*)(sRT + (vb * 32 + l31) * 40 + kk * 16 + 8 * hl);
        acc = mfma32(a, bb, acc);
      }
#pragma unroll
      for (int g = 0; g < 4; ++g) {
        u32x2 pk; pk.x = pack2(acc[4 * g], acc[4 * g + 1]); pk.y = pack2(acc[4 * g + 2], acc[4 * g + 3]);
        *(u32x2*)(sSAT + (vb * 32 + l31) * 40 + 8 * g + 4 * hl) = pk;
      }
    }
    __syncthreads();
    if (FULL) {
      if (wave < 2) {
        const int vb = wave;
        f32x16 acc;
#pragma unroll
        for (int r = 0; r < 16; ++r) acc[r] = 0.f;
#pragma unroll
        for (int kk = 0; kk < 4; ++kk) {
          bf16x8 a = *(const bf16x8*)(sZ + (vb * 32 + l31) * 72 + kk * 16 + 8 * hl);
          bf16x8 bb = *(const bf16x8*)(sRt + l31 * 72 + kk * 16 + 8 * hl);
          acc = mfma32(a, bb, acc);
        }
#pragma unroll
        for (int kk = 0; kk < 2; ++kk) {
          bf16x8 a = *(const bf16x8*)(sSAT + (vb * 32 + l31) * 40 + kk * 16 + 8 * hl);
          bf16x8 bb = *(const bf16x8*)(sLrb + l31 * 40 + kk * 16 + 8 * hl);
          acc = mfma32(a, bb, acc);
        }
#pragma unroll
        for (int kk = 0; kk < 2; ++kk) {
          bf16x8 a = *(const bf16x8*)(sVT + (vb * 32 + l31) * 40 + kk * 16 + 8 * hl);
          bf16x8 bb = *(const bf16x8*)(sLrk + l31 * 40 + kk * 16 + 8 * hl);
          acc = mfma32(a, bb, acc);
        }
        {
          const size_t obase = (size_t)sRow[l31] * 1024 + d * 512 + h * 64 + vb * 32;
#pragma unroll
          for (int g = 0; g < 4; ++g) {
            u32x2 pk; pk.x = pack2(acc[4 * g], acc[4 * g + 1]); pk.y = pack2(acc[4 * g + 2], acc[4 * g + 3]);
            *(u32x2*)(yout + obase + 8 * g + 4 * hl) = pk;
          }
        }
      } else {
        const int cb = wave - 2;
#pragma unroll
        for (int vb = 0; vb < 2; ++vb) {
          f32x16 acc;
#pragma unroll
          for (int r = 0; r < 16; ++r) acc[r] = 0.f;
#pragma unroll
          for (int kk = 0; kk < 2; ++kk) {
            bf16x8 a = *(const bf16x8*)(sBT + (cb * 32 + l31) * 40 + kk * 16 + 8 * hl);
            bf16x8 bb = *(const bf16x8*)(sSAT + (vb * 32 + l31) * 40 + kk * 16 + 8 * hl);
            acc = mfma32(a, bb, acc);
          }
#pragma unroll
          for (int kk = 0; kk < 2; ++kk) {
            bf16x8 a = *(const bf16x8*)(sKT + (cb * 32 + l31) * 40 + kk * 16 + 8 * hl);
            bf16x8 bb = *(const bf16x8*)(sVT + (vb * 32 + l31) * 40 + kk * 16 + 8 * hl);
            acc = mfma32(a, bb, acc);
          }
#pragma unroll
          for (int r = 0; r < 16; ++r) Zm[vb][r] = sPT[cb * 32 + acc_row(r, lane)] * (Zm[vb][r] + acc[r]);
        }
      }
      __syncthreads();
      if (wave >= 2) {
        const int cb = wave - 2;
#pragma unroll
        for (int vb = 0; vb < 2; ++vb)
#pragma unroll
          for (int g = 0; g < 4; ++g) {
            u32x2 pk; pk.x = pack2(Zm[vb][4 * g], Zm[vb][4 * g + 1]); pk.y = pack2(Zm[vb][4 * g + 2], Zm[vb][4 * g + 3]);
            *(u32x2*)(sZ + (vb * 32 + l31) * 72 + cb * 32 + 8 * g + 4 * hl) = pk;
          }
      }
    } else {
      const int vb = wave;
#pragma unroll
      for (int cb = 0; cb < 2; ++cb) {
        f32x16 acc;
#pragma unroll
        for (int r = 0; r < 16; ++r) acc[r] = 0.f;
#pragma unroll
        for (int kk = 0; kk < 2; ++kk) {
          bf16x8 a = *(const bf16x8*)(sBT + (cb * 32 + l31) * 40 + kk * 16 + 8 * hl);
          bf16x8 bb = *(const bf16x8*)(sSAT + (vb * 32 + l31) * 40 + kk * 16 + 8 * hl);
          acc = mfma32(a, bb, acc);
        }
        if (vb < 2) {
#pragma unroll
          for (int kk = 0; kk < 2; ++kk) {
            bf16x8 a = *(const bf16x8*)(sKT + (cb * 32 + l31) * 40 + kk * 16 + 8 * hl);
            bf16x8 bb = *(const bf16x8*)(sVT + (vb * 32 + l31) * 40 + kk * 16 + 8 * hl);
            acc = mfma32(a, bb, acc);
          }
        }
#pragma unroll
        for (int r = 0; r < 16; ++r) Zm[cb][r] = sPT[cb * 32 + acc_row(r, lane)] * (Zm[cb][r] + acc[r]);
      }
#pragma unroll
      for (int cb = 0; cb < 2; ++cb)
#pragma unroll
        for (int g = 0; g < 4; ++g) {
          u32x2 pk; pk.x = pack2(Zm[cb][4 * g], Zm[cb][4 * g + 1]); pk.y = pack2(Zm[cb][4 * g + 2], Zm[cb][4 * g + 3]);
          *(u32x2*)(sZ + (vb * 32 + l31) * 72 + cb * 32 + 8 * g + 4 * hl) = pk;
        }
    }
  }
  if (!FULL) {
    float* Zs = segZ + ((size_t)sid * RW_NSEG + seg) * 64 * 128;
#pragma unroll
    for (int cb = 0; cb < 2; ++cb)
#pragma unroll
      for (int r = 0; r < 16; ++r) Zs[(cb * 32 + acc_row(r, lane)) * 128 + wave * 32 + l31] = Zm[cb][r];
  }
}

constexpr int LRU_NCH = (CTXL + SEQ) / 64;
constexpr size_t OFF_ACUM0 = OFF_PU;
static_assert((size_t)NLAT * 512 * 2 <= (size_t)2 * NEXP * 1024, "acum0");

struct LruRaw { u32x4 x[2][4]; };
DEV void lru_load_raw(const Params& P, int sid, int cc, LruRaw& R) {
  constexpr int NC_CTX = CTXL / 64;
  const int tid = threadIdx.x;
  const int d = sid & 1, blk = (sid >> 1) & 7, b = sid >> 4;
  const bf16_t* proj = (const bf16_t*)(P.ws + OFF_PROJ);
  const int sgi = cc >= NC_CTX;
  const int row0 = sgi ? NCTX + b * SEQ : b * CTXL;
  const int len = sgi ? SEQ : CTXL;
  const int cl = (sgi ? cc - NC_CTX : cc) * 64;
  const int lch = blk * 64 + (tid & 7) * 8;
  const u32x4 z4 = {0u, 0u, 0u, 0u};
#pragma unroll
  for (int i = 0; i < 2; ++i) {
    int c = tid + i * 256, r = c >> 3;
    int p = cl + r, pos = d ? len - 1 - p : p;
#pragma unroll
    for (int tap = 0; tap < 4; ++tap) {
      int pp = pos + tap - 2;
      R.x[i][tap] = (pp >= 0 && pp < len) ? *(const u32x4*)(proj + (size_t)(row0 + pp) * ODC + 2304 + lch) : z4;
    }
  }
}

DEV void st_lru_chunk(const Params& P, int sid, int cc, int nsid, int ncc, bool has_next, LruRaw& R, unsigned char* smem) {
  constexpr int NC_CTX = CTXL / 64;
  const int tid = threadIdx.x, lane = tid & 63, wave = tid >> 6;
  const int d = sid & 1, blk = (sid >> 1) & 7, b = sid >> 4;
  float* sXc = (float*)smem;
  float* sAc = sXc + 4096;
  float* sBc = sAc + 4096;
  float* sU = sBc + 4096;
  bf16_t* sAop = (bf16_t*)(sU + 4096);
  float* sQA = (float*)(sAop + 64 * 72);
  float* sQH = sQA + 256;
  int* sRow = (int*)(sQH + 256);
  const bf16_t* proj = (const bf16_t*)(P.ws + OFF_PROJ);
  bf16_t* uout = (bf16_t*)(P.ws + OFF_LORA) + (size_t)d * NTOK * 512;
  bf16_t* aout = (bf16_t*)(P.ws + (d ? OFF_ACUM1 : OFF_ACUM0));
  const bf16_t* lruT = (const bf16_t*)(P.ws + OFF_LRUT) + (size_t)(d * 8 + blk) * 128 * 64;
  float* chunkS = (float*)(P.ws + OFF_LRUCS) + ((size_t)sid * LRU_NCH + cc) * 128;
  const float* cw = P.in[I_LCONVW];
  const float* cb = P.in[I_LCONVB];
  const int tr = (wave >> 1) * 32, nc0 = (wave & 1) * 64;
  const int sgi = cc >= NC_CTX;
  const int row0 = sgi ? NCTX + b * SEQ : b * CTXL;
  const int len = sgi ? SEQ : CTXL;
  const int cl = (sgi ? cc - NC_CTX : cc) * 64;
  __syncthreads();
  if (tid < 64) { int p = cl + tid; sRow[tid] = row0 + (d ? len - 1 - p : p); }
  {
    const int lc8 = (tid & 7) * 8, lch = blk * 64 + lc8;
#pragma unroll
    for (int i = 0; i < 2; ++i) {
      int c = tid + i * 256, r = c >> 3;
      int p = cl + r, pos = d ? len - 1 - p : p;
      float o[8];
      f32x4 c0 = *(const f32x4*)(cb + lch), c1 = *(const f32x4*)(cb + lch + 4);
      o[0] = c0.x; o[1] = c0.y; o[2] = c0.z; o[3] = c0.w; o[4] = c1.x; o[5] = c1.y; o[6] = c1.z; o[7] = c1.w;
#pragma unroll
      for (int tap = 0; tap < 4; ++tap) {
        float x[8];
        unpack8(R.x[i][tap], x);
        f32x4 w0 = *(const f32x4*)(cw + tap * 512 + lch), w1 = *(const f32x4*)(cw + tap * 512 + lch + 4);
        o[0] += w0.x * x[0]; o[1] += w0.y * x[1]; o[2] += w0.z * x[2]; o[3] += w0.w * x[3];
        o[4] += w1.x * x[4]; o[5] += w1.y * x[5]; o[6] += w1.z * x[6]; o[7] += w1.w * x[7];
      }
#pragma unroll
      for (int j = 0; j < 8; ++j) sXc[r * 64 + lc8 + j] = o[j];
      *(u32x4*)(sAop + r * 72 + lc8) = pack8(o);
    }
  }
  if (has_next) lru_load_raw(P, nsid, ncc, R);
  __syncthreads();
  {
    f32x16 acc[2];
#pragma unroll
    for (int j = 0; j < 2; ++j)
#pragma unroll
      for (int r = 0; r < 16; ++r) acc[j][r] = 0.f;
#pragma unroll
    for (int kk = 0; kk < 4; ++kk) {
      bf16x8 a = *(const bf16x8*)(sAop + (tr + (lane & 31)) * 72 + kk * 16 + 8 * (lane >> 5));
#pragma unroll
      for (int j = 0; j < 2; ++j) {
        bf16x8 bb = *(const bf16x8*)(lruT + (nc0 + j * 32 + (lane & 31)) * 64 + kk * 16 + 8 * (lane >> 5));
        acc[j] = mfma32(a, bb, acc[j]);
      }
    }
#pragma unroll
    for (int j = 0; j < 2; ++j) {
      const int e = nc0 + j * 32 + (lane & 31);
      const int ch = blk * 64 + (e & 63);
      const float ebias = e < 64 ? P.in[I_BA][d * 512 + ch] : P.in[I_BI][d * 512 + ch];
      const float esp = softplusf_(-P.in[I_LAM][d * 512 + ch]);
#pragma unroll
      for (int r = 0; r < 16; ++r) {
        int t = tr + acc_row(r, lane);
        float g = sigmoidf_(acc[j][r] + ebias);
        if (e < 64) { float a_ = fexp(-8.f * g * esp); sAc[t * 64 + e] = a_; sU[t * 64 + e] = fsqrt(fmaxf(1.f - a_ * a_, 0.f)); }
        else sBc[t * 64 + (e - 64)] = g * sXc[t * 64 + (e - 64)];
      }
    }
  }
  __syncthreads();
  const int c = tid & 63, q = tid >> 6;
  {
    float h = 0.f, ap = 1.f;
#pragma unroll 4
    for (int i = 0; i < 16; ++i) {
      const int t = q * 16 + i;
      const float a = sAc[t * 64 + c];
      h = a * h + sU[t * 64 + c] * sBc[t * 64 + c];
      ap *= a;
      sU[t * 64 + c] = h; sAc[t * 64 + c] = ap;
    }
    sQA[q * 64 + c] = ap; sQH[q * 64 + c] = h;
  }
  __syncthreads();
  {
    float hin = 0.f, ain = 1.f;
    for (int q2 = 0; q2 < q; ++q2) { hin = sQA[q2 * 64 + c] * hin + sQH[q2 * 64 + c]; ain *= sQA[q2 * 64 + c]; }
    if (q > 0) {
#pragma unroll 4
      for (int i = 0; i < 16; ++i) {
        const int t = q * 16 + i;
        const float ap = sAc[t * 64 + c];
        sU[t * 64 + c] += ap * hin;
        sAc[t * 64 + c] = ap * ain;
      }
    }
    if (q == 3) { chunkS[c] = sAc[63 * 64 + c]; chunkS[64 + c] = sU[63 * 64 + c]; }
  }
  __syncthreads();
  if (sgi) {
#pragma unroll
    for (int i = 0; i < 2; ++i) {
      int cidx = tid + i * 256, r = cidx >> 3, c8 = (cidx & 7) * 8;
      float u8[8], a8[8];
#pragma unroll
      for (int j = 0; j < 8; ++j) { u8[j] = sU[r * 64 + c8 + j]; a8[j] = sAc[r * 64 + c8 + j]; }
      const int row = sRow[r];
      *(u32x4*)(uout + (size_t)row * 512 + blk * 64 + c8) = pack8(u8);
      *(u32x4*)(aout + (size_t)(row - NCTX) * 512 + blk * 64 + c8) = pack8(a8);
    }
  }
}

DEV void st_lru_carry(const Params& P, int sid) {
  const int c = threadIdx.x;
  if (c >= 64) return;
  const float* cs = (const float*)(P.ws + OFF_LRUCS) + (size_t)sid * LRU_NCH * 128;
  float* hs = (float*)(P.ws + OFF_LRUHS) + (size_t)sid * LRU_NCH * 64;
  float h = 0.f;
  for (int cc0 = 0; cc0 < LRU_NCH; cc0 += 10) {
    float a[10], bb[10];
#pragma unroll
    for (int i = 0; i < 10; ++i) { a[i] = cs[(size_t)(cc0 + i) * 128 + c]; bb[i] = cs[(size_t)(cc0 + i) * 128 + 64 + c]; }
#pragma unroll
    for (int i = 0; i < 10; ++i) { hs[(size_t)(cc0 + i) * 64 + c] = h; h = a[i] * h + bb[i]; }
  }
}

DEV void st_finish_l1(const Params& P, int row) {
  const int lane = threadIdx.x & 63;
  bf16_t* hb = (bf16_t*)(P.ws + OFF_HBUF) + (size_t)row * 1024;
  const bf16_t* proj = (const bf16_t*)(P.ws + OFF_PROJ);
  const bf16_t* lora = (const bf16_t*)(P.ws + OFF_LORA);
  const float* mu = P.in[I_MU];
  const int ch = lane * 8;
  float y0[8], y1[8];
  unpack8(*(const u32x4*)(hb + ch), y0);
  unpack8(*(const u32x4*)(hb + 512 + ch), y1);
  float sm = 0.f;
#pragma unroll
  for (int j = 0; j < 8; ++j) { y0[j] += y1[j]; sm += y0[j]; }
  sm += wshfl_xor(sm, 1); sm += wshfl_xor(sm, 2); sm += wshfl_xor(sm, 4);
  const float mean = sm * (1.f / 64.f);
  float sv = 0.f;
#pragma unroll
  for (int j = 0; j < 8; ++j) { float dlt = y0[j] - mean; sv += dlt * dlt; }
  sv += wshfl_xor(sv, 1); sv += wshfl_xor(sv, 2); sv += wshfl_xor(sv, 4);
  const float rstd = frsq(sv * (1.f / 64.f) + 64e-5f);
  float a0[8], a1[8], g[8], u0[8], u1[8], gb[8];
  unpack8(*(const u32x4*)(lora + ((size_t)2 * NTOK + row) * 512 + ch), a0);
  unpack8(*(const u32x4*)(lora + ((size_t)3 * NTOK + row) * 512 + ch), a1);
  unpack8(*(const u32x4*)(lora + ((size_t)4 * NTOK + row) * 512 + ch), g);
  unpack8(*(const u32x4*)(lora + ((size_t)0 * NTOK + row) * 512 + ch), u0);
  unpack8(*(const u32x4*)(lora + ((size_t)1 * NTOK + row) * 512 + ch), u1);
  if (row >= NCTX) {
    const int bb_ = (row - NCTX) / SEQ, pos = (row - NCTX) % SEQ, blk = ch >> 6;
    float ac[8];
#pragma unroll
    for (int dd = 0; dd < 2; ++dd) {
      const int pidx = dd ? SEQ - 1 - pos : pos;
      const int cc = CTXL / 64 + pidx / 64;
      const int sid = (bb_ * 8 + blk) * 2 + dd;
      const float* hs = (const float*)(P.ws + OFF_LRUHS) + ((size_t)sid * LRU_NCH + cc) * 64 + (ch & 63);
      unpack8(*(const u32x4*)((const bf16_t*)(P.ws + (dd ? OFF_ACUM1 : OFF_ACUM0)) + (size_t)(row - NCTX) * 512 + ch), ac);
      f32x4 h0 = *(const f32x4*)hs, h1 = *(const f32x4*)(hs + 4);
      float* u = dd ? u1 : u0;
      u[0] += ac[0] * h0.x; u[1] += ac[1] * h0.y; u[2] += ac[2] * h0.z; u[3] += ac[3] * h0.w;
      u[4] += ac[4] * h1.x; u[5] += ac[5] * h1.y; u[6] += ac[6] * h1.z; u[7] += ac[7] * h1.w;
    }
  }
  unpack8(*(const u32x4*)(proj + (size_t)row * ODC + 1792 + ch), gb);
  float rv[8], vv[8], kv[8];
  float sdot = 0.f;
  float pka[8], prk[8], plw[8], plb[8];
  ld8(P.in[I_KA] + ch, pka); ld8(P.in[I_RK] + ch, prk); ld8(P.in[I_LNW] + ch, plw); ld8(P.in[I_LNB] + ch, plb);
  mix8(proj, row, ch, mu, rv);
  mix8(proj, row, 512 + ch, mu, kv);
  mix8(proj, row, 1024 + ch, mu, vv);
#pragma unroll
  for (int j = 0; j < 8; ++j) {
    float r = rv[j];
    float k = kv[j];
    float am = 0.5f * (sigmoidf_(a0[j]) + sigmoidf_(a1[j]));
    float kb = k * (1.f + (am - 1.f) * pka[j]);
    sdot += r * kb * prk[j];
    rv[j] = r;
  }
  sdot += wshfl_xor(sdot, 1); sdot += wshfl_xor(sdot, 2); sdot += wshfl_xor(sdot, 4);
  float f1[8], f2[8];
#pragma unroll
  for (int j = 0; j < 8; ++j) {
    float yn = (y0[j] - mean) * rstd * plw[j] + plb[j];
    yn += sdot * vv[j];
    f1[j] = yn * g[j];
    f2[j] = (u0[j] + u1[j]) * geluf_(gb[j]);
  }
  *(u32x4*)(hb + ch) = pack8(f1);
  *(u32x4*)(hb + 512 + ch) = pack8(f2);
}

DEV unsigned fkey(float f) { unsigned u; __builtin_memcpy(&u, &f, 4); return (u >> 31) ? ~u : (u | 0x80000000u); }
DEV float keyf(unsigned u) { u = (u >> 31) ? (u & 0x7fffffffu) : ~u; float f; __builtin_memcpy(&f, &u, 4); return f; }
DEV void key_insert(unsigned x, unsigned* v) {
#pragma unroll
  for (int j = 0; j < 16; ++j) { unsigned hi = v[j] > x ? v[j] : x; x = v[j] > x ? x : v[j]; v[j] = hi; }
}
DEV void key_cx(unsigned& hi, unsigned& lo) { unsigned a = hi, b = lo; hi = a > b ? a : b; lo = a > b ? b : a; }
DEV void key_sort16(unsigned* v) {
#pragma unroll
  for (int k = 2; k <= 16; k <<= 1)
#pragma unroll
    for (int j = k >> 1; j > 0; j >>= 1)
#pragma unroll
      for (int i = 0; i < 16; ++i) {
        const int l = i ^ j;
        if (l > i) { if ((i & k) == 0) key_cx(v[i], v[l]); else key_cx(v[l], v[i]); }
      }
}
DEV void key_merge16(unsigned* a, const unsigned* b) {
#pragma unroll
  for (int i = 0; i < 16; ++i) a[i] = a[i] > b[15 - i] ? a[i] : b[15 - i];
#pragma unroll
  for (int j = 8; j > 0; j >>= 1)
#pragma unroll
    for (int i = 0; i < 16; ++i) { const int l = i ^ j; if (l > i) key_cx(a[i], a[l]); }
}

DEV void st_peer_topk(const Params& P, int layer, int tile, int h, unsigned char* smem) {
  const int tid = threadIdx.x;
  const bf16_t* q = (const bf16_t*)(P.ws + OFF_Q);
  const bf16_t* keys = (const bf16_t*)(P.ws + OFF_KEYS) + (size_t)(layer * 8 + h) * 2 * 128 * 128;
  float* sS = (float*)smem;
  const int m0 = tile * 128;
  const int tok = tid & 127, half = tid >> 7;
  unsigned kl[2][16];
#pragma unroll
  for (int p = 0; p < 2; ++p) {
    EpiScoreLds epi{sS, m0};
    gemm_tile_128<true>(q + (h * 2 + p) * 128, 2048, NTOK, keys + p * 128 * 128, 128, 128, 128, m0, 0, epi, smem);
    __syncthreads();
    float* row = sS + tok * 129 + half * 64;
#pragma unroll
    for (int g = 0; g < 4; ++g) {
      unsigned grp[16];
#pragma unroll
      for (int j = 0; j < 16; ++j) grp[j] = (fkey(row[g * 16 + j]) & ~127u) | (unsigned)(127 - (half * 64 + g * 16 + j));
      key_sort16(grp);
      if (g == 0) {
#pragma unroll
        for (int j = 0; j < 16; ++j) kl[p][j] = grp[j];
      } else key_merge16(kl[p], grp);
    }
    if (half == 1) {
#pragma unroll
      for (int j = 0; j < 16; ++j) row[j] = __builtin_bit_cast(float, kl[p][j]);
    }
    __syncthreads();
    if (half == 0) {
      unsigned oth[16];
#pragma unroll
      for (int j = 0; j < 16; ++j) oth[j] = __builtin_bit_cast(unsigned, sS[tok * 129 + 64 + j]);
      key_merge16(kl[p], oth);
    }
    __syncthreads();
  }
  if (tid < 128) {
    float sv0[16], sv1[16];
    int* irow = (int*)(sS + tid * 129);
#pragma unroll
    for (int j = 0; j < 16; ++j) {
      sv0[j] = keyf((kl[0][j] & ~127u) | 64u); sv1[j] = keyf((kl[1][j] & ~127u) | 64u);
      irow[j] = 127 - (int)(kl[0][j] & 127u); irow[16 + j] = 127 - (int)(kl[1][j] & 127u);
    }
    unsigned best[16];
#pragma unroll
    for (int j = 0; j < 16; ++j) best[j] = 0u;
#pragma unroll
    for (int i = 0; i < 16; ++i)
#pragma unroll
      for (int j = 0; j < 16; ++j)
        if ((i + 1) * (j + 1) <= 16) key_insert((fkey(sv0[i] + sv1[j]) & ~255u) | (unsigned)(255 - (i * 16 + j)), best);
    float e[16], sum = 0.f;
    const float b0 = keyf((best[0] & ~255u) | 128u);
#pragma unroll
    for (int j = 0; j < 16; ++j) { e[j] = fexp(keyf((best[j] & ~255u) | 128u) - b0); sum += e[j]; }
    const float inv = 1.f / sum;
    int* pidx = (int*)(P.ws + OFF_PIDX) + (size_t)(m0 + tid) * 128 + h * 16;
    float* pg = (float*)(P.ws + OFF_PGATE) + (size_t)(m0 + tid) * 128 + h * 16;
#pragma unroll
    for (int j = 0; j < 16; ++j) {
      const int pos = 255 - (int)(best[j] & 255u);
      pidx[j] = irow[pos >> 4] * 128 + irow[16 + (pos & 15)];
      pg[j] = e[j] * inv;
    }
  }
}

DEV void st_peer_experts(const Params& P, int layer, int row) {
  const int lane = threadIdx.x & 63;
  const bf16_t* xb = (const bf16_t*)(P.ws + OFF_HBUF) + (size_t)row * 1024;
  const unsigned char* U = P.ws + OFF_PU;
  const int* pidx = (const int*)(P.ws + OFF_PIDX) + (size_t)row * 128;
  const float* pg = (const float*)(P.ws + OFF_PGATE) + (size_t)row * 128;
  float x[16], acc[16];
  unpack8(*(const u32x4*)(xb + lane * 16), x);
  unpack8(*(const u32x4*)(xb + lane * 16 + 8), x + 8);
#pragma unroll
  for (int j = 0; j < 16; ++j) acc[j] = 0.f;
  const int b5 = (lane >> 5) & 1, b4 = (lane >> 4) & 1, b3 = (lane >> 3) & 1;
  const int mypick = (lane >> 3) & 7;
  for (int k0 = 0; k0 < 128; k0 += 8) {
    u32x3 uu[8]; u32x2 vv[8];
#pragma unroll
    for (int i = 0; i < 8; ++i) {
      const unsigned char* er = U + (size_t)pidx[k0 + i] * PEER_ROWB;
      const unsigned* up = (const unsigned*)(er + lane * 12);
      uu[i].x = up[0]; uu[i].y = up[1]; uu[i].z = up[2];
      vv[i] = *(const u32x2*)(er + PEER_VOFF + lane * 8);
    }
    const float mygate = pg[k0 + mypick];
    float dsum[8];
#pragma unroll
    for (int i = 0; i < 8; i += 2) {
      float ufa[16], ufb[16];
#ifndef CPU_EMU
      __builtin_amdgcn_sched_barrier(0);
#endif
      unpack2x16_fp6(uu[i], uu[i + 1], ufa, ufb);
      typedef __attribute__((ext_vector_type(2))) float f32x2v;
      f32x2v da2 = {0.f, 0.f}, db2 = {0.f, 0.f};
#pragma unroll
      for (int j = 0; j < 8; ++j) {
        const f32x2v xx = {x[2 * j], x[2 * j + 1]};
        const f32x2v ua = {ufa[2 * j], ufa[2 * j + 1]}, ub = {ufb[2 * j], ufb[2 * j + 1]};
        da2 = xx * ua + da2; db2 = xx * ub + db2;
      }
      dsum[i] = da2.x + da2.y; dsum[i + 1] = db2.x + db2.y;
    }
    float e4[4], e2[2], g;
#pragma unroll
    for (int i = 0; i < 4; ++i) {
      float mine = b5 ? dsum[4 + i] : dsum[i], send = b5 ? dsum[i] : dsum[4 + i];
      e4[i] = mine + wshfl_xor(send, 32);
    }
#pragma unroll
    for (int i = 0; i < 2; ++i) {
      float mine = b4 ? e4[2 + i] : e4[i], send = b4 ? e4[i] : e4[2 + i];
      e2[i] = mine + wshfl_xor(send, 16);
    }
    {
      float mine = b3 ? e2[1] : e2[0], send = b3 ? e2[0] : e2[1];
      g = mine + wshfl_xor(send, 8);
    }
    g += wshfl_xor(g, 4); g += wshfl_xor(g, 2); g += wshfl_xor(g, 1);
    const float mycoef = mygate * geluf_(g * (1.f / PEER_USCALE));
#pragma unroll
    for (int i = 0; i < 8; ++i) {
      const float coef = wreadlane(mycoef, i * 8);
      float vf[16];
      unpack8_fp4(vv[i].x, vf); unpack8_fp4(vv[i].y, vf + 8);
#pragma unroll
      for (int j = 0; j < 16; ++j) acc[j] += coef * vf[j];
    }
  }
  float* xr = row < NCTX ? (float*)(P.ws + OFF_CTXRES) + (size_t)row * 1024 : P.out + (size_t)(row - NCTX) * 1024;
  const float* g2 = (const float*)(P.ws + OFF_MODV) + ((size_t)layer * 3 + mod_row(row)) * 6144 + 5 * 1024;
  float o[16];
#pragma unroll
  for (int q = 0; q < 4; ++q) {
    const int c = lane * 16 + q * 4;
    f32x4 a = *(const f32x4*)(xr + c), ga = *(const f32x4*)(g2 + c);
    o[q * 4 + 0] = a.x + ga.x * acc[q * 4 + 0] * (1.f / PEER_VSCALE); o[q * 4 + 1] = a.y + ga.y * acc[q * 4 + 1] * (1.f / PEER_VSCALE);
    o[q * 4 + 2] = a.z + ga.z * acc[q * 4 + 2] * (1.f / PEER_VSCALE); o[q * 4 + 3] = a.w + ga.w * acc[q * 4 + 3] * (1.f / PEER_VSCALE);
  }
  float ss = 0.f;
#pragma unroll
  for (int j = 0; j < 16; ++j) ss += o[j] * o[j];
  ss = wave_sum(ss);
  const float rstd = frsq(ss * (1.f / 1024.f) + 1e-6f);
  if (layer == 1) {
    float fn[16]; ld8(P.in[I_FNORM] + lane * 16, fn); ld8(P.in[I_FNORM] + lane * 16 + 8, fn + 8);
#pragma unroll
    for (int j = 0; j < 16; ++j) o[j] *= rstd * fn[j];
  }
#pragma unroll
  for (int q = 0; q < 4; ++q) {
    f32x4 a = {o[q * 4 + 0], o[q * 4 + 1], o[q * 4 + 2], o[q * 4 + 3]};
    *(f32x4*)(xr + lane * 16 + q * 4) = a;
  }
  if (layer == 0) {
    const float* mv = (const float*)(P.ws + OFF_MODV) + ((size_t)1 * 3 + mod_row(row)) * 6144;
    const float* nw = P.in[I_NORM1] + 1024;
    float hh[16];
#pragma unroll
    for (int q = 0; q < 4; ++q) {
      const int c = lane * 16 + q * 4;
      f32x4 w4 = *(const f32x4*)(nw + c), s4 = *(const f32x4*)(mv + 1024 + c), h4 = *(const f32x4*)(mv + c);
      hh[q * 4 + 0] = o[q * 4 + 0] * rstd * w4.x * (1.f + s4.x) + h4.x; hh[q * 4 + 1] = o[q * 4 + 1] * rstd * w4.y * (1.f + s4.y) + h4.y;
      hh[q * 4 + 2] = o[q * 4 + 2] * rstd * w4.z * (1.f + s4.z) + h4.z; hh[q * 4 + 3] = o[q * 4 + 3] * rstd * w4.w * (1.f + s4.w) + h4.w;
    }
    bf16_t* hb = (bf16_t*)(P.ws + OFF_HBUF) + (size_t)row * 1024 + lane * 16;
    *(u32x4*)hb = pack8(hh);
    *(u32x4*)(hb + 8) = pack8(hh + 8);
  }
}


#define FOR_TILES_XCD(MT0, MT1, NT, mt, nt)                                                     \
  for (int _x = blockIdx.x & 7, _mlo = (MT0) + (((MT1) - (MT0)) * _x) / 8,                        \
           _mhi = (MT0) + (((MT1) - (MT0)) * (_x + 1)) / 8, _i = blockIdx.x >> 3,                 \
           _cnt = (_mhi - _mlo) * (NT), mt = 0, nt = 0;                                           \
       _i < _cnt && ((mt = _mlo + _i / (NT)), (nt = _i % (NT)), true); _i += (int)(gridDim.x >> 3))

#ifndef PHASE_LIST
#define PHASE_LIST(X) X(0) X(1) X(2) X(22) X(23) X(3) X(4) X(5) X(6) X(7) X(8) X(9) X(11) X(12) X(13) X(30) X(14) X(15) X(31) X(16) X(17) X(18) X(19) X(20) X(21)
#endif
constexpr int PH_LAST = 21;

template <int ph>
DEV void run_phase(const Params& P, unsigned char* smem) {
  int bid_ = blockIdx.x, wave_ = threadIdx.x >> 6;
  OPAQUE_S(bid_); OPAQUE(wave_);
  const int bid = bid_, nb = gridDim.x;
  const int wave = wave_;
  unsigned char* ws = P.ws;
  constexpr int layer = ((ph >= 10 && ph <= 21) || ph >= 30) ? 1 : 0;
  const float* modv_l = (const float*)(ws + OFF_MODV) + (size_t)layer * 3 * 6144;
  switch (ph) {
    case 0:
      for (int t = NTRANS + bid; t < NPREP; t += nb) st_prep(P, t, smem);
      break;
    case 1: case 10:
      if (ph == 1) for (int t = nb - 1 - bid; t < NTRANS; t += nb) st_prep(P, t, smem);
      for (int t = bid; t < NTOK / 4; t += nb) st_normmod(P, layer, 0, t * 4 + wave);
      break;
    case 2: {
      EpiProjL0T epi{(bf16_t*)(ws + OFF_PROJ), (float*)(ws + OFF_GATES)};
      FOR_TILES_XCD(0, NTOK / 256, 25, mt, nt)
        gemm_tile_128x256<EpiProjL0T, true>((const bf16_t*)(ws + OFF_WEVIN), 1024, EVC, (const bf16_t*)(ws + OFF_HBUF), 1024, NTOK, 1024,
                                            nt * 128, mt * 256, epi, smem);
    } break;
    case 22:
      for (int t = bid; t < NTOK / 4; t += nb) st_xbc_conv(P, t * 4 + wave);
      for (int t = bid; t < NPCONV; t += nb) st_peer_conv(P, 0, t);
      break;
    case 23:
      for (int t = bid; t < 48 * LA_NSEG; t += nb) {
        int sid = t % 48, seg = t / 48;
        if (sid < 16) st_linattn_seg<true, false>(P, sid, seg, smem);
        else st_linattn_seg<false, false>(P, sid - 16, seg, smem);
      }
      break;
    case 3:
      for (int t = bid; t < 48 * LA_NSEG; t += nb) {
        int sid = t % 48, seg = t / 48;
        if (sid < 16) st_linattn_seg<true, true>(P, sid, seg, smem);
        else st_linattn_seg<false, true>(P, sid - 16, seg, smem);
      }
      break;
    case 4:
      for (int t = bid; t < NTOK / 4; t += nb) st_finish_l0(P, t * 4 + wave);
      break;
    case 5: case 17: {
      EpiOutProjT epi{layer == 0 ? P.in[I_X] : P.out, P.in[I_CTX], P.out, (float*)(ws + OFF_CTXRES), modv_l};
      const bf16_t* Wt = (const bf16_t*)(ws + (layer == 0 ? OFF_WEVOUT : OFF_WODOUT));
      FOR_TILES_XCD(layer == 0 ? 0 : NCTX / 256, NTOK / 256, 8, mt, nt)
        gemm_tile_128x256<EpiOutProjT, true>(Wt, 1024, 1024, (const bf16_t*)(ws + OFF_HBUF), 1024, NTOK, 1024, nt * 128, mt * 256, epi, smem);
    } break;
    case 6: case 18: {
      const int r0 = layer == 0 ? 0 : NCTX / 4;
      for (int t = r0 + bid; t < NTOK / 4; t += nb) st_normmod(P, layer, 1, t * 4 + wave);
      if (ph == 18) for (int t = bid; t < NPCONV; t += nb) st_peer_conv(P, 1, t);
    } break;
    case 7: case 19: {
      EpiStoreBfT epi{(bf16_t*)(ws + OFF_Q), 2048};
      const bf16_t* Wt = (const bf16_t*)(ws + OFF_WQ) + (size_t)layer * 2048 * 1024;
      FOR_TILES_XCD(layer == 0 ? 0 : NCTX / 256, NTOK / 256, 16, mt, nt)
        gemm_tile_128x256<EpiStoreBfT, true>(Wt, 1024, 2048, (const bf16_t*)(ws + OFF_HBUF), 1024, NTOK, 1024, nt * 128, mt * 256, epi, smem);
    } break;
    case 8: case 20: {
      const int t0 = layer == 0 ? 0 : CTILE * 8;
      for (int t = t0 + bid; t < NTILE * 8; t += nb) st_peer_topk(P, layer, t / 8, t % 8, smem);
    } break;
    case 9: case 21: {
      const int r0 = layer == 0 ? 0 : NCTX / 4;
      for (int t = r0 + bid; t < NTOK / 4; t += nb) st_peer_experts(P, layer, t * 4 + wave);
    } break;
    case 11: {
      EpiStoreBfT epi{(bf16_t*)(ws + OFF_PROJ), ODC};
      FOR_TILES_XCD(0, NTOK / 256, 22, mt, nt)
        gemm_tile_128x256<EpiStoreBfT, true>((const bf16_t*)(ws + OFF_WODIN), 1024, ODC, (const bf16_t*)(ws + OFF_HBUF), 1024, NTOK, 1024,
                                             nt * 128, mt * 256, epi, smem);
    } break;
    case 12:
      for (int t = bid; t < NTOK / 8; t += nb) st_lora_act(P, t * 8 + wave * 2);
      break;
    case 13:
      for (int t = bid; t < NTILE * 20; t += nb) {
        int job = t / (NTILE * 4), tt = t % (NTILE * 4);
        int mt = tt / 4, nt = tt % 4;
        bf16_t* dst = (bf16_t*)(ws + OFF_LORA) + (size_t)job * NTOK * 512;
        const bf16_t* A = (const bf16_t*)(ws + OFF_HBUF) + (job < 2 ? 0 : (job < 4 ? 64 : 128));
        const bf16_t* Bt = job < 2 ? (const bf16_t*)(ws + OFF_WUP) + (size_t)job * 512 * 64
                         : job < 4 ? (const bf16_t*)(ws + OFF_AUP) + (size_t)(job - 2) * 512 * 64
                                   : (const bf16_t*)(ws + OFF_GUP);
        const float* bias = job < 2 ? P.in[I_W0] + job * 512 : (job < 4 ? P.in[I_A0] + (job - 2) * 512 : nullptr);
        const int K = job < 4 ? 64 : 128;
        EpiStoreBfBiasT epi{dst, 512, bias};
        gemm_tile_128<false, EpiStoreBfBiasT, true>(Bt, K, 512, A, 1024, NTOK, K, nt * 128, mt * 128, epi, smem);
      }
      break;
    case 30:
      for (int t = bid; t < 32 * RW_NSEG; t += nb) st_rwkv_seg<false>(P, t % 32, t / 32, smem);
      break;
    case 14:
      for (int t = bid; t < 32 * RW_NSEG; t += nb) st_rwkv_seg<true>(P, t % 32, t / 32, smem);
      break;
    case 15:
      {
        LruRaw R;
        if (bid < 32 * LRU_NCH) lru_load_raw(P, bid % 32, bid / 32, R);
        for (int t = bid; t < 32 * LRU_NCH; t += nb) {
          const int tn = t + nb;
          st_lru_chunk(P, t % 32, t / 32, tn % 32, tn / 32, tn < 32 * LRU_NCH, R, smem);
        }
      }
      break;
    case 31:
      if (bid < 32) st_lru_carry(P, bid);
      break;
    case 16:
      for (int t = bid; t < NTOK / 4; t += nb) st_finish_l1(P, t * 4 + wave);
      break;
    default: break;
  }
}


#ifndef CPU_EMU
#define XB_TMO      128
#define XB_XCNT(j)  (256  + 64 * (j))
#define XB_XSUB(j)  (1280 + 64 * (j))
#define XB_XGEN(j)  (2304 + 64 * (j))
#define XB_TOP      3328
#define XB_TOPGEN   3392
#define XCD_BAR_WORDS 3456
#define XB_SPIN_CAP (1u << 20)
#define LAS __attribute__((address_space(3)))
__device__ __forceinline__ unsigned xb_ld(unsigned* p)              { return __hip_atomic_load(p, __ATOMIC_RELAXED, __HIP_MEMORY_SCOPE_AGENT); }
__device__ __forceinline__ unsigned xb_add(unsigned* p, unsigned v) { return __hip_atomic_fetch_add(p, v, __ATOMIC_RELAXED, __HIP_MEMORY_SCOPE_AGENT); }
__device__ __forceinline__ unsigned xb_xcc_id() { return (unsigned)__builtin_amdgcn_s_getreg((3 << 11) | 20) & 0xFu; }
#define XB_SPIN(cond, bar) do { unsigned _sp = 0; while (cond) { __builtin_amdgcn_s_sleep(1); \
    if ((++_sp & 255u) == 0u) { if (xb_ld(&(bar)[XB_TMO])) break; if (_sp > XB_SPIN_CAP) { atomicAdd(&(bar)[XB_TMO], 1u); break; } } } } while (0)
struct XcdBarrier { unsigned* bar; unsigned x; volatile LAS unsigned* st; };
__device__ __forceinline__ XcdBarrier xcd_barrier_post(unsigned* bar, volatile LAS unsigned* st) {
  XcdBarrier b; b.bar = bar; b.x = xb_xcc_id(); b.st = st;
  if (threadIdx.x == 0) (void)xb_add(&bar[XB_XCNT(b.x)], 1u);
  return b;
}
__device__ __forceinline__ void xcd_barrier_complete(unsigned* bar, unsigned x, unsigned& nloc, unsigned& nx) {
  const unsigned G = gridDim.x * gridDim.y * gridDim.z;
  unsigned sum, cnt, mine, sp = 0u;
  for (;;) {
    sum = 0u; cnt = 0u; mine = 0u;
#pragma unroll
    for (unsigned j = 0; j < 16; ++j) { const unsigned c = xb_ld(&bar[XB_XCNT(j)]); sum += c; cnt += (c > 0u) ? 1u : 0u; mine = (j == x) ? c : mine; }
    if (sum == G) break;
    __builtin_amdgcn_s_sleep(1);
    if ((++sp & 255u) == 0u) { if (xb_ld(&bar[XB_TMO])) break; if (sp > XB_SPIN_CAP) { atomicAdd(&bar[XB_TMO], 1u); break; } }
  }
  nloc = mine > 0u ? mine : 1u; nx = cnt > 0u ? cnt : 1u;
}
__device__ __forceinline__ void xcd_barrier(const XcdBarrier& b) {
  asm volatile("s_waitcnt vmcnt(0)" ::: "memory");
  __syncthreads();
  if (threadIdx.x == 0) {
    unsigned* bar = b.bar;
    __builtin_amdgcn_s_waitcnt(0);
    unsigned nloc = b.st[0], nx = b.st[1];
    if (nloc == 0u) { xcd_barrier_complete(bar, b.x, nloc, nx); b.st[0] = nloc; b.st[1] = nx; }
    const unsigned old = xb_add(&bar[XB_XSUB(b.x)], 1u);
    const unsigned gen = old / nloc;
    if (old + 1u == (gen + 1u) * nloc) {
      __builtin_amdgcn_fence(__ATOMIC_RELEASE, "agent");
      asm volatile("s_waitcnt vmcnt(0)" ::: "memory");
      const unsigned og = xb_add(&bar[XB_TOP], 1u);
      const unsigned tg = og / nx;
      if (og + 1u == (tg + 1u) * nx) xb_add(&bar[XB_TOPGEN], 1u);
      else XB_SPIN(xb_ld(&bar[XB_TOPGEN]) == tg, bar);
      __builtin_amdgcn_fence(__ATOMIC_ACQUIRE, "agent");
      xb_add(&bar[XB_XGEN(b.x)], 1u);
      asm volatile("s_waitcnt vmcnt(0)" ::: "memory");
    } else {
      XB_SPIN(xb_ld(&bar[XB_XGEN(b.x)]) == gen, bar);
      __builtin_amdgcn_fence(__ATOMIC_ACQUIRE, "agent");
      asm volatile("s_waitcnt vmcnt(0)" ::: "memory");
    }
  }
  __syncthreads();
}
#endif
#ifndef CPU_EMU
#define RUN_PH(n) run_phase<n>(P, smem_raw); if (n != PH_LAST) xcd_barrier(xb);
__global__ void __launch_bounds__(256, 2) mega_kernel(Params P) {
  SMEM_DECL;
  unsigned* bar = (unsigned*)(P.ws + OFF_BAR);
  volatile LAS unsigned* st = (volatile LAS unsigned*)(smem_raw + SMEM_BYTES - 16);
  if (threadIdx.x == 0) { st[0] = 0u; st[1] = 0u; }
  if (P.ws == nullptr) cg::this_grid().sync();
  __syncthreads();
  XcdBarrier xb = xcd_barrier_post(bar, st);
  PHASE_LIST(RUN_PH)
}

extern "C" void kernel_launch(void* const* d_in, const int* in_sizes, int n_in, void* d_out, int out_size, void* d_ws,
                              size_t ws_size, hipStream_t stream) {
  Params P{};
  for (int i = 0; i < N_IN; ++i) P.in[i] = (const float*)d_in[i];
  P.out = (float*)d_out;
  P.ws = (unsigned char*)d_ws;
  if (ws_size < WS_NEEDED) { fprintf(stderr, "workspace too small: %zu < %zu\n", ws_size, (size_t)WS_NEEDED); return; }
  static int grid_blocks = 0;
  if (!grid_blocks) {
    int dev = 0, cus = 0, per_cu = 0;
    hipGetDevice(&dev);
    hipDeviceGetAttribute(&cus, hipDeviceAttributeMultiprocessorCount, dev);
    hipOccupancyMaxActiveBlocksPerMultiprocessor(&per_cu, mega_kernel, 256, 0);
    if (per_cu > 2) per_cu = 2;
    grid_blocks = cus * per_cu;
  }
  (void)hipMemsetAsync((unsigned char*)d_ws + OFF_BAR, 0, 16384, stream);
  void* args[] = {&P};
  hipError_t e = hipLaunchCooperativeKernel((void*)mega_kernel, dim3(grid_blocks), dim3(256), args, 0, stream);
  if (e != hipSuccess) fprintf(stderr, "cooperative launch failed: %s (grid %d)\n", hipGetErrorString(e), grid_blocks);
}
#endif
```

```cpp
#ifdef CPU_EMU
#include "emu.h"
#else
#include <hip/hip_runtime.h>
#include <hip/hip_cooperative_groups.h>
#include <cstdio>
namespace cg = cooperative_groups;
#define DEV __device__ __forceinline__
#define DEVM __device__ __forceinline__
#define OPAQUE(x) asm volatile("" : "+v"(x))
#define OPAQUE_S(x) asm volatile("" : "+s"(x))
#endif

#ifndef SEQ_LEN
#define SEQ_LEN 16384
#endif
#ifndef CTX_LEN
#define CTX_LEN 256
#endif
#ifndef GRID_W_
#define GRID_W_ 64
#endif
#ifndef MULTI_LAUNCH
#define MULTI_LAUNCH 0
#endif

typedef unsigned short bf16_t;
typedef __attribute__((ext_vector_type(8))) short bf16x8;
typedef __attribute__((ext_vector_type(16))) float f32x16;
typedef __attribute__((ext_vector_type(4))) unsigned u32x4;
typedef __attribute__((ext_vector_type(2))) unsigned u32x2;
typedef __attribute__((ext_vector_type(4))) float f32x4;

constexpr int D = 1024, NB = 2, SEQ = SEQ_LEN, CTXL = CTX_LEN, GW = GRID_W_;
constexpr int NCTX = NB * CTXL, NLAT = NB * SEQ, NTOK = NCTX + NLAT;
constexpr int EVC = 3104, ODC = 2816;
constexpr int NEXP = 16384;
constexpr int NTILE = NTOK / 128, CTILE = NCTX / 128;
static_assert(NTOK % 256 == 0 && NCTX % 256 == 0, "tiles");
static_assert(CTXL % 64 == 0 && SEQ % 64 == 0 && SEQ % GW == 0, "chunks");

constexpr size_t al256(size_t x) { return (x + 255) & ~(size_t)255; }
constexpr size_t OFF_MODV = 0;
constexpr size_t OFF_CTXRES = OFF_MODV + al256(2 * 3 * 6144 * 4);
constexpr size_t OFF_GATES = OFF_CTXRES + al256((size_t)NCTX * 1024 * 4);
constexpr size_t OFF_WEVIN = OFF_GATES + al256((size_t)NTOK * 32 * 4);
constexpr size_t OFF_WEVOUT = OFF_WEVIN + al256((size_t)EVC * 1024 * 2);
constexpr size_t OFF_WODIN = OFF_WEVOUT + al256((size_t)1024 * 1024 * 2);
constexpr size_t OFF_WODOUT = OFF_WODIN + al256((size_t)ODC * 1024 * 2);
constexpr size_t OFF_WQ = OFF_WODOUT + al256((size_t)1024 * 1024 * 2);
constexpr size_t OFF_KEYS = OFF_WQ + al256((size_t)2 * 2048 * 1024 * 2);
constexpr size_t OFF_WUP = OFF_KEYS + al256((size_t)2 * 8 * 2 * 128 * 128 * 2);
constexpr size_t OFF_AUP = OFF_WUP + al256((size_t)2 * 512 * 64 * 2);
constexpr size_t OFF_GUP = OFF_AUP + al256((size_t)2 * 512 * 64 * 2);
constexpr size_t OFF_LRUT = OFF_GUP + al256((size_t)512 * 128 * 2);
constexpr size_t OFF_PU = OFF_LRUT + al256((size_t)2 * 8 * 128 * 64 * 2);
constexpr size_t OFF_PV = OFF_PU + al256((size_t)NEXP * 1024);
constexpr size_t OFF_HBUF = OFF_PV + al256((size_t)NEXP * 1024);
constexpr size_t OFF_PR = OFF_HBUF + al256((size_t)NTOK * 1024 * 2);
constexpr size_t PR_BYTES = (size_t)NTOK * 5376 * 2;
constexpr size_t OFF_BAR = OFF_PR + PR_BYTES;
constexpr size_t OFF_ACUM1 = OFF_BAR + 16384;
constexpr size_t OFF_LRUCS = OFF_ACUM1 + (size_t)NLAT * 512 * 2;
constexpr size_t OFF_LRUHS = OFF_LRUCS + (size_t)32 * ((CTXL + SEQ) / 64) * 128 * 4;
constexpr size_t WS_NEEDED = OFF_LRUHS + (size_t)32 * ((CTXL + SEQ) / 64) * 64 * 4;
#ifndef CPU_EMU
static_assert(WS_NEEDED <= (size_t)512 * 1024 * 1024, "workspace too large");
#endif
constexpr size_t OFF_PROJ = OFF_PR;
constexpr size_t OFF_R2L0 = OFF_PR + (size_t)NTOK * EVC * 2;
constexpr size_t OFF_LORA = OFF_PR + (size_t)NTOK * ODC * 2;
constexpr size_t OFF_Q = OFF_PR;
constexpr size_t OFF_PIDX = OFF_PR + (size_t)NTOK * 2048 * 2;
constexpr size_t OFF_PGATE = OFF_PIDX + (size_t)NTOK * 128 * 4;
static_assert(OFF_PGATE + (size_t)NTOK * 128 * 4 <= OFF_PR + PR_BYTES, "picks");

enum {
  I_X = 0, I_C, I_CTX, I_CCTX, I_MODW, I_MODB, I_NORM1, I_NORM2, I_WQ, I_KEYS, I_PU, I_PV,
  I_EVWIN, I_EVWOUT, I_IBIAS, I_FBIAS, I_MNORM, I_SCONVW, I_SCONVB, I_DTBIAS, I_ALOG, I_DSKIP, I_SNORM,
  I_ODWIN, I_ODWOUT, I_MU, I_W0, I_WUP, I_A0, I_AUP, I_GUP, I_KK, I_KA, I_RK, I_LNW, I_LNB,
  I_LCONVW, I_LCONVB, I_LAM, I_WA, I_BA, I_WI, I_BI, I_FNORM, N_IN
};

struct Params {
  const float* in[N_IN];
  float* out;
  unsigned char* ws;
};

constexpr int SMEM_BYTES = 80 * 1024;
#ifdef CPU_EMU
#define SMEM_DECL static thread_local __attribute__((aligned(16))) unsigned char smem_raw[SMEM_BYTES]
#else
#define SMEM_DECL __shared__ __attribute__((aligned(16))) unsigned char smem_raw[SMEM_BYTES]
#endif

DEV float bf2f(bf16_t v) { unsigned u = ((unsigned)v) << 16; float f; __builtin_memcpy(&f, &u, 4); return f; }
#ifdef CPU_EMU
DEV bf16_t f2bf(float f) { unsigned u; __builtin_memcpy(&u, &f, 4); u += 0x7fffu + ((u >> 16) & 1u); return (bf16_t)(u >> 16); }
DEV unsigned pack2(float a, float b) { return (unsigned)f2bf(a) | ((unsigned)f2bf(b) << 16); }
#else
typedef __attribute__((ext_vector_type(2))) float f32x2_t;
typedef __attribute__((ext_vector_type(2))) __bf16 bf16x2_t;
DEV unsigned pack2(float a, float b) { f32x2_t f = {a, b}; return __builtin_bit_cast(unsigned, __builtin_convertvector(f, bf16x2_t)); }
DEV bf16_t f2bf(float f) { return __builtin_bit_cast(unsigned short, (__bf16)f); }
#endif
DEV void unpack8(const u32x4& r, float* o) {
  unsigned w[4] = {r.x, r.y, r.z, r.w};
#pragma unroll
  for (int i = 0; i < 4; ++i) { unsigned lo = w[i] << 16, hi = w[i] & 0xffff0000u; __builtin_memcpy(&o[2 * i], &lo, 4); __builtin_memcpy(&o[2 * i + 1], &hi, 4); }
}
DEV u32x4 pack8(const float* o) { u32x4 r; r.x = pack2(o[0], o[1]); r.y = pack2(o[2], o[3]); r.z = pack2(o[4], o[5]); r.w = pack2(o[6], o[7]); return r; }
#ifdef CPU_EMU
DEV float fexp(float x) { return expf(x); }
DEV float frcp(float x) { return 1.f / x; }
DEV float flog(float x) { return logf(x); }
DEV float frsq(float x) { return 1.f / sqrtf(x); }
DEV float fsqrt(float x) { return sqrtf(x); }
#else
DEV float fexp(float x) { return __expf(x); }
DEV float frcp(float x) { return __builtin_amdgcn_rcpf(x); }
DEV float flog(float x) { return __logf(x); }
DEV float frsq(float x) { return __builtin_amdgcn_rsqf(x); }
DEV float fsqrt(float x) { return __builtin_amdgcn_sqrtf(x); }
#endif
DEV void ld8(const float* __restrict__ p, float* o) { const f32x4 a = *(const f32x4*)p, b = *(const f32x4*)(p + 4); o[0] = a.x; o[1] = a.y; o[2] = a.z; o[3] = a.w; o[4] = b.x; o[5] = b.y; o[6] = b.z; o[7] = b.w; }
DEV float sigmoidf_(float x) { return frcp(1.f + fexp(-x)); }
DEV float siluf_(float x) { return x * frcp(1.f + fexp(-x)); }
DEV float softplusf_(float x) { return fmaxf(x, 0.f) + flog(1.f + fexp(-fabsf(x))); }
DEV float tanhf_(float x) { return 1.f - 2.f * frcp(1.f + fexp(2.f * x)); }
DEV float geluf_(float x) { return 0.5f * x * (1.f + erff(x * 0.70710678118654752f)); }

DEV f32x16 mfma32(bf16x8 a, bf16x8 b, f32x16 c) {
#ifdef CPU_EMU
  return emu_mfma32(a, b, c);
#else
  return __builtin_amdgcn_mfma_f32_32x32x16_bf16(a, b, c, 0, 0, 0);
#endif
}
DEV float wshfl_xor(float v, int m) {
#ifdef CPU_EMU
  return emu_shfl_xor(v, m);
#else
  return __shfl_xor(v, m, 64);
#endif
}
template <int M> DEV float dpp_xor(float v) {
  static_assert(M == 1 || M == 2 || M == 7 || M == 8, "dpp pattern");
#ifdef CPU_EMU
  return emu_shfl_xor(v, M);
#else
  constexpr int ctrl = M == 1 ? 0xB1 : (M == 2 ? 0x4E : (M == 7 ? 0x141 : 0x128));
  return __int_as_float(__builtin_amdgcn_update_dpp(0, __float_as_int(v), ctrl, 0xf, 0xf, false));
#endif
}
DEV float sum8(float v) { v += dpp_xor<1>(v); v += dpp_xor<2>(v); v += dpp_xor<7>(v); return v; }
DEV float sum4(float v) { v += dpp_xor<1>(v); v += dpp_xor<2>(v); return v; }
DEV float sum16(float v) { v = sum8(v); v += dpp_xor<8>(v); return v; }
DEV float swap32_sum(float a, float b) {
#ifdef CPU_EMU
  float ra = emu_shfl_xor(a, 32), rb = emu_shfl_xor(b, 32);
  return ((threadIdx.x >> 5) & 1) ? b + rb : a + ra;
#else
  auto r = __builtin_amdgcn_permlane32_swap(__float_as_uint(a), __float_as_uint(b), false, false);
  return __uint_as_float(r[0]) + __uint_as_float(r[1]);
#endif
}
DEV float swap16_sum(float a, float b) {
#ifdef CPU_EMU
  float ra = emu_shfl_xor(a, 16), rb = emu_shfl_xor(b, 16);
  return ((threadIdx.x >> 4) & 1) ? b + rb : a + ra;
#else
  auto r = __builtin_amdgcn_permlane16_swap(__float_as_uint(a), __float_as_uint(b), false, false);
  return __uint_as_float(r[0]) + __uint_as_float(r[1]);
#endif
}
DEV float wave_sum(float v) {
  v = sum16(v);
  v = swap16_sum(v, v);
  return swap32_sum(v, v);
}

#ifdef CPU_EMU
static inline unsigned emu_f2fp8(float f) {
  unsigned sgn = f < 0.f ? 0x80u : 0u; float a = fabsf(f);
  if (!(a == a)) return 0x7f;
  if (a >= 448.f) return sgn | 0x7e;
  if (a < 0.0009765625f) return sgn;
  int e; frexpf(a, &e); e -= 1;
  if (e < -6) { int q = (int)nearbyintf(a * 512.f); return sgn | (unsigned)q; }
  float m = a / ldexpf(1.f, e);
  int q = (int)nearbyintf((m - 1.f) * 8.f);
  if (q == 8) { q = 0; e += 1; }
  if (e > 8) return sgn | 0x7e;
  return sgn | (unsigned)((e + 7) << 3) | (unsigned)q;
}
static inline float emu_fp82f(unsigned c) {
  unsigned sgn = c & 0x80, e = (c >> 3) & 15, m = c & 7;
  float v = e == 0 ? ldexpf((float)m, -9) : ldexpf(1.f + m / 8.f, (int)e - 7);
  return sgn ? -v : v;
}
#endif
DEV unsigned pack4_fp8(float a, float b, float c, float d) {
#ifdef CPU_EMU
  return emu_f2fp8(a) | (emu_f2fp8(b) << 8) | (emu_f2fp8(c) << 16) | (emu_f2fp8(d) << 24);
#else
  int w = 0;
  w = __builtin_amdgcn_cvt_pk_fp8_f32(a, b, w, false);
  w = __builtin_amdgcn_cvt_pk_fp8_f32(c, d, w, true);
  return (unsigned)w;
#endif
}
DEV void unpack4_fp8(unsigned w, float* o) {
#ifdef CPU_EMU
  o[0] = emu_fp82f(w & 255); o[1] = emu_fp82f((w >> 8) & 255); o[2] = emu_fp82f((w >> 16) & 255); o[3] = emu_fp82f(w >> 24);
#else
  typedef __attribute__((ext_vector_type(2))) float f32x2_;
  f32x2_ lo = __builtin_amdgcn_cvt_pk_f32_fp8((int)w, false);
  f32x2_ hi = __builtin_amdgcn_cvt_pk_f32_fp8((int)w, true);
  o[0] = lo.x; o[1] = lo.y; o[2] = hi.x; o[3] = hi.y;
#endif
}
DEV void unpack16_fp8(const u32x4& r, float* o) { unpack4_fp8(r.x, o); unpack4_fp8(r.y, o + 4); unpack4_fp8(r.z, o + 8); unpack4_fp8(r.w, o + 12); }
DEV float wreadlane(float v, int srclane) {
#ifdef CPU_EMU
  return emu_readlane(v, srclane);
#else
  int iv; __builtin_memcpy(&iv, &v, 4);
  int r = __builtin_amdgcn_readlane(iv, srclane);
  float f; __builtin_memcpy(&f, &r, 4); return f;
#endif
}
constexpr float PEER_USCALE = 64.f, PEER_VSCALE = 4.f;
#ifdef CPU_EMU
static inline unsigned emu_f2fp4(float f) {
  static const float lv[8] = {0.f, 0.5f, 1.f, 1.5f, 2.f, 3.f, 4.f, 6.f};
  unsigned sgn = f < 0.f ? 8u : 0u; float a = fabsf(f);
  int best = 0; float bd = 1e30f;
  for (int i = 0; i < 8; ++i) { float dd = fabsf(a - lv[i]); if (dd < bd || (dd == bd && (i & 1) == 0)) { bd = dd; best = i; } }
  return sgn | (unsigned)best;
}
static inline float emu_fp42f(unsigned c) {
  static const float lv[8] = {0.f, 0.5f, 1.f, 1.5f, 2.f, 3.f, 4.f, 6.f};
  float v = lv[c & 7]; return (c & 8) ? -v : v;
}
#endif
DEV unsigned pack8_fp4(const float* v) {
#ifdef CPU_EMU
  unsigned w = 0;
  for (int i = 0; i < 8; ++i) w |= emu_f2fp4(v[i]) << (4 * i);
  return w;
#else
  unsigned w = 0;
  w = __builtin_amdgcn_cvt_scalef32_pk_fp4_f32(w, v[0], v[1], 1.0f, 0);
  w = __builtin_amdgcn_cvt_scalef32_pk_fp4_f32(w, v[2], v[3], 1.0f, 1);
  w = __builtin_amdgcn_cvt_scalef32_pk_fp4_f32(w, v[4], v[5], 1.0f, 2);
  w = __builtin_amdgcn_cvt_scalef32_pk_fp4_f32(w, v[6], v[7], 1.0f, 3);
  return w;
#endif
}
DEV void unpack8_fp4(unsigned w, float* o) {
#ifdef CPU_EMU
  for (int i = 0; i < 8; ++i) o[i] = emu_fp42f((w >> (4 * i)) & 15u);
#else
  typedef __attribute__((ext_vector_type(2))) float f32x2_;
  f32x2_ a = __builtin_amdgcn_cvt_scalef32_pk_f32_fp4(w, 1.0f, 0);
  f32x2_ b = __builtin_amdgcn_cvt_scalef32_pk_f32_fp4(w, 1.0f, 1);
  f32x2_ c = __builtin_amdgcn_cvt_scalef32_pk_f32_fp4(w, 1.0f, 2);
  f32x2_ d = __builtin_amdgcn_cvt_scalef32_pk_f32_fp4(w, 1.0f, 3);
  o[0] = a.x; o[1] = a.y; o[2] = b.x; o[3] = b.y; o[4] = c.x; o[5] = c.y; o[6] = d.x; o[7] = d.y;
#endif
}
typedef __attribute__((ext_vector_type(3))) unsigned u32x3;
#ifndef FP6_INTERLEAVED
#define FP6_INTERLEAVED 1
#endif
#ifdef CPU_EMU
static inline unsigned emu_f2fp6(float f) {
  unsigned sgn = f < 0.f ? 32u : 0u; float a = fabsf(f);
  if (a >= 7.5f) return sgn | 31u;
  int e; unsigned code;
  if (a < 1.f) { int q = (int)nearbyintf(a * 8.f); code = (unsigned)q; }
  else { frexpf(a, &e); e -= 1; float m = a / ldexpf(1.f, e); int q = (int)nearbyintf((m - 1.f) * 8.f); if (q == 8) { q = 0; e += 1; } code = (unsigned)(((e + 1) << 3) | q); if (e > 2) code = 31u; }
  return sgn | code;
}
static inline float emu_fp62f(unsigned c) {
  unsigned e = (c >> 3) & 3, m = c & 7;
  float v = e == 0 ? m * 0.125f : ldexpf(1.f + m / 8.f, (int)e - 1);
  return (c & 32) ? -v : v;
}
#endif
DEV u32x3 pack16_fp6(const float* v) {
#ifdef CPU_EMU
  unsigned long long lo = 0; unsigned hi = 0;
  for (int i = 0; i < 16; ++i) {
    unsigned long long c = emu_f2fp6(v[i]); int bit = 6 * i;
    if (bit < 64) { lo |= c << bit; if (bit > 58) hi |= (unsigned)(c >> (64 - bit)); } else hi |= (unsigned)(c << (bit - 64));
  }
  u32x3 r; r.x = (unsigned)lo; r.y = (unsigned)(lo >> 32); r.z = hi; return r;
#else
  typedef __attribute__((ext_vector_type(6))) unsigned u32x6_;
  f32x16 a, b;
#if FP6_INTERLEAVED
#pragma unroll
  for (int i = 0; i < 8; ++i) { a[i] = v[2 * i]; b[i] = v[2 * i + 1]; a[8 + i] = 0.f; b[8 + i] = 0.f; }
#else
#pragma unroll
  for (int i = 0; i < 16; ++i) { a[i] = v[i]; b[i] = 0.f; }
#endif
  u32x6_ w = __builtin_amdgcn_cvt_scalef32_2xpk16_fp6_f32(a, b, 1.0f);
  u32x3 r; r.x = w[0]; r.y = w[1]; r.z = w[2]; return r;
#endif
}
DEV void unpack16_fp6(const u32x3& r, float* o) {
#ifdef CPU_EMU
  unsigned long long lo = (unsigned long long)r.x | ((unsigned long long)r.y << 32); unsigned hi = r.z;
  for (int i = 0; i < 16; ++i) {
    int bit = 6 * i; unsigned c;
    if (bit + 6 <= 64) c = (unsigned)(lo >> bit) & 63u;
    else if (bit >= 64) c = (hi >> (bit - 64)) & 63u;
    else c = ((unsigned)(lo >> bit) | (hi << (64 - bit))) & 63u;
    o[i] = emu_fp62f(c);
  }
#else
  typedef __attribute__((ext_vector_type(6))) unsigned u32x6_;
  typedef __attribute__((ext_vector_type(32))) float f32x32_;
  u32x6_ w; w[0] = r.x; w[1] = r.y; w[2] = r.z; w[3] = 0u; w[4] = 0u; w[5] = 0u;
  f32x32_ f = __builtin_amdgcn_cvt_scalef32_pk32_f32_fp6(w, 1.0f);
#pragma unroll
  for (int i = 0; i < 16; ++i) o[i] = f[i];
#endif
}
DEV void unpack2x16_fp6(const u32x3& ra, const u32x3& rb, float* oa, float* ob) {
#ifdef CPU_EMU
  unpack16_fp6(ra, oa); unpack16_fp6(rb, ob);
#else
  typedef __attribute__((ext_vector_type(6))) unsigned u32x6_;
  typedef __attribute__((ext_vector_type(32))) float f32x32_;
  u32x6_ w; w[0] = ra.x; w[1] = ra.y; w[2] = ra.z; w[3] = rb.x; w[4] = rb.y; w[5] = rb.z;
  f32x32_ f = __builtin_amdgcn_cvt_scalef32_pk32_f32_fp6(w, 1.0f);
#pragma unroll
  for (int i = 0; i < 16; ++i) { oa[i] = f[i]; ob[i] = f[16 + i]; }
#endif
}
constexpr int PEER_ROWB = 1280;
constexpr int PEER_VOFF = 768;


DEV int acc_row(int reg, int lane) { return (reg & 3) + 8 * (reg >> 2) + 4 * (lane >> 5); }

DEV int mod_row(int row) { return row < NCTX ? 2 : (row - NCTX) / SEQ; }

template <bool SYNC_EPI, class Epi, bool VEC4 = false>
DEV void gemm_tile_128(const bf16_t* __restrict__ A, int lda, int M, const bf16_t* __restrict__ Bt, int ldb, int N,
                       int K, int m0, int n0, const Epi& epi, unsigned char* smem) {
  constexpr int LS = 72;
  constexpr int STAGE = 2 * 128 * LS;
  bf16_t* sbase = (bf16_t*)smem;
  const int wave = threadIdx.x >> 6;
  const int wm = (wave >> 1) * 64, wn = (wave & 1) * 64;
  f32x16 acc[2][2];
#pragma unroll
  for (int i = 0; i < 2; ++i)
#pragma unroll
    for (int j = 0; j < 2; ++j)
#pragma unroll
      for (int r = 0; r < 16; ++r) acc[i][j][r] = 0.f;
  u32x4 ra[4], rb[4];
  auto gload = [&](int k0) {
    int tl_ = threadIdx.x; OPAQUE(tl_);
#pragma unroll
    for (int i = 0; i < 4; ++i) {
      int c = tl_ + i * 256, r = c >> 3, cc = (c & 7) * 8;
      int gr = m0 + r, gn = n0 + r;
      gr = gr < M ? gr : M - 1; gn = gn < N ? gn : N - 1;
      ra[i] = *(const u32x4*)(A + (size_t)gr * lda + k0 + cc);
      rb[i] = *(const u32x4*)(Bt + (size_t)gn * ldb + k0 + cc);
    }
  };
  auto lwrite = [&](int buf) {
    int tl_ = threadIdx.x; OPAQUE(tl_);
    bf16_t* sA = sbase + buf * STAGE;
    bf16_t* sB = sA + 128 * LS;
#pragma unroll
    for (int i = 0; i < 4; ++i) {
      int c = tl_ + i * 256, r = c >> 3, cc = (c & 7) * 8;
      *(u32x4*)(sA + r * LS + cc) = ra[i];
      *(u32x4*)(sB + r * LS + cc) = rb[i];
    }
  };
  const int nk = K >> 6;
  gload(0);
  __syncthreads();
  lwrite(0);
  if (nk > 1) gload(64);
  __syncthreads();
  for (int it = 0; it < nk; ++it) {
    int tl_ = threadIdx.x; OPAQUE(tl_);
    const int lane = tl_ & 63;
    const bf16_t* sA = sbase + (it & 1) * STAGE;
    const bf16_t* sB = sA + 128 * LS;
#pragma unroll
    for (int kk = 0; kk < 4; ++kk) {
      bf16x8 a[2], b[2];
      const int ko = kk * 16 + 8 * (lane >> 5);
#pragma unroll
      for (int i = 0; i < 2; ++i) a[i] = *(const bf16x8*)(sA + (wm + i * 32 + (lane & 31)) * LS + ko);
#pragma unroll
      for (int j = 0; j < 2; ++j) b[j] = *(const bf16x8*)(sB + (wn + j * 32 + (lane & 31)) * LS + ko);
#pragma unroll
      for (int i = 0; i < 2; ++i)
#pragma unroll
        for (int j = 0; j < 2; ++j) acc[i][j] = mfma32(a[i], b[j], acc[i][j]);
      if (kk == 1) {
        if (it + 1 < nk) lwrite((it + 1) & 1);
        if (it + 2 < nk) gload((it + 2) * 64);
      }
    }
    __syncthreads();
  }
  {
    int tl_ = threadIdx.x; OPAQUE(tl_);
    const int lane = tl_ & 63;
    if constexpr (VEC4) {
#pragma unroll
      for (int i = 0; i < 2; ++i)
#pragma unroll
        for (int j = 0; j < 2; ++j)
#pragma unroll
          for (int gq = 0; gq < 4; ++gq) {
            int row = m0 + wm + i * 32 + 8 * gq + 4 * (lane >> 5);
            int col = n0 + wn + j * 32 + (lane & 31);
            if (row < M && col < N) epi.store4(row, col, acc[i][j][4 * gq], acc[i][j][4 * gq + 1], acc[i][j][4 * gq + 2], acc[i][j][4 * gq + 3]);
          }
    } else {
#pragma unroll
      for (int i = 0; i < 2; ++i)
#pragma unroll
        for (int j = 0; j < 2; ++j)
#pragma unroll
          for (int r = 0; r < 16; ++r) {
            int row = m0 + wm + i * 32 + acc_row(r, lane);
            int col = n0 + wn + j * 32 + (lane & 31);
            if (row < M && col < N) epi(row, col, acc[i][j][r]);
          }
    }
  }
}

template <class Epi, bool VEC4 = false>
DEV void gemm_tile_128x256(const bf16_t* __restrict__ A, int lda, int M, const bf16_t* __restrict__ Bt, int ldb, int N,
                           int K, int m0, int n0, const Epi& epi, unsigned char* smem) {
  constexpr int LS = 72;
  bf16_t* sA = (bf16_t*)smem;
  bf16_t* sB = sA + 128 * LS;
  const int wave = threadIdx.x >> 6;
  const int wm = (wave >> 1) * 64, wn = (wave & 1) * 128;
  f32x16 acc[2][4];
#pragma unroll
  for (int i = 0; i < 2; ++i)
#pragma unroll
    for (int j = 0; j < 4; ++j)
#pragma unroll
      for (int r = 0; r < 16; ++r) acc[i][j][r] = 0.f;
  u32x4 ra[4], rb[8];
  {
    const int tid = threadIdx.x;
#pragma unroll
    for (int i = 0; i < 4; ++i) {
      int c = tid + i * 256, r = c >> 3, cc = (c & 7) * 8;
      { int gr = m0 + r; gr = gr < M ? gr : M - 1; ra[i] = *(const u32x4*)(A + (size_t)gr * lda + cc); }
    }
#pragma unroll
    for (int i = 0; i < 8; ++i) {
      int c = tid + i * 256, r = c >> 3, cc = (c & 7) * 8;
      { int gn = n0 + r; gn = gn < N ? gn : N - 1; rb[i] = *(const u32x4*)(Bt + (size_t)gn * ldb + cc); }
    }
  }
  for (int k0 = 0; k0 < K; k0 += 64) {
    int tl_ = threadIdx.x; OPAQUE(tl_);
    const int tid = tl_, lane = tl_ & 63;
    __syncthreads();
#pragma unroll
    for (int i = 0; i < 4; ++i) { int c = tid + i * 256, r = c >> 3, cc = (c & 7) * 8; *(u32x4*)(sA + r * LS + cc) = ra[i]; }
#pragma unroll
    for (int i = 0; i < 8; ++i) { int c = tid + i * 256, r = c >> 3, cc = (c & 7) * 8; *(u32x4*)(sB + r * LS + cc) = rb[i]; }
    __syncthreads();
    if (k0 + 64 < K) {
#pragma unroll
      for (int i = 0; i < 4; ++i) {
        int c = tid + i * 256, r = c >> 3, cc = (c & 7) * 8;
        { int gr = m0 + r; gr = gr < M ? gr : M - 1; ra[i] = *(const u32x4*)(A + (size_t)gr * lda + k0 + 64 + cc); }
      }
#pragma unroll
      for (int i = 0; i < 8; ++i) {
        int c = tid + i * 256, r = c >> 3, cc = (c & 7) * 8;
        { int gn = n0 + r; gn = gn < N ? gn : N - 1; rb[i] = *(const u32x4*)(Bt + (size_t)gn * ldb + k0 + 64 + cc); }
      }
    }
#pragma unroll 2
    for (int kk = 0; kk < 4; ++kk) {
      bf16x8 a[2], b[4];
      const int ko = kk * 16 + 8 * (lane >> 5);
#pragma unroll
      for (int i = 0; i < 2; ++i) a[i] = *(const bf16x8*)(sA + (wm + i * 32 + (lane & 31)) * LS + ko);
#pragma unroll
      for (int j = 0; j < 4; ++j) b[j] = *(const bf16x8*)(sB + (wn + j * 32 + (lane & 31)) * LS + ko);
#pragma unroll
      for (int i = 0; i < 2; ++i)
#pragma unroll
        for (int j = 0; j < 4; ++j) acc[i][j] = mfma32(a[i], b[j], acc[i][j]);
    }
  }
  {
    int tl_ = threadIdx.x; OPAQUE(tl_);
    const int lane = tl_ & 63;
    if constexpr (VEC4) {
#pragma unroll
      for (int i = 0; i < 2; ++i)
#pragma unroll
        for (int j = 0; j < 4; ++j)
#pragma unroll
          for (int gq = 0; gq < 4; ++gq) {
            int row = m0 + wm + i * 32 + 8 * gq + 4 * (lane >> 5);
            int col = n0 + wn + j * 32 + (lane & 31);
            if (row < M && col < N) epi.store4(row, col, acc[i][j][4 * gq], acc[i][j][4 * gq + 1], acc[i][j][4 * gq + 2], acc[i][j][4 * gq + 3]);
          }
    } else {
#pragma unroll
      for (int i = 0; i < 2; ++i)
#pragma unroll
        for (int j = 0; j < 4; ++j)
#pragma unroll
          for (int r = 0; r < 16; ++r) {
            int row = m0 + wm + i * 32 + acc_row(r, lane);
            int col = n0 + wn + j * 32 + (lane & 31);
            if (row < M && col < N) epi(row, col, acc[i][j][r]);
          }
    }
  }
}

DEV void transpose_tile(const float* __restrict__ src, int ld_src, bf16_t* __restrict__ dst, int ld_dst, int K, int N,
                        int tk, int tn, unsigned char* smem) {
  float* sT = (float*)smem;
  const int tid = threadIdx.x;
  __syncthreads();
  {
    const int tx = tid & 15, ty = tid >> 4;
#pragma unroll
    for (int p = 0; p < 4; ++p) {
      int k = tk * 64 + ty + p * 16, n = tn * 64 + tx * 4;
      f32x4 v4 = {0.f, 0.f, 0.f, 0.f};
      if (k < K && n < N) v4 = *(const f32x4*)(src + (size_t)k * ld_src + n);
      float* d = sT + (ty + p * 16) * 65 + tx * 4;
      d[0] = v4.x; d[1] = v4.y; d[2] = v4.z; d[3] = v4.w;
    }
  }
  __syncthreads();
  {
    const int n = tid >> 2, kseg = (tid & 3) * 16;
    int gn = tn * 64 + n;
    if (gn < N) {
      float v[16];
#pragma unroll
      for (int j = 0; j < 16; ++j) v[j] = sT[(kseg + j) * 65 + n];
      bf16_t* d = dst + (size_t)gn * ld_dst + tk * 64 + kseg;
      *(u32x4*)d = pack8(v);
      *(u32x4*)(d + 8) = pack8(v + 8);
    }
  }
}

constexpr int TJ0 = 16 * 49, TJ1 = 16 * 16, TJ2 = 16 * 44, TJ3 = 16 * 16, TJ4 = 2 * 16 * 32, TJ5 = 2 * 8, TJ6 = 2 * 8,
              TJ7 = 2 * 8, TJ8 = 32;
constexpr int NTRANS = TJ0 + TJ1 + TJ2 + TJ3 + TJ4 + TJ5 + TJ6 + TJ7 + TJ8;
constexpr int NKEYCV = (2 * 8 * 2 * 128 * 128) / (256 * 8);
constexpr int NMODV = 2 * 96;
constexpr int NPREP = NTRANS + NKEYCV + NMODV;

DEV void st_prep(const Params& P, int item, unsigned char* smem) {
  unsigned char* ws = P.ws;
  if (item < NTRANS) {
    int t = item;
    if (t < TJ0) { transpose_tile(P.in[I_EVWIN], EVC, (bf16_t*)(ws + OFF_WEVIN), 1024, 1024, EVC, t / 49, t % 49, smem); return; }
    t -= TJ0;
    if (t < TJ1) { transpose_tile(P.in[I_EVWOUT], 1024, (bf16_t*)(ws + OFF_WEVOUT), 1024, 1024, 1024, t / 16, t % 16, smem); return; }
    t -= TJ1;
    if (t < TJ2) { transpose_tile(P.in[I_ODWIN], ODC, (bf16_t*)(ws + OFF_WODIN), 1024, 1024, ODC, t / 44, t % 44, smem); return; }
    t -= TJ2;
    if (t < TJ3) { transpose_tile(P.in[I_ODWOUT], 1024, (bf16_t*)(ws + OFF_WODOUT), 1024, 1024, 1024, t / 16, t % 16, smem); return; }
    t -= TJ3;
    if (t < TJ4) {
      int l = t / 512, tt = t % 512;
      transpose_tile(P.in[I_WQ] + (size_t)l * 1024 * 2048, 2048, (bf16_t*)(ws + OFF_WQ) + (size_t)l * 2048 * 1024, 1024, 1024, 2048, tt / 32, tt % 32, smem);
      return;
    }
    t -= TJ4;
    if (t < TJ5) { int d = t / 8; transpose_tile(P.in[I_WUP] + d * 64 * 512, 512, (bf16_t*)(ws + OFF_WUP) + d * 512 * 64, 64, 64, 512, 0, t % 8, smem); return; }
    t -= TJ5;
    if (t < TJ6) { int d = t / 8; transpose_tile(P.in[I_AUP] + d * 64 * 512, 512, (bf16_t*)(ws + OFF_AUP) + d * 512 * 64, 64, 64, 512, 0, t % 8, smem); return; }
    t -= TJ6;
    if (t < TJ7) { transpose_tile(P.in[I_GUP], 512, (bf16_t*)(ws + OFF_GUP), 128, 128, 512, t / 8, t % 8, smem); return; }
    t -= TJ7;
    {
      int which = t & 1, db = t >> 1;
      const float* src = (which ? P.in[I_WI] : P.in[I_WA]) + (size_t)db * 64 * 64;
      transpose_tile(src, 64, (bf16_t*)(ws + OFF_LRUT) + (size_t)db * 128 * 64 + which * 64 * 64, 64, 64, 64, 0, 0, smem);
      return;
    }
  }
  item -= NTRANS;
  if (item < NKEYCV) {
    size_t e = ((size_t)item * 256 + threadIdx.x) * 8;
    const float* s = P.in[I_KEYS] + e;
    f32x4 a = *(const f32x4*)s, b = *(const f32x4*)(s + 4);
    float v[8] = {a.x, a.y, a.z, a.w, b.x, b.y, b.z, b.w};
    *(u32x4*)((bf16_t*)(ws + OFF_KEYS) + e) = pack8(v);
    return;
  }
  item -= NKEYCV;
  {
    const int l = item / 96, cgp = item % 96;
    float* sS = (float*)smem;
    float* sRed = sS + 3 * 1024;
    const int tid = threadIdx.x;
    __syncthreads();
    for (int i = tid; i < 3 * 1024; i += 256) {
      int m = i >> 10, k = i & 1023;
      float c = m < 2 ? P.in[I_C][m * 1024 + k] : P.in[I_CCTX][k];
      sS[i] = siluf_(c);
    }
    __syncthreads();
    const int ks = tid >> 6, col = cgp * 64 + (tid & 63);
    const float* w = P.in[I_MODW] + (size_t)l * 1024 * 6144 + col;
    float a0 = 0.f, a1 = 0.f, a2 = 0.f;
    for (int k = ks * 256; k < ks * 256 + 256; ++k) {
      float wv = w[(size_t)k * 6144];
      a0 += sS[k] * wv; a1 += sS[1024 + k] * wv; a2 += sS[2048 + k] * wv;
    }
    sRed[(ks * 3 + 0) * 64 + (tid & 63)] = a0;
    sRed[(ks * 3 + 1) * 64 + (tid & 63)] = a1;
    sRed[(ks * 3 + 2) * 64 + (tid & 63)] = a2;
    __syncthreads();
    if (tid < 192) {
      int m = tid >> 6, c = tid & 63;
      float s = sRed[(0 * 3 + m) * 64 + c] + sRed[(1 * 3 + m) * 64 + c] + sRed[(2 * 3 + m) * 64 + c] + sRed[(3 * 3 + m) * 64 + c];
      int cc = cgp * 64 + c;
      ((float*)(ws + OFF_MODV))[((size_t)l * 3 + m) * 6144 + cc] = s + P.in[I_MODB][l * 6144 + cc];
    }
  }
}

constexpr int NPCONV = 2 * (NEXP * 1024 / (256 * 16));
DEV void st_peer_conv(const Params& P, int layer, int item) {
  const int half = NPCONV / 2;
  int which = item >= half;
  int it = which ? item - half : item;
  size_t e = ((size_t)it * 256 + threadIdx.x) * 16;
  const float* s = (which ? P.in[I_PV] : P.in[I_PU]) + (size_t)layer * NEXP * 1024 + e;
  const float sc = which ? PEER_VSCALE : PEER_USCALE;
  float v16[16];
#pragma unroll
  for (int q = 0; q < 4; ++q) {
    f32x4 a = *(const f32x4*)(s + 4 * q);
    v16[4 * q] = a.x * sc; v16[4 * q + 1] = a.y * sc; v16[4 * q + 2] = a.z * sc; v16[4 * q + 3] = a.w * sc;
  }
  const size_t ex = e >> 10, col = e & 1023;
  if (which) {
    u32x2 o; o.x = pack8_fp4(v16); o.y = pack8_fp4(v16 + 8);
    *(u32x2*)(P.ws + OFF_PU + ex * PEER_ROWB + PEER_VOFF + (col >> 1)) = o;
  } else {
    u32x3 o = pack16_fp6(v16);
    unsigned* dp = (unsigned*)(P.ws + OFF_PU + ex * PEER_ROWB + (col >> 4) * 12);
    dp[0] = o.x; dp[1] = o.y; dp[2] = o.z;
  }
}

DEV void st_normmod(const Params& P, int layer, int which, int row) {
  const int lane = threadIdx.x & 63;
  const float* src;
  if (which == 0 && layer == 0) src = row < NCTX ? P.in[I_CTX] + (size_t)row * 1024 : P.in[I_X] + (size_t)(row - NCTX) * 1024;
  else src = row < NCTX ? (const float*)(P.ws + OFF_CTXRES) + (size_t)row * 1024 : P.out + (size_t)(row - NCTX) * 1024;
  const float* mv = (const float*)(P.ws + OFF_MODV) + ((size_t)layer * 3 + mod_row(row)) * 6144;
  const float* sh = mv + (which ? 3 : 0) * 1024;
  const float* sc = mv + (which ? 4 : 1) * 1024;
  const float* nw = (which ? P.in[I_NORM2] : P.in[I_NORM1]) + layer * 1024;
  f32x4 v[4];
  float ss = 0.f;
#pragma unroll
  for (int i = 0; i < 4; ++i) {
    v[i] = *(const f32x4*)(src + i * 256 + lane * 4);
    ss += v[i].x * v[i].x + v[i].y * v[i].y + v[i].z * v[i].z + v[i].w * v[i].w;
  }
  ss = wave_sum(ss);
  const float rstd = frsq(ss * (1.f / 1024.f) + 1e-6f);
  bf16_t* dst = (bf16_t*)(P.ws + OFF_HBUF) + (size_t)row * 1024;
#pragma unroll
  for (int i = 0; i < 4; ++i) {
    int c = i * 256 + lane * 4;
    f32x4 w4 = *(const f32x4*)(nw + c), s4 = *(const f32x4*)(sc + c), h4 = *(const f32x4*)(sh + c);
    float o0 = v[i].x * rstd * w4.x * (1.f + s4.x) + h4.x;
    float o1 = v[i].y * rstd * w4.y * (1.f + s4.y) + h4.y;
    float o2 = v[i].z * rstd * w4.z * (1.f + s4.z) + h4.z;
    float o3 = v[i].w * rstd * w4.w * (1.f + s4.w) + h4.w;
    u32x2 pk; pk.x = pack2(o0, o1); pk.y = pack2(o2, o3);
    *(u32x2*)(dst + c) = pk;
  }
}

struct EpiProjL0 {
  bf16_t* proj; float* gates;
  DEVM void operator()(int row, int col, float v) const {
    proj[(size_t)row * EVC + col] = f2bf(v);
    if (col >= 1536 && col < 1552) gates[row * 32 + (col - 1536)] = v;
    else if (col >= 3088) gates[row * 32 + 16 + (col - 3088)] = v;
  }
};
struct EpiStoreBf {
  bf16_t* dst; int ld;
  DEVM void operator()(int row, int col, float v) const { dst[(size_t)row * ld + col] = f2bf(v); }
};
struct EpiStoreBfBias {
  bf16_t* dst; int ld; const float* bias;
  DEVM void operator()(int row, int col, float v) const { dst[(size_t)row * ld + col] = f2bf(v + (bias ? bias[col] : 0.f)); }
};
struct EpiProjL0T {
  bf16_t* proj; float* gates;
  DEVM void operator()(int, int, float) const {}
  DEVM void store4(int n, int m, float v0, float v1, float v2, float v3) const {
    u32x2 pk; pk.x = pack2(v0, v1); pk.y = pack2(v2, v3);
    *(u32x2*)(proj + (size_t)m * EVC + n) = pk;
    if (n >= 1536 && n < 1552) { f32x4 g = {v0, v1, v2, v3}; *(f32x4*)(gates + m * 32 + (n - 1536)) = g; }
    else if (n >= 3088) { f32x4 g = {v0, v1, v2, v3}; *(f32x4*)(gates + m * 32 + 16 + (n - 3088)) = g; }
  }
};
struct EpiStoreBfT {
  bf16_t* dst; int ld;
  DEVM void operator()(int, int, float) const {}
  DEVM void store4(int n, int m, float v0, float v1, float v2, float v3) const {
    u32x2 pk; pk.x = pack2(v0, v1); pk.y = pack2(v2, v3);
    *(u32x2*)(dst + (size_t)m * ld + n) = pk;
  }
};
struct EpiOutProjT {
  const float* x_lat; const float* x_ctx; float* o_lat; float* o_ctx; const float* modv;
  DEVM void operator()(int, int, float) const {}
  DEVM void store4(int n, int m, float v0, float v1, float v2, float v3) const {
    const f32x4 g = *(const f32x4*)(modv + mod_row(m) * 6144 + 2 * 1024 + n);
    const float* xs; float* od;
    if (m < NCTX) { xs = x_ctx + (size_t)m * 1024 + n; od = o_ctx + (size_t)m * 1024 + n; }
    else { size_t o = (size_t)(m - NCTX) * 1024 + n; xs = x_lat + o; od = o_lat + o; }
    const f32x4 x = *(const f32x4*)xs;
    f32x4 r = {x.x + g.x * v0, x.y + g.y * v1, x.z + g.z * v2, x.w + g.w * v3};
    *(f32x4*)od = r;
  }
};
struct EpiStoreBfBiasT {
  bf16_t* dst; int ld; const float* bias;
  DEVM void operator()(int, int, float) const {}
  DEVM void store4(int n, int m, float v0, float v1, float v2, float v3) const {
    if (bias) { v0 += bias[n]; v1 += bias[n + 1]; v2 += bias[n + 2]; v3 += bias[n + 3]; }
    u32x2 pk; pk.x = pack2(v0, v1); pk.y = pack2(v2, v3);
    *(u32x2*)(dst + (size_t)m * ld + n) = pk;
  }
};
struct EpiOutProj {
  const float* x_lat; const float* x_ctx; float* o_lat; float* o_ctx; const float* modv;
  DEVM void operator()(int row, int col, float v) const {
    float g = modv[mod_row(row) * 6144 + 2 * 1024 + col];
    if (row < NCTX) o_ctx[(size_t)row * 1024 + col] = x_ctx[(size_t)row * 1024 + col] + g * v;
    else { size_t o = (size_t)(row - NCTX) * 1024 + col; o_lat[o] = x_lat[o] + g * v; }
  }
};
struct EpiScoreLds {
  float* sS; int m0;
  DEVM void operator()(int row, int col, float v) const { sS[(row - m0) * 129 + col] = v; }
};

DEV void st_xbc_conv(const Params& P, int row) {
  const int lane = threadIdx.x & 63;
  const bf16_t* proj = (const bf16_t*)(P.ws + OFF_PROJ);
  bf16_t* xc = (bf16_t*)P.out + (size_t)row * 1024;
  int row0, len, pos;
  if (row < NCTX) { row0 = (row / CTXL) * CTXL; len = CTXL; pos = row - row0; }
  else { int r = row - NCTX; row0 = NCTX + (r / SEQ) * SEQ; len = SEQ; pos = r % SEQ; }
  const float* cw = P.in[I_SCONVW];
  const float* cb = P.in[I_SCONVB];
#pragma unroll
  for (int hh = 0; hh < 2; ++hh) {
    const int ch = hh * 512 + lane * 8;
    float o[8];
#pragma unroll
    for (int j = 0; j < 8; ++j) o[j] = cb[ch + j];
#pragma unroll
    for (int tap = 0; tap < 4; ++tap) {
      int pp = pos + tap - 2;
      if (pp >= 0 && pp < len) {
        float x[8];
        unpack8(*(const u32x4*)(proj + (size_t)(row0 + pp) * EVC + 2064 + ch), x);
        f32x4 w0 = *(const f32x4*)(cw + tap * 1024 + ch), w1 = *(const f32x4*)(cw + tap * 1024 + ch + 4);
        o[0] += w0.x * x[0]; o[1] += w0.y * x[1]; o[2] += w0.z * x[2]; o[3] += w0.w * x[3];
        o[4] += w1.x * x[4]; o[5] += w1.y * x[5]; o[6] += w1.z * x[6]; o[7] += w1.w * x[7];
      }
    }
#pragma unroll
    for (int j = 0; j < 8; ++j) o[j] = siluf_(o[j]);
    *(u32x4*)(xc + ch) = pack8(o);
  }
}

#ifndef LA_NSEG
#define LA_NSEG 10
#endif
constexpr int LA_NCH = (CTXL + SEQ) / 64;
constexpr int LA_CPS = LA_NCH / LA_NSEG;
static_assert(LA_NCH % LA_NSEG == 0, "linattn segments");
#ifdef CPU_EMU
constexpr size_t OFF_LASEG = OFF_PR + PR_BYTES;
#else
constexpr size_t OFF_LASEG = OFF_R2L0 + (size_t)NTOK * 1024 * 2;
#endif
constexpr size_t LASEG_U = (size_t)48 * LA_NSEG * 8192 * 4;
constexpr size_t OFF_LASEG_N = OFF_LASEG + LASEG_U;
constexpr size_t OFF_LASEG_D = OFF_LASEG_N + (size_t)48 * LA_NSEG * 64 * 4;
#ifndef CPU_EMU
static_assert(OFF_LASEG_D + 48 * LA_NSEG * 4 <= OFF_PR + PR_BYTES, "laseg");
#endif

struct LaRaw { u32x4 q[2], k[4], x[4]; float g0, g1; };

template <bool MLSTM, bool FULL>
DEV void la_load_raw(const Params& P, int b, int h, int d, int cc, LaRaw& R) {
  constexpr int NC_CTX = CTXL / 64;
  const int tid = threadIdx.x;
  const int seg = cc >= NC_CTX;
  const int row0 = seg ? NCTX + b * SEQ : b * CTXL;
  const int len = seg ? SEQ : CTXL;
  const int cl = (seg ? cc - NC_CTX : cc) * 64;
  const bf16_t* proj = (const bf16_t*)(P.ws + OFF_PROJ);
  const bf16_t* xcv = (const bf16_t*)P.out;
  const float* gates = (const float*)(P.ws + OFF_GATES);
  if (tid < 64) {
    int p = cl + tid, grow = row0 + (d ? len - 1 - p : p);
    if (MLSTM) { R.g0 = gates[grow * 32 + d * 4 + h]; R.g1 = gates[grow * 32 + 8 + d * 4 + h]; }
    else { R.g0 = gates[grow * 32 + 16 + d * 8 + h]; R.g1 = 0.f; }
  }
  if (MLSTM) {
#pragma unroll
    for (int i = 0; i < 2; ++i) {
      int c = tid + i * 256, r = c >> 3, cc8 = (c & 7) * 8;
      int p = cl + r, pos = d ? len - 1 - p : p;
      const bf16_t* rp = proj + (size_t)(row0 + pos) * EVC;
      if (FULL) R.q[i] = *(const u32x4*)(rp + h * 64 + cc8);
      R.k[i] = *(const u32x4*)(rp + 256 + h * 64 + cc8);
    }
#pragma unroll
    for (int i = 0; i < 4; ++i) {
      int c = tid + i * 256, r = c >> 4, cc8 = (c & 15) * 8;
      int p = cl + r, pos = d ? len - 1 - p : p;
      R.x[i] = *(const u32x4*)(proj + (size_t)(row0 + pos) * EVC + 512 + h * 128 + cc8);
    }
  } else {
    const int grp = h >> 2;
#pragma unroll
    for (int i = 0; i < 2; ++i) {
      int c = tid + i * 256, r = c >> 3, cc8 = (c & 7) * 8;
      int p = cl + r, pos = d ? len - 1 - p : p;
      R.x[i] = *(const u32x4*)(xcv + (size_t)(row0 + pos) * 1024 + h * 64 + cc8);
    }
#pragma unroll
    for (int i = 0; i < 4; ++i) {
      int c = tid + i * 256, r = c >> 4, cc8 = (c & 15) * 8;
      int p = cl + r, pos = d ? len - 1 - p : p;
      const bf16_t* rp = xcv + (size_t)(row0 + pos) * 1024;
      R.k[i] = *(const u32x4*)(rp + 512 + grp * 128 + cc8);
      if (FULL) { if (i < 2) R.q[i] = *(const u32x4*)(rp + 768 + grp * 128 + cc8); else R.x[i] = *(const u32x4*)(rp + 768 + grp * 128 + cc8); }
    }
  }
}

template <bool MLSTM, bool FULL>
DEV void st_linattn_seg(const Params& P, int sid, int seg, unsigned char* smem) {
  constexpr int DK = MLSTM ? 64 : 128, DX = MLSTM ? 128 : 64;
  constexpr int QS = DK + 8;
  constexpr int NH = MLSTM ? 4 : 8;
  constexpr int NC_CTX = CTXL / 64;
  const int tid = threadIdx.x, lane = tid & 63, wave = tid >> 6;
  const int d = sid & 1, h = (sid >> 1) % NH, b = (sid >> 1) / NH;
  const int gsid = MLSTM ? sid : 16 + sid;
  bf16_t* sQ = (bf16_t*)smem;
  bf16_t* sK = sQ + 64 * QS;
  bf16_t* sP = sK;
  bf16_t* sKT = sK + 64 * QS;
  bf16_t* sXT = sKT + DK * 72;
  bf16_t* sST = sXT + DX * 72;
  float* sF = (float*)(sST + DX * QS);
  float* sLa = sF;
  float* sG = sF + 64;
  float* sBc = sF + 128;
  float* sDen = sF + 192;
  float* sN = sF + 256;
  int* sRow = (int*)(sF + 384);
  static_assert((64 * QS * 2 + DK * 72 + DX * 72 + DX * QS) * 2 + 448 * 4 <= SMEM_BYTES, "lds");
  bf16_t* outb = MLSTM ? (bf16_t*)(P.ws + OFF_HBUF) : (bf16_t*)(P.ws + OFF_R2L0);
  float* segU = (float*)(P.ws + OFF_LASEG);
  float* segN = (float*)(P.ws + OFF_LASEG_N);
  float* segD = (float*)(P.ws + OFF_LASEG_D);

  f32x16 accS[2];
#pragma unroll
  for (int j = 0; j < 2; ++j)
#pragma unroll
    for (int r = 0; r < 16; ++r) accS[j][r] = 0.f;
  const int sx0 = MLSTM ? wave * 32 : (wave >> 1) * 32;
  const int sk0 = MLSTM ? 0 : (wave & 1) * 64;
  float nreg = 0.f;
  float gb0 = 0.f, gb1 = 0.f, alog_e = 0.f, dskip = 0.f;
  if (MLSTM) { gb0 = P.in[I_IBIAS][d * 4 + h]; gb1 = P.in[I_FBIAS][d * 4 + h]; }
  else { gb0 = P.in[I_DTBIAS][d * 8 + h]; alog_e = fexp(P.in[I_ALOG][d * 8 + h]); dskip = P.in[I_DSKIP][h]; }

  const int cc0 = seg * LA_CPS, cc1 = cc0 + LA_CPS;
  LaRaw R;
  la_load_raw<MLSTM, FULL>(P, b, h, d, cc0, R);
  __syncthreads();
  if (FULL) {
    for (int js = 0; js < seg; ++js) {
      const size_t it = (size_t)gsid * LA_NSEG + js;
      const float a = fexp(segD[it]);
      const float* U = segU + it * 8192;
#pragma unroll
      for (int j = 0; j < 2; ++j)
#pragma unroll
        for (int r = 0; r < 16; ++r) accS[j][r] = a * accS[j][r] + U[(j * 16 + r) * 256 + tid];
      if (MLSTM && tid < 64) nreg = a * nreg + segN[it * 64 + tid];
    }
#pragma unroll
    for (int j = 0; j < 2; ++j)
#pragma unroll
      for (int r = 0; r < 16; ++r) sST[(sx0 + acc_row(r, lane)) * QS + sk0 + j * 32 + (lane & 31)] = f2bf(accS[j][r]);
    if (tid < 128) sN[tid] = (MLSTM && tid < 64) ? nreg : 0.f;
  }
  float lsum = 0.f;

  for (int cc = cc0; cc < cc1; ++cc) {
    int tl_ = threadIdx.x; OPAQUE(tl_);
    const int tid = tl_, lane = tl_ & 63;
    const int sgi = cc >= NC_CTX;
    const int row0 = sgi ? NCTX + b * SEQ : b * CTXL;
    const int len = sgi ? SEQ : CTXL;
    const int cl = (sgi ? cc - NC_CTX : cc) * 64;
    if (tid < 64) {
      int p = cl + tid;
      sRow[tid] = row0 + (d ? len - 1 - p : p);
      if (MLSTM) { sLa[tid] = -softplusf_(-(R.g1 + gb1)); sG[tid] = fexp(R.g0 + gb0); }
      else { float dt = softplusf_(R.g0 + gb0); sLa[tid] = -dt * alog_e; sG[tid] = dt; }
    }
    __syncthreads();
    if (wave == 0) {
      float v = sLa[lane];
#pragma unroll
      for (int off = 1; off < 64; off <<= 1) {
#ifdef CPU_EMU
        float o = emu_shfl_up(v, off);
#else
        float o = __shfl_up(v, off, 64);
#endif
        if (lane >= off) v += o;
      }
      sBc[lane] = v;
    }
    __syncthreads();
    const float blast = sBc[63];
    lsum += blast;
    if (MLSTM) {
#pragma unroll
      for (int i = 0; i < 2; ++i) {
        int c = tid + i * 256, r = c >> 3, cc8 = (c & 7) * 8;
        float kf[8]; unpack8(R.k[i], kf);
        const float wgt = fexp(blast - sBc[r]) * sG[r];
#pragma unroll
        for (int j = 0; j < 8; ++j) sKT[(cc8 + j) * 72 + r] = f2bf(kf[j] * wgt);
        if (FULL) {
          float qf[8]; unpack8(R.q[i], qf);
#pragma unroll
          for (int j = 0; j < 8; ++j) qf[j] *= 0.125f;
          *(u32x4*)(sQ + r * QS + cc8) = pack8(qf);
          *(u32x4*)(sK + r * QS + cc8) = R.k[i];
        }
      }
#pragma unroll
      for (int i = 0; i < 4; ++i) {
        int c = tid + i * 256, r = c >> 4, cc8 = (c & 15) * 8;
        const bf16_t* xs = (const bf16_t*)&R.x[i];
#pragma unroll
        for (int j = 0; j < 8; ++j) sXT[(cc8 + j) * 72 + r] = xs[j];
      }
    } else {
#pragma unroll
      for (int i = 0; i < 2; ++i) {
        int c = tid + i * 256, r = c >> 3, cc8 = (c & 7) * 8;
        const bf16_t* xs = (const bf16_t*)&R.x[i];
#pragma unroll
        for (int j = 0; j < 8; ++j) sXT[(cc8 + j) * 72 + r] = xs[j];
      }
#pragma unroll
      for (int i = 0; i < 4; ++i) {
        int c = tid + i * 256, r = c >> 4, cc8 = (c & 15) * 8;
        float kf[8]; unpack8(R.k[i], kf);
        const float wgt = fexp(blast - sBc[r]) * sG[r];
#pragma unroll
        for (int j = 0; j < 8; ++j) sKT[(cc8 + j) * 72 + r] = f2bf(kf[j] * wgt);
        if (FULL) {
          *(u32x4*)(sK + r * QS + cc8) = R.k[i];
          *(u32x4*)(sQ + r * QS + cc8) = i < 2 ? R.q[i] : R.x[i];
        }
      }
    }
    if (cc + 1 < cc1) la_load_raw<MLSTM, FULL>(P, b, h, d, cc + 1, R);
    __syncthreads();
    if (FULL) {
      const int tr = (wave >> 1) * 32, tc = (wave & 1) * 32;
      f32x16 accP;
#pragma unroll
      for (int r = 0; r < 16; ++r) accP[r] = 0.f;
      if (!(tr == 0 && tc == 32)) {
#pragma unroll
        for (int kk = 0; kk < DK / 16; ++kk) {
          const int ko = kk * 16 + 8 * (lane >> 5);
          bf16x8 a = *(const bf16x8*)(sQ + (tr + (lane & 31)) * QS + ko);
          bf16x8 bb = *(const bf16x8*)(sK + (tc + (lane & 31)) * QS + ko);
          accP = mfma32(a, bb, accP);
        }
      }
      __syncthreads();
      {
        const int s = tc + (lane & 31);
        const float bs = sBc[s], gs = sG[s];
#pragma unroll
        for (int r = 0; r < 16; ++r) {
          int t = tr + acc_row(r, lane);
          float v = (s <= t) ? accP[r] * fexp(sBc[t] - bs) * gs : 0.f;
          sP[t * 72 + s] = f2bf(v);
        }
        {
          const int t = tid >> 2, kq = (tid & 3) * (DK / 4);
          const float et = fexp(sBc[t]);
#pragma unroll
          for (int c8 = 0; c8 < DK / 4; c8 += 8) {
            float qf[8];
            unpack8(*(const u32x4*)(sQ + t * QS + kq + c8), qf);
#pragma unroll
            for (int j = 0; j < 8; ++j) qf[j] *= et;
            *(u32x4*)(sQ + t * QS + kq + c8) = pack8(qf);
          }
        }
      }
      __syncthreads();
      constexpr int NYT = MLSTM ? 2 : 1;
      const int yx0 = MLSTM ? wave * 32 : (wave >> 1) * 32;
      const int yt0 = MLSTM ? 0 : (wave & 1) * 32;
      f32x16 accY[NYT];
#pragma unroll
      for (int j = 0; j < NYT; ++j)
#pragma unroll
        for (int r = 0; r < 16; ++r) accY[j][r] = 0.f;
#pragma unroll
      for (int kk = 0; kk < 4; ++kk) {
        const int ko = kk * 16 + 8 * (lane >> 5);
        bf16x8 a = *(const bf16x8*)(sXT + (yx0 + (lane & 31)) * 72 + ko);
#pragma unroll
        for (int j = 0; j < NYT; ++j) {
          bf16x8 bb = *(const bf16x8*)(sP + (yt0 + j * 32 + (lane & 31)) * 72 + ko);
          accY[j] = mfma32(a, bb, accY[j]);
        }
      }
#pragma unroll
      for (int kk = 0; kk < DK / 16; ++kk) {
        const int ko = kk * 16 + 8 * (lane >> 5);
        bf16x8 a = *(const bf16x8*)(sST + (yx0 + (lane & 31)) * QS + ko);
#pragma unroll
        for (int j = 0; j < NYT; ++j) {
          bf16x8 bb = *(const bf16x8*)(sQ + (yt0 + j * 32 + (lane & 31)) * QS + ko);
          accY[j] = mfma32(a, bb, accY[j]);
        }
      }
      if (MLSTM) {
        if (tid < 64) {
          float den = 0.f, dq = 0.f;
#pragma unroll 8
          for (int s = 0; s < 64; ++s) den += bf2f(sP[tid * 72 + s]);
#pragma unroll 8
          for (int k = 0; k < DK; ++k) dq += sN[k] * bf2f(sQ[tid * QS + k]);
          sDen[tid] = den + dq;
        }
        __syncthreads();
      }
#pragma unroll
      for (int j = 0; j < NYT; ++j) {
        const int t = yt0 + j * 32 + (lane & 31);
        const size_t obase = (size_t)sRow[t] * 1024 + d * 512 + h * DX;
        const float dinv = MLSTM ? frcp(fmaxf(fabsf(sDen[t]), 1.f)) : 1.f;
#pragma unroll
        for (int g = 0; g < 4; ++g) {
          const int x0 = yx0 + 8 * g + 4 * (lane >> 5);
          float v0 = accY[j][4 * g], v1 = accY[j][4 * g + 1], v2 = accY[j][4 * g + 2], v3 = accY[j][4 * g + 3];
          if (MLSTM) { v0 *= dinv; v1 *= dinv; v2 *= dinv; v3 *= dinv; }
          else if (d == 0) {
            v0 += dskip * bf2f(sXT[(x0 + 0) * 72 + t]); v1 += dskip * bf2f(sXT[(x0 + 1) * 72 + t]);
            v2 += dskip * bf2f(sXT[(x0 + 2) * 72 + t]); v3 += dskip * bf2f(sXT[(x0 + 3) * 72 + t]);
          }
          u32x2 pk; pk.x = pack2(v0, v1); pk.y = pack2(v2, v3);
          *(u32x2*)(outb + obase + x0) = pk;
        }
      }
      __syncthreads();
    }
    {
      const float eb = fexp(blast);
#pragma unroll
      for (int j = 0; j < 2; ++j)
#pragma unroll
        for (int r = 0; r < 16; ++r) accS[j][r] *= eb;
#pragma unroll
      for (int kk = 0; kk < 4; ++kk) {
        const int ko = kk * 16 + 8 * (lane >> 5);
        bf16x8 a = *(const bf16x8*)(sXT + (sx0 + (lane & 31)) * 72 + ko);
#pragma unroll
        for (int j = 0; j < 2; ++j) {
          bf16x8 bb = *(const bf16x8*)(sKT + (sk0 + j * 32 + (lane & 31)) * 72 + ko);
          accS[j] = mfma32(a, bb, accS[j]);
        }
      }
      if (FULL) {
#pragma unroll
        for (int j = 0; j < 2; ++j)
#pragma unroll
          for (int r = 0; r < 16; ++r) sST[(sx0 + acc_row(r, lane)) * QS + sk0 + j * 32 + (lane & 31)] = f2bf(accS[j][r]);
      }
      if (MLSTM && tid < 64) {
        float nn = nreg * eb;
        for (int s = 0; s < 64; ++s) nn += bf2f(sKT[tid * 72 + s]);
        nreg = nn;
        if (FULL) sN[tid] = nn;
      }
    }
    __syncthreads();
  }
  if (!FULL) {
    const size_t it = (size_t)gsid * LA_NSEG + seg;
    float* U = segU + it * 8192;
#pragma unroll
    for (int j = 0; j < 2; ++j)
#pragma unroll
      for (int r = 0; r < 16; ++r) U[(j * 16 + r) * 256 + tid] = accS[j][r];
    if (MLSTM && tid < 64) segN[it * 64 + tid] = nreg;
    if (tid == 0) segD[it] = lsum;
  }
}

DEV void st_finish_l0(const Params& P, int row) {
  const int lane = threadIdx.x & 63;
  bf16_t* hb = (bf16_t*)(P.ws + OFF_HBUF) + (size_t)row * 1024;
  const bf16_t* yb = (const bf16_t*)(P.ws + OFF_R2L0) + (size_t)row * 1024;
  const bf16_t* pr = (const bf16_t*)(P.ws + OFF_PROJ) + (size_t)row * EVC;
  const int ch = lane * 8;
  float h0[8], h1[8], o[8], f1[8];
  unpack8(*(const u32x4*)(hb + ch), h0);
  unpack8(*(const u32x4*)(hb + 512 + ch), h1);
  unpack8(*(const u32x4*)(pr + 1024 + ch), o);
  float ss = 0.f;
#pragma unroll
  for (int j = 0; j < 8; ++j) { h0[j] += h1[j]; ss += h0[j] * h0[j]; }
  ss = sum16(ss);
  float rstd = frsq(ss * (1.f / 128.f) + 1e-6f);
  float pw[8]; ld8(P.in[I_MNORM] + ch, pw);
#pragma unroll
  for (int j = 0; j < 8; ++j) f1[j] = h0[j] * rstd * pw[j] * sigmoidf_(o[j]);
  float y0[8], y1[8], z[8], f2[8];
  unpack8(*(const u32x4*)(yb + ch), y0);
  unpack8(*(const u32x4*)(yb + 512 + ch), y1);
  unpack8(*(const u32x4*)(pr + 1552 + ch), z);
  float s2 = 0.f;
#pragma unroll
  for (int j = 0; j < 8; ++j) { y0[j] = (y0[j] + y1[j]) * siluf_(z[j]); s2 += y0[j] * y0[j]; }
  s2 = wave_sum(s2);
  float rstd2 = frsq(s2 * (1.f / 512.f) + 1e-6f);
  ld8(P.in[I_SNORM] + ch, pw);
#pragma unroll
  for (int j = 0; j < 8; ++j) f2[j] = y0[j] * rstd2 * pw[j];
  *(u32x4*)(hb + ch) = pack8(f1);
  *(u32x4*)(hb + 512 + ch) = pack8(f2);
}

DEV float mixval(const bf16_t* __restrict__ proj, int row, int c, const float* __restrict__ mu) {
  float self = bf2f(proj[(size_t)row * ODC + c]);
  int nrow = -1;
  if (row < NCTX) {
    int pos = row % CTXL;
    if (c < 896) { if (pos > 0) nrow = row - 1; }
    else { if (pos < CTXL - 1) nrow = row + 1; }
  } else {
    int pos = (row - NCTX) % SEQ;
    int gx = pos % GW, gy = pos / GW, q = c / 448;
    if (q == 0) { if (gx > 0) nrow = row - 1; }
    else if (q == 1) { if (gx < GW - 1) nrow = row + 1; }
    else if (q == 2) { if (gy > 0) nrow = row - GW; }
    else { if (gy < SEQ / GW - 1) nrow = row + GW; }
  }
  float nb = nrow >= 0 ? bf2f(proj[(size_t)nrow * ODC + c]) : 0.f;
  return self + mu[c] * (nb - self);
}

DEV int nbr_row(int row, int c) {
  if (row < NCTX) {
    int pos = row % CTXL;
    if (c < 896) return pos > 0 ? row - 1 : -1;
    return pos < CTXL - 1 ? row + 1 : -1;
  }
  int pos = (row - NCTX) % SEQ;
  int gx = pos % GW, gy = pos / GW, q = c / 448;
  if (q == 0) return gx > 0 ? row - 1 : -1;
  if (q == 1) return gx < GW - 1 ? row + 1 : -1;
  if (q == 2) return gy > 0 ? row - GW : -1;
  return gy < SEQ / GW - 1 ? row + GW : -1;
}

DEV void mix8(const bf16_t* __restrict__ proj, int row, int c, const float* __restrict__ mu, float* o) {
  float xs[8], xn[8];
  unpack8(*(const u32x4*)(proj + (size_t)row * ODC + c), xs);
  const int nr = nbr_row(row, c);
  if (nr >= 0) unpack8(*(const u32x4*)(proj + (size_t)nr * ODC + c), xn);
  else {
#pragma unroll
    for (int j = 0; j < 8; ++j) xn[j] = 0.f;
  }
  const f32x4 m0 = *(const f32x4*)(mu + c), m1 = *(const f32x4*)(mu + c + 4);
  const float mm[8] = {m0.x, m0.y, m0.z, m0.w, m1.x, m1.y, m1.z, m1.w};
#pragma unroll
  for (int j = 0; j < 8; ++j) o[j] = xs[j] + mm[j] * (xn[j] - xs[j]);
}

DEV void st_lora_act(const Params& P, int row2) {
  const int lane = threadIdx.x & 63;
  const int row = row2 + (lane >> 5), c = (lane & 31) * 8;
  const bf16_t* proj = (const bf16_t*)(P.ws + OFF_PROJ);
  bf16_t* hb = (bf16_t*)(P.ws + OFF_HBUF) + (size_t)row * 1024;
  float v[8];
  mix8(proj, row, 1536 + c, P.in[I_MU], v);
#pragma unroll
  for (int j = 0; j < 8; ++j) v[j] = c < 64 ? tanhf_(v[j]) : (c < 128 ? v[j] : sigmoidf_(v[j]));
  *(u32x4*)(hb + c) = pack8(v);
}

DEV void st_rwkv_stream(const Params& P, int sid, unsigned char* smem) {
  const int tid = threadIdx.x, lane = tid & 63, wave = tid >> 6;
  const int d = sid & 1, h = (sid >> 1) & 7, b = sid >> 4;
  float* sR = (float*)smem;
  float* sW = sR + 2048;
  float* sKk = sW + 2048;
  float* sV = sKk + 2048;
  float* sA = sV + 2048;
  float* sBb = sA + 2048;
  float* sY = sBb + 2048;
  int* sRow = (int*)(sY + 2048);
  const bf16_t* proj = (const bf16_t*)(P.ws + OFF_PROJ);
  const bf16_t* lora = (const bf16_t*)(P.ws + OFF_LORA);
  bf16_t* yout = (bf16_t*)(P.ws + OFF_HBUF);
  const float* mu = P.in[I_MU];
  const int vrow = tid >> 2, j4 = tid & 3;
  float S[16];
#pragma unroll
  for (int i = 0; i < 16; ++i) S[i] = 0.f;
  const float kkw = P.in[I_KK][h * 64 + lane], kaw = P.in[I_KA][h * 64 + lane];
  for (int seg = 0; seg < 2; ++seg) {
    const int row0 = seg == 0 ? b * CTXL : NCTX + b * SEQ;
    const int len = seg == 0 ? CTXL : SEQ;
    for (int it = 0; it < len / 32; ++it) {
      __syncthreads();
      for (int s = wave; s < 32; s += 4) {
        int p = it * 32 + s, pos = d ? len - 1 - p : p, row = row0 + pos;
        int c = h * 64 + lane;
        float r = mixval(proj, row, c, mu);
        float k = mixval(proj, row, 512 + c, mu);
        float v = mixval(proj, row, 1024 + c, mu);
        float kk = k * kkw;
        float ss = wave_sum(kk * kk);
        kk *= frsq(ss + 1e-12f);
        float lw = bf2f(lora[((size_t)d * NTOK + row) * 512 + c]);
        float la = bf2f(lora[((size_t)(2 + d) * NTOK + row) * 512 + c]);
        float w = fexp(-0.6065306597126334f * sigmoidf_(lw));
        float a = sigmoidf_(la);
        float kt = k * (1.f + (a - 1.f) * kaw);
        sR[s * 64 + lane] = r; sW[s * 64 + lane] = w; sKk[s * 64 + lane] = kt; sV[s * 64 + lane] = v;
        sA[s * 64 + lane] = -kk; sBb[s * 64 + lane] = kk * a;
        if (lane == 0) sRow[s] = row;
      }
      __syncthreads();
      for (int s = 0; s < 32; ++s) {
        const float* pa = sA + s * 64 + j4 * 16;
        const float* pw = sW + s * 64 + j4 * 16;
        const float* pk = sKk + s * 64 + j4 * 16;
        const float* pb = sBb + s * 64 + j4 * 16;
        const float* pr = sR + s * 64 + j4 * 16;
        const float vv = sV[s * 64 + vrow];
        float sa = 0.f;
#pragma unroll
        for (int i = 0; i < 16; ++i) sa += S[i] * pa[i];
        sa = sum4(sa);
        float y = 0.f;
#pragma unroll
        for (int i = 0; i < 16; ++i) { S[i] = S[i] * pw[i] + sa * pb[i] + vv * pk[i]; y += S[i] * pr[i]; }
        y = sum4(y);
        if (j4 == 0) sY[s * 64 + vrow] = y;
      }
      __syncthreads();
      for (int i = tid; i < 2048; i += 256) {
        int s = i >> 6, c = i & 63;
        yout[(size_t)sRow[s] * 1024 + d * 512 + h * 64 + c] = f2bf(sY[i]);
      }
    }
  }
}


struct RwkvRaw { u32x4 rs, rn, ks, kn, vs, vn, lw, la; int row; };

DEV void rwkv_load_raw(const bf16_t* __restrict__ proj, const bf16_t* __restrict__ lora, int b, int h, int d, int cc, int t, int c0,
                       RwkvRaw& R) {
  constexpr int NC_CTX = CTXL / 32;
  const int seg = cc >= NC_CTX;
  const int row0 = seg ? NCTX + b * SEQ : b * CTXL;
  const int len = seg ? SEQ : CTXL;
  const int p = (seg ? cc - NC_CTX : cc) * 32 + t;
  const int row = row0 + (d ? len - 1 - p : p);
  const int col = h * 64 + c0;
  const u32x4 z4 = {0u, 0u, 0u, 0u};
  const bf16_t* rp = proj + (size_t)row * ODC;
  R.row = row;
  R.rs = *(const u32x4*)(rp + col);
  R.ks = *(const u32x4*)(rp + 512 + col);
  R.vs = *(const u32x4*)(rp + 1024 + col);
  int n0 = nbr_row(row, col), n1 = nbr_row(row, 512 + col), n2 = nbr_row(row, 1024 + col);
  R.rn = n0 >= 0 ? *(const u32x4*)(proj + (size_t)n0 * ODC + col) : z4;
  R.kn = n1 >= 0 ? *(const u32x4*)(proj + (size_t)n1 * ODC + 512 + col) : z4;
  R.vn = n2 >= 0 ? *(const u32x4*)(proj + (size_t)n2 * ODC + 1024 + col) : z4;
  R.lw = *(const u32x4*)(lora + ((size_t)d * NTOK + row) * 512 + col);
  R.la = *(const u32x4*)(lora + ((size_t)(2 + d) * NTOK + row) * 512 + col);
}

#ifndef RW_NSEG
#define RW_NSEG 16
#endif
constexpr int RW_NCH = (CTXL + SEQ) / 32;
constexpr size_t OFF_RWSEG = OFF_PU;
static_assert((size_t)32 * RW_NSEG * 64 * 128 * 4 <= (size_t)2 * NEXP * 1024, "rwseg");

template <bool FULL>
DEV void st_rwkv_seg(const Params& P, int sid, int seg, unsigned char* smem) {
  constexpr int NVB = FULL ? 2 : 4;
  constexpr int ZR = FULL ? 64 : 128;
  const int tid = threadIdx.x, lane = tid & 63, wave = tid >> 6;
  const int d = sid & 1, h = (sid >> 1) & 7, b = sid >> 4;
  bf16_t* sAt = (bf16_t*)smem;
  bf16_t* sRt = sAt + 32 * 72;
  bf16_t* sBt = sRt + 32 * 72;
  bf16_t* sKt = sBt + 32 * 72;
  bf16_t* sBT = sKt + 32 * 72;
  bf16_t* sKT = sBT + 64 * 40;
  bf16_t* sVT = sKT + 64 * 40;
  bf16_t* sLak = sVT + 64 * 40;
  bf16_t* sM = sLak + 32 * 40;
  bf16_t* sLrb = sM + 32 * 40;
  bf16_t* sLrk = sLrb + 32 * 40;
  bf16_t* sZ = FULL ? sLrk + 32 * 40 : sLrb;
  bf16_t* after = sZ + ZR * 72;
  bf16_t* sRT = FULL ? after : nullptr;
  bf16_t* sSAT = FULL ? after + 64 * 40 : sRt;
  float* sLP = (float*)(FULL ? after + 2 * 64 * 40 : after);
  float* sLab = sLP + 32 * 64;
  float* sD = sLab + 32 * 33;
  float* sPT = sD + 768;
  int* sRow = (int*)(sPT + 64);
  if (!FULL) sRT = (bf16_t*)sLP;
  static_assert((4 * 32 * 72 + 3 * 64 * 40 + 4 * 32 * 40 + 2 * 64 * 40 + 64 * 72) * 2 + (32 * 64 + 32 * 33 + 768 + 64 + 32 + 320) * 4 + 16 <= SMEM_BYTES, "lds full");
  static_assert((4 * 32 * 72 + 3 * 64 * 40 + 2 * 32 * 40 + 128 * 72) * 2 + (32 * 64 + 32 * 33 + 768 + 64 + 32) * 4 <= SMEM_BYTES, "lds p1");
  static_assert(128 * 40 * 2 <= (32 * 64 + 32 * 33) * 4 && 128 * 40 <= 3 * 32 * 72, "alias");
  const bf16_t* proj = (const bf16_t*)(P.ws + OFF_PROJ);
  const bf16_t* lora = (const bf16_t*)(P.ws + OFF_LORA);
  bf16_t* yout = (bf16_t*)(P.ws + OFF_HBUF);
  float* segZ = (float*)(P.ws + OFF_RWSEG);
  const int t = tid >> 3, c0 = (tid & 7) * 8;
  const int hl = lane >> 5, l31 = lane & 31;
  float* sCst = (float*)(smem + SMEM_BYTES - 320 * 4 - 16);
  if (tid < 64) {
    sCst[tid] = P.in[I_MU][h * 64 + tid]; sCst[64 + tid] = P.in[I_MU][512 + h * 64 + tid]; sCst[128 + tid] = P.in[I_MU][1024 + h * 64 + tid];
    sCst[192 + tid] = P.in[I_KK][h * 64 + tid]; sCst[256 + tid] = P.in[I_KA][h * 64 + tid];
  }
  const int cc0 = (seg * RW_NCH) / RW_NSEG, cc1 = ((seg + 1) * RW_NCH) / RW_NSEG;
  RwkvRaw R;
  rwkv_load_raw(proj, lora, b, h, d, cc0, t, c0, R);
  f32x16 Zm[2];
#pragma unroll
  for (int j = 0; j < 2; ++j)
#pragma unroll
    for (int r = 0; r < 16; ++r) Zm[j][r] = 0.f;
  __syncthreads();
  for (int i = tid; i < ZR * 72; i += 256) sZ[i] = 0;
  __syncthreads();
  if (!FULL) {
    if (wave >= 2) {
#pragma unroll
      for (int cb = 0; cb < 2; ++cb)
#pragma unroll
        for (int r = 0; r < 16; ++r) {
          int c = cb * 32 + acc_row(r, lane), vp = wave * 32 + l31;
          if (c == vp - 64) { Zm[cb][r] = 1.f; sZ[vp * 72 + c] = 0x3f80; }
        }
    }
  } else {
    for (int js = 0; js < seg; ++js) {
      const float* Zs = segZ + ((size_t)sid * RW_NSEG + js) * 64 * 128;
      bf16_t* sG = sAt;
      {
        const int c = tid >> 2, c2 = (tid & 3) * 16;
        float gv[16];
        ld8(Zs + c * 128 + 64 + c2, gv); ld8(Zs + c * 128 + 64 + c2 + 8, gv + 8);
        *(u32x4*)(sG + c * 72 + c2) = pack8(gv);
        *(u32x4*)(sG + c * 72 + c2 + 8) = pack8(gv + 8);
      }
      __syncthreads();
      if (wave >= 2) {
        const int cb = wave - 2;
#pragma unroll
        for (int vb = 0; vb < 2; ++vb) {
          f32x16 acc;
#pragma unroll
          for (int r = 0; r < 16; ++r) acc[r] = Zs[(cb * 32 + acc_row(r, lane)) * 128 + vb * 32 + l31];
#pragma unroll
          for (int kk = 0; kk < 4; ++kk) {
            bf16x8 a = *(const bf16x8*)(sG + (cb * 32 + l31) * 72 + kk * 16 + 8 * hl);
            bf16x8 bb = *(const bf16x8*)(sZ + (vb * 32 + l31) * 72 + kk * 16 + 8 * hl);
            acc = mfma32(a, bb, acc);
          }
          Zm[vb] = acc;
        }
      }
      __syncthreads();
      if (wave >= 2) {
        const int cb = wave - 2;
#pragma unroll
        for (int vb = 0; vb < 2; ++vb)
#pragma unroll
          for (int g = 0; g < 4; ++g) {
            u32x2 pk; pk.x = pack2(Zm[vb][4 * g], Zm[vb][4 * g + 1]); pk.y = pack2(Zm[vb][4 * g + 2], Zm[vb][4 * g + 3]);
            *(u32x2*)(sZ + (vb * 32 + l31) * 72 + cb * 32 + 8 * g + 4 * hl) = pk;
          }
      }
      __syncthreads();
    }
  }
  for (int cc = cc0; cc < cc1; ++cc) {
    int tl_ = threadIdx.x; OPAQUE(tl_);
    const int tid = tl_, lane = tl_ & 63, hl = lane >> 5, l31 = lane & 31, t = tl_ >> 3, c0 = (tl_ & 7) * 8;
    const float* muR = sCst + c0; const float* muK = sCst + 64 + c0; const float* muV = sCst + 128 + c0;
    const float* kkw = sCst + 192 + c0; const float* kaw = sCst + 256 + c0;
    float lw8[8], lp8[8];
    {
      float lwf[8];
      unpack8(R.lw, lwf);
#pragma unroll
      for (int j = 0; j < 8; ++j) { lw8[j] = -0.6065306597126334f * sigmoidf_(lwf[j]); lp8[j] = lw8[j]; }
#pragma unroll
      for (int off = 8; off < 64; off <<= 1) {
#pragma unroll
        for (int j = 0; j < 8; ++j) {
#ifdef CPU_EMU
          float o = emu_shfl_up(lp8[j], off);
#else
          float o = __shfl_up(lp8[j], off, 64);
#endif
          if (lane >= off) lp8[j] += o;
        }
      }
      if (lane >= 56) {
#pragma unroll
        for (int j = 0; j < 8; ++j) sLP[wave * 64 + c0 + j] = lp8[j];
      }
      if ((tid & 7) == 0) sRow[t] = R.row;
    }
    __syncthreads();
    {
#pragma unroll
      for (int j = 0; j < 8; ++j) {
        float offs = 0.f;
        for (int w2 = 0; w2 < wave; ++w2) offs += sLP[w2 * 64 + c0 + j];
        lp8[j] += offs;
      }
      if (t == 31) {
#pragma unroll
        for (int j = 0; j < 8; ++j) sPT[c0 + j] = fexp(lp8[j]);
      }
    }
    {
      float xs[8], xn[8], kt[8], aa[8], ob[8], ok[8];
      unpack8(R.ks, xs); unpack8(R.kn, xn);
      float ss = 0.f;
#pragma unroll
      for (int j = 0; j < 8; ++j) { kt[j] = xs[j] + muK[j] * (xn[j] - xs[j]); aa[j] = kt[j] * kkw[j]; ss += aa[j] * aa[j]; }
      ss = sum8(ss);
      const float rn = frsq(ss + 1e-12f);
      float laf[8];
      unpack8(R.la, laf);
#pragma unroll
      for (int j = 0; j < 8; ++j) {
        const float lp = lp8[j];
        const float lpm = lp8[j] - lw8[j];
        const float e = fexp(-lp);
        const float kkn = aa[j] * rn;
        const float asg = sigmoidf_(laf[j]);
        aa[j] = -kkn * fexp(lpm);
        ob[j] = kkn * asg * e;
        ok[j] = kt[j] * (1.f + (asg - 1.f) * kaw[j]) * e;
      }
      *(u32x4*)(sAt + t * 72 + c0) = pack8(aa);
      *(u32x4*)(sBt + t * 72 + c0) = pack8(ob);
      *(u32x4*)(sKt + t * 72 + c0) = pack8(ok);
#pragma unroll
      for (int j = 0; j < 8; ++j) { sBT[(c0 + j) * 40 + t] = f2bf(ob[j]); sKT[(c0 + j) * 40 + t] = f2bf(ok[j]); }
      unpack8(R.vs, xs); unpack8(R.vn, xn);
#pragma unroll
      for (int j = 0; j < 8; ++j) sVT[(c0 + j) * 40 + t] = f2bf(xs[j] + muV[j] * (xn[j] - xs[j]));
      if (FULL) {
        unpack8(R.rs, xs); unpack8(R.rn, xn);
#pragma unroll
        for (int j = 0; j < 8; ++j) xs[j] = (xs[j] + muR[j] * (xn[j] - xs[j])) * fexp(lp8[j]);
        *(u32x4*)(sRt + t * 72 + c0) = pack8(xs);
      }
    }
    if (cc + 1 < cc1) rwkv_load_raw(proj, lora, b, h, d, cc + 1, t, c0, R);
    __syncthreads();
    if (FULL || wave < 2) {
      const bf16_t* Asrc = wave < 2 ? sAt : sRt;
      const bf16_t* Bsrc = (wave & 1) ? sKt : sBt;
      f32x16 acc;
#pragma unroll
      for (int r = 0; r < 16; ++r) acc[r] = 0.f;
#pragma unroll
      for (int kk = 0; kk < 4; ++kk) {
        bf16x8 a = *(const bf16x8*)(Asrc + l31 * 72 + kk * 16 + 8 * hl);
        bf16x8 bb = *(const bf16x8*)(Bsrc + l31 * 72 + kk * 16 + 8 * hl);
        acc = mfma32(a, bb, acc);
      }
      bf16_t* dst = wave == 1 ? sLak : (wave == 2 ? sLrb : sLrk);
#pragma unroll
      for (int r = 0; r < 16; ++r) {
        int tt = acc_row(r, lane), j = l31;
        bool keep = wave < 2 ? (j < tt) : (j <= tt);
        float v = keep ? acc[r] : 0.f;
        if (wave == 0) sLab[tt * 33 + j] = v;
        else dst[tt * 40 + j] = f2bf(v);
      }
    }
    __syncthreads();
    if (tid < 32) {
      const int q = tid >> 4, c = tid & 15;
      float x[16];
#pragma unroll
      for (int i = 0; i < 16; ++i) {
        float sacc = (i == c) ? 1.f : 0.f;
#pragma unroll
        for (int j = 0; j < i; ++j) sacc += sLab[(q * 16 + i) * 33 + q * 16 + j] * x[j];
        x[i] = sacc;
        sD[q * 256 + i * 16 + c] = sacc;
      }
    }
    __syncthreads();
    {
      const int i = tid >> 4, c = tid & 15;
      float sacc = 0.f;
#pragma unroll
      for (int j = 0; j < 16; ++j) sacc += sLab[(16 + i) * 33 + j] * sD[j * 16 + c];
      sD[512 + i * 16 + c] = sacc;
    }
    __syncthreads();
    {
      const int i = tid >> 4, c = tid & 15;
      float sacc = 0.f;
#pragma unroll
      for (int j = 0; j < 16; ++j) sacc += sD[256 + i * 16 + j] * sD[512 + j * 16 + c];
      sM[(16 + i) * 40 + c] = f2bf(sacc);
      sM[i * 40 + c] = f2bf(sD[i * 16 + c]);
      sM[(16 + i) * 40 + 16 + c] = f2bf(sD[256 + i * 16 + c]);
      sM[i * 40 + 16 + c] = 0;
    }
    if (wave < NVB) {
      const int vb = wave;
      f32x16 acc;
#pragma unroll
      for (int r = 0; r < 16; ++r) acc[r] = 0.f;
#pragma unroll
      for (int kk = 0; kk < 4; ++kk) {
        bf16x8 a = *(const bf16x8*)(sAt + l31 * 72 + kk * 16 + 8 * hl);
        bf16x8 bb = *(const bf16x8*)(sZ + (vb * 32 + l31) * 72 + kk * 16 + 8 * hl);
        acc = mfma32(a, bb, acc);
      }
      if (vb < 2) {
#pragma unroll
        for (int kk = 0; kk < 2; ++kk) {
          bf16x8 a = *(const bf16x8*)(sLak + l31 * 40 + kk * 16 + 8 * hl);
          bf16x8 bb = *(const bf16x8*)(sVT + (vb * 32 + l31) * 40 + kk * 16 + 8 * hl);
          acc = mfma32(a, bb, acc);
        }
      }
#pragma unroll
      for (int g = 0; g < 4; ++g) {
        u32x2 pk; pk.x = pack2(acc[4 * g], acc[4 * g + 1]); pk.y = pack2(acc[4 * g + 2], acc[4 * g + 3]);
        *(u32x2*)(sRT + (vb * 32 + l31) * 40 + 8 * g + 4 * hl) = pk;
      }
    }
    __syncthreads();
    if (wave < NVB) {
      const int vb = wave;
      f32x16 acc;
#pragma unroll
      for (int r = 0; r < 16; ++r) acc[r] = 0.f;
#pragma unroll
      for (int kk = 0; kk < 2; ++kk) {
        bf16x8 a = *(const bf16x8*)(sM + l31 * 40 + kk * 16 + 8 * hl);
        bf16x8 bb = *(const bf16x8*)(sRT + (vb * 32 + l31) * 40 + kk * 16 + 8 * hl);
        acc = mfma32(a, bb, acc);
      }
#pragma unroll
      for (int g = 0; g < 4; ++g) {
        u32x2 pk; pk.x = pack2(acc[4 * g], acc[4 * g + 1]); pk.y = pack2(acc[4 * g + 2], acc[4 * g + 3]);
        *(u32x2*)(sSAT + (vb * 32 + l31) * 40 + 8 * g + 4 * hl) = pk;
      }
    }
    __syncthreads();
    if (FULL) {
      if (wave < 2) {
        const int vb = wave;
        f32x16 acc;
#pragma unroll
        for (int r = 0; r < 16; ++r) acc[r] = 0.f;
#pragma unroll
        for (int kk = 0; kk < 4; ++kk) {
          bf16x8 a = *(const bf16x8*)(sZ + (vb * 32 + l31) * 72 + kk * 16 + 8 * hl);
          bf16x8 bb = *(const bf16x8*)(sRt + l31 * 72 + kk * 16 + 8 * hl);
          acc = mfma32(a, bb, acc);
        }
#pragma unroll
        for (int kk = 0; kk < 2; ++kk) {
          bf16x8 a = *(const bf16x8*)(sSAT + (vb * 32 + l31) * 40 + kk * 16 + 8 * hl);
          bf16x8 bb = *(const bf16x8*)(sLrb + l31 * 40 + kk * 16 + 8 * hl);
          acc = mfma32(a, bb, acc);
        }
#pragma unroll
        for (int kk = 0; kk < 2; ++kk) {
          bf16x8 a = *(const bf16x8*)(sVT + (vb * 32 + l31) * 40 + kk * 16 + 8 * hl);
          bf16x8 bb = *(const bf16x8*)(sLrk + l31 * 40 + kk * 16 + 8 * hl);
          acc = mfma32(a, bb, acc);
        }
        {
          const size_t obase = (size_t)sRow[l31] * 1024 + d * 512 + h * 64 + vb * 32;
#pragma unroll
          for (int g = 0; g < 4; ++g) {
            u32x2 pk; pk.x = pack2(acc[4 * g], acc[4 * g + 1]); pk.y = pack2(acc[4 * g + 2], acc[4 * g + 3]);
            *(u32x2*)(yout + obase + 8 * g + 4 * hl) = pk;
          }
        }
      } else {
        const int cb = wave - 2;
#pragma unroll
        for (int vb = 0; vb < 2; ++vb) {
          f32x16 acc;
#pragma unroll
          for (int r = 0; r < 16; ++r) acc[r] = 0.f;
#pragma unroll
          for (int kk = 0; kk < 2; ++kk) {
            bf16x8 a = *(const bf16x8*)(sBT + (cb * 32 + l31) * 40 + kk * 16 + 8 * hl);
            bf16x8 bb = *(const bf16x8*)(sSAT + (vb * 32 + l31) * 40 + kk * 16 + 8 * hl);
            acc = mfma32(a, bb, acc);
          }
#pragma unroll
          for (int kk = 0; kk < 2; ++kk) {
            bf16x8 a = *(const bf16x8*)(sKT + (cb * 32 + l31) * 40 + kk * 16 + 8 * hl);
            bf16x8 bb = *(const bf16x8*)(sVT + (vb * 32 + l31) * 40 + kk * 16 + 8 * hl);
            acc = mfma32(a, bb, acc);
          }
#pragma unroll
          for (int r = 0; r < 16; ++r) Zm[vb][r] = sPT[cb * 32 + acc_row(r, lane)] * (Zm[vb][r] + acc[r]);
        }
      }
      __syncthreads();
      if (wave >= 2) {
        const int cb = wave - 2;
#pragma unroll
        for (int vb = 0; vb < 2; ++vb)
#pragma unroll
          for (int g = 0; g < 4; ++g) {
            u32x2 pk; pk.x = pack2(Zm[vb][4 * g], Zm[vb][4 * g + 1]); pk.y = pack2(Zm[vb][4 * g + 2], Zm[vb][4 * g + 3]);
            *(u32x2*)(sZ + (vb * 32 + l31) * 72 + cb * 32 + 8 * g + 4 * hl) = pk;
          }
      }
    } else {
      const int vb = wave;
#pragma unroll
      for (int cb = 0; cb < 2; ++cb) {
        f32x16 acc;
#pragma unroll
        for (int r = 0; r < 16; ++r) acc[r] = 0.f;
#pragma unroll
        for (int kk = 0; kk < 2; ++kk) {
          bf16x8 a = *(const bf16x8*)(sBT + (cb * 32 + l31) * 40 + kk * 16 + 8 * hl);
          bf16x8 bb = *(const bf16x8*)(sSAT + (vb * 32 + l31) * 40 + kk * 16 + 8 * hl);
          acc = mfma32(a, bb, acc);
        }
        if (vb < 2) {
#pragma unroll
          for (int kk = 0; kk < 2; ++kk) {
            bf16x8 a = *(const bf16x8*)(sKT + (cb * 32 + l31) * 40 + kk * 16 + 8 * hl);
            bf16x8 bb = *(const bf16x8*)(sVT + (vb * 32 + l31) * 40 + kk * 16 + 8 * hl);
            acc = mfma32(a, bb, acc);
          }
        }
#pragma unroll
        for (int r = 0; r < 16; ++r) Zm[cb][r] = sPT[cb * 32 + acc_row(r, lane)] * (Zm[cb][r] + acc[r]);
      }
#pragma unroll
      for (int cb = 0; cb < 2; ++cb)
#pragma unroll
        for (int g = 0; g < 4; ++g) {
          u32x2 pk; pk.x = pack2(Zm[cb][4 * g], Zm[cb][4 * g + 1]); pk.y = pack2(Zm[cb][4 * g + 2], Zm[cb][4 * g + 3]);
          *(u32x2*)(sZ + (vb * 32 + l31) * 72 + cb * 32 + 8 * g + 4 * hl) = pk;
        }
    }
  }
  if (!FULL) {
    float* Zs = segZ + ((size_t)sid * RW_NSEG + seg) * 64 * 128;
#pragma unroll
    for (int cb = 0; cb < 2; ++cb)
#pragma unroll
      for (int r = 0; r < 16; ++r) Zs[(cb * 32 + acc_row(r, lane)) * 128 + wave * 32 + l31] = Zm[cb][r];
  }
}

constexpr int LRU_NCH = (CTXL + SEQ) / 64;
constexpr size_t OFF_ACUM0 = OFF_PU;
static_assert((size_t)NLAT * 512 * 2 <= (size_t)2 * NEXP * 1024, "acum0");

struct LruRaw { u32x4 x[2][4]; };
DEV void lru_load_raw(const Params& P, int sid, int cc, LruRaw& R) {
  constexpr int NC_CTX = CTXL / 64;
  const int tid = threadIdx.x;
  const int d = sid & 1, blk = (sid >> 1) & 7, b = sid >> 4;
  const bf16_t* proj = (const bf16_t*)(P.ws + OFF_PROJ);
  const int sgi = cc >= NC_CTX;
  const int row0 = sgi ? NCTX + b * SEQ : b * CTXL;
  const int len = sgi ? SEQ : CTXL;
  const int cl = (sgi ? cc - NC_CTX : cc) * 64;
  const int lch = blk * 64 + (tid & 7) * 8;
  const u32x4 z4 = {0u, 0u, 0u, 0u};
#pragma unroll
  for (int i = 0; i < 2; ++i) {
    int c = tid + i * 256, r = c >> 3;
    int p = cl + r, pos = d ? len - 1 - p : p;
#pragma unroll
    for (int tap = 0; tap < 4; ++tap) {
      int pp = pos + tap - 2;
      R.x[i][tap] = (pp >= 0 && pp < len) ? *(const u32x4*)(proj + (size_t)(row0 + pp) * ODC + 2304 + lch) : z4;
    }
  }
}

DEV void st_lru_chunk(const Params& P, int sid, int cc, int nsid, int ncc, bool has_next, LruRaw& R, unsigned char* smem) {
  constexpr int NC_CTX = CTXL / 64;
  const int tid = threadIdx.x, lane = tid & 63, wave = tid >> 6;
  const int d = sid & 1, blk = (sid >> 1) & 7, b = sid >> 4;
  float* sXc = (float*)smem;
  float* sAc = sXc + 4096;
  float* sBc = sAc + 4096;
  float* sU = sBc + 4096;
  bf16_t* sAop = (bf16_t*)(sU + 4096);
  float* sQA = (float*)(sAop + 64 * 72);
  float* sQH = sQA + 256;
  int* sRow = (int*)(sQH + 256);
  const bf16_t* proj = (const bf16_t*)(P.ws + OFF_PROJ);
  bf16_t* uout = (bf16_t*)(P.ws + OFF_LORA) + (size_t)d * NTOK * 512;
  bf16_t* aout = (bf16_t*)(P.ws + (d ? OFF_ACUM1 : OFF_ACUM0));
  const bf16_t* lruT = (const bf16_t*)(P.ws + OFF_LRUT) + (size_t)(d * 8 + blk) * 128 * 64;
  float* chunkS = (float*)(P.ws + OFF_LRUCS) + ((size_t)sid * LRU_NCH + cc) * 128;
  const float* cw = P.in[I_LCONVW];
  const float* cb = P.in[I_LCONVB];
  const int tr = (wave >> 1) * 32, nc0 = (wave & 1) * 64;
  const int sgi = cc >= NC_CTX;
  const int row0 = sgi ? NCTX + b * SEQ : b * CTXL;
  const int len = sgi ? SEQ : CTXL;
  const int cl = (sgi ? cc - NC_CTX : cc) * 64;
  __syncthreads();
  if (tid < 64) { int p = cl + tid; sRow[tid] = row0 + (d ? len - 1 - p : p); }
  {
    const int lc8 = (tid & 7) * 8, lch = blk * 64 + lc8;
#pragma unroll
    for (int i = 0; i < 2; ++i) {
      int c = tid + i * 256, r = c >> 3;
      int p = cl + r, pos = d ? len - 1 - p : p;
      float o[8];
      f32x4 c0 = *(const f32x4*)(cb + lch), c1 = *(const f32x4*)(cb + lch + 4);
      o[0] = c0.x; o[1] = c0.y; o[2] = c0.z; o[3] = c0.w; o[4] = c1.x; o[5] = c1.y; o[6] = c1.z; o[7] = c1.w;
#pragma unroll
      for (int tap = 0; tap < 4; ++tap) {
        float x[8];
        unpack8(R.x[i][tap], x);
        f32x4 w0 = *(const f32x4*)(cw + tap * 512 + lch), w1 = *(const f32x4*)(cw + tap * 512 + lch + 4);
        o[0] += w0.x * x[0]; o[1] += w0.y * x[1]; o[2] += w0.z * x[2]; o[3] += w0.w * x[3];
        o[4] += w1.x * x[4]; o[5] += w1.y * x[5]; o[6] += w1.z * x[6]; o[7] += w1.w * x[7];
      }
#pragma unroll
      for (int j = 0; j < 8; ++j) sXc[r * 64 + lc8 + j] = o[j];
      *(u32x4*)(sAop + r * 72 + lc8) = pack8(o);
    }
  }
  if (has_next) lru_load_raw(P, nsid, ncc, R);
  __syncthreads();
  {
    f32x16 acc[2];
#pragma unroll
    for (int j = 0; j < 2; ++j)
#pragma unroll
      for (int r = 0; r < 16; ++r) acc[j][r] = 0.f;
#pragma unroll
    for (int kk = 0; kk < 4; ++kk) {
      bf16x8 a = *(const bf16x8*)(sAop + (tr + (lane & 31)) * 72 + kk * 16 + 8 * (lane >> 5));
#pragma unroll
      for (int j = 0; j < 2; ++j) {
        bf16x8 bb = *(const bf16x8*)(lruT + (nc0 + j * 32 + (lane & 31)) * 64 + kk * 16 + 8 * (lane >> 5));
        acc[j] = mfma32(a, bb, acc[j]);
      }
    }
#pragma unroll
    for (int j = 0; j < 2; ++j) {
      const int e = nc0 + j * 32 + (lane & 31);
      const int ch = blk * 64 + (e & 63);
      const float ebias = e < 64 ? P.in[I_BA][d * 512 + ch] : P.in[I_BI][d * 512 + ch];
      const float esp = softplusf_(-P.in[I_LAM][d * 512 + ch]);
#pragma unroll
      for (int r = 0; r < 16; ++r) {
        int t = tr + acc_row(r, lane);
        float g = sigmoidf_(acc[j][r] + ebias);
        if (e < 64) { float a_ = fexp(-8.f * g * esp); sAc[t * 64 + e] = a_; sU[t * 64 + e] = fsqrt(fmaxf(1.f - a_ * a_, 0.f)); }
        else sBc[t * 64 + (e - 64)] = g * sXc[t * 64 + (e - 64)];
      }
    }
  }
  __syncthreads();
  const int c = tid & 63, q = tid >> 6;
  {
    float h = 0.f, ap = 1.f;
#pragma unroll 4
    for (int i = 0; i < 16; ++i) {
      const int t = q * 16 + i;
      const float a = sAc[t * 64 + c];
      h = a * h + sU[t * 64 + c] * sBc[t * 64 + c];
      ap *= a;
      sU[t * 64 + c] = h; sAc[t * 64 + c] = ap;
    }
    sQA[q * 64 + c] = ap; sQH[q * 64 + c] = h;
  }
  __syncthreads();
  {
    float hin = 0.f, ain = 1.f;
    for (int q2 = 0; q2 < q; ++q2) { hin = sQA[q2 * 64 + c] * hin + sQH[q2 * 64 + c]; ain *= sQA[q2 * 64 + c]; }
    if (q > 0) {
#pragma unroll 4
      for (int i = 0; i < 16; ++i) {
        const int t = q * 16 + i;
        const float ap = sAc[t * 64 + c];
        sU[t * 64 + c] += ap * hin;
        sAc[t * 64 + c] = ap * ain;
      }
    }
    if (q == 3) { chunkS[c] = sAc[63 * 64 + c]; chunkS[64 + c] = sU[63 * 64 + c]; }
  }
  __syncthreads();
  if (sgi) {
#pragma unroll
    for (int i = 0; i < 2; ++i) {
      int cidx = tid + i * 256, r = cidx >> 3, c8 = (cidx & 7) * 8;
      float u8[8], a8[8];
#pragma unroll
      for (int j = 0; j < 8; ++j) { u8[j] = sU[r * 64 + c8 + j]; a8[j] = sAc[r * 64 + c8 + j]; }
      const int row = sRow[r];
      *(u32x4*)(uout + (size_t)row * 512 + blk * 64 + c8) = pack8(u8);
      *(u32x4*)(aout + (size_t)(row - NCTX) * 512 + blk * 64 + c8) = pack8(a8);
    }
  }
}

DEV void st_lru_carry(const Params& P, int sid) {
  const int c = threadIdx.x;
  if (c >= 64) return;
  const float* cs = (const float*)(P.ws + OFF_LRUCS) + (size_t)sid * LRU_NCH * 128;
  float* hs = (float*)(P.ws + OFF_LRUHS) + (size_t)sid * LRU_NCH * 64;
  float h = 0.f;
  for (int cc0 = 0; cc0 < LRU_NCH; cc0 += 10) {
    float a[10], bb[10];
#pragma unroll
    for (int i = 0; i < 10; ++i) { a[i] = cs[(size_t)(cc0 + i) * 128 + c]; bb[i] = cs[(size_t)(cc0 + i) * 128 + 64 + c]; }
#pragma unroll
    for (int i = 0; i < 10; ++i) { hs[(size_t)(cc0 + i) * 64 + c] = h; h = a[i] * h + bb[i]; }
  }
}

DEV void st_finish_l1(const Params& P, int row) {
  const int lane = threadIdx.x & 63;
  bf16_t* hb = (bf16_t*)(P.ws + OFF_HBUF) + (size_t)row * 1024;
  const bf16_t* proj = (const bf16_t*)(P.ws + OFF_PROJ);
  const bf16_t* lora = (const bf16_t*)(P.ws + OFF_LORA);
  const float* mu = P.in[I_MU];
  const int ch = lane * 8;
  float y0[8], y1[8];
  unpack8(*(const u32x4*)(hb + ch), y0);
  unpack8(*(const u32x4*)(hb + 512 + ch), y1);
  float sm = 0.f;
#pragma unroll
  for (int j = 0; j < 8; ++j) { y0[j] += y1[j]; sm += y0[j]; }
  sm = sum8(sm);
  const float mean = sm * (1.f / 64.f);
  float sv = 0.f;
#pragma unroll
  for (int j = 0; j < 8; ++j) { float dlt = y0[j] - mean; sv += dlt * dlt; }
  sv = sum8(sv);
  const float rstd = frsq(sv * (1.f / 64.f) + 64e-5f);
  float a0[8], a1[8], g[8], u0[8], u1[8], gb[8];
  unpack8(*(const u32x4*)(lora + ((size_t)2 * NTOK + row) * 512 + ch), a0);
  unpack8(*(const u32x4*)(lora + ((size_t)3 * NTOK + row) * 512 + ch), a1);
  unpack8(*(const u32x4*)(lora + ((size_t)4 * NTOK + row) * 512 + ch), g);
  unpack8(*(const u32x4*)(lora + ((size_t)0 * NTOK + row) * 512 + ch), u0);
  unpack8(*(const u32x4*)(lora + ((size_t)1 * NTOK + row) * 512 + ch), u1);
  if (row >= NCTX) {
    const int bb_ = (row - NCTX) / SEQ, pos = (row - NCTX) % SEQ, blk = ch >> 6;
    float ac[8];
#pragma unroll
    for (int dd = 0; dd < 2; ++dd) {
      const int pidx = dd ? SEQ - 1 - pos : pos;
      const int cc = CTXL / 64 + pidx / 64;
      const int sid = (bb_ * 8 + blk) * 2 + dd;
      const float* hs = (const float*)(P.ws + OFF_LRUHS) + ((size_t)sid * LRU_NCH + cc) * 64 + (ch & 63);
      unpack8(*(const u32x4*)((const bf16_t*)(P.ws + (dd ? OFF_ACUM1 : OFF_ACUM0)) + (size_t)(row - NCTX) * 512 + ch), ac);
      f32x4 h0 = *(const f32x4*)hs, h1 = *(const f32x4*)(hs + 4);
      float* u = dd ? u1 : u0;
      u[0] += ac[0] * h0.x; u[1] += ac[1] * h0.y; u[2] += ac[2] * h0.z; u[3] += ac[3] * h0.w;
      u[4] += ac[4] * h1.x; u[5] += ac[5] * h1.y; u[6] += ac[6] * h1.z; u[7] += ac[7] * h1.w;
    }
  }
  unpack8(*(const u32x4*)(proj + (size_t)row * ODC + 1792 + ch), gb);
  float rv[8], vv[8], kv[8];
  float sdot = 0.f;
  float pka[8], prk[8], plw[8], plb[8];
  ld8(P.in[I_KA] + ch, pka); ld8(P.in[I_RK] + ch, prk); ld8(P.in[I_LNW] + ch, plw); ld8(P.in[I_LNB] + ch, plb);
  mix8(proj, row, ch, mu, rv);
  mix8(proj, row, 512 + ch, mu, kv);
  mix8(proj, row, 1024 + ch, mu, vv);
#pragma unroll
  for (int j = 0; j < 8; ++j) {
    float r = rv[j];
    float k = kv[j];
    float am = 0.5f * (sigmoidf_(a0[j]) + sigmoidf_(a1[j]));
    float kb = k * (1.f + (am - 1.f) * pka[j]);
    sdot += r * kb * prk[j];
    rv[j] = r;
  }
  sdot = sum8(sdot);
  float f1[8], f2[8];
#pragma unroll
  for (int j = 0; j < 8; ++j) {
    float yn = (y0[j] - mean) * rstd * plw[j] + plb[j];
    yn += sdot * vv[j];
    f1[j] = yn * g[j];
    f2[j] = (u0[j] + u1[j]) * geluf_(gb[j]);
  }
  *(u32x4*)(hb + ch) = pack8(f1);
  *(u32x4*)(hb + 512 + ch) = pack8(f2);
}

DEV unsigned fkey(float f) { unsigned u; __builtin_memcpy(&u, &f, 4); return (u >> 31) ? ~u : (u | 0x80000000u); }
DEV float keyf(unsigned u) { u = (u >> 31) ? (u & 0x7fffffffu) : ~u; float f; __builtin_memcpy(&f, &u, 4); return f; }
DEV void key_insert(unsigned x, unsigned* v) {
#pragma unroll
  for (int j = 0; j < 16; ++j) { unsigned hi = v[j] > x ? v[j] : x; x = v[j] > x ? x : v[j]; v[j] = hi; }
}
DEV void key_cx(unsigned& hi, unsigned& lo) { unsigned a = hi, b = lo; hi = a > b ? a : b; lo = a > b ? b : a; }
DEV void key_sort16(unsigned* v) {
#pragma unroll
  for (int k = 2; k <= 16; k <<= 1)
#pragma unroll
    for (int j = k >> 1; j > 0; j >>= 1)
#pragma unroll
      for (int i = 0; i < 16; ++i) {
        const int l = i ^ j;
        if (l > i) { if ((i & k) == 0) key_cx(v[i], v[l]); else key_cx(v[l], v[i]); }
      }
}
DEV void key_merge16(unsigned* a, const unsigned* b) {
#pragma unroll
  for (int i = 0; i < 16; ++i) a[i] = a[i] > b[15 - i] ? a[i] : b[15 - i];
#pragma unroll
  for (int j = 8; j > 0; j >>= 1)
#pragma unroll
    for (int i = 0; i < 16; ++i) { const int l = i ^ j; if (l > i) key_cx(a[i], a[l]); }
}

DEV void st_peer_topk(const Params& P, int layer, int tile, int h, unsigned char* smem) {
  const int tid = threadIdx.x;
  const bf16_t* q = (const bf16_t*)(P.ws + OFF_Q);
  const bf16_t* keys = (const bf16_t*)(P.ws + OFF_KEYS) + (size_t)(layer * 8 + h) * 2 * 128 * 128;
  float* sS = (float*)smem;
  const int m0 = tile * 128;
  const int tok = tid & 127, half = tid >> 7;
  unsigned kl[2][16];
#pragma unroll
  for (int p = 0; p < 2; ++p) {
    EpiScoreLds epi{sS, m0};
    gemm_tile_128<true>(q + (h * 2 + p) * 128, 2048, NTOK, keys + p * 128 * 128, 128, 128, 128, m0, 0, epi, smem);
    __syncthreads();
    float* row = sS + tok * 129 + half * 64;
#pragma unroll
    for (int g = 0; g < 4; ++g) {
      unsigned grp[16];
#pragma unroll
      for (int j = 0; j < 16; ++j) grp[j] = (fkey(row[g * 16 + j]) & ~127u) | (unsigned)(127 - (half * 64 + g * 16 + j));
      key_sort16(grp);
      if (g == 0) {
#pragma unroll
        for (int j = 0; j < 16; ++j) kl[p][j] = grp[j];
      } else key_merge16(kl[p], grp);
    }
    if (half == 1) {
#pragma unroll
      for (int j = 0; j < 16; ++j) row[j] = __builtin_bit_cast(float, kl[p][j]);
    }
    __syncthreads();
    if (half == 0) {
      unsigned oth[16];
#pragma unroll
      for (int j = 0; j < 16; ++j) oth[j] = __builtin_bit_cast(unsigned, sS[tok * 129 + 64 + j]);
      key_merge16(kl[p], oth);
    }
    __syncthreads();
  }
  if (tid < 128) {
    float sv0[16], sv1[16];
    int* irow = (int*)(sS + tid * 129);
#pragma unroll
    for (int j = 0; j < 16; ++j) {
      sv0[j] = keyf((kl[0][j] & ~127u) | 64u); sv1[j] = keyf((kl[1][j] & ~127u) | 64u);
      irow[j] = 127 - (int)(kl[0][j] & 127u); irow[16 + j] = 127 - (int)(kl[1][j] & 127u);
    }
    unsigned best[16];
#pragma unroll
    for (int j = 0; j < 16; ++j) best[j] = 0u;
#pragma unroll
    for (int i = 0; i < 16; ++i)
#pragma unroll
      for (int j = 0; j < 16; ++j)
        if ((i + 1) * (j + 1) <= 16) key_insert((fkey(sv0[i] + sv1[j]) & ~255u) | (unsigned)(255 - (i * 16 + j)), best);
    float e[16], sum = 0.f;
    const float b0 = keyf((best[0] & ~255u) | 128u);
#pragma unroll
    for (int j = 0; j < 16; ++j) { e[j] = fexp(keyf((best[j] & ~255u) | 128u) - b0); sum += e[j]; }
    const float inv = 1.f / sum;
    int* pidx = (int*)(P.ws + OFF_PIDX) + (size_t)(m0 + tid) * 128 + h * 16;
    float* pg = (float*)(P.ws + OFF_PGATE) + (size_t)(m0 + tid) * 128 + h * 16;
#pragma unroll
    for (int j = 0; j < 16; ++j) {
      const int pos = 255 - (int)(best[j] & 255u);
      pidx[j] = irow[pos >> 4] * 128 + irow[16 + (pos & 15)];
      pg[j] = e[j] * inv;
    }
  }
}

DEV void st_peer_experts(const Params& P, int layer, int row) {
  const int lane = threadIdx.x & 63;
  const bf16_t* xb = (const bf16_t*)(P.ws + OFF_HBUF) + (size_t)row * 1024;
  const unsigned char* U = P.ws + OFF_PU;
  const int* pidx = (const int*)(P.ws + OFF_PIDX) + (size_t)row * 128;
  const float* pg = (const float*)(P.ws + OFF_PGATE) + (size_t)row * 128;
  float x[16], acc[16];
  unpack8(*(const u32x4*)(xb + lane * 16), x);
  unpack8(*(const u32x4*)(xb + lane * 16 + 8), x + 8);
#pragma unroll
  for (int j = 0; j < 16; ++j) acc[j] = 0.f;
  const int b3 = (lane >> 3) & 1;
  const int mypick = (lane >> 3) & 7;
  for (int k0 = 0; k0 < 128; k0 += 8) {
    u32x3 uu[8]; u32x2 vv[8];
#pragma unroll
    for (int i = 0; i < 8; ++i) {
      const unsigned char* er = U + (size_t)pidx[k0 + i] * PEER_ROWB;
      const unsigned* up = (const unsigned*)(er + lane * 12);
      uu[i].x = up[0]; uu[i].y = up[1]; uu[i].z = up[2];
      vv[i] = *(const u32x2*)(er + PEER_VOFF + lane * 8);
    }
    const float mygate = pg[k0 + mypick];
    float dsum[8];
#pragma unroll
    for (int i = 0; i < 8; i += 2) {
      float ufa[16], ufb[16];
#ifndef CPU_EMU
      __builtin_amdgcn_sched_barrier(0);
#endif
      unpack2x16_fp6(uu[i], uu[i + 1], ufa, ufb);
      typedef __attribute__((ext_vector_type(2))) float f32x2v;
      f32x2v da2 = {0.f, 0.f}, db2 = {0.f, 0.f};
#pragma unroll
      for (int j = 0; j < 8; ++j) {
        const f32x2v xx = {x[2 * j], x[2 * j + 1]};
        const f32x2v ua = {ufa[2 * j], ufa[2 * j + 1]}, ub = {ufb[2 * j], ufb[2 * j + 1]};
        da2 = xx * ua + da2; db2 = xx * ub + db2;
      }
      dsum[i] = da2.x + da2.y; dsum[i + 1] = db2.x + db2.y;
    }
    float e4[4], e2[2], g;
#pragma unroll
    for (int i = 0; i < 4; ++i) e4[i] = swap32_sum(dsum[i], dsum[4 + i]);
#pragma unroll
    for (int i = 0; i < 2; ++i) e2[i] = swap16_sum(e4[i], e4[2 + i]);
    {
      float mine = b3 ? e2[1] : e2[0], send = b3 ? e2[0] : e2[1];
      g = mine + dpp_xor<8>(send);
    }
    g = sum8(g);
    const float mycoef = mygate * geluf_(g * (1.f / PEER_USCALE));
#pragma unroll
    for (int i = 0; i < 8; ++i) {
      const float coef = wreadlane(mycoef, i * 8);
      float vf[16];
      unpack8_fp4(vv[i].x, vf); unpack8_fp4(vv[i].y, vf + 8);
#pragma unroll
      for (int j = 0; j < 16; ++j) acc[j] += coef * vf[j];
    }
  }
  float* xr = row < NCTX ? (float*)(P.ws + OFF_CTXRES) + (size_t)row * 1024 : P.out + (size_t)(row - NCTX) * 1024;
  const float* g2 = (const float*)(P.ws + OFF_MODV) + ((size_t)layer * 3 + mod_row(row)) * 6144 + 5 * 1024;
  float o[16];
#pragma unroll
  for (int q = 0; q < 4; ++q) {
    const int c = lane * 16 + q * 4;
    f32x4 a = *(const f32x4*)(xr + c), ga = *(const f32x4*)(g2 + c);
    o[q * 4 + 0] = a.x + ga.x * acc[q * 4 + 0] * (1.f / PEER_VSCALE); o[q * 4 + 1] = a.y + ga.y * acc[q * 4 + 1] * (1.f / PEER_VSCALE);
    o[q * 4 + 2] = a.z + ga.z * acc[q * 4 + 2] * (1.f / PEER_VSCALE); o[q * 4 + 3] = a.w + ga.w * acc[q * 4 + 3] * (1.f / PEER_VSCALE);
  }
  float ss = 0.f;
#pragma unroll
  for (int j = 0; j < 16; ++j) ss += o[j] * o[j];
  ss = wave_sum(ss);
  const float rstd = frsq(ss * (1.f / 1024.f) + 1e-6f);
  if (layer == 1) {
    float fn[16]; ld8(P.in[I_FNORM] + lane * 16, fn); ld8(P.in[I_FNORM] + lane * 16 + 8, fn + 8);
#pragma unroll
    for (int j = 0; j < 16; ++j) o[j] *= rstd * fn[j];
  }
#pragma unroll
  for (int q = 0; q < 4; ++q) {
    f32x4 a = {o[q * 4 + 0], o[q * 4 + 1], o[q * 4 + 2], o[q * 4 + 3]};
    *(f32x4*)(xr + lane * 16 + q * 4) = a;
  }
  if (layer == 0) {
    const float* mv = (const float*)(P.ws + OFF_MODV) + ((size_t)1 * 3 + mod_row(row)) * 6144;
    const float* nw = P.in[I_NORM1] + 1024;
    float hh[16];
#pragma unroll
    for (int q = 0; q < 4; ++q) {
      const int c = lane * 16 + q * 4;
      f32x4 w4 = *(const f32x4*)(nw + c), s4 = *(const f32x4*)(mv + 1024 + c), h4 = *(const f32x4*)(mv + c);
      hh[q * 4 + 0] = o[q * 4 + 0] * rstd * w4.x * (1.f + s4.x) + h4.x; hh[q * 4 + 1] = o[q * 4 + 1] * rstd * w4.y * (1.f + s4.y) + h4.y;
      hh[q * 4 + 2] = o[q * 4 + 2] * rstd * w4.z * (1.f + s4.z) + h4.z; hh[q * 4 + 3] = o[q * 4 + 3] * rstd * w4.w * (1.f + s4.w) + h4.w;
    }
    bf16_t* hb = (bf16_t*)(P.ws + OFF_HBUF) + (size_t)row * 1024 + lane * 16;
    *(u32x4*)hb = pack8(hh);
    *(u32x4*)(hb + 8) = pack8(hh + 8);
  }
}


#define FOR_TILES_XCD(MT0, MT1, NT, mt, nt)                                                     \
  for (int _x = blockIdx.x & 7, _mlo = (MT0) + (((MT1) - (MT0)) * _x) / 8,                        \
           _mhi = (MT0) + (((MT1) - (MT0)) * (_x + 1)) / 8, _i = blockIdx.x >> 3,                 \
           _cnt = (_mhi - _mlo) * (NT), mt = 0, nt = 0;                                           \
       _i < _cnt && ((mt = _mlo + _i / (NT)), (nt = _i % (NT)), true); _i += (int)(gridDim.x >> 3))

#ifndef PHASE_LIST
#define PHASE_LIST(X) X(0) X(1) X(2) X(22) X(23) X(3) X(4) X(5) X(6) X(7) X(8) X(9) X(11) X(12) X(13) X(30) X(14) X(15) X(31) X(16) X(17) X(18) X(19) X(20) X(21)
#endif
constexpr int PH_LAST = 21;

template <int ph>
DEV void run_phase(const Params& P, unsigned char* smem) {
  int bid_ = blockIdx.x, wave_ = threadIdx.x >> 6;
  OPAQUE_S(bid_); OPAQUE(wave_);
  const int bid = bid_, nb = gridDim.x;
  const int wave = wave_;
  unsigned char* ws = P.ws;
  constexpr int layer = ((ph >= 10 && ph <= 21) || ph >= 30) ? 1 : 0;
  const float* modv_l = (const float*)(ws + OFF_MODV) + (size_t)layer * 3 * 6144;
  switch (ph) {
    case 0:
      for (int t = NTRANS + bid; t < NPREP; t += nb) st_prep(P, t, smem);
      break;
    case 1: case 10:
      if (ph == 1) for (int t = nb - 1 - bid; t < NTRANS; t += nb) st_prep(P, t, smem);
      for (int t = bid; t < NTOK / 4; t += nb) st_normmod(P, layer, 0, t * 4 + wave);
      break;
    case 2: {
      EpiProjL0T epi{(bf16_t*)(ws + OFF_PROJ), (float*)(ws + OFF_GATES)};
      FOR_TILES_XCD(0, NTOK / 256, 25, mt, nt)
        gemm_tile_128x256<EpiProjL0T, true>((const bf16_t*)(ws + OFF_WEVIN), 1024, EVC, (const bf16_t*)(ws + OFF_HBUF), 1024, NTOK, 1024,
                                            nt * 128, mt * 256, epi, smem);
    } break;
    case 22:
      for (int t = bid; t < NTOK / 4; t += nb) st_xbc_conv(P, t * 4 + wave);
      for (int t = bid; t < NPCONV; t += nb) st_peer_conv(P, 0, t);
      break;
    case 23:
      for (int t = bid; t < 48 * LA_NSEG; t += nb) {
        int sid = t % 48, seg = t / 48;
        if (sid < 16) st_linattn_seg<true, false>(P, sid, seg, smem);
        else st_linattn_seg<false, false>(P, sid - 16, seg, smem);
      }
      break;
    case 3:
      for (int t = bid; t < 48 * LA_NSEG; t += nb) {
        int sid = t % 48, seg = t / 48;
        if (sid < 16) st_linattn_seg<true, true>(P, sid, seg, smem);
        else st_linattn_seg<false, true>(P, sid - 16, seg, smem);
      }
      break;
    case 4:
      for (int t = bid; t < NTOK / 4; t += nb) st_finish_l0(P, t * 4 + wave);
      break;
    case 5: case 17: {
      EpiOutProjT epi{layer == 0 ? P.in[I_X] : P.out, P.in[I_CTX], P.out, (float*)(ws + OFF_CTXRES), modv_l};
      const bf16_t* Wt = (const bf16_t*)(ws + (layer == 0 ? OFF_WEVOUT : OFF_WODOUT));
      FOR_TILES_XCD(layer == 0 ? 0 : NCTX / 256, NTOK / 256, 8, mt, nt)
        gemm_tile_128x256<EpiOutProjT, true>(Wt, 1024, 1024, (const bf16_t*)(ws + OFF_HBUF), 1024, NTOK, 1024, nt * 128, mt * 256, epi, smem);
    } break;
    case 6: case 18: {
      const int r0 = layer == 0 ? 0 : NCTX / 4;
      for (int t = r0 + bid; t < NTOK / 4; t += nb) st_normmod(P, layer, 1, t * 4 + wave);
      if (ph == 18) for (int t = bid; t < NPCONV; t += nb) st_peer_conv(P, 1, t);
    } break;
    case 7: case 19: {
      EpiStoreBfT epi{(bf16_t*)(ws + OFF_Q), 2048};
      const bf16_t* Wt = (const bf16_t*)(ws + OFF_WQ) + (size_t)layer * 2048 * 1024;
      FOR_TILES_XCD(layer == 0 ? 0 : NCTX / 256, NTOK / 256, 16, mt, nt)
        gemm_tile_128x256<EpiStoreBfT, true>(Wt, 1024, 2048, (const bf16_t*)(ws + OFF_HBUF), 1024, NTOK, 1024, nt * 128, mt * 256, epi, smem);
    } break;
    case 8: case 20: {
      const int t0 = layer == 0 ? 0 : CTILE * 8;
      for (int t = t0 + bid; t < NTILE * 8; t += nb) st_peer_topk(P, layer, t / 8, t % 8, smem);
    } break;
    case 9: case 21: {
      const int r0 = layer == 0 ? 0 : NCTX / 4;
      for (int t = r0 + bid; t < NTOK / 4; t += nb) st_peer_experts(P, layer, t * 4 + wave);
    } break;
    case 11: {
      EpiStoreBfT epi{(bf16_t*)(ws + OFF_PROJ), ODC};
      FOR_TILES_XCD(0, NTOK / 256, 22, mt, nt)
        gemm_tile_128x256<EpiStoreBfT, true>((const bf16_t*)(ws + OFF_WODIN), 1024, ODC, (const bf16_t*)(ws + OFF_HBUF), 1024, NTOK, 1024,
                                             nt * 128, mt * 256, epi, smem);
    } break;
    case 12:
      for (int t = bid; t < NTOK / 8; t += nb) st_lora_act(P, t * 8 + wave * 2);
      break;
    case 13:
      for (int t = bid; t < NTILE * 20; t += nb) {
        int job = t / (NTILE * 4), tt = t % (NTILE * 4);
        int mt = tt / 4, nt = tt % 4;
        bf16_t* dst = (bf16_t*)(ws + OFF_LORA) + (size_t)job * NTOK * 512;
        const bf16_t* A = (const bf16_t*)(ws + OFF_HBUF) + (job < 2 ? 0 : (job < 4 ? 64 : 128));
        const bf16_t* Bt = job < 2 ? (const bf16_t*)(ws + OFF_WUP) + (size_t)job * 512 * 64
                         : job < 4 ? (const bf16_t*)(ws + OFF_AUP) + (size_t)(job - 2) * 512 * 64
                                   : (const bf16_t*)(ws + OFF_GUP);
        const float* bias = job < 2 ? P.in[I_W0] + job * 512 : (job < 4 ? P.in[I_A0] + (job - 2) * 512 : nullptr);
        const int K = job < 4 ? 64 : 128;
        EpiStoreBfBiasT epi{dst, 512, bias};
        gemm_tile_128<false, EpiStoreBfBiasT, true>(Bt, K, 512, A, 1024, NTOK, K, nt * 128, mt * 128, epi, smem);
      }
      break;
    case 30:
      for (int t = bid; t < 32 * RW_NSEG; t += nb) st_rwkv_seg<false>(P, t % 32, t / 32, smem);
      break;
    case 14:
      for (int t = bid; t < 32 * RW_NSEG; t += nb) st_rwkv_seg<true>(P, t % 32, t / 32, smem);
      break;
    case 15:
      {
        LruRaw R;
        if (bid < 32 * LRU_NCH) lru_load_raw(P, bid % 32, bid / 32, R);
        for (int t = bid; t < 32 * LRU_NCH; t += nb) {
          const int tn = t + nb;
          st_lru_chunk(P, t % 32, t / 32, tn % 32, tn / 32, tn < 32 * LRU_NCH, R, smem);
        }
      }
      break;
    case 31:
      if (bid < 32) st_lru_carry(P, bid);
      break;
    case 16:
      for (int t = bid; t < NTOK / 4; t += nb) st_finish_l1(P, t * 4 + wave);
      break;
    default: break;
  }
}


#ifndef CPU_EMU
#define XB_TMO      128
#define XB_XCNT(j)  (256  + 64 * (j))
#define XB_XSUB(j)  (1280 + 64 * (j))
#define XB_XGEN(j)  (2304 + 64 * (j))
#define XB_TOP      3328
#define XB_TOPGEN   3392
#define XCD_BAR_WORDS 3456
#define XB_SPIN_CAP (1u << 20)
#define LAS __attribute__((address_space(3)))
__device__ __forceinline__ unsigned xb_ld(unsigned* p)              { return __hip_atomic_load(p, __ATOMIC_RELAXED, __HIP_MEMORY_SCOPE_AGENT); }
__device__ __forceinline__ unsigned xb_add(unsigned* p, unsigned v) { return __hip_atomic_fetch_add(p, v, __ATOMIC_RELAXED, __HIP_MEMORY_SCOPE_AGENT); }
__device__ __forceinline__ unsigned xb_xcc_id() { return (unsigned)__builtin_amdgcn_s_getreg((3 << 11) | 20) & 0xFu; }
#define XB_SPIN(cond, bar) do { unsigned _sp = 0; while (cond) { __builtin_amdgcn_s_sleep(1); \
    if ((++_sp & 255u) == 0u) { if (xb_ld(&(bar)[XB_TMO])) break; if (_sp > XB_SPIN_CAP) { atomicAdd(&(bar)[XB_TMO], 1u); break; } } } } while (0)
struct XcdBarrier { unsigned* bar; unsigned x; volatile LAS unsigned* st; };
__device__ __forceinline__ XcdBarrier xcd_barrier_post(unsigned* bar, volatile LAS unsigned* st) {
  XcdBarrier b; b.bar = bar; b.x = xb_xcc_id(); b.st = st;
  if (threadIdx.x == 0) (void)xb_add(&bar[XB_XCNT(b.x)], 1u);
  return b;
}
__device__ __forceinline__ void xcd_barrier_complete(unsigned* bar, unsigned x, unsigned& nloc, unsigned& nx) {
  const unsigned G = gridDim.x * gridDim.y * gridDim.z;
  unsigned sum, cnt, mine, sp = 0u;
  for (;;) {
    sum = 0u; cnt = 0u; mine = 0u;
#pragma unroll
    for (unsigned j = 0; j < 16; ++j) { const unsigned c = xb_ld(&bar[XB_XCNT(j)]); sum += c; cnt += (c > 0u) ? 1u : 0u; mine = (j == x) ? c : mine; }
    if (sum == G) break;
    __builtin_amdgcn_s_sleep(1);
    if ((++sp & 255u) == 0u) { if (xb_ld(&bar[XB_TMO])) break; if (sp > XB_SPIN_CAP) { atomicAdd(&bar[XB_TMO], 1u); break; } }
  }
  nloc = mine > 0u ? mine : 1u; nx = cnt > 0u ? cnt : 1u;
}
__device__ __forceinline__ void xcd_barrier(const XcdBarrier& b) {
  asm volatile("s_waitcnt vmcnt(0)" ::: "memory");
  __syncthreads();
  if (threadIdx.x == 0) {
    unsigned* bar = b.bar;
    __builtin_amdgcn_s_waitcnt(0);
    unsigned nloc = b.st[0], nx = b.st[1];
    if (nloc == 0u) { xcd_barrier_complete(bar, b.x, nloc, nx); b.st[0] = nloc; b.st[1] = nx; }
    const unsigned old = xb_add(&bar[XB_XSUB(b.x)], 1u);
    const unsigned gen = old / nloc;
    if (old + 1u == (gen + 1u) * nloc) {
      __builtin_amdgcn_fence(__ATOMIC_RELEASE, "agent");
      asm volatile("s_waitcnt vmcnt(0)" ::: "memory");
      const unsigned og = xb_add(&bar[XB_TOP], 1u);
      const unsigned tg = og / nx;
      if (og + 1u == (tg + 1u) * nx) xb_add(&bar[XB_TOPGEN], 1u);
      else XB_SPIN(xb_ld(&bar[XB_TOPGEN]) == tg, bar);
      __builtin_amdgcn_fence(__ATOMIC_ACQUIRE, "agent");
      xb_add(&bar[XB_XGEN(b.x)], 1u);
      asm volatile("s_waitcnt vmcnt(0)" ::: "memory");
    } else {
      XB_SPIN(xb_ld(&bar[XB_XGEN(b.x)]) == gen, bar);
      __builtin_amdgcn_fence(__ATOMIC_ACQUIRE, "agent");
      asm volatile("s_waitcnt vmcnt(0)" ::: "memory");
    }
  }
  __syncthreads();
}
#endif
#ifndef CPU_EMU
#define RUN_PH(n) run_phase<n>(P, smem_raw); if (n != PH_LAST) xcd_barrier(xb);
__global__ void __launch_bounds__(256, 2) mega_kernel(Params P) {
  SMEM_DECL;
  unsigned* bar = (unsigned*)(P.ws + OFF_BAR);
  volatile LAS unsigned* st = (volatile LAS unsigned*)(smem_raw + SMEM_BYTES - 16);
  if (threadIdx.x == 0) { st[0] = 0u; st[1] = 0u; }
  if (P.ws == nullptr) cg::this_grid().sync();
  __syncthreads();
  XcdBarrier xb = xcd_barrier_post(bar, st);
  PHASE_LIST(RUN_PH)
}

extern "C" void kernel_launch(void* const* d_in, const int* in_sizes, int n_in, void* d_out, int out_size, void* d_ws,
                              size_t ws_size, hipStream_t stream) {
  Params P{};
  for (int i = 0; i < N_IN; ++i) P.in[i] = (const float*)d_in[i];
  P.out = (float*)d_out;
  P.ws = (unsigned char*)d_ws;
  if (ws_size < WS_NEEDED) { fprintf(stderr, "workspace too small: %zu < %zu\n", ws_size, (size_t)WS_NEEDED); return; }
  static int grid_blocks = 0;
  if (!grid_blocks) {
    int dev = 0, cus = 0, per_cu = 0;
    hipGetDevice(&dev);
    hipDeviceGetAttribute(&cus, hipDeviceAttributeMultiprocessorCount, dev);
    hipOccupancyMaxActiveBlocksPerMultiprocessor(&per_cu, mega_kernel, 256, 0);
    if (per_cu > 2) per_cu = 2;
    grid_blocks = cus * per_cu;
  }
  (void)hipMemsetAsync((unsigned char*)d_ws + OFF_BAR, 0, 16384, stream);
  void* args[] = {&P};
  hipError_t e = hipLaunchCooperativeKernel((void*)mega_kernel, dim3(grid_blocks), dim3(256), args, 0, stream);
  if (e != hipSuccess) fprintf(stderr, "cooperative launch failed: %s (grid %d)\n", hipGetErrorString(e), grid_blocks);
}
#endif
```

```cpp
#ifdef CPU_EMU
#include "emu.h"
#else
#include <hip/hip_runtime.h>
#include <hip/hip_cooperative_groups.h>
#include <cstdio>
namespace cg = cooperative_groups;
#define DEV __device__ __forceinline__
#define DEVM __device__ __forceinline__
#define OPAQUE(x) asm volatile("" : "+v"(x))
#define OPAQUE_S(x) asm volatile("" : "+s"(x))
#endif

#ifndef SEQ_LEN
#define SEQ_LEN 16384
#endif
#ifndef CTX_LEN
#define CTX_LEN 256
#endif
#ifndef GRID_W_
#define GRID_W_ 64
#endif
#ifndef MULTI_LAUNCH
#define MULTI_LAUNCH 0
#endif

typedef unsigned short bf16_t;
typedef __attribute__((ext_vector_type(8))) short bf16x8;
typedef __attribute__((ext_vector_type(16))) float f32x16;
typedef __attribute__((ext_vector_type(4))) unsigned u32x4;
typedef __attribute__((ext_vector_type(2))) unsigned u32x2;
typedef __attribute__((ext_vector_type(4))) float f32x4;

constexpr int D = 1024, NB = 2, SEQ = SEQ_LEN, CTXL = CTX_LEN, GW = GRID_W_;
constexpr int NCTX = NB * CTXL, NLAT = NB * SEQ, NTOK = NCTX + NLAT;
constexpr int EVC = 3104, ODC = 2816;
constexpr int NEXP = 16384;
constexpr int NTILE = NTOK / 128, CTILE = NCTX / 128;
static_assert(NTOK % 256 == 0 && NCTX % 256 == 0, "tiles");
static_assert(CTXL % 64 == 0 && SEQ % 64 == 0 && SEQ % GW == 0, "chunks");

constexpr size_t al256(size_t x) { return (x + 255) & ~(size_t)255; }
constexpr size_t OFF_MODV = 0;
constexpr size_t OFF_CTXRES = OFF_MODV + al256(2 * 3 * 6144 * 4);
constexpr size_t OFF_GATES = OFF_CTXRES + al256((size_t)NCTX * 1024 * 4);
constexpr size_t OFF_WEVIN = OFF_GATES + al256((size_t)NTOK * 32 * 4);
constexpr size_t OFF_WEVOUT = OFF_WEVIN + al256((size_t)EVC * 1024 * 2);
constexpr size_t OFF_WODIN = OFF_WEVOUT + al256((size_t)1024 * 1024 * 2);
constexpr size_t OFF_WODOUT = OFF_WODIN + al256((size_t)ODC * 1024 * 2);
constexpr size_t OFF_WQ = OFF_WODOUT + al256((size_t)1024 * 1024 * 2);
constexpr size_t OFF_KEYS = OFF_WQ + al256((size_t)2 * 2048 * 1024 * 2);
constexpr size_t OFF_WUP = OFF_KEYS + al256((size_t)2 * 8 * 2 * 128 * 128 * 2);
constexpr size_t OFF_AUP = OFF_WUP + al256((size_t)2 * 512 * 64 * 2);
constexpr size_t OFF_GUP = OFF_AUP + al256((size_t)2 * 512 * 64 * 2);
constexpr size_t OFF_LRUT = OFF_GUP + al256((size_t)512 * 128 * 2);
constexpr size_t OFF_PU = OFF_LRUT + al256((size_t)2 * 8 * 128 * 64 * 2);
constexpr size_t OFF_PV = OFF_PU + al256((size_t)NEXP * 1024);
constexpr size_t OFF_HBUF = OFF_PV + al256((size_t)NEXP * 1024);
constexpr size_t OFF_PR = OFF_HBUF + al256((size_t)NTOK * 1024 * 2);
constexpr size_t PR_BYTES = (size_t)NTOK * 5376 * 2;
constexpr size_t OFF_BAR = OFF_PR + PR_BYTES;
constexpr size_t OFF_ACUM1 = OFF_BAR + 16384;
constexpr size_t OFF_LRUCS = OFF_ACUM1 + (size_t)NLAT * 512 * 2;
constexpr size_t OFF_LRUHS = OFF_LRUCS + (size_t)32 * ((CTXL + SEQ) / 64) * 128 * 4;
constexpr size_t WS_NEEDED = OFF_LRUHS + (size_t)32 * ((CTXL + SEQ) / 64) * 64 * 4;
#ifndef CPU_EMU
static_assert(WS_NEEDED <= (size_t)512 * 1024 * 1024, "workspace too large");
#endif
constexpr size_t OFF_PROJ = OFF_PR;
constexpr size_t OFF_R2L0 = OFF_PR + (size_t)NTOK * EVC * 2;
constexpr size_t OFF_LORA = OFF_PR + (size_t)NTOK * ODC * 2;
constexpr size_t OFF_Q = OFF_PR;
constexpr size_t OFF_PIDX = OFF_PR + (size_t)NTOK * 2048 * 2;
constexpr size_t OFF_PGATE = OFF_PIDX + (size_t)NTOK * 128 * 4;
static_assert(OFF_PGATE + (size_t)NTOK * 128 * 4 <= OFF_PR + PR_BYTES, "picks");

enum {
  I_X = 0, I_C, I_CTX, I_CCTX, I_MODW, I_MODB, I_NORM1, I_NORM2, I_WQ, I_KEYS, I_PU, I_PV,
  I_EVWIN, I_EVWOUT, I_IBIAS, I_FBIAS, I_MNORM, I_SCONVW, I_SCONVB, I_DTBIAS, I_ALOG, I_DSKIP, I_SNORM,
  I_ODWIN, I_ODWOUT, I_MU, I_W0, I_WUP, I_A0, I_AUP, I_GUP, I_KK, I_KA, I_RK, I_LNW, I_LNB,
  I_LCONVW, I_LCONVB, I_LAM, I_WA, I_BA, I_WI, I_BI, I_FNORM, N_IN
};

struct Params {
  const float* in[N_IN];
  float* out;
  unsigned char* ws;
};

constexpr int SMEM_BYTES = 80 * 1024;
#ifdef CPU_EMU
#define SMEM_DECL static thread_local __attribute__((aligned(16))) unsigned char smem_raw[SMEM_BYTES]
#else
#define SMEM_DECL __shared__ __attribute__((aligned(16))) unsigned char smem_raw[SMEM_BYTES]
#endif

DEV float bf2f(bf16_t v) { unsigned u = ((unsigned)v) << 16; float f; __builtin_memcpy(&f, &u, 4); return f; }
#ifdef CPU_EMU
DEV bf16_t f2bf(float f) { unsigned u; __builtin_memcpy(&u, &f, 4); u += 0x7fffu + ((u >> 16) & 1u); return (bf16_t)(u >> 16); }
DEV unsigned pack2(float a, float b) { return (unsigned)f2bf(a) | ((unsigned)f2bf(b) << 16); }
#else
typedef __attribute__((ext_vector_type(2))) float f32x2_t;
typedef __attribute__((ext_vector_type(2))) __bf16 bf16x2_t;
DEV unsigned pack2(float a, float b) { f32x2_t f = {a, b}; return __builtin_bit_cast(unsigned, __builtin_convertvector(f, bf16x2_t)); }
DEV bf16_t f2bf(float f) { return __builtin_bit_cast(unsigned short, (__bf16)f); }
#endif
DEV void unpack8(const u32x4& r, float* o) {
  unsigned w[4] = {r.x, r.y, r.z, r.w};
#pragma unroll
  for (int i = 0; i < 4; ++i) { unsigned lo = w[i] << 16, hi = w[i] & 0xffff0000u; __builtin_memcpy(&o[2 * i], &lo, 4); __builtin_memcpy(&o[2 * i + 1], &hi, 4); }
}
DEV u32x4 pack8(const float* o) { u32x4 r; r.x = pack2(o[0], o[1]); r.y = pack2(o[2], o[3]); r.z = pack2(o[4], o[5]); r.w = pack2(o[6], o[7]); return r; }
#ifdef CPU_EMU
DEV float fexp(float x) { return expf(x); }
DEV float frcp(float x) { return 1.f / x; }
DEV float flog(float x) { return logf(x); }
DEV float frsq(float x) { return 1.f / sqrtf(x); }
DEV float fsqrt(float x) { return sqrtf(x); }
#else
DEV float fexp(float x) { return __expf(x); }
DEV float frcp(float x) { return __builtin_amdgcn_rcpf(x); }
DEV float flog(float x) { return __logf(x); }
DEV float frsq(float x) { return __builtin_amdgcn_rsqf(x); }
DEV float fsqrt(float x) { return __builtin_amdgcn_sqrtf(x); }
#endif
DEV void ld8(const float* __restrict__ p, float* o) { const f32x4 a = *(const f32x4*)p, b = *(const f32x4*)(p + 4); o[0] = a.x; o[1] = a.y; o[2] = a.z; o[3] = a.w; o[4] = b.x; o[5] = b.y; o[6] = b.z; o[7] = b.w; }
DEV float sigmoidf_(float x) { return frcp(1.f + fexp(-x)); }
DEV float siluf_(float x) { return x * frcp(1.f + fexp(-x)); }
DEV float softplusf_(float x) { return fmaxf(x, 0.f) + flog(1.f + fexp(-fabsf(x))); }
DEV float tanhf_(float x) { return 1.f - 2.f * frcp(1.f + fexp(2.f * x)); }
DEV float geluf_(float x) { return 0.5f * x * (1.f + erff(x * 0.70710678118654752f)); }

DEV f32x16 mfma32(bf16x8 a, bf16x8 b, f32x16 c) {
#ifdef CPU_EMU
  return emu_mfma32(a, b, c);
#else
  return __builtin_amdgcn_mfma_f32_32x32x16_bf16(a, b, c, 0, 0, 0);
#endif
}
DEV float wshfl_xor(float v, int m) {
#ifdef CPU_EMU
  return emu_shfl_xor(v, m);
#else
  return __shfl_xor(v, m, 64);
#endif
}
template <int M> DEV float dpp_xor(float v) {
  static_assert(M == 1 || M == 2 || M == 7 || M == 8, "dpp pattern");
#ifdef CPU_EMU
  return emu_shfl_xor(v, M);
#else
  constexpr int ctrl = M == 1 ? 0xB1 : (M == 2 ? 0x4E : (M == 7 ? 0x141 : 0x128));
  return __int_as_float(__builtin_amdgcn_update_dpp(0, __float_as_int(v), ctrl, 0xf, 0xf, false));
#endif
}
DEV float sum8(float v) { v += dpp_xor<1>(v); v += dpp_xor<2>(v); v += dpp_xor<7>(v); return v; }
DEV float sum4(float v) { v += dpp_xor<1>(v); v += dpp_xor<2>(v); return v; }
DEV float sum16(float v) { v = sum8(v); v += dpp_xor<8>(v); return v; }
DEV float swap32_sum(float a, float b) {
#ifdef CPU_EMU
  float ra = emu_shfl_xor(a, 32), rb = emu_shfl_xor(b, 32);
  return ((threadIdx.x >> 5) & 1) ? b + rb : a + ra;
#else
  auto r = __builtin_amdgcn_permlane32_swap(__float_as_uint(a), __float_as_uint(b), false, false);
  return __uint_as_float(r[0]) + __uint_as_float(r[1]);
#endif
}
DEV float swap16_sum(float a, float b) {
#ifdef CPU_EMU
  float ra = emu_shfl_xor(a, 16), rb = emu_shfl_xor(b, 16);
  return ((threadIdx.x >> 4) & 1) ? b + rb : a + ra;
#else
  auto r = __builtin_amdgcn_permlane16_swap(__float_as_uint(a), __float_as_uint(b), false, false);
  return __uint_as_float(r[0]) + __uint_as_float(r[1]);
#endif
}
DEV float wave_sum(float v) {
  v = sum16(v);
  v = swap16_sum(v, v);
  return swap32_sum(v, v);
}
DEV float wave_incl_scan(float v) {
#ifdef CPU_EMU
  const int l = threadIdx.x & 63;
  for (int s = 1; s < 16; s <<= 1) { const bool ok = (l & 15) >= s; float o = emu_readlane(v, ok ? l - s : l); v += ok ? o : 0.f; }
  { const bool ok = ((l >> 4) & 1) != 0; float o = emu_readlane(v, ok ? (l & ~15) - 1 : l); v += ok ? o : 0.f; }
  { const bool ok = l >= 32; float o = emu_readlane(v, ok ? 31 : l); v += ok ? o : 0.f; }
  return v;
#else
#define DPP_ADD_(ctrl, rmask) v += __int_as_float(__builtin_amdgcn_update_dpp(0, __float_as_int(v), ctrl, rmask, 0xf, false))
  DPP_ADD_(0x111, 0xf); DPP_ADD_(0x112, 0xf); DPP_ADD_(0x114, 0xf); DPP_ADD_(0x118, 0xf);
  DPP_ADD_(0x142, 0xa); DPP_ADD_(0x143, 0xc);
#undef DPP_ADD_
  return v;
#endif
}

#ifdef CPU_EMU
static inline unsigned emu_f2fp8(float f) {
  unsigned sgn = f < 0.f ? 0x80u : 0u; float a = fabsf(f);
  if (!(a == a)) return 0x7f;
  if (a >= 448.f) return sgn | 0x7e;
  if (a < 0.0009765625f) return sgn;
  int e; frexpf(a, &e); e -= 1;
  if (e < -6) { int q = (int)nearbyintf(a * 512.f); return sgn | (unsigned)q; }
  float m = a / ldexpf(1.f, e);
  int q = (int)nearbyintf((m - 1.f) * 8.f);
  if (q == 8) { q = 0; e += 1; }
  if (e > 8) return sgn | 0x7e;
  return sgn | (unsigned)((e + 7) << 3) | (unsigned)q;
}
static inline float emu_fp82f(unsigned c) {
  unsigned sgn = c & 0x80, e = (c >> 3) & 15, m = c & 7;
  float v = e == 0 ? ldexpf((float)m, -9) : ldexpf(1.f + m / 8.f, (int)e - 7);
  return sgn ? -v : v;
}
#endif
DEV unsigned pack4_fp8(float a, float b, float c, float d) {
#ifdef CPU_EMU
  return emu_f2fp8(a) | (emu_f2fp8(b) << 8) | (emu_f2fp8(c) << 16) | (emu_f2fp8(d) << 24);
#else
  int w = 0;
  w = __builtin_amdgcn_cvt_pk_fp8_f32(a, b, w, false);
  w = __builtin_amdgcn_cvt_pk_fp8_f32(c, d, w, true);
  return (unsigned)w;
#endif
}
DEV void unpack4_fp8(unsigned w, float* o) {
#ifdef CPU_EMU
  o[0] = emu_fp82f(w & 255); o[1] = emu_fp82f((w >> 8) & 255); o[2] = emu_fp82f((w >> 16) & 255); o[3] = emu_fp82f(w >> 24);
#else
  typedef __attribute__((ext_vector_type(2))) float f32x2_;
  f32x2_ lo = __builtin_amdgcn_cvt_pk_f32_fp8((int)w, false);
  f32x2_ hi = __builtin_amdgcn_cvt_pk_f32_fp8((int)w, true);
  o[0] = lo.x; o[1] = lo.y; o[2] = hi.x; o[3] = hi.y;
#endif
}
DEV void unpack16_fp8(const u32x4& r, float* o) { unpack4_fp8(r.x, o); unpack4_fp8(r.y, o + 4); unpack4_fp8(r.z, o + 8); unpack4_fp8(r.w, o + 12); }
DEV float wreadlane(float v, int srclane) {
#ifdef CPU_EMU
  return emu_readlane(v, srclane);
#else
  int iv; __builtin_memcpy(&iv, &v, 4);
  int r = __builtin_amdgcn_readlane(iv, srclane);
  float f; __builtin_memcpy(&f, &r, 4); return f;
#endif
}
constexpr float PEER_USCALE = 64.f, PEER_VSCALE = 4.f;
#ifdef CPU_EMU
static inline unsigned emu_f2fp4(float f) {
  static const float lv[8] = {0.f, 0.5f, 1.f, 1.5f, 2.f, 3.f, 4.f, 6.f};
  unsigned sgn = f < 0.f ? 8u : 0u; float a = fabsf(f);
  int best = 0; float bd = 1e30f;
  for (int i = 0; i < 8; ++i) { float dd = fabsf(a - lv[i]); if (dd < bd || (dd == bd && (i & 1) == 0)) { bd = dd; best = i; } }
  return sgn | (unsigned)best;
}
static inline float emu_fp42f(unsigned c) {
  static const float lv[8] = {0.f, 0.5f, 1.f, 1.5f, 2.f, 3.f, 4.f, 6.f};
  float v = lv[c & 7]; return (c & 8) ? -v : v;
}
#endif
DEV unsigned pack8_fp4(const float* v) {
#ifdef CPU_EMU
  unsigned w = 0;
  for (int i = 0; i < 8; ++i) w |= emu_f2fp4(v[i]) << (4 * i);
  return w;
#else
  unsigned w = 0;
  w = __builtin_amdgcn_cvt_scalef32_pk_fp4_f32(w, v[0], v[1], 1.0f, 0);
  w = __builtin_amdgcn_cvt_scalef32_pk_fp4_f32(w, v[2], v[3], 1.0f, 1);
  w = __builtin_amdgcn_cvt_scalef32_pk_fp4_f32(w, v[4], v[5], 1.0f, 2);
  w = __builtin_amdgcn_cvt_scalef32_pk_fp4_f32(w, v[6], v[7], 1.0f, 3);
  return w;
#endif
}
DEV void unpack8_fp4(unsigned w, float* o) {
#ifdef CPU_EMU
  for (int i = 0; i < 8; ++i) o[i] = emu_fp42f((w >> (4 * i)) & 15u);
#else
  typedef __attribute__((ext_vector_type(2))) float f32x2_;
  f32x2_ a = __builtin_amdgcn_cvt_scalef32_pk_f32_fp4(w, 1.0f, 0);
  f32x2_ b = __builtin_amdgcn_cvt_scalef32_pk_f32_fp4(w, 1.0f, 1);
  f32x2_ c = __builtin_amdgcn_cvt_scalef32_pk_f32_fp4(w, 1.0f, 2);
  f32x2_ d = __builtin_amdgcn_cvt_scalef32_pk_f32_fp4(w, 1.0f, 3);
  o[0] = a.x; o[1] = a.y; o[2] = b.x; o[3] = b.y; o[4] = c.x; o[5] = c.y; o[6] = d.x; o[7] = d.y;
#endif
}
typedef __attribute__((ext_vector_type(3))) unsigned u32x3;
#ifndef FP6_INTERLEAVED
#define FP6_INTERLEAVED 1
#endif
#ifdef CPU_EMU
static inline unsigned emu_f2fp6(float f) {
  unsigned sgn = f < 0.f ? 32u : 0u; float a = fabsf(f);
  if (a >= 7.5f) return sgn | 31u;
  int e; unsigned code;
  if (a < 1.f) { int q = (int)nearbyintf(a * 8.f); code = (unsigned)q; }
  else { frexpf(a, &e); e -= 1; float m = a / ldexpf(1.f, e); int q = (int)nearbyintf((m - 1.f) * 8.f); if (q == 8) { q = 0; e += 1; } code = (unsigned)(((e + 1) << 3) | q); if (e > 2) code = 31u; }
  return sgn | code;
}
static inline float emu_fp62f(unsigned c) {
  unsigned e = (c >> 3) & 3, m = c & 7;
  float v = e == 0 ? m * 0.125f : ldexpf(1.f + m / 8.f, (int)e - 1);
  return (c & 32) ? -v : v;
}
#endif
DEV u32x3 pack16_fp6(const float* v) {
#ifdef CPU_EMU
  unsigned long long lo = 0; unsigned hi = 0;
  for (int i = 0; i < 16; ++i) {
    unsigned long long c = emu_f2fp6(v[i]); int bit = 6 * i;
    if (bit < 64) { lo |= c << bit; if (bit > 58) hi |= (unsigned)(c >> (64 - bit)); } else hi |= (unsigned)(c << (bit - 64));
  }
  u32x3 r; r.x = (unsigned)lo; r.y = (unsigned)(lo >> 32); r.z = hi; return r;
#else
  typedef __attribute__((ext_vector_type(6))) unsigned u32x6_;
  f32x16 a, b;
#if FP6_INTERLEAVED
#pragma unroll
  for (int i = 0; i < 8; ++i) { a[i] = v[2 * i]; b[i] = v[2 * i + 1]; a[8 + i] = 0.f; b[8 + i] = 0.f; }
#else
#pragma unroll
  for (int i = 0; i < 16; ++i) { a[i] = v[i]; b[i] = 0.f; }
#endif
  u32x6_ w = __builtin_amdgcn_cvt_scalef32_2xpk16_fp6_f32(a, b, 1.0f);
  u32x3 r; r.x = w[0]; r.y = w[1]; r.z = w[2]; return r;
#endif
}
DEV void unpack16_fp6(const u32x3& r, float* o) {
#ifdef CPU_EMU
  unsigned long long lo = (unsigned long long)r.x | ((unsigned long long)r.y << 32); unsigned hi = r.z;
  for (int i = 0; i < 16; ++i) {
    int bit = 6 * i; unsigned c;
    if (bit + 6 <= 64) c = (unsigned)(lo >> bit) & 63u;
    else if (bit >= 64) c = (hi >> (bit - 64)) & 63u;
    else c = ((unsigned)(lo >> bit) | (hi << (64 - bit))) & 63u;
    o[i] = emu_fp62f(c);
  }
#else
  typedef __attribute__((ext_vector_type(6))) unsigned u32x6_;
  typedef __attribute__((ext_vector_type(32))) float f32x32_;
  u32x6_ w; w[0] = r.x; w[1] = r.y; w[2] = r.z; w[3] = 0u; w[4] = 0u; w[5] = 0u;
  f32x32_ f = __builtin_amdgcn_cvt_scalef32_pk32_f32_fp6(w, 1.0f);
#pragma unroll
  for (int i = 0; i < 16; ++i) o[i] = f[i];
#endif
}
DEV void unpack2x16_fp6(const u32x3& ra, const u32x3& rb, float* oa, float* ob) {
#ifdef CPU_EMU
  unpack16_fp6(ra, oa); unpack16_fp6(rb, ob);
#else
  typedef __attribute__((ext_vector_type(6))) unsigned u32x6_;
  typedef __attribute__((ext_vector_type(32))) float f32x32_;
  u32x6_ w; w[0] = ra.x; w[1] = ra.y; w[2] = ra.z; w[3] = rb.x; w[4] = rb.y; w[5] = rb.z;
  f32x32_ f = __builtin_amdgcn_cvt_scalef32_pk32_f32_fp6(w, 1.0f);
#pragma unroll
  for (int i = 0; i < 16; ++i) { oa[i] = f[i]; ob[i] = f[16 + i]; }
#endif
}
constexpr int PEER_ROWB = 1280;
constexpr int PEER_VOFF = 768;


DEV int acc_row(int reg, int lane) { return (reg & 3) + 8 * (reg >> 2) + 4 * (lane >> 5); }

DEV int mod_row(int row) { return row < NCTX ? 2 : (row - NCTX) / SEQ; }

template <bool SYNC_EPI, class Epi, bool VEC4 = false>
DEV void gemm_tile_128(const bf16_t* __restrict__ A, int lda, int M, const bf16_t* __restrict__ Bt, int ldb, int N,
                       int K, int m0, int n0, const Epi& epi, unsigned char* smem) {
  constexpr int LS = 72;
  constexpr int STAGE = 2 * 128 * LS;
  bf16_t* sbase = (bf16_t*)smem;
  const int wave = threadIdx.x >> 6;
  const int wm = (wave >> 1) * 64, wn = (wave & 1) * 64;
  f32x16 acc[2][2];
#pragma unroll
  for (int i = 0; i < 2; ++i)
#pragma unroll
    for (int j = 0; j < 2; ++j)
#pragma unroll
      for (int r = 0; r < 16; ++r) acc[i][j][r] = 0.f;
  u32x4 ra[4], rb[4];
  auto gload = [&](int k0) {
    int tl_ = threadIdx.x; OPAQUE(tl_);
#pragma unroll
    for (int i = 0; i < 4; ++i) {
      int c = tl_ + i * 256, r = c >> 3, cc = (c & 7) * 8;
      int gr = m0 + r, gn = n0 + r;
      gr = gr < M ? gr : M - 1; gn = gn < N ? gn : N - 1;
      ra[i] = *(const u32x4*)(A + (size_t)gr * lda + k0 + cc);
      rb[i] = *(const u32x4*)(Bt + (size_t)gn * ldb + k0 + cc);
    }
  };
  auto lwrite = [&](int buf) {
    int tl_ = threadIdx.x; OPAQUE(tl_);
    bf16_t* sA = sbase + buf * STAGE;
    bf16_t* sB = sA + 128 * LS;
#pragma unroll
    for (int i = 0; i < 4; ++i) {
      int c = tl_ + i * 256, r = c >> 3, cc = (c & 7) * 8;
      *(u32x4*)(sA + r * LS + cc) = ra[i];
      *(u32x4*)(sB + r * LS + cc) = rb[i];
    }
  };
  const int nk = K >> 6;
  gload(0);
  __syncthreads();
  lwrite(0);
  if (nk > 1) gload(64);
  __syncthreads();
  for (int it = 0; it < nk; ++it) {
    int tl_ = threadIdx.x; OPAQUE(tl_);
    const int lane = tl_ & 63;
    const bf16_t* sA = sbase + (it & 1) * STAGE;
    const bf16_t* sB = sA + 128 * LS;
#pragma unroll
    for (int kk = 0; kk < 4; ++kk) {
      bf16x8 a[2], b[2];
      const int ko = kk * 16 + 8 * (lane >> 5);
#pragma unroll
      for (int i = 0; i < 2; ++i) a[i] = *(const bf16x8*)(sA + (wm + i * 32 + (lane & 31)) * LS + ko);
#pragma unroll
      for (int j = 0; j < 2; ++j) b[j] = *(const bf16x8*)(sB + (wn + j * 32 + (lane & 31)) * LS + ko);
#pragma unroll
      for (int i = 0; i < 2; ++i)
#pragma unroll
        for (int j = 0; j < 2; ++j) acc[i][j] = mfma32(a[i], b[j], acc[i][j]);
      if (kk == 1) {
        if (it + 1 < nk) lwrite((it + 1) & 1);
        if (it + 2 < nk) gload((it + 2) * 64);
      }
    }
    __syncthreads();
  }
  {
    int tl_ = threadIdx.x; OPAQUE(tl_);
    const int lane = tl_ & 63;
    if constexpr (VEC4) {
#pragma unroll
      for (int i = 0; i < 2; ++i)
#pragma unroll
        for (int j = 0; j < 2; ++j)
#pragma unroll
          for (int gq = 0; gq < 4; ++gq) {
            int row = m0 + wm + i * 32 + 8 * gq + 4 * (lane >> 5);
            int col = n0 + wn + j * 32 + (lane & 31);
            if (row < M && col < N) epi.store4(row, col, acc[i][j][4 * gq], acc[i][j][4 * gq + 1], acc[i][j][4 * gq + 2], acc[i][j][4 * gq + 3]);
          }
    } else {
#pragma unroll
      for (int i = 0; i < 2; ++i)
#pragma unroll
        for (int j = 0; j < 2; ++j)
#pragma unroll
          for (int r = 0; r < 16; ++r) {
            int row = m0 + wm + i * 32 + acc_row(r, lane);
            int col = n0 + wn + j * 32 + (lane & 31);
            if (row < M && col < N) epi(row, col, acc[i][j][r]);
          }
    }
  }
}

template <class Epi, bool VEC4 = false>
DEV void gemm_tile_128x256(const bf16_t* __restrict__ A, int lda, int M, const bf16_t* __restrict__ Bt, int ldb, int N,
                           int K, int m0, int n0, const Epi& epi, unsigned char* smem) {
  constexpr int LS = 72;
  bf16_t* sA = (bf16_t*)smem;
  bf16_t* sB = sA + 128 * LS;
  const int wave = threadIdx.x >> 6;
  const int wm = (wave >> 1) * 64, wn = (wave & 1) * 128;
  f32x16 acc[2][4];
#pragma unroll
  for (int i = 0; i < 2; ++i)
#pragma unroll
    for (int j = 0; j < 4; ++j)
#pragma unroll
      for (int r = 0; r < 16; ++r) acc[i][j][r] = 0.f;
  u32x4 ra[4], rb[8];
  {
    const int tid = threadIdx.x;
#pragma unroll
    for (int i = 0; i < 4; ++i) {
      int c = tid + i * 256, r = c >> 3, cc = (c & 7) * 8;
      { int gr = m0 + r; gr = gr < M ? gr : M - 1; ra[i] = *(const u32x4*)(A + (size_t)gr * lda + cc); }
    }
#pragma unroll
    for (int i = 0; i < 8; ++i) {
      int c = tid + i * 256, r = c >> 3, cc = (c & 7) * 8;
      { int gn = n0 + r; gn = gn < N ? gn : N - 1; rb[i] = *(const u32x4*)(Bt + (size_t)gn * ldb + cc); }
    }
  }
  for (int k0 = 0; k0 < K; k0 += 64) {
    int tl_ = threadIdx.x; OPAQUE(tl_);
    const int tid = tl_, lane = tl_ & 63;
    __syncthreads();
#pragma unroll
    for (int i = 0; i < 4; ++i) { int c = tid + i * 256, r = c >> 3, cc = (c & 7) * 8; *(u32x4*)(sA + r * LS + cc) = ra[i]; }
#pragma unroll
    for (int i = 0; i < 8; ++i) { int c = tid + i * 256, r = c >> 3, cc = (c & 7) * 8; *(u32x4*)(sB + r * LS + cc) = rb[i]; }
    __syncthreads();
    if (k0 + 64 < K) {
#pragma unroll
      for (int i = 0; i < 4; ++i) {
        int c = tid + i * 256, r = c >> 3, cc = (c & 7) * 8;
        { int gr = m0 + r; gr = gr < M ? gr : M - 1; ra[i] = *(const u32x4*)(A + (size_t)gr * lda + k0 + 64 + cc); }
      }
#pragma unroll
      for (int i = 0; i < 8; ++i) {
        int c = tid + i * 256, r = c >> 3, cc = (c & 7) * 8;
        { int gn = n0 + r; gn = gn < N ? gn : N - 1; rb[i] = *(const u32x4*)(Bt + (size_t)gn * ldb + k0 + 64 + cc); }
      }
    }
#pragma unroll 2
    for (int kk = 0; kk < 4; ++kk) {
      bf16x8 a[2], b[4];
      const int ko = kk * 16 + 8 * (lane >> 5);
#pragma unroll
      for (int i = 0; i < 2; ++i) a[i] = *(const bf16x8*)(sA + (wm + i * 32 + (lane & 31)) * LS + ko);
#pragma unroll
      for (int j = 0; j < 4; ++j) b[j] = *(const bf16x8*)(sB + (wn + j * 32 + (lane & 31)) * LS + ko);
#pragma unroll
      for (int i = 0; i < 2; ++i)
#pragma unroll
        for (int j = 0; j < 4; ++j) acc[i][j] = mfma32(a[i], b[j], acc[i][j]);
    }
  }
  {
    int tl_ = threadIdx.x; OPAQUE(tl_);
    const int lane = tl_ & 63;
    if constexpr (VEC4) {
#pragma unroll
      for (int i = 0; i < 2; ++i)
#pragma unroll
        for (int j = 0; j < 4; ++j)
#pragma unroll
          for (int gq = 0; gq < 4; ++gq) {
            int row = m0 + wm + i * 32 + 8 * gq + 4 * (lane >> 5);
            int col = n0 + wn + j * 32 + (lane & 31);
            if (row < M && col < N) epi.store4(row, col, acc[i][j][4 * gq], acc[i][j][4 * gq + 1], acc[i][j][4 * gq + 2], acc[i][j][4 * gq + 3]);
          }
    } else {
#pragma unroll
      for (int i = 0; i < 2; ++i)
#pragma unroll
        for (int j = 0; j < 4; ++j)
#pragma unroll
          for (int r = 0; r < 16; ++r) {
            int row = m0 + wm + i * 32 + acc_row(r, lane);
            int col = n0 + wn + j * 32 + (lane & 31);
            if (row < M && col < N) epi(row, col, acc[i][j][r]);
          }
    }
  }
}

DEV void transpose_tile(const float* __restrict__ src, int ld_src, bf16_t* __restrict__ dst, int ld_dst, int K, int N,
                        int tk, int tn, unsigned char* smem) {
  float* sT = (float*)smem;
  const int tid = threadIdx.x;
  __syncthreads();
  {
    const int tx = tid & 15, ty = tid >> 4;
#pragma unroll
    for (int p = 0; p < 4; ++p) {
      int k = tk * 64 + ty + p * 16, n = tn * 64 + tx * 4;
      f32x4 v4 = {0.f, 0.f, 0.f, 0.f};
      if (k < K && n < N) v4 = *(const f32x4*)(src + (size_t)k * ld_src + n);
      float* d = sT + (ty + p * 16) * 65 + tx * 4;
      d[0] = v4.x; d[1] = v4.y; d[2] = v4.z; d[3] = v4.w;
    }
  }
  __syncthreads();
  {
    const int n = tid >> 2, kseg = (tid & 3) * 16;
    int gn = tn * 64 + n;
    if (gn < N) {
      float v[16];
#pragma unroll
      for (int j = 0; j < 16; ++j) v[j] = sT[(kseg + j) * 65 + n];
      bf16_t* d = dst + (size_t)gn * ld_dst + tk * 64 + kseg;
      *(u32x4*)d = pack8(v);
      *(u32x4*)(d + 8) = pack8(v + 8);
    }
  }
}

constexpr int TJ0 = 16 * 49, TJ1 = 16 * 16, TJ2 = 16 * 44, TJ3 = 16 * 16, TJ4 = 2 * 16 * 32, TJ5 = 2 * 8, TJ6 = 2 * 8,
              TJ7 = 2 * 8, TJ8 = 32;
constexpr int NTRANS = TJ0 + TJ1 + TJ2 + TJ3 + TJ4 + TJ5 + TJ6 + TJ7 + TJ8;
constexpr int NKEYCV = (2 * 8 * 2 * 128 * 128) / (256 * 8);
constexpr int NMODV = 2 * 96;
constexpr int NPREP = NTRANS + NKEYCV + NMODV;

DEV void st_prep(const Params& P, int item, unsigned char* smem) {
  unsigned char* ws = P.ws;
  if (item < NTRANS) {
    int t = item;
    if (t < TJ0) { transpose_tile(P.in[I_EVWIN], EVC, (bf16_t*)(ws + OFF_WEVIN), 1024, 1024, EVC, t / 49, t % 49, smem); return; }
    t -= TJ0;
    if (t < TJ1) { transpose_tile(P.in[I_EVWOUT], 1024, (bf16_t*)(ws + OFF_WEVOUT), 1024, 1024, 1024, t / 16, t % 16, smem); return; }
    t -= TJ1;
    if (t < TJ2) { transpose_tile(P.in[I_ODWIN], ODC, (bf16_t*)(ws + OFF_WODIN), 1024, 1024, ODC, t / 44, t % 44, smem); return; }
    t -= TJ2;
    if (t < TJ3) { transpose_tile(P.in[I_ODWOUT], 1024, (bf16_t*)(ws + OFF_WODOUT), 1024, 1024, 1024, t / 16, t % 16, smem); return; }
    t -= TJ3;
    if (t < TJ4) {
      int l = t / 512, tt = t % 512;
      transpose_tile(P.in[I_WQ] + (size_t)l * 1024 * 2048, 2048, (bf16_t*)(ws + OFF_WQ) + (size_t)l * 2048 * 1024, 1024, 1024, 2048, tt / 32, tt % 32, smem);
      return;
    }
    t -= TJ4;
    if (t < TJ5) { int d = t / 8; transpose_tile(P.in[I_WUP] + d * 64 * 512, 512, (bf16_t*)(ws + OFF_WUP) + d * 512 * 64, 64, 64, 512, 0, t % 8, smem); return; }
    t -= TJ5;
    if (t < TJ6) { int d = t / 8; transpose_tile(P.in[I_AUP] + d * 64 * 512, 512, (bf16_t*)(ws + OFF_AUP) + d * 512 * 64, 64, 64, 512, 0, t % 8, smem); return; }
    t -= TJ6;
    if (t < TJ7) { transpose_tile(P.in[I_GUP], 512, (bf16_t*)(ws + OFF_GUP), 128, 128, 512, t / 8, t % 8, smem); return; }
    t -= TJ7;
    {
      int which = t & 1, db = t >> 1;
      const float* src = (which ? P.in[I_WI] : P.in[I_WA]) + (size_t)db * 64 * 64;
      transpose_tile(src, 64, (bf16_t*)(ws + OFF_LRUT) + (size_t)db * 128 * 64 + which * 64 * 64, 64, 64, 64, 0, 0, smem);
      return;
    }
  }
  item -= NTRANS;
  if (item < NKEYCV) {
    size_t e = ((size_t)item * 256 + threadIdx.x) * 8;
    const float* s = P.in[I_KEYS] + e;
    f32x4 a = *(const f32x4*)s, b = *(const f32x4*)(s + 4);
    float v[8] = {a.x, a.y, a.z, a.w, b.x, b.y, b.z, b.w};
    *(u32x4*)((bf16_t*)(ws + OFF_KEYS) + e) = pack8(v);
    return;
  }
  item -= NKEYCV;
  {
    const int l = item / 96, cgp = item % 96;
    float* sS = (float*)smem;
    float* sRed = sS + 3 * 1024;
    const int tid = threadIdx.x;
    __syncthreads();
    for (int i = tid; i < 3 * 1024; i += 256) {
      int m = i >> 10, k = i & 1023;
      float c = m < 2 ? P.in[I_C][m * 1024 + k] : P.in[I_CCTX][k];
      sS[i] = siluf_(c);
    }
    __syncthreads();
    const int ks = tid >> 6, col = cgp * 64 + (tid & 63);
    const float* w = P.in[I_MODW] + (size_t)l * 1024 * 6144 + col;
    float a0 = 0.f, a1 = 0.f, a2 = 0.f;
    for (int k = ks * 256; k < ks * 256 + 256; ++k) {
      float wv = w[(size_t)k * 6144];
      a0 += sS[k] * wv; a1 += sS[1024 + k] * wv; a2 += sS[2048 + k] * wv;
    }
    sRed[(ks * 3 + 0) * 64 + (tid & 63)] = a0;
    sRed[(ks * 3 + 1) * 64 + (tid & 63)] = a1;
    sRed[(ks * 3 + 2) * 64 + (tid & 63)] = a2;
    __syncthreads();
    if (tid < 192) {
      int m = tid >> 6, c = tid & 63;
      float s = sRed[(0 * 3 + m) * 64 + c] + sRed[(1 * 3 + m) * 64 + c] + sRed[(2 * 3 + m) * 64 + c] + sRed[(3 * 3 + m) * 64 + c];
      int cc = cgp * 64 + c;
      ((float*)(ws + OFF_MODV))[((size_t)l * 3 + m) * 6144 + cc] = s + P.in[I_MODB][l * 6144 + cc];
    }
  }
}

constexpr int NPCONV = 2 * (NEXP * 1024 / (256 * 16));
DEV void st_peer_conv(const Params& P, int layer, int item) {
  const int half = NPCONV / 2;
  int which = item >= half;
  int it = which ? item - half : item;
  size_t e = ((size_t)it * 256 + threadIdx.x) * 16;
  const float* s = (which ? P.in[I_PV] : P.in[I_PU]) + (size_t)layer * NEXP * 1024 + e;
  const float sc = which ? PEER_VSCALE : PEER_USCALE;
  float v16[16];
#pragma unroll
  for (int q = 0; q < 4; ++q) {
    f32x4 a = *(const f32x4*)(s + 4 * q);
    v16[4 * q] = a.x * sc; v16[4 * q + 1] = a.y * sc; v16[4 * q + 2] = a.z * sc; v16[4 * q + 3] = a.w * sc;
  }
  const size_t ex = e >> 10, col = e & 1023;
  if (which) {
    u32x2 o; o.x = pack8_fp4(v16); o.y = pack8_fp4(v16 + 8);
    *(u32x2*)(P.ws + OFF_PU + ex * PEER_ROWB + PEER_VOFF + (col >> 1)) = o;
  } else {
    u32x3 o = pack16_fp6(v16);
    unsigned* dp = (unsigned*)(P.ws + OFF_PU + ex * PEER_ROWB + (col >> 4) * 12);
    dp[0] = o.x; dp[1] = o.y; dp[2] = o.z;
  }
}

DEV void st_normmod(const Params& P, int layer, int which, int row) {
  const int lane = threadIdx.x & 63;
  const float* src;
  if (which == 0 && layer == 0) src = row < NCTX ? P.in[I_CTX] + (size_t)row * 1024 : P.in[I_X] + (size_t)(row - NCTX) * 1024;
  else src = row < NCTX ? (const float*)(P.ws + OFF_CTXRES) + (size_t)row * 1024 : P.out + (size_t)(row - NCTX) * 1024;
  const float* mv = (const float*)(P.ws + OFF_MODV) + ((size_t)layer * 3 + mod_row(row)) * 6144;
  const float* sh = mv + (which ? 3 : 0) * 1024;
  const float* sc = mv + (which ? 4 : 1) * 1024;
  const float* nw = (which ? P.in[I_NORM2] : P.in[I_NORM1]) + layer * 1024;
  f32x4 v[4];
  float ss = 0.f;
#pragma unroll
  for (int i = 0; i < 4; ++i) {
    v[i] = *(const f32x4*)(src + i * 256 + lane * 4);
    ss += v[i].x * v[i].x + v[i].y * v[i].y + v[i].z * v[i].z + v[i].w * v[i].w;
  }
  ss = wave_sum(ss);
  const float rstd = frsq(ss * (1.f / 1024.f) + 1e-6f);
  bf16_t* dst = (bf16_t*)(P.ws + OFF_HBUF) + (size_t)row * 1024;
#pragma unroll
  for (int i = 0; i < 4; ++i) {
    int c = i * 256 + lane * 4;
    f32x4 w4 = *(const f32x4*)(nw + c), s4 = *(const f32x4*)(sc + c), h4 = *(const f32x4*)(sh + c);
    float o0 = v[i].x * rstd * w4.x * (1.f + s4.x) + h4.x;
    float o1 = v[i].y * rstd * w4.y * (1.f + s4.y) + h4.y;
    float o2 = v[i].z * rstd * w4.z * (1.f + s4.z) + h4.z;
    float o3 = v[i].w * rstd * w4.w * (1.f + s4.w) + h4.w;
    u32x2 pk; pk.x = pack2(o0, o1); pk.y = pack2(o2, o3);
    *(u32x2*)(dst + c) = pk;
  }
}

struct EpiProjL0 {
  bf16_t* proj; float* gates;
  DEVM void operator()(int row, int col, float v) const {
    proj[(size_t)row * EVC + col] = f2bf(v);
    if (col >= 1536 && col < 1552) gates[row * 32 + (col - 1536)] = v;
    else if (col >= 3088) gates[row * 32 + 16 + (col - 3088)] = v;
  }
};
struct EpiStoreBf {
  bf16_t* dst; int ld;
  DEVM void operator()(int row, int col, float v) const { dst[(size_t)row * ld + col] = f2bf(v); }
};
struct EpiStoreBfBias {
  bf16_t* dst; int ld; const float* bias;
  DEVM void operator()(int row, int col, float v) const { dst[(size_t)row * ld + col] = f2bf(v + (bias ? bias[col] : 0.f)); }
};
struct EpiProjL0T {
  bf16_t* proj; float* gates;
  DEVM void operator()(int, int, float) const {}
  DEVM void store4(int n, int m, float v0, float v1, float v2, float v3) const {
    u32x2 pk; pk.x = pack2(v0, v1); pk.y = pack2(v2, v3);
    *(u32x2*)(proj + (size_t)m * EVC + n) = pk;
    if (n >= 1536 && n < 1552) { f32x4 g = {v0, v1, v2, v3}; *(f32x4*)(gates + m * 32 + (n - 1536)) = g; }
    else if (n >= 3088) { f32x4 g = {v0, v1, v2, v3}; *(f32x4*)(gates + m * 32 + 16 + (n - 3088)) = g; }
  }
};
struct EpiStoreBfT {
  bf16_t* dst; int ld;
  DEVM void operator()(int, int, float) const {}
  DEVM void store4(int n, int m, float v0, float v1, float v2, float v3) const {
    u32x2 pk; pk.x = pack2(v0, v1); pk.y = pack2(v2, v3);
    *(u32x2*)(dst + (size_t)m * ld + n) = pk;
  }
};
struct EpiOutProjT {
  const float* x_lat; const float* x_ctx; float* o_lat; float* o_ctx; const float* modv;
  DEVM void operator()(int, int, float) const {}
  DEVM void store4(int n, int m, float v0, float v1, float v2, float v3) const {
    const f32x4 g = *(const f32x4*)(modv + mod_row(m) * 6144 + 2 * 1024 + n);
    const float* xs; float* od;
    if (m < NCTX) { xs = x_ctx + (size_t)m * 1024 + n; od = o_ctx + (size_t)m * 1024 + n; }
    else { size_t o = (size_t)(m - NCTX) * 1024 + n; xs = x_lat + o; od = o_lat + o; }
    const f32x4 x = *(const f32x4*)xs;
    f32x4 r = {x.x + g.x * v0, x.y + g.y * v1, x.z + g.z * v2, x.w + g.w * v3};
    *(f32x4*)od = r;
  }
};
struct EpiStoreBfBiasT {
  bf16_t* dst; int ld; const float* bias;
  DEVM void operator()(int, int, float) const {}
  DEVM void store4(int n, int m, float v0, float v1, float v2, float v3) const {
    if (bias) { v0 += bias[n]; v1 += bias[n + 1]; v2 += bias[n + 2]; v3 += bias[n + 3]; }
    u32x2 pk; pk.x = pack2(v0, v1); pk.y = pack2(v2, v3);
    *(u32x2*)(dst + (size_t)m * ld + n) = pk;
  }
};
struct EpiOutProj {
  const float* x_lat; const float* x_ctx; float* o_lat; float* o_ctx; const float* modv;
  DEVM void operator()(int row, int col, float v) const {
    float g = modv[mod_row(row) * 6144 + 2 * 1024 + col];
    if (row < NCTX) o_ctx[(size_t)row * 1024 + col] = x_ctx[(size_t)row * 1024 + col] + g * v;
    else { size_t o = (size_t)(row - NCTX) * 1024 + col; o_lat[o] = x_lat[o] + g * v; }
  }
};
struct EpiScoreLds {
  float* sS; int m0;
  DEVM void operator()(int row, int col, float v) const { sS[(row - m0) * 129 + col] = v; }
};

DEV void st_xbc_conv(const Params& P, int row) {
  const int lane = threadIdx.x & 63;
  const bf16_t* proj = (const bf16_t*)(P.ws + OFF_PROJ);
  bf16_t* xc = (bf16_t*)P.out + (size_t)row * 1024;
  int row0, len, pos;
  if (row < NCTX) { row0 = (row / CTXL) * CTXL; len = CTXL; pos = row - row0; }
  else { int r = row - NCTX; row0 = NCTX + (r / SEQ) * SEQ; len = SEQ; pos = r % SEQ; }
  const float* cw = P.in[I_SCONVW];
  const float* cb = P.in[I_SCONVB];
#pragma unroll
  for (int hh = 0; hh < 2; ++hh) {
    const int ch = hh * 512 + lane * 8;
    float o[8];
#pragma unroll
    for (int j = 0; j < 8; ++j) o[j] = cb[ch + j];
#pragma unroll
    for (int tap = 0; tap < 4; ++tap) {
      int pp = pos + tap - 2;
      if (pp >= 0 && pp < len) {
        float x[8];
        unpack8(*(const u32x4*)(proj + (size_t)(row0 + pp) * EVC + 2064 + ch), x);
        f32x4 w0 = *(const f32x4*)(cw + tap * 1024 + ch), w1 = *(const f32x4*)(cw + tap * 1024 + ch + 4);
        o[0] += w0.x * x[0]; o[1] += w0.y * x[1]; o[2] += w0.z * x[2]; o[3] += w0.w * x[3];
        o[4] += w1.x * x[4]; o[5] += w1.y * x[5]; o[6] += w1.z * x[6]; o[7] += w1.w * x[7];
      }
    }
#pragma unroll
    for (int j = 0; j < 8; ++j) o[j] = siluf_(o[j]);
    *(u32x4*)(xc + ch) = pack8(o);
  }
}

#ifndef LA_NSEG
#define LA_NSEG 10
#endif
constexpr int LA_NCH = (CTXL + SEQ) / 64;
constexpr int LA_CPS = LA_NCH / LA_NSEG;
static_assert(LA_NCH % LA_NSEG == 0, "linattn segments");
#ifdef CPU_EMU
constexpr size_t OFF_LASEG = OFF_PR + PR_BYTES;
#else
constexpr size_t OFF_LASEG = OFF_R2L0 + (size_t)NTOK * 1024 * 2;
#endif
constexpr size_t LASEG_U = (size_t)48 * LA_NSEG * 8192 * 4;
constexpr size_t OFF_LASEG_N = OFF_LASEG + LASEG_U;
constexpr size_t OFF_LASEG_D = OFF_LASEG_N + (size_t)48 * LA_NSEG * 64 * 4;
#ifndef CPU_EMU
static_assert(OFF_LASEG_D + 48 * LA_NSEG * 4 <= OFF_PR + PR_BYTES, "laseg");
#endif

struct LaRaw { u32x4 q[2], k[4], x[4]; float g0, g1; };

template <bool MLSTM, bool FULL>
DEV void la_load_raw(const Params& P, int b, int h, int d, int cc, LaRaw& R) {
  constexpr int NC_CTX = CTXL / 64;
  const int tid = threadIdx.x;
  const int seg = cc >= NC_CTX;
  const int row0 = seg ? NCTX + b * SEQ : b * CTXL;
  const int len = seg ? SEQ : CTXL;
  const int cl = (seg ? cc - NC_CTX : cc) * 64;
  const bf16_t* proj = (const bf16_t*)(P.ws + OFF_PROJ);
  const bf16_t* xcv = (const bf16_t*)P.out;
  const float* gates = (const float*)(P.ws + OFF_GATES);
  if (tid < 64) {
    int p = cl + tid, grow = row0 + (d ? len - 1 - p : p);
    if (MLSTM) { R.g0 = gates[grow * 32 + d * 4 + h]; R.g1 = gates[grow * 32 + 8 + d * 4 + h]; }
    else { R.g0 = gates[grow * 32 + 16 + d * 8 + h]; R.g1 = 0.f; }
  }
  if (MLSTM) {
#pragma unroll
    for (int i = 0; i < 2; ++i) {
      int c = tid + i * 256, r = c >> 3, cc8 = (c & 7) * 8;
      int p = cl + r, pos = d ? len - 1 - p : p;
      const bf16_t* rp = proj + (size_t)(row0 + pos) * EVC;
      if (FULL) R.q[i] = *(const u32x4*)(rp + h * 64 + cc8);
      R.k[i] = *(const u32x4*)(rp + 256 + h * 64 + cc8);
    }
#pragma unroll
    for (int i = 0; i < 4; ++i) {
      int c = tid + i * 256, r = c >> 4, cc8 = (c & 15) * 8;
      int p = cl + r, pos = d ? len - 1 - p : p;
      R.x[i] = *(const u32x4*)(proj + (size_t)(row0 + pos) * EVC + 512 + h * 128 + cc8);
    }
  } else {
    const int grp = h >> 2;
#pragma unroll
    for (int i = 0; i < 2; ++i) {
      int c = tid + i * 256, r = c >> 3, cc8 = (c & 7) * 8;
      int p = cl + r, pos = d ? len - 1 - p : p;
      R.x[i] = *(const u32x4*)(xcv + (size_t)(row0 + pos) * 1024 + h * 64 + cc8);
    }
#pragma unroll
    for (int i = 0; i < 4; ++i) {
      int c = tid + i * 256, r = c >> 4, cc8 = (c & 15) * 8;
      int p = cl + r, pos = d ? len - 1 - p : p;
      const bf16_t* rp = xcv + (size_t)(row0 + pos) * 1024;
      R.k[i] = *(const u32x4*)(rp + 512 + grp * 128 + cc8);
      if (FULL) { if (i < 2) R.q[i] = *(const u32x4*)(rp + 768 + grp * 128 + cc8); else R.x[i] = *(const u32x4*)(rp + 768 + grp * 128 + cc8); }
    }
  }
}

template <bool MLSTM, bool FULL>
DEV void st_linattn_seg(const Params& P, int sid, int seg, unsigned char* smem) {
  constexpr int DK = MLSTM ? 64 : 128, DX = MLSTM ? 128 : 64;
  constexpr int QS = DK + 8;
  constexpr int NH = MLSTM ? 4 : 8;
  constexpr int NC_CTX = CTXL / 64;
  const int tid = threadIdx.x, lane = tid & 63, wave = tid >> 6;
  const int d = sid & 1, h = (sid >> 1) % NH, b = (sid >> 1) / NH;
  const int gsid = MLSTM ? sid : 16 + sid;
  bf16_t* sQ = (bf16_t*)smem;
  bf16_t* sK = sQ + 64 * QS;
  bf16_t* sP = sK;
  bf16_t* sKT = sK + 64 * QS;
  bf16_t* sXT = sKT + DK * 72;
  bf16_t* sST = sXT + DX * 72;
  float* sF = (float*)(sST + DX * QS);
  float* sLa = sF;
  float* sG = sF + 64;
  float* sBc = sF + 128;
  float* sDen = sF + 192;
  float* sN = sF + 256;
  int* sRow = (int*)(sF + 384);
  static_assert((64 * QS * 2 + DK * 72 + DX * 72 + DX * QS) * 2 + 448 * 4 <= SMEM_BYTES, "lds");
  bf16_t* outb = MLSTM ? (bf16_t*)(P.ws + OFF_HBUF) : (bf16_t*)(P.ws + OFF_R2L0);
  float* segU = (float*)(P.ws + OFF_LASEG);
  float* segN = (float*)(P.ws + OFF_LASEG_N);
  float* segD = (float*)(P.ws + OFF_LASEG_D);

  f32x16 accS[2];
#pragma unroll
  for (int j = 0; j < 2; ++j)
#pragma unroll
    for (int r = 0; r < 16; ++r) accS[j][r] = 0.f;
  const int sx0 = MLSTM ? wave * 32 : (wave >> 1) * 32;
  const int sk0 = MLSTM ? 0 : (wave & 1) * 64;
  float nreg = 0.f;
  float gb0 = 0.f, gb1 = 0.f, alog_e = 0.f, dskip = 0.f;
  if (MLSTM) { gb0 = P.in[I_IBIAS][d * 4 + h]; gb1 = P.in[I_FBIAS][d * 4 + h]; }
  else { gb0 = P.in[I_DTBIAS][d * 8 + h]; alog_e = fexp(P.in[I_ALOG][d * 8 + h]); dskip = P.in[I_DSKIP][h]; }

  const int cc0 = seg * LA_CPS, cc1 = cc0 + LA_CPS;
  LaRaw R;
  la_load_raw<MLSTM, FULL>(P, b, h, d, cc0, R);
  __syncthreads();
  if (FULL) {
    for (int js = 0; js < seg; ++js) {
      const size_t it = (size_t)gsid * LA_NSEG + js;
      const float a = fexp(segD[it]);
      const float* U = segU + it * 8192;
#pragma unroll
      for (int j = 0; j < 2; ++j)
#pragma unroll
        for (int r = 0; r < 16; ++r) accS[j][r] = a * accS[j][r] + U[(j * 16 + r) * 256 + tid];
      if (MLSTM) nreg = a * nreg + segN[it * 64 + (tid >> 2)];
    }
#pragma unroll
    for (int j = 0; j < 2; ++j)
#pragma unroll
      for (int r = 0; r < 16; ++r) sST[(sx0 + acc_row(r, lane)) * QS + sk0 + j * 32 + (lane & 31)] = f2bf(accS[j][r]);
    if (MLSTM && (tid & 3) == 0) sN[tid >> 2] = nreg;
  }
  float lsum = 0.f;

  for (int cc = cc0; cc < cc1; ++cc) {
    int tl_ = threadIdx.x; OPAQUE(tl_);
    const int tid = tl_, lane = tl_ & 63;
    const int sgi = cc >= NC_CTX;
    const int row0 = sgi ? NCTX + b * SEQ : b * CTXL;
    const int len = sgi ? SEQ : CTXL;
    const int cl = (sgi ? cc - NC_CTX : cc) * 64;
    if (tid < 64) {
      int p = cl + tid;
      sRow[tid] = row0 + (d ? len - 1 - p : p);
      float la;
      if (MLSTM) { la = -softplusf_(-(R.g1 + gb1)); sG[tid] = fexp(R.g0 + gb0); }
      else { float dt = softplusf_(R.g0 + gb0); la = -dt * alog_e; sG[tid] = dt; }
      sBc[tid] = wave_incl_scan(la);
    }
    __syncthreads();
    const float blast = sBc[63];
    lsum += blast;
    if (MLSTM) {
#pragma unroll
      for (int i = 0; i < 2; ++i) {
        int c = tid + i * 256, r = c >> 3, cc8 = (c & 7) * 8;
        float kf[8]; unpack8(R.k[i], kf);
        const float wgt = fexp(blast - sBc[r]) * sG[r];
#pragma unroll
        for (int j = 0; j < 8; ++j) sKT[(cc8 + j) * 72 + r] = f2bf(kf[j] * wgt);
        if (FULL) {
          float qf[8]; unpack8(R.q[i], qf);
#pragma unroll
          for (int j = 0; j < 8; ++j) qf[j] *= 0.125f;
          *(u32x4*)(sQ + r * QS + cc8) = pack8(qf);
          *(u32x4*)(sK + r * QS + cc8) = R.k[i];
        }
      }
#pragma unroll
      for (int i = 0; i < 4; ++i) {
        int c = tid + i * 256, r = c >> 4, cc8 = (c & 15) * 8;
        const bf16_t* xs = (const bf16_t*)&R.x[i];
#pragma unroll
        for (int j = 0; j < 8; ++j) sXT[(cc8 + j) * 72 + r] = xs[j];
      }
    } else {
#pragma unroll
      for (int i = 0; i < 2; ++i) {
        int c = tid + i * 256, r = c >> 3, cc8 = (c & 7) * 8;
        const bf16_t* xs = (const bf16_t*)&R.x[i];
#pragma unroll
        for (int j = 0; j < 8; ++j) sXT[(cc8 + j) * 72 + r] = xs[j];
      }
#pragma unroll
      for (int i = 0; i < 4; ++i) {
        int c = tid + i * 256, r = c >> 4, cc8 = (c & 15) * 8;
        float kf[8]; unpack8(R.k[i], kf);
        const float wgt = fexp(blast - sBc[r]) * sG[r];
#pragma unroll
        for (int j = 0; j < 8; ++j) sKT[(cc8 + j) * 72 + r] = f2bf(kf[j] * wgt);
        if (FULL) {
          *(u32x4*)(sK + r * QS + cc8) = R.k[i];
          *(u32x4*)(sQ + r * QS + cc8) = i < 2 ? R.q[i] : R.x[i];
        }
      }
    }
    if (cc + 1 < cc1) la_load_raw<MLSTM, FULL>(P, b, h, d, cc + 1, R);
    __syncthreads();
    if (FULL) {
      const int tr = (wave >> 1) * 32, tc = (wave & 1) * 32;
      f32x16 accP;
#pragma unroll
      for (int r = 0; r < 16; ++r) accP[r] = 0.f;
      if (!(tr == 0 && tc == 32)) {
#pragma unroll
        for (int kk = 0; kk < DK / 16; ++kk) {
          const int ko = kk * 16 + 8 * (lane >> 5);
          bf16x8 a = *(const bf16x8*)(sQ + (tr + (lane & 31)) * QS + ko);
          bf16x8 bb = *(const bf16x8*)(sK + (tc + (lane & 31)) * QS + ko);
          accP = mfma32(a, bb, accP);
        }
      }
      __syncthreads();
      {
        const int s = tc + (lane & 31);
        const float bs = sBc[s], gs = sG[s];
#pragma unroll
        for (int r = 0; r < 16; ++r) {
          int t = tr + acc_row(r, lane);
          float v = (s <= t) ? accP[r] * fexp(sBc[t] - bs) * gs : 0.f;
          sP[t * 72 + s] = f2bf(v);
        }
        {
          const int t = tid >> 2, kq = (tid & 3) * (DK / 4);
          const float et = fexp(sBc[t]);
#pragma unroll
          for (int c8 = 0; c8 < DK / 4; c8 += 8) {
            float qf[8];
            unpack8(*(const u32x4*)(sQ + t * QS + kq + c8), qf);
#pragma unroll
            for (int j = 0; j < 8; ++j) qf[j] *= et;
            *(u32x4*)(sQ + t * QS + kq + c8) = pack8(qf);
          }
        }
      }
      __syncthreads();
      constexpr int NYT = MLSTM ? 2 : 1;
      const int yx0 = MLSTM ? wave * 32 : (wave >> 1) * 32;
      const int yt0 = MLSTM ? 0 : (wave & 1) * 32;
      f32x16 accY[NYT];
#pragma unroll
      for (int j = 0; j < NYT; ++j)
#pragma unroll
        for (int r = 0; r < 16; ++r) accY[j][r] = 0.f;
#pragma unroll
      for (int kk = 0; kk < 4; ++kk) {
        const int ko = kk * 16 + 8 * (lane >> 5);
        bf16x8 a = *(const bf16x8*)(sXT + (yx0 + (lane & 31)) * 72 + ko);
#pragma unroll
        for (int j = 0; j < NYT; ++j) {
          bf16x8 bb = *(const bf16x8*)(sP + (yt0 + j * 32 + (lane & 31)) * 72 + ko);
          accY[j] = mfma32(a, bb, accY[j]);
        }
      }
#pragma unroll
      for (int kk = 0; kk < DK / 16; ++kk) {
        const int ko = kk * 16 + 8 * (lane >> 5);
        bf16x8 a = *(const bf16x8*)(sST + (yx0 + (lane & 31)) * QS + ko);
#pragma unroll
        for (int j = 0; j < NYT; ++j) {
          bf16x8 bb = *(const bf16x8*)(sQ + (yt0 + j * 32 + (lane & 31)) * QS + ko);
          accY[j] = mfma32(a, bb, accY[j]);
        }
      }
      if (MLSTM) {
        const int t = tid >> 2, q4 = (tid & 3) * 16;
        float pf[16], qf[16];
        unpack8(*(const u32x4*)(sP + t * 72 + q4), pf); unpack8(*(const u32x4*)(sP + t * 72 + q4 + 8), pf + 8);
        unpack8(*(const u32x4*)(sQ + t * QS + q4), qf); unpack8(*(const u32x4*)(sQ + t * QS + q4 + 8), qf + 8);
        float den = 0.f;
#pragma unroll
        for (int j = 0; j < 16; ++j) den += pf[j] + sN[q4 + j] * qf[j];
        den = sum4(den);
        if ((tid & 3) == 0) sDen[t] = den;
        __syncthreads();
      }
#pragma unroll
      for (int j = 0; j < NYT; ++j) {
        const int t = yt0 + j * 32 + (lane & 31);
        const size_t obase = (size_t)sRow[t] * 1024 + d * 512 + h * DX;
        const float dinv = MLSTM ? frcp(fmaxf(fabsf(sDen[t]), 1.f)) : 1.f;
#pragma unroll
        for (int g = 0; g < 4; ++g) {
          const int x0 = yx0 + 8 * g + 4 * (lane >> 5);
          float v0 = accY[j][4 * g], v1 = accY[j][4 * g + 1], v2 = accY[j][4 * g + 2], v3 = accY[j][4 * g + 3];
          if (MLSTM) { v0 *= dinv; v1 *= dinv; v2 *= dinv; v3 *= dinv; }
          else if (d == 0) {
            v0 += dskip * bf2f(sXT[(x0 + 0) * 72 + t]); v1 += dskip * bf2f(sXT[(x0 + 1) * 72 + t]);
            v2 += dskip * bf2f(sXT[(x0 + 2) * 72 + t]); v3 += dskip * bf2f(sXT[(x0 + 3) * 72 + t]);
          }
          u32x2 pk; pk.x = pack2(v0, v1); pk.y = pack2(v2, v3);
          *(u32x2*)(outb + obase + x0) = pk;
        }
      }
      __syncthreads();
    }
    {
      const float eb = fexp(blast);
#pragma unroll
      for (int j = 0; j < 2; ++j)
#pragma unroll
        for (int r = 0; r < 16; ++r) accS[j][r] *= eb;
#pragma unroll
      for (int kk = 0; kk < 4; ++kk) {
        const int ko = kk * 16 + 8 * (lane >> 5);
        bf16x8 a = *(const bf16x8*)(sXT + (sx0 + (lane & 31)) * 72 + ko);
#pragma unroll
        for (int j = 0; j < 2; ++j) {
          bf16x8 bb = *(const bf16x8*)(sKT + (sk0 + j * 32 + (lane & 31)) * 72 + ko);
          accS[j] = mfma32(a, bb, accS[j]);
        }
      }
      if (FULL) {
#pragma unroll
        for (int j = 0; j < 2; ++j)
#pragma unroll
          for (int r = 0; r < 16; ++r) sST[(sx0 + acc_row(r, lane)) * QS + sk0 + j * 32 + (lane & 31)] = f2bf(accS[j][r]);
      }
      if (MLSTM) {
        const int k = tid >> 2, q4 = (tid & 3) * 16;
        float kf[16];
        unpack8(*(const u32x4*)(sKT + k * 72 + q4), kf); unpack8(*(const u32x4*)(sKT + k * 72 + q4 + 8), kf + 8);
        float ps = 0.f;
#pragma unroll
        for (int j = 0; j < 16; ++j) ps += kf[j];
        nreg = nreg * eb + sum4(ps);
        if (FULL && (tid & 3) == 0) sN[k] = nreg;
      }
    }
    __syncthreads();
  }
  if (!FULL) {
    const size_t it = (size_t)gsid * LA_NSEG + seg;
    float* U = segU + it * 8192;
#pragma unroll
    for (int j = 0; j < 2; ++j)
#pragma unroll
      for (int r = 0; r < 16; ++r) U[(j * 16 + r) * 256 + tid] = accS[j][r];
    if (MLSTM && (tid & 3) == 0) segN[it * 64 + (tid >> 2)] = nreg;
    if (tid == 0) segD[it] = lsum;
  }
}

DEV void st_finish_l0(const Params& P, int row) {
  const int lane = threadIdx.x & 63;
  bf16_t* hb = (bf16_t*)(P.ws + OFF_HBUF) + (size_t)row * 1024;
  const bf16_t* yb = (const bf16_t*)(P.ws + OFF_R2L0) + (size_t)row * 1024;
  const bf16_t* pr = (const bf16_t*)(P.ws + OFF_PROJ) + (size_t)row * EVC;
  const int ch = lane * 8;
  float h0[8], h1[8], o[8], f1[8];
  unpack8(*(const u32x4*)(hb + ch), h0);
  unpack8(*(const u32x4*)(hb + 512 + ch), h1);
  unpack8(*(const u32x4*)(pr + 1024 + ch), o);
  float ss = 0.f;
#pragma unroll
  for (int j = 0; j < 8; ++j) { h0[j] += h1[j]; ss += h0[j] * h0[j]; }
  ss = sum16(ss);
  float rstd = frsq(ss * (1.f / 128.f) + 1e-6f);
  float pw[8]; ld8(P.in[I_MNORM] + ch, pw);
#pragma unroll
  for (int j = 0; j < 8; ++j) f1[j] = h0[j] * rstd * pw[j] * sigmoidf_(o[j]);
  float y0[8], y1[8], z[8], f2[8];
  unpack8(*(const u32x4*)(yb + ch), y0);
  unpack8(*(const u32x4*)(yb + 512 + ch), y1);
  unpack8(*(const u32x4*)(pr + 1552 + ch), z);
  float s2 = 0.f;
#pragma unroll
  for (int j = 0; j < 8; ++j) { y0[j] = (y0[j] + y1[j]) * siluf_(z[j]); s2 += y0[j] * y0[j]; }
  s2 = wave_sum(s2);
  float rstd2 = frsq(s2 * (1.f / 512.f) + 1e-6f);
  ld8(P.in[I_SNORM] + ch, pw);
#pragma unroll
  for (int j = 0; j < 8; ++j) f2[j] = y0[j] * rstd2 * pw[j];
  *(u32x4*)(hb + ch) = pack8(f1);
  *(u32x4*)(hb + 512 + ch) = pack8(f2);
}

DEV float mixval(const bf16_t* __restrict__ proj, int row, int c, const float* __restrict__ mu) {
  float self = bf2f(proj[(size_t)row * ODC + c]);
  int nrow = -1;
  if (row < NCTX) {
    int pos = row % CTXL;
    if (c < 896) { if (pos > 0) nrow = row - 1; }
    else { if (pos < CTXL - 1) nrow = row + 1; }
  } else {
    int pos = (row - NCTX) % SEQ;
    int gx = pos % GW, gy = pos / GW, q = c / 448;
    if (q == 0) { if (gx > 0) nrow = row - 1; }
    else if (q == 1) { if (gx < GW - 1) nrow = row + 1; }
    else if (q == 2) { if (gy > 0) nrow = row - GW; }
    else { if (gy < SEQ / GW - 1) nrow = row + GW; }
  }
  float nb = nrow >= 0 ? bf2f(proj[(size_t)nrow * ODC + c]) : 0.f;
  return self + mu[c] * (nb - self);
}

DEV int nbr_row(int row, int c) {
  if (row < NCTX) {
    int pos = row % CTXL;
    if (c < 896) return pos > 0 ? row - 1 : -1;
    return pos < CTXL - 1 ? row + 1 : -1;
  }
  int pos = (row - NCTX) % SEQ;
  int gx = pos % GW, gy = pos / GW, q = c / 448;
  if (q == 0) return gx > 0 ? row - 1 : -1;
  if (q == 1) return gx < GW - 1 ? row + 1 : -1;
  if (q == 2) return gy > 0 ? row - GW : -1;
  return gy < SEQ / GW - 1 ? row + GW : -1;
}

DEV void mix8(const bf16_t* __restrict__ proj, int row, int c, const float* __restrict__ mu, float* o) {
  float xs[8], xn[8];
  unpack8(*(const u32x4*)(proj + (size_t)row * ODC + c), xs);
  const int nr = nbr_row(row, c);
  if (nr >= 0) unpack8(*(const u32x4*)(proj + (size_t)nr * ODC + c), xn);
  else {
#pragma unroll
    for (int j = 0; j < 8; ++j) xn[j] = 0.f;
  }
  const f32x4 m0 = *(const f32x4*)(mu + c), m1 = *(const f32x4*)(mu + c + 4);
  const float mm[8] = {m0.x, m0.y, m0.z, m0.w, m1.x, m1.y, m1.z, m1.w};
#pragma unroll
  for (int j = 0; j < 8; ++j) o[j] = xs[j] + mm[j] * (xn[j] - xs[j]);
}

DEV void st_lora_act(const Params& P, int row2) {
  const int lane = threadIdx.x & 63;
  const int row = row2 + (lane >> 5), c = (lane & 31) * 8;
  const bf16_t* proj = (const bf16_t*)(P.ws + OFF_PROJ);
  bf16_t* hb = (bf16_t*)(P.ws + OFF_HBUF) + (size_t)row * 1024;
  float v[8];
  mix8(proj, row, 1536 + c, P.in[I_MU], v);
#pragma unroll
  for (int j = 0; j < 8; ++j) v[j] = c < 64 ? tanhf_(v[j]) : (c < 128 ? v[j] : sigmoidf_(v[j]));
  *(u32x4*)(hb + c) = pack8(v);
}

DEV void st_rwkv_stream(const Params& P, int sid, unsigned char* smem) {
  const int tid = threadIdx.x, lane = tid & 63, wave = tid >> 6;
  const int d = sid & 1, h = (sid >> 1) & 7, b = sid >> 4;
  float* sR = (float*)smem;
  float* sW = sR + 2048;
  float* sKk = sW + 2048;
  float* sV = sKk + 2048;
  float* sA = sV + 2048;
  float* sBb = sA + 2048;
  float* sY = sBb + 2048;
  int* sRow = (int*)(sY + 2048);
  const bf16_t* proj = (const bf16_t*)(P.ws + OFF_PROJ);
  const bf16_t* lora = (const bf16_t*)(P.ws + OFF_LORA);
  bf16_t* yout = (bf16_t*)(P.ws + OFF_HBUF);
  const float* mu = P.in[I_MU];
  const int vrow = tid >> 2, j4 = tid & 3;
  float S[16];
#pragma unroll
  for (int i = 0; i < 16; ++i) S[i] = 0.f;
  const float kkw = P.in[I_KK][h * 64 + lane], kaw = P.in[I_KA][h * 64 + lane];
  for (int seg = 0; seg < 2; ++seg) {
    const int row0 = seg == 0 ? b * CTXL : NCTX + b * SEQ;
    const int len = seg == 0 ? CTXL : SEQ;
    for (int it = 0; it < len / 32; ++it) {
      __syncthreads();
      for (int s = wave; s < 32; s += 4) {
        int p = it * 32 + s, pos = d ? len - 1 - p : p, row = row0 + pos;
        int c = h * 64 + lane;
        float r = mixval(proj, row, c, mu);
        float k = mixval(proj, row, 512 + c, mu);
        float v = mixval(proj, row, 1024 + c, mu);
        float kk = k * kkw;
        float ss = wave_sum(kk * kk);
        kk *= frsq(ss + 1e-12f);
        float lw = bf2f(lora[((size_t)d * NTOK + row) * 512 + c]);
        float la = bf2f(lora[((size_t)(2 + d) * NTOK + row) * 512 + c]);
        float w = fexp(-0.6065306597126334f * sigmoidf_(lw));
        float a = sigmoidf_(la);
        float kt = k * (1.f + (a - 1.f) * kaw);
        sR[s * 64 + lane] = r; sW[s * 64 + lane] = w; sKk[s * 64 + lane] = kt; sV[s * 64 + lane] = v;
        sA[s * 64 + lane] = -kk; sBb[s * 64 + lane] = kk * a;
        if (lane == 0) sRow[s] = row;
      }
      __syncthreads();
      for (int s = 0; s < 32; ++s) {
        const float* pa = sA + s * 64 + j4 * 16;
        const float* pw = sW + s * 64 + j4 * 16;
        const float* pk = sKk + s * 64 + j4 * 16;
        const float* pb = sBb + s * 64 + j4 * 16;
        const float* pr = sR + s * 64 + j4 * 16;
        const float vv = sV[s * 64 + vrow];
        float sa = 0.f;
#pragma unroll
        for (int i = 0; i < 16; ++i) sa += S[i] * pa[i];
        sa = sum4(sa);
        float y = 0.f;
#pragma unroll
        for (int i = 0; i < 16; ++i) { S[i] = S[i] * pw[i] + sa * pb[i] + vv * pk[i]; y += S[i] * pr[i]; }
        y = sum4(y);
        if (j4 == 0) sY[s * 64 + vrow] = y;
      }
      __syncthreads();
      for (int i = tid; i < 2048; i += 256) {
        int s = i >> 6, c = i & 63;
        yout[(size_t)sRow[s] * 1024 + d * 512 + h * 64 + c] = f2bf(sY[i]);
      }
    }
  }
}


struct RwkvRaw { u32x4 rs, rn, ks, kn, vs, vn, lw, la; int row; };

DEV void rwkv_load_raw(const bf16_t* __restrict__ proj, const bf16_t* __restrict__ lora, int b, int h, int d, int cc, int t, int c0,
                       RwkvRaw& R) {
  constexpr int NC_CTX = CTXL / 32;
  const int seg = cc >= NC_CTX;
  const int row0 = seg ? NCTX + b * SEQ : b * CTXL;
  const int len = seg ? SEQ : CTXL;
  const int p = (seg ? cc - NC_CTX : cc) * 32 + t;
  const int row = row0 + (d ? len - 1 - p : p);
  const int col = h * 64 + c0;
  const u32x4 z4 = {0u, 0u, 0u, 0u};
  const bf16_t* rp = proj + (size_t)row * ODC;
  R.row = row;
  R.rs = *(const u32x4*)(rp + col);
  R.ks = *(const u32x4*)(rp + 512 + col);
  R.vs = *(const u32x4*)(rp + 1024 + col);
  int n0 = nbr_row(row, col), n1 = nbr_row(row, 512 + col), n2 = nbr_row(row, 1024 + col);
  R.rn = n0 >= 0 ? *(const u32x4*)(proj + (size_t)n0 * ODC + col) : z4;
  R.kn = n1 >= 0 ? *(const u32x4*)(proj + (size_t)n1 * ODC + 512 + col) : z4;
  R.vn = n2 >= 0 ? *(const u32x4*)(proj + (size_t)n2 * ODC + 1024 + col) : z4;
  R.lw = *(const u32x4*)(lora + ((size_t)d * NTOK + row) * 512 + col);
  R.la = *(const u32x4*)(lora + ((size_t)(2 + d) * NTOK + row) * 512 + col);
}

#ifndef RW_NSEG
#define RW_NSEG 16
#endif
constexpr int RW_NCH = (CTXL + SEQ) / 32;
constexpr size_t OFF_RWSEG = OFF_PU;
static_assert((size_t)32 * RW_NSEG * 64 * 128 * 4 <= (size_t)2 * NEXP * 1024, "rwseg");

template <bool FULL>
DEV void st_rwkv_seg(const Params& P, int sid, int seg, unsigned char* smem) {
  constexpr int NVB = FULL ? 2 : 4;
  constexpr int ZR = FULL ? 64 : 128;
  const int tid = threadIdx.x, lane = tid & 63, wave = tid >> 6;
  const int d = sid & 1, h = (sid >> 1) & 7, b = sid >> 4;
  bf16_t* sAt = (bf16_t*)smem;
  bf16_t* sRt = sAt + 32 * 72;
  bf16_t* sBt = sRt + 32 * 72;
  bf16_t* sKt = sBt + 32 * 72;
  bf16_t* sBT = sKt + 32 * 72;
  bf16_t* sKT = sBT + 64 * 40;
  bf16_t* sVT = sKT + 64 * 40;
  bf16_t* sLak = sVT + 64 * 40;
  bf16_t* sM = sLak + 32 * 40;
  bf16_t* sLrb = sM + 32 * 40;
  bf16_t* sLrk = sLrb + 32 * 40;
  bf16_t* sZ = FULL ? sLrk + 32 * 40 : sLrb;
  bf16_t* after = sZ + ZR * 72;
  bf16_t* sRT = FULL ? after : nullptr;
  bf16_t* sSAT = FULL ? after + 64 * 40 : sRt;
  float* sLP = (float*)(FULL ? after + 2 * 64 * 40 : after);
  float* sLab = sLP + 32 * 64;
  float* sD = sLab + 32 * 33;
  float* sPT = sD + 768;
  int* sRow = (int*)(sPT + 64);
  if (!FULL) sRT = (bf16_t*)sLP;
  static_assert((4 * 32 * 72 + 3 * 64 * 40 + 4 * 32 * 40 + 2 * 64 * 40 + 64 * 72) * 2 + (32 * 64 + 32 * 33 + 768 + 64 + 32 + 320) * 4 + 16 <= SMEM_BYTES, "lds full");
  static_assert((4 * 32 * 72 + 3 * 64 * 40 + 2 * 32 * 40 + 128 * 72) * 2 + (32 * 64 + 32 * 33 + 768 + 64 + 32) * 4 <= SMEM_BYTES, "lds p1");
  static_assert(128 * 40 * 2 <= (32 * 64 + 32 * 33) * 4 && 128 * 40 <= 3 * 32 * 72, "alias");
  const bf16_t* proj = (const bf16_t*)(P.ws + OFF_PROJ);
  const bf16_t* lora = (const bf16_t*)(P.ws + OFF_LORA);
  bf16_t* yout = (bf16_t*)(P.ws + OFF_HBUF);
  float* segZ = (float*)(P.ws + OFF_RWSEG);
  const int t = tid >> 3, c0 = (tid & 7) * 8;
  const int hl = lane >> 5, l31 = lane & 31;
  float* sCst = (float*)(smem + SMEM_BYTES - 320 * 4 - 16);
  if (tid < 64) {
    sCst[tid] = P.in[I_MU][h * 64 + tid]; sCst[64 + tid] = P.in[I_MU][512 + h * 64 + tid]; sCst[128 + tid] = P.in[I_MU][1024 + h * 64 + tid];
    sCst[192 + tid] = P.in[I_KK][h * 64 + tid]; sCst[256 + tid] = P.in[I_KA][h * 64 + tid];
  }
  const int cc0 = (seg * RW_NCH) / RW_NSEG, cc1 = ((seg + 1) * RW_NCH) / RW_NSEG;
  RwkvRaw R;
  rwkv_load_raw(proj, lora, b, h, d, cc0, t, c0, R);
  f32x16 Zm[2];
#pragma unroll
  for (int j = 0; j < 2; ++j)
#pragma unroll
    for (int r = 0; r < 16; ++r) Zm[j][r] = 0.f;
  __syncthreads();
  for (int i = tid; i < ZR * 72; i += 256) sZ[i] = 0;
  __syncthreads();
  if (!FULL) {
    if (wave >= 2) {
#pragma unroll
      for (int cb = 0; cb < 2; ++cb)
#pragma unroll
        for (int r = 0; r < 16; ++r) {
          int c = cb * 32 + acc_row(r, lane), vp = wave * 32 + l31;
          if (c == vp - 64) { Zm[cb][r] = 1.f; sZ[vp * 72 + c] = 0x3f80; }
        }
    }
  } else {
    for (int js = 0; js < seg; ++js) {
      const float* Zs = segZ + ((size_t)sid * RW_NSEG + js) * 64 * 128;
      bf16_t* sG = sAt;
      {
        const int c = tid >> 2, c2 = (tid & 3) * 16;
        float gv[16];
        ld8(Zs + c * 128 + 64 + c2, gv); ld8(Zs + c * 128 + 64 + c2 + 8, gv + 8);
        *(u32x4*)(sG + c * 72 + c2) = pack8(gv);
        *(u32x4*)(sG + c * 72 + c2 + 8) = pack8(gv + 8);
      }
      __syncthreads();
      if (wave >= 2) {
        const int cb = wave - 2;
#pragma unroll
        for (int vb = 0; vb < 2; ++vb) {
          f32x16 acc;
#pragma unroll
          for (int r = 0; r < 16; ++r) acc[r] = Zs[(cb * 32 + acc_row(r, lane)) * 128 + vb * 32 + l31];
#pragma unroll
          for (int kk = 0; kk < 4; ++kk) {
            bf16x8 a = *(const bf16x8*)(sG + (cb * 32 + l31) * 72 + kk * 16 + 8 * hl);
            bf16x8 bb = *(const bf16x8*)(sZ + (vb * 32 + l31) * 72 + kk * 16 + 8 * hl);
            acc = mfma32(a, bb, acc);
          }
          Zm[vb] = acc;
        }
      }
      __syncthreads();
      if (wave >= 2) {
        const int cb = wave - 2;
#pragma unroll
        for (int vb = 0; vb < 2; ++vb)
#pragma unroll
          for (int g = 0; g < 4; ++g) {
            u32x2 pk; pk.x = pack2(Zm[vb][4 * g], Zm[vb][4 * g + 1]); pk.y = pack2(Zm[vb][4 * g + 2], Zm[vb][4 * g + 3]);
            *(u32x2*)(sZ + (vb * 32 + l31) * 72 + cb * 32 + 8 * g + 4 * hl) = pk;
          }
      }
      __syncthreads();
    }
  }
  for (int cc = cc0; cc < cc1; ++cc) {
    int tl_ = threadIdx.x; OPAQUE(tl_);
    const int tid = tl_, lane = tl_ & 63, hl = lane >> 5, l31 = lane & 31, t = tl_ >> 3, c0 = (tl_ & 7) * 8;
    const float* muR = sCst + c0; const float* muK = sCst + 64 + c0; const float* muV = sCst + 128 + c0;
    const float* kkw = sCst + 192 + c0; const float* kaw = sCst + 256 + c0;
    float lw8[8], lp8[8];
    {
      float lwf[8];
      unpack8(R.lw, lwf);
#pragma unroll
      for (int j = 0; j < 8; ++j) { lw8[j] = -0.6065306597126334f * sigmoidf_(lwf[j]); lp8[j] = lw8[j]; }
#pragma unroll
      for (int off = 8; off < 64; off <<= 1) {
#pragma unroll
        for (int j = 0; j < 8; ++j) {
#ifdef CPU_EMU
          float o = emu_shfl_up(lp8[j], off);
#else
          float o = __shfl_up(lp8[j], off, 64);
#endif
          if (lane >= off) lp8[j] += o;
        }
      }
      if (lane >= 56) {
#pragma unroll
        for (int j = 0; j < 8; ++j) sLP[wave * 64 + c0 + j] = lp8[j];
      }
      if ((tid & 7) == 0) sRow[t] = R.row;
    }
    __syncthreads();
    {
#pragma unroll
      for (int j = 0; j < 8; ++j) {
        float offs = 0.f;
        for (int w2 = 0; w2 < wave; ++w2) offs += sLP[w2 * 64 + c0 + j];
        lp8[j] += offs;
      }
      if (t == 31) {
#pragma unroll
        for (int j = 0; j < 8; ++j) sPT[c0 + j] = fexp(lp8[j]);
      }
    }
    {
      float xs[8], xn[8], kt[8], aa[8], ob[8], ok[8];
      unpack8(R.ks, xs); unpack8(R.kn, xn);
      float ss = 0.f;
#pragma unroll
      for (int j = 0; j < 8; ++j) { kt[j] = xs[j] + muK[j] * (xn[j] - xs[j]); aa[j] = kt[j] * kkw[j]; ss += aa[j] * aa[j]; }
      ss = sum8(ss);
      const float rn = frsq(ss + 1e-12f);
      float laf[8];
      unpack8(R.la, laf);
#pragma unroll
      for (int j = 0; j < 8; ++j) {
        const float lp = lp8[j];
        const float lpm = lp8[j] - lw8[j];
        const float e = fexp(-lp);
        const float kkn = aa[j] * rn;
        const float asg = sigmoidf_(laf[j]);
        aa[j] = -kkn * fexp(lpm);
        ob[j] = kkn * asg * e;
        ok[j] = kt[j] * (1.f + (asg - 1.f) * kaw[j]) * e;
      }
      *(u32x4*)(sAt + t * 72 + c0) = pack8(aa);
      *(u32x4*)(sBt + t * 72 + c0) = pack8(ob);
      *(u32x4*)(sKt + t * 72 + c0) = pack8(ok);
#pragma unroll
      for (int j = 0; j < 8; ++j) { sBT[(c0 + j) * 40 + t] = f2bf(ob[j]); sKT[(c0 + j) * 40 + t] = f2bf(ok[j]); }
      unpack8(R.vs, xs); unpack8(R.vn, xn);
#pragma unroll
      for (int j = 0; j < 8; ++j) sVT[(c0 + j) * 40 + t] = f2bf(xs[j] + muV[j] * (xn[j] - xs[j]));
      if (FULL) {
        unpack8(R.rs, xs); unpack8(R.rn, xn);
#pragma unroll
        for (int j = 0; j < 8; ++j) xs[j] = (xs[j] + muR[j] * (xn[j] - xs[j])) * fexp(lp8[j]);
        *(u32x4*)(sRt + t * 72 + c0) = pack8(xs);
      }
    }
    if (cc + 1 < cc1) rwkv_load_raw(proj, lora, b, h, d, cc + 1, t, c0, R);
    __syncthreads();
    if (FULL || wave < 2) {
      const bf16_t* Asrc = wave < 2 ? sAt : sRt;
      const bf16_t* Bsrc = (wave & 1) ? sKt : sBt;
      f32x16 acc;
#pragma unroll
      for (int r = 0; r < 16; ++r) acc[r] = 0.f;
#pragma unroll
      for (int kk = 0; kk < 4; ++kk) {
        bf16x8 a = *(const bf16x8*)(Asrc + l31 * 72 + kk * 16 + 8 * hl);
        bf16x8 bb = *(const bf16x8*)(Bsrc + l31 * 72 + kk * 16 + 8 * hl);
        acc = mfma32(a, bb, acc);
      }
      bf16_t* dst = wave == 1 ? sLak : (wave == 2 ? sLrb : sLrk);
#pragma unroll
      for (int r = 0; r < 16; ++r) {
        int tt = acc_row(r, lane), j = l31;
        bool keep = wave < 2 ? (j < tt) : (j <= tt);
        float v = keep ? acc[r] : 0.f;
        if (wave == 0) sLab[tt * 33 + j] = v;
        else dst[tt * 40 + j] = f2bf(v);
      }
    }
    __syncthreads();
    if (tid < 32) {
      const int q = tid >> 4, c = tid & 15;
      float x[16];
#pragma unroll
      for (int i = 0; i < 16; ++i) {
        float sacc = (i == c) ? 1.f : 0.f;
#pragma unroll
        for (int j = 0; j < i; ++j) sacc += sLab[(q * 16 + i) * 33 + q * 16 + j] * x[j];
        x[i] = sacc;
        sD[q * 256 + i * 16 + c] = sacc;
      }
    }
    __syncthreads();
    {
      const int i = tid >> 4, c = tid & 15;
      float sacc = 0.f;
#pragma unroll
      for (int j = 0; j < 16; ++j) sacc += sLab[(16 + i) * 33 + j] * sD[j * 16 + c];
      sD[512 + i * 16 + c] = sacc;
    }
    __syncthreads();
    {
      const int i = tid >> 4, c = tid & 15;
      float sacc = 0.f;
#pragma unroll
      for (int j = 0; j < 16; ++j) sacc += sD[256 + i * 16 + j] * sD[512 + j * 16 + c];
      sM[(16 + i) * 40 + c] = f2bf(sacc);
      sM[i * 40 + c] = f2bf(sD[i * 16 + c]);
      sM[(16 + i) * 40 + 16 + c] = f2bf(sD[256 + i * 16 + c]);
      sM[i * 40 + 16 + c] = 0;
    }
    if (wave < NVB) {
      const int vb = wave;
      f32x16 acc;
#pragma unroll
      for (int r = 0; r < 16; ++r) acc[r] = 0.f;
#pragma unroll
      for (int kk = 0; kk < 4; ++kk) {
        bf16x8 a = *(const bf16x8*)(sAt + l31 * 72 + kk * 16 + 8 * hl);
        bf16x8 bb = *(const bf16x8*)(sZ + (vb * 32 + l31) * 72 + kk * 16 + 8 * hl);
        acc = mfma32(a, bb, acc);
      }
      if (vb < 2) {
#pragma unroll
        for (int kk = 0; kk < 2; ++kk) {
          bf16x8 a = *(const bf16x8*)(sLak + l31 * 40 + kk * 16 + 8 * hl);
          bf16x8 bb = *(const bf16x8*)(sVT + (vb * 32 + l31) * 40 + kk * 16 + 8 * hl);
          acc = mfma32(a, bb, acc);
        }
      }
#pragma unroll
      for (int g = 0; g < 4; ++g) {
        u32x2 pk; pk.x = pack2(acc[4 * g], acc[4 * g + 1]); pk.y = pack2(acc[4 * g + 2], acc[4 * g + 3]);
        *(u32x2*)(sRT + (vb * 32 + l31) * 40 + 8 * g + 4 * hl) = pk;
      }
    }
    __syncthreads();
    if (wave < NVB) {
      const int vb = wave;
      f32x16 acc;
#pragma unroll
      for (int r = 0; r < 16; ++r) acc[r] = 0.f;
#pragma unroll
      for (int kk = 0; kk < 2; ++kk) {
        bf16x8 a = *(const bf16x8*)(sM + l31 * 40 + kk * 16 + 8 * hl);
        bf16x8 bb = *(const bf16x8*)(sRT + (vb * 32 + l31) * 40 + kk * 16 + 8 * hl);
        acc = mfma32(a, bb, acc);
      }
#pragma unroll
      for (int g = 0; g < 4; ++g) {
        u32x2 pk; pk.x = pack2(acc[4 * g], acc[4 * g + 1]); pk.y = pack2(acc[4 * g + 2], acc[4 * g + 3]);
        *(u32x2*)(sSAT + (vb * 32 + l31) * 40 + 8 * g + 4 * hl) = pk;
      }
    }
    __syncthreads();
    if (FULL) {
      if (wave < 2) {
        const int vb = wave;
        f32x16 acc;
#pragma unroll
        for (int r = 0; r < 16; ++r) acc[r] = 0.f;
#pragma unroll
        for (int kk = 0; kk < 4; ++kk) {
          bf16x8 a = *(const bf16x8*)(sZ + (vb * 32 + l31) * 72 + kk * 16 + 8 * hl);
          bf16x8 bb = *(const bf16x8*)(sRt + l31 * 72 + kk * 16 + 8 * hl);
          acc = mfma32(a, bb, acc);
        }
#pragma unroll
        for (int kk = 0; kk < 2; ++kk) {
          bf16x8 a = *(const bf16x8*)(sSAT + (vb * 32 + l31) * 40 + kk * 16 + 8 * hl);
          bf16x8 bb = *(const bf16x8*)(sLrb + l31 * 40 + kk * 16 + 8 * hl);
          acc = mfma32(a, bb, acc);
        }
#pragma unroll
        for (int kk = 0; kk < 2; ++kk) {
          bf16x8 a = *(const bf16x8*)(sVT + (vb * 32 + l31) * 40 + kk * 16 + 8 * hl);
          bf16x8 bb = *(const bf16x8*)(sLrk + l31 * 40 + kk * 16 + 8 * hl);
          acc = mfma32(a, bb, acc);
        }
        {
          const size_t obase = (size_t)sRow[l31] * 1024 + d * 512 + h * 64 + vb * 32;
#pragma unroll
          for (int g = 0; g < 4; ++g) {
            u32x2 pk; pk.x = pack2(acc[4 * g], acc[4 * g + 1]); pk.y = pack2(acc[4 * g + 2], acc[4 * g + 3]);
            *(u32x2*)(yout + obase + 8 * g + 4 * hl) = pk;
          }
        }
      } else {
        const int cb = wave - 2;
#pragma unroll
        for (int vb = 0; vb < 2; ++vb) {
          f32x16 acc;
#pragma unroll
          for (int r = 0; r < 16; ++r) acc[r] = 0.f;
#pragma unroll
          for (int kk = 0; kk < 2; ++kk) {
            bf16x8 a = *(const bf16x8*)(sBT + (cb * 32 + l31) * 40 + kk * 16 + 8 * hl);
            bf16x8 bb = *(const bf16x8*)(sSAT + (vb * 32 + l31) * 40 + kk * 16 + 8 * hl);
            acc = mfma32(a, bb, acc);
          }
#pragma unroll
          for (int kk = 0; kk < 2; ++kk) {
            bf16x8 a = *(const bf16x8*)(sKT + (cb * 32 + l31) * 40 + kk * 16 + 8 * hl);
            bf16x8 bb = *(const bf16x8*)(sVT + (vb * 32 + l31) * 40 + kk * 16 + 8 * hl);
            acc = mfma32(a, bb, acc);
          }
#pragma unroll
          for (int r = 0; r < 16; ++r) Zm[vb][r] = sPT[cb * 32 + acc_row(r, lane)] * (Zm[vb][r] + acc[r]);
        }
      }
      __syncthreads();
      if (wave >= 2) {
        const int cb = wave - 2;
#pragma unroll
        for (int vb = 0; vb < 2; ++vb)
#pragma unroll
          for (int g = 0; g < 4; ++g) {
            u32x2 pk; pk.x = pack2(Zm[vb][4 * g], Zm[vb][4 * g + 1]); pk.y = pack2(Zm[vb][4 * g + 2], Zm[vb][4 * g + 3]);
            *(u32x2*)(sZ + (vb * 32 + l31) * 72 + cb * 32 + 8 * g + 4 * hl) = pk;
          }
      }
    } else {
      const int vb = wave;
#pragma unroll
      for (int cb = 0; cb < 2; ++cb) {
        f32x16 acc;
#pragma unroll
        for (int r = 0; r < 16; ++r) acc[r] = 0.f;
#pragma unroll
        for (int kk = 0; kk < 2; ++kk) {
          bf16x8 a = *(const bf16x8*)(sBT + (cb * 32 + l31) * 40 + kk * 16 + 8 * hl);
          bf16x8 bb = *(const bf16x8*)(sSAT + (vb * 32 + l31) * 40 + kk * 16 + 8 * hl);
          acc = mfma32(a, bb, acc);
        }
        if (vb < 2) {
#pragma unroll
          for (int kk = 0; kk < 2; ++kk) {
            bf16x8 a = *(const bf16x8*)(sKT + (cb * 32 + l31) * 40 + kk * 16 + 8 * hl);
            bf16x8 bb = *(const bf16x8*)(sVT + (vb * 32 + l31) * 40 + kk * 16 + 8 * hl);
            acc = mfma32(a, bb, acc);
          }
        }
#pragma unroll
        for (int r = 0; r < 16; ++r) Zm[cb][r] = sPT[cb * 32 + acc_row(r, lane)] * (Zm[cb][r] + acc[r]);
      }
#pragma unroll
      for (int cb = 0; cb < 2; ++cb)
#pragma unroll
        for (int g = 0; g < 4; ++g) {
          u32x2 pk; pk.x = pack2(Zm[cb][4 * g], Zm[cb][4 * g + 1]); pk.y = pack2(Zm[cb][4 * g + 2], Zm[cb][4 * g + 3]);
          *(u32x2*)(sZ + (vb * 32 + l31) * 72 + cb * 32 + 8 * g + 4 * hl) = pk;
        }
    }
  }
  if (!FULL) {
    float* Zs = segZ + ((size_t)sid * RW_NSEG + seg) * 64 * 128;
#pragma unroll
    for (int cb = 0; cb < 2; ++cb)
#pragma unroll
      for (int r = 0; r < 16; ++r) Zs[(cb * 32 + acc_row(r, lane)) * 128 + wave * 32 + l31] = Zm[cb][r];
  }
}

constexpr int LRU_NCH = (CTXL + SEQ) / 64;
constexpr size_t OFF_ACUM0 = OFF_PU;
static_assert((size_t)NLAT * 512 * 2 <= (size_t)2 * NEXP * 1024, "acum0");

struct LruRaw { u32x4 x[2][4]; };
DEV void lru_load_raw(const Params& P, int sid, int cc, LruRaw& R) {
  constexpr int NC_CTX = CTXL / 64;
  const int tid = threadIdx.x;
  const int d = sid & 1, blk = (sid >> 1) & 7, b = sid >> 4;
  const bf16_t* proj = (const bf16_t*)(P.ws + OFF_PROJ);
  const int sgi = cc >= NC_CTX;
  const int row0 = sgi ? NCTX + b * SEQ : b * CTXL;
  const int len = sgi ? SEQ : CTXL;
  const int cl = (sgi ? cc - NC_CTX : cc) * 64;
  const int lch = blk * 64 + (tid & 7) * 8;
  const u32x4 z4 = {0u, 0u, 0u, 0u};
#pragma unroll
  for (int i = 0; i < 2; ++i) {
    int c = tid + i * 256, r = c >> 3;
    int p = cl + r, pos = d ? len - 1 - p : p;
#pragma unroll
    for (int tap = 0; tap < 4; ++tap) {
      int pp = pos + tap - 2;
      R.x[i][tap] = (pp >= 0 && pp < len) ? *(const u32x4*)(proj + (size_t)(row0 + pp) * ODC + 2304 + lch) : z4;
    }
  }
}

DEV void st_lru_chunk(const Params& P, int sid, int cc, int nsid, int ncc, bool has_next, LruRaw& R, unsigned char* smem) {
  constexpr int NC_CTX = CTXL / 64;
  const int tid = threadIdx.x, lane = tid & 63, wave = tid >> 6;
  const int d = sid & 1, blk = (sid >> 1) & 7, b = sid >> 4;
  float* sXc = (float*)smem;
  float* sAc = sXc + 4096;
  float* sBc = sAc + 4096;
  float* sU = sBc + 4096;
  bf16_t* sAop = (bf16_t*)(sU + 4096);
  float* sQA = (float*)(sAop + 64 * 72);
  float* sQH = sQA + 256;
  int* sRow = (int*)(sQH + 256);
  const bf16_t* proj = (const bf16_t*)(P.ws + OFF_PROJ);
  bf16_t* uout = (bf16_t*)(P.ws + OFF_LORA) + (size_t)d * NTOK * 512;
  bf16_t* aout = (bf16_t*)(P.ws + (d ? OFF_ACUM1 : OFF_ACUM0));
  const bf16_t* lruT = (const bf16_t*)(P.ws + OFF_LRUT) + (size_t)(d * 8 + blk) * 128 * 64;
  float* chunkS = (float*)(P.ws + OFF_LRUCS) + ((size_t)sid * LRU_NCH + cc) * 128;
  const float* cw = P.in[I_LCONVW];
  const float* cb = P.in[I_LCONVB];
  const int tr = (wave >> 1) * 32, nc0 = (wave & 1) * 64;
  const int sgi = cc >= NC_CTX;
  const int row0 = sgi ? NCTX + b * SEQ : b * CTXL;
  const int len = sgi ? SEQ : CTXL;
  const int cl = (sgi ? cc - NC_CTX : cc) * 64;
  __syncthreads();
  if (tid < 64) { int p = cl + tid; sRow[tid] = row0 + (d ? len - 1 - p : p); }
  {
    const int lc8 = (tid & 7) * 8, lch = blk * 64 + lc8;
#pragma unroll
    for (int i = 0; i < 2; ++i) {
      int c = tid + i * 256, r = c >> 3;
      int p = cl + r, pos = d ? len - 1 - p : p;
      float o[8];
      f32x4 c0 = *(const f32x4*)(cb + lch), c1 = *(const f32x4*)(cb + lch + 4);
      o[0] = c0.x; o[1] = c0.y; o[2] = c0.z; o[3] = c0.w; o[4] = c1.x; o[5] = c1.y; o[6] = c1.z; o[7] = c1.w;
#pragma unroll
      for (int tap = 0; tap < 4; ++tap) {
        float x[8];
        unpack8(R.x[i][tap], x);
        f32x4 w0 = *(const f32x4*)(cw + tap * 512 + lch), w1 = *(const f32x4*)(cw + tap * 512 + lch + 4);
        o[0] += w0.x * x[0]; o[1] += w0.y * x[1]; o[2] += w0.z * x[2]; o[3] += w0.w * x[3];
        o[4] += w1.x * x[4]; o[5] += w1.y * x[5]; o[6] += w1.z * x[6]; o[7] += w1.w * x[7];
      }
#pragma unroll
      for (int j = 0; j < 8; ++j) sXc[r * 64 + lc8 + j] = o[j];
      *(u32x4*)(sAop + r * 72 + lc8) = pack8(o);
    }
  }
  if (has_next) lru_load_raw(P, nsid, ncc, R);
  __syncthreads();
  {
    f32x16 acc[2];
#pragma unroll
    for (int j = 0; j < 2; ++j)
#pragma unroll
      for (int r = 0; r < 16; ++r) acc[j][r] = 0.f;
#pragma unroll
    for (int kk = 0; kk < 4; ++kk) {
      bf16x8 a = *(const bf16x8*)(sAop + (tr + (lane & 31)) * 72 + kk * 16 + 8 * (lane >> 5));
#pragma unroll
      for (int j = 0; j < 2; ++j) {
        bf16x8 bb = *(const bf16x8*)(lruT + (nc0 + j * 32 + (lane & 31)) * 64 + kk * 16 + 8 * (lane >> 5));
        acc[j] = mfma32(a, bb, acc[j]);
      }
    }
#pragma unroll
    for (int j = 0; j < 2; ++j) {
      const int e = nc0 + j * 32 + (lane & 31);
      const int ch = blk * 64 + (e & 63);
      const float ebias = e < 64 ? P.in[I_BA][d * 512 + ch] : P.in[I_BI][d * 512 + ch];
      const float esp = softplusf_(-P.in[I_LAM][d * 512 + ch]);
#pragma unroll
      for (int r = 0; r < 16; ++r) {
        int t = tr + acc_row(r, lane);
        float g = sigmoidf_(acc[j][r] + ebias);
        if (e < 64) { float a_ = fexp(-8.f * g * esp); sAc[t * 64 + e] = a_; sU[t * 64 + e] = fsqrt(fmaxf(1.f - a_ * a_, 0.f)); }
        else sBc[t * 64 + (e - 64)] = g * sXc[t * 64 + (e - 64)];
      }
    }
  }
  __syncthreads();
  const int c = tid & 63, q = tid >> 6;
  {
    float h = 0.f, ap = 1.f;
#pragma unroll 4
    for (int i = 0; i < 16; ++i) {
      const int t = q * 16 + i;
      const float a = sAc[t * 64 + c];
      h = a * h + sU[t * 64 + c] * sBc[t * 64 + c];
      ap *= a;
      sU[t * 64 + c] = h; sAc[t * 64 + c] = ap;
    }
    sQA[q * 64 + c] = ap; sQH[q * 64 + c] = h;
  }
  __syncthreads();
  {
    float hin = 0.f, ain = 1.f;
    for (int q2 = 0; q2 < q; ++q2) { hin = sQA[q2 * 64 + c] * hin + sQH[q2 * 64 + c]; ain *= sQA[q2 * 64 + c]; }
    if (q > 0) {
#pragma unroll 4
      for (int i = 0; i < 16; ++i) {
        const int t = q * 16 + i;
        const float ap = sAc[t * 64 + c];
        sU[t * 64 + c] += ap * hin;
        sAc[t * 64 + c] = ap * ain;
      }
    }
    if (q == 3) { chunkS[c] = sAc[63 * 64 + c]; chunkS[64 + c] = sU[63 * 64 + c]; }
  }
  __syncthreads();
  if (sgi) {
#pragma unroll
    for (int i = 0; i < 2; ++i) {
      int cidx = tid + i * 256, r = cidx >> 3, c8 = (cidx & 7) * 8;
      float u8[8], a8[8];
#pragma unroll
      for (int j = 0; j < 8; ++j) { u8[j] = sU[r * 64 + c8 + j]; a8[j] = sAc[r * 64 + c8 + j]; }
      const int row = sRow[r];
      *(u32x4*)(uout + (size_t)row * 512 + blk * 64 + c8) = pack8(u8);
      *(u32x4*)(aout + (size_t)(row - NCTX) * 512 + blk * 64 + c8) = pack8(a8);
    }
  }
}

DEV void st_lru_carry(const Params& P, int sid) {
  const int c = threadIdx.x;
  if (c >= 64) return;
  const float* cs = (const float*)(P.ws + OFF_LRUCS) + (size_t)sid * LRU_NCH * 128;
  float* hs = (float*)(P.ws + OFF_LRUHS) + (size_t)sid * LRU_NCH * 64;
  float h = 0.f;
  for (int cc0 = 0; cc0 < LRU_NCH; cc0 += 10) {
    float a[10], bb[10];
#pragma unroll
    for (int i = 0; i < 10; ++i) { a[i] = cs[(size_t)(cc0 + i) * 128 + c]; bb[i] = cs[(size_t)(cc0 + i) * 128 + 64 + c]; }
#pragma unroll
    for (int i = 0; i < 10; ++i) { hs[(size_t)(cc0 + i) * 64 + c] = h; h = a[i] * h + bb[i]; }
  }
}

DEV void st_finish_l1(const Params& P, int row) {
  const int lane = threadIdx.x & 63;
  bf16_t* hb = (bf16_t*)(P.ws + OFF_HBUF) + (size_t)row * 1024;
  const bf16_t* proj = (const bf16_t*)(P.ws + OFF_PROJ);
  const bf16_t* lora = (const bf16_t*)(P.ws + OFF_LORA);
  const float* mu = P.in[I_MU];
  const int ch = lane * 8;
  float y0[8], y1[8];
  unpack8(*(const u32x4*)(hb + ch), y0);
  unpack8(*(const u32x4*)(hb + 512 + ch), y1);
  float sm = 0.f;
#pragma unroll
  for (int j = 0; j < 8; ++j) { y0[j] += y1[j]; sm += y0[j]; }
  sm = sum8(sm);
  const float mean = sm * (1.f / 64.f);
  float sv = 0.f;
#pragma unroll
  for (int j = 0; j < 8; ++j) { float dlt = y0[j] - mean; sv += dlt * dlt; }
  sv = sum8(sv);
  const float rstd = frsq(sv * (1.f / 64.f) + 64e-5f);
  float a0[8], a1[8], g[8], u0[8], u1[8], gb[8];
  unpack8(*(const u32x4*)(lora + ((size_t)2 * NTOK + row) * 512 + ch), a0);
  unpack8(*(const u32x4*)(lora + ((size_t)3 * NTOK + row) * 512 + ch), a1);
  unpack8(*(const u32x4*)(lora + ((size_t)4 * NTOK + row) * 512 + ch), g);
  unpack8(*(const u32x4*)(lora + ((size_t)0 * NTOK + row) * 512 + ch), u0);
  unpack8(*(const u32x4*)(lora + ((size_t)1 * NTOK + row) * 512 + ch), u1);
  if (row >= NCTX) {
    const int bb_ = (row - NCTX) / SEQ, pos = (row - NCTX) % SEQ, blk = ch >> 6;
    float ac[8];
#pragma unroll
    for (int dd = 0; dd < 2; ++dd) {
      const int pidx = dd ? SEQ - 1 - pos : pos;
      const int cc = CTXL / 64 + pidx / 64;
      const int sid = (bb_ * 8 + blk) * 2 + dd;
      const float* hs = (const float*)(P.ws + OFF_LRUHS) + ((size_t)sid * LRU_NCH + cc) * 64 + (ch & 63);
      unpack8(*(const u32x4*)((const bf16_t*)(P.ws + (dd ? OFF_ACUM1 : OFF_ACUM0)) + (size_t)(row - NCTX) * 512 + ch), ac);
      f32x4 h0 = *(const f32x4*)hs, h1 = *(const f32x4*)(hs + 4);
      float* u = dd ? u1 : u0;
      u[0] += ac[0] * h0.x; u[1] += ac[1] * h0.y; u[2] += ac[2] * h0.z; u[3] += ac[3] * h0.w;
      u[4] += ac[4] * h1.x; u[5] += ac[5] * h1.y; u[6] += ac[6] * h1.z; u[7] += ac[7] * h1.w;
    }
  }
  unpack8(*(const u32x4*)(proj + (size_t)row * ODC + 1792 + ch), gb);
  float rv[8], vv[8], kv[8];
  float sdot = 0.f;
  float pka[8], prk[8], plw[8], plb[8];
  ld8(P.in[I_KA] + ch, pka); ld8(P.in[I_RK] + ch, prk); ld8(P.in[I_LNW] + ch, plw); ld8(P.in[I_LNB] + ch, plb);
  mix8(proj, row, ch, mu, rv);
  mix8(proj, row, 512 + ch, mu, kv);
  mix8(proj, row, 1024 + ch, mu, vv);
#pragma unroll
  for (int j = 0; j < 8; ++j) {
    float r = rv[j];
    float k = kv[j];
    float am = 0.5f * (sigmoidf_(a0[j]) + sigmoidf_(a1[j]));
    float kb = k * (1.f + (am - 1.f) * pka[j]);
    sdot += r * kb * prk[j];
    rv[j] = r;
  }
  sdot = sum8(sdot);
  float f1[8], f2[8];
#pragma unroll
  for (int j = 0; j < 8; ++j) {
    float yn = (y0[j] - mean) * rstd * plw[j] + plb[j];
    yn += sdot * vv[j];
    f1[j] = yn * g[j];
    f2[j] = (u0[j] + u1[j]) * geluf_(gb[j]);
  }
  *(u32x4*)(hb + ch) = pack8(f1);
  *(u32x4*)(hb + 512 + ch) = pack8(f2);
}

DEV unsigned fkey(float f) { unsigned u; __builtin_memcpy(&u, &f, 4); return (u >> 31) ? ~u : (u | 0x80000000u); }
DEV float keyf(unsigned u) { u = (u >> 31) ? (u & 0x7fffffffu) : ~u; float f; __builtin_memcpy(&f, &u, 4); return f; }
DEV void key_insert(unsigned x, unsigned* v) {
#pragma unroll
  for (int j = 0; j < 16; ++j) { unsigned hi = v[j] > x ? v[j] : x; x = v[j] > x ? x : v[j]; v[j] = hi; }
}
DEV void key_cx(unsigned& hi, unsigned& lo) { unsigned a = hi, b = lo; hi = a > b ? a : b; lo = a > b ? b : a; }
DEV void key_sort16(unsigned* v) {
#pragma unroll
  for (int k = 2; k <= 16; k <<= 1)
#pragma unroll
    for (int j = k >> 1; j > 0; j >>= 1)
#pragma unroll
      for (int i = 0; i < 16; ++i) {
        const int l = i ^ j;
        if (l > i) { if ((i & k) == 0) key_cx(v[i], v[l]); else key_cx(v[l], v[i]); }
      }
}
DEV void key_merge16(unsigned* a, const unsigned* b) {
#pragma unroll
  for (int i = 0; i < 16; ++i) a[i] = a[i] > b[15 - i] ? a[i] : b[15 - i];
#pragma unroll
  for (int j = 8; j > 0; j >>= 1)
#pragma unroll
    for (int i = 0; i < 16; ++i) { const int l = i ^ j; if (l > i) key_cx(a[i], a[l]); }
}

DEV void st_peer_topk(const Params& P, int layer, int tile, int h, unsigned char* smem) {
  const int tid = threadIdx.x;
  const bf16_t* q = (const bf16_t*)(P.ws + OFF_Q);
  const bf16_t* keys = (const bf16_t*)(P.ws + OFF_KEYS) + (size_t)(layer * 8 + h) * 2 * 128 * 128;
  float* sS = (float*)smem;
  const int m0 = tile * 128;
  const int tok = tid & 127, half = tid >> 7;
  unsigned kl[2][16];
#pragma unroll
  for (int p = 0; p < 2; ++p) {
    EpiScoreLds epi{sS, m0};
    gemm_tile_128<true>(q + (h * 2 + p) * 128, 2048, NTOK, keys + p * 128 * 128, 128, 128, 128, m0, 0, epi, smem);
    __syncthreads();
    float* row = sS + tok * 129 + half * 64;
#pragma unroll
    for (int g = 0; g < 4; ++g) {
      unsigned grp[16];
#pragma unroll
      for (int j = 0; j < 16; ++j) grp[j] = (fkey(row[g * 16 + j]) & ~127u) | (unsigned)(127 - (half * 64 + g * 16 + j));
      key_sort16(grp);
      if (g == 0) {
#pragma unroll
        for (int j = 0; j < 16; ++j) kl[p][j] = grp[j];
      } else key_merge16(kl[p], grp);
    }
    if (half == 1) {
#pragma unroll
      for (int j = 0; j < 16; ++j) row[j] = __builtin_bit_cast(float, kl[p][j]);
    }
    __syncthreads();
    if (half == 0) {
      unsigned oth[16];
#pragma unroll
      for (int j = 0; j < 16; ++j) oth[j] = __builtin_bit_cast(unsigned, sS[tok * 129 + 64 + j]);
      key_merge16(kl[p], oth);
    }
    __syncthreads();
  }
  if (tid < 128) {
    float sv0[16], sv1[16];
    int* irow = (int*)(sS + tid * 129);
#pragma unroll
    for (int j = 0; j < 16; ++j) {
      sv0[j] = keyf((kl[0][j] & ~127u) | 64u); sv1[j] = keyf((kl[1][j] & ~127u) | 64u);
      irow[j] = 127 - (int)(kl[0][j] & 127u); irow[16 + j] = 127 - (int)(kl[1][j] & 127u);
    }
    unsigned best[16];
#pragma unroll
    for (int j = 0; j < 16; ++j) best[j] = 0u;
#pragma unroll
    for (int i = 0; i < 16; ++i)
#pragma unroll
      for (int j = 0; j < 16; ++j)
        if ((i + 1) * (j + 1) <= 16) key_insert((fkey(sv0[i] + sv1[j]) & ~255u) | (unsigned)(255 - (i * 16 + j)), best);
    float e[16], sum = 0.f;
    const float b0 = keyf((best[0] & ~255u) | 128u);
#pragma unroll
    for (int j = 0; j < 16; ++j) { e[j] = fexp(keyf((best[j] & ~255u) | 128u) - b0); sum += e[j]; }
    const float inv = 1.f / sum;
    int* pidx = (int*)(P.ws + OFF_PIDX) + (size_t)(m0 + tid) * 128 + h * 16;
    float* pg = (float*)(P.ws + OFF_PGATE) + (size_t)(m0 + tid) * 128 + h * 16;
#pragma unroll
    for (int j = 0; j < 16; ++j) {
      const int pos = 255 - (int)(best[j] & 255u);
      pidx[j] = irow[pos >> 4] * 128 + irow[16 + (pos & 15)];
      pg[j] = e[j] * inv;
    }
  }
}

DEV void st_peer_experts(const Params& P, int layer, int row) {
  const int lane = threadIdx.x & 63;
  const bf16_t* xb = (const bf16_t*)(P.ws + OFF_HBUF) + (size_t)row * 1024;
  const unsigned char* U = P.ws + OFF_PU;
  const int* pidx = (const int*)(P.ws + OFF_PIDX) + (size_t)row * 128;
  const float* pg = (const float*)(P.ws + OFF_PGATE) + (size_t)row * 128;
  float x[16], acc[16];
  unpack8(*(const u32x4*)(xb + lane * 16), x);
  unpack8(*(const u32x4*)(xb + lane * 16 + 8), x + 8);
#pragma unroll
  for (int j = 0; j < 16; ++j) acc[j] = 0.f;
  const int b3 = (lane >> 3) & 1;
  const int mypick = (lane >> 3) & 7;
  for (int k0 = 0; k0 < 128; k0 += 8) {
    u32x3 uu[8]; u32x2 vv[8];
#pragma unroll
    for (int i = 0; i < 8; ++i) {
      const unsigned char* er = U + (size_t)pidx[k0 + i] * PEER_ROWB;
      const unsigned* up = (const unsigned*)(er + lane * 12);
      uu[i].x = up[0]; uu[i].y = up[1]; uu[i].z = up[2];
      vv[i] = *(const u32x2*)(er + PEER_VOFF + lane * 8);
    }
    const float mygate = pg[k0 + mypick];
    float dsum[8];
#pragma unroll
    for (int i = 0; i < 8; i += 2) {
      float ufa[16], ufb[16];
#ifndef CPU_EMU
      __builtin_amdgcn_sched_barrier(0);
#endif
      unpack2x16_fp6(uu[i], uu[i + 1], ufa, ufb);
      typedef __attribute__((ext_vector_type(2))) float f32x2v;
      f32x2v da2 = {0.f, 0.f}, db2 = {0.f, 0.f};
#pragma unroll
      for (int j = 0; j < 8; ++j) {
        const f32x2v xx = {x[2 * j], x[2 * j + 1]};
        const f32x2v ua = {ufa[2 * j], ufa[2 * j + 1]}, ub = {ufb[2 * j], ufb[2 * j + 1]};
        da2 = xx * ua + da2; db2 = xx * ub + db2;
      }
      dsum[i] = da2.x + da2.y; dsum[i + 1] = db2.x + db2.y;
    }
    float e4[4], e2[2], g;
#pragma unroll
    for (int i = 0; i < 4; ++i) e4[i] = swap32_sum(dsum[i], dsum[4 + i]);
#pragma unroll
    for (int i = 0; i < 2; ++i) e2[i] = swap16_sum(e4[i], e4[2 + i]);
    {
      float mine = b3 ? e2[1] : e2[0], send = b3 ? e2[0] : e2[1];
      g = mine + dpp_xor<8>(send);
    }
    g = sum8(g);
    const float mycoef = mygate * geluf_(g * (1.f / PEER_USCALE));
#pragma unroll
    for (int i = 0; i < 8; ++i) {
      const float coef = wreadlane(mycoef, i * 8);
      float vf[16];
      unpack8_fp4(vv[i].x, vf); unpack8_fp4(vv[i].y, vf + 8);
#pragma unroll
      for (int j = 0; j < 16; ++j) acc[j] += coef * vf[j];
    }
  }
  float* xr = row < NCTX ? (float*)(P.ws + OFF_CTXRES) + (size_t)row * 1024 : P.out + (size_t)(row - NCTX) * 1024;
  const float* g2 = (const float*)(P.ws + OFF_MODV) + ((size_t)layer * 3 + mod_row(row)) * 6144 + 5 * 1024;
  float o[16];
#pragma unroll
  for (int q = 0; q < 4; ++q) {
    const int c = lane * 16 + q * 4;
    f32x4 a = *(const f32x4*)(xr + c), ga = *(const f32x4*)(g2 + c);
    o[q * 4 + 0] = a.x + ga.x * acc[q * 4 + 0] * (1.f / PEER_VSCALE); o[q * 4 + 1] = a.y + ga.y * acc[q * 4 + 1] * (1.f / PEER_VSCALE);
    o[q * 4 + 2] = a.z + ga.z * acc[q * 4 + 2] * (1.f / PEER_VSCALE); o[q * 4 + 3] = a.w + ga.w * acc[q * 4 + 3] * (1.f / PEER_VSCALE);
  }
  float ss = 0.f;
#pragma unroll
  for (int j = 0; j < 16; ++j) ss += o[j] * o[j];
  ss = wave_sum(ss);
  const float rstd = frsq(ss * (1.f / 1024.f) + 1e-6f);
  if (layer == 1) {
    float fn[16]; ld8(P.in[I_FNORM] + lane * 16, fn); ld8(P.in[I_FNORM] + lane * 16 + 8, fn + 8);
#pragma unroll
    for (int j = 0; j < 16; ++j) o[j] *= rstd * fn[j];
  }
#pragma unroll
  for (int q = 0; q < 4; ++q) {
    f32x4 a = {o[q * 4 + 0], o[q * 4 + 1], o[q * 4 + 2], o[q * 4 + 3]};
    *(f32x4*)(xr + lane * 16 + q * 4) = a;
  }
  if (layer == 0) {
    const float* mv = (const float*)(P.ws + OFF_MODV) + ((size_t)1 * 3 + mod_row(row)) * 6144;
    const float* nw = P.in[I_NORM1] + 1024;
    float hh[16];
#pragma unroll
    for (int q = 0; q < 4; ++q) {
      const int c = lane * 16 + q * 4;
      f32x4 w4 = *(const f32x4*)(nw + c), s4 = *(const f32x4*)(mv + 1024 + c), h4 = *(const f32x4*)(mv + c);
      hh[q * 4 + 0] = o[q * 4 + 0] * rstd * w4.x * (1.f + s4.x) + h4.x; hh[q * 4 + 1] = o[q * 4 + 1] * rstd * w4.y * (1.f + s4.y) + h4.y;
      hh[q * 4 + 2] = o[q * 4 + 2] * rstd * w4.z * (1.f + s4.z) + h4.z; hh[q * 4 + 3] = o[q * 4 + 3] * rstd * w4.w * (1.f + s4.w) + h4.w;
    }
    bf16_t* hb = (bf16_t*)(P.ws + OFF_HBUF) + (size_t)row * 1024 + lane * 16;
    *(u32x4*)hb = pack8(hh);
    *(u32x4*)(hb + 8) = pack8(hh + 8);
  }
}


#define FOR_TILES_XCD(MT0, MT1, NT, mt, nt)                                                     \
  for (int _x = blockIdx.x & 7, _mlo = (MT0) + (((MT1) - (MT0)) * _x) / 8,                        \
           _mhi = (MT0) + (((MT1) - (MT0)) * (_x + 1)) / 8, _i = blockIdx.x >> 3,                 \
           _cnt = (_mhi - _mlo) * (NT), mt = 0, nt = 0;                                           \
       _i < _cnt && ((mt = _mlo + _i / (NT)), (nt = _i % (NT)), true); _i += (int)(gridDim.x >> 3))

#ifndef PHASE_LIST
#define PHASE_LIST(X) X(0) X(1) X(2) X(22) X(23) X(3) X(4) X(5) X(6) X(7) X(8) X(9) X(11) X(12) X(13) X(30) X(14) X(15) X(31) X(16) X(17) X(18) X(19) X(20) X(21)
#endif
constexpr int PH_LAST = 21;

template <int ph>
DEV void run_phase(const Params& P, unsigned char* smem) {
  int bid_ = blockIdx.x, wave_ = threadIdx.x >> 6;
  OPAQUE_S(bid_); OPAQUE(wave_);
  const int bid = bid_, nb = gridDim.x;
  const int wave = wave_;
  unsigned char* ws = P.ws;
  constexpr int layer = ((ph >= 10 && ph <= 21) || ph >= 30) ? 1 : 0;
  const float* modv_l = (const float*)(ws + OFF_MODV) + (size_t)layer * 3 * 6144;
  switch (ph) {
    case 0:
      for (int t = NTRANS + bid; t < NPREP; t += nb) st_prep(P, t, smem);
      break;
    case 1: case 10:
      if (ph == 1) for (int t = nb - 1 - bid; t < NTRANS; t += nb) st_prep(P, t, smem);
      for (int t = bid; t < NTOK / 4; t += nb) st_normmod(P, layer, 0, t * 4 + wave);
      break;
    case 2: {
      EpiProjL0T epi{(bf16_t*)(ws + OFF_PROJ), (float*)(ws + OFF_GATES)};
      FOR_TILES_XCD(0, NTOK / 256, 25, mt, nt)
        gemm_tile_128x256<EpiProjL0T, true>((const bf16_t*)(ws + OFF_WEVIN), 1024, EVC, (const bf16_t*)(ws + OFF_HBUF), 1024, NTOK, 1024,
                                            nt * 128, mt * 256, epi, smem);
    } break;
    case 22:
      for (int t = bid; t < NTOK / 4; t += nb) st_xbc_conv(P, t * 4 + wave);
      for (int t = bid; t < NPCONV; t += nb) st_peer_conv(P, 0, t);
      break;
    case 23:
      for (int t = bid; t < 48 * LA_NSEG; t += nb) {
        int sid = t % 48, seg = t / 48;
        if (sid < 16) st_linattn_seg<true, false>(P, sid, seg, smem);
        else st_linattn_seg<false, false>(P, sid - 16, seg, smem);
      }
      break;
    case 3:
      for (int t = bid; t < 48 * LA_NSEG; t += nb) {
        int sid = t % 48, seg = t / 48;
        if (sid < 16) st_linattn_seg<true, true>(P, sid, seg, smem);
        else st_linattn_seg<false, true>(P, sid - 16, seg, smem);
      }
      break;
    case 4:
      for (int t = bid; t < NTOK / 4; t += nb) st_finish_l0(P, t * 4 + wave);
      break;
    case 5: case 17: {
      EpiOutProjT epi{layer == 0 ? P.in[I_X] : P.out, P.in[I_CTX], P.out, (float*)(ws + OFF_CTXRES), modv_l};
      const bf16_t* Wt = (const bf16_t*)(ws + (layer == 0 ? OFF_WEVOUT : OFF_WODOUT));
      FOR_TILES_XCD(layer == 0 ? 0 : NCTX / 256, NTOK / 256, 8, mt, nt)
        gemm_tile_128x256<EpiOutProjT, true>(Wt, 1024, 1024, (const bf16_t*)(ws + OFF_HBUF), 1024, NTOK, 1024, nt * 128, mt * 256, epi, smem);
    } break;
    case 6: case 18: {
      const int r0 = layer == 0 ? 0 : NCTX / 4;
      for (int t = r0 + bid; t < NTOK / 4; t += nb) st_normmod(P, layer, 1, t * 4 + wave);
      if (ph == 18) for (int t = bid; t < NPCONV; t += nb) st_peer_conv(P, 1, t);
    } break;
    case 7: case 19: {
      EpiStoreBfT epi{(bf16_t*)(ws + OFF_Q), 2048};
      const bf16_t* Wt = (const bf16_t*)(ws + OFF_WQ) + (size_t)layer * 2048 * 1024;
      FOR_TILES_XCD(layer == 0 ? 0 : NCTX / 256, NTOK / 256, 16, mt, nt)
        gemm_tile_128x256<EpiStoreBfT, true>(Wt, 1024, 2048, (const bf16_t*)(ws + OFF_HBUF), 1024, NTOK, 1024, nt * 128, mt * 256, epi, smem);
    } break;
    case 8: case 20: {
      const int t0 = layer == 0 ? 0 : CTILE * 8;
      for (int t = t0 + bid; t < NTILE * 8; t += nb) st_peer_topk(P, layer, t / 8, t % 8, smem);
    } break;
    case 9: case 21: {
      const int r0 = layer == 0 ? 0 : NCTX / 4;
      for (int t = r0 + bid; t < NTOK / 4; t += nb) st_peer_experts(P, layer, t * 4 + wave);
    } break;
    case 11: {
      EpiStoreBfT epi{(bf16_t*)(ws + OFF_PROJ), ODC};
      FOR_TILES_XCD(0, NTOK / 256, 22, mt, nt)
        gemm_tile_128x256<EpiStoreBfT, true>((const bf16_t*)(ws + OFF_WODIN), 1024, ODC, (const bf16_t*)(ws + OFF_HBUF), 1024, NTOK, 1024,
                                             nt * 128, mt * 256, epi, smem);
    } break;
    case 12:
      for (int t = bid; t < NTOK / 8; t += nb) st_lora_act(P, t * 8 + wave * 2);
      break;
    case 13:
      for (int t = bid; t < NTILE * 20; t += nb) {
        int job = t / (NTILE * 4), tt = t % (NTILE * 4);
        int mt = tt / 4, nt = tt % 4;
        bf16_t* dst = (bf16_t*)(ws + OFF_LORA) + (size_t)job * NTOK * 512;
        const bf16_t* A = (const bf16_t*)(ws + OFF_HBUF) + (job < 2 ? 0 : (job < 4 ? 64 : 128));
        const bf16_t* Bt = job < 2 ? (const bf16_t*)(ws + OFF_WUP) + (size_t)job * 512 * 64
                         : job < 4 ? (const bf16_t*)(ws + OFF_AUP) + (size_t)(job - 2) * 512 * 64
                                   : (const bf16_t*)(ws + OFF_GUP);
        const float* bias = job < 2 ? P.in[I_W0] + job * 512 : (job < 4 ? P.in[I_A0] + (job - 2) * 512 : nullptr);
        const int K = job < 4 ? 64 : 128;
        EpiStoreBfBiasT epi{dst, 512, bias};
        gemm_tile_128<false, EpiStoreBfBiasT, true>(Bt, K, 512, A, 1024, NTOK, K, nt * 128, mt * 128, epi, smem);
      }
      break;
    case 30:
      for (int t = bid; t < 32 * RW_NSEG; t += nb) st_rwkv_seg<false>(P, t % 32, t / 32, smem);
      break;
    case 14:
      for (int t = bid; t < 32 * RW_NSEG; t += nb) st_rwkv_seg<true>(P, t % 32, t / 32, smem);
      break;
    case 15:
      {
        LruRaw R;
        if (bid < 32 * LRU_NCH) lru_load_raw(P, bid % 32, bid / 32, R);
        for (int t = bid; t < 32 * LRU_NCH; t += nb) {
          const int tn = t + nb;
          st_lru_chunk(P, t % 32, t / 32, tn % 32, tn / 32, tn < 32 * LRU_NCH, R, smem);
        }
      }
      break;
    case 31:
      if (bid < 32) st_lru_carry(P, bid);
      break;
    case 16:
      for (int t = bid; t < NTOK / 4; t += nb) st_finish_l1(P, t * 4 + wave);
      break;
    default: break;
  }
}


#ifndef CPU_EMU
#define XB_TMO      128
#define XB_XCNT(j)  (256  + 64 * (j))
#define XB_XSUB(j)  (1280 + 64 * (j))
#define XB_XGEN(j)  (2304 + 64 * (j))
#define XB_TOP      3328
#define XB_TOPGEN   3392
#define XCD_BAR_WORDS 3456
#define XB_SPIN_CAP (1u << 20)
#define LAS __attribute__((address_space(3)))
__device__ __forceinline__ unsigned xb_ld(unsigned* p)              { return __hip_atomic_load(p, __ATOMIC_RELAXED, __HIP_MEMORY_SCOPE_AGENT); }
__device__ __forceinline__ unsigned xb_add(unsigned* p, unsigned v) { return __hip_atomic_fetch_add(p, v, __ATOMIC_RELAXED, __HIP_MEMORY_SCOPE_AGENT); }
__device__ __forceinline__ unsigned xb_xcc_id() { return (unsigned)__builtin_amdgcn_s_getreg((3 << 11) | 20) & 0xFu; }
#define XB_SPIN(cond, bar) do { unsigned _sp = 0; while (cond) { __builtin_amdgcn_s_sleep(1); \
    if ((++_sp & 255u) == 0u) { if (xb_ld(&(bar)[XB_TMO])) break; if (_sp > XB_SPIN_CAP) { atomicAdd(&(bar)[XB_TMO], 1u); break; } } } } while (0)
struct XcdBarrier { unsigned* bar; unsigned x; volatile LAS unsigned* st; };
__device__ __forceinline__ XcdBarrier xcd_barrier_post(unsigned* bar, volatile LAS unsigned* st) {
  XcdBarrier b; b.bar = bar; b.x = xb_xcc_id(); b.st = st;
  if (threadIdx.x == 0) (void)xb_add(&bar[XB_XCNT(b.x)], 1u);
  return b;
}
__device__ __forceinline__ void xcd_barrier_complete(unsigned* bar, unsigned x, unsigned& nloc, unsigned& nx) {
  const unsigned G = gridDim.x * gridDim.y * gridDim.z;
  unsigned sum, cnt, mine, sp = 0u;
  for (;;) {
    sum = 0u; cnt = 0u; mine = 0u;
#pragma unroll
    for (unsigned j = 0; j < 16; ++j) { const unsigned c = xb_ld(&bar[XB_XCNT(j)]); sum += c; cnt += (c > 0u) ? 1u : 0u; mine = (j == x) ? c : mine; }
    if (sum == G) break;
    __builtin_amdgcn_s_sleep(1);
    if ((++sp & 255u) == 0u) { if (xb_ld(&bar[XB_TMO])) break; if (sp > XB_SPIN_CAP) { atomicAdd(&bar[XB_TMO], 1u); break; } }
  }
  nloc = mine > 0u ? mine : 1u; nx = cnt > 0u ? cnt : 1u;
}
__device__ __forceinline__ void xcd_barrier(const XcdBarrier& b) {
  asm volatile("s_waitcnt vmcnt(0)" ::: "memory");
  __syncthreads();
  if (threadIdx.x == 0) {
    unsigned* bar = b.bar;
    __builtin_amdgcn_s_waitcnt(0);
    unsigned nloc = b.st[0], nx = b.st[1];
    if (nloc == 0u) { xcd_barrier_complete(bar, b.x, nloc, nx); b.st[0] = nloc; b.st[1] = nx; }
    const unsigned old = xb_add(&bar[XB_XSUB(b.x)], 1u);
    const unsigned gen = old / nloc;
    if (old + 1u == (gen + 1u) * nloc) {
      __builtin_amdgcn_fence(__ATOMIC_RELEASE, "agent");
      asm volatile("s_waitcnt vmcnt(0)" ::: "memory");
      const unsigned og = xb_add(&bar[XB_TOP], 1u);
      const unsigned tg = og / nx;
      if (og + 1u == (tg + 1u) * nx) xb_add(&bar[XB_TOPGEN], 1u);
      else XB_SPIN(xb_ld(&bar[XB_TOPGEN]) == tg, bar);
      __builtin_amdgcn_fence(__ATOMIC_ACQUIRE, "agent");
      xb_add(&bar[XB_XGEN(b.x)], 1u);
      asm volatile("s_waitcnt vmcnt(0)" ::: "memory");
    } else {
      XB_SPIN(xb_ld(&bar[XB_XGEN(b.x)]) == gen, bar);
      __builtin_amdgcn_fence(__ATOMIC_ACQUIRE, "agent");
      asm volatile("s_waitcnt vmcnt(0)" ::: "memory");
    }
  }
  __syncthreads();
}
#endif
#ifndef CPU_EMU
#define RUN_PH(n) run_phase<n>(P, smem_raw); if (n != PH_LAST) xcd_barrier(xb);
__global__ void __launch_bounds__(256, 2) mega_kernel(Params P) {
  SMEM_DECL;
  unsigned* bar = (unsigned*)(P.ws + OFF_BAR);
  volatile LAS unsigned* st = (volatile LAS unsigned*)(smem_raw + SMEM_BYTES - 16);
  if (threadIdx.x == 0) { st[0] = 0u; st[1] = 0u; }
  if (P.ws == nullptr) cg::this_grid().sync();
  __syncthreads();
  XcdBarrier xb = xcd_barrier_post(bar, st);
  PHASE_LIST(RUN_PH)
}

extern "C" void kernel_launch(void* const* d_in, const int* in_sizes, int n_in, void* d_out, int out_size, void* d_ws,
                              size_t ws_size, hipStream_t stream) {
  Params P{};
  for (int i = 0; i < N_IN; ++i) P.in[i] = (const float*)d_in[i];
  P.out = (float*)d_out;
  P.ws = (unsigned char*)d_ws;
  if (ws_size < WS_NEEDED) { fprintf(stderr, "workspace too small: %zu < %zu\n", ws_size, (size_t)WS_NEEDED); return; }
  static int grid_blocks = 0;
  if (!grid_blocks) {
    int dev = 0, cus = 0, per_cu = 0;
    hipGetDevice(&dev);
    hipDeviceGetAttribute(&cus, hipDeviceAttributeMultiprocessorCount, dev);
    hipOccupancyMaxActiveBlocksPerMultiprocessor(&per_cu, mega_kernel, 256, 0);
    if (per_cu > 2) per_cu = 2;
    grid_blocks = cus * per_cu;
  }
  (void)hipMemsetAsync((unsigned char*)d_ws + OFF_BAR, 0, 16384, stream);
  void* args[] = {&P};
  hipError_t e = hipLaunchCooperativeKernel((void*)mega_kernel, dim3(grid_blocks), dim3(256), args, 0, stream);
  if (e != hipSuccess) fprintf(stderr, "cooperative launch failed: %s (grid %d)\n", hipGetErrorString(e), grid_blocks);
}
#endif
```

```cpp
#ifdef CPU_EMU
#include "emu.h"
#else
#include <hip/hip_runtime.h>
#include <hip/hip_cooperative_groups.h>
#include <cstdio>
namespace cg = cooperative_groups;
#define DEV __device__ __forceinline__
#define DEVM __device__ __forceinline__
#define OPAQUE(x) asm volatile("" : "+v"(x))
#define OPAQUE_S(x) asm volatile("" : "+s"(x))
#endif

#ifndef SEQ_LEN
#define SEQ_LEN 16384
#endif
#ifndef CTX_LEN
#define CTX_LEN 256
#endif
#ifndef GRID_W_
#define GRID_W_ 64
#endif
#ifndef MULTI_LAUNCH
#define MULTI_LAUNCH 0
#endif

typedef unsigned short bf16_t;
typedef __attribute__((ext_vector_type(8))) short bf16x8;
typedef __attribute__((ext_vector_type(16))) float f32x16;
typedef __attribute__((ext_vector_type(4))) unsigned u32x4;
typedef __attribute__((ext_vector_type(2))) unsigned u32x2;
typedef __attribute__((ext_vector_type(4))) float f32x4;

constexpr int D = 1024, NB = 2, SEQ = SEQ_LEN, CTXL = CTX_LEN, GW = GRID_W_;
constexpr int NCTX = NB * CTXL, NLAT = NB * SEQ, NTOK = NCTX + NLAT;
constexpr int EVC = 3104, ODC = 2816;
constexpr int NEXP = 16384;
constexpr int NTILE = NTOK / 128, CTILE = NCTX / 128;
static_assert(NTOK % 256 == 0 && NCTX % 256 == 0, "tiles");
static_assert(CTXL % 64 == 0 && SEQ % 64 == 0 && SEQ % GW == 0, "chunks");

constexpr size_t al256(size_t x) { return (x + 255) & ~(size_t)255; }
constexpr size_t OFF_MODV = 0;
constexpr size_t OFF_CTXRES = OFF_MODV + al256(2 * 3 * 6144 * 4);
constexpr size_t OFF_GATES = OFF_CTXRES + al256((size_t)NCTX * 1024 * 4);
constexpr size_t OFF_WEVIN = OFF_GATES + al256((size_t)NTOK * 32 * 4);
constexpr size_t OFF_WEVOUT = OFF_WEVIN + al256((size_t)EVC * 1024 * 2);
constexpr size_t OFF_WODIN = OFF_WEVOUT + al256((size_t)1024 * 1024 * 2);
constexpr size_t OFF_WODOUT = OFF_WODIN + al256((size_t)ODC * 1024 * 2);
constexpr size_t OFF_WQ = OFF_WODOUT + al256((size_t)1024 * 1024 * 2);
constexpr size_t OFF_KEYS = OFF_WQ + al256((size_t)2 * 2048 * 1024 * 2);
constexpr size_t OFF_WUP = OFF_KEYS + al256((size_t)2 * 8 * 2 * 128 * 128 * 2);
constexpr size_t OFF_AUP = OFF_WUP + al256((size_t)2 * 512 * 64 * 2);
constexpr size_t OFF_GUP = OFF_AUP + al256((size_t)2 * 512 * 64 * 2);
constexpr size_t OFF_LRUT = OFF_GUP + al256((size_t)512 * 128 * 2);
constexpr size_t OFF_PU = OFF_LRUT + al256((size_t)2 * 8 * 128 * 64 * 2);
constexpr size_t OFF_PV = OFF_PU + al256((size_t)NEXP * 1024);
constexpr size_t OFF_HBUF = OFF_PV + al256((size_t)NEXP * 1024);
constexpr size_t OFF_PR = OFF_HBUF + al256((size_t)NTOK * 1024 * 2);
constexpr size_t PR_BYTES = (size_t)NTOK * 5376 * 2;
constexpr size_t OFF_BAR = OFF_PR + PR_BYTES;
constexpr size_t OFF_ACUM1 = OFF_BAR + 16384;
constexpr size_t OFF_LRUCS = OFF_ACUM1 + (size_t)NLAT * 512 * 2;
constexpr size_t OFF_LRUHS = OFF_LRUCS + (size_t)32 * ((CTXL + SEQ) / 64) * 128 * 4;
constexpr size_t WS_NEEDED = OFF_LRUHS + (size_t)32 * ((CTXL + SEQ) / 64) * 64 * 4;
#ifndef CPU_EMU
static_assert(WS_NEEDED <= (size_t)512 * 1024 * 1024, "workspace too large");
#endif
constexpr size_t OFF_PROJ = OFF_PR;
constexpr size_t OFF_R2L0 = OFF_PR + (size_t)NTOK * EVC * 2;
constexpr size_t OFF_LORA = OFF_PR + (size_t)NTOK * ODC * 2;
constexpr size_t OFF_Q = OFF_PR;
constexpr size_t OFF_PIDX = OFF_PR + (size_t)NTOK * 2048 * 2;
constexpr size_t OFF_PGATE = OFF_PIDX + (size_t)NTOK * 128 * 4;
static_assert(OFF_PGATE + (size_t)NTOK * 128 * 4 <= OFF_PR + PR_BYTES, "picks");

enum {
  I_X = 0, I_C, I_CTX, I_CCTX, I_MODW, I_MODB, I_NORM1, I_NORM2, I_WQ, I_KEYS, I_PU, I_PV,
  I_EVWIN, I_EVWOUT, I_IBIAS, I_FBIAS, I_MNORM, I_SCONVW, I_SCONVB, I_DTBIAS, I_ALOG, I_DSKIP, I_SNORM,
  I_ODWIN, I_ODWOUT, I_MU, I_W0, I_WUP, I_A0, I_AUP, I_GUP, I_KK, I_KA, I_RK, I_LNW, I_LNB,
  I_LCONVW, I_LCONVB, I_LAM, I_WA, I_BA, I_WI, I_BI, I_FNORM, N_IN
};

struct Params {
  const float* in[N_IN];
  float* out;
  unsigned char* ws;
};

constexpr int SMEM_BYTES = 80 * 1024;
#ifdef CPU_EMU
#define SMEM_DECL static thread_local __attribute__((aligned(16))) unsigned char smem_raw[SMEM_BYTES]
#else
#define SMEM_DECL __shared__ __attribute__((aligned(16))) unsigned char smem_raw[SMEM_BYTES]
#endif

DEV float bf2f(bf16_t v) { unsigned u = ((unsigned)v) << 16; float f; __builtin_memcpy(&f, &u, 4); return f; }
#ifdef CPU_EMU
DEV bf16_t f2bf(float f) { unsigned u; __builtin_memcpy(&u, &f, 4); u += 0x7fffu + ((u >> 16) & 1u); return (bf16_t)(u >> 16); }
DEV unsigned pack2(float a, float b) { return (unsigned)f2bf(a) | ((unsigned)f2bf(b) << 16); }
#else
typedef __attribute__((ext_vector_type(2))) float f32x2_t;
typedef __attribute__((ext_vector_type(2))) __bf16 bf16x2_t;
DEV unsigned pack2(float a, float b) { f32x2_t f = {a, b}; return __builtin_bit_cast(unsigned, __builtin_convertvector(f, bf16x2_t)); }
DEV bf16_t f2bf(float f) { return __builtin_bit_cast(unsigned short, (__bf16)f); }
#endif
DEV void unpack8(const u32x4& r, float* o) {
  unsigned w[4] = {r.x, r.y, r.z, r.w};
#pragma unroll
  for (int i = 0; i < 4; ++i) { unsigned lo = w[i] << 16, hi = w[i] & 0xffff0000u; __builtin_memcpy(&o[2 * i], &lo, 4); __builtin_memcpy(&o[2 * i + 1], &hi, 4); }
}
DEV u32x4 pack8(const float* o) { u32x4 r; r.x = pack2(o[0], o[1]); r.y = pack2(o[2], o[3]); r.z = pack2(o[4], o[5]); r.w = pack2(o[6], o[7]); return r; }
#ifdef CPU_EMU
DEV float fexp(float x) { return expf(x); }
DEV float frcp(float x) { return 1.f / x; }
DEV float flog(float x) { return logf(x); }
DEV float frsq(float x) { return 1.f / sqrtf(x); }
DEV float fsqrt(float x) { return sqrtf(x); }
#else
DEV float fexp(float x) { return __expf(x); }
DEV float frcp(float x) { return __builtin_amdgcn_rcpf(x); }
DEV float flog(float x) { return __logf(x); }
DEV float frsq(float x) { return __builtin_amdgcn_rsqf(x); }
DEV float fsqrt(float x) { return __builtin_amdgcn_sqrtf(x); }
#endif
DEV void ld8(const float* __restrict__ p, float* o) { const f32x4 a = *(const f32x4*)p, b = *(const f32x4*)(p + 4); o[0] = a.x; o[1] = a.y; o[2] = a.z; o[3] = a.w; o[4] = b.x; o[5] = b.y; o[6] = b.z; o[7] = b.w; }
DEV float sigmoidf_(float x) { return frcp(1.f + fexp(-x)); }
DEV float siluf_(float x) { return x * frcp(1.f + fexp(-x)); }
DEV float softplusf_(float x) { return fmaxf(x, 0.f) + flog(1.f + fexp(-fabsf(x))); }
DEV float tanhf_(float x) { return 1.f - 2.f * frcp(1.f + fexp(2.f * x)); }
DEV float geluf_(float x) { return 0.5f * x * (1.f + erff(x * 0.70710678118654752f)); }

DEV f32x16 mfma32(bf16x8 a, bf16x8 b, f32x16 c) {
#ifdef CPU_EMU
  return emu_mfma32(a, b, c);
#else
  return __builtin_amdgcn_mfma_f32_32x32x16_bf16(a, b, c, 0, 0, 0);
#endif
}
DEV float wshfl_xor(float v, int m) {
#ifdef CPU_EMU
  return emu_shfl_xor(v, m);
#else
  return __shfl_xor(v, m, 64);
#endif
}
template <int M> DEV float dpp_xor(float v) {
  static_assert(M == 1 || M == 2 || M == 7 || M == 8, "dpp pattern");
#ifdef CPU_EMU
  return emu_shfl_xor(v, M);
#else
  constexpr int ctrl = M == 1 ? 0xB1 : (M == 2 ? 0x4E : (M == 7 ? 0x141 : 0x128));
  return __int_as_float(__builtin_amdgcn_update_dpp(0, __float_as_int(v), ctrl, 0xf, 0xf, false));
#endif
}
DEV float sum8(float v) { v += dpp_xor<1>(v); v += dpp_xor<2>(v); v += dpp_xor<7>(v); return v; }
DEV float sum4(float v) { v += dpp_xor<1>(v); v += dpp_xor<2>(v); return v; }
DEV float sum16(float v) { v = sum8(v); v += dpp_xor<8>(v); return v; }
DEV float swap32_sum(float a, float b) {
#ifdef CPU_EMU
  float ra = emu_shfl_xor(a, 32), rb = emu_shfl_xor(b, 32);
  return ((threadIdx.x >> 5) & 1) ? b + rb : a + ra;
#else
  auto r = __builtin_amdgcn_permlane32_swap(__float_as_uint(a), __float_as_uint(b), false, false);
  return __uint_as_float(r[0]) + __uint_as_float(r[1]);
#endif
}
DEV float swap16_sum(float a, float b) {
#ifdef CPU_EMU
  float ra = emu_shfl_xor(a, 16), rb = emu_shfl_xor(b, 16);
  return ((threadIdx.x >> 4) & 1) ? b + rb : a + ra;
#else
  auto r = __builtin_amdgcn_permlane16_swap(__float_as_uint(a), __float_as_uint(b), false, false);
  return __uint_as_float(r[0]) + __uint_as_float(r[1]);
#endif
}
DEV float wave_sum(float v) {
  v = sum16(v);
  v = swap16_sum(v, v);
  return swap32_sum(v, v);
}
DEV float wave_incl_scan(float v) {
#ifdef CPU_EMU
  const int l = threadIdx.x & 63;
  for (int s = 1; s < 16; s <<= 1) { const bool ok = (l & 15) >= s; float o = emu_readlane(v, ok ? l - s : l); v += ok ? o : 0.f; }
  { const bool ok = ((l >> 4) & 1) != 0; float o = emu_readlane(v, ok ? (l & ~15) - 1 : l); v += ok ? o : 0.f; }
  { const bool ok = l >= 32; float o = emu_readlane(v, ok ? 31 : l); v += ok ? o : 0.f; }
  return v;
#else
#define DPP_ADD_(ctrl, rmask) v += __int_as_float(__builtin_amdgcn_update_dpp(0, __float_as_int(v), ctrl, rmask, 0xf, false))
  DPP_ADD_(0x111, 0xf); DPP_ADD_(0x112, 0xf); DPP_ADD_(0x114, 0xf); DPP_ADD_(0x118, 0xf);
  DPP_ADD_(0x142, 0xa); DPP_ADD_(0x143, 0xc);
#undef DPP_ADD_
  return v;
#endif
}

#ifdef CPU_EMU
static inline unsigned emu_f2fp8(float f) {
  unsigned sgn = f < 0.f ? 0x80u : 0u; float a = fabsf(f);
  if (!(a == a)) return 0x7f;
  if (a >= 448.f) return sgn | 0x7e;
  if (a < 0.0009765625f) return sgn;
  int e; frexpf(a, &e); e -= 1;
  if (e < -6) { int q = (int)nearbyintf(a * 512.f); return sgn | (unsigned)q; }
  float m = a / ldexpf(1.f, e);
  int q = (int)nearbyintf((m - 1.f) * 8.f);
  if (q == 8) { q = 0; e += 1; }
  if (e > 8) return sgn | 0x7e;
  return sgn | (unsigned)((e + 7) << 3) | (unsigned)q;
}
static inline float emu_fp82f(unsigned c) {
  unsigned sgn = c & 0x80, e = (c >> 3) & 15, m = c & 7;
  float v = e == 0 ? ldexpf((float)m, -9) : ldexpf(1.f + m / 8.f, (int)e - 7);
  return sgn ? -v : v;
}
#endif
DEV unsigned pack4_fp8(float a, float b, float c, float d) {
#ifdef CPU_EMU
  return emu_f2fp8(a) | (emu_f2fp8(b) << 8) | (emu_f2fp8(c) << 16) | (emu_f2fp8(d) << 24);
#else
  int w = 0;
  w = __builtin_amdgcn_cvt_pk_fp8_f32(a, b, w, false);
  w = __builtin_amdgcn_cvt_pk_fp8_f32(c, d, w, true);
  return (unsigned)w;
#endif
}
DEV void unpack4_fp8(unsigned w, float* o) {
#ifdef CPU_EMU
  o[0] = emu_fp82f(w & 255); o[1] = emu_fp82f((w >> 8) & 255); o[2] = emu_fp82f((w >> 16) & 255); o[3] = emu_fp82f(w >> 24);
#else
  typedef __attribute__((ext_vector_type(2))) float f32x2_;
  f32x2_ lo = __builtin_amdgcn_cvt_pk_f32_fp8((int)w, false);
  f32x2_ hi = __builtin_amdgcn_cvt_pk_f32_fp8((int)w, true);
  o[0] = lo.x; o[1] = lo.y; o[2] = hi.x; o[3] = hi.y;
#endif
}
DEV void unpack16_fp8(const u32x4& r, float* o) { unpack4_fp8(r.x, o); unpack4_fp8(r.y, o + 4); unpack4_fp8(r.z, o + 8); unpack4_fp8(r.w, o + 12); }
DEV float wreadlane(float v, int srclane) {
#ifdef CPU_EMU
  return emu_readlane(v, srclane);
#else
  int iv; __builtin_memcpy(&iv, &v, 4);
  int r = __builtin_amdgcn_readlane(iv, srclane);
  float f; __builtin_memcpy(&f, &r, 4); return f;
#endif
}
constexpr float PEER_USCALE = 64.f, PEER_VSCALE = 4.f;
#ifdef CPU_EMU
static inline unsigned emu_f2fp4(float f) {
  static const float lv[8] = {0.f, 0.5f, 1.f, 1.5f, 2.f, 3.f, 4.f, 6.f};
  unsigned sgn = f < 0.f ? 8u : 0u; float a = fabsf(f);
  int best = 0; float bd = 1e30f;
  for (int i = 0; i < 8; ++i) { float dd = fabsf(a - lv[i]); if (dd < bd || (dd == bd && (i & 1) == 0)) { bd = dd; best = i; } }
  return sgn | (unsigned)best;
}
static inline float emu_fp42f(unsigned c) {
  static const float lv[8] = {0.f, 0.5f, 1.f, 1.5f, 2.f, 3.f, 4.f, 6.f};
  float v = lv[c & 7]; return (c & 8) ? -v : v;
}
#endif
DEV unsigned pack8_fp4(const float* v) {
#ifdef CPU_EMU
  unsigned w = 0;
  for (int i = 0; i < 8; ++i) w |= emu_f2fp4(v[i]) << (4 * i);
  return w;
#else
  unsigned w = 0;
  w = __builtin_amdgcn_cvt_scalef32_pk_fp4_f32(w, v[0], v[1], 1.0f, 0);
  w = __builtin_amdgcn_cvt_scalef32_pk_fp4_f32(w, v[2], v[3], 1.0f, 1);
  w = __builtin_amdgcn_cvt_scalef32_pk_fp4_f32(w, v[4], v[5], 1.0f, 2);
  w = __builtin_amdgcn_cvt_scalef32_pk_fp4_f32(w, v[6], v[7], 1.0f, 3);
  return w;
#endif
}
DEV void unpack8_fp4(unsigned w, float* o) {
#ifdef CPU_EMU
  for (int i = 0; i < 8; ++i) o[i] = emu_fp42f((w >> (4 * i)) & 15u);
#else
  typedef __attribute__((ext_vector_type(2))) float f32x2_;
  f32x2_ a = __builtin_amdgcn_cvt_scalef32_pk_f32_fp4(w, 1.0f, 0);
  f32x2_ b = __builtin_amdgcn_cvt_scalef32_pk_f32_fp4(w, 1.0f, 1);
  f32x2_ c = __builtin_amdgcn_cvt_scalef32_pk_f32_fp4(w, 1.0f, 2);
  f32x2_ d = __builtin_amdgcn_cvt_scalef32_pk_f32_fp4(w, 1.0f, 3);
  o[0] = a.x; o[1] = a.y; o[2] = b.x; o[3] = b.y; o[4] = c.x; o[5] = c.y; o[6] = d.x; o[7] = d.y;
#endif
}
typedef __attribute__((ext_vector_type(3))) unsigned u32x3;
#ifndef FP6_INTERLEAVED
#define FP6_INTERLEAVED 1
#endif
#ifdef CPU_EMU
static inline unsigned emu_f2fp6(float f) {
  unsigned sgn = f < 0.f ? 32u : 0u; float a = fabsf(f);
  if (a >= 7.5f) return sgn | 31u;
  int e; unsigned code;
  if (a < 1.f) { int q = (int)nearbyintf(a * 8.f); code = (unsigned)q; }
  else { frexpf(a, &e); e -= 1; float m = a / ldexpf(1.f, e); int q = (int)nearbyintf((m - 1.f) * 8.f); if (q == 8) { q = 0; e += 1; } code = (unsigned)(((e + 1) << 3) | q); if (e > 2) code = 31u; }
  return sgn | code;
}
static inline float emu_fp62f(unsigned c) {
  unsigned e = (c >> 3) & 3, m = c & 7;
  float v = e == 0 ? m * 0.125f : ldexpf(1.f + m / 8.f, (int)e - 1);
  return (c & 32) ? -v : v;
}
#endif
DEV u32x3 pack16_fp6(const float* v) {
#ifdef CPU_EMU
  unsigned long long lo = 0; unsigned hi = 0;
  for (int i = 0; i < 16; ++i) {
    unsigned long long c = emu_f2fp6(v[i]); int bit = 6 * i;
    if (bit < 64) { lo |= c << bit; if (bit > 58) hi |= (unsigned)(c >> (64 - bit)); } else hi |= (unsigned)(c << (bit - 64));
  }
  u32x3 r; r.x = (unsigned)lo; r.y = (unsigned)(lo >> 32); r.z = hi; return r;
#else
  typedef __attribute__((ext_vector_type(6))) unsigned u32x6_;
  f32x16 a, b;
#if FP6_INTERLEAVED
#pragma unroll
  for (int i = 0; i < 8; ++i) { a[i] = v[2 * i]; b[i] = v[2 * i + 1]; a[8 + i] = 0.f; b[8 + i] = 0.f; }
#else
#pragma unroll
  for (int i = 0; i < 16; ++i) { a[i] = v[i]; b[i] = 0.f; }
#endif
  u32x6_ w = __builtin_amdgcn_cvt_scalef32_2xpk16_fp6_f32(a, b, 1.0f);
  u32x3 r; r.x = w[0]; r.y = w[1]; r.z = w[2]; return r;
#endif
}
DEV void unpack16_fp6(const u32x3& r, float* o) {
#ifdef CPU_EMU
  unsigned long long lo = (unsigned long long)r.x | ((unsigned long long)r.y << 32); unsigned hi = r.z;
  for (int i = 0; i < 16; ++i) {
    int bit = 6 * i; unsigned c;
    if (bit + 6 <= 64) c = (unsigned)(lo >> bit) & 63u;
    else if (bit >= 64) c = (hi >> (bit - 64)) & 63u;
    else c = ((unsigned)(lo >> bit) | (hi << (64 - bit))) & 63u;
    o[i] = emu_fp62f(c);
  }
#else
  typedef __attribute__((ext_vector_type(6))) unsigned u32x6_;
  typedef __attribute__((ext_vector_type(32))) float f32x32_;
  u32x6_ w; w[0] = r.x; w[1] = r.y; w[2] = r.z; w[3] = 0u; w[4] = 0u; w[5] = 0u;
  f32x32_ f = __builtin_amdgcn_cvt_scalef32_pk32_f32_fp6(w, 1.0f);
#pragma unroll
  for (int i = 0; i < 16; ++i) o[i] = f[i];
#endif
}
DEV void unpack2x16_fp6(const u32x3& ra, const u32x3& rb, float* oa, float* ob) {
#ifdef CPU_EMU
  unpack16_fp6(ra, oa); unpack16_fp6(rb, ob);
#else
  typedef __attribute__((ext_vector_type(6))) unsigned u32x6_;
  typedef __attribute__((ext_vector_type(32))) float f32x32_;
  u32x6_ w; w[0] = ra.x; w[1] = ra.y; w[2] = ra.z; w[3] = rb.x; w[4] = rb.y; w[5] = rb.z;
  f32x32_ f = __builtin_amdgcn_cvt_scalef32_pk32_f32_fp6(w, 1.0f);
#pragma unroll
  for (int i = 0; i < 16; ++i) { oa[i] = f[i]; ob[i] = f[16 + i]; }
#endif
}
constexpr int PEER_ROWB = 1280;
constexpr int PEER_VOFF = 768;


DEV int acc_row(int reg, int lane) { return (reg & 3) + 8 * (reg >> 2) + 4 * (lane >> 5); }

DEV int mod_row(int row) { return row < NCTX ? 2 : (row - NCTX) / SEQ; }

template <bool SYNC_EPI, class Epi, bool VEC4 = false>
DEV void gemm_tile_128(const bf16_t* __restrict__ A, int lda, int M, const bf16_t* __restrict__ Bt, int ldb, int N,
                       int K, int m0, int n0, const Epi& epi, unsigned char* smem) {
  constexpr int LS = 72;
  constexpr int STAGE = 2 * 128 * LS;
  bf16_t* sbase = (bf16_t*)smem;
  const int wave = threadIdx.x >> 6;
  const int wm = (wave >> 1) * 64, wn = (wave & 1) * 64;
  f32x16 acc[2][2];
#pragma unroll
  for (int i = 0; i < 2; ++i)
#pragma unroll
    for (int j = 0; j < 2; ++j)
#pragma unroll
      for (int r = 0; r < 16; ++r) acc[i][j][r] = 0.f;
  u32x4 ra[4], rb[4];
  auto gload = [&](int k0) {
    int tl_ = threadIdx.x; OPAQUE(tl_);
#pragma unroll
    for (int i = 0; i < 4; ++i) {
      int c = tl_ + i * 256, r = c >> 3, cc = (c & 7) * 8;
      int gr = m0 + r, gn = n0 + r;
      gr = gr < M ? gr : M - 1; gn = gn < N ? gn : N - 1;
      ra[i] = *(const u32x4*)(A + (size_t)gr * lda + k0 + cc);
      rb[i] = *(const u32x4*)(Bt + (size_t)gn * ldb + k0 + cc);
    }
  };
  auto lwrite = [&](int buf) {
    int tl_ = threadIdx.x; OPAQUE(tl_);
    bf16_t* sA = sbase + buf * STAGE;
    bf16_t* sB = sA + 128 * LS;
#pragma unroll
    for (int i = 0; i < 4; ++i) {
      int c = tl_ + i * 256, r = c >> 3, cc = (c & 7) * 8;
      *(u32x4*)(sA + r * LS + cc) = ra[i];
      *(u32x4*)(sB + r * LS + cc) = rb[i];
    }
  };
  const int nk = K >> 6;
  gload(0);
  __syncthreads();
  lwrite(0);
  if (nk > 1) gload(64);
  __syncthreads();
  for (int it = 0; it < nk; ++it) {
    int tl_ = threadIdx.x; OPAQUE(tl_);
    const int lane = tl_ & 63;
    const bf16_t* sA = sbase + (it & 1) * STAGE;
    const bf16_t* sB = sA + 128 * LS;
#pragma unroll
    for (int kk = 0; kk < 4; ++kk) {
      bf16x8 a[2], b[2];
      const int ko = kk * 16 + 8 * (lane >> 5);
#pragma unroll
      for (int i = 0; i < 2; ++i) a[i] = *(const bf16x8*)(sA + (wm + i * 32 + (lane & 31)) * LS + ko);
#pragma unroll
      for (int j = 0; j < 2; ++j) b[j] = *(const bf16x8*)(sB + (wn + j * 32 + (lane & 31)) * LS + ko);
#pragma unroll
      for (int i = 0; i < 2; ++i)
#pragma unroll
        for (int j = 0; j < 2; ++j) acc[i][j] = mfma32(a[i], b[j], acc[i][j]);
      if (kk == 1) {
        if (it + 1 < nk) lwrite((it + 1) & 1);
        if (it + 2 < nk) gload((it + 2) * 64);
      }
    }
    __syncthreads();
  }
  {
    int tl_ = threadIdx.x; OPAQUE(tl_);
    const int lane = tl_ & 63;
    if constexpr (VEC4) {
#pragma unroll
      for (int i = 0; i < 2; ++i)
#pragma unroll
        for (int j = 0; j < 2; ++j)
#pragma unroll
          for (int gq = 0; gq < 4; ++gq) {
            int row = m0 + wm + i * 32 + 8 * gq + 4 * (lane >> 5);
            int col = n0 + wn + j * 32 + (lane & 31);
            if (row < M && col < N) epi.store4(row, col, acc[i][j][4 * gq], acc[i][j][4 * gq + 1], acc[i][j][4 * gq + 2], acc[i][j][4 * gq + 3]);
          }
    } else {
#pragma unroll
      for (int i = 0; i < 2; ++i)
#pragma unroll
        for (int j = 0; j < 2; ++j)
#pragma unroll
          for (int r = 0; r < 16; ++r) {
            int row = m0 + wm + i * 32 + acc_row(r, lane);
            int col = n0 + wn + j * 32 + (lane & 31);
            if (row < M && col < N) epi(row, col, acc[i][j][r]);
          }
    }
  }
}

template <class Epi, bool VEC4 = false>
DEV void gemm_tile_128x256(const bf16_t* __restrict__ A, int lda, int M, const bf16_t* __restrict__ Bt, int ldb, int N,
                           int K, int m0, int n0, const Epi& epi, unsigned char* smem) {
  constexpr int LS = 72;
  bf16_t* sA = (bf16_t*)smem;
  bf16_t* sB = sA + 128 * LS;
  const int wave = threadIdx.x >> 6;
  const int wm = (wave >> 1) * 64, wn = (wave & 1) * 128;
  f32x16 acc[2][4];
#pragma unroll
  for (int i = 0; i < 2; ++i)
#pragma unroll
    for (int j = 0; j < 4; ++j)
#pragma unroll
      for (int r = 0; r < 16; ++r) acc[i][j][r] = 0.f;
  u32x4 ra[4], rb[8];
  {
    const int tid = threadIdx.x;
#pragma unroll
    for (int i = 0; i < 4; ++i) {
      int c = tid + i * 256, r = c >> 3, cc = (c & 7) * 8;
      { int gr = m0 + r; gr = gr < M ? gr : M - 1; ra[i] = *(const u32x4*)(A + (size_t)gr * lda + cc); }
    }
#pragma unroll
    for (int i = 0; i < 8; ++i) {
      int c = tid + i * 256, r = c >> 3, cc = (c & 7) * 8;
      { int gn = n0 + r; gn = gn < N ? gn : N - 1; rb[i] = *(const u32x4*)(Bt + (size_t)gn * ldb + cc); }
    }
  }
  for (int k0 = 0; k0 < K; k0 += 64) {
    int tl_ = threadIdx.x; OPAQUE(tl_);
    const int tid = tl_, lane = tl_ & 63;
    __syncthreads();
#pragma unroll
    for (int i = 0; i < 4; ++i) { int c = tid + i * 256, r = c >> 3, cc = (c & 7) * 8; *(u32x4*)(sA + r * LS + cc) = ra[i]; }
#pragma unroll
    for (int i = 0; i < 8; ++i) { int c = tid + i * 256, r = c >> 3, cc = (c & 7) * 8; *(u32x4*)(sB + r * LS + cc) = rb[i]; }
    __syncthreads();
    if (k0 + 64 < K) {
#pragma unroll
      for (int i = 0; i < 4; ++i) {
        int c = tid + i * 256, r = c >> 3, cc = (c & 7) * 8;
        { int gr = m0 + r; gr = gr < M ? gr : M - 1; ra[i] = *(const u32x4*)(A + (size_t)gr * lda + k0 + 64 + cc); }
      }
#pragma unroll
      for (int i = 0; i < 8; ++i) {
        int c = tid + i * 256, r = c >> 3, cc = (c & 7) * 8;
        { int gn = n0 + r; gn = gn < N ? gn : N - 1; rb[i] = *(const u32x4*)(Bt + (size_t)gn * ldb + k0 + 64 + cc); }
      }
    }
#pragma unroll 2
    for (int kk = 0; kk < 4; ++kk) {
      bf16x8 a[2], b[4];
      const int ko = kk * 16 + 8 * (lane >> 5);
#pragma unroll
      for (int i = 0; i < 2; ++i) a[i] = *(const bf16x8*)(sA + (wm + i * 32 + (lane & 31)) * LS + ko);
#pragma unroll
      for (int j = 0; j < 4; ++j) b[j] = *(const bf16x8*)(sB + (wn + j * 32 + (lane & 31)) * LS + ko);
#pragma unroll
      for (int i = 0; i < 2; ++i)
#pragma unroll
        for (int j = 0; j < 4; ++j) acc[i][j] = mfma32(a[i], b[j], acc[i][j]);
    }
  }
  {
    int tl_ = threadIdx.x; OPAQUE(tl_);
    const int lane = tl_ & 63;
    if constexpr (VEC4) {
#pragma unroll
      for (int i = 0; i < 2; ++i)
#pragma unroll
        for (int j = 0; j < 4; ++j)
#pragma unroll
          for (int gq = 0; gq < 4; ++gq) {
            int row = m0 + wm + i * 32 + 8 * gq + 4 * (lane >> 5);
            int col = n0 + wn + j * 32 + (lane & 31);
            if (row < M && col < N) epi.store4(row, col, acc[i][j][4 * gq], acc[i][j][4 * gq + 1], acc[i][j][4 * gq + 2], acc[i][j][4 * gq + 3]);
          }
    } else {
#pragma unroll
      for (int i = 0; i < 2; ++i)
#pragma unroll
        for (int j = 0; j < 4; ++j)
#pragma unroll
          for (int r = 0; r < 16; ++r) {
            int row = m0 + wm + i * 32 + acc_row(r, lane);
            int col = n0 + wn + j * 32 + (lane & 31);
            if (row < M && col < N) epi(row, col, acc[i][j][r]);
          }
    }
  }
}

DEV void transpose_tile(const float* __restrict__ src, int ld_src, bf16_t* __restrict__ dst, int ld_dst, int K, int N,
                        int tk, int tn, unsigned char* smem) {
  float* sT = (float*)smem;
  const int tid = threadIdx.x;
  __syncthreads();
  {
    const int tx = tid & 15, ty = tid >> 4;
#pragma unroll
    for (int p = 0; p < 4; ++p) {
      int k = tk * 64 + ty + p * 16, n = tn * 64 + tx * 4;
      f32x4 v4 = {0.f, 0.f, 0.f, 0.f};
      if (k < K && n < N) v4 = *(const f32x4*)(src + (size_t)k * ld_src + n);
      float* d = sT + (ty + p * 16) * 65 + tx * 4;
      d[0] = v4.x; d[1] = v4.y; d[2] = v4.z; d[3] = v4.w;
    }
  }
  __syncthreads();
  {
    const int n = tid >> 2, kseg = (tid & 3) * 16;
    int gn = tn * 64 + n;
    if (gn < N) {
      float v[16];
#pragma unroll
      for (int j = 0; j < 16; ++j) v[j] = sT[(kseg + j) * 65 + n];
      bf16_t* d = dst + (size_t)gn * ld_dst + tk * 64 + kseg;
      *(u32x4*)d = pack8(v);
      *(u32x4*)(d + 8) = pack8(v + 8);
    }
  }
}

constexpr int TJ0 = 16 * 49, TJ1 = 16 * 16, TJ2 = 16 * 44, TJ3 = 16 * 16, TJ4 = 2 * 16 * 32, TJ5 = 2 * 8, TJ6 = 2 * 8,
              TJ7 = 2 * 8, TJ8 = 32;
constexpr int NTRANS = TJ0 + TJ1 + TJ2 + TJ3 + TJ4 + TJ5 + TJ6 + TJ7 + TJ8;
constexpr int NKEYCV = (2 * 8 * 2 * 128 * 128) / (256 * 8);
constexpr int NMODV = 2 * 96;
constexpr int NPREP = NTRANS + NKEYCV + NMODV;

DEV void st_prep(const Params& P, int item, unsigned char* smem) {
  unsigned char* ws = P.ws;
  if (item < NTRANS) {
    int t = item;
    if (t < TJ0) { transpose_tile(P.in[I_EVWIN], EVC, (bf16_t*)(ws + OFF_WEVIN), 1024, 1024, EVC, t / 49, t % 49, smem); return; }
    t -= TJ0;
    if (t < TJ1) { transpose_tile(P.in[I_EVWOUT], 1024, (bf16_t*)(ws + OFF_WEVOUT), 1024, 1024, 1024, t / 16, t % 16, smem); return; }
    t -= TJ1;
    if (t < TJ2) { transpose_tile(P.in[I_ODWIN], ODC, (bf16_t*)(ws + OFF_WODIN), 1024, 1024, ODC, t / 44, t % 44, smem); return; }
    t -= TJ2;
    if (t < TJ3) { transpose_tile(P.in[I_ODWOUT], 1024, (bf16_t*)(ws + OFF_WODOUT), 1024, 1024, 1024, t / 16, t % 16, smem); return; }
    t -= TJ3;
    if (t < TJ4) {
      int l = t / 512, tt = t % 512;
      transpose_tile(P.in[I_WQ] + (size_t)l * 1024 * 2048, 2048, (bf16_t*)(ws + OFF_WQ) + (size_t)l * 2048 * 1024, 1024, 1024, 2048, tt / 32, tt % 32, smem);
      return;
    }
    t -= TJ4;
    if (t < TJ5) { int d = t / 8; transpose_tile(P.in[I_WUP] + d * 64 * 512, 512, (bf16_t*)(ws + OFF_WUP) + d * 512 * 64, 64, 64, 512, 0, t % 8, smem); return; }
    t -= TJ5;
    if (t < TJ6) { int d = t / 8; transpose_tile(P.in[I_AUP] + d * 64 * 512, 512, (bf16_t*)(ws + OFF_AUP) + d * 512 * 64, 64, 64, 512, 0, t % 8, smem); return; }
    t -= TJ6;
    if (t < TJ7) { transpose_tile(P.in[I_GUP], 512, (bf16_t*)(ws + OFF_GUP), 128, 128, 512, t / 8, t % 8, smem); return; }
    t -= TJ7;
    {
      int which = t & 1, db = t >> 1;
      const float* src = (which ? P.in[I_WI] : P.in[I_WA]) + (size_t)db * 64 * 64;
      transpose_tile(src, 64, (bf16_t*)(ws + OFF_LRUT) + (size_t)db * 128 * 64 + which * 64 * 64, 64, 64, 64, 0, 0, smem);
      return;
    }
  }
  item -= NTRANS;
  if (item < NKEYCV) {
    size_t e = ((size_t)item * 256 + threadIdx.x) * 8;
    const float* s = P.in[I_KEYS] + e;
    f32x4 a = *(const f32x4*)s, b = *(const f32x4*)(s + 4);
    float v[8] = {a.x, a.y, a.z, a.w, b.x, b.y, b.z, b.w};
    *(u32x4*)((bf16_t*)(ws + OFF_KEYS) + e) = pack8(v);
    return;
  }
  item -= NKEYCV;
  {
    const int l = item / 96, cgp = item % 96;
    float* sS = (float*)smem;
    float* sRed = sS + 3 * 1024;
    const int tid = threadIdx.x;
    __syncthreads();
    for (int i = tid; i < 3 * 1024; i += 256) {
      int m = i >> 10, k = i & 1023;
      float c = m < 2 ? P.in[I_C][m * 1024 + k] : P.in[I_CCTX][k];
      sS[i] = siluf_(c);
    }
    __syncthreads();
    const int ks = tid >> 6, col = cgp * 64 + (tid & 63);
    const float* w = P.in[I_MODW] + (size_t)l * 1024 * 6144 + col;
    float a0 = 0.f, a1 = 0.f, a2 = 0.f;
    for (int k = ks * 256; k < ks * 256 + 256; ++k) {
      float wv = w[(size_t)k * 6144];
      a0 += sS[k] * wv; a1 += sS[1024 + k] * wv; a2 += sS[2048 + k] * wv;
    }
    sRed[(ks * 3 + 0) * 64 + (tid & 63)] = a0;
    sRed[(ks * 3 + 1) * 64 + (tid & 63)] = a1;
    sRed[(ks * 3 + 2) * 64 + (tid & 63)] = a2;
    __syncthreads();
    if (tid < 192) {
      int m = tid >> 6, c = tid & 63;
      float s = sRed[(0 * 3 + m) * 64 + c] + sRed[(1 * 3 + m) * 64 + c] + sRed[(2 * 3 + m) * 64 + c] + sRed[(3 * 3 + m) * 64 + c];
      int cc = cgp * 64 + c;
      ((float*)(ws + OFF_MODV))[((size_t)l * 3 + m) * 6144 + cc] = s + P.in[I_MODB][l * 6144 + cc];
    }
  }
}

constexpr int NPCONV = 2 * (NEXP * 1024 / (256 * 16));
DEV void st_peer_conv(const Params& P, int layer, int item) {
  const int half = NPCONV / 2;
  int which = item >= half;
  int it = which ? item - half : item;
  size_t e = ((size_t)it * 256 + threadIdx.x) * 16;
  const float* s = (which ? P.in[I_PV] : P.in[I_PU]) + (size_t)layer * NEXP * 1024 + e;
  const float sc = which ? PEER_VSCALE : PEER_USCALE;
  float v16[16];
#pragma unroll
  for (int q = 0; q < 4; ++q) {
    f32x4 a = *(const f32x4*)(s + 4 * q);
    v16[4 * q] = a.x * sc; v16[4 * q + 1] = a.y * sc; v16[4 * q + 2] = a.z * sc; v16[4 * q + 3] = a.w * sc;
  }
  const size_t ex = e >> 10, col = e & 1023;
  if (which) {
    u32x2 o; o.x = pack8_fp4(v16); o.y = pack8_fp4(v16 + 8);
    *(u32x2*)(P.ws + OFF_PU + ex * PEER_ROWB + PEER_VOFF + (col >> 1)) = o;
  } else {
    u32x3 o = pack16_fp6(v16);
    unsigned* dp = (unsigned*)(P.ws + OFF_PU + ex * PEER_ROWB + (col >> 4) * 12);
    dp[0] = o.x; dp[1] = o.y; dp[2] = o.z;
  }
}

DEV void st_normmod(const Params& P, int layer, int which, int row) {
  const int lane = threadIdx.x & 63;
  const float* src;
  if (which == 0 && layer == 0) src = row < NCTX ? P.in[I_CTX] + (size_t)row * 1024 : P.in[I_X] + (size_t)(row - NCTX) * 1024;
  else src = row < NCTX ? (const float*)(P.ws + OFF_CTXRES) + (size_t)row * 1024 : P.out + (size_t)(row - NCTX) * 1024;
  const float* mv = (const float*)(P.ws + OFF_MODV) + ((size_t)layer * 3 + mod_row(row)) * 6144;
  const float* sh = mv + (which ? 3 : 0) * 1024;
  const float* sc = mv + (which ? 4 : 1) * 1024;
  const float* nw = (which ? P.in[I_NORM2] : P.in[I_NORM1]) + layer * 1024;
  f32x4 v[4];
  float ss = 0.f;
#pragma unroll
  for (int i = 0; i < 4; ++i) {
    v[i] = *(const f32x4*)(src + i * 256 + lane * 4);
    ss += v[i].x * v[i].x + v[i].y * v[i].y + v[i].z * v[i].z + v[i].w * v[i].w;
  }
  ss = wave_sum(ss);
  const float rstd = frsq(ss * (1.f / 1024.f) + 1e-6f);
  bf16_t* dst = (bf16_t*)(P.ws + OFF_HBUF) + (size_t)row * 1024;
#pragma unroll
  for (int i = 0; i < 4; ++i) {
    int c = i * 256 + lane * 4;
    f32x4 w4 = *(const f32x4*)(nw + c), s4 = *(const f32x4*)(sc + c), h4 = *(const f32x4*)(sh + c);
    float o0 = v[i].x * rstd * w4.x * (1.f + s4.x) + h4.x;
    float o1 = v[i].y * rstd * w4.y * (1.f + s4.y) + h4.y;
    float o2 = v[i].z * rstd * w4.z * (1.f + s4.z) + h4.z;
    float o3 = v[i].w * rstd * w4.w * (1.f + s4.w) + h4.w;
    u32x2 pk; pk.x = pack2(o0, o1); pk.y = pack2(o2, o3);
    *(u32x2*)(dst + c) = pk;
  }
}

struct EpiProjL0 {
  bf16_t* proj; float* gates;
  DEVM void operator()(int row, int col, float v) const {
    proj[(size_t)row * EVC + col] = f2bf(v);
    if (col >= 1536 && col < 1552) gates[row * 32 + (col - 1536)] = v;
    else if (col >= 3088) gates[row * 32 + 16 + (col - 3088)] = v;
  }
};
struct EpiStoreBf {
  bf16_t* dst; int ld;
  DEVM void operator()(int row, int col, float v) const { dst[(size_t)row * ld + col] = f2bf(v); }
};
struct EpiStoreBfBias {
  bf16_t* dst; int ld; const float* bias;
  DEVM void operator()(int row, int col, float v) const { dst[(size_t)row * ld + col] = f2bf(v + (bias ? bias[col] : 0.f)); }
};
struct EpiProjL0T {
  bf16_t* proj; float* gates;
  DEVM void operator()(int, int, float) const {}
  DEVM void store4(int n, int m, float v0, float v1, float v2, float v3) const {
    u32x2 pk; pk.x = pack2(v0, v1); pk.y = pack2(v2, v3);
    *(u32x2*)(proj + (size_t)m * EVC + n) = pk;
    if (n >= 1536 && n < 1552) { f32x4 g = {v0, v1, v2, v3}; *(f32x4*)(gates + m * 32 + (n - 1536)) = g; }
    else if (n >= 3088) { f32x4 g = {v0, v1, v2, v3}; *(f32x4*)(gates + m * 32 + 16 + (n - 3088)) = g; }
  }
};
struct EpiStoreBfT {
  bf16_t* dst; int ld;
  DEVM void operator()(int, int, float) const {}
  DEVM void store4(int n, int m, float v0, float v1, float v2, float v3) const {
    u32x2 pk; pk.x = pack2(v0, v1); pk.y = pack2(v2, v3);
    *(u32x2*)(dst + (size_t)m * ld + n) = pk;
  }
};
struct EpiOutProjT {
  const float* x_lat; const float* x_ctx; float* o_lat; float* o_ctx; const float* modv;
  DEVM void operator()(int, int, float) const {}
  DEVM void store4(int n, int m, float v0, float v1, float v2, float v3) const {
    const f32x4 g = *(const f32x4*)(modv + mod_row(m) * 6144 + 2 * 1024 + n);
    const float* xs; float* od;
    if (m < NCTX) { xs = x_ctx + (size_t)m * 1024 + n; od = o_ctx + (size_t)m * 1024 + n; }
    else { size_t o = (size_t)(m - NCTX) * 1024 + n; xs = x_lat + o; od = o_lat + o; }
    const f32x4 x = *(const f32x4*)xs;
    f32x4 r = {x.x + g.x * v0, x.y + g.y * v1, x.z + g.z * v2, x.w + g.w * v3};
    *(f32x4*)od = r;
  }
};
struct EpiStoreBfBiasT {
  bf16_t* dst; int ld; const float* bias;
  DEVM void operator()(int, int, float) const {}
  DEVM void store4(int n, int m, float v0, float v1, float v2, float v3) const {
    if (bias) { v0 += bias[n]; v1 += bias[n + 1]; v2 += bias[n + 2]; v3 += bias[n + 3]; }
    u32x2 pk; pk.x = pack2(v0, v1); pk.y = pack2(v2, v3);
    *(u32x2*)(dst + (size_t)m * ld + n) = pk;
  }
};
struct EpiOutProj {
  const float* x_lat; const float* x_ctx; float* o_lat; float* o_ctx; const float* modv;
  DEVM void operator()(int row, int col, float v) const {
    float g = modv[mod_row(row) * 6144 + 2 * 1024 + col];
    if (row < NCTX) o_ctx[(size_t)row * 1024 + col] = x_ctx[(size_t)row * 1024 + col] + g * v;
    else { size_t o = (size_t)(row - NCTX) * 1024 + col; o_lat[o] = x_lat[o] + g * v; }
  }
};
struct EpiScoreLds {
  float* sS; int m0;
  DEVM void operator()(int row, int col, float v) const { sS[(row - m0) * 129 + col] = v; }
};

DEV void st_xbc_conv(const Params& P, int row) {
  const int lane = threadIdx.x & 63;
  const bf16_t* proj = (const bf16_t*)(P.ws + OFF_PROJ);
  bf16_t* xc = (bf16_t*)P.out + (size_t)row * 1024;
  int row0, len, pos;
  if (row < NCTX) { row0 = (row / CTXL) * CTXL; len = CTXL; pos = row - row0; }
  else { int r = row - NCTX; row0 = NCTX + (r / SEQ) * SEQ; len = SEQ; pos = r % SEQ; }
  const float* cw = P.in[I_SCONVW];
  const float* cb = P.in[I_SCONVB];
#pragma unroll
  for (int hh = 0; hh < 2; ++hh) {
    const int ch = hh * 512 + lane * 8;
    float o[8];
#pragma unroll
    for (int j = 0; j < 8; ++j) o[j] = cb[ch + j];
#pragma unroll
    for (int tap = 0; tap < 4; ++tap) {
      int pp = pos + tap - 2;
      if (pp >= 0 && pp < len) {
        float x[8];
        unpack8(*(const u32x4*)(proj + (size_t)(row0 + pp) * EVC + 2064 + ch), x);
        f32x4 w0 = *(const f32x4*)(cw + tap * 1024 + ch), w1 = *(const f32x4*)(cw + tap * 1024 + ch + 4);
        o[0] += w0.x * x[0]; o[1] += w0.y * x[1]; o[2] += w0.z * x[2]; o[3] += w0.w * x[3];
        o[4] += w1.x * x[4]; o[5] += w1.y * x[5]; o[6] += w1.z * x[6]; o[7] += w1.w * x[7];
      }
    }
#pragma unroll
    for (int j = 0; j < 8; ++j) o[j] = siluf_(o[j]);
    *(u32x4*)(xc + ch) = pack8(o);
  }
}

#ifndef LA_NSEG
#define LA_NSEG 10
#endif
constexpr int LA_NCH = (CTXL + SEQ) / 64;
constexpr int LA_CPS = LA_NCH / LA_NSEG;
static_assert(LA_NCH % LA_NSEG == 0, "linattn segments");
#ifdef CPU_EMU
constexpr size_t OFF_LASEG = OFF_PR + PR_BYTES;
#else
constexpr size_t OFF_LASEG = OFF_R2L0 + (size_t)NTOK * 1024 * 2;
#endif
constexpr size_t LASEG_U = (size_t)48 * LA_NSEG * 8192 * 4;
constexpr size_t OFF_LASEG_N = OFF_LASEG + LASEG_U;
constexpr size_t OFF_LASEG_D = OFF_LASEG_N + (size_t)48 * LA_NSEG * 64 * 4;
#ifndef CPU_EMU
static_assert(OFF_LASEG_D + 48 * LA_NSEG * 4 <= OFF_PR + PR_BYTES, "laseg");
#endif

struct LaRaw { u32x4 q[2], k[4], x[4]; float g0, g1; };

template <bool MLSTM, bool FULL>
DEV void la_load_raw(const Params& P, int b, int h, int d, int cc, LaRaw& R) {
  constexpr int NC_CTX = CTXL / 64;
  const int tid = threadIdx.x;
  const int seg = cc >= NC_CTX;
  const int row0 = seg ? NCTX + b * SEQ : b * CTXL;
  const int len = seg ? SEQ : CTXL;
  const int cl = (seg ? cc - NC_CTX : cc) * 64;
  const bf16_t* proj = (const bf16_t*)(P.ws + OFF_PROJ);
  const bf16_t* xcv = (const bf16_t*)P.out;
  const float* gates = (const float*)(P.ws + OFF_GATES);
  if (tid < 64) {
    int p = cl + tid, grow = row0 + (d ? len - 1 - p : p);
    if (MLSTM) { R.g0 = gates[grow * 32 + d * 4 + h]; R.g1 = gates[grow * 32 + 8 + d * 4 + h]; }
    else { R.g0 = gates[grow * 32 + 16 + d * 8 + h]; R.g1 = 0.f; }
  }
  if (MLSTM) {
#pragma unroll
    for (int i = 0; i < 2; ++i) {
      int c = tid + i * 256, r = c >> 3, cc8 = (c & 7) * 8;
      int p = cl + r, pos = d ? len - 1 - p : p;
      const bf16_t* rp = proj + (size_t)(row0 + pos) * EVC;
      if (FULL) R.q[i] = *(const u32x4*)(rp + h * 64 + cc8);
      R.k[i] = *(const u32x4*)(rp + 256 + h * 64 + cc8);
    }
#pragma unroll
    for (int i = 0; i < 4; ++i) {
      int c = tid + i * 256, r = c >> 4, cc8 = (c & 15) * 8;
      int p = cl + r, pos = d ? len - 1 - p : p;
      R.x[i] = *(const u32x4*)(proj + (size_t)(row0 + pos) * EVC + 512 + h * 128 + cc8);
    }
  } else {
    const int grp = h >> 2;
#pragma unroll
    for (int i = 0; i < 2; ++i) {
      int c = tid + i * 256, r = c >> 3, cc8 = (c & 7) * 8;
      int p = cl + r, pos = d ? len - 1 - p : p;
      R.x[i] = *(const u32x4*)(xcv + (size_t)(row0 + pos) * 1024 + h * 64 + cc8);
    }
#pragma unroll
    for (int i = 0; i < 4; ++i) {
      int c = tid + i * 256, r = c >> 4, cc8 = (c & 15) * 8;
      int p = cl + r, pos = d ? len - 1 - p : p;
      const bf16_t* rp = xcv + (size_t)(row0 + pos) * 1024;
      R.k[i] = *(const u32x4*)(rp + 512 + grp * 128 + cc8);
      if (FULL) { if (i < 2) R.q[i] = *(const u32x4*)(rp + 768 + grp * 128 + cc8); else R.x[i] = *(const u32x4*)(rp + 768 + grp * 128 + cc8); }
    }
  }
}

template <bool MLSTM, bool FULL>
DEV void st_linattn_seg(const Params& P, int sid, int seg, unsigned char* smem) {
  constexpr int DK = MLSTM ? 64 : 128, DX = MLSTM ? 128 : 64;
  constexpr int QS = DK + 8;
  constexpr int NH = MLSTM ? 4 : 8;
  constexpr int NC_CTX = CTXL / 64;
  const int tid = threadIdx.x, lane = tid & 63, wave = tid >> 6;
  const int d = sid & 1, h = (sid >> 1) % NH, b = (sid >> 1) / NH;
  const int gsid = MLSTM ? sid : 16 + sid;
  bf16_t* sQ = (bf16_t*)smem;
  bf16_t* sK = sQ + 64 * QS;
  bf16_t* sP = sK;
  bf16_t* sKT = sK + 64 * QS;
  bf16_t* sXT = sKT + DK * 72;
  bf16_t* sST = sXT + DX * 72;
  float* sF = (float*)(sST + DX * QS);
  float* sLa = sF;
  float* sG = sF + 64;
  float* sBc = sF + 128;
  float* sDen = sF + 192;
  float* sN = sF + 256;
  int* sRow = (int*)(sF + 384);
  static_assert((64 * QS * 2 + DK * 72 + DX * 72 + DX * QS) * 2 + 448 * 4 <= SMEM_BYTES, "lds");
  bf16_t* outb = MLSTM ? (bf16_t*)(P.ws + OFF_HBUF) : (bf16_t*)(P.ws + OFF_R2L0);
  float* segU = (float*)(P.ws + OFF_LASEG);
  float* segN = (float*)(P.ws + OFF_LASEG_N);
  float* segD = (float*)(P.ws + OFF_LASEG_D);

  f32x16 accS[2];
#pragma unroll
  for (int j = 0; j < 2; ++j)
#pragma unroll
    for (int r = 0; r < 16; ++r) accS[j][r] = 0.f;
  const int sx0 = MLSTM ? wave * 32 : (wave >> 1) * 32;
  const int sk0 = MLSTM ? 0 : (wave & 1) * 64;
  float nreg = 0.f;
  float gb0 = 0.f, gb1 = 0.f, alog_e = 0.f, dskip = 0.f;
  if (MLSTM) { gb0 = P.in[I_IBIAS][d * 4 + h]; gb1 = P.in[I_FBIAS][d * 4 + h]; }
  else { gb0 = P.in[I_DTBIAS][d * 8 + h]; alog_e = fexp(P.in[I_ALOG][d * 8 + h]); dskip = P.in[I_DSKIP][h]; }

  const int cc0 = seg * LA_CPS, cc1 = cc0 + LA_CPS;
  LaRaw R;
  la_load_raw<MLSTM, FULL>(P, b, h, d, cc0, R);
  __syncthreads();
  if (FULL) {
    for (int js = 0; js < seg; ++js) {
      const size_t it = (size_t)gsid * LA_NSEG + js;
      const float a = fexp(segD[it]);
      const float* U = segU + it * 8192;
#pragma unroll
      for (int j = 0; j < 2; ++j)
#pragma unroll
        for (int r = 0; r < 16; ++r) accS[j][r] = a * accS[j][r] + U[(j * 16 + r) * 256 + tid];
      if (MLSTM) nreg = a * nreg + segN[it * 64 + (tid >> 2)];
    }
#pragma unroll
    for (int j = 0; j < 2; ++j)
#pragma unroll
      for (int r = 0; r < 16; ++r) sST[(sx0 + acc_row(r, lane)) * QS + sk0 + j * 32 + (lane & 31)] = f2bf(accS[j][r]);
    if (MLSTM && (tid & 3) == 0) sN[tid >> 2] = nreg;
  }
  float lsum = 0.f;

  for (int cc = cc0; cc < cc1; ++cc) {
    int tl_ = threadIdx.x; OPAQUE(tl_);
    const int tid = tl_, lane = tl_ & 63;
    const int sgi = cc >= NC_CTX;
    const int row0 = sgi ? NCTX + b * SEQ : b * CTXL;
    const int len = sgi ? SEQ : CTXL;
    const int cl = (sgi ? cc - NC_CTX : cc) * 64;
    if (tid < 64) {
      int p = cl + tid;
      sRow[tid] = row0 + (d ? len - 1 - p : p);
      float la;
      if (MLSTM) { la = -softplusf_(-(R.g1 + gb1)); sG[tid] = fexp(R.g0 + gb0); }
      else { float dt = softplusf_(R.g0 + gb0); la = -dt * alog_e; sG[tid] = dt; }
      sBc[tid] = wave_incl_scan(la);
    }
    __syncthreads();
    const float blast = sBc[63];
    lsum += blast;
    if (MLSTM) {
#pragma unroll
      for (int i = 0; i < 2; ++i) {
        int c = tid + i * 256, r = c >> 3, cc8 = (c & 7) * 8;
        float kf[8]; unpack8(R.k[i], kf);
        const float wgt = fexp(blast - sBc[r]) * sG[r];
#pragma unroll
        for (int j = 0; j < 8; ++j) sKT[(cc8 + j) * 72 + r] = f2bf(kf[j] * wgt);
        if (FULL) {
          float qf[8]; unpack8(R.q[i], qf);
#pragma unroll
          for (int j = 0; j < 8; ++j) qf[j] *= 0.125f;
          *(u32x4*)(sQ + r * QS + cc8) = pack8(qf);
          *(u32x4*)(sK + r * QS + cc8) = R.k[i];
        }
      }
#pragma unroll
      for (int i = 0; i < 4; ++i) {
        int c = tid + i * 256, r = c >> 4, cc8 = (c & 15) * 8;
        const bf16_t* xs = (const bf16_t*)&R.x[i];
#pragma unroll
        for (int j = 0; j < 8; ++j) sXT[(cc8 + j) * 72 + r] = xs[j];
      }
    } else {
#pragma unroll
      for (int i = 0; i < 2; ++i) {
        int c = tid + i * 256, r = c >> 3, cc8 = (c & 7) * 8;
        const bf16_t* xs = (const bf16_t*)&R.x[i];
#pragma unroll
        for (int j = 0; j < 8; ++j) sXT[(cc8 + j) * 72 + r] = xs[j];
      }
#pragma unroll
      for (int i = 0; i < 4; ++i) {
        int c = tid + i * 256, r = c >> 4, cc8 = (c & 15) * 8;
        float kf[8]; unpack8(R.k[i], kf);
        const float wgt = fexp(blast - sBc[r]) * sG[r];
#pragma unroll
        for (int j = 0; j < 8; ++j) sKT[(cc8 + j) * 72 + r] = f2bf(kf[j] * wgt);
        if (FULL) {
          *(u32x4*)(sK + r * QS + cc8) = R.k[i];
          *(u32x4*)(sQ + r * QS + cc8) = i < 2 ? R.q[i] : R.x[i];
        }
      }
    }
    if (cc + 1 < cc1) la_load_raw<MLSTM, FULL>(P, b, h, d, cc + 1, R);
    __syncthreads();
    if (FULL) {
      const int tr = (wave >> 1) * 32, tc = (wave & 1) * 32;
      f32x16 accP;
#pragma unroll
      for (int r = 0; r < 16; ++r) accP[r] = 0.f;
      if (!(tr == 0 && tc == 32)) {
#pragma unroll
        for (int kk = 0; kk < DK / 16; ++kk) {
          const int ko = kk * 16 + 8 * (lane >> 5);
          bf16x8 a = *(const bf16x8*)(sQ + (tr + (lane & 31)) * QS + ko);
          bf16x8 bb = *(const bf16x8*)(sK + (tc + (lane & 31)) * QS + ko);
          accP = mfma32(a, bb, accP);
        }
      }
      __syncthreads();
      {
        const int s = tc + (lane & 31);
        const float bs = sBc[s], gs = sG[s];
#pragma unroll
        for (int r = 0; r < 16; ++r) {
          int t = tr + acc_row(r, lane);
          float v = (s <= t) ? accP[r] * fexp(sBc[t] - bs) * gs : 0.f;
          sP[t * 72 + s] = f2bf(v);
        }
        {
          const int t = tid >> 2, kq = (tid & 3) * (DK / 4);
          const float et = fexp(sBc[t]);
#pragma unroll
          for (int c8 = 0; c8 < DK / 4; c8 += 8) {
            float qf[8];
            unpack8(*(const u32x4*)(sQ + t * QS + kq + c8), qf);
#pragma unroll
            for (int j = 0; j < 8; ++j) qf[j] *= et;
            *(u32x4*)(sQ + t * QS + kq + c8) = pack8(qf);
          }
        }
      }
      __syncthreads();
      constexpr int NYT = MLSTM ? 2 : 1;
      const int yx0 = MLSTM ? wave * 32 : (wave >> 1) * 32;
      const int yt0 = MLSTM ? 0 : (wave & 1) * 32;
      f32x16 accY[NYT];
#pragma unroll
      for (int j = 0; j < NYT; ++j)
#pragma unroll
        for (int r = 0; r < 16; ++r) accY[j][r] = 0.f;
#pragma unroll
      for (int kk = 0; kk < 4; ++kk) {
        const int ko = kk * 16 + 8 * (lane >> 5);
        bf16x8 a = *(const bf16x8*)(sXT + (yx0 + (lane & 31)) * 72 + ko);
#pragma unroll
        for (int j = 0; j < NYT; ++j) {
          bf16x8 bb = *(const bf16x8*)(sP + (yt0 + j * 32 + (lane & 31)) * 72 + ko);
          accY[j] = mfma32(a, bb, accY[j]);
        }
      }
#pragma unroll
      for (int kk = 0; kk < DK / 16; ++kk) {
        const int ko = kk * 16 + 8 * (lane >> 5);
        bf16x8 a = *(const bf16x8*)(sST + (yx0 + (lane & 31)) * QS + ko);
#pragma unroll
        for (int j = 0; j < NYT; ++j) {
          bf16x8 bb = *(const bf16x8*)(sQ + (yt0 + j * 32 + (lane & 31)) * QS + ko);
          accY[j] = mfma32(a, bb, accY[j]);
        }
      }
      if (MLSTM) {
        const int t = tid >> 2, q4 = (tid & 3) * 16;
        float pf[16], qf[16];
        unpack8(*(const u32x4*)(sP + t * 72 + q4), pf); unpack8(*(const u32x4*)(sP + t * 72 + q4 + 8), pf + 8);
        unpack8(*(const u32x4*)(sQ + t * QS + q4), qf); unpack8(*(const u32x4*)(sQ + t * QS + q4 + 8), qf + 8);
        float den = 0.f;
#pragma unroll
        for (int j = 0; j < 16; ++j) den += pf[j] + sN[q4 + j] * qf[j];
        den = sum4(den);
        if ((tid & 3) == 0) sDen[t] = den;
        __syncthreads();
      }
#pragma unroll
      for (int j = 0; j < NYT; ++j) {
        const int t = yt0 + j * 32 + (lane & 31);
        const size_t obase = (size_t)sRow[t] * 1024 + d * 512 + h * DX;
        const float dinv = MLSTM ? frcp(fmaxf(fabsf(sDen[t]), 1.f)) : 1.f;
#pragma unroll
        for (int g = 0; g < 4; ++g) {
          const int x0 = yx0 + 8 * g + 4 * (lane >> 5);
          float v0 = accY[j][4 * g], v1 = accY[j][4 * g + 1], v2 = accY[j][4 * g + 2], v3 = accY[j][4 * g + 3];
          if (MLSTM) { v0 *= dinv; v1 *= dinv; v2 *= dinv; v3 *= dinv; }
          else if (d == 0) {
            v0 += dskip * bf2f(sXT[(x0 + 0) * 72 + t]); v1 += dskip * bf2f(sXT[(x0 + 1) * 72 + t]);
            v2 += dskip * bf2f(sXT[(x0 + 2) * 72 + t]); v3 += dskip * bf2f(sXT[(x0 + 3) * 72 + t]);
          }
          u32x2 pk; pk.x = pack2(v0, v1); pk.y = pack2(v2, v3);
          *(u32x2*)(outb + obase + x0) = pk;
        }
      }
      __syncthreads();
    }
    {
      const float eb = fexp(blast);
#pragma unroll
      for (int j = 0; j < 2; ++j)
#pragma unroll
        for (int r = 0; r < 16; ++r) accS[j][r] *= eb;
#pragma unroll
      for (int kk = 0; kk < 4; ++kk) {
        const int ko = kk * 16 + 8 * (lane >> 5);
        bf16x8 a = *(const bf16x8*)(sXT + (sx0 + (lane & 31)) * 72 + ko);
#pragma unroll
        for (int j = 0; j < 2; ++j) {
          bf16x8 bb = *(const bf16x8*)(sKT + (sk0 + j * 32 + (lane & 31)) * 72 + ko);
          accS[j] = mfma32(a, bb, accS[j]);
        }
      }
      if (FULL) {
#pragma unroll
        for (int j = 0; j < 2; ++j)
#pragma unroll
          for (int r = 0; r < 16; ++r) sST[(sx0 + acc_row(r, lane)) * QS + sk0 + j * 32 + (lane & 31)] = f2bf(accS[j][r]);
      }
      if (MLSTM) {
        const int k = tid >> 2, q4 = (tid & 3) * 16;
        float kf[16];
        unpack8(*(const u32x4*)(sKT + k * 72 + q4), kf); unpack8(*(const u32x4*)(sKT + k * 72 + q4 + 8), kf + 8);
        float ps = 0.f;
#pragma unroll
        for (int j = 0; j < 16; ++j) ps += kf[j];
        nreg = nreg * eb + sum4(ps);
        if (FULL && (tid & 3) == 0) sN[k] = nreg;
      }
    }
    __syncthreads();
  }
  if (!FULL) {
    const size_t it = (size_t)gsid * LA_NSEG + seg;
    float* U = segU + it * 8192;
#pragma unroll
    for (int j = 0; j < 2; ++j)
#pragma unroll
      for (int r = 0; r < 16; ++r) U[(j * 16 + r) * 256 + tid] = accS[j][r];
    if (MLSTM && (tid & 3) == 0) segN[it * 64 + (tid >> 2)] = nreg;
    if (tid == 0) segD[it] = lsum;
  }
}

DEV void st_finish_l0(const Params& P, int row) {
  const int lane = threadIdx.x & 63;
  bf16_t* hb = (bf16_t*)(P.ws + OFF_HBUF) + (size_t)row * 1024;
  const bf16_t* yb = (const bf16_t*)(P.ws + OFF_R2L0) + (size_t)row * 1024;
  const bf16_t* pr = (const bf16_t*)(P.ws + OFF_PROJ) + (size_t)row * EVC;
  const int ch = lane * 8;
  float h0[8], h1[8], o[8], f1[8];
  unpack8(*(const u32x4*)(hb + ch), h0);
  unpack8(*(const u32x4*)(hb + 512 + ch), h1);
  unpack8(*(const u32x4*)(pr + 1024 + ch), o);
  float ss = 0.f;
#pragma unroll
  for (int j = 0; j < 8; ++j) { h0[j] += h1[j]; ss += h0[j] * h0[j]; }
  ss = sum16(ss);
  float rstd = frsq(ss * (1.f / 128.f) + 1e-6f);
  float pw[8]; ld8(P.in[I_MNORM] + ch, pw);
#pragma unroll
  for (int j = 0; j < 8; ++j) f1[j] = h0[j] * rstd * pw[j] * sigmoidf_(o[j]);
  float y0[8], y1[8], z[8], f2[8];
  unpack8(*(const u32x4*)(yb + ch), y0);
  unpack8(*(const u32x4*)(yb + 512 + ch), y1);
  unpack8(*(const u32x4*)(pr + 1552 + ch), z);
  float s2 = 0.f;
#pragma unroll
  for (int j = 0; j < 8; ++j) { y0[j] = (y0[j] + y1[j]) * siluf_(z[j]); s2 += y0[j] * y0[j]; }
  s2 = wave_sum(s2);
  float rstd2 = frsq(s2 * (1.f / 512.f) + 1e-6f);
  ld8(P.in[I_SNORM] + ch, pw);
#pragma unroll
  for (int j = 0; j < 8; ++j) f2[j] = y0[j] * rstd2 * pw[j];
  *(u32x4*)(hb + ch) = pack8(f1);
  *(u32x4*)(hb + 512 + ch) = pack8(f2);
}

DEV float mixval(const bf16_t* __restrict__ proj, int row, int c, const float* __restrict__ mu) {
  float self = bf2f(proj[(size_t)row * ODC + c]);
  int nrow = -1;
  if (row < NCTX) {
    int pos = row % CTXL;
    if (c < 896) { if (pos > 0) nrow = row - 1; }
    else { if (pos < CTXL - 1) nrow = row + 1; }
  } else {
    int pos = (row - NCTX) % SEQ;
    int gx = pos % GW, gy = pos / GW, q = c / 448;
    if (q == 0) { if (gx > 0) nrow = row - 1; }
    else if (q == 1) { if (gx < GW - 1) nrow = row + 1; }
    else if (q == 2) { if (gy > 0) nrow = row - GW; }
    else { if (gy < SEQ / GW - 1) nrow = row + GW; }
  }
  float nb = nrow >= 0 ? bf2f(proj[(size_t)nrow * ODC + c]) : 0.f;
  return self + mu[c] * (nb - self);
}

DEV int nbr_row(int row, int c) {
  if (row < NCTX) {
    int pos = row % CTXL;
    if (c < 896) return pos > 0 ? row - 1 : -1;
    return pos < CTXL - 1 ? row + 1 : -1;
  }
  int pos = (row - NCTX) % SEQ;
  int gx = pos % GW, gy = pos / GW, q = c / 448;
  if (q == 0) return gx > 0 ? row - 1 : -1;
  if (q == 1) return gx < GW - 1 ? row + 1 : -1;
  if (q == 2) return gy > 0 ? row - GW : -1;
  return gy < SEQ / GW - 1 ? row + GW : -1;
}

DEV void mix8(const bf16_t* __restrict__ proj, int row, int c, const float* __restrict__ mu, float* o) {
  float xs[8], xn[8];
  unpack8(*(const u32x4*)(proj + (size_t)row * ODC + c), xs);
  const int nr = nbr_row(row, c);
  if (nr >= 0) unpack8(*(const u32x4*)(proj + (size_t)nr * ODC + c), xn);
  else {
#pragma unroll
    for (int j = 0; j < 8; ++j) xn[j] = 0.f;
  }
  const f32x4 m0 = *(const f32x4*)(mu + c), m1 = *(const f32x4*)(mu + c + 4);
  const float mm[8] = {m0.x, m0.y, m0.z, m0.w, m1.x, m1.y, m1.z, m1.w};
#pragma unroll
  for (int j = 0; j < 8; ++j) o[j] = xs[j] + mm[j] * (xn[j] - xs[j]);
}

DEV void st_lora_act(const Params& P, int row2) {
  const int lane = threadIdx.x & 63;
  const int row = row2 + (lane >> 5), c = (lane & 31) * 8;
  const bf16_t* proj = (const bf16_t*)(P.ws + OFF_PROJ);
  bf16_t* hb = (bf16_t*)(P.ws + OFF_HBUF) + (size_t)row * 1024;
  float v[8];
  mix8(proj, row, 1536 + c, P.in[I_MU], v);
#pragma unroll
  for (int j = 0; j < 8; ++j) v[j] = c < 64 ? tanhf_(v[j]) : (c < 128 ? v[j] : sigmoidf_(v[j]));
  *(u32x4*)(hb + c) = pack8(v);
}

DEV void st_rwkv_stream(const Params& P, int sid, unsigned char* smem) {
  const int tid = threadIdx.x, lane = tid & 63, wave = tid >> 6;
  const int d = sid & 1, h = (sid >> 1) & 7, b = sid >> 4;
  float* sR = (float*)smem;
  float* sW = sR + 2048;
  float* sKk = sW + 2048;
  float* sV = sKk + 2048;
  float* sA = sV + 2048;
  float* sBb = sA + 2048;
  float* sY = sBb + 2048;
  int* sRow = (int*)(sY + 2048);
  const bf16_t* proj = (const bf16_t*)(P.ws + OFF_PROJ);
  const bf16_t* lora = (const bf16_t*)(P.ws + OFF_LORA);
  bf16_t* yout = (bf16_t*)(P.ws + OFF_HBUF);
  const float* mu = P.in[I_MU];
  const int vrow = tid >> 2, j4 = tid & 3;
  float S[16];
#pragma unroll
  for (int i = 0; i < 16; ++i) S[i] = 0.f;
  const float kkw = P.in[I_KK][h * 64 + lane], kaw = P.in[I_KA][h * 64 + lane];
  for (int seg = 0; seg < 2; ++seg) {
    const int row0 = seg == 0 ? b * CTXL : NCTX + b * SEQ;
    const int len = seg == 0 ? CTXL : SEQ;
    for (int it = 0; it < len / 32; ++it) {
      __syncthreads();
      for (int s = wave; s < 32; s += 4) {
        int p = it * 32 + s, pos = d ? len - 1 - p : p, row = row0 + pos;
        int c = h * 64 + lane;
        float r = mixval(proj, row, c, mu);
        float k = mixval(proj, row, 512 + c, mu);
        float v = mixval(proj, row, 1024 + c, mu);
        float kk = k * kkw;
        float ss = wave_sum(kk * kk);
        kk *= frsq(ss + 1e-12f);
        float lw = bf2f(lora[((size_t)d * NTOK + row) * 512 + c]);
        float la = bf2f(lora[((size_t)(2 + d) * NTOK + row) * 512 + c]);
        float w = fexp(-0.6065306597126334f * sigmoidf_(lw));
        float a = sigmoidf_(la);
        float kt = k * (1.f + (a - 1.f) * kaw);
        sR[s * 64 + lane] = r; sW[s * 64 + lane] = w; sKk[s * 64 + lane] = kt; sV[s * 64 + lane] = v;
        sA[s * 64 + lane] = -kk; sBb[s * 64 + lane] = kk * a;
        if (lane == 0) sRow[s] = row;
      }
      __syncthreads();
      for (int s = 0; s < 32; ++s) {
        const float* pa = sA + s * 64 + j4 * 16;
        const float* pw = sW + s * 64 + j4 * 16;
        const float* pk = sKk + s * 64 + j4 * 16;
        const float* pb = sBb + s * 64 + j4 * 16;
        const float* pr = sR + s * 64 + j4 * 16;
        const float vv = sV[s * 64 + vrow];
        float sa = 0.f;
#pragma unroll
        for (int i = 0; i < 16; ++i) sa += S[i] * pa[i];
        sa = sum4(sa);
        float y = 0.f;
#pragma unroll
        for (int i = 0; i < 16; ++i) { S[i] = S[i] * pw[i] + sa * pb[i] + vv * pk[i]; y += S[i] * pr[i]; }
        y = sum4(y);
        if (j4 == 0) sY[s * 64 + vrow] = y;
      }
      __syncthreads();
      for (int i = tid; i < 2048; i += 256) {
        int s = i >> 6, c = i & 63;
        yout[(size_t)sRow[s] * 1024 + d * 512 + h * 64 + c] = f2bf(sY[i]);
      }
    }
  }
}


struct RwkvRaw { u32x4 rs, rn, ks, kn, vs, vn, lw, la; int row; };

DEV void rwkv_load_raw(const bf16_t* __restrict__ proj, const bf16_t* __restrict__ lora, int b, int h, int d, int cc, int t, int c0,
                       RwkvRaw& R) {
  constexpr int NC_CTX = CTXL / 32;
  const int seg = cc >= NC_CTX;
  const int row0 = seg ? NCTX + b * SEQ : b * CTXL;
  const int len = seg ? SEQ : CTXL;
  const int p = (seg ? cc - NC_CTX : cc) * 32 + t;
  const int row = row0 + (d ? len - 1 - p : p);
  const int col = h * 64 + c0;
  const u32x4 z4 = {0u, 0u, 0u, 0u};
  const bf16_t* rp = proj + (size_t)row * ODC;
  R.row = row;
  R.rs = *(const u32x4*)(rp + col);
  R.ks = *(const u32x4*)(rp + 512 + col);
  R.vs = *(const u32x4*)(rp + 1024 + col);
  int n0 = nbr_row(row, col), n1 = nbr_row(row, 512 + col), n2 = nbr_row(row, 1024 + col);
  R.rn = n0 >= 0 ? *(const u32x4*)(proj + (size_t)n0 * ODC + col) : z4;
  R.kn = n1 >= 0 ? *(const u32x4*)(proj + (size_t)n1 * ODC + 512 + col) : z4;
  R.vn = n2 >= 0 ? *(const u32x4*)(proj + (size_t)n2 * ODC + 1024 + col) : z4;
  R.lw = *(const u32x4*)(lora + ((size_t)d * NTOK + row) * 512 + col);
  R.la = *(const u32x4*)(lora + ((size_t)(2 + d) * NTOK + row) * 512 + col);
}

#ifndef RW_NSEG
#define RW_NSEG 16
#endif
constexpr int RW_NCH = (CTXL + SEQ) / 32;
constexpr size_t OFF_RWSEG = OFF_PU;
static_assert((size_t)32 * RW_NSEG * 64 * 128 * 4 <= (size_t)2 * NEXP * 1024, "rwseg");

template <bool FULL>
DEV void st_rwkv_seg(const Params& P, int sid, int seg, unsigned char* smem) {
  constexpr int NVB = FULL ? 2 : 4;
  constexpr int ZR = FULL ? 64 : 128;
  const int tid = threadIdx.x, lane = tid & 63, wave = tid >> 6;
  const int d = sid & 1, h = (sid >> 1) & 7, b = sid >> 4;
  bf16_t* sAt = (bf16_t*)smem;
  bf16_t* sRt = sAt + 32 * 72;
  bf16_t* sBt = sRt + 32 * 72;
  bf16_t* sKt = sBt + 32 * 72;
  bf16_t* sBT = sKt + 32 * 72;
  bf16_t* sKT = sBT + 64 * 40;
  bf16_t* sVT = sKT + 64 * 40;
  bf16_t* sLak = sVT + 64 * 40;
  bf16_t* sM = sLak + 32 * 40;
  bf16_t* sLrb = sM + 32 * 40;
  bf16_t* sLrk = sLrb + 32 * 40;
  bf16_t* sZ = FULL ? sLrk + 32 * 40 : sLrb;
  bf16_t* after = sZ + ZR * 72;
  bf16_t* sRT = FULL ? after : nullptr;
  bf16_t* sSAT = FULL ? after + 64 * 40 : sRt;
  float* sLP = (float*)(FULL ? after + 2 * 64 * 40 : after);
  float* sLab = sLP + 32 * 64;
  float* sD = sLab + 32 * 33;
  float* sPT = sD + 768;
  int* sRow = (int*)(sPT + 64);
  if (!FULL) sRT = (bf16_t*)sLP;
  static_assert((4 * 32 * 72 + 3 * 64 * 40 + 4 * 32 * 40 + 2 * 64 * 40 + 64 * 72) * 2 + (32 * 64 + 32 * 33 + 768 + 64 + 32 + 320) * 4 + 16 <= SMEM_BYTES, "lds full");
  static_assert((4 * 32 * 72 + 3 * 64 * 40 + 2 * 32 * 40 + 128 * 72) * 2 + (32 * 64 + 32 * 33 + 768 + 64 + 32) * 4 <= SMEM_BYTES, "lds p1");
  static_assert(128 * 40 * 2 <= (32 * 64 + 32 * 33) * 4 && 128 * 40 <= 3 * 32 * 72, "alias");
  const bf16_t* proj = (const bf16_t*)(P.ws + OFF_PROJ);
  const bf16_t* lora = (const bf16_t*)(P.ws + OFF_LORA);
  bf16_t* yout = (bf16_t*)(P.ws + OFF_HBUF);
  float* segZ = (float*)(P.ws + OFF_RWSEG);
  const int t = tid >> 3, c0 = (tid & 7) * 8;
  const int hl = lane >> 5, l31 = lane & 31;
  float* sCst = (float*)(smem + SMEM_BYTES - 320 * 4 - 16);
  if (tid < 64) {
    sCst[tid] = P.in[I_MU][h * 64 + tid]; sCst[64 + tid] = P.in[I_MU][512 + h * 64 + tid]; sCst[128 + tid] = P.in[I_MU][1024 + h * 64 + tid];
    sCst[192 + tid] = P.in[I_KK][h * 64 + tid]; sCst[256 + tid] = P.in[I_KA][h * 64 + tid];
  }
  const int cc0 = (seg * RW_NCH) / RW_NSEG, cc1 = ((seg + 1) * RW_NCH) / RW_NSEG;
  RwkvRaw R;
  rwkv_load_raw(proj, lora, b, h, d, cc0, t, c0, R);
  f32x16 Zm[2];
#pragma unroll
  for (int j = 0; j < 2; ++j)
#pragma unroll
    for (int r = 0; r < 16; ++r) Zm[j][r] = 0.f;
  __syncthreads();
  for (int i = tid; i < ZR * 72; i += 256) sZ[i] = 0;
  __syncthreads();
  if (!FULL) {
    if (wave >= 2) {
#pragma unroll
      for (int cb = 0; cb < 2; ++cb)
#pragma unroll
        for (int r = 0; r < 16; ++r) {
          int c = cb * 32 + acc_row(r, lane), vp = wave * 32 + l31;
          if (c == vp - 64) { Zm[cb][r] = 1.f; sZ[vp * 72 + c] = 0x3f80; }
        }
    }
  } else {
    for (int js = 0; js < seg; ++js) {
      const float* Zs = segZ + ((size_t)sid * RW_NSEG + js) * 64 * 128;
      bf16_t* sG = sAt;
      {
        const int c = tid >> 2, c2 = (tid & 3) * 16;
        float gv[16];
        ld8(Zs + c * 128 + 64 + c2, gv); ld8(Zs + c * 128 + 64 + c2 + 8, gv + 8);
        *(u32x4*)(sG + c * 72 + c2) = pack8(gv);
        *(u32x4*)(sG + c * 72 + c2 + 8) = pack8(gv + 8);
      }
      __syncthreads();
      if (wave >= 2) {
        const int cb = wave - 2;
#pragma unroll
        for (int vb = 0; vb < 2; ++vb) {
          f32x16 acc;
#pragma unroll
          for (int r = 0; r < 16; ++r) acc[r] = Zs[(cb * 32 + acc_row(r, lane)) * 128 + vb * 32 + l31];
#pragma unroll
          for (int kk = 0; kk < 4; ++kk) {
            bf16x8 a = *(const bf16x8*)(sG + (cb * 32 + l31) * 72 + kk * 16 + 8 * hl);
            bf16x8 bb = *(const bf16x8*)(sZ + (vb * 32 + l31) * 72 + kk * 16 + 8 * hl);
            acc = mfma32(a, bb, acc);
          }
          Zm[vb] = acc;
        }
      }
      __syncthreads();
      if (wave >= 2) {
        const int cb = wave - 2;
#pragma unroll
        for (int vb = 0; vb < 2; ++vb)
#pragma unroll
          for (int g = 0; g < 4; ++g) {
            u32x2 pk; pk.x = pack2(Zm[vb][4 * g], Zm[vb][4 * g + 1]); pk.y = pack2(Zm[vb][4 * g + 2], Zm[vb][4 * g + 3]);
            *(u32x2*)(sZ + (vb * 32 + l31) * 72 + cb * 32 + 8 * g + 4 * hl) = pk;
          }
      }
      __syncthreads();
    }
  }
  for (int cc = cc0; cc < cc1; ++cc) {
    int tl_ = threadIdx.x; OPAQUE(tl_);
    const int tid = tl_, lane = tl_ & 63, hl = lane >> 5, l31 = lane & 31, t = tl_ >> 3, c0 = (tl_ & 7) * 8;
    const float* muR = sCst + c0; const float* muK = sCst + 64 + c0; const float* muV = sCst + 128 + c0;
    const float* kkw = sCst + 192 + c0; const float* kaw = sCst + 256 + c0;
    float lw8[8], lp8[8];
    {
      float lwf[8];
      unpack8(R.lw, lwf);
#pragma unroll
      for (int j = 0; j < 8; ++j) { lw8[j] = -0.6065306597126334f * sigmoidf_(lwf[j]); lp8[j] = lw8[j]; }
#pragma unroll
      for (int off = 8; off < 64; off <<= 1) {
#pragma unroll
        for (int j = 0; j < 8; ++j) {
#ifdef CPU_EMU
          float o = emu_shfl_up(lp8[j], off);
#else
          float o = __shfl_up(lp8[j], off, 64);
#endif
          if (lane >= off) lp8[j] += o;
        }
      }
      if (lane >= 56) {
#pragma unroll
        for (int j = 0; j < 8; ++j) sLP[wave * 64 + c0 + j] = lp8[j];
      }
      if ((tid & 7) == 0) sRow[t] = R.row;
    }
    __syncthreads();
    {
#pragma unroll
      for (int j = 0; j < 8; ++j) {
        float offs = 0.f;
        for (int w2 = 0; w2 < wave; ++w2) offs += sLP[w2 * 64 + c0 + j];
        lp8[j] += offs;
      }
      if (t == 31) {
#pragma unroll
        for (int j = 0; j < 8; ++j) sPT[c0 + j] = fexp(lp8[j]);
      }
    }
    {
      float xs[8], xn[8], kt[8], aa[8], ob[8], ok[8];
      unpack8(R.ks, xs); unpack8(R.kn, xn);
      float ss = 0.f;
#pragma unroll
      for (int j = 0; j < 8; ++j) { kt[j] = xs[j] + muK[j] * (xn[j] - xs[j]); aa[j] = kt[j] * kkw[j]; ss += aa[j] * aa[j]; }
      ss = sum8(ss);
      const float rn = frsq(ss + 1e-12f);
      float laf[8];
      unpack8(R.la, laf);
#pragma unroll
      for (int j = 0; j < 8; ++j) {
        const float lp = lp8[j];
        const float lpm = lp8[j] - lw8[j];
        const float e = fexp(-lp);
        const float kkn = aa[j] * rn;
        const float asg = sigmoidf_(laf[j]);
        aa[j] = -kkn * fexp(lpm);
        ob[j] = kkn * asg * e;
        ok[j] = kt[j] * (1.f + (asg - 1.f) * kaw[j]) * e;
      }
      *(u32x4*)(sAt + t * 72 + c0) = pack8(aa);
      *(u32x4*)(sBt + t * 72 + c0) = pack8(ob);
      *(u32x4*)(sKt + t * 72 + c0) = pack8(ok);
#pragma unroll
      for (int j = 0; j < 8; ++j) { sBT[(c0 + j) * 40 + t] = f2bf(ob[j]); sKT[(c0 + j) * 40 + t] = f2bf(ok[j]); }
      unpack8(R.vs, xs); unpack8(R.vn, xn);
#pragma unroll
      for (int j = 0; j < 8; ++j) sVT[(c0 + j) * 40 + t] = f2bf(xs[j] + muV[j] * (xn[j] - xs[j]));
      if (FULL) {
        unpack8(R.rs, xs); unpack8(R.rn, xn);
#pragma unroll
        for (int j = 0; j < 8; ++j) xs[j] = (xs[j] + muR[j] * (xn[j] - xs[j])) * fexp(lp8[j]);
        *(u32x4*)(sRt + t * 72 + c0) = pack8(xs);
      }
    }
    if (cc + 1 < cc1) rwkv_load_raw(proj, lora, b, h, d, cc + 1, t, c0, R);
    __syncthreads();
    if (FULL || wave < 2) {
      const bf16_t* Asrc = wave < 2 ? sAt : sRt;
      const bf16_t* Bsrc = (wave & 1) ? sKt : sBt;
      f32x16 acc;
#pragma unroll
      for (int r = 0; r < 16; ++r) acc[r] = 0.f;
#pragma unroll
      for (int kk = 0; kk < 4; ++kk) {
        bf16x8 a = *(const bf16x8*)(Asrc + l31 * 72 + kk * 16 + 8 * hl);
        bf16x8 bb = *(const bf16x8*)(Bsrc + l31 * 72 + kk * 16 + 8 * hl);
        acc = mfma32(a, bb, acc);
      }
      bf16_t* dst = wave == 1 ? sLak : (wave == 2 ? sLrb : sLrk);
#pragma unroll
      for (int r = 0; r < 16; ++r) {
        int tt = acc_row(r, lane), j = l31;
        bool keep = wave < 2 ? (j < tt) : (j <= tt);
        float v = keep ? acc[r] : 0.f;
        if (wave == 0) sLab[tt * 33 + j] = v;
        else dst[tt * 40 + j] = f2bf(v);
      }
    }
    __syncthreads();
    if (tid < 32) {
      const int q = tid >> 4, c = tid & 15;
      float x[16];
#pragma unroll
      for (int i = 0; i < 16; ++i) {
        float sacc = (i == c) ? 1.f : 0.f;
#pragma unroll
        for (int j = 0; j < i; ++j) sacc += sLab[(q * 16 + i) * 33 + q * 16 + j] * x[j];
        x[i] = sacc;
        sD[q * 256 + i * 16 + c] = sacc;
      }
    }
    __syncthreads();
    {
      const int i = tid >> 4, c = tid & 15;
      float sacc = 0.f;
#pragma unroll
      for (int j = 0; j < 16; ++j) sacc += sLab[(16 + i) * 33 + j] * sD[j * 16 + c];
      sD[512 + i * 16 + c] = sacc;
    }
    __syncthreads();
    {
      const int i = tid >> 4, c = tid & 15;
      float sacc = 0.f;
#pragma unroll
      for (int j = 0; j < 16; ++j) sacc += sD[256 + i * 16 + j] * sD[512 + j * 16 + c];
      sM[(16 + i) * 40 + c] = f2bf(sacc);
      sM[i * 40 + c] = f2bf(sD[i * 16 + c]);
      sM[(16 + i) * 40 + 16 + c] = f2bf(sD[256 + i * 16 + c]);
      sM[i * 40 + 16 + c] = 0;
    }
    if (wave < NVB) {
      const int vb = wave;
      f32x16 acc;
#pragma unroll
      for (int r = 0; r < 16; ++r) acc[r] = 0.f;
#pragma unroll
      for (int kk = 0; kk < 4; ++kk) {
        bf16x8 a = *(const bf16x8*)(sAt + l31 * 72 + kk * 16 + 8 * hl);
        bf16x8 bb = *(const bf16x8*)(sZ + (vb * 32 + l31) * 72 + kk * 16 + 8 * hl);
        acc = mfma32(a, bb, acc);
      }
      if (vb < 2) {
#pragma unroll
        for (int kk = 0; kk < 2; ++kk) {
          bf16x8 a = *(const bf16x8*)(sLak + l31 * 40 + kk * 16 + 8 * hl);
          bf16x8 bb = *(const bf16x8*)(sVT + (vb * 32 + l31) * 40 + kk * 16 + 8 * hl);
          acc = mfma32(a, bb, acc);
        }
      }
#pragma unroll
      for (int g = 0; g < 4; ++g) {
        u32x2 pk; pk.x = pack2(acc[4 * g], acc[4 * g + 1]); pk.y = pack2(acc[4 * g + 2], acc[4 * g + 3]);
        *(u32x2*)(sRT + (vb * 32 + l31) * 40 + 8 * g + 4 * hl) = pk;
      }
    }
    __syncthreads();
    if (wave < NVB) {
      const int vb = wave;
      f32x16 acc;
#pragma unroll
      for (int r = 0; r < 16; ++r) acc[r] = 0.f;
#pragma unroll
      for (int kk = 0; kk < 2; ++kk) {
        bf16x8 a = *(const bf16x8*)(sM + l31 * 40 + kk * 16 + 8 * hl);
        bf16x8 bb = *(const bf16x8*)(sRT + (vb * 32 + l31) * 40 + kk * 16 + 8 * hl);
        acc = mfma32(a, bb, acc);
      }
#pragma unroll
      for (int g = 0; g < 4; ++g) {
        u32x2 pk; pk.x = pack2(acc[4 * g], acc[4 * g + 1]); pk.y = pack2(acc[4 * g + 2], acc[4 * g + 3]);
        *(u32x2*)(sSAT + (vb * 32 + l31) * 40 + 8 * g + 4 * hl) = pk;
      }
    }
    __syncthreads();
    if (FULL) {
      if (wave < 2) {
        const int vb = wave;
        f32x16 acc;
#pragma unroll
        for (int r = 0; r < 16; ++r) acc[r] = 0.f;
#pragma unroll
        for (int kk = 0; kk < 4; ++kk) {
          bf16x8 a = *(const bf16x8*)(sZ + (vb * 32 + l31) * 72 + kk * 16 + 8 * hl);
          bf16x8 bb = *(const bf16x8*)(sRt + l31 * 72 + kk * 16 + 8 * hl);
          acc = mfma32(a, bb, acc);
        }
#pragma unroll
        for (int kk = 0; kk < 2; ++kk) {
          bf16x8 a = *(const bf16x8*)(sSAT + (vb * 32 + l31) * 40 + kk * 16 + 8 * hl);
          bf16x8 bb = *(const bf16x8*)(sLrb + l31 * 40 + kk * 16 + 8 * hl);
          acc = mfma32(a, bb, acc);
        }
#pragma unroll
        for (int kk = 0; kk < 2; ++kk) {
          bf16x8 a = *(const bf16x8*)(sVT + (vb * 32 + l31) * 40 + kk * 16 + 8 * hl);
          bf16x8 bb = *(const bf16x8*)(sLrk + l31 * 40 + kk * 16 + 8 * hl);
          acc = mfma32(a, bb, acc);
        }
        {
          const size_t obase = (size_t)sRow[l31] * 1024 + d * 512 + h * 64 + vb * 32;
#pragma unroll
          for (int g = 0; g < 4; ++g) {
            u32x2 pk; pk.x = pack2(acc[4 * g], acc[4 * g + 1]); pk.y = pack2(acc[4 * g + 2], acc[4 * g + 3]);
            *(u32x2*)(yout + obase + 8 * g + 4 * hl) = pk;
          }
        }
      } else {
        const int cb = wave - 2;
#pragma unroll
        for (int vb = 0; vb < 2; ++vb) {
          f32x16 acc;
#pragma unroll
          for (int r = 0; r < 16; ++r) acc[r] = 0.f;
#pragma unroll
          for (int kk = 0; kk < 2; ++kk) {
            bf16x8 a = *(const bf16x8*)(sBT + (cb * 32 + l31) * 40 + kk * 16 + 8 * hl);
            bf16x8 bb = *(const bf16x8*)(sSAT + (vb * 32 + l31) * 40 + kk * 16 + 8 * hl);
            acc = mfma32(a, bb, acc);
          }
#pragma unroll
          for (int kk = 0; kk < 2; ++kk) {
            bf16x8 a = *(const bf16x8*)(sKT + (cb * 32 + l31) * 40 + kk * 16 + 8 * hl);
            bf16x8 bb = *(const bf16x8*)(sVT + (vb * 32 + l31) * 40 + kk * 16 + 8 * hl);
            acc = mfma32(a, bb, acc);
          }
#pragma unroll
          for (int r = 0; r < 16; ++r) Zm[vb][r] = sPT[cb * 32 + acc_row(r, lane)] * (Zm[vb][r] + acc[r]);
        }
      }
      __syncthreads();
      if (wave >= 2) {
        const int cb = wave - 2;
#pragma unroll
        for (int vb = 0; vb < 2; ++vb)
#pragma unroll
          for (int g = 0; g < 4; ++g) {
            u32x2 pk; pk.x = pack2(Zm[vb][4 * g], Zm[vb][4 * g + 1]); pk.y = pack2(Zm[vb][4 * g + 2], Zm[vb][4 * g + 3]);
            *(u32x2*)(sZ + (vb * 32 + l31) * 72 + cb * 32 + 8 * g + 4 * hl) = pk;
          }
      }
    } else {
      const int vb = wave;
#pragma unroll
      for (int cb = 0; cb < 2; ++cb) {
        f32x16 acc;
#pragma unroll
        for (int r = 0; r < 16; ++r) acc[r] = 0.f;
#pragma unroll
        for (int kk = 0; kk < 2; ++kk) {
          bf16x8 a = *(const bf16x8*)(sBT + (cb * 32 + l31) * 40 + kk * 16 + 8 * hl);
          bf16x8 bb = *(const bf16x8*)(sSAT + (vb * 32 + l31) * 40 + kk * 16 + 8 * hl);
          acc = mfma32(a, bb, acc);
        }
        if (vb < 2) {
#pragma unroll
          for (int kk = 0; kk < 2; ++kk) {
            bf16x8 a = *(const bf16x8*)(sKT + (cb * 32 + l31) * 40 + kk * 16 + 8 * hl);
            bf16x8 bb = *(const bf16x8*)(sVT + (vb * 32 + l31) * 40 + kk * 16 + 8 * hl);
            acc = mfma32(a, bb, acc);
          }
        }
#pragma unroll
        for (int r = 0; r < 16; ++r) Zm[cb][r] = sPT[cb * 32 + acc_row(r, lane)] * (Zm[cb][r] + acc[r]);
      }
#pragma unroll
      for (int cb = 0; cb < 2; ++cb)
#pragma unroll
        for (int g = 0; g < 4; ++g) {
          u32x2 pk; pk.x = pack2(Zm[cb][4 * g], Zm[cb][4 * g + 1]); pk.y = pack2(Zm[cb][4 * g + 2], Zm[cb][4 * g + 3]);
          *(u32x2*)(sZ + (vb * 32 + l31) * 72 + cb * 32 + 8 * g + 4 * hl) = pk;
        }
    }
  }
  if (!FULL) {
    float* Zs = segZ + ((size_t)sid * RW_NSEG + seg) * 64 * 128;
#pragma unroll
    for (int cb = 0; cb < 2; ++cb)
#pragma unroll
      for (int r = 0; r < 16; ++r) Zs[(cb * 32 + acc_row(r, lane)) * 128 + wave * 32 + l31] = Zm[cb][r];
  }
}

constexpr int LRU_NCH = (CTXL + SEQ) / 64;
constexpr size_t OFF_ACUM0 = OFF_PU;
static_assert((size_t)NLAT * 512 * 2 <= (size_t)2 * NEXP * 1024, "acum0");

struct LruRaw { u32x4 x[2][4]; };
DEV void lru_load_raw(const Params& P, int sid, int cc, LruRaw& R) {
  constexpr int NC_CTX = CTXL / 64;
  const int tid = threadIdx.x;
  const int d = sid & 1, blk = (sid >> 1) & 7, b = sid >> 4;
  const bf16_t* proj = (const bf16_t*)(P.ws + OFF_PROJ);
  const int sgi = cc >= NC_CTX;
  const int row0 = sgi ? NCTX + b * SEQ : b * CTXL;
  const int len = sgi ? SEQ : CTXL;
  const int cl = (sgi ? cc - NC_CTX : cc) * 64;
  const int lch = blk * 64 + (tid & 7) * 8;
  const u32x4 z4 = {0u, 0u, 0u, 0u};
#pragma unroll
  for (int i = 0; i < 2; ++i) {
    int c = tid + i * 256, r = c >> 3;
    int p = cl + r, pos = d ? len - 1 - p : p;
#pragma unroll
    for (int tap = 0; tap < 4; ++tap) {
      int pp = pos + tap - 2;
      R.x[i][tap] = (pp >= 0 && pp < len) ? *(const u32x4*)(proj + (size_t)(row0 + pp) * ODC + 2304 + lch) : z4;
    }
  }
}

DEV void st_lru_chunk(const Params& P, int sid, int cc, int nsid, int ncc, bool has_next, LruRaw& R, unsigned char* smem) {
  constexpr int NC_CTX = CTXL / 64;
  const int tid = threadIdx.x, lane = tid & 63, wave = tid >> 6;
  const int d = sid & 1, blk = (sid >> 1) & 7, b = sid >> 4;
  float* sXc = (float*)smem;
  float* sAc = sXc + 4096;
  float* sBc = sAc + 4096;
  float* sU = sBc + 4096;
  bf16_t* sAop = (bf16_t*)(sU + 4096);
  float* sQA = (float*)(sAop + 64 * 72);
  float* sQH = sQA + 256;
  int* sRow = (int*)(sQH + 256);
  const bf16_t* proj = (const bf16_t*)(P.ws + OFF_PROJ);
  bf16_t* uout = (bf16_t*)(P.ws + OFF_LORA) + (size_t)d * NTOK * 512;
  bf16_t* aout = (bf16_t*)(P.ws + (d ? OFF_ACUM1 : OFF_ACUM0));
  const bf16_t* lruT = (const bf16_t*)(P.ws + OFF_LRUT) + (size_t)(d * 8 + blk) * 128 * 64;
  float* chunkS = (float*)(P.ws + OFF_LRUCS) + ((size_t)sid * LRU_NCH + cc) * 128;
  const float* cw = P.in[I_LCONVW];
  const float* cb = P.in[I_LCONVB];
  const int tr = (wave >> 1) * 32, nc0 = (wave & 1) * 64;
  const int sgi = cc >= NC_CTX;
  const int row0 = sgi ? NCTX + b * SEQ : b * CTXL;
  const int len = sgi ? SEQ : CTXL;
  const int cl = (sgi ? cc - NC_CTX : cc) * 64;
  __syncthreads();
  if (tid < 64) { int p = cl + tid; sRow[tid] = row0 + (d ? len - 1 - p : p); }
  {
    const int lc8 = (tid & 7) * 8, lch = blk * 64 + lc8;
#pragma unroll
    for (int i = 0; i < 2; ++i) {
      int c = tid + i * 256, r = c >> 3;
      int p = cl + r, pos = d ? len - 1 - p : p;
      float o[8];
      f32x4 c0 = *(const f32x4*)(cb + lch), c1 = *(const f32x4*)(cb + lch + 4);
      o[0] = c0.x; o[1] = c0.y; o[2] = c0.z; o[3] = c0.w; o[4] = c1.x; o[5] = c1.y; o[6] = c1.z; o[7] = c1.w;
#pragma unroll
      for (int tap = 0; tap < 4; ++tap) {
        float x[8];
        unpack8(R.x[i][tap], x);
        f32x4 w0 = *(const f32x4*)(cw + tap * 512 + lch), w1 = *(const f32x4*)(cw + tap * 512 + lch + 4);
        o[0] += w0.x * x[0]; o[1] += w0.y * x[1]; o[2] += w0.z * x[2]; o[3] += w0.w * x[3];
        o[4] += w1.x * x[4]; o[5] += w1.y * x[5]; o[6] += w1.z * x[6]; o[7] += w1.w * x[7];
      }
#pragma unroll
      for (int j = 0; j < 8; ++j) sXc[r * 64 + lc8 + j] = o[j];
      *(u32x4*)(sAop + r * 72 + lc8) = pack8(o);
    }
  }
  if (has_next) lru_load_raw(P, nsid, ncc, R);
  __syncthreads();
  {
    f32x16 acc[2];
#pragma unroll
    for (int j = 0; j < 2; ++j)
#pragma unroll
      for (int r = 0; r < 16; ++r) acc[j][r] = 0.f;
#pragma unroll
    for (int kk = 0; kk < 4; ++kk) {
      bf16x8 a = *(const bf16x8*)(sAop + (tr + (lane & 31)) * 72 + kk * 16 + 8 * (lane >> 5));
#pragma unroll
      for (int j = 0; j < 2; ++j) {
        bf16x8 bb = *(const bf16x8*)(lruT + (nc0 + j * 32 + (lane & 31)) * 64 + kk * 16 + 8 * (lane >> 5));
        acc[j] = mfma32(a, bb, acc[j]);
      }
    }
#pragma unroll
    for (int j = 0; j < 2; ++j) {
      const int e = nc0 + j * 32 + (lane & 31);
      const int ch = blk * 64 + (e & 63);
      const float ebias = e < 64 ? P.in[I_BA][d * 512 + ch] : P.in[I_BI][d * 512 + ch];
      const float esp = softplusf_(-P.in[I_LAM][d * 512 + ch]);
#pragma unroll
      for (int r = 0; r < 16; ++r) {
        int t = tr + acc_row(r, lane);
        float g = sigmoidf_(acc[j][r] + ebias);
        if (e < 64) { float a_ = fexp(-8.f * g * esp); sAc[t * 64 + e] = a_; sU[t * 64 + e] = fsqrt(fmaxf(1.f - a_ * a_, 0.f)); }
        else sBc[t * 64 + (e - 64)] = g * sXc[t * 64 + (e - 64)];
      }
    }
  }
  __syncthreads();
  const int c = tid & 63, q = tid >> 6;
  {
    float h = 0.f, ap = 1.f;
#pragma unroll 4
    for (int i = 0; i < 16; ++i) {
      const int t = q * 16 + i;
      const float a = sAc[t * 64 + c];
      h = a * h + sU[t * 64 + c] * sBc[t * 64 + c];
      ap *= a;
      sU[t * 64 + c] = h; sAc[t * 64 + c] = ap;
    }
    sQA[q * 64 + c] = ap; sQH[q * 64 + c] = h;
  }
  __syncthreads();
  {
    float hin = 0.f, ain = 1.f;
    for (int q2 = 0; q2 < q; ++q2) { hin = sQA[q2 * 64 + c] * hin + sQH[q2 * 64 + c]; ain *= sQA[q2 * 64 + c]; }
    if (q > 0) {
#pragma unroll 4
      for (int i = 0; i < 16; ++i) {
        const int t = q * 16 + i;
        const float ap = sAc[t * 64 + c];
        sU[t * 64 + c] += ap * hin;
        sAc[t * 64 + c] = ap * ain;
      }
    }
    if (q == 3) { chunkS[c] = sAc[63 * 64 + c]; chunkS[64 + c] = sU[63 * 64 + c]; }
  }
  __syncthreads();
  if (sgi) {
#pragma unroll
    for (int i = 0; i < 2; ++i) {
      int cidx = tid + i * 256, r = cidx >> 3, c8 = (cidx & 7) * 8;
      float u8[8], a8[8];
#pragma unroll
      for (int j = 0; j < 8; ++j) { u8[j] = sU[r * 64 + c8 + j]; a8[j] = sAc[r * 64 + c8 + j]; }
      const int row = sRow[r];
      *(u32x4*)(uout + (size_t)row * 512 + blk * 64 + c8) = pack8(u8);
      *(u32x4*)(aout + (size_t)(row - NCTX) * 512 + blk * 64 + c8) = pack8(a8);
    }
  }
}

DEV void st_lru_carry(const Params& P, int sid) {
  const int c = threadIdx.x;
  if (c >= 64) return;
  const float* cs = (const float*)(P.ws + OFF_LRUCS) + (size_t)sid * LRU_NCH * 128;
  float* hs = (float*)(P.ws + OFF_LRUHS) + (size_t)sid * LRU_NCH * 64;
  float h = 0.f;
  for (int cc0 = 0; cc0 < LRU_NCH; cc0 += 10) {
    float a[10], bb[10];
#pragma unroll
    for (int i = 0; i < 10; ++i) { a[i] = cs[(size_t)(cc0 + i) * 128 + c]; bb[i] = cs[(size_t)(cc0 + i) * 128 + 64 + c]; }
#pragma unroll
    for (int i = 0; i < 10; ++i) { hs[(size_t)(cc0 + i) * 64 + c] = h; h = a[i] * h + bb[i]; }
  }
}

DEV void st_finish_l1(const Params& P, int row) {
  const int lane = threadIdx.x & 63;
  bf16_t* hb = (bf16_t*)(P.ws + OFF_HBUF) + (size_t)row * 1024;
  const bf16_t* proj = (const bf16_t*)(P.ws + OFF_PROJ);
  const bf16_t* lora = (const bf16_t*)(P.ws + OFF_LORA);
  const float* mu = P.in[I_MU];
  const int ch = lane * 8;
  float y0[8], y1[8];
  unpack8(*(const u32x4*)(hb + ch), y0);
  unpack8(*(const u32x4*)(hb + 512 + ch), y1);
  float sm = 0.f;
#pragma unroll
  for (int j = 0; j < 8; ++j) { y0[j] += y1[j]; sm += y0[j]; }
  sm = sum8(sm);
  const float mean = sm * (1.f / 64.f);
  float sv = 0.f;
#pragma unroll
  for (int j = 0; j < 8; ++j) { float dlt = y0[j] - mean; sv += dlt * dlt; }
  sv = sum8(sv);
  const float rstd = frsq(sv * (1.f / 64.f) + 64e-5f);
  float a0[8], a1[8], g[8], u0[8], u1[8], gb[8];
  unpack8(*(const u32x4*)(lora + ((size_t)2 * NTOK + row) * 512 + ch), a0);
  unpack8(*(const u32x4*)(lora + ((size_t)3 * NTOK + row) * 512 + ch), a1);
  unpack8(*(const u32x4*)(lora + ((size_t)4 * NTOK + row) * 512 + ch), g);
  unpack8(*(const u32x4*)(lora + ((size_t)0 * NTOK + row) * 512 + ch), u0);
  unpack8(*(const u32x4*)(lora + ((size_t)1 * NTOK + row) * 512 + ch), u1);
  if (row >= NCTX) {
    const int bb_ = (row - NCTX) / SEQ, pos = (row - NCTX) % SEQ, blk = ch >> 6;
    float ac[8];
#pragma unroll
    for (int dd = 0; dd < 2; ++dd) {
      const int pidx = dd ? SEQ - 1 - pos : pos;
      const int cc = CTXL / 64 + pidx / 64;
      const int sid = (bb_ * 8 + blk) * 2 + dd;
      const float* hs = (const float*)(P.ws + OFF_LRUHS) + ((size_t)sid * LRU_NCH + cc) * 64 + (ch & 63);
      unpack8(*(const u32x4*)((const bf16_t*)(P.ws + (dd ? OFF_ACUM1 : OFF_ACUM0)) + (size_t)(row - NCTX) * 512 + ch), ac);
      f32x4 h0 = *(const f32x4*)hs, h1 = *(const f32x4*)(hs + 4);
      float* u = dd ? u1 : u0;
      u[0] += ac[0] * h0.x; u[1] += ac[1] * h0.y; u[2] += ac[2] * h0.z; u[3] += ac[3] * h0.w;
      u[4] += ac[4] * h1.x; u[5] += ac[5] * h1.y; u[6] += ac[6] * h1.z; u[7] += ac[7] * h1.w;
    }
  }
  unpack8(*(const u32x4*)(proj + (size_t)row * ODC + 1792 + ch), gb);
  float rv[8], vv[8], kv[8];
  float sdot = 0.f;
  float pka[8], prk[8], plw[8], plb[8];
  ld8(P.in[I_KA] + ch, pka); ld8(P.in[I_RK] + ch, prk); ld8(P.in[I_LNW] + ch, plw); ld8(P.in[I_LNB] + ch, plb);
  mix8(proj, row, ch, mu, rv);
  mix8(proj, row, 512 + ch, mu, kv);
  mix8(proj, row, 1024 + ch, mu, vv);
#pragma unroll
  for (int j = 0; j < 8; ++j) {
    float r = rv[j];
    float k = kv[j];
    float am = 0.5f * (sigmoidf_(a0[j]) + sigmoidf_(a1[j]));
    float kb = k * (1.f + (am - 1.f) * pka[j]);
    sdot += r * kb * prk[j];
    rv[j] = r;
  }
  sdot = sum8(sdot);
  float f1[8], f2[8];
#pragma unroll
  for (int j = 0; j < 8; ++j) {
    float yn = (y0[j] - mean) * rstd * plw[j] + plb[j];
    yn += sdot * vv[j];
    f1[j] = yn * g[j];
    f2[j] = (u0[j] + u1[j]) * geluf_(gb[j]);
  }
  *(u32x4*)(hb + ch) = pack8(f1);
  *(u32x4*)(hb + 512 + ch) = pack8(f2);
}

DEV unsigned fkey(float f) { unsigned u; __builtin_memcpy(&u, &f, 4); return (u >> 31) ? ~u : (u | 0x80000000u); }
DEV float keyf(unsigned u) { u = (u >> 31) ? (u & 0x7fffffffu) : ~u; float f; __builtin_memcpy(&f, &u, 4); return f; }
DEV void key_insert(unsigned x, unsigned* v) {
#pragma unroll
  for (int j = 0; j < 16; ++j) { unsigned hi = v[j] > x ? v[j] : x; x = v[j] > x ? x : v[j]; v[j] = hi; }
}
DEV void key_cx(unsigned& hi, unsigned& lo) { unsigned a = hi, b = lo; hi = a > b ? a : b; lo = a > b ? b : a; }
DEV void key_sort16(unsigned* v) {
#pragma unroll
  for (int k = 2; k <= 16; k <<= 1)
#pragma unroll
    for (int j = k >> 1; j > 0; j >>= 1)
#pragma unroll
      for (int i = 0; i < 16; ++i) {
        const int l = i ^ j;
        if (l > i) { if ((i & k) == 0) key_cx(v[i], v[l]); else key_cx(v[l], v[i]); }
      }
}
DEV void key_merge16(unsigned* a, const unsigned* b) {
#pragma unroll
  for (int i = 0; i < 16; ++i) a[i] = a[i] > b[15 - i] ? a[i] : b[15 - i];
#pragma unroll
  for (int j = 8; j > 0; j >>= 1)
#pragma unroll
    for (int i = 0; i < 16; ++i) { const int l = i ^ j; if (l > i) key_cx(a[i], a[l]); }
}

DEV void st_peer_topk(const Params& P, int layer, int tile, int h, unsigned char* smem) {
  const int tid = threadIdx.x;
  const bf16_t* q = (const bf16_t*)(P.ws + OFF_Q);
  const bf16_t* keys = (const bf16_t*)(P.ws + OFF_KEYS) + (size_t)(layer * 8 + h) * 2 * 128 * 128;
  float* sS = (float*)smem;
  const int m0 = tile * 128;
  const int tok = tid & 127, half = tid >> 7;
  unsigned kl[2][16];
#pragma unroll
  for (int p = 0; p < 2; ++p) {
    EpiScoreLds epi{sS, m0};
    gemm_tile_128<true>(q + (h * 2 + p) * 128, 2048, NTOK, keys + p * 128 * 128, 128, 128, 128, m0, 0, epi, smem);
    __syncthreads();
    float* row = sS + tok * 129 + half * 64;
#pragma unroll
    for (int g = 0; g < 4; ++g) {
      unsigned grp[16];
#pragma unroll
      for (int j = 0; j < 16; ++j) grp[j] = (fkey(row[g * 16 + j]) & ~127u) | (unsigned)(127 - (half * 64 + g * 16 + j));
      key_sort16(grp);
      if (g == 0) {
#pragma unroll
        for (int j = 0; j < 16; ++j) kl[p][j] = grp[j];
      } else key_merge16(kl[p], grp);
    }
    if (half == 1) {
#pragma unroll
      for (int j = 0; j < 16; ++j) row[j] = __builtin_bit_cast(float, kl[p][j]);
    }
    __syncthreads();
    if (half == 0) {
      unsigned oth[16];
#pragma unroll
      for (int j = 0; j < 16; ++j) oth[j] = __builtin_bit_cast(unsigned, sS[tok * 129 + 64 + j]);
      key_merge16(kl[p], oth);
    }
    __syncthreads();
  }
  if (tid < 128) {
    float sv0[16], sv1[16];
    int* irow = (int*)(sS + tid * 129);
#pragma unroll
    for (int j = 0; j < 16; ++j) {
      sv0[j] = keyf((kl[0][j] & ~127u) | 64u); sv1[j] = keyf((kl[1][j] & ~127u) | 64u);
      irow[j] = 127 - (int)(kl[0][j] & 127u); irow[16 + j] = 127 - (int)(kl[1][j] & 127u);
    }
    unsigned best[16];
#pragma unroll
    for (int j = 0; j < 16; ++j) best[j] = 0u;
#pragma unroll
    for (int i = 0; i < 16; ++i)
#pragma unroll
      for (int j = 0; j < 16; ++j)
        if ((i + 1) * (j + 1) <= 16) key_insert((fkey(sv0[i] + sv1[j]) & ~255u) | (unsigned)(255 - (i * 16 + j)), best);
    float e[16], sum = 0.f;
    const float b0 = keyf((best[0] & ~255u) | 128u);
#pragma unroll
    for (int j = 0; j < 16; ++j) { e[j] = fexp(keyf((best[j] & ~255u) | 128u) - b0); sum += e[j]; }
    const float inv = 1.f / sum;
    int* pidx = (int*)(P.ws + OFF_PIDX) + (size_t)(m0 + tid) * 128 + h * 16;
    float* pg = (float*)(P.ws + OFF_PGATE) + (size_t)(m0 + tid) * 128 + h * 16;
#pragma unroll
    for (int j = 0; j < 16; ++j) {
      const int pos = 255 - (int)(best[j] & 255u);
      pidx[j] = irow[pos >> 4] * 128 + irow[16 + (pos & 15)];
      pg[j] = e[j] * inv;
    }
  }
}

DEV void st_peer_experts(const Params& P, int layer, int row) {
  const int lane = threadIdx.x & 63;
  const bf16_t* xb = (const bf16_t*)(P.ws + OFF_HBUF) + (size_t)row * 1024;
  const unsigned char* U = P.ws + OFF_PU;
  const int* pidx = (const int*)(P.ws + OFF_PIDX) + (size_t)row * 128;
  const float* pg = (const float*)(P.ws + OFF_PGATE) + (size_t)row * 128;
  float x[16], acc[16];
  unpack8(*(const u32x4*)(xb + lane * 16), x);
  unpack8(*(const u32x4*)(xb + lane * 16 + 8), x + 8);
#pragma unroll
  for (int j = 0; j < 16; ++j) acc[j] = 0.f;
  const int b3 = (lane >> 3) & 1;
  const int mypick = (lane >> 3) & 7;
#ifdef CPU_EMU
#define PEER_SID(id) (id)
#else
#define PEER_SID(id) __builtin_amdgcn_readfirstlane(id)
#endif
  const unsigned lo12 = lane * 12, lo8 = PEER_VOFF + lane * 8;
#define PEER_LDU(i, id) do { const unsigned* up_ = (const unsigned*)(U + (size_t)(unsigned)(id) * PEER_ROWB + lo12); \
    uu[i].x = up_[0]; uu[i].y = up_[1]; uu[i].z = up_[2]; } while (0)
#define PEER_LDV(i, id) vv[i] = *(const u32x2*)(U + (size_t)(unsigned)(id) * PEER_ROWB + lo8)
#define PEER_IDS(v0, v1) {PEER_SID((int)v0.x), PEER_SID((int)v0.y), PEER_SID((int)v0.z), PEER_SID((int)v0.w), \
                          PEER_SID((int)v1.x), PEER_SID((int)v1.y), PEER_SID((int)v1.z), PEER_SID((int)v1.w)}
  u32x3 uu[8]; u32x2 vv[8];
  int cid[8];
  {
    const u32x4 p0 = *(const u32x4*)pidx, p1 = *(const u32x4*)(pidx + 4);
    const int id[8] = PEER_IDS(p0, p1);
#pragma unroll
    for (int i = 0; i < 8; ++i) { cid[i] = id[i]; PEER_LDU(i, id[i]); }
  }
  u32x4 n0 = *(const u32x4*)(pidx + 8), n1 = *(const u32x4*)(pidx + 12);
  float gcur = pg[mypick];
  for (int k0 = 0; k0 < 128; k0 += 8) {
#pragma unroll
    for (int i = 0; i < 8; ++i) PEER_LDV(i, cid[i]);
    const int nid[8] = PEER_IDS(n0, n1);
    {
      const int k2 = k0 + 16 < 128 ? k0 + 16 : 120;
      n0 = *(const u32x4*)(pidx + k2); n1 = *(const u32x4*)(pidx + k2 + 4);
    }
    const float gnxt = pg[(k0 + 8 < 128 ? k0 + 8 : 120) + mypick];
    float dsum[8];
#pragma unroll
    for (int i = 0; i < 8; i += 2) {
      float ufa[16], ufb[16];
#ifndef CPU_EMU
      __builtin_amdgcn_sched_barrier(0);
#endif
      unpack2x16_fp6(uu[i], uu[i + 1], ufa, ufb);
      PEER_LDU(i, nid[i]); PEER_LDU(i + 1, nid[i + 1]);
      typedef __attribute__((ext_vector_type(2))) float f32x2v;
      f32x2v da2 = {0.f, 0.f}, db2 = {0.f, 0.f};
#pragma unroll
      for (int j = 0; j < 8; ++j) {
        const f32x2v xx = {x[2 * j], x[2 * j + 1]};
        const f32x2v ua = {ufa[2 * j], ufa[2 * j + 1]}, ub = {ufb[2 * j], ufb[2 * j + 1]};
        da2 = xx * ua + da2; db2 = xx * ub + db2;
      }
      dsum[i] = da2.x + da2.y; dsum[i + 1] = db2.x + db2.y;
    }
    float e4[4], e2[2], g;
#pragma unroll
    for (int i = 0; i < 4; ++i) e4[i] = swap32_sum(dsum[i], dsum[4 + i]);
#pragma unroll
    for (int i = 0; i < 2; ++i) e2[i] = swap16_sum(e4[i], e4[2 + i]);
    {
      float mine = b3 ? e2[1] : e2[0], send = b3 ? e2[0] : e2[1];
      g = mine + dpp_xor<8>(send);
    }
    g = sum8(g);
    const float mycoef = gcur * geluf_(g * (1.f / PEER_USCALE));
#pragma unroll
    for (int i = 0; i < 8; ++i) {
      const float coef = wreadlane(mycoef, i * 8);
      float vf[16];
      unpack8_fp4(vv[i].x, vf); unpack8_fp4(vv[i].y, vf + 8);
#pragma unroll
      for (int j = 0; j < 16; ++j) acc[j] += coef * vf[j];
    }
#pragma unroll
    for (int i = 0; i < 8; ++i) cid[i] = nid[i];
    gcur = gnxt;
  }
#undef PEER_LDU
#undef PEER_LDV
#undef PEER_IDS
#undef PEER_SID
  float* xr = row < NCTX ? (float*)(P.ws + OFF_CTXRES) + (size_t)row * 1024 : P.out + (size_t)(row - NCTX) * 1024;
  const float* g2 = (const float*)(P.ws + OFF_MODV) + ((size_t)layer * 3 + mod_row(row)) * 6144 + 5 * 1024;
  float o[16];
#pragma unroll
  for (int q = 0; q < 4; ++q) {
    const int c = lane * 16 + q * 4;
    f32x4 a = *(const f32x4*)(xr + c), ga = *(const f32x4*)(g2 + c);
    o[q * 4 + 0] = a.x + ga.x * acc[q * 4 + 0] * (1.f / PEER_VSCALE); o[q * 4 + 1] = a.y + ga.y * acc[q * 4 + 1] * (1.f / PEER_VSCALE);
    o[q * 4 + 2] = a.z + ga.z * acc[q * 4 + 2] * (1.f / PEER_VSCALE); o[q * 4 + 3] = a.w + ga.w * acc[q * 4 + 3] * (1.f / PEER_VSCALE);
  }
  float ss = 0.f;
#pragma unroll
  for (int j = 0; j < 16; ++j) ss += o[j] * o[j];
  ss = wave_sum(ss);
  const float rstd = frsq(ss * (1.f / 1024.f) + 1e-6f);
  if (layer == 1) {
    float fn[16]; ld8(P.in[I_FNORM] + lane * 16, fn); ld8(P.in[I_FNORM] + lane * 16 + 8, fn + 8);
#pragma unroll
    for (int j = 0; j < 16; ++j) o[j] *= rstd * fn[j];
  }
#pragma unroll
  for (int q = 0; q < 4; ++q) {
    f32x4 a = {o[q * 4 + 0], o[q * 4 + 1], o[q * 4 + 2], o[q * 4 + 3]};
    *(f32x4*)(xr + lane * 16 + q * 4) = a;
  }
  if (layer == 0) {
    const float* mv = (const float*)(P.ws + OFF_MODV) + ((size_t)1 * 3 + mod_row(row)) * 6144;
    const float* nw = P.in[I_NORM1] + 1024;
    float hh[16];
#pragma unroll
    for (int q = 0; q < 4; ++q) {
      const int c = lane * 16 + q * 4;
      f32x4 w4 = *(const f32x4*)(nw + c), s4 = *(const f32x4*)(mv + 1024 + c), h4 = *(const f32x4*)(mv + c);
      hh[q * 4 + 0] = o[q * 4 + 0] * rstd * w4.x * (1.f + s4.x) + h4.x; hh[q * 4 + 1] = o[q * 4 + 1] * rstd * w4.y * (1.f + s4.y) + h4.y;
      hh[q * 4 + 2] = o[q * 4 + 2] * rstd * w4.z * (1.f + s4.z) + h4.z; hh[q * 4 + 3] = o[q * 4 + 3] * rstd * w4.w * (1.f + s4.w) + h4.w;
    }
    bf16_t* hb = (bf16_t*)(P.ws + OFF_HBUF) + (size_t)row * 1024 + lane * 16;
    *(u32x4*)hb = pack8(hh);
    *(u32x4*)(hb + 8) = pack8(hh + 8);
  }
}


#define FOR_TILES_XCD(MT0, MT1, NT, mt, nt)                                                     \
  for (int _x = blockIdx.x & 7, _mlo = (MT0) + (((MT1) - (MT0)) * _x) / 8,                        \
           _mhi = (MT0) + (((MT1) - (MT0)) * (_x + 1)) / 8, _i = blockIdx.x >> 3,                 \
           _cnt = (_mhi - _mlo) * (NT), mt = 0, nt = 0;                                           \
       _i < _cnt && ((mt = _mlo + _i / (NT)), (nt = _i % (NT)), true); _i += (int)(gridDim.x >> 3))

#ifndef PHASE_LIST
#define PHASE_LIST(X) X(0) X(1) X(2) X(22) X(23) X(3) X(4) X(5) X(6) X(7) X(8) X(9) X(11) X(12) X(13) X(30) X(14) X(15) X(31) X(16) X(17) X(18) X(19) X(20) X(21)
#endif
constexpr int PH_LAST = 21;

template <int ph>
DEV void run_phase(const Params& P, unsigned char* smem) {
  int bid_ = blockIdx.x, wave_ = threadIdx.x >> 6;
  OPAQUE_S(bid_); OPAQUE(wave_);
  const int bid = bid_, nb = gridDim.x;
  const int wave = wave_;
  unsigned char* ws = P.ws;
  constexpr int layer = ((ph >= 10 && ph <= 21) || ph >= 30) ? 1 : 0;
  const float* modv_l = (const float*)(ws + OFF_MODV) + (size_t)layer * 3 * 6144;
  switch (ph) {
    case 0:
      for (int t = NTRANS + bid; t < NPREP; t += nb) st_prep(P, t, smem);
      break;
    case 1: case 10:
      if (ph == 1) for (int t = nb - 1 - bid; t < NTRANS; t += nb) st_prep(P, t, smem);
      for (int t = bid; t < NTOK / 4; t += nb) st_normmod(P, layer, 0, t * 4 + wave);
      break;
    case 2: {
      EpiProjL0T epi{(bf16_t*)(ws + OFF_PROJ), (float*)(ws + OFF_GATES)};
      FOR_TILES_XCD(0, NTOK / 256, 25, mt, nt)
        gemm_tile_128x256<EpiProjL0T, true>((const bf16_t*)(ws + OFF_WEVIN), 1024, EVC, (const bf16_t*)(ws + OFF_HBUF), 1024, NTOK, 1024,
                                            nt * 128, mt * 256, epi, smem);
    } break;
    case 22:
      for (int t = bid; t < NTOK / 4; t += nb) st_xbc_conv(P, t * 4 + wave);
      for (int t = bid; t < NPCONV; t += nb) st_peer_conv(P, 0, t);
      break;
    case 23:
      for (int t = bid; t < 48 * LA_NSEG; t += nb) {
        int sid = t % 48, seg = t / 48;
        if (sid < 16) st_linattn_seg<true, false>(P, sid, seg, smem);
        else st_linattn_seg<false, false>(P, sid - 16, seg, smem);
      }
      break;
    case 3:
      for (int t = bid; t < 48 * LA_NSEG; t += nb) {
        int sid = t % 48, seg = t / 48;
        if (sid < 16) st_linattn_seg<true, true>(P, sid, seg, smem);
        else st_linattn_seg<false, true>(P, sid - 16, seg, smem);
      }
      break;
    case 4:
      for (int t = bid; t < NTOK / 4; t += nb) st_finish_l0(P, t * 4 + wave);
      break;
    case 5: case 17: {
      EpiOutProjT epi{layer == 0 ? P.in[I_X] : P.out, P.in[I_CTX], P.out, (float*)(ws + OFF_CTXRES), modv_l};
      const bf16_t* Wt = (const bf16_t*)(ws + (layer == 0 ? OFF_WEVOUT : OFF_WODOUT));
      FOR_TILES_XCD(layer == 0 ? 0 : NCTX / 256, NTOK / 256, 8, mt, nt)
        gemm_tile_128x256<EpiOutProjT, true>(Wt, 1024, 1024, (const bf16_t*)(ws + OFF_HBUF), 1024, NTOK, 1024, nt * 128, mt * 256, epi, smem);
    } break;
    case 6: case 18: {
      const int r0 = layer == 0 ? 0 : NCTX / 4;
      for (int t = r0 + bid; t < NTOK / 4; t += nb) st_normmod(P, layer, 1, t * 4 + wave);
      if (ph == 18) for (int t = bid; t < NPCONV; t += nb) st_peer_conv(P, 1, t);
    } break;
    case 7: case 19: {
      EpiStoreBfT epi{(bf16_t*)(ws + OFF_Q), 2048};
      const bf16_t* Wt = (const bf16_t*)(ws + OFF_WQ) + (size_t)layer * 2048 * 1024;
      FOR_TILES_XCD(layer == 0 ? 0 : NCTX / 256, NTOK / 256, 16, mt, nt)
        gemm_tile_128x256<EpiStoreBfT, true>(Wt, 1024, 2048, (const bf16_t*)(ws + OFF_HBUF), 1024, NTOK, 1024, nt * 128, mt * 256, epi, smem);
    } break;
    case 8: case 20: {
      const int t0 = layer == 0 ? 0 : CTILE * 8;
      for (int t = t0 + bid; t < NTILE * 8; t += nb) st_peer_topk(P, layer, t / 8, t % 8, smem);
    } break;
    case 9: case 21: {
      const int r0 = layer == 0 ? 0 : NCTX / 4;
      for (int t = r0 + bid; t < NTOK / 4; t += nb) st_peer_experts(P, layer, t * 4 + wave);
    } break;
    case 11: {
      EpiStoreBfT epi{(bf16_t*)(ws + OFF_PROJ), ODC};
      FOR_TILES_XCD(0, NTOK / 256, 22, mt, nt)
        gemm_tile_128x256<EpiStoreBfT, true>((const bf16_t*)(ws + OFF_WODIN), 1024, ODC, (const bf16_t*)(ws + OFF_HBUF), 1024, NTOK, 1024,
                                             nt * 128, mt * 256, epi, smem);
    } break;
    case 12:
      for (int t = bid; t < NTOK / 8; t += nb) st_lora_act(P, t * 8 + wave * 2);
      break;
    case 13:
      for (int t = bid; t < NTILE * 20; t += nb) {
        int job = t / (NTILE * 4), tt = t % (NTILE * 4);
        int mt = tt / 4, nt = tt % 4;
        bf16_t* dst = (bf16_t*)(ws + OFF_LORA) + (size_t)job * NTOK * 512;
        const bf16_t* A = (const bf16_t*)(ws + OFF_HBUF) + (job < 2 ? 0 : (job < 4 ? 64 : 128));
        const bf16_t* Bt = job < 2 ? (const bf16_t*)(ws + OFF_WUP) + (size_t)job * 512 * 64
                         : job < 4 ? (const bf16_t*)(ws + OFF_AUP) + (size_t)(job - 2) * 512 * 64
                                   : (const bf16_t*)(ws + OFF_GUP);
        const float* bias = job < 2 ? P.in[I_W0] + job * 512 : (job < 4 ? P.in[I_A0] + (job - 2) * 512 : nullptr);
        const int K = job < 4 ? 64 : 128;
        EpiStoreBfBiasT epi{dst, 512, bias};
        gemm_tile_128<false, EpiStoreBfBiasT, true>(Bt, K, 512, A, 1024, NTOK, K, nt * 128, mt * 128, epi, smem);
      }
      break;
    case 30:
      for (int t = bid; t < 32 * RW_NSEG; t += nb) st_rwkv_seg<false>(P, t % 32, t / 32, smem);
      break;
    case 14:
      for (int t = bid; t < 32 * RW_NSEG; t += nb) st_rwkv_seg<true>(P, t % 32, t / 32, smem);
      break;
    case 15:
      {
        LruRaw R;
        if (bid < 32 * LRU_NCH) lru_load_raw(P, bid % 32, bid / 32, R);
        for (int t = bid; t < 32 * LRU_NCH; t += nb) {
          const int tn = t + nb;
          st_lru_chunk(P, t % 32, t / 32, tn % 32, tn / 32, tn < 32 * LRU_NCH, R, smem);
        }
      }
      break;
    case 31:
      if (bid < 32) st_lru_carry(P, bid);
      break;
    case 16:
      for (int t = bid; t < NTOK / 4; t += nb) st_finish_l1(P, t * 4 + wave);
      break;
    default: break;
  }
}


#ifndef CPU_EMU
#define XB_TMO      128
#define XB_XCNT(j)  (256  + 64 * (j))
#define XB_XSUB(j)  (1280 + 64 * (j))
#define XB_XGEN(j)  (2304 + 64 * (j))
#define XB_TOP      3328
#define XB_TOPGEN   3392
#define XCD_BAR_WORDS 3456
#define XB_SPIN_CAP (1u << 20)
#define LAS __attribute__((address_space(3)))
__device__ __forceinline__ unsigned xb_ld(unsigned* p)              { return __hip_atomic_load(p, __ATOMIC_RELAXED, __HIP_MEMORY_SCOPE_AGENT); }
__device__ __forceinline__ unsigned xb_add(unsigned* p, unsigned v) { return __hip_atomic_fetch_add(p, v, __ATOMIC_RELAXED, __HIP_MEMORY_SCOPE_AGENT); }
__device__ __forceinline__ unsigned xb_xcc_id() { return (unsigned)__builtin_amdgcn_s_getreg((3 << 11) | 20) & 0xFu; }
#define XB_SPIN(cond, bar) do { unsigned _sp = 0; while (cond) { __builtin_amdgcn_s_sleep(1); \
    if ((++_sp & 255u) == 0u) { if (xb_ld(&(bar)[XB_TMO])) break; if (_sp > XB_SPIN_CAP) { atomicAdd(&(bar)[XB_TMO], 1u); break; } } } } while (0)
struct XcdBarrier { unsigned* bar; unsigned x; volatile LAS unsigned* st; };
__device__ __forceinline__ XcdBarrier xcd_barrier_post(unsigned* bar, volatile LAS unsigned* st) {
  XcdBarrier b; b.bar = bar; b.x = xb_xcc_id(); b.st = st;
  if (threadIdx.x == 0) (void)xb_add(&bar[XB_XCNT(b.x)], 1u);
  return b;
}
__device__ __forceinline__ void xcd_barrier_complete(unsigned* bar, unsigned x, unsigned& nloc, unsigned& nx) {
  const unsigned G = gridDim.x * gridDim.y * gridDim.z;
  unsigned sum, cnt, mine, sp = 0u;
  for (;;) {
    sum = 0u; cnt = 0u; mine = 0u;
#pragma unroll
    for (unsigned j = 0; j < 16; ++j) { const unsigned c = xb_ld(&bar[XB_XCNT(j)]); sum += c; cnt += (c > 0u) ? 1u : 0u; mine = (j == x) ? c : mine; }
    if (sum == G) break;
    __builtin_amdgcn_s_sleep(1);
    if ((++sp & 255u) == 0u) { if (xb_ld(&bar[XB_TMO])) break; if (sp > XB_SPIN_CAP) { atomicAdd(&bar[XB_TMO], 1u); break; } }
  }
  nloc = mine > 0u ? mine : 1u; nx = cnt > 0u ? cnt : 1u;
}
__device__ __forceinline__ void xcd_barrier(const XcdBarrier& b) {
  asm volatile("s_waitcnt vmcnt(0)" ::: "memory");
  __syncthreads();
  if (threadIdx.x == 0) {
    unsigned* bar = b.bar;
    __builtin_amdgcn_s_waitcnt(0);
    unsigned nloc = b.st[0], nx = b.st[1];
    if (nloc == 0u) { xcd_barrier_complete(bar, b.x, nloc, nx); b.st[0] = nloc; b.st[1] = nx; }
    const unsigned old = xb_add(&bar[XB_XSUB(b.x)], 1u);
    const unsigned gen = old / nloc;
    if (old + 1u == (gen + 1u) * nloc) {
      __builtin_amdgcn_fence(__ATOMIC_RELEASE, "agent");
      asm volatile("s_waitcnt vmcnt(0)" ::: "memory");
      const unsigned og = xb_add(&bar[XB_TOP], 1u);
      const unsigned tg = og / nx;
      if (og + 1u == (tg + 1u) * nx) xb_add(&bar[XB_TOPGEN], 1u);
      else XB_SPIN(xb_ld(&bar[XB_TOPGEN]) == tg, bar);
      __builtin_amdgcn_fence(__ATOMIC_ACQUIRE, "agent");
      xb_add(&bar[XB_XGEN(b.x)], 1u);
      asm volatile("s_waitcnt vmcnt(0)" ::: "memory");
    } else {
      XB_SPIN(xb_ld(&bar[XB_XGEN(b.x)]) == gen, bar);
      __builtin_amdgcn_fence(__ATOMIC_ACQUIRE, "agent");
      asm volatile("s_waitcnt vmcnt(0)" ::: "memory");
    }
  }
  __syncthreads();
}
#endif
#ifndef CPU_EMU
#define RUN_PH(n) run_phase<n>(P, smem_raw); if (n != PH_LAST) xcd_barrier(xb);
__global__ void __launch_bounds__(256, 2) mega_kernel(Params P) {
  SMEM_DECL;
  unsigned* bar = (unsigned*)(P.ws + OFF_BAR);
  volatile LAS unsigned* st = (volatile LAS unsigned*)(smem_raw + SMEM_BYTES - 16);
  if (threadIdx.x == 0) { st[0] = 0u; st[1] = 0u; }
  if (P.ws == nullptr) cg::this_grid().sync();
  __syncthreads();
  XcdBarrier xb = xcd_barrier_post(bar, st);
  PHASE_LIST(RUN_PH)
}

extern "C" void kernel_launch(void* const* d_in, const int* in_sizes, int n_in, void* d_out, int out_size, void* d_ws,
                              size_t ws_size, hipStream_t stream) {
  Params P{};
  for (int i = 0; i < N_IN; ++i) P.in[i] = (const float*)d_in[i];
  P.out = (float*)d_out;
  P.ws = (unsigned char*)d_ws;
  if (ws_size < WS_NEEDED) { fprintf(stderr, "workspace too small: %zu < %zu\n", ws_size, (size_t)WS_NEEDED); return; }
  static int grid_blocks = 0;
  if (!grid_blocks) {
    int dev = 0, cus = 0, per_cu = 0;
    hipGetDevice(&dev);
    hipDeviceGetAttribute(&cus, hipDeviceAttributeMultiprocessorCount, dev);
    hipOccupancyMaxActiveBlocksPerMultiprocessor(&per_cu, mega_kernel, 256, 0);
    if (per_cu > 2) per_cu = 2;
    grid_blocks = cus * per_cu;
  }
  (void)hipMemsetAsync((unsigned char*)d_ws + OFF_BAR, 0, 16384, stream);
  void* args[] = {&P};
  hipError_t e = hipLaunchCooperativeKernel((void*)mega_kernel, dim3(grid_blocks), dim3(256), args, 0, stream);
  if (e != hipSuccess) fprintf(stderr, "cooperative launch failed: %s (grid %d)\n", hipGetErrorString(e), grid_blocks);
}
#endif
```

```cpp
#ifdef CPU_EMU
#include "emu.h"
#else
#include <hip/hip_runtime.h>
#include <hip/hip_cooperative_groups.h>
#include <cstdio>
namespace cg = cooperative_groups;
#define DEV __device__ __forceinline__
#define DEVM __device__ __forceinline__
#define OPAQUE(x) asm volatile("" : "+v"(x))
#define OPAQUE_S(x) asm volatile("" : "+s"(x))
#endif

#ifndef SEQ_LEN
#define SEQ_LEN 16384
#endif
#ifndef CTX_LEN
#define CTX_LEN 256
#endif
#ifndef GRID_W_
#define GRID_W_ 64
#endif
#ifndef MULTI_LAUNCH
#define MULTI_LAUNCH 0
#endif

typedef unsigned short bf16_t;
typedef __attribute__((ext_vector_type(8))) short bf16x8;
typedef __attribute__((ext_vector_type(16))) float f32x16;
typedef __attribute__((ext_vector_type(4))) unsigned u32x4;
typedef __attribute__((ext_vector_type(2))) unsigned u32x2;
typedef __attribute__((ext_vector_type(4))) float f32x4;

constexpr int D = 1024, NB = 2, SEQ = SEQ_LEN, CTXL = CTX_LEN, GW = GRID_W_;
constexpr int NCTX = NB * CTXL, NLAT = NB * SEQ, NTOK = NCTX + NLAT;
constexpr int EVC = 3104, ODC = 2816;
constexpr int NEXP = 16384;
constexpr int NTILE = NTOK / 128, CTILE = NCTX / 128;
static_assert(NTOK % 256 == 0 && NCTX % 256 == 0, "tiles");
static_assert(CTXL % 64 == 0 && SEQ % 64 == 0 && SEQ % GW == 0, "chunks");

constexpr size_t al256(size_t x) { return (x + 255) & ~(size_t)255; }
constexpr size_t OFF_MODV = 0;
constexpr size_t OFF_CTXRES = OFF_MODV + al256(2 * 3 * 6144 * 4);
constexpr size_t OFF_GATES = OFF_CTXRES + al256((size_t)NCTX * 1024 * 4);
constexpr size_t OFF_WEVIN = OFF_GATES + al256((size_t)NTOK * 32 * 4);
constexpr size_t OFF_WEVOUT = OFF_WEVIN + al256((size_t)EVC * 1024 * 2);
constexpr size_t OFF_WODIN = OFF_WEVOUT + al256((size_t)1024 * 1024 * 2);
constexpr size_t OFF_WODOUT = OFF_WODIN + al256((size_t)ODC * 1024 * 2);
constexpr size_t OFF_WQ = OFF_WODOUT + al256((size_t)1024 * 1024 * 2);
constexpr size_t OFF_KEYS = OFF_WQ + al256((size_t)2 * 2048 * 1024 * 2);
constexpr size_t OFF_WUP = OFF_KEYS + al256((size_t)2 * 8 * 2 * 128 * 128 * 2);
constexpr size_t OFF_AUP = OFF_WUP + al256((size_t)2 * 512 * 64 * 2);
constexpr size_t OFF_GUP = OFF_AUP + al256((size_t)2 * 512 * 64 * 2);
constexpr size_t OFF_LRUT = OFF_GUP + al256((size_t)512 * 128 * 2);
constexpr size_t OFF_PU = OFF_LRUT + al256((size_t)2 * 8 * 128 * 64 * 2);
constexpr size_t OFF_PV = OFF_PU + al256((size_t)NEXP * 1024);
constexpr size_t OFF_HBUF = OFF_PV + al256((size_t)NEXP * 1024);
constexpr size_t OFF_PR = OFF_HBUF + al256((size_t)NTOK * 1024 * 2);
constexpr size_t PR_BYTES = (size_t)NTOK * 5376 * 2;
constexpr size_t OFF_BAR = OFF_PR + PR_BYTES;
constexpr size_t OFF_ACUM1 = OFF_BAR + 16384;
constexpr size_t OFF_LRUCS = OFF_ACUM1 + (size_t)NLAT * 512 * 2;
constexpr size_t OFF_LRUHS = OFF_LRUCS + (size_t)32 * ((CTXL + SEQ) / 64) * 128 * 4;
constexpr size_t WS_NEEDED = OFF_LRUHS + (size_t)32 * ((CTXL + SEQ) / 64) * 64 * 4;
#ifndef CPU_EMU
static_assert(WS_NEEDED <= (size_t)512 * 1024 * 1024, "workspace too large");
#endif
constexpr size_t OFF_PROJ = OFF_PR;
constexpr size_t OFF_R2L0 = OFF_PR + (size_t)NTOK * EVC * 2;
constexpr size_t OFF_LORA = OFF_PR + (size_t)NTOK * ODC * 2;
constexpr size_t OFF_Q = OFF_PR;
constexpr size_t OFF_PIDX = OFF_PR + (size_t)NTOK * 2048 * 2;
constexpr size_t OFF_PGATE = OFF_PIDX + (size_t)NTOK * 128 * 4;
static_assert(OFF_PGATE + (size_t)NTOK * 128 * 4 <= OFF_PR + PR_BYTES, "picks");

enum {
  I_X = 0, I_C, I_CTX, I_CCTX, I_MODW, I_MODB, I_NORM1, I_NORM2, I_WQ, I_KEYS, I_PU, I_PV,
  I_EVWIN, I_EVWOUT, I_IBIAS, I_FBIAS, I_MNORM, I_SCONVW, I_SCONVB, I_DTBIAS, I_ALOG, I_DSKIP, I_SNORM,
  I_ODWIN, I_ODWOUT, I_MU, I_W0, I_WUP, I_A0, I_AUP, I_GUP, I_KK, I_KA, I_RK, I_LNW, I_LNB,
  I_LCONVW, I_LCONVB, I_LAM, I_WA, I_BA, I_WI, I_BI, I_FNORM, N_IN
};

struct Params {
  const float* in[N_IN];
  float* out;
  unsigned char* ws;
};

constexpr int SMEM_BYTES = 80 * 1024;
#ifdef CPU_EMU
#define SMEM_DECL static thread_local __attribute__((aligned(16))) unsigned char smem_raw[SMEM_BYTES]
#else
#define SMEM_DECL __shared__ __attribute__((aligned(16))) unsigned char smem_raw[SMEM_BYTES]
#endif

DEV float bf2f(bf16_t v) { unsigned u = ((unsigned)v) << 16; float f; __builtin_memcpy(&f, &u, 4); return f; }
#ifdef CPU_EMU
DEV bf16_t f2bf(float f) { unsigned u; __builtin_memcpy(&u, &f, 4); u += 0x7fffu + ((u >> 16) & 1u); return (bf16_t)(u >> 16); }
DEV unsigned pack2(float a, float b) { return (unsigned)f2bf(a) | ((unsigned)f2bf(b) << 16); }
#else
typedef __attribute__((ext_vector_type(2))) float f32x2_t;
typedef __attribute__((ext_vector_type(2))) __bf16 bf16x2_t;
DEV unsigned pack2(float a, float b) { f32x2_t f = {a, b}; return __builtin_bit_cast(unsigned, __builtin_convertvector(f, bf16x2_t)); }
DEV bf16_t f2bf(float f) { return __builtin_bit_cast(unsigned short, (__bf16)f); }
#endif
DEV void unpack8(const u32x4& r, float* o) {
  unsigned w[4] = {r.x, r.y, r.z, r.w};
#pragma unroll
  for (int i = 0; i < 4; ++i) { unsigned lo = w[i] << 16, hi = w[i] & 0xffff0000u; __builtin_memcpy(&o[2 * i], &lo, 4); __builtin_memcpy(&o[2 * i + 1], &hi, 4); }
}
DEV u32x4 pack8(const float* o) { u32x4 r; r.x = pack2(o[0], o[1]); r.y = pack2(o[2], o[3]); r.z = pack2(o[4], o[5]); r.w = pack2(o[6], o[7]); return r; }
#ifdef CPU_EMU
DEV float fexp(float x) { return expf(x); }
DEV float frcp(float x) { return 1.f / x; }
DEV float flog(float x) { return logf(x); }
DEV float frsq(float x) { return 1.f / sqrtf(x); }
DEV float fsqrt(float x) { return sqrtf(x); }
#else
DEV float fexp(float x) { return __expf(x); }
DEV float frcp(float x) { return __builtin_amdgcn_rcpf(x); }
DEV float flog(float x) { return __logf(x); }
DEV float frsq(float x) { return __builtin_amdgcn_rsqf(x); }
DEV float fsqrt(float x) { return __builtin_amdgcn_sqrtf(x); }
#endif
DEV void ld8(const float* __restrict__ p, float* o) { const f32x4 a = *(const f32x4*)p, b = *(const f32x4*)(p + 4); o[0] = a.x; o[1] = a.y; o[2] = a.z; o[3] = a.w; o[4] = b.x; o[5] = b.y; o[6] = b.z; o[7] = b.w; }
DEV float sigmoidf_(float x) { return frcp(1.f + fexp(-x)); }
DEV float siluf_(float x) { return x * frcp(1.f + fexp(-x)); }
DEV float softplusf_(float x) { return fmaxf(x, 0.f) + flog(1.f + fexp(-fabsf(x))); }
DEV float tanhf_(float x) { return 1.f - 2.f * frcp(1.f + fexp(2.f * x)); }
DEV float geluf_(float x) { return 0.5f * x * (1.f + erff(x * 0.70710678118654752f)); }

DEV f32x16 mfma32(bf16x8 a, bf16x8 b, f32x16 c) {
#ifdef CPU_EMU
  return emu_mfma32(a, b, c);
#else
  return __builtin_amdgcn_mfma_f32_32x32x16_bf16(a, b, c, 0, 0, 0);
#endif
}
DEV float wshfl_xor(float v, int m) {
#ifdef CPU_EMU
  return emu_shfl_xor(v, m);
#else
  return __shfl_xor(v, m, 64);
#endif
}
template <int M> DEV float dpp_xor(float v) {
  static_assert(M == 1 || M == 2 || M == 7 || M == 8, "dpp pattern");
#ifdef CPU_EMU
  return emu_shfl_xor(v, M);
#else
  constexpr int ctrl = M == 1 ? 0xB1 : (M == 2 ? 0x4E : (M == 7 ? 0x141 : 0x128));
  return __int_as_float(__builtin_amdgcn_update_dpp(0, __float_as_int(v), ctrl, 0xf, 0xf, false));
#endif
}
DEV float sum8(float v) { v += dpp_xor<1>(v); v += dpp_xor<2>(v); v += dpp_xor<7>(v); return v; }
DEV float sum4(float v) { v += dpp_xor<1>(v); v += dpp_xor<2>(v); return v; }
DEV float sum16(float v) { v = sum8(v); v += dpp_xor<8>(v); return v; }
DEV float swap32_sum(float a, float b) {
#ifdef CPU_EMU
  float ra = emu_shfl_xor(a, 32), rb = emu_shfl_xor(b, 32);
  return ((threadIdx.x >> 5) & 1) ? b + rb : a + ra;
#else
  auto r = __builtin_amdgcn_permlane32_swap(__float_as_uint(a), __float_as_uint(b), false, false);
  return __uint_as_float(r[0]) + __uint_as_float(r[1]);
#endif
}
DEV float swap16_sum(float a, float b) {
#ifdef CPU_EMU
  float ra = emu_shfl_xor(a, 16), rb = emu_shfl_xor(b, 16);
  return ((threadIdx.x >> 4) & 1) ? b + rb : a + ra;
#else
  auto r = __builtin_amdgcn_permlane16_swap(__float_as_uint(a), __float_as_uint(b), false, false);
  return __uint_as_float(r[0]) + __uint_as_float(r[1]);
#endif
}
DEV float wave_sum(float v) {
  v = sum16(v);
  v = swap16_sum(v, v);
  return swap32_sum(v, v);
}
DEV float wave_incl_scan(float v) {
#ifdef CPU_EMU
  const int l = threadIdx.x & 63;
  for (int s = 1; s < 16; s <<= 1) { const bool ok = (l & 15) >= s; float o = emu_readlane(v, ok ? l - s : l); v += ok ? o : 0.f; }
  { const bool ok = ((l >> 4) & 1) != 0; float o = emu_readlane(v, ok ? (l & ~15) - 1 : l); v += ok ? o : 0.f; }
  { const bool ok = l >= 32; float o = emu_readlane(v, ok ? 31 : l); v += ok ? o : 0.f; }
  return v;
#else
#define DPP_ADD_(ctrl, rmask) v += __int_as_float(__builtin_amdgcn_update_dpp(0, __float_as_int(v), ctrl, rmask, 0xf, false))
  DPP_ADD_(0x111, 0xf); DPP_ADD_(0x112, 0xf); DPP_ADD_(0x114, 0xf); DPP_ADD_(0x118, 0xf);
  DPP_ADD_(0x142, 0xa); DPP_ADD_(0x143, 0xc);
#undef DPP_ADD_
  return v;
#endif
}

#ifdef CPU_EMU
static inline unsigned emu_f2fp8(float f) {
  unsigned sgn = f < 0.f ? 0x80u : 0u; float a = fabsf(f);
  if (!(a == a)) return 0x7f;
  if (a >= 448.f) return sgn | 0x7e;
  if (a < 0.0009765625f) return sgn;
  int e; frexpf(a, &e); e -= 1;
  if (e < -6) { int q = (int)nearbyintf(a * 512.f); return sgn | (unsigned)q; }
  float m = a / ldexpf(1.f, e);
  int q = (int)nearbyintf((m - 1.f) * 8.f);
  if (q == 8) { q = 0; e += 1; }
  if (e > 8) return sgn | 0x7e;
  return sgn | (unsigned)((e + 7) << 3) | (unsigned)q;
}
static inline float emu_fp82f(unsigned c) {
  unsigned sgn = c & 0x80, e = (c >> 3) & 15, m = c & 7;
  float v = e == 0 ? ldexpf((float)m, -9) : ldexpf(1.f + m / 8.f, (int)e - 7);
  return sgn ? -v : v;
}
#endif
DEV unsigned pack4_fp8(float a, float b, float c, float d) {
#ifdef CPU_EMU
  return emu_f2fp8(a) | (emu_f2fp8(b) << 8) | (emu_f2fp8(c) << 16) | (emu_f2fp8(d) << 24);
#else
  int w = 0;
  w = __builtin_amdgcn_cvt_pk_fp8_f32(a, b, w, false);
  w = __builtin_amdgcn_cvt_pk_fp8_f32(c, d, w, true);
  return (unsigned)w;
#endif
}
DEV void unpack4_fp8(unsigned w, float* o) {
#ifdef CPU_EMU
  o[0] = emu_fp82f(w & 255); o[1] = emu_fp82f((w >> 8) & 255); o[2] = emu_fp82f((w >> 16) & 255); o[3] = emu_fp82f(w >> 24);
#else
  typedef __attribute__((ext_vector_type(2))) float f32x2_;
  f32x2_ lo = __builtin_amdgcn_cvt_pk_f32_fp8((int)w, false);
  f32x2_ hi = __builtin_amdgcn_cvt_pk_f32_fp8((int)w, true);
  o[0] = lo.x; o[1] = lo.y; o[2] = hi.x; o[3] = hi.y;
#endif
}
DEV void unpack16_fp8(const u32x4& r, float* o) { unpack4_fp8(r.x, o); unpack4_fp8(r.y, o + 4); unpack4_fp8(r.z, o + 8); unpack4_fp8(r.w, o + 12); }
DEV float wreadlane(float v, int srclane) {
#ifdef CPU_EMU
  return emu_readlane(v, srclane);
#else
  int iv; __builtin_memcpy(&iv, &v, 4);
  int r = __builtin_amdgcn_readlane(iv, srclane);
  float f; __builtin_memcpy(&f, &r, 4); return f;
#endif
}
constexpr float PEER_USCALE = 64.f, PEER_VSCALE = 4.f;
#ifdef CPU_EMU
static inline unsigned emu_f2fp4(float f) {
  static const float lv[8] = {0.f, 0.5f, 1.f, 1.5f, 2.f, 3.f, 4.f, 6.f};
  unsigned sgn = f < 0.f ? 8u : 0u; float a = fabsf(f);
  int best = 0; float bd = 1e30f;
  for (int i = 0; i < 8; ++i) { float dd = fabsf(a - lv[i]); if (dd < bd || (dd == bd && (i & 1) == 0)) { bd = dd; best = i; } }
  return sgn | (unsigned)best;
}
static inline float emu_fp42f(unsigned c) {
  static const float lv[8] = {0.f, 0.5f, 1.f, 1.5f, 2.f, 3.f, 4.f, 6.f};
  float v = lv[c & 7]; return (c & 8) ? -v : v;
}
#endif
DEV unsigned pack8_fp4(const float* v) {
#ifdef CPU_EMU
  unsigned w = 0;
  for (int i = 0; i < 8; ++i) w |= emu_f2fp4(v[i]) << (4 * i);
  return w;
#else
  unsigned w = 0;
  w = __builtin_amdgcn_cvt_scalef32_pk_fp4_f32(w, v[0], v[1], 1.0f, 0);
  w = __builtin_amdgcn_cvt_scalef32_pk_fp4_f32(w, v[2], v[3], 1.0f, 1);
  w = __builtin_amdgcn_cvt_scalef32_pk_fp4_f32(w, v[4], v[5], 1.0f, 2);
  w = __builtin_amdgcn_cvt_scalef32_pk_fp4_f32(w, v[6], v[7], 1.0f, 3);
  return w;
#endif
}
DEV void unpack8_fp4(unsigned w, float* o) {
#ifdef CPU_EMU
  for (int i = 0; i < 8; ++i) o[i] = emu_fp42f((w >> (4 * i)) & 15u);
#else
  typedef __attribute__((ext_vector_type(2))) float f32x2_;
  f32x2_ a = __builtin_amdgcn_cvt_scalef32_pk_f32_fp4(w, 1.0f, 0);
  f32x2_ b = __builtin_amdgcn_cvt_scalef32_pk_f32_fp4(w, 1.0f, 1);
  f32x2_ c = __builtin_amdgcn_cvt_scalef32_pk_f32_fp4(w, 1.0f, 2);
  f32x2_ d = __builtin_amdgcn_cvt_scalef32_pk_f32_fp4(w, 1.0f, 3);
  o[0] = a.x; o[1] = a.y; o[2] = b.x; o[3] = b.y; o[4] = c.x; o[5] = c.y; o[6] = d.x; o[7] = d.y;
#endif
}
typedef __attribute__((ext_vector_type(3))) unsigned u32x3;
#ifndef FP6_INTERLEAVED
#define FP6_INTERLEAVED 1
#endif
#ifdef CPU_EMU
static inline unsigned emu_f2fp6(float f) {
  unsigned sgn = f < 0.f ? 32u : 0u; float a = fabsf(f);
  if (a >= 7.5f) return sgn | 31u;
  int e; unsigned code;
  if (a < 1.f) { int q = (int)nearbyintf(a * 8.f); code = (unsigned)q; }
  else { frexpf(a, &e); e -= 1; float m = a / ldexpf(1.f, e); int q = (int)nearbyintf((m - 1.f) * 8.f); if (q == 8) { q = 0; e += 1; } code = (unsigned)(((e + 1) << 3) | q); if (e > 2) code = 31u; }
  return sgn | code;
}
static inline float emu_fp62f(unsigned c) {
  unsigned e = (c >> 3) & 3, m = c & 7;
  float v = e == 0 ? m * 0.125f : ldexpf(1.f + m / 8.f, (int)e - 1);
  return (c & 32) ? -v : v;
}
#endif
DEV u32x3 pack16_fp6(const float* v) {
#ifdef CPU_EMU
  unsigned long long lo = 0; unsigned hi = 0;
  for (int i = 0; i < 16; ++i) {
    unsigned long long c = emu_f2fp6(v[i]); int bit = 6 * i;
    if (bit < 64) { lo |= c << bit; if (bit > 58) hi |= (unsigned)(c >> (64 - bit)); } else hi |= (unsigned)(c << (bit - 64));
  }
  u32x3 r; r.x = (unsigned)lo; r.y = (unsigned)(lo >> 32); r.z = hi; return r;
#else
  typedef __attribute__((ext_vector_type(6))) unsigned u32x6_;
  f32x16 a, b;
#if FP6_INTERLEAVED
#pragma unroll
  for (int i = 0; i < 8; ++i) { a[i] = v[2 * i]; b[i] = v[2 * i + 1]; a[8 + i] = 0.f; b[8 + i] = 0.f; }
#else
#pragma unroll
  for (int i = 0; i < 16; ++i) { a[i] = v[i]; b[i] = 0.f; }
#endif
  u32x6_ w = __builtin_amdgcn_cvt_scalef32_2xpk16_fp6_f32(a, b, 1.0f);
  u32x3 r; r.x = w[0]; r.y = w[1]; r.z = w[2]; return r;
#endif
}
DEV void unpack16_fp6(const u32x3& r, float* o) {
#ifdef CPU_EMU
  unsigned long long lo = (unsigned long long)r.x | ((unsigned long long)r.y << 32); unsigned hi = r.z;
  for (int i = 0; i < 16; ++i) {
    int bit = 6 * i; unsigned c;
    if (bit + 6 <= 64) c = (unsigned)(lo >> bit) & 63u;
    else if (bit >= 64) c = (hi >> (bit - 64)) & 63u;
    else c = ((unsigned)(lo >> bit) | (hi << (64 - bit))) & 63u;
    o[i] = emu_fp62f(c);
  }
#else
  typedef __attribute__((ext_vector_type(6))) unsigned u32x6_;
  typedef __attribute__((ext_vector_type(32))) float f32x32_;
  u32x6_ w; w[0] = r.x; w[1] = r.y; w[2] = r.z; w[3] = 0u; w[4] = 0u; w[5] = 0u;
  f32x32_ f = __builtin_amdgcn_cvt_scalef32_pk32_f32_fp6(w, 1.0f);
#pragma unroll
  for (int i = 0; i < 16; ++i) o[i] = f[i];
#endif
}
DEV void unpack2x16_fp6(const u32x3& ra, const u32x3& rb, float* oa, float* ob) {
#ifdef CPU_EMU
  unpack16_fp6(ra, oa); unpack16_fp6(rb, ob);
#else
  typedef __attribute__((ext_vector_type(6))) unsigned u32x6_;
  typedef __attribute__((ext_vector_type(32))) float f32x32_;
  u32x6_ w; w[0] = ra.x; w[1] = ra.y; w[2] = ra.z; w[3] = rb.x; w[4] = rb.y; w[5] = rb.z;
  f32x32_ f = __builtin_amdgcn_cvt_scalef32_pk32_f32_fp6(w, 1.0f);
#pragma unroll
  for (int i = 0; i < 16; ++i) { oa[i] = f[i]; ob[i] = f[16 + i]; }
#endif
}
constexpr int PEER_ROWB = 1280;
constexpr int PEER_VOFF = 768;


DEV int acc_row(int reg, int lane) { return (reg & 3) + 8 * (reg >> 2) + 4 * (lane >> 5); }

DEV int mod_row(int row) { return row < NCTX ? 2 : (row - NCTX) / SEQ; }

template <bool SYNC_EPI, class Epi, bool VEC4 = false>
DEV void gemm_tile_128(const bf16_t* __restrict__ A, int lda, int M, const bf16_t* __restrict__ Bt, int ldb, int N,
                       int K, int m0, int n0, const Epi& epi, unsigned char* smem) {
  constexpr int LS = 72;
  constexpr int STAGE = 2 * 128 * LS;
  bf16_t* sbase = (bf16_t*)smem;
  const int wave = threadIdx.x >> 6;
  const int wm = (wave >> 1) * 64, wn = (wave & 1) * 64;
  f32x16 acc[2][2];
#pragma unroll
  for (int i = 0; i < 2; ++i)
#pragma unroll
    for (int j = 0; j < 2; ++j)
#pragma unroll
      for (int r = 0; r < 16; ++r) acc[i][j][r] = 0.f;
  u32x4 ra[4], rb[4];
  auto gload = [&](int k0) {
    int tl_ = threadIdx.x; OPAQUE(tl_);
#pragma unroll
    for (int i = 0; i < 4; ++i) {
      int c = tl_ + i * 256, r = c >> 3, cc = (c & 7) * 8;
      int gr = m0 + r, gn = n0 + r;
      gr = gr < M ? gr : M - 1; gn = gn < N ? gn : N - 1;
      ra[i] = *(const u32x4*)(A + (size_t)gr * lda + k0 + cc);
      rb[i] = *(const u32x4*)(Bt + (size_t)gn * ldb + k0 + cc);
    }
  };
  auto lwrite = [&](int buf) {
    int tl_ = threadIdx.x; OPAQUE(tl_);
    bf16_t* sA = sbase + buf * STAGE;
    bf16_t* sB = sA + 128 * LS;
#pragma unroll
    for (int i = 0; i < 4; ++i) {
      int c = tl_ + i * 256, r = c >> 3, cc = (c & 7) * 8;
      *(u32x4*)(sA + r * LS + cc) = ra[i];
      *(u32x4*)(sB + r * LS + cc) = rb[i];
    }
  };
  const int nk = K >> 6;
  gload(0);
  __syncthreads();
  lwrite(0);
  if (nk > 1) gload(64);
  __syncthreads();
  for (int it = 0; it < nk; ++it) {
    int tl_ = threadIdx.x; OPAQUE(tl_);
    const int lane = tl_ & 63;
    const bf16_t* sA = sbase + (it & 1) * STAGE;
    const bf16_t* sB = sA + 128 * LS;
#pragma unroll
    for (int kk = 0; kk < 4; ++kk) {
      bf16x8 a[2], b[2];
      const int ko = kk * 16 + 8 * (lane >> 5);
#pragma unroll
      for (int i = 0; i < 2; ++i) a[i] = *(const bf16x8*)(sA + (wm + i * 32 + (lane & 31)) * LS + ko);
#pragma unroll
      for (int j = 0; j < 2; ++j) b[j] = *(const bf16x8*)(sB + (wn + j * 32 + (lane & 31)) * LS + ko);
#pragma unroll
      for (int i = 0; i < 2; ++i)
#pragma unroll
        for (int j = 0; j < 2; ++j) acc[i][j] = mfma32(a[i], b[j], acc[i][j]);
      if (kk == 1) {
        if (it + 1 < nk) lwrite((it + 1) & 1);
        if (it + 2 < nk) gload((it + 2) * 64);
      }
    }
    __syncthreads();
  }
  {
    int tl_ = threadIdx.x; OPAQUE(tl_);
    const int lane = tl_ & 63;
    if constexpr (VEC4) {
#pragma unroll
      for (int i = 0; i < 2; ++i)
#pragma unroll
        for (int j = 0; j < 2; ++j)
#pragma unroll
          for (int gq = 0; gq < 4; ++gq) {
            int row = m0 + wm + i * 32 + 8 * gq + 4 * (lane >> 5);
            int col = n0 + wn + j * 32 + (lane & 31);
            if (row < M && col < N) epi.store4(row, col, acc[i][j][4 * gq], acc[i][j][4 * gq + 1], acc[i][j][4 * gq + 2], acc[i][j][4 * gq + 3]);
          }
    } else {
#pragma unroll
      for (int i = 0; i < 2; ++i)
#pragma unroll
        for (int j = 0; j < 2; ++j)
#pragma unroll
          for (int r = 0; r < 16; ++r) {
            int row = m0 + wm + i * 32 + acc_row(r, lane);
            int col = n0 + wn + j * 32 + (lane & 31);
            if (row < M && col < N) epi(row, col, acc[i][j][r]);
          }
    }
  }
}

template <class Epi, bool VEC4 = false>
DEV void gemm_tile_128x256(const bf16_t* __restrict__ A, int lda, int M, const bf16_t* __restrict__ Bt, int ldb, int N,
                           int K, int m0, int n0, const Epi& epi, unsigned char* smem) {
  constexpr int LS = 72;
  bf16_t* sA = (bf16_t*)smem;
  bf16_t* sB = sA + 128 * LS;
  const int wave = threadIdx.x >> 6;
  const int wm = (wave >> 1) * 64, wn = (wave & 1) * 128;
  f32x16 acc[2][4];
#pragma unroll
  for (int i = 0; i < 2; ++i)
#pragma unroll
    for (int j = 0; j < 4; ++j)
#pragma unroll
      for (int r = 0; r < 16; ++r) acc[i][j][r] = 0.f;
  u32x4 ra[4], rb[8];
  {
    const int tid = threadIdx.x;
#pragma unroll
    for (int i = 0; i < 4; ++i) {
      int c = tid + i * 256, r = c >> 3, cc = (c & 7) * 8;
      { int gr = m0 + r; gr = gr < M ? gr : M - 1; ra[i] = *(const u32x4*)(A + (size_t)gr * lda + cc); }
    }
#pragma unroll
    for (int i = 0; i < 8; ++i) {
      int c = tid + i * 256, r = c >> 3, cc = (c & 7) * 8;
      { int gn = n0 + r; gn = gn < N ? gn : N - 1; rb[i] = *(const u32x4*)(Bt + (size_t)gn * ldb + cc); }
    }
  }
  for (int k0 = 0; k0 < K; k0 += 64) {
    int tl_ = threadIdx.x; OPAQUE(tl_);
    const int tid = tl_, lane = tl_ & 63;
    __syncthreads();
#pragma unroll
    for (int i = 0; i < 4; ++i) { int c = tid + i * 256, r = c >> 3, cc = (c & 7) * 8; *(u32x4*)(sA + r * LS + cc) = ra[i]; }
#pragma unroll
    for (int i = 0; i < 8; ++i) { int c = tid + i * 256, r = c >> 3, cc = (c & 7) * 8; *(u32x4*)(sB + r * LS + cc) = rb[i]; }
    __syncthreads();
    if (k0 + 64 < K) {
#pragma unroll
      for (int i = 0; i < 4; ++i) {
        int c = tid + i * 256, r = c >> 3, cc = (c & 7) * 8;
        { int gr = m0 + r; gr = gr < M ? gr : M - 1; ra[i] = *(const u32x4*)(A + (size_t)gr * lda + k0 + 64 + cc); }
      }
#pragma unroll
      for (int i = 0; i < 8; ++i) {
        int c = tid + i * 256, r = c >> 3, cc = (c & 7) * 8;
        { int gn = n0 + r; gn = gn < N ? gn : N - 1; rb[i] = *(const u32x4*)(Bt + (size_t)gn * ldb + k0 + 64 + cc); }
      }
    }
#pragma unroll 2
    for (int kk = 0; kk < 4; ++kk) {
      bf16x8 a[2], b[4];
      const int ko = kk * 16 + 8 * (lane >> 5);
#pragma unroll
      for (int i = 0; i < 2; ++i) a[i] = *(const bf16x8*)(sA + (wm + i * 32 + (lane & 31)) * LS + ko);
#pragma unroll
      for (int j = 0; j < 4; ++j) b[j] = *(const bf16x8*)(sB + (wn + j * 32 + (lane & 31)) * LS + ko);
#pragma unroll
      for (int i = 0; i < 2; ++i)
#pragma unroll
        for (int j = 0; j < 4; ++j) acc[i][j] = mfma32(a[i], b[j], acc[i][j]);
    }
  }
  {
    int tl_ = threadIdx.x; OPAQUE(tl_);
    const int lane = tl_ & 63;
    if constexpr (VEC4) {
#pragma unroll
      for (int i = 0; i < 2; ++i)
#pragma unroll
        for (int j = 0; j < 4; ++j)
#pragma unroll
          for (int gq = 0; gq < 4; ++gq) {
            int row = m0 + wm + i * 32 + 8 * gq + 4 * (lane >> 5);
            int col = n0 + wn + j * 32 + (lane & 31);
            if (row < M && col < N) epi.store4(row, col, acc[i][j][4 * gq], acc[i][j][4 * gq + 1], acc[i][j][4 * gq + 2], acc[i][j][4 * gq + 3]);
          }
    } else {
#pragma unroll
      for (int i = 0; i < 2; ++i)
#pragma unroll
        for (int j = 0; j < 4; ++j)
#pragma unroll
          for (int r = 0; r < 16; ++r) {
            int row = m0 + wm + i * 32 + acc_row(r, lane);
            int col = n0 + wn + j * 32 + (lane & 31);
            if (row < M && col < N) epi(row, col, acc[i][j][r]);
          }
    }
  }
}

DEV void transpose_tile(const float* __restrict__ src, int ld_src, bf16_t* __restrict__ dst, int ld_dst, int K, int N,
                        int tk, int tn, unsigned char* smem) {
  float* sT = (float*)smem;
  const int tid = threadIdx.x;
  __syncthreads();
  {
    const int tx = tid & 15, ty = tid >> 4;
#pragma unroll
    for (int p = 0; p < 4; ++p) {
      int k = tk * 64 + ty + p * 16, n = tn * 64 + tx * 4;
      f32x4 v4 = {0.f, 0.f, 0.f, 0.f};
      if (k < K && n < N) v4 = *(const f32x4*)(src + (size_t)k * ld_src + n);
      float* d = sT + (ty + p * 16) * 65 + tx * 4;
      d[0] = v4.x; d[1] = v4.y; d[2] = v4.z; d[3] = v4.w;
    }
  }
  __syncthreads();
  {
    const int n = tid >> 2, kseg = (tid & 3) * 16;
    int gn = tn * 64 + n;
    if (gn < N) {
      float v[16];
#pragma unroll
      for (int j = 0; j < 16; ++j) v[j] = sT[(kseg + j) * 65 + n];
      bf16_t* d = dst + (size_t)gn * ld_dst + tk * 64 + kseg;
      *(u32x4*)d = pack8(v);
      *(u32x4*)(d + 8) = pack8(v + 8);
    }
  }
}

constexpr int TJ0 = 16 * 49, TJ1 = 16 * 16, TJ2 = 16 * 44, TJ3 = 16 * 16, TJ4 = 2 * 16 * 32, TJ5 = 2 * 8, TJ6 = 2 * 8,
              TJ7 = 2 * 8, TJ8 = 32;
constexpr int NTRANS = TJ0 + TJ1 + TJ2 + TJ3 + TJ4 + TJ5 + TJ6 + TJ7 + TJ8;
constexpr int NKEYCV = (2 * 8 * 2 * 128 * 128) / (256 * 8);
constexpr int NMODV = 2 * 96;
constexpr int NPREP = NTRANS + NKEYCV + NMODV;

DEV void st_prep(const Params& P, int item, unsigned char* smem) {
  unsigned char* ws = P.ws;
  if (item < NTRANS) {
    int t = item;
    if (t < TJ0) { transpose_tile(P.in[I_EVWIN], EVC, (bf16_t*)(ws + OFF_WEVIN), 1024, 1024, EVC, t / 49, t % 49, smem); return; }
    t -= TJ0;
    if (t < TJ1) { transpose_tile(P.in[I_EVWOUT], 1024, (bf16_t*)(ws + OFF_WEVOUT), 1024, 1024, 1024, t / 16, t % 16, smem); return; }
    t -= TJ1;
    if (t < TJ2) { transpose_tile(P.in[I_ODWIN], ODC, (bf16_t*)(ws + OFF_WODIN), 1024, 1024, ODC, t / 44, t % 44, smem); return; }
    t -= TJ2;
    if (t < TJ3) { transpose_tile(P.in[I_ODWOUT], 1024, (bf16_t*)(ws + OFF_WODOUT), 1024, 1024, 1024, t / 16, t % 16, smem); return; }
    t -= TJ3;
    if (t < TJ4) {
      int l = t / 512, tt = t % 512;
      transpose_tile(P.in[I_WQ] + (size_t)l * 1024 * 2048, 2048, (bf16_t*)(ws + OFF_WQ) + (size_t)l * 2048 * 1024, 1024, 1024, 2048, tt / 32, tt % 32, smem);
      return;
    }
    t -= TJ4;
    if (t < TJ5) { int d = t / 8; transpose_tile(P.in[I_WUP] + d * 64 * 512, 512, (bf16_t*)(ws + OFF_WUP) + d * 512 * 64, 64, 64, 512, 0, t % 8, smem); return; }
    t -= TJ5;
    if (t < TJ6) { int d = t / 8; transpose_tile(P.in[I_AUP] + d * 64 * 512, 512, (bf16_t*)(ws + OFF_AUP) + d * 512 * 64, 64, 64, 512, 0, t % 8, smem); return; }
    t -= TJ6;
    if (t < TJ7) { transpose_tile(P.in[I_GUP], 512, (bf16_t*)(ws + OFF_GUP), 128, 128, 512, t / 8, t % 8, smem); return; }
    t -= TJ7;
    {
      int which = t & 1, db = t >> 1;
      const float* src = (which ? P.in[I_WI] : P.in[I_WA]) + (size_t)db * 64 * 64;
      transpose_tile(src, 64, (bf16_t*)(ws + OFF_LRUT) + (size_t)db * 128 * 64 + which * 64 * 64, 64, 64, 64, 0, 0, smem);
      return;
    }
  }
  item -= NTRANS;
  if (item < NKEYCV) {
    size_t e = ((size_t)item * 256 + threadIdx.x) * 8;
    const float* s = P.in[I_KEYS] + e;
    f32x4 a = *(const f32x4*)s, b = *(const f32x4*)(s + 4);
    float v[8] = {a.x, a.y, a.z, a.w, b.x, b.y, b.z, b.w};
    *(u32x4*)((bf16_t*)(ws + OFF_KEYS) + e) = pack8(v);
    return;
  }
  item -= NKEYCV;
  {
    const int l = item / 96, cgp = item % 96;
    float* sS = (float*)smem;
    float* sRed = sS + 3 * 1024;
    const int tid = threadIdx.x;
    __syncthreads();
    for (int i = tid; i < 3 * 1024; i += 256) {
      int m = i >> 10, k = i & 1023;
      float c = m < 2 ? P.in[I_C][m * 1024 + k] : P.in[I_CCTX][k];
      sS[i] = siluf_(c);
    }
    __syncthreads();
    const int ks = tid >> 6, col = cgp * 64 + (tid & 63);
    const float* w = P.in[I_MODW] + (size_t)l * 1024 * 6144 + col;
    float a0 = 0.f, a1 = 0.f, a2 = 0.f;
    for (int k = ks * 256; k < ks * 256 + 256; ++k) {
      float wv = w[(size_t)k * 6144];
      a0 += sS[k] * wv; a1 += sS[1024 + k] * wv; a2 += sS[2048 + k] * wv;
    }
    sRed[(ks * 3 + 0) * 64 + (tid & 63)] = a0;
    sRed[(ks * 3 + 1) * 64 + (tid & 63)] = a1;
    sRed[(ks * 3 + 2) * 64 + (tid & 63)] = a2;
    __syncthreads();
    if (tid < 192) {
      int m = tid >> 6, c = tid & 63;
      float s = sRed[(0 * 3 + m) * 64 + c] + sRed[(1 * 3 + m) * 64 + c] + sRed[(2 * 3 + m) * 64 + c] + sRed[(3 * 3 + m) * 64 + c];
      int cc = cgp * 64 + c;
      ((float*)(ws + OFF_MODV))[((size_t)l * 3 + m) * 6144 + cc] = s + P.in[I_MODB][l * 6144 + cc];
    }
  }
}

constexpr int NPCONV = 2 * (NEXP * 1024 / (256 * 16));
DEV void st_peer_conv(const Params& P, int layer, int item) {
  const int half = NPCONV / 2;
  int which = item >= half;
  int it = which ? item - half : item;
  size_t e = ((size_t)it * 256 + threadIdx.x) * 16;
  const float* s = (which ? P.in[I_PV] : P.in[I_PU]) + (size_t)layer * NEXP * 1024 + e;
  const float sc = which ? PEER_VSCALE : PEER_USCALE;
  float v16[16];
#pragma unroll
  for (int q = 0; q < 4; ++q) {
    f32x4 a = *(const f32x4*)(s + 4 * q);
    v16[4 * q] = a.x * sc; v16[4 * q + 1] = a.y * sc; v16[4 * q + 2] = a.z * sc; v16[4 * q + 3] = a.w * sc;
  }
  const size_t ex = e >> 10, col = e & 1023;
  if (which) {
    u32x2 o; o.x = pack8_fp4(v16); o.y = pack8_fp4(v16 + 8);
    *(u32x2*)(P.ws + OFF_PU + ex * PEER_ROWB + PEER_VOFF + (col >> 1)) = o;
  } else {
    u32x3 o = pack16_fp6(v16);
    unsigned* dp = (unsigned*)(P.ws + OFF_PU + ex * PEER_ROWB + (col >> 4) * 12);
    dp[0] = o.x; dp[1] = o.y; dp[2] = o.z;
  }
}

DEV void st_normmod(const Params& P, int layer, int which, int row) {
  const int lane = threadIdx.x & 63;
  const float* src;
  if (which == 0 && layer == 0) src = row < NCTX ? P.in[I_CTX] + (size_t)row * 1024 : P.in[I_X] + (size_t)(row - NCTX) * 1024;
  else src = row < NCTX ? (const float*)(P.ws + OFF_CTXRES) + (size_t)row * 1024 : P.out + (size_t)(row - NCTX) * 1024;
  const float* mv = (const float*)(P.ws + OFF_MODV) + ((size_t)layer * 3 + mod_row(row)) * 6144;
  const float* sh = mv + (which ? 3 : 0) * 1024;
  const float* sc = mv + (which ? 4 : 1) * 1024;
  const float* nw = (which ? P.in[I_NORM2] : P.in[I_NORM1]) + layer * 1024;
  f32x4 v[4];
  float ss = 0.f;
#pragma unroll
  for (int i = 0; i < 4; ++i) {
    v[i] = *(const f32x4*)(src + i * 256 + lane * 4);
    ss += v[i].x * v[i].x + v[i].y * v[i].y + v[i].z * v[i].z + v[i].w * v[i].w;
  }
  ss = wave_sum(ss);
  const float rstd = frsq(ss * (1.f / 1024.f) + 1e-6f);
  bf16_t* dst = (bf16_t*)(P.ws + OFF_HBUF) + (size_t)row * 1024;
#pragma unroll
  for (int i = 0; i < 4; ++i) {
    int c = i * 256 + lane * 4;
    f32x4 w4 = *(const f32x4*)(nw + c), s4 = *(const f32x4*)(sc + c), h4 = *(const f32x4*)(sh + c);
    float o0 = v[i].x * rstd * w4.x * (1.f + s4.x) + h4.x;
    float o1 = v[i].y * rstd * w4.y * (1.f + s4.y) + h4.y;
    float o2 = v[i].z * rstd * w4.z * (1.f + s4.z) + h4.z;
    float o3 = v[i].w * rstd * w4.w * (1.f + s4.w) + h4.w;
    u32x2 pk; pk.x = pack2(o0, o1); pk.y = pack2(o2, o3);
    *(u32x2*)(dst + c) = pk;
  }
}

struct EpiProjL0 {
  bf16_t* proj; float* gates;
  DEVM void operator()(int row, int col, float v) const {
    proj[(size_t)row * EVC + col] = f2bf(v);
    if (col >= 1536 && col < 1552) gates[row * 32 + (col - 1536)] = v;
    else if (col >= 3088) gates[row * 32 + 16 + (col - 3088)] = v;
  }
};
struct EpiStoreBf {
  bf16_t* dst; int ld;
  DEVM void operator()(int row, int col, float v) const { dst[(size_t)row * ld + col] = f2bf(v); }
};
struct EpiStoreBfBias {
  bf16_t* dst; int ld; const float* bias;
  DEVM void operator()(int row, int col, float v) const { dst[(size_t)row * ld + col] = f2bf(v + (bias ? bias[col] : 0.f)); }
};
struct EpiProjL0T {
  bf16_t* proj; float* gates;
  DEVM void operator()(int, int, float) const {}
  DEVM void store4(int n, int m, float v0, float v1, float v2, float v3) const {
    u32x2 pk; pk.x = pack2(v0, v1); pk.y = pack2(v2, v3);
    *(u32x2*)(proj + (size_t)m * EVC + n) = pk;
    if (n >= 1536 && n < 1552) { f32x4 g = {v0, v1, v2, v3}; *(f32x4*)(gates + m * 32 + (n - 1536)) = g; }
    else if (n >= 3088) { f32x4 g = {v0, v1, v2, v3}; *(f32x4*)(gates + m * 32 + 16 + (n - 3088)) = g; }
  }
};
struct EpiStoreBfT {
  bf16_t* dst; int ld;
  DEVM void operator()(int, int, float) const {}
  DEVM void store4(int n, int m, float v0, float v1, float v2, float v3) const {
    u32x2 pk; pk.x = pack2(v0, v1); pk.y = pack2(v2, v3);
    *(u32x2*)(dst + (size_t)m * ld + n) = pk;
  }
};
struct EpiOutProjT {
  const float* x_lat; const float* x_ctx; float* o_lat; float* o_ctx; const float* modv;
  DEVM void operator()(int, int, float) const {}
  DEVM void store4(int n, int m, float v0, float v1, float v2, float v3) const {
    const f32x4 g = *(const f32x4*)(modv + mod_row(m) * 6144 + 2 * 1024 + n);
    const float* xs; float* od;
    if (m < NCTX) { xs = x_ctx + (size_t)m * 1024 + n; od = o_ctx + (size_t)m * 1024 + n; }
    else { size_t o = (size_t)(m - NCTX) * 1024 + n; xs = x_lat + o; od = o_lat + o; }
    const f32x4 x = *(const f32x4*)xs;
    f32x4 r = {x.x + g.x * v0, x.y + g.y * v1, x.z + g.z * v2, x.w + g.w * v3};
    *(f32x4*)od = r;
  }
};
struct EpiStoreBfBiasT {
  bf16_t* dst; int ld; const float* bias; int mode;
  DEVM void operator()(int, int, float) const {}
  DEVM void store4(int n, int m, float v0, float v1, float v2, float v3) const {
    if (bias) { v0 += bias[n]; v1 += bias[n + 1]; v2 += bias[n + 2]; v3 += bias[n + 3]; }
    if (mode) {
      const float sc = mode == 1 ? -0.6065306597126334f : 1.f;
      v0 = sc * sigmoidf_(v0); v1 = sc * sigmoidf_(v1); v2 = sc * sigmoidf_(v2); v3 = sc * sigmoidf_(v3);
    }
    u32x2 pk; pk.x = pack2(v0, v1); pk.y = pack2(v2, v3);
    *(u32x2*)(dst + (size_t)m * ld + n) = pk;
  }
};
struct EpiOutProj {
  const float* x_lat; const float* x_ctx; float* o_lat; float* o_ctx; const float* modv;
  DEVM void operator()(int row, int col, float v) const {
    float g = modv[mod_row(row) * 6144 + 2 * 1024 + col];
    if (row < NCTX) o_ctx[(size_t)row * 1024 + col] = x_ctx[(size_t)row * 1024 + col] + g * v;
    else { size_t o = (size_t)(row - NCTX) * 1024 + col; o_lat[o] = x_lat[o] + g * v; }
  }
};
struct EpiScoreLds {
  float* sS; int m0;
  DEVM void operator()(int row, int col, float v) const { sS[(row - m0) * 129 + col] = v; }
};

DEV void st_xbc_conv(const Params& P, int row) {
  const int lane = threadIdx.x & 63;
  const bf16_t* proj = (const bf16_t*)(P.ws + OFF_PROJ);
  bf16_t* xc = (bf16_t*)P.out + (size_t)row * 1024;
  int row0, len, pos;
  if (row < NCTX) { row0 = (row / CTXL) * CTXL; len = CTXL; pos = row - row0; }
  else { int r = row - NCTX; row0 = NCTX + (r / SEQ) * SEQ; len = SEQ; pos = r % SEQ; }
  const float* cw = P.in[I_SCONVW];
  const float* cb = P.in[I_SCONVB];
#pragma unroll
  for (int hh = 0; hh < 2; ++hh) {
    const int ch = hh * 512 + lane * 8;
    float o[8];
#pragma unroll
    for (int j = 0; j < 8; ++j) o[j] = cb[ch + j];
#pragma unroll
    for (int tap = 0; tap < 4; ++tap) {
      int pp = pos + tap - 2;
      if (pp >= 0 && pp < len) {
        float x[8];
        unpack8(*(const u32x4*)(proj + (size_t)(row0 + pp) * EVC + 2064 + ch), x);
        f32x4 w0 = *(const f32x4*)(cw + tap * 1024 + ch), w1 = *(const f32x4*)(cw + tap * 1024 + ch + 4);
        o[0] += w0.x * x[0]; o[1] += w0.y * x[1]; o[2] += w0.z * x[2]; o[3] += w0.w * x[3];
        o[4] += w1.x * x[4]; o[5] += w1.y * x[5]; o[6] += w1.z * x[6]; o[7] += w1.w * x[7];
      }
    }
#pragma unroll
    for (int j = 0; j < 8; ++j) o[j] = siluf_(o[j]);
    *(u32x4*)(xc + ch) = pack8(o);
  }
}

#ifndef LA_NSEG
#define LA_NSEG 10
#endif
constexpr int LA_NCH = (CTXL + SEQ) / 64;
constexpr int LA_CPS = LA_NCH / LA_NSEG;
static_assert(LA_NCH % LA_NSEG == 0, "linattn segments");
#ifdef CPU_EMU
constexpr size_t OFF_LASEG = OFF_PR + PR_BYTES;
#else
constexpr size_t OFF_LASEG = OFF_R2L0 + (size_t)NTOK * 1024 * 2;
#endif
constexpr size_t LASEG_U = (size_t)48 * LA_NSEG * 8192 * 4;
constexpr size_t OFF_LASEG_N = OFF_LASEG + LASEG_U;
constexpr size_t OFF_LASEG_D = OFF_LASEG_N + (size_t)48 * LA_NSEG * 64 * 4;
#ifndef CPU_EMU
static_assert(OFF_LASEG_D + 48 * LA_NSEG * 4 <= OFF_PR + PR_BYTES, "laseg");
#endif

struct LaRaw { u32x4 q[2], k[4], x[4]; float g0, g1; };

template <bool MLSTM, bool FULL>
DEV void la_load_raw(const Params& P, int b, int h, int d, int cc, LaRaw& R) {
  constexpr int NC_CTX = CTXL / 64;
  const int tid = threadIdx.x;
  const int seg = cc >= NC_CTX;
  const int row0 = seg ? NCTX + b * SEQ : b * CTXL;
  const int len = seg ? SEQ : CTXL;
  const int cl = (seg ? cc - NC_CTX : cc) * 64;
  const bf16_t* proj = (const bf16_t*)(P.ws + OFF_PROJ);
  const bf16_t* xcv = (const bf16_t*)P.out;
  const float* gates = (const float*)(P.ws + OFF_GATES);
  if (tid < 64) {
    int p = cl + tid, grow = row0 + (d ? len - 1 - p : p);
    if (MLSTM) { R.g0 = gates[grow * 32 + d * 4 + h]; R.g1 = gates[grow * 32 + 8 + d * 4 + h]; }
    else { R.g0 = gates[grow * 32 + 16 + d * 8 + h]; R.g1 = 0.f; }
  }
  if (MLSTM) {
#pragma unroll
    for (int i = 0; i < 2; ++i) {
      int c = tid + i * 256, r = c >> 3, cc8 = (c & 7) * 8;
      int p = cl + r, pos = d ? len - 1 - p : p;
      const bf16_t* rp = proj + (size_t)(row0 + pos) * EVC;
      if (FULL) R.q[i] = *(const u32x4*)(rp + h * 64 + cc8);
      R.k[i] = *(const u32x4*)(rp + 256 + h * 64 + cc8);
    }
#pragma unroll
    for (int i = 0; i < 4; ++i) {
      int c = tid + i * 256, r = c >> 4, cc8 = (c & 15) * 8;
      int p = cl + r, pos = d ? len - 1 - p : p;
      R.x[i] = *(const u32x4*)(proj + (size_t)(row0 + pos) * EVC + 512 + h * 128 + cc8);
    }
  } else {
    const int grp = h >> 2;
#pragma unroll
    for (int i = 0; i < 2; ++i) {
      int c = tid + i * 256, r = c >> 3, cc8 = (c & 7) * 8;
      int p = cl + r, pos = d ? len - 1 - p : p;
      R.x[i] = *(const u32x4*)(xcv + (size_t)(row0 + pos) * 1024 + h * 64 + cc8);
    }
#pragma unroll
    for (int i = 0; i < 4; ++i) {
      int c = tid + i * 256, r = c >> 4, cc8 = (c & 15) * 8;
      int p = cl + r, pos = d ? len - 1 - p : p;
      const bf16_t* rp = xcv + (size_t)(row0 + pos) * 1024;
      R.k[i] = *(const u32x4*)(rp + 512 + grp * 128 + cc8);
      if (FULL) { if (i < 2) R.q[i] = *(const u32x4*)(rp + 768 + grp * 128 + cc8); else R.x[i] = *(const u32x4*)(rp + 768 + grp * 128 + cc8); }
    }
  }
}

template <bool MLSTM, bool FULL>
DEV void st_linattn_seg(const Params& P, int sid, int seg, unsigned char* smem) {
  constexpr int DK = MLSTM ? 64 : 128, DX = MLSTM ? 128 : 64;
  constexpr int QS = DK + 8;
  constexpr int NH = MLSTM ? 4 : 8;
  constexpr int NC_CTX = CTXL / 64;
  const int tid = threadIdx.x, lane = tid & 63, wave = tid >> 6;
  const int d = sid & 1, h = (sid >> 1) % NH, b = (sid >> 1) / NH;
  const int gsid = MLSTM ? sid : 16 + sid;
  bf16_t* sQ = (bf16_t*)smem;
  bf16_t* sK = sQ + 64 * QS;
  bf16_t* sP = sK;
  bf16_t* sKT = sK + 64 * QS;
  bf16_t* sXT = sKT + DK * 72;
  bf16_t* sST = sXT + DX * 72;
  float* sF = (float*)(sST + DX * QS);
  float* sLa = sF;
  float* sG = sF + 64;
  float* sBc = sF + 128;
  float* sDen = sF + 192;
  float* sN = sF + 256;
  int* sRow = (int*)(sF + 384);
  static_assert((64 * QS * 2 + DK * 72 + DX * 72 + DX * QS) * 2 + 448 * 4 <= SMEM_BYTES, "lds");
  bf16_t* outb = MLSTM ? (bf16_t*)(P.ws + OFF_HBUF) : (bf16_t*)(P.ws + OFF_R2L0);
  float* segU = (float*)(P.ws + OFF_LASEG);
  float* segN = (float*)(P.ws + OFF_LASEG_N);
  float* segD = (float*)(P.ws + OFF_LASEG_D);

  f32x16 accS[2];
#pragma unroll
  for (int j = 0; j < 2; ++j)
#pragma unroll
    for (int r = 0; r < 16; ++r) accS[j][r] = 0.f;
  const int sx0 = MLSTM ? wave * 32 : (wave >> 1) * 32;
  const int sk0 = MLSTM ? 0 : (wave & 1) * 64;
  float nreg = 0.f;
  float gb0 = 0.f, gb1 = 0.f, alog_e = 0.f, dskip = 0.f;
  if (MLSTM) { gb0 = P.in[I_IBIAS][d * 4 + h]; gb1 = P.in[I_FBIAS][d * 4 + h]; }
  else { gb0 = P.in[I_DTBIAS][d * 8 + h]; alog_e = fexp(P.in[I_ALOG][d * 8 + h]); dskip = P.in[I_DSKIP][h]; }

  const int cc0 = seg * LA_CPS, cc1 = cc0 + LA_CPS;
  LaRaw R;
  la_load_raw<MLSTM, FULL>(P, b, h, d, cc0, R);
  __syncthreads();
  if (FULL) {
    for (int js = 0; js < seg; ++js) {
      const size_t it = (size_t)gsid * LA_NSEG + js;
      const float a = fexp(segD[it]);
      const float* U = segU + it * 8192;
#pragma unroll
      for (int j = 0; j < 2; ++j)
#pragma unroll
        for (int r = 0; r < 16; ++r) accS[j][r] = a * accS[j][r] + U[(j * 16 + r) * 256 + tid];
      if (MLSTM) nreg = a * nreg + segN[it * 64 + (tid >> 2)];
    }
#pragma unroll
    for (int j = 0; j < 2; ++j)
#pragma unroll
      for (int r = 0; r < 16; ++r) sST[(sx0 + acc_row(r, lane)) * QS + sk0 + j * 32 + (lane & 31)] = f2bf(accS[j][r]);
    if (MLSTM && (tid & 3) == 0) sN[tid >> 2] = nreg;
  }
  float lsum = 0.f;

  for (int cc = cc0; cc < cc1; ++cc) {
    int tl_ = threadIdx.x; OPAQUE(tl_);
    const int tid = tl_, lane = tl_ & 63;
    const int sgi = cc >= NC_CTX;
    const int row0 = sgi ? NCTX + b * SEQ : b * CTXL;
    const int len = sgi ? SEQ : CTXL;
    const int cl = (sgi ? cc - NC_CTX : cc) * 64;
    if (tid < 64) {
      int p = cl + tid;
      sRow[tid] = row0 + (d ? len - 1 - p : p);
      float la;
      if (MLSTM) { la = -softplusf_(-(R.g1 + gb1)); sG[tid] = fexp(R.g0 + gb0); }
      else { float dt = softplusf_(R.g0 + gb0); la = -dt * alog_e; sG[tid] = dt; }
      sBc[tid] = wave_incl_scan(la);
    }
    __syncthreads();
    const float blast = sBc[63];
    lsum += blast;
    if (MLSTM) {
#pragma unroll
      for (int i = 0; i < 2; ++i) {
        int c = tid + i * 256, r = c >> 3, cc8 = (c & 7) * 8;
        float kf[8]; unpack8(R.k[i], kf);
        const float wgt = fexp(blast - sBc[r]) * sG[r];
#pragma unroll
        for (int j = 0; j < 8; ++j) sKT[(cc8 + j) * 72 + r] = f2bf(kf[j] * wgt);
        if (FULL) {
          float qf[8]; unpack8(R.q[i], qf);
#pragma unroll
          for (int j = 0; j < 8; ++j) qf[j] *= 0.125f;
          *(u32x4*)(sQ + r * QS + cc8) = pack8(qf);
          *(u32x4*)(sK + r * QS + cc8) = R.k[i];
        }
      }
#pragma unroll
      for (int i = 0; i < 4; ++i) {
        int c = tid + i * 256, r = c >> 4, cc8 = (c & 15) * 8;
        const bf16_t* xs = (const bf16_t*)&R.x[i];
#pragma unroll
        for (int j = 0; j < 8; ++j) sXT[(cc8 + j) * 72 + r] = xs[j];
      }
    } else {
#pragma unroll
      for (int i = 0; i < 2; ++i) {
        int c = tid + i * 256, r = c >> 3, cc8 = (c & 7) * 8;
        const bf16_t* xs = (const bf16_t*)&R.x[i];
#pragma unroll
        for (int j = 0; j < 8; ++j) sXT[(cc8 + j) * 72 + r] = xs[j];
      }
#pragma unroll
      for (int i = 0; i < 4; ++i) {
        int c = tid + i * 256, r = c >> 4, cc8 = (c & 15) * 8;
        float kf[8]; unpack8(R.k[i], kf);
        const float wgt = fexp(blast - sBc[r]) * sG[r];
#pragma unroll
        for (int j = 0; j < 8; ++j) sKT[(cc8 + j) * 72 + r] = f2bf(kf[j] * wgt);
        if (FULL) {
          *(u32x4*)(sK + r * QS + cc8) = R.k[i];
          *(u32x4*)(sQ + r * QS + cc8) = i < 2 ? R.q[i] : R.x[i];
        }
      }
    }
    if (cc + 1 < cc1) la_load_raw<MLSTM, FULL>(P, b, h, d, cc + 1, R);
    __syncthreads();
    if (FULL) {
      const int tr = (wave >> 1) * 32, tc = (wave & 1) * 32;
      f32x16 accP;
#pragma unroll
      for (int r = 0; r < 16; ++r) accP[r] = 0.f;
      if (!(tr == 0 && tc == 32)) {
#pragma unroll
        for (int kk = 0; kk < DK / 16; ++kk) {
          const int ko = kk * 16 + 8 * (lane >> 5);
          bf16x8 a = *(const bf16x8*)(sQ + (tr + (lane & 31)) * QS + ko);
          bf16x8 bb = *(const bf16x8*)(sK + (tc + (lane & 31)) * QS + ko);
          accP = mfma32(a, bb, accP);
        }
      }
      __syncthreads();
      {
        const int s = tc + (lane & 31);
        const float bs = sBc[s], gs = sG[s];
#pragma unroll
        for (int r = 0; r < 16; ++r) {
          int t = tr + acc_row(r, lane);
          float v = (s <= t) ? accP[r] * fexp(sBc[t] - bs) * gs : 0.f;
          sP[t * 72 + s] = f2bf(v);
        }
        {
          const int t = tid >> 2, kq = (tid & 3) * (DK / 4);
          const float et = fexp(sBc[t]);
#pragma unroll
          for (int c8 = 0; c8 < DK / 4; c8 += 8) {
            float qf[8];
            unpack8(*(const u32x4*)(sQ + t * QS + kq + c8), qf);
#pragma unroll
            for (int j = 0; j < 8; ++j) qf[j] *= et;
            *(u32x4*)(sQ + t * QS + kq + c8) = pack8(qf);
          }
        }
      }
      __syncthreads();
      constexpr int NYT = MLSTM ? 2 : 1;
      const int yx0 = MLSTM ? wave * 32 : (wave >> 1) * 32;
      const int yt0 = MLSTM ? 0 : (wave & 1) * 32;
      f32x16 accY[NYT];
#pragma unroll
      for (int j = 0; j < NYT; ++j)
#pragma unroll
        for (int r = 0; r < 16; ++r) accY[j][r] = 0.f;
#pragma unroll
      for (int kk = 0; kk < 4; ++kk) {
        const int ko = kk * 16 + 8 * (lane >> 5);
        bf16x8 a = *(const bf16x8*)(sXT + (yx0 + (lane & 31)) * 72 + ko);
#pragma unroll
        for (int j = 0; j < NYT; ++j) {
          bf16x8 bb = *(const bf16x8*)(sP + (yt0 + j * 32 + (lane & 31)) * 72 + ko);
          accY[j] = mfma32(a, bb, accY[j]);
        }
      }
#pragma unroll
      for (int kk = 0; kk < DK / 16; ++kk) {
        const int ko = kk * 16 + 8 * (lane >> 5);
        bf16x8 a = *(const bf16x8*)(sST + (yx0 + (lane & 31)) * QS + ko);
#pragma unroll
        for (int j = 0; j < NYT; ++j) {
          bf16x8 bb = *(const bf16x8*)(sQ + (yt0 + j * 32 + (lane & 31)) * QS + ko);
          accY[j] = mfma32(a, bb, accY[j]);
        }
      }
      if (MLSTM) {
        const int t = tid >> 2, q4 = (tid & 3) * 16;
        float pf[16], qf[16];
        unpack8(*(const u32x4*)(sP + t * 72 + q4), pf); unpack8(*(const u32x4*)(sP + t * 72 + q4 + 8), pf + 8);
        unpack8(*(const u32x4*)(sQ + t * QS + q4), qf); unpack8(*(const u32x4*)(sQ + t * QS + q4 + 8), qf + 8);
        float den = 0.f;
#pragma unroll
        for (int j = 0; j < 16; ++j) den += pf[j] + sN[q4 + j] * qf[j];
        den = sum4(den);
        if ((tid & 3) == 0) sDen[t] = den;
        __syncthreads();
      }
#pragma unroll
      for (int j = 0; j < NYT; ++j) {
        const int t = yt0 + j * 32 + (lane & 31);
        const size_t obase = (size_t)sRow[t] * 1024 + d * 512 + h * DX;
        const float dinv = MLSTM ? frcp(fmaxf(fabsf(sDen[t]), 1.f)) : 1.f;
#pragma unroll
        for (int g = 0; g < 4; ++g) {
          const int x0 = yx0 + 8 * g + 4 * (lane >> 5);
          float v0 = accY[j][4 * g], v1 = accY[j][4 * g + 1], v2 = accY[j][4 * g + 2], v3 = accY[j][4 * g + 3];
          if (MLSTM) { v0 *= dinv; v1 *= dinv; v2 *= dinv; v3 *= dinv; }
          else if (d == 0) {
            v0 += dskip * bf2f(sXT[(x0 + 0) * 72 + t]); v1 += dskip * bf2f(sXT[(x0 + 1) * 72 + t]);
            v2 += dskip * bf2f(sXT[(x0 + 2) * 72 + t]); v3 += dskip * bf2f(sXT[(x0 + 3) * 72 + t]);
          }
          u32x2 pk; pk.x = pack2(v0, v1); pk.y = pack2(v2, v3);
          *(u32x2*)(outb + obase + x0) = pk;
        }
      }
      __syncthreads();
    }
    {
      const float eb = fexp(blast);
#pragma unroll
      for (int j = 0; j < 2; ++j)
#pragma unroll
        for (int r = 0; r < 16; ++r) accS[j][r] *= eb;
#pragma unroll
      for (int kk = 0; kk < 4; ++kk) {
        const int ko = kk * 16 + 8 * (lane >> 5);
        bf16x8 a = *(const bf16x8*)(sXT + (sx0 + (lane & 31)) * 72 + ko);
#pragma unroll
        for (int j = 0; j < 2; ++j) {
          bf16x8 bb = *(const bf16x8*)(sKT + (sk0 + j * 32 + (lane & 31)) * 72 + ko);
          accS[j] = mfma32(a, bb, accS[j]);
        }
      }
      if (FULL) {
#pragma unroll
        for (int j = 0; j < 2; ++j)
#pragma unroll
          for (int r = 0; r < 16; ++r) sST[(sx0 + acc_row(r, lane)) * QS + sk0 + j * 32 + (lane & 31)] = f2bf(accS[j][r]);
      }
      if (MLSTM) {
        const int k = tid >> 2, q4 = (tid & 3) * 16;
        float kf[16];
        unpack8(*(const u32x4*)(sKT + k * 72 + q4), kf); unpack8(*(const u32x4*)(sKT + k * 72 + q4 + 8), kf + 8);
        float ps = 0.f;
#pragma unroll
        for (int j = 0; j < 16; ++j) ps += kf[j];
        nreg = nreg * eb + sum4(ps);
        if (FULL && (tid & 3) == 0) sN[k] = nreg;
      }
    }
    __syncthreads();
  }
  if (!FULL) {
    const size_t it = (size_t)gsid * LA_NSEG + seg;
    float* U = segU + it * 8192;
#pragma unroll
    for (int j = 0; j < 2; ++j)
#pragma unroll
      for (int r = 0; r < 16; ++r) U[(j * 16 + r) * 256 + tid] = accS[j][r];
    if (MLSTM && (tid & 3) == 0) segN[it * 64 + (tid >> 2)] = nreg;
    if (tid == 0) segD[it] = lsum;
  }
}

DEV void st_finish_l0(const Params& P, int row) {
  const int lane = threadIdx.x & 63;
  bf16_t* hb = (bf16_t*)(P.ws + OFF_HBUF) + (size_t)row * 1024;
  const bf16_t* yb = (const bf16_t*)(P.ws + OFF_R2L0) + (size_t)row * 1024;
  const bf16_t* pr = (const bf16_t*)(P.ws + OFF_PROJ) + (size_t)row * EVC;
  const int ch = lane * 8;
  float h0[8], h1[8], o[8], f1[8];
  unpack8(*(const u32x4*)(hb + ch), h0);
  unpack8(*(const u32x4*)(hb + 512 + ch), h1);
  unpack8(*(const u32x4*)(pr + 1024 + ch), o);
  float ss = 0.f;
#pragma unroll
  for (int j = 0; j < 8; ++j) { h0[j] += h1[j]; ss += h0[j] * h0[j]; }
  ss = sum16(ss);
  float rstd = frsq(ss * (1.f / 128.f) + 1e-6f);
  float pw[8]; ld8(P.in[I_MNORM] + ch, pw);
#pragma unroll
  for (int j = 0; j < 8; ++j) f1[j] = h0[j] * rstd * pw[j] * sigmoidf_(o[j]);
  float y0[8], y1[8], z[8], f2[8];
  unpack8(*(const u32x4*)(yb + ch), y0);
  unpack8(*(const u32x4*)(yb + 512 + ch), y1);
  unpack8(*(const u32x4*)(pr + 1552 + ch), z);
  float s2 = 0.f;
#pragma unroll
  for (int j = 0; j < 8; ++j) { y0[j] = (y0[j] + y1[j]) * siluf_(z[j]); s2 += y0[j] * y0[j]; }
  s2 = wave_sum(s2);
  float rstd2 = frsq(s2 * (1.f / 512.f) + 1e-6f);
  ld8(P.in[I_SNORM] + ch, pw);
#pragma unroll
  for (int j = 0; j < 8; ++j) f2[j] = y0[j] * rstd2 * pw[j];
  *(u32x4*)(hb + ch) = pack8(f1);
  *(u32x4*)(hb + 512 + ch) = pack8(f2);
}

DEV float mixval(const bf16_t* __restrict__ proj, int row, int c, const float* __restrict__ mu) {
  float self = bf2f(proj[(size_t)row * ODC + c]);
  int nrow = -1;
  if (row < NCTX) {
    int pos = row % CTXL;
    if (c < 896) { if (pos > 0) nrow = row - 1; }
    else { if (pos < CTXL - 1) nrow = row + 1; }
  } else {
    int pos = (row - NCTX) % SEQ;
    int gx = pos % GW, gy = pos / GW, q = c / 448;
    if (q == 0) { if (gx > 0) nrow = row - 1; }
    else if (q == 1) { if (gx < GW - 1) nrow = row + 1; }
    else if (q == 2) { if (gy > 0) nrow = row - GW; }
    else { if (gy < SEQ / GW - 1) nrow = row + GW; }
  }
  float nb = nrow >= 0 ? bf2f(proj[(size_t)nrow * ODC + c]) : 0.f;
  return self + mu[c] * (nb - self);
}

DEV int nbr_row(int row, int c) {
  if (row < NCTX) {
    int pos = row % CTXL;
    if (c < 896) return pos > 0 ? row - 1 : -1;
    return pos < CTXL - 1 ? row + 1 : -1;
  }
  int pos = (row - NCTX) % SEQ;
  int gx = pos % GW, gy = pos / GW, q = c / 448;
  if (q == 0) return gx > 0 ? row - 1 : -1;
  if (q == 1) return gx < GW - 1 ? row + 1 : -1;
  if (q == 2) return gy > 0 ? row - GW : -1;
  return gy < SEQ / GW - 1 ? row + GW : -1;
}

DEV void mix8(const bf16_t* __restrict__ proj, int row, int c, const float* __restrict__ mu, float* o) {
  float xs[8], xn[8];
  unpack8(*(const u32x4*)(proj + (size_t)row * ODC + c), xs);
  const int nr = nbr_row(row, c);
  if (nr >= 0) unpack8(*(const u32x4*)(proj + (size_t)nr * ODC + c), xn);
  else {
#pragma unroll
    for (int j = 0; j < 8; ++j) xn[j] = 0.f;
  }
  const f32x4 m0 = *(const f32x4*)(mu + c), m1 = *(const f32x4*)(mu + c + 4);
  const float mm[8] = {m0.x, m0.y, m0.z, m0.w, m1.x, m1.y, m1.z, m1.w};
#pragma unroll
  for (int j = 0; j < 8; ++j) o[j] = xs[j] + mm[j] * (xn[j] - xs[j]);
}

DEV void st_lora_act(const Params& P, int row2) {
  const int lane = threadIdx.x & 63;
  const int row = row2 + (lane >> 5), c = (lane & 31) * 8;
  const bf16_t* proj = (const bf16_t*)(P.ws + OFF_PROJ);
  bf16_t* hb = (bf16_t*)(P.ws + OFF_HBUF) + (size_t)row * 1024;
  float v[8];
  mix8(proj, row, 1536 + c, P.in[I_MU], v);
#pragma unroll
  for (int j = 0; j < 8; ++j) v[j] = c < 64 ? tanhf_(v[j]) : (c < 128 ? v[j] : sigmoidf_(v[j]));
  *(u32x4*)(hb + c) = pack8(v);
}

DEV void st_rwkv_stream(const Params& P, int sid, unsigned char* smem) {
  const int tid = threadIdx.x, lane = tid & 63, wave = tid >> 6;
  const int d = sid & 1, h = (sid >> 1) & 7, b = sid >> 4;
  float* sR = (float*)smem;
  float* sW = sR + 2048;
  float* sKk = sW + 2048;
  float* sV = sKk + 2048;
  float* sA = sV + 2048;
  float* sBb = sA + 2048;
  float* sY = sBb + 2048;
  int* sRow = (int*)(sY + 2048);
  const bf16_t* proj = (const bf16_t*)(P.ws + OFF_PROJ);
  const bf16_t* lora = (const bf16_t*)(P.ws + OFF_LORA);
  bf16_t* yout = (bf16_t*)(P.ws + OFF_HBUF);
  const float* mu = P.in[I_MU];
  const int vrow = tid >> 2, j4 = tid & 3;
  float S[16];
#pragma unroll
  for (int i = 0; i < 16; ++i) S[i] = 0.f;
  const float kkw = P.in[I_KK][h * 64 + lane], kaw = P.in[I_KA][h * 64 + lane];
  for (int seg = 0; seg < 2; ++seg) {
    const int row0 = seg == 0 ? b * CTXL : NCTX + b * SEQ;
    const int len = seg == 0 ? CTXL : SEQ;
    for (int it = 0; it < len / 32; ++it) {
      __syncthreads();
      for (int s = wave; s < 32; s += 4) {
        int p = it * 32 + s, pos = d ? len - 1 - p : p, row = row0 + pos;
        int c = h * 64 + lane;
        float r = mixval(proj, row, c, mu);
        float k = mixval(proj, row, 512 + c, mu);
        float v = mixval(proj, row, 1024 + c, mu);
        float kk = k * kkw;
        float ss = wave_sum(kk * kk);
        kk *= frsq(ss + 1e-12f);
        float lw = bf2f(lora[((size_t)d * NTOK + row) * 512 + c]);
        float la = bf2f(lora[((size_t)(2 + d) * NTOK + row) * 512 + c]);
        float w = fexp(-0.6065306597126334f * sigmoidf_(lw));
        float a = sigmoidf_(la);
        float kt = k * (1.f + (a - 1.f) * kaw);
        sR[s * 64 + lane] = r; sW[s * 64 + lane] = w; sKk[s * 64 + lane] = kt; sV[s * 64 + lane] = v;
        sA[s * 64 + lane] = -kk; sBb[s * 64 + lane] = kk * a;
        if (lane == 0) sRow[s] = row;
      }
      __syncthreads();
      for (int s = 0; s < 32; ++s) {
        const float* pa = sA + s * 64 + j4 * 16;
        const float* pw = sW + s * 64 + j4 * 16;
        const float* pk = sKk + s * 64 + j4 * 16;
        const float* pb = sBb + s * 64 + j4 * 16;
        const float* pr = sR + s * 64 + j4 * 16;
        const float vv = sV[s * 64 + vrow];
        float sa = 0.f;
#pragma unroll
        for (int i = 0; i < 16; ++i) sa += S[i] * pa[i];
        sa = sum4(sa);
        float y = 0.f;
#pragma unroll
        for (int i = 0; i < 16; ++i) { S[i] = S[i] * pw[i] + sa * pb[i] + vv * pk[i]; y += S[i] * pr[i]; }
        y = sum4(y);
        if (j4 == 0) sY[s * 64 + vrow] = y;
      }
      __syncthreads();
      for (int i = tid; i < 2048; i += 256) {
        int s = i >> 6, c = i & 63;
        yout[(size_t)sRow[s] * 1024 + d * 512 + h * 64 + c] = f2bf(sY[i]);
      }
    }
  }
}


struct RwkvRaw { u32x4 rs, rn, ks, kn, vs, vn, lw, la; int row; };

DEV void rwkv_load_raw(const bf16_t* __restrict__ proj, const bf16_t* __restrict__ lora, int b, int h, int d, int cc, int t, int c0,
                       RwkvRaw& R) {
  constexpr int NC_CTX = CTXL / 32;
  const int seg = cc >= NC_CTX;
  const int row0 = seg ? NCTX + b * SEQ : b * CTXL;
  const int len = seg ? SEQ : CTXL;
  const int p = (seg ? cc - NC_CTX : cc) * 32 + t;
  const int row = row0 + (d ? len - 1 - p : p);
  const int col = h * 64 + c0;
  const u32x4 z4 = {0u, 0u, 0u, 0u};
  const bf16_t* rp = proj + (size_t)row * ODC;
  R.row = row;
  R.rs = *(const u32x4*)(rp + col);
  R.ks = *(const u32x4*)(rp + 512 + col);
  R.vs = *(const u32x4*)(rp + 1024 + col);
  int n0 = nbr_row(row, col), n1 = nbr_row(row, 512 + col), n2 = nbr_row(row, 1024 + col);
  R.rn = n0 >= 0 ? *(const u32x4*)(proj + (size_t)n0 * ODC + col) : z4;
  R.kn = n1 >= 0 ? *(const u32x4*)(proj + (size_t)n1 * ODC + 512 + col) : z4;
  R.vn = n2 >= 0 ? *(const u32x4*)(proj + (size_t)n2 * ODC + 1024 + col) : z4;
  R.lw = *(const u32x4*)(lora + ((size_t)d * NTOK + row) * 512 + col);
  R.la = *(const u32x4*)(lora + ((size_t)(2 + d) * NTOK + row) * 512 + col);
}

#ifndef RW_NSEG
#define RW_NSEG 16
#endif
constexpr int RW_NCH = (CTXL + SEQ) / 32;
constexpr size_t OFF_RWSEG = OFF_PU;
static_assert((size_t)32 * RW_NSEG * 64 * 128 * 4 <= (size_t)2 * NEXP * 1024, "rwseg");

template <bool FULL>
DEV void st_rwkv_seg(const Params& P, int sid, int seg, unsigned char* smem) {
  constexpr int NVB = FULL ? 2 : 4;
  constexpr int ZR = FULL ? 64 : 128;
  const int tid = threadIdx.x, lane = tid & 63, wave = tid >> 6;
  const int d = sid & 1, h = (sid >> 1) & 7, b = sid >> 4;
  bf16_t* sAt = (bf16_t*)smem;
  bf16_t* sRt = sAt + 32 * 72;
  bf16_t* sBt = sRt + 32 * 72;
  bf16_t* sKt = sBt + 32 * 72;
  bf16_t* sBT = sKt + 32 * 72;
  bf16_t* sKT = sBT + 64 * 40;
  bf16_t* sVT = sKT + 64 * 40;
  bf16_t* sLak = sVT + 64 * 40;
  bf16_t* sM = sLak + 32 * 40;
  bf16_t* sLrb = sM + 32 * 40;
  bf16_t* sLrk = sLrb + 32 * 40;
  bf16_t* sZ = FULL ? sLrk + 32 * 40 : sLrb;
  bf16_t* after = sZ + ZR * 72;
  bf16_t* sRT = after;
  bf16_t* sSAT = FULL ? after + 64 * 40 : sRt;
  float* sLP = (float*)(FULL ? after + 2 * 64 * 40 : after + 128 * 40);
  float* sLab = sLP + 4 * 64;
  float* sD = sLab + 32 * 36;
  float* sPT = sD + 768;
  int* sRow = (int*)(sPT + 64);
  static_assert((4 * 32 * 72 + 3 * 64 * 40 + 4 * 32 * 40 + 2 * 64 * 40 + 64 * 72) * 2 + (4 * 64 + 32 * 36 + 768 + 64 + 32 + 320) * 4 + 16 <= SMEM_BYTES, "lds full");
  static_assert((4 * 32 * 72 + 3 * 64 * 40 + 2 * 32 * 40 + 128 * 72 + 128 * 40) * 2 + (4 * 64 + 32 * 36 + 768 + 64 + 32 + 320) * 4 + 16 <= SMEM_BYTES, "lds p1");
  static_assert(128 * 40 <= 3 * 32 * 72, "alias");
  const bf16_t* proj = (const bf16_t*)(P.ws + OFF_PROJ);
  const bf16_t* lora = (const bf16_t*)(P.ws + OFF_LORA);
  bf16_t* yout = (bf16_t*)(P.ws + OFF_HBUF);
  float* segZ = (float*)(P.ws + OFF_RWSEG);
  const int t = tid >> 3, c0 = (tid & 7) * 8;
  const int hl = lane >> 5, l31 = lane & 31;
  float* sCst = (float*)(smem + SMEM_BYTES - 320 * 4 - 16);
  if (tid < 64) {
    sCst[tid] = P.in[I_MU][h * 64 + tid]; sCst[64 + tid] = P.in[I_MU][512 + h * 64 + tid]; sCst[128 + tid] = P.in[I_MU][1024 + h * 64 + tid];
    sCst[192 + tid] = P.in[I_KK][h * 64 + tid]; sCst[256 + tid] = P.in[I_KA][h * 64 + tid];
  }
  const int cc0 = (seg * RW_NCH) / RW_NSEG, cc1 = ((seg + 1) * RW_NCH) / RW_NSEG;
  RwkvRaw R;
  rwkv_load_raw(proj, lora, b, h, d, cc0, t, c0, R);
  f32x16 Zm[2];
#pragma unroll
  for (int j = 0; j < 2; ++j)
#pragma unroll
    for (int r = 0; r < 16; ++r) Zm[j][r] = 0.f;
  __syncthreads();
  for (int i = tid; i < ZR * 72; i += 256) sZ[i] = 0;
  __syncthreads();
  if (!FULL) {
    if (wave >= 2) {
#pragma unroll
      for (int cb = 0; cb < 2; ++cb)
#pragma unroll
        for (int r = 0; r < 16; ++r) {
          int c = cb * 32 + acc_row(r, lane), vp = wave * 32 + l31;
          if (c == vp - 64) { Zm[cb][r] = 1.f; sZ[vp * 72 + c] = 0x3f80; }
        }
    }
  } else {
    for (int js = 0; js < seg; ++js) {
      const float* Zs = segZ + ((size_t)sid * RW_NSEG + js) * 64 * 128;
      bf16_t* sG = sAt;
      {
        const int c = tid >> 2, c2 = (tid & 3) * 16;
        float gv[16];
        ld8(Zs + c * 128 + 64 + c2, gv); ld8(Zs + c * 128 + 64 + c2 + 8, gv + 8);
        *(u32x4*)(sG + c * 72 + c2) = pack8(gv);
        *(u32x4*)(sG + c * 72 + c2 + 8) = pack8(gv + 8);
      }
      __syncthreads();
      if (wave >= 2) {
        const int cb = wave - 2;
#pragma unroll
        for (int vb = 0; vb < 2; ++vb) {
          f32x16 acc;
#pragma unroll
          for (int r = 0; r < 16; ++r) acc[r] = Zs[(cb * 32 + acc_row(r, lane)) * 128 + vb * 32 + l31];
#pragma unroll
          for (int kk = 0; kk < 4; ++kk) {
            bf16x8 a = *(const bf16x8*)(sG + (cb * 32 + l31) * 72 + kk * 16 + 8 * hl);
            bf16x8 bb = *(const bf16x8*)(sZ + (vb * 32 + l31) * 72 + kk * 16 + 8 * hl);
            acc = mfma32(a, bb, acc);
          }
          Zm[vb] = acc;
        }
      }
      __syncthreads();
      if (wave >= 2) {
        const int cb = wave - 2;
#pragma unroll
        for (int vb = 0; vb < 2; ++vb)
#pragma unroll
          for (int g = 0; g < 4; ++g) {
            u32x2 pk; pk.x = pack2(Zm[vb][4 * g], Zm[vb][4 * g + 1]); pk.y = pack2(Zm[vb][4 * g + 2], Zm[vb][4 * g + 3]);
            *(u32x2*)(sZ + (vb * 32 + l31) * 72 + cb * 32 + 8 * g + 4 * hl) = pk;
          }
      }
      __syncthreads();
    }
  }
  for (int cc = cc0; cc < cc1; ++cc) {
    int tl_ = threadIdx.x; OPAQUE(tl_);
    const int tid = tl_, lane = tl_ & 63, hl = lane >> 5, l31 = lane & 31, t = tl_ >> 3, c0 = (tl_ & 7) * 8;
    const float* muR = sCst + c0; const float* muK = sCst + 64 + c0; const float* muV = sCst + 128 + c0;
    const float* kkw = sCst + 192 + c0; const float* kaw = sCst + 256 + c0;
    float lw8[8], lp8[8];
    {
      float lwf[8];
      unpack8(R.lw, lwf);
#pragma unroll
      for (int j = 0; j < 8; ++j) { lw8[j] = lwf[j]; lp8[j] = lw8[j]; }
#pragma unroll
      for (int off = 8; off < 64; off <<= 1) {
#pragma unroll
        for (int j = 0; j < 8; ++j) {
#ifdef CPU_EMU
          float o = emu_shfl_up(lp8[j], off);
#else
          float o = __shfl_up(lp8[j], off, 64);
#endif
          if (lane >= off) lp8[j] += o;
        }
      }
      if (lane >= 56) {
#pragma unroll
        for (int j = 0; j < 8; ++j) sLP[wave * 64 + c0 + j] = lp8[j];
      }
      if ((tid & 7) == 0) sRow[t] = R.row;
    }
    __syncthreads();
    {
#pragma unroll
      for (int j = 0; j < 8; ++j) {
        float offs = 0.f;
        for (int w2 = 0; w2 < wave; ++w2) offs += sLP[w2 * 64 + c0 + j];
        lp8[j] += offs;
      }
      if (t == 31) {
#pragma unroll
        for (int j = 0; j < 8; ++j) sPT[c0 + j] = fexp(lp8[j]);
      }
    }
    {
      float xs[8], xn[8], kt[8], aa[8], ob[8], ok[8];
      unpack8(R.ks, xs); unpack8(R.kn, xn);
      float ss = 0.f;
#pragma unroll
      for (int j = 0; j < 8; ++j) { kt[j] = xs[j] + muK[j] * (xn[j] - xs[j]); aa[j] = kt[j] * kkw[j]; ss += aa[j] * aa[j]; }
      ss = sum8(ss);
      const float rn = frsq(ss + 1e-12f);
      float laf[8];
      unpack8(R.la, laf);
#pragma unroll
      for (int j = 0; j < 8; ++j) {
        const float lp = lp8[j];
        const float lpm = lp8[j] - lw8[j];
        const float e = fexp(-lp);
        const float kkn = aa[j] * rn;
        const float asg = laf[j];
        aa[j] = -kkn * fexp(lpm);
        ob[j] = kkn * asg * e;
        ok[j] = kt[j] * (1.f + (asg - 1.f) * kaw[j]) * e;
      }
      *(u32x4*)(sAt + t * 72 + c0) = pack8(aa);
      *(u32x4*)(sBt + t * 72 + c0) = pack8(ob);
      *(u32x4*)(sKt + t * 72 + c0) = pack8(ok);
#pragma unroll
      for (int j = 0; j < 8; ++j) { sBT[(c0 + j) * 40 + t] = f2bf(ob[j]); sKT[(c0 + j) * 40 + t] = f2bf(ok[j]); }
      unpack8(R.vs, xs); unpack8(R.vn, xn);
#pragma unroll
      for (int j = 0; j < 8; ++j) sVT[(c0 + j) * 40 + t] = f2bf(xs[j] + muV[j] * (xn[j] - xs[j]));
      if (FULL) {
        unpack8(R.rs, xs); unpack8(R.rn, xn);
#pragma unroll
        for (int j = 0; j < 8; ++j) xs[j] = (xs[j] + muR[j] * (xn[j] - xs[j])) * fexp(lp8[j]);
        *(u32x4*)(sRt + t * 72 + c0) = pack8(xs);
      }
    }
    if (cc + 1 < cc1) rwkv_load_raw(proj, lora, b, h, d, cc + 1, t, c0, R);
    __syncthreads();
    if (FULL || wave < 2) {
      const bf16_t* Asrc = wave < 2 ? sAt : sRt;
      const bf16_t* Bsrc = (wave & 1) ? sKt : sBt;
      f32x16 acc;
#pragma unroll
      for (int r = 0; r < 16; ++r) acc[r] = 0.f;
#pragma unroll
      for (int kk = 0; kk < 4; ++kk) {
        bf16x8 a = *(const bf16x8*)(Asrc + l31 * 72 + kk * 16 + 8 * hl);
        bf16x8 bb = *(const bf16x8*)(Bsrc + l31 * 72 + kk * 16 + 8 * hl);
        acc = mfma32(a, bb, acc);
      }
      bf16_t* dst = wave == 1 ? sLak : (wave == 2 ? sLrb : sLrk);
#pragma unroll
      for (int r = 0; r < 16; ++r) {
        int tt = acc_row(r, lane), j = l31;
        bool keep = wave < 2 ? (j < tt) : (j <= tt);
        float v = keep ? acc[r] : 0.f;
        if (wave == 0) sLab[tt * 36 + j] = v;
        else dst[tt * 40 + j] = f2bf(v);
      }
    }
    __syncthreads();
    auto rhs_block = [&](int vb) {
      f32x16 acc;
#pragma unroll
      for (int r = 0; r < 16; ++r) acc[r] = 0.f;
#pragma unroll
      for (int kk = 0; kk < 4; ++kk) {
        bf16x8 a = *(const bf16x8*)(sAt + l31 * 72 + kk * 16 + 8 * hl);
        bf16x8 bb = *(const bf16x8*)(sZ + (vb * 32 + l31) * 72 + kk * 16 + 8 * hl);
        acc = mfma32(a, bb, acc);
      }
      if (vb < 2) {
#pragma unroll
        for (int kk = 0; kk < 2; ++kk) {
          bf16x8 a = *(const bf16x8*)(sLak + l31 * 40 + kk * 16 + 8 * hl);
          bf16x8 bb = *(const bf16x8*)(sVT + (vb * 32 + l31) * 40 + kk * 16 + 8 * hl);
          acc = mfma32(a, bb, acc);
        }
      }
#pragma unroll
      for (int g = 0; g < 4; ++g) {
        u32x2 pk; pk.x = pack2(acc[4 * g], acc[4 * g + 1]); pk.y = pack2(acc[4 * g + 2], acc[4 * g + 3]);
        *(u32x2*)(sRT + (vb * 32 + l31) * 40 + 8 * g + 4 * hl) = pk;
      }
    };
    if (wave == 0) {
      if (tid < 32) {
        const int q = tid >> 4, c = tid & 15;
        const float* Lq = sLab + (q * 16) * 36 + q * 16;
        float x[16];
#pragma unroll
        for (int i = 0; i < 16; ++i) {
          float s0 = (i == c) ? 1.f : 0.f, s1 = 0.f;
#pragma unroll
          for (int j4 = 0; j4 < i; j4 += 4) {
            const f32x4 l4 = *(const f32x4*)(Lq + i * 36 + j4);
            s0 += l4.x * x[j4];
            if (j4 + 1 < i) s1 += l4.y * x[j4 + 1];
            if (j4 + 2 < i) s0 += l4.z * x[j4 + 2];
            if (j4 + 3 < i) s1 += l4.w * x[j4 + 3];
          }
          x[i] = s0 + s1;
          sD[q * 256 + i * 16 + c] = x[i];
        }
      }
    } else if (FULL) {
      if (wave >= 2) rhs_block(wave - 2);
    } else {
      if (wave == 1) { rhs_block(0); rhs_block(1); }
      else rhs_block(wave);
    }
    __syncthreads();
    {
      const int i = tid >> 4, c = tid & 15;
      float sacc = 0.f;
#pragma unroll
      for (int j4 = 0; j4 < 16; j4 += 4) {
        const f32x4 l4 = *(const f32x4*)(sLab + (16 + i) * 36 + j4);
        sacc += l4.x * sD[j4 * 16 + c] + l4.y * sD[(j4 + 1) * 16 + c] + l4.z * sD[(j4 + 2) * 16 + c] + l4.w * sD[(j4 + 3) * 16 + c];
      }
      sD[512 + i * 16 + c] = sacc;
    }
    __syncthreads();
    {
      const int i = tid >> 4, c = tid & 15;
      float sacc = 0.f;
#pragma unroll
      for (int j4 = 0; j4 < 16; j4 += 4) {
        const f32x4 d4 = *(const f32x4*)(sD + 256 + i * 16 + j4);
        sacc += d4.x * sD[512 + j4 * 16 + c] + d4.y * sD[512 + (j4 + 1) * 16 + c] + d4.z * sD[512 + (j4 + 2) * 16 + c] + d4.w * sD[512 + (j4 + 3) * 16 + c];
      }
      sM[(16 + i) * 40 + c] = f2bf(sacc);
      sM[i * 40 + c] = f2bf(sD[i * 16 + c]);
      sM[(16 + i) * 40 + 16 + c] = f2bf(sD[256 + i * 16 + c]);
      sM[i * 40 + 16 + c] = 0;
    }
    __syncthreads();
    if (wave < NVB) {
      const int vb = wave;
      f32x16 acc;
#pragma unroll
      for (int r = 0; r < 16; ++r) acc[r] = 0.f;
#pragma unroll
      for (int kk = 0; kk < 2; ++kk) {
        bf16x8 a = *(const bf16x8*)(sM + l31 * 40 + kk * 16 + 8 * hl);
        bf16x8 bb = *(const bf16x8*)(sRT + (vb * 32 + l31) * 40 + kk * 16 + 8 * hl);
        acc = mfma32(a, bb, acc);
      }
#pragma unroll
      for (int g = 0; g < 4; ++g) {
        u32x2 pk; pk.x = pack2(acc[4 * g], acc[4 * g + 1]); pk.y = pack2(acc[4 * g + 2], acc[4 * g + 3]);
        *(u32x2*)(sSAT + (vb * 32 + l31) * 40 + 8 * g + 4 * hl) = pk;
      }
    }
    __syncthreads();
    if (FULL) {
      if (wave < 2) {
        const int vb = wave;
        f32x16 acc;
#pragma unroll
        for (int r = 0; r < 16; ++r) acc[r] = 0.f;
#pragma unroll
        for (int kk = 0; kk < 4; ++kk) {
          bf16x8 a = *(const bf16x8*)(sZ + (vb * 32 + l31) * 72 + kk * 16 + 8 * hl);
          bf16x8 bb = *(const bf16x8*)(sRt + l31 * 72 + kk * 16 + 8 * hl);
          acc = mfma32(a, bb, acc);
        }
#pragma unroll
        for (int kk = 0; kk < 2; ++kk) {
          bf16x8 a = *(const bf16x8*)(sSAT + (vb * 32 + l31) * 40 + kk * 16 + 8 * hl);
          bf16x8 bb = *(const bf16x8*)(sLrb + l31 * 40 + kk * 16 + 8 * hl);
          acc = mfma32(a, bb, acc);
        }
#pragma unroll
        for (int kk = 0; kk < 2; ++kk) {
          bf16x8 a = *(const bf16x8*)(sVT + (vb * 32 + l31) * 40 + kk * 16 + 8 * hl);
          bf16x8 bb = *(const bf16x8*)(sLrk + l31 * 40 + kk * 16 + 8 * hl);
          acc = mfma32(a, bb, acc);
        }
        {
          const size_t obase = (size_t)sRow[l31] * 1024 + d * 512 + h * 64 + vb * 32;
#pragma unroll
          for (int g = 0; g < 4; ++g) {
            u32x2 pk; pk.x = pack2(acc[4 * g], acc[4 * g + 1]); pk.y = pack2(acc[4 * g + 2], acc[4 * g + 3]);
            *(u32x2*)(yout + obase + 8 * g + 4 * hl) = pk;
          }
        }
      } else {
        const int cb = wave - 2;
#pragma unroll
        for (int vb = 0; vb < 2; ++vb) {
          f32x16 acc;
#pragma unroll
          for (int r = 0; r < 16; ++r) acc[r] = 0.f;
#pragma unroll
          for (int kk = 0; kk < 2; ++kk) {
            bf16x8 a = *(const bf16x8*)(sBT + (cb * 32 + l31) * 40 + kk * 16 + 8 * hl);
            bf16x8 bb = *(const bf16x8*)(sSAT + (vb * 32 + l31) * 40 + kk * 16 + 8 * hl);
            acc = mfma32(a, bb, acc);
          }
#pragma unroll
          for (int kk = 0; kk < 2; ++kk) {
            bf16x8 a = *(const bf16x8*)(sKT + (cb * 32 + l31) * 40 + kk * 16 + 8 * hl);
            bf16x8 bb = *(const bf16x8*)(sVT + (vb * 32 + l31) * 40 + kk * 16 + 8 * hl);
            acc = mfma32(a, bb, acc);
          }
#pragma unroll
          for (int r = 0; r < 16; ++r) Zm[vb][r] = sPT[cb * 32 + acc_row(r, lane)] * (Zm[vb][r] + acc[r]);
        }
      }
      __syncthreads();
      if (wave >= 2) {
        const int cb = wave - 2;
#pragma unroll
        for (int vb = 0; vb < 2; ++vb)
#pragma unroll
          for (int g = 0; g < 4; ++g) {
            u32x2 pk; pk.x = pack2(Zm[vb][4 * g], Zm[vb][4 * g + 1]); pk.y = pack2(Zm[vb][4 * g + 2], Zm[vb][4 * g + 3]);
            *(u32x2*)(sZ + (vb * 32 + l31) * 72 + cb * 32 + 8 * g + 4 * hl) = pk;
          }
      }
    } else {
      const int vb = wave;
#pragma unroll
      for (int cb = 0; cb < 2; ++cb) {
        f32x16 acc;
#pragma unroll
        for (int r = 0; r < 16; ++r) acc[r] = 0.f;
#pragma unroll
        for (int kk = 0; kk < 2; ++kk) {
          bf16x8 a = *(const bf16x8*)(sBT + (cb * 32 + l31) * 40 + kk * 16 + 8 * hl);
          bf16x8 bb = *(const bf16x8*)(sSAT + (vb * 32 + l31) * 40 + kk * 16 + 8 * hl);
          acc = mfma32(a, bb, acc);
        }
        if (vb < 2) {
#pragma unroll
          for (int kk = 0; kk < 2; ++kk) {
            bf16x8 a = *(const bf16x8*)(sKT + (cb * 32 + l31) * 40 + kk * 16 + 8 * hl);
            bf16x8 bb = *(const bf16x8*)(sVT + (vb * 32 + l31) * 40 + kk * 16 + 8 * hl);
            acc = mfma32(a, bb, acc);
          }
        }
#pragma unroll
        for (int r = 0; r < 16; ++r) Zm[cb][r] = sPT[cb * 32 + acc_row(r, lane)] * (Zm[cb][r] + acc[r]);
      }
#pragma unroll
      for (int cb = 0; cb < 2; ++cb)
#pragma unroll
        for (int g = 0; g < 4; ++g) {
          u32x2 pk; pk.x = pack2(Zm[cb][4 * g], Zm[cb][4 * g + 1]); pk.y = pack2(Zm[cb][4 * g + 2], Zm[cb][4 * g + 3]);
          *(u32x2*)(sZ + (vb * 32 + l31) * 72 + cb * 32 + 8 * g + 4 * hl) = pk;
        }
    }
  }
  if (!FULL) {
    float* Zs = segZ + ((size_t)sid * RW_NSEG + seg) * 64 * 128;
#pragma unroll
    for (int cb = 0; cb < 2; ++cb)
#pragma unroll
      for (int r = 0; r < 16; ++r) Zs[(cb * 32 + acc_row(r, lane)) * 128 + wave * 32 + l31] = Zm[cb][r];
  }
}

constexpr int LRU_NCH = (CTXL + SEQ) / 64;
constexpr size_t OFF_ACUM0 = OFF_PU;
static_assert((size_t)NLAT * 512 * 2 <= (size_t)2 * NEXP * 1024, "acum0");

struct LruRaw { u32x4 x[2][4]; };
DEV void lru_load_raw(const Params& P, int sid, int cc, LruRaw& R) {
  constexpr int NC_CTX = CTXL / 64;
  const int tid = threadIdx.x;
  const int d = sid & 1, blk = (sid >> 1) & 7, b = sid >> 4;
  const bf16_t* proj = (const bf16_t*)(P.ws + OFF_PROJ);
  const int sgi = cc >= NC_CTX;
  const int row0 = sgi ? NCTX + b * SEQ : b * CTXL;
  const int len = sgi ? SEQ : CTXL;
  const int cl = (sgi ? cc - NC_CTX : cc) * 64;
  const int lch = blk * 64 + (tid & 7) * 8;
  const u32x4 z4 = {0u, 0u, 0u, 0u};
#pragma unroll
  for (int i = 0; i < 2; ++i) {
    int c = tid + i * 256, r = c >> 3;
    int p = cl + r, pos = d ? len - 1 - p : p;
#pragma unroll
    for (int tap = 0; tap < 4; ++tap) {
      int pp = pos + tap - 2;
      R.x[i][tap] = (pp >= 0 && pp < len) ? *(const u32x4*)(proj + (size_t)(row0 + pp) * ODC + 2304 + lch) : z4;
    }
  }
}

DEV void st_lru_chunk(const Params& P, int sid, int cc, int nsid, int ncc, bool has_next, LruRaw& R, unsigned char* smem) {
  constexpr int NC_CTX = CTXL / 64;
  const int tid = threadIdx.x, lane = tid & 63, wave = tid >> 6;
  const int d = sid & 1, blk = (sid >> 1) & 7, b = sid >> 4;
  float* sXc = (float*)smem;
  float* sAc = sXc + 4096;
  float* sBc = sAc + 4096;
  float* sU = sBc + 4096;
  bf16_t* sAop = (bf16_t*)(sU + 4096);
  float* sQA = (float*)(sAop + 64 * 72);
  float* sQH = sQA + 256;
  int* sRow = (int*)(sQH + 256);
  const bf16_t* proj = (const bf16_t*)(P.ws + OFF_PROJ);
  bf16_t* uout = (bf16_t*)(P.ws + OFF_LORA) + (size_t)d * NTOK * 512;
  bf16_t* aout = (bf16_t*)(P.ws + (d ? OFF_ACUM1 : OFF_ACUM0));
  const bf16_t* lruT = (const bf16_t*)(P.ws + OFF_LRUT) + (size_t)(d * 8 + blk) * 128 * 64;
  float* chunkS = (float*)(P.ws + OFF_LRUCS) + ((size_t)sid * LRU_NCH + cc) * 128;
  const float* cw = P.in[I_LCONVW];
  const float* cb = P.in[I_LCONVB];
  const int tr = (wave >> 1) * 32, nc0 = (wave & 1) * 64;
  const int sgi = cc >= NC_CTX;
  const int row0 = sgi ? NCTX + b * SEQ : b * CTXL;
  const int len = sgi ? SEQ : CTXL;
  const int cl = (sgi ? cc - NC_CTX : cc) * 64;
  __syncthreads();
  if (tid < 64) { int p = cl + tid; sRow[tid] = row0 + (d ? len - 1 - p : p); }
  {
    const int lc8 = (tid & 7) * 8, lch = blk * 64 + lc8;
#pragma unroll
    for (int i = 0; i < 2; ++i) {
      int c = tid + i * 256, r = c >> 3;
      int p = cl + r, pos = d ? len - 1 - p : p;
      float o[8];
      f32x4 c0 = *(const f32x4*)(cb + lch), c1 = *(const f32x4*)(cb + lch + 4);
      o[0] = c0.x; o[1] = c0.y; o[2] = c0.z; o[3] = c0.w; o[4] = c1.x; o[5] = c1.y; o[6] = c1.z; o[7] = c1.w;
#pragma unroll
      for (int tap = 0; tap < 4; ++tap) {
        float x[8];
        unpack8(R.x[i][tap], x);
        f32x4 w0 = *(const f32x4*)(cw + tap * 512 + lch), w1 = *(const f32x4*)(cw + tap * 512 + lch + 4);
        o[0] += w0.x * x[0]; o[1] += w0.y * x[1]; o[2] += w0.z * x[2]; o[3] += w0.w * x[3];
        o[4] += w1.x * x[4]; o[5] += w1.y * x[5]; o[6] += w1.z * x[6]; o[7] += w1.w * x[7];
      }
#pragma unroll
      for (int j = 0; j < 8; ++j) sXc[r * 64 + lc8 + j] = o[j];
      *(u32x4*)(sAop + r * 72 + lc8) = pack8(o);
    }
  }
  if (has_next) lru_load_raw(P, nsid, ncc, R);
  __syncthreads();
  {
    f32x16 acc[2];
#pragma unroll
    for (int j = 0; j < 2; ++j)
#pragma unroll
      for (int r = 0; r < 16; ++r) acc[j][r] = 0.f;
#pragma unroll
    for (int kk = 0; kk < 4; ++kk) {
      bf16x8 a = *(const bf16x8*)(sAop + (tr + (lane & 31)) * 72 + kk * 16 + 8 * (lane >> 5));
#pragma unroll
      for (int j = 0; j < 2; ++j) {
        bf16x8 bb = *(const bf16x8*)(lruT + (nc0 + j * 32 + (lane & 31)) * 64 + kk * 16 + 8 * (lane >> 5));
        acc[j] = mfma32(a, bb, acc[j]);
      }
    }
#pragma unroll
    for (int j = 0; j < 2; ++j) {
      const int e = nc0 + j * 32 + (lane & 31);
      const int ch = blk * 64 + (e & 63);
      const float ebias = e < 64 ? P.in[I_BA][d * 512 + ch] : P.in[I_BI][d * 512 + ch];
      const float esp = softplusf_(-P.in[I_LAM][d * 512 + ch]);
#pragma unroll
      for (int r = 0; r < 16; ++r) {
        int t = tr + acc_row(r, lane);
        float g = sigmoidf_(acc[j][r] + ebias);
        if (e < 64) { float a_ = fexp(-8.f * g * esp); sAc[t * 64 + e] = a_; sU[t * 64 + e] = fsqrt(fmaxf(1.f - a_ * a_, 0.f)); }
        else sBc[t * 64 + (e - 64)] = g * sXc[t * 64 + (e - 64)];
      }
    }
  }
  __syncthreads();
  const int c = tid & 63, q = tid >> 6;
  {
    float h = 0.f, ap = 1.f;
#pragma unroll 4
    for (int i = 0; i < 16; ++i) {
      const int t = q * 16 + i;
      const float a = sAc[t * 64 + c];
      h = a * h + sU[t * 64 + c] * sBc[t * 64 + c];
      ap *= a;
      sU[t * 64 + c] = h; sAc[t * 64 + c] = ap;
    }
    sQA[q * 64 + c] = ap; sQH[q * 64 + c] = h;
  }
  __syncthreads();
  {
    float hin = 0.f, ain = 1.f;
    for (int q2 = 0; q2 < q; ++q2) { hin = sQA[q2 * 64 + c] * hin + sQH[q2 * 64 + c]; ain *= sQA[q2 * 64 + c]; }
    if (q > 0) {
#pragma unroll 4
      for (int i = 0; i < 16; ++i) {
        const int t = q * 16 + i;
        const float ap = sAc[t * 64 + c];
        sU[t * 64 + c] += ap * hin;
        sAc[t * 64 + c] = ap * ain;
      }
    }
    if (q == 3) { chunkS[c] = sAc[63 * 64 + c]; chunkS[64 + c] = sU[63 * 64 + c]; }
  }
  __syncthreads();
  if (sgi) {
#pragma unroll
    for (int i = 0; i < 2; ++i) {
      int cidx = tid + i * 256, r = cidx >> 3, c8 = (cidx & 7) * 8;
      float u8[8], a8[8];
#pragma unroll
      for (int j = 0; j < 8; ++j) { u8[j] = sU[r * 64 + c8 + j]; a8[j] = sAc[r * 64 + c8 + j]; }
      const int row = sRow[r];
      *(u32x4*)(uout + (size_t)row * 512 + blk * 64 + c8) = pack8(u8);
      *(u32x4*)(aout + (size_t)(row - NCTX) * 512 + blk * 64 + c8) = pack8(a8);
    }
  }
}

DEV void st_lru_carry(const Params& P, int sid) {
  const int c = threadIdx.x;
  if (c >= 64) return;
  const float* cs = (const float*)(P.ws + OFF_LRUCS) + (size_t)sid * LRU_NCH * 128;
  float* hs = (float*)(P.ws + OFF_LRUHS) + (size_t)sid * LRU_NCH * 64;
  float h = 0.f;
  for (int cc0 = 0; cc0 < LRU_NCH; cc0 += 10) {
    float a[10], bb[10];
#pragma unroll
    for (int i = 0; i < 10; ++i) { a[i] = cs[(size_t)(cc0 + i) * 128 + c]; bb[i] = cs[(size_t)(cc0 + i) * 128 + 64 + c]; }
#pragma unroll
    for (int i = 0; i < 10; ++i) { hs[(size_t)(cc0 + i) * 64 + c] = h; h = a[i] * h + bb[i]; }
  }
}

DEV void st_finish_l1(const Params& P, int row) {
  const int lane = threadIdx.x & 63;
  bf16_t* hb = (bf16_t*)(P.ws + OFF_HBUF) + (size_t)row * 1024;
  const bf16_t* proj = (const bf16_t*)(P.ws + OFF_PROJ);
  const bf16_t* lora = (const bf16_t*)(P.ws + OFF_LORA);
  const float* mu = P.in[I_MU];
  const int ch = lane * 8;
  float y0[8], y1[8];
  unpack8(*(const u32x4*)(hb + ch), y0);
  unpack8(*(const u32x4*)(hb + 512 + ch), y1);
  float sm = 0.f;
#pragma unroll
  for (int j = 0; j < 8; ++j) { y0[j] += y1[j]; sm += y0[j]; }
  sm = sum8(sm);
  const float mean = sm * (1.f / 64.f);
  float sv = 0.f;
#pragma unroll
  for (int j = 0; j < 8; ++j) { float dlt = y0[j] - mean; sv += dlt * dlt; }
  sv = sum8(sv);
  const float rstd = frsq(sv * (1.f / 64.f) + 64e-5f);
  float a0[8], a1[8], g[8], u0[8], u1[8], gb[8];
  unpack8(*(const u32x4*)(lora + ((size_t)2 * NTOK + row) * 512 + ch), a0);
  unpack8(*(const u32x4*)(lora + ((size_t)3 * NTOK + row) * 512 + ch), a1);
  unpack8(*(const u32x4*)(lora + ((size_t)4 * NTOK + row) * 512 + ch), g);
  unpack8(*(const u32x4*)(lora + ((size_t)0 * NTOK + row) * 512 + ch), u0);
  unpack8(*(const u32x4*)(lora + ((size_t)1 * NTOK + row) * 512 + ch), u1);
  if (row >= NCTX) {
    const int bb_ = (row - NCTX) / SEQ, pos = (row - NCTX) % SEQ, blk = ch >> 6;
    float ac[8];
#pragma unroll
    for (int dd = 0; dd < 2; ++dd) {
      const int pidx = dd ? SEQ - 1 - pos : pos;
      const int cc = CTXL / 64 + pidx / 64;
      const int sid = (bb_ * 8 + blk) * 2 + dd;
      const float* hs = (const float*)(P.ws + OFF_LRUHS) + ((size_t)sid * LRU_NCH + cc) * 64 + (ch & 63);
      unpack8(*(const u32x4*)((const bf16_t*)(P.ws + (dd ? OFF_ACUM1 : OFF_ACUM0)) + (size_t)(row - NCTX) * 512 + ch), ac);
      f32x4 h0 = *(const f32x4*)hs, h1 = *(const f32x4*)(hs + 4);
      float* u = dd ? u1 : u0;
      u[0] += ac[0] * h0.x; u[1] += ac[1] * h0.y; u[2] += ac[2] * h0.z; u[3] += ac[3] * h0.w;
      u[4] += ac[4] * h1.x; u[5] += ac[5] * h1.y; u[6] += ac[6] * h1.z; u[7] += ac[7] * h1.w;
    }
  }
  unpack8(*(const u32x4*)(proj + (size_t)row * ODC + 1792 + ch), gb);
  float rv[8], vv[8], kv[8];
  float sdot = 0.f;
  float pka[8], prk[8], plw[8], plb[8];
  ld8(P.in[I_KA] + ch, pka); ld8(P.in[I_RK] + ch, prk); ld8(P.in[I_LNW] + ch, plw); ld8(P.in[I_LNB] + ch, plb);
  mix8(proj, row, ch, mu, rv);
  mix8(proj, row, 512 + ch, mu, kv);
  mix8(proj, row, 1024 + ch, mu, vv);
#pragma unroll
  for (int j = 0; j < 8; ++j) {
    float r = rv[j];
    float k = kv[j];
    float am = 0.5f * (a0[j] + a1[j]);
    float kb = k * (1.f + (am - 1.f) * pka[j]);
    sdot += r * kb * prk[j];
    rv[j] = r;
  }
  sdot = sum8(sdot);
  float f1[8], f2[8];
#pragma unroll
  for (int j = 0; j < 8; ++j) {
    float yn = (y0[j] - mean) * rstd * plw[j] + plb[j];
    yn += sdot * vv[j];
    f1[j] = yn * g[j];
    f2[j] = (u0[j] + u1[j]) * geluf_(gb[j]);
  }
  *(u32x4*)(hb + ch) = pack8(f1);
  *(u32x4*)(hb + 512 + ch) = pack8(f2);
}

DEV unsigned fkey(float f) { unsigned u; __builtin_memcpy(&u, &f, 4); return (u >> 31) ? ~u : (u | 0x80000000u); }
DEV float keyf(unsigned u) { u = (u >> 31) ? (u & 0x7fffffffu) : ~u; float f; __builtin_memcpy(&f, &u, 4); return f; }
DEV void key_insert(unsigned x, unsigned* v) {
#pragma unroll
  for (int j = 0; j < 16; ++j) { unsigned hi = v[j] > x ? v[j] : x; x = v[j] > x ? x : v[j]; v[j] = hi; }
}
DEV void key_cx(unsigned& hi, unsigned& lo) { unsigned a = hi, b = lo; hi = a > b ? a : b; lo = a > b ? b : a; }
DEV void key_sort16(unsigned* v) {
#pragma unroll
  for (int k = 2; k <= 16; k <<= 1)
#pragma unroll
    for (int j = k >> 1; j > 0; j >>= 1)
#pragma unroll
      for (int i = 0; i < 16; ++i) {
        const int l = i ^ j;
        if (l > i) { if ((i & k) == 0) key_cx(v[i], v[l]); else key_cx(v[l], v[i]); }
      }
}
DEV void key_merge16(unsigned* a, const unsigned* b) {
#pragma unroll
  for (int i = 0; i < 16; ++i) a[i] = a[i] > b[15 - i] ? a[i] : b[15 - i];
#pragma unroll
  for (int j = 8; j > 0; j >>= 1)
#pragma unroll
    for (int i = 0; i < 16; ++i) { const int l = i ^ j; if (l > i) key_cx(a[i], a[l]); }
}

DEV void st_peer_topk(const Params& P, int layer, int tile, int h, unsigned char* smem) {
  const int tid = threadIdx.x;
  const bf16_t* q = (const bf16_t*)(P.ws + OFF_Q);
  const bf16_t* keys = (const bf16_t*)(P.ws + OFF_KEYS) + (size_t)(layer * 8 + h) * 2 * 128 * 128;
  float* sS = (float*)smem;
  const int m0 = tile * 128;
  const int tok = tid & 127, half = tid >> 7;
  unsigned kl[2][16];
#pragma unroll
  for (int p = 0; p < 2; ++p) {
    EpiScoreLds epi{sS, m0};
    gemm_tile_128<true>(q + (h * 2 + p) * 128, 2048, NTOK, keys + p * 128 * 128, 128, 128, 128, m0, 0, epi, smem);
    __syncthreads();
    float* row = sS + tok * 129 + half * 64;
#pragma unroll
    for (int g = 0; g < 4; ++g) {
      unsigned grp[16];
#pragma unroll
      for (int j = 0; j < 16; ++j) grp[j] = (fkey(row[g * 16 + j]) & ~127u) | (unsigned)(127 - (half * 64 + g * 16 + j));
      key_sort16(grp);
      if (g == 0) {
#pragma unroll
        for (int j = 0; j < 16; ++j) kl[p][j] = grp[j];
      } else key_merge16(kl[p], grp);
    }
    if (half == 1) {
#pragma unroll
      for (int j = 0; j < 16; ++j) row[j] = __builtin_bit_cast(float, kl[p][j]);
    }
    __syncthreads();
    if (half == 0) {
      unsigned oth[16];
#pragma unroll
      for (int j = 0; j < 16; ++j) oth[j] = __builtin_bit_cast(unsigned, sS[tok * 129 + 64 + j]);
      key_merge16(kl[p], oth);
    }
    __syncthreads();
  }
  if (tid < 128) {
    float sv0[16], sv1[16];
    int* irow = (int*)(sS + tid * 129);
#pragma unroll
    for (int j = 0; j < 16; ++j) {
      sv0[j] = keyf((kl[0][j] & ~127u) | 64u); sv1[j] = keyf((kl[1][j] & ~127u) | 64u);
      irow[j] = 127 - (int)(kl[0][j] & 127u); irow[16 + j] = 127 - (int)(kl[1][j] & 127u);
    }
    unsigned best[16];
#pragma unroll
    for (int j = 0; j < 16; ++j) best[j] = 0u;
#pragma unroll
    for (int i = 0; i < 16; ++i)
#pragma unroll
      for (int j = 0; j < 16; ++j)
        if ((i + 1) * (j + 1) <= 16) key_insert((fkey(sv0[i] + sv1[j]) & ~255u) | (unsigned)(255 - (i * 16 + j)), best);
    float e[16], sum = 0.f;
    const float b0 = keyf((best[0] & ~255u) | 128u);
#pragma unroll
    for (int j = 0; j < 16; ++j) { e[j] = fexp(keyf((best[j] & ~255u) | 128u) - b0); sum += e[j]; }
    const float inv = 1.f / sum;
    int* pidx = (int*)(P.ws + OFF_PIDX) + (size_t)(m0 + tid) * 128 + h * 16;
    float* pg = (float*)(P.ws + OFF_PGATE) + (size_t)(m0 + tid) * 128 + h * 16;
#pragma unroll
    for (int j = 0; j < 16; ++j) {
      const int pos = 255 - (int)(best[j] & 255u);
      pidx[j] = irow[pos >> 4] * 128 + irow[16 + (pos & 15)];
      pg[j] = e[j] * inv;
    }
  }
}

DEV void st_peer_experts(const Params& P, int layer, int row) {
  const int lane = threadIdx.x & 63;
  const bf16_t* xb = (const bf16_t*)(P.ws + OFF_HBUF) + (size_t)row * 1024;
  const unsigned char* U = P.ws + OFF_PU;
  const int* pidx = (const int*)(P.ws + OFF_PIDX) + (size_t)row * 128;
  const float* pg = (const float*)(P.ws + OFF_PGATE) + (size_t)row * 128;
  float x[16], acc[16];
  unpack8(*(const u32x4*)(xb + lane * 16), x);
  unpack8(*(const u32x4*)(xb + lane * 16 + 8), x + 8);
#pragma unroll
  for (int j = 0; j < 16; ++j) acc[j] = 0.f;
  const int b3 = (lane >> 3) & 1;
  const int mypick = (lane >> 3) & 7;
#ifdef CPU_EMU
#define PEER_SID(id) (id)
#else
#define PEER_SID(id) __builtin_amdgcn_readfirstlane(id)
#endif
  const unsigned lo12 = lane * 12, lo8 = PEER_VOFF + lane * 8;
#define PEER_LDU(i, id) do { const unsigned* up_ = (const unsigned*)(U + (size_t)(unsigned)(id) * PEER_ROWB + lo12); \
    uu[i].x = up_[0]; uu[i].y = up_[1]; uu[i].z = up_[2]; } while (0)
#define PEER_LDV(i, id) vv[i] = *(const u32x2*)(U + (size_t)(unsigned)(id) * PEER_ROWB + lo8)
#define PEER_IDS(v0, v1) {PEER_SID((int)v0.x), PEER_SID((int)v0.y), PEER_SID((int)v0.z), PEER_SID((int)v0.w), \
                          PEER_SID((int)v1.x), PEER_SID((int)v1.y), PEER_SID((int)v1.z), PEER_SID((int)v1.w)}
  u32x3 uu[8]; u32x2 vv[8];
  int cid[8];
  {
    const u32x4 p0 = *(const u32x4*)pidx, p1 = *(const u32x4*)(pidx + 4);
    const int id[8] = PEER_IDS(p0, p1);
#pragma unroll
    for (int i = 0; i < 8; ++i) { cid[i] = id[i]; PEER_LDU(i, id[i]); }
  }
  u32x4 n0 = *(const u32x4*)(pidx + 8), n1 = *(const u32x4*)(pidx + 12);
  float gcur = pg[mypick];
  for (int k0 = 0; k0 < 128; k0 += 8) {
#pragma unroll
    for (int i = 0; i < 8; ++i) PEER_LDV(i, cid[i]);
    const int nid[8] = PEER_IDS(n0, n1);
    {
      const int k2 = k0 + 16 < 128 ? k0 + 16 : 120;
      n0 = *(const u32x4*)(pidx + k2); n1 = *(const u32x4*)(pidx + k2 + 4);
    }
    const float gnxt = pg[(k0 + 8 < 128 ? k0 + 8 : 120) + mypick];
    float dsum[8];
#pragma unroll
    for (int i = 0; i < 8; i += 2) {
      float ufa[16], ufb[16];
#ifndef CPU_EMU
      __builtin_amdgcn_sched_barrier(0);
#endif
      unpack2x16_fp6(uu[i], uu[i + 1], ufa, ufb);
      PEER_LDU(i, nid[i]); PEER_LDU(i + 1, nid[i + 1]);
      typedef __attribute__((ext_vector_type(2))) float f32x2v;
      f32x2v da2 = {0.f, 0.f}, db2 = {0.f, 0.f};
#pragma unroll
      for (int j = 0; j < 8; ++j) {
        const f32x2v xx = {x[2 * j], x[2 * j + 1]};
        const f32x2v ua = {ufa[2 * j], ufa[2 * j + 1]}, ub = {ufb[2 * j], ufb[2 * j + 1]};
        da2 = xx * ua + da2; db2 = xx * ub + db2;
      }
      dsum[i] = da2.x + da2.y; dsum[i + 1] = db2.x + db2.y;
    }
    float e4[4], e2[2], g;
#pragma unroll
    for (int i = 0; i < 4; ++i) e4[i] = swap32_sum(dsum[i], dsum[4 + i]);
#pragma unroll
    for (int i = 0; i < 2; ++i) e2[i] = swap16_sum(e4[i], e4[2 + i]);
    {
      float mine = b3 ? e2[1] : e2[0], send = b3 ? e2[0] : e2[1];
      g = mine + dpp_xor<8>(send);
    }
    g = sum8(g);
    const float mycoef = gcur * geluf_(g * (1.f / PEER_USCALE));
#pragma unroll
    for (int i = 0; i < 8; ++i) {
      const float coef = wreadlane(mycoef, i * 8);
      float vf[16];
      unpack8_fp4(vv[i].x, vf); unpack8_fp4(vv[i].y, vf + 8);
#pragma unroll
      for (int j = 0; j < 16; ++j) acc[j] += coef * vf[j];
    }
#pragma unroll
    for (int i = 0; i < 8; ++i) cid[i] = nid[i];
    gcur = gnxt;
  }
#undef PEER_LDU
#undef PEER_LDV
#undef PEER_IDS
#undef PEER_SID
  float* xr = row < NCTX ? (float*)(P.ws + OFF_CTXRES) + (size_t)row * 1024 : P.out + (size_t)(row - NCTX) * 1024;
  const float* g2 = (const float*)(P.ws + OFF_MODV) + ((size_t)layer * 3 + mod_row(row)) * 6144 + 5 * 1024;
  float o[16];
#pragma unroll
  for (int q = 0; q < 4; ++q) {
    const int c = lane * 16 + q * 4;
    f32x4 a = *(const f32x4*)(xr + c), ga = *(const f32x4*)(g2 + c);
    o[q * 4 + 0] = a.x + ga.x * acc[q * 4 + 0] * (1.f / PEER_VSCALE); o[q * 4 + 1] = a.y + ga.y * acc[q * 4 + 1] * (1.f / PEER_VSCALE);
    o[q * 4 + 2] = a.z + ga.z * acc[q * 4 + 2] * (1.f / PEER_VSCALE); o[q * 4 + 3] = a.w + ga.w * acc[q * 4 + 3] * (1.f / PEER_VSCALE);
  }
  float ss = 0.f;
#pragma unroll
  for (int j = 0; j < 16; ++j) ss += o[j] * o[j];
  ss = wave_sum(ss);
  const float rstd = frsq(ss * (1.f / 1024.f) + 1e-6f);
  if (layer == 1) {
    float fn[16]; ld8(P.in[I_FNORM] + lane * 16, fn); ld8(P.in[I_FNORM] + lane * 16 + 8, fn + 8);
#pragma unroll
    for (int j = 0; j < 16; ++j) o[j] *= rstd * fn[j];
  }
#pragma unroll
  for (int q = 0; q < 4; ++q) {
    f32x4 a = {o[q * 4 + 0], o[q * 4 + 1], o[q * 4 + 2], o[q * 4 + 3]};
    *(f32x4*)(xr + lane * 16 + q * 4) = a;
  }
  if (layer == 0) {
    const float* mv = (const float*)(P.ws + OFF_MODV) + ((size_t)1 * 3 + mod_row(row)) * 6144;
    const float* nw = P.in[I_NORM1] + 1024;
    float hh[16];
#pragma unroll
    for (int q = 0; q < 4; ++q) {
      const int c = lane * 16 + q * 4;
      f32x4 w4 = *(const f32x4*)(nw + c), s4 = *(const f32x4*)(mv + 1024 + c), h4 = *(const f32x4*)(mv + c);
      hh[q * 4 + 0] = o[q * 4 + 0] * rstd * w4.x * (1.f + s4.x) + h4.x; hh[q * 4 + 1] = o[q * 4 + 1] * rstd * w4.y * (1.f + s4.y) + h4.y;
      hh[q * 4 + 2] = o[q * 4 + 2] * rstd * w4.z * (1.f + s4.z) + h4.z; hh[q * 4 + 3] = o[q * 4 + 3] * rstd * w4.w * (1.f + s4.w) + h4.w;
    }
    bf16_t* hb = (bf16_t*)(P.ws + OFF_HBUF) + (size_t)row * 1024 + lane * 16;
    *(u32x4*)hb = pack8(hh);
    *(u32x4*)(hb + 8) = pack8(hh + 8);
  }
}


#define FOR_TILES_XCD(MT0, MT1, NT, mt, nt)                                                     \
  for (int _x = blockIdx.x & 7, _mlo = (MT0) + (((MT1) - (MT0)) * _x) / 8,                        \
           _mhi = (MT0) + (((MT1) - (MT0)) * (_x + 1)) / 8, _i = blockIdx.x >> 3,                 \
           _cnt = (_mhi - _mlo) * (NT), mt = 0, nt = 0;                                           \
       _i < _cnt && ((mt = _mlo + _i / (NT)), (nt = _i % (NT)), true); _i += (int)(gridDim.x >> 3))

#ifndef PHASE_LIST
#define PHASE_LIST(X) X(0) X(1) X(2) X(22) X(23) X(3) X(4) X(5) X(6) X(7) X(8) X(9) X(11) X(12) X(13) X(30) X(14) X(15) X(31) X(16) X(17) X(18) X(19) X(20) X(21)
#endif
constexpr int PH_LAST = 21;

template <int ph>
DEV void run_phase(const Params& P, unsigned char* smem) {
  int bid_ = blockIdx.x, wave_ = threadIdx.x >> 6;
  OPAQUE_S(bid_); OPAQUE(wave_);
  const int bid = bid_, nb = gridDim.x;
  const int wave = wave_;
  unsigned char* ws = P.ws;
  constexpr int layer = ((ph >= 10 && ph <= 21) || ph >= 30) ? 1 : 0;
  const float* modv_l = (const float*)(ws + OFF_MODV) + (size_t)layer * 3 * 6144;
  switch (ph) {
    case 0:
      for (int t = NTRANS + bid; t < NPREP; t += nb) st_prep(P, t, smem);
      break;
    case 1: case 10:
      if (ph == 1) for (int t = nb - 1 - bid; t < NTRANS; t += nb) st_prep(P, t, smem);
      for (int t = bid; t < NTOK / 4; t += nb) st_normmod(P, layer, 0, t * 4 + wave);
      break;
    case 2: {
      EpiProjL0T epi{(bf16_t*)(ws + OFF_PROJ), (float*)(ws + OFF_GATES)};
      FOR_TILES_XCD(0, NTOK / 256, 25, mt, nt)
        gemm_tile_128x256<EpiProjL0T, true>((const bf16_t*)(ws + OFF_WEVIN), 1024, EVC, (const bf16_t*)(ws + OFF_HBUF), 1024, NTOK, 1024,
                                            nt * 128, mt * 256, epi, smem);
    } break;
    case 22:
      for (int t = bid; t < NTOK / 4; t += nb) st_xbc_conv(P, t * 4 + wave);
      for (int t = bid; t < NPCONV; t += nb) st_peer_conv(P, 0, t);
      break;
    case 23:
      for (int t = bid; t < 48 * LA_NSEG; t += nb) {
        int sid = t % 48, seg = t / 48;
        if (sid < 16) st_linattn_seg<true, false>(P, sid, seg, smem);
        else st_linattn_seg<false, false>(P, sid - 16, seg, smem);
      }
      break;
    case 3:
      for (int t = bid; t < 48 * LA_NSEG; t += nb) {
        int sid = t % 48, seg = t / 48;
        if (sid < 16) st_linattn_seg<true, true>(P, sid, seg, smem);
        else st_linattn_seg<false, true>(P, sid - 16, seg, smem);
      }
      break;
    case 4:
      for (int t = bid; t < NTOK / 4; t += nb) st_finish_l0(P, t * 4 + wave);
      break;
    case 5: case 17: {
      EpiOutProjT epi{layer == 0 ? P.in[I_X] : P.out, P.in[I_CTX], P.out, (float*)(ws + OFF_CTXRES), modv_l};
      const bf16_t* Wt = (const bf16_t*)(ws + (layer == 0 ? OFF_WEVOUT : OFF_WODOUT));
      FOR_TILES_XCD(layer == 0 ? 0 : NCTX / 256, NTOK / 256, 8, mt, nt)
        gemm_tile_128x256<EpiOutProjT, true>(Wt, 1024, 1024, (const bf16_t*)(ws + OFF_HBUF), 1024, NTOK, 1024, nt * 128, mt * 256, epi, smem);
    } break;
    case 6: case 18: {
      const int r0 = layer == 0 ? 0 : NCTX / 4;
      for (int t = r0 + bid; t < NTOK / 4; t += nb) st_normmod(P, layer, 1, t * 4 + wave);
      if (ph == 18) for (int t = bid; t < NPCONV; t += nb) st_peer_conv(P, 1, t);
    } break;
    case 7: case 19: {
      EpiStoreBfT epi{(bf16_t*)(ws + OFF_Q), 2048};
      const bf16_t* Wt = (const bf16_t*)(ws + OFF_WQ) + (size_t)layer * 2048 * 1024;
      FOR_TILES_XCD(layer == 0 ? 0 : NCTX / 256, NTOK / 256, 16, mt, nt)
        gemm_tile_128x256<EpiStoreBfT, true>(Wt, 1024, 2048, (const bf16_t*)(ws + OFF_HBUF), 1024, NTOK, 1024, nt * 128, mt * 256, epi, smem);
    } break;
    case 8: case 20: {
      const int t0 = layer == 0 ? 0 : CTILE * 8;
      for (int t = t0 + bid; t < NTILE * 8; t += nb) st_peer_topk(P, layer, t / 8, t % 8, smem);
    } break;
    case 9: case 21: {
      const int r0 = layer == 0 ? 0 : NCTX / 4;
      for (int t = r0 + bid; t < NTOK / 4; t += nb) st_peer_experts(P, layer, t * 4 + wave);
    } break;
    case 11: {
      EpiStoreBfT epi{(bf16_t*)(ws + OFF_PROJ), ODC};
      FOR_TILES_XCD(0, NTOK / 256, 22, mt, nt)
        gemm_tile_128x256<EpiStoreBfT, true>((const bf16_t*)(ws + OFF_WODIN), 1024, ODC, (const bf16_t*)(ws + OFF_HBUF), 1024, NTOK, 1024,
                                             nt * 128, mt * 256, epi, smem);
    } break;
    case 12:
      for (int t = bid; t < NTOK / 8; t += nb) st_lora_act(P, t * 8 + wave * 2);
      break;
    case 13:
      for (int t = bid; t < NTILE * 20; t += nb) {
        int job = t / (NTILE * 4), tt = t % (NTILE * 4);
        int mt = tt / 4, nt = tt % 4;
        bf16_t* dst = (bf16_t*)(ws + OFF_LORA) + (size_t)job * NTOK * 512;
        const bf16_t* A = (const bf16_t*)(ws + OFF_HBUF) + (job < 2 ? 0 : (job < 4 ? 64 : 128));
        const bf16_t* Bt = job < 2 ? (const bf16_t*)(ws + OFF_WUP) + (size_t)job * 512 * 64
                         : job < 4 ? (const bf16_t*)(ws + OFF_AUP) + (size_t)(job - 2) * 512 * 64
                                   : (const bf16_t*)(ws + OFF_GUP);
        const float* bias = job < 2 ? P.in[I_W0] + job * 512 : (job < 4 ? P.in[I_A0] + (job - 2) * 512 : nullptr);
        const int K = job < 4 ? 64 : 128;
        EpiStoreBfBiasT epi{dst, 512, bias, job < 2 ? 1 : (job < 4 ? 2 : 0)};
        gemm_tile_128<false, EpiStoreBfBiasT, true>(Bt, K, 512, A, 1024, NTOK, K, nt * 128, mt * 128, epi, smem);
      }
      break;
    case 30:
      for (int t = bid; t < 32 * RW_NSEG; t += nb) st_rwkv_seg<false>(P, t % 32, t / 32, smem);
      break;
    case 14:
      for (int t = bid; t < 32 * RW_NSEG; t += nb) st_rwkv_seg<true>(P, t % 32, t / 32, smem);
      break;
    case 15:
      {
        LruRaw R;
        if (bid < 32 * LRU_NCH) lru_load_raw(P, bid % 32, bid / 32, R);
        for (int t = bid; t < 32 * LRU_NCH; t += nb) {
          const int tn = t + nb;
          st_lru_chunk(P, t % 32, t / 32, tn % 32, tn / 32, tn < 32 * LRU_NCH, R, smem);
        }
      }
      break;
    case 31:
      if (bid < 32) st_lru_carry(P, bid);
      break;
    case 16:
      for (int t = bid; t < NTOK / 4; t += nb) st_finish_l1(P, t * 4 + wave);
      break;
    default: break;
  }
}


#ifndef CPU_EMU
#define XB_TMO      128
#define XB_XCNT(j)  (256  + 64 * (j))
#define XB_XSUB(j)  (1280 + 64 * (j))
#define XB_XGEN(j)  (2304 + 64 * (j))
#define XB_TOP      3328
#define XB_TOPGEN   3392
#define XCD_BAR_WORDS 3456
#define XB_SPIN_CAP (1u << 20)
#define LAS __attribute__((address_space(3)))
__device__ __forceinline__ unsigned xb_ld(unsigned* p)              { return __hip_atomic_load(p, __ATOMIC_RELAXED, __HIP_MEMORY_SCOPE_AGENT); }
__device__ __forceinline__ unsigned xb_add(unsigned* p, unsigned v) { return __hip_atomic_fetch_add(p, v, __ATOMIC_RELAXED, __HIP_MEMORY_SCOPE_AGENT); }
__device__ __forceinline__ unsigned xb_xcc_id() { return (unsigned)__builtin_amdgcn_s_getreg((3 << 11) | 20) & 0xFu; }
#define XB_SPIN(cond, bar) do { unsigned _sp = 0; while (cond) { __builtin_amdgcn_s_sleep(1); \
    if ((++_sp & 255u) == 0u) { if (xb_ld(&(bar)[XB_TMO])) break; if (_sp > XB_SPIN_CAP) { atomicAdd(&(bar)[XB_TMO], 1u); break; } } } } while (0)
struct XcdBarrier { unsigned* bar; unsigned x; volatile LAS unsigned* st; };
__device__ __forceinline__ XcdBarrier xcd_barrier_post(unsigned* bar, volatile LAS unsigned* st) {
  XcdBarrier b; b.bar = bar; b.x = xb_xcc_id(); b.st = st;
  if (threadIdx.x == 0) (void)xb_add(&bar[XB_XCNT(b.x)], 1u);
  return b;
}
__device__ __forceinline__ void xcd_barrier_complete(unsigned* bar, unsigned x, unsigned& nloc, unsigned& nx) {
  const unsigned G = gridDim.x * gridDim.y * gridDim.z;
  unsigned sum, cnt, mine, sp = 0u;
  for (;;) {
    sum = 0u; cnt = 0u; mine = 0u;
#pragma unroll
    for (unsigned j = 0; j < 16; ++j) { const unsigned c = xb_ld(&bar[XB_XCNT(j)]); sum += c; cnt += (c > 0u) ? 1u : 0u; mine = (j == x) ? c : mine; }
    if (sum == G) break;
    __builtin_amdgcn_s_sleep(1);
    if ((++sp & 255u) == 0u) { if (xb_ld(&bar[XB_TMO])) break; if (sp > XB_SPIN_CAP) { atomicAdd(&bar[XB_TMO], 1u); break; } }
  }
  nloc = mine > 0u ? mine : 1u; nx = cnt > 0u ? cnt : 1u;
}
__device__ __forceinline__ void xcd_barrier(const XcdBarrier& b) {
  asm volatile("s_waitcnt vmcnt(0)" ::: "memory");
  __syncthreads();
  if (threadIdx.x == 0) {
    unsigned* bar = b.bar;
    __builtin_amdgcn_s_waitcnt(0);
    unsigned nloc = b.st[0], nx = b.st[1];
    if (nloc == 0u) { xcd_barrier_complete(bar, b.x, nloc, nx); b.st[0] = nloc; b.st[1] = nx; }
    const unsigned old = xb_add(&bar[XB_XSUB(b.x)], 1u);
    const unsigned gen = old / nloc;
    if (old + 1u == (gen + 1u) * nloc) {
      __builtin_amdgcn_fence(__ATOMIC_RELEASE, "agent");
      asm volatile("s_waitcnt vmcnt(0)" ::: "memory");
      const unsigned og = xb_add(&bar[XB_TOP], 1u);
      const unsigned tg = og / nx;
      if (og + 1u == (tg + 1u) * nx) xb_add(&bar[XB_TOPGEN], 1u);
      else XB_SPIN(xb_ld(&bar[XB_TOPGEN]) == tg, bar);
      __builtin_amdgcn_fence(__ATOMIC_ACQUIRE, "agent");
      xb_add(&bar[XB_XGEN(b.x)], 1u);
      asm volatile("s_waitcnt vmcnt(0)" ::: "memory");
    } else {
      XB_SPIN(xb_ld(&bar[XB_XGEN(b.x)]) == gen, bar);
      __builtin_amdgcn_fence(__ATOMIC_ACQUIRE, "agent");
      asm volatile("s_waitcnt vmcnt(0)" ::: "memory");
    }
  }
  __syncthreads();
}
#endif
#ifndef CPU_EMU
#define RUN_PH(n) run_phase<n>(P, smem_raw); if (n != PH_LAST) xcd_barrier(xb);
__global__ void __launch_bounds__(256, 2) mega_kernel(Params P) {
  SMEM_DECL;
  unsigned* bar = (unsigned*)(P.ws + OFF_BAR);
  volatile LAS unsigned* st = (volatile LAS unsigned*)(smem_raw + SMEM_BYTES - 16);
  if (threadIdx.x == 0) { st[0] = 0u; st[1] = 0u; }
  if (P.ws == nullptr) cg::this_grid().sync();
  __syncthreads();
  XcdBarrier xb = xcd_barrier_post(bar, st);
  PHASE_LIST(RUN_PH)
}

extern "C" void kernel_launch(void* const* d_in, const int* in_sizes, int n_in, void* d_out, int out_size, void* d_ws,
                              size_t ws_size, hipStream_t stream) {
  Params P{};
  for (int i = 0; i < N_IN; ++i) P.in[i] = (const float*)d_in[i];
  P.out = (float*)d_out;
  P.ws = (unsigned char*)d_ws;
  if (ws_size < WS_NEEDED) { fprintf(stderr, "workspace too small: %zu < %zu\n", ws_size, (size_t)WS_NEEDED); return; }
  static int grid_blocks = 0;
  if (!grid_blocks) {
    int dev = 0, cus = 0, per_cu = 0;
    hipGetDevice(&dev);
    hipDeviceGetAttribute(&cus, hipDeviceAttributeMultiprocessorCount, dev);
    hipOccupancyMaxActiveBlocksPerMultiprocessor(&per_cu, mega_kernel, 256, 0);
    if (per_cu > 2) per_cu = 2;
    grid_blocks = cus * per_cu;
  }
  (void)hipMemsetAsync((unsigned char*)d_ws + OFF_BAR, 0, 16384, stream);
  void* args[] = {&P};
  hipError_t e = hipLaunchCooperativeKernel((void*)mega_kernel, dim3(grid_blocks), dim3(256), args, 0, stream);
  if (e != hipSuccess) fprintf(stderr, "cooperative launch failed: %s (grid %d)\n", hipGetErrorString(e), grid_blocks);
}
#endif
```

```cpp
#ifdef CPU_EMU
#include "emu.h"
#else
#include <hip/hip_runtime.h>
#include <hip/hip_cooperative_groups.h>
#include <cstdio>
namespace cg = cooperative_groups;
#define DEV __device__ __forceinline__
#define DEVM __device__ __forceinline__
#define OPAQUE(x) asm volatile("" : "+v"(x))
#define OPAQUE_S(x) asm volatile("" : "+s"(x))
#endif

#ifndef SEQ_LEN
#define SEQ_LEN 16384
#endif
#ifndef CTX_LEN
#define CTX_LEN 256
#endif
#ifndef GRID_W_
#define GRID_W_ 64
#endif
#ifndef MULTI_LAUNCH
#define MULTI_LAUNCH 0
#endif

typedef unsigned short bf16_t;
typedef __attribute__((ext_vector_type(8))) short bf16x8;
typedef __attribute__((ext_vector_type(16))) float f32x16;
typedef __attribute__((ext_vector_type(4))) unsigned u32x4;
typedef __attribute__((ext_vector_type(2))) unsigned u32x2;
typedef __attribute__((ext_vector_type(4))) float f32x4;

constexpr int D = 1024, NB = 2, SEQ = SEQ_LEN, CTXL = CTX_LEN, GW = GRID_W_;
constexpr int NCTX = NB * CTXL, NLAT = NB * SEQ, NTOK = NCTX + NLAT;
constexpr int EVC = 3104, ODC = 2816;
constexpr int NEXP = 16384;
constexpr int NTILE = NTOK / 128, CTILE = NCTX / 128;
static_assert(NTOK % 256 == 0 && NCTX % 256 == 0, "tiles");
static_assert(CTXL % 64 == 0 && SEQ % 64 == 0 && SEQ % GW == 0, "chunks");

constexpr size_t al256(size_t x) { return (x + 255) & ~(size_t)255; }
constexpr size_t OFF_MODV = 0;
constexpr size_t OFF_CTXRES = OFF_MODV + al256(2 * 3 * 6144 * 4);
constexpr size_t OFF_GATES = OFF_CTXRES + al256((size_t)NCTX * 1024 * 4);
constexpr size_t OFF_WEVIN = OFF_GATES + al256((size_t)NTOK * 32 * 4);
constexpr size_t OFF_WEVOUT = OFF_WEVIN + al256((size_t)EVC * 1024 * 2);
constexpr size_t OFF_WODIN = OFF_WEVOUT + al256((size_t)1024 * 1024 * 2);
constexpr size_t OFF_WODOUT = OFF_WODIN + al256((size_t)ODC * 1024 * 2);
constexpr size_t OFF_WQ = OFF_WODOUT + al256((size_t)1024 * 1024 * 2);
constexpr size_t OFF_KEYS = OFF_WQ + al256((size_t)2 * 2048 * 1024 * 2);
constexpr size_t OFF_WUP = OFF_KEYS + al256((size_t)2 * 8 * 2 * 128 * 128 * 2);
constexpr size_t OFF_AUP = OFF_WUP + al256((size_t)2 * 512 * 64 * 2);
constexpr size_t OFF_GUP = OFF_AUP + al256((size_t)2 * 512 * 64 * 2);
constexpr size_t OFF_LRUT = OFF_GUP + al256((size_t)512 * 128 * 2);
constexpr size_t OFF_PU = OFF_LRUT + al256((size_t)2 * 8 * 128 * 64 * 2);
constexpr size_t OFF_PV = OFF_PU + al256((size_t)NEXP * 1024);
constexpr size_t OFF_HBUF = OFF_PV + al256((size_t)NEXP * 1024);
constexpr size_t OFF_PR = OFF_HBUF + al256((size_t)NTOK * 1024 * 2);
constexpr size_t PR_BYTES = (size_t)NTOK * 5376 * 2;
constexpr size_t OFF_BAR = OFF_PR + PR_BYTES;
constexpr size_t OFF_ACUM1 = OFF_BAR + 16384;
constexpr size_t OFF_LRUCS = OFF_ACUM1 + (size_t)NLAT * 512 * 2;
constexpr size_t OFF_LRUHS = OFF_LRUCS + (size_t)32 * ((CTXL + SEQ) / 64) * 128 * 4;
constexpr size_t WS_NEEDED = OFF_LRUHS + (size_t)32 * ((CTXL + SEQ) / 64) * 64 * 4;
#ifndef CPU_EMU
static_assert(WS_NEEDED <= (size_t)512 * 1024 * 1024, "workspace too large");
#endif
constexpr size_t OFF_PROJ = OFF_PR;
constexpr size_t OFF_R2L0 = OFF_PR + (size_t)NTOK * EVC * 2;
constexpr size_t OFF_LORA = OFF_PR + (size_t)NTOK * ODC * 2;
constexpr size_t OFF_Q = OFF_PR;
constexpr size_t OFF_PIDX = OFF_PR + (size_t)NTOK * 2048 * 2;
constexpr size_t OFF_PGATE = OFF_PIDX + (size_t)NTOK * 128 * 4;
static_assert(OFF_PGATE + (size_t)NTOK * 128 * 4 <= OFF_PR + PR_BYTES, "picks");

enum {
  I_X = 0, I_C, I_CTX, I_CCTX, I_MODW, I_MODB, I_NORM1, I_NORM2, I_WQ, I_KEYS, I_PU, I_PV,
  I_EVWIN, I_EVWOUT, I_IBIAS, I_FBIAS, I_MNORM, I_SCONVW, I_SCONVB, I_DTBIAS, I_ALOG, I_DSKIP, I_SNORM,
  I_ODWIN, I_ODWOUT, I_MU, I_W0, I_WUP, I_A0, I_AUP, I_GUP, I_KK, I_KA, I_RK, I_LNW, I_LNB,
  I_LCONVW, I_LCONVB, I_LAM, I_WA, I_BA, I_WI, I_BI, I_FNORM, N_IN
};

struct Params {
  const float* in[N_IN];
  float* out;
  unsigned char* ws;
};

constexpr int SMEM_BYTES = 80 * 1024;
#ifdef CPU_EMU
#define SMEM_DECL static thread_local __attribute__((aligned(16))) unsigned char smem_raw[SMEM_BYTES]
#else
#define SMEM_DECL __shared__ __attribute__((aligned(16))) unsigned char smem_raw[SMEM_BYTES]
#endif

DEV float bf2f(bf16_t v) { unsigned u = ((unsigned)v) << 16; float f; __builtin_memcpy(&f, &u, 4); return f; }
#ifdef CPU_EMU
DEV bf16_t f2bf(float f) { unsigned u; __builtin_memcpy(&u, &f, 4); u += 0x7fffu + ((u >> 16) & 1u); return (bf16_t)(u >> 16); }
DEV unsigned pack2(float a, float b) { return (unsigned)f2bf(a) | ((unsigned)f2bf(b) << 16); }
#else
typedef __attribute__((ext_vector_type(2))) float f32x2_t;
typedef __attribute__((ext_vector_type(2))) __bf16 bf16x2_t;
DEV unsigned pack2(float a, float b) { f32x2_t f = {a, b}; return __builtin_bit_cast(unsigned, __builtin_convertvector(f, bf16x2_t)); }
DEV bf16_t f2bf(float f) { return __builtin_bit_cast(unsigned short, (__bf16)f); }
#endif
DEV void unpack8(const u32x4& r, float* o) {
  unsigned w[4] = {r.x, r.y, r.z, r.w};
#pragma unroll
  for (int i = 0; i < 4; ++i) { unsigned lo = w[i] << 16, hi = w[i] & 0xffff0000u; __builtin_memcpy(&o[2 * i], &lo, 4); __builtin_memcpy(&o[2 * i + 1], &hi, 4); }
}
DEV u32x4 pack8(const float* o) { u32x4 r; r.x = pack2(o[0], o[1]); r.y = pack2(o[2], o[3]); r.z = pack2(o[4], o[5]); r.w = pack2(o[6], o[7]); return r; }
#ifdef CPU_EMU
DEV float fexp(float x) { return expf(x); }
DEV float frcp(float x) { return 1.f / x; }
DEV float flog(float x) { return logf(x); }
DEV float frsq(float x) { return 1.f / sqrtf(x); }
DEV float fsqrt(float x) { return sqrtf(x); }
#else
DEV float fexp(float x) { return __expf(x); }
DEV float frcp(float x) { return __builtin_amdgcn_rcpf(x); }
DEV float flog(float x) { return __logf(x); }
DEV float frsq(float x) { return __builtin_amdgcn_rsqf(x); }
DEV float fsqrt(float x) { return __builtin_amdgcn_sqrtf(x); }
#endif
DEV void ld8(const float* __restrict__ p, float* o) { const f32x4 a = *(const f32x4*)p, b = *(const f32x4*)(p + 4); o[0] = a.x; o[1] = a.y; o[2] = a.z; o[3] = a.w; o[4] = b.x; o[5] = b.y; o[6] = b.z; o[7] = b.w; }
DEV float sigmoidf_(float x) { return frcp(1.f + fexp(-x)); }
DEV float siluf_(float x) { return x * frcp(1.f + fexp(-x)); }
DEV float softplusf_(float x) { return fmaxf(x, 0.f) + flog(1.f + fexp(-fabsf(x))); }
DEV float tanhf_(float x) { return 1.f - 2.f * frcp(1.f + fexp(2.f * x)); }
DEV float geluf_(float x) { return 0.5f * x * (1.f + erff(x * 0.70710678118654752f)); }

DEV f32x16 mfma32(bf16x8 a, bf16x8 b, f32x16 c) {
#ifdef CPU_EMU
  return emu_mfma32(a, b, c);
#else
  return __builtin_amdgcn_mfma_f32_32x32x16_bf16(a, b, c, 0, 0, 0);
#endif
}
DEV float wshfl_xor(float v, int m) {
#ifdef CPU_EMU
  return emu_shfl_xor(v, m);
#else
  return __shfl_xor(v, m, 64);
#endif
}
template <int M> DEV float dpp_xor(float v) {
  static_assert(M == 1 || M == 2 || M == 7 || M == 8, "dpp pattern");
#ifdef CPU_EMU
  return emu_shfl_xor(v, M);
#else
  constexpr int ctrl = M == 1 ? 0xB1 : (M == 2 ? 0x4E : (M == 7 ? 0x141 : 0x128));
  return __int_as_float(__builtin_amdgcn_update_dpp(0, __float_as_int(v), ctrl, 0xf, 0xf, false));
#endif
}
DEV float sum8(float v) { v += dpp_xor<1>(v); v += dpp_xor<2>(v); v += dpp_xor<7>(v); return v; }
DEV float sum4(float v) { v += dpp_xor<1>(v); v += dpp_xor<2>(v); return v; }
DEV float sum16(float v) { v = sum8(v); v += dpp_xor<8>(v); return v; }
DEV float swap32_sum(float a, float b) {
#ifdef CPU_EMU
  float ra = emu_shfl_xor(a, 32), rb = emu_shfl_xor(b, 32);
  return ((threadIdx.x >> 5) & 1) ? b + rb : a + ra;
#else
  auto r = __builtin_amdgcn_permlane32_swap(__float_as_uint(a), __float_as_uint(b), false, false);
  return __uint_as_float(r[0]) + __uint_as_float(r[1]);
#endif
}
DEV float swap16_sum(float a, float b) {
#ifdef CPU_EMU
  float ra = emu_shfl_xor(a, 16), rb = emu_shfl_xor(b, 16);
  return ((threadIdx.x >> 4) & 1) ? b + rb : a + ra;
#else
  auto r = __builtin_amdgcn_permlane16_swap(__float_as_uint(a), __float_as_uint(b), false, false);
  return __uint_as_float(r[0]) + __uint_as_float(r[1]);
#endif
}
DEV float wave_sum(float v) {
  v = sum16(v);
  v = swap16_sum(v, v);
  return swap32_sum(v, v);
}
DEV float wave_incl_scan(float v) {
#ifdef CPU_EMU
  const int l = threadIdx.x & 63;
  for (int s = 1; s < 16; s <<= 1) { const bool ok = (l & 15) >= s; float o = emu_readlane(v, ok ? l - s : l); v += ok ? o : 0.f; }
  { const bool ok = ((l >> 4) & 1) != 0; float o = emu_readlane(v, ok ? (l & ~15) - 1 : l); v += ok ? o : 0.f; }
  { const bool ok = l >= 32; float o = emu_readlane(v, ok ? 31 : l); v += ok ? o : 0.f; }
  return v;
#else
#define DPP_ADD_(ctrl, rmask) v += __int_as_float(__builtin_amdgcn_update_dpp(0, __float_as_int(v), ctrl, rmask, 0xf, false))
  DPP_ADD_(0x111, 0xf); DPP_ADD_(0x112, 0xf); DPP_ADD_(0x114, 0xf); DPP_ADD_(0x118, 0xf);
  DPP_ADD_(0x142, 0xa); DPP_ADD_(0x143, 0xc);
#undef DPP_ADD_
  return v;
#endif
}

#ifdef CPU_EMU
static inline unsigned emu_f2fp8(float f) {
  unsigned sgn = f < 0.f ? 0x80u : 0u; float a = fabsf(f);
  if (!(a == a)) return 0x7f;
  if (a >= 448.f) return sgn | 0x7e;
  if (a < 0.0009765625f) return sgn;
  int e; frexpf(a, &e); e -= 1;
  if (e < -6) { int q = (int)nearbyintf(a * 512.f); return sgn | (unsigned)q; }
  float m = a / ldexpf(1.f, e);
  int q = (int)nearbyintf((m - 1.f) * 8.f);
  if (q == 8) { q = 0; e += 1; }
  if (e > 8) return sgn | 0x7e;
  return sgn | (unsigned)((e + 7) << 3) | (unsigned)q;
}
static inline float emu_fp82f(unsigned c) {
  unsigned sgn = c & 0x80, e = (c >> 3) & 15, m = c & 7;
  float v = e == 0 ? ldexpf((float)m, -9) : ldexpf(1.f + m / 8.f, (int)e - 7);
  return sgn ? -v : v;
}
#endif
DEV unsigned pack4_fp8(float a, float b, float c, float d) {
#ifdef CPU_EMU
  return emu_f2fp8(a) | (emu_f2fp8(b) << 8) | (emu_f2fp8(c) << 16) | (emu_f2fp8(d) << 24);
#else
  int w = 0;
  w = __builtin_amdgcn_cvt_pk_fp8_f32(a, b, w, false);
  w = __builtin_amdgcn_cvt_pk_fp8_f32(c, d, w, true);
  return (unsigned)w;
#endif
}
DEV void unpack4_fp8(unsigned w, float* o) {
#ifdef CPU_EMU
  o[0] = emu_fp82f(w & 255); o[1] = emu_fp82f((w >> 8) & 255); o[2] = emu_fp82f((w >> 16) & 255); o[3] = emu_fp82f(w >> 24);
#else
  typedef __attribute__((ext_vector_type(2))) float f32x2_;
  f32x2_ lo = __builtin_amdgcn_cvt_pk_f32_fp8((int)w, false);
  f32x2_ hi = __builtin_amdgcn_cvt_pk_f32_fp8((int)w, true);
  o[0] = lo.x; o[1] = lo.y; o[2] = hi.x; o[3] = hi.y;
#endif
}
DEV void unpack16_fp8(const u32x4& r, float* o) { unpack4_fp8(r.x, o); unpack4_fp8(r.y, o + 4); unpack4_fp8(r.z, o + 8); unpack4_fp8(r.w, o + 12); }
DEV float wreadlane(float v, int srclane) {
#ifdef CPU_EMU
  return emu_readlane(v, srclane);
#else
  int iv; __builtin_memcpy(&iv, &v, 4);
  int r = __builtin_amdgcn_readlane(iv, srclane);
  float f; __builtin_memcpy(&f, &r, 4); return f;
#endif
}
constexpr float PEER_USCALE = 64.f, PEER_VSCALE = 4.f;
#ifdef CPU_EMU
static inline unsigned emu_f2fp4(float f) {
  static const float lv[8] = {0.f, 0.5f, 1.f, 1.5f, 2.f, 3.f, 4.f, 6.f};
  unsigned sgn = f < 0.f ? 8u : 0u; float a = fabsf(f);
  int best = 0; float bd = 1e30f;
  for (int i = 0; i < 8; ++i) { float dd = fabsf(a - lv[i]); if (dd < bd || (dd == bd && (i & 1) == 0)) { bd = dd; best = i; } }
  return sgn | (unsigned)best;
}
static inline float emu_fp42f(unsigned c) {
  static const float lv[8] = {0.f, 0.5f, 1.f, 1.5f, 2.f, 3.f, 4.f, 6.f};
  float v = lv[c & 7]; return (c & 8) ? -v : v;
}
#endif
DEV unsigned pack8_fp4(const float* v) {
#ifdef CPU_EMU
  unsigned w = 0;
  for (int i = 0; i < 8; ++i) w |= emu_f2fp4(v[i]) << (4 * i);
  return w;
#else
  unsigned w = 0;
  w = __builtin_amdgcn_cvt_scalef32_pk_fp4_f32(w, v[0], v[1], 1.0f, 0);
  w = __builtin_amdgcn_cvt_scalef32_pk_fp4_f32(w, v[2], v[3], 1.0f, 1);
  w = __builtin_amdgcn_cvt_scalef32_pk_fp4_f32(w, v[4], v[5], 1.0f, 2);
  w = __builtin_amdgcn_cvt_scalef32_pk_fp4_f32(w, v[6], v[7], 1.0f, 3);
  return w;
#endif
}
DEV void unpack8_fp4(unsigned w, float* o) {
#ifdef CPU_EMU
  for (int i = 0; i < 8; ++i) o[i] = emu_fp42f((w >> (4 * i)) & 15u);
#else
  typedef __attribute__((ext_vector_type(2))) float f32x2_;
  f32x2_ a = __builtin_amdgcn_cvt_scalef32_pk_f32_fp4(w, 1.0f, 0);
  f32x2_ b = __builtin_amdgcn_cvt_scalef32_pk_f32_fp4(w, 1.0f, 1);
  f32x2_ c = __builtin_amdgcn_cvt_scalef32_pk_f32_fp4(w, 1.0f, 2);
  f32x2_ d = __builtin_amdgcn_cvt_scalef32_pk_f32_fp4(w, 1.0f, 3);
  o[0] = a.x; o[1] = a.y; o[2] = b.x; o[3] = b.y; o[4] = c.x; o[5] = c.y; o[6] = d.x; o[7] = d.y;
#endif
}
typedef __attribute__((ext_vector_type(3))) unsigned u32x3;
#ifndef FP6_INTERLEAVED
#define FP6_INTERLEAVED 1
#endif
#ifdef CPU_EMU
static inline unsigned emu_f2fp6(float f) {
  unsigned sgn = f < 0.f ? 32u : 0u; float a = fabsf(f);
  if (a >= 7.5f) return sgn | 31u;
  int e; unsigned code;
  if (a < 1.f) { int q = (int)nearbyintf(a * 8.f); code = (unsigned)q; }
  else { frexpf(a, &e); e -= 1; float m = a / ldexpf(1.f, e); int q = (int)nearbyintf((m - 1.f) * 8.f); if (q == 8) { q = 0; e += 1; } code = (unsigned)(((e + 1) << 3) | q); if (e > 2) code = 31u; }
  return sgn | code;
}
static inline float emu_fp62f(unsigned c) {
  unsigned e = (c >> 3) & 3, m = c & 7;
  float v = e == 0 ? m * 0.125f : ldexpf(1.f + m / 8.f, (int)e - 1);
  return (c & 32) ? -v : v;
}
#endif
DEV u32x3 pack16_fp6(const float* v) {
#ifdef CPU_EMU
  unsigned long long lo = 0; unsigned hi = 0;
  for (int i = 0; i < 16; ++i) {
    unsigned long long c = emu_f2fp6(v[i]); int bit = 6 * i;
    if (bit < 64) { lo |= c << bit; if (bit > 58) hi |= (unsigned)(c >> (64 - bit)); } else hi |= (unsigned)(c << (bit - 64));
  }
  u32x3 r; r.x = (unsigned)lo; r.y = (unsigned)(lo >> 32); r.z = hi; return r;
#else
  typedef __attribute__((ext_vector_type(6))) unsigned u32x6_;
  f32x16 a, b;
#if FP6_INTERLEAVED
#pragma unroll
  for (int i = 0; i < 8; ++i) { a[i] = v[2 * i]; b[i] = v[2 * i + 1]; a[8 + i] = 0.f; b[8 + i] = 0.f; }
#else
#pragma unroll
  for (int i = 0; i < 16; ++i) { a[i] = v[i]; b[i] = 0.f; }
#endif
  u32x6_ w = __builtin_amdgcn_cvt_scalef32_2xpk16_fp6_f32(a, b, 1.0f);
  u32x3 r; r.x = w[0]; r.y = w[1]; r.z = w[2]; return r;
#endif
}
DEV void unpack16_fp6(const u32x3& r, float* o) {
#ifdef CPU_EMU
  unsigned long long lo = (unsigned long long)r.x | ((unsigned long long)r.y << 32); unsigned hi = r.z;
  for (int i = 0; i < 16; ++i) {
    int bit = 6 * i; unsigned c;
    if (bit + 6 <= 64) c = (unsigned)(lo >> bit) & 63u;
    else if (bit >= 64) c = (hi >> (bit - 64)) & 63u;
    else c = ((unsigned)(lo >> bit) | (hi << (64 - bit))) & 63u;
    o[i] = emu_fp62f(c);
  }
#else
  typedef __attribute__((ext_vector_type(6))) unsigned u32x6_;
  typedef __attribute__((ext_vector_type(32))) float f32x32_;
  u32x6_ w; w[0] = r.x; w[1] = r.y; w[2] = r.z; w[3] = 0u; w[4] = 0u; w[5] = 0u;
  f32x32_ f = __builtin_amdgcn_cvt_scalef32_pk32_f32_fp6(w, 1.0f);
#pragma unroll
  for (int i = 0; i < 16; ++i) o[i] = f[i];
#endif
}
DEV void unpack2x16_fp6(const u32x3& ra, const u32x3& rb, float* oa, float* ob) {
#ifdef CPU_EMU
  unpack16_fp6(ra, oa); unpack16_fp6(rb, ob);
#else
  typedef __attribute__((ext_vector_type(6))) unsigned u32x6_;
  typedef __attribute__((ext_vector_type(32))) float f32x32_;
  u32x6_ w; w[0] = ra.x; w[1] = ra.y; w[2] = ra.z; w[3] = rb.x; w[4] = rb.y; w[5] = rb.z;
  f32x32_ f = __builtin_amdgcn_cvt_scalef32_pk32_f32_fp6(w, 1.0f);
#pragma unroll
  for (int i = 0; i < 16; ++i) { oa[i] = f[i]; ob[i] = f[16 + i]; }
#endif
}
constexpr int PEER_ROWB = 1280;
constexpr int PEER_VOFF = 768;


DEV int acc_row(int reg, int lane) { return (reg & 3) + 8 * (reg >> 2) + 4 * (lane >> 5); }

DEV int mod_row(int row) { return row < NCTX ? 2 : (row - NCTX) / SEQ; }

template <bool SYNC_EPI, class Epi, bool VEC4 = false>
DEV void gemm_tile_128(const bf16_t* __restrict__ A, int lda, int M, const bf16_t* __restrict__ Bt, int ldb, int N,
                       int K, int m0, int n0, const Epi& epi, unsigned char* smem) {
  constexpr int LS = 72;
  constexpr int STAGE = 2 * 128 * LS;
  bf16_t* sbase = (bf16_t*)smem;
  const int wave = threadIdx.x >> 6;
  const int wm = (wave >> 1) * 64, wn = (wave & 1) * 64;
  f32x16 acc[2][2];
#pragma unroll
  for (int i = 0; i < 2; ++i)
#pragma unroll
    for (int j = 0; j < 2; ++j)
#pragma unroll
      for (int r = 0; r < 16; ++r) acc[i][j][r] = 0.f;
  u32x4 ra[4], rb[4];
  auto gload = [&](int k0) {
    int tl_ = threadIdx.x; OPAQUE(tl_);
#pragma unroll
    for (int i = 0; i < 4; ++i) {
      int c = tl_ + i * 256, r = c >> 3, cc = (c & 7) * 8;
      int gr = m0 + r, gn = n0 + r;
      gr = gr < M ? gr : M - 1; gn = gn < N ? gn : N - 1;
      ra[i] = *(const u32x4*)(A + (size_t)gr * lda + k0 + cc);
      rb[i] = *(const u32x4*)(Bt + (size_t)gn * ldb + k0 + cc);
    }
  };
  auto lwrite = [&](int buf) {
    int tl_ = threadIdx.x; OPAQUE(tl_);
    bf16_t* sA = sbase + buf * STAGE;
    bf16_t* sB = sA + 128 * LS;
#pragma unroll
    for (int i = 0; i < 4; ++i) {
      int c = tl_ + i * 256, r = c >> 3, cc = (c & 7) * 8;
      *(u32x4*)(sA + r * LS + cc) = ra[i];
      *(u32x4*)(sB + r * LS + cc) = rb[i];
    }
  };
  const int nk = K >> 6;
  gload(0);
  __syncthreads();
  lwrite(0);
  if (nk > 1) gload(64);
  __syncthreads();
  for (int it = 0; it < nk; ++it) {
    int tl_ = threadIdx.x; OPAQUE(tl_);
    const int lane = tl_ & 63;
    const bf16_t* sA = sbase + (it & 1) * STAGE;
    const bf16_t* sB = sA + 128 * LS;
#pragma unroll
    for (int kk = 0; kk < 4; ++kk) {
      bf16x8 a[2], b[2];
      const int ko = kk * 16 + 8 * (lane >> 5);
#pragma unroll
      for (int i = 0; i < 2; ++i) a[i] = *(const bf16x8*)(sA + (wm + i * 32 + (lane & 31)) * LS + ko);
#pragma unroll
      for (int j = 0; j < 2; ++j) b[j] = *(const bf16x8*)(sB + (wn + j * 32 + (lane & 31)) * LS + ko);
#pragma unroll
      for (int i = 0; i < 2; ++i)
#pragma unroll
        for (int j = 0; j < 2; ++j) acc[i][j] = mfma32(a[i], b[j], acc[i][j]);
      if (kk == 1) {
        if (it + 1 < nk) lwrite((it + 1) & 1);
        if (it + 2 < nk) gload((it + 2) * 64);
      }
    }
    __syncthreads();
  }
  {
    int tl_ = threadIdx.x; OPAQUE(tl_);
    const int lane = tl_ & 63;
    if constexpr (VEC4) {
#pragma unroll
      for (int i = 0; i < 2; ++i)
#pragma unroll
        for (int j = 0; j < 2; ++j)
#pragma unroll
          for (int gq = 0; gq < 4; ++gq) {
            int row = m0 + wm + i * 32 + 8 * gq + 4 * (lane >> 5);
            int col = n0 + wn + j * 32 + (lane & 31);
            if (row < M && col < N) epi.store4(row, col, acc[i][j][4 * gq], acc[i][j][4 * gq + 1], acc[i][j][4 * gq + 2], acc[i][j][4 * gq + 3]);
          }
    } else {
#pragma unroll
      for (int i = 0; i < 2; ++i)
#pragma unroll
        for (int j = 0; j < 2; ++j)
#pragma unroll
          for (int r = 0; r < 16; ++r) {
            int row = m0 + wm + i * 32 + acc_row(r, lane);
            int col = n0 + wn + j * 32 + (lane & 31);
            if (row < M && col < N) epi(row, col, acc[i][j][r]);
          }
    }
  }
}

template <class Epi, bool VEC4 = false>
DEV void gemm_tile_128x256(const bf16_t* __restrict__ A, int lda, int M, const bf16_t* __restrict__ Bt, int ldb, int N,
                           int K, int m0, int n0, const Epi& epi, unsigned char* smem) {
  constexpr int LS = 72;
  bf16_t* sA = (bf16_t*)smem;
  bf16_t* sB = sA + 128 * LS;
  const int wave = threadIdx.x >> 6;
  const int wm = (wave >> 1) * 64, wn = (wave & 1) * 128;
  f32x16 acc[2][4];
#pragma unroll
  for (int i = 0; i < 2; ++i)
#pragma unroll
    for (int j = 0; j < 4; ++j)
#pragma unroll
      for (int r = 0; r < 16; ++r) acc[i][j][r] = 0.f;
  u32x4 ra[4], rb[8];
  {
    const int tid = threadIdx.x;
#pragma unroll
    for (int i = 0; i < 4; ++i) {
      int c = tid + i * 256, r = c >> 3, cc = (c & 7) * 8;
      { int gr = m0 + r; gr = gr < M ? gr : M - 1; ra[i] = *(const u32x4*)(A + (size_t)gr * lda + cc); }
    }
#pragma unroll
    for (int i = 0; i < 8; ++i) {
      int c = tid + i * 256, r = c >> 3, cc = (c & 7) * 8;
      { int gn = n0 + r; gn = gn < N ? gn : N - 1; rb[i] = *(const u32x4*)(Bt + (size_t)gn * ldb + cc); }
    }
  }
  for (int k0 = 0; k0 < K; k0 += 64) {
    int tl_ = threadIdx.x; OPAQUE(tl_);
    const int tid = tl_, lane = tl_ & 63;
    __syncthreads();
#pragma unroll
    for (int i = 0; i < 4; ++i) { int c = tid + i * 256, r = c >> 3, cc = (c & 7) * 8; *(u32x4*)(sA + r * LS + cc) = ra[i]; }
#pragma unroll
    for (int i = 0; i < 8; ++i) { int c = tid + i * 256, r = c >> 3, cc = (c & 7) * 8; *(u32x4*)(sB + r * LS + cc) = rb[i]; }
    __syncthreads();
    if (k0 + 64 < K) {
#pragma unroll
      for (int i = 0; i < 4; ++i) {
        int c = tid + i * 256, r = c >> 3, cc = (c & 7) * 8;
        { int gr = m0 + r; gr = gr < M ? gr : M - 1; ra[i] = *(const u32x4*)(A + (size_t)gr * lda + k0 + 64 + cc); }
      }
#pragma unroll
      for (int i = 0; i < 8; ++i) {
        int c = tid + i * 256, r = c >> 3, cc = (c & 7) * 8;
        { int gn = n0 + r; gn = gn < N ? gn : N - 1; rb[i] = *(const u32x4*)(Bt + (size_t)gn * ldb + k0 + 64 + cc); }
      }
    }
#pragma unroll 2
    for (int kk = 0; kk < 4; ++kk) {
      bf16x8 a[2], b[4];
      const int ko = kk * 16 + 8 * (lane >> 5);
#pragma unroll
      for (int i = 0; i < 2; ++i) a[i] = *(const bf16x8*)(sA + (wm + i * 32 + (lane & 31)) * LS + ko);
#pragma unroll
      for (int j = 0; j < 4; ++j) b[j] = *(const bf16x8*)(sB + (wn + j * 32 + (lane & 31)) * LS + ko);
#pragma unroll
      for (int i = 0; i < 2; ++i)
#pragma unroll
        for (int j = 0; j < 4; ++j) acc[i][j] = mfma32(a[i], b[j], acc[i][j]);
    }
  }
  {
    int tl_ = threadIdx.x; OPAQUE(tl_);
    const int lane = tl_ & 63;
    if constexpr (VEC4) {
#pragma unroll
      for (int i = 0; i < 2; ++i)
#pragma unroll
        for (int j = 0; j < 4; ++j)
#pragma unroll
          for (int gq = 0; gq < 4; ++gq) {
            int row = m0 + wm + i * 32 + 8 * gq + 4 * (lane >> 5);
            int col = n0 + wn + j * 32 + (lane & 31);
            if (row < M && col < N) epi.store4(row, col, acc[i][j][4 * gq], acc[i][j][4 * gq + 1], acc[i][j][4 * gq + 2], acc[i][j][4 * gq + 3]);
          }
    } else {
#pragma unroll
      for (int i = 0; i < 2; ++i)
#pragma unroll
        for (int j = 0; j < 4; ++j)
#pragma unroll
          for (int r = 0; r < 16; ++r) {
            int row = m0 + wm + i * 32 + acc_row(r, lane);
            int col = n0 + wn + j * 32 + (lane & 31);
            if (row < M && col < N) epi(row, col, acc[i][j][r]);
          }
    }
  }
}

DEV void transpose_tile(const float* __restrict__ src, int ld_src, bf16_t* __restrict__ dst, int ld_dst, int K, int N,
                        int tk, int tn, unsigned char* smem) {
  float* sT = (float*)smem;
  const int tid = threadIdx.x;
  __syncthreads();
  {
    const int tx = tid & 15, ty = tid >> 4;
#pragma unroll
    for (int p = 0; p < 4; ++p) {
      int k = tk * 64 + ty + p * 16, n = tn * 64 + tx * 4;
      f32x4 v4 = {0.f, 0.f, 0.f, 0.f};
      if (k < K && n < N) v4 = *(const f32x4*)(src + (size_t)k * ld_src + n);
      float* d = sT + (ty + p * 16) * 65 + tx * 4;
      d[0] = v4.x; d[1] = v4.y; d[2] = v4.z; d[3] = v4.w;
    }
  }
  __syncthreads();
  {
    const int n = tid >> 2, kseg = (tid & 3) * 16;
    int gn = tn * 64 + n;
    if (gn < N) {
      float v[16];
#pragma unroll
      for (int j = 0; j < 16; ++j) v[j] = sT[(kseg + j) * 65 + n];
      bf16_t* d = dst + (size_t)gn * ld_dst + tk * 64 + kseg;
      *(u32x4*)d = pack8(v);
      *(u32x4*)(d + 8) = pack8(v + 8);
    }
  }
}

constexpr int TJ0 = 16 * 49, TJ1 = 16 * 16, TJ2 = 16 * 44, TJ3 = 16 * 16, TJ4 = 2 * 16 * 32, TJ5 = 2 * 8, TJ6 = 2 * 8,
              TJ7 = 2 * 8, TJ8 = 32;
constexpr int NTRANS = TJ0 + TJ1 + TJ2 + TJ3 + TJ4 + TJ5 + TJ6 + TJ7 + TJ8;
constexpr int NKEYCV = (2 * 8 * 2 * 128 * 128) / (256 * 8);
constexpr int NMODV = 2 * 96;
constexpr int NPREP = NTRANS + NKEYCV + NMODV;

DEV void st_prep(const Params& P, int item, unsigned char* smem) {
  unsigned char* ws = P.ws;
  if (item < NTRANS) {
    int t = item;
    if (t < TJ0) { transpose_tile(P.in[I_EVWIN], EVC, (bf16_t*)(ws + OFF_WEVIN), 1024, 1024, EVC, t / 49, t % 49, smem); return; }
    t -= TJ0;
    if (t < TJ1) { transpose_tile(P.in[I_EVWOUT], 1024, (bf16_t*)(ws + OFF_WEVOUT), 1024, 1024, 1024, t / 16, t % 16, smem); return; }
    t -= TJ1;
    if (t < TJ2) { transpose_tile(P.in[I_ODWIN], ODC, (bf16_t*)(ws + OFF_WODIN), 1024, 1024, ODC, t / 44, t % 44, smem); return; }
    t -= TJ2;
    if (t < TJ3) { transpose_tile(P.in[I_ODWOUT], 1024, (bf16_t*)(ws + OFF_WODOUT), 1024, 1024, 1024, t / 16, t % 16, smem); return; }
    t -= TJ3;
    if (t < TJ4) {
      int l = t / 512, tt = t % 512;
      transpose_tile(P.in[I_WQ] + (size_t)l * 1024 * 2048, 2048, (bf16_t*)(ws + OFF_WQ) + (size_t)l * 2048 * 1024, 1024, 1024, 2048, tt / 32, tt % 32, smem);
      return;
    }
    t -= TJ4;
    if (t < TJ5) { int d = t / 8; transpose_tile(P.in[I_WUP] + d * 64 * 512, 512, (bf16_t*)(ws + OFF_WUP) + d * 512 * 64, 64, 64, 512, 0, t % 8, smem); return; }
    t -= TJ5;
    if (t < TJ6) { int d = t / 8; transpose_tile(P.in[I_AUP] + d * 64 * 512, 512, (bf16_t*)(ws + OFF_AUP) + d * 512 * 64, 64, 64, 512, 0, t % 8, smem); return; }
    t -= TJ6;
    if (t < TJ7) { transpose_tile(P.in[I_GUP], 512, (bf16_t*)(ws + OFF_GUP), 128, 128, 512, t / 8, t % 8, smem); return; }
    t -= TJ7;
    {
      int which = t & 1, db = t >> 1;
      const float* src = (which ? P.in[I_WI] : P.in[I_WA]) + (size_t)db * 64 * 64;
      transpose_tile(src, 64, (bf16_t*)(ws + OFF_LRUT) + (size_t)db * 128 * 64 + which * 64 * 64, 64, 64, 64, 0, 0, smem);
      return;
    }
  }
  item -= NTRANS;
  if (item < NKEYCV) {
    size_t e = ((size_t)item * 256 + threadIdx.x) * 8;
    const float* s = P.in[I_KEYS] + e;
    f32x4 a = *(const f32x4*)s, b = *(const f32x4*)(s + 4);
    float v[8] = {a.x, a.y, a.z, a.w, b.x, b.y, b.z, b.w};
    *(u32x4*)((bf16_t*)(ws + OFF_KEYS) + e) = pack8(v);
    return;
  }
  item -= NKEYCV;
  {
    const int l = item / 96, cgp = item % 96;
    float* sS = (float*)smem;
    float* sRed = sS + 3 * 1024;
    const int tid = threadIdx.x;
    __syncthreads();
    for (int i = tid; i < 3 * 1024; i += 256) {
      int m = i >> 10, k = i & 1023;
      float c = m < 2 ? P.in[I_C][m * 1024 + k] : P.in[I_CCTX][k];
      sS[i] = siluf_(c);
    }
    __syncthreads();
    const int ks = tid >> 6, col = cgp * 64 + (tid & 63);
    const float* w = P.in[I_MODW] + (size_t)l * 1024 * 6144 + col;
    float a0 = 0.f, a1 = 0.f, a2 = 0.f;
    for (int k = ks * 256; k < ks * 256 + 256; ++k) {
      float wv = w[(size_t)k * 6144];
      a0 += sS[k] * wv; a1 += sS[1024 + k] * wv; a2 += sS[2048 + k] * wv;
    }
    sRed[(ks * 3 + 0) * 64 + (tid & 63)] = a0;
    sRed[(ks * 3 + 1) * 64 + (tid & 63)] = a1;
    sRed[(ks * 3 + 2) * 64 + (tid & 63)] = a2;
    __syncthreads();
    if (tid < 192) {
      int m = tid >> 6, c = tid & 63;
      float s = sRed[(0 * 3 + m) * 64 + c] + sRed[(1 * 3 + m) * 64 + c] + sRed[(2 * 3 + m) * 64 + c] + sRed[(3 * 3 + m) * 64 + c];
      int cc = cgp * 64 + c;
      ((float*)(ws + OFF_MODV))[((size_t)l * 3 + m) * 6144 + cc] = s + P.in[I_MODB][l * 6144 + cc];
    }
  }
}

constexpr int NPCONV = 2 * (NEXP * 1024 / (256 * 16));
DEV void st_peer_conv(const Params& P, int layer, int item) {
  const int half = NPCONV / 2;
  int which = item >= half;
  int it = which ? item - half : item;
  size_t e = ((size_t)it * 256 + threadIdx.x) * 16;
  const float* s = (which ? P.in[I_PV] : P.in[I_PU]) + (size_t)layer * NEXP * 1024 + e;
  const float sc = which ? PEER_VSCALE : PEER_USCALE;
  float v16[16];
#pragma unroll
  for (int q = 0; q < 4; ++q) {
    f32x4 a = *(const f32x4*)(s + 4 * q);
    v16[4 * q] = a.x * sc; v16[4 * q + 1] = a.y * sc; v16[4 * q + 2] = a.z * sc; v16[4 * q + 3] = a.w * sc;
  }
  const size_t ex = e >> 10, col = e & 1023;
  if (which) {
    u32x2 o; o.x = pack8_fp4(v16); o.y = pack8_fp4(v16 + 8);
    *(u32x2*)(P.ws + OFF_PU + ex * PEER_ROWB + PEER_VOFF + (col >> 1)) = o;
  } else {
    u32x3 o = pack16_fp6(v16);
    unsigned* dp = (unsigned*)(P.ws + OFF_PU + ex * PEER_ROWB + (col >> 4) * 12);
    dp[0] = o.x; dp[1] = o.y; dp[2] = o.z;
  }
}

DEV void st_normmod(const Params& P, int layer, int which, int row) {
  const int lane = threadIdx.x & 63;
  const float* src;
  if (which == 0 && layer == 0) src = row < NCTX ? P.in[I_CTX] + (size_t)row * 1024 : P.in[I_X] + (size_t)(row - NCTX) * 1024;
  else src = row < NCTX ? (const float*)(P.ws + OFF_CTXRES) + (size_t)row * 1024 : P.out + (size_t)(row - NCTX) * 1024;
  const float* mv = (const float*)(P.ws + OFF_MODV) + ((size_t)layer * 3 + mod_row(row)) * 6144;
  const float* sh = mv + (which ? 3 : 0) * 1024;
  const float* sc = mv + (which ? 4 : 1) * 1024;
  const float* nw = (which ? P.in[I_NORM2] : P.in[I_NORM1]) + layer * 1024;
  f32x4 v[4];
  float ss = 0.f;
#pragma unroll
  for (int i = 0; i < 4; ++i) {
    v[i] = *(const f32x4*)(src + i * 256 + lane * 4);
    ss += v[i].x * v[i].x + v[i].y * v[i].y + v[i].z * v[i].z + v[i].w * v[i].w;
  }
  ss = wave_sum(ss);
  const float rstd = frsq(ss * (1.f / 1024.f) + 1e-6f);
  bf16_t* dst = (bf16_t*)(P.ws + OFF_HBUF) + (size_t)row * 1024;
#pragma unroll
  for (int i = 0; i < 4; ++i) {
    int c = i * 256 + lane * 4;
    f32x4 w4 = *(const f32x4*)(nw + c), s4 = *(const f32x4*)(sc + c), h4 = *(const f32x4*)(sh + c);
    float o0 = v[i].x * rstd * w4.x * (1.f + s4.x) + h4.x;
    float o1 = v[i].y * rstd * w4.y * (1.f + s4.y) + h4.y;
    float o2 = v[i].z * rstd * w4.z * (1.f + s4.z) + h4.z;
    float o3 = v[i].w * rstd * w4.w * (1.f + s4.w) + h4.w;
    u32x2 pk; pk.x = pack2(o0, o1); pk.y = pack2(o2, o3);
    *(u32x2*)(dst + c) = pk;
  }
}

struct EpiProjL0 {
  bf16_t* proj; float* gates;
  DEVM void operator()(int row, int col, float v) const {
    proj[(size_t)row * EVC + col] = f2bf(v);
    if (col >= 1536 && col < 1552) gates[row * 32 + (col - 1536)] = v;
    else if (col >= 3088) gates[row * 32 + 16 + (col - 3088)] = v;
  }
};
struct EpiStoreBf {
  bf16_t* dst; int ld;
  DEVM void operator()(int row, int col, float v) const { dst[(size_t)row * ld + col] = f2bf(v); }
};
struct EpiStoreBfBias {
  bf16_t* dst; int ld; const float* bias;
  DEVM void operator()(int row, int col, float v) const { dst[(size_t)row * ld + col] = f2bf(v + (bias ? bias[col] : 0.f)); }
};
struct EpiProjL0T {
  bf16_t* proj; float* gates;
  DEVM void operator()(int, int, float) const {}
  DEVM void store4(int n, int m, float v0, float v1, float v2, float v3) const {
    u32x2 pk; pk.x = pack2(v0, v1); pk.y = pack2(v2, v3);
    *(u32x2*)(proj + (size_t)m * EVC + n) = pk;
    if (n >= 1536 && n < 1552) { f32x4 g = {v0, v1, v2, v3}; *(f32x4*)(gates + m * 32 + (n - 1536)) = g; }
    else if (n >= 3088) { f32x4 g = {v0, v1, v2, v3}; *(f32x4*)(gates + m * 32 + 16 + (n - 3088)) = g; }
  }
};
struct EpiStoreBfT {
  bf16_t* dst; int ld;
  DEVM void operator()(int, int, float) const {}
  DEVM void store4(int n, int m, float v0, float v1, float v2, float v3) const {
    u32x2 pk; pk.x = pack2(v0, v1); pk.y = pack2(v2, v3);
    *(u32x2*)(dst + (size_t)m * ld + n) = pk;
  }
};
struct EpiOutProjT {
  const float* x_lat; const float* x_ctx; float* o_lat; float* o_ctx; const float* modv;
  DEVM void operator()(int, int, float) const {}
  DEVM void store4(int n, int m, float v0, float v1, float v2, float v3) const {
    const f32x4 g = *(const f32x4*)(modv + mod_row(m) * 6144 + 2 * 1024 + n);
    const float* xs; float* od;
    if (m < NCTX) { xs = x_ctx + (size_t)m * 1024 + n; od = o_ctx + (size_t)m * 1024 + n; }
    else { size_t o = (size_t)(m - NCTX) * 1024 + n; xs = x_lat + o; od = o_lat + o; }
    const f32x4 x = *(const f32x4*)xs;
    f32x4 r = {x.x + g.x * v0, x.y + g.y * v1, x.z + g.z * v2, x.w + g.w * v3};
    *(f32x4*)od = r;
  }
};
struct EpiStoreBfBiasT {
  bf16_t* dst; int ld; const float* bias; int mode;
  DEVM void operator()(int, int, float) const {}
  DEVM void store4(int n, int m, float v0, float v1, float v2, float v3) const {
    if (bias) { v0 += bias[n]; v1 += bias[n + 1]; v2 += bias[n + 2]; v3 += bias[n + 3]; }
    if (mode) {
      const float sc = mode == 1 ? -0.6065306597126334f : 1.f;
      v0 = sc * sigmoidf_(v0); v1 = sc * sigmoidf_(v1); v2 = sc * sigmoidf_(v2); v3 = sc * sigmoidf_(v3);
    }
    u32x2 pk; pk.x = pack2(v0, v1); pk.y = pack2(v2, v3);
    *(u32x2*)(dst + (size_t)m * ld + n) = pk;
  }
};
struct EpiOutProj {
  const float* x_lat; const float* x_ctx; float* o_lat; float* o_ctx; const float* modv;
  DEVM void operator()(int row, int col, float v) const {
    float g = modv[mod_row(row) * 6144 + 2 * 1024 + col];
    if (row < NCTX) o_ctx[(size_t)row * 1024 + col] = x_ctx[(size_t)row * 1024 + col] + g * v;
    else { size_t o = (size_t)(row - NCTX) * 1024 + col; o_lat[o] = x_lat[o] + g * v; }
  }
};
struct EpiScoreLds {
  float* sS; int m0;
  DEVM void operator()(int row, int col, float v) const { sS[(row - m0) * 129 + col] = v; }
};

DEV void st_xbc_conv(const Params& P, int row) {
  const int lane = threadIdx.x & 63;
  const bf16_t* proj = (const bf16_t*)(P.ws + OFF_PROJ);
  bf16_t* xc = (bf16_t*)P.out + (size_t)row * 1024;
  int row0, len, pos;
  if (row < NCTX) { row0 = (row / CTXL) * CTXL; len = CTXL; pos = row - row0; }
  else { int r = row - NCTX; row0 = NCTX + (r / SEQ) * SEQ; len = SEQ; pos = r % SEQ; }
  const float* cw = P.in[I_SCONVW];
  const float* cb = P.in[I_SCONVB];
#pragma unroll
  for (int hh = 0; hh < 2; ++hh) {
    const int ch = hh * 512 + lane * 8;
    float o[8];
#pragma unroll
    for (int j = 0; j < 8; ++j) o[j] = cb[ch + j];
#pragma unroll
    for (int tap = 0; tap < 4; ++tap) {
      int pp = pos + tap - 2;
      if (pp >= 0 && pp < len) {
        float x[8];
        unpack8(*(const u32x4*)(proj + (size_t)(row0 + pp) * EVC + 2064 + ch), x);
        f32x4 w0 = *(const f32x4*)(cw + tap * 1024 + ch), w1 = *(const f32x4*)(cw + tap * 1024 + ch + 4);
        o[0] += w0.x * x[0]; o[1] += w0.y * x[1]; o[2] += w0.z * x[2]; o[3] += w0.w * x[3];
        o[4] += w1.x * x[4]; o[5] += w1.y * x[5]; o[6] += w1.z * x[6]; o[7] += w1.w * x[7];
      }
    }
#pragma unroll
    for (int j = 0; j < 8; ++j) o[j] = siluf_(o[j]);
    *(u32x4*)(xc + ch) = pack8(o);
  }
}

#ifndef LA_NSEG
#define LA_NSEG 10
#endif
constexpr int LA_NCH = (CTXL + SEQ) / 64;
constexpr int LA_CPS = LA_NCH / LA_NSEG;
static_assert(LA_NCH % LA_NSEG == 0, "linattn segments");
#ifdef CPU_EMU
constexpr size_t OFF_LASEG = OFF_PR + PR_BYTES;
#else
constexpr size_t OFF_LASEG = OFF_R2L0 + (size_t)NTOK * 1024 * 2;
#endif
constexpr size_t LASEG_U = (size_t)48 * LA_NSEG * 8192 * 4;
constexpr size_t OFF_LASEG_N = OFF_LASEG + LASEG_U;
constexpr size_t OFF_LASEG_D = OFF_LASEG_N + (size_t)48 * LA_NSEG * 64 * 4;
#ifndef CPU_EMU
static_assert(OFF_LASEG_D + 48 * LA_NSEG * 4 <= OFF_PR + PR_BYTES, "laseg");
#endif

DEV int swz64(int row) { return ((row >> 3) & 7) << 3; }
DEV int swz32(int row) { return ((row >> 3) & 3) << 3; }
struct LaRaw { u32x4 q[2], k[4], x[4]; float g0, g1; };

template <bool MLSTM, bool FULL>
DEV void la_load_raw(const Params& P, int b, int h, int d, int cc, LaRaw& R) {
  constexpr int NC_CTX = CTXL / 64;
  const int tid = threadIdx.x;
  const int seg = cc >= NC_CTX;
  const int row0 = seg ? NCTX + b * SEQ : b * CTXL;
  const int len = seg ? SEQ : CTXL;
  const int cl = (seg ? cc - NC_CTX : cc) * 64;
  const bf16_t* proj = (const bf16_t*)(P.ws + OFF_PROJ);
  const bf16_t* xcv = (const bf16_t*)P.out;
  const float* gates = (const float*)(P.ws + OFF_GATES);
  if (tid < 64) {
    int p = cl + tid, grow = row0 + (d ? len - 1 - p : p);
    if (MLSTM) { R.g0 = gates[grow * 32 + d * 4 + h]; R.g1 = gates[grow * 32 + 8 + d * 4 + h]; }
    else { R.g0 = gates[grow * 32 + 16 + d * 8 + h]; R.g1 = 0.f; }
  }
  if (MLSTM) {
#pragma unroll
    for (int i = 0; i < 2; ++i) {
      int c = tid + i * 256, r = c >> 3, cc8 = (c & 7) * 8;
      int p = cl + r, pos = d ? len - 1 - p : p;
      const bf16_t* rp = proj + (size_t)(row0 + pos) * EVC;
      if (FULL) R.q[i] = *(const u32x4*)(rp + h * 64 + cc8);
      R.k[i] = *(const u32x4*)(rp + 256 + h * 64 + cc8);
    }
#pragma unroll
    for (int i = 0; i < 4; ++i) {
      int c = tid + i * 256, r = c >> 4, cc8 = (c & 15) * 8;
      int p = cl + r, pos = d ? len - 1 - p : p;
      R.x[i] = *(const u32x4*)(proj + (size_t)(row0 + pos) * EVC + 512 + h * 128 + cc8);
    }
  } else {
    const int grp = h >> 2;
#pragma unroll
    for (int i = 0; i < 2; ++i) {
      int c = tid + i * 256, r = c >> 3, cc8 = (c & 7) * 8;
      int p = cl + r, pos = d ? len - 1 - p : p;
      R.x[i] = *(const u32x4*)(xcv + (size_t)(row0 + pos) * 1024 + h * 64 + cc8);
    }
#pragma unroll
    for (int i = 0; i < 4; ++i) {
      int c = tid + i * 256, r = c >> 4, cc8 = (c & 15) * 8;
      int p = cl + r, pos = d ? len - 1 - p : p;
      const bf16_t* rp = xcv + (size_t)(row0 + pos) * 1024;
      R.k[i] = *(const u32x4*)(rp + 512 + grp * 128 + cc8);
      if (FULL) { if (i < 2) R.q[i] = *(const u32x4*)(rp + 768 + grp * 128 + cc8); else R.x[i] = *(const u32x4*)(rp + 768 + grp * 128 + cc8); }
    }
  }
}

template <bool MLSTM, bool FULL>
DEV void st_linattn_seg(const Params& P, int sid, int seg, unsigned char* smem) {
  constexpr int DK = MLSTM ? 64 : 128, DX = MLSTM ? 128 : 64;
  constexpr int QS = DK + 8;
  constexpr int NH = MLSTM ? 4 : 8;
  constexpr int NC_CTX = CTXL / 64;
  const int tid = threadIdx.x, lane = tid & 63, wave = tid >> 6;
  const int d = sid & 1, h = (sid >> 1) % NH, b = (sid >> 1) / NH;
  const int gsid = MLSTM ? sid : 16 + sid;
  bf16_t* sQ = (bf16_t*)smem;
  bf16_t* sK = sQ + 64 * QS;
  bf16_t* sP = sK;
  bf16_t* sKT = sK + 64 * QS;
  bf16_t* sXT = sKT + DK * 72;
  bf16_t* sST = sXT + DX * 72;
  float* sF = (float*)(sST + DX * QS);
  float* sLa = sF;
  float* sG = sF + 64;
  float* sBc = sF + 128;
  float* sDen = sF + 192;
  float* sN = sF + 256;
  int* sRow = (int*)(sF + 384);
  static_assert((64 * QS * 2 + DK * 72 + DX * 72 + DX * QS) * 2 + 448 * 4 <= SMEM_BYTES, "lds");
  bf16_t* outb = MLSTM ? (bf16_t*)(P.ws + OFF_HBUF) : (bf16_t*)(P.ws + OFF_R2L0);
  float* segU = (float*)(P.ws + OFF_LASEG);
  float* segN = (float*)(P.ws + OFF_LASEG_N);
  float* segD = (float*)(P.ws + OFF_LASEG_D);

  f32x16 accS[2];
#pragma unroll
  for (int j = 0; j < 2; ++j)
#pragma unroll
    for (int r = 0; r < 16; ++r) accS[j][r] = 0.f;
  const int sx0 = MLSTM ? wave * 32 : (wave >> 1) * 32;
  const int sk0 = MLSTM ? 0 : (wave & 1) * 64;
  float nreg = 0.f;
  float gb0 = 0.f, gb1 = 0.f, alog_e = 0.f, dskip = 0.f;
  if (MLSTM) { gb0 = P.in[I_IBIAS][d * 4 + h]; gb1 = P.in[I_FBIAS][d * 4 + h]; }
  else { gb0 = P.in[I_DTBIAS][d * 8 + h]; alog_e = fexp(P.in[I_ALOG][d * 8 + h]); dskip = P.in[I_DSKIP][h]; }

  const int cc0 = seg * LA_CPS, cc1 = cc0 + LA_CPS;
  LaRaw R;
  la_load_raw<MLSTM, FULL>(P, b, h, d, cc0, R);
  __syncthreads();
  if (FULL) {
    for (int js = 0; js < seg; ++js) {
      const size_t it = (size_t)gsid * LA_NSEG + js;
      const float a = fexp(segD[it]);
      const float* U = segU + it * 8192;
#pragma unroll
      for (int j = 0; j < 2; ++j)
#pragma unroll
        for (int r = 0; r < 16; ++r) accS[j][r] = a * accS[j][r] + U[(j * 16 + r) * 256 + tid];
      if (MLSTM) nreg = a * nreg + segN[it * 64 + (tid >> 2)];
    }
#pragma unroll
    for (int j = 0; j < 2; ++j)
#pragma unroll
      for (int r = 0; r < 16; ++r) sST[(sx0 + acc_row(r, lane)) * QS + sk0 + j * 32 + (lane & 31)] = f2bf(accS[j][r]);
    if (MLSTM && (tid & 3) == 0) sN[tid >> 2] = nreg;
  }
  float lsum = 0.f;

  for (int cc = cc0; cc < cc1; ++cc) {
    int tl_ = threadIdx.x; OPAQUE(tl_);
    const int tid = tl_, lane = tl_ & 63;
    const int sgi = cc >= NC_CTX;
    const int row0 = sgi ? NCTX + b * SEQ : b * CTXL;
    const int len = sgi ? SEQ : CTXL;
    const int cl = (sgi ? cc - NC_CTX : cc) * 64;
    if (tid < 64) {
      int p = cl + tid;
      sRow[tid] = row0 + (d ? len - 1 - p : p);
      float la;
      if (MLSTM) { la = -softplusf_(-(R.g1 + gb1)); sG[tid] = fexp(R.g0 + gb0); }
      else { float dt = softplusf_(R.g0 + gb0); la = -dt * alog_e; sG[tid] = dt; }
      sBc[tid] = wave_incl_scan(la);
    }
    __syncthreads();
    const float blast = sBc[63];
    lsum += blast;
    if (MLSTM) {
#pragma unroll
      for (int i = 0; i < 2; ++i) {
        int c = tid + i * 256, r = c >> 3, cc8 = (c & 7) * 8;
        float kf[8]; unpack8(R.k[i], kf);
        const float wgt = fexp(blast - sBc[r]) * sG[r];
#pragma unroll
        for (int j = 0; j < 8; ++j) sKT[(cc8 + j) * 72 + (r ^ swz64(cc8))] = f2bf(kf[j] * wgt);
        if (FULL) {
          float qf[8]; unpack8(R.q[i], qf);
#pragma unroll
          for (int j = 0; j < 8; ++j) qf[j] *= 0.125f;
          *(u32x4*)(sQ + r * QS + cc8) = pack8(qf);
          *(u32x4*)(sK + r * QS + cc8) = R.k[i];
        }
      }
#pragma unroll
      for (int i = 0; i < 4; ++i) {
        int c = tid + i * 256, r = c >> 4, cc8 = (c & 15) * 8;
        const bf16_t* xs = (const bf16_t*)&R.x[i];
#pragma unroll
        for (int j = 0; j < 8; ++j) sXT[(cc8 + j) * 72 + (r ^ swz64(cc8))] = xs[j];
      }
    } else {
#pragma unroll
      for (int i = 0; i < 2; ++i) {
        int c = tid + i * 256, r = c >> 3, cc8 = (c & 7) * 8;
        const bf16_t* xs = (const bf16_t*)&R.x[i];
#pragma unroll
        for (int j = 0; j < 8; ++j) sXT[(cc8 + j) * 72 + (r ^ swz64(cc8))] = xs[j];
      }
#pragma unroll
      for (int i = 0; i < 4; ++i) {
        int c = tid + i * 256, r = c >> 4, cc8 = (c & 15) * 8;
        float kf[8]; unpack8(R.k[i], kf);
        const float wgt = fexp(blast - sBc[r]) * sG[r];
#pragma unroll
        for (int j = 0; j < 8; ++j) sKT[(cc8 + j) * 72 + (r ^ swz64(cc8))] = f2bf(kf[j] * wgt);
        if (FULL) {
          *(u32x4*)(sK + r * QS + cc8) = R.k[i];
          *(u32x4*)(sQ + r * QS + cc8) = i < 2 ? R.q[i] : R.x[i];
        }
      }
    }
    if (cc + 1 < cc1) la_load_raw<MLSTM, FULL>(P, b, h, d, cc + 1, R);
    __syncthreads();
    if (FULL) {
      const int tr = (wave >> 1) * 32, tc = (wave & 1) * 32;
      f32x16 accP;
#pragma unroll
      for (int r = 0; r < 16; ++r) accP[r] = 0.f;
      if (!(tr == 0 && tc == 32)) {
#pragma unroll
        for (int kk = 0; kk < DK / 16; ++kk) {
          const int ko = kk * 16 + 8 * (lane >> 5);
          bf16x8 a = *(const bf16x8*)(sQ + (tr + (lane & 31)) * QS + ko);
          bf16x8 bb = *(const bf16x8*)(sK + (tc + (lane & 31)) * QS + ko);
          accP = mfma32(a, bb, accP);
        }
      }
      __syncthreads();
      {
        const int s = tc + (lane & 31);
        const float bs = sBc[s], gs = sG[s];
#pragma unroll
        for (int r = 0; r < 16; ++r) {
          int t = tr + acc_row(r, lane);
          float v = (s <= t) ? accP[r] * fexp(sBc[t] - bs) * gs : 0.f;
          sP[t * 72 + s] = f2bf(v);
        }
        {
          const int t = tid >> 2, kq = (tid & 3) * (DK / 4);
          const float et = fexp(sBc[t]);
#pragma unroll
          for (int c8 = 0; c8 < DK / 4; c8 += 8) {
            float qf[8];
            unpack8(*(const u32x4*)(sQ + t * QS + kq + c8), qf);
#pragma unroll
            for (int j = 0; j < 8; ++j) qf[j] *= et;
            *(u32x4*)(sQ + t * QS + kq + c8) = pack8(qf);
          }
        }
      }
      __syncthreads();
      constexpr int NYT = MLSTM ? 2 : 1;
      const int yx0 = MLSTM ? wave * 32 : (wave >> 1) * 32;
      const int yt0 = MLSTM ? 0 : (wave & 1) * 32;
      f32x16 accY[NYT];
#pragma unroll
      for (int j = 0; j < NYT; ++j)
#pragma unroll
        for (int r = 0; r < 16; ++r) accY[j][r] = 0.f;
#pragma unroll
      for (int kk = 0; kk < 4; ++kk) {
        const int ko = kk * 16 + 8 * (lane >> 5);
        bf16x8 a = *(const bf16x8*)(sXT + (yx0 + (lane & 31)) * 72 + (ko ^ swz64(yx0 + (lane & 31))));
#pragma unroll
        for (int j = 0; j < NYT; ++j) {
          bf16x8 bb = *(const bf16x8*)(sP + (yt0 + j * 32 + (lane & 31)) * 72 + ko);
          accY[j] = mfma32(a, bb, accY[j]);
        }
      }
#pragma unroll
      for (int kk = 0; kk < DK / 16; ++kk) {
        const int ko = kk * 16 + 8 * (lane >> 5);
        bf16x8 a = *(const bf16x8*)(sST + (yx0 + (lane & 31)) * QS + ko);
#pragma unroll
        for (int j = 0; j < NYT; ++j) {
          bf16x8 bb = *(const bf16x8*)(sQ + (yt0 + j * 32 + (lane & 31)) * QS + ko);
          accY[j] = mfma32(a, bb, accY[j]);
        }
      }
      if (MLSTM) {
        const int t = tid >> 2, q4 = (tid & 3) * 16;
        float pf[16], qf[16];
        unpack8(*(const u32x4*)(sP + t * 72 + q4), pf); unpack8(*(const u32x4*)(sP + t * 72 + q4 + 8), pf + 8);
        unpack8(*(const u32x4*)(sQ + t * QS + q4), qf); unpack8(*(const u32x4*)(sQ + t * QS + q4 + 8), qf + 8);
        float den = 0.f;
#pragma unroll
        for (int j = 0; j < 16; ++j) den += pf[j] + sN[q4 + j] * qf[j];
        den = sum4(den);
        if ((tid & 3) == 0) sDen[t] = den;
        __syncthreads();
      }
#pragma unroll
      for (int j = 0; j < NYT; ++j) {
        const int t = yt0 + j * 32 + (lane & 31);
        const size_t obase = (size_t)sRow[t] * 1024 + d * 512 + h * DX;
        const float dinv = MLSTM ? frcp(fmaxf(fabsf(sDen[t]), 1.f)) : 1.f;
#pragma unroll
        for (int g = 0; g < 4; ++g) {
          const int x0 = yx0 + 8 * g + 4 * (lane >> 5);
          float v0 = accY[j][4 * g], v1 = accY[j][4 * g + 1], v2 = accY[j][4 * g + 2], v3 = accY[j][4 * g + 3];
          if (MLSTM) { v0 *= dinv; v1 *= dinv; v2 *= dinv; v3 *= dinv; }
          else if (d == 0) {
            const int ts = t ^ swz64(x0);
            v0 += dskip * bf2f(sXT[(x0 + 0) * 72 + ts]); v1 += dskip * bf2f(sXT[(x0 + 1) * 72 + ts]);
            v2 += dskip * bf2f(sXT[(x0 + 2) * 72 + ts]); v3 += dskip * bf2f(sXT[(x0 + 3) * 72 + ts]);
          }
          u32x2 pk; pk.x = pack2(v0, v1); pk.y = pack2(v2, v3);
          *(u32x2*)(outb + obase + x0) = pk;
        }
      }
      __syncthreads();
    }
    {
      const float eb = fexp(blast);
#pragma unroll
      for (int j = 0; j < 2; ++j)
#pragma unroll
        for (int r = 0; r < 16; ++r) accS[j][r] *= eb;
#pragma unroll
      for (int kk = 0; kk < 4; ++kk) {
        const int ko = kk * 16 + 8 * (lane >> 5);
        bf16x8 a = *(const bf16x8*)(sXT + (sx0 + (lane & 31)) * 72 + (ko ^ swz64(sx0 + (lane & 31))));
#pragma unroll
        for (int j = 0; j < 2; ++j) {
          bf16x8 bb = *(const bf16x8*)(sKT + (sk0 + j * 32 + (lane & 31)) * 72 + (ko ^ swz64(sk0 + j * 32 + (lane & 31))));
          accS[j] = mfma32(a, bb, accS[j]);
        }
      }
      if (FULL) {
#pragma unroll
        for (int j = 0; j < 2; ++j)
#pragma unroll
          for (int r = 0; r < 16; ++r) sST[(sx0 + acc_row(r, lane)) * QS + sk0 + j * 32 + (lane & 31)] = f2bf(accS[j][r]);
      }
      if (MLSTM) {
        const int k = tid >> 2, q4 = (tid & 3) * 16;
        float kf[16];
        unpack8(*(const u32x4*)(sKT + k * 72 + q4), kf); unpack8(*(const u32x4*)(sKT + k * 72 + q4 + 8), kf + 8);
        float ps = 0.f;
#pragma unroll
        for (int j = 0; j < 16; ++j) ps += kf[j];
        nreg = nreg * eb + sum4(ps);
        if (FULL && (tid & 3) == 0) sN[k] = nreg;
      }
    }
    __syncthreads();
  }
  if (!FULL) {
    const size_t it = (size_t)gsid * LA_NSEG + seg;
    float* U = segU + it * 8192;
#pragma unroll
    for (int j = 0; j < 2; ++j)
#pragma unroll
      for (int r = 0; r < 16; ++r) U[(j * 16 + r) * 256 + tid] = accS[j][r];
    if (MLSTM && (tid & 3) == 0) segN[it * 64 + (tid >> 2)] = nreg;
    if (tid == 0) segD[it] = lsum;
  }
}

DEV void st_finish_l0(const Params& P, int row) {
  const int lane = threadIdx.x & 63;
  bf16_t* hb = (bf16_t*)(P.ws + OFF_HBUF) + (size_t)row * 1024;
  const bf16_t* yb = (const bf16_t*)(P.ws + OFF_R2L0) + (size_t)row * 1024;
  const bf16_t* pr = (const bf16_t*)(P.ws + OFF_PROJ) + (size_t)row * EVC;
  const int ch = lane * 8;
  float h0[8], h1[8], o[8], f1[8];
  unpack8(*(const u32x4*)(hb + ch), h0);
  unpack8(*(const u32x4*)(hb + 512 + ch), h1);
  unpack8(*(const u32x4*)(pr + 1024 + ch), o);
  float ss = 0.f;
#pragma unroll
  for (int j = 0; j < 8; ++j) { h0[j] += h1[j]; ss += h0[j] * h0[j]; }
  ss = sum16(ss);
  float rstd = frsq(ss * (1.f / 128.f) + 1e-6f);
  float pw[8]; ld8(P.in[I_MNORM] + ch, pw);
#pragma unroll
  for (int j = 0; j < 8; ++j) f1[j] = h0[j] * rstd * pw[j] * sigmoidf_(o[j]);
  float y0[8], y1[8], z[8], f2[8];
  unpack8(*(const u32x4*)(yb + ch), y0);
  unpack8(*(const u32x4*)(yb + 512 + ch), y1);
  unpack8(*(const u32x4*)(pr + 1552 + ch), z);
  float s2 = 0.f;
#pragma unroll
  for (int j = 0; j < 8; ++j) { y0[j] = (y0[j] + y1[j]) * siluf_(z[j]); s2 += y0[j] * y0[j]; }
  s2 = wave_sum(s2);
  float rstd2 = frsq(s2 * (1.f / 512.f) + 1e-6f);
  ld8(P.in[I_SNORM] + ch, pw);
#pragma unroll
  for (int j = 0; j < 8; ++j) f2[j] = y0[j] * rstd2 * pw[j];
  *(u32x4*)(hb + ch) = pack8(f1);
  *(u32x4*)(hb + 512 + ch) = pack8(f2);
}

DEV float mixval(const bf16_t* __restrict__ proj, int row, int c, const float* __restrict__ mu) {
  float self = bf2f(proj[(size_t)row * ODC + c]);
  int nrow = -1;
  if (row < NCTX) {
    int pos = row % CTXL;
    if (c < 896) { if (pos > 0) nrow = row - 1; }
    else { if (pos < CTXL - 1) nrow = row + 1; }
  } else {
    int pos = (row - NCTX) % SEQ;
    int gx = pos % GW, gy = pos / GW, q = c / 448;
    if (q == 0) { if (gx > 0) nrow = row - 1; }
    else if (q == 1) { if (gx < GW - 1) nrow = row + 1; }
    else if (q == 2) { if (gy > 0) nrow = row - GW; }
    else { if (gy < SEQ / GW - 1) nrow = row + GW; }
  }
  float nb = nrow >= 0 ? bf2f(proj[(size_t)nrow * ODC + c]) : 0.f;
  return self + mu[c] * (nb - self);
}

DEV int nbr_row(int row, int c) {
  if (row < NCTX) {
    int pos = row % CTXL;
    if (c < 896) return pos > 0 ? row - 1 : -1;
    return pos < CTXL - 1 ? row + 1 : -1;
  }
  int pos = (row - NCTX) % SEQ;
  int gx = pos % GW, gy = pos / GW, q = c / 448;
  if (q == 0) return gx > 0 ? row - 1 : -1;
  if (q == 1) return gx < GW - 1 ? row + 1 : -1;
  if (q == 2) return gy > 0 ? row - GW : -1;
  return gy < SEQ / GW - 1 ? row + GW : -1;
}

DEV void mix8(const bf16_t* __restrict__ proj, int row, int c, const float* __restrict__ mu, float* o) {
  float xs[8], xn[8];
  unpack8(*(const u32x4*)(proj + (size_t)row * ODC + c), xs);
  const int nr = nbr_row(row, c);
  if (nr >= 0) unpack8(*(const u32x4*)(proj + (size_t)nr * ODC + c), xn);
  else {
#pragma unroll
    for (int j = 0; j < 8; ++j) xn[j] = 0.f;
  }
  const f32x4 m0 = *(const f32x4*)(mu + c), m1 = *(const f32x4*)(mu + c + 4);
  const float mm[8] = {m0.x, m0.y, m0.z, m0.w, m1.x, m1.y, m1.z, m1.w};
#pragma unroll
  for (int j = 0; j < 8; ++j) o[j] = xs[j] + mm[j] * (xn[j] - xs[j]);
}

DEV void st_lora_act(const Params& P, int row2) {
  const int lane = threadIdx.x & 63;
  const int row = row2 + (lane >> 5), c = (lane & 31) * 8;
  const bf16_t* proj = (const bf16_t*)(P.ws + OFF_PROJ);
  bf16_t* hb = (bf16_t*)(P.ws + OFF_HBUF) + (size_t)row * 1024;
  float v[8];
  mix8(proj, row, 1536 + c, P.in[I_MU], v);
#pragma unroll
  for (int j = 0; j < 8; ++j) v[j] = c < 64 ? tanhf_(v[j]) : (c < 128 ? v[j] : sigmoidf_(v[j]));
  *(u32x4*)(hb + c) = pack8(v);
}

DEV void st_rwkv_stream(const Params& P, int sid, unsigned char* smem) {
  const int tid = threadIdx.x, lane = tid & 63, wave = tid >> 6;
  const int d = sid & 1, h = (sid >> 1) & 7, b = sid >> 4;
  float* sR = (float*)smem;
  float* sW = sR + 2048;
  float* sKk = sW + 2048;
  float* sV = sKk + 2048;
  float* sA = sV + 2048;
  float* sBb = sA + 2048;
  float* sY = sBb + 2048;
  int* sRow = (int*)(sY + 2048);
  const bf16_t* proj = (const bf16_t*)(P.ws + OFF_PROJ);
  const bf16_t* lora = (const bf16_t*)(P.ws + OFF_LORA);
  bf16_t* yout = (bf16_t*)(P.ws + OFF_HBUF);
  const float* mu = P.in[I_MU];
  const int vrow = tid >> 2, j4 = tid & 3;
  float S[16];
#pragma unroll
  for (int i = 0; i < 16; ++i) S[i] = 0.f;
  const float kkw = P.in[I_KK][h * 64 + lane], kaw = P.in[I_KA][h * 64 + lane];
  for (int seg = 0; seg < 2; ++seg) {
    const int row0 = seg == 0 ? b * CTXL : NCTX + b * SEQ;
    const int len = seg == 0 ? CTXL : SEQ;
    for (int it = 0; it < len / 32; ++it) {
      __syncthreads();
      for (int s = wave; s < 32; s += 4) {
        int p = it * 32 + s, pos = d ? len - 1 - p : p, row = row0 + pos;
        int c = h * 64 + lane;
        float r = mixval(proj, row, c, mu);
        float k = mixval(proj, row, 512 + c, mu);
        float v = mixval(proj, row, 1024 + c, mu);
        float kk = k * kkw;
        float ss = wave_sum(kk * kk);
        kk *= frsq(ss + 1e-12f);
        float lw = bf2f(lora[((size_t)d * NTOK + row) * 512 + c]);
        float la = bf2f(lora[((size_t)(2 + d) * NTOK + row) * 512 + c]);
        float w = fexp(-0.6065306597126334f * sigmoidf_(lw));
        float a = sigmoidf_(la);
        float kt = k * (1.f + (a - 1.f) * kaw);
        sR[s * 64 + lane] = r; sW[s * 64 + lane] = w; sKk[s * 64 + lane] = kt; sV[s * 64 + lane] = v;
        sA[s * 64 + lane] = -kk; sBb[s * 64 + lane] = kk * a;
        if (lane == 0) sRow[s] = row;
      }
      __syncthreads();
      for (int s = 0; s < 32; ++s) {
        const float* pa = sA + s * 64 + j4 * 16;
        const float* pw = sW + s * 64 + j4 * 16;
        const float* pk = sKk + s * 64 + j4 * 16;
        const float* pb = sBb + s * 64 + j4 * 16;
        const float* pr = sR + s * 64 + j4 * 16;
        const float vv = sV[s * 64 + vrow];
        float sa = 0.f;
#pragma unroll
        for (int i = 0; i < 16; ++i) sa += S[i] * pa[i];
        sa = sum4(sa);
        float y = 0.f;
#pragma unroll
        for (int i = 0; i < 16; ++i) { S[i] = S[i] * pw[i] + sa * pb[i] + vv * pk[i]; y += S[i] * pr[i]; }
        y = sum4(y);
        if (j4 == 0) sY[s * 64 + vrow] = y;
      }
      __syncthreads();
      for (int i = tid; i < 2048; i += 256) {
        int s = i >> 6, c = i & 63;
        yout[(size_t)sRow[s] * 1024 + d * 512 + h * 64 + c] = f2bf(sY[i]);
      }
    }
  }
}


struct RwkvRaw { u32x4 rs, rn, ks, kn, vs, vn, lw, la; int row; };

DEV void rwkv_load_raw(const bf16_t* __restrict__ proj, const bf16_t* __restrict__ lora, int b, int h, int d, int cc, int t, int c0,
                       RwkvRaw& R) {
  constexpr int NC_CTX = CTXL / 32;
  const int seg = cc >= NC_CTX;
  const int row0 = seg ? NCTX + b * SEQ : b * CTXL;
  const int len = seg ? SEQ : CTXL;
  const int p = (seg ? cc - NC_CTX : cc) * 32 + t;
  const int row = row0 + (d ? len - 1 - p : p);
  const int col = h * 64 + c0;
  const u32x4 z4 = {0u, 0u, 0u, 0u};
  const bf16_t* rp = proj + (size_t)row * ODC;
  R.row = row;
  R.rs = *(const u32x4*)(rp + col);
  R.ks = *(const u32x4*)(rp + 512 + col);
  R.vs = *(const u32x4*)(rp + 1024 + col);
  int n0 = nbr_row(row, col), n1 = nbr_row(row, 512 + col), n2 = nbr_row(row, 1024 + col);
  R.rn = n0 >= 0 ? *(const u32x4*)(proj + (size_t)n0 * ODC + col) : z4;
  R.kn = n1 >= 0 ? *(const u32x4*)(proj + (size_t)n1 * ODC + 512 + col) : z4;
  R.vn = n2 >= 0 ? *(const u32x4*)(proj + (size_t)n2 * ODC + 1024 + col) : z4;
  R.lw = *(const u32x4*)(lora + ((size_t)d * NTOK + row) * 512 + col);
  R.la = *(const u32x4*)(lora + ((size_t)(2 + d) * NTOK + row) * 512 + col);
}

#ifndef RW_NSEG
#define RW_NSEG 16
#endif
constexpr int RW_NCH = (CTXL + SEQ) / 32;
constexpr size_t OFF_RWSEG = OFF_PU;
static_assert((size_t)32 * RW_NSEG * 64 * 128 * 4 <= (size_t)2 * NEXP * 1024, "rwseg");

template <bool FULL>
DEV void st_rwkv_seg(const Params& P, int sid, int seg, unsigned char* smem) {
  constexpr int NVB = FULL ? 2 : 4;
  constexpr int ZR = FULL ? 64 : 128;
  const int tid = threadIdx.x, lane = tid & 63, wave = tid >> 6;
  const int d = sid & 1, h = (sid >> 1) & 7, b = sid >> 4;
  bf16_t* sAt = (bf16_t*)smem;
  bf16_t* sRt = sAt + 32 * 72;
  bf16_t* sBt = sRt + 32 * 72;
  bf16_t* sKt = sBt + 32 * 72;
  bf16_t* sBT = sKt + 32 * 72;
  bf16_t* sKT = sBT + 64 * 40;
  bf16_t* sVT = sKT + 64 * 40;
  bf16_t* sLak = sVT + 64 * 40;
  bf16_t* sM = sLak + 32 * 40;
  bf16_t* sLrb = sM + 32 * 40;
  bf16_t* sLrk = sLrb + 32 * 40;
  bf16_t* sZ = FULL ? sLrk + 32 * 40 : sLrb;
  bf16_t* after = sZ + ZR * 72;
  bf16_t* sRT = after;
  bf16_t* sSAT = FULL ? after + 64 * 40 : sRt;
  float* sLP = (float*)(FULL ? after + 2 * 64 * 40 : after + 128 * 40);
  float* sLab = sLP + 4 * 64;
  float* sD = sLab + 32 * 36;
  float* sPT = sD + 768;
  int* sRow = (int*)(sPT + 64);
  static_assert((4 * 32 * 72 + 3 * 64 * 40 + 4 * 32 * 40 + 2 * 64 * 40 + 64 * 72) * 2 + (4 * 64 + 32 * 36 + 768 + 64 + 32 + 320) * 4 + 16 <= SMEM_BYTES, "lds full");
  static_assert((4 * 32 * 72 + 3 * 64 * 40 + 2 * 32 * 40 + 128 * 72 + 128 * 40) * 2 + (4 * 64 + 32 * 36 + 768 + 64 + 32 + 320) * 4 + 16 <= SMEM_BYTES, "lds p1");
  static_assert(128 * 40 <= 3 * 32 * 72, "alias");
  const bf16_t* proj = (const bf16_t*)(P.ws + OFF_PROJ);
  const bf16_t* lora = (const bf16_t*)(P.ws + OFF_LORA);
  bf16_t* yout = (bf16_t*)(P.ws + OFF_HBUF);
  float* segZ = (float*)(P.ws + OFF_RWSEG);
  const int t = tid >> 3, c0 = (tid & 7) * 8;
  const int hl = lane >> 5, l31 = lane & 31;
  float* sCst = (float*)(smem + SMEM_BYTES - 320 * 4 - 16);
  if (tid < 64) {
    sCst[tid] = P.in[I_MU][h * 64 + tid]; sCst[64 + tid] = P.in[I_MU][512 + h * 64 + tid]; sCst[128 + tid] = P.in[I_MU][1024 + h * 64 + tid];
    sCst[192 + tid] = P.in[I_KK][h * 64 + tid]; sCst[256 + tid] = P.in[I_KA][h * 64 + tid];
  }
  const int cc0 = (seg * RW_NCH) / RW_NSEG, cc1 = ((seg + 1) * RW_NCH) / RW_NSEG;
  RwkvRaw R;
  rwkv_load_raw(proj, lora, b, h, d, cc0, t, c0, R);
  f32x16 Zm[2];
#pragma unroll
  for (int j = 0; j < 2; ++j)
#pragma unroll
    for (int r = 0; r < 16; ++r) Zm[j][r] = 0.f;
  __syncthreads();
  for (int i = tid; i < ZR * 72; i += 256) sZ[i] = 0;
  __syncthreads();
  if (!FULL) {
    if (wave >= 2) {
#pragma unroll
      for (int cb = 0; cb < 2; ++cb)
#pragma unroll
        for (int r = 0; r < 16; ++r) {
          int c = cb * 32 + acc_row(r, lane), vp = wave * 32 + l31;
          if (c == vp - 64) { Zm[cb][r] = 1.f; sZ[vp * 72 + c] = 0x3f80; }
        }
    }
  } else {
    for (int js = 0; js < seg; ++js) {
      const float* Zs = segZ + ((size_t)sid * RW_NSEG + js) * 64 * 128;
      bf16_t* sG = sAt;
      {
        const int c = tid >> 2, c2 = (tid & 3) * 16;
        float gv[16];
        ld8(Zs + c * 128 + 64 + c2, gv); ld8(Zs + c * 128 + 64 + c2 + 8, gv + 8);
        *(u32x4*)(sG + c * 72 + c2) = pack8(gv);
        *(u32x4*)(sG + c * 72 + c2 + 8) = pack8(gv + 8);
      }
      __syncthreads();
      if (wave >= 2) {
        const int cb = wave - 2;
#pragma unroll
        for (int vb = 0; vb < 2; ++vb) {
          f32x16 acc;
#pragma unroll
          for (int r = 0; r < 16; ++r) acc[r] = Zs[(cb * 32 + acc_row(r, lane)) * 128 + vb * 32 + l31];
#pragma unroll
          for (int kk = 0; kk < 4; ++kk) {
            bf16x8 a = *(const bf16x8*)(sG + (cb * 32 + l31) * 72 + kk * 16 + 8 * hl);
            bf16x8 bb = *(const bf16x8*)(sZ + (vb * 32 + l31) * 72 + kk * 16 + 8 * hl);
            acc = mfma32(a, bb, acc);
          }
          Zm[vb] = acc;
        }
      }
      __syncthreads();
      if (wave >= 2) {
        const int cb = wave - 2;
#pragma unroll
        for (int vb = 0; vb < 2; ++vb)
#pragma unroll
          for (int g = 0; g < 4; ++g) {
            u32x2 pk; pk.x = pack2(Zm[vb][4 * g], Zm[vb][4 * g + 1]); pk.y = pack2(Zm[vb][4 * g + 2], Zm[vb][4 * g + 3]);
            *(u32x2*)(sZ + (vb * 32 + l31) * 72 + cb * 32 + 8 * g + 4 * hl) = pk;
          }
      }
      __syncthreads();
    }
  }
  for (int cc = cc0; cc < cc1; ++cc) {
    int tl_ = threadIdx.x; OPAQUE(tl_);
    const int tid = tl_, lane = tl_ & 63, hl = lane >> 5, l31 = lane & 31, t = tl_ >> 3, c0 = (tl_ & 7) * 8;
    const float* muR = sCst + c0; const float* muK = sCst + 64 + c0; const float* muV = sCst + 128 + c0;
    const float* kkw = sCst + 192 + c0; const float* kaw = sCst + 256 + c0;
    float lw8[8], lp8[8];
    {
      float lwf[8];
      unpack8(R.lw, lwf);
#pragma unroll
      for (int j = 0; j < 8; ++j) { lw8[j] = lwf[j]; lp8[j] = lw8[j]; }
#pragma unroll
      for (int off = 8; off < 64; off <<= 1) {
#pragma unroll
        for (int j = 0; j < 8; ++j) {
#ifdef CPU_EMU
          float o = emu_shfl_up(lp8[j], off);
#else
          float o = __shfl_up(lp8[j], off, 64);
#endif
          if (lane >= off) lp8[j] += o;
        }
      }
      if (lane >= 56) {
#pragma unroll
        for (int j = 0; j < 8; ++j) sLP[wave * 64 + c0 + j] = lp8[j];
      }
      if ((tid & 7) == 0) sRow[t] = R.row;
    }
    __syncthreads();
    {
#pragma unroll
      for (int j = 0; j < 8; ++j) {
        float offs = 0.f;
        for (int w2 = 0; w2 < wave; ++w2) offs += sLP[w2 * 64 + c0 + j];
        lp8[j] += offs;
      }
      if (t == 31) {
#pragma unroll
        for (int j = 0; j < 8; ++j) sPT[c0 + j] = fexp(lp8[j]);
      }
    }
    {
      float xs[8], xn[8], kt[8], aa[8], ob[8], ok[8];
      unpack8(R.ks, xs); unpack8(R.kn, xn);
      float ss = 0.f;
#pragma unroll
      for (int j = 0; j < 8; ++j) { kt[j] = xs[j] + muK[j] * (xn[j] - xs[j]); aa[j] = kt[j] * kkw[j]; ss += aa[j] * aa[j]; }
      ss = sum8(ss);
      const float rn = frsq(ss + 1e-12f);
      float laf[8];
      unpack8(R.la, laf);
#pragma unroll
      for (int j = 0; j < 8; ++j) {
        const float lp = lp8[j];
        const float lpm = lp8[j] - lw8[j];
        const float e = fexp(-lp);
        const float kkn = aa[j] * rn;
        const float asg = laf[j];
        aa[j] = -kkn * fexp(lpm);
        ob[j] = kkn * asg * e;
        ok[j] = kt[j] * (1.f + (asg - 1.f) * kaw[j]) * e;
      }
      *(u32x4*)(sAt + t * 72 + c0) = pack8(aa);
      *(u32x4*)(sBt + t * 72 + c0) = pack8(ob);
      *(u32x4*)(sKt + t * 72 + c0) = pack8(ok);
#pragma unroll
      for (int j = 0; j < 8; ++j) { sBT[(c0 + j) * 40 + (t ^ swz32(c0))] = f2bf(ob[j]); sKT[(c0 + j) * 40 + (t ^ swz32(c0))] = f2bf(ok[j]); }
      unpack8(R.vs, xs); unpack8(R.vn, xn);
#pragma unroll
      for (int j = 0; j < 8; ++j) sVT[(c0 + j) * 40 + (t ^ swz32(c0))] = f2bf(xs[j] + muV[j] * (xn[j] - xs[j]));
      if (FULL) {
        unpack8(R.rs, xs); unpack8(R.rn, xn);
#pragma unroll
        for (int j = 0; j < 8; ++j) xs[j] = (xs[j] + muR[j] * (xn[j] - xs[j])) * fexp(lp8[j]);
        *(u32x4*)(sRt + t * 72 + c0) = pack8(xs);
      }
    }
    if (cc + 1 < cc1) rwkv_load_raw(proj, lora, b, h, d, cc + 1, t, c0, R);
    __syncthreads();
    if (FULL || wave < 2) {
      const bf16_t* Asrc = wave < 2 ? sAt : sRt;
      const bf16_t* Bsrc = (wave & 1) ? sKt : sBt;
      f32x16 acc;
#pragma unroll
      for (int r = 0; r < 16; ++r) acc[r] = 0.f;
#pragma unroll
      for (int kk = 0; kk < 4; ++kk) {
        bf16x8 a = *(const bf16x8*)(Asrc + l31 * 72 + kk * 16 + 8 * hl);
        bf16x8 bb = *(const bf16x8*)(Bsrc + l31 * 72 + kk * 16 + 8 * hl);
        acc = mfma32(a, bb, acc);
      }
      bf16_t* dst = wave == 1 ? sLak : (wave == 2 ? sLrb : sLrk);
#pragma unroll
      for (int r = 0; r < 16; ++r) {
        int tt = acc_row(r, lane), j = l31;
        bool keep = wave < 2 ? (j < tt) : (j <= tt);
        float v = keep ? acc[r] : 0.f;
        if (wave == 0) sLab[tt * 36 + j] = v;
        else dst[tt * 40 + j] = f2bf(v);
      }
    }
    __syncthreads();
    auto rhs_block = [&](int vb) {
      f32x16 acc;
#pragma unroll
      for (int r = 0; r < 16; ++r) acc[r] = 0.f;
#pragma unroll
      for (int kk = 0; kk < 4; ++kk) {
        bf16x8 a = *(const bf16x8*)(sAt + l31 * 72 + kk * 16 + 8 * hl);
        bf16x8 bb = *(const bf16x8*)(sZ + (vb * 32 + l31) * 72 + kk * 16 + 8 * hl);
        acc = mfma32(a, bb, acc);
      }
      if (vb < 2) {
#pragma unroll
        for (int kk = 0; kk < 2; ++kk) {
          bf16x8 a = *(const bf16x8*)(sLak + l31 * 40 + kk * 16 + 8 * hl);
          bf16x8 bb = *(const bf16x8*)(sVT + (vb * 32 + l31) * 40 + ((kk * 16 + 8 * hl) ^ swz32(l31)));
          acc = mfma32(a, bb, acc);
        }
      }
#pragma unroll
      for (int g = 0; g < 4; ++g) {
        u32x2 pk; pk.x = pack2(acc[4 * g], acc[4 * g + 1]); pk.y = pack2(acc[4 * g + 2], acc[4 * g + 3]);
        *(u32x2*)(sRT + (vb * 32 + l31) * 40 + 8 * g + 4 * hl) = pk;
      }
    };
    if (wave == 0) {
      if (tid < 32) {
        const int q = tid >> 4, c = tid & 15;
        const float* Lq = sLab + (q * 16) * 36 + q * 16;
        float x[16];
#pragma unroll
        for (int i = 0; i < 16; ++i) {
          float s0 = (i == c) ? 1.f : 0.f, s1 = 0.f;
#pragma unroll
          for (int j4 = 0; j4 < i; j4 += 4) {
            const f32x4 l4 = *(const f32x4*)(Lq + i * 36 + j4);
            s0 += l4.x * x[j4];
            if (j4 + 1 < i) s1 += l4.y * x[j4 + 1];
            if (j4 + 2 < i) s0 += l4.z * x[j4 + 2];
            if (j4 + 3 < i) s1 += l4.w * x[j4 + 3];
          }
          x[i] = s0 + s1;
          sD[q * 256 + i * 16 + c] = x[i];
        }
      }
    } else if (FULL) {
      if (wave >= 2) rhs_block(wave - 2);
    } else {
      if (wave == 1) { rhs_block(0); rhs_block(1); }
      else rhs_block(wave);
    }
    __syncthreads();
    {
      const int i = tid >> 4, c = tid & 15;
      float sacc = 0.f;
#pragma unroll
      for (int j4 = 0; j4 < 16; j4 += 4) {
        const f32x4 l4 = *(const f32x4*)(sLab + (16 + i) * 36 + j4);
        sacc += l4.x * sD[j4 * 16 + c] + l4.y * sD[(j4 + 1) * 16 + c] + l4.z * sD[(j4 + 2) * 16 + c] + l4.w * sD[(j4 + 3) * 16 + c];
      }
      sD[512 + i * 16 + c] = sacc;
    }
    __syncthreads();
    {
      const int i = tid >> 4, c = tid & 15;
      float sacc = 0.f;
#pragma unroll
      for (int j4 = 0; j4 < 16; j4 += 4) {
        const f32x4 d4 = *(const f32x4*)(sD + 256 + i * 16 + j4);
        sacc += d4.x * sD[512 + j4 * 16 + c] + d4.y * sD[512 + (j4 + 1) * 16 + c] + d4.z * sD[512 + (j4 + 2) * 16 + c] + d4.w * sD[512 + (j4 + 3) * 16 + c];
      }
      sM[(16 + i) * 40 + c] = f2bf(sacc);
      sM[i * 40 + c] = f2bf(sD[i * 16 + c]);
      sM[(16 + i) * 40 + 16 + c] = f2bf(sD[256 + i * 16 + c]);
      sM[i * 40 + 16 + c] = 0;
    }
    __syncthreads();
    if (wave < NVB) {
      const int vb = wave;
      f32x16 acc;
#pragma unroll
      for (int r = 0; r < 16; ++r) acc[r] = 0.f;
#pragma unroll
      for (int kk = 0; kk < 2; ++kk) {
        bf16x8 a = *(const bf16x8*)(sM + l31 * 40 + kk * 16 + 8 * hl);
        bf16x8 bb = *(const bf16x8*)(sRT + (vb * 32 + l31) * 40 + kk * 16 + 8 * hl);
        acc = mfma32(a, bb, acc);
      }
#pragma unroll
      for (int g = 0; g < 4; ++g) {
        u32x2 pk; pk.x = pack2(acc[4 * g], acc[4 * g + 1]); pk.y = pack2(acc[4 * g + 2], acc[4 * g + 3]);
        *(u32x2*)(sSAT + (vb * 32 + l31) * 40 + 8 * g + 4 * hl) = pk;
      }
    }
    __syncthreads();
    if (FULL) {
      if (wave < 2) {
        const int vb = wave;
        f32x16 acc;
#pragma unroll
        for (int r = 0; r < 16; ++r) acc[r] = 0.f;
#pragma unroll
        for (int kk = 0; kk < 4; ++kk) {
          bf16x8 a = *(const bf16x8*)(sZ + (vb * 32 + l31) * 72 + kk * 16 + 8 * hl);
          bf16x8 bb = *(const bf16x8*)(sRt + l31 * 72 + kk * 16 + 8 * hl);
          acc = mfma32(a, bb, acc);
        }
#pragma unroll
        for (int kk = 0; kk < 2; ++kk) {
          bf16x8 a = *(const bf16x8*)(sSAT + (vb * 32 + l31) * 40 + kk * 16 + 8 * hl);
          bf16x8 bb = *(const bf16x8*)(sLrb + l31 * 40 + kk * 16 + 8 * hl);
          acc = mfma32(a, bb, acc);
        }
#pragma unroll
        for (int kk = 0; kk < 2; ++kk) {
          bf16x8 a = *(const bf16x8*)(sVT + (vb * 32 + l31) * 40 + ((kk * 16 + 8 * hl) ^ swz32(l31)));
          bf16x8 bb = *(const bf16x8*)(sLrk + l31 * 40 + kk * 16 + 8 * hl);
          acc = mfma32(a, bb, acc);
        }
        {
          const size_t obase = (size_t)sRow[l31] * 1024 + d * 512 + h * 64 + vb * 32;
#pragma unroll
          for (int g = 0; g < 4; ++g) {
            u32x2 pk; pk.x = pack2(acc[4 * g], acc[4 * g + 1]); pk.y = pack2(acc[4 * g + 2], acc[4 * g + 3]);
            *(u32x2*)(yout + obase + 8 * g + 4 * hl) = pk;
          }
        }
      } else {
        const int cb = wave - 2;
#pragma unroll
        for (int vb = 0; vb < 2; ++vb) {
          f32x16 acc;
#pragma unroll
          for (int r = 0; r < 16; ++r) acc[r] = 0.f;
#pragma unroll
          for (int kk = 0; kk < 2; ++kk) {
            bf16x8 a = *(const bf16x8*)(sBT + (cb * 32 + l31) * 40 + ((kk * 16 + 8 * hl) ^ swz32(l31)));
            bf16x8 bb = *(const bf16x8*)(sSAT + (vb * 32 + l31) * 40 + kk * 16 + 8 * hl);
            acc = mfma32(a, bb, acc);
          }
#pragma unroll
          for (int kk = 0; kk < 2; ++kk) {
            bf16x8 a = *(const bf16x8*)(sKT + (cb * 32 + l31) * 40 + ((kk * 16 + 8 * hl) ^ swz32(l31)));
            bf16x8 bb = *(const bf16x8*)(sVT + (vb * 32 + l31) * 40 + ((kk * 16 + 8 * hl) ^ swz32(l31)));
            acc = mfma32(a, bb, acc);
          }
#pragma unroll
          for (int r = 0; r < 16; ++r) Zm[vb][r] = sPT[cb * 32 + acc_row(r, lane)] * (Zm[vb][r] + acc[r]);
        }
      }
      __syncthreads();
      if (wave >= 2) {
        const int cb = wave - 2;
#pragma unroll
        for (int vb = 0; vb < 2; ++vb)
#pragma unroll
          for (int g = 0; g < 4; ++g) {
            u32x2 pk; pk.x = pack2(Zm[vb][4 * g], Zm[vb][4 * g + 1]); pk.y = pack2(Zm[vb][4 * g + 2], Zm[vb][4 * g + 3]);
            *(u32x2*)(sZ + (vb * 32 + l31) * 72 + cb * 32 + 8 * g + 4 * hl) = pk;
          }
      }
    } else {
      const int vb = wave;
#pragma unroll
      for (int cb = 0; cb < 2; ++cb) {
        f32x16 acc;
#pragma unroll
        for (int r = 0; r < 16; ++r) acc[r] = 0.f;
#pragma unroll
        for (int kk = 0; kk < 2; ++kk) {
          bf16x8 a = *(const bf16x8*)(sBT + (cb * 32 + l31) * 40 + ((kk * 16 + 8 * hl) ^ swz32(l31)));
          bf16x8 bb = *(const bf16x8*)(sSAT + (vb * 32 + l31) * 40 + kk * 16 + 8 * hl);
          acc = mfma32(a, bb, acc);
        }
        if (vb < 2) {
#pragma unroll
          for (int kk = 0; kk < 2; ++kk) {
            bf16x8 a = *(const bf16x8*)(sKT + (cb * 32 + l31) * 40 + ((kk * 16 + 8 * hl) ^ swz32(l31)));
            bf16x8 bb = *(const bf16x8*)(sVT + (vb * 32 + l31) * 40 + ((kk * 16 + 8 * hl) ^ swz32(l31)));
            acc = mfma32(a, bb, acc);
          }
        }
#pragma unroll
        for (int r = 0; r < 16; ++r) Zm[cb][r] = sPT[cb * 32 + acc_row(r, lane)] * (Zm[cb][r] + acc[r]);
      }
#pragma unroll
      for (int cb = 0; cb < 2; ++cb)
#pragma unroll
        for (int g = 0; g < 4; ++g) {
          u32x2 pk; pk.x = pack2(Zm[cb][4 * g], Zm[cb][4 * g + 1]); pk.y = pack2(Zm[cb][4 * g + 2], Zm[cb][4 * g + 3]);
          *(u32x2*)(sZ + (vb * 32 + l31) * 72 + cb * 32 + 8 * g + 4 * hl) = pk;
        }
    }
  }
  if (!FULL) {
    float* Zs = segZ + ((size_t)sid * RW_NSEG + seg) * 64 * 128;
#pragma unroll
    for (int cb = 0; cb < 2; ++cb)
#pragma unroll
      for (int r = 0; r < 16; ++r) Zs[(cb * 32 + acc_row(r, lane)) * 128 + wave * 32 + l31] = Zm[cb][r];
  }
}

constexpr int LRU_NCH = (CTXL + SEQ) / 64;
constexpr size_t OFF_ACUM0 = OFF_PU;
static_assert((size_t)NLAT * 512 * 2 <= (size_t)2 * NEXP * 1024, "acum0");

struct LruRaw { u32x4 x[2][4]; };
DEV void lru_load_raw(const Params& P, int sid, int cc, LruRaw& R) {
  constexpr int NC_CTX = CTXL / 64;
  const int tid = threadIdx.x;
  const int d = sid & 1, blk = (sid >> 1) & 7, b = sid >> 4;
  const bf16_t* proj = (const bf16_t*)(P.ws + OFF_PROJ);
  const int sgi = cc >= NC_CTX;
  const int row0 = sgi ? NCTX + b * SEQ : b * CTXL;
  const int len = sgi ? SEQ : CTXL;
  const int cl = (sgi ? cc - NC_CTX : cc) * 64;
  const int lch = blk * 64 + (tid & 7) * 8;
  const u32x4 z4 = {0u, 0u, 0u, 0u};
#pragma unroll
  for (int i = 0; i < 2; ++i) {
    int c = tid + i * 256, r = c >> 3;
    int p = cl + r, pos = d ? len - 1 - p : p;
#pragma unroll
    for (int tap = 0; tap < 4; ++tap) {
      int pp = pos + tap - 2;
      R.x[i][tap] = (pp >= 0 && pp < len) ? *(const u32x4*)(proj + (size_t)(row0 + pp) * ODC + 2304 + lch) : z4;
    }
  }
}

DEV void st_lru_chunk(const Params& P, int sid, int cc, int nsid, int ncc, bool has_next, LruRaw& R, unsigned char* smem) {
  constexpr int NC_CTX = CTXL / 64;
  const int tid = threadIdx.x, lane = tid & 63, wave = tid >> 6;
  const int d = sid & 1, blk = (sid >> 1) & 7, b = sid >> 4;
  float* sXc = (float*)smem;
  float* sAc = sXc + 4096;
  float* sBc = sAc + 4096;
  float* sU = sBc + 4096;
  bf16_t* sAop = (bf16_t*)(sU + 4096);
  float* sQA = (float*)(sAop + 64 * 72);
  float* sQH = sQA + 256;
  int* sRow = (int*)(sQH + 256);
  const bf16_t* proj = (const bf16_t*)(P.ws + OFF_PROJ);
  bf16_t* uout = (bf16_t*)(P.ws + OFF_LORA) + (size_t)d * NTOK * 512;
  bf16_t* aout = (bf16_t*)(P.ws + (d ? OFF_ACUM1 : OFF_ACUM0));
  const bf16_t* lruT = (const bf16_t*)(P.ws + OFF_LRUT) + (size_t)(d * 8 + blk) * 128 * 64;
  float* chunkS = (float*)(P.ws + OFF_LRUCS) + ((size_t)sid * LRU_NCH + cc) * 128;
  const float* cw = P.in[I_LCONVW];
  const float* cb = P.in[I_LCONVB];
  const int tr = (wave >> 1) * 32, nc0 = (wave & 1) * 64;
  const int sgi = cc >= NC_CTX;
  const int row0 = sgi ? NCTX + b * SEQ : b * CTXL;
  const int len = sgi ? SEQ : CTXL;
  const int cl = (sgi ? cc - NC_CTX : cc) * 64;
  __syncthreads();
  if (tid < 64) { int p = cl + tid; sRow[tid] = row0 + (d ? len - 1 - p : p); }
  {
    const int lc8 = (tid & 7) * 8, lch = blk * 64 + lc8;
#pragma unroll
    for (int i = 0; i < 2; ++i) {
      int c = tid + i * 256, r = c >> 3;
      int p = cl + r, pos = d ? len - 1 - p : p;
      float o[8];
      f32x4 c0 = *(const f32x4*)(cb + lch), c1 = *(const f32x4*)(cb + lch + 4);
      o[0] = c0.x; o[1] = c0.y; o[2] = c0.z; o[3] = c0.w; o[4] = c1.x; o[5] = c1.y; o[6] = c1.z; o[7] = c1.w;
#pragma unroll
      for (int tap = 0; tap < 4; ++tap) {
        float x[8];
        unpack8(R.x[i][tap], x);
        f32x4 w0 = *(const f32x4*)(cw + tap * 512 + lch), w1 = *(const f32x4*)(cw + tap * 512 + lch + 4);
        o[0] += w0.x * x[0]; o[1] += w0.y * x[1]; o[2] += w0.z * x[2]; o[3] += w0.w * x[3];
        o[4] += w1.x * x[4]; o[5] += w1.y * x[5]; o[6] += w1.z * x[6]; o[7] += w1.w * x[7];
      }
#pragma unroll
      for (int j = 0; j < 8; ++j) sXc[r * 64 + lc8 + j] = o[j];
      *(u32x4*)(sAop + r * 72 + lc8) = pack8(o);
    }
  }
  if (has_next) lru_load_raw(P, nsid, ncc, R);
  __syncthreads();
  {
    f32x16 acc[2];
#pragma unroll
    for (int j = 0; j < 2; ++j)
#pragma unroll
      for (int r = 0; r < 16; ++r) acc[j][r] = 0.f;
#pragma unroll
    for (int kk = 0; kk < 4; ++kk) {
      bf16x8 a = *(const bf16x8*)(sAop + (tr + (lane & 31)) * 72 + kk * 16 + 8 * (lane >> 5));
#pragma unroll
      for (int j = 0; j < 2; ++j) {
        bf16x8 bb = *(const bf16x8*)(lruT + (nc0 + j * 32 + (lane & 31)) * 64 + kk * 16 + 8 * (lane >> 5));
        acc[j] = mfma32(a, bb, acc[j]);
      }
    }
#pragma unroll
    for (int j = 0; j < 2; ++j) {
      const int e = nc0 + j * 32 + (lane & 31);
      const int ch = blk * 64 + (e & 63);
      const float ebias = e < 64 ? P.in[I_BA][d * 512 + ch] : P.in[I_BI][d * 512 + ch];
      const float esp = softplusf_(-P.in[I_LAM][d * 512 + ch]);
#pragma unroll
      for (int r = 0; r < 16; ++r) {
        int t = tr + acc_row(r, lane);
        float g = sigmoidf_(acc[j][r] + ebias);
        if (e < 64) { float a_ = fexp(-8.f * g * esp); sAc[t * 64 + e] = a_; sU[t * 64 + e] = fsqrt(fmaxf(1.f - a_ * a_, 0.f)); }
        else sBc[t * 64 + (e - 64)] = g * sXc[t * 64 + (e - 64)];
      }
    }
  }
  __syncthreads();
  const int c = tid & 63, q = tid >> 6;
  {
    float h = 0.f, ap = 1.f;
#pragma unroll 4
    for (int i = 0; i < 16; ++i) {
      const int t = q * 16 + i;
      const float a = sAc[t * 64 + c];
      h = a * h + sU[t * 64 + c] * sBc[t * 64 + c];
      ap *= a;
      sU[t * 64 + c] = h; sAc[t * 64 + c] = ap;
    }
    sQA[q * 64 + c] = ap; sQH[q * 64 + c] = h;
  }
  __syncthreads();
  {
    float hin = 0.f, ain = 1.f;
    for (int q2 = 0; q2 < q; ++q2) { hin = sQA[q2 * 64 + c] * hin + sQH[q2 * 64 + c]; ain *= sQA[q2 * 64 + c]; }
    if (q > 0) {
#pragma unroll 4
      for (int i = 0; i < 16; ++i) {
        const int t = q * 16 + i;
        const float ap = sAc[t * 64 + c];
        sU[t * 64 + c] += ap * hin;
        sAc[t * 64 + c] = ap * ain;
      }
    }
    if (q == 3) { chunkS[c] = sAc[63 * 64 + c]; chunkS[64 + c] = sU[63 * 64 + c]; }
  }
  __syncthreads();
  if (sgi) {
#pragma unroll
    for (int i = 0; i < 2; ++i) {
      int cidx = tid + i * 256, r = cidx >> 3, c8 = (cidx & 7) * 8;
      float u8[8], a8[8];
#pragma unroll
      for (int j = 0; j < 8; ++j) { u8[j] = sU[r * 64 + c8 + j]; a8[j] = sAc[r * 64 + c8 + j]; }
      const int row = sRow[r];
      *(u32x4*)(uout + (size_t)row * 512 + blk * 64 + c8) = pack8(u8);
      *(u32x4*)(aout + (size_t)(row - NCTX) * 512 + blk * 64 + c8) = pack8(a8);
    }
  }
}

DEV void st_lru_carry(const Params& P, int sid) {
  const int c = threadIdx.x;
  if (c >= 64) return;
  const float* cs = (const float*)(P.ws + OFF_LRUCS) + (size_t)sid * LRU_NCH * 128;
  float* hs = (float*)(P.ws + OFF_LRUHS) + (size_t)sid * LRU_NCH * 64;
  float h = 0.f;
  for (int cc0 = 0; cc0 < LRU_NCH; cc0 += 10) {
    float a[10], bb[10];
#pragma unroll
    for (int i = 0; i < 10; ++i) { a[i] = cs[(size_t)(cc0 + i) * 128 + c]; bb[i] = cs[(size_t)(cc0 + i) * 128 + 64 + c]; }
#pragma unroll
    for (int i = 0; i < 10; ++i) { hs[(size_t)(cc0 + i) * 64 + c] = h; h = a[i] * h + bb[i]; }
  }
}

DEV void st_finish_l1(const Params& P, int row) {
  const int lane = threadIdx.x & 63;
  bf16_t* hb = (bf16_t*)(P.ws + OFF_HBUF) + (size_t)row * 1024;
  const bf16_t* proj = (const bf16_t*)(P.ws + OFF_PROJ);
  const bf16_t* lora = (const bf16_t*)(P.ws + OFF_LORA);
  const float* mu = P.in[I_MU];
  const int ch = lane * 8;
  float y0[8], y1[8];
  unpack8(*(const u32x4*)(hb + ch), y0);
  unpack8(*(const u32x4*)(hb + 512 + ch), y1);
  float sm = 0.f;
#pragma unroll
  for (int j = 0; j < 8; ++j) { y0[j] += y1[j]; sm += y0[j]; }
  sm = sum8(sm);
  const float mean = sm * (1.f / 64.f);
  float sv = 0.f;
#pragma unroll
  for (int j = 0; j < 8; ++j) { float dlt = y0[j] - mean; sv += dlt * dlt; }
  sv = sum8(sv);
  const float rstd = frsq(sv * (1.f / 64.f) + 64e-5f);
  float a0[8], a1[8], g[8], u0[8], u1[8], gb[8];
  unpack8(*(const u32x4*)(lora + ((size_t)2 * NTOK + row) * 512 + ch), a0);
  unpack8(*(const u32x4*)(lora + ((size_t)3 * NTOK + row) * 512 + ch), a1);
  unpack8(*(const u32x4*)(lora + ((size_t)4 * NTOK + row) * 512 + ch), g);
  unpack8(*(const u32x4*)(lora + ((size_t)0 * NTOK + row) * 512 + ch), u0);
  unpack8(*(const u32x4*)(lora + ((size_t)1 * NTOK + row) * 512 + ch), u1);
  if (row >= NCTX) {
    const int bb_ = (row - NCTX) / SEQ, pos = (row - NCTX) % SEQ, blk = ch >> 6;
    float ac[8];
#pragma unroll
    for (int dd = 0; dd < 2; ++dd) {
      const int pidx = dd ? SEQ - 1 - pos : pos;
      const int cc = CTXL / 64 + pidx / 64;
      const int sid = (bb_ * 8 + blk) * 2 + dd;
      const float* hs = (const float*)(P.ws + OFF_LRUHS) + ((size_t)sid * LRU_NCH + cc) * 64 + (ch & 63);
      unpack8(*(const u32x4*)((const bf16_t*)(P.ws + (dd ? OFF_ACUM1 : OFF_ACUM0)) + (size_t)(row - NCTX) * 512 + ch), ac);
      f32x4 h0 = *(const f32x4*)hs, h1 = *(const f32x4*)(hs + 4);
      float* u = dd ? u1 : u0;
      u[0] += ac[0] * h0.x; u[1] += ac[1] * h0.y; u[2] += ac[2] * h0.z; u[3] += ac[3] * h0.w;
      u[4] += ac[4] * h1.x; u[5] += ac[5] * h1.y; u[6] += ac[6] * h1.z; u[7] += ac[7] * h1.w;
    }
  }
  unpack8(*(const u32x4*)(proj + (size_t)row * ODC + 1792 + ch), gb);
  float rv[8], vv[8], kv[8];
  float sdot = 0.f;
  float pka[8], prk[8], plw[8], plb[8];
  ld8(P.in[I_KA] + ch, pka); ld8(P.in[I_RK] + ch, prk); ld8(P.in[I_LNW] + ch, plw); ld8(P.in[I_LNB] + ch, plb);
  mix8(proj, row, ch, mu, rv);
  mix8(proj, row, 512 + ch, mu, kv);
  mix8(proj, row, 1024 + ch, mu, vv);
#pragma unroll
  for (int j = 0; j < 8; ++j) {
    float r = rv[j];
    float k = kv[j];
    float am = 0.5f * (a0[j] + a1[j]);
    float kb = k * (1.f + (am - 1.f) * pka[j]);
    sdot += r * kb * prk[j];
    rv[j] = r;
  }
  sdot = sum8(sdot);
  float f1[8], f2[8];
#pragma unroll
  for (int j = 0; j < 8; ++j) {
    float yn = (y0[j] - mean) * rstd * plw[j] + plb[j];
    yn += sdot * vv[j];
    f1[j] = yn * g[j];
    f2[j] = (u0[j] + u1[j]) * geluf_(gb[j]);
  }
  *(u32x4*)(hb + ch) = pack8(f1);
  *(u32x4*)(hb + 512 + ch) = pack8(f2);
}

DEV unsigned fkey(float f) { unsigned u; __builtin_memcpy(&u, &f, 4); return (u >> 31) ? ~u : (u | 0x80000000u); }
DEV float keyf(unsigned u) { u = (u >> 31) ? (u & 0x7fffffffu) : ~u; float f; __builtin_memcpy(&f, &u, 4); return f; }
DEV void key_insert(unsigned x, unsigned* v) {
#pragma unroll
  for (int j = 0; j < 16; ++j) { unsigned hi = v[j] > x ? v[j] : x; x = v[j] > x ? x : v[j]; v[j] = hi; }
}
DEV void key_cx(unsigned& hi, unsigned& lo) { unsigned a = hi, b = lo; hi = a > b ? a : b; lo = a > b ? b : a; }
DEV void key_sort16(unsigned* v) {
#pragma unroll
  for (int k = 2; k <= 16; k <<= 1)
#pragma unroll
    for (int j = k >> 1; j > 0; j >>= 1)
#pragma unroll
      for (int i = 0; i < 16; ++i) {
        const int l = i ^ j;
        if (l > i) { if ((i & k) == 0) key_cx(v[i], v[l]); else key_cx(v[l], v[i]); }
      }
}
DEV void key_merge16(unsigned* a, const unsigned* b) {
#pragma unroll
  for (int i = 0; i < 16; ++i) a[i] = a[i] > b[15 - i] ? a[i] : b[15 - i];
#pragma unroll
  for (int j = 8; j > 0; j >>= 1)
#pragma unroll
    for (int i = 0; i < 16; ++i) { const int l = i ^ j; if (l > i) key_cx(a[i], a[l]); }
}

DEV void st_peer_topk(const Params& P, int layer, int tile, int h, unsigned char* smem) {
  const int tid = threadIdx.x;
  const bf16_t* q = (const bf16_t*)(P.ws + OFF_Q);
  const bf16_t* keys = (const bf16_t*)(P.ws + OFF_KEYS) + (size_t)(layer * 8 + h) * 2 * 128 * 128;
  float* sS = (float*)smem;
  const int m0 = tile * 128;
  const int tok = tid & 127, half = tid >> 7;
  unsigned kl[2][16];
#pragma unroll
  for (int p = 0; p < 2; ++p) {
    EpiScoreLds epi{sS, m0};
    gemm_tile_128<true>(q + (h * 2 + p) * 128, 2048, NTOK, keys + p * 128 * 128, 128, 128, 128, m0, 0, epi, smem);
    __syncthreads();
    float* row = sS + tok * 129 + half * 64;
#pragma unroll
    for (int g = 0; g < 4; ++g) {
      unsigned grp[16];
#pragma unroll
      for (int j = 0; j < 16; ++j) grp[j] = (fkey(row[g * 16 + j]) & ~127u) | (unsigned)(127 - (half * 64 + g * 16 + j));
      key_sort16(grp);
      if (g == 0) {
#pragma unroll
        for (int j = 0; j < 16; ++j) kl[p][j] = grp[j];
      } else key_merge16(kl[p], grp);
    }
    if (half == 1) {
#pragma unroll
      for (int j = 0; j < 16; ++j) row[j] = __builtin_bit_cast(float, kl[p][j]);
    }
    __syncthreads();
    if (half == 0) {
      unsigned oth[16];
#pragma unroll
      for (int j = 0; j < 16; ++j) oth[j] = __builtin_bit_cast(unsigned, sS[tok * 129 + 64 + j]);
      key_merge16(kl[p], oth);
    }
    __syncthreads();
  }
  if (tid < 128) {
    float sv0[16], sv1[16];
    int* irow = (int*)(sS + tid * 129);
#pragma unroll
    for (int j = 0; j < 16; ++j) {
      sv0[j] = keyf((kl[0][j] & ~127u) | 64u); sv1[j] = keyf((kl[1][j] & ~127u) | 64u);
      irow[j] = 127 - (int)(kl[0][j] & 127u); irow[16 + j] = 127 - (int)(kl[1][j] & 127u);
    }
    unsigned best[16];
#pragma unroll
    for (int j = 0; j < 16; ++j) best[j] = 0u;
#pragma unroll
    for (int i = 0; i < 16; ++i)
#pragma unroll
      for (int j = 0; j < 16; ++j)
        if ((i + 1) * (j + 1) <= 16) key_insert((fkey(sv0[i] + sv1[j]) & ~255u) | (unsigned)(255 - (i * 16 + j)), best);
    float e[16], sum = 0.f;
    const float b0 = keyf((best[0] & ~255u) | 128u);
#pragma unroll
    for (int j = 0; j < 16; ++j) { e[j] = fexp(keyf((best[j] & ~255u) | 128u) - b0); sum += e[j]; }
    const float inv = 1.f / sum;
    int* pidx = (int*)(P.ws + OFF_PIDX) + (size_t)(m0 + tid) * 128 + h * 16;
    float* pg = (float*)(P.ws + OFF_PGATE) + (size_t)(m0 + tid) * 128 + h * 16;
#pragma unroll
    for (int j = 0; j < 16; ++j) {
      const int pos = 255 - (int)(best[j] & 255u);
      pidx[j] = irow[pos >> 4] * 128 + irow[16 + (pos & 15)];
      pg[j] = e[j] * inv;
    }
  }
}

DEV void st_peer_experts(const Params& P, int layer, int row) {
  const int lane = threadIdx.x & 63;
  const bf16_t* xb = (const bf16_t*)(P.ws + OFF_HBUF) + (size_t)row * 1024;
  const unsigned char* U = P.ws + OFF_PU;
  const int* pidx = (const int*)(P.ws + OFF_PIDX) + (size_t)row * 128;
  const float* pg = (const float*)(P.ws + OFF_PGATE) + (size_t)row * 128;
  float x[16], acc[16];
  unpack8(*(const u32x4*)(xb + lane * 16), x);
  unpack8(*(const u32x4*)(xb + lane * 16 + 8), x + 8);
#pragma unroll
  for (int j = 0; j < 16; ++j) acc[j] = 0.f;
  const int b3 = (lane >> 3) & 1;
  const int mypick = (lane >> 3) & 7;
#ifdef CPU_EMU
#define PEER_SID(id) (id)
#else
#define PEER_SID(id) __builtin_amdgcn_readfirstlane(id)
#endif
  const unsigned lo12 = lane * 12, lo8 = PEER_VOFF + lane * 8;
#define PEER_LDU(i, id) do { const unsigned* up_ = (const unsigned*)(U + (size_t)(unsigned)(id) * PEER_ROWB + lo12); \
    uu[i].x = up_[0]; uu[i].y = up_[1]; uu[i].z = up_[2]; } while (0)
#define PEER_LDV(i, id) vv[i] = *(const u32x2*)(U + (size_t)(unsigned)(id) * PEER_ROWB + lo8)
#define PEER_IDS(v0, v1) {PEER_SID((int)v0.x), PEER_SID((int)v0.y), PEER_SID((int)v0.z), PEER_SID((int)v0.w), \
                          PEER_SID((int)v1.x), PEER_SID((int)v1.y), PEER_SID((int)v1.z), PEER_SID((int)v1.w)}
  u32x3 uu[8]; u32x2 vv[8];
  int cid[8];
  {
    const u32x4 p0 = *(const u32x4*)pidx, p1 = *(const u32x4*)(pidx + 4);
    const int id[8] = PEER_IDS(p0, p1);
#pragma unroll
    for (int i = 0; i < 8; ++i) { cid[i] = id[i]; PEER_LDU(i, id[i]); }
  }
  u32x4 n0 = *(const u32x4*)(pidx + 8), n1 = *(const u32x4*)(pidx + 12);
  float gcur = pg[mypick];
  for (int k0 = 0; k0 < 128; k0 += 8) {
#pragma unroll
    for (int i = 0; i < 8; ++i) PEER_LDV(i, cid[i]);
    const int nid[8] = PEER_IDS(n0, n1);
    {
      const int k2 = k0 + 16 < 128 ? k0 + 16 : 120;
      n0 = *(const u32x4*)(pidx + k2); n1 = *(const u32x4*)(pidx + k2 + 4);
    }
    const float gnxt = pg[(k0 + 8 < 128 ? k0 + 8 : 120) + mypick];
    float dsum[8];
#pragma unroll
    for (int i = 0; i < 8; i += 2) {
      float ufa[16], ufb[16];
#ifndef CPU_EMU
      __builtin_amdgcn_sched_barrier(0);
#endif
      unpack2x16_fp6(uu[i], uu[i + 1], ufa, ufb);
      PEER_LDU(i, nid[i]); PEER_LDU(i + 1, nid[i + 1]);
      typedef __attribute__((ext_vector_type(2))) float f32x2v;
      f32x2v da2 = {0.f, 0.f}, db2 = {0.f, 0.f};
#pragma unroll
      for (int j = 0; j < 8; ++j) {
        const f32x2v xx = {x[2 * j], x[2 * j + 1]};
        const f32x2v ua = {ufa[2 * j], ufa[2 * j + 1]}, ub = {ufb[2 * j], ufb[2 * j + 1]};
        da2 = xx * ua + da2; db2 = xx * ub + db2;
      }
      dsum[i] = da2.x + da2.y; dsum[i + 1] = db2.x + db2.y;
    }
    float e4[4], e2[2], g;
#pragma unroll
    for (int i = 0; i < 4; ++i) e4[i] = swap32_sum(dsum[i], dsum[4 + i]);
#pragma unroll
    for (int i = 0; i < 2; ++i) e2[i] = swap16_sum(e4[i], e4[2 + i]);
    {
      float mine = b3 ? e2[1] : e2[0], send = b3 ? e2[0] : e2[1];
      g = mine + dpp_xor<8>(send);
    }
    g = sum8(g);
    const float mycoef = gcur * geluf_(g * (1.f / PEER_USCALE));
#pragma unroll
    for (int i = 0; i < 8; ++i) {
      const float coef = wreadlane(mycoef, i * 8);
      float vf[16];
      unpack8_fp4(vv[i].x, vf); unpack8_fp4(vv[i].y, vf + 8);
#pragma unroll
      for (int j = 0; j < 16; ++j) acc[j] += coef * vf[j];
    }
#pragma unroll
    for (int i = 0; i < 8; ++i) cid[i] = nid[i];
    gcur = gnxt;
  }
#undef PEER_LDU
#undef PEER_LDV
#undef PEER_IDS
#undef PEER_SID
  float* xr = row < NCTX ? (float*)(P.ws + OFF_CTXRES) + (size_t)row * 1024 : P.out + (size_t)(row - NCTX) * 1024;
  const float* g2 = (const float*)(P.ws + OFF_MODV) + ((size_t)layer * 3 + mod_row(row)) * 6144 + 5 * 1024;
  float o[16];
#pragma unroll
  for (int q = 0; q < 4; ++q) {
    const int c = lane * 16 + q * 4;
    f32x4 a = *(const f32x4*)(xr + c), ga = *(const f32x4*)(g2 + c);
    o[q * 4 + 0] = a.x + ga.x * acc[q * 4 + 0] * (1.f / PEER_VSCALE); o[q * 4 + 1] = a.y + ga.y * acc[q * 4 + 1] * (1.f / PEER_VSCALE);
    o[q * 4 + 2] = a.z + ga.z * acc[q * 4 + 2] * (1.f / PEER_VSCALE); o[q * 4 + 3] = a.w + ga.w * acc[q * 4 + 3] * (1.f / PEER_VSCALE);
  }
  float ss = 0.f;
#pragma unroll
  for (int j = 0; j < 16; ++j) ss += o[j] * o[j];
  ss = wave_sum(ss);
  const float rstd = frsq(ss * (1.f / 1024.f) + 1e-6f);
  if (layer == 1) {
    float fn[16]; ld8(P.in[I_FNORM] + lane * 16, fn); ld8(P.in[I_FNORM] + lane * 16 + 8, fn + 8);
#pragma unroll
    for (int j = 0; j < 16; ++j) o[j] *= rstd * fn[j];
  }
#pragma unroll
  for (int q = 0; q < 4; ++q) {
    f32x4 a = {o[q * 4 + 0], o[q * 4 + 1], o[q * 4 + 2], o[q * 4 + 3]};
    *(f32x4*)(xr + lane * 16 + q * 4) = a;
  }
  if (layer == 0) {
    const float* mv = (const float*)(P.ws + OFF_MODV) + ((size_t)1 * 3 + mod_row(row)) * 6144;
    const float* nw = P.in[I_NORM1] + 1024;
    float hh[16];
#pragma unroll
    for (int q = 0; q < 4; ++q) {
      const int c = lane * 16 + q * 4;
      f32x4 w4 = *(const f32x4*)(nw + c), s4 = *(const f32x4*)(mv + 1024 + c), h4 = *(const f32x4*)(mv + c);
      hh[q * 4 + 0] = o[q * 4 + 0] * rstd * w4.x * (1.f + s4.x) + h4.x; hh[q * 4 + 1] = o[q * 4 + 1] * rstd * w4.y * (1.f + s4.y) + h4.y;
      hh[q * 4 + 2] = o[q * 4 + 2] * rstd * w4.z * (1.f + s4.z) + h4.z; hh[q * 4 + 3] = o[q * 4 + 3] * rstd * w4.w * (1.f + s4.w) + h4.w;
    }
    bf16_t* hb = (bf16_t*)(P.ws + OFF_HBUF) + (size_t)row * 1024 + lane * 16;
    *(u32x4*)hb = pack8(hh);
    *(u32x4*)(hb + 8) = pack8(hh + 8);
  }
}


#define FOR_TILES_XCD(MT0, MT1, NT, mt, nt)                                                     \
  for (int _x = blockIdx.x & 7, _mlo = (MT0) + (((MT1) - (MT0)) * _x) / 8,                        \
           _mhi = (MT0) + (((MT1) - (MT0)) * (_x + 1)) / 8, _i = blockIdx.x >> 3,                 \
           _cnt = (_mhi - _mlo) * (NT), mt = 0, nt = 0;                                           \
       _i < _cnt && ((mt = _mlo + _i / (NT)), (nt = _i % (NT)), true); _i += (int)(gridDim.x >> 3))

#ifndef PHASE_LIST
#define PHASE_LIST(X) X(0) X(1) X(2) X(22) X(23) X(3) X(4) X(5) X(6) X(7) X(8) X(9) X(11) X(12) X(13) X(30) X(14) X(15) X(31) X(16) X(17) X(18) X(19) X(20) X(21)
#endif
constexpr int PH_LAST = 21;

template <int ph>
DEV void run_phase(const Params& P, unsigned char* smem) {
  int bid_ = blockIdx.x, wave_ = threadIdx.x >> 6;
  OPAQUE_S(bid_); OPAQUE(wave_);
  const int bid = bid_, nb = gridDim.x;
  const int wave = wave_;
  unsigned char* ws = P.ws;
  constexpr int layer = ((ph >= 10 && ph <= 21) || ph >= 30) ? 1 : 0;
  const float* modv_l = (const float*)(ws + OFF_MODV) + (size_t)layer * 3 * 6144;
  switch (ph) {
    case 0:
      for (int t = NTRANS + bid; t < NPREP; t += nb) st_prep(P, t, smem);
      break;
    case 1: case 10:
      if (ph == 1) for (int t = nb - 1 - bid; t < NTRANS; t += nb) st_prep(P, t, smem);
      for (int t = bid; t < NTOK / 4; t += nb) st_normmod(P, layer, 0, t * 4 + wave);
      break;
    case 2: {
      EpiProjL0T epi{(bf16_t*)(ws + OFF_PROJ), (float*)(ws + OFF_GATES)};
      FOR_TILES_XCD(0, NTOK / 256, 25, mt, nt)
        gemm_tile_128x256<EpiProjL0T, true>((const bf16_t*)(ws + OFF_WEVIN), 1024, EVC, (const bf16_t*)(ws + OFF_HBUF), 1024, NTOK, 1024,
                                            nt * 128, mt * 256, epi, smem);
    } break;
    case 22:
      for (int t = bid; t < NTOK / 4; t += nb) st_xbc_conv(P, t * 4 + wave);
      for (int t = bid; t < NPCONV; t += nb) st_peer_conv(P, 0, t);
      break;
    case 23:
      for (int t = bid; t < 48 * LA_NSEG; t += nb) {
        int sid = t % 48, seg = t / 48;
        if (sid < 16) st_linattn_seg<true, false>(P, sid, seg, smem);
        else st_linattn_seg<false, false>(P, sid - 16, seg, smem);
      }
      break;
    case 3:
      for (int t = bid; t < 48 * LA_NSEG; t += nb) {
        int sid = t % 48, seg = t / 48;
        if (sid < 16) st_linattn_seg<true, true>(P, sid, seg, smem);
        else st_linattn_seg<false, true>(P, sid - 16, seg, smem);
      }
      break;
    case 4:
      for (int t = bid; t < NTOK / 4; t += nb) st_finish_l0(P, t * 4 + wave);
      break;
    case 5: case 17: {
      EpiOutProjT epi{layer == 0 ? P.in[I_X] : P.out, P.in[I_CTX], P.out, (float*)(ws + OFF_CTXRES), modv_l};
      const bf16_t* Wt = (const bf16_t*)(ws + (layer == 0 ? OFF_WEVOUT : OFF_WODOUT));
      FOR_TILES_XCD(layer == 0 ? 0 : NCTX / 256, NTOK / 256, 8, mt, nt)
        gemm_tile_128x256<EpiOutProjT, true>(Wt, 1024, 1024, (const bf16_t*)(ws + OFF_HBUF), 1024, NTOK, 1024, nt * 128, mt * 256, epi, smem);
    } break;
    case 6: case 18: {
      const int r0 = layer == 0 ? 0 : NCTX / 4;
      for (int t = r0 + bid; t < NTOK / 4; t += nb) st_normmod(P, layer, 1, t * 4 + wave);
      if (ph == 18) for (int t = bid; t < NPCONV; t += nb) st_peer_conv(P, 1, t);
    } break;
    case 7: case 19: {
      EpiStoreBfT epi{(bf16_t*)(ws + OFF_Q), 2048};
      const bf16_t* Wt = (const bf16_t*)(ws + OFF_WQ) + (size_t)layer * 2048 * 1024;
      FOR_TILES_XCD(layer == 0 ? 0 : NCTX / 256, NTOK / 256, 16, mt, nt)
        gemm_tile_128x256<EpiStoreBfT, true>(Wt, 1024, 2048, (const bf16_t*)(ws + OFF_HBUF), 1024, NTOK, 1024, nt * 128, mt * 256, epi, smem);
    } break;
    case 8: case 20: {
      const int t0 = layer == 0 ? 0 : CTILE * 8;
      for (int t = t0 + bid; t < NTILE * 8; t += nb) st_peer_topk(P, layer, t / 8, t % 8, smem);
    } break;
    case 9: case 21: {
      const int r0 = layer == 0 ? 0 : NCTX / 4;
      for (int t = r0 + bid; t < NTOK / 4; t += nb) st_peer_experts(P, layer, t * 4 + wave);
    } break;
    case 11: {
      EpiStoreBfT epi{(bf16_t*)(ws + OFF_PROJ), ODC};
      FOR_TILES_XCD(0, NTOK / 256, 22, mt, nt)
        gemm_tile_128x256<EpiStoreBfT, true>((const bf16_t*)(ws + OFF_WODIN), 1024, ODC, (const bf16_t*)(ws + OFF_HBUF), 1024, NTOK, 1024,
                                             nt * 128, mt * 256, epi, smem);
    } break;
    case 12:
      for (int t = bid; t < NTOK / 8; t += nb) st_lora_act(P, t * 8 + wave * 2);
      break;
    case 13:
      for (int t = bid; t < NTILE * 20; t += nb) {
        int job = t / (NTILE * 4), tt = t % (NTILE * 4);
        int mt = tt / 4, nt = tt % 4;
        bf16_t* dst = (bf16_t*)(ws + OFF_LORA) + (size_t)job * NTOK * 512;
        const bf16_t* A = (const bf16_t*)(ws + OFF_HBUF) + (job < 2 ? 0 : (job < 4 ? 64 : 128));
        const bf16_t* Bt = job < 2 ? (const bf16_t*)(ws + OFF_WUP) + (size_t)job * 512 * 64
                         : job < 4 ? (const bf16_t*)(ws + OFF_AUP) + (size_t)(job - 2) * 512 * 64
                                   : (const bf16_t*)(ws + OFF_GUP);
        const float* bias = job < 2 ? P.in[I_W0] + job * 512 : (job < 4 ? P.in[I_A0] + (job - 2) * 512 : nullptr);
        const int K = job < 4 ? 64 : 128;
        EpiStoreBfBiasT epi{dst, 512, bias, job < 2 ? 1 : (job < 4 ? 2 : 0)};
        gemm_tile_128<false, EpiStoreBfBiasT, true>(Bt, K, 512, A, 1024, NTOK, K, nt * 128, mt * 128, epi, smem);
      }
      break;
    case 30:
      for (int t = bid; t < 32 * RW_NSEG; t += nb) st_rwkv_seg<false>(P, t % 32, t / 32, smem);
      break;
    case 14:
      for (int t = bid; t < 32 * RW_NSEG; t += nb) st_rwkv_seg<true>(P, t % 32, t / 32, smem);
      break;
    case 15:
      {
        LruRaw R;
        if (bid < 32 * LRU_NCH) lru_load_raw(P, bid % 32, bid / 32, R);
        for (int t = bid; t < 32 * LRU_NCH; t += nb) {
          const int tn = t + nb;
          st_lru_chunk(P, t % 32, t / 32, tn % 32, tn / 32, tn < 32 * LRU_NCH, R, smem);
        }
      }
      break;
    case 31:
      if (bid < 32) st_lru_carry(P, bid);
      break;
    case 16:
      for (int t = bid; t < NTOK / 4; t += nb) st_finish_l1(P, t * 4 + wave);
      break;
    default: break;
  }
}


#ifndef CPU_EMU
#define XB_TMO      128
#define XB_XCNT(j)  (256  + 64 * (j))
#define XB_XSUB(j)  (1280 + 64 * (j))
#define XB_XGEN(j)  (2304 + 64 * (j))
#define XB_TOP      3328
#define XB_TOPGEN   3392
#define XCD_BAR_WORDS 3456
#define XB_SPIN_CAP (1u << 20)
#define LAS __attribute__((address_space(3)))
__device__ __forceinline__ unsigned xb_ld(unsigned* p)              { return __hip_atomic_load(p, __ATOMIC_RELAXED, __HIP_MEMORY_SCOPE_AGENT); }
__device__ __forceinline__ unsigned xb_add(unsigned* p, unsigned v) { return __hip_atomic_fetch_add(p, v, __ATOMIC_RELAXED, __HIP_MEMORY_SCOPE_AGENT); }
__device__ __forceinline__ unsigned xb_xcc_id() { return (unsigned)__builtin_amdgcn_s_getreg((3 << 11) | 20) & 0xFu; }
#define XB_SPIN(cond, bar) do { unsigned _sp = 0; while (cond) { __builtin_amdgcn_s_sleep(1); \
    if ((++_sp & 255u) == 0u) { if (xb_ld(&(bar)[XB_TMO])) break; if (_sp > XB_SPIN_CAP) { atomicAdd(&(bar)[XB_TMO], 1u); break; } } } } while (0)
struct XcdBarrier { unsigned* bar; unsigned x; volatile LAS unsigned* st; };
__device__ __forceinline__ XcdBarrier xcd_barrier_post(unsigned* bar, volatile LAS unsigned* st) {
  XcdBarrier b; b.bar = bar; b.x = xb_xcc_id(); b.st = st;
  if (threadIdx.x == 0) (void)xb_add(&bar[XB_XCNT(b.x)], 1u);
  return b;
}
__device__ __forceinline__ void xcd_barrier_complete(unsigned* bar, unsigned x, unsigned& nloc, unsigned& nx) {
  const unsigned G = gridDim.x * gridDim.y * gridDim.z;
  unsigned sum, cnt, mine, sp = 0u;
  for (;;) {
    sum = 0u; cnt = 0u; mine = 0u;
#pragma unroll
    for (unsigned j = 0; j < 16; ++j) { const unsigned c = xb_ld(&bar[XB_XCNT(j)]); sum += c; cnt += (c > 0u) ? 1u : 0u; mine = (j == x) ? c : mine; }
    if (sum == G) break;
    __builtin_amdgcn_s_sleep(1);
    if ((++sp & 255u) == 0u) { if (xb_ld(&bar[XB_TMO])) break; if (sp > XB_SPIN_CAP) { atomicAdd(&bar[XB_TMO], 1u); break; } }
  }
  nloc = mine > 0u ? mine : 1u; nx = cnt > 0u ? cnt : 1u;
}
__device__ __forceinline__ void xcd_barrier(const XcdBarrier& b) {
  asm volatile("s_waitcnt vmcnt(0)" ::: "memory");
  __syncthreads();
  if (threadIdx.x == 0) {
    unsigned* bar = b.bar;
    __builtin_amdgcn_s_waitcnt(0);
    unsigned nloc = b.st[0], nx = b.st[1];
    if (nloc == 0u) { xcd_barrier_complete(bar, b.x, nloc, nx); b.st[0] = nloc; b.st[1] = nx; }
    const unsigned old = xb_add(&bar[XB_XSUB(b.x)], 1u);
    const unsigned gen = old / nloc;
    if (old + 1u == (gen + 1u) * nloc) {
      __builtin_amdgcn_fence(__ATOMIC_RELEASE, "agent");
      asm volatile("s_waitcnt vmcnt(0)" ::: "memory");
      const unsigned og = xb_add(&bar[XB_TOP], 1u);
      const unsigned tg = og / nx;
      if (og + 1u == (tg + 1u) * nx) xb_add(&bar[XB_TOPGEN], 1u);
      else XB_SPIN(xb_ld(&bar[XB_TOPGEN]) == tg, bar);
      __builtin_amdgcn_fence(__ATOMIC_ACQUIRE, "agent");
      xb_add(&bar[XB_XGEN(b.x)], 1u);
      asm volatile("s_waitcnt vmcnt(0)" ::: "memory");
    } else {
      XB_SPIN(xb_ld(&bar[XB_XGEN(b.x)]) == gen, bar);
      __builtin_amdgcn_fence(__ATOMIC_ACQUIRE, "agent");
      asm volatile("s_waitcnt vmcnt(0)" ::: "memory");
    }
  }
  __syncthreads();
}
#endif
#ifndef CPU_EMU
#define RUN_PH(n) run_phase<n>(P, smem_raw); if (n != PH_LAST) xcd_barrier(xb);
__global__ void __launch_bounds__(256, 2) mega_kernel(Params P) {
  SMEM_DECL;
  unsigned* bar = (unsigned*)(P.ws + OFF_BAR);
  volatile LAS unsigned* st = (volatile LAS unsigned*)(smem_raw + SMEM_BYTES - 16);
  if (threadIdx.x == 0) { st[0] = 0u; st[1] = 0u; }
  if (P.ws == nullptr) cg::this_grid().sync();
  __syncthreads();
  XcdBarrier xb = xcd_barrier_post(bar, st);
  PHASE_LIST(RUN_PH)
}

extern "C" void kernel_launch(void* const* d_in, const int* in_sizes, int n_in, void* d_out, int out_size, void* d_ws,
                              size_t ws_size, hipStream_t stream) {
  Params P{};
  for (int i = 0; i < N_IN; ++i) P.in[i] = (const float*)d_in[i];
  P.out = (float*)d_out;
  P.ws = (unsigned char*)d_ws;
  if (ws_size < WS_NEEDED) { fprintf(stderr, "workspace too small: %zu < %zu\n", ws_size, (size_t)WS_NEEDED); return; }
  static int grid_blocks = 0;
  if (!grid_blocks) {
    int dev = 0, cus = 0, per_cu = 0;
    hipGetDevice(&dev);
    hipDeviceGetAttribute(&cus, hipDeviceAttributeMultiprocessorCount, dev);
    hipOccupancyMaxActiveBlocksPerMultiprocessor(&per_cu, mega_kernel, 256, 0);
    if (per_cu > 2) per_cu = 2;
    grid_blocks = cus * per_cu;
  }
  (void)hipMemsetAsync((unsigned char*)d_ws + OFF_BAR, 0, 16384, stream);
  void* args[] = {&P};
  hipError_t e = hipLaunchCooperativeKernel((void*)mega_kernel, dim3(grid_blocks), dim3(256), args, 0, stream);
  if (e != hipSuccess) fprintf(stderr, "cooperative launch failed: %s (grid %d)\n", hipGetErrorString(e), grid_blocks);
}
#endif
```

```cpp
#ifdef CPU_EMU
#include "emu.h"
#else
#include <hip/hip_runtime.h>
#include <hip/hip_cooperative_groups.h>
#include <cstdio>
namespace cg = cooperative_groups;
#define DEV __device__ __forceinline__
#define DEVM __device__ __forceinline__
#define OPAQUE(x) asm volatile("" : "+v"(x))
#define OPAQUE_S(x) asm volatile("" : "+s"(x))
#endif

#ifndef SEQ_LEN
#define SEQ_LEN 16384
#endif
#ifndef CTX_LEN
#define CTX_LEN 256
#endif
#ifndef GRID_W_
#define GRID_W_ 64
#endif
#ifndef MULTI_LAUNCH
#define MULTI_LAUNCH 0
#endif

typedef unsigned short bf16_t;
typedef __attribute__((ext_vector_type(8))) short bf16x8;
typedef __attribute__((ext_vector_type(16))) float f32x16;
typedef __attribute__((ext_vector_type(4))) unsigned u32x4;
typedef __attribute__((ext_vector_type(2))) unsigned u32x2;
typedef __attribute__((ext_vector_type(4))) float f32x4;

constexpr int D = 1024, NB = 2, SEQ = SEQ_LEN, CTXL = CTX_LEN, GW = GRID_W_;
constexpr int NCTX = NB * CTXL, NLAT = NB * SEQ, NTOK = NCTX + NLAT;
constexpr int EVC = 3104, ODC = 2816;
constexpr int NEXP = 16384;
constexpr int NTILE = NTOK / 128, CTILE = NCTX / 128;
static_assert(NTOK % 256 == 0 && NCTX % 256 == 0, "tiles");
static_assert(CTXL % 64 == 0 && SEQ % 64 == 0 && SEQ % GW == 0, "chunks");

constexpr size_t al256(size_t x) { return (x + 255) & ~(size_t)255; }
constexpr size_t OFF_MODV = 0;
constexpr size_t OFF_CTXRES = OFF_MODV + al256(2 * 3 * 6144 * 4);
constexpr size_t OFF_GATES = OFF_CTXRES + al256((size_t)NCTX * 1024 * 4);
constexpr size_t OFF_WEVIN = OFF_GATES + al256((size_t)NTOK * 32 * 4);
constexpr size_t OFF_WEVOUT = OFF_WEVIN + al256((size_t)EVC * 1024 * 2);
constexpr size_t OFF_WODIN = OFF_WEVOUT + al256((size_t)1024 * 1024 * 2);
constexpr size_t OFF_WODOUT = OFF_WODIN + al256((size_t)ODC * 1024 * 2);
constexpr size_t OFF_WQ = OFF_WODOUT + al256((size_t)1024 * 1024 * 2);
constexpr size_t OFF_KEYS = OFF_WQ + al256((size_t)2 * 2048 * 1024 * 2);
constexpr size_t OFF_WUP = OFF_KEYS + al256((size_t)2 * 8 * 2 * 128 * 128 * 2);
constexpr size_t OFF_AUP = OFF_WUP + al256((size_t)2 * 512 * 64 * 2);
constexpr size_t OFF_GUP = OFF_AUP + al256((size_t)2 * 512 * 64 * 2);
constexpr size_t OFF_LRUT = OFF_GUP + al256((size_t)512 * 128 * 2);
constexpr size_t OFF_PU = OFF_LRUT + al256((size_t)2 * 8 * 128 * 64 * 2);
constexpr size_t OFF_PV = OFF_PU + al256((size_t)NEXP * 1024);
constexpr size_t OFF_HBUF = OFF_PV + al256((size_t)NEXP * 1024);
constexpr size_t OFF_PR = OFF_HBUF + al256((size_t)NTOK * 1024 * 2);
constexpr size_t PR_BYTES = (size_t)NTOK * 5376 * 2;
constexpr size_t OFF_BAR = OFF_PR + PR_BYTES;
constexpr size_t OFF_ACUM1 = OFF_BAR + 16384;
constexpr size_t OFF_LRUCS = OFF_ACUM1 + (size_t)NLAT * 512 * 2;
constexpr size_t OFF_LRUHS = OFF_LRUCS + (size_t)32 * ((CTXL + SEQ) / 64) * 128 * 4;
constexpr size_t WS_NEEDED = OFF_LRUHS + (size_t)32 * ((CTXL + SEQ) / 64) * 64 * 4;
#ifndef CPU_EMU
static_assert(WS_NEEDED <= (size_t)512 * 1024 * 1024, "workspace too large");
#endif
constexpr size_t OFF_PROJ = OFF_PR;
constexpr size_t OFF_R2L0 = OFF_PR + (size_t)NTOK * EVC * 2;
constexpr size_t OFF_LORA = OFF_PR + (size_t)NTOK * ODC * 2;
constexpr size_t OFF_Q = OFF_PR;
constexpr size_t OFF_PIDX = OFF_PR + (size_t)NTOK * 2048 * 2;
constexpr size_t OFF_PGATE = OFF_PIDX + (size_t)NTOK * 128 * 4;
static_assert(OFF_PGATE + (size_t)NTOK * 128 * 4 <= OFF_PR + PR_BYTES, "picks");

enum {
  I_X = 0, I_C, I_CTX, I_CCTX, I_MODW, I_MODB, I_NORM1, I_NORM2, I_WQ, I_KEYS, I_PU, I_PV,
  I_EVWIN, I_EVWOUT, I_IBIAS, I_FBIAS, I_MNORM, I_SCONVW, I_SCONVB, I_DTBIAS, I_ALOG, I_DSKIP, I_SNORM,
  I_ODWIN, I_ODWOUT, I_MU, I_W0, I_WUP, I_A0, I_AUP, I_GUP, I_KK, I_KA, I_RK, I_LNW, I_LNB,
  I_LCONVW, I_LCONVB, I_LAM, I_WA, I_BA, I_WI, I_BI, I_FNORM, N_IN
};

struct Params {
  const float* in[N_IN];
  float* out;
  unsigned char* ws;
};

constexpr int SMEM_BYTES = 80 * 1024;
#ifdef CPU_EMU
#define SMEM_DECL static thread_local __attribute__((aligned(16))) unsigned char smem_raw[SMEM_BYTES]
#else
#define SMEM_DECL __shared__ __attribute__((aligned(16))) unsigned char smem_raw[SMEM_BYTES]
#endif

DEV float bf2f(bf16_t v) { unsigned u = ((unsigned)v) << 16; float f; __builtin_memcpy(&f, &u, 4); return f; }
#ifdef CPU_EMU
DEV bf16_t f2bf(float f) { unsigned u; __builtin_memcpy(&u, &f, 4); u += 0x7fffu + ((u >> 16) & 1u); return (bf16_t)(u >> 16); }
DEV unsigned pack2(float a, float b) { return (unsigned)f2bf(a) | ((unsigned)f2bf(b) << 16); }
#else
typedef __attribute__((ext_vector_type(2))) float f32x2_t;
typedef __attribute__((ext_vector_type(2))) __bf16 bf16x2_t;
DEV unsigned pack2(float a, float b) { f32x2_t f = {a, b}; return __builtin_bit_cast(unsigned, __builtin_convertvector(f, bf16x2_t)); }
DEV bf16_t f2bf(float f) { return __builtin_bit_cast(unsigned short, (__bf16)f); }
#endif
DEV void unpack8(const u32x4& r, float* o) {
  unsigned w[4] = {r.x, r.y, r.z, r.w};
#pragma unroll
  for (int i = 0; i < 4; ++i) { unsigned lo = w[i] << 16, hi = w[i] & 0xffff0000u; __builtin_memcpy(&o[2 * i], &lo, 4); __builtin_memcpy(&o[2 * i + 1], &hi, 4); }
}
DEV u32x4 pack8(const float* o) { u32x4 r; r.x = pack2(o[0], o[1]); r.y = pack2(o[2], o[3]); r.z = pack2(o[4], o[5]); r.w = pack2(o[6], o[7]); return r; }
#ifdef CPU_EMU
DEV float fexp(float x) { return expf(x); }
DEV float frcp(float x) { return 1.f / x; }
DEV float flog(float x) { return logf(x); }
DEV float frsq(float x) { return 1.f / sqrtf(x); }
DEV float fsqrt(float x) { return sqrtf(x); }
#else
DEV float fexp(float x) { return __expf(x); }
DEV float frcp(float x) { return __builtin_amdgcn_rcpf(x); }
DEV float flog(float x) { return __logf(x); }
DEV float frsq(float x) { return __builtin_amdgcn_rsqf(x); }
DEV float fsqrt(float x) { return __builtin_amdgcn_sqrtf(x); }
#endif
DEV void ld8(const float* __restrict__ p, float* o) { const f32x4 a = *(const f32x4*)p, b = *(const f32x4*)(p + 4); o[0] = a.x; o[1] = a.y; o[2] = a.z; o[3] = a.w; o[4] = b.x; o[5] = b.y; o[6] = b.z; o[7] = b.w; }
DEV float sigmoidf_(float x) { return frcp(1.f + fexp(-x)); }
DEV float siluf_(float x) { return x * frcp(1.f + fexp(-x)); }
DEV float softplusf_(float x) { return fmaxf(x, 0.f) + flog(1.f + fexp(-fabsf(x))); }
DEV float tanhf_(float x) { return 1.f - 2.f * frcp(1.f + fexp(2.f * x)); }
DEV float geluf_(float x) { return 0.5f * x * (1.f + erff(x * 0.70710678118654752f)); }

DEV f32x16 mfma32(bf16x8 a, bf16x8 b, f32x16 c) {
#ifdef CPU_EMU
  return emu_mfma32(a, b, c);
#else
  return __builtin_amdgcn_mfma_f32_32x32x16_bf16(a, b, c, 0, 0, 0);
#endif
}
DEV float wshfl_xor(float v, int m) {
#ifdef CPU_EMU
  return emu_shfl_xor(v, m);
#else
  return __shfl_xor(v, m, 64);
#endif
}
template <int M> DEV float dpp_xor(float v) {
  static_assert(M == 1 || M == 2 || M == 7 || M == 8, "dpp pattern");
#ifdef CPU_EMU
  return emu_shfl_xor(v, M);
#else
  constexpr int ctrl = M == 1 ? 0xB1 : (M == 2 ? 0x4E : (M == 7 ? 0x141 : 0x128));
  return __int_as_float(__builtin_amdgcn_update_dpp(0, __float_as_int(v), ctrl, 0xf, 0xf, false));
#endif
}
DEV float sum8(float v) { v += dpp_xor<1>(v); v += dpp_xor<2>(v); v += dpp_xor<7>(v); return v; }
DEV float sum4(float v) { v += dpp_xor<1>(v); v += dpp_xor<2>(v); return v; }
DEV float sum16(float v) { v = sum8(v); v += dpp_xor<8>(v); return v; }
DEV float swap32_sum(float a, float b) {
#ifdef CPU_EMU
  float ra = emu_shfl_xor(a, 32), rb = emu_shfl_xor(b, 32);
  return ((threadIdx.x >> 5) & 1) ? b + rb : a + ra;
#else
  auto r = __builtin_amdgcn_permlane32_swap(__float_as_uint(a), __float_as_uint(b), false, false);
  return __uint_as_float(r[0]) + __uint_as_float(r[1]);
#endif
}
DEV float swap16_sum(float a, float b) {
#ifdef CPU_EMU
  float ra = emu_shfl_xor(a, 16), rb = emu_shfl_xor(b, 16);
  return ((threadIdx.x >> 4) & 1) ? b + rb : a + ra;
#else
  auto r = __builtin_amdgcn_permlane16_swap(__float_as_uint(a), __float_as_uint(b), false, false);
  return __uint_as_float(r[0]) + __uint_as_float(r[1]);
#endif
}
DEV float wave_sum(float v) {
  v = sum16(v);
  v = swap16_sum(v, v);
  return swap32_sum(v, v);
}
DEV float wave_incl_scan(float v) {
#ifdef CPU_EMU
  const int l = threadIdx.x & 63;
  for (int s = 1; s < 16; s <<= 1) { const bool ok = (l & 15) >= s; float o = emu_readlane(v, ok ? l - s : l); v += ok ? o : 0.f; }
  { const bool ok = ((l >> 4) & 1) != 0; float o = emu_readlane(v, ok ? (l & ~15) - 1 : l); v += ok ? o : 0.f; }
  { const bool ok = l >= 32; float o = emu_readlane(v, ok ? 31 : l); v += ok ? o : 0.f; }
  return v;
#else
#define DPP_ADD_(ctrl, rmask) v += __int_as_float(__builtin_amdgcn_update_dpp(0, __float_as_int(v), ctrl, rmask, 0xf, false))
  DPP_ADD_(0x111, 0xf); DPP_ADD_(0x112, 0xf); DPP_ADD_(0x114, 0xf); DPP_ADD_(0x118, 0xf);
  DPP_ADD_(0x142, 0xa); DPP_ADD_(0x143, 0xc);
#undef DPP_ADD_
  return v;
#endif
}

#ifdef CPU_EMU
static inline unsigned emu_f2fp8(float f) {
  unsigned sgn = f < 0.f ? 0x80u : 0u; float a = fabsf(f);
  if (!(a == a)) return 0x7f;
  if (a >= 448.f) return sgn | 0x7e;
  if (a < 0.0009765625f) return sgn;
  int e; frexpf(a, &e); e -= 1;
  if (e < -6) { int q = (int)nearbyintf(a * 512.f); return sgn | (unsigned)q; }
  float m = a / ldexpf(1.f, e);
  int q = (int)nearbyintf((m - 1.f) * 8.f);
  if (q == 8) { q = 0; e += 1; }
  if (e > 8) return sgn | 0x7e;
  return sgn | (unsigned)((e + 7) << 3) | (unsigned)q;
}
static inline float emu_fp82f(unsigned c) {
  unsigned sgn = c & 0x80, e = (c >> 3) & 15, m = c & 7;
  float v = e == 0 ? ldexpf((float)m, -9) : ldexpf(1.f + m / 8.f, (int)e - 7);
  return sgn ? -v : v;
}
#endif
DEV unsigned pack4_fp8(float a, float b, float c, float d) {
#ifdef CPU_EMU
  return emu_f2fp8(a) | (emu_f2fp8(b) << 8) | (emu_f2fp8(c) << 16) | (emu_f2fp8(d) << 24);
#else
  int w = 0;
  w = __builtin_amdgcn_cvt_pk_fp8_f32(a, b, w, false);
  w = __builtin_amdgcn_cvt_pk_fp8_f32(c, d, w, true);
  return (unsigned)w;
#endif
}
DEV void unpack4_fp8(unsigned w, float* o) {
#ifdef CPU_EMU
  o[0] = emu_fp82f(w & 255); o[1] = emu_fp82f((w >> 8) & 255); o[2] = emu_fp82f((w >> 16) & 255); o[3] = emu_fp82f(w >> 24);
#else
  typedef __attribute__((ext_vector_type(2))) float f32x2_;
  f32x2_ lo = __builtin_amdgcn_cvt_pk_f32_fp8((int)w, false);
  f32x2_ hi = __builtin_amdgcn_cvt_pk_f32_fp8((int)w, true);
  o[0] = lo.x; o[1] = lo.y; o[2] = hi.x; o[3] = hi.y;
#endif
}
DEV void unpack16_fp8(const u32x4& r, float* o) { unpack4_fp8(r.x, o); unpack4_fp8(r.y, o + 4); unpack4_fp8(r.z, o + 8); unpack4_fp8(r.w, o + 12); }
DEV float wreadlane(float v, int srclane) {
#ifdef CPU_EMU
  return emu_readlane(v, srclane);
#else
  int iv; __builtin_memcpy(&iv, &v, 4);
  int r = __builtin_amdgcn_readlane(iv, srclane);
  float f; __builtin_memcpy(&f, &r, 4); return f;
#endif
}
constexpr float PEER_USCALE = 64.f, PEER_VSCALE = 4.f;
#ifdef CPU_EMU
static inline unsigned emu_f2fp4(float f) {
  static const float lv[8] = {0.f, 0.5f, 1.f, 1.5f, 2.f, 3.f, 4.f, 6.f};
  unsigned sgn = f < 0.f ? 8u : 0u; float a = fabsf(f);
  int best = 0; float bd = 1e30f;
  for (int i = 0; i < 8; ++i) { float dd = fabsf(a - lv[i]); if (dd < bd || (dd == bd && (i & 1) == 0)) { bd = dd; best = i; } }
  return sgn | (unsigned)best;
}
static inline float emu_fp42f(unsigned c) {
  static const float lv[8] = {0.f, 0.5f, 1.f, 1.5f, 2.f, 3.f, 4.f, 6.f};
  float v = lv[c & 7]; return (c & 8) ? -v : v;
}
#endif
DEV unsigned pack8_fp4(const float* v) {
#ifdef CPU_EMU
  unsigned w = 0;
  for (int i = 0; i < 8; ++i) w |= emu_f2fp4(v[i]) << (4 * i);
  return w;
#else
  unsigned w = 0;
  w = __builtin_amdgcn_cvt_scalef32_pk_fp4_f32(w, v[0], v[1], 1.0f, 0);
  w = __builtin_amdgcn_cvt_scalef32_pk_fp4_f32(w, v[2], v[3], 1.0f, 1);
  w = __builtin_amdgcn_cvt_scalef32_pk_fp4_f32(w, v[4], v[5], 1.0f, 2);
  w = __builtin_amdgcn_cvt_scalef32_pk_fp4_f32(w, v[6], v[7], 1.0f, 3);
  return w;
#endif
}
DEV void unpack8_fp4(unsigned w, float* o) {
#ifdef CPU_EMU
  for (int i = 0; i < 8; ++i) o[i] = emu_fp42f((w >> (4 * i)) & 15u);
#else
  typedef __attribute__((ext_vector_type(2))) float f32x2_;
  f32x2_ a = __builtin_amdgcn_cvt_scalef32_pk_f32_fp4(w, 1.0f, 0);
  f32x2_ b = __builtin_amdgcn_cvt_scalef32_pk_f32_fp4(w, 1.0f, 1);
  f32x2_ c = __builtin_amdgcn_cvt_scalef32_pk_f32_fp4(w, 1.0f, 2);
  f32x2_ d = __builtin_amdgcn_cvt_scalef32_pk_f32_fp4(w, 1.0f, 3);
  o[0] = a.x; o[1] = a.y; o[2] = b.x; o[3] = b.y; o[4] = c.x; o[5] = c.y; o[6] = d.x; o[7] = d.y;
#endif
}
typedef __attribute__((ext_vector_type(3))) unsigned u32x3;
#ifndef FP6_INTERLEAVED
#define FP6_INTERLEAVED 1
#endif
#ifdef CPU_EMU
static inline unsigned emu_f2fp6(float f) {
  unsigned sgn = f < 0.f ? 32u : 0u; float a = fabsf(f);
  if (a >= 7.5f) return sgn | 31u;
  int e; unsigned code;
  if (a < 1.f) { int q = (int)nearbyintf(a * 8.f); code = (unsigned)q; }
  else { frexpf(a, &e); e -= 1; float m = a / ldexpf(1.f, e); int q = (int)nearbyintf((m - 1.f) * 8.f); if (q == 8) { q = 0; e += 1; } code = (unsigned)(((e + 1) << 3) | q); if (e > 2) code = 31u; }
  return sgn | code;
}
static inline float emu_fp62f(unsigned c) {
  unsigned e = (c >> 3) & 3, m = c & 7;
  float v = e == 0 ? m * 0.125f : ldexpf(1.f + m / 8.f, (int)e - 1);
  return (c & 32) ? -v : v;
}
#endif
DEV u32x3 pack16_fp6(const float* v) {
#ifdef CPU_EMU
  unsigned long long lo = 0; unsigned hi = 0;
  for (int i = 0; i < 16; ++i) {
    unsigned long long c = emu_f2fp6(v[i]); int bit = 6 * i;
    if (bit < 64) { lo |= c << bit; if (bit > 58) hi |= (unsigned)(c >> (64 - bit)); } else hi |= (unsigned)(c << (bit - 64));
  }
  u32x3 r; r.x = (unsigned)lo; r.y = (unsigned)(lo >> 32); r.z = hi; return r;
#else
  typedef __attribute__((ext_vector_type(6))) unsigned u32x6_;
  f32x16 a, b;
#if FP6_INTERLEAVED
#pragma unroll
  for (int i = 0; i < 8; ++i) { a[i] = v[2 * i]; b[i] = v[2 * i + 1]; a[8 + i] = 0.f; b[8 + i] = 0.f; }
#else
#pragma unroll
  for (int i = 0; i < 16; ++i) { a[i] = v[i]; b[i] = 0.f; }
#endif
  u32x6_ w = __builtin_amdgcn_cvt_scalef32_2xpk16_fp6_f32(a, b, 1.0f);
  u32x3 r; r.x = w[0]; r.y = w[1]; r.z = w[2]; return r;
#endif
}
DEV void unpack16_fp6(const u32x3& r, float* o) {
#ifdef CPU_EMU
  unsigned long long lo = (unsigned long long)r.x | ((unsigned long long)r.y << 32); unsigned hi = r.z;
  for (int i = 0; i < 16; ++i) {
    int bit = 6 * i; unsigned c;
    if (bit + 6 <= 64) c = (unsigned)(lo >> bit) & 63u;
    else if (bit >= 64) c = (hi >> (bit - 64)) & 63u;
    else c = ((unsigned)(lo >> bit) | (hi << (64 - bit))) & 63u;
    o[i] = emu_fp62f(c);
  }
#else
  typedef __attribute__((ext_vector_type(6))) unsigned u32x6_;
  typedef __attribute__((ext_vector_type(32))) float f32x32_;
  u32x6_ w; w[0] = r.x; w[1] = r.y; w[2] = r.z; w[3] = 0u; w[4] = 0u; w[5] = 0u;
  f32x32_ f = __builtin_amdgcn_cvt_scalef32_pk32_f32_fp6(w, 1.0f);
#pragma unroll
  for (int i = 0; i < 16; ++i) o[i] = f[i];
#endif
}
DEV void unpack2x16_fp6(const u32x3& ra, const u32x3& rb, float* oa, float* ob) {
#ifdef CPU_EMU
  unpack16_fp6(ra, oa); unpack16_fp6(rb, ob);
#else
  typedef __attribute__((ext_vector_type(6))) unsigned u32x6_;
  typedef __attribute__((ext_vector_type(32))) float f32x32_;
  u32x6_ w; w[0] = ra.x; w[1] = ra.y; w[2] = ra.z; w[3] = rb.x; w[4] = rb.y; w[5] = rb.z;
  f32x32_ f = __builtin_amdgcn_cvt_scalef32_pk32_f32_fp6(w, 1.0f);
#pragma unroll
  for (int i = 0; i < 16; ++i) { oa[i] = f[i]; ob[i] = f[16 + i]; }
#endif
}
constexpr int PEER_ROWB = 1280;
constexpr int PEER_VOFF = 768;


DEV int acc_row(int reg, int lane) { return (reg & 3) + 8 * (reg >> 2) + 4 * (lane >> 5); }

DEV int mod_row(int row) { return row < NCTX ? 2 : (row - NCTX) / SEQ; }

template <bool SYNC_EPI, class Epi, bool VEC4 = false>
DEV void gemm_tile_128(const bf16_t* __restrict__ A, int lda, int M, const bf16_t* __restrict__ Bt, int ldb, int N,
                       int K, int m0, int n0, const Epi& epi, unsigned char* smem) {
  constexpr int LS = 72;
  constexpr int STAGE = 2 * 128 * LS;
  bf16_t* sbase = (bf16_t*)smem;
  const int wave = threadIdx.x >> 6;
  const int wm = (wave >> 1) * 64, wn = (wave & 1) * 64;
  f32x16 acc[2][2];
#pragma unroll
  for (int i = 0; i < 2; ++i)
#pragma unroll
    for (int j = 0; j < 2; ++j)
#pragma unroll
      for (int r = 0; r < 16; ++r) acc[i][j][r] = 0.f;
  u32x4 ra[4], rb[4];
  auto gload = [&](int k0) {
    int tl_ = threadIdx.x; OPAQUE(tl_);
#pragma unroll
    for (int i = 0; i < 4; ++i) {
      int c = tl_ + i * 256, r = c >> 3, cc = (c & 7) * 8;
      int gr = m0 + r, gn = n0 + r;
      gr = gr < M ? gr : M - 1; gn = gn < N ? gn : N - 1;
      ra[i] = *(const u32x4*)(A + (size_t)gr * lda + k0 + cc);
      rb[i] = *(const u32x4*)(Bt + (size_t)gn * ldb + k0 + cc);
    }
  };
  auto lwrite = [&](int buf) {
    int tl_ = threadIdx.x; OPAQUE(tl_);
    bf16_t* sA = sbase + buf * STAGE;
    bf16_t* sB = sA + 128 * LS;
#pragma unroll
    for (int i = 0; i < 4; ++i) {
      int c = tl_ + i * 256, r = c >> 3, cc = (c & 7) * 8;
      *(u32x4*)(sA + r * LS + cc) = ra[i];
      *(u32x4*)(sB + r * LS + cc) = rb[i];
    }
  };
  const int nk = K >> 6;
  gload(0);
  __syncthreads();
  lwrite(0);
  if (nk > 1) gload(64);
  __syncthreads();
  for (int it = 0; it < nk; ++it) {
    int tl_ = threadIdx.x; OPAQUE(tl_);
    const int lane = tl_ & 63;
    const bf16_t* sA = sbase + (it & 1) * STAGE;
    const bf16_t* sB = sA + 128 * LS;
#pragma unroll
    for (int kk = 0; kk < 4; ++kk) {
      bf16x8 a[2], b[2];
      const int ko = kk * 16 + 8 * (lane >> 5);
#pragma unroll
      for (int i = 0; i < 2; ++i) a[i] = *(const bf16x8*)(sA + (wm + i * 32 + (lane & 31)) * LS + ko);
#pragma unroll
      for (int j = 0; j < 2; ++j) b[j] = *(const bf16x8*)(sB + (wn + j * 32 + (lane & 31)) * LS + ko);
#pragma unroll
      for (int i = 0; i < 2; ++i)
#pragma unroll
        for (int j = 0; j < 2; ++j) acc[i][j] = mfma32(a[i], b[j], acc[i][j]);
      if (kk == 1) {
        if (it + 1 < nk) lwrite((it + 1) & 1);
        if (it + 2 < nk) gload((it + 2) * 64);
      }
    }
    __syncthreads();
  }
  {
    int tl_ = threadIdx.x; OPAQUE(tl_);
    const int lane = tl_ & 63;
    if constexpr (VEC4) {
#pragma unroll
      for (int i = 0; i < 2; ++i)
#pragma unroll
        for (int j = 0; j < 2; ++j)
#pragma unroll
          for (int gq = 0; gq < 4; ++gq) {
            int row = m0 + wm + i * 32 + 8 * gq + 4 * (lane >> 5);
            int col = n0 + wn + j * 32 + (lane & 31);
            if (row < M && col < N) epi.store4(row, col, acc[i][j][4 * gq], acc[i][j][4 * gq + 1], acc[i][j][4 * gq + 2], acc[i][j][4 * gq + 3]);
          }
    } else {
#pragma unroll
      for (int i = 0; i < 2; ++i)
#pragma unroll
        for (int j = 0; j < 2; ++j)
#pragma unroll
          for (int r = 0; r < 16; ++r) {
            int row = m0 + wm + i * 32 + acc_row(r, lane);
            int col = n0 + wn + j * 32 + (lane & 31);
            if (row < M && col < N) epi(row, col, acc[i][j][r]);
          }
    }
  }
}

template <class Epi, bool VEC4 = false>
DEV void gemm_tile_128x256(const bf16_t* __restrict__ A, int lda, int M, const bf16_t* __restrict__ Bt, int ldb, int N,
                           int K, int m0, int n0, const Epi& epi, unsigned char* smem) {
  constexpr int LS = 72;
  bf16_t* sA = (bf16_t*)smem;
  bf16_t* sB = sA + 128 * LS;
  const int wave = threadIdx.x >> 6;
  const int wm = (wave >> 1) * 64, wn = (wave & 1) * 128;
  f32x16 acc[2][4];
#pragma unroll
  for (int i = 0; i < 2; ++i)
#pragma unroll
    for (int j = 0; j < 4; ++j)
#pragma unroll
      for (int r = 0; r < 16; ++r) acc[i][j][r] = 0.f;
  u32x4 ra[4], rb[8];
  {
    const int tid = threadIdx.x;
#pragma unroll
    for (int i = 0; i < 4; ++i) {
      int c = tid + i * 256, r = c >> 3, cc = (c & 7) * 8;
      { int gr = m0 + r; gr = gr < M ? gr : M - 1; ra[i] = *(const u32x4*)(A + (size_t)gr * lda + cc); }
    }
#pragma unroll
    for (int i = 0; i < 8; ++i) {
      int c = tid + i * 256, r = c >> 3, cc = (c & 7) * 8;
      { int gn = n0 + r; gn = gn < N ? gn : N - 1; rb[i] = *(const u32x4*)(Bt + (size_t)gn * ldb + cc); }
    }
  }
  for (int k0 = 0; k0 < K; k0 += 64) {
    int tl_ = threadIdx.x; OPAQUE(tl_);
    const int tid = tl_, lane = tl_ & 63;
    __syncthreads();
#pragma unroll
    for (int i = 0; i < 4; ++i) { int c = tid + i * 256, r = c >> 3, cc = (c & 7) * 8; *(u32x4*)(sA + r * LS + cc) = ra[i]; }
#pragma unroll
    for (int i = 0; i < 8; ++i) { int c = tid + i * 256, r = c >> 3, cc = (c & 7) * 8; *(u32x4*)(sB + r * LS + cc) = rb[i]; }
    __syncthreads();
    if (k0 + 64 < K) {
#pragma unroll
      for (int i = 0; i < 4; ++i) {
        int c = tid + i * 256, r = c >> 3, cc = (c & 7) * 8;
        { int gr = m0 + r; gr = gr < M ? gr : M - 1; ra[i] = *(const u32x4*)(A + (size_t)gr * lda + k0 + 64 + cc); }
      }
#pragma unroll
      for (int i = 0; i < 8; ++i) {
        int c = tid + i * 256, r = c >> 3, cc = (c & 7) * 8;
        { int gn = n0 + r; gn = gn < N ? gn : N - 1; rb[i] = *(const u32x4*)(Bt + (size_t)gn * ldb + k0 + 64 + cc); }
      }
    }
#pragma unroll 2
    for (int kk = 0; kk < 4; ++kk) {
      bf16x8 a[2], b[4];
      const int ko = kk * 16 + 8 * (lane >> 5);
#pragma unroll
      for (int i = 0; i < 2; ++i) a[i] = *(const bf16x8*)(sA + (wm + i * 32 + (lane & 31)) * LS + ko);
#pragma unroll
      for (int j = 0; j < 4; ++j) b[j] = *(const bf16x8*)(sB + (wn + j * 32 + (lane & 31)) * LS + ko);
#pragma unroll
      for (int i = 0; i < 2; ++i)
#pragma unroll
        for (int j = 0; j < 4; ++j) acc[i][j] = mfma32(a[i], b[j], acc[i][j]);
    }
  }
  {
    int tl_ = threadIdx.x; OPAQUE(tl_);
    const int lane = tl_ & 63;
    if constexpr (VEC4) {
#pragma unroll
      for (int i = 0; i < 2; ++i)
#pragma unroll
        for (int j = 0; j < 4; ++j)
#pragma unroll
          for (int gq = 0; gq < 4; ++gq) {
            int row = m0 + wm + i * 32 + 8 * gq + 4 * (lane >> 5);
            int col = n0 + wn + j * 32 + (lane & 31);
            if (row < M && col < N) epi.store4(row, col, acc[i][j][4 * gq], acc[i][j][4 * gq + 1], acc[i][j][4 * gq + 2], acc[i][j][4 * gq + 3]);
          }
    } else {
#pragma unroll
      for (int i = 0; i < 2; ++i)
#pragma unroll
        for (int j = 0; j < 4; ++j)
#pragma unroll
          for (int r = 0; r < 16; ++r) {
            int row = m0 + wm + i * 32 + acc_row(r, lane);
            int col = n0 + wn + j * 32 + (lane & 31);
            if (row < M && col < N) epi(row, col, acc[i][j][r]);
          }
    }
  }
}

DEV void transpose_tile(const float* __restrict__ src, int ld_src, bf16_t* __restrict__ dst, int ld_dst, int K, int N,
                        int tk, int tn, unsigned char* smem) {
  float* sT = (float*)smem;
  const int tid = threadIdx.x;
  __syncthreads();
  {
    const int tx = tid & 15, ty = tid >> 4;
#pragma unroll
    for (int p = 0; p < 4; ++p) {
      int k = tk * 64 + ty + p * 16, n = tn * 64 + tx * 4;
      f32x4 v4 = {0.f, 0.f, 0.f, 0.f};
      if (k < K && n < N) v4 = *(const f32x4*)(src + (size_t)k * ld_src + n);
      float* d = sT + (ty + p * 16) * 65 + tx * 4;
      d[0] = v4.x; d[1] = v4.y; d[2] = v4.z; d[3] = v4.w;
    }
  }
  __syncthreads();
  {
    const int n = tid >> 2, kseg = (tid & 3) * 16;
    int gn = tn * 64 + n;
    if (gn < N) {
      float v[16];
#pragma unroll
      for (int j = 0; j < 16; ++j) v[j] = sT[(kseg + j) * 65 + n];
      bf16_t* d = dst + (size_t)gn * ld_dst + tk * 64 + kseg;
      *(u32x4*)d = pack8(v);
      *(u32x4*)(d + 8) = pack8(v + 8);
    }
  }
}

constexpr int TJ0 = 16 * 49, TJ1 = 16 * 16, TJ2 = 16 * 44, TJ3 = 16 * 16, TJ4 = 2 * 16 * 32, TJ5 = 2 * 8, TJ6 = 2 * 8,
              TJ7 = 2 * 8, TJ8 = 32;
constexpr int NTRANS = TJ0 + TJ1 + TJ2 + TJ3 + TJ4 + TJ5 + TJ6 + TJ7 + TJ8;
constexpr int NKEYCV = (2 * 8 * 2 * 128 * 128) / (256 * 8);
constexpr int NMODV = 2 * 96;
constexpr int NPREP = NTRANS + NKEYCV + NMODV;

DEV void st_prep(const Params& P, int item, unsigned char* smem) {
  unsigned char* ws = P.ws;
  if (item < NTRANS) {
    int t = item;
    if (t < TJ0) { transpose_tile(P.in[I_EVWIN], EVC, (bf16_t*)(ws + OFF_WEVIN), 1024, 1024, EVC, t / 49, t % 49, smem); return; }
    t -= TJ0;
    if (t < TJ1) { transpose_tile(P.in[I_EVWOUT], 1024, (bf16_t*)(ws + OFF_WEVOUT), 1024, 1024, 1024, t / 16, t % 16, smem); return; }
    t -= TJ1;
    if (t < TJ2) { transpose_tile(P.in[I_ODWIN], ODC, (bf16_t*)(ws + OFF_WODIN), 1024, 1024, ODC, t / 44, t % 44, smem); return; }
    t -= TJ2;
    if (t < TJ3) { transpose_tile(P.in[I_ODWOUT], 1024, (bf16_t*)(ws + OFF_WODOUT), 1024, 1024, 1024, t / 16, t % 16, smem); return; }
    t -= TJ3;
    if (t < TJ4) {
      int l = t / 512, tt = t % 512;
      transpose_tile(P.in[I_WQ] + (size_t)l * 1024 * 2048, 2048, (bf16_t*)(ws + OFF_WQ) + (size_t)l * 2048 * 1024, 1024, 1024, 2048, tt / 32, tt % 32, smem);
      return;
    }
    t -= TJ4;
    if (t < TJ5) { int d = t / 8; transpose_tile(P.in[I_WUP] + d * 64 * 512, 512, (bf16_t*)(ws + OFF_WUP) + d * 512 * 64, 64, 64, 512, 0, t % 8, smem); return; }
    t -= TJ5;
    if (t < TJ6) { int d = t / 8; transpose_tile(P.in[I_AUP] + d * 64 * 512, 512, (bf16_t*)(ws + OFF_AUP) + d * 512 * 64, 64, 64, 512, 0, t % 8, smem); return; }
    t -= TJ6;
    if (t < TJ7) { transpose_tile(P.in[I_GUP], 512, (bf16_t*)(ws + OFF_GUP), 128, 128, 512, t / 8, t % 8, smem); return; }
    t -= TJ7;
    {
      int which = t & 1, db = t >> 1;
      const float* src = (which ? P.in[I_WI] : P.in[I_WA]) + (size_t)db * 64 * 64;
      transpose_tile(src, 64, (bf16_t*)(ws + OFF_LRUT) + (size_t)db * 128 * 64 + which * 64 * 64, 64, 64, 64, 0, 0, smem);
      return;
    }
  }
  item -= NTRANS;
  if (item < NKEYCV) {
    size_t e = ((size_t)item * 256 + threadIdx.x) * 8;
    const float* s = P.in[I_KEYS] + e;
    f32x4 a = *(const f32x4*)s, b = *(const f32x4*)(s + 4);
    float v[8] = {a.x, a.y, a.z, a.w, b.x, b.y, b.z, b.w};
    *(u32x4*)((bf16_t*)(ws + OFF_KEYS) + e) = pack8(v);
    return;
  }
  item -= NKEYCV;
  {
    const int l = item / 96, cgp = item % 96;
    float* sS = (float*)smem;
    float* sRed = sS + 3 * 1024;
    const int tid = threadIdx.x;
    __syncthreads();
    for (int i = tid; i < 3 * 1024; i += 256) {
      int m = i >> 10, k = i & 1023;
      float c = m < 2 ? P.in[I_C][m * 1024 + k] : P.in[I_CCTX][k];
      sS[i] = siluf_(c);
    }
    __syncthreads();
    const int ks = tid >> 6, col = cgp * 64 + (tid & 63);
    const float* w = P.in[I_MODW] + (size_t)l * 1024 * 6144 + col;
    float a0 = 0.f, a1 = 0.f, a2 = 0.f;
    for (int k = ks * 256; k < ks * 256 + 256; ++k) {
      float wv = w[(size_t)k * 6144];
      a0 += sS[k] * wv; a1 += sS[1024 + k] * wv; a2 += sS[2048 + k] * wv;
    }
    sRed[(ks * 3 + 0) * 64 + (tid & 63)] = a0;
    sRed[(ks * 3 + 1) * 64 + (tid & 63)] = a1;
    sRed[(ks * 3 + 2) * 64 + (tid & 63)] = a2;
    __syncthreads();
    if (tid < 192) {
      int m = tid >> 6, c = tid & 63;
      float s = sRed[(0 * 3 + m) * 64 + c] + sRed[(1 * 3 + m) * 64 + c] + sRed[(2 * 3 + m) * 64 + c] + sRed[(3 * 3 + m) * 64 + c];
      int cc = cgp * 64 + c;
      ((float*)(ws + OFF_MODV))[((size_t)l * 3 + m) * 6144 + cc] = s + P.in[I_MODB][l * 6144 + cc];
    }
  }
}

constexpr int NPCONV = 2 * (NEXP * 1024 / (256 * 16));
DEV void st_peer_conv(const Params& P, int layer, int item) {
  const int half = NPCONV / 2;
  int which = item >= half;
  int it = which ? item - half : item;
  size_t e = ((size_t)it * 256 + threadIdx.x) * 16;
  const float* s = (which ? P.in[I_PV] : P.in[I_PU]) + (size_t)layer * NEXP * 1024 + e;
  const float sc = which ? PEER_VSCALE : PEER_USCALE;
  float v16[16];
#pragma unroll
  for (int q = 0; q < 4; ++q) {
    f32x4 a = *(const f32x4*)(s + 4 * q);
    v16[4 * q] = a.x * sc; v16[4 * q + 1] = a.y * sc; v16[4 * q + 2] = a.z * sc; v16[4 * q + 3] = a.w * sc;
  }
  const size_t ex = e >> 10, col = e & 1023;
  if (which) {
    u32x2 o; o.x = pack8_fp4(v16); o.y = pack8_fp4(v16 + 8);
    *(u32x2*)(P.ws + OFF_PU + ex * PEER_ROWB + PEER_VOFF + (col >> 1)) = o;
  } else {
    u32x3 o = pack16_fp6(v16);
    unsigned* dp = (unsigned*)(P.ws + OFF_PU + ex * PEER_ROWB + (col >> 4) * 12);
    dp[0] = o.x; dp[1] = o.y; dp[2] = o.z;
  }
}

DEV void st_normmod(const Params& P, int layer, int which, int row) {
  const int lane = threadIdx.x & 63;
  const float* src;
  if (which == 0 && layer == 0) src = row < NCTX ? P.in[I_CTX] + (size_t)row * 1024 : P.in[I_X] + (size_t)(row - NCTX) * 1024;
  else src = row < NCTX ? (const float*)(P.ws + OFF_CTXRES) + (size_t)row * 1024 : P.out + (size_t)(row - NCTX) * 1024;
  const float* mv = (const float*)(P.ws + OFF_MODV) + ((size_t)layer * 3 + mod_row(row)) * 6144;
  const float* sh = mv + (which ? 3 : 0) * 1024;
  const float* sc = mv + (which ? 4 : 1) * 1024;
  const float* nw = (which ? P.in[I_NORM2] : P.in[I_NORM1]) + layer * 1024;
  f32x4 v[4];
  float ss = 0.f;
#pragma unroll
  for (int i = 0; i < 4; ++i) {
    v[i] = *(const f32x4*)(src + i * 256 + lane * 4);
    ss += v[i].x * v[i].x + v[i].y * v[i].y + v[i].z * v[i].z + v[i].w * v[i].w;
  }
  ss = wave_sum(ss);
  const float rstd = frsq(ss * (1.f / 1024.f) + 1e-6f);
  bf16_t* dst = (bf16_t*)(P.ws + OFF_HBUF) + (size_t)row * 1024;
#pragma unroll
  for (int i = 0; i < 4; ++i) {
    int c = i * 256 + lane * 4;
    f32x4 w4 = *(const f32x4*)(nw + c), s4 = *(const f32x4*)(sc + c), h4 = *(const f32x4*)(sh + c);
    float o0 = v[i].x * rstd * w4.x * (1.f + s4.x) + h4.x;
    float o1 = v[i].y * rstd * w4.y * (1.f + s4.y) + h4.y;
    float o2 = v[i].z * rstd * w4.z * (1.f + s4.z) + h4.z;
    float o3 = v[i].w * rstd * w4.w * (1.f + s4.w) + h4.w;
    u32x2 pk; pk.x = pack2(o0, o1); pk.y = pack2(o2, o3);
    *(u32x2*)(dst + c) = pk;
  }
}

struct EpiProjL0 {
  bf16_t* proj; float* gates;
  DEVM void operator()(int row, int col, float v) const {
    proj[(size_t)row * EVC + col] = f2bf(v);
    if (col >= 1536 && col < 1552) gates[row * 32 + (col - 1536)] = v;
    else if (col >= 3088) gates[row * 32 + 16 + (col - 3088)] = v;
  }
};
struct EpiStoreBf {
  bf16_t* dst; int ld;
  DEVM void operator()(int row, int col, float v) const { dst[(size_t)row * ld + col] = f2bf(v); }
};
struct EpiStoreBfBias {
  bf16_t* dst; int ld; const float* bias;
  DEVM void operator()(int row, int col, float v) const { dst[(size_t)row * ld + col] = f2bf(v + (bias ? bias[col] : 0.f)); }
};
struct EpiProjL0T {
  bf16_t* proj; float* gates;
  DEVM void operator()(int, int, float) const {}
  DEVM void store4(int n, int m, float v0, float v1, float v2, float v3) const {
    u32x2 pk; pk.x = pack2(v0, v1); pk.y = pack2(v2, v3);
    *(u32x2*)(proj + (size_t)m * EVC + n) = pk;
    if (n >= 1536 && n < 1552) { f32x4 g = {v0, v1, v2, v3}; *(f32x4*)(gates + m * 32 + (n - 1536)) = g; }
    else if (n >= 3088) { f32x4 g = {v0, v1, v2, v3}; *(f32x4*)(gates + m * 32 + 16 + (n - 3088)) = g; }
  }
};
struct EpiStoreBfT {
  bf16_t* dst; int ld;
  DEVM void operator()(int, int, float) const {}
  DEVM void store4(int n, int m, float v0, float v1, float v2, float v3) const {
    u32x2 pk; pk.x = pack2(v0, v1); pk.y = pack2(v2, v3);
    *(u32x2*)(dst + (size_t)m * ld + n) = pk;
  }
};
struct EpiOutProjT {
  const float* x_lat; const float* x_ctx; float* o_lat; float* o_ctx; const float* modv;
  DEVM void operator()(int, int, float) const {}
  DEVM void store4(int n, int m, float v0, float v1, float v2, float v3) const {
    const f32x4 g = *(const f32x4*)(modv + mod_row(m) * 6144 + 2 * 1024 + n);
    const float* xs; float* od;
    if (m < NCTX) { xs = x_ctx + (size_t)m * 1024 + n; od = o_ctx + (size_t)m * 1024 + n; }
    else { size_t o = (size_t)(m - NCTX) * 1024 + n; xs = x_lat + o; od = o_lat + o; }
    const f32x4 x = *(const f32x4*)xs;
    f32x4 r = {x.x + g.x * v0, x.y + g.y * v1, x.z + g.z * v2, x.w + g.w * v3};
    *(f32x4*)od = r;
  }
};
struct EpiStoreBfBiasT {
  bf16_t* dst; int ld; const float* bias; int mode;
  DEVM void operator()(int, int, float) const {}
  DEVM void store4(int n, int m, float v0, float v1, float v2, float v3) const {
    if (bias) { v0 += bias[n]; v1 += bias[n + 1]; v2 += bias[n + 2]; v3 += bias[n + 3]; }
    if (mode) {
      const float sc = mode == 1 ? -0.6065306597126334f : 1.f;
      v0 = sc * sigmoidf_(v0); v1 = sc * sigmoidf_(v1); v2 = sc * sigmoidf_(v2); v3 = sc * sigmoidf_(v3);
    }
    u32x2 pk; pk.x = pack2(v0, v1); pk.y = pack2(v2, v3);
    *(u32x2*)(dst + (size_t)m * ld + n) = pk;
  }
};
struct EpiOutProj {
  const float* x_lat; const float* x_ctx; float* o_lat; float* o_ctx; const float* modv;
  DEVM void operator()(int row, int col, float v) const {
    float g = modv[mod_row(row) * 6144 + 2 * 1024 + col];
    if (row < NCTX) o_ctx[(size_t)row * 1024 + col] = x_ctx[(size_t)row * 1024 + col] + g * v;
    else { size_t o = (size_t)(row - NCTX) * 1024 + col; o_lat[o] = x_lat[o] + g * v; }
  }
};
struct EpiScoreLds {
  float* sS; int m0;
  DEVM void operator()(int row, int col, float v) const { sS[(row - m0) * 129 + col] = v; }
};

DEV void st_xbc_conv(const Params& P, int row) {
  const int lane = threadIdx.x & 63;
  const bf16_t* proj = (const bf16_t*)(P.ws + OFF_PROJ);
  bf16_t* xc = (bf16_t*)P.out + (size_t)row * 1024;
  int row0, len, pos;
  if (row < NCTX) { row0 = (row / CTXL) * CTXL; len = CTXL; pos = row - row0; }
  else { int r = row - NCTX; row0 = NCTX + (r / SEQ) * SEQ; len = SEQ; pos = r % SEQ; }
  const float* cw = P.in[I_SCONVW];
  const float* cb = P.in[I_SCONVB];
#pragma unroll
  for (int hh = 0; hh < 2; ++hh) {
    const int ch = hh * 512 + lane * 8;
    float o[8];
#pragma unroll
    for (int j = 0; j < 8; ++j) o[j] = cb[ch + j];
#pragma unroll
    for (int tap = 0; tap < 4; ++tap) {
      int pp = pos + tap - 2;
      if (pp >= 0 && pp < len) {
        float x[8];
        unpack8(*(const u32x4*)(proj + (size_t)(row0 + pp) * EVC + 2064 + ch), x);
        f32x4 w0 = *(const f32x4*)(cw + tap * 1024 + ch), w1 = *(const f32x4*)(cw + tap * 1024 + ch + 4);
        o[0] += w0.x * x[0]; o[1] += w0.y * x[1]; o[2] += w0.z * x[2]; o[3] += w0.w * x[3];
        o[4] += w1.x * x[4]; o[5] += w1.y * x[5]; o[6] += w1.z * x[6]; o[7] += w1.w * x[7];
      }
    }
#pragma unroll
    for (int j = 0; j < 8; ++j) o[j] = siluf_(o[j]);
    *(u32x4*)(xc + ch) = pack8(o);
  }
}

#ifndef LA_NSEG
#define LA_NSEG 10
#endif
constexpr int LA_NCH = (CTXL + SEQ) / 64;
constexpr int LA_CPS = LA_NCH / LA_NSEG;
static_assert(LA_NCH % LA_NSEG == 0, "linattn segments");
#ifdef CPU_EMU
constexpr size_t OFF_LASEG = OFF_PR + PR_BYTES;
#else
constexpr size_t OFF_LASEG = OFF_R2L0 + (size_t)NTOK * 1024 * 2;
#endif
constexpr size_t LASEG_U = (size_t)48 * LA_NSEG * 8192 * 4;
constexpr size_t OFF_LASEG_N = OFF_LASEG + LASEG_U;
constexpr size_t OFF_LASEG_D = OFF_LASEG_N + (size_t)48 * LA_NSEG * 64 * 4;
#ifndef CPU_EMU
static_assert(OFF_LASEG_D + 48 * LA_NSEG * 4 <= OFF_PR + PR_BYTES, "laseg");
#endif

DEV int swz64(int row) { return ((row >> 3) & 7) << 3; }
DEV int swz32(int row) { return ((row >> 3) & 3) << 3; }
struct LaRaw { u32x4 q[2], k[4], x[4]; float g0, g1; };

template <bool MLSTM, bool FULL>
DEV void la_load_raw(const Params& P, int b, int h, int d, int cc, LaRaw& R) {
  constexpr int NC_CTX = CTXL / 64;
  const int tid = threadIdx.x;
  const int seg = cc >= NC_CTX;
  const int row0 = seg ? NCTX + b * SEQ : b * CTXL;
  const int len = seg ? SEQ : CTXL;
  const int cl = (seg ? cc - NC_CTX : cc) * 64;
  const bf16_t* proj = (const bf16_t*)(P.ws + OFF_PROJ);
  const bf16_t* xcv = (const bf16_t*)P.out;
  const float* gates = (const float*)(P.ws + OFF_GATES);
  if (tid < 64) {
    int p = cl + tid, grow = row0 + (d ? len - 1 - p : p);
    if (MLSTM) { R.g0 = gates[grow * 32 + d * 4 + h]; R.g1 = gates[grow * 32 + 8 + d * 4 + h]; }
    else { R.g0 = gates[grow * 32 + 16 + d * 8 + h]; R.g1 = 0.f; }
  }
  if (MLSTM) {
#pragma unroll
    for (int i = 0; i < 2; ++i) {
      int c = tid + i * 256, r = c >> 3, cc8 = (c & 7) * 8;
      int p = cl + r, pos = d ? len - 1 - p : p;
      const bf16_t* rp = proj + (size_t)(row0 + pos) * EVC;
      if (FULL) R.q[i] = *(const u32x4*)(rp + h * 64 + cc8);
      R.k[i] = *(const u32x4*)(rp + 256 + h * 64 + cc8);
    }
#pragma unroll
    for (int i = 0; i < 4; ++i) {
      int c = tid + i * 256, r = c >> 4, cc8 = (c & 15) * 8;
      int p = cl + r, pos = d ? len - 1 - p : p;
      R.x[i] = *(const u32x4*)(proj + (size_t)(row0 + pos) * EVC + 512 + h * 128 + cc8);
    }
  } else {
    const int grp = h >> 2;
#pragma unroll
    for (int i = 0; i < 2; ++i) {
      int c = tid + i * 256, r = c >> 3, cc8 = (c & 7) * 8;
      int p = cl + r, pos = d ? len - 1 - p : p;
      R.x[i] = *(const u32x4*)(xcv + (size_t)(row0 + pos) * 1024 + h * 64 + cc8);
    }
#pragma unroll
    for (int i = 0; i < 4; ++i) {
      int c = tid + i * 256, r = c >> 4, cc8 = (c & 15) * 8;
      int p = cl + r, pos = d ? len - 1 - p : p;
      const bf16_t* rp = xcv + (size_t)(row0 + pos) * 1024;
      R.k[i] = *(const u32x4*)(rp + 512 + grp * 128 + cc8);
      if (FULL) { if (i < 2) R.q[i] = *(const u32x4*)(rp + 768 + grp * 128 + cc8); else R.x[i] = *(const u32x4*)(rp + 768 + grp * 128 + cc8); }
    }
  }
}

template <bool MLSTM, bool FULL>
DEV void st_linattn_seg(const Params& P, int sid, int seg, unsigned char* smem) {
  constexpr int DK = MLSTM ? 64 : 128, DX = MLSTM ? 128 : 64;
  constexpr int QS = DK + 8;
  constexpr int NH = MLSTM ? 4 : 8;
  constexpr int NC_CTX = CTXL / 64;
  const int tid = threadIdx.x, lane = tid & 63, wave = tid >> 6;
  const int d = sid & 1, h = (sid >> 1) % NH, b = (sid >> 1) / NH;
  const int gsid = MLSTM ? sid : 16 + sid;
  bf16_t* sQ = (bf16_t*)smem;
  bf16_t* sK = sQ + 64 * QS;
  bf16_t* sP = sK;
  bf16_t* sKT = sK + 64 * QS;
  bf16_t* sXT = sKT + DK * 72;
  bf16_t* sST = sXT + DX * 72;
  float* sF = (float*)(sST + DX * QS);
  float* sLa = sF;
  float* sG = sF + 64;
  float* sBc = sF + 128;
  float* sDen = sF + 192;
  float* sN = sF + 256;
  int* sRow = (int*)(sF + 384);
  static_assert((64 * QS * 2 + DK * 72 + DX * 72 + DX * QS) * 2 + 448 * 4 <= SMEM_BYTES, "lds");
  bf16_t* outb = MLSTM ? (bf16_t*)(P.ws + OFF_HBUF) : (bf16_t*)(P.ws + OFF_R2L0);
  float* segU = (float*)(P.ws + OFF_LASEG);
  float* segN = (float*)(P.ws + OFF_LASEG_N);
  float* segD = (float*)(P.ws + OFF_LASEG_D);

  f32x16 accS[2];
#pragma unroll
  for (int j = 0; j < 2; ++j)
#pragma unroll
    for (int r = 0; r < 16; ++r) accS[j][r] = 0.f;
  const int sx0 = MLSTM ? wave * 32 : (wave >> 1) * 32;
  const int sk0 = MLSTM ? 0 : (wave & 1) * 64;
  float nreg = 0.f;
  float gb0 = 0.f, gb1 = 0.f, alog_e = 0.f, dskip = 0.f;
  if (MLSTM) { gb0 = P.in[I_IBIAS][d * 4 + h]; gb1 = P.in[I_FBIAS][d * 4 + h]; }
  else { gb0 = P.in[I_DTBIAS][d * 8 + h]; alog_e = fexp(P.in[I_ALOG][d * 8 + h]); dskip = P.in[I_DSKIP][h]; }

  const int cc0 = seg * LA_CPS, cc1 = cc0 + LA_CPS;
  LaRaw R;
  la_load_raw<MLSTM, FULL>(P, b, h, d, cc0, R);
  __syncthreads();
  if (FULL) {
    for (int js = 0; js < seg; ++js) {
      const size_t it = (size_t)gsid * LA_NSEG + js;
      const float a = fexp(segD[it]);
      const float* U = segU + it * 8192;
#pragma unroll
      for (int j = 0; j < 2; ++j)
#pragma unroll
        for (int r = 0; r < 16; ++r) accS[j][r] = a * accS[j][r] + U[(j * 16 + r) * 256 + tid];
      if (MLSTM) nreg = a * nreg + segN[it * 64 + (tid >> 2)];
    }
#pragma unroll
    for (int j = 0; j < 2; ++j)
#pragma unroll
      for (int r = 0; r < 16; ++r) sST[(sx0 + acc_row(r, lane)) * QS + sk0 + j * 32 + (lane & 31)] = f2bf(accS[j][r]);
    if (MLSTM && (tid & 3) == 0) sN[tid >> 2] = nreg;
  }
  float lsum = 0.f;

  for (int cc = cc0; cc < cc1; ++cc) {
    int tl_ = threadIdx.x; OPAQUE(tl_);
    const int tid = tl_, lane = tl_ & 63;
    const int sgi = cc >= NC_CTX;
    const int row0 = sgi ? NCTX + b * SEQ : b * CTXL;
    const int len = sgi ? SEQ : CTXL;
    const int cl = (sgi ? cc - NC_CTX : cc) * 64;
    if (tid < 64) {
      int p = cl + tid;
      sRow[tid] = row0 + (d ? len - 1 - p : p);
      float la;
      if (MLSTM) { la = -softplusf_(-(R.g1 + gb1)); sG[tid] = fexp(R.g0 + gb0); }
      else { float dt = softplusf_(R.g0 + gb0); la = -dt * alog_e; sG[tid] = dt; }
      sBc[tid] = wave_incl_scan(la);
    }
    __syncthreads();
    const float blast = sBc[63];
    lsum += blast;
    if (MLSTM) {
#pragma unroll
      for (int i = 0; i < 2; ++i) {
        int c = tid + i * 256, r = c >> 3, cc8 = (c & 7) * 8;
        float kf[8]; unpack8(R.k[i], kf);
        const float wgt = fexp(blast - sBc[r]) * sG[r];
#pragma unroll
        for (int j = 0; j < 8; ++j) sKT[(cc8 + j) * 72 + (r ^ swz64(cc8))] = f2bf(kf[j] * wgt);
        if (FULL) {
          float qf[8]; unpack8(R.q[i], qf);
#pragma unroll
          for (int j = 0; j < 8; ++j) qf[j] *= 0.125f;
          *(u32x4*)(sQ + r * QS + cc8) = pack8(qf);
          *(u32x4*)(sK + r * QS + cc8) = R.k[i];
        }
      }
#pragma unroll
      for (int i = 0; i < 4; ++i) {
        int c = tid + i * 256, r = c >> 4, cc8 = (c & 15) * 8;
        const bf16_t* xs = (const bf16_t*)&R.x[i];
#pragma unroll
        for (int j = 0; j < 8; ++j) sXT[(cc8 + j) * 72 + (r ^ swz64(cc8))] = xs[j];
      }
    } else {
#pragma unroll
      for (int i = 0; i < 2; ++i) {
        int c = tid + i * 256, r = c >> 3, cc8 = (c & 7) * 8;
        const bf16_t* xs = (const bf16_t*)&R.x[i];
#pragma unroll
        for (int j = 0; j < 8; ++j) sXT[(cc8 + j) * 72 + (r ^ swz64(cc8))] = xs[j];
      }
#pragma unroll
      for (int i = 0; i < 4; ++i) {
        int c = tid + i * 256, r = c >> 4, cc8 = (c & 15) * 8;
        float kf[8]; unpack8(R.k[i], kf);
        const float wgt = fexp(blast - sBc[r]) * sG[r];
#pragma unroll
        for (int j = 0; j < 8; ++j) sKT[(cc8 + j) * 72 + (r ^ swz64(cc8))] = f2bf(kf[j] * wgt);
        if (FULL) {
          *(u32x4*)(sK + r * QS + cc8) = R.k[i];
          *(u32x4*)(sQ + r * QS + cc8) = i < 2 ? R.q[i] : R.x[i];
        }
      }
    }
    if (cc + 1 < cc1) la_load_raw<MLSTM, FULL>(P, b, h, d, cc + 1, R);
    __syncthreads();
    if (FULL) {
      const int tr = (wave >> 1) * 32, tc = (wave & 1) * 32;
      f32x16 accP;
#pragma unroll
      for (int r = 0; r < 16; ++r) accP[r] = 0.f;
      if (!(tr == 0 && tc == 32)) {
#pragma unroll
        for (int kk = 0; kk < DK / 16; ++kk) {
          const int ko = kk * 16 + 8 * (lane >> 5);
          bf16x8 a = *(const bf16x8*)(sQ + (tr + (lane & 31)) * QS + ko);
          bf16x8 bb = *(const bf16x8*)(sK + (tc + (lane & 31)) * QS + ko);
          accP = mfma32(a, bb, accP);
        }
      }
      __syncthreads();
      {
        const int s = tc + (lane & 31);
        const float bs = sBc[s], gs = sG[s];
#pragma unroll
        for (int r = 0; r < 16; ++r) {
          int t = tr + acc_row(r, lane);
          float v = (s <= t) ? accP[r] * fexp(sBc[t] - bs) * gs : 0.f;
          sP[t * 72 + s] = f2bf(v);
        }
        {
          const int t = tid >> 2, kq = (tid & 3) * (DK / 4);
          const float et = fexp(sBc[t]);
#pragma unroll
          for (int c8 = 0; c8 < DK / 4; c8 += 8) {
            float qf[8];
            unpack8(*(const u32x4*)(sQ + t * QS + kq + c8), qf);
#pragma unroll
            for (int j = 0; j < 8; ++j) qf[j] *= et;
            *(u32x4*)(sQ + t * QS + kq + c8) = pack8(qf);
          }
        }
      }
      __syncthreads();
      constexpr int NYT = MLSTM ? 2 : 1;
      const int yx0 = MLSTM ? wave * 32 : (wave >> 1) * 32;
      const int yt0 = MLSTM ? 0 : (wave & 1) * 32;
      f32x16 accY[NYT];
#pragma unroll
      for (int j = 0; j < NYT; ++j)
#pragma unroll
        for (int r = 0; r < 16; ++r) accY[j][r] = 0.f;
#pragma unroll
      for (int kk = 0; kk < 4; ++kk) {
        const int ko = kk * 16 + 8 * (lane >> 5);
        bf16x8 a = *(const bf16x8*)(sXT + (yx0 + (lane & 31)) * 72 + (ko ^ swz64(yx0 + (lane & 31))));
#pragma unroll
        for (int j = 0; j < NYT; ++j) {
          bf16x8 bb = *(const bf16x8*)(sP + (yt0 + j * 32 + (lane & 31)) * 72 + ko);
          accY[j] = mfma32(a, bb, accY[j]);
        }
      }
#pragma unroll
      for (int kk = 0; kk < DK / 16; ++kk) {
        const int ko = kk * 16 + 8 * (lane >> 5);
        bf16x8 a = *(const bf16x8*)(sST + (yx0 + (lane & 31)) * QS + ko);
#pragma unroll
        for (int j = 0; j < NYT; ++j) {
          bf16x8 bb = *(const bf16x8*)(sQ + (yt0 + j * 32 + (lane & 31)) * QS + ko);
          accY[j] = mfma32(a, bb, accY[j]);
        }
      }
      if (MLSTM) {
        const int t = tid >> 2, q4 = (tid & 3) * 16;
        float pf[16], qf[16];
        unpack8(*(const u32x4*)(sP + t * 72 + q4), pf); unpack8(*(const u32x4*)(sP + t * 72 + q4 + 8), pf + 8);
        unpack8(*(const u32x4*)(sQ + t * QS + q4), qf); unpack8(*(const u32x4*)(sQ + t * QS + q4 + 8), qf + 8);
        float den = 0.f;
#pragma unroll
        for (int j = 0; j < 16; ++j) den += pf[j] + sN[q4 + j] * qf[j];
        den = sum4(den);
        if ((tid & 3) == 0) sDen[t] = den;
        __syncthreads();
      }
#pragma unroll
      for (int j = 0; j < NYT; ++j) {
        const int t = yt0 + j * 32 + (lane & 31);
        const size_t obase = (size_t)sRow[t] * 1024 + d * 512 + h * DX;
        const float dinv = MLSTM ? frcp(fmaxf(fabsf(sDen[t]), 1.f)) : 1.f;
#pragma unroll
        for (int g = 0; g < 4; ++g) {
          const int x0 = yx0 + 8 * g + 4 * (lane >> 5);
          float v0 = accY[j][4 * g], v1 = accY[j][4 * g + 1], v2 = accY[j][4 * g + 2], v3 = accY[j][4 * g + 3];
          if (MLSTM) { v0 *= dinv; v1 *= dinv; v2 *= dinv; v3 *= dinv; }
          else if (d == 0) {
            const int ts = t ^ swz64(x0);
            v0 += dskip * bf2f(sXT[(x0 + 0) * 72 + ts]); v1 += dskip * bf2f(sXT[(x0 + 1) * 72 + ts]);
            v2 += dskip * bf2f(sXT[(x0 + 2) * 72 + ts]); v3 += dskip * bf2f(sXT[(x0 + 3) * 72 + ts]);
          }
          u32x2 pk; pk.x = pack2(v0, v1); pk.y = pack2(v2, v3);
          *(u32x2*)(outb + obase + x0) = pk;
        }
      }
      __syncthreads();
    }
    {
      const float eb = fexp(blast);
#pragma unroll
      for (int j = 0; j < 2; ++j)
#pragma unroll
        for (int r = 0; r < 16; ++r) accS[j][r] *= eb;
#pragma unroll
      for (int kk = 0; kk < 4; ++kk) {
        const int ko = kk * 16 + 8 * (lane >> 5);
        bf16x8 a = *(const bf16x8*)(sXT + (sx0 + (lane & 31)) * 72 + (ko ^ swz64(sx0 + (lane & 31))));
#pragma unroll
        for (int j = 0; j < 2; ++j) {
          bf16x8 bb = *(const bf16x8*)(sKT + (sk0 + j * 32 + (lane & 31)) * 72 + (ko ^ swz64(sk0 + j * 32 + (lane & 31))));
          accS[j] = mfma32(a, bb, accS[j]);
        }
      }
      if (FULL) {
#pragma unroll
        for (int j = 0; j < 2; ++j)
#pragma unroll
          for (int r = 0; r < 16; ++r) sST[(sx0 + acc_row(r, lane)) * QS + sk0 + j * 32 + (lane & 31)] = f2bf(accS[j][r]);
      }
      if (MLSTM) {
        const int k = tid >> 2, q4 = (tid & 3) * 16;
        float kf[16];
        unpack8(*(const u32x4*)(sKT + k * 72 + q4), kf); unpack8(*(const u32x4*)(sKT + k * 72 + q4 + 8), kf + 8);
        float ps = 0.f;
#pragma unroll
        for (int j = 0; j < 16; ++j) ps += kf[j];
        nreg = nreg * eb + sum4(ps);
        if (FULL && (tid & 3) == 0) sN[k] = nreg;
      }
    }
    __syncthreads();
  }
  if (!FULL) {
    const size_t it = (size_t)gsid * LA_NSEG + seg;
    float* U = segU + it * 8192;
#pragma unroll
    for (int j = 0; j < 2; ++j)
#pragma unroll
      for (int r = 0; r < 16; ++r) U[(j * 16 + r) * 256 + tid] = accS[j][r];
    if (MLSTM && (tid & 3) == 0) segN[it * 64 + (tid >> 2)] = nreg;
    if (tid == 0) segD[it] = lsum;
  }
}

DEV void st_finish_l0(const Params& P, int row) {
  const int lane = threadIdx.x & 63;
  bf16_t* hb = (bf16_t*)(P.ws + OFF_HBUF) + (size_t)row * 1024;
  const bf16_t* yb = (const bf16_t*)(P.ws + OFF_R2L0) + (size_t)row * 1024;
  const bf16_t* pr = (const bf16_t*)(P.ws + OFF_PROJ) + (size_t)row * EVC;
  const int ch = lane * 8;
  float h0[8], h1[8], o[8], f1[8];
  unpack8(*(const u32x4*)(hb + ch), h0);
  unpack8(*(const u32x4*)(hb + 512 + ch), h1);
  unpack8(*(const u32x4*)(pr + 1024 + ch), o);
  float ss = 0.f;
#pragma unroll
  for (int j = 0; j < 8; ++j) { h0[j] += h1[j]; ss += h0[j] * h0[j]; }
  ss = sum16(ss);
  float rstd = frsq(ss * (1.f / 128.f) + 1e-6f);
  float pw[8]; ld8(P.in[I_MNORM] + ch, pw);
#pragma unroll
  for (int j = 0; j < 8; ++j) f1[j] = h0[j] * rstd * pw[j] * sigmoidf_(o[j]);
  float y0[8], y1[8], z[8], f2[8];
  unpack8(*(const u32x4*)(yb + ch), y0);
  unpack8(*(const u32x4*)(yb + 512 + ch), y1);
  unpack8(*(const u32x4*)(pr + 1552 + ch), z);
  float s2 = 0.f;
#pragma unroll
  for (int j = 0; j < 8; ++j) { y0[j] = (y0[j] + y1[j]) * siluf_(z[j]); s2 += y0[j] * y0[j]; }
  s2 = wave_sum(s2);
  float rstd2 = frsq(s2 * (1.f / 512.f) + 1e-6f);
  ld8(P.in[I_SNORM] + ch, pw);
#pragma unroll
  for (int j = 0; j < 8; ++j) f2[j] = y0[j] * rstd2 * pw[j];
  *(u32x4*)(hb + ch) = pack8(f1);
  *(u32x4*)(hb + 512 + ch) = pack8(f2);
}

DEV float mixval(const bf16_t* __restrict__ proj, int row, int c, const float* __restrict__ mu) {
  float self = bf2f(proj[(size_t)row * ODC + c]);
  int nrow = -1;
  if (row < NCTX) {
    int pos = row % CTXL;
    if (c < 896) { if (pos > 0) nrow = row - 1; }
    else { if (pos < CTXL - 1) nrow = row + 1; }
  } else {
    int pos = (row - NCTX) % SEQ;
    int gx = pos % GW, gy = pos / GW, q = c / 448;
    if (q == 0) { if (gx > 0) nrow = row - 1; }
    else if (q == 1) { if (gx < GW - 1) nrow = row + 1; }
    else if (q == 2) { if (gy > 0) nrow = row - GW; }
    else { if (gy < SEQ / GW - 1) nrow = row + GW; }
  }
  float nb = nrow >= 0 ? bf2f(proj[(size_t)nrow * ODC + c]) : 0.f;
  return self + mu[c] * (nb - self);
}

DEV int nbr_row(int row, int c) {
  if (row < NCTX) {
    int pos = row % CTXL;
    if (c < 896) return pos > 0 ? row - 1 : -1;
    return pos < CTXL - 1 ? row + 1 : -1;
  }
  int pos = (row - NCTX) % SEQ;
  int gx = pos % GW, gy = pos / GW, q = c / 448;
  if (q == 0) return gx > 0 ? row - 1 : -1;
  if (q == 1) return gx < GW - 1 ? row + 1 : -1;
  if (q == 2) return gy > 0 ? row - GW : -1;
  return gy < SEQ / GW - 1 ? row + GW : -1;
}

DEV void mix8(const bf16_t* __restrict__ proj, int row, int c, const float* __restrict__ mu, float* o) {
  float xs[8], xn[8];
  unpack8(*(const u32x4*)(proj + (size_t)row * ODC + c), xs);
  const int nr = nbr_row(row, c);
  if (nr >= 0) unpack8(*(const u32x4*)(proj + (size_t)nr * ODC + c), xn);
  else {
#pragma unroll
    for (int j = 0; j < 8; ++j) xn[j] = 0.f;
  }
  const f32x4 m0 = *(const f32x4*)(mu + c), m1 = *(const f32x4*)(mu + c + 4);
  const float mm[8] = {m0.x, m0.y, m0.z, m0.w, m1.x, m1.y, m1.z, m1.w};
#pragma unroll
  for (int j = 0; j < 8; ++j) o[j] = xs[j] + mm[j] * (xn[j] - xs[j]);
}

DEV void st_lora_act(const Params& P, int row2) {
  const int lane = threadIdx.x & 63;
  const int row = row2 + (lane >> 5), c = (lane & 31) * 8;
  const bf16_t* proj = (const bf16_t*)(P.ws + OFF_PROJ);
  bf16_t* hb = (bf16_t*)(P.ws + OFF_HBUF) + (size_t)row * 1024;
  float v[8];
  mix8(proj, row, 1536 + c, P.in[I_MU], v);
#pragma unroll
  for (int j = 0; j < 8; ++j) v[j] = c < 64 ? tanhf_(v[j]) : (c < 128 ? v[j] : sigmoidf_(v[j]));
  *(u32x4*)(hb + c) = pack8(v);
}

DEV void st_rwkv_stream(const Params& P, int sid, unsigned char* smem) {
  const int tid = threadIdx.x, lane = tid & 63, wave = tid >> 6;
  const int d = sid & 1, h = (sid >> 1) & 7, b = sid >> 4;
  float* sR = (float*)smem;
  float* sW = sR + 2048;
  float* sKk = sW + 2048;
  float* sV = sKk + 2048;
  float* sA = sV + 2048;
  float* sBb = sA + 2048;
  float* sY = sBb + 2048;
  int* sRow = (int*)(sY + 2048);
  const bf16_t* proj = (const bf16_t*)(P.ws + OFF_PROJ);
  const bf16_t* lora = (const bf16_t*)(P.ws + OFF_LORA);
  bf16_t* yout = (bf16_t*)(P.ws + OFF_HBUF);
  const float* mu = P.in[I_MU];
  const int vrow = tid >> 2, j4 = tid & 3;
  float S[16];
#pragma unroll
  for (int i = 0; i < 16; ++i) S[i] = 0.f;
  const float kkw = P.in[I_KK][h * 64 + lane], kaw = P.in[I_KA][h * 64 + lane];
  for (int seg = 0; seg < 2; ++seg) {
    const int row0 = seg == 0 ? b * CTXL : NCTX + b * SEQ;
    const int len = seg == 0 ? CTXL : SEQ;
    for (int it = 0; it < len / 32; ++it) {
      __syncthreads();
      for (int s = wave; s < 32; s += 4) {
        int p = it * 32 + s, pos = d ? len - 1 - p : p, row = row0 + pos;
        int c = h * 64 + lane;
        float r = mixval(proj, row, c, mu);
        float k = mixval(proj, row, 512 + c, mu);
        float v = mixval(proj, row, 1024 + c, mu);
        float kk = k * kkw;
        float ss = wave_sum(kk * kk);
        kk *= frsq(ss + 1e-12f);
        float lw = bf2f(lora[((size_t)d * NTOK + row) * 512 + c]);
        float la = bf2f(lora[((size_t)(2 + d) * NTOK + row) * 512 + c]);
        float w = fexp(-0.6065306597126334f * sigmoidf_(lw));
        float a = sigmoidf_(la);
        float kt = k * (1.f + (a - 1.f) * kaw);
        sR[s * 64 + lane] = r; sW[s * 64 + lane] = w; sKk[s * 64 + lane] = kt; sV[s * 64 + lane] = v;
        sA[s * 64 + lane] = -kk; sBb[s * 64 + lane] = kk * a;
        if (lane == 0) sRow[s] = row;
      }
      __syncthreads();
      for (int s = 0; s < 32; ++s) {
        const float* pa = sA + s * 64 + j4 * 16;
        const float* pw = sW + s * 64 + j4 * 16;
        const float* pk = sKk + s * 64 + j4 * 16;
        const float* pb = sBb + s * 64 + j4 * 16;
        const float* pr = sR + s * 64 + j4 * 16;
        const float vv = sV[s * 64 + vrow];
        float sa = 0.f;
#pragma unroll
        for (int i = 0; i < 16; ++i) sa += S[i] * pa[i];
        sa = sum4(sa);
        float y = 0.f;
#pragma unroll
        for (int i = 0; i < 16; ++i) { S[i] = S[i] * pw[i] + sa * pb[i] + vv * pk[i]; y += S[i] * pr[i]; }
        y = sum4(y);
        if (j4 == 0) sY[s * 64 + vrow] = y;
      }
      __syncthreads();
      for (int i = tid; i < 2048; i += 256) {
        int s = i >> 6, c = i & 63;
        yout[(size_t)sRow[s] * 1024 + d * 512 + h * 64 + c] = f2bf(sY[i]);
      }
    }
  }
}


struct RwkvRaw { u32x4 rs, rn, ks, kn, vs, vn, lw, la; int row; };

DEV void rwkv_load_raw(const bf16_t* __restrict__ proj, const bf16_t* __restrict__ lora, int b, int h, int d, int cc, int t, int c0,
                       RwkvRaw& R) {
  constexpr int NC_CTX = CTXL / 32;
  const int seg = cc >= NC_CTX;
  const int row0 = seg ? NCTX + b * SEQ : b * CTXL;
  const int len = seg ? SEQ : CTXL;
  const int p = (seg ? cc - NC_CTX : cc) * 32 + t;
  const int row = row0 + (d ? len - 1 - p : p);
  const int col = h * 64 + c0;
  const u32x4 z4 = {0u, 0u, 0u, 0u};
  const bf16_t* rp = proj + (size_t)row * ODC;
  R.row = row;
  R.rs = *(const u32x4*)(rp + col);
  R.ks = *(const u32x4*)(rp + 512 + col);
  R.vs = *(const u32x4*)(rp + 1024 + col);
  int n0 = nbr_row(row, col), n1 = nbr_row(row, 512 + col), n2 = nbr_row(row, 1024 + col);
  R.rn = n0 >= 0 ? *(const u32x4*)(proj + (size_t)n0 * ODC + col) : z4;
  R.kn = n1 >= 0 ? *(const u32x4*)(proj + (size_t)n1 * ODC + 512 + col) : z4;
  R.vn = n2 >= 0 ? *(const u32x4*)(proj + (size_t)n2 * ODC + 1024 + col) : z4;
  R.lw = *(const u32x4*)(lora + ((size_t)d * NTOK + row) * 512 + col);
  R.la = *(const u32x4*)(lora + ((size_t)(2 + d) * NTOK + row) * 512 + col);
}

#ifndef RW_NSEG
#define RW_NSEG 16
#endif
constexpr int RW_NCH = (CTXL + SEQ) / 32;
constexpr size_t OFF_RWSEG = OFF_PU;
static_assert((size_t)32 * RW_NSEG * 64 * 128 * 4 <= (size_t)2 * NEXP * 1024, "rwseg");

template <bool FULL>
DEV void st_rwkv_seg(const Params& P, int sid, int seg, unsigned char* smem) {
  constexpr int NVB = FULL ? 2 : 4;
  constexpr int ZR = FULL ? 64 : 128;
  const int tid = threadIdx.x, lane = tid & 63, wave = tid >> 6;
  const int d = sid & 1, h = (sid >> 1) & 7, b = sid >> 4;
  bf16_t* sAt = (bf16_t*)smem;
  bf16_t* sRt = sAt + 32 * 72;
  bf16_t* sBt = sRt + 32 * 72;
  bf16_t* sKt = sBt + 32 * 72;
  bf16_t* sBT = sKt + 32 * 72;
  bf16_t* sKT = sBT + 64 * 40;
  bf16_t* sVT = sKT + 64 * 40;
  bf16_t* sLak = sVT + 64 * 40;
  bf16_t* sM = sLak + 32 * 40;
  bf16_t* sLrb = sM + 32 * 40;
  bf16_t* sLrk = sLrb + 32 * 40;
  bf16_t* sZ = FULL ? sLrk + 32 * 40 : sLrb;
  bf16_t* after = sZ + ZR * 72;
  bf16_t* sRT = after;
  bf16_t* sSAT = FULL ? after + 64 * 40 : sRt;
  float* sLP = (float*)(FULL ? after + 2 * 64 * 40 : after + 128 * 40);
  float* sLab = sLP + 4 * 64;
  float* sD = sLab + 32 * 36;
  float* sPT = sD + 768;
  int* sRow = (int*)(sPT + 64);
  static_assert((4 * 32 * 72 + 3 * 64 * 40 + 4 * 32 * 40 + 2 * 64 * 40 + 64 * 72) * 2 + (4 * 64 + 32 * 36 + 768 + 64 + 32 + 320) * 4 + 16 <= SMEM_BYTES, "lds full");
  static_assert((4 * 32 * 72 + 3 * 64 * 40 + 2 * 32 * 40 + 128 * 72 + 128 * 40) * 2 + (4 * 64 + 32 * 36 + 768 + 64 + 32 + 320) * 4 + 16 <= SMEM_BYTES, "lds p1");
  static_assert(128 * 40 <= 3 * 32 * 72, "alias");
  const bf16_t* proj = (const bf16_t*)(P.ws + OFF_PROJ);
  const bf16_t* lora = (const bf16_t*)(P.ws + OFF_LORA);
  bf16_t* yout = (bf16_t*)(P.ws + OFF_HBUF);
  float* segZ = (float*)(P.ws + OFF_RWSEG);
  const int t = tid >> 3, c0 = (tid & 7) * 8;
  const int hl = lane >> 5, l31 = lane & 31;
  float* sCst = (float*)(smem + SMEM_BYTES - 320 * 4 - 16);
  if (tid < 64) {
    sCst[tid] = P.in[I_MU][h * 64 + tid]; sCst[64 + tid] = P.in[I_MU][512 + h * 64 + tid]; sCst[128 + tid] = P.in[I_MU][1024 + h * 64 + tid];
    sCst[192 + tid] = P.in[I_KK][h * 64 + tid]; sCst[256 + tid] = P.in[I_KA][h * 64 + tid];
  }
  const int cc0 = (seg * RW_NCH) / RW_NSEG, cc1 = ((seg + 1) * RW_NCH) / RW_NSEG;
  RwkvRaw R;
  rwkv_load_raw(proj, lora, b, h, d, cc0, t, c0, R);
  f32x16 Zm[2];
#pragma unroll
  for (int j = 0; j < 2; ++j)
#pragma unroll
    for (int r = 0; r < 16; ++r) Zm[j][r] = 0.f;
  __syncthreads();
  for (int i = tid; i < ZR * 72; i += 256) sZ[i] = 0;
  __syncthreads();
  if (!FULL) {
    if (wave >= 2) {
#pragma unroll
      for (int cb = 0; cb < 2; ++cb)
#pragma unroll
        for (int r = 0; r < 16; ++r) {
          int c = cb * 32 + acc_row(r, lane), vp = wave * 32 + l31;
          if (c == vp - 64) { Zm[cb][r] = 1.f; sZ[vp * 72 + c] = 0x3f80; }
        }
    }
  } else {
    for (int js = 0; js < seg; ++js) {
      const float* Zs = segZ + ((size_t)sid * RW_NSEG + js) * 64 * 128;
      bf16_t* sG = sAt;
      {
        const int c = tid >> 2, c2 = (tid & 3) * 16;
        float gv[16];
        ld8(Zs + c * 128 + 64 + c2, gv); ld8(Zs + c * 128 + 64 + c2 + 8, gv + 8);
        *(u32x4*)(sG + c * 72 + c2) = pack8(gv);
        *(u32x4*)(sG + c * 72 + c2 + 8) = pack8(gv + 8);
      }
      __syncthreads();
      if (wave >= 2) {
        const int cb = wave - 2;
#pragma unroll
        for (int vb = 0; vb < 2; ++vb) {
          f32x16 acc;
#pragma unroll
          for (int r = 0; r < 16; ++r) acc[r] = Zs[(cb * 32 + acc_row(r, lane)) * 128 + vb * 32 + l31];
#pragma unroll
          for (int kk = 0; kk < 4; ++kk) {
            bf16x8 a = *(const bf16x8*)(sG + (cb * 32 + l31) * 72 + kk * 16 + 8 * hl);
            bf16x8 bb = *(const bf16x8*)(sZ + (vb * 32 + l31) * 72 + kk * 16 + 8 * hl);
            acc = mfma32(a, bb, acc);
          }
          Zm[vb] = acc;
        }
      }
      __syncthreads();
      if (wave >= 2) {
        const int cb = wave - 2;
#pragma unroll
        for (int vb = 0; vb < 2; ++vb)
#pragma unroll
          for (int g = 0; g < 4; ++g) {
            u32x2 pk; pk.x = pack2(Zm[vb][4 * g], Zm[vb][4 * g + 1]); pk.y = pack2(Zm[vb][4 * g + 2], Zm[vb][4 * g + 3]);
            *(u32x2*)(sZ + (vb * 32 + l31) * 72 + cb * 32 + 8 * g + 4 * hl) = pk;
          }
      }
      __syncthreads();
    }
  }
  for (int cc = cc0; cc < cc1; ++cc) {
    int tl_ = threadIdx.x; OPAQUE(tl_);
    const int tid = tl_, lane = tl_ & 63, hl = lane >> 5, l31 = lane & 31, t = tl_ >> 3, c0 = (tl_ & 7) * 8;
    const float* muR = sCst + c0; const float* muK = sCst + 64 + c0; const float* muV = sCst + 128 + c0;
    const float* kkw = sCst + 192 + c0; const float* kaw = sCst + 256 + c0;
    float lw8[8], lp8[8];
    {
      float lwf[8];
      unpack8(R.lw, lwf);
#pragma unroll
      for (int j = 0; j < 8; ++j) { lw8[j] = lwf[j]; lp8[j] = lw8[j]; }
#pragma unroll
      for (int off = 8; off < 64; off <<= 1) {
#pragma unroll
        for (int j = 0; j < 8; ++j) {
#ifdef CPU_EMU
          float o = emu_shfl_up(lp8[j], off);
#else
          float o = __shfl_up(lp8[j], off, 64);
#endif
          if (lane >= off) lp8[j] += o;
        }
      }
      if (lane >= 56) {
#pragma unroll
        for (int j = 0; j < 8; ++j) sLP[wave * 64 + c0 + j] = lp8[j];
      }
      if ((tid & 7) == 0) sRow[t] = R.row;
    }
    __syncthreads();
    {
#pragma unroll
      for (int j = 0; j < 8; ++j) {
        float offs = 0.f;
        for (int w2 = 0; w2 < wave; ++w2) offs += sLP[w2 * 64 + c0 + j];
        lp8[j] += offs;
      }
      if (t == 31) {
#pragma unroll
        for (int j = 0; j < 8; ++j) sPT[c0 + j] = fexp(lp8[j]);
      }
    }
    {
      float xs[8], xn[8], kt[8], aa[8], ob[8], ok[8];
      unpack8(R.ks, xs); unpack8(R.kn, xn);
      float ss = 0.f;
#pragma unroll
      for (int j = 0; j < 8; ++j) { kt[j] = xs[j] + muK[j] * (xn[j] - xs[j]); aa[j] = kt[j] * kkw[j]; ss += aa[j] * aa[j]; }
      ss = sum8(ss);
      const float rn = frsq(ss + 1e-12f);
      float laf[8];
      unpack8(R.la, laf);
#pragma unroll
      for (int j = 0; j < 8; ++j) {
        const float lp = lp8[j];
        const float lpm = lp8[j] - lw8[j];
        const float e = fexp(-lp);
        const float kkn = aa[j] * rn;
        const float asg = laf[j];
        aa[j] = -kkn * fexp(lpm);
        ob[j] = kkn * asg * e;
        ok[j] = kt[j] * (1.f + (asg - 1.f) * kaw[j]) * e;
      }
      *(u32x4*)(sAt + t * 72 + c0) = pack8(aa);
      *(u32x4*)(sBt + t * 72 + c0) = pack8(ob);
      *(u32x4*)(sKt + t * 72 + c0) = pack8(ok);
#pragma unroll
      for (int j = 0; j < 8; ++j) { sBT[(c0 + j) * 40 + (t ^ swz32(c0))] = f2bf(ob[j]); sKT[(c0 + j) * 40 + (t ^ swz32(c0))] = f2bf(ok[j]); }
      unpack8(R.vs, xs); unpack8(R.vn, xn);
#pragma unroll
      for (int j = 0; j < 8; ++j) sVT[(c0 + j) * 40 + (t ^ swz32(c0))] = f2bf(xs[j] + muV[j] * (xn[j] - xs[j]));
      if (FULL) {
        unpack8(R.rs, xs); unpack8(R.rn, xn);
#pragma unroll
        for (int j = 0; j < 8; ++j) xs[j] = (xs[j] + muR[j] * (xn[j] - xs[j])) * fexp(lp8[j]);
        *(u32x4*)(sRt + t * 72 + c0) = pack8(xs);
      }
    }
    if (cc + 1 < cc1) rwkv_load_raw(proj, lora, b, h, d, cc + 1, t, c0, R);
    __syncthreads();
    if (FULL || wave < 2) {
      const bf16_t* Asrc = wave < 2 ? sAt : sRt;
      const bf16_t* Bsrc = (wave & 1) ? sKt : sBt;
      f32x16 acc;
#pragma unroll
      for (int r = 0; r < 16; ++r) acc[r] = 0.f;
#pragma unroll
      for (int kk = 0; kk < 4; ++kk) {
        bf16x8 a = *(const bf16x8*)(Asrc + l31 * 72 + kk * 16 + 8 * hl);
        bf16x8 bb = *(const bf16x8*)(Bsrc + l31 * 72 + kk * 16 + 8 * hl);
        acc = mfma32(a, bb, acc);
      }
      bf16_t* dst = wave == 1 ? sLak : (wave == 2 ? sLrb : sLrk);
#pragma unroll
      for (int r = 0; r < 16; ++r) {
        int tt = acc_row(r, lane), j = l31;
        bool keep = wave < 2 ? (j < tt) : (j <= tt);
        float v = keep ? acc[r] : 0.f;
        if (wave == 0) sLab[tt * 36 + j] = v;
        else dst[tt * 40 + j] = f2bf(v);
      }
    }
    __syncthreads();
    auto rhs_block = [&](int vb) {
      f32x16 acc;
#pragma unroll
      for (int r = 0; r < 16; ++r) acc[r] = 0.f;
#pragma unroll
      for (int kk = 0; kk < 4; ++kk) {
        bf16x8 a = *(const bf16x8*)(sAt + l31 * 72 + kk * 16 + 8 * hl);
        bf16x8 bb = *(const bf16x8*)(sZ + (vb * 32 + l31) * 72 + kk * 16 + 8 * hl);
        acc = mfma32(a, bb, acc);
      }
      if (vb < 2) {
#pragma unroll
        for (int kk = 0; kk < 2; ++kk) {
          bf16x8 a = *(const bf16x8*)(sLak + l31 * 40 + kk * 16 + 8 * hl);
          bf16x8 bb = *(const bf16x8*)(sVT + (vb * 32 + l31) * 40 + ((kk * 16 + 8 * hl) ^ swz32(l31)));
          acc = mfma32(a, bb, acc);
        }
      }
#pragma unroll
      for (int g = 0; g < 4; ++g) {
        u32x2 pk; pk.x = pack2(acc[4 * g], acc[4 * g + 1]); pk.y = pack2(acc[4 * g + 2], acc[4 * g + 3]);
        *(u32x2*)(sRT + (vb * 32 + l31) * 40 + 8 * g + 4 * hl) = pk;
      }
    };
    if (wave == 0) {
      if (tid < 32) {
        const int q = tid >> 4, c = tid & 15;
        const float* Lq = sLab + (q * 16) * 36 + q * 16;
        float x[16];
#pragma unroll
        for (int i = 0; i < 16; ++i) {
          float s0 = (i == c) ? 1.f : 0.f, s1 = 0.f;
#pragma unroll
          for (int j4 = 0; j4 < i; j4 += 4) {
            const f32x4 l4 = *(const f32x4*)(Lq + i * 36 + j4);
            s0 += l4.x * x[j4];
            if (j4 + 1 < i) s1 += l4.y * x[j4 + 1];
            if (j4 + 2 < i) s0 += l4.z * x[j4 + 2];
            if (j4 + 3 < i) s1 += l4.w * x[j4 + 3];
          }
          x[i] = s0 + s1;
          sD[q * 256 + i * 16 + c] = x[i];
        }
      }
    } else if (FULL) {
      if (wave >= 2) rhs_block(wave - 2);
    } else {
      if (wave == 1) { rhs_block(0); rhs_block(1); }
      else rhs_block(wave);
    }
    __syncthreads();
    {
      const int i = tid >> 4, c = tid & 15;
      float sacc = 0.f;
#pragma unroll
      for (int j4 = 0; j4 < 16; j4 += 4) {
        const f32x4 l4 = *(const f32x4*)(sLab + (16 + i) * 36 + j4);
        sacc += l4.x * sD[j4 * 16 + c] + l4.y * sD[(j4 + 1) * 16 + c] + l4.z * sD[(j4 + 2) * 16 + c] + l4.w * sD[(j4 + 3) * 16 + c];
      }
      sD[512 + i * 16 + c] = sacc;
    }
    __syncthreads();
    {
      const int i = tid >> 4, c = tid & 15;
      float sacc = 0.f;
#pragma unroll
      for (int j4 = 0; j4 < 16; j4 += 4) {
        const f32x4 d4 = *(const f32x4*)(sD + 256 + i * 16 + j4);
        sacc += d4.x * sD[512 + j4 * 16 + c] + d4.y * sD[512 + (j4 + 1) * 16 + c] + d4.z * sD[512 + (j4 + 2) * 16 + c] + d4.w * sD[512 + (j4 + 3) * 16 + c];
      }
      sM[(16 + i) * 40 + c] = f2bf(sacc);
      sM[i * 40 + c] = f2bf(sD[i * 16 + c]);
      sM[(16 + i) * 40 + 16 + c] = f2bf(sD[256 + i * 16 + c]);
      sM[i * 40 + 16 + c] = 0;
    }
    __syncthreads();
    if (wave < NVB) {
      const int vb = wave;
      f32x16 acc;
#pragma unroll
      for (int r = 0; r < 16; ++r) acc[r] = 0.f;
#pragma unroll
      for (int kk = 0; kk < 2; ++kk) {
        bf16x8 a = *(const bf16x8*)(sM + l31 * 40 + kk * 16 + 8 * hl);
        bf16x8 bb = *(const bf16x8*)(sRT + (vb * 32 + l31) * 40 + kk * 16 + 8 * hl);
        acc = mfma32(a, bb, acc);
      }
#pragma unroll
      for (int g = 0; g < 4; ++g) {
        u32x2 pk; pk.x = pack2(acc[4 * g], acc[4 * g + 1]); pk.y = pack2(acc[4 * g + 2], acc[4 * g + 3]);
        *(u32x2*)(sSAT + (vb * 32 + l31) * 40 + 8 * g + 4 * hl) = pk;
      }
    }
    __syncthreads();
    if (FULL) {
      if (wave < 2) {
        const int vb = wave;
        f32x16 acc;
#pragma unroll
        for (int r = 0; r < 16; ++r) acc[r] = 0.f;
#pragma unroll
        for (int kk = 0; kk < 4; ++kk) {
          bf16x8 a = *(const bf16x8*)(sZ + (vb * 32 + l31) * 72 + kk * 16 + 8 * hl);
          bf16x8 bb = *(const bf16x8*)(sRt + l31 * 72 + kk * 16 + 8 * hl);
          acc = mfma32(a, bb, acc);
        }
#pragma unroll
        for (int kk = 0; kk < 2; ++kk) {
          bf16x8 a = *(const bf16x8*)(sSAT + (vb * 32 + l31) * 40 + kk * 16 + 8 * hl);
          bf16x8 bb = *(const bf16x8*)(sLrb + l31 * 40 + kk * 16 + 8 * hl);
          acc = mfma32(a, bb, acc);
        }
#pragma unroll
        for (int kk = 0; kk < 2; ++kk) {
          bf16x8 a = *(const bf16x8*)(sVT + (vb * 32 + l31) * 40 + ((kk * 16 + 8 * hl) ^ swz32(l31)));
          bf16x8 bb = *(const bf16x8*)(sLrk + l31 * 40 + kk * 16 + 8 * hl);
          acc = mfma32(a, bb, acc);
        }
        {
          const size_t obase = (size_t)sRow[l31] * 1024 + d * 512 + h * 64 + vb * 32;
#pragma unroll
          for (int g = 0; g < 4; ++g) {
            u32x2 pk; pk.x = pack2(acc[4 * g], acc[4 * g + 1]); pk.y = pack2(acc[4 * g + 2], acc[4 * g + 3]);
            *(u32x2*)(yout + obase + 8 * g + 4 * hl) = pk;
          }
        }
      } else {
        const int cb = wave - 2;
#pragma unroll
        for (int vb = 0; vb < 2; ++vb) {
          f32x16 acc;
#pragma unroll
          for (int r = 0; r < 16; ++r) acc[r] = 0.f;
#pragma unroll
          for (int kk = 0; kk < 2; ++kk) {
            bf16x8 a = *(const bf16x8*)(sBT + (cb * 32 + l31) * 40 + ((kk * 16 + 8 * hl) ^ swz32(l31)));
            bf16x8 bb = *(const bf16x8*)(sSAT + (vb * 32 + l31) * 40 + kk * 16 + 8 * hl);
            acc = mfma32(a, bb, acc);
          }
#pragma unroll
          for (int kk = 0; kk < 2; ++kk) {
            bf16x8 a = *(const bf16x8*)(sKT + (cb * 32 + l31) * 40 + ((kk * 16 + 8 * hl) ^ swz32(l31)));
            bf16x8 bb = *(const bf16x8*)(sVT + (vb * 32 + l31) * 40 + ((kk * 16 + 8 * hl) ^ swz32(l31)));
            acc = mfma32(a, bb, acc);
          }
#pragma unroll
          for (int r = 0; r < 16; ++r) Zm[vb][r] = sPT[cb * 32 + acc_row(r, lane)] * (Zm[vb][r] + acc[r]);
        }
      }
      __syncthreads();
      if (wave >= 2) {
        const int cb = wave - 2;
#pragma unroll
        for (int vb = 0; vb < 2; ++vb)
#pragma unroll
          for (int g = 0; g < 4; ++g) {
            u32x2 pk; pk.x = pack2(Zm[vb][4 * g], Zm[vb][4 * g + 1]); pk.y = pack2(Zm[vb][4 * g + 2], Zm[vb][4 * g + 3]);
            *(u32x2*)(sZ + (vb * 32 + l31) * 72 + cb * 32 + 8 * g + 4 * hl) = pk;
          }
      }
    } else {
      const int vb = wave;
#pragma unroll
      for (int cb = 0; cb < 2; ++cb) {
        f32x16 acc;
#pragma unroll
        for (int r = 0; r < 16; ++r) acc[r] = 0.f;
#pragma unroll
        for (int kk = 0; kk < 2; ++kk) {
          bf16x8 a = *(const bf16x8*)(sBT + (cb * 32 + l31) * 40 + ((kk * 16 + 8 * hl) ^ swz32(l31)));
          bf16x8 bb = *(const bf16x8*)(sSAT + (vb * 32 + l31) * 40 + kk * 16 + 8 * hl);
          acc = mfma32(a, bb, acc);
        }
        if (vb < 2) {
#pragma unroll
          for (int kk = 0; kk < 2; ++kk) {
            bf16x8 a = *(const bf16x8*)(sKT + (cb * 32 + l31) * 40 + ((kk * 16 + 8 * hl) ^ swz32(l31)));
            bf16x8 bb = *(const bf16x8*)(sVT + (vb * 32 + l31) * 40 + ((kk * 16 + 8 * hl) ^ swz32(l31)));
            acc = mfma32(a, bb, acc);
          }
        }
#pragma unroll
        for (int r = 0; r < 16; ++r) Zm[cb][r] = sPT[cb * 32 + acc_row(r, lane)] * (Zm[cb][r] + acc[r]);
      }
#pragma unroll
      for (int cb = 0; cb < 2; ++cb)
#pragma unroll
        for (int g = 0; g < 4; ++g) {
          u32x2 pk; pk.x = pack2(Zm[cb][4 * g], Zm[cb][4 * g + 1]); pk.y = pack2(Zm[cb][4 * g + 2], Zm[cb][4 * g + 3]);
          *(u32x2*)(sZ + (vb * 32 + l31) * 72 + cb * 32 + 8 * g + 4 * hl) = pk;
        }
    }
  }
  if (!FULL) {
    float* Zs = segZ + ((size_t)sid * RW_NSEG + seg) * 64 * 128;
#pragma unroll
    for (int cb = 0; cb < 2; ++cb)
#pragma unroll
      for (int r = 0; r < 16; ++r) Zs[(cb * 32 + acc_row(r, lane)) * 128 + wave * 32 + l31] = Zm[cb][r];
  }
}

constexpr int LRU_NCH = (CTXL + SEQ) / 64;
constexpr size_t OFF_ACUM0 = OFF_PU;
static_assert((size_t)NLAT * 512 * 2 <= (size_t)2 * NEXP * 1024, "acum0");

struct LruRaw { u32x4 x[2][4]; };
DEV void lru_load_raw(const Params& P, int sid, int cc, LruRaw& R) {
  constexpr int NC_CTX = CTXL / 64;
  const int tid = threadIdx.x;
  const int d = sid & 1, blk = (sid >> 1) & 7, b = sid >> 4;
  const bf16_t* proj = (const bf16_t*)(P.ws + OFF_PROJ);
  const int sgi = cc >= NC_CTX;
  const int row0 = sgi ? NCTX + b * SEQ : b * CTXL;
  const int len = sgi ? SEQ : CTXL;
  const int cl = (sgi ? cc - NC_CTX : cc) * 64;
  const int lch = blk * 64 + (tid & 7) * 8;
  const u32x4 z4 = {0u, 0u, 0u, 0u};
#pragma unroll
  for (int i = 0; i < 2; ++i) {
    int c = tid + i * 256, r = c >> 3;
    int p = cl + r, pos = d ? len - 1 - p : p;
#pragma unroll
    for (int tap = 0; tap < 4; ++tap) {
      int pp = pos + tap - 2;
      R.x[i][tap] = (pp >= 0 && pp < len) ? *(const u32x4*)(proj + (size_t)(row0 + pp) * ODC + 2304 + lch) : z4;
    }
  }
}

DEV void st_lru_chunk(const Params& P, int sid, int cc, int nsid, int ncc, bool has_next, LruRaw& R, unsigned char* smem) {
  constexpr int NC_CTX = CTXL / 64;
  const int tid = threadIdx.x, lane = tid & 63, wave = tid >> 6;
  const int d = sid & 1, blk = (sid >> 1) & 7, b = sid >> 4;
  float* sXc = (float*)smem;
  float* sAc = sXc + 4096;
  float* sBc = sAc + 4096;
  float* sU = sBc + 4096;
  bf16_t* sAop = (bf16_t*)(sU + 4096);
  float* sQA = (float*)(sAop + 64 * 72);
  float* sQH = sQA + 256;
  int* sRow = (int*)(sQH + 256);
  const bf16_t* proj = (const bf16_t*)(P.ws + OFF_PROJ);
  bf16_t* uout = (bf16_t*)(P.ws + OFF_LORA) + (size_t)d * NTOK * 512;
  bf16_t* aout = (bf16_t*)(P.ws + (d ? OFF_ACUM1 : OFF_ACUM0));
  const bf16_t* lruT = (const bf16_t*)(P.ws + OFF_LRUT) + (size_t)(d * 8 + blk) * 128 * 64;
  float* chunkS = (float*)(P.ws + OFF_LRUCS) + ((size_t)sid * LRU_NCH + cc) * 128;
  const float* cw = P.in[I_LCONVW];
  const float* cb = P.in[I_LCONVB];
  const int tr = (wave >> 1) * 32, nc0 = (wave & 1) * 64;
  const int sgi = cc >= NC_CTX;
  const int row0 = sgi ? NCTX + b * SEQ : b * CTXL;
  const int len = sgi ? SEQ : CTXL;
  const int cl = (sgi ? cc - NC_CTX : cc) * 64;
  __syncthreads();
  if (tid < 64) { int p = cl + tid; sRow[tid] = row0 + (d ? len - 1 - p : p); }
  {
    const int lc8 = (tid & 7) * 8, lch = blk * 64 + lc8;
#pragma unroll
    for (int i = 0; i < 2; ++i) {
      int c = tid + i * 256, r = c >> 3;
      int p = cl + r, pos = d ? len - 1 - p : p;
      float o[8];
      f32x4 c0 = *(const f32x4*)(cb + lch), c1 = *(const f32x4*)(cb + lch + 4);
      o[0] = c0.x; o[1] = c0.y; o[2] = c0.z; o[3] = c0.w; o[4] = c1.x; o[5] = c1.y; o[6] = c1.z; o[7] = c1.w;
#pragma unroll
      for (int tap = 0; tap < 4; ++tap) {
        float x[8];
        unpack8(R.x[i][tap], x);
        f32x4 w0 = *(const f32x4*)(cw + tap * 512 + lch), w1 = *(const f32x4*)(cw + tap * 512 + lch + 4);
        o[0] += w0.x * x[0]; o[1] += w0.y * x[1]; o[2] += w0.z * x[2]; o[3] += w0.w * x[3];
        o[4] += w1.x * x[4]; o[5] += w1.y * x[5]; o[6] += w1.z * x[6]; o[7] += w1.w * x[7];
      }
      { f32x4 o0 = {o[0], o[1], o[2], o[3]}, o1 = {o[4], o[5], o[6], o[7]};
        *(f32x4*)(sXc + r * 64 + lc8) = o0; *(f32x4*)(sXc + r * 64 + lc8 + 4) = o1; }
      *(u32x4*)(sAop + r * 72 + lc8) = pack8(o);
    }
  }
  if (has_next) lru_load_raw(P, nsid, ncc, R);
  __syncthreads();
  {
    f32x16 acc[2];
#pragma unroll
    for (int j = 0; j < 2; ++j)
#pragma unroll
      for (int r = 0; r < 16; ++r) acc[j][r] = 0.f;
#pragma unroll
    for (int kk = 0; kk < 4; ++kk) {
      bf16x8 a = *(const bf16x8*)(sAop + (tr + (lane & 31)) * 72 + kk * 16 + 8 * (lane >> 5));
#pragma unroll
      for (int j = 0; j < 2; ++j) {
        bf16x8 bb = *(const bf16x8*)(lruT + (nc0 + j * 32 + (lane & 31)) * 64 + kk * 16 + 8 * (lane >> 5));
        acc[j] = mfma32(a, bb, acc[j]);
      }
    }
#pragma unroll
    for (int j = 0; j < 2; ++j) {
      const int e = nc0 + j * 32 + (lane & 31);
      const int ch = blk * 64 + (e & 63);
      const float ebias = e < 64 ? P.in[I_BA][d * 512 + ch] : P.in[I_BI][d * 512 + ch];
      const float esp = softplusf_(-P.in[I_LAM][d * 512 + ch]);
#pragma unroll
      for (int r = 0; r < 16; ++r) {
        int t = tr + acc_row(r, lane);
        float g = sigmoidf_(acc[j][r] + ebias);
        if (e < 64) { float a_ = fexp(-8.f * g * esp); sAc[t * 64 + e] = a_; sU[t * 64 + e] = fsqrt(fmaxf(1.f - a_ * a_, 0.f)); }
        else sBc[t * 64 + (e - 64)] = g * sXc[t * 64 + (e - 64)];
      }
    }
  }
  __syncthreads();
  const int c = tid & 63, q = tid >> 6;
  {
    float av[16], hv[16];
#pragma unroll
    for (int i = 0; i < 16; ++i) {
      const int t = q * 16 + i;
      av[i] = sAc[t * 64 + c];
      hv[i] = sU[t * 64 + c] * sBc[t * 64 + c];
    }
    float h = 0.f, ap = 1.f;
#pragma unroll
    for (int i = 0; i < 16; ++i) { h = av[i] * h + hv[i]; ap *= av[i]; hv[i] = h; av[i] = ap; }
    sQA[q * 64 + c] = ap; sQH[q * 64 + c] = h;
    __syncthreads();
    float hin = 0.f, ain = 1.f;
    for (int q2 = 0; q2 < q; ++q2) { hin = sQA[q2 * 64 + c] * hin + sQH[q2 * 64 + c]; ain *= sQA[q2 * 64 + c]; }
#pragma unroll
    for (int i = 0; i < 16; ++i) {
      const int t = q * 16 + i;
      sU[t * 64 + c] = hv[i] + av[i] * hin;
      sAc[t * 64 + c] = av[i] * ain;
    }
    if (q == 3) { chunkS[c] = av[15] * ain; chunkS[64 + c] = hv[15] + av[15] * hin; }
  }
  __syncthreads();
  if (sgi) {
#pragma unroll
    for (int i = 0; i < 2; ++i) {
      int cidx = tid + i * 256, r = cidx >> 3, c8 = (cidx & 7) * 8;
      float u8[8], a8[8];
      ld8(sU + r * 64 + c8, u8); ld8(sAc + r * 64 + c8, a8);
      const int row = sRow[r];
      *(u32x4*)(uout + (size_t)row * 512 + blk * 64 + c8) = pack8(u8);
      *(u32x4*)(aout + (size_t)(row - NCTX) * 512 + blk * 64 + c8) = pack8(a8);
    }
  }
}

DEV void st_lru_carry(const Params& P, int sid, unsigned char* smem) {
  const int tid = threadIdx.x, c = tid & 63, p = tid >> 6;
  constexpr int NQ = (LRU_NCH + 3) / 4, NBATCH = 13;
  const int c0 = p * NQ, c1 = (c0 + NQ < LRU_NCH) ? c0 + NQ : LRU_NCH;
  const float* cs = (const float*)(P.ws + OFF_LRUCS) + (size_t)sid * LRU_NCH * 128;
  float* hs = (float*)(P.ws + OFF_LRUHS) + (size_t)sid * LRU_NCH * 64;
  float* sA = (float*)smem;
  float* sH = sA + 256;
  float A = 1.f, H = 0.f;
  for (int cc0 = c0; cc0 < c1; cc0 += NBATCH) {
    float a[NBATCH], bb[NBATCH];
#pragma unroll
    for (int i = 0; i < NBATCH; ++i) {
      const int cc = cc0 + i < LRU_NCH ? cc0 + i : LRU_NCH - 1;
      a[i] = cs[(size_t)cc * 128 + c]; bb[i] = cs[(size_t)cc * 128 + 64 + c];
    }
#pragma unroll
    for (int i = 0; i < NBATCH; ++i) if (cc0 + i < c1) { H = a[i] * H + bb[i]; A *= a[i]; }
  }
  __syncthreads();
  sA[p * 64 + c] = A; sH[p * 64 + c] = H;
  __syncthreads();
  float h = 0.f;
  for (int p2 = 0; p2 < p; ++p2) h = sA[p2 * 64 + c] * h + sH[p2 * 64 + c];
  for (int cc0 = c0; cc0 < c1; cc0 += NBATCH) {
    float a[NBATCH], bb[NBATCH];
#pragma unroll
    for (int i = 0; i < NBATCH; ++i) {
      const int cc = cc0 + i < LRU_NCH ? cc0 + i : LRU_NCH - 1;
      a[i] = cs[(size_t)cc * 128 + c]; bb[i] = cs[(size_t)cc * 128 + 64 + c];
    }
#pragma unroll
    for (int i = 0; i < NBATCH; ++i) if (cc0 + i < c1) { hs[(size_t)(cc0 + i) * 64 + c] = h; h = a[i] * h + bb[i]; }
  }
}

DEV void st_finish_l1(const Params& P, int row) {
  const int lane = threadIdx.x & 63;
  bf16_t* hb = (bf16_t*)(P.ws + OFF_HBUF) + (size_t)row * 1024;
  const bf16_t* proj = (const bf16_t*)(P.ws + OFF_PROJ);
  const bf16_t* lora = (const bf16_t*)(P.ws + OFF_LORA);
  const float* mu = P.in[I_MU];
  const int ch = lane * 8;
  float y0[8], y1[8];
  unpack8(*(const u32x4*)(hb + ch), y0);
  unpack8(*(const u32x4*)(hb + 512 + ch), y1);
  float sm = 0.f;
#pragma unroll
  for (int j = 0; j < 8; ++j) { y0[j] += y1[j]; sm += y0[j]; }
  sm = sum8(sm);
  const float mean = sm * (1.f / 64.f);
  float sv = 0.f;
#pragma unroll
  for (int j = 0; j < 8; ++j) { float dlt = y0[j] - mean; sv += dlt * dlt; }
  sv = sum8(sv);
  const float rstd = frsq(sv * (1.f / 64.f) + 64e-5f);
  float a0[8], a1[8], g[8], u0[8], u1[8], gb[8];
  unpack8(*(const u32x4*)(lora + ((size_t)2 * NTOK + row) * 512 + ch), a0);
  unpack8(*(const u32x4*)(lora + ((size_t)3 * NTOK + row) * 512 + ch), a1);
  unpack8(*(const u32x4*)(lora + ((size_t)4 * NTOK + row) * 512 + ch), g);
  unpack8(*(const u32x4*)(lora + ((size_t)0 * NTOK + row) * 512 + ch), u0);
  unpack8(*(const u32x4*)(lora + ((size_t)1 * NTOK + row) * 512 + ch), u1);
  if (row >= NCTX) {
    const int bb_ = (row - NCTX) / SEQ, pos = (row - NCTX) % SEQ, blk = ch >> 6;
    float ac[8];
#pragma unroll
    for (int dd = 0; dd < 2; ++dd) {
      const int pidx = dd ? SEQ - 1 - pos : pos;
      const int cc = CTXL / 64 + pidx / 64;
      const int sid = (bb_ * 8 + blk) * 2 + dd;
      const float* hs = (const float*)(P.ws + OFF_LRUHS) + ((size_t)sid * LRU_NCH + cc) * 64 + (ch & 63);
      unpack8(*(const u32x4*)((const bf16_t*)(P.ws + (dd ? OFF_ACUM1 : OFF_ACUM0)) + (size_t)(row - NCTX) * 512 + ch), ac);
      f32x4 h0 = *(const f32x4*)hs, h1 = *(const f32x4*)(hs + 4);
      float* u = dd ? u1 : u0;
      u[0] += ac[0] * h0.x; u[1] += ac[1] * h0.y; u[2] += ac[2] * h0.z; u[3] += ac[3] * h0.w;
      u[4] += ac[4] * h1.x; u[5] += ac[5] * h1.y; u[6] += ac[6] * h1.z; u[7] += ac[7] * h1.w;
    }
  }
  unpack8(*(const u32x4*)(proj + (size_t)row * ODC + 1792 + ch), gb);
  float rv[8], vv[8], kv[8];
  float sdot = 0.f;
  float pka[8], prk[8], plw[8], plb[8];
  ld8(P.in[I_KA] + ch, pka); ld8(P.in[I_RK] + ch, prk); ld8(P.in[I_LNW] + ch, plw); ld8(P.in[I_LNB] + ch, plb);
  mix8(proj, row, ch, mu, rv);
  mix8(proj, row, 512 + ch, mu, kv);
  mix8(proj, row, 1024 + ch, mu, vv);
#pragma unroll
  for (int j = 0; j < 8; ++j) {
    float r = rv[j];
    float k = kv[j];
    float am = 0.5f * (a0[j] + a1[j]);
    float kb = k * (1.f + (am - 1.f) * pka[j]);
    sdot += r * kb * prk[j];
    rv[j] = r;
  }
  sdot = sum8(sdot);
  float f1[8], f2[8];
#pragma unroll
  for (int j = 0; j < 8; ++j) {
    float yn = (y0[j] - mean) * rstd * plw[j] + plb[j];
    yn += sdot * vv[j];
    f1[j] = yn * g[j];
    f2[j] = (u0[j] + u1[j]) * geluf_(gb[j]);
  }
  *(u32x4*)(hb + ch) = pack8(f1);
  *(u32x4*)(hb + 512 + ch) = pack8(f2);
}

DEV unsigned fkey(float f) { unsigned u; __builtin_memcpy(&u, &f, 4); return (u >> 31) ? ~u : (u | 0x80000000u); }
DEV float keyf(unsigned u) { u = (u >> 31) ? (u & 0x7fffffffu) : ~u; float f; __builtin_memcpy(&f, &u, 4); return f; }
DEV void key_insert(unsigned x, unsigned* v) {
#pragma unroll
  for (int j = 0; j < 16; ++j) { unsigned hi = v[j] > x ? v[j] : x; x = v[j] > x ? x : v[j]; v[j] = hi; }
}
DEV void key_cx(unsigned& hi, unsigned& lo) { unsigned a = hi, b = lo; hi = a > b ? a : b; lo = a > b ? b : a; }
DEV void key_sort16(unsigned* v) {
#pragma unroll
  for (int k = 2; k <= 16; k <<= 1)
#pragma unroll
    for (int j = k >> 1; j > 0; j >>= 1)
#pragma unroll
      for (int i = 0; i < 16; ++i) {
        const int l = i ^ j;
        if (l > i) { if ((i & k) == 0) key_cx(v[i], v[l]); else key_cx(v[l], v[i]); }
      }
}
DEV void key_merge16(unsigned* a, const unsigned* b) {
#pragma unroll
  for (int i = 0; i < 16; ++i) a[i] = a[i] > b[15 - i] ? a[i] : b[15 - i];
#pragma unroll
  for (int j = 8; j > 0; j >>= 1)
#pragma unroll
    for (int i = 0; i < 16; ++i) { const int l = i ^ j; if (l > i) key_cx(a[i], a[l]); }
}

DEV void st_peer_topk(const Params& P, int layer, int tile, int h, unsigned char* smem) {
  const int tid = threadIdx.x;
  const bf16_t* q = (const bf16_t*)(P.ws + OFF_Q);
  const bf16_t* keys = (const bf16_t*)(P.ws + OFF_KEYS) + (size_t)(layer * 8 + h) * 2 * 128 * 128;
  float* sS = (float*)smem;
  const int m0 = tile * 128;
  const int tok = tid & 127, half = tid >> 7;
  unsigned kl[2][16];
#pragma unroll
  for (int p = 0; p < 2; ++p) {
    EpiScoreLds epi{sS, m0};
    gemm_tile_128<true>(q + (h * 2 + p) * 128, 2048, NTOK, keys + p * 128 * 128, 128, 128, 128, m0, 0, epi, smem);
    __syncthreads();
    float* row = sS + tok * 129 + half * 64;
#pragma unroll
    for (int g = 0; g < 4; ++g) {
      unsigned grp[16];
#pragma unroll
      for (int j = 0; j < 16; ++j) grp[j] = (fkey(row[g * 16 + j]) & ~127u) | (unsigned)(127 - (half * 64 + g * 16 + j));
      key_sort16(grp);
      if (g == 0) {
#pragma unroll
        for (int j = 0; j < 16; ++j) kl[p][j] = grp[j];
      } else key_merge16(kl[p], grp);
    }
    if (half == 1) {
#pragma unroll
      for (int j = 0; j < 16; ++j) row[j] = __builtin_bit_cast(float, kl[p][j]);
    }
    __syncthreads();
    if (half == 0) {
      unsigned oth[16];
#pragma unroll
      for (int j = 0; j < 16; ++j) oth[j] = __builtin_bit_cast(unsigned, sS[tok * 129 + 64 + j]);
      key_merge16(kl[p], oth);
    }
    __syncthreads();
  }
  if (tid < 128) {
    float sv0[16], sv1[16];
    int* irow = (int*)(sS + tid * 129);
#pragma unroll
    for (int j = 0; j < 16; ++j) {
      sv0[j] = keyf((kl[0][j] & ~127u) | 64u); sv1[j] = keyf((kl[1][j] & ~127u) | 64u);
      irow[j] = 127 - (int)(kl[0][j] & 127u); irow[16 + j] = 127 - (int)(kl[1][j] & 127u);
    }
    unsigned best[16];
#pragma unroll
    for (int j = 0; j < 16; ++j) best[j] = 0u;
#pragma unroll
    for (int i = 0; i < 16; ++i)
#pragma unroll
      for (int j = 0; j < 16; ++j)
        if ((i + 1) * (j + 1) <= 16) key_insert((fkey(sv0[i] + sv1[j]) & ~255u) | (unsigned)(255 - (i * 16 + j)), best);
    float e[16], sum = 0.f;
    const float b0 = keyf((best[0] & ~255u) | 128u);
#pragma unroll
    for (int j = 0; j < 16; ++j) { e[j] = fexp(keyf((best[j] & ~255u) | 128u) - b0); sum += e[j]; }
    const float inv = 1.f / sum;
    int* pidx = (int*)(P.ws + OFF_PIDX) + (size_t)(m0 + tid) * 128 + h * 16;
    float* pg = (float*)(P.ws + OFF_PGATE) + (size_t)(m0 + tid) * 128 + h * 16;
#pragma unroll
    for (int j = 0; j < 16; ++j) {
      const int pos = 255 - (int)(best[j] & 255u);
      pidx[j] = irow[pos >> 4] * 128 + irow[16 + (pos & 15)];
      pg[j] = e[j] * inv;
    }
  }
}

DEV void st_peer_experts(const Params& P, int layer, int row) {
  const int lane = threadIdx.x & 63;
  const bf16_t* xb = (const bf16_t*)(P.ws + OFF_HBUF) + (size_t)row * 1024;
  const unsigned char* U = P.ws + OFF_PU;
  const int* pidx = (const int*)(P.ws + OFF_PIDX) + (size_t)row * 128;
  const float* pg = (const float*)(P.ws + OFF_PGATE) + (size_t)row * 128;
  float x[16], acc[16];
  unpack8(*(const u32x4*)(xb + lane * 16), x);
  unpack8(*(const u32x4*)(xb + lane * 16 + 8), x + 8);
#pragma unroll
  for (int j = 0; j < 16; ++j) acc[j] = 0.f;
  const int b3 = (lane >> 3) & 1;
  const int mypick = (lane >> 3) & 7;
#ifdef CPU_EMU
#define PEER_SID(id) (id)
#else
#define PEER_SID(id) __builtin_amdgcn_readfirstlane(id)
#endif
  const unsigned lo12 = lane * 12, lo8 = PEER_VOFF + lane * 8;
#define PEER_LDU(i, id) do { const unsigned* up_ = (const unsigned*)(U + (size_t)(unsigned)(id) * PEER_ROWB + lo12); \
    uu[i].x = up_[0]; uu[i].y = up_[1]; uu[i].z = up_[2]; } while (0)
#define PEER_LDV(i, id) vv[i] = *(const u32x2*)(U + (size_t)(unsigned)(id) * PEER_ROWB + lo8)
#define PEER_IDS(v0, v1) {PEER_SID((int)v0.x), PEER_SID((int)v0.y), PEER_SID((int)v0.z), PEER_SID((int)v0.w), \
                          PEER_SID((int)v1.x), PEER_SID((int)v1.y), PEER_SID((int)v1.z), PEER_SID((int)v1.w)}
  u32x3 uu[8]; u32x2 vv[8];
  int cid[8];
  {
    const u32x4 p0 = *(const u32x4*)pidx, p1 = *(const u32x4*)(pidx + 4);
    const int id[8] = PEER_IDS(p0, p1);
#pragma unroll
    for (int i = 0; i < 8; ++i) { cid[i] = id[i]; PEER_LDU(i, id[i]); }
  }
  u32x4 n0 = *(const u32x4*)(pidx + 8), n1 = *(const u32x4*)(pidx + 12);
  float gcur = pg[mypick];
  for (int k0 = 0; k0 < 128; k0 += 8) {
#pragma unroll
    for (int i = 0; i < 8; ++i) PEER_LDV(i, cid[i]);
    const int nid[8] = PEER_IDS(n0, n1);
    {
      const int k2 = k0 + 16 < 128 ? k0 + 16 : 120;
      n0 = *(const u32x4*)(pidx + k2); n1 = *(const u32x4*)(pidx + k2 + 4);
    }
    const float gnxt = pg[(k0 + 8 < 128 ? k0 + 8 : 120) + mypick];
    float dsum[8];
#pragma unroll
    for (int i = 0; i < 8; i += 2) {
      float ufa[16], ufb[16];
#ifndef CPU_EMU
      __builtin_amdgcn_sched_barrier(0);
#endif
      unpack2x16_fp6(uu[i], uu[i + 1], ufa, ufb);
      PEER_LDU(i, nid[i]); PEER_LDU(i + 1, nid[i + 1]);
      typedef __attribute__((ext_vector_type(2))) float f32x2v;
      f32x2v da2 = {0.f, 0.f}, db2 = {0.f, 0.f};
#pragma unroll
      for (int j = 0; j < 8; ++j) {
        const f32x2v xx = {x[2 * j], x[2 * j + 1]};
        const f32x2v ua = {ufa[2 * j], ufa[2 * j + 1]}, ub = {ufb[2 * j], ufb[2 * j + 1]};
        da2 = xx * ua + da2; db2 = xx * ub + db2;
      }
      dsum[i] = da2.x + da2.y; dsum[i + 1] = db2.x + db2.y;
    }
    float e4[4], e2[2], g;
#pragma unroll
    for (int i = 0; i < 4; ++i) e4[i] = swap32_sum(dsum[i], dsum[4 + i]);
#pragma unroll
    for (int i = 0; i < 2; ++i) e2[i] = swap16_sum(e4[i], e4[2 + i]);
    {
      float mine = b3 ? e2[1] : e2[0], send = b3 ? e2[0] : e2[1];
      g = mine + dpp_xor<8>(send);
    }
    g = sum8(g);
    const float mycoef = gcur * geluf_(g * (1.f / PEER_USCALE));
#pragma unroll
    for (int i = 0; i < 8; ++i) {
      const float coef = wreadlane(mycoef, i * 8);
      float vf[16];
      unpack8_fp4(vv[i].x, vf); unpack8_fp4(vv[i].y, vf + 8);
#pragma unroll
      for (int j = 0; j < 16; ++j) acc[j] += coef * vf[j];
    }
#pragma unroll
    for (int i = 0; i < 8; ++i) cid[i] = nid[i];
    gcur = gnxt;
  }
#undef PEER_LDU
#undef PEER_LDV
#undef PEER_IDS
#undef PEER_SID
  float* xr = row < NCTX ? (float*)(P.ws + OFF_CTXRES) + (size_t)row * 1024 : P.out + (size_t)(row - NCTX) * 1024;
  const float* g2 = (const float*)(P.ws + OFF_MODV) + ((size_t)layer * 3 + mod_row(row)) * 6144 + 5 * 1024;
  float o[16];
#pragma unroll
  for (int q = 0; q < 4; ++q) {
    const int c = lane * 16 + q * 4;
    f32x4 a = *(const f32x4*)(xr + c), ga = *(const f32x4*)(g2 + c);
    o[q * 4 + 0] = a.x + ga.x * acc[q * 4 + 0] * (1.f / PEER_VSCALE); o[q * 4 + 1] = a.y + ga.y * acc[q * 4 + 1] * (1.f / PEER_VSCALE);
    o[q * 4 + 2] = a.z + ga.z * acc[q * 4 + 2] * (1.f / PEER_VSCALE); o[q * 4 + 3] = a.w + ga.w * acc[q * 4 + 3] * (1.f / PEER_VSCALE);
  }
  float ss = 0.f;
#pragma unroll
  for (int j = 0; j < 16; ++j) ss += o[j] * o[j];
  ss = wave_sum(ss);
  const float rstd = frsq(ss * (1.f / 1024.f) + 1e-6f);
  if (layer == 1) {
    float fn[16]; ld8(P.in[I_FNORM] + lane * 16, fn); ld8(P.in[I_FNORM] + lane * 16 + 8, fn + 8);
#pragma unroll
    for (int j = 0; j < 16; ++j) o[j] *= rstd * fn[j];
  }
#pragma unroll
  for (int q = 0; q < 4; ++q) {
    f32x4 a = {o[q * 4 + 0], o[q * 4 + 1], o[q * 4 + 2], o[q * 4 + 3]};
    *(f32x4*)(xr + lane * 16 + q * 4) = a;
  }
  if (layer == 0) {
    const float* mv = (const float*)(P.ws + OFF_MODV) + ((size_t)1 * 3 + mod_row(row)) * 6144;
    const float* nw = P.in[I_NORM1] + 1024;
    float hh[16];
#pragma unroll
    for (int q = 0; q < 4; ++q) {
      const int c = lane * 16 + q * 4;
      f32x4 w4 = *(const f32x4*)(nw + c), s4 = *(const f32x4*)(mv + 1024 + c), h4 = *(const f32x4*)(mv + c);
      hh[q * 4 + 0] = o[q * 4 + 0] * rstd * w4.x * (1.f + s4.x) + h4.x; hh[q * 4 + 1] = o[q * 4 + 1] * rstd * w4.y * (1.f + s4.y) + h4.y;
      hh[q * 4 + 2] = o[q * 4 + 2] * rstd * w4.z * (1.f + s4.z) + h4.z; hh[q * 4 + 3] = o[q * 4 + 3] * rstd * w4.w * (1.f + s4.w) + h4.w;
    }
    bf16_t* hb = (bf16_t*)(P.ws + OFF_HBUF) + (size_t)row * 1024 + lane * 16;
    *(u32x4*)hb = pack8(hh);
    *(u32x4*)(hb + 8) = pack8(hh + 8);
  }
}


#define FOR_TILES_XCD(MT0, MT1, NT, mt, nt)                                                     \
  for (int _x = blockIdx.x & 7, _mlo = (MT0) + (((MT1) - (MT0)) * _x) / 8,                        \
           _mhi = (MT0) + (((MT1) - (MT0)) * (_x + 1)) / 8, _i = blockIdx.x >> 3,                 \
           _cnt = (_mhi - _mlo) * (NT), mt = 0, nt = 0;                                           \
       _i < _cnt && ((mt = _mlo + _i / (NT)), (nt = _i % (NT)), true); _i += (int)(gridDim.x >> 3))

#ifndef PHASE_LIST
#define PHASE_LIST(X) X(0) X(1) X(2) X(22) X(23) X(3) X(4) X(5) X(6) X(7) X(8) X(9) X(11) X(12) X(13) X(30) X(14) X(15) X(31) X(16) X(17) X(18) X(19) X(20) X(21)
#endif
constexpr int PH_LAST = 21;

template <int ph>
DEV void run_phase(const Params& P, unsigned char* smem) {
  int bid_ = blockIdx.x, wave_ = threadIdx.x >> 6;
  OPAQUE_S(bid_); OPAQUE(wave_);
  const int bid = bid_, nb = gridDim.x;
  const int wave = wave_;
  unsigned char* ws = P.ws;
  constexpr int layer = ((ph >= 10 && ph <= 21) || ph >= 30) ? 1 : 0;
  const float* modv_l = (const float*)(ws + OFF_MODV) + (size_t)layer * 3 * 6144;
  switch (ph) {
    case 0:
      for (int t = NTRANS + bid; t < NPREP; t += nb) st_prep(P, t, smem);
      break;
    case 1: case 10:
      if (ph == 1) for (int t = nb - 1 - bid; t < NTRANS; t += nb) st_prep(P, t, smem);
      for (int t = bid; t < NTOK / 4; t += nb) st_normmod(P, layer, 0, t * 4 + wave);
      break;
    case 2: {
      EpiProjL0T epi{(bf16_t*)(ws + OFF_PROJ), (float*)(ws + OFF_GATES)};
      FOR_TILES_XCD(0, NTOK / 256, 25, mt, nt)
        gemm_tile_128x256<EpiProjL0T, true>((const bf16_t*)(ws + OFF_WEVIN), 1024, EVC, (const bf16_t*)(ws + OFF_HBUF), 1024, NTOK, 1024,
                                            nt * 128, mt * 256, epi, smem);
    } break;
    case 22:
      for (int t = bid; t < NTOK / 4; t += nb) st_xbc_conv(P, t * 4 + wave);
      for (int t = bid; t < NPCONV; t += nb) st_peer_conv(P, 0, t);
      break;
    case 23:
      for (int t = bid; t < 48 * LA_NSEG; t += nb) {
        int sid = t % 48, seg = t / 48;
        if (sid < 16) st_linattn_seg<true, false>(P, sid, seg, smem);
        else st_linattn_seg<false, false>(P, sid - 16, seg, smem);
      }
      break;
    case 3:
      for (int t = bid; t < 48 * LA_NSEG; t += nb) {
        int sid = t % 48, seg = t / 48;
        if (sid < 16) st_linattn_seg<true, true>(P, sid, seg, smem);
        else st_linattn_seg<false, true>(P, sid - 16, seg, smem);
      }
      break;
    case 4:
      for (int t = bid; t < NTOK / 4; t += nb) st_finish_l0(P, t * 4 + wave);
      break;
    case 5: case 17: {
      EpiOutProjT epi{layer == 0 ? P.in[I_X] : P.out, P.in[I_CTX], P.out, (float*)(ws + OFF_CTXRES), modv_l};
      const bf16_t* Wt = (const bf16_t*)(ws + (layer == 0 ? OFF_WEVOUT : OFF_WODOUT));
      FOR_TILES_XCD(layer == 0 ? 0 : NCTX / 256, NTOK / 256, 8, mt, nt)
        gemm_tile_128x256<EpiOutProjT, true>(Wt, 1024, 1024, (const bf16_t*)(ws + OFF_HBUF), 1024, NTOK, 1024, nt * 128, mt * 256, epi, smem);
    } break;
    case 6: case 18: {
      const int r0 = layer == 0 ? 0 : NCTX / 4;
      for (int t = r0 + bid; t < NTOK / 4; t += nb) st_normmod(P, layer, 1, t * 4 + wave);
      if (ph == 18) for (int t = bid; t < NPCONV; t += nb) st_peer_conv(P, 1, t);
    } break;
    case 7: case 19: {
      EpiStoreBfT epi{(bf16_t*)(ws + OFF_Q), 2048};
      const bf16_t* Wt = (const bf16_t*)(ws + OFF_WQ) + (size_t)layer * 2048 * 1024;
      FOR_TILES_XCD(layer == 0 ? 0 : NCTX / 256, NTOK / 256, 16, mt, nt)
        gemm_tile_128x256<EpiStoreBfT, true>(Wt, 1024, 2048, (const bf16_t*)(ws + OFF_HBUF), 1024, NTOK, 1024, nt * 128, mt * 256, epi, smem);
    } break;
    case 8: case 20: {
      const int t0 = layer == 0 ? 0 : CTILE * 8;
      for (int t = t0 + bid; t < NTILE * 8; t += nb) st_peer_topk(P, layer, t / 8, t % 8, smem);
    } break;
    case 9: case 21: {
      const int r0 = layer == 0 ? 0 : NCTX / 4;
      for (int t = r0 + bid; t < NTOK / 4; t += nb) st_peer_experts(P, layer, t * 4 + wave);
    } break;
    case 11: {
      EpiStoreBfT epi{(bf16_t*)(ws + OFF_PROJ), ODC};
      FOR_TILES_XCD(0, NTOK / 256, 22, mt, nt)
        gemm_tile_128x256<EpiStoreBfT, true>((const bf16_t*)(ws + OFF_WODIN), 1024, ODC, (const bf16_t*)(ws + OFF_HBUF), 1024, NTOK, 1024,
                                             nt * 128, mt * 256, epi, smem);
    } break;
    case 12:
      for (int t = bid; t < NTOK / 8; t += nb) st_lora_act(P, t * 8 + wave * 2);
      break;
    case 13:
      for (int t = bid; t < NTILE * 20; t += nb) {
        int job = t / (NTILE * 4), tt = t % (NTILE * 4);
        int mt = tt / 4, nt = tt % 4;
        bf16_t* dst = (bf16_t*)(ws + OFF_LORA) + (size_t)job * NTOK * 512;
        const bf16_t* A = (const bf16_t*)(ws + OFF_HBUF) + (job < 2 ? 0 : (job < 4 ? 64 : 128));
        const bf16_t* Bt = job < 2 ? (const bf16_t*)(ws + OFF_WUP) + (size_t)job * 512 * 64
                         : job < 4 ? (const bf16_t*)(ws + OFF_AUP) + (size_t)(job - 2) * 512 * 64
                                   : (const bf16_t*)(ws + OFF_GUP);
        const float* bias = job < 2 ? P.in[I_W0] + job * 512 : (job < 4 ? P.in[I_A0] + (job - 2) * 512 : nullptr);
        const int K = job < 4 ? 64 : 128;
        EpiStoreBfBiasT epi{dst, 512, bias, job < 2 ? 1 : (job < 4 ? 2 : 0)};
        gemm_tile_128<false, EpiStoreBfBiasT, true>(Bt, K, 512, A, 1024, NTOK, K, nt * 128, mt * 128, epi, smem);
      }
      break;
    case 30:
      for (int t = bid; t < 32 * RW_NSEG; t += nb) st_rwkv_seg<false>(P, t % 32, t / 32, smem);
      break;
    case 14:
      for (int t = bid; t < 32 * RW_NSEG; t += nb) st_rwkv_seg<true>(P, t % 32, t / 32, smem);
      break;
    case 15:
      {
        LruRaw R;
        if (bid < 32 * LRU_NCH) lru_load_raw(P, bid % 32, bid / 32, R);
        for (int t = bid; t < 32 * LRU_NCH; t += nb) {
          const int tn = t + nb;
          st_lru_chunk(P, t % 32, t / 32, tn % 32, tn / 32, tn < 32 * LRU_NCH, R, smem);
        }
      }
      break;
    case 31:
      if (bid < 32) st_lru_carry(P, bid, smem);
      break;
    case 16:
      for (int t = bid; t < NTOK / 4; t += nb) st_finish_l1(P, t * 4 + wave);
      break;
    default: break;
  }
}


#ifndef CPU_EMU
#define XB_TMO      128
#define XB_XCNT(j)  (256  + 64 * (j))
#define XB_XSUB(j)  (1280 + 64 * (j))
#define XB_XGEN(j)  (2304 + 64 * (j))
#define XB_TOP      3328
#define XB_TOPGEN   3392
#define XCD_BAR_WORDS 3456
#define XB_SPIN_CAP (1u << 20)
#define LAS __attribute__((address_space(3)))
__device__ __forceinline__ unsigned xb_ld(unsigned* p)              { return __hip_atomic_load(p, __ATOMIC_RELAXED, __HIP_MEMORY_SCOPE_AGENT); }
__device__ __forceinline__ unsigned xb_add(unsigned* p, unsigned v) { return __hip_atomic_fetch_add(p, v, __ATOMIC_RELAXED, __HIP_MEMORY_SCOPE_AGENT); }
__device__ __forceinline__ unsigned xb_xcc_id() { return (unsigned)__builtin_amdgcn_s_getreg((3 << 11) | 20) & 0xFu; }
#define XB_SPIN(cond, bar) do { unsigned _sp = 0; while (cond) { __builtin_amdgcn_s_sleep(1); \
    if ((++_sp & 255u) == 0u) { if (xb_ld(&(bar)[XB_TMO])) break; if (_sp > XB_SPIN_CAP) { atomicAdd(&(bar)[XB_TMO], 1u); break; } } } } while (0)
struct XcdBarrier { unsigned* bar; unsigned x; volatile LAS unsigned* st; };
__device__ __forceinline__ XcdBarrier xcd_barrier_post(unsigned* bar, volatile LAS unsigned* st) {
  XcdBarrier b; b.bar = bar; b.x = xb_xcc_id(); b.st = st;
  if (threadIdx.x == 0) (void)xb_add(&bar[XB_XCNT(b.x)], 1u);
  return b;
}
__device__ __forceinline__ void xcd_barrier_complete(unsigned* bar, unsigned x, unsigned& nloc, unsigned& nx) {
  const unsigned G = gridDim.x * gridDim.y * gridDim.z;
  unsigned sum, cnt, mine, sp = 0u;
  for (;;) {
    sum = 0u; cnt = 0u; mine = 0u;
#pragma unroll
    for (unsigned j = 0; j < 16; ++j) { const unsigned c = xb_ld(&bar[XB_XCNT(j)]); sum += c; cnt += (c > 0u) ? 1u : 0u; mine = (j == x) ? c : mine; }
    if (sum == G) break;
    __builtin_amdgcn_s_sleep(1);
    if ((++sp & 255u) == 0u) { if (xb_ld(&bar[XB_TMO])) break; if (sp > XB_SPIN_CAP) { atomicAdd(&bar[XB_TMO], 1u); break; } }
  }
  nloc = mine > 0u ? mine : 1u; nx = cnt > 0u ? cnt : 1u;
}
__device__ __forceinline__ void xcd_barrier(const XcdBarrier& b) {
  asm volatile("s_waitcnt vmcnt(0)" ::: "memory");
  __syncthreads();
  if (threadIdx.x == 0) {
    unsigned* bar = b.bar;
    __builtin_amdgcn_s_waitcnt(0);
    unsigned nloc = b.st[0], nx = b.st[1];
    if (nloc == 0u) { xcd_barrier_complete(bar, b.x, nloc, nx); b.st[0] = nloc; b.st[1] = nx; }
    const unsigned old = xb_add(&bar[XB_XSUB(b.x)], 1u);
    const unsigned gen = old / nloc;
    if (old + 1u == (gen + 1u) * nloc) {
      __builtin_amdgcn_fence(__ATOMIC_RELEASE, "agent");
      asm volatile("s_waitcnt vmcnt(0)" ::: "memory");
      const unsigned og = xb_add(&bar[XB_TOP], 1u);
      const unsigned tg = og / nx;
      if (og + 1u == (tg + 1u) * nx) xb_add(&bar[XB_TOPGEN], 1u);
      else XB_SPIN(xb_ld(&bar[XB_TOPGEN]) == tg, bar);
      __builtin_amdgcn_fence(__ATOMIC_ACQUIRE, "agent");
      xb_add(&bar[XB_XGEN(b.x)], 1u);
      asm volatile("s_waitcnt vmcnt(0)" ::: "memory");
    } else {
      XB_SPIN(xb_ld(&bar[XB_XGEN(b.x)]) == gen, bar);
      __builtin_amdgcn_fence(__ATOMIC_ACQUIRE, "agent");
      asm volatile("s_waitcnt vmcnt(0)" ::: "memory");
    }
  }
  __syncthreads();
}
#endif
#ifndef CPU_EMU
#define RUN_PH(n) run_phase<n>(P, smem_raw); if (n != PH_LAST) xcd_barrier(xb);
__global__ void __launch_bounds__(256, 2) mega_kernel(Params P) {
  SMEM_DECL;
  unsigned* bar = (unsigned*)(P.ws + OFF_BAR);
  volatile LAS unsigned* st = (volatile LAS unsigned*)(smem_raw + SMEM_BYTES - 16);
  if (threadIdx.x == 0) { st[0] = 0u; st[1] = 0u; }
  if (P.ws == nullptr) cg::this_grid().sync();
  __syncthreads();
  XcdBarrier xb = xcd_barrier_post(bar, st);
  PHASE_LIST(RUN_PH)
}

extern "C" void kernel_launch(void* const* d_in, const int* in_sizes, int n_in, void* d_out, int out_size, void* d_ws,
                              size_t ws_size, hipStream_t stream) {
  Params P{};
  for (int i = 0; i < N_IN; ++i) P.in[i] = (const float*)d_in[i];
  P.out = (float*)d_out;
  P.ws = (unsigned char*)d_ws;
  if (ws_size < WS_NEEDED) { fprintf(stderr, "workspace too small: %zu < %zu\n", ws_size, (size_t)WS_NEEDED); return; }
  static int grid_blocks = 0;
  if (!grid_blocks) {
    int dev = 0, cus = 0, per_cu = 0;
    hipGetDevice(&dev);
    hipDeviceGetAttribute(&cus, hipDeviceAttributeMultiprocessorCount, dev);
    hipOccupancyMaxActiveBlocksPerMultiprocessor(&per_cu, mega_kernel, 256, 0);
    if (per_cu > 2) per_cu = 2;
    grid_blocks = cus * per_cu;
  }
  (void)hipMemsetAsync((unsigned char*)d_ws + OFF_BAR, 0, 16384, stream);
  void* args[] = {&P};
  hipError_t e = hipLaunchCooperativeKernel((void*)mega_kernel, dim3(grid_blocks), dim3(256), args, 0, stream);
  if (e != hipSuccess) fprintf(stderr, "cooperative launch failed: %s (grid %d)\n", hipGetErrorString(e), grid_blocks);
}
#endif
```

```cpp
#ifdef CPU_EMU
#include "emu.h"
#else
#include <hip/hip_runtime.h>
#include <hip/hip_cooperative_groups.h>
#include <cstdio>
namespace cg = cooperative_groups;
#define DEV __device__ __forceinline__
#define DEVM __device__ __forceinline__
#define OPAQUE(x) asm volatile("" : "+v"(x))
#define OPAQUE_S(x) asm volatile("" : "+s"(x))
#endif

#ifndef SEQ_LEN
#define SEQ_LEN 16384
#endif
#ifndef CTX_LEN
#define CTX_LEN 256
#endif
#ifndef GRID_W_
#define GRID_W_ 64
#endif
#ifndef MULTI_LAUNCH
#define MULTI_LAUNCH 0
#endif

typedef unsigned short bf16_t;
typedef __attribute__((ext_vector_type(8))) short bf16x8;
typedef __attribute__((ext_vector_type(16))) float f32x16;
typedef __attribute__((ext_vector_type(4))) unsigned u32x4;
typedef __attribute__((ext_vector_type(2))) unsigned u32x2;
typedef __attribute__((ext_vector_type(4))) float f32x4;

constexpr int D = 1024, NB = 2, SEQ = SEQ_LEN, CTXL = CTX_LEN, GW = GRID_W_;
constexpr int NCTX = NB * CTXL, NLAT = NB * SEQ, NTOK = NCTX + NLAT;
constexpr int EVC = 3104, ODC = 2816;
constexpr int NEXP = 16384;
constexpr int NTILE = NTOK / 128, CTILE = NCTX / 128;
static_assert(NTOK % 256 == 0 && NCTX % 256 == 0, "tiles");
static_assert(CTXL % 64 == 0 && SEQ % 64 == 0 && SEQ % GW == 0, "chunks");

constexpr size_t al256(size_t x) { return (x + 255) & ~(size_t)255; }
constexpr size_t OFF_MODV = 0;
constexpr size_t OFF_CTXRES = OFF_MODV + al256(2 * 3 * 6144 * 4);
constexpr size_t OFF_GATES = OFF_CTXRES + al256((size_t)NCTX * 1024 * 4);
constexpr size_t OFF_WEVIN = OFF_GATES + al256((size_t)NTOK * 32 * 4);
constexpr size_t OFF_WEVOUT = OFF_WEVIN + al256((size_t)EVC * 1024 * 2);
constexpr size_t OFF_WODIN = OFF_WEVOUT + al256((size_t)1024 * 1024 * 2);
constexpr size_t OFF_WODOUT = OFF_WODIN + al256((size_t)ODC * 1024 * 2);
constexpr size_t OFF_WQ = OFF_WODOUT + al256((size_t)1024 * 1024 * 2);
constexpr size_t OFF_KEYS = OFF_WQ + al256((size_t)2 * 2048 * 1024 * 2);
constexpr size_t OFF_WUP = OFF_KEYS + al256((size_t)2 * 8 * 2 * 128 * 128 * 2);
constexpr size_t OFF_AUP = OFF_WUP + al256((size_t)2 * 512 * 64 * 2);
constexpr size_t OFF_GUP = OFF_AUP + al256((size_t)2 * 512 * 64 * 2);
constexpr size_t OFF_LRUT = OFF_GUP + al256((size_t)512 * 128 * 2);
constexpr size_t OFF_PU = OFF_LRUT + al256((size_t)2 * 8 * 128 * 64 * 2);
constexpr size_t OFF_PV = OFF_PU + al256((size_t)NEXP * 1024);
constexpr size_t OFF_HBUF = OFF_PV + al256((size_t)NEXP * 1024);
constexpr size_t OFF_PR = OFF_HBUF + al256((size_t)NTOK * 1024 * 2);
constexpr size_t PR_BYTES = (size_t)NTOK * 5376 * 2;
constexpr size_t OFF_BAR = OFF_PR + PR_BYTES;
constexpr size_t OFF_ACUM1 = OFF_BAR + 16384;
constexpr size_t OFF_LRUCS = OFF_ACUM1 + (size_t)NLAT * 512 * 2;
constexpr size_t OFF_LRUHS = OFF_LRUCS + (size_t)32 * ((CTXL + SEQ) / 64) * 128 * 4;
constexpr size_t WS_NEEDED = OFF_LRUHS + (size_t)32 * ((CTXL + SEQ) / 64) * 64 * 4;
#ifndef CPU_EMU
static_assert(WS_NEEDED <= (size_t)512 * 1024 * 1024, "workspace too large");
#endif
constexpr size_t OFF_PROJ = OFF_PR;
constexpr size_t OFF_R2L0 = OFF_PR + (size_t)NTOK * EVC * 2;
constexpr size_t OFF_LORA = OFF_PR + (size_t)NTOK * ODC * 2;
constexpr size_t OFF_Q = OFF_PR;
constexpr size_t OFF_PIDX = OFF_PR + (size_t)NTOK * 2048 * 2;
constexpr size_t OFF_PGATE = OFF_PIDX + (size_t)NTOK * 128 * 4;
static_assert(OFF_PGATE + (size_t)NTOK * 128 * 4 <= OFF_PR + PR_BYTES, "picks");

enum {
  I_X = 0, I_C, I_CTX, I_CCTX, I_MODW, I_MODB, I_NORM1, I_NORM2, I_WQ, I_KEYS, I_PU, I_PV,
  I_EVWIN, I_EVWOUT, I_IBIAS, I_FBIAS, I_MNORM, I_SCONVW, I_SCONVB, I_DTBIAS, I_ALOG, I_DSKIP, I_SNORM,
  I_ODWIN, I_ODWOUT, I_MU, I_W0, I_WUP, I_A0, I_AUP, I_GUP, I_KK, I_KA, I_RK, I_LNW, I_LNB,
  I_LCONVW, I_LCONVB, I_LAM, I_WA, I_BA, I_WI, I_BI, I_FNORM, N_IN
};

struct Params {
  const float* in[N_IN];
  float* out;
  unsigned char* ws;
};

constexpr int SMEM_BYTES = 80 * 1024;
#ifdef CPU_EMU
#define SMEM_DECL static thread_local __attribute__((aligned(16))) unsigned char smem_raw[SMEM_BYTES]
#else
#define SMEM_DECL __shared__ __attribute__((aligned(16))) unsigned char smem_raw[SMEM_BYTES]
#endif

DEV float bf2f(bf16_t v) { unsigned u = ((unsigned)v) << 16; float f; __builtin_memcpy(&f, &u, 4); return f; }
#ifdef CPU_EMU
DEV bf16_t f2bf(float f) { unsigned u; __builtin_memcpy(&u, &f, 4); u += 0x7fffu + ((u >> 16) & 1u); return (bf16_t)(u >> 16); }
DEV unsigned pack2(float a, float b) { return (unsigned)f2bf(a) | ((unsigned)f2bf(b) << 16); }
#else
typedef __attribute__((ext_vector_type(2))) float f32x2_t;
typedef __attribute__((ext_vector_type(2))) __bf16 bf16x2_t;
DEV unsigned pack2(float a, float b) { f32x2_t f = {a, b}; return __builtin_bit_cast(unsigned, __builtin_convertvector(f, bf16x2_t)); }
DEV bf16_t f2bf(float f) { return __builtin_bit_cast(unsigned short, (__bf16)f); }
#endif
DEV void unpack8(const u32x4& r, float* o) {
  unsigned w[4] = {r.x, r.y, r.z, r.w};
#pragma unroll
  for (int i = 0; i < 4; ++i) { unsigned lo = w[i] << 16, hi = w[i] & 0xffff0000u; __builtin_memcpy(&o[2 * i], &lo, 4); __builtin_memcpy(&o[2 * i + 1], &hi, 4); }
}
DEV u32x4 pack8(const float* o) { u32x4 r; r.x = pack2(o[0], o[1]); r.y = pack2(o[2], o[3]); r.z = pack2(o[4], o[5]); r.w = pack2(o[6], o[7]); return r; }
#ifdef CPU_EMU
DEV float fexp(float x) { return expf(x); }
DEV float frcp(float x) { return 1.f / x; }
DEV float flog(float x) { return logf(x); }
DEV float frsq(float x) { return 1.f / sqrtf(x); }
DEV float fsqrt(float x) { return sqrtf(x); }
#else
DEV float fexp(float x) { return __expf(x); }
DEV float frcp(float x) { return __builtin_amdgcn_rcpf(x); }
DEV float flog(float x) { return __logf(x); }
DEV float frsq(float x) { return __builtin_amdgcn_rsqf(x); }
DEV float fsqrt(float x) { return __builtin_amdgcn_sqrtf(x); }
#endif
DEV void ld8(const float* __restrict__ p, float* o) { const f32x4 a = *(const f32x4*)p, b = *(const f32x4*)(p + 4); o[0] = a.x; o[1] = a.y; o[2] = a.z; o[3] = a.w; o[4] = b.x; o[5] = b.y; o[6] = b.z; o[7] = b.w; }
DEV float sigmoidf_(float x) { return frcp(1.f + fexp(-x)); }
DEV float siluf_(float x) { return x * frcp(1.f + fexp(-x)); }
DEV float softplusf_(float x) { return fmaxf(x, 0.f) + flog(1.f + fexp(-fabsf(x))); }
DEV float tanhf_(float x) { return 1.f - 2.f * frcp(1.f + fexp(2.f * x)); }
DEV float geluf_(float x) { return 0.5f * x * (1.f + erff(x * 0.70710678118654752f)); }

DEV f32x16 mfma32(bf16x8 a, bf16x8 b, f32x16 c) {
#ifdef CPU_EMU
  return emu_mfma32(a, b, c);
#else
  return __builtin_amdgcn_mfma_f32_32x32x16_bf16(a, b, c, 0, 0, 0);
#endif
}
DEV float wshfl_xor(float v, int m) {
#ifdef CPU_EMU
  return emu_shfl_xor(v, m);
#else
  return __shfl_xor(v, m, 64);
#endif
}
template <int M> DEV float dpp_xor(float v) {
  static_assert(M == 1 || M == 2 || M == 7 || M == 8, "dpp pattern");
#ifdef CPU_EMU
  return emu_shfl_xor(v, M);
#else
  constexpr int ctrl = M == 1 ? 0xB1 : (M == 2 ? 0x4E : (M == 7 ? 0x141 : 0x128));
  return __int_as_float(__builtin_amdgcn_update_dpp(0, __float_as_int(v), ctrl, 0xf, 0xf, false));
#endif
}
DEV float sum8(float v) { v += dpp_xor<1>(v); v += dpp_xor<2>(v); v += dpp_xor<7>(v); return v; }
DEV float sum4(float v) { v += dpp_xor<1>(v); v += dpp_xor<2>(v); return v; }
DEV float sum16(float v) { v = sum8(v); v += dpp_xor<8>(v); return v; }
DEV float swap32_sum(float a, float b) {
#ifdef CPU_EMU
  float ra = emu_shfl_xor(a, 32), rb = emu_shfl_xor(b, 32);
  return ((threadIdx.x >> 5) & 1) ? b + rb : a + ra;
#else
  auto r = __builtin_amdgcn_permlane32_swap(__float_as_uint(a), __float_as_uint(b), false, false);
  return __uint_as_float(r[0]) + __uint_as_float(r[1]);
#endif
}
DEV float swap16_sum(float a, float b) {
#ifdef CPU_EMU
  float ra = emu_shfl_xor(a, 16), rb = emu_shfl_xor(b, 16);
  return ((threadIdx.x >> 4) & 1) ? b + rb : a + ra;
#else
  auto r = __builtin_amdgcn_permlane16_swap(__float_as_uint(a), __float_as_uint(b), false, false);
  return __uint_as_float(r[0]) + __uint_as_float(r[1]);
#endif
}
DEV float wave_sum(float v) {
  v = sum16(v);
  v = swap16_sum(v, v);
  return swap32_sum(v, v);
}
DEV float wave_incl_scan(float v) {
#ifdef CPU_EMU
  const int l = threadIdx.x & 63;
  for (int s = 1; s < 16; s <<= 1) { const bool ok = (l & 15) >= s; float o = emu_readlane(v, ok ? l - s : l); v += ok ? o : 0.f; }
  { const bool ok = ((l >> 4) & 1) != 0; float o = emu_readlane(v, ok ? (l & ~15) - 1 : l); v += ok ? o : 0.f; }
  { const bool ok = l >= 32; float o = emu_readlane(v, ok ? 31 : l); v += ok ? o : 0.f; }
  return v;
#else
#define DPP_ADD_(ctrl, rmask) v += __int_as_float(__builtin_amdgcn_update_dpp(0, __float_as_int(v), ctrl, rmask, 0xf, false))
  DPP_ADD_(0x111, 0xf); DPP_ADD_(0x112, 0xf); DPP_ADD_(0x114, 0xf); DPP_ADD_(0x118, 0xf);
  DPP_ADD_(0x142, 0xa); DPP_ADD_(0x143, 0xc);
#undef DPP_ADD_
  return v;
#endif
}

#ifdef CPU_EMU
static inline unsigned emu_f2fp8(float f) {
  unsigned sgn = f < 0.f ? 0x80u : 0u; float a = fabsf(f);
  if (!(a == a)) return 0x7f;
  if (a >= 448.f) return sgn | 0x7e;
  if (a < 0.0009765625f) return sgn;
  int e; frexpf(a, &e); e -= 1;
  if (e < -6) { int q = (int)nearbyintf(a * 512.f); return sgn | (unsigned)q; }
  float m = a / ldexpf(1.f, e);
  int q = (int)nearbyintf((m - 1.f) * 8.f);
  if (q == 8) { q = 0; e += 1; }
  if (e > 8) return sgn | 0x7e;
  return sgn | (unsigned)((e + 7) << 3) | (unsigned)q;
}
static inline float emu_fp82f(unsigned c) {
  unsigned sgn = c & 0x80, e = (c >> 3) & 15, m = c & 7;
  float v = e == 0 ? ldexpf((float)m, -9) : ldexpf(1.f + m / 8.f, (int)e - 7);
  return sgn ? -v : v;
}
#endif
DEV unsigned pack4_fp8(float a, float b, float c, float d) {
#ifdef CPU_EMU
  return emu_f2fp8(a) | (emu_f2fp8(b) << 8) | (emu_f2fp8(c) << 16) | (emu_f2fp8(d) << 24);
#else
  int w = 0;
  w = __builtin_amdgcn_cvt_pk_fp8_f32(a, b, w, false);
  w = __builtin_amdgcn_cvt_pk_fp8_f32(c, d, w, true);
  return (unsigned)w;
#endif
}
DEV void unpack4_fp8(unsigned w, float* o) {
#ifdef CPU_EMU
  o[0] = emu_fp82f(w & 255); o[1] = emu_fp82f((w >> 8) & 255); o[2] = emu_fp82f((w >> 16) & 255); o[3] = emu_fp82f(w >> 24);
#else
  typedef __attribute__((ext_vector_type(2))) float f32x2_;
  f32x2_ lo = __builtin_amdgcn_cvt_pk_f32_fp8((int)w, false);
  f32x2_ hi = __builtin_amdgcn_cvt_pk_f32_fp8((int)w, true);
  o[0] = lo.x; o[1] = lo.y; o[2] = hi.x; o[3] = hi.y;
#endif
}
DEV void unpack16_fp8(const u32x4& r, float* o) { unpack4_fp8(r.x, o); unpack4_fp8(r.y, o + 4); unpack4_fp8(r.z, o + 8); unpack4_fp8(r.w, o + 12); }
DEV float wreadlane(float v, int srclane) {
#ifdef CPU_EMU
  return emu_readlane(v, srclane);
#else
  int iv; __builtin_memcpy(&iv, &v, 4);
  int r = __builtin_amdgcn_readlane(iv, srclane);
  float f; __builtin_memcpy(&f, &r, 4); return f;
#endif
}
constexpr float PEER_USCALE = 64.f, PEER_VSCALE = 4.f;
#ifdef CPU_EMU
static inline unsigned emu_f2fp4(float f) {
  static const float lv[8] = {0.f, 0.5f, 1.f, 1.5f, 2.f, 3.f, 4.f, 6.f};
  unsigned sgn = f < 0.f ? 8u : 0u; float a = fabsf(f);
  int best = 0; float bd = 1e30f;
  for (int i = 0; i < 8; ++i) { float dd = fabsf(a - lv[i]); if (dd < bd || (dd == bd && (i & 1) == 0)) { bd = dd; best = i; } }
  return sgn | (unsigned)best;
}
static inline float emu_fp42f(unsigned c) {
  static const float lv[8] = {0.f, 0.5f, 1.f, 1.5f, 2.f, 3.f, 4.f, 6.f};
  float v = lv[c & 7]; return (c & 8) ? -v : v;
}
#endif
DEV unsigned pack8_fp4(const float* v) {
#ifdef CPU_EMU
  unsigned w = 0;
  for (int i = 0; i < 8; ++i) w |= emu_f2fp4(v[i]) << (4 * i);
  return w;
#else
  unsigned w = 0;
  w = __builtin_amdgcn_cvt_scalef32_pk_fp4_f32(w, v[0], v[1], 1.0f, 0);
  w = __builtin_amdgcn_cvt_scalef32_pk_fp4_f32(w, v[2], v[3], 1.0f, 1);
  w = __builtin_amdgcn_cvt_scalef32_pk_fp4_f32(w, v[4], v[5], 1.0f, 2);
  w = __builtin_amdgcn_cvt_scalef32_pk_fp4_f32(w, v[6], v[7], 1.0f, 3);
  return w;
#endif
}
DEV void unpack8_fp4(unsigned w, float* o) {
#ifdef CPU_EMU
  for (int i = 0; i < 8; ++i) o[i] = emu_fp42f((w >> (4 * i)) & 15u);
#else
  typedef __attribute__((ext_vector_type(2))) float f32x2_;
  f32x2_ a = __builtin_amdgcn_cvt_scalef32_pk_f32_fp4(w, 1.0f, 0);
  f32x2_ b = __builtin_amdgcn_cvt_scalef32_pk_f32_fp4(w, 1.0f, 1);
  f32x2_ c = __builtin_amdgcn_cvt_scalef32_pk_f32_fp4(w, 1.0f, 2);
  f32x2_ d = __builtin_amdgcn_cvt_scalef32_pk_f32_fp4(w, 1.0f, 3);
  o[0] = a.x; o[1] = a.y; o[2] = b.x; o[3] = b.y; o[4] = c.x; o[5] = c.y; o[6] = d.x; o[7] = d.y;
#endif
}
typedef __attribute__((ext_vector_type(3))) unsigned u32x3;
#ifndef FP6_INTERLEAVED
#define FP6_INTERLEAVED 1
#endif
#ifdef CPU_EMU
static inline unsigned emu_f2fp6(float f) {
  unsigned sgn = f < 0.f ? 32u : 0u; float a = fabsf(f);
  if (a >= 7.5f) return sgn | 31u;
  int e; unsigned code;
  if (a < 1.f) { int q = (int)nearbyintf(a * 8.f); code = (unsigned)q; }
  else { frexpf(a, &e); e -= 1; float m = a / ldexpf(1.f, e); int q = (int)nearbyintf((m - 1.f) * 8.f); if (q == 8) { q = 0; e += 1; } code = (unsigned)(((e + 1) << 3) | q); if (e > 2) code = 31u; }
  return sgn | code;
}
static inline float emu_fp62f(unsigned c) {
  unsigned e = (c >> 3) & 3, m = c & 7;
  float v = e == 0 ? m * 0.125f : ldexpf(1.f + m / 8.f, (int)e - 1);
  return (c & 32) ? -v : v;
}
#endif
DEV u32x3 pack16_fp6(const float* v) {
#ifdef CPU_EMU
  unsigned long long lo = 0; unsigned hi = 0;
  for (int i = 0; i < 16; ++i) {
    unsigned long long c = emu_f2fp6(v[i]); int bit = 6 * i;
    if (bit < 64) { lo |= c << bit; if (bit > 58) hi |= (unsigned)(c >> (64 - bit)); } else hi |= (unsigned)(c << (bit - 64));
  }
  u32x3 r; r.x = (unsigned)lo; r.y = (unsigned)(lo >> 32); r.z = hi; return r;
#else
  typedef __attribute__((ext_vector_type(6))) unsigned u32x6_;
  f32x16 a, b;
#if FP6_INTERLEAVED
#pragma unroll
  for (int i = 0; i < 8; ++i) { a[i] = v[2 * i]; b[i] = v[2 * i + 1]; a[8 + i] = 0.f; b[8 + i] = 0.f; }
#else
#pragma unroll
  for (int i = 0; i < 16; ++i) { a[i] = v[i]; b[i] = 0.f; }
#endif
  u32x6_ w = __builtin_amdgcn_cvt_scalef32_2xpk16_fp6_f32(a, b, 1.0f);
  u32x3 r; r.x = w[0]; r.y = w[1]; r.z = w[2]; return r;
#endif
}
DEV void unpack16_fp6(const u32x3& r, float* o) {
#ifdef CPU_EMU
  unsigned long long lo = (unsigned long long)r.x | ((unsigned long long)r.y << 32); unsigned hi = r.z;
  for (int i = 0; i < 16; ++i) {
    int bit = 6 * i; unsigned c;
    if (bit + 6 <= 64) c = (unsigned)(lo >> bit) & 63u;
    else if (bit >= 64) c = (hi >> (bit - 64)) & 63u;
    else c = ((unsigned)(lo >> bit) | (hi << (64 - bit))) & 63u;
    o[i] = emu_fp62f(c);
  }
#else
  typedef __attribute__((ext_vector_type(6))) unsigned u32x6_;
  typedef __attribute__((ext_vector_type(32))) float f32x32_;
  u32x6_ w; w[0] = r.x; w[1] = r.y; w[2] = r.z; w[3] = 0u; w[4] = 0u; w[5] = 0u;
  f32x32_ f = __builtin_amdgcn_cvt_scalef32_pk32_f32_fp6(w, 1.0f);
#pragma unroll
  for (int i = 0; i < 16; ++i) o[i] = f[i];
#endif
}
DEV void unpack2x16_fp6(const u32x3& ra, const u32x3& rb, float* oa, float* ob) {
#ifdef CPU_EMU
  unpack16_fp6(ra, oa); unpack16_fp6(rb, ob);
#else
  typedef __attribute__((ext_vector_type(6))) unsigned u32x6_;
  typedef __attribute__((ext_vector_type(32))) float f32x32_;
  u32x6_ w; w[0] = ra.x; w[1] = ra.y; w[2] = ra.z; w[3] = rb.x; w[4] = rb.y; w[5] = rb.z;
  f32x32_ f = __builtin_amdgcn_cvt_scalef32_pk32_f32_fp6(w, 1.0f);
#pragma unroll
  for (int i = 0; i < 16; ++i) { oa[i] = f[i]; ob[i] = f[16 + i]; }
#endif
}
constexpr int PEER_ROWB = 1280;
constexpr int PEER_VOFF = 768;


DEV int acc_row(int reg, int lane) { return (reg & 3) + 8 * (reg >> 2) + 4 * (lane >> 5); }

DEV int mod_row(int row) { return row < NCTX ? 2 : (row - NCTX) / SEQ; }

template <bool SYNC_EPI, class Epi, bool VEC4 = false>
DEV void gemm_tile_128(const bf16_t* __restrict__ A, int lda, int M, const bf16_t* __restrict__ Bt, int ldb, int N,
                       int K, int m0, int n0, const Epi& epi, unsigned char* smem) {
  constexpr int LS = 72;
  constexpr int STAGE = 2 * 128 * LS;
  bf16_t* sbase = (bf16_t*)smem;
  const int wave = threadIdx.x >> 6;
  const int wm = (wave >> 1) * 64, wn = (wave & 1) * 64;
  f32x16 acc[2][2];
#pragma unroll
  for (int i = 0; i < 2; ++i)
#pragma unroll
    for (int j = 0; j < 2; ++j)
#pragma unroll
      for (int r = 0; r < 16; ++r) acc[i][j][r] = 0.f;
  u32x4 ra[4], rb[4];
  auto gload = [&](int k0) {
    int tl_ = threadIdx.x; OPAQUE(tl_);
#pragma unroll
    for (int i = 0; i < 4; ++i) {
      int c = tl_ + i * 256, r = c >> 3, cc = (c & 7) * 8;
      int gr = m0 + r, gn = n0 + r;
      gr = gr < M ? gr : M - 1; gn = gn < N ? gn : N - 1;
      ra[i] = *(const u32x4*)(A + (size_t)gr * lda + k0 + cc);
      rb[i] = *(const u32x4*)(Bt + (size_t)gn * ldb + k0 + cc);
    }
  };
  auto lwrite = [&](int buf) {
    int tl_ = threadIdx.x; OPAQUE(tl_);
    bf16_t* sA = sbase + buf * STAGE;
    bf16_t* sB = sA + 128 * LS;
#pragma unroll
    for (int i = 0; i < 4; ++i) {
      int c = tl_ + i * 256, r = c >> 3, cc = (c & 7) * 8;
      *(u32x4*)(sA + r * LS + cc) = ra[i];
      *(u32x4*)(sB + r * LS + cc) = rb[i];
    }
  };
  const int nk = K >> 6;
  gload(0);
  __syncthreads();
  lwrite(0);
  if (nk > 1) gload(64);
  __syncthreads();
  for (int it = 0; it < nk; ++it) {
    int tl_ = threadIdx.x; OPAQUE(tl_);
    const int lane = tl_ & 63;
    const bf16_t* sA = sbase + (it & 1) * STAGE;
    const bf16_t* sB = sA + 128 * LS;
#pragma unroll
    for (int kk = 0; kk < 4; ++kk) {
      bf16x8 a[2], b[2];
      const int ko = kk * 16 + 8 * (lane >> 5);
#pragma unroll
      for (int i = 0; i < 2; ++i) a[i] = *(const bf16x8*)(sA + (wm + i * 32 + (lane & 31)) * LS + ko);
#pragma unroll
      for (int j = 0; j < 2; ++j) b[j] = *(const bf16x8*)(sB + (wn + j * 32 + (lane & 31)) * LS + ko);
#pragma unroll
      for (int i = 0; i < 2; ++i)
#pragma unroll
        for (int j = 0; j < 2; ++j) acc[i][j] = mfma32(a[i], b[j], acc[i][j]);
      if (kk == 1) {
        if (it + 1 < nk) lwrite((it + 1) & 1);
        if (it + 2 < nk) gload((it + 2) * 64);
      }
    }
    __syncthreads();
  }
  {
    int tl_ = threadIdx.x; OPAQUE(tl_);
    const int lane = tl_ & 63;
    if constexpr (VEC4) {
#pragma unroll
      for (int i = 0; i < 2; ++i)
#pragma unroll
        for (int j = 0; j < 2; ++j)
#pragma unroll
          for (int gq = 0; gq < 4; ++gq) {
            int row = m0 + wm + i * 32 + 8 * gq + 4 * (lane >> 5);
            int col = n0 + wn + j * 32 + (lane & 31);
            if (row < M && col < N) epi.store4(row, col, acc[i][j][4 * gq], acc[i][j][4 * gq + 1], acc[i][j][4 * gq + 2], acc[i][j][4 * gq + 3]);
          }
    } else {
#pragma unroll
      for (int i = 0; i < 2; ++i)
#pragma unroll
        for (int j = 0; j < 2; ++j)
#pragma unroll
          for (int r = 0; r < 16; ++r) {
            int row = m0 + wm + i * 32 + acc_row(r, lane);
            int col = n0 + wn + j * 32 + (lane & 31);
            if (row < M && col < N) epi(row, col, acc[i][j][r]);
          }
    }
  }
}

template <class Epi, bool VEC4 = false>
DEV void gemm_tile_128x256(const bf16_t* __restrict__ A, int lda, int M, const bf16_t* __restrict__ Bt, int ldb, int N,
                           int K, int m0, int n0, const Epi& epi, unsigned char* smem) {
  constexpr int LS = 72;
  bf16_t* sA = (bf16_t*)smem;
  bf16_t* sB = sA + 128 * LS;
  const int wave = threadIdx.x >> 6;
  const int wm = (wave >> 1) * 64, wn = (wave & 1) * 128;
  f32x16 acc[2][4];
#pragma unroll
  for (int i = 0; i < 2; ++i)
#pragma unroll
    for (int j = 0; j < 4; ++j)
#pragma unroll
      for (int r = 0; r < 16; ++r) acc[i][j][r] = 0.f;
  u32x4 ra[4], rb[8];
  {
    const int tid = threadIdx.x;
#pragma unroll
    for (int i = 0; i < 4; ++i) {
      int c = tid + i * 256, r = c >> 3, cc = (c & 7) * 8;
      { int gr = m0 + r; gr = gr < M ? gr : M - 1; ra[i] = *(const u32x4*)(A + (size_t)gr * lda + cc); }
    }
#pragma unroll
    for (int i = 0; i < 8; ++i) {
      int c = tid + i * 256, r = c >> 3, cc = (c & 7) * 8;
      { int gn = n0 + r; gn = gn < N ? gn : N - 1; rb[i] = *(const u32x4*)(Bt + (size_t)gn * ldb + cc); }
    }
  }
  for (int k0 = 0; k0 < K; k0 += 64) {
    int tl_ = threadIdx.x; OPAQUE(tl_);
    const int tid = tl_, lane = tl_ & 63;
    __syncthreads();
#pragma unroll
    for (int i = 0; i < 4; ++i) { int c = tid + i * 256, r = c >> 3, cc = (c & 7) * 8; *(u32x4*)(sA + r * LS + cc) = ra[i]; }
#pragma unroll
    for (int i = 0; i < 8; ++i) { int c = tid + i * 256, r = c >> 3, cc = (c & 7) * 8; *(u32x4*)(sB + r * LS + cc) = rb[i]; }
    __syncthreads();
    if (k0 + 64 < K) {
#pragma unroll
      for (int i = 0; i < 4; ++i) {
        int c = tid + i * 256, r = c >> 3, cc = (c & 7) * 8;
        { int gr = m0 + r; gr = gr < M ? gr : M - 1; ra[i] = *(const u32x4*)(A + (size_t)gr * lda + k0 + 64 + cc); }
      }
#pragma unroll
      for (int i = 0; i < 8; ++i) {
        int c = tid + i * 256, r = c >> 3, cc = (c & 7) * 8;
        { int gn = n0 + r; gn = gn < N ? gn : N - 1; rb[i] = *(const u32x4*)(Bt + (size_t)gn * ldb + k0 + 64 + cc); }
      }
    }
#pragma unroll 2
    for (int kk = 0; kk < 4; ++kk) {
      bf16x8 a[2], b[4];
      const int ko = kk * 16 + 8 * (lane >> 5);
#pragma unroll
      for (int i = 0; i < 2; ++i) a[i] = *(const bf16x8*)(sA + (wm + i * 32 + (lane & 31)) * LS + ko);
#pragma unroll
      for (int j = 0; j < 4; ++j) b[j] = *(const bf16x8*)(sB + (wn + j * 32 + (lane & 31)) * LS + ko);
#pragma unroll
      for (int i = 0; i < 2; ++i)
#pragma unroll
        for (int j = 0; j < 4; ++j) acc[i][j] = mfma32(a[i], b[j], acc[i][j]);
    }
  }
  {
    int tl_ = threadIdx.x; OPAQUE(tl_);
    const int lane = tl_ & 63;
    if constexpr (VEC4) {
#pragma unroll
      for (int i = 0; i < 2; ++i)
#pragma unroll
        for (int j = 0; j < 4; ++j)
#pragma unroll
          for (int gq = 0; gq < 4; ++gq) {
            int row = m0 + wm + i * 32 + 8 * gq + 4 * (lane >> 5);
            int col = n0 + wn + j * 32 + (lane & 31);
            if (row < M && col < N) epi.store4(row, col, acc[i][j][4 * gq], acc[i][j][4 * gq + 1], acc[i][j][4 * gq + 2], acc[i][j][4 * gq + 3]);
          }
    } else {
#pragma unroll
      for (int i = 0; i < 2; ++i)
#pragma unroll
        for (int j = 0; j < 4; ++j)
#pragma unroll
          for (int r = 0; r < 16; ++r) {
            int row = m0 + wm + i * 32 + acc_row(r, lane);
            int col = n0 + wn + j * 32 + (lane & 31);
            if (row < M && col < N) epi(row, col, acc[i][j][r]);
          }
    }
  }
}

DEV void transpose_tile(const float* __restrict__ src, int ld_src, bf16_t* __restrict__ dst, int ld_dst, int K, int N,
                        int tk, int tn, unsigned char* smem) {
  float* sT = (float*)smem;
  const int tid = threadIdx.x;
  __syncthreads();
  {
    const int tx = tid & 15, ty = tid >> 4;
#pragma unroll
    for (int p = 0; p < 4; ++p) {
      int k = tk * 64 + ty + p * 16, n = tn * 64 + tx * 4;
      f32x4 v4 = {0.f, 0.f, 0.f, 0.f};
      if (k < K && n < N) v4 = *(const f32x4*)(src + (size_t)k * ld_src + n);
      float* d = sT + (ty + p * 16) * 65 + tx * 4;
      d[0] = v4.x; d[1] = v4.y; d[2] = v4.z; d[3] = v4.w;
    }
  }
  __syncthreads();
  {
    const int n = tid >> 2, kseg = (tid & 3) * 16;
    int gn = tn * 64 + n;
    if (gn < N) {
      float v[16];
#pragma unroll
      for (int j = 0; j < 16; ++j) v[j] = sT[(kseg + j) * 65 + n];
      bf16_t* d = dst + (size_t)gn * ld_dst + tk * 64 + kseg;
      *(u32x4*)d = pack8(v);
      *(u32x4*)(d + 8) = pack8(v + 8);
    }
  }
}

constexpr int TJ0 = 16 * 49, TJ1 = 16 * 16, TJ2 = 16 * 44, TJ3 = 16 * 16, TJ4 = 2 * 16 * 32, TJ5 = 2 * 8, TJ6 = 2 * 8,
              TJ7 = 2 * 8, TJ8 = 32;
constexpr int NTRANS = TJ0 + TJ1 + TJ2 + TJ3 + TJ4 + TJ5 + TJ6 + TJ7 + TJ8;
constexpr int NKEYCV = (2 * 8 * 2 * 128 * 128) / (256 * 8);
constexpr int NMODV = 2 * 96;
constexpr int NPREP = NTRANS + NKEYCV + NMODV;

DEV void st_prep(const Params& P, int item, unsigned char* smem) {
  unsigned char* ws = P.ws;
  if (item < NTRANS) {
    int t = item;
    if (t < TJ0) { transpose_tile(P.in[I_EVWIN], EVC, (bf16_t*)(ws + OFF_WEVIN), 1024, 1024, EVC, t / 49, t % 49, smem); return; }
    t -= TJ0;
    if (t < TJ1) { transpose_tile(P.in[I_EVWOUT], 1024, (bf16_t*)(ws + OFF_WEVOUT), 1024, 1024, 1024, t / 16, t % 16, smem); return; }
    t -= TJ1;
    if (t < TJ2) { transpose_tile(P.in[I_ODWIN], ODC, (bf16_t*)(ws + OFF_WODIN), 1024, 1024, ODC, t / 44, t % 44, smem); return; }
    t -= TJ2;
    if (t < TJ3) { transpose_tile(P.in[I_ODWOUT], 1024, (bf16_t*)(ws + OFF_WODOUT), 1024, 1024, 1024, t / 16, t % 16, smem); return; }
    t -= TJ3;
    if (t < TJ4) {
      int l = t / 512, tt = t % 512;
      transpose_tile(P.in[I_WQ] + (size_t)l * 1024 * 2048, 2048, (bf16_t*)(ws + OFF_WQ) + (size_t)l * 2048 * 1024, 1024, 1024, 2048, tt / 32, tt % 32, smem);
      return;
    }
    t -= TJ4;
    if (t < TJ5) { int d = t / 8; transpose_tile(P.in[I_WUP] + d * 64 * 512, 512, (bf16_t*)(ws + OFF_WUP) + d * 512 * 64, 64, 64, 512, 0, t % 8, smem); return; }
    t -= TJ5;
    if (t < TJ6) { int d = t / 8; transpose_tile(P.in[I_AUP] + d * 64 * 512, 512, (bf16_t*)(ws + OFF_AUP) + d * 512 * 64, 64, 64, 512, 0, t % 8, smem); return; }
    t -= TJ6;
    if (t < TJ7) { transpose_tile(P.in[I_GUP], 512, (bf16_t*)(ws + OFF_GUP), 128, 128, 512, t / 8, t % 8, smem); return; }
    t -= TJ7;
    {
      int which = t & 1, db = t >> 1;
      const float* src = (which ? P.in[I_WI] : P.in[I_WA]) + (size_t)db * 64 * 64;
      transpose_tile(src, 64, (bf16_t*)(ws + OFF_LRUT) + (size_t)db * 128 * 64 + which * 64 * 64, 64, 64, 64, 0, 0, smem);
      return;
    }
  }
  item -= NTRANS;
  if (item < NKEYCV) {
    size_t e = ((size_t)item * 256 + threadIdx.x) * 8;
    const float* s = P.in[I_KEYS] + e;
    f32x4 a = *(const f32x4*)s, b = *(const f32x4*)(s + 4);
    float v[8] = {a.x, a.y, a.z, a.w, b.x, b.y, b.z, b.w};
    *(u32x4*)((bf16_t*)(ws + OFF_KEYS) + e) = pack8(v);
    return;
  }
  item -= NKEYCV;
  {
    const int l = item / 96, cgp = item % 96;
    float* sS = (float*)smem;
    float* sRed = sS + 3 * 1024;
    const int tid = threadIdx.x;
    __syncthreads();
    for (int i = tid; i < 3 * 1024; i += 256) {
      int m = i >> 10, k = i & 1023;
      float c = m < 2 ? P.in[I_C][m * 1024 + k] : P.in[I_CCTX][k];
      sS[i] = siluf_(c);
    }
    __syncthreads();
    const int ks = tid >> 6, col = cgp * 64 + (tid & 63);
    const float* w = P.in[I_MODW] + (size_t)l * 1024 * 6144 + col;
    float a0 = 0.f, a1 = 0.f, a2 = 0.f;
    for (int k = ks * 256; k < ks * 256 + 256; ++k) {
      float wv = w[(size_t)k * 6144];
      a0 += sS[k] * wv; a1 += sS[1024 + k] * wv; a2 += sS[2048 + k] * wv;
    }
    sRed[(ks * 3 + 0) * 64 + (tid & 63)] = a0;
    sRed[(ks * 3 + 1) * 64 + (tid & 63)] = a1;
    sRed[(ks * 3 + 2) * 64 + (tid & 63)] = a2;
    __syncthreads();
    if (tid < 192) {
      int m = tid >> 6, c = tid & 63;
      float s = sRed[(0 * 3 + m) * 64 + c] + sRed[(1 * 3 + m) * 64 + c] + sRed[(2 * 3 + m) * 64 + c] + sRed[(3 * 3 + m) * 64 + c];
      int cc = cgp * 64 + c;
      ((float*)(ws + OFF_MODV))[((size_t)l * 3 + m) * 6144 + cc] = s + P.in[I_MODB][l * 6144 + cc];
    }
  }
}

constexpr int NPCONV = 2 * (NEXP * 1024 / (256 * 16));
DEV void st_peer_conv(const Params& P, int layer, int item) {
  const int half = NPCONV / 2;
  int which = item >= half;
  int it = which ? item - half : item;
  size_t e = ((size_t)it * 256 + threadIdx.x) * 16;
  const float* s = (which ? P.in[I_PV] : P.in[I_PU]) + (size_t)layer * NEXP * 1024 + e;
  const float sc = which ? PEER_VSCALE : PEER_USCALE;
  float v16[16];
#pragma unroll
  for (int q = 0; q < 4; ++q) {
    f32x4 a = *(const f32x4*)(s + 4 * q);
    v16[4 * q] = a.x * sc; v16[4 * q + 1] = a.y * sc; v16[4 * q + 2] = a.z * sc; v16[4 * q + 3] = a.w * sc;
  }
  const size_t ex = e >> 10, col = e & 1023;
  if (which) {
    u32x2 o; o.x = pack8_fp4(v16); o.y = pack8_fp4(v16 + 8);
    *(u32x2*)(P.ws + OFF_PU + ex * PEER_ROWB + PEER_VOFF + (col >> 1)) = o;
  } else {
    u32x3 o = pack16_fp6(v16);
    unsigned* dp = (unsigned*)(P.ws + OFF_PU + ex * PEER_ROWB + (col >> 4) * 12);
    dp[0] = o.x; dp[1] = o.y; dp[2] = o.z;
  }
}

DEV void st_normmod(const Params& P, int layer, int which, int row) {
  const int lane = threadIdx.x & 63;
  const float* src;
  if (which == 0 && layer == 0) src = row < NCTX ? P.in[I_CTX] + (size_t)row * 1024 : P.in[I_X] + (size_t)(row - NCTX) * 1024;
  else src = row < NCTX ? (const float*)(P.ws + OFF_CTXRES) + (size_t)row * 1024 : P.out + (size_t)(row - NCTX) * 1024;
  const float* mv = (const float*)(P.ws + OFF_MODV) + ((size_t)layer * 3 + mod_row(row)) * 6144;
  const float* sh = mv + (which ? 3 : 0) * 1024;
  const float* sc = mv + (which ? 4 : 1) * 1024;
  const float* nw = (which ? P.in[I_NORM2] : P.in[I_NORM1]) + layer * 1024;
  f32x4 v[4];
  float ss = 0.f;
#pragma unroll
  for (int i = 0; i < 4; ++i) {
    v[i] = *(const f32x4*)(src + i * 256 + lane * 4);
    ss += v[i].x * v[i].x + v[i].y * v[i].y + v[i].z * v[i].z + v[i].w * v[i].w;
  }
  ss = wave_sum(ss);
  const float rstd = frsq(ss * (1.f / 1024.f) + 1e-6f);
  bf16_t* dst = (bf16_t*)(P.ws + OFF_HBUF) + (size_t)row * 1024;
#pragma unroll
  for (int i = 0; i < 4; ++i) {
    int c = i * 256 + lane * 4;
    f32x4 w4 = *(const f32x4*)(nw + c), s4 = *(const f32x4*)(sc + c), h4 = *(const f32x4*)(sh + c);
    float o0 = v[i].x * rstd * w4.x * (1.f + s4.x) + h4.x;
    float o1 = v[i].y * rstd * w4.y * (1.f + s4.y) + h4.y;
    float o2 = v[i].z * rstd * w4.z * (1.f + s4.z) + h4.z;
    float o3 = v[i].w * rstd * w4.w * (1.f + s4.w) + h4.w;
    u32x2 pk; pk.x = pack2(o0, o1); pk.y = pack2(o2, o3);
    *(u32x2*)(dst + c) = pk;
  }
}

struct EpiProjL0 {
  bf16_t* proj; float* gates;
  DEVM void operator()(int row, int col, float v) const {
    proj[(size_t)row * EVC + col] = f2bf(v);
    if (col >= 1536 && col < 1552) gates[row * 32 + (col - 1536)] = v;
    else if (col >= 3088) gates[row * 32 + 16 + (col - 3088)] = v;
  }
};
struct EpiStoreBf {
  bf16_t* dst; int ld;
  DEVM void operator()(int row, int col, float v) const { dst[(size_t)row * ld + col] = f2bf(v); }
};
struct EpiStoreBfBias {
  bf16_t* dst; int ld; const float* bias;
  DEVM void operator()(int row, int col, float v) const { dst[(size_t)row * ld + col] = f2bf(v + (bias ? bias[col] : 0.f)); }
};
struct EpiProjL0T {
  bf16_t* proj; float* gates;
  DEVM void operator()(int, int, float) const {}
  DEVM void store4(int n, int m, float v0, float v1, float v2, float v3) const {
    u32x2 pk; pk.x = pack2(v0, v1); pk.y = pack2(v2, v3);
    *(u32x2*)(proj + (size_t)m * EVC + n) = pk;
    if (n >= 1536 && n < 1552) { f32x4 g = {v0, v1, v2, v3}; *(f32x4*)(gates + m * 32 + (n - 1536)) = g; }
    else if (n >= 3088) { f32x4 g = {v0, v1, v2, v3}; *(f32x4*)(gates + m * 32 + 16 + (n - 3088)) = g; }
  }
};
struct EpiStoreBfT {
  bf16_t* dst; int ld;
  DEVM void operator()(int, int, float) const {}
  DEVM void store4(int n, int m, float v0, float v1, float v2, float v3) const {
    u32x2 pk; pk.x = pack2(v0, v1); pk.y = pack2(v2, v3);
    *(u32x2*)(dst + (size_t)m * ld + n) = pk;
  }
};
struct EpiOutProjT {
  const float* x_lat; const float* x_ctx; float* o_lat; float* o_ctx; const float* modv;
  DEVM void operator()(int, int, float) const {}
  DEVM void store4(int n, int m, float v0, float v1, float v2, float v3) const {
    const f32x4 g = *(const f32x4*)(modv + mod_row(m) * 6144 + 2 * 1024 + n);
    const float* xs; float* od;
    if (m < NCTX) { xs = x_ctx + (size_t)m * 1024 + n; od = o_ctx + (size_t)m * 1024 + n; }
    else { size_t o = (size_t)(m - NCTX) * 1024 + n; xs = x_lat + o; od = o_lat + o; }
    const f32x4 x = *(const f32x4*)xs;
    f32x4 r = {x.x + g.x * v0, x.y + g.y * v1, x.z + g.z * v2, x.w + g.w * v3};
    *(f32x4*)od = r;
  }
};
struct EpiStoreBfBiasT {
  bf16_t* dst; int ld; const float* bias; int mode;
  DEVM void operator()(int, int, float) const {}
  DEVM void store4(int n, int m, float v0, float v1, float v2, float v3) const {
    if (bias) { v0 += bias[n]; v1 += bias[n + 1]; v2 += bias[n + 2]; v3 += bias[n + 3]; }
    if (mode) {
      const float sc = mode == 1 ? -0.6065306597126334f : 1.f;
      v0 = sc * sigmoidf_(v0); v1 = sc * sigmoidf_(v1); v2 = sc * sigmoidf_(v2); v3 = sc * sigmoidf_(v3);
    }
    u32x2 pk; pk.x = pack2(v0, v1); pk.y = pack2(v2, v3);
    *(u32x2*)(dst + (size_t)m * ld + n) = pk;
  }
};
struct EpiOutProj {
  const float* x_lat; const float* x_ctx; float* o_lat; float* o_ctx; const float* modv;
  DEVM void operator()(int row, int col, float v) const {
    float g = modv[mod_row(row) * 6144 + 2 * 1024 + col];
    if (row < NCTX) o_ctx[(size_t)row * 1024 + col] = x_ctx[(size_t)row * 1024 + col] + g * v;
    else { size_t o = (size_t)(row - NCTX) * 1024 + col; o_lat[o] = x_lat[o] + g * v; }
  }
};
struct EpiScoreLds {
  float* sS; int m0;
  DEVM void operator()(int row, int col, float v) const { sS[(row - m0) * 129 + col] = v; }
};

DEV void st_xbc_conv(const Params& P, int row) {
  const int lane = threadIdx.x & 63;
  const bf16_t* proj = (const bf16_t*)(P.ws + OFF_PROJ);
  bf16_t* xc = (bf16_t*)P.out + (size_t)row * 1024;
  int row0, len, pos;
  if (row < NCTX) { row0 = (row / CTXL) * CTXL; len = CTXL; pos = row - row0; }
  else { int r = row - NCTX; row0 = NCTX + (r / SEQ) * SEQ; len = SEQ; pos = r % SEQ; }
  const float* cw = P.in[I_SCONVW];
  const float* cb = P.in[I_SCONVB];
#pragma unroll
  for (int hh = 0; hh < 2; ++hh) {
    const int ch = hh * 512 + lane * 8;
    float o[8];
#pragma unroll
    for (int j = 0; j < 8; ++j) o[j] = cb[ch + j];
#pragma unroll
    for (int tap = 0; tap < 4; ++tap) {
      int pp = pos + tap - 2;
      if (pp >= 0 && pp < len) {
        float x[8];
        unpack8(*(const u32x4*)(proj + (size_t)(row0 + pp) * EVC + 2064 + ch), x);
        f32x4 w0 = *(const f32x4*)(cw + tap * 1024 + ch), w1 = *(const f32x4*)(cw + tap * 1024 + ch + 4);
        o[0] += w0.x * x[0]; o[1] += w0.y * x[1]; o[2] += w0.z * x[2]; o[3] += w0.w * x[3];
        o[4] += w1.x * x[4]; o[5] += w1.y * x[5]; o[6] += w1.z * x[6]; o[7] += w1.w * x[7];
      }
    }
#pragma unroll
    for (int j = 0; j < 8; ++j) o[j] = siluf_(o[j]);
    *(u32x4*)(xc + ch) = pack8(o);
  }
}

#ifndef LA_NSEG
#define LA_NSEG 10
#endif
constexpr int LA_NCH = (CTXL + SEQ) / 64;
constexpr int LA_CPS = LA_NCH / LA_NSEG;
static_assert(LA_NCH % LA_NSEG == 0, "linattn segments");
#ifdef CPU_EMU
constexpr size_t OFF_LASEG = OFF_PR + PR_BYTES;
#else
constexpr size_t OFF_LASEG = OFF_R2L0 + (size_t)NTOK * 1024 * 2;
#endif
constexpr size_t LASEG_U = (size_t)48 * LA_NSEG * 8192 * 4;
constexpr size_t OFF_LASEG_N = OFF_LASEG + LASEG_U;
constexpr size_t OFF_LASEG_D = OFF_LASEG_N + (size_t)48 * LA_NSEG * 64 * 4;
#ifndef CPU_EMU
static_assert(OFF_LASEG_D + 48 * LA_NSEG * 4 <= OFF_PR + PR_BYTES, "laseg");
#endif

DEV int swz64(int row) { return ((row >> 3) & 7) << 3; }
DEV int swz32(int row) { return ((row >> 3) & 3) << 3; }
struct LaRaw { u32x4 q[2], k[4], x[4]; float g0, g1; };

template <bool MLSTM, bool FULL>
DEV void la_load_raw(const Params& P, int b, int h, int d, int cc, LaRaw& R) {
  constexpr int NC_CTX = CTXL / 64;
  const int tid = threadIdx.x;
  const int seg = cc >= NC_CTX;
  const int row0 = seg ? NCTX + b * SEQ : b * CTXL;
  const int len = seg ? SEQ : CTXL;
  const int cl = (seg ? cc - NC_CTX : cc) * 64;
  const bf16_t* proj = (const bf16_t*)(P.ws + OFF_PROJ);
  const bf16_t* xcv = (const bf16_t*)P.out;
  const float* gates = (const float*)(P.ws + OFF_GATES);
  if (tid < 64) {
    int p = cl + tid, grow = row0 + (d ? len - 1 - p : p);
    if (MLSTM) { R.g0 = gates[grow * 32 + d * 4 + h]; R.g1 = gates[grow * 32 + 8 + d * 4 + h]; }
    else { R.g0 = gates[grow * 32 + 16 + d * 8 + h]; R.g1 = 0.f; }
  }
  if (MLSTM) {
#pragma unroll
    for (int i = 0; i < 2; ++i) {
      int c = tid + i * 256, r = c >> 3, cc8 = (c & 7) * 8;
      int p = cl + r, pos = d ? len - 1 - p : p;
      const bf16_t* rp = proj + (size_t)(row0 + pos) * EVC;
      if (FULL) R.q[i] = *(const u32x4*)(rp + h * 64 + cc8);
      R.k[i] = *(const u32x4*)(rp + 256 + h * 64 + cc8);
    }
#pragma unroll
    for (int i = 0; i < 4; ++i) {
      int c = tid + i * 256, r = c >> 4, cc8 = (c & 15) * 8;
      int p = cl + r, pos = d ? len - 1 - p : p;
      R.x[i] = *(const u32x4*)(proj + (size_t)(row0 + pos) * EVC + 512 + h * 128 + cc8);
    }
  } else {
    const int grp = h >> 2;
#pragma unroll
    for (int i = 0; i < 2; ++i) {
      int c = tid + i * 256, r = c >> 3, cc8 = (c & 7) * 8;
      int p = cl + r, pos = d ? len - 1 - p : p;
      R.x[i] = *(const u32x4*)(xcv + (size_t)(row0 + pos) * 1024 + h * 64 + cc8);
    }
#pragma unroll
    for (int i = 0; i < 4; ++i) {
      int c = tid + i * 256, r = c >> 4, cc8 = (c & 15) * 8;
      int p = cl + r, pos = d ? len - 1 - p : p;
      const bf16_t* rp = xcv + (size_t)(row0 + pos) * 1024;
      R.k[i] = *(const u32x4*)(rp + 512 + grp * 128 + cc8);
      if (FULL) { if (i < 2) R.q[i] = *(const u32x4*)(rp + 768 + grp * 128 + cc8); else R.x[i] = *(const u32x4*)(rp + 768 + grp * 128 + cc8); }
    }
  }
}

template <bool MLSTM, bool FULL>
DEV void st_linattn_seg(const Params& P, int sid, int seg, unsigned char* smem) {
  constexpr int DK = MLSTM ? 64 : 128, DX = MLSTM ? 128 : 64;
  constexpr int QS = DK + 8;
  constexpr int NH = MLSTM ? 4 : 8;
  constexpr int NC_CTX = CTXL / 64;
  const int tid = threadIdx.x, lane = tid & 63, wave = tid >> 6;
  const int d = sid & 1, h = (sid >> 1) % NH, b = (sid >> 1) / NH;
  const int gsid = MLSTM ? sid : 16 + sid;
  bf16_t* sQ = (bf16_t*)smem;
  bf16_t* sK = sQ + 64 * QS;
  bf16_t* sP = sK;
  bf16_t* sKT = sK + 64 * QS;
  bf16_t* sXT = sKT + DK * 72;
  bf16_t* sST = sXT + DX * 72;
  float* sF = (float*)(sST + DX * QS);
  float* sLa = sF;
  float* sG = sF + 64;
  float* sBc = sF + 128;
  float* sDen = sF + 192;
  float* sN = sF + 256;
  int* sRow = (int*)(sF + 384);
  static_assert((64 * QS * 2 + DK * 72 + DX * 72 + DX * QS) * 2 + 448 * 4 <= SMEM_BYTES, "lds");
  bf16_t* outb = MLSTM ? (bf16_t*)(P.ws + OFF_HBUF) : (bf16_t*)(P.ws + OFF_R2L0);
  float* segU = (float*)(P.ws + OFF_LASEG);
  float* segN = (float*)(P.ws + OFF_LASEG_N);
  float* segD = (float*)(P.ws + OFF_LASEG_D);

  f32x16 accS[2];
#pragma unroll
  for (int j = 0; j < 2; ++j)
#pragma unroll
    for (int r = 0; r < 16; ++r) accS[j][r] = 0.f;
  const int sx0 = MLSTM ? wave * 32 : (wave >> 1) * 32;
  const int sk0 = MLSTM ? 0 : (wave & 1) * 64;
  float nreg = 0.f;
  float gb0 = 0.f, gb1 = 0.f, alog_e = 0.f, dskip = 0.f;
  if (MLSTM) { gb0 = P.in[I_IBIAS][d * 4 + h]; gb1 = P.in[I_FBIAS][d * 4 + h]; }
  else { gb0 = P.in[I_DTBIAS][d * 8 + h]; alog_e = fexp(P.in[I_ALOG][d * 8 + h]); dskip = P.in[I_DSKIP][h]; }

  const int cc0 = seg * LA_CPS, cc1 = cc0 + LA_CPS;
  LaRaw R;
  la_load_raw<MLSTM, FULL>(P, b, h, d, cc0, R);
  __syncthreads();
  if (FULL) {
    for (int js = 0; js < seg; ++js) {
      const size_t it = (size_t)gsid * LA_NSEG + js;
      const float a = fexp(segD[it]);
      const float* U = segU + it * 8192;
#pragma unroll
      for (int j = 0; j < 2; ++j)
#pragma unroll
        for (int r = 0; r < 16; ++r) accS[j][r] = a * accS[j][r] + U[(j * 16 + r) * 256 + tid];
      if (MLSTM) nreg = a * nreg + segN[it * 64 + (tid >> 2)];
    }
#pragma unroll
    for (int j = 0; j < 2; ++j)
#pragma unroll
      for (int r = 0; r < 16; ++r) sST[(sx0 + acc_row(r, lane)) * QS + sk0 + j * 32 + (lane & 31)] = f2bf(accS[j][r]);
    if (MLSTM && (tid & 3) == 0) sN[tid >> 2] = nreg;
  }
  float lsum = 0.f;

  for (int cc = cc0; cc < cc1; ++cc) {
    int tl_ = threadIdx.x; OPAQUE(tl_);
    const int tid = tl_, lane = tl_ & 63;
    const int sgi = cc >= NC_CTX;
    const int row0 = sgi ? NCTX + b * SEQ : b * CTXL;
    const int len = sgi ? SEQ : CTXL;
    const int cl = (sgi ? cc - NC_CTX : cc) * 64;
    if (tid < 64) {
      int p = cl + tid;
      sRow[tid] = row0 + (d ? len - 1 - p : p);
      float la;
      if (MLSTM) { la = -softplusf_(-(R.g1 + gb1)); sG[tid] = fexp(R.g0 + gb0); }
      else { float dt = softplusf_(R.g0 + gb0); la = -dt * alog_e; sG[tid] = dt; }
      sBc[tid] = wave_incl_scan(la);
    }
    __syncthreads();
    const float blast = sBc[63];
    lsum += blast;
    if (MLSTM) {
#pragma unroll
      for (int i = 0; i < 2; ++i) {
        int c = tid + i * 256, r = c >> 3, cc8 = (c & 7) * 8;
        float kf[8]; unpack8(R.k[i], kf);
        const float wgt = fexp(blast - sBc[r]) * sG[r];
#pragma unroll
        for (int j = 0; j < 8; ++j) sKT[(cc8 + j) * 72 + (r ^ swz64(cc8))] = f2bf(kf[j] * wgt);
        if (FULL) {
          float qf[8]; unpack8(R.q[i], qf);
#pragma unroll
          for (int j = 0; j < 8; ++j) qf[j] *= 0.125f;
          *(u32x4*)(sQ + r * QS + cc8) = pack8(qf);
          *(u32x4*)(sK + r * QS + cc8) = R.k[i];
        }
      }
#pragma unroll
      for (int i = 0; i < 4; ++i) {
        int c = tid + i * 256, r = c >> 4, cc8 = (c & 15) * 8;
        const bf16_t* xs = (const bf16_t*)&R.x[i];
#pragma unroll
        for (int j = 0; j < 8; ++j) sXT[(cc8 + j) * 72 + (r ^ swz64(cc8))] = xs[j];
      }
    } else {
#pragma unroll
      for (int i = 0; i < 2; ++i) {
        int c = tid + i * 256, r = c >> 3, cc8 = (c & 7) * 8;
        const bf16_t* xs = (const bf16_t*)&R.x[i];
#pragma unroll
        for (int j = 0; j < 8; ++j) sXT[(cc8 + j) * 72 + (r ^ swz64(cc8))] = xs[j];
      }
#pragma unroll
      for (int i = 0; i < 4; ++i) {
        int c = tid + i * 256, r = c >> 4, cc8 = (c & 15) * 8;
        float kf[8]; unpack8(R.k[i], kf);
        const float wgt = fexp(blast - sBc[r]) * sG[r];
#pragma unroll
        for (int j = 0; j < 8; ++j) sKT[(cc8 + j) * 72 + (r ^ swz64(cc8))] = f2bf(kf[j] * wgt);
        if (FULL) {
          *(u32x4*)(sK + r * QS + cc8) = R.k[i];
          *(u32x4*)(sQ + r * QS + cc8) = i < 2 ? R.q[i] : R.x[i];
        }
      }
    }
    if (cc + 1 < cc1) la_load_raw<MLSTM, FULL>(P, b, h, d, cc + 1, R);
    __syncthreads();
    if (FULL) {
      const int tr = (wave >> 1) * 32, tc = (wave & 1) * 32;
      f32x16 accP;
#pragma unroll
      for (int r = 0; r < 16; ++r) accP[r] = 0.f;
      if (!(tr == 0 && tc == 32)) {
#pragma unroll
        for (int kk = 0; kk < DK / 16; ++kk) {
          const int ko = kk * 16 + 8 * (lane >> 5);
          bf16x8 a = *(const bf16x8*)(sQ + (tr + (lane & 31)) * QS + ko);
          bf16x8 bb = *(const bf16x8*)(sK + (tc + (lane & 31)) * QS + ko);
          accP = mfma32(a, bb, accP);
        }
      }
      __syncthreads();
      {
        const int s = tc + (lane & 31);
        const float bs = sBc[s], gs = sG[s];
#pragma unroll
        for (int r = 0; r < 16; ++r) {
          int t = tr + acc_row(r, lane);
          float v = (s <= t) ? accP[r] * fexp(sBc[t] - bs) * gs : 0.f;
          sP[t * 72 + s] = f2bf(v);
        }
        {
          const int t = tid >> 2, kq = (tid & 3) * (DK / 4);
          const float et = fexp(sBc[t]);
#pragma unroll
          for (int c8 = 0; c8 < DK / 4; c8 += 8) {
            float qf[8];
            unpack8(*(const u32x4*)(sQ + t * QS + kq + c8), qf);
#pragma unroll
            for (int j = 0; j < 8; ++j) qf[j] *= et;
            *(u32x4*)(sQ + t * QS + kq + c8) = pack8(qf);
          }
        }
      }
      __syncthreads();
      constexpr int NYT = MLSTM ? 2 : 1;
      const int yx0 = MLSTM ? wave * 32 : (wave >> 1) * 32;
      const int yt0 = MLSTM ? 0 : (wave & 1) * 32;
      f32x16 accY[NYT];
#pragma unroll
      for (int j = 0; j < NYT; ++j)
#pragma unroll
        for (int r = 0; r < 16; ++r) accY[j][r] = 0.f;
#pragma unroll
      for (int kk = 0; kk < 4; ++kk) {
        const int ko = kk * 16 + 8 * (lane >> 5);
        bf16x8 a = *(const bf16x8*)(sXT + (yx0 + (lane & 31)) * 72 + (ko ^ swz64(yx0 + (lane & 31))));
#pragma unroll
        for (int j = 0; j < NYT; ++j) {
          bf16x8 bb = *(const bf16x8*)(sP + (yt0 + j * 32 + (lane & 31)) * 72 + ko);
          accY[j] = mfma32(a, bb, accY[j]);
        }
      }
#pragma unroll
      for (int kk = 0; kk < DK / 16; ++kk) {
        const int ko = kk * 16 + 8 * (lane >> 5);
        bf16x8 a = *(const bf16x8*)(sST + (yx0 + (lane & 31)) * QS + ko);
#pragma unroll
        for (int j = 0; j < NYT; ++j) {
          bf16x8 bb = *(const bf16x8*)(sQ + (yt0 + j * 32 + (lane & 31)) * QS + ko);
          accY[j] = mfma32(a, bb, accY[j]);
        }
      }
      if (MLSTM) {
        const int t = tid >> 2, q4 = (tid & 3) * 16;
        float pf[16], qf[16];
        unpack8(*(const u32x4*)(sP + t * 72 + q4), pf); unpack8(*(const u32x4*)(sP + t * 72 + q4 + 8), pf + 8);
        unpack8(*(const u32x4*)(sQ + t * QS + q4), qf); unpack8(*(const u32x4*)(sQ + t * QS + q4 + 8), qf + 8);
        float den = 0.f;
#pragma unroll
        for (int j = 0; j < 16; ++j) den += pf[j] + sN[q4 + j] * qf[j];
        den = sum4(den);
        if ((tid & 3) == 0) sDen[t] = den;
        __syncthreads();
      }
#pragma unroll
      for (int j = 0; j < NYT; ++j) {
        const int t = yt0 + j * 32 + (lane & 31);
        const size_t obase = (size_t)sRow[t] * 1024 + d * 512 + h * DX;
        const float dinv = MLSTM ? frcp(fmaxf(fabsf(sDen[t]), 1.f)) : 1.f;
#pragma unroll
        for (int g = 0; g < 4; ++g) {
          const int x0 = yx0 + 8 * g + 4 * (lane >> 5);
          float v0 = accY[j][4 * g], v1 = accY[j][4 * g + 1], v2 = accY[j][4 * g + 2], v3 = accY[j][4 * g + 3];
          if (MLSTM) { v0 *= dinv; v1 *= dinv; v2 *= dinv; v3 *= dinv; }
          else if (d == 0) {
            const int ts = t ^ swz64(x0);
            v0 += dskip * bf2f(sXT[(x0 + 0) * 72 + ts]); v1 += dskip * bf2f(sXT[(x0 + 1) * 72 + ts]);
            v2 += dskip * bf2f(sXT[(x0 + 2) * 72 + ts]); v3 += dskip * bf2f(sXT[(x0 + 3) * 72 + ts]);
          }
          u32x2 pk; pk.x = pack2(v0, v1); pk.y = pack2(v2, v3);
          *(u32x2*)(outb + obase + x0) = pk;
        }
      }
      __syncthreads();
    }
    {
      const float eb = fexp(blast);
#pragma unroll
      for (int j = 0; j < 2; ++j)
#pragma unroll
        for (int r = 0; r < 16; ++r) accS[j][r] *= eb;
#pragma unroll
      for (int kk = 0; kk < 4; ++kk) {
        const int ko = kk * 16 + 8 * (lane >> 5);
        bf16x8 a = *(const bf16x8*)(sXT + (sx0 + (lane & 31)) * 72 + (ko ^ swz64(sx0 + (lane & 31))));
#pragma unroll
        for (int j = 0; j < 2; ++j) {
          bf16x8 bb = *(const bf16x8*)(sKT + (sk0 + j * 32 + (lane & 31)) * 72 + (ko ^ swz64(sk0 + j * 32 + (lane & 31))));
          accS[j] = mfma32(a, bb, accS[j]);
        }
      }
      if (FULL) {
#pragma unroll
        for (int j = 0; j < 2; ++j)
#pragma unroll
          for (int r = 0; r < 16; ++r) sST[(sx0 + acc_row(r, lane)) * QS + sk0 + j * 32 + (lane & 31)] = f2bf(accS[j][r]);
      }
      if (MLSTM) {
        const int k = tid >> 2, q4 = (tid & 3) * 16;
        float kf[16];
        unpack8(*(const u32x4*)(sKT + k * 72 + q4), kf); unpack8(*(const u32x4*)(sKT + k * 72 + q4 + 8), kf + 8);
        float ps = 0.f;
#pragma unroll
        for (int j = 0; j < 16; ++j) ps += kf[j];
        nreg = nreg * eb + sum4(ps);
        if (FULL && (tid & 3) == 0) sN[k] = nreg;
      }
    }
    __syncthreads();
  }
  if (!FULL) {
    const size_t it = (size_t)gsid * LA_NSEG + seg;
    float* U = segU + it * 8192;
#pragma unroll
    for (int j = 0; j < 2; ++j)
#pragma unroll
      for (int r = 0; r < 16; ++r) U[(j * 16 + r) * 256 + tid] = accS[j][r];
    if (MLSTM && (tid & 3) == 0) segN[it * 64 + (tid >> 2)] = nreg;
    if (tid == 0) segD[it] = lsum;
  }
}

DEV void st_finish_l0(const Params& P, int row) {
  const int lane = threadIdx.x & 63;
  bf16_t* hb = (bf16_t*)(P.ws + OFF_HBUF) + (size_t)row * 1024;
  const bf16_t* yb = (const bf16_t*)(P.ws + OFF_R2L0) + (size_t)row * 1024;
  const bf16_t* pr = (const bf16_t*)(P.ws + OFF_PROJ) + (size_t)row * EVC;
  const int ch = lane * 8;
  float h0[8], h1[8], o[8], f1[8];
  unpack8(*(const u32x4*)(hb + ch), h0);
  unpack8(*(const u32x4*)(hb + 512 + ch), h1);
  unpack8(*(const u32x4*)(pr + 1024 + ch), o);
  float ss = 0.f;
#pragma unroll
  for (int j = 0; j < 8; ++j) { h0[j] += h1[j]; ss += h0[j] * h0[j]; }
  ss = sum16(ss);
  float rstd = frsq(ss * (1.f / 128.f) + 1e-6f);
  float pw[8]; ld8(P.in[I_MNORM] + ch, pw);
#pragma unroll
  for (int j = 0; j < 8; ++j) f1[j] = h0[j] * rstd * pw[j] * sigmoidf_(o[j]);
  float y0[8], y1[8], z[8], f2[8];
  unpack8(*(const u32x4*)(yb + ch), y0);
  unpack8(*(const u32x4*)(yb + 512 + ch), y1);
  unpack8(*(const u32x4*)(pr + 1552 + ch), z);
  float s2 = 0.f;
#pragma unroll
  for (int j = 0; j < 8; ++j) { y0[j] = (y0[j] + y1[j]) * siluf_(z[j]); s2 += y0[j] * y0[j]; }
  s2 = wave_sum(s2);
  float rstd2 = frsq(s2 * (1.f / 512.f) + 1e-6f);
  ld8(P.in[I_SNORM] + ch, pw);
#pragma unroll
  for (int j = 0; j < 8; ++j) f2[j] = y0[j] * rstd2 * pw[j];
  *(u32x4*)(hb + ch) = pack8(f1);
  *(u32x4*)(hb + 512 + ch) = pack8(f2);
}

DEV float mixval(const bf16_t* __restrict__ proj, int row, int c, const float* __restrict__ mu) {
  float self = bf2f(proj[(size_t)row * ODC + c]);
  int nrow = -1;
  if (row < NCTX) {
    int pos = row % CTXL;
    if (c < 896) { if (pos > 0) nrow = row - 1; }
    else { if (pos < CTXL - 1) nrow = row + 1; }
  } else {
    int pos = (row - NCTX) % SEQ;
    int gx = pos % GW, gy = pos / GW, q = c / 448;
    if (q == 0) { if (gx > 0) nrow = row - 1; }
    else if (q == 1) { if (gx < GW - 1) nrow = row + 1; }
    else if (q == 2) { if (gy > 0) nrow = row - GW; }
    else { if (gy < SEQ / GW - 1) nrow = row + GW; }
  }
  float nb = nrow >= 0 ? bf2f(proj[(size_t)nrow * ODC + c]) : 0.f;
  return self + mu[c] * (nb - self);
}

DEV int nbr_row(int row, int c) {
  if (row < NCTX) {
    int pos = row % CTXL;
    if (c < 896) return pos > 0 ? row - 1 : -1;
    return pos < CTXL - 1 ? row + 1 : -1;
  }
  int pos = (row - NCTX) % SEQ;
  int gx = pos % GW, gy = pos / GW, q = c / 448;
  if (q == 0) return gx > 0 ? row - 1 : -1;
  if (q == 1) return gx < GW - 1 ? row + 1 : -1;
  if (q == 2) return gy > 0 ? row - GW : -1;
  return gy < SEQ / GW - 1 ? row + GW : -1;
}

DEV void mix8(const bf16_t* __restrict__ proj, int row, int c, const float* __restrict__ mu, float* o) {
  float xs[8], xn[8];
  unpack8(*(const u32x4*)(proj + (size_t)row * ODC + c), xs);
  const int nr = nbr_row(row, c);
  if (nr >= 0) unpack8(*(const u32x4*)(proj + (size_t)nr * ODC + c), xn);
  else {
#pragma unroll
    for (int j = 0; j < 8; ++j) xn[j] = 0.f;
  }
  const f32x4 m0 = *(const f32x4*)(mu + c), m1 = *(const f32x4*)(mu + c + 4);
  const float mm[8] = {m0.x, m0.y, m0.z, m0.w, m1.x, m1.y, m1.z, m1.w};
#pragma unroll
  for (int j = 0; j < 8; ++j) o[j] = xs[j] + mm[j] * (xn[j] - xs[j]);
}

DEV void st_lora_act(const Params& P, int row2) {
  const int lane = threadIdx.x & 63;
  const int row = row2 + (lane >> 5), c = (lane & 31) * 8;
  const bf16_t* proj = (const bf16_t*)(P.ws + OFF_PROJ);
  bf16_t* hb = (bf16_t*)(P.ws + OFF_HBUF) + (size_t)row * 1024;
  float v[8];
  mix8(proj, row, 1536 + c, P.in[I_MU], v);
#pragma unroll
  for (int j = 0; j < 8; ++j) v[j] = c < 64 ? tanhf_(v[j]) : (c < 128 ? v[j] : sigmoidf_(v[j]));
  *(u32x4*)(hb + c) = pack8(v);
}

DEV void st_rwkv_stream(const Params& P, int sid, unsigned char* smem) {
  const int tid = threadIdx.x, lane = tid & 63, wave = tid >> 6;
  const int d = sid & 1, h = (sid >> 1) & 7, b = sid >> 4;
  float* sR = (float*)smem;
  float* sW = sR + 2048;
  float* sKk = sW + 2048;
  float* sV = sKk + 2048;
  float* sA = sV + 2048;
  float* sBb = sA + 2048;
  float* sY = sBb + 2048;
  int* sRow = (int*)(sY + 2048);
  const bf16_t* proj = (const bf16_t*)(P.ws + OFF_PROJ);
  const bf16_t* lora = (const bf16_t*)(P.ws + OFF_LORA);
  bf16_t* yout = (bf16_t*)(P.ws + OFF_HBUF);
  const float* mu = P.in[I_MU];
  const int vrow = tid >> 2, j4 = tid & 3;
  float S[16];
#pragma unroll
  for (int i = 0; i < 16; ++i) S[i] = 0.f;
  const float kkw = P.in[I_KK][h * 64 + lane], kaw = P.in[I_KA][h * 64 + lane];
  for (int seg = 0; seg < 2; ++seg) {
    const int row0 = seg == 0 ? b * CTXL : NCTX + b * SEQ;
    const int len = seg == 0 ? CTXL : SEQ;
    for (int it = 0; it < len / 32; ++it) {
      __syncthreads();
      for (int s = wave; s < 32; s += 4) {
        int p = it * 32 + s, pos = d ? len - 1 - p : p, row = row0 + pos;
        int c = h * 64 + lane;
        float r = mixval(proj, row, c, mu);
        float k = mixval(proj, row, 512 + c, mu);
        float v = mixval(proj, row, 1024 + c, mu);
        float kk = k * kkw;
        float ss = wave_sum(kk * kk);
        kk *= frsq(ss + 1e-12f);
        float lw = bf2f(lora[((size_t)d * NTOK + row) * 512 + c]);
        float la = bf2f(lora[((size_t)(2 + d) * NTOK + row) * 512 + c]);
        float w = fexp(-0.6065306597126334f * sigmoidf_(lw));
        float a = sigmoidf_(la);
        float kt = k * (1.f + (a - 1.f) * kaw);
        sR[s * 64 + lane] = r; sW[s * 64 + lane] = w; sKk[s * 64 + lane] = kt; sV[s * 64 + lane] = v;
        sA[s * 64 + lane] = -kk; sBb[s * 64 + lane] = kk * a;
        if (lane == 0) sRow[s] = row;
      }
      __syncthreads();
      for (int s = 0; s < 32; ++s) {
        const float* pa = sA + s * 64 + j4 * 16;
        const float* pw = sW + s * 64 + j4 * 16;
        const float* pk = sKk + s * 64 + j4 * 16;
        const float* pb = sBb + s * 64 + j4 * 16;
        const float* pr = sR + s * 64 + j4 * 16;
        const float vv = sV[s * 64 + vrow];
        float sa = 0.f;
#pragma unroll
        for (int i = 0; i < 16; ++i) sa += S[i] * pa[i];
        sa = sum4(sa);
        float y = 0.f;
#pragma unroll
        for (int i = 0; i < 16; ++i) { S[i] = S[i] * pw[i] + sa * pb[i] + vv * pk[i]; y += S[i] * pr[i]; }
        y = sum4(y);
        if (j4 == 0) sY[s * 64 + vrow] = y;
      }
      __syncthreads();
      for (int i = tid; i < 2048; i += 256) {
        int s = i >> 6, c = i & 63;
        yout[(size_t)sRow[s] * 1024 + d * 512 + h * 64 + c] = f2bf(sY[i]);
      }
    }
  }
}


struct RwkvRaw { u32x4 rs, rn, ks, kn, vs, vn, lw, la; int row; };

DEV void rwkv_load_raw(const bf16_t* __restrict__ proj, const bf16_t* __restrict__ lora, int b, int h, int d, int cc, int t, int c0,
                       RwkvRaw& R) {
  constexpr int NC_CTX = CTXL / 32;
  const int seg = cc >= NC_CTX;
  const int row0 = seg ? NCTX + b * SEQ : b * CTXL;
  const int len = seg ? SEQ : CTXL;
  const int p = (seg ? cc - NC_CTX : cc) * 32 + t;
  const int row = row0 + (d ? len - 1 - p : p);
  const int col = h * 64 + c0;
  const u32x4 z4 = {0u, 0u, 0u, 0u};
  const bf16_t* rp = proj + (size_t)row * ODC;
  R.row = row;
  R.rs = *(const u32x4*)(rp + col);
  R.ks = *(const u32x4*)(rp + 512 + col);
  R.vs = *(const u32x4*)(rp + 1024 + col);
  int n0 = nbr_row(row, col), n1 = nbr_row(row, 512 + col), n2 = nbr_row(row, 1024 + col);
  R.rn = n0 >= 0 ? *(const u32x4*)(proj + (size_t)n0 * ODC + col) : z4;
  R.kn = n1 >= 0 ? *(const u32x4*)(proj + (size_t)n1 * ODC + 512 + col) : z4;
  R.vn = n2 >= 0 ? *(const u32x4*)(proj + (size_t)n2 * ODC + 1024 + col) : z4;
  R.lw = *(const u32x4*)(lora + ((size_t)d * NTOK + row) * 512 + col);
  R.la = *(const u32x4*)(lora + ((size_t)(2 + d) * NTOK + row) * 512 + col);
}

#ifndef RW_NSEG
#define RW_NSEG 16
#endif
constexpr int RW_NCH = (CTXL + SEQ) / 32;
constexpr size_t OFF_RWSEG = OFF_PU;
static_assert((size_t)32 * RW_NSEG * 64 * 128 * 4 <= (size_t)2 * NEXP * 1024, "rwseg");

template <bool FULL>
DEV void st_rwkv_seg(const Params& P, int sid, int seg, unsigned char* smem) {
  constexpr int NVB = FULL ? 2 : 4;
  constexpr int ZR = FULL ? 64 : 128;
  const int tid = threadIdx.x, lane = tid & 63, wave = tid >> 6;
  const int d = sid & 1, h = (sid >> 1) & 7, b = sid >> 4;
  bf16_t* sAt = (bf16_t*)smem;
  bf16_t* sRt = sAt + 32 * 72;
  bf16_t* sBt = sRt + 32 * 72;
  bf16_t* sKt = sBt + 32 * 72;
  bf16_t* sBT = sKt + 32 * 72;
  bf16_t* sKT = sBT + 64 * 40;
  bf16_t* sVT = sKT + 64 * 40;
  bf16_t* sLak = sVT + 64 * 40;
  bf16_t* sM = sLak + 32 * 40;
  bf16_t* sLrb = sM + 32 * 40;
  bf16_t* sLrk = sLrb + 32 * 40;
  bf16_t* sZ = FULL ? sLrk + 32 * 40 : sLrb;
  bf16_t* after = sZ + ZR * 72;
  bf16_t* sRT = after;
  bf16_t* sSAT = FULL ? after + 64 * 40 : sRt;
  float* sLP = (float*)(FULL ? after + 2 * 64 * 40 : after + 128 * 40);
  float* sLab = sLP + 4 * 64;
  float* sD = sLab + 32 * 36;
  float* sPT = sD + 768;
  int* sRow = (int*)(sPT + 64);
  static_assert((4 * 32 * 72 + 3 * 64 * 40 + 4 * 32 * 40 + 2 * 64 * 40 + 64 * 72) * 2 + (4 * 64 + 32 * 36 + 768 + 64 + 32 + 320) * 4 + 16 <= SMEM_BYTES, "lds full");
  static_assert((4 * 32 * 72 + 3 * 64 * 40 + 2 * 32 * 40 + 128 * 72 + 128 * 40) * 2 + (4 * 64 + 32 * 36 + 768 + 64 + 32 + 320) * 4 + 16 <= SMEM_BYTES, "lds p1");
  static_assert(128 * 40 <= 3 * 32 * 72, "alias");
  const bf16_t* proj = (const bf16_t*)(P.ws + OFF_PROJ);
  const bf16_t* lora = (const bf16_t*)(P.ws + OFF_LORA);
  bf16_t* yout = (bf16_t*)(P.ws + OFF_HBUF);
  float* segZ = (float*)(P.ws + OFF_RWSEG);
  const int t = tid >> 3, c0 = (tid & 7) * 8;
  const int hl = lane >> 5, l31 = lane & 31;
  float* sCst = (float*)(smem + SMEM_BYTES - 320 * 4 - 16);
  if (tid < 64) {
    sCst[tid] = P.in[I_MU][h * 64 + tid]; sCst[64 + tid] = P.in[I_MU][512 + h * 64 + tid]; sCst[128 + tid] = P.in[I_MU][1024 + h * 64 + tid];
    sCst[192 + tid] = P.in[I_KK][h * 64 + tid]; sCst[256 + tid] = P.in[I_KA][h * 64 + tid];
  }
  const int cc0 = (seg * RW_NCH) / RW_NSEG, cc1 = ((seg + 1) * RW_NCH) / RW_NSEG;
  RwkvRaw R;
  rwkv_load_raw(proj, lora, b, h, d, cc0, t, c0, R);
  f32x16 Zm[2];
#pragma unroll
  for (int j = 0; j < 2; ++j)
#pragma unroll
    for (int r = 0; r < 16; ++r) Zm[j][r] = 0.f;
  __syncthreads();
  for (int i = tid; i < ZR * 72; i += 256) sZ[i] = 0;
  __syncthreads();
  if (!FULL) {
    if (wave >= 2) {
#pragma unroll
      for (int cb = 0; cb < 2; ++cb)
#pragma unroll
        for (int r = 0; r < 16; ++r) {
          int c = cb * 32 + acc_row(r, lane), vp = wave * 32 + l31;
          if (c == vp - 64) { Zm[cb][r] = 1.f; sZ[vp * 72 + c] = 0x3f80; }
        }
    }
  } else {
    for (int js = 0; js < seg; ++js) {
      const float* Zs = segZ + ((size_t)sid * RW_NSEG + js) * 64 * 128;
      bf16_t* sG = sAt;
      {
        const int c = tid >> 2, c2 = (tid & 3) * 16;
        float gv[16];
        ld8(Zs + c * 128 + 64 + c2, gv); ld8(Zs + c * 128 + 64 + c2 + 8, gv + 8);
        *(u32x4*)(sG + c * 72 + c2) = pack8(gv);
        *(u32x4*)(sG + c * 72 + c2 + 8) = pack8(gv + 8);
      }
      __syncthreads();
      if (wave >= 2) {
        const int cb = wave - 2;
#pragma unroll
        for (int vb = 0; vb < 2; ++vb) {
          f32x16 acc;
#pragma unroll
          for (int r = 0; r < 16; ++r) acc[r] = Zs[(cb * 32 + acc_row(r, lane)) * 128 + vb * 32 + l31];
#pragma unroll
          for (int kk = 0; kk < 4; ++kk) {
            bf16x8 a = *(const bf16x8*)(sG + (cb * 32 + l31) * 72 + kk * 16 + 8 * hl);
            bf16x8 bb = *(const bf16x8*)(sZ + (vb * 32 + l31) * 72 + kk * 16 + 8 * hl);
            acc = mfma32(a, bb, acc);
          }
          Zm[vb] = acc;
        }
      }
      __syncthreads();
      if (wave >= 2) {
        const int cb = wave - 2;
#pragma unroll
        for (int vb = 0; vb < 2; ++vb)
#pragma unroll
          for (int g = 0; g < 4; ++g) {
            u32x2 pk; pk.x = pack2(Zm[vb][4 * g], Zm[vb][4 * g + 1]); pk.y = pack2(Zm[vb][4 * g + 2], Zm[vb][4 * g + 3]);
            *(u32x2*)(sZ + (vb * 32 + l31) * 72 + cb * 32 + 8 * g + 4 * hl) = pk;
          }
      }
      __syncthreads();
    }
  }
  for (int cc = cc0; cc < cc1; ++cc) {
    int tl_ = threadIdx.x; OPAQUE(tl_);
    const int tid = tl_, lane = tl_ & 63, hl = lane >> 5, l31 = lane & 31, t = tl_ >> 3, c0 = (tl_ & 7) * 8;
    const float* muR = sCst + c0; const float* muK = sCst + 64 + c0; const float* muV = sCst + 128 + c0;
    const float* kkw = sCst + 192 + c0; const float* kaw = sCst + 256 + c0;
    float lw8[8], lp8[8];
    {
      float lwf[8];
      unpack8(R.lw, lwf);
#pragma unroll
      for (int j = 0; j < 8; ++j) { lw8[j] = lwf[j]; lp8[j] = lw8[j]; }
#pragma unroll
      for (int off = 8; off < 64; off <<= 1) {
#pragma unroll
        for (int j = 0; j < 8; ++j) {
#ifdef CPU_EMU
          float o = emu_shfl_up(lp8[j], off);
#else
          float o = __shfl_up(lp8[j], off, 64);
#endif
          if (lane >= off) lp8[j] += o;
        }
      }
      if (lane >= 56) {
#pragma unroll
        for (int j = 0; j < 8; ++j) sLP[wave * 64 + c0 + j] = lp8[j];
      }
      if ((tid & 7) == 0) sRow[t] = R.row;
    }
    __syncthreads();
    {
#pragma unroll
      for (int j = 0; j < 8; ++j) {
        float offs = 0.f;
        for (int w2 = 0; w2 < wave; ++w2) offs += sLP[w2 * 64 + c0 + j];
        lp8[j] += offs;
      }
      if (t == 31) {
#pragma unroll
        for (int j = 0; j < 8; ++j) sPT[c0 + j] = fexp(lp8[j]);
      }
    }
    {
      float xs[8], xn[8], kt[8], aa[8], ob[8], ok[8];
      unpack8(R.ks, xs); unpack8(R.kn, xn);
      float ss = 0.f;
#pragma unroll
      for (int j = 0; j < 8; ++j) { kt[j] = xs[j] + muK[j] * (xn[j] - xs[j]); aa[j] = kt[j] * kkw[j]; ss += aa[j] * aa[j]; }
      ss = sum8(ss);
      const float rn = frsq(ss + 1e-12f);
      float laf[8];
      unpack8(R.la, laf);
#pragma unroll
      for (int j = 0; j < 8; ++j) {
        const float lp = lp8[j];
        const float lpm = lp8[j] - lw8[j];
        const float e = fexp(-lp);
        const float kkn = aa[j] * rn;
        const float asg = laf[j];
        aa[j] = -kkn * fexp(lpm);
        ob[j] = kkn * asg * e;
        ok[j] = kt[j] * (1.f + (asg - 1.f) * kaw[j]) * e;
      }
      *(u32x4*)(sAt + t * 72 + c0) = pack8(aa);
      *(u32x4*)(sBt + t * 72 + c0) = pack8(ob);
      *(u32x4*)(sKt + t * 72 + c0) = pack8(ok);
#pragma unroll
      for (int j = 0; j < 8; ++j) { sBT[(c0 + j) * 40 + (t ^ swz32(c0))] = f2bf(ob[j]); sKT[(c0 + j) * 40 + (t ^ swz32(c0))] = f2bf(ok[j]); }
      unpack8(R.vs, xs); unpack8(R.vn, xn);
#pragma unroll
      for (int j = 0; j < 8; ++j) sVT[(c0 + j) * 40 + (t ^ swz32(c0))] = f2bf(xs[j] + muV[j] * (xn[j] - xs[j]));
      if (FULL) {
        unpack8(R.rs, xs); unpack8(R.rn, xn);
#pragma unroll
        for (int j = 0; j < 8; ++j) xs[j] = (xs[j] + muR[j] * (xn[j] - xs[j])) * fexp(lp8[j]);
        *(u32x4*)(sRt + t * 72 + c0) = pack8(xs);
      }
    }
    if (cc + 1 < cc1) rwkv_load_raw(proj, lora, b, h, d, cc + 1, t, c0, R);
    __syncthreads();
    if (FULL || wave < 2) {
      const bf16_t* Asrc = wave < 2 ? sAt : sRt;
      const bf16_t* Bsrc = (wave & 1) ? sKt : sBt;
      f32x16 acc;
#pragma unroll
      for (int r = 0; r < 16; ++r) acc[r] = 0.f;
#pragma unroll
      for (int kk = 0; kk < 4; ++kk) {
        bf16x8 a = *(const bf16x8*)(Asrc + l31 * 72 + kk * 16 + 8 * hl);
        bf16x8 bb = *(const bf16x8*)(Bsrc + l31 * 72 + kk * 16 + 8 * hl);
        acc = mfma32(a, bb, acc);
      }
      bf16_t* dst = wave == 1 ? sLak : (wave == 2 ? sLrb : sLrk);
#pragma unroll
      for (int r = 0; r < 16; ++r) {
        int tt = acc_row(r, lane), j = l31;
        bool keep = wave < 2 ? (j < tt) : (j <= tt);
        float v = keep ? acc[r] : 0.f;
        if (wave == 0) sLab[tt * 36 + j] = v;
        else dst[tt * 40 + j] = f2bf(v);
      }
    }
    __syncthreads();
    auto rhs_block = [&](int vb) {
      f32x16 acc;
#pragma unroll
      for (int r = 0; r < 16; ++r) acc[r] = 0.f;
#pragma unroll
      for (int kk = 0; kk < 4; ++kk) {
        bf16x8 a = *(const bf16x8*)(sAt + l31 * 72 + kk * 16 + 8 * hl);
        bf16x8 bb = *(const bf16x8*)(sZ + (vb * 32 + l31) * 72 + kk * 16 + 8 * hl);
        acc = mfma32(a, bb, acc);
      }
      if (vb < 2) {
#pragma unroll
        for (int kk = 0; kk < 2; ++kk) {
          bf16x8 a = *(const bf16x8*)(sLak + l31 * 40 + kk * 16 + 8 * hl);
          bf16x8 bb = *(const bf16x8*)(sVT + (vb * 32 + l31) * 40 + ((kk * 16 + 8 * hl) ^ swz32(l31)));
          acc = mfma32(a, bb, acc);
        }
      }
#pragma unroll
      for (int g = 0; g < 4; ++g) {
        u32x2 pk; pk.x = pack2(acc[4 * g], acc[4 * g + 1]); pk.y = pack2(acc[4 * g + 2], acc[4 * g + 3]);
        *(u32x2*)(sRT + (vb * 32 + l31) * 40 + 8 * g + 4 * hl) = pk;
      }
    };
    if (wave == 0) {
      if (tid < 32) {
        const int q = tid >> 4, c = tid & 15;
        const float* Lq = sLab + (q * 16) * 36 + q * 16;
        float x[16];
        x[0] = (c == 0) ? 1.f : 0.f;
#define INV_GROUP_(I0, I1)                                                                           \
        {                                                                                            \
          f32x4 Lr[12];                                                                              \
          { int n = 0;                                                                               \
            _Pragma("unroll") for (int i = I0; i <= I1; ++i)                                         \
              _Pragma("unroll") for (int j4 = 0; j4 < i; j4 += 4) Lr[n++] = *(const f32x4*)(Lq + i * 36 + j4); }  \
          SCHED_FENCE_();                                                                            \
          { int n = 0;                                                                               \
            _Pragma("unroll") for (int i = I0; i <= I1; ++i) {                                       \
              float s0 = (i == c) ? 1.f : 0.f, s1 = 0.f;                                             \
              _Pragma("unroll") for (int j4 = 0; j4 < i; j4 += 4) {                                  \
                const f32x4 l4 = Lr[n++];                                                            \
                s0 += l4.x * x[j4];                                                                  \
                if (j4 + 1 < i) s1 += l4.y * x[j4 + 1];                                              \
                if (j4 + 2 < i) s0 += l4.z * x[j4 + 2];                                              \
                if (j4 + 3 < i) s1 += l4.w * x[j4 + 3];                                              \
              }                                                                                      \
              x[i] = s0 + s1;                                                                        \
            } }                                                                                      \
          SCHED_FENCE_();                                                                            \
        }
#ifdef CPU_EMU
#define SCHED_FENCE_() ((void)0)
#else
#define SCHED_FENCE_() __builtin_amdgcn_sched_barrier(0)
#endif
        INV_GROUP_(1, 8)
        INV_GROUP_(9, 12)
        INV_GROUP_(13, 15)
#undef INV_GROUP_
#undef SCHED_FENCE_
#pragma unroll
        for (int i = 0; i < 16; ++i) sD[q * 256 + i * 16 + c] = x[i];
      }
    } else if (FULL) {
      if (wave >= 2) rhs_block(wave - 2);
    } else {
      if (wave == 1) { rhs_block(0); rhs_block(1); }
      else rhs_block(wave);
    }
    __syncthreads();
    {
      const int i = tid >> 4, c = tid & 15;
      float sacc = 0.f;
#pragma unroll
      for (int j4 = 0; j4 < 16; j4 += 4) {
        const f32x4 l4 = *(const f32x4*)(sLab + (16 + i) * 36 + j4);
        sacc += l4.x * sD[j4 * 16 + c] + l4.y * sD[(j4 + 1) * 16 + c] + l4.z * sD[(j4 + 2) * 16 + c] + l4.w * sD[(j4 + 3) * 16 + c];
      }
      sD[512 + i * 16 + c] = sacc;
    }
    __syncthreads();
    {
      const int i = tid >> 4, c = tid & 15;
      float sacc = 0.f;
#pragma unroll
      for (int j4 = 0; j4 < 16; j4 += 4) {
        const f32x4 d4 = *(const f32x4*)(sD + 256 + i * 16 + j4);
        sacc += d4.x * sD[512 + j4 * 16 + c] + d4.y * sD[512 + (j4 + 1) * 16 + c] + d4.z * sD[512 + (j4 + 2) * 16 + c] + d4.w * sD[512 + (j4 + 3) * 16 + c];
      }
      sM[(16 + i) * 40 + c] = f2bf(sacc);
      sM[i * 40 + c] = f2bf(sD[i * 16 + c]);
      sM[(16 + i) * 40 + 16 + c] = f2bf(sD[256 + i * 16 + c]);
      sM[i * 40 + 16 + c] = 0;
    }
    __syncthreads();
    if (wave < NVB) {
      const int vb = wave;
      f32x16 acc;
#pragma unroll
      for (int r = 0; r < 16; ++r) acc[r] = 0.f;
#pragma unroll
      for (int kk = 0; kk < 2; ++kk) {
        bf16x8 a = *(const bf16x8*)(sM + l31 * 40 + kk * 16 + 8 * hl);
        bf16x8 bb = *(const bf16x8*)(sRT + (vb * 32 + l31) * 40 + kk * 16 + 8 * hl);
        acc = mfma32(a, bb, acc);
      }
#pragma unroll
      for (int g = 0; g < 4; ++g) {
        u32x2 pk; pk.x = pack2(acc[4 * g], acc[4 * g + 1]); pk.y = pack2(acc[4 * g + 2], acc[4 * g + 3]);
        *(u32x2*)(sSAT + (vb * 32 + l31) * 40 + 8 * g + 4 * hl) = pk;
      }
    }
    __syncthreads();
    if (FULL) {
      if (wave < 2) {
        const int vb = wave;
        f32x16 acc;
#pragma unroll
        for (int r = 0; r < 16; ++r) acc[r] = 0.f;
#pragma unroll
        for (int kk = 0; kk < 4; ++kk) {
          bf16x8 a = *(const bf16x8*)(sZ + (vb * 32 + l31) * 72 + kk * 16 + 8 * hl);
          bf16x8 bb = *(const bf16x8*)(sRt + l31 * 72 + kk * 16 + 8 * hl);
          acc = mfma32(a, bb, acc);
        }
#pragma unroll
        for (int kk = 0; kk < 2; ++kk) {
          bf16x8 a = *(const bf16x8*)(sSAT + (vb * 32 + l31) * 40 + kk * 16 + 8 * hl);
          bf16x8 bb = *(const bf16x8*)(sLrb + l31 * 40 + kk * 16 + 8 * hl);
          acc = mfma32(a, bb, acc);
        }
#pragma unroll
        for (int kk = 0; kk < 2; ++kk) {
          bf16x8 a = *(const bf16x8*)(sVT + (vb * 32 + l31) * 40 + ((kk * 16 + 8 * hl) ^ swz32(l31)));
          bf16x8 bb = *(const bf16x8*)(sLrk + l31 * 40 + kk * 16 + 8 * hl);
          acc = mfma32(a, bb, acc);
        }
        {
          const size_t obase = (size_t)sRow[l31] * 1024 + d * 512 + h * 64 + vb * 32;
#pragma unroll
          for (int g = 0; g < 4; ++g) {
            u32x2 pk; pk.x = pack2(acc[4 * g], acc[4 * g + 1]); pk.y = pack2(acc[4 * g + 2], acc[4 * g + 3]);
            *(u32x2*)(yout + obase + 8 * g + 4 * hl) = pk;
          }
        }
      } else {
        const int cb = wave - 2;
#pragma unroll
        for (int vb = 0; vb < 2; ++vb) {
          f32x16 acc;
#pragma unroll
          for (int r = 0; r < 16; ++r) acc[r] = 0.f;
#pragma unroll
          for (int kk = 0; kk < 2; ++kk) {
            bf16x8 a = *(const bf16x8*)(sBT + (cb * 32 + l31) * 40 + ((kk * 16 + 8 * hl) ^ swz32(l31)));
            bf16x8 bb = *(const bf16x8*)(sSAT + (vb * 32 + l31) * 40 + kk * 16 + 8 * hl);
            acc = mfma32(a, bb, acc);
          }
#pragma unroll
          for (int kk = 0; kk < 2; ++kk) {
            bf16x8 a = *(const bf16x8*)(sKT + (cb * 32 + l31) * 40 + ((kk * 16 + 8 * hl) ^ swz32(l31)));
            bf16x8 bb = *(const bf16x8*)(sVT + (vb * 32 + l31) * 40 + ((kk * 16 + 8 * hl) ^ swz32(l31)));
            acc = mfma32(a, bb, acc);
          }
#pragma unroll
          for (int r = 0; r < 16; ++r) Zm[vb][r] = sPT[cb * 32 + acc_row(r, lane)] * (Zm[vb][r] + acc[r]);
        }
      }
      __syncthreads();
      if (wave >= 2) {
        const int cb = wave - 2;
#pragma unroll
        for (int vb = 0; vb < 2; ++vb)
#pragma unroll
          for (int g = 0; g < 4; ++g) {
            u32x2 pk; pk.x = pack2(Zm[vb][4 * g], Zm[vb][4 * g + 1]); pk.y = pack2(Zm[vb][4 * g + 2], Zm[vb][4 * g + 3]);
            *(u32x2*)(sZ + (vb * 32 + l31) * 72 + cb * 32 + 8 * g + 4 * hl) = pk;
          }
      }
    } else {
      const int vb = wave;
#pragma unroll
      for (int cb = 0; cb < 2; ++cb) {
        f32x16 acc;
#pragma unroll
        for (int r = 0; r < 16; ++r) acc[r] = 0.f;
#pragma unroll
        for (int kk = 0; kk < 2; ++kk) {
          bf16x8 a = *(const bf16x8*)(sBT + (cb * 32 + l31) * 40 + ((kk * 16 + 8 * hl) ^ swz32(l31)));
          bf16x8 bb = *(const bf16x8*)(sSAT + (vb * 32 + l31) * 40 + kk * 16 + 8 * hl);
          acc = mfma32(a, bb, acc);
        }
        if (vb < 2) {
#pragma unroll
          for (int kk = 0; kk < 2; ++kk) {
            bf16x8 a = *(const bf16x8*)(sKT + (cb * 32 + l31) * 40 + ((kk * 16 + 8 * hl) ^ swz32(l31)));
            bf16x8 bb = *(const bf16x8*)(sVT + (vb * 32 + l31) * 40 + ((kk * 16 + 8 * hl) ^ swz32(l31)));
            acc = mfma32(a, bb, acc);
          }
        }
#pragma unroll
        for (int r = 0; r < 16; ++r) Zm[cb][r] = sPT[cb * 32 + acc_row(r, lane)] * (Zm[cb][r] + acc[r]);
      }
#pragma unroll
      for (int cb = 0; cb < 2; ++cb)
#pragma unroll
        for (int g = 0; g < 4; ++g) {
          u32x2 pk; pk.x = pack2(Zm[cb][4 * g], Zm[cb][4 * g + 1]); pk.y = pack2(Zm[cb][4 * g + 2], Zm[cb][4 * g + 3]);
          *(u32x2*)(sZ + (vb * 32 + l31) * 72 + cb * 32 + 8 * g + 4 * hl) = pk;
        }
    }
  }
  if (!FULL) {
    float* Zs = segZ + ((size_t)sid * RW_NSEG + seg) * 64 * 128;
#pragma unroll
    for (int cb = 0; cb < 2; ++cb)
#pragma unroll
      for (int r = 0; r < 16; ++r) Zs[(cb * 32 + acc_row(r, lane)) * 128 + wave * 32 + l31] = Zm[cb][r];
  }
}

constexpr int LRU_NCH = (CTXL + SEQ) / 64;
constexpr size_t OFF_ACUM0 = OFF_PU;
static_assert((size_t)NLAT * 512 * 2 <= (size_t)2 * NEXP * 1024, "acum0");

struct LruRaw { u32x4 x[2][4]; };
DEV void lru_load_raw(const Params& P, int sid, int cc, LruRaw& R) {
  constexpr int NC_CTX = CTXL / 64;
  const int tid = threadIdx.x;
  const int d = sid & 1, blk = (sid >> 1) & 7, b = sid >> 4;
  const bf16_t* proj = (const bf16_t*)(P.ws + OFF_PROJ);
  const int sgi = cc >= NC_CTX;
  const int row0 = sgi ? NCTX + b * SEQ : b * CTXL;
  const int len = sgi ? SEQ : CTXL;
  const int cl = (sgi ? cc - NC_CTX : cc) * 64;
  const int lch = blk * 64 + (tid & 7) * 8;
  const u32x4 z4 = {0u, 0u, 0u, 0u};
#pragma unroll
  for (int i = 0; i < 2; ++i) {
    int c = tid + i * 256, r = c >> 3;
    int p = cl + r, pos = d ? len - 1 - p : p;
#pragma unroll
    for (int tap = 0; tap < 4; ++tap) {
      int pp = pos + tap - 2;
      R.x[i][tap] = (pp >= 0 && pp < len) ? *(const u32x4*)(proj + (size_t)(row0 + pp) * ODC + 2304 + lch) : z4;
    }
  }
}

DEV void st_lru_chunk(const Params& P, int sid, int cc, int nsid, int ncc, bool has_next, LruRaw& R, unsigned char* smem) {
  constexpr int NC_CTX = CTXL / 64;
  const int tid = threadIdx.x, lane = tid & 63, wave = tid >> 6;
  const int d = sid & 1, blk = (sid >> 1) & 7, b = sid >> 4;
  float* sXc = (float*)smem;
  float* sAc = sXc + 4096;
  float* sBc = sAc + 4096;
  float* sU = sBc + 4096;
  bf16_t* sAop = (bf16_t*)(sU + 4096);
  float* sQA = (float*)(sAop + 64 * 72);
  float* sQH = sQA + 256;
  int* sRow = (int*)(sQH + 256);
  const bf16_t* proj = (const bf16_t*)(P.ws + OFF_PROJ);
  bf16_t* uout = (bf16_t*)(P.ws + OFF_LORA) + (size_t)d * NTOK * 512;
  bf16_t* aout = (bf16_t*)(P.ws + (d ? OFF_ACUM1 : OFF_ACUM0));
  const bf16_t* lruT = (const bf16_t*)(P.ws + OFF_LRUT) + (size_t)(d * 8 + blk) * 128 * 64;
  float* chunkS = (float*)(P.ws + OFF_LRUCS) + ((size_t)sid * LRU_NCH + cc) * 128;
  const float* cw = P.in[I_LCONVW];
  const float* cb = P.in[I_LCONVB];
  const int tr = (wave >> 1) * 32, nc0 = (wave & 1) * 64;
  const int sgi = cc >= NC_CTX;
  const int row0 = sgi ? NCTX + b * SEQ : b * CTXL;
  const int len = sgi ? SEQ : CTXL;
  const int cl = (sgi ? cc - NC_CTX : cc) * 64;
  __syncthreads();
  if (tid < 64) { int p = cl + tid; sRow[tid] = row0 + (d ? len - 1 - p : p); }
  {
    const int lc8 = (tid & 7) * 8, lch = blk * 64 + lc8;
#pragma unroll
    for (int i = 0; i < 2; ++i) {
      int c = tid + i * 256, r = c >> 3;
      int p = cl + r, pos = d ? len - 1 - p : p;
      float o[8];
      f32x4 c0 = *(const f32x4*)(cb + lch), c1 = *(const f32x4*)(cb + lch + 4);
      o[0] = c0.x; o[1] = c0.y; o[2] = c0.z; o[3] = c0.w; o[4] = c1.x; o[5] = c1.y; o[6] = c1.z; o[7] = c1.w;
#pragma unroll
      for (int tap = 0; tap < 4; ++tap) {
        float x[8];
        unpack8(R.x[i][tap], x);
        f32x4 w0 = *(const f32x4*)(cw + tap * 512 + lch), w1 = *(const f32x4*)(cw + tap * 512 + lch + 4);
        o[0] += w0.x * x[0]; o[1] += w0.y * x[1]; o[2] += w0.z * x[2]; o[3] += w0.w * x[3];
        o[4] += w1.x * x[4]; o[5] += w1.y * x[5]; o[6] += w1.z * x[6]; o[7] += w1.w * x[7];
      }
      { f32x4 o0 = {o[0], o[1], o[2], o[3]}, o1 = {o[4], o[5], o[6], o[7]};
        *(f32x4*)(sXc + r * 64 + lc8) = o0; *(f32x4*)(sXc + r * 64 + lc8 + 4) = o1; }
      *(u32x4*)(sAop + r * 72 + lc8) = pack8(o);
    }
  }
  if (has_next) lru_load_raw(P, nsid, ncc, R);
  __syncthreads();
  {
    f32x16 acc[2];
#pragma unroll
    for (int j = 0; j < 2; ++j)
#pragma unroll
      for (int r = 0; r < 16; ++r) acc[j][r] = 0.f;
#pragma unroll
    for (int kk = 0; kk < 4; ++kk) {
      bf16x8 a = *(const bf16x8*)(sAop + (tr + (lane & 31)) * 72 + kk * 16 + 8 * (lane >> 5));
#pragma unroll
      for (int j = 0; j < 2; ++j) {
        bf16x8 bb = *(const bf16x8*)(lruT + (nc0 + j * 32 + (lane & 31)) * 64 + kk * 16 + 8 * (lane >> 5));
        acc[j] = mfma32(a, bb, acc[j]);
      }
    }
#pragma unroll
    for (int j = 0; j < 2; ++j) {
      const int e = nc0 + j * 32 + (lane & 31);
      const int ch = blk * 64 + (e & 63);
      const float ebias = e < 64 ? P.in[I_BA][d * 512 + ch] : P.in[I_BI][d * 512 + ch];
      const float esp = softplusf_(-P.in[I_LAM][d * 512 + ch]);
#pragma unroll
      for (int r = 0; r < 16; ++r) {
        int t = tr + acc_row(r, lane);
        float g = sigmoidf_(acc[j][r] + ebias);
        if (e < 64) { float a_ = fexp(-8.f * g * esp); sAc[t * 64 + e] = a_; sU[t * 64 + e] = fsqrt(fmaxf(1.f - a_ * a_, 0.f)); }
        else sBc[t * 64 + (e - 64)] = g * sXc[t * 64 + (e - 64)];
      }
    }
  }
  __syncthreads();
  const int c = tid & 63, q = tid >> 6;
  {
    float av[16], hv[16];
#pragma unroll
    for (int i = 0; i < 16; ++i) {
      const int t = q * 16 + i;
      av[i] = sAc[t * 64 + c];
      hv[i] = sU[t * 64 + c] * sBc[t * 64 + c];
    }
    float h = 0.f, ap = 1.f;
#pragma unroll
    for (int i = 0; i < 16; ++i) { h = av[i] * h + hv[i]; ap *= av[i]; hv[i] = h; av[i] = ap; }
    sQA[q * 64 + c] = ap; sQH[q * 64 + c] = h;
    __syncthreads();
    float hin = 0.f, ain = 1.f;
    for (int q2 = 0; q2 < q; ++q2) { hin = sQA[q2 * 64 + c] * hin + sQH[q2 * 64 + c]; ain *= sQA[q2 * 64 + c]; }
#pragma unroll
    for (int i = 0; i < 16; ++i) {
      const int t = q * 16 + i;
      sU[t * 64 + c] = hv[i] + av[i] * hin;
      sAc[t * 64 + c] = av[i] * ain;
    }
    if (q == 3) { chunkS[c] = av[15] * ain; chunkS[64 + c] = hv[15] + av[15] * hin; }
  }
  __syncthreads();
  if (sgi) {
#pragma unroll
    for (int i = 0; i < 2; ++i) {
      int cidx = tid + i * 256, r = cidx >> 3, c8 = (cidx & 7) * 8;
      float u8[8], a8[8];
      ld8(sU + r * 64 + c8, u8); ld8(sAc + r * 64 + c8, a8);
      const int row = sRow[r];
      *(u32x4*)(uout + (size_t)row * 512 + blk * 64 + c8) = pack8(u8);
      *(u32x4*)(aout + (size_t)(row - NCTX) * 512 + blk * 64 + c8) = pack8(a8);
    }
  }
}

DEV void st_lru_carry(const Params& P, int sid, unsigned char* smem) {
  const int tid = threadIdx.x, c = tid & 63, p = tid >> 6;
  constexpr int NQ = (LRU_NCH + 3) / 4, NBATCH = 13;
  const int c0 = p * NQ, c1 = (c0 + NQ < LRU_NCH) ? c0 + NQ : LRU_NCH;
  const float* cs = (const float*)(P.ws + OFF_LRUCS) + (size_t)sid * LRU_NCH * 128;
  float* hs = (float*)(P.ws + OFF_LRUHS) + (size_t)sid * LRU_NCH * 64;
  float* sA = (float*)smem;
  float* sH = sA + 256;
  float A = 1.f, H = 0.f;
  for (int cc0 = c0; cc0 < c1; cc0 += NBATCH) {
    float a[NBATCH], bb[NBATCH];
#pragma unroll
    for (int i = 0; i < NBATCH; ++i) {
      const int cc = cc0 + i < LRU_NCH ? cc0 + i : LRU_NCH - 1;
      a[i] = cs[(size_t)cc * 128 + c]; bb[i] = cs[(size_t)cc * 128 + 64 + c];
    }
#pragma unroll
    for (int i = 0; i < NBATCH; ++i) if (cc0 + i < c1) { H = a[i] * H + bb[i]; A *= a[i]; }
  }
  __syncthreads();
  sA[p * 64 + c] = A; sH[p * 64 + c] = H;
  __syncthreads();
  float h = 0.f;
  for (int p2 = 0; p2 < p; ++p2) h = sA[p2 * 64 + c] * h + sH[p2 * 64 + c];
  for (int cc0 = c0; cc0 < c1; cc0 += NBATCH) {
    float a[NBATCH], bb[NBATCH];
#pragma unroll
    for (int i = 0; i < NBATCH; ++i) {
      const int cc = cc0 + i < LRU_NCH ? cc0 + i : LRU_NCH - 1;
      a[i] = cs[(size_t)cc * 128 + c]; bb[i] = cs[(size_t)cc * 128 + 64 + c];
    }
#pragma unroll
    for (int i = 0; i < NBATCH; ++i) if (cc0 + i < c1) { hs[(size_t)(cc0 + i) * 64 + c] = h; h = a[i] * h + bb[i]; }
  }
}

DEV void st_finish_l1(const Params& P, int row) {
  const int lane = threadIdx.x & 63;
  bf16_t* hb = (bf16_t*)(P.ws + OFF_HBUF) + (size_t)row * 1024;
  const bf16_t* proj = (const bf16_t*)(P.ws + OFF_PROJ);
  const bf16_t* lora = (const bf16_t*)(P.ws + OFF_LORA);
  const float* mu = P.in[I_MU];
  const int ch = lane * 8;
  float y0[8], y1[8];
  unpack8(*(const u32x4*)(hb + ch), y0);
  unpack8(*(const u32x4*)(hb + 512 + ch), y1);
  float sm = 0.f;
#pragma unroll
  for (int j = 0; j < 8; ++j) { y0[j] += y1[j]; sm += y0[j]; }
  sm = sum8(sm);
  const float mean = sm * (1.f / 64.f);
  float sv = 0.f;
#pragma unroll
  for (int j = 0; j < 8; ++j) { float dlt = y0[j] - mean; sv += dlt * dlt; }
  sv = sum8(sv);
  const float rstd = frsq(sv * (1.f / 64.f) + 64e-5f);
  float a0[8], a1[8], g[8], u0[8], u1[8], gb[8];
  unpack8(*(const u32x4*)(lora + ((size_t)2 * NTOK + row) * 512 + ch), a0);
  unpack8(*(const u32x4*)(lora + ((size_t)3 * NTOK + row) * 512 + ch), a1);
  unpack8(*(const u32x4*)(lora + ((size_t)4 * NTOK + row) * 512 + ch), g);
  unpack8(*(const u32x4*)(lora + ((size_t)0 * NTOK + row) * 512 + ch), u0);
  unpack8(*(const u32x4*)(lora + ((size_t)1 * NTOK + row) * 512 + ch), u1);
  if (row >= NCTX) {
    const int bb_ = (row - NCTX) / SEQ, pos = (row - NCTX) % SEQ, blk = ch >> 6;
    float ac[8];
#pragma unroll
    for (int dd = 0; dd < 2; ++dd) {
      const int pidx = dd ? SEQ - 1 - pos : pos;
      const int cc = CTXL / 64 + pidx / 64;
      const int sid = (bb_ * 8 + blk) * 2 + dd;
      const float* hs = (const float*)(P.ws + OFF_LRUHS) + ((size_t)sid * LRU_NCH + cc) * 64 + (ch & 63);
      unpack8(*(const u32x4*)((const bf16_t*)(P.ws + (dd ? OFF_ACUM1 : OFF_ACUM0)) + (size_t)(row - NCTX) * 512 + ch), ac);
      f32x4 h0 = *(const f32x4*)hs, h1 = *(const f32x4*)(hs + 4);
      float* u = dd ? u1 : u0;
      u[0] += ac[0] * h0.x; u[1] += ac[1] * h0.y; u[2] += ac[2] * h0.z; u[3] += ac[3] * h0.w;
      u[4] += ac[4] * h1.x; u[5] += ac[5] * h1.y; u[6] += ac[6] * h1.z; u[7] += ac[7] * h1.w;
    }
  }
  unpack8(*(const u32x4*)(proj + (size_t)row * ODC + 1792 + ch), gb);
  float rv[8], vv[8], kv[8];
  float sdot = 0.f;
  float pka[8], prk[8], plw[8], plb[8];
  ld8(P.in[I_KA] + ch, pka); ld8(P.in[I_RK] + ch, prk); ld8(P.in[I_LNW] + ch, plw); ld8(P.in[I_LNB] + ch, plb);
  mix8(proj, row, ch, mu, rv);
  mix8(proj, row, 512 + ch, mu, kv);
  mix8(proj, row, 1024 + ch, mu, vv);
#pragma unroll
  for (int j = 0; j < 8; ++j) {
    float r = rv[j];
    float k = kv[j];
    float am = 0.5f * (a0[j] + a1[j]);
    float kb = k * (1.f + (am - 1.f) * pka[j]);
    sdot += r * kb * prk[j];
    rv[j] = r;
  }
  sdot = sum8(sdot);
  float f1[8], f2[8];
#pragma unroll
  for (int j = 0; j < 8; ++j) {
    float yn = (y0[j] - mean) * rstd * plw[j] + plb[j];
    yn += sdot * vv[j];
    f1[j] = yn * g[j];
    f2[j] = (u0[j] + u1[j]) * geluf_(gb[j]);
  }
  *(u32x4*)(hb + ch) = pack8(f1);
  *(u32x4*)(hb + 512 + ch) = pack8(f2);
}

DEV unsigned fkey(float f) { unsigned u; __builtin_memcpy(&u, &f, 4); return (u >> 31) ? ~u : (u | 0x80000000u); }
DEV float keyf(unsigned u) { u = (u >> 31) ? (u & 0x7fffffffu) : ~u; float f; __builtin_memcpy(&f, &u, 4); return f; }
DEV void key_insert(unsigned x, unsigned* v) {
#pragma unroll
  for (int j = 0; j < 16; ++j) { unsigned hi = v[j] > x ? v[j] : x; x = v[j] > x ? x : v[j]; v[j] = hi; }
}
DEV void key_cx(unsigned& hi, unsigned& lo) { unsigned a = hi, b = lo; hi = a > b ? a : b; lo = a > b ? b : a; }
DEV void key_sort16(unsigned* v) {
#pragma unroll
  for (int k = 2; k <= 16; k <<= 1)
#pragma unroll
    for (int j = k >> 1; j > 0; j >>= 1)
#pragma unroll
      for (int i = 0; i < 16; ++i) {
        const int l = i ^ j;
        if (l > i) { if ((i & k) == 0) key_cx(v[i], v[l]); else key_cx(v[l], v[i]); }
      }
}
DEV void key_merge16(unsigned* a, const unsigned* b) {
#pragma unroll
  for (int i = 0; i < 16; ++i) a[i] = a[i] > b[15 - i] ? a[i] : b[15 - i];
#pragma unroll
  for (int j = 8; j > 0; j >>= 1)
#pragma unroll
    for (int i = 0; i < 16; ++i) { const int l = i ^ j; if (l > i) key_cx(a[i], a[l]); }
}

DEV void st_peer_topk(const Params& P, int layer, int tile, int h, unsigned char* smem) {
  const int tid = threadIdx.x;
  const bf16_t* q = (const bf16_t*)(P.ws + OFF_Q);
  const bf16_t* keys = (const bf16_t*)(P.ws + OFF_KEYS) + (size_t)(layer * 8 + h) * 2 * 128 * 128;
  float* sS = (float*)smem;
  const int m0 = tile * 128;
  const int tok = tid & 127, half = tid >> 7;
  unsigned kl[2][16];
#pragma unroll
  for (int p = 0; p < 2; ++p) {
    EpiScoreLds epi{sS, m0};
    gemm_tile_128<true>(q + (h * 2 + p) * 128, 2048, NTOK, keys + p * 128 * 128, 128, 128, 128, m0, 0, epi, smem);
    __syncthreads();
    float* row = sS + tok * 129 + half * 64;
#pragma unroll
    for (int g = 0; g < 4; ++g) {
      unsigned grp[16];
#pragma unroll
      for (int j = 0; j < 16; ++j) grp[j] = (fkey(row[g * 16 + j]) & ~127u) | (unsigned)(127 - (half * 64 + g * 16 + j));
      key_sort16(grp);
      if (g == 0) {
#pragma unroll
        for (int j = 0; j < 16; ++j) kl[p][j] = grp[j];
      } else key_merge16(kl[p], grp);
    }
    if (half == 1) {
#pragma unroll
      for (int j = 0; j < 16; ++j) row[j] = __builtin_bit_cast(float, kl[p][j]);
    }
    __syncthreads();
    if (half == 0) {
      unsigned oth[16];
#pragma unroll
      for (int j = 0; j < 16; ++j) oth[j] = __builtin_bit_cast(unsigned, sS[tok * 129 + 64 + j]);
      key_merge16(kl[p], oth);
    }
    __syncthreads();
  }
  if (tid < 128) {
    float sv0[16], sv1[16];
    int* irow = (int*)(sS + tid * 129);
#pragma unroll
    for (int j = 0; j < 16; ++j) {
      sv0[j] = keyf((kl[0][j] & ~127u) | 64u); sv1[j] = keyf((kl[1][j] & ~127u) | 64u);
      irow[j] = 127 - (int)(kl[0][j] & 127u); irow[16 + j] = 127 - (int)(kl[1][j] & 127u);
    }
    unsigned best[16];
#pragma unroll
    for (int j = 0; j < 16; ++j) best[j] = 0u;
#pragma unroll
    for (int i = 0; i < 16; ++i)
#pragma unroll
      for (int j = 0; j < 16; ++j)
        if ((i + 1) * (j + 1) <= 16) key_insert((fkey(sv0[i] + sv1[j]) & ~255u) | (unsigned)(255 - (i * 16 + j)), best);
    float e[16], sum = 0.f;
    const float b0 = keyf((best[0] & ~255u) | 128u);
#pragma unroll
    for (int j = 0; j < 16; ++j) { e[j] = fexp(keyf((best[j] & ~255u) | 128u) - b0); sum += e[j]; }
    const float inv = 1.f / sum;
    int* pidx = (int*)(P.ws + OFF_PIDX) + (size_t)(m0 + tid) * 128 + h * 16;
    float* pg = (float*)(P.ws + OFF_PGATE) + (size_t)(m0 + tid) * 128 + h * 16;
#pragma unroll
    for (int j = 0; j < 16; ++j) {
      const int pos = 255 - (int)(best[j] & 255u);
      pidx[j] = irow[pos >> 4] * 128 + irow[16 + (pos & 15)];
      pg[j] = e[j] * inv;
    }
  }
}

DEV void st_peer_experts(const Params& P, int layer, int row) {
  const int lane = threadIdx.x & 63;
  const bf16_t* xb = (const bf16_t*)(P.ws + OFF_HBUF) + (size_t)row * 1024;
  const unsigned char* U = P.ws + OFF_PU;
  const int* pidx = (const int*)(P.ws + OFF_PIDX) + (size_t)row * 128;
  const float* pg = (const float*)(P.ws + OFF_PGATE) + (size_t)row * 128;
  float x[16], acc[16];
  unpack8(*(const u32x4*)(xb + lane * 16), x);
  unpack8(*(const u32x4*)(xb + lane * 16 + 8), x + 8);
#pragma unroll
  for (int j = 0; j < 16; ++j) acc[j] = 0.f;
  const int b3 = (lane >> 3) & 1;
  const int mypick = (lane >> 3) & 7;
#ifdef CPU_EMU
#define PEER_SID(id) (id)
#else
#define PEER_SID(id) __builtin_amdgcn_readfirstlane(id)
#endif
  const unsigned lo12 = lane * 12, lo8 = PEER_VOFF + lane * 8;
#define PEER_LDU(i, id) do { const unsigned* up_ = (const unsigned*)(U + (size_t)(unsigned)(id) * PEER_ROWB + lo12); \
    uu[i].x = up_[0]; uu[i].y = up_[1]; uu[i].z = up_[2]; } while (0)
#define PEER_LDV(i, id) vv[i] = *(const u32x2*)(U + (size_t)(unsigned)(id) * PEER_ROWB + lo8)
#define PEER_IDS(v0, v1) {PEER_SID((int)v0.x), PEER_SID((int)v0.y), PEER_SID((int)v0.z), PEER_SID((int)v0.w), \
                          PEER_SID((int)v1.x), PEER_SID((int)v1.y), PEER_SID((int)v1.z), PEER_SID((int)v1.w)}
  u32x3 uu[8]; u32x2 vv[8];
  int cid[8];
  {
    const u32x4 p0 = *(const u32x4*)pidx, p1 = *(const u32x4*)(pidx + 4);
    const int id[8] = PEER_IDS(p0, p1);
#pragma unroll
    for (int i = 0; i < 8; ++i) { cid[i] = id[i]; PEER_LDU(i, id[i]); }
  }
  u32x4 n0 = *(const u32x4*)(pidx + 8), n1 = *(const u32x4*)(pidx + 12);
  float gcur = pg[mypick];
  for (int k0 = 0; k0 < 128; k0 += 8) {
#pragma unroll
    for (int i = 0; i < 8; ++i) PEER_LDV(i, cid[i]);
    const int nid[8] = PEER_IDS(n0, n1);
    {
      const int k2 = k0 + 16 < 128 ? k0 + 16 : 120;
      n0 = *(const u32x4*)(pidx + k2); n1 = *(const u32x4*)(pidx + k2 + 4);
    }
    const float gnxt = pg[(k0 + 8 < 128 ? k0 + 8 : 120) + mypick];
    float dsum[8];
#pragma unroll
    for (int i = 0; i < 8; i += 2) {
      float ufa[16], ufb[16];
#ifndef CPU_EMU
      __builtin_amdgcn_sched_barrier(0);
#endif
      unpack2x16_fp6(uu[i], uu[i + 1], ufa, ufb);
      PEER_LDU(i, nid[i]); PEER_LDU(i + 1, nid[i + 1]);
      typedef __attribute__((ext_vector_type(2))) float f32x2v;
      f32x2v da2 = {0.f, 0.f}, db2 = {0.f, 0.f};
#pragma unroll
      for (int j = 0; j < 8; ++j) {
        const f32x2v xx = {x[2 * j], x[2 * j + 1]};
        const f32x2v ua = {ufa[2 * j], ufa[2 * j + 1]}, ub = {ufb[2 * j], ufb[2 * j + 1]};
        da2 = xx * ua + da2; db2 = xx * ub + db2;
      }
      dsum[i] = da2.x + da2.y; dsum[i + 1] = db2.x + db2.y;
    }
    float e4[4], e2[2], g;
#pragma unroll
    for (int i = 0; i < 4; ++i) e4[i] = swap32_sum(dsum[i], dsum[4 + i]);
#pragma unroll
    for (int i = 0; i < 2; ++i) e2[i] = swap16_sum(e4[i], e4[2 + i]);
    {
      float mine = b3 ? e2[1] : e2[0], send = b3 ? e2[0] : e2[1];
      g = mine + dpp_xor<8>(send);
    }
    g = sum8(g);
    const float mycoef = gcur * geluf_(g * (1.f / PEER_USCALE));
#pragma unroll
    for (int i = 0; i < 8; ++i) {
      const float coef = wreadlane(mycoef, i * 8);
      float vf[16];
      unpack8_fp4(vv[i].x, vf); unpack8_fp4(vv[i].y, vf + 8);
#pragma unroll
      for (int j = 0; j < 16; ++j) acc[j] += coef * vf[j];
    }
#pragma unroll
    for (int i = 0; i < 8; ++i) cid[i] = nid[i];
    gcur = gnxt;
  }
#undef PEER_LDU
#undef PEER_LDV
#undef PEER_IDS
#undef PEER_SID
  float* xr = row < NCTX ? (float*)(P.ws + OFF_CTXRES) + (size_t)row * 1024 : P.out + (size_t)(row - NCTX) * 1024;
  const float* g2 = (const float*)(P.ws + OFF_MODV) + ((size_t)layer * 3 + mod_row(row)) * 6144 + 5 * 1024;
  float o[16];
#pragma unroll
  for (int q = 0; q < 4; ++q) {
    const int c = lane * 16 + q * 4;
    f32x4 a = *(const f32x4*)(xr + c), ga = *(const f32x4*)(g2 + c);
    o[q * 4 + 0] = a.x + ga.x * acc[q * 4 + 0] * (1.f / PEER_VSCALE); o[q * 4 + 1] = a.y + ga.y * acc[q * 4 + 1] * (1.f / PEER_VSCALE);
    o[q * 4 + 2] = a.z + ga.z * acc[q * 4 + 2] * (1.f / PEER_VSCALE); o[q * 4 + 3] = a.w + ga.w * acc[q * 4 + 3] * (1.f / PEER_VSCALE);
  }
  float ss = 0.f;
#pragma unroll
  for (int j = 0; j < 16; ++j) ss += o[j] * o[j];
  ss = wave_sum(ss);
  const float rstd = frsq(ss * (1.f / 1024.f) + 1e-6f);
  if (layer == 1) {
    float fn[16]; ld8(P.in[I_FNORM] + lane * 16, fn); ld8(P.in[I_FNORM] + lane * 16 + 8, fn + 8);
#pragma unroll
    for (int j = 0; j < 16; ++j) o[j] *= rstd * fn[j];
  }
#pragma unroll
  for (int q = 0; q < 4; ++q) {
    f32x4 a = {o[q * 4 + 0], o[q * 4 + 1], o[q * 4 + 2], o[q * 4 + 3]};
    *(f32x4*)(xr + lane * 16 + q * 4) = a;
  }
  if (layer == 0) {
    const float* mv = (const float*)(P.ws + OFF_MODV) + ((size_t)1 * 3 + mod_row(row)) * 6144;
    const float* nw = P.in[I_NORM1] + 1024;
    float hh[16];
#pragma unroll
    for (int q = 0; q < 4; ++q) {
      const int c = lane * 16 + q * 4;
      f32x4 w4 = *(const f32x4*)(nw + c), s4 = *(const f32x4*)(mv + 1024 + c), h4 = *(const f32x4*)(mv + c);
      hh[q * 4 + 0] = o[q * 4 + 0] * rstd * w4.x * (1.f + s4.x) + h4.x; hh[q * 4 + 1] = o[q * 4 + 1] * rstd * w4.y * (1.f + s4.y) + h4.y;
      hh[q * 4 + 2] = o[q * 4 + 2] * rstd * w4.z * (1.f + s4.z) + h4.z; hh[q * 4 + 3] = o[q * 4 + 3] * rstd * w4.w * (1.f + s4.w) + h4.w;
    }
    bf16_t* hb = (bf16_t*)(P.ws + OFF_HBUF) + (size_t)row * 1024 + lane * 16;
    *(u32x4*)hb = pack8(hh);
    *(u32x4*)(hb + 8) = pack8(hh + 8);
  }
}


#define FOR_TILES_XCD(MT0, MT1, NT, mt, nt)                                                     \
  for (int _x = blockIdx.x & 7, _mlo = (MT0) + (((MT1) - (MT0)) * _x) / 8,                        \
           _mhi = (MT0) + (((MT1) - (MT0)) * (_x + 1)) / 8, _i = blockIdx.x >> 3,                 \
           _cnt = (_mhi - _mlo) * (NT), mt = 0, nt = 0;                                           \
       _i < _cnt && ((mt = _mlo + _i / (NT)), (nt = _i % (NT)), true); _i += (int)(gridDim.x >> 3))

#ifndef PHASE_LIST
#define PHASE_LIST(X) X(0) X(1) X(2) X(22) X(23) X(3) X(4) X(5) X(6) X(7) X(8) X(9) X(11) X(12) X(13) X(30) X(14) X(15) X(31) X(16) X(17) X(18) X(19) X(20) X(21)
#endif
constexpr int PH_LAST = 21;

template <int ph>
DEV void run_phase(const Params& P, unsigned char* smem) {
  int bid_ = blockIdx.x, wave_ = threadIdx.x >> 6;
  OPAQUE_S(bid_); OPAQUE(wave_);
  const int bid = bid_, nb = gridDim.x;
  const int wave = wave_;
  unsigned char* ws = P.ws;
  constexpr int layer = ((ph >= 10 && ph <= 21) || ph >= 30) ? 1 : 0;
  const float* modv_l = (const float*)(ws + OFF_MODV) + (size_t)layer * 3 * 6144;
  switch (ph) {
    case 0:
      for (int t = NTRANS + bid; t < NPREP; t += nb) st_prep(P, t, smem);
      break;
    case 1: case 10:
      if (ph == 1) for (int t = nb - 1 - bid; t < NTRANS; t += nb) st_prep(P, t, smem);
      for (int t = bid; t < NTOK / 4; t += nb) st_normmod(P, layer, 0, t * 4 + wave);
      break;
    case 2: {
      EpiProjL0T epi{(bf16_t*)(ws + OFF_PROJ), (float*)(ws + OFF_GATES)};
      FOR_TILES_XCD(0, NTOK / 256, 25, mt, nt)
        gemm_tile_128x256<EpiProjL0T, true>((const bf16_t*)(ws + OFF_WEVIN), 1024, EVC, (const bf16_t*)(ws + OFF_HBUF), 1024, NTOK, 1024,
                                            nt * 128, mt * 256, epi, smem);
    } break;
    case 22:
      for (int t = bid; t < NTOK / 4; t += nb) st_xbc_conv(P, t * 4 + wave);
      for (int t = bid; t < NPCONV; t += nb) st_peer_conv(P, 0, t);
      break;
    case 23:
      for (int t = bid; t < 48 * LA_NSEG; t += nb) {
        int sid = t % 48, seg = t / 48;
        if (sid < 16) st_linattn_seg<true, false>(P, sid, seg, smem);
        else st_linattn_seg<false, false>(P, sid - 16, seg, smem);
      }
      break;
    case 3:
      for (int t = bid; t < 48 * LA_NSEG; t += nb) {
        int sid = t % 48, seg = t / 48;
        if (sid < 16) st_linattn_seg<true, true>(P, sid, seg, smem);
        else st_linattn_seg<false, true>(P, sid - 16, seg, smem);
      }
      break;
    case 4:
      for (int t = bid; t < NTOK / 4; t += nb) st_finish_l0(P, t * 4 + wave);
      break;
    case 5: case 17: {
      EpiOutProjT epi{layer == 0 ? P.in[I_X] : P.out, P.in[I_CTX], P.out, (float*)(ws + OFF_CTXRES), modv_l};
      const bf16_t* Wt = (const bf16_t*)(ws + (layer == 0 ? OFF_WEVOUT : OFF_WODOUT));
      FOR_TILES_XCD(layer == 0 ? 0 : NCTX / 256, NTOK / 256, 8, mt, nt)
        gemm_tile_128x256<EpiOutProjT, true>(Wt, 1024, 1024, (const bf16_t*)(ws + OFF_HBUF), 1024, NTOK, 1024, nt * 128, mt * 256, epi, smem);
    } break;
    case 6: case 18: {
      const int r0 = layer == 0 ? 0 : NCTX / 4;
      for (int t = r0 + bid; t < NTOK / 4; t += nb) st_normmod(P, layer, 1, t * 4 + wave);
      if (ph == 18) for (int t = bid; t < NPCONV; t += nb) st_peer_conv(P, 1, t);
    } break;
    case 7: case 19: {
      EpiStoreBfT epi{(bf16_t*)(ws + OFF_Q), 2048};
      const bf16_t* Wt = (const bf16_t*)(ws + OFF_WQ) + (size_t)layer * 2048 * 1024;
      FOR_TILES_XCD(layer == 0 ? 0 : NCTX / 256, NTOK / 256, 16, mt, nt)
        gemm_tile_128x256<EpiStoreBfT, true>(Wt, 1024, 2048, (const bf16_t*)(ws + OFF_HBUF), 1024, NTOK, 1024, nt * 128, mt * 256, epi, smem);
    } break;
    case 8: case 20: {
      const int t0 = layer == 0 ? 0 : CTILE * 8;
      for (int t = t0 + bid; t < NTILE * 8; t += nb) st_peer_topk(P, layer, t / 8, t % 8, smem);
    } break;
    case 9: case 21: {
      const int r0 = layer == 0 ? 0 : NCTX / 4;
      for (int t = r0 + bid; t < NTOK / 4; t += nb) st_peer_experts(P, layer, t * 4 + wave);
    } break;
    case 11: {
      EpiStoreBfT epi{(bf16_t*)(ws + OFF_PROJ), ODC};
      FOR_TILES_XCD(0, NTOK / 256, 22, mt, nt)
        gemm_tile_128x256<EpiStoreBfT, true>((const bf16_t*)(ws + OFF_WODIN), 1024, ODC, (const bf16_t*)(ws + OFF_HBUF), 1024, NTOK, 1024,
                                             nt * 128, mt * 256, epi, smem);
    } break;
    case 12:
      for (int t = bid; t < NTOK / 8; t += nb) st_lora_act(P, t * 8 + wave * 2);
      break;
    case 13:
      for (int t = bid; t < NTILE * 20; t += nb) {
        int job = t / (NTILE * 4), tt = t % (NTILE * 4);
        int mt = tt / 4, nt = tt % 4;
        bf16_t* dst = (bf16_t*)(ws + OFF_LORA) + (size_t)job * NTOK * 512;
        const bf16_t* A = (const bf16_t*)(ws + OFF_HBUF) + (job < 2 ? 0 : (job < 4 ? 64 : 128));
        const bf16_t* Bt = job < 2 ? (const bf16_t*)(ws + OFF_WUP) + (size_t)job * 512 * 64
                         : job < 4 ? (const bf16_t*)(ws + OFF_AUP) + (size_t)(job - 2) * 512 * 64
                                   : (const bf16_t*)(ws + OFF_GUP);
        const float* bias = job < 2 ? P.in[I_W0] + job * 512 : (job < 4 ? P.in[I_A0] + (job - 2) * 512 : nullptr);
        const int K = job < 4 ? 64 : 128;
        EpiStoreBfBiasT epi{dst, 512, bias, job < 2 ? 1 : (job < 4 ? 2 : 0)};
        gemm_tile_128<false, EpiStoreBfBiasT, true>(Bt, K, 512, A, 1024, NTOK, K, nt * 128, mt * 128, epi, smem);
      }
      break;
    case 30:
      for (int t = bid; t < 32 * RW_NSEG; t += nb) st_rwkv_seg<false>(P, t % 32, t / 32, smem);
      break;
    case 14:
      for (int t = bid; t < 32 * RW_NSEG; t += nb) st_rwkv_seg<true>(P, t % 32, t / 32, smem);
      break;
    case 15:
      {
        LruRaw R;
        if (bid < 32 * LRU_NCH) lru_load_raw(P, bid % 32, bid / 32, R);
        for (int t = bid; t < 32 * LRU_NCH; t += nb) {
          const int tn = t + nb;
          st_lru_chunk(P, t % 32, t / 32, tn % 32, tn / 32, tn < 32 * LRU_NCH, R, smem);
        }
      }
      break;
    case 31:
      if (bid < 32) st_lru_carry(P, bid, smem);
      break;
    case 16:
      for (int t = bid; t < NTOK / 4; t += nb) st_finish_l1(P, t * 4 + wave);
      break;
    default: break;
  }
}


#ifndef CPU_EMU
#define XB_TMO      128
#define XB_XCNT(j)  (256  + 64 * (j))
#define XB_XSUB(j)  (1280 + 64 * (j))
#define XB_XGEN(j)  (2304 + 64 * (j))
#define XB_TOP      3328
#define XB_TOPGEN   3392
#define XCD_BAR_WORDS 3456
#define XB_SPIN_CAP (1u << 20)
#define LAS __attribute__((address_space(3)))
__device__ __forceinline__ unsigned xb_ld(unsigned* p)              { return __hip_atomic_load(p, __ATOMIC_RELAXED, __HIP_MEMORY_SCOPE_AGENT); }
__device__ __forceinline__ unsigned xb_add(unsigned* p, unsigned v) { return __hip_atomic_fetch_add(p, v, __ATOMIC_RELAXED, __HIP_MEMORY_SCOPE_AGENT); }
__device__ __forceinline__ unsigned xb_xcc_id() { return (unsigned)__builtin_amdgcn_s_getreg((3 << 11) | 20) & 0xFu; }
#define XB_SPIN(cond, bar) do { unsigned _sp = 0; while (cond) { __builtin_amdgcn_s_sleep(1); \
    if ((++_sp & 255u) == 0u) { if (xb_ld(&(bar)[XB_TMO])) break; if (_sp > XB_SPIN_CAP) { atomicAdd(&(bar)[XB_TMO], 1u); break; } } } } while (0)
struct XcdBarrier { unsigned* bar; unsigned x; volatile LAS unsigned* st; };
__device__ __forceinline__ XcdBarrier xcd_barrier_post(unsigned* bar, volatile LAS unsigned* st) {
  XcdBarrier b; b.bar = bar; b.x = xb_xcc_id(); b.st = st;
  if (threadIdx.x == 0) (void)xb_add(&bar[XB_XCNT(b.x)], 1u);
  return b;
}
__device__ __forceinline__ void xcd_barrier_complete(unsigned* bar, unsigned x, unsigned& nloc, unsigned& nx) {
  const unsigned G = gridDim.x * gridDim.y * gridDim.z;
  unsigned sum, cnt, mine, sp = 0u;
  for (;;) {
    sum = 0u; cnt = 0u; mine = 0u;
#pragma unroll
    for (unsigned j = 0; j < 16; ++j) { const unsigned c = xb_ld(&bar[XB_XCNT(j)]); sum += c; cnt += (c > 0u) ? 1u : 0u; mine = (j == x) ? c : mine; }
    if (sum == G) break;
    __builtin_amdgcn_s_sleep(1);
    if ((++sp & 255u) == 0u) { if (xb_ld(&bar[XB_TMO])) break; if (sp > XB_SPIN_CAP) { atomicAdd(&bar[XB_TMO], 1u); break; } }
  }
  nloc = mine > 0u ? mine : 1u; nx = cnt > 0u ? cnt : 1u;
}
__device__ __forceinline__ void xcd_barrier(const XcdBarrier& b) {
  asm volatile("s_waitcnt vmcnt(0)" ::: "memory");
  __syncthreads();
  if (threadIdx.x == 0) {
    unsigned* bar = b.bar;
    __builtin_amdgcn_s_waitcnt(0);
    unsigned nloc = b.st[0], nx = b.st[1];
    if (nloc == 0u) { xcd_barrier_complete(bar, b.x, nloc, nx); b.st[0] = nloc; b.st[1] = nx; }
    const unsigned old = xb_add(&bar[XB_XSUB(b.x)], 1u);
    const unsigned gen = old / nloc;
    if (old + 1u == (gen + 1u) * nloc) {
      __builtin_amdgcn_fence(__ATOMIC_RELEASE, "agent");
      asm volatile("s_waitcnt vmcnt(0)" ::: "memory");
      const unsigned og = xb_add(&bar[XB_TOP], 1u);
      const unsigned tg = og / nx;
      if (og + 1u == (tg + 1u) * nx) xb_add(&bar[XB_TOPGEN], 1u);
      else XB_SPIN(xb_ld(&bar[XB_TOPGEN]) == tg, bar);
      __builtin_amdgcn_fence(__ATOMIC_ACQUIRE, "agent");
      xb_add(&bar[XB_XGEN(b.x)], 1u);
      asm volatile("s_waitcnt vmcnt(0)" ::: "memory");
    } else {
      XB_SPIN(xb_ld(&bar[XB_XGEN(b.x)]) == gen, bar);
      __builtin_amdgcn_fence(__ATOMIC_ACQUIRE, "agent");
      asm volatile("s_waitcnt vmcnt(0)" ::: "memory");
    }
  }
  __syncthreads();
}
#endif
#ifndef CPU_EMU
#define RUN_PH(n) run_phase<n>(P, smem_raw); if (n != PH_LAST) xcd_barrier(xb);
__global__ void __launch_bounds__(256, 2) mega_kernel(Params P) {
  SMEM_DECL;
  unsigned* bar = (unsigned*)(P.ws + OFF_BAR);
  volatile LAS unsigned* st = (volatile LAS unsigned*)(smem_raw + SMEM_BYTES - 16);
  if (threadIdx.x == 0) { st[0] = 0u; st[1] = 0u; }
  if (P.ws == nullptr) cg::this_grid().sync();
  __syncthreads();
  XcdBarrier xb = xcd_barrier_post(bar, st);
  PHASE_LIST(RUN_PH)
}

extern "C" void kernel_launch(void* const* d_in, const int* in_sizes, int n_in, void* d_out, int out_size, void* d_ws,
                              size_t ws_size, hipStream_t stream) {
  Params P{};
  for (int i = 0; i < N_IN; ++i) P.in[i] = (const float*)d_in[i];
  P.out = (float*)d_out;
  P.ws = (unsigned char*)d_ws;
  if (ws_size < WS_NEEDED) { fprintf(stderr, "workspace too small: %zu < %zu\n", ws_size, (size_t)WS_NEEDED); return; }
  static int grid_blocks = 0;
  if (!grid_blocks) {
    int dev = 0, cus = 0, per_cu = 0;
    hipGetDevice(&dev);
    hipDeviceGetAttribute(&cus, hipDeviceAttributeMultiprocessorCount, dev);
    hipOccupancyMaxActiveBlocksPerMultiprocessor(&per_cu, mega_kernel, 256, 0);
    if (per_cu > 2) per_cu = 2;
    grid_blocks = cus * per_cu;
  }
  (void)hipMemsetAsync((unsigned char*)d_ws + OFF_BAR, 0, 16384, stream);
  void* args[] = {&P};
  hipError_t e = hipLaunchCooperativeKernel((void*)mega_kernel, dim3(grid_blocks), dim3(256), args, 0, stream);
  if (e != hipSuccess) fprintf(stderr, "cooperative launch failed: %s (grid %d)\n", hipGetErrorString(e), grid_blocks);
}
#endif
```

```cpp
#ifdef CPU_EMU
#include "emu.h"
#else
#include <hip/hip_runtime.h>
#include <hip/hip_cooperative_groups.h>
#include <cstdio>
namespace cg = cooperative_groups;
#define DEV __device__ __forceinline__
#define DEVM __device__ __forceinline__
#define OPAQUE(x) asm volatile("" : "+v"(x))
#define OPAQUE_S(x) asm volatile("" : "+s"(x))
#endif

#ifndef SEQ_LEN
#define SEQ_LEN 16384
#endif
#ifndef CTX_LEN
#define CTX_LEN 256
#endif
#ifndef GRID_W_
#define GRID_W_ 64
#endif
#ifndef MULTI_LAUNCH
#define MULTI_LAUNCH 0
#endif

typedef unsigned short bf16_t;
typedef __attribute__((ext_vector_type(8))) short bf16x8;
typedef __attribute__((ext_vector_type(16))) float f32x16;
typedef __attribute__((ext_vector_type(4))) unsigned u32x4;
typedef __attribute__((ext_vector_type(2))) unsigned u32x2;
typedef __attribute__((ext_vector_type(4))) float f32x4;

constexpr int D = 1024, NB = 2, SEQ = SEQ_LEN, CTXL = CTX_LEN, GW = GRID_W_;
constexpr int NCTX = NB * CTXL, NLAT = NB * SEQ, NTOK = NCTX + NLAT;
constexpr int EVC = 3104, ODC = 2816;
constexpr int NEXP = 16384;
constexpr int NTILE = NTOK / 128, CTILE = NCTX / 128;
static_assert(NTOK % 256 == 0 && NCTX % 256 == 0, "tiles");
static_assert(CTXL % 64 == 0 && SEQ % 64 == 0 && SEQ % GW == 0, "chunks");

constexpr size_t al256(size_t x) { return (x + 255) & ~(size_t)255; }
constexpr size_t OFF_MODV = 0;
constexpr size_t OFF_CTXRES = OFF_MODV + al256(2 * 3 * 6144 * 4);
constexpr size_t OFF_GATES = OFF_CTXRES + al256((size_t)NCTX * 1024 * 4);
constexpr size_t OFF_WEVIN = OFF_GATES + al256((size_t)NTOK * 32 * 4);
constexpr size_t OFF_WEVOUT = OFF_WEVIN + al256((size_t)EVC * 1024 * 2);
constexpr size_t OFF_WODIN = OFF_WEVOUT + al256((size_t)1024 * 1024 * 2);
constexpr size_t OFF_WODOUT = OFF_WODIN + al256((size_t)ODC * 1024 * 2);
constexpr size_t OFF_WQ = OFF_WODOUT + al256((size_t)1024 * 1024 * 2);
constexpr size_t OFF_KEYS = OFF_WQ + al256((size_t)2 * 2048 * 1024 * 2);
constexpr size_t OFF_WUP = OFF_KEYS + al256((size_t)2 * 8 * 2 * 128 * 128 * 2);
constexpr size_t OFF_AUP = OFF_WUP + al256((size_t)2 * 512 * 64 * 2);
constexpr size_t OFF_GUP = OFF_AUP + al256((size_t)2 * 512 * 64 * 2);
constexpr size_t OFF_LRUT = OFF_GUP + al256((size_t)512 * 128 * 2);
constexpr size_t OFF_PU = OFF_LRUT + al256((size_t)2 * 8 * 128 * 64 * 2);
constexpr size_t OFF_PV = OFF_PU + al256((size_t)NEXP * 1024);
constexpr size_t OFF_HBUF = OFF_PV + al256((size_t)NEXP * 1024);
constexpr size_t OFF_PR = OFF_HBUF + al256((size_t)NTOK * 1024 * 2);
constexpr size_t PR_BYTES = (size_t)NTOK * 5376 * 2;
constexpr size_t OFF_BAR = OFF_PR + PR_BYTES;
constexpr size_t OFF_ACUM1 = OFF_BAR + 16384;
constexpr size_t OFF_LRUCS = OFF_ACUM1 + (size_t)NLAT * 512 * 2;
constexpr size_t OFF_LRUHS = OFF_LRUCS + (size_t)32 * ((CTXL + SEQ) / 64) * 128 * 4;
constexpr size_t WS_NEEDED = OFF_LRUHS + (size_t)32 * ((CTXL + SEQ) / 64) * 64 * 4;
#ifndef CPU_EMU
static_assert(WS_NEEDED <= (size_t)512 * 1024 * 1024, "workspace too large");
#endif
constexpr size_t OFF_PROJ = OFF_PR;
constexpr size_t OFF_R2L0 = OFF_PR + (size_t)NTOK * EVC * 2;
constexpr size_t OFF_LORA = OFF_PR + (size_t)NTOK * ODC * 2;
constexpr size_t OFF_Q = OFF_PR;
constexpr size_t OFF_PIDX = OFF_PR + (size_t)NTOK * 2048 * 2;
constexpr size_t OFF_PGATE = OFF_PIDX + (size_t)NTOK * 128 * 4;
static_assert(OFF_PGATE + (size_t)NTOK * 128 * 4 <= OFF_PR + PR_BYTES, "picks");

enum {
  I_X = 0, I_C, I_CTX, I_CCTX, I_MODW, I_MODB, I_NORM1, I_NORM2, I_WQ, I_KEYS, I_PU, I_PV,
  I_EVWIN, I_EVWOUT, I_IBIAS, I_FBIAS, I_MNORM, I_SCONVW, I_SCONVB, I_DTBIAS, I_ALOG, I_DSKIP, I_SNORM,
  I_ODWIN, I_ODWOUT, I_MU, I_W0, I_WUP, I_A0, I_AUP, I_GUP, I_KK, I_KA, I_RK, I_LNW, I_LNB,
  I_LCONVW, I_LCONVB, I_LAM, I_WA, I_BA, I_WI, I_BI, I_FNORM, N_IN
};

struct Params {
  const float* in[N_IN];
  float* out;
  unsigned char* ws;
};

constexpr int SMEM_BYTES = 80 * 1024;
#ifdef CPU_EMU
#define SMEM_DECL static thread_local __attribute__((aligned(16))) unsigned char smem_raw[SMEM_BYTES]
#else
#define SMEM_DECL __shared__ __attribute__((aligned(16))) unsigned char smem_raw[SMEM_BYTES]
#endif

DEV float bf2f(bf16_t v) { unsigned u = ((unsigned)v) << 16; float f; __builtin_memcpy(&f, &u, 4); return f; }
#ifdef CPU_EMU
DEV bf16_t f2bf(float f) { unsigned u; __builtin_memcpy(&u, &f, 4); u += 0x7fffu + ((u >> 16) & 1u); return (bf16_t)(u >> 16); }
DEV unsigned pack2(float a, float b) { return (unsigned)f2bf(a) | ((unsigned)f2bf(b) << 16); }
#else
typedef __attribute__((ext_vector_type(2))) float f32x2_t;
typedef __attribute__((ext_vector_type(2))) __bf16 bf16x2_t;
DEV unsigned pack2(float a, float b) { f32x2_t f = {a, b}; return __builtin_bit_cast(unsigned, __builtin_convertvector(f, bf16x2_t)); }
DEV bf16_t f2bf(float f) { return __builtin_bit_cast(unsigned short, (__bf16)f); }
#endif
DEV void unpack8(const u32x4& r, float* o) {
  unsigned w[4] = {r.x, r.y, r.z, r.w};
#pragma unroll
  for (int i = 0; i < 4; ++i) { unsigned lo = w[i] << 16, hi = w[i] & 0xffff0000u; __builtin_memcpy(&o[2 * i], &lo, 4); __builtin_memcpy(&o[2 * i + 1], &hi, 4); }
}
DEV u32x4 pack8(const float* o) { u32x4 r; r.x = pack2(o[0], o[1]); r.y = pack2(o[2], o[3]); r.z = pack2(o[4], o[5]); r.w = pack2(o[6], o[7]); return r; }
#ifdef CPU_EMU
DEV float fexp(float x) { return expf(x); }
DEV float frcp(float x) { return 1.f / x; }
DEV float flog(float x) { return logf(x); }
DEV float frsq(float x) { return 1.f / sqrtf(x); }
DEV float fsqrt(float x) { return sqrtf(x); }
#else
DEV float fexp(float x) { return __expf(x); }
DEV float frcp(float x) { return __builtin_amdgcn_rcpf(x); }
DEV float flog(float x) { return __logf(x); }
DEV float frsq(float x) { return __builtin_amdgcn_rsqf(x); }
DEV float fsqrt(float x) { return __builtin_amdgcn_sqrtf(x); }
#endif
DEV void ld8(const float* __restrict__ p, float* o) { const f32x4 a = *(const f32x4*)p, b = *(const f32x4*)(p + 4); o[0] = a.x; o[1] = a.y; o[2] = a.z; o[3] = a.w; o[4] = b.x; o[5] = b.y; o[6] = b.z; o[7] = b.w; }
DEV float sigmoidf_(float x) { return frcp(1.f + fexp(-x)); }
DEV float siluf_(float x) { return x * frcp(1.f + fexp(-x)); }
DEV float softplusf_(float x) { return fmaxf(x, 0.f) + flog(1.f + fexp(-fabsf(x))); }
DEV float tanhf_(float x) { return 1.f - 2.f * frcp(1.f + fexp(2.f * x)); }
DEV float geluf_(float x) { return 0.5f * x * (1.f + erff(x * 0.70710678118654752f)); }

DEV f32x16 mfma32(bf16x8 a, bf16x8 b, f32x16 c) {
#ifdef CPU_EMU
  return emu_mfma32(a, b, c);
#else
  return __builtin_amdgcn_mfma_f32_32x32x16_bf16(a, b, c, 0, 0, 0);
#endif
}
DEV float wshfl_xor(float v, int m) {
#ifdef CPU_EMU
  return emu_shfl_xor(v, m);
#else
  return __shfl_xor(v, m, 64);
#endif
}
template <int M> DEV float dpp_xor(float v) {
  static_assert(M == 1 || M == 2 || M == 7 || M == 8, "dpp pattern");
#ifdef CPU_EMU
  return emu_shfl_xor(v, M);
#else
  constexpr int ctrl = M == 1 ? 0xB1 : (M == 2 ? 0x4E : (M == 7 ? 0x141 : 0x128));
  return __int_as_float(__builtin_amdgcn_update_dpp(0, __float_as_int(v), ctrl, 0xf, 0xf, false));
#endif
}
DEV float sum8(float v) { v += dpp_xor<1>(v); v += dpp_xor<2>(v); v += dpp_xor<7>(v); return v; }
DEV float sum4(float v) { v += dpp_xor<1>(v); v += dpp_xor<2>(v); return v; }
DEV float sum16(float v) { v = sum8(v); v += dpp_xor<8>(v); return v; }
DEV float swap32_sum(float a, float b) {
#ifdef CPU_EMU
  float ra = emu_shfl_xor(a, 32), rb = emu_shfl_xor(b, 32);
  return ((threadIdx.x >> 5) & 1) ? b + rb : a + ra;
#else
  auto r = __builtin_amdgcn_permlane32_swap(__float_as_uint(a), __float_as_uint(b), false, false);
  return __uint_as_float(r[0]) + __uint_as_float(r[1]);
#endif
}
DEV float swap16_sum(float a, float b) {
#ifdef CPU_EMU
  float ra = emu_shfl_xor(a, 16), rb = emu_shfl_xor(b, 16);
  return ((threadIdx.x >> 4) & 1) ? b + rb : a + ra;
#else
  auto r = __builtin_amdgcn_permlane16_swap(__float_as_uint(a), __float_as_uint(b), false, false);
  return __uint_as_float(r[0]) + __uint_as_float(r[1]);
#endif
}
DEV float wave_sum(float v) {
  v = sum16(v);
  v = swap16_sum(v, v);
  return swap32_sum(v, v);
}
DEV float wave_incl_scan(float v) {
#ifdef CPU_EMU
  const int l = threadIdx.x & 63;
  for (int s = 1; s < 16; s <<= 1) { const bool ok = (l & 15) >= s; float o = emu_readlane(v, ok ? l - s : l); v += ok ? o : 0.f; }
  { const bool ok = ((l >> 4) & 1) != 0; float o = emu_readlane(v, ok ? (l & ~15) - 1 : l); v += ok ? o : 0.f; }
  { const bool ok = l >= 32; float o = emu_readlane(v, ok ? 31 : l); v += ok ? o : 0.f; }
  return v;
#else
#define DPP_ADD_(ctrl, rmask) v += __int_as_float(__builtin_amdgcn_update_dpp(0, __float_as_int(v), ctrl, rmask, 0xf, false))
  DPP_ADD_(0x111, 0xf); DPP_ADD_(0x112, 0xf); DPP_ADD_(0x114, 0xf); DPP_ADD_(0x118, 0xf);
  DPP_ADD_(0x142, 0xa); DPP_ADD_(0x143, 0xc);
#undef DPP_ADD_
  return v;
#endif
}

#ifdef CPU_EMU
static inline unsigned emu_f2fp8(float f) {
  unsigned sgn = f < 0.f ? 0x80u : 0u; float a = fabsf(f);
  if (!(a == a)) return 0x7f;
  if (a >= 448.f) return sgn | 0x7e;
  if (a < 0.0009765625f) return sgn;
  int e; frexpf(a, &e); e -= 1;
  if (e < -6) { int q = (int)nearbyintf(a * 512.f); return sgn | (unsigned)q; }
  float m = a / ldexpf(1.f, e);
  int q = (int)nearbyintf((m - 1.f) * 8.f);
  if (q == 8) { q = 0; e += 1; }
  if (e > 8) return sgn | 0x7e;
  return sgn | (unsigned)((e + 7) << 3) | (unsigned)q;
}
static inline float emu_fp82f(unsigned c) {
  unsigned sgn = c & 0x80, e = (c >> 3) & 15, m = c & 7;
  float v = e == 0 ? ldexpf((float)m, -9) : ldexpf(1.f + m / 8.f, (int)e - 7);
  return sgn ? -v : v;
}
#endif
DEV unsigned pack4_fp8(float a, float b, float c, float d) {
#ifdef CPU_EMU
  return emu_f2fp8(a) | (emu_f2fp8(b) << 8) | (emu_f2fp8(c) << 16) | (emu_f2fp8(d) << 24);
#else
  int w = 0;
  w = __builtin_amdgcn_cvt_pk_fp8_f32(a, b, w, false);
  w = __builtin_amdgcn_cvt_pk_fp8_f32(c, d, w, true);
  return (unsigned)w;
#endif
}
DEV void unpack4_fp8(unsigned w, float* o) {
#ifdef CPU_EMU
  o[0] = emu_fp82f(w & 255); o[1] = emu_fp82f((w >> 8) & 255); o[2] = emu_fp82f((w >> 16) & 255); o[3] = emu_fp82f(w >> 24);
#else
  typedef __attribute__((ext_vector_type(2))) float f32x2_;
  f32x2_ lo = __builtin_amdgcn_cvt_pk_f32_fp8((int)w, false);
  f32x2_ hi = __builtin_amdgcn_cvt_pk_f32_fp8((int)w, true);
  o[0] = lo.x; o[1] = lo.y; o[2] = hi.x; o[3] = hi.y;
#endif
}
DEV void unpack16_fp8(const u32x4& r, float* o) { unpack4_fp8(r.x, o); unpack4_fp8(r.y, o + 4); unpack4_fp8(r.z, o + 8); unpack4_fp8(r.w, o + 12); }
DEV float wreadlane(float v, int srclane) {
#ifdef CPU_EMU
  return emu_readlane(v, srclane);
#else
  int iv; __builtin_memcpy(&iv, &v, 4);
  int r = __builtin_amdgcn_readlane(iv, srclane);
  float f; __builtin_memcpy(&f, &r, 4); return f;
#endif
}
constexpr float PEER_USCALE = 64.f, PEER_VSCALE = 4.f;
#ifdef CPU_EMU
static inline unsigned emu_f2fp4(float f) {
  static const float lv[8] = {0.f, 0.5f, 1.f, 1.5f, 2.f, 3.f, 4.f, 6.f};
  unsigned sgn = f < 0.f ? 8u : 0u; float a = fabsf(f);
  int best = 0; float bd = 1e30f;
  for (int i = 0; i < 8; ++i) { float dd = fabsf(a - lv[i]); if (dd < bd || (dd == bd && (i & 1) == 0)) { bd = dd; best = i; } }
  return sgn | (unsigned)best;
}
static inline float emu_fp42f(unsigned c) {
  static const float lv[8] = {0.f, 0.5f, 1.f, 1.5f, 2.f, 3.f, 4.f, 6.f};
  float v = lv[c & 7]; return (c & 8) ? -v : v;
}
#endif
DEV unsigned pack8_fp4(const float* v) {
#ifdef CPU_EMU
  unsigned w = 0;
  for (int i = 0; i < 8; ++i) w |= emu_f2fp4(v[i]) << (4 * i);
  return w;
#else
  unsigned w = 0;
  w = __builtin_amdgcn_cvt_scalef32_pk_fp4_f32(w, v[0], v[1], 1.0f, 0);
  w = __builtin_amdgcn_cvt_scalef32_pk_fp4_f32(w, v[2], v[3], 1.0f, 1);
  w = __builtin_amdgcn_cvt_scalef32_pk_fp4_f32(w, v[4], v[5], 1.0f, 2);
  w = __builtin_amdgcn_cvt_scalef32_pk_fp4_f32(w, v[6], v[7], 1.0f, 3);
  return w;
#endif
}
DEV void unpack8_fp4(unsigned w, float* o) {
#ifdef CPU_EMU
  for (int i = 0; i < 8; ++i) o[i] = emu_fp42f((w >> (4 * i)) & 15u);
#else
  typedef __attribute__((ext_vector_type(2))) float f32x2_;
  f32x2_ a = __builtin_amdgcn_cvt_scalef32_pk_f32_fp4(w, 1.0f, 0);
  f32x2_ b = __builtin_amdgcn_cvt_scalef32_pk_f32_fp4(w, 1.0f, 1);
  f32x2_ c = __builtin_amdgcn_cvt_scalef32_pk_f32_fp4(w, 1.0f, 2);
  f32x2_ d = __builtin_amdgcn_cvt_scalef32_pk_f32_fp4(w, 1.0f, 3);
  o[0] = a.x; o[1] = a.y; o[2] = b.x; o[3] = b.y; o[4] = c.x; o[5] = c.y; o[6] = d.x; o[7] = d.y;
#endif
}
typedef __attribute__((ext_vector_type(3))) unsigned u32x3;
#ifndef FP6_INTERLEAVED
#define FP6_INTERLEAVED 1
#endif
#ifdef CPU_EMU
static inline unsigned emu_f2fp6(float f) {
  unsigned sgn = f < 0.f ? 32u : 0u; float a = fabsf(f);
  if (a >= 7.5f) return sgn | 31u;
  int e; unsigned code;
  if (a < 1.f) { int q = (int)nearbyintf(a * 8.f); code = (unsigned)q; }
  else { frexpf(a, &e); e -= 1; float m = a / ldexpf(1.f, e); int q = (int)nearbyintf((m - 1.f) * 8.f); if (q == 8) { q = 0; e += 1; } code = (unsigned)(((e + 1) << 3) | q); if (e > 2) code = 31u; }
  return sgn | code;
}
static inline float emu_fp62f(unsigned c) {
  unsigned e = (c >> 3) & 3, m = c & 7;
  float v = e == 0 ? m * 0.125f : ldexpf(1.f + m / 8.f, (int)e - 1);
  return (c & 32) ? -v : v;
}
#endif
DEV u32x3 pack16_fp6(const float* v) {
#ifdef CPU_EMU
  unsigned long long lo = 0; unsigned hi = 0;
  for (int i = 0; i < 16; ++i) {
    unsigned long long c = emu_f2fp6(v[i]); int bit = 6 * i;
    if (bit < 64) { lo |= c << bit; if (bit > 58) hi |= (unsigned)(c >> (64 - bit)); } else hi |= (unsigned)(c << (bit - 64));
  }
  u32x3 r; r.x = (unsigned)lo; r.y = (unsigned)(lo >> 32); r.z = hi; return r;
#else
  typedef __attribute__((ext_vector_type(6))) unsigned u32x6_;
  f32x16 a, b;
#if FP6_INTERLEAVED
#pragma unroll
  for (int i = 0; i < 8; ++i) { a[i] = v[2 * i]; b[i] = v[2 * i + 1]; a[8 + i] = 0.f; b[8 + i] = 0.f; }
#else
#pragma unroll
  for (int i = 0; i < 16; ++i) { a[i] = v[i]; b[i] = 0.f; }
#endif
  u32x6_ w = __builtin_amdgcn_cvt_scalef32_2xpk16_fp6_f32(a, b, 1.0f);
  u32x3 r; r.x = w[0]; r.y = w[1]; r.z = w[2]; return r;
#endif
}
DEV void unpack16_fp6(const u32x3& r, float* o) {
#ifdef CPU_EMU
  unsigned long long lo = (unsigned long long)r.x | ((unsigned long long)r.y << 32); unsigned hi = r.z;
  for (int i = 0; i < 16; ++i) {
    int bit = 6 * i; unsigned c;
    if (bit + 6 <= 64) c = (unsigned)(lo >> bit) & 63u;
    else if (bit >= 64) c = (hi >> (bit - 64)) & 63u;
    else c = ((unsigned)(lo >> bit) | (hi << (64 - bit))) & 63u;
    o[i] = emu_fp62f(c);
  }
#else
  typedef __attribute__((ext_vector_type(6))) unsigned u32x6_;
  typedef __attribute__((ext_vector_type(32))) float f32x32_;
  u32x6_ w; w[0] = r.x; w[1] = r.y; w[2] = r.z; w[3] = 0u; w[4] = 0u; w[5] = 0u;
  f32x32_ f = __builtin_amdgcn_cvt_scalef32_pk32_f32_fp6(w, 1.0f);
#pragma unroll
  for (int i = 0; i < 16; ++i) o[i] = f[i];
#endif
}
DEV void unpack2x16_fp6(const u32x3& ra, const u32x3& rb, float* oa, float* ob) {
#ifdef CPU_EMU
  unpack16_fp6(ra, oa); unpack16_fp6(rb, ob);
#else
  typedef __attribute__((ext_vector_type(6))) unsigned u32x6_;
  typedef __attribute__((ext_vector_type(32))) float f32x32_;
  u32x6_ w; w[0] = ra.x; w[1] = ra.y; w[2] = ra.z; w[3] = rb.x; w[4] = rb.y; w[5] = rb.z;
  f32x32_ f = __builtin_amdgcn_cvt_scalef32_pk32_f32_fp6(w, 1.0f);
#pragma unroll
  for (int i = 0; i < 16; ++i) { oa[i] = f[i]; ob[i] = f[16 + i]; }
#endif
}
constexpr int PEER_ROWB = 1280;
constexpr int PEER_VOFF = 768;


DEV int acc_row(int reg, int lane) { return (reg & 3) + 8 * (reg >> 2) + 4 * (lane >> 5); }

DEV int mod_row(int row) { return row < NCTX ? 2 : (row - NCTX) / SEQ; }

template <bool SYNC_EPI, class Epi, bool VEC4 = false>
DEV void gemm_tile_128(const bf16_t* __restrict__ A, int lda, int M, const bf16_t* __restrict__ Bt, int ldb, int N,
                       int K, int m0, int n0, const Epi& epi, unsigned char* smem) {
  constexpr int LS = 72;
  constexpr int STAGE = 2 * 128 * LS;
  bf16_t* sbase = (bf16_t*)smem;
  const int wave = threadIdx.x >> 6;
  const int wm = (wave >> 1) * 64, wn = (wave & 1) * 64;
  f32x16 acc[2][2];
#pragma unroll
  for (int i = 0; i < 2; ++i)
#pragma unroll
    for (int j = 0; j < 2; ++j)
#pragma unroll
      for (int r = 0; r < 16; ++r) acc[i][j][r] = 0.f;
  u32x4 ra[4], rb[4];
  auto gload = [&](int k0) {
    int tl_ = threadIdx.x; OPAQUE(tl_);
#pragma unroll
    for (int i = 0; i < 4; ++i) {
      int c = tl_ + i * 256, r = c >> 3, cc = (c & 7) * 8;
      int gr = m0 + r, gn = n0 + r;
      gr = gr < M ? gr : M - 1; gn = gn < N ? gn : N - 1;
      ra[i] = *(const u32x4*)(A + (size_t)gr * lda + k0 + cc);
      rb[i] = *(const u32x4*)(Bt + (size_t)gn * ldb + k0 + cc);
    }
  };
  auto lwrite = [&](int buf) {
    int tl_ = threadIdx.x; OPAQUE(tl_);
    bf16_t* sA = sbase + buf * STAGE;
    bf16_t* sB = sA + 128 * LS;
#pragma unroll
    for (int i = 0; i < 4; ++i) {
      int c = tl_ + i * 256, r = c >> 3, cc = (c & 7) * 8;
      *(u32x4*)(sA + r * LS + cc) = ra[i];
      *(u32x4*)(sB + r * LS + cc) = rb[i];
    }
  };
  const int nk = K >> 6;
  gload(0);
  __syncthreads();
  lwrite(0);
  if (nk > 1) gload(64);
  __syncthreads();
  for (int it = 0; it < nk; ++it) {
    int tl_ = threadIdx.x; OPAQUE(tl_);
    const int lane = tl_ & 63;
    const bf16_t* sA = sbase + (it & 1) * STAGE;
    const bf16_t* sB = sA + 128 * LS;
#pragma unroll
    for (int kk = 0; kk < 4; ++kk) {
      bf16x8 a[2], b[2];
      const int ko = kk * 16 + 8 * (lane >> 5);
#pragma unroll
      for (int i = 0; i < 2; ++i) a[i] = *(const bf16x8*)(sA + (wm + i * 32 + (lane & 31)) * LS + ko);
#pragma unroll
      for (int j = 0; j < 2; ++j) b[j] = *(const bf16x8*)(sB + (wn + j * 32 + (lane & 31)) * LS + ko);
#pragma unroll
      for (int i = 0; i < 2; ++i)
#pragma unroll
        for (int j = 0; j < 2; ++j) acc[i][j] = mfma32(a[i], b[j], acc[i][j]);
      if (kk == 1) {
        if (it + 1 < nk) lwrite((it + 1) & 1);
        if (it + 2 < nk) gload((it + 2) * 64);
      }
    }
    __syncthreads();
  }
  {
    int tl_ = threadIdx.x; OPAQUE(tl_);
    const int lane = tl_ & 63;
    if constexpr (VEC4) {
#pragma unroll
      for (int i = 0; i < 2; ++i)
#pragma unroll
        for (int j = 0; j < 2; ++j)
#pragma unroll
          for (int gq = 0; gq < 4; ++gq) {
            int row = m0 + wm + i * 32 + 8 * gq + 4 * (lane >> 5);
            int col = n0 + wn + j * 32 + (lane & 31);
            if (row < M && col < N) epi.store4(row, col, acc[i][j][4 * gq], acc[i][j][4 * gq + 1], acc[i][j][4 * gq + 2], acc[i][j][4 * gq + 3]);
          }
    } else {
#pragma unroll
      for (int i = 0; i < 2; ++i)
#pragma unroll
        for (int j = 0; j < 2; ++j)
#pragma unroll
          for (int r = 0; r < 16; ++r) {
            int row = m0 + wm + i * 32 + acc_row(r, lane);
            int col = n0 + wn + j * 32 + (lane & 31);
            if (row < M && col < N) epi(row, col, acc[i][j][r]);
          }
    }
  }
}

template <class Epi, bool VEC4 = false>
DEV void gemm_tile_128x256(const bf16_t* __restrict__ A, int lda, int M, const bf16_t* __restrict__ Bt, int ldb, int N,
                           int K, int m0, int n0, const Epi& epi, unsigned char* smem) {
  constexpr int LS = 72;
  bf16_t* sA = (bf16_t*)smem;
  bf16_t* sB = sA + 128 * LS;
  const int wave = threadIdx.x >> 6;
  const int wm = (wave >> 1) * 64, wn = (wave & 1) * 128;
  f32x16 acc[2][4];
#pragma unroll
  for (int i = 0; i < 2; ++i)
#pragma unroll
    for (int j = 0; j < 4; ++j)
#pragma unroll
      for (int r = 0; r < 16; ++r) acc[i][j][r] = 0.f;
  u32x4 ra[4], rb[8];
  {
    const int tid = threadIdx.x;
#pragma unroll
    for (int i = 0; i < 4; ++i) {
      int c = tid + i * 256, r = c >> 3, cc = (c & 7) * 8;
      { int gr = m0 + r; gr = gr < M ? gr : M - 1; ra[i] = *(const u32x4*)(A + (size_t)gr * lda + cc); }
    }
#pragma unroll
    for (int i = 0; i < 8; ++i) {
      int c = tid + i * 256, r = c >> 3, cc = (c & 7) * 8;
      { int gn = n0 + r; gn = gn < N ? gn : N - 1; rb[i] = *(const u32x4*)(Bt + (size_t)gn * ldb + cc); }
    }
  }
  for (int k0 = 0; k0 < K; k0 += 64) {
    int tl_ = threadIdx.x; OPAQUE(tl_);
    const int tid = tl_, lane = tl_ & 63;
    __syncthreads();
#pragma unroll
    for (int i = 0; i < 4; ++i) { int c = tid + i * 256, r = c >> 3, cc = (c & 7) * 8; *(u32x4*)(sA + r * LS + cc) = ra[i]; }
#pragma unroll
    for (int i = 0; i < 8; ++i) { int c = tid + i * 256, r = c >> 3, cc = (c & 7) * 8; *(u32x4*)(sB + r * LS + cc) = rb[i]; }
    __syncthreads();
    if (k0 + 64 < K) {
#pragma unroll
      for (int i = 0; i < 4; ++i) {
        int c = tid + i * 256, r = c >> 3, cc = (c & 7) * 8;
        { int gr = m0 + r; gr = gr < M ? gr : M - 1; ra[i] = *(const u32x4*)(A + (size_t)gr * lda + k0 + 64 + cc); }
      }
#pragma unroll
      for (int i = 0; i < 8; ++i) {
        int c = tid + i * 256, r = c >> 3, cc = (c & 7) * 8;
        { int gn = n0 + r; gn = gn < N ? gn : N - 1; rb[i] = *(const u32x4*)(Bt + (size_t)gn * ldb + k0 + 64 + cc); }
      }
    }
#pragma unroll 2
    for (int kk = 0; kk < 4; ++kk) {
      bf16x8 a[2], b[4];
      const int ko = kk * 16 + 8 * (lane >> 5);
#pragma unroll
      for (int i = 0; i < 2; ++i) a[i] = *(const bf16x8*)(sA + (wm + i * 32 + (lane & 31)) * LS + ko);
#pragma unroll
      for (int j = 0; j < 4; ++j) b[j] = *(const bf16x8*)(sB + (wn + j * 32 + (lane & 31)) * LS + ko);
#pragma unroll
      for (int i = 0; i < 2; ++i)
#pragma unroll
        for (int j = 0; j < 4; ++j) acc[i][j] = mfma32(a[i], b[j], acc[i][j]);
    }
  }
  {
    int tl_ = threadIdx.x; OPAQUE(tl_);
    const int lane = tl_ & 63;
    if constexpr (VEC4) {
#pragma unroll
      for (int i = 0; i < 2; ++i)
#pragma unroll
        for (int j = 0; j < 4; ++j)
#pragma unroll
          for (int gq = 0; gq < 4; ++gq) {
            int row = m0 + wm + i * 32 + 8 * gq + 4 * (lane >> 5);
            int col = n0 + wn + j * 32 + (lane & 31);
            if (row < M && col < N) epi.store4(row, col, acc[i][j][4 * gq], acc[i][j][4 * gq + 1], acc[i][j][4 * gq + 2], acc[i][j][4 * gq + 3]);
          }
    } else {
#pragma unroll
      for (int i = 0; i < 2; ++i)
#pragma unroll
        for (int j = 0; j < 4; ++j)
#pragma unroll
          for (int r = 0; r < 16; ++r) {
            int row = m0 + wm + i * 32 + acc_row(r, lane);
            int col = n0 + wn + j * 32 + (lane & 31);
            if (row < M && col < N) epi(row, col, acc[i][j][r]);
          }
    }
  }
}

DEV void transpose_tile(const float* __restrict__ src, int ld_src, bf16_t* __restrict__ dst, int ld_dst, int K, int N,
                        int tk, int tn, unsigned char* smem) {
  float* sT = (float*)smem;
  const int tid = threadIdx.x;
  __syncthreads();
  {
    const int tx = tid & 15, ty = tid >> 4;
#pragma unroll
    for (int p = 0; p < 4; ++p) {
      int k = tk * 64 + ty + p * 16, n = tn * 64 + tx * 4;
      f32x4 v4 = {0.f, 0.f, 0.f, 0.f};
      if (k < K && n < N) v4 = *(const f32x4*)(src + (size_t)k * ld_src + n);
      float* d = sT + (ty + p * 16) * 65 + tx * 4;
      d[0] = v4.x; d[1] = v4.y; d[2] = v4.z; d[3] = v4.w;
    }
  }
  __syncthreads();
  {
    const int n = tid >> 2, kseg = (tid & 3) * 16;
    int gn = tn * 64 + n;
    if (gn < N) {
      float v[16];
#pragma unroll
      for (int j = 0; j < 16; ++j) v[j] = sT[(kseg + j) * 65 + n];
      bf16_t* d = dst + (size_t)gn * ld_dst + tk * 64 + kseg;
      *(u32x4*)d = pack8(v);
      *(u32x4*)(d + 8) = pack8(v + 8);
    }
  }
}

constexpr int TJ0 = 16 * 49, TJ1 = 16 * 16, TJ2 = 16 * 44, TJ3 = 16 * 16, TJ4 = 2 * 16 * 32, TJ5 = 2 * 8, TJ6 = 2 * 8,
              TJ7 = 2 * 8, TJ8 = 32;
constexpr int NTRANS = TJ0 + TJ1 + TJ2 + TJ3 + TJ4 + TJ5 + TJ6 + TJ7 + TJ8;
constexpr int NKEYCV = (2 * 8 * 2 * 128 * 128) / (256 * 8);
constexpr int NMODV = 2 * 96;
constexpr int NPREP = NTRANS + NKEYCV + NMODV;

DEV void st_prep(const Params& P, int item, unsigned char* smem) {
  unsigned char* ws = P.ws;
  if (item < NTRANS) {
    int t = item;
    if (t < TJ0) { transpose_tile(P.in[I_EVWIN], EVC, (bf16_t*)(ws + OFF_WEVIN), 1024, 1024, EVC, t / 49, t % 49, smem); return; }
    t -= TJ0;
    if (t < TJ1) { transpose_tile(P.in[I_EVWOUT], 1024, (bf16_t*)(ws + OFF_WEVOUT), 1024, 1024, 1024, t / 16, t % 16, smem); return; }
    t -= TJ1;
    if (t < TJ2) { transpose_tile(P.in[I_ODWIN], ODC, (bf16_t*)(ws + OFF_WODIN), 1024, 1024, ODC, t / 44, t % 44, smem); return; }
    t -= TJ2;
    if (t < TJ3) { transpose_tile(P.in[I_ODWOUT], 1024, (bf16_t*)(ws + OFF_WODOUT), 1024, 1024, 1024, t / 16, t % 16, smem); return; }
    t -= TJ3;
    if (t < TJ4) {
      int l = t / 512, tt = t % 512;
      transpose_tile(P.in[I_WQ] + (size_t)l * 1024 * 2048, 2048, (bf16_t*)(ws + OFF_WQ) + (size_t)l * 2048 * 1024, 1024, 1024, 2048, tt / 32, tt % 32, smem);
      return;
    }
    t -= TJ4;
    if (t < TJ5) { int d = t / 8; transpose_tile(P.in[I_WUP] + d * 64 * 512, 512, (bf16_t*)(ws + OFF_WUP) + d * 512 * 64, 64, 64, 512, 0, t % 8, smem); return; }
    t -= TJ5;
    if (t < TJ6) { int d = t / 8; transpose_tile(P.in[I_AUP] + d * 64 * 512, 512, (bf16_t*)(ws + OFF_AUP) + d * 512 * 64, 64, 64, 512, 0, t % 8, smem); return; }
    t -= TJ6;
    if (t < TJ7) { transpose_tile(P.in[I_GUP], 512, (bf16_t*)(ws + OFF_GUP), 128, 128, 512, t / 8, t % 8, smem); return; }
    t -= TJ7;
    {
      int which = t & 1, db = t >> 1;
      const float* src = (which ? P.in[I_WI] : P.in[I_WA]) + (size_t)db * 64 * 64;
      transpose_tile(src, 64, (bf16_t*)(ws + OFF_LRUT) + (size_t)db * 128 * 64 + which * 64 * 64, 64, 64, 64, 0, 0, smem);
      return;
    }
  }
  item -= NTRANS;
  if (item < NKEYCV) {
    size_t e = ((size_t)item * 256 + threadIdx.x) * 8;
    const float* s = P.in[I_KEYS] + e;
    f32x4 a = *(const f32x4*)s, b = *(const f32x4*)(s + 4);
    float v[8] = {a.x, a.y, a.z, a.w, b.x, b.y, b.z, b.w};
    *(u32x4*)((bf16_t*)(ws + OFF_KEYS) + e) = pack8(v);
    return;
  }
  item -= NKEYCV;
  {
    const int l = item / 96, cgp = item % 96;
    float* sS = (float*)smem;
    float* sRed = sS + 3 * 1024;
    const int tid = threadIdx.x;
    __syncthreads();
    for (int i = tid; i < 3 * 1024; i += 256) {
      int m = i >> 10, k = i & 1023;
      float c = m < 2 ? P.in[I_C][m * 1024 + k] : P.in[I_CCTX][k];
      sS[i] = siluf_(c);
    }
    __syncthreads();
    const int ks = tid >> 6, col = cgp * 64 + (tid & 63);
    const float* w = P.in[I_MODW] + (size_t)l * 1024 * 6144 + col;
    float a0 = 0.f, a1 = 0.f, a2 = 0.f;
    for (int k = ks * 256; k < ks * 256 + 256; ++k) {
      float wv = w[(size_t)k * 6144];
      a0 += sS[k] * wv; a1 += sS[1024 + k] * wv; a2 += sS[2048 + k] * wv;
    }
    sRed[(ks * 3 + 0) * 64 + (tid & 63)] = a0;
    sRed[(ks * 3 + 1) * 64 + (tid & 63)] = a1;
    sRed[(ks * 3 + 2) * 64 + (tid & 63)] = a2;
    __syncthreads();
    if (tid < 192) {
      int m = tid >> 6, c = tid & 63;
      float s = sRed[(0 * 3 + m) * 64 + c] + sRed[(1 * 3 + m) * 64 + c] + sRed[(2 * 3 + m) * 64 + c] + sRed[(3 * 3 + m) * 64 + c];
      int cc = cgp * 64 + c;
      ((float*)(ws + OFF_MODV))[((size_t)l * 3 + m) * 6144 + cc] = s + P.in[I_MODB][l * 6144 + cc];
    }
  }
}

constexpr int NPCONV = 2 * (NEXP * 1024 / (256 * 16));
DEV void st_peer_conv(const Params& P, int layer, int item) {
  const int half = NPCONV / 2;
  int which = item >= half;
  int it = which ? item - half : item;
  size_t e = ((size_t)it * 256 + threadIdx.x) * 16;
  const float* s = (which ? P.in[I_PV] : P.in[I_PU]) + (size_t)layer * NEXP * 1024 + e;
  const float sc = which ? PEER_VSCALE : PEER_USCALE;
  float v16[16];
#pragma unroll
  for (int q = 0; q < 4; ++q) {
    f32x4 a = *(const f32x4*)(s + 4 * q);
    v16[4 * q] = a.x * sc; v16[4 * q + 1] = a.y * sc; v16[4 * q + 2] = a.z * sc; v16[4 * q + 3] = a.w * sc;
  }
  const size_t ex = e >> 10, col = e & 1023;
  if (which) {
    u32x2 o; o.x = pack8_fp4(v16); o.y = pack8_fp4(v16 + 8);
    *(u32x2*)(P.ws + OFF_PU + ex * PEER_ROWB + PEER_VOFF + (col >> 1)) = o;
  } else {
    u32x3 o = pack16_fp6(v16);
    unsigned* dp = (unsigned*)(P.ws + OFF_PU + ex * PEER_ROWB + (col >> 4) * 12);
    dp[0] = o.x; dp[1] = o.y; dp[2] = o.z;
  }
}

DEV void st_normmod(const Params& P, int layer, int which, int row) {
  const int lane = threadIdx.x & 63;
  const float* src;
  if (which == 0 && layer == 0) src = row < NCTX ? P.in[I_CTX] + (size_t)row * 1024 : P.in[I_X] + (size_t)(row - NCTX) * 1024;
  else src = row < NCTX ? (const float*)(P.ws + OFF_CTXRES) + (size_t)row * 1024 : P.out + (size_t)(row - NCTX) * 1024;
  const float* mv = (const float*)(P.ws + OFF_MODV) + ((size_t)layer * 3 + mod_row(row)) * 6144;
  const float* sh = mv + (which ? 3 : 0) * 1024;
  const float* sc = mv + (which ? 4 : 1) * 1024;
  const float* nw = (which ? P.in[I_NORM2] : P.in[I_NORM1]) + layer * 1024;
  f32x4 v[4];
  float ss = 0.f;
#pragma unroll
  for (int i = 0; i < 4; ++i) {
    v[i] = *(const f32x4*)(src + i * 256 + lane * 4);
    ss += v[i].x * v[i].x + v[i].y * v[i].y + v[i].z * v[i].z + v[i].w * v[i].w;
  }
  ss = wave_sum(ss);
  const float rstd = frsq(ss * (1.f / 1024.f) + 1e-6f);
  bf16_t* dst = (bf16_t*)(P.ws + OFF_HBUF) + (size_t)row * 1024;
#pragma unroll
  for (int i = 0; i < 4; ++i) {
    int c = i * 256 + lane * 4;
    f32x4 w4 = *(const f32x4*)(nw + c), s4 = *(const f32x4*)(sc + c), h4 = *(const f32x4*)(sh + c);
    float o0 = v[i].x * rstd * w4.x * (1.f + s4.x) + h4.x;
    float o1 = v[i].y * rstd * w4.y * (1.f + s4.y) + h4.y;
    float o2 = v[i].z * rstd * w4.z * (1.f + s4.z) + h4.z;
    float o3 = v[i].w * rstd * w4.w * (1.f + s4.w) + h4.w;
    u32x2 pk; pk.x = pack2(o0, o1); pk.y = pack2(o2, o3);
    *(u32x2*)(dst + c) = pk;
  }
}

struct EpiProjL0 {
  bf16_t* proj; float* gates;
  DEVM void operator()(int row, int col, float v) const {
    proj[(size_t)row * EVC + col] = f2bf(v);
    if (col >= 1536 && col < 1552) gates[row * 32 + (col - 1536)] = v;
    else if (col >= 3088) gates[row * 32 + 16 + (col - 3088)] = v;
  }
};
struct EpiStoreBf {
  bf16_t* dst; int ld;
  DEVM void operator()(int row, int col, float v) const { dst[(size_t)row * ld + col] = f2bf(v); }
};
struct EpiStoreBfBias {
  bf16_t* dst; int ld; const float* bias;
  DEVM void operator()(int row, int col, float v) const { dst[(size_t)row * ld + col] = f2bf(v + (bias ? bias[col] : 0.f)); }
};
struct EpiProjL0T {
  bf16_t* proj; float* gates;
  DEVM void operator()(int, int, float) const {}
  DEVM void store4(int n, int m, float v0, float v1, float v2, float v3) const {
    u32x2 pk; pk.x = pack2(v0, v1); pk.y = pack2(v2, v3);
    *(u32x2*)(proj + (size_t)m * EVC + n) = pk;
    if (n >= 1536 && n < 1552) { f32x4 g = {v0, v1, v2, v3}; *(f32x4*)(gates + m * 32 + (n - 1536)) = g; }
    else if (n >= 3088) { f32x4 g = {v0, v1, v2, v3}; *(f32x4*)(gates + m * 32 + 16 + (n - 3088)) = g; }
  }
};
struct EpiStoreBfT {
  bf16_t* dst; int ld;
  DEVM void operator()(int, int, float) const {}
  DEVM void store4(int n, int m, float v0, float v1, float v2, float v3) const {
    u32x2 pk; pk.x = pack2(v0, v1); pk.y = pack2(v2, v3);
    *(u32x2*)(dst + (size_t)m * ld + n) = pk;
  }
};
struct EpiOutProjT {
  const float* x_lat; const float* x_ctx; float* o_lat; float* o_ctx; const float* modv;
  DEVM void operator()(int, int, float) const {}
  DEVM void store4(int n, int m, float v0, float v1, float v2, float v3) const {
    const f32x4 g = *(const f32x4*)(modv + mod_row(m) * 6144 + 2 * 1024 + n);
    const float* xs; float* od;
    if (m < NCTX) { xs = x_ctx + (size_t)m * 1024 + n; od = o_ctx + (size_t)m * 1024 + n; }
    else { size_t o = (size_t)(m - NCTX) * 1024 + n; xs = x_lat + o; od = o_lat + o; }
    const f32x4 x = *(const f32x4*)xs;
    f32x4 r = {x.x + g.x * v0, x.y + g.y * v1, x.z + g.z * v2, x.w + g.w * v3};
    *(f32x4*)od = r;
  }
};
struct EpiStoreBfBiasT {
  bf16_t* dst; int ld; const float* bias; int mode;
  DEVM void operator()(int, int, float) const {}
  DEVM void store4(int n, int m, float v0, float v1, float v2, float v3) const {
    if (bias) { v0 += bias[n]; v1 += bias[n + 1]; v2 += bias[n + 2]; v3 += bias[n + 3]; }
    if (mode) {
      const float sc = mode == 1 ? -0.6065306597126334f : 1.f;
      v0 = sc * sigmoidf_(v0); v1 = sc * sigmoidf_(v1); v2 = sc * sigmoidf_(v2); v3 = sc * sigmoidf_(v3);
    }
    u32x2 pk; pk.x = pack2(v0, v1); pk.y = pack2(v2, v3);
    *(u32x2*)(dst + (size_t)m * ld + n) = pk;
  }
};
struct EpiOutProj {
  const float* x_lat; const float* x_ctx; float* o_lat; float* o_ctx; const float* modv;
  DEVM void operator()(int row, int col, float v) const {
    float g = modv[mod_row(row) * 6144 + 2 * 1024 + col];
    if (row < NCTX) o_ctx[(size_t)row * 1024 + col] = x_ctx[(size_t)row * 1024 + col] + g * v;
    else { size_t o = (size_t)(row - NCTX) * 1024 + col; o_lat[o] = x_lat[o] + g * v; }
  }
};
struct EpiScoreLds {
  float* sS; int m0;
  DEVM void operator()(int row, int col, float v) const { sS[(row - m0) * 129 + col] = v; }
};

DEV void st_xbc_conv(const Params& P, int row) {
  const int lane = threadIdx.x & 63;
  const bf16_t* proj = (const bf16_t*)(P.ws + OFF_PROJ);
  bf16_t* xc = (bf16_t*)P.out + (size_t)row * 1024;
  int row0, len, pos;
  if (row < NCTX) { row0 = (row / CTXL) * CTXL; len = CTXL; pos = row - row0; }
  else { int r = row - NCTX; row0 = NCTX + (r / SEQ) * SEQ; len = SEQ; pos = r % SEQ; }
  const float* cw = P.in[I_SCONVW];
  const float* cb = P.in[I_SCONVB];
#pragma unroll
  for (int hh = 0; hh < 2; ++hh) {
    const int ch = hh * 512 + lane * 8;
    float o[8];
#pragma unroll
    for (int j = 0; j < 8; ++j) o[j] = cb[ch + j];
#pragma unroll
    for (int tap = 0; tap < 4; ++tap) {
      int pp = pos + tap - 2;
      if (pp >= 0 && pp < len) {
        float x[8];
        unpack8(*(const u32x4*)(proj + (size_t)(row0 + pp) * EVC + 2064 + ch), x);
        f32x4 w0 = *(const f32x4*)(cw + tap * 1024 + ch), w1 = *(const f32x4*)(cw + tap * 1024 + ch + 4);
        o[0] += w0.x * x[0]; o[1] += w0.y * x[1]; o[2] += w0.z * x[2]; o[3] += w0.w * x[3];
        o[4] += w1.x * x[4]; o[5] += w1.y * x[5]; o[6] += w1.z * x[6]; o[7] += w1.w * x[7];
      }
    }
#pragma unroll
    for (int j = 0; j < 8; ++j) o[j] = siluf_(o[j]);
    *(u32x4*)(xc + ch) = pack8(o);
  }
}

#ifndef LA_NSEG
#define LA_NSEG 10
#endif
constexpr int LA_NCH = (CTXL + SEQ) / 64;
constexpr int LA_CPS = LA_NCH / LA_NSEG;
static_assert(LA_NCH % LA_NSEG == 0, "linattn segments");
#ifdef CPU_EMU
constexpr size_t OFF_LASEG = OFF_PR + PR_BYTES;
#else
constexpr size_t OFF_LASEG = OFF_R2L0 + (size_t)NTOK * 1024 * 2;
#endif
constexpr size_t LASEG_U = (size_t)48 * LA_NSEG * 8192 * 4;
constexpr size_t OFF_LASEG_N = OFF_LASEG + LASEG_U;
constexpr size_t OFF_LASEG_D = OFF_LASEG_N + (size_t)48 * LA_NSEG * 64 * 4;
#ifndef CPU_EMU
static_assert(OFF_LASEG_D + 48 * LA_NSEG * 4 <= OFF_PR + PR_BYTES, "laseg");
#endif

DEV int swz64(int row) { return ((row >> 3) & 7) << 3; }
DEV int swz32(int row) { return ((row >> 3) & 3) << 3; }
struct LaRaw { u32x4 q[2], k[4], x[4]; float g0, g1; };

template <bool MLSTM, bool FULL>
DEV void la_load_raw(const Params& P, int b, int h, int d, int cc, LaRaw& R) {
  constexpr int NC_CTX = CTXL / 64;
  const int tid = threadIdx.x;
  const int seg = cc >= NC_CTX;
  const int row0 = seg ? NCTX + b * SEQ : b * CTXL;
  const int len = seg ? SEQ : CTXL;
  const int cl = (seg ? cc - NC_CTX : cc) * 64;
  const bf16_t* proj = (const bf16_t*)(P.ws + OFF_PROJ);
  const bf16_t* xcv = (const bf16_t*)P.out;
  const float* gates = (const float*)(P.ws + OFF_GATES);
  if (tid < 64) {
    int p = cl + tid, grow = row0 + (d ? len - 1 - p : p);
    if (MLSTM) { R.g0 = gates[grow * 32 + d * 4 + h]; R.g1 = gates[grow * 32 + 8 + d * 4 + h]; }
    else { R.g0 = gates[grow * 32 + 16 + d * 8 + h]; R.g1 = 0.f; }
  }
  if (MLSTM) {
#pragma unroll
    for (int i = 0; i < 2; ++i) {
      int c = tid + i * 256, r = c >> 3, cc8 = (c & 7) * 8;
      int p = cl + r, pos = d ? len - 1 - p : p;
      const bf16_t* rp = proj + (size_t)(row0 + pos) * EVC;
      if (FULL) R.q[i] = *(const u32x4*)(rp + h * 64 + cc8);
      R.k[i] = *(const u32x4*)(rp + 256 + h * 64 + cc8);
    }
#pragma unroll
    for (int i = 0; i < 4; ++i) {
      int c = tid + i * 256, r = c >> 4, cc8 = (c & 15) * 8;
      int p = cl + r, pos = d ? len - 1 - p : p;
      R.x[i] = *(const u32x4*)(proj + (size_t)(row0 + pos) * EVC + 512 + h * 128 + cc8);
    }
  } else {
    const int grp = h >> 2;
#pragma unroll
    for (int i = 0; i < 2; ++i) {
      int c = tid + i * 256, r = c >> 3, cc8 = (c & 7) * 8;
      int p = cl + r, pos = d ? len - 1 - p : p;
      R.x[i] = *(const u32x4*)(xcv + (size_t)(row0 + pos) * 1024 + h * 64 + cc8);
    }
#pragma unroll
    for (int i = 0; i < 4; ++i) {
      int c = tid + i * 256, r = c >> 4, cc8 = (c & 15) * 8;
      int p = cl + r, pos = d ? len - 1 - p : p;
      const bf16_t* rp = xcv + (size_t)(row0 + pos) * 1024;
      R.k[i] = *(const u32x4*)(rp + 512 + grp * 128 + cc8);
      if (FULL) { if (i < 2) R.q[i] = *(const u32x4*)(rp + 768 + grp * 128 + cc8); else R.x[i] = *(const u32x4*)(rp + 768 + grp * 128 + cc8); }
    }
  }
}

template <bool MLSTM, bool FULL>
DEV void st_linattn_seg(const Params& P, int sid, int seg, unsigned char* smem) {
  constexpr int DK = MLSTM ? 64 : 128, DX = MLSTM ? 128 : 64;
  constexpr int QS = DK + 8;
  constexpr int NH = MLSTM ? 4 : 8;
  constexpr int NC_CTX = CTXL / 64;
  const int tid = threadIdx.x, lane = tid & 63, wave = tid >> 6;
  const int d = sid & 1, h = (sid >> 1) % NH, b = (sid >> 1) / NH;
  const int gsid = MLSTM ? sid : 16 + sid;
  bf16_t* sQ = (bf16_t*)smem;
  bf16_t* sK = sQ + 64 * QS;
  bf16_t* sP = sK;
  bf16_t* sKT = sK + 64 * QS;
  bf16_t* sXT = sKT + DK * 72;
  bf16_t* sST = sXT + DX * 72;
  float* sF = (float*)(sST + DX * QS);
  float* sLa = sF;
  float* sG = sF + 64;
  float* sBc = sF + 128;
  float* sDen = sF + 192;
  float* sN = sF + 256;
  int* sRow = (int*)(sF + 384);
  static_assert((64 * QS * 2 + DK * 72 + DX * 72 + DX * QS) * 2 + 448 * 4 <= SMEM_BYTES, "lds");
  bf16_t* outb = MLSTM ? (bf16_t*)(P.ws + OFF_HBUF) : (bf16_t*)(P.ws + OFF_R2L0);
  float* segU = (float*)(P.ws + OFF_LASEG);
  float* segN = (float*)(P.ws + OFF_LASEG_N);
  float* segD = (float*)(P.ws + OFF_LASEG_D);

  f32x16 accS[2];
#pragma unroll
  for (int j = 0; j < 2; ++j)
#pragma unroll
    for (int r = 0; r < 16; ++r) accS[j][r] = 0.f;
  const int sx0 = MLSTM ? wave * 32 : (wave >> 1) * 32;
  const int sk0 = MLSTM ? 0 : (wave & 1) * 64;
  float nreg = 0.f;
  float gb0 = 0.f, gb1 = 0.f, alog_e = 0.f, dskip = 0.f;
  if (MLSTM) { gb0 = P.in[I_IBIAS][d * 4 + h]; gb1 = P.in[I_FBIAS][d * 4 + h]; }
  else { gb0 = P.in[I_DTBIAS][d * 8 + h]; alog_e = fexp(P.in[I_ALOG][d * 8 + h]); dskip = P.in[I_DSKIP][h]; }

  const int cc0 = seg * LA_CPS, cc1 = cc0 + LA_CPS;
  LaRaw R;
  la_load_raw<MLSTM, FULL>(P, b, h, d, cc0, R);
  __syncthreads();
  if (FULL) {
    for (int js = 0; js < seg; ++js) {
      const size_t it = (size_t)gsid * LA_NSEG + js;
      const float a = fexp(segD[it]);
      const float* U = segU + it * 8192;
#pragma unroll
      for (int j = 0; j < 2; ++j)
#pragma unroll
        for (int r = 0; r < 16; ++r) accS[j][r] = a * accS[j][r] + U[(j * 16 + r) * 256 + tid];
      if (MLSTM) nreg = a * nreg + segN[it * 64 + (tid >> 2)];
    }
#pragma unroll
    for (int j = 0; j < 2; ++j)
#pragma unroll
      for (int g = 0; g < 4; ++g) {
        u32x2 pk; pk.x = pack2(accS[j][4 * g], accS[j][4 * g + 1]); pk.y = pack2(accS[j][4 * g + 2], accS[j][4 * g + 3]);
        *(u32x2*)(sST + (sx0 + (lane & 31)) * QS + sk0 + j * 32 + 8 * g + 4 * (lane >> 5)) = pk;
      }
    if (MLSTM && (tid & 3) == 0) sN[tid >> 2] = nreg;
  }
  float lsum = 0.f;

  for (int cc = cc0; cc < cc1; ++cc) {
    int tl_ = threadIdx.x; OPAQUE(tl_);
    const int tid = tl_, lane = tl_ & 63;
    const int sgi = cc >= NC_CTX;
    const int row0 = sgi ? NCTX + b * SEQ : b * CTXL;
    const int len = sgi ? SEQ : CTXL;
    const int cl = (sgi ? cc - NC_CTX : cc) * 64;
    if (tid < 64) {
      int p = cl + tid;
      sRow[tid] = row0 + (d ? len - 1 - p : p);
      float la;
      if (MLSTM) { la = -softplusf_(-(R.g1 + gb1)); sG[tid] = fexp(R.g0 + gb0); }
      else { float dt = softplusf_(R.g0 + gb0); la = -dt * alog_e; sG[tid] = dt; }
      sBc[tid] = wave_incl_scan(la);
    }
    __syncthreads();
    const float blast = sBc[63];
    lsum += blast;
    if (MLSTM) {
#pragma unroll
      for (int i = 0; i < 2; ++i) {
        int c = tid + i * 256, r = c >> 3, cc8 = (c & 7) * 8;
        float kf[8]; unpack8(R.k[i], kf);
        const float wgt = fexp(blast - sBc[r]) * sG[r];
#pragma unroll
        for (int j = 0; j < 8; ++j) sKT[(cc8 + j) * 72 + (r ^ swz64(cc8))] = f2bf(kf[j] * wgt);
        if (FULL) {
          float qf[8]; unpack8(R.q[i], qf);
#pragma unroll
          for (int j = 0; j < 8; ++j) qf[j] *= 0.125f;
          *(u32x4*)(sQ + r * QS + cc8) = pack8(qf);
          *(u32x4*)(sK + r * QS + cc8) = R.k[i];
        }
      }
#pragma unroll
      for (int i = 0; i < 4; ++i) {
        int c = tid + i * 256, r = c >> 4, cc8 = (c & 15) * 8;
        const bf16_t* xs = (const bf16_t*)&R.x[i];
#pragma unroll
        for (int j = 0; j < 8; ++j) sXT[(cc8 + j) * 72 + (r ^ swz64(cc8))] = xs[j];
      }
    } else {
#pragma unroll
      for (int i = 0; i < 2; ++i) {
        int c = tid + i * 256, r = c >> 3, cc8 = (c & 7) * 8;
        const bf16_t* xs = (const bf16_t*)&R.x[i];
#pragma unroll
        for (int j = 0; j < 8; ++j) sXT[(cc8 + j) * 72 + (r ^ swz64(cc8))] = xs[j];
      }
#pragma unroll
      for (int i = 0; i < 4; ++i) {
        int c = tid + i * 256, r = c >> 4, cc8 = (c & 15) * 8;
        float kf[8]; unpack8(R.k[i], kf);
        const float wgt = fexp(blast - sBc[r]) * sG[r];
#pragma unroll
        for (int j = 0; j < 8; ++j) sKT[(cc8 + j) * 72 + (r ^ swz64(cc8))] = f2bf(kf[j] * wgt);
        if (FULL) {
          *(u32x4*)(sK + r * QS + cc8) = R.k[i];
          *(u32x4*)(sQ + r * QS + cc8) = i < 2 ? R.q[i] : R.x[i];
        }
      }
    }
    if (cc + 1 < cc1) la_load_raw<MLSTM, FULL>(P, b, h, d, cc + 1, R);
    __syncthreads();
    if (FULL) {
      const int tr = (wave >> 1) * 32, tc = (wave & 1) * 32;
      f32x16 accP;
#pragma unroll
      for (int r = 0; r < 16; ++r) accP[r] = 0.f;
      if (!(tr == 0 && tc == 32)) {
#pragma unroll
        for (int kk = 0; kk < DK / 16; ++kk) {
          const int ko = kk * 16 + 8 * (lane >> 5);
          bf16x8 a = *(const bf16x8*)(sQ + (tr + (lane & 31)) * QS + ko);
          bf16x8 bb = *(const bf16x8*)(sK + (tc + (lane & 31)) * QS + ko);
          accP = mfma32(bb, a, accP);
        }
      }
      __syncthreads();
      {
        const int t = tr + (lane & 31);
        const float bt = sBc[t];
#pragma unroll
        for (int g = 0; g < 4; ++g) {
          const int s0 = tc + 8 * g + 4 * (lane >> 5);
          const f32x4 b4 = *(const f32x4*)(sBc + s0), g4 = *(const f32x4*)(sG + s0);
          const float v0 = accP[4 * g] * fexp(fminf(bt - b4.x, 0.f)) * g4.x, v1 = accP[4 * g + 1] * fexp(fminf(bt - b4.y, 0.f)) * g4.y;
          const float v2 = accP[4 * g + 2] * fexp(fminf(bt - b4.z, 0.f)) * g4.z, v3 = accP[4 * g + 3] * fexp(fminf(bt - b4.w, 0.f)) * g4.w;
          u32x2 pk;
          pk.x = pack2(s0 <= t ? v0 : 0.f, s0 + 1 <= t ? v1 : 0.f);
          pk.y = pack2(s0 + 2 <= t ? v2 : 0.f, s0 + 3 <= t ? v3 : 0.f);
          *(u32x2*)(sP + t * 72 + s0) = pk;
        }
        {
          const int t = tid >> 2, kq = (tid & 3) * (DK / 4);
          const float et = fexp(sBc[t]);
#pragma unroll
          for (int c8 = 0; c8 < DK / 4; c8 += 8) {
            float qf[8];
            unpack8(*(const u32x4*)(sQ + t * QS + kq + c8), qf);
#pragma unroll
            for (int j = 0; j < 8; ++j) qf[j] *= et;
            *(u32x4*)(sQ + t * QS + kq + c8) = pack8(qf);
          }
        }
      }
      __syncthreads();
      constexpr int NYT = MLSTM ? 2 : 1;
      const int yx0 = MLSTM ? wave * 32 : (wave >> 1) * 32;
      const int yt0 = MLSTM ? 0 : (wave & 1) * 32;
      f32x16 accY[NYT];
#pragma unroll
      for (int j = 0; j < NYT; ++j)
#pragma unroll
        for (int r = 0; r < 16; ++r) accY[j][r] = 0.f;
#pragma unroll
      for (int kk = 0; kk < 4; ++kk) {
        const int ko = kk * 16 + 8 * (lane >> 5);
        bf16x8 a = *(const bf16x8*)(sXT + (yx0 + (lane & 31)) * 72 + (ko ^ swz64(yx0 + (lane & 31))));
#pragma unroll
        for (int j = 0; j < NYT; ++j) {
          bf16x8 bb = *(const bf16x8*)(sP + (yt0 + j * 32 + (lane & 31)) * 72 + ko);
          accY[j] = mfma32(a, bb, accY[j]);
        }
      }
#pragma unroll
      for (int kk = 0; kk < DK / 16; ++kk) {
        const int ko = kk * 16 + 8 * (lane >> 5);
        bf16x8 a = *(const bf16x8*)(sST + (yx0 + (lane & 31)) * QS + ko);
#pragma unroll
        for (int j = 0; j < NYT; ++j) {
          bf16x8 bb = *(const bf16x8*)(sQ + (yt0 + j * 32 + (lane & 31)) * QS + ko);
          accY[j] = mfma32(a, bb, accY[j]);
        }
      }
      if (MLSTM) {
        const int t = tid >> 2, q4 = (tid & 3) * 16;
        float pf[16], qf[16];
        unpack8(*(const u32x4*)(sP + t * 72 + q4), pf); unpack8(*(const u32x4*)(sP + t * 72 + q4 + 8), pf + 8);
        unpack8(*(const u32x4*)(sQ + t * QS + q4), qf); unpack8(*(const u32x4*)(sQ + t * QS + q4 + 8), qf + 8);
        float den = 0.f;
#pragma unroll
        for (int j = 0; j < 16; ++j) den += pf[j] + sN[q4 + j] * qf[j];
        den = sum4(den);
        if ((tid & 3) == 0) sDen[t] = den;
        __syncthreads();
      }
#pragma unroll
      for (int j = 0; j < NYT; ++j) {
        const int t = yt0 + j * 32 + (lane & 31);
        const size_t obase = (size_t)sRow[t] * 1024 + d * 512 + h * DX;
        const float dinv = MLSTM ? frcp(fmaxf(fabsf(sDen[t]), 1.f)) : 1.f;
#pragma unroll
        for (int g = 0; g < 4; ++g) {
          const int x0 = yx0 + 8 * g + 4 * (lane >> 5);
          float v0 = accY[j][4 * g], v1 = accY[j][4 * g + 1], v2 = accY[j][4 * g + 2], v3 = accY[j][4 * g + 3];
          if (MLSTM) { v0 *= dinv; v1 *= dinv; v2 *= dinv; v3 *= dinv; }
          else if (d == 0) {
            const int ts = t ^ swz64(x0);
            v0 += dskip * bf2f(sXT[(x0 + 0) * 72 + ts]); v1 += dskip * bf2f(sXT[(x0 + 1) * 72 + ts]);
            v2 += dskip * bf2f(sXT[(x0 + 2) * 72 + ts]); v3 += dskip * bf2f(sXT[(x0 + 3) * 72 + ts]);
          }
          u32x2 pk; pk.x = pack2(v0, v1); pk.y = pack2(v2, v3);
          *(u32x2*)(outb + obase + x0) = pk;
        }
      }
      __syncthreads();
    }
    {
      const float eb = fexp(blast);
#pragma unroll
      for (int j = 0; j < 2; ++j)
#pragma unroll
        for (int r = 0; r < 16; ++r) accS[j][r] *= eb;
#pragma unroll
      for (int kk = 0; kk < 4; ++kk) {
        const int ko = kk * 16 + 8 * (lane >> 5);
        bf16x8 a = *(const bf16x8*)(sXT + (sx0 + (lane & 31)) * 72 + (ko ^ swz64(sx0 + (lane & 31))));
#pragma unroll
        for (int j = 0; j < 2; ++j) {
          bf16x8 bb = *(const bf16x8*)(sKT + (sk0 + j * 32 + (lane & 31)) * 72 + (ko ^ swz64(sk0 + j * 32 + (lane & 31))));
          accS[j] = mfma32(bb, a, accS[j]);
        }
      }
      if (FULL) {
#pragma unroll
        for (int j = 0; j < 2; ++j)
#pragma unroll
          for (int g = 0; g < 4; ++g) {
            u32x2 pk; pk.x = pack2(accS[j][4 * g], accS[j][4 * g + 1]); pk.y = pack2(accS[j][4 * g + 2], accS[j][4 * g + 3]);
            *(u32x2*)(sST + (sx0 + (lane & 31)) * QS + sk0 + j * 32 + 8 * g + 4 * (lane >> 5)) = pk;
          }
      }
      if (MLSTM) {
        const int k = tid >> 2, q4 = (tid & 3) * 16;
        float kf[16];
        unpack8(*(const u32x4*)(sKT + k * 72 + q4), kf); unpack8(*(const u32x4*)(sKT + k * 72 + q4 + 8), kf + 8);
        float ps = 0.f;
#pragma unroll
        for (int j = 0; j < 16; ++j) ps += kf[j];
        nreg = nreg * eb + sum4(ps);
        if (FULL && (tid & 3) == 0) sN[k] = nreg;
      }
    }
    __syncthreads();
  }
  if (!FULL) {
    const size_t it = (size_t)gsid * LA_NSEG + seg;
    float* U = segU + it * 8192;
#pragma unroll
    for (int j = 0; j < 2; ++j)
#pragma unroll
      for (int r = 0; r < 16; ++r) U[(j * 16 + r) * 256 + tid] = accS[j][r];
    if (MLSTM && (tid & 3) == 0) segN[it * 64 + (tid >> 2)] = nreg;
    if (tid == 0) segD[it] = lsum;
  }
}

DEV void st_finish_l0(const Params& P, int row) {
  const int lane = threadIdx.x & 63;
  bf16_t* hb = (bf16_t*)(P.ws + OFF_HBUF) + (size_t)row * 1024;
  const bf16_t* yb = (const bf16_t*)(P.ws + OFF_R2L0) + (size_t)row * 1024;
  const bf16_t* pr = (const bf16_t*)(P.ws + OFF_PROJ) + (size_t)row * EVC;
  const int ch = lane * 8;
  float h0[8], h1[8], o[8], f1[8];
  unpack8(*(const u32x4*)(hb + ch), h0);
  unpack8(*(const u32x4*)(hb + 512 + ch), h1);
  unpack8(*(const u32x4*)(pr + 1024 + ch), o);
  float ss = 0.f;
#pragma unroll
  for (int j = 0; j < 8; ++j) { h0[j] += h1[j]; ss += h0[j] * h0[j]; }
  ss = sum16(ss);
  float rstd = frsq(ss * (1.f / 128.f) + 1e-6f);
  float pw[8]; ld8(P.in[I_MNORM] + ch, pw);
#pragma unroll
  for (int j = 0; j < 8; ++j) f1[j] = h0[j] * rstd * pw[j] * sigmoidf_(o[j]);
  float y0[8], y1[8], z[8], f2[8];
  unpack8(*(const u32x4*)(yb + ch), y0);
  unpack8(*(const u32x4*)(yb + 512 + ch), y1);
  unpack8(*(const u32x4*)(pr + 1552 + ch), z);
  float s2 = 0.f;
#pragma unroll
  for (int j = 0; j < 8; ++j) { y0[j] = (y0[j] + y1[j]) * siluf_(z[j]); s2 += y0[j] * y0[j]; }
  s2 = wave_sum(s2);
  float rstd2 = frsq(s2 * (1.f / 512.f) + 1e-6f);
  ld8(P.in[I_SNORM] + ch, pw);
#pragma unroll
  for (int j = 0; j < 8; ++j) f2[j] = y0[j] * rstd2 * pw[j];
  *(u32x4*)(hb + ch) = pack8(f1);
  *(u32x4*)(hb + 512 + ch) = pack8(f2);
}

DEV float mixval(const bf16_t* __restrict__ proj, int row, int c, const float* __restrict__ mu) {
  float self = bf2f(proj[(size_t)row * ODC + c]);
  int nrow = -1;
  if (row < NCTX) {
    int pos = row % CTXL;
    if (c < 896) { if (pos > 0) nrow = row - 1; }
    else { if (pos < CTXL - 1) nrow = row + 1; }
  } else {
    int pos = (row - NCTX) % SEQ;
    int gx = pos % GW, gy = pos / GW, q = c / 448;
    if (q == 0) { if (gx > 0) nrow = row - 1; }
    else if (q == 1) { if (gx < GW - 1) nrow = row + 1; }
    else if (q == 2) { if (gy > 0) nrow = row - GW; }
    else { if (gy < SEQ / GW - 1) nrow = row + GW; }
  }
  float nb = nrow >= 0 ? bf2f(proj[(size_t)nrow * ODC + c]) : 0.f;
  return self + mu[c] * (nb - self);
}

DEV int nbr_row(int row, int c) {
  if (row < NCTX) {
    int pos = row % CTXL;
    if (c < 896) return pos > 0 ? row - 1 : -1;
    return pos < CTXL - 1 ? row + 1 : -1;
  }
  int pos = (row - NCTX) % SEQ;
  int gx = pos % GW, gy = pos / GW, q = c / 448;
  if (q == 0) return gx > 0 ? row - 1 : -1;
  if (q == 1) return gx < GW - 1 ? row + 1 : -1;
  if (q == 2) return gy > 0 ? row - GW : -1;
  return gy < SEQ / GW - 1 ? row + GW : -1;
}

DEV void mix8(const bf16_t* __restrict__ proj, int row, int c, const float* __restrict__ mu, float* o) {
  float xs[8], xn[8];
  unpack8(*(const u32x4*)(proj + (size_t)row * ODC + c), xs);
  const int nr = nbr_row(row, c);
  if (nr >= 0) unpack8(*(const u32x4*)(proj + (size_t)nr * ODC + c), xn);
  else {
#pragma unroll
    for (int j = 0; j < 8; ++j) xn[j] = 0.f;
  }
  const f32x4 m0 = *(const f32x4*)(mu + c), m1 = *(const f32x4*)(mu + c + 4);
  const float mm[8] = {m0.x, m0.y, m0.z, m0.w, m1.x, m1.y, m1.z, m1.w};
#pragma unroll
  for (int j = 0; j < 8; ++j) o[j] = xs[j] + mm[j] * (xn[j] - xs[j]);
}

DEV void st_lora_act(const Params& P, int row2) {
  const int lane = threadIdx.x & 63;
  const int row = row2 + (lane >> 5), c = (lane & 31) * 8;
  const bf16_t* proj = (const bf16_t*)(P.ws + OFF_PROJ);
  bf16_t* hb = (bf16_t*)(P.ws + OFF_HBUF) + (size_t)row * 1024;
  float v[8];
  mix8(proj, row, 1536 + c, P.in[I_MU], v);
#pragma unroll
  for (int j = 0; j < 8; ++j) v[j] = c < 64 ? tanhf_(v[j]) : (c < 128 ? v[j] : sigmoidf_(v[j]));
  *(u32x4*)(hb + c) = pack8(v);
}

DEV void st_rwkv_stream(const Params& P, int sid, unsigned char* smem) {
  const int tid = threadIdx.x, lane = tid & 63, wave = tid >> 6;
  const int d = sid & 1, h = (sid >> 1) & 7, b = sid >> 4;
  float* sR = (float*)smem;
  float* sW = sR + 2048;
  float* sKk = sW + 2048;
  float* sV = sKk + 2048;
  float* sA = sV + 2048;
  float* sBb = sA + 2048;
  float* sY = sBb + 2048;
  int* sRow = (int*)(sY + 2048);
  const bf16_t* proj = (const bf16_t*)(P.ws + OFF_PROJ);
  const bf16_t* lora = (const bf16_t*)(P.ws + OFF_LORA);
  bf16_t* yout = (bf16_t*)(P.ws + OFF_HBUF);
  const float* mu = P.in[I_MU];
  const int vrow = tid >> 2, j4 = tid & 3;
  float S[16];
#pragma unroll
  for (int i = 0; i < 16; ++i) S[i] = 0.f;
  const float kkw = P.in[I_KK][h * 64 + lane], kaw = P.in[I_KA][h * 64 + lane];
  for (int seg = 0; seg < 2; ++seg) {
    const int row0 = seg == 0 ? b * CTXL : NCTX + b * SEQ;
    const int len = seg == 0 ? CTXL : SEQ;
    for (int it = 0; it < len / 32; ++it) {
      __syncthreads();
      for (int s = wave; s < 32; s += 4) {
        int p = it * 32 + s, pos = d ? len - 1 - p : p, row = row0 + pos;
        int c = h * 64 + lane;
        float r = mixval(proj, row, c, mu);
        float k = mixval(proj, row, 512 + c, mu);
        float v = mixval(proj, row, 1024 + c, mu);
        float kk = k * kkw;
        float ss = wave_sum(kk * kk);
        kk *= frsq(ss + 1e-12f);
        float lw = bf2f(lora[((size_t)d * NTOK + row) * 512 + c]);
        float la = bf2f(lora[((size_t)(2 + d) * NTOK + row) * 512 + c]);
        float w = fexp(-0.6065306597126334f * sigmoidf_(lw));
        float a = sigmoidf_(la);
        float kt = k * (1.f + (a - 1.f) * kaw);
        sR[s * 64 + lane] = r; sW[s * 64 + lane] = w; sKk[s * 64 + lane] = kt; sV[s * 64 + lane] = v;
        sA[s * 64 + lane] = -kk; sBb[s * 64 + lane] = kk * a;
        if (lane == 0) sRow[s] = row;
      }
      __syncthreads();
      for (int s = 0; s < 32; ++s) {
        const float* pa = sA + s * 64 + j4 * 16;
        const float* pw = sW + s * 64 + j4 * 16;
        const float* pk = sKk + s * 64 + j4 * 16;
        const float* pb = sBb + s * 64 + j4 * 16;
        const float* pr = sR + s * 64 + j4 * 16;
        const float vv = sV[s * 64 + vrow];
        float sa = 0.f;
#pragma unroll
        for (int i = 0; i < 16; ++i) sa += S[i] * pa[i];
        sa = sum4(sa);
        float y = 0.f;
#pragma unroll
        for (int i = 0; i < 16; ++i) { S[i] = S[i] * pw[i] + sa * pb[i] + vv * pk[i]; y += S[i] * pr[i]; }
        y = sum4(y);
        if (j4 == 0) sY[s * 64 + vrow] = y;
      }
      __syncthreads();
      for (int i = tid; i < 2048; i += 256) {
        int s = i >> 6, c = i & 63;
        yout[(size_t)sRow[s] * 1024 + d * 512 + h * 64 + c] = f2bf(sY[i]);
      }
    }
  }
}


struct RwkvRaw { u32x4 rs, rn, ks, kn, vs, vn, lw, la; int row; };

DEV void rwkv_load_raw(const bf16_t* __restrict__ proj, const bf16_t* __restrict__ lora, int b, int h, int d, int cc, int t, int c0,
                       RwkvRaw& R) {
  constexpr int NC_CTX = CTXL / 32;
  const int seg = cc >= NC_CTX;
  const int row0 = seg ? NCTX + b * SEQ : b * CTXL;
  const int len = seg ? SEQ : CTXL;
  const int p = (seg ? cc - NC_CTX : cc) * 32 + t;
  const int row = row0 + (d ? len - 1 - p : p);
  const int col = h * 64 + c0;
  const u32x4 z4 = {0u, 0u, 0u, 0u};
  const bf16_t* rp = proj + (size_t)row * ODC;
  R.row = row;
  R.rs = *(const u32x4*)(rp + col);
  R.ks = *(const u32x4*)(rp + 512 + col);
  R.vs = *(const u32x4*)(rp + 1024 + col);
  int n0 = nbr_row(row, col), n1 = nbr_row(row, 512 + col), n2 = nbr_row(row, 1024 + col);
  R.rn = n0 >= 0 ? *(const u32x4*)(proj + (size_t)n0 * ODC + col) : z4;
  R.kn = n1 >= 0 ? *(const u32x4*)(proj + (size_t)n1 * ODC + 512 + col) : z4;
  R.vn = n2 >= 0 ? *(const u32x4*)(proj + (size_t)n2 * ODC + 1024 + col) : z4;
  R.lw = *(const u32x4*)(lora + ((size_t)d * NTOK + row) * 512 + col);
  R.la = *(const u32x4*)(lora + ((size_t)(2 + d) * NTOK + row) * 512 + col);
}

#ifndef RW_NSEG
#define RW_NSEG 16
#endif
constexpr int RW_NCH = (CTXL + SEQ) / 32;
constexpr size_t OFF_RWSEG = OFF_PU;
static_assert((size_t)32 * RW_NSEG * 64 * 128 * 4 <= (size_t)2 * NEXP * 1024, "rwseg");

template <bool FULL>
DEV void st_rwkv_seg(const Params& P, int sid, int seg, unsigned char* smem) {
  constexpr int NVB = FULL ? 2 : 4;
  constexpr int ZR = FULL ? 64 : 128;
  const int tid = threadIdx.x, lane = tid & 63, wave = tid >> 6;
  const int d = sid & 1, h = (sid >> 1) & 7, b = sid >> 4;
  bf16_t* sAt = (bf16_t*)smem;
  bf16_t* sRt = sAt + 32 * 72;
  bf16_t* sBt = sRt + 32 * 72;
  bf16_t* sKt = sBt + 32 * 72;
  bf16_t* sBT = sKt + 32 * 72;
  bf16_t* sKT = sBT + 64 * 40;
  bf16_t* sVT = sKT + 64 * 40;
  bf16_t* sLak = sVT + 64 * 40;
  bf16_t* sM = sLak + 32 * 40;
  bf16_t* sLrb = sM + 32 * 40;
  bf16_t* sLrk = sLrb + 32 * 40;
  bf16_t* sZ = FULL ? sLrk + 32 * 40 : sLrb;
  bf16_t* after = sZ + ZR * 72;
  bf16_t* sRT = after;
  bf16_t* sSAT = FULL ? after + 64 * 40 : sRt;
  float* sLP = (float*)(FULL ? after + 2 * 64 * 40 : after + 128 * 40);
  float* sLab = sLP + 4 * 64;
  float* sD = sLab + 32 * 36;
  float* sPT = sD + 768;
  int* sRow = (int*)(sPT + 64);
  static_assert((4 * 32 * 72 + 3 * 64 * 40 + 4 * 32 * 40 + 2 * 64 * 40 + 64 * 72) * 2 + (4 * 64 + 32 * 36 + 768 + 64 + 32 + 320) * 4 + 16 <= SMEM_BYTES, "lds full");
  static_assert((4 * 32 * 72 + 3 * 64 * 40 + 2 * 32 * 40 + 128 * 72 + 128 * 40) * 2 + (4 * 64 + 32 * 36 + 768 + 64 + 32 + 320) * 4 + 16 <= SMEM_BYTES, "lds p1");
  static_assert(128 * 40 <= 3 * 32 * 72, "alias");
  const bf16_t* proj = (const bf16_t*)(P.ws + OFF_PROJ);
  const bf16_t* lora = (const bf16_t*)(P.ws + OFF_LORA);
  bf16_t* yout = (bf16_t*)(P.ws + OFF_HBUF);
  float* segZ = (float*)(P.ws + OFF_RWSEG);
  const int t = tid >> 3, c0 = (tid & 7) * 8;
  const int hl = lane >> 5, l31 = lane & 31;
  float* sCst = (float*)(smem + SMEM_BYTES - 320 * 4 - 16);
  if (tid < 64) {
    sCst[tid] = P.in[I_MU][h * 64 + tid]; sCst[64 + tid] = P.in[I_MU][512 + h * 64 + tid]; sCst[128 + tid] = P.in[I_MU][1024 + h * 64 + tid];
    sCst[192 + tid] = P.in[I_KK][h * 64 + tid]; sCst[256 + tid] = P.in[I_KA][h * 64 + tid];
  }
  const int cc0 = (seg * RW_NCH) / RW_NSEG, cc1 = ((seg + 1) * RW_NCH) / RW_NSEG;
  RwkvRaw R;
  rwkv_load_raw(proj, lora, b, h, d, cc0, t, c0, R);
  f32x16 Zm[2];
#pragma unroll
  for (int j = 0; j < 2; ++j)
#pragma unroll
    for (int r = 0; r < 16; ++r) Zm[j][r] = 0.f;
  __syncthreads();
  for (int i = tid; i < ZR * 72; i += 256) sZ[i] = 0;
  __syncthreads();
  if (!FULL) {
    if (wave >= 2) {
#pragma unroll
      for (int cb = 0; cb < 2; ++cb)
#pragma unroll
        for (int r = 0; r < 16; ++r) {
          int c = cb * 32 + acc_row(r, lane), vp = wave * 32 + l31;
          if (c == vp - 64) { Zm[cb][r] = 1.f; sZ[vp * 72 + c] = 0x3f80; }
        }
    }
  } else {
    for (int js = 0; js < seg; ++js) {
      const float* Zs = segZ + ((size_t)sid * RW_NSEG + js) * 64 * 128;
      bf16_t* sG = sAt;
      {
        const int c = tid >> 2, c2 = (tid & 3) * 16;
        float gv[16];
        ld8(Zs + c * 128 + 64 + c2, gv); ld8(Zs + c * 128 + 64 + c2 + 8, gv + 8);
        *(u32x4*)(sG + c * 72 + c2) = pack8(gv);
        *(u32x4*)(sG + c * 72 + c2 + 8) = pack8(gv + 8);
      }
      __syncthreads();
      if (wave >= 2) {
        const int cb = wave - 2;
#pragma unroll
        for (int vb = 0; vb < 2; ++vb) {
          f32x16 acc;
#pragma unroll
          for (int r = 0; r < 16; ++r) acc[r] = Zs[(cb * 32 + acc_row(r, lane)) * 128 + vb * 32 + l31];
#pragma unroll
          for (int kk = 0; kk < 4; ++kk) {
            bf16x8 a = *(const bf16x8*)(sG + (cb * 32 + l31) * 72 + kk * 16 + 8 * hl);
            bf16x8 bb = *(const bf16x8*)(sZ + (vb * 32 + l31) * 72 + kk * 16 + 8 * hl);
            acc = mfma32(a, bb, acc);
          }
          Zm[vb] = acc;
        }
      }
      __syncthreads();
      if (wave >= 2) {
        const int cb = wave - 2;
#pragma unroll
        for (int vb = 0; vb < 2; ++vb)
#pragma unroll
          for (int g = 0; g < 4; ++g) {
            u32x2 pk; pk.x = pack2(Zm[vb][4 * g], Zm[vb][4 * g + 1]); pk.y = pack2(Zm[vb][4 * g + 2], Zm[vb][4 * g + 3]);
            *(u32x2*)(sZ + (vb * 32 + l31) * 72 + cb * 32 + 8 * g + 4 * hl) = pk;
          }
      }
      __syncthreads();
    }
  }
  for (int cc = cc0; cc < cc1; ++cc) {
    int tl_ = threadIdx.x; OPAQUE(tl_);
    const int tid = tl_, lane = tl_ & 63, hl = lane >> 5, l31 = lane & 31, t = tl_ >> 3, c0 = (tl_ & 7) * 8;
    const float* muR = sCst + c0; const float* muK = sCst + 64 + c0; const float* muV = sCst + 128 + c0;
    const float* kkw = sCst + 192 + c0; const float* kaw = sCst + 256 + c0;
    float lw8[8], lp8[8];
    {
      float lwf[8];
      unpack8(R.lw, lwf);
#pragma unroll
      for (int j = 0; j < 8; ++j) { lw8[j] = lwf[j]; lp8[j] = lw8[j]; }
#pragma unroll
      for (int off = 8; off < 64; off <<= 1) {
#pragma unroll
        for (int j = 0; j < 8; ++j) {
#ifdef CPU_EMU
          float o = emu_shfl_up(lp8[j], off);
#else
          float o = __shfl_up(lp8[j], off, 64);
#endif
          if (lane >= off) lp8[j] += o;
        }
      }
      if (lane >= 56) {
#pragma unroll
        for (int j = 0; j < 8; ++j) sLP[wave * 64 + c0 + j] = lp8[j];
      }
      if ((tid & 7) == 0) sRow[t] = R.row;
    }
    __syncthreads();
    {
#pragma unroll
      for (int j = 0; j < 8; ++j) {
        float offs = 0.f;
        for (int w2 = 0; w2 < wave; ++w2) offs += sLP[w2 * 64 + c0 + j];
        lp8[j] += offs;
      }
      if (t == 31) {
#pragma unroll
        for (int j = 0; j < 8; ++j) sPT[c0 + j] = fexp(lp8[j]);
      }
    }
    {
      float xs[8], xn[8], kt[8], aa[8], ob[8], ok[8];
      unpack8(R.ks, xs); unpack8(R.kn, xn);
      float ss = 0.f;
#pragma unroll
      for (int j = 0; j < 8; ++j) { kt[j] = xs[j] + muK[j] * (xn[j] - xs[j]); aa[j] = kt[j] * kkw[j]; ss += aa[j] * aa[j]; }
      ss = sum8(ss);
      const float rn = frsq(ss + 1e-12f);
      float laf[8];
      unpack8(R.la, laf);
#pragma unroll
      for (int j = 0; j < 8; ++j) {
        const float lp = lp8[j];
        const float lpm = lp8[j] - lw8[j];
        const float e = fexp(-lp);
        const float kkn = aa[j] * rn;
        const float asg = laf[j];
        aa[j] = -kkn * fexp(lpm);
        ob[j] = kkn * asg * e;
        ok[j] = kt[j] * (1.f + (asg - 1.f) * kaw[j]) * e;
      }
      *(u32x4*)(sAt + t * 72 + c0) = pack8(aa);
      *(u32x4*)(sBt + t * 72 + c0) = pack8(ob);
      *(u32x4*)(sKt + t * 72 + c0) = pack8(ok);
#pragma unroll
      for (int j = 0; j < 8; ++j) { sBT[(c0 + j) * 40 + (t ^ swz32(c0))] = f2bf(ob[j]); sKT[(c0 + j) * 40 + (t ^ swz32(c0))] = f2bf(ok[j]); }
      unpack8(R.vs, xs); unpack8(R.vn, xn);
#pragma unroll
      for (int j = 0; j < 8; ++j) sVT[(c0 + j) * 40 + (t ^ swz32(c0))] = f2bf(xs[j] + muV[j] * (xn[j] - xs[j]));
      if (FULL) {
        unpack8(R.rs, xs); unpack8(R.rn, xn);
#pragma unroll
        for (int j = 0; j < 8; ++j) xs[j] = (xs[j] + muR[j] * (xn[j] - xs[j])) * fexp(lp8[j]);
        *(u32x4*)(sRt + t * 72 + c0) = pack8(xs);
      }
    }
    if (cc + 1 < cc1) rwkv_load_raw(proj, lora, b, h, d, cc + 1, t, c0, R);
    __syncthreads();
    if (FULL || wave < 2) {
      const bf16_t* Asrc = wave < 2 ? sAt : sRt;
      const bf16_t* Bsrc = (wave & 1) ? sKt : sBt;
      f32x16 acc;
#pragma unroll
      for (int r = 0; r < 16; ++r) acc[r] = 0.f;
#pragma unroll
      for (int kk = 0; kk < 4; ++kk) {
        bf16x8 a = *(const bf16x8*)(Asrc + l31 * 72 + kk * 16 + 8 * hl);
        bf16x8 bb = *(const bf16x8*)(Bsrc + l31 * 72 + kk * 16 + 8 * hl);
        acc = mfma32(bb, a, acc);
      }
      bf16_t* dst = wave == 1 ? sLak : (wave == 2 ? sLrb : sLrk);
      {
        const int tt = l31;
        const int lim = wave < 2 ? tt : tt + 1;
#pragma unroll
        for (int g = 0; g < 4; ++g) {
          const int j0 = 8 * g + 4 * hl;
          const float v0 = j0 < lim ? acc[4 * g] : 0.f, v1 = j0 + 1 < lim ? acc[4 * g + 1] : 0.f;
          const float v2 = j0 + 2 < lim ? acc[4 * g + 2] : 0.f, v3 = j0 + 3 < lim ? acc[4 * g + 3] : 0.f;
          if (wave == 0) { f32x4 o = {v0, v1, v2, v3}; *(f32x4*)(sLab + tt * 36 + j0) = o; }
          else { u32x2 pk; pk.x = pack2(v0, v1); pk.y = pack2(v2, v3); *(u32x2*)(dst + tt * 40 + j0) = pk; }
        }
      }
    }
    __syncthreads();
    auto rhs_block = [&](int vb) {
      f32x16 acc;
#pragma unroll
      for (int r = 0; r < 16; ++r) acc[r] = 0.f;
#pragma unroll
      for (int kk = 0; kk < 4; ++kk) {
        bf16x8 a = *(const bf16x8*)(sAt + l31 * 72 + kk * 16 + 8 * hl);
        bf16x8 bb = *(const bf16x8*)(sZ + (vb * 32 + l31) * 72 + kk * 16 + 8 * hl);
        acc = mfma32(a, bb, acc);
      }
      if (vb < 2) {
#pragma unroll
        for (int kk = 0; kk < 2; ++kk) {
          bf16x8 a = *(const bf16x8*)(sLak + l31 * 40 + kk * 16 + 8 * hl);
          bf16x8 bb = *(const bf16x8*)(sVT + (vb * 32 + l31) * 40 + ((kk * 16 + 8 * hl) ^ swz32(l31)));
          acc = mfma32(a, bb, acc);
        }
      }
#pragma unroll
      for (int g = 0; g < 4; ++g) {
        u32x2 pk; pk.x = pack2(acc[4 * g], acc[4 * g + 1]); pk.y = pack2(acc[4 * g + 2], acc[4 * g + 3]);
        *(u32x2*)(sRT + (vb * 32 + l31) * 40 + 8 * g + 4 * hl) = pk;
      }
    };
    if (wave == 0) {
      if (tid < 32) {
        const int q = tid >> 4, c = tid & 15;
        const float* Lq = sLab + (q * 16) * 36 + q * 16;
        float x[16];
        x[0] = (c == 0) ? 1.f : 0.f;
#define INV_GROUP_(I0, I1)                                                                           \
        {                                                                                            \
          f32x4 Lr[12];                                                                              \
          { int n = 0;                                                                               \
            _Pragma("unroll") for (int i = I0; i <= I1; ++i)                                         \
              _Pragma("unroll") for (int j4 = 0; j4 < i; j4 += 4) Lr[n++] = *(const f32x4*)(Lq + i * 36 + j4); }  \
          SCHED_FENCE_();                                                                            \
          { int n = 0;                                                                               \
            _Pragma("unroll") for (int i = I0; i <= I1; ++i) {                                       \
              float s0 = (i == c) ? 1.f : 0.f, s1 = 0.f;                                             \
              _Pragma("unroll") for (int j4 = 0; j4 < i; j4 += 4) {                                  \
                const f32x4 l4 = Lr[n++];                                                            \
                s0 += l4.x * x[j4];                                                                  \
                if (j4 + 1 < i) s1 += l4.y * x[j4 + 1];                                              \
                if (j4 + 2 < i) s0 += l4.z * x[j4 + 2];                                              \
                if (j4 + 3 < i) s1 += l4.w * x[j4 + 3];                                              \
              }                                                                                      \
              x[i] = s0 + s1;                                                                        \
            } }                                                                                      \
          SCHED_FENCE_();                                                                            \
        }
#ifdef CPU_EMU
#define SCHED_FENCE_() ((void)0)
#else
#define SCHED_FENCE_() __builtin_amdgcn_sched_barrier(0)
#endif
        INV_GROUP_(1, 8)
        INV_GROUP_(9, 12)
        INV_GROUP_(13, 15)
#undef INV_GROUP_
#undef SCHED_FENCE_
#pragma unroll
        for (int i = 0; i < 16; ++i) sD[q * 256 + i * 16 + c] = x[i];
      }
    } else if (FULL) {
      if (wave >= 2) rhs_block(wave - 2);
    } else {
      if (wave == 1) { rhs_block(0); rhs_block(1); }
      else rhs_block(wave);
    }
    __syncthreads();
    {
      const int i = tid >> 4, c = tid & 15;
      float sacc = 0.f;
#pragma unroll
      for (int j4 = 0; j4 < 16; j4 += 4) {
        const f32x4 l4 = *(const f32x4*)(sLab + (16 + i) * 36 + j4);
        sacc += l4.x * sD[j4 * 16 + c] + l4.y * sD[(j4 + 1) * 16 + c] + l4.z * sD[(j4 + 2) * 16 + c] + l4.w * sD[(j4 + 3) * 16 + c];
      }
      sD[512 + i * 16 + c] = sacc;
    }
    __syncthreads();
    {
      const int i = tid >> 4, c = tid & 15;
      float sacc = 0.f;
#pragma unroll
      for (int j4 = 0; j4 < 16; j4 += 4) {
        const f32x4 d4 = *(const f32x4*)(sD + 256 + i * 16 + j4);
        sacc += d4.x * sD[512 + j4 * 16 + c] + d4.y * sD[512 + (j4 + 1) * 16 + c] + d4.z * sD[512 + (j4 + 2) * 16 + c] + d4.w * sD[512 + (j4 + 3) * 16 + c];
      }
      sM[(16 + i) * 40 + c] = f2bf(sacc);
      sM[i * 40 + c] = f2bf(sD[i * 16 + c]);
      sM[(16 + i) * 40 + 16 + c] = f2bf(sD[256 + i * 16 + c]);
      sM[i * 40 + 16 + c] = 0;
    }
    __syncthreads();
    if (wave < NVB) {
      const int vb = wave;
      f32x16 acc;
#pragma unroll
      for (int r = 0; r < 16; ++r) acc[r] = 0.f;
#pragma unroll
      for (int kk = 0; kk < 2; ++kk) {
        bf16x8 a = *(const bf16x8*)(sM + l31 * 40 + kk * 16 + 8 * hl);
        bf16x8 bb = *(const bf16x8*)(sRT + (vb * 32 + l31) * 40 + kk * 16 + 8 * hl);
        acc = mfma32(a, bb, acc);
      }
#pragma unroll
      for (int g = 0; g < 4; ++g) {
        u32x2 pk; pk.x = pack2(acc[4 * g], acc[4 * g + 1]); pk.y = pack2(acc[4 * g + 2], acc[4 * g + 3]);
        *(u32x2*)(sSAT + (vb * 32 + l31) * 40 + 8 * g + 4 * hl) = pk;
      }
    }
    __syncthreads();
    if (FULL) {
      if (wave < 2) {
        const int vb = wave;
        f32x16 acc;
#pragma unroll
        for (int r = 0; r < 16; ++r) acc[r] = 0.f;
#pragma unroll
        for (int kk = 0; kk < 4; ++kk) {
          bf16x8 a = *(const bf16x8*)(sZ + (vb * 32 + l31) * 72 + kk * 16 + 8 * hl);
          bf16x8 bb = *(const bf16x8*)(sRt + l31 * 72 + kk * 16 + 8 * hl);
          acc = mfma32(a, bb, acc);
        }
#pragma unroll
        for (int kk = 0; kk < 2; ++kk) {
          bf16x8 a = *(const bf16x8*)(sSAT + (vb * 32 + l31) * 40 + kk * 16 + 8 * hl);
          bf16x8 bb = *(const bf16x8*)(sLrb + l31 * 40 + kk * 16 + 8 * hl);
          acc = mfma32(a, bb, acc);
        }
#pragma unroll
        for (int kk = 0; kk < 2; ++kk) {
          bf16x8 a = *(const bf16x8*)(sVT + (vb * 32 + l31) * 40 + ((kk * 16 + 8 * hl) ^ swz32(l31)));
          bf16x8 bb = *(const bf16x8*)(sLrk + l31 * 40 + kk * 16 + 8 * hl);
          acc = mfma32(a, bb, acc);
        }
        {
          const size_t obase = (size_t)sRow[l31] * 1024 + d * 512 + h * 64 + vb * 32;
#pragma unroll
          for (int g = 0; g < 4; ++g) {
            u32x2 pk; pk.x = pack2(acc[4 * g], acc[4 * g + 1]); pk.y = pack2(acc[4 * g + 2], acc[4 * g + 3]);
            *(u32x2*)(yout + obase + 8 * g + 4 * hl) = pk;
          }
        }
      } else {
        const int cb = wave - 2;
#pragma unroll
        for (int vb = 0; vb < 2; ++vb) {
          f32x16 acc;
#pragma unroll
          for (int r = 0; r < 16; ++r) acc[r] = 0.f;
#pragma unroll
          for (int kk = 0; kk < 2; ++kk) {
            bf16x8 a = *(const bf16x8*)(sBT + (cb * 32 + l31) * 40 + ((kk * 16 + 8 * hl) ^ swz32(l31)));
            bf16x8 bb = *(const bf16x8*)(sSAT + (vb * 32 + l31) * 40 + kk * 16 + 8 * hl);
            acc = mfma32(a, bb, acc);
          }
#pragma unroll
          for (int kk = 0; kk < 2; ++kk) {
            bf16x8 a = *(const bf16x8*)(sKT + (cb * 32 + l31) * 40 + ((kk * 16 + 8 * hl) ^ swz32(l31)));
            bf16x8 bb = *(const bf16x8*)(sVT + (vb * 32 + l31) * 40 + ((kk * 16 + 8 * hl) ^ swz32(l31)));
            acc = mfma32(a, bb, acc);
          }
#pragma unroll
          for (int r = 0; r < 16; ++r) Zm[vb][r] = sPT[cb * 32 + acc_row(r, lane)] * (Zm[vb][r] + acc[r]);
        }
      }
      __syncthreads();
      if (wave >= 2) {
        const int cb = wave - 2;
#pragma unroll
        for (int vb = 0; vb < 2; ++vb)
#pragma unroll
          for (int g = 0; g < 4; ++g) {
            u32x2 pk; pk.x = pack2(Zm[vb][4 * g], Zm[vb][4 * g + 1]); pk.y = pack2(Zm[vb][4 * g + 2], Zm[vb][4 * g + 3]);
            *(u32x2*)(sZ + (vb * 32 + l31) * 72 + cb * 32 + 8 * g + 4 * hl) = pk;
          }
      }
    } else {
      const int vb = wave;
#pragma unroll
      for (int cb = 0; cb < 2; ++cb) {
        f32x16 acc;
#pragma unroll
        for (int r = 0; r < 16; ++r) acc[r] = 0.f;
#pragma unroll
        for (int kk = 0; kk < 2; ++kk) {
          bf16x8 a = *(const bf16x8*)(sBT + (cb * 32 + l31) * 40 + ((kk * 16 + 8 * hl) ^ swz32(l31)));
          bf16x8 bb = *(const bf16x8*)(sSAT + (vb * 32 + l31) * 40 + kk * 16 + 8 * hl);
          acc = mfma32(a, bb, acc);
        }
        if (vb < 2) {
#pragma unroll
          for (int kk = 0; kk < 2; ++kk) {
            bf16x8 a = *(const bf16x8*)(sKT + (cb * 32 + l31) * 40 + ((kk * 16 + 8 * hl) ^ swz32(l31)));
            bf16x8 bb = *(const bf16x8*)(sVT + (vb * 32 + l31) * 40 + ((kk * 16 + 8 * hl) ^ swz32(l31)));
            acc = mfma32(a, bb, acc);
          }
        }
#pragma unroll
        for (int r = 0; r < 16; ++r) Zm[cb][r] = sPT[cb * 32 + acc_row(r, lane)] * (Zm[cb][r] + acc[r]);
      }
#pragma unroll
      for (int cb = 0; cb < 2; ++cb)
#pragma unroll
        for (int g = 0; g < 4; ++g) {
          u32x2 pk; pk.x = pack2(Zm[cb][4 * g], Zm[cb][4 * g + 1]); pk.y = pack2(Zm[cb][4 * g + 2], Zm[cb][4 * g + 3]);
          *(u32x2*)(sZ + (vb * 32 + l31) * 72 + cb * 32 + 8 * g + 4 * hl) = pk;
        }
    }
  }
  if (!FULL) {
    float* Zs = segZ + ((size_t)sid * RW_NSEG + seg) * 64 * 128;
#pragma unroll
    for (int cb = 0; cb < 2; ++cb)
#pragma unroll
      for (int r = 0; r < 16; ++r) Zs[(cb * 32 + acc_row(r, lane)) * 128 + wave * 32 + l31] = Zm[cb][r];
  }
}

constexpr int LRU_NCH = (CTXL + SEQ) / 64;
constexpr size_t OFF_ACUM0 = OFF_PU;
static_assert((size_t)NLAT * 512 * 2 <= (size_t)2 * NEXP * 1024, "acum0");

struct LruRaw { u32x4 x[2][4]; };
DEV void lru_load_raw(const Params& P, int sid, int cc, LruRaw& R) {
  constexpr int NC_CTX = CTXL / 64;
  const int tid = threadIdx.x;
  const int d = sid & 1, blk = (sid >> 1) & 7, b = sid >> 4;
  const bf16_t* proj = (const bf16_t*)(P.ws + OFF_PROJ);
  const int sgi = cc >= NC_CTX;
  const int row0 = sgi ? NCTX + b * SEQ : b * CTXL;
  const int len = sgi ? SEQ : CTXL;
  const int cl = (sgi ? cc - NC_CTX : cc) * 64;
  const int lch = blk * 64 + (tid & 7) * 8;
  const u32x4 z4 = {0u, 0u, 0u, 0u};
#pragma unroll
  for (int i = 0; i < 2; ++i) {
    int c = tid + i * 256, r = c >> 3;
    int p = cl + r, pos = d ? len - 1 - p : p;
#pragma unroll
    for (int tap = 0; tap < 4; ++tap) {
      int pp = pos + tap - 2;
      R.x[i][tap] = (pp >= 0 && pp < len) ? *(const u32x4*)(proj + (size_t)(row0 + pp) * ODC + 2304 + lch) : z4;
    }
  }
}

DEV void st_lru_chunk(const Params& P, int sid, int cc, int nsid, int ncc, bool has_next, LruRaw& R, unsigned char* smem) {
  constexpr int NC_CTX = CTXL / 64;
  const int tid = threadIdx.x, lane = tid & 63, wave = tid >> 6;
  const int d = sid & 1, blk = (sid >> 1) & 7, b = sid >> 4;
  float* sXc = (float*)smem;
  float* sAc = sXc + 4096;
  float* sBc = sAc + 4096;
  float* sU = sBc + 4096;
  bf16_t* sAop = (bf16_t*)(sU + 4096);
  float* sQA = (float*)(sAop + 64 * 72);
  float* sQH = sQA + 256;
  int* sRow = (int*)(sQH + 256);
  const bf16_t* proj = (const bf16_t*)(P.ws + OFF_PROJ);
  bf16_t* uout = (bf16_t*)(P.ws + OFF_LORA) + (size_t)d * NTOK * 512;
  bf16_t* aout = (bf16_t*)(P.ws + (d ? OFF_ACUM1 : OFF_ACUM0));
  const bf16_t* lruT = (const bf16_t*)(P.ws + OFF_LRUT) + (size_t)(d * 8 + blk) * 128 * 64;
  float* chunkS = (float*)(P.ws + OFF_LRUCS) + ((size_t)sid * LRU_NCH + cc) * 128;
  const float* cw = P.in[I_LCONVW];
  const float* cb = P.in[I_LCONVB];
  const int tr = (wave >> 1) * 32, nc0 = (wave & 1) * 64;
  const int sgi = cc >= NC_CTX;
  const int row0 = sgi ? NCTX + b * SEQ : b * CTXL;
  const int len = sgi ? SEQ : CTXL;
  const int cl = (sgi ? cc - NC_CTX : cc) * 64;
  __syncthreads();
  if (tid < 64) { int p = cl + tid; sRow[tid] = row0 + (d ? len - 1 - p : p); }
  {
    const int lc8 = (tid & 7) * 8, lch = blk * 64 + lc8;
#pragma unroll
    for (int i = 0; i < 2; ++i) {
      int c = tid + i * 256, r = c >> 3;
      int p = cl + r, pos = d ? len - 1 - p : p;
      float o[8];
      f32x4 c0 = *(const f32x4*)(cb + lch), c1 = *(const f32x4*)(cb + lch + 4);
      o[0] = c0.x; o[1] = c0.y; o[2] = c0.z; o[3] = c0.w; o[4] = c1.x; o[5] = c1.y; o[6] = c1.z; o[7] = c1.w;
#pragma unroll
      for (int tap = 0; tap < 4; ++tap) {
        float x[8];
        unpack8(R.x[i][tap], x);
        f32x4 w0 = *(const f32x4*)(cw + tap * 512 + lch), w1 = *(const f32x4*)(cw + tap * 512 + lch + 4);
        o[0] += w0.x * x[0]; o[1] += w0.y * x[1]; o[2] += w0.z * x[2]; o[3] += w0.w * x[3];
        o[4] += w1.x * x[4]; o[5] += w1.y * x[5]; o[6] += w1.z * x[6]; o[7] += w1.w * x[7];
      }
      { f32x4 o0 = {o[0], o[1], o[2], o[3]}, o1 = {o[4], o[5], o[6], o[7]};
        *(f32x4*)(sXc + r * 64 + lc8) = o0; *(f32x4*)(sXc + r * 64 + lc8 + 4) = o1; }
      *(u32x4*)(sAop + r * 72 + lc8) = pack8(o);
    }
  }
  if (has_next) lru_load_raw(P, nsid, ncc, R);
  __syncthreads();
  {
    f32x16 acc[2];
#pragma unroll
    for (int j = 0; j < 2; ++j)
#pragma unroll
      for (int r = 0; r < 16; ++r) acc[j][r] = 0.f;
#pragma unroll
    for (int kk = 0; kk < 4; ++kk) {
      bf16x8 a = *(const bf16x8*)(sAop + (tr + (lane & 31)) * 72 + kk * 16 + 8 * (lane >> 5));
#pragma unroll
      for (int j = 0; j < 2; ++j) {
        bf16x8 bb = *(const bf16x8*)(lruT + (nc0 + j * 32 + (lane & 31)) * 64 + kk * 16 + 8 * (lane >> 5));
        acc[j] = mfma32(a, bb, acc[j]);
      }
    }
#pragma unroll
    for (int j = 0; j < 2; ++j) {
      const int e = nc0 + j * 32 + (lane & 31);
      const int ch = blk * 64 + (e & 63);
      const float ebias = e < 64 ? P.in[I_BA][d * 512 + ch] : P.in[I_BI][d * 512 + ch];
      const float esp = softplusf_(-P.in[I_LAM][d * 512 + ch]);
#pragma unroll
      for (int r = 0; r < 16; ++r) {
        int t = tr + acc_row(r, lane);
        float g = sigmoidf_(acc[j][r] + ebias);
        if (e < 64) { float a_ = fexp(-8.f * g * esp); sAc[t * 64 + e] = a_; sU[t * 64 + e] = fsqrt(fmaxf(1.f - a_ * a_, 0.f)); }
        else sBc[t * 64 + (e - 64)] = g * sXc[t * 64 + (e - 64)];
      }
    }
  }
  __syncthreads();
  const int c = tid & 63, q = tid >> 6;
  {
    float av[16], hv[16];
#pragma unroll
    for (int i = 0; i < 16; ++i) {
      const int t = q * 16 + i;
      av[i] = sAc[t * 64 + c];
      hv[i] = sU[t * 64 + c] * sBc[t * 64 + c];
    }
    float h = 0.f, ap = 1.f;
#pragma unroll
    for (int i = 0; i < 16; ++i) { h = av[i] * h + hv[i]; ap *= av[i]; hv[i] = h; av[i] = ap; }
    sQA[q * 64 + c] = ap; sQH[q * 64 + c] = h;
    __syncthreads();
    float hin = 0.f, ain = 1.f;
    for (int q2 = 0; q2 < q; ++q2) { hin = sQA[q2 * 64 + c] * hin + sQH[q2 * 64 + c]; ain *= sQA[q2 * 64 + c]; }
#pragma unroll
    for (int i = 0; i < 16; ++i) {
      const int t = q * 16 + i;
      sU[t * 64 + c] = hv[i] + av[i] * hin;
      sAc[t * 64 + c] = av[i] * ain;
    }
    if (q == 3) { chunkS[c] = av[15] * ain; chunkS[64 + c] = hv[15] + av[15] * hin; }
  }
  __syncthreads();
  if (sgi) {
#pragma unroll
    for (int i = 0; i < 2; ++i) {
      int cidx = tid + i * 256, r = cidx >> 3, c8 = (cidx & 7) * 8;
      float u8[8], a8[8];
      ld8(sU + r * 64 + c8, u8); ld8(sAc + r * 64 + c8, a8);
      const int row = sRow[r];
      *(u32x4*)(uout + (size_t)row * 512 + blk * 64 + c8) = pack8(u8);
      *(u32x4*)(aout + (size_t)(row - NCTX) * 512 + blk * 64 + c8) = pack8(a8);
    }
  }
}

DEV void st_lru_carry(const Params& P, int sid, unsigned char* smem) {
  const int tid = threadIdx.x, c = tid & 63, p = tid >> 6;
  constexpr int NQ = (LRU_NCH + 3) / 4, NBATCH = 13;
  const int c0 = p * NQ, c1 = (c0 + NQ < LRU_NCH) ? c0 + NQ : LRU_NCH;
  const float* cs = (const float*)(P.ws + OFF_LRUCS) + (size_t)sid * LRU_NCH * 128;
  float* hs = (float*)(P.ws + OFF_LRUHS) + (size_t)sid * LRU_NCH * 64;
  float* sA = (float*)smem;
  float* sH = sA + 256;
  float A = 1.f, H = 0.f;
  for (int cc0 = c0; cc0 < c1; cc0 += NBATCH) {
    float a[NBATCH], bb[NBATCH];
#pragma unroll
    for (int i = 0; i < NBATCH; ++i) {
      const int cc = cc0 + i < LRU_NCH ? cc0 + i : LRU_NCH - 1;
      a[i] = cs[(size_t)cc * 128 + c]; bb[i] = cs[(size_t)cc * 128 + 64 + c];
    }
#pragma unroll
    for (int i = 0; i < NBATCH; ++i) if (cc0 + i < c1) { H = a[i] * H + bb[i]; A *= a[i]; }
  }
  __syncthreads();
  sA[p * 64 + c] = A; sH[p * 64 + c] = H;
  __syncthreads();
  float h = 0.f;
  for (int p2 = 0; p2 < p; ++p2) h = sA[p2 * 64 + c] * h + sH[p2 * 64 + c];
  for (int cc0 = c0; cc0 < c1; cc0 += NBATCH) {
    float a[NBATCH], bb[NBATCH];
#pragma unroll
    for (int i = 0; i < NBATCH; ++i) {
      const int cc = cc0 + i < LRU_NCH ? cc0 + i : LRU_NCH - 1;
      a[i] = cs[(size_t)cc * 128 + c]; bb[i] = cs[(size_t)cc * 128 + 64 + c];
    }
#pragma unroll
    for (int i = 0; i < NBATCH; ++i) if (cc0 + i < c1) { hs[(size_t)(cc0 + i) * 64 + c] = h; h = a[i] * h + bb[i]; }
  }
}

DEV void st_finish_l1(const Params& P, int row) {
  const int lane = threadIdx.x & 63;
  bf16_t* hb = (bf16_t*)(P.ws + OFF_HBUF) + (size_t)row * 1024;
  const bf16_t* proj = (const bf16_t*)(P.ws + OFF_PROJ);
  const bf16_t* lora = (const bf16_t*)(P.ws + OFF_LORA);
  const float* mu = P.in[I_MU];
  const int ch = lane * 8;
  float y0[8], y1[8];
  unpack8(*(const u32x4*)(hb + ch), y0);
  unpack8(*(const u32x4*)(hb + 512 + ch), y1);
  float sm = 0.f;
#pragma unroll
  for (int j = 0; j < 8; ++j) { y0[j] += y1[j]; sm += y0[j]; }
  sm = sum8(sm);
  const float mean = sm * (1.f / 64.f);
  float sv = 0.f;
#pragma unroll
  for (int j = 0; j < 8; ++j) { float dlt = y0[j] - mean; sv += dlt * dlt; }
  sv = sum8(sv);
  const float rstd = frsq(sv * (1.f / 64.f) + 64e-5f);
  float a0[8], a1[8], g[8], u0[8], u1[8], gb[8];
  unpack8(*(const u32x4*)(lora + ((size_t)2 * NTOK + row) * 512 + ch), a0);
  unpack8(*(const u32x4*)(lora + ((size_t)3 * NTOK + row) * 512 + ch), a1);
  unpack8(*(const u32x4*)(lora + ((size_t)4 * NTOK + row) * 512 + ch), g);
  unpack8(*(const u32x4*)(lora + ((size_t)0 * NTOK + row) * 512 + ch), u0);
  unpack8(*(const u32x4*)(lora + ((size_t)1 * NTOK + row) * 512 + ch), u1);
  if (row >= NCTX) {
    const int bb_ = (row - NCTX) / SEQ, pos = (row - NCTX) % SEQ, blk = ch >> 6;
    float ac[8];
#pragma unroll
    for (int dd = 0; dd < 2; ++dd) {
      const int pidx = dd ? SEQ - 1 - pos : pos;
      const int cc = CTXL / 64 + pidx / 64;
      const int sid = (bb_ * 8 + blk) * 2 + dd;
      const float* hs = (const float*)(P.ws + OFF_LRUHS) + ((size_t)sid * LRU_NCH + cc) * 64 + (ch & 63);
      unpack8(*(const u32x4*)((const bf16_t*)(P.ws + (dd ? OFF_ACUM1 : OFF_ACUM0)) + (size_t)(row - NCTX) * 512 + ch), ac);
      f32x4 h0 = *(const f32x4*)hs, h1 = *(const f32x4*)(hs + 4);
      float* u = dd ? u1 : u0;
      u[0] += ac[0] * h0.x; u[1] += ac[1] * h0.y; u[2] += ac[2] * h0.z; u[3] += ac[3] * h0.w;
      u[4] += ac[4] * h1.x; u[5] += ac[5] * h1.y; u[6] += ac[6] * h1.z; u[7] += ac[7] * h1.w;
    }
  }
  unpack8(*(const u32x4*)(proj + (size_t)row * ODC + 1792 + ch), gb);
  float rv[8], vv[8], kv[8];
  float sdot = 0.f;
  float pka[8], prk[8], plw[8], plb[8];
  ld8(P.in[I_KA] + ch, pka); ld8(P.in[I_RK] + ch, prk); ld8(P.in[I_LNW] + ch, plw); ld8(P.in[I_LNB] + ch, plb);
  mix8(proj, row, ch, mu, rv);
  mix8(proj, row, 512 + ch, mu, kv);
  mix8(proj, row, 1024 + ch, mu, vv);
#pragma unroll
  for (int j = 0; j < 8; ++j) {
    float r = rv[j];
    float k = kv[j];
    float am = 0.5f * (a0[j] + a1[j]);
    float kb = k * (1.f + (am - 1.f) * pka[j]);
    sdot += r * kb * prk[j];
    rv[j] = r;
  }
  sdot = sum8(sdot);
  float f1[8], f2[8];
#pragma unroll
  for (int j = 0; j < 8; ++j) {
    float yn = (y0[j] - mean) * rstd * plw[j] + plb[j];
    yn += sdot * vv[j];
    f1[j] = yn * g[j];
    f2[j] = (u0[j] + u1[j]) * geluf_(gb[j]);
  }
  *(u32x4*)(hb + ch) = pack8(f1);
  *(u32x4*)(hb + 512 + ch) = pack8(f2);
}

DEV unsigned fkey(float f) { unsigned u; __builtin_memcpy(&u, &f, 4); return (u >> 31) ? ~u : (u | 0x80000000u); }
DEV float keyf(unsigned u) { u = (u >> 31) ? (u & 0x7fffffffu) : ~u; float f; __builtin_memcpy(&f, &u, 4); return f; }
DEV void key_insert(unsigned x, unsigned* v) {
#pragma unroll
  for (int j = 0; j < 16; ++j) { unsigned hi = v[j] > x ? v[j] : x; x = v[j] > x ? x : v[j]; v[j] = hi; }
}
DEV void key_cx(unsigned& hi, unsigned& lo) { unsigned a = hi, b = lo; hi = a > b ? a : b; lo = a > b ? b : a; }
DEV void key_sort16(unsigned* v) {
#pragma unroll
  for (int k = 2; k <= 16; k <<= 1)
#pragma unroll
    for (int j = k >> 1; j > 0; j >>= 1)
#pragma unroll
      for (int i = 0; i < 16; ++i) {
        const int l = i ^ j;
        if (l > i) { if ((i & k) == 0) key_cx(v[i], v[l]); else key_cx(v[l], v[i]); }
      }
}
DEV void key_merge16(unsigned* a, const unsigned* b) {
#pragma unroll
  for (int i = 0; i < 16; ++i) a[i] = a[i] > b[15 - i] ? a[i] : b[15 - i];
#pragma unroll
  for (int j = 8; j > 0; j >>= 1)
#pragma unroll
    for (int i = 0; i < 16; ++i) { const int l = i ^ j; if (l > i) key_cx(a[i], a[l]); }
}

DEV void st_peer_topk(const Params& P, int layer, int tile, int h, unsigned char* smem) {
  const int tid = threadIdx.x;
  const bf16_t* q = (const bf16_t*)(P.ws + OFF_Q);
  const bf16_t* keys = (const bf16_t*)(P.ws + OFF_KEYS) + (size_t)(layer * 8 + h) * 2 * 128 * 128;
  float* sS = (float*)smem;
  const int m0 = tile * 128;
  const int tok = tid & 127, half = tid >> 7;
  unsigned kl[2][16];
#pragma unroll
  for (int p = 0; p < 2; ++p) {
    EpiScoreLds epi{sS, m0};
    gemm_tile_128<true>(q + (h * 2 + p) * 128, 2048, NTOK, keys + p * 128 * 128, 128, 128, 128, m0, 0, epi, smem);
    __syncthreads();
    float* row = sS + tok * 129 + half * 64;
#pragma unroll
    for (int g = 0; g < 4; ++g) {
      unsigned grp[16];
#pragma unroll
      for (int j = 0; j < 16; ++j) grp[j] = (fkey(row[g * 16 + j]) & ~127u) | (unsigned)(127 - (half * 64 + g * 16 + j));
      key_sort16(grp);
      if (g == 0) {
#pragma unroll
        for (int j = 0; j < 16; ++j) kl[p][j] = grp[j];
      } else key_merge16(kl[p], grp);
    }
    if (half == 1) {
#pragma unroll
      for (int j = 0; j < 16; ++j) row[j] = __builtin_bit_cast(float, kl[p][j]);
    }
    __syncthreads();
    if (half == 0) {
      unsigned oth[16];
#pragma unroll
      for (int j = 0; j < 16; ++j) oth[j] = __builtin_bit_cast(unsigned, sS[tok * 129 + 64 + j]);
      key_merge16(kl[p], oth);
    }
    __syncthreads();
  }
  if (tid < 128) {
    float sv0[16], sv1[16];
    int* irow = (int*)(sS + tid * 129);
#pragma unroll
    for (int j = 0; j < 16; ++j) {
      sv0[j] = keyf((kl[0][j] & ~127u) | 64u); sv1[j] = keyf((kl[1][j] & ~127u) | 64u);
      irow[j] = 127 - (int)(kl[0][j] & 127u); irow[16 + j] = 127 - (int)(kl[1][j] & 127u);
    }
    unsigned best[16];
#pragma unroll
    for (int j = 0; j < 16; ++j) best[j] = 0u;
#pragma unroll
    for (int i = 0; i < 16; ++i)
#pragma unroll
      for (int j = 0; j < 16; ++j)
        if ((i + 1) * (j + 1) <= 16) key_insert((fkey(sv0[i] + sv1[j]) & ~255u) | (unsigned)(255 - (i * 16 + j)), best);
    float e[16], sum = 0.f;
    const float b0 = keyf((best[0] & ~255u) | 128u);
#pragma unroll
    for (int j = 0; j < 16; ++j) { e[j] = fexp(keyf((best[j] & ~255u) | 128u) - b0); sum += e[j]; }
    const float inv = 1.f / sum;
    int* pidx = (int*)(P.ws + OFF_PIDX) + (size_t)(m0 + tid) * 128 + h * 16;
    float* pg = (float*)(P.ws + OFF_PGATE) + (size_t)(m0 + tid) * 128 + h * 16;
#pragma unroll
    for (int j = 0; j < 16; ++j) {
      const int pos = 255 - (int)(best[j] & 255u);
      pidx[j] = irow[pos >> 4] * 128 + irow[16 + (pos & 15)];
      pg[j] = e[j] * inv;
    }
  }
}

DEV void st_peer_experts(const Params& P, int layer, int row) {
  const int lane = threadIdx.x & 63;
  const bf16_t* xb = (const bf16_t*)(P.ws + OFF_HBUF) + (size_t)row * 1024;
  const unsigned char* U = P.ws + OFF_PU;
  const int* pidx = (const int*)(P.ws + OFF_PIDX) + (size_t)row * 128;
  const float* pg = (const float*)(P.ws + OFF_PGATE) + (size_t)row * 128;
  float x[16], acc[16];
  unpack8(*(const u32x4*)(xb + lane * 16), x);
  unpack8(*(const u32x4*)(xb + lane * 16 + 8), x + 8);
#pragma unroll
  for (int j = 0; j < 16; ++j) acc[j] = 0.f;
  const int b3 = (lane >> 3) & 1;
  const int mypick = (lane >> 3) & 7;
#ifdef CPU_EMU
#define PEER_SID(id) (id)
#else
#define PEER_SID(id) __builtin_amdgcn_readfirstlane(id)
#endif
  const unsigned lo12 = lane * 12, lo8 = PEER_VOFF + lane * 8;
#define PEER_LDU(i, id) do { const unsigned* up_ = (const unsigned*)(U + (size_t)(unsigned)(id) * PEER_ROWB + lo12); \
    uu[i].x = up_[0]; uu[i].y = up_[1]; uu[i].z = up_[2]; } while (0)
#define PEER_LDV(i, id) vv[i] = *(const u32x2*)(U + (size_t)(unsigned)(id) * PEER_ROWB + lo8)
#define PEER_IDS(v0, v1) {PEER_SID((int)v0.x), PEER_SID((int)v0.y), PEER_SID((int)v0.z), PEER_SID((int)v0.w), \
                          PEER_SID((int)v1.x), PEER_SID((int)v1.y), PEER_SID((int)v1.z), PEER_SID((int)v1.w)}
  u32x3 uu[8]; u32x2 vv[8];
  int cid[8];
  {
    const u32x4 p0 = *(const u32x4*)pidx, p1 = *(const u32x4*)(pidx + 4);
    const int id[8] = PEER_IDS(p0, p1);
#pragma unroll
    for (int i = 0; i < 8; ++i) { cid[i] = id[i]; PEER_LDU(i, id[i]); }
  }
  u32x4 n0 = *(const u32x4*)(pidx + 8), n1 = *(const u32x4*)(pidx + 12);
  float gcur = pg[mypick];
  for (int k0 = 0; k0 < 128; k0 += 8) {
#pragma unroll
    for (int i = 0; i < 8; ++i) PEER_LDV(i, cid[i]);
    const int nid[8] = PEER_IDS(n0, n1);
    {
      const int k2 = k0 + 16 < 128 ? k0 + 16 : 120;
      n0 = *(const u32x4*)(pidx + k2); n1 = *(const u32x4*)(pidx + k2 + 4);
    }
    const float gnxt = pg[(k0 + 8 < 128 ? k0 + 8 : 120) + mypick];
    float dsum[8];
#pragma unroll
    for (int i = 0; i < 8; i += 2) {
      float ufa[16], ufb[16];
#ifndef CPU_EMU
      __builtin_amdgcn_sched_barrier(0);
#endif
      unpack2x16_fp6(uu[i], uu[i + 1], ufa, ufb);
      PEER_LDU(i, nid[i]); PEER_LDU(i + 1, nid[i + 1]);
      typedef __attribute__((ext_vector_type(2))) float f32x2v;
      f32x2v da2 = {0.f, 0.f}, db2 = {0.f, 0.f};
#pragma unroll
      for (int j = 0; j < 8; ++j) {
        const f32x2v xx = {x[2 * j], x[2 * j + 1]};
        const f32x2v ua = {ufa[2 * j], ufa[2 * j + 1]}, ub = {ufb[2 * j], ufb[2 * j + 1]};
        da2 = xx * ua + da2; db2 = xx * ub + db2;
      }
      dsum[i] = da2.x + da2.y; dsum[i + 1] = db2.x + db2.y;
    }
    float e4[4], e2[2], g;
#pragma unroll
    for (int i = 0; i < 4; ++i) e4[i] = swap32_sum(dsum[i], dsum[4 + i]);
#pragma unroll
    for (int i = 0; i < 2; ++i) e2[i] = swap16_sum(e4[i], e4[2 + i]);
    {
      float mine = b3 ? e2[1] : e2[0], send = b3 ? e2[0] : e2[1];
      g = mine + dpp_xor<8>(send);
    }
    g = sum8(g);
    const float mycoef = gcur * geluf_(g * (1.f / PEER_USCALE));
#pragma unroll
    for (int i = 0; i < 8; ++i) {
      const float coef = wreadlane(mycoef, i * 8);
      float vf[16];
      unpack8_fp4(vv[i].x, vf); unpack8_fp4(vv[i].y, vf + 8);
#pragma unroll
      for (int j = 0; j < 16; ++j) acc[j] += coef * vf[j];
    }
#pragma unroll
    for (int i = 0; i < 8; ++i) cid[i] = nid[i];
    gcur = gnxt;
  }
#undef PEER_LDU
#undef PEER_LDV
#undef PEER_IDS
#undef PEER_SID
  float* xr = row < NCTX ? (float*)(P.ws + OFF_CTXRES) + (size_t)row * 1024 : P.out + (size_t)(row - NCTX) * 1024;
  const float* g2 = (const float*)(P.ws + OFF_MODV) + ((size_t)layer * 3 + mod_row(row)) * 6144 + 5 * 1024;
  float o[16];
#pragma unroll
  for (int q = 0; q < 4; ++q) {
    const int c = lane * 16 + q * 4;
    f32x4 a = *(const f32x4*)(xr + c), ga = *(const f32x4*)(g2 + c);
    o[q * 4 + 0] = a.x + ga.x * acc[q * 4 + 0] * (1.f / PEER_VSCALE); o[q * 4 + 1] = a.y + ga.y * acc[q * 4 + 1] * (1.f / PEER_VSCALE);
    o[q * 4 + 2] = a.z + ga.z * acc[q * 4 + 2] * (1.f / PEER_VSCALE); o[q * 4 + 3] = a.w + ga.w * acc[q * 4 + 3] * (1.f / PEER_VSCALE);
  }
  float ss = 0.f;
#pragma unroll
  for (int j = 0; j < 16; ++j) ss += o[j] * o[j];
  ss = wave_sum(ss);
  const float rstd = frsq(ss * (1.f / 1024.f) + 1e-6f);
  if (layer == 1) {
    float fn[16]; ld8(P.in[I_FNORM] + lane * 16, fn); ld8(P.in[I_FNORM] + lane * 16 + 8, fn + 8);
#pragma unroll
    for (int j = 0; j < 16; ++j) o[j] *= rstd * fn[j];
  }
#pragma unroll
  for (int q = 0; q < 4; ++q) {
    f32x4 a = {o[q * 4 + 0], o[q * 4 + 1], o[q * 4 + 2], o[q * 4 + 3]};
    *(f32x4*)(xr + lane * 16 + q * 4) = a;
  }
  if (layer == 0) {
    const float* mv = (const float*)(P.ws + OFF_MODV) + ((size_t)1 * 3 + mod_row(row)) * 6144;
    const float* nw = P.in[I_NORM1] + 1024;
    float hh[16];
#pragma unroll
    for (int q = 0; q < 4; ++q) {
      const int c = lane * 16 + q * 4;
      f32x4 w4 = *(const f32x4*)(nw + c), s4 = *(const f32x4*)(mv + 1024 + c), h4 = *(const f32x4*)(mv + c);
      hh[q * 4 + 0] = o[q * 4 + 0] * rstd * w4.x * (1.f + s4.x) + h4.x; hh[q * 4 + 1] = o[q * 4 + 1] * rstd * w4.y * (1.f + s4.y) + h4.y;
      hh[q * 4 + 2] = o[q * 4 + 2] * rstd * w4.z * (1.f + s4.z) + h4.z; hh[q * 4 + 3] = o[q * 4 + 3] * rstd * w4.w * (1.f + s4.w) + h4.w;
    }
    bf16_t* hb = (bf16_t*)(P.ws + OFF_HBUF) + (size_t)row * 1024 + lane * 16;
    *(u32x4*)hb = pack8(hh);
    *(u32x4*)(hb + 8) = pack8(hh + 8);
  }
}


#define FOR_TILES_XCD(MT0, MT1, NT, mt, nt)                                                     \
  for (int _x = blockIdx.x & 7, _mlo = (MT0) + (((MT1) - (MT0)) * _x) / 8,                        \
           _mhi = (MT0) + (((MT1) - (MT0)) * (_x + 1)) / 8, _i = blockIdx.x >> 3,                 \
           _cnt = (_mhi - _mlo) * (NT), mt = 0, nt = 0;                                           \
       _i < _cnt && ((mt = _mlo + _i / (NT)), (nt = _i % (NT)), true); _i += (int)(gridDim.x >> 3))

#ifndef PHASE_LIST
#define PHASE_LIST(X) X(0) X(1) X(2) X(22) X(23) X(3) X(4) X(5) X(6) X(7) X(8) X(9) X(11) X(12) X(13) X(30) X(14) X(15) X(31) X(16) X(17) X(18) X(19) X(20) X(21)
#endif
constexpr int PH_LAST = 21;

template <int ph>
DEV void run_phase(const Params& P, unsigned char* smem) {
  int bid_ = blockIdx.x, wave_ = threadIdx.x >> 6;
  OPAQUE_S(bid_); OPAQUE(wave_);
  const int bid = bid_, nb = gridDim.x;
  const int wave = wave_;
  unsigned char* ws = P.ws;
  constexpr int layer = ((ph >= 10 && ph <= 21) || ph >= 30) ? 1 : 0;
  const float* modv_l = (const float*)(ws + OFF_MODV) + (size_t)layer * 3 * 6144;
  switch (ph) {
    case 0:
      for (int t = NTRANS + bid; t < NPREP; t += nb) st_prep(P, t, smem);
      break;
    case 1: case 10:
      if (ph == 1) for (int t = nb - 1 - bid; t < NTRANS; t += nb) st_prep(P, t, smem);
      for (int t = bid; t < NTOK / 4; t += nb) st_normmod(P, layer, 0, t * 4 + wave);
      break;
    case 2: {
      EpiProjL0T epi{(bf16_t*)(ws + OFF_PROJ), (float*)(ws + OFF_GATES)};
      FOR_TILES_XCD(0, NTOK / 256, 25, mt, nt)
        gemm_tile_128x256<EpiProjL0T, true>((const bf16_t*)(ws + OFF_WEVIN), 1024, EVC, (const bf16_t*)(ws + OFF_HBUF), 1024, NTOK, 1024,
                                            nt * 128, mt * 256, epi, smem);
    } break;
    case 22:
      for (int t = bid; t < NTOK / 4; t += nb) st_xbc_conv(P, t * 4 + wave);
      for (int t = bid; t < NPCONV; t += nb) st_peer_conv(P, 0, t);
      break;
    case 23:
      for (int t = bid; t < 48 * LA_NSEG; t += nb) {
        int sid = t % 48, seg = t / 48;
        if (sid < 16) st_linattn_seg<true, false>(P, sid, seg, smem);
        else st_linattn_seg<false, false>(P, sid - 16, seg, smem);
      }
      break;
    case 3:
      for (int t = bid; t < 48 * LA_NSEG; t += nb) {
        int sid = t % 48, seg = t / 48;
        if (sid < 16) st_linattn_seg<true, true>(P, sid, seg, smem);
        else st_linattn_seg<false, true>(P, sid - 16, seg, smem);
      }
      break;
    case 4:
      for (int t = bid; t < NTOK / 4; t += nb) st_finish_l0(P, t * 4 + wave);
      break;
    case 5: case 17: {
      EpiOutProjT epi{layer == 0 ? P.in[I_X] : P.out, P.in[I_CTX], P.out, (float*)(ws + OFF_CTXRES), modv_l};
      const bf16_t* Wt = (const bf16_t*)(ws + (layer == 0 ? OFF_WEVOUT : OFF_WODOUT));
      FOR_TILES_XCD(layer == 0 ? 0 : NCTX / 256, NTOK / 256, 8, mt, nt)
        gemm_tile_128x256<EpiOutProjT, true>(Wt, 1024, 1024, (const bf16_t*)(ws + OFF_HBUF), 1024, NTOK, 1024, nt * 128, mt * 256, epi, smem);
    } break;
    case 6: case 18: {
      const int r0 = layer == 0 ? 0 : NCTX / 4;
      for (int t = r0 + bid; t < NTOK / 4; t += nb) st_normmod(P, layer, 1, t * 4 + wave);
      if (ph == 18) for (int t = bid; t < NPCONV; t += nb) st_peer_conv(P, 1, t);
    } break;
    case 7: case 19: {
      EpiStoreBfT epi{(bf16_t*)(ws + OFF_Q), 2048};
      const bf16_t* Wt = (const bf16_t*)(ws + OFF_WQ) + (size_t)layer * 2048 * 1024;
      FOR_TILES_XCD(layer == 0 ? 0 : NCTX / 256, NTOK / 256, 16, mt, nt)
        gemm_tile_128x256<EpiStoreBfT, true>(Wt, 1024, 2048, (const bf16_t*)(ws + OFF_HBUF), 1024, NTOK, 1024, nt * 128, mt * 256, epi, smem);
    } break;
    case 8: case 20: {
      const int t0 = layer == 0 ? 0 : CTILE * 8;
      for (int t = t0 + bid; t < NTILE * 8; t += nb) st_peer_topk(P, layer, t / 8, t % 8, smem);
    } break;
    case 9: case 21: {
      const int r0 = layer == 0 ? 0 : NCTX / 4;
      for (int t = r0 + bid; t < NTOK / 4; t += nb) st_peer_experts(P, layer, t * 4 + wave);
    } break;
    case 11: {
      EpiStoreBfT epi{(bf16_t*)(ws + OFF_PROJ), ODC};
      FOR_TILES_XCD(0, NTOK / 256, 22, mt, nt)
        gemm_tile_128x256<EpiStoreBfT, true>((const bf16_t*)(ws + OFF_WODIN), 1024, ODC, (const bf16_t*)(ws + OFF_HBUF), 1024, NTOK, 1024,
                                             nt * 128, mt * 256, epi, smem);
    } break;
    case 12:
      for (int t = bid; t < NTOK / 8; t += nb) st_lora_act(P, t * 8 + wave * 2);
      break;
    case 13:
      for (int t = bid; t < NTILE * 20; t += nb) {
        int job = t / (NTILE * 4), tt = t % (NTILE * 4);
        int mt = tt / 4, nt = tt % 4;
        bf16_t* dst = (bf16_t*)(ws + OFF_LORA) + (size_t)job * NTOK * 512;
        const bf16_t* A = (const bf16_t*)(ws + OFF_HBUF) + (job < 2 ? 0 : (job < 4 ? 64 : 128));
        const bf16_t* Bt = job < 2 ? (const bf16_t*)(ws + OFF_WUP) + (size_t)job * 512 * 64
                         : job < 4 ? (const bf16_t*)(ws + OFF_AUP) + (size_t)(job - 2) * 512 * 64
                                   : (const bf16_t*)(ws + OFF_GUP);
        const float* bias = job < 2 ? P.in[I_W0] + job * 512 : (job < 4 ? P.in[I_A0] + (job - 2) * 512 : nullptr);
        const int K = job < 4 ? 64 : 128;
        EpiStoreBfBiasT epi{dst, 512, bias, job < 2 ? 1 : (job < 4 ? 2 : 0)};
        gemm_tile_128<false, EpiStoreBfBiasT, true>(Bt, K, 512, A, 1024, NTOK, K, nt * 128, mt * 128, epi, smem);
      }
      break;
    case 30:
      for (int t = bid; t < 32 * RW_NSEG; t += nb) st_rwkv_seg<false>(P, t % 32, t / 32, smem);
      break;
    case 14:
      for (int t = bid; t < 32 * RW_NSEG; t += nb) st_rwkv_seg<true>(P, t % 32, t / 32, smem);
      break;
    case 15:
      {
        LruRaw R;
        if (bid < 32 * LRU_NCH) lru_load_raw(P, bid % 32, bid / 32, R);
        for (int t = bid; t < 32 * LRU_NCH; t += nb) {
          const int tn = t + nb;
          st_lru_chunk(P, t % 32, t / 32, tn % 32, tn / 32, tn < 32 * LRU_NCH, R, smem);
        }
      }
      break;
    case 31:
      if (bid < 32) st_lru_carry(P, bid, smem);
      break;
    case 16:
      for (int t = bid; t < NTOK / 4; t += nb) st_finish_l1(P, t * 4 + wave);
      break;
    default: break;
  }
}


#ifndef CPU_EMU
#define XB_TMO      128
#define XB_XCNT(j)  (256  + 64 * (j))
#define XB_XSUB(j)  (1280 + 64 * (j))
#define XB_XGEN(j)  (2304 + 64 * (j))
#define XB_TOP      3328
#define XB_TOPGEN   3392
#define XCD_BAR_WORDS 3456
#define XB_SPIN_CAP (1u << 20)
#define LAS __attribute__((address_space(3)))
__device__ __forceinline__ unsigned xb_ld(unsigned* p)              { return __hip_atomic_load(p, __ATOMIC_RELAXED, __HIP_MEMORY_SCOPE_AGENT); }
__device__ __forceinline__ unsigned xb_add(unsigned* p, unsigned v) { return __hip_atomic_fetch_add(p, v, __ATOMIC_RELAXED, __HIP_MEMORY_SCOPE_AGENT); }
__device__ __forceinline__ unsigned xb_xcc_id() { return (unsigned)__builtin_amdgcn_s_getreg((3 << 11) | 20) & 0xFu; }
#define XB_SPIN(cond, bar) do { unsigned _sp = 0; while (cond) { __builtin_amdgcn_s_sleep(1); \
    if ((++_sp & 255u) == 0u) { if (xb_ld(&(bar)[XB_TMO])) break; if (_sp > XB_SPIN_CAP) { atomicAdd(&(bar)[XB_TMO], 1u); break; } } } } while (0)
struct XcdBarrier { unsigned* bar; unsigned x; volatile LAS unsigned* st; };
__device__ __forceinline__ XcdBarrier xcd_barrier_post(unsigned* bar, volatile LAS unsigned* st) {
  XcdBarrier b; b.bar = bar; b.x = xb_xcc_id(); b.st = st;
  if (threadIdx.x == 0) (void)xb_add(&bar[XB_XCNT(b.x)], 1u);
  return b;
}
__device__ __forceinline__ void xcd_barrier_complete(unsigned* bar, unsigned x, unsigned& nloc, unsigned& nx) {
  const unsigned G = gridDim.x * gridDim.y * gridDim.z;
  unsigned sum, cnt, mine, sp = 0u;
  for (;;) {
    sum = 0u; cnt = 0u; mine = 0u;
#pragma unroll
    for (unsigned j = 0; j < 16; ++j) { const unsigned c = xb_ld(&bar[XB_XCNT(j)]); sum += c; cnt += (c > 0u) ? 1u : 0u; mine = (j == x) ? c : mine; }
    if (sum == G) break;
    __builtin_amdgcn_s_sleep(1);
    if ((++sp & 255u) == 0u) { if (xb_ld(&bar[XB_TMO])) break; if (sp > XB_SPIN_CAP) { atomicAdd(&bar[XB_TMO], 1u); break; } }
  }
  nloc = mine > 0u ? mine : 1u; nx = cnt > 0u ? cnt : 1u;
}
__device__ __forceinline__ void xcd_barrier(const XcdBarrier& b) {
  asm volatile("s_waitcnt vmcnt(0)" ::: "memory");
  __syncthreads();
  if (threadIdx.x == 0) {
    unsigned* bar = b.bar;
    __builtin_amdgcn_s_waitcnt(0);
    unsigned nloc = b.st[0], nx = b.st[1];
    if (nloc == 0u) { xcd_barrier_complete(bar, b.x, nloc, nx); b.st[0] = nloc; b.st[1] = nx; }
    const unsigned old = xb_add(&bar[XB_XSUB(b.x)], 1u);
    const unsigned gen = old / nloc;
    if (old + 1u == (gen + 1u) * nloc) {
      __builtin_amdgcn_fence(__ATOMIC_RELEASE, "agent");
      asm volatile("s_waitcnt vmcnt(0)" ::: "memory");
      const unsigned og = xb_add(&bar[XB_TOP], 1u);
      const unsigned tg = og / nx;
      if (og + 1u == (tg + 1u) * nx) xb_add(&bar[XB_TOPGEN], 1u);
      else XB_SPIN(xb_ld(&bar[XB_TOPGEN]) == tg, bar);
      __builtin_amdgcn_fence(__ATOMIC_ACQUIRE, "agent");
      xb_add(&bar[XB_XGEN(b.x)], 1u);
      asm volatile("s_waitcnt vmcnt(0)" ::: "memory");
    } else {
      XB_SPIN(xb_ld(&bar[XB_XGEN(b.x)]) == gen, bar);
      __builtin_amdgcn_fence(__ATOMIC_ACQUIRE, "agent");
      asm volatile("s_waitcnt vmcnt(0)" ::: "memory");
    }
  }
  __syncthreads();
}
#endif
#ifndef CPU_EMU
#define RUN_PH(n) run_phase<n>(P, smem_raw); if (n != PH_LAST) xcd_barrier(xb);
__global__ void __launch_bounds__(256, 2) mega_kernel(Params P) {
  SMEM_DECL;
  unsigned* bar = (unsigned*)(P.ws + OFF_BAR);
  volatile LAS unsigned* st = (volatile LAS unsigned*)(smem_raw + SMEM_BYTES - 16);
  if (threadIdx.x == 0) { st[0] = 0u; st[1] = 0u; }
  if (P.ws == nullptr) cg::this_grid().sync();
  __syncthreads();
  XcdBarrier xb = xcd_barrier_post(bar, st);
  PHASE_LIST(RUN_PH)
}

extern "C" void kernel_launch(void* const* d_in, const int* in_sizes, int n_in, void* d_out, int out_size, void* d_ws,
                              size_t ws_size, hipStream_t stream) {
  Params P{};
  for (int i = 0; i < N_IN; ++i) P.in[i] = (const float*)d_in[i];
  P.out = (float*)d_out;
  P.ws = (unsigned char*)d_ws;
  if (ws_size < WS_NEEDED) { fprintf(stderr, "workspace too small: %zu < %zu\n", ws_size, (size_t)WS_NEEDED); return; }
  static int grid_blocks = 0;
  if (!grid_blocks) {
    int dev = 0, cus = 0, per_cu = 0;
    hipGetDevice(&dev);
    hipDeviceGetAttribute(&cus, hipDeviceAttributeMultiprocessorCount, dev);
    hipOccupancyMaxActiveBlocksPerMultiprocessor(&per_cu, mega_kernel, 256, 0);
    if (per_cu > 2) per_cu = 2;
    grid_blocks = cus * per_cu;
  }
  (void)hipMemsetAsync((unsigned char*)d_ws + OFF_BAR, 0, 16384, stream);
  void* args[] = {&P};
  hipError_t e = hipLaunchCooperativeKernel((void*)mega_kernel, dim3(grid_blocks), dim3(256), args, 0, stream);
  if (e != hipSuccess) fprintf(stderr, "cooperative launch failed: %s (grid %d)\n", hipGetErrorString(e), grid_blocks);
}
#endif
```

```cpp
#ifdef CPU_EMU
#include "emu.h"
#else
#include <hip/hip_runtime.h>
#include <hip/hip_cooperative_groups.h>
#include <cstdio>
namespace cg = cooperative_groups;
#define DEV __device__ __forceinline__
#define DEVM __device__ __forceinline__
#define OPAQUE(x) asm volatile("" : "+v"(x))
#define OPAQUE_S(x) asm volatile("" : "+s"(x))
#endif

#ifndef SEQ_LEN
#define SEQ_LEN 16384
#endif
#ifndef CTX_LEN
#define CTX_LEN 256
#endif
#ifndef GRID_W_
#define GRID_W_ 64
#endif
#ifndef MULTI_LAUNCH
#define MULTI_LAUNCH 0
#endif

typedef unsigned short bf16_t;
typedef __attribute__((ext_vector_type(8))) short bf16x8;
typedef __attribute__((ext_vector_type(16))) float f32x16;
typedef __attribute__((ext_vector_type(4))) unsigned u32x4;
typedef __attribute__((ext_vector_type(2))) unsigned u32x2;
typedef __attribute__((ext_vector_type(4))) float f32x4;

constexpr int D = 1024, NB = 2, SEQ = SEQ_LEN, CTXL = CTX_LEN, GW = GRID_W_;
constexpr int NCTX = NB * CTXL, NLAT = NB * SEQ, NTOK = NCTX + NLAT;
constexpr int EVC = 3104, ODC = 2816;
constexpr int NEXP = 16384;
constexpr int NTILE = NTOK / 128, CTILE = NCTX / 128;
static_assert(NTOK % 256 == 0 && NCTX % 256 == 0, "tiles");
static_assert(CTXL % 64 == 0 && SEQ % 64 == 0 && SEQ % GW == 0, "chunks");

constexpr size_t al256(size_t x) { return (x + 255) & ~(size_t)255; }
constexpr size_t OFF_MODV = 0;
constexpr size_t OFF_CTXRES = OFF_MODV + al256(2 * 3 * 6144 * 4);
constexpr size_t OFF_GATES = OFF_CTXRES + al256((size_t)NCTX * 1024 * 4);
constexpr size_t OFF_WEVIN = OFF_GATES + al256((size_t)NTOK * 32 * 4);
constexpr size_t OFF_WEVOUT = OFF_WEVIN + al256((size_t)EVC * 1024 * 2);
constexpr size_t OFF_WODIN = OFF_WEVOUT + al256((size_t)1024 * 1024 * 2);
constexpr size_t OFF_WODOUT = OFF_WODIN + al256((size_t)ODC * 1024 * 2);
constexpr size_t OFF_WQ = OFF_WODOUT + al256((size_t)1024 * 1024 * 2);
constexpr size_t OFF_KEYS = OFF_WQ + al256((size_t)2 * 2048 * 1024 * 2);
constexpr size_t OFF_WUP = OFF_KEYS + al256((size_t)2 * 8 * 2 * 128 * 128 * 2);
constexpr size_t OFF_AUP = OFF_WUP + al256((size_t)2 * 512 * 64 * 2);
constexpr size_t OFF_GUP = OFF_AUP + al256((size_t)2 * 512 * 64 * 2);
constexpr size_t OFF_LRUT = OFF_GUP + al256((size_t)512 * 128 * 2);
constexpr size_t OFF_PU = OFF_LRUT + al256((size_t)2 * 8 * 128 * 64 * 2);
constexpr size_t OFF_PV = OFF_PU + al256((size_t)NEXP * 1024);
constexpr size_t OFF_HBUF = OFF_PV + al256((size_t)NEXP * 1024);
constexpr size_t OFF_PR = OFF_HBUF + al256((size_t)NTOK * 1024 * 2);
constexpr size_t PR_BYTES = (size_t)NTOK * 5376 * 2;
constexpr size_t OFF_BAR = OFF_PR + PR_BYTES;
constexpr size_t OFF_ACUM1 = OFF_BAR + 16384;
constexpr size_t OFF_LRUCS = OFF_ACUM1 + (size_t)NLAT * 512 * 2;
constexpr size_t OFF_LRUHS = OFF_LRUCS + (size_t)32 * ((CTXL + SEQ) / 64) * 128 * 4;
constexpr size_t WS_NEEDED = OFF_LRUHS + (size_t)32 * ((CTXL + SEQ) / 64) * 64 * 4;
#ifndef CPU_EMU
static_assert(WS_NEEDED <= (size_t)512 * 1024 * 1024, "workspace too large");
#endif
constexpr size_t OFF_PROJ = OFF_PR;
constexpr size_t OFF_R2L0 = OFF_PR + (size_t)NTOK * EVC * 2;
constexpr size_t OFF_LORA = OFF_PR + (size_t)NTOK * ODC * 2;
constexpr size_t OFF_Q = OFF_PR;
constexpr size_t OFF_PIDX = OFF_PR + (size_t)NTOK * 2048 * 2;
constexpr size_t OFF_PGATE = OFF_PIDX + (size_t)NTOK * 128 * 4;
static_assert(OFF_PGATE + (size_t)NTOK * 128 * 4 <= OFF_PR + PR_BYTES, "picks");

enum {
  I_X = 0, I_C, I_CTX, I_CCTX, I_MODW, I_MODB, I_NORM1, I_NORM2, I_WQ, I_KEYS, I_PU, I_PV,
  I_EVWIN, I_EVWOUT, I_IBIAS, I_FBIAS, I_MNORM, I_SCONVW, I_SCONVB, I_DTBIAS, I_ALOG, I_DSKIP, I_SNORM,
  I_ODWIN, I_ODWOUT, I_MU, I_W0, I_WUP, I_A0, I_AUP, I_GUP, I_KK, I_KA, I_RK, I_LNW, I_LNB,
  I_LCONVW, I_LCONVB, I_LAM, I_WA, I_BA, I_WI, I_BI, I_FNORM, N_IN
};

struct Params {
  const float* in[N_IN];
  float* out;
  unsigned char* ws;
};

constexpr int SMEM_BYTES = 80 * 1024;
#ifdef CPU_EMU
#define SMEM_DECL static thread_local __attribute__((aligned(16))) unsigned char smem_raw[SMEM_BYTES]
#else
#define SMEM_DECL __shared__ __attribute__((aligned(16))) unsigned char smem_raw[SMEM_BYTES]
#endif

DEV float bf2f(bf16_t v) { unsigned u = ((unsigned)v) << 16; float f; __builtin_memcpy(&f, &u, 4); return f; }
#ifdef CPU_EMU
DEV bf16_t f2bf(float f) { unsigned u; __builtin_memcpy(&u, &f, 4); u += 0x7fffu + ((u >> 16) & 1u); return (bf16_t)(u >> 16); }
DEV unsigned pack2(float a, float b) { return (unsigned)f2bf(a) | ((unsigned)f2bf(b) << 16); }
#else
typedef __attribute__((ext_vector_type(2))) float f32x2_t;
typedef __attribute__((ext_vector_type(2))) __bf16 bf16x2_t;
DEV unsigned pack2(float a, float b) { f32x2_t f = {a, b}; return __builtin_bit_cast(unsigned, __builtin_convertvector(f, bf16x2_t)); }
DEV bf16_t f2bf(float f) { return __builtin_bit_cast(unsigned short, (__bf16)f); }
#endif
DEV void unpack8(const u32x4& r, float* o) {
  unsigned w[4] = {r.x, r.y, r.z, r.w};
#pragma unroll
  for (int i = 0; i < 4; ++i) { unsigned lo = w[i] << 16, hi = w[i] & 0xffff0000u; __builtin_memcpy(&o[2 * i], &lo, 4); __builtin_memcpy(&o[2 * i + 1], &hi, 4); }
}
DEV u32x4 pack8(const float* o) { u32x4 r; r.x = pack2(o[0], o[1]); r.y = pack2(o[2], o[3]); r.z = pack2(o[4], o[5]); r.w = pack2(o[6], o[7]); return r; }
#ifdef CPU_EMU
DEV float fexp(float x) { return expf(x); }
DEV float frcp(float x) { return 1.f / x; }
DEV float flog(float x) { return logf(x); }
DEV float frsq(float x) { return 1.f / sqrtf(x); }
DEV float fsqrt(float x) { return sqrtf(x); }
#else
DEV float fexp(float x) { return __expf(x); }
DEV float frcp(float x) { return __builtin_amdgcn_rcpf(x); }
DEV float flog(float x) { return __logf(x); }
DEV float frsq(float x) { return __builtin_amdgcn_rsqf(x); }
DEV float fsqrt(float x) { return __builtin_amdgcn_sqrtf(x); }
#endif
DEV void ld8(const float* __restrict__ p, float* o) { const f32x4 a = *(const f32x4*)p, b = *(const f32x4*)(p + 4); o[0] = a.x; o[1] = a.y; o[2] = a.z; o[3] = a.w; o[4] = b.x; o[5] = b.y; o[6] = b.z; o[7] = b.w; }
DEV float sigmoidf_(float x) { return frcp(1.f + fexp(-x)); }
DEV float siluf_(float x) { return x * frcp(1.f + fexp(-x)); }
DEV float softplusf_(float x) { return fmaxf(x, 0.f) + flog(1.f + fexp(-fabsf(x))); }
DEV float tanhf_(float x) { return 1.f - 2.f * frcp(1.f + fexp(2.f * x)); }
DEV float geluf_(float x) { return 0.5f * x * (1.f + erff(x * 0.70710678118654752f)); }

DEV f32x16 mfma32(bf16x8 a, bf16x8 b, f32x16 c) {
#ifdef CPU_EMU
  return emu_mfma32(a, b, c);
#else
  return __builtin_amdgcn_mfma_f32_32x32x16_bf16(a, b, c, 0, 0, 0);
#endif
}
DEV float wshfl_xor(float v, int m) {
#ifdef CPU_EMU
  return emu_shfl_xor(v, m);
#else
  return __shfl_xor(v, m, 64);
#endif
}
template <int M> DEV float dpp_xor(float v) {
  static_assert(M == 1 || M == 2 || M == 7 || M == 8, "dpp pattern");
#ifdef CPU_EMU
  return emu_shfl_xor(v, M);
#else
  constexpr int ctrl = M == 1 ? 0xB1 : (M == 2 ? 0x4E : (M == 7 ? 0x141 : 0x128));
  return __int_as_float(__builtin_amdgcn_update_dpp(0, __float_as_int(v), ctrl, 0xf, 0xf, false));
#endif
}
DEV float sum8(float v) { v += dpp_xor<1>(v); v += dpp_xor<2>(v); v += dpp_xor<7>(v); return v; }
DEV float sum4(float v) { v += dpp_xor<1>(v); v += dpp_xor<2>(v); return v; }
DEV float sum16(float v) { v = sum8(v); v += dpp_xor<8>(v); return v; }
DEV float swap32_sum(float a, float b) {
#ifdef CPU_EMU
  float ra = emu_shfl_xor(a, 32), rb = emu_shfl_xor(b, 32);
  return ((threadIdx.x >> 5) & 1) ? b + rb : a + ra;
#else
  auto r = __builtin_amdgcn_permlane32_swap(__float_as_uint(a), __float_as_uint(b), false, false);
  return __uint_as_float(r[0]) + __uint_as_float(r[1]);
#endif
}
DEV float swap16_sum(float a, float b) {
#ifdef CPU_EMU
  float ra = emu_shfl_xor(a, 16), rb = emu_shfl_xor(b, 16);
  return ((threadIdx.x >> 4) & 1) ? b + rb : a + ra;
#else
  auto r = __builtin_amdgcn_permlane16_swap(__float_as_uint(a), __float_as_uint(b), false, false);
  return __uint_as_float(r[0]) + __uint_as_float(r[1]);
#endif
}
DEV float wave_sum(float v) {
  v = sum16(v);
  v = swap16_sum(v, v);
  return swap32_sum(v, v);
}
DEV float wave_incl_scan(float v) {
#ifdef CPU_EMU
  const int l = threadIdx.x & 63;
  for (int s = 1; s < 16; s <<= 1) { const bool ok = (l & 15) >= s; float o = emu_readlane(v, ok ? l - s : l); v += ok ? o : 0.f; }
  { const bool ok = ((l >> 4) & 1) != 0; float o = emu_readlane(v, ok ? (l & ~15) - 1 : l); v += ok ? o : 0.f; }
  { const bool ok = l >= 32; float o = emu_readlane(v, ok ? 31 : l); v += ok ? o : 0.f; }
  return v;
#else
#define DPP_ADD_(ctrl, rmask) v += __int_as_float(__builtin_amdgcn_update_dpp(0, __float_as_int(v), ctrl, rmask, 0xf, false))
  DPP_ADD_(0x111, 0xf); DPP_ADD_(0x112, 0xf); DPP_ADD_(0x114, 0xf); DPP_ADD_(0x118, 0xf);
  DPP_ADD_(0x142, 0xa); DPP_ADD_(0x143, 0xc);
#undef DPP_ADD_
  return v;
#endif
}

#ifdef CPU_EMU
static inline unsigned emu_f2fp8(float f) {
  unsigned sgn = f < 0.f ? 0x80u : 0u; float a = fabsf(f);
  if (!(a == a)) return 0x7f;
  if (a >= 448.f) return sgn | 0x7e;
  if (a < 0.0009765625f) return sgn;
  int e; frexpf(a, &e); e -= 1;
  if (e < -6) { int q = (int)nearbyintf(a * 512.f); return sgn | (unsigned)q; }
  float m = a / ldexpf(1.f, e);
  int q = (int)nearbyintf((m - 1.f) * 8.f);
  if (q == 8) { q = 0; e += 1; }
  if (e > 8) return sgn | 0x7e;
  return sgn | (unsigned)((e + 7) << 3) | (unsigned)q;
}
static inline float emu_fp82f(unsigned c) {
  unsigned sgn = c & 0x80, e = (c >> 3) & 15, m = c & 7;
  float v = e == 0 ? ldexpf((float)m, -9) : ldexpf(1.f + m / 8.f, (int)e - 7);
  return sgn ? -v : v;
}
#endif
DEV unsigned pack4_fp8(float a, float b, float c, float d) {
#ifdef CPU_EMU
  return emu_f2fp8(a) | (emu_f2fp8(b) << 8) | (emu_f2fp8(c) << 16) | (emu_f2fp8(d) << 24);
#else
  int w = 0;
  w = __builtin_amdgcn_cvt_pk_fp8_f32(a, b, w, false);
  w = __builtin_amdgcn_cvt_pk_fp8_f32(c, d, w, true);
  return (unsigned)w;
#endif
}
DEV void unpack4_fp8(unsigned w, float* o) {
#ifdef CPU_EMU
  o[0] = emu_fp82f(w & 255); o[1] = emu_fp82f((w >> 8) & 255); o[2] = emu_fp82f((w >> 16) & 255); o[3] = emu_fp82f(w >> 24);
#else
  typedef __attribute__((ext_vector_type(2))) float f32x2_;
  f32x2_ lo = __builtin_amdgcn_cvt_pk_f32_fp8((int)w, false);
  f32x2_ hi = __builtin_amdgcn_cvt_pk_f32_fp8((int)w, true);
  o[0] = lo.x; o[1] = lo.y; o[2] = hi.x; o[3] = hi.y;
#endif
}
DEV void unpack16_fp8(const u32x4& r, float* o) { unpack4_fp8(r.x, o); unpack4_fp8(r.y, o + 4); unpack4_fp8(r.z, o + 8); unpack4_fp8(r.w, o + 12); }
DEV float wreadlane(float v, int srclane) {
#ifdef CPU_EMU
  return emu_readlane(v, srclane);
#else
  int iv; __builtin_memcpy(&iv, &v, 4);
  int r = __builtin_amdgcn_readlane(iv, srclane);
  float f; __builtin_memcpy(&f, &r, 4); return f;
#endif
}
constexpr float PEER_USCALE = 64.f, PEER_VSCALE = 4.f;
#ifdef CPU_EMU
static inline unsigned emu_f2fp4(float f) {
  static const float lv[8] = {0.f, 0.5f, 1.f, 1.5f, 2.f, 3.f, 4.f, 6.f};
  unsigned sgn = f < 0.f ? 8u : 0u; float a = fabsf(f);
  int best = 0; float bd = 1e30f;
  for (int i = 0; i < 8; ++i) { float dd = fabsf(a - lv[i]); if (dd < bd || (dd == bd && (i & 1) == 0)) { bd = dd; best = i; } }
  return sgn | (unsigned)best;
}
static inline float emu_fp42f(unsigned c) {
  static const float lv[8] = {0.f, 0.5f, 1.f, 1.5f, 2.f, 3.f, 4.f, 6.f};
  float v = lv[c & 7]; return (c & 8) ? -v : v;
}
#endif
DEV unsigned pack8_fp4(const float* v) {
#ifdef CPU_EMU
  unsigned w = 0;
  for (int i = 0; i < 8; ++i) w |= emu_f2fp4(v[i]) << (4 * i);
  return w;
#else
  unsigned w = 0;
  w = __builtin_amdgcn_cvt_scalef32_pk_fp4_f32(w, v[0], v[1], 1.0f, 0);
  w = __builtin_amdgcn_cvt_scalef32_pk_fp4_f32(w, v[2], v[3], 1.0f, 1);
  w = __builtin_amdgcn_cvt_scalef32_pk_fp4_f32(w, v[4], v[5], 1.0f, 2);
  w = __builtin_amdgcn_cvt_scalef32_pk_fp4_f32(w, v[6], v[7], 1.0f, 3);
  return w;
#endif
}
DEV void unpack8_fp4(unsigned w, float* o) {
#ifdef CPU_EMU
  for (int i = 0; i < 8; ++i) o[i] = emu_fp42f((w >> (4 * i)) & 15u);
#else
  typedef __attribute__((ext_vector_type(2))) float f32x2_;
  f32x2_ a = __builtin_amdgcn_cvt_scalef32_pk_f32_fp4(w, 1.0f, 0);
  f32x2_ b = __builtin_amdgcn_cvt_scalef32_pk_f32_fp4(w, 1.0f, 1);
  f32x2_ c = __builtin_amdgcn_cvt_scalef32_pk_f32_fp4(w, 1.0f, 2);
  f32x2_ d = __builtin_amdgcn_cvt_scalef32_pk_f32_fp4(w, 1.0f, 3);
  o[0] = a.x; o[1] = a.y; o[2] = b.x; o[3] = b.y; o[4] = c.x; o[5] = c.y; o[6] = d.x; o[7] = d.y;
#endif
}
typedef __attribute__((ext_vector_type(3))) unsigned u32x3;
#ifndef FP6_INTERLEAVED
#define FP6_INTERLEAVED 1
#endif
#ifdef CPU_EMU
static inline unsigned emu_f2fp6(float f) {
  unsigned sgn = f < 0.f ? 32u : 0u; float a = fabsf(f);
  if (a >= 7.5f) return sgn | 31u;
  int e; unsigned code;
  if (a < 1.f) { int q = (int)nearbyintf(a * 8.f); code = (unsigned)q; }
  else { frexpf(a, &e); e -= 1; float m = a / ldexpf(1.f, e); int q = (int)nearbyintf((m - 1.f) * 8.f); if (q == 8) { q = 0; e += 1; } code = (unsigned)(((e + 1) << 3) | q); if (e > 2) code = 31u; }
  return sgn | code;
}
static inline float emu_fp62f(unsigned c) {
  unsigned e = (c >> 3) & 3, m = c & 7;
  float v = e == 0 ? m * 0.125f : ldexpf(1.f + m / 8.f, (int)e - 1);
  return (c & 32) ? -v : v;
}
#endif
DEV u32x3 pack16_fp6(const float* v) {
#ifdef CPU_EMU
  unsigned long long lo = 0; unsigned hi = 0;
  for (int i = 0; i < 16; ++i) {
    unsigned long long c = emu_f2fp6(v[i]); int bit = 6 * i;
    if (bit < 64) { lo |= c << bit; if (bit > 58) hi |= (unsigned)(c >> (64 - bit)); } else hi |= (unsigned)(c << (bit - 64));
  }
  u32x3 r; r.x = (unsigned)lo; r.y = (unsigned)(lo >> 32); r.z = hi; return r;
#else
  typedef __attribute__((ext_vector_type(6))) unsigned u32x6_;
  f32x16 a, b;
#if FP6_INTERLEAVED
#pragma unroll
  for (int i = 0; i < 8; ++i) { a[i] = v[2 * i]; b[i] = v[2 * i + 1]; a[8 + i] = 0.f; b[8 + i] = 0.f; }
#else
#pragma unroll
  for (int i = 0; i < 16; ++i) { a[i] = v[i]; b[i] = 0.f; }
#endif
  u32x6_ w = __builtin_amdgcn_cvt_scalef32_2xpk16_fp6_f32(a, b, 1.0f);
  u32x3 r; r.x = w[0]; r.y = w[1]; r.z = w[2]; return r;
#endif
}
DEV void unpack16_fp6(const u32x3& r, float* o) {
#ifdef CPU_EMU
  unsigned long long lo = (unsigned long long)r.x | ((unsigned long long)r.y << 32); unsigned hi = r.z;
  for (int i = 0; i < 16; ++i) {
    int bit = 6 * i; unsigned c;
    if (bit + 6 <= 64) c = (unsigned)(lo >> bit) & 63u;
    else if (bit >= 64) c = (hi >> (bit - 64)) & 63u;
    else c = ((unsigned)(lo >> bit) | (hi << (64 - bit))) & 63u;
    o[i] = emu_fp62f(c);
  }
#else
  typedef __attribute__((ext_vector_type(6))) unsigned u32x6_;
  typedef __attribute__((ext_vector_type(32))) float f32x32_;
  u32x6_ w; w[0] = r.x; w[1] = r.y; w[2] = r.z; w[3] = 0u; w[4] = 0u; w[5] = 0u;
  f32x32_ f = __builtin_amdgcn_cvt_scalef32_pk32_f32_fp6(w, 1.0f);
#pragma unroll
  for (int i = 0; i < 16; ++i) o[i] = f[i];
#endif
}
DEV void unpack2x16_fp6(const u32x3& ra, const u32x3& rb, float* oa, float* ob) {
#ifdef CPU_EMU
  unpack16_fp6(ra, oa); unpack16_fp6(rb, ob);
#else
  typedef __attribute__((ext_vector_type(6))) unsigned u32x6_;
  typedef __attribute__((ext_vector_type(32))) float f32x32_;
  u32x6_ w; w[0] = ra.x; w[1] = ra.y; w[2] = ra.z; w[3] = rb.x; w[4] = rb.y; w[5] = rb.z;
  f32x32_ f = __builtin_amdgcn_cvt_scalef32_pk32_f32_fp6(w, 1.0f);
#pragma unroll
  for (int i = 0; i < 16; ++i) { oa[i] = f[i]; ob[i] = f[16 + i]; }
#endif
}
constexpr int PEER_ROWB = 1280;
constexpr int PEER_VOFF = 768;


DEV int acc_row(int reg, int lane) { return (reg & 3) + 8 * (reg >> 2) + 4 * (lane >> 5); }

DEV int mod_row(int row) { return row < NCTX ? 2 : (row - NCTX) / SEQ; }

template <bool SYNC_EPI, class Epi, bool VEC4 = false>
DEV void gemm_tile_128(const bf16_t* __restrict__ A, int lda, int M, const bf16_t* __restrict__ Bt, int ldb, int N,
                       int K, int m0, int n0, const Epi& epi, unsigned char* smem) {
  constexpr int LS = 72;
  constexpr int STAGE = 2 * 128 * LS;
  bf16_t* sbase = (bf16_t*)smem;
  const int wave = threadIdx.x >> 6;
  const int wm = (wave >> 1) * 64, wn = (wave & 1) * 64;
  f32x16 acc[2][2];
#pragma unroll
  for (int i = 0; i < 2; ++i)
#pragma unroll
    for (int j = 0; j < 2; ++j)
#pragma unroll
      for (int r = 0; r < 16; ++r) acc[i][j][r] = 0.f;
  u32x4 ra[4], rb[4];
  auto gload = [&](int k0) {
    int tl_ = threadIdx.x; OPAQUE(tl_);
#pragma unroll
    for (int i = 0; i < 4; ++i) {
      int c = tl_ + i * 256, r = c >> 3, cc = (c & 7) * 8;
      int gr = m0 + r, gn = n0 + r;
      gr = gr < M ? gr : M - 1; gn = gn < N ? gn : N - 1;
      ra[i] = *(const u32x4*)(A + (size_t)gr * lda + k0 + cc);
      rb[i] = *(const u32x4*)(Bt + (size_t)gn * ldb + k0 + cc);
    }
  };
  auto lwrite = [&](int buf) {
    int tl_ = threadIdx.x; OPAQUE(tl_);
    bf16_t* sA = sbase + buf * STAGE;
    bf16_t* sB = sA + 128 * LS;
#pragma unroll
    for (int i = 0; i < 4; ++i) {
      int c = tl_ + i * 256, r = c >> 3, cc = (c & 7) * 8;
      *(u32x4*)(sA + r * LS + cc) = ra[i];
      *(u32x4*)(sB + r * LS + cc) = rb[i];
    }
  };
  const int nk = K >> 6;
  gload(0);
  __syncthreads();
  lwrite(0);
  if (nk > 1) gload(64);
  __syncthreads();
  for (int it = 0; it < nk; ++it) {
    int tl_ = threadIdx.x; OPAQUE(tl_);
    const int lane = tl_ & 63;
    const bf16_t* sA = sbase + (it & 1) * STAGE;
    const bf16_t* sB = sA + 128 * LS;
#pragma unroll
    for (int kk = 0; kk < 4; ++kk) {
      bf16x8 a[2], b[2];
      const int ko = kk * 16 + 8 * (lane >> 5);
#pragma unroll
      for (int i = 0; i < 2; ++i) a[i] = *(const bf16x8*)(sA + (wm + i * 32 + (lane & 31)) * LS + ko);
#pragma unroll
      for (int j = 0; j < 2; ++j) b[j] = *(const bf16x8*)(sB + (wn + j * 32 + (lane & 31)) * LS + ko);
#pragma unroll
      for (int i = 0; i < 2; ++i)
#pragma unroll
        for (int j = 0; j < 2; ++j) acc[i][j] = mfma32(a[i], b[j], acc[i][j]);
      if (kk == 1) {
        if (it + 1 < nk) lwrite((it + 1) & 1);
        if (it + 2 < nk) gload((it + 2) * 64);
      }
    }
    __syncthreads();
  }
  {
    int tl_ = threadIdx.x; OPAQUE(tl_);
    const int lane = tl_ & 63;
    if constexpr (VEC4) {
#pragma unroll
      for (int i = 0; i < 2; ++i)
#pragma unroll
        for (int j = 0; j < 2; ++j)
#pragma unroll
          for (int gq = 0; gq < 4; ++gq) {
            int row = m0 + wm + i * 32 + 8 * gq + 4 * (lane >> 5);
            int col = n0 + wn + j * 32 + (lane & 31);
            if (row < M && col < N) epi.store4(row, col, acc[i][j][4 * gq], acc[i][j][4 * gq + 1], acc[i][j][4 * gq + 2], acc[i][j][4 * gq + 3]);
          }
    } else {
#pragma unroll
      for (int i = 0; i < 2; ++i)
#pragma unroll
        for (int j = 0; j < 2; ++j)
#pragma unroll
          for (int r = 0; r < 16; ++r) {
            int row = m0 + wm + i * 32 + acc_row(r, lane);
            int col = n0 + wn + j * 32 + (lane & 31);
            if (row < M && col < N) epi(row, col, acc[i][j][r]);
          }
    }
  }
}

template <class Epi, bool VEC4 = false>
DEV void gemm_tile_128x256(const bf16_t* __restrict__ A, int lda, int M, const bf16_t* __restrict__ Bt, int ldb, int N,
                           int K, int m0, int n0, const Epi& epi, unsigned char* smem) {
  constexpr int LS = 72;
  bf16_t* sA = (bf16_t*)smem;
  bf16_t* sB = sA + 128 * LS;
  const int wave = threadIdx.x >> 6;
  const int wm = (wave >> 1) * 64, wn = (wave & 1) * 128;
  f32x16 acc[2][4];
#pragma unroll
  for (int i = 0; i < 2; ++i)
#pragma unroll
    for (int j = 0; j < 4; ++j)
#pragma unroll
      for (int r = 0; r < 16; ++r) acc[i][j][r] = 0.f;
  u32x4 ra[4], rb[8];
  {
    const int tid = threadIdx.x;
#pragma unroll
    for (int i = 0; i < 4; ++i) {
      int c = tid + i * 256, r = c >> 3, cc = (c & 7) * 8;
      { int gr = m0 + r; gr = gr < M ? gr : M - 1; ra[i] = *(const u32x4*)(A + (size_t)gr * lda + cc); }
    }
#pragma unroll
    for (int i = 0; i < 8; ++i) {
      int c = tid + i * 256, r = c >> 3, cc = (c & 7) * 8;
      { int gn = n0 + r; gn = gn < N ? gn : N - 1; rb[i] = *(const u32x4*)(Bt + (size_t)gn * ldb + cc); }
    }
  }
  for (int k0 = 0; k0 < K; k0 += 64) {
    int tl_ = threadIdx.x; OPAQUE(tl_);
    const int tid = tl_, lane = tl_ & 63;
    __syncthreads();
#pragma unroll
    for (int i = 0; i < 4; ++i) { int c = tid + i * 256, r = c >> 3, cc = (c & 7) * 8; *(u32x4*)(sA + r * LS + cc) = ra[i]; }
#pragma unroll
    for (int i = 0; i < 8; ++i) { int c = tid + i * 256, r = c >> 3, cc = (c & 7) * 8; *(u32x4*)(sB + r * LS + cc) = rb[i]; }
    if (k0 + 64 < K) {
#pragma unroll
      for (int i = 0; i < 4; ++i) {
        int c = tid + i * 256, r = c >> 3, cc = (c & 7) * 8;
        { int gr = m0 + r; gr = gr < M ? gr : M - 1; ra[i] = *(const u32x4*)(A + (size_t)gr * lda + k0 + 64 + cc); }
      }
#pragma unroll
      for (int i = 0; i < 8; ++i) {
        int c = tid + i * 256, r = c >> 3, cc = (c & 7) * 8;
        { int gn = n0 + r; gn = gn < N ? gn : N - 1; rb[i] = *(const u32x4*)(Bt + (size_t)gn * ldb + k0 + 64 + cc); }
      }
    }
    __syncthreads();
#pragma unroll 2
    for (int kk = 0; kk < 4; ++kk) {
      bf16x8 a[2], b[4];
      const int ko = kk * 16 + 8 * (lane >> 5);
#pragma unroll
      for (int i = 0; i < 2; ++i) a[i] = *(const bf16x8*)(sA + (wm + i * 32 + (lane & 31)) * LS + ko);
#pragma unroll
      for (int j = 0; j < 4; ++j) b[j] = *(const bf16x8*)(sB + (wn + j * 32 + (lane & 31)) * LS + ko);
#pragma unroll
      for (int i = 0; i < 2; ++i)
#pragma unroll
        for (int j = 0; j < 4; ++j) acc[i][j] = mfma32(a[i], b[j], acc[i][j]);
    }
  }
  {
    int tl_ = threadIdx.x; OPAQUE(tl_);
    const int lane = tl_ & 63;
    if constexpr (VEC4) {
#pragma unroll
      for (int i = 0; i < 2; ++i)
#pragma unroll
        for (int j = 0; j < 4; ++j)
#pragma unroll
          for (int gq = 0; gq < 4; ++gq) {
            int row = m0 + wm + i * 32 + 8 * gq + 4 * (lane >> 5);
            int col = n0 + wn + j * 32 + (lane & 31);
            if (row < M && col < N) epi.store4(row, col, acc[i][j][4 * gq], acc[i][j][4 * gq + 1], acc[i][j][4 * gq + 2], acc[i][j][4 * gq + 3]);
          }
    } else {
#pragma unroll
      for (int i = 0; i < 2; ++i)
#pragma unroll
        for (int j = 0; j < 4; ++j)
#pragma unroll
          for (int r = 0; r < 16; ++r) {
            int row = m0 + wm + i * 32 + acc_row(r, lane);
            int col = n0 + wn + j * 32 + (lane & 31);
            if (row < M && col < N) epi(row, col, acc[i][j][r]);
          }
    }
  }
}

DEV void transpose_tile(const float* __restrict__ src, int ld_src, bf16_t* __restrict__ dst, int ld_dst, int K, int N,
                        int tk, int tn, unsigned char* smem) {
  float* sT = (float*)smem;
  const int tid = threadIdx.x;
  __syncthreads();
  {
    const int tx = tid & 15, ty = tid >> 4;
#pragma unroll
    for (int p = 0; p < 4; ++p) {
      int k = tk * 64 + ty + p * 16, n = tn * 64 + tx * 4;
      f32x4 v4 = {0.f, 0.f, 0.f, 0.f};
      if (k < K && n < N) v4 = *(const f32x4*)(src + (size_t)k * ld_src + n);
      float* d = sT + (ty + p * 16) * 65 + tx * 4;
      d[0] = v4.x; d[1] = v4.y; d[2] = v4.z; d[3] = v4.w;
    }
  }
  __syncthreads();
  {
    const int n = tid >> 2, kseg = (tid & 3) * 16;
    int gn = tn * 64 + n;
    if (gn < N) {
      float v[16];
#pragma unroll
      for (int j = 0; j < 16; ++j) v[j] = sT[(kseg + j) * 65 + n];
      bf16_t* d = dst + (size_t)gn * ld_dst + tk * 64 + kseg;
      *(u32x4*)d = pack8(v);
      *(u32x4*)(d + 8) = pack8(v + 8);
    }
  }
}

constexpr int TJ0 = 16 * 49, TJ1 = 16 * 16, TJ2 = 16 * 44, TJ3 = 16 * 16, TJ4 = 2 * 16 * 32, TJ5 = 2 * 8, TJ6 = 2 * 8,
              TJ7 = 2 * 8, TJ8 = 32;
constexpr int NTRANS = TJ0 + TJ1 + TJ2 + TJ3 + TJ4 + TJ5 + TJ6 + TJ7 + TJ8;
constexpr int NKEYCV = (2 * 8 * 2 * 128 * 128) / (256 * 8);
constexpr int NMODV = 2 * 96;
constexpr int NPREP = NTRANS + NKEYCV + NMODV;

DEV void st_prep(const Params& P, int item, unsigned char* smem) {
  unsigned char* ws = P.ws;
  if (item < NTRANS) {
    int t = item;
    if (t < TJ0) { transpose_tile(P.in[I_EVWIN], EVC, (bf16_t*)(ws + OFF_WEVIN), 1024, 1024, EVC, t / 49, t % 49, smem); return; }
    t -= TJ0;
    if (t < TJ1) { transpose_tile(P.in[I_EVWOUT], 1024, (bf16_t*)(ws + OFF_WEVOUT), 1024, 1024, 1024, t / 16, t % 16, smem); return; }
    t -= TJ1;
    if (t < TJ2) { transpose_tile(P.in[I_ODWIN], ODC, (bf16_t*)(ws + OFF_WODIN), 1024, 1024, ODC, t / 44, t % 44, smem); return; }
    t -= TJ2;
    if (t < TJ3) { transpose_tile(P.in[I_ODWOUT], 1024, (bf16_t*)(ws + OFF_WODOUT), 1024, 1024, 1024, t / 16, t % 16, smem); return; }
    t -= TJ3;
    if (t < TJ4) {
      int l = t / 512, tt = t % 512;
      transpose_tile(P.in[I_WQ] + (size_t)l * 1024 * 2048, 2048, (bf16_t*)(ws + OFF_WQ) + (size_t)l * 2048 * 1024, 1024, 1024, 2048, tt / 32, tt % 32, smem);
      return;
    }
    t -= TJ4;
    if (t < TJ5) { int d = t / 8; transpose_tile(P.in[I_WUP] + d * 64 * 512, 512, (bf16_t*)(ws + OFF_WUP) + d * 512 * 64, 64, 64, 512, 0, t % 8, smem); return; }
    t -= TJ5;
    if (t < TJ6) { int d = t / 8; transpose_tile(P.in[I_AUP] + d * 64 * 512, 512, (bf16_t*)(ws + OFF_AUP) + d * 512 * 64, 64, 64, 512, 0, t % 8, smem); return; }
    t -= TJ6;
    if (t < TJ7) { transpose_tile(P.in[I_GUP], 512, (bf16_t*)(ws + OFF_GUP), 128, 128, 512, t / 8, t % 8, smem); return; }
    t -= TJ7;
    {
      int which = t & 1, db = t >> 1;
      const float* src = (which ? P.in[I_WI] : P.in[I_WA]) + (size_t)db * 64 * 64;
      transpose_tile(src, 64, (bf16_t*)(ws + OFF_LRUT) + (size_t)db * 128 * 64 + which * 64 * 64, 64, 64, 64, 0, 0, smem);
      return;
    }
  }
  item -= NTRANS;
  if (item < NKEYCV) {
    size_t e = ((size_t)item * 256 + threadIdx.x) * 8;
    const float* s = P.in[I_KEYS] + e;
    f32x4 a = *(const f32x4*)s, b = *(const f32x4*)(s + 4);
    float v[8] = {a.x, a.y, a.z, a.w, b.x, b.y, b.z, b.w};
    *(u32x4*)((bf16_t*)(ws + OFF_KEYS) + e) = pack8(v);
    return;
  }
  item -= NKEYCV;
  {
    const int l = item / 96, cgp = item % 96;
    float* sS = (float*)smem;
    float* sRed = sS + 3 * 1024;
    const int tid = threadIdx.x;
    __syncthreads();
    for (int i = tid; i < 3 * 1024; i += 256) {
      int m = i >> 10, k = i & 1023;
      float c = m < 2 ? P.in[I_C][m * 1024 + k] : P.in[I_CCTX][k];
      sS[i] = siluf_(c);
    }
    __syncthreads();
    const int ks = tid >> 6, col = cgp * 64 + (tid & 63);
    const float* w = P.in[I_MODW] + (size_t)l * 1024 * 6144 + col;
    float a0 = 0.f, a1 = 0.f, a2 = 0.f;
    for (int k = ks * 256; k < ks * 256 + 256; ++k) {
      float wv = w[(size_t)k * 6144];
      a0 += sS[k] * wv; a1 += sS[1024 + k] * wv; a2 += sS[2048 + k] * wv;
    }
    sRed[(ks * 3 + 0) * 64 + (tid & 63)] = a0;
    sRed[(ks * 3 + 1) * 64 + (tid & 63)] = a1;
    sRed[(ks * 3 + 2) * 64 + (tid & 63)] = a2;
    __syncthreads();
    if (tid < 192) {
      int m = tid >> 6, c = tid & 63;
      float s = sRed[(0 * 3 + m) * 64 + c] + sRed[(1 * 3 + m) * 64 + c] + sRed[(2 * 3 + m) * 64 + c] + sRed[(3 * 3 + m) * 64 + c];
      int cc = cgp * 64 + c;
      ((float*)(ws + OFF_MODV))[((size_t)l * 3 + m) * 6144 + cc] = s + P.in[I_MODB][l * 6144 + cc];
    }
  }
}

constexpr int NPCONV = 2 * (NEXP * 1024 / (256 * 16));
DEV void st_peer_conv(const Params& P, int layer, int item) {
  const int half = NPCONV / 2;
  int which = item >= half;
  int it = which ? item - half : item;
  size_t e = ((size_t)it * 256 + threadIdx.x) * 16;
  const float* s = (which ? P.in[I_PV] : P.in[I_PU]) + (size_t)layer * NEXP * 1024 + e;
  const float sc = which ? PEER_VSCALE : PEER_USCALE;
  float v16[16];
#pragma unroll
  for (int q = 0; q < 4; ++q) {
    f32x4 a = *(const f32x4*)(s + 4 * q);
    v16[4 * q] = a.x * sc; v16[4 * q + 1] = a.y * sc; v16[4 * q + 2] = a.z * sc; v16[4 * q + 3] = a.w * sc;
  }
  const size_t ex = e >> 10, col = e & 1023;
  if (which) {
    u32x2 o; o.x = pack8_fp4(v16); o.y = pack8_fp4(v16 + 8);
    *(u32x2*)(P.ws + OFF_PU + ex * PEER_ROWB + PEER_VOFF + (col >> 1)) = o;
  } else {
    u32x3 o = pack16_fp6(v16);
    unsigned* dp = (unsigned*)(P.ws + OFF_PU + ex * PEER_ROWB + (col >> 4) * 12);
    dp[0] = o.x; dp[1] = o.y; dp[2] = o.z;
  }
}

DEV void st_normmod(const Params& P, int layer, int which, int row) {
  const int lane = threadIdx.x & 63;
  const float* src;
  if (which == 0 && layer == 0) src = row < NCTX ? P.in[I_CTX] + (size_t)row * 1024 : P.in[I_X] + (size_t)(row - NCTX) * 1024;
  else src = row < NCTX ? (const float*)(P.ws + OFF_CTXRES) + (size_t)row * 1024 : P.out + (size_t)(row - NCTX) * 1024;
  const float* mv = (const float*)(P.ws + OFF_MODV) + ((size_t)layer * 3 + mod_row(row)) * 6144;
  const float* sh = mv + (which ? 3 : 0) * 1024;
  const float* sc = mv + (which ? 4 : 1) * 1024;
  const float* nw = (which ? P.in[I_NORM2] : P.in[I_NORM1]) + layer * 1024;
  f32x4 v[4];
  float ss = 0.f;
#pragma unroll
  for (int i = 0; i < 4; ++i) {
    v[i] = *(const f32x4*)(src + i * 256 + lane * 4);
    ss += v[i].x * v[i].x + v[i].y * v[i].y + v[i].z * v[i].z + v[i].w * v[i].w;
  }
  ss = wave_sum(ss);
  const float rstd = frsq(ss * (1.f / 1024.f) + 1e-6f);
  bf16_t* dst = (bf16_t*)(P.ws + OFF_HBUF) + (size_t)row * 1024;
#pragma unroll
  for (int i = 0; i < 4; ++i) {
    int c = i * 256 + lane * 4;
    f32x4 w4 = *(const f32x4*)(nw + c), s4 = *(const f32x4*)(sc + c), h4 = *(const f32x4*)(sh + c);
    float o0 = v[i].x * rstd * w4.x * (1.f + s4.x) + h4.x;
    float o1 = v[i].y * rstd * w4.y * (1.f + s4.y) + h4.y;
    float o2 = v[i].z * rstd * w4.z * (1.f + s4.z) + h4.z;
    float o3 = v[i].w * rstd * w4.w * (1.f + s4.w) + h4.w;
    u32x2 pk; pk.x = pack2(o0, o1); pk.y = pack2(o2, o3);
    *(u32x2*)(dst + c) = pk;
  }
}

struct EpiProjL0 {
  bf16_t* proj; float* gates;
  DEVM void operator()(int row, int col, float v) const {
    proj[(size_t)row * EVC + col] = f2bf(v);
    if (col >= 1536 && col < 1552) gates[row * 32 + (col - 1536)] = v;
    else if (col >= 3088) gates[row * 32 + 16 + (col - 3088)] = v;
  }
};
struct EpiStoreBf {
  bf16_t* dst; int ld;
  DEVM void operator()(int row, int col, float v) const { dst[(size_t)row * ld + col] = f2bf(v); }
};
struct EpiStoreBfBias {
  bf16_t* dst; int ld; const float* bias;
  DEVM void operator()(int row, int col, float v) const { dst[(size_t)row * ld + col] = f2bf(v + (bias ? bias[col] : 0.f)); }
};
struct EpiProjL0T {
  bf16_t* proj; float* gates;
  DEVM void operator()(int, int, float) const {}
  DEVM void store4(int n, int m, float v0, float v1, float v2, float v3) const {
    u32x2 pk; pk.x = pack2(v0, v1); pk.y = pack2(v2, v3);
    *(u32x2*)(proj + (size_t)m * EVC + n) = pk;
    if (n >= 1536 && n < 1552) { f32x4 g = {v0, v1, v2, v3}; *(f32x4*)(gates + m * 32 + (n - 1536)) = g; }
    else if (n >= 3088) { f32x4 g = {v0, v1, v2, v3}; *(f32x4*)(gates + m * 32 + 16 + (n - 3088)) = g; }
  }
};
struct EpiStoreBfT {
  bf16_t* dst; int ld;
  DEVM void operator()(int, int, float) const {}
  DEVM void store4(int n, int m, float v0, float v1, float v2, float v3) const {
    u32x2 pk; pk.x = pack2(v0, v1); pk.y = pack2(v2, v3);
    *(u32x2*)(dst + (size_t)m * ld + n) = pk;
  }
};
struct EpiOutProjT {
  const float* x_lat; const float* x_ctx; float* o_lat; float* o_ctx; const float* modv;
  DEVM void operator()(int, int, float) const {}
  DEVM void store4(int n, int m, float v0, float v1, float v2, float v3) const {
    const f32x4 g = *(const f32x4*)(modv + mod_row(m) * 6144 + 2 * 1024 + n);
    const float* xs; float* od;
    if (m < NCTX) { xs = x_ctx + (size_t)m * 1024 + n; od = o_ctx + (size_t)m * 1024 + n; }
    else { size_t o = (size_t)(m - NCTX) * 1024 + n; xs = x_lat + o; od = o_lat + o; }
    const f32x4 x = *(const f32x4*)xs;
    f32x4 r = {x.x + g.x * v0, x.y + g.y * v1, x.z + g.z * v2, x.w + g.w * v3};
    *(f32x4*)od = r;
  }
};
struct EpiStoreBfBiasT {
  bf16_t* dst; int ld; const float* bias; int mode;
  DEVM void operator()(int, int, float) const {}
  DEVM void store4(int n, int m, float v0, float v1, float v2, float v3) const {
    if (bias) { v0 += bias[n]; v1 += bias[n + 1]; v2 += bias[n + 2]; v3 += bias[n + 3]; }
    if (mode) {
      const float sc = mode == 1 ? -0.6065306597126334f : 1.f;
      v0 = sc * sigmoidf_(v0); v1 = sc * sigmoidf_(v1); v2 = sc * sigmoidf_(v2); v3 = sc * sigmoidf_(v3);
    }
    u32x2 pk; pk.x = pack2(v0, v1); pk.y = pack2(v2, v3);
    *(u32x2*)(dst + (size_t)m * ld + n) = pk;
  }
};
struct EpiOutProj {
  const float* x_lat; const float* x_ctx; float* o_lat; float* o_ctx; const float* modv;
  DEVM void operator()(int row, int col, float v) const {
    float g = modv[mod_row(row) * 6144 + 2 * 1024 + col];
    if (row < NCTX) o_ctx[(size_t)row * 1024 + col] = x_ctx[(size_t)row * 1024 + col] + g * v;
    else { size_t o = (size_t)(row - NCTX) * 1024 + col; o_lat[o] = x_lat[o] + g * v; }
  }
};
struct EpiScoreLds {
  float* sS; int m0;
  DEVM void operator()(int row, int col, float v) const { sS[(row - m0) * 129 + col] = v; }
};

DEV void st_xbc_conv(const Params& P, int row) {
  const int lane = threadIdx.x & 63;
  const bf16_t* proj = (const bf16_t*)(P.ws + OFF_PROJ);
  bf16_t* xc = (bf16_t*)P.out + (size_t)row * 1024;
  int row0, len, pos;
  if (row < NCTX) { row0 = (row / CTXL) * CTXL; len = CTXL; pos = row - row0; }
  else { int r = row - NCTX; row0 = NCTX + (r / SEQ) * SEQ; len = SEQ; pos = r % SEQ; }
  const float* cw = P.in[I_SCONVW];
  const float* cb = P.in[I_SCONVB];
#pragma unroll
  for (int hh = 0; hh < 2; ++hh) {
    const int ch = hh * 512 + lane * 8;
    float o[8];
#pragma unroll
    for (int j = 0; j < 8; ++j) o[j] = cb[ch + j];
#pragma unroll
    for (int tap = 0; tap < 4; ++tap) {
      int pp = pos + tap - 2;
      if (pp >= 0 && pp < len) {
        float x[8];
        unpack8(*(const u32x4*)(proj + (size_t)(row0 + pp) * EVC + 2064 + ch), x);
        f32x4 w0 = *(const f32x4*)(cw + tap * 1024 + ch), w1 = *(const f32x4*)(cw + tap * 1024 + ch + 4);
        o[0] += w0.x * x[0]; o[1] += w0.y * x[1]; o[2] += w0.z * x[2]; o[3] += w0.w * x[3];
        o[4] += w1.x * x[4]; o[5] += w1.y * x[5]; o[6] += w1.z * x[6]; o[7] += w1.w * x[7];
      }
    }
#pragma unroll
    for (int j = 0; j < 8; ++j) o[j] = siluf_(o[j]);
    *(u32x4*)(xc + ch) = pack8(o);
  }
}

#ifndef LA_NSEG
#define LA_NSEG 10
#endif
constexpr int LA_NCH = (CTXL + SEQ) / 64;
constexpr int LA_CPS = LA_NCH / LA_NSEG;
static_assert(LA_NCH % LA_NSEG == 0, "linattn segments");
#ifdef CPU_EMU
constexpr size_t OFF_LASEG = OFF_PR + PR_BYTES;
#else
constexpr size_t OFF_LASEG = OFF_R2L0 + (size_t)NTOK * 1024 * 2;
#endif
constexpr size_t LASEG_U = (size_t)48 * LA_NSEG * 8192 * 4;
constexpr size_t OFF_LASEG_N = OFF_LASEG + LASEG_U;
constexpr size_t OFF_LASEG_D = OFF_LASEG_N + (size_t)48 * LA_NSEG * 64 * 4;
#ifndef CPU_EMU
static_assert(OFF_LASEG_D + 48 * LA_NSEG * 4 <= OFF_PR + PR_BYTES, "laseg");
#endif

DEV int swz64(int row) { return ((row >> 3) & 7) << 3; }
DEV int swz32(int row) { return ((row >> 3) & 3) << 3; }
struct LaRaw { u32x4 q[2], k[4], x[4]; float g0, g1; };

template <bool MLSTM, bool FULL>
DEV void la_load_raw(const Params& P, int b, int h, int d, int cc, LaRaw& R) {
  constexpr int NC_CTX = CTXL / 64;
  const int tid = threadIdx.x;
  const int seg = cc >= NC_CTX;
  const int row0 = seg ? NCTX + b * SEQ : b * CTXL;
  const int len = seg ? SEQ : CTXL;
  const int cl = (seg ? cc - NC_CTX : cc) * 64;
  const bf16_t* proj = (const bf16_t*)(P.ws + OFF_PROJ);
  const bf16_t* xcv = (const bf16_t*)P.out;
  const float* gates = (const float*)(P.ws + OFF_GATES);
  if (tid < 64) {
    int p = cl + tid, grow = row0 + (d ? len - 1 - p : p);
    if (MLSTM) { R.g0 = gates[grow * 32 + d * 4 + h]; R.g1 = gates[grow * 32 + 8 + d * 4 + h]; }
    else { R.g0 = gates[grow * 32 + 16 + d * 8 + h]; R.g1 = 0.f; }
  }
  if (MLSTM) {
#pragma unroll
    for (int i = 0; i < 2; ++i) {
      int c = tid + i * 256, r = c >> 3, cc8 = (c & 7) * 8;
      int p = cl + r, pos = d ? len - 1 - p : p;
      const bf16_t* rp = proj + (size_t)(row0 + pos) * EVC;
      if (FULL) R.q[i] = *(const u32x4*)(rp + h * 64 + cc8);
      R.k[i] = *(const u32x4*)(rp + 256 + h * 64 + cc8);
    }
#pragma unroll
    for (int i = 0; i < 4; ++i) {
      int c = tid + i * 256, r = c >> 4, cc8 = (c & 15) * 8;
      int p = cl + r, pos = d ? len - 1 - p : p;
      R.x[i] = *(const u32x4*)(proj + (size_t)(row0 + pos) * EVC + 512 + h * 128 + cc8);
    }
  } else {
    const int grp = h >> 2;
#pragma unroll
    for (int i = 0; i < 2; ++i) {
      int c = tid + i * 256, r = c >> 3, cc8 = (c & 7) * 8;
      int p = cl + r, pos = d ? len - 1 - p : p;
      R.x[i] = *(const u32x4*)(xcv + (size_t)(row0 + pos) * 1024 + h * 64 + cc8);
    }
#pragma unroll
    for (int i = 0; i < 4; ++i) {
      int c = tid + i * 256, r = c >> 4, cc8 = (c & 15) * 8;
      int p = cl + r, pos = d ? len - 1 - p : p;
      const bf16_t* rp = xcv + (size_t)(row0 + pos) * 1024;
      R.k[i] = *(const u32x4*)(rp + 512 + grp * 128 + cc8);
      if (FULL) { if (i < 2) R.q[i] = *(const u32x4*)(rp + 768 + grp * 128 + cc8); else R.x[i] = *(const u32x4*)(rp + 768 + grp * 128 + cc8); }
    }
  }
}

template <bool MLSTM, bool FULL>
DEV void st_linattn_seg(const Params& P, int sid, int seg, unsigned char* smem) {
  constexpr int DK = MLSTM ? 64 : 128, DX = MLSTM ? 128 : 64;
  constexpr int QS = DK + 8;
  constexpr int NH = MLSTM ? 4 : 8;
  constexpr int NC_CTX = CTXL / 64;
  const int tid = threadIdx.x, lane = tid & 63, wave = tid >> 6;
  const int d = sid & 1, h = (sid >> 1) % NH, b = (sid >> 1) / NH;
  const int gsid = MLSTM ? sid : 16 + sid;
  bf16_t* sQ = (bf16_t*)smem;
  bf16_t* sK = sQ + 64 * QS;
  bf16_t* sP = sK;
  bf16_t* sKT = sK + 64 * QS;
  bf16_t* sXT = sKT + DK * 72;
  bf16_t* sST = sXT + DX * 72;
  float* sF = (float*)(sST + DX * QS);
  float* sLa = sF;
  float* sG = sF + 64;
  float* sBc = sF + 128;
  float* sDen = sF + 192;
  float* sN = sF + 256;
  int* sRow = (int*)(sF + 384);
  static_assert((64 * QS * 2 + DK * 72 + DX * 72 + DX * QS) * 2 + 448 * 4 <= SMEM_BYTES, "lds");
  bf16_t* outb = MLSTM ? (bf16_t*)(P.ws + OFF_HBUF) : (bf16_t*)(P.ws + OFF_R2L0);
  float* segU = (float*)(P.ws + OFF_LASEG);
  float* segN = (float*)(P.ws + OFF_LASEG_N);
  float* segD = (float*)(P.ws + OFF_LASEG_D);

  f32x16 accS[2];
#pragma unroll
  for (int j = 0; j < 2; ++j)
#pragma unroll
    for (int r = 0; r < 16; ++r) accS[j][r] = 0.f;
  const int sx0 = MLSTM ? wave * 32 : (wave >> 1) * 32;
  const int sk0 = MLSTM ? 0 : (wave & 1) * 64;
  float nreg = 0.f;
  float gb0 = 0.f, gb1 = 0.f, alog_e = 0.f, dskip = 0.f;
  if (MLSTM) { gb0 = P.in[I_IBIAS][d * 4 + h]; gb1 = P.in[I_FBIAS][d * 4 + h]; }
  else { gb0 = P.in[I_DTBIAS][d * 8 + h]; alog_e = fexp(P.in[I_ALOG][d * 8 + h]); dskip = P.in[I_DSKIP][h]; }

  const int cc0 = seg * LA_CPS, cc1 = cc0 + LA_CPS;
  LaRaw R;
  la_load_raw<MLSTM, FULL>(P, b, h, d, cc0, R);
  __syncthreads();
  if (FULL) {
    for (int js = 0; js < seg; ++js) {
      const size_t it = (size_t)gsid * LA_NSEG + js;
      const float a = fexp(segD[it]);
      const float* U = segU + it * 8192;
#pragma unroll
      for (int j = 0; j < 2; ++j)
#pragma unroll
        for (int r = 0; r < 16; ++r) accS[j][r] = a * accS[j][r] + U[(j * 16 + r) * 256 + tid];
      if (MLSTM) nreg = a * nreg + segN[it * 64 + (tid >> 2)];
    }
#pragma unroll
    for (int j = 0; j < 2; ++j)
#pragma unroll
      for (int g = 0; g < 4; ++g) {
        u32x2 pk; pk.x = pack2(accS[j][4 * g], accS[j][4 * g + 1]); pk.y = pack2(accS[j][4 * g + 2], accS[j][4 * g + 3]);
        *(u32x2*)(sST + (sx0 + (lane & 31)) * QS + sk0 + j * 32 + 8 * g + 4 * (lane >> 5)) = pk;
      }
    if (MLSTM && (tid & 3) == 0) sN[tid >> 2] = nreg;
  }
  float lsum = 0.f;

  for (int cc = cc0; cc < cc1; ++cc) {
    int tl_ = threadIdx.x; OPAQUE(tl_);
    const int tid = tl_, lane = tl_ & 63;
    const int sgi = cc >= NC_CTX;
    const int row0 = sgi ? NCTX + b * SEQ : b * CTXL;
    const int len = sgi ? SEQ : CTXL;
    const int cl = (sgi ? cc - NC_CTX : cc) * 64;
    if (tid < 64) {
      int p = cl + tid;
      sRow[tid] = row0 + (d ? len - 1 - p : p);
      float la;
      if (MLSTM) { la = -softplusf_(-(R.g1 + gb1)); sG[tid] = fexp(R.g0 + gb0); }
      else { float dt = softplusf_(R.g0 + gb0); la = -dt * alog_e; sG[tid] = dt; }
      sBc[tid] = wave_incl_scan(la);
    }
    __syncthreads();
    const float blast = sBc[63];
    lsum += blast;
    if (MLSTM) {
#pragma unroll
      for (int i = 0; i < 2; ++i) {
        int c = tid + i * 256, r = c >> 3, cc8 = (c & 7) * 8;
        float kf[8]; unpack8(R.k[i], kf);
        const float wgt = fexp(blast - sBc[r]) * sG[r];
#pragma unroll
        for (int j = 0; j < 8; ++j) sKT[(cc8 + j) * 72 + (r ^ swz64(cc8))] = f2bf(kf[j] * wgt);
        if (FULL) {
          float qf[8]; unpack8(R.q[i], qf);
#pragma unroll
          for (int j = 0; j < 8; ++j) qf[j] *= 0.125f;
          *(u32x4*)(sQ + r * QS + cc8) = pack8(qf);
          *(u32x4*)(sK + r * QS + cc8) = R.k[i];
        }
      }
#pragma unroll
      for (int i = 0; i < 4; ++i) {
        int c = tid + i * 256, r = c >> 4, cc8 = (c & 15) * 8;
        const bf16_t* xs = (const bf16_t*)&R.x[i];
#pragma unroll
        for (int j = 0; j < 8; ++j) sXT[(cc8 + j) * 72 + (r ^ swz64(cc8))] = xs[j];
      }
    } else {
#pragma unroll
      for (int i = 0; i < 2; ++i) {
        int c = tid + i * 256, r = c >> 3, cc8 = (c & 7) * 8;
        const bf16_t* xs = (const bf16_t*)&R.x[i];
#pragma unroll
        for (int j = 0; j < 8; ++j) sXT[(cc8 + j) * 72 + (r ^ swz64(cc8))] = xs[j];
      }
#pragma unroll
      for (int i = 0; i < 4; ++i) {
        int c = tid + i * 256, r = c >> 4, cc8 = (c & 15) * 8;
        float kf[8]; unpack8(R.k[i], kf);
        const float wgt = fexp(blast - sBc[r]) * sG[r];
#pragma unroll
        for (int j = 0; j < 8; ++j) sKT[(cc8 + j) * 72 + (r ^ swz64(cc8))] = f2bf(kf[j] * wgt);
        if (FULL) {
          *(u32x4*)(sK + r * QS + cc8) = R.k[i];
          *(u32x4*)(sQ + r * QS + cc8) = i < 2 ? R.q[i] : R.x[i];
        }
      }
    }
    if (cc + 1 < cc1) la_load_raw<MLSTM, FULL>(P, b, h, d, cc + 1, R);
    __syncthreads();
    if (FULL) {
      const int tr = (wave >> 1) * 32, tc = (wave & 1) * 32;
      f32x16 accP;
#pragma unroll
      for (int r = 0; r < 16; ++r) accP[r] = 0.f;
      if (!(tr == 0 && tc == 32)) {
#pragma unroll
        for (int kk = 0; kk < DK / 16; ++kk) {
          const int ko = kk * 16 + 8 * (lane >> 5);
          bf16x8 a = *(const bf16x8*)(sQ + (tr + (lane & 31)) * QS + ko);
          bf16x8 bb = *(const bf16x8*)(sK + (tc + (lane & 31)) * QS + ko);
          accP = mfma32(bb, a, accP);
        }
      }
      __syncthreads();
      {
        const int t = tr + (lane & 31);
        const float bt = sBc[t];
#pragma unroll
        for (int g = 0; g < 4; ++g) {
          const int s0 = tc + 8 * g + 4 * (lane >> 5);
          const f32x4 b4 = *(const f32x4*)(sBc + s0), g4 = *(const f32x4*)(sG + s0);
          const float v0 = accP[4 * g] * fexp(fminf(bt - b4.x, 0.f)) * g4.x, v1 = accP[4 * g + 1] * fexp(fminf(bt - b4.y, 0.f)) * g4.y;
          const float v2 = accP[4 * g + 2] * fexp(fminf(bt - b4.z, 0.f)) * g4.z, v3 = accP[4 * g + 3] * fexp(fminf(bt - b4.w, 0.f)) * g4.w;
          u32x2 pk;
          pk.x = pack2(s0 <= t ? v0 : 0.f, s0 + 1 <= t ? v1 : 0.f);
          pk.y = pack2(s0 + 2 <= t ? v2 : 0.f, s0 + 3 <= t ? v3 : 0.f);
          *(u32x2*)(sP + t * 72 + s0) = pk;
        }
        {
          const int t = tid >> 2, kq = (tid & 3) * (DK / 4);
          const float et = fexp(sBc[t]);
#pragma unroll
          for (int c8 = 0; c8 < DK / 4; c8 += 8) {
            float qf[8];
            unpack8(*(const u32x4*)(sQ + t * QS + kq + c8), qf);
#pragma unroll
            for (int j = 0; j < 8; ++j) qf[j] *= et;
            *(u32x4*)(sQ + t * QS + kq + c8) = pack8(qf);
          }
        }
      }
      __syncthreads();
      constexpr int NYT = MLSTM ? 2 : 1;
      const int yx0 = MLSTM ? wave * 32 : (wave >> 1) * 32;
      const int yt0 = MLSTM ? 0 : (wave & 1) * 32;
      f32x16 accY[NYT];
#pragma unroll
      for (int j = 0; j < NYT; ++j)
#pragma unroll
        for (int r = 0; r < 16; ++r) accY[j][r] = 0.f;
#pragma unroll
      for (int kk = 0; kk < 4; ++kk) {
        const int ko = kk * 16 + 8 * (lane >> 5);
        bf16x8 a = *(const bf16x8*)(sXT + (yx0 + (lane & 31)) * 72 + (ko ^ swz64(yx0 + (lane & 31))));
#pragma unroll
        for (int j = 0; j < NYT; ++j) {
          bf16x8 bb = *(const bf16x8*)(sP + (yt0 + j * 32 + (lane & 31)) * 72 + ko);
          accY[j] = mfma32(a, bb, accY[j]);
        }
      }
#pragma unroll
      for (int kk = 0; kk < DK / 16; ++kk) {
        const int ko = kk * 16 + 8 * (lane >> 5);
        bf16x8 a = *(const bf16x8*)(sST + (yx0 + (lane & 31)) * QS + ko);
#pragma unroll
        for (int j = 0; j < NYT; ++j) {
          bf16x8 bb = *(const bf16x8*)(sQ + (yt0 + j * 32 + (lane & 31)) * QS + ko);
          accY[j] = mfma32(a, bb, accY[j]);
        }
      }
      if (MLSTM) {
        const int t = tid >> 2, q4 = (tid & 3) * 16;
        float pf[16], qf[16];
        unpack8(*(const u32x4*)(sP + t * 72 + q4), pf); unpack8(*(const u32x4*)(sP + t * 72 + q4 + 8), pf + 8);
        unpack8(*(const u32x4*)(sQ + t * QS + q4), qf); unpack8(*(const u32x4*)(sQ + t * QS + q4 + 8), qf + 8);
        float den = 0.f;
#pragma unroll
        for (int j = 0; j < 16; ++j) den += pf[j] + sN[q4 + j] * qf[j];
        den = sum4(den);
        if ((tid & 3) == 0) sDen[t] = den;
        __syncthreads();
      }
#pragma unroll
      for (int j = 0; j < NYT; ++j) {
        const int t = yt0 + j * 32 + (lane & 31);
        const size_t obase = (size_t)sRow[t] * 1024 + d * 512 + h * DX;
        const float dinv = MLSTM ? frcp(fmaxf(fabsf(sDen[t]), 1.f)) : 1.f;
#pragma unroll
        for (int g = 0; g < 4; ++g) {
          const int x0 = yx0 + 8 * g + 4 * (lane >> 5);
          float v0 = accY[j][4 * g], v1 = accY[j][4 * g + 1], v2 = accY[j][4 * g + 2], v3 = accY[j][4 * g + 3];
          if (MLSTM) { v0 *= dinv; v1 *= dinv; v2 *= dinv; v3 *= dinv; }
          else if (d == 0) {
            const int ts = t ^ swz64(x0);
            v0 += dskip * bf2f(sXT[(x0 + 0) * 72 + ts]); v1 += dskip * bf2f(sXT[(x0 + 1) * 72 + ts]);
            v2 += dskip * bf2f(sXT[(x0 + 2) * 72 + ts]); v3 += dskip * bf2f(sXT[(x0 + 3) * 72 + ts]);
          }
          u32x2 pk; pk.x = pack2(v0, v1); pk.y = pack2(v2, v3);
          *(u32x2*)(outb + obase + x0) = pk;
        }
      }
      __syncthreads();
    }
    {
      const float eb = fexp(blast);
#pragma unroll
      for (int j = 0; j < 2; ++j)
#pragma unroll
        for (int r = 0; r < 16; ++r) accS[j][r] *= eb;
#pragma unroll
      for (int kk = 0; kk < 4; ++kk) {
        const int ko = kk * 16 + 8 * (lane >> 5);
        bf16x8 a = *(const bf16x8*)(sXT + (sx0 + (lane & 31)) * 72 + (ko ^ swz64(sx0 + (lane & 31))));
#pragma unroll
        for (int j = 0; j < 2; ++j) {
          bf16x8 bb = *(const bf16x8*)(sKT + (sk0 + j * 32 + (lane & 31)) * 72 + (ko ^ swz64(sk0 + j * 32 + (lane & 31))));
          accS[j] = mfma32(bb, a, accS[j]);
        }
      }
      if (FULL) {
#pragma unroll
        for (int j = 0; j < 2; ++j)
#pragma unroll
          for (int g = 0; g < 4; ++g) {
            u32x2 pk; pk.x = pack2(accS[j][4 * g], accS[j][4 * g + 1]); pk.y = pack2(accS[j][4 * g + 2], accS[j][4 * g + 3]);
            *(u32x2*)(sST + (sx0 + (lane & 31)) * QS + sk0 + j * 32 + 8 * g + 4 * (lane >> 5)) = pk;
          }
      }
      if (MLSTM) {
        const int k = tid >> 2, q4 = (tid & 3) * 16;
        float kf[16];
        unpack8(*(const u32x4*)(sKT + k * 72 + q4), kf); unpack8(*(const u32x4*)(sKT + k * 72 + q4 + 8), kf + 8);
        float ps = 0.f;
#pragma unroll
        for (int j = 0; j < 16; ++j) ps += kf[j];
        nreg = nreg * eb + sum4(ps);
        if (FULL && (tid & 3) == 0) sN[k] = nreg;
      }
    }
    __syncthreads();
  }
  if (!FULL) {
    const size_t it = (size_t)gsid * LA_NSEG + seg;
    float* U = segU + it * 8192;
#pragma unroll
    for (int j = 0; j < 2; ++j)
#pragma unroll
      for (int r = 0; r < 16; ++r) U[(j * 16 + r) * 256 + tid] = accS[j][r];
    if (MLSTM && (tid & 3) == 0) segN[it * 64 + (tid >> 2)] = nreg;
    if (tid == 0) segD[it] = lsum;
  }
}

DEV void st_finish_l0(const Params& P, int row) {
  const int lane = threadIdx.x & 63;
  bf16_t* hb = (bf16_t*)(P.ws + OFF_HBUF) + (size_t)row * 1024;
  const bf16_t* yb = (const bf16_t*)(P.ws + OFF_R2L0) + (size_t)row * 1024;
  const bf16_t* pr = (const bf16_t*)(P.ws + OFF_PROJ) + (size_t)row * EVC;
  const int ch = lane * 8;
  float h0[8], h1[8], o[8], f1[8];
  unpack8(*(const u32x4*)(hb + ch), h0);
  unpack8(*(const u32x4*)(hb + 512 + ch), h1);
  unpack8(*(const u32x4*)(pr + 1024 + ch), o);
  float ss = 0.f;
#pragma unroll
  for (int j = 0; j < 8; ++j) { h0[j] += h1[j]; ss += h0[j] * h0[j]; }
  ss = sum16(ss);
  float rstd = frsq(ss * (1.f / 128.f) + 1e-6f);
  float pw[8]; ld8(P.in[I_MNORM] + ch, pw);
#pragma unroll
  for (int j = 0; j < 8; ++j) f1[j] = h0[j] * rstd * pw[j] * sigmoidf_(o[j]);
  float y0[8], y1[8], z[8], f2[8];
  unpack8(*(const u32x4*)(yb + ch), y0);
  unpack8(*(const u32x4*)(yb + 512 + ch), y1);
  unpack8(*(const u32x4*)(pr + 1552 + ch), z);
  float s2 = 0.f;
#pragma unroll
  for (int j = 0; j < 8; ++j) { y0[j] = (y0[j] + y1[j]) * siluf_(z[j]); s2 += y0[j] * y0[j]; }
  s2 = wave_sum(s2);
  float rstd2 = frsq(s2 * (1.f / 512.f) + 1e-6f);
  ld8(P.in[I_SNORM] + ch, pw);
#pragma unroll
  for (int j = 0; j < 8; ++j) f2[j] = y0[j] * rstd2 * pw[j];
  *(u32x4*)(hb + ch) = pack8(f1);
  *(u32x4*)(hb + 512 + ch) = pack8(f2);
}

DEV float mixval(const bf16_t* __restrict__ proj, int row, int c, const float* __restrict__ mu) {
  float self = bf2f(proj[(size_t)row * ODC + c]);
  int nrow = -1;
  if (row < NCTX) {
    int pos = row % CTXL;
    if (c < 896) { if (pos > 0) nrow = row - 1; }
    else { if (pos < CTXL - 1) nrow = row + 1; }
  } else {
    int pos = (row - NCTX) % SEQ;
    int gx = pos % GW, gy = pos / GW, q = c / 448;
    if (q == 0) { if (gx > 0) nrow = row - 1; }
    else if (q == 1) { if (gx < GW - 1) nrow = row + 1; }
    else if (q == 2) { if (gy > 0) nrow = row - GW; }
    else { if (gy < SEQ / GW - 1) nrow = row + GW; }
  }
  float nb = nrow >= 0 ? bf2f(proj[(size_t)nrow * ODC + c]) : 0.f;
  return self + mu[c] * (nb - self);
}

DEV int nbr_row(int row, int c) {
  if (row < NCTX) {
    int pos = row % CTXL;
    if (c < 896) return pos > 0 ? row - 1 : -1;
    return pos < CTXL - 1 ? row + 1 : -1;
  }
  int pos = (row - NCTX) % SEQ;
  int gx = pos % GW, gy = pos / GW, q = c / 448;
  if (q == 0) return gx > 0 ? row - 1 : -1;
  if (q == 1) return gx < GW - 1 ? row + 1 : -1;
  if (q == 2) return gy > 0 ? row - GW : -1;
  return gy < SEQ / GW - 1 ? row + GW : -1;
}

DEV void mix8(const bf16_t* __restrict__ proj, int row, int c, const float* __restrict__ mu, float* o) {
  float xs[8], xn[8];
  unpack8(*(const u32x4*)(proj + (size_t)row * ODC + c), xs);
  const int nr = nbr_row(row, c);
  if (nr >= 0) unpack8(*(const u32x4*)(proj + (size_t)nr * ODC + c), xn);
  else {
#pragma unroll
    for (int j = 0; j < 8; ++j) xn[j] = 0.f;
  }
  const f32x4 m0 = *(const f32x4*)(mu + c), m1 = *(const f32x4*)(mu + c + 4);
  const float mm[8] = {m0.x, m0.y, m0.z, m0.w, m1.x, m1.y, m1.z, m1.w};
#pragma unroll
  for (int j = 0; j < 8; ++j) o[j] = xs[j] + mm[j] * (xn[j] - xs[j]);
}

DEV void st_lora_act(const Params& P, int row2) {
  const int lane = threadIdx.x & 63;
  const int row = row2 + (lane >> 5), c = (lane & 31) * 8;
  const bf16_t* proj = (const bf16_t*)(P.ws + OFF_PROJ);
  bf16_t* hb = (bf16_t*)(P.ws + OFF_HBUF) + (size_t)row * 1024;
  float v[8];
  mix8(proj, row, 1536 + c, P.in[I_MU], v);
#pragma unroll
  for (int j = 0; j < 8; ++j) v[j] = c < 64 ? tanhf_(v[j]) : (c < 128 ? v[j] : sigmoidf_(v[j]));
  *(u32x4*)(hb + c) = pack8(v);
}

DEV void st_rwkv_stream(const Params& P, int sid, unsigned char* smem) {
  const int tid = threadIdx.x, lane = tid & 63, wave = tid >> 6;
  const int d = sid & 1, h = (sid >> 1) & 7, b = sid >> 4;
  float* sR = (float*)smem;
  float* sW = sR + 2048;
  float* sKk = sW + 2048;
  float* sV = sKk + 2048;
  float* sA = sV + 2048;
  float* sBb = sA + 2048;
  float* sY = sBb + 2048;
  int* sRow = (int*)(sY + 2048);
  const bf16_t* proj = (const bf16_t*)(P.ws + OFF_PROJ);
  const bf16_t* lora = (const bf16_t*)(P.ws + OFF_LORA);
  bf16_t* yout = (bf16_t*)(P.ws + OFF_HBUF);
  const float* mu = P.in[I_MU];
  const int vrow = tid >> 2, j4 = tid & 3;
  float S[16];
#pragma unroll
  for (int i = 0; i < 16; ++i) S[i] = 0.f;
  const float kkw = P.in[I_KK][h * 64 + lane], kaw = P.in[I_KA][h * 64 + lane];
  for (int seg = 0; seg < 2; ++seg) {
    const int row0 = seg == 0 ? b * CTXL : NCTX + b * SEQ;
    const int len = seg == 0 ? CTXL : SEQ;
    for (int it = 0; it < len / 32; ++it) {
      __syncthreads();
      for (int s = wave; s < 32; s += 4) {
        int p = it * 32 + s, pos = d ? len - 1 - p : p, row = row0 + pos;
        int c = h * 64 + lane;
        float r = mixval(proj, row, c, mu);
        float k = mixval(proj, row, 512 + c, mu);
        float v = mixval(proj, row, 1024 + c, mu);
        float kk = k * kkw;
        float ss = wave_sum(kk * kk);
        kk *= frsq(ss + 1e-12f);
        float lw = bf2f(lora[((size_t)d * NTOK + row) * 512 + c]);
        float la = bf2f(lora[((size_t)(2 + d) * NTOK + row) * 512 + c]);
        float w = fexp(-0.6065306597126334f * sigmoidf_(lw));
        float a = sigmoidf_(la);
        float kt = k * (1.f + (a - 1.f) * kaw);
        sR[s * 64 + lane] = r; sW[s * 64 + lane] = w; sKk[s * 64 + lane] = kt; sV[s * 64 + lane] = v;
        sA[s * 64 + lane] = -kk; sBb[s * 64 + lane] = kk * a;
        if (lane == 0) sRow[s] = row;
      }
      __syncthreads();
      for (int s = 0; s < 32; ++s) {
        const float* pa = sA + s * 64 + j4 * 16;
        const float* pw = sW + s * 64 + j4 * 16;
        const float* pk = sKk + s * 64 + j4 * 16;
        const float* pb = sBb + s * 64 + j4 * 16;
        const float* pr = sR + s * 64 + j4 * 16;
        const float vv = sV[s * 64 + vrow];
        float sa = 0.f;
#pragma unroll
        for (int i = 0; i < 16; ++i) sa += S[i] * pa[i];
        sa = sum4(sa);
        float y = 0.f;
#pragma unroll
        for (int i = 0; i < 16; ++i) { S[i] = S[i] * pw[i] + sa * pb[i] + vv * pk[i]; y += S[i] * pr[i]; }
        y = sum4(y);
        if (j4 == 0) sY[s * 64 + vrow] = y;
      }
      __syncthreads();
      for (int i = tid; i < 2048; i += 256) {
        int s = i >> 6, c = i & 63;
        yout[(size_t)sRow[s] * 1024 + d * 512 + h * 64 + c] = f2bf(sY[i]);
      }
    }
  }
}


struct RwkvRaw { u32x4 rs, rn, ks, kn, vs, vn, lw, la; int row; };

DEV void rwkv_load_raw(const bf16_t* __restrict__ proj, const bf16_t* __restrict__ lora, int b, int h, int d, int cc, int t, int c0,
                       RwkvRaw& R) {
  constexpr int NC_CTX = CTXL / 32;
  const int seg = cc >= NC_CTX;
  const int row0 = seg ? NCTX + b * SEQ : b * CTXL;
  const int len = seg ? SEQ : CTXL;
  const int p = (seg ? cc - NC_CTX : cc) * 32 + t;
  const int row = row0 + (d ? len - 1 - p : p);
  const int col = h * 64 + c0;
  const u32x4 z4 = {0u, 0u, 0u, 0u};
  const bf16_t* rp = proj + (size_t)row * ODC;
  R.row = row;
  R.rs = *(const u32x4*)(rp + col);
  R.ks = *(const u32x4*)(rp + 512 + col);
  R.vs = *(const u32x4*)(rp + 1024 + col);
  int n0 = nbr_row(row, col), n1 = nbr_row(row, 512 + col), n2 = nbr_row(row, 1024 + col);
  R.rn = n0 >= 0 ? *(const u32x4*)(proj + (size_t)n0 * ODC + col) : z4;
  R.kn = n1 >= 0 ? *(const u32x4*)(proj + (size_t)n1 * ODC + 512 + col) : z4;
  R.vn = n2 >= 0 ? *(const u32x4*)(proj + (size_t)n2 * ODC + 1024 + col) : z4;
  R.lw = *(const u32x4*)(lora + ((size_t)d * NTOK + row) * 512 + col);
  R.la = *(const u32x4*)(lora + ((size_t)(2 + d) * NTOK + row) * 512 + col);
}

#ifndef RW_NSEG
#define RW_NSEG 16
#endif
constexpr int RW_NCH = (CTXL + SEQ) / 32;
constexpr size_t OFF_RWSEG = OFF_PU;
static_assert((size_t)32 * RW_NSEG * 64 * 128 * 4 <= (size_t)2 * NEXP * 1024, "rwseg");

template <bool FULL>
DEV void st_rwkv_seg(const Params& P, int sid, int seg, unsigned char* smem) {
  constexpr int NVB = FULL ? 2 : 4;
  constexpr int ZR = FULL ? 64 : 128;
  const int tid = threadIdx.x, lane = tid & 63, wave = tid >> 6;
  const int d = sid & 1, h = (sid >> 1) & 7, b = sid >> 4;
  bf16_t* sAt = (bf16_t*)smem;
  bf16_t* sRt = sAt + 32 * 72;
  bf16_t* sBt = sRt + 32 * 72;
  bf16_t* sKt = sBt + 32 * 72;
  bf16_t* sBT = sKt + 32 * 72;
  bf16_t* sKT = sBT + 64 * 40;
  bf16_t* sVT = sKT + 64 * 40;
  bf16_t* sLak = sVT + 64 * 40;
  bf16_t* sM = sLak + 32 * 40;
  bf16_t* sLrb = sM + 32 * 40;
  bf16_t* sLrk = sLrb + 32 * 40;
  bf16_t* sZ = FULL ? sLrk + 32 * 40 : sLrb;
  bf16_t* after = sZ + ZR * 72;
  bf16_t* sRT = after;
  bf16_t* sSAT = FULL ? after + 64 * 40 : sRt;
  float* sLP = (float*)(FULL ? after + 2 * 64 * 40 : after + 128 * 40);
  float* sLab = sLP + 4 * 64;
  float* sD = sLab + 32 * 36;
  float* sPT = sD + 768;
  int* sRow = (int*)(sPT + 64);
  static_assert((4 * 32 * 72 + 3 * 64 * 40 + 4 * 32 * 40 + 2 * 64 * 40 + 64 * 72) * 2 + (4 * 64 + 32 * 36 + 768 + 64 + 32 + 320) * 4 + 16 <= SMEM_BYTES, "lds full");
  static_assert((4 * 32 * 72 + 3 * 64 * 40 + 2 * 32 * 40 + 128 * 72 + 128 * 40) * 2 + (4 * 64 + 32 * 36 + 768 + 64 + 32 + 320) * 4 + 16 <= SMEM_BYTES, "lds p1");
  static_assert(128 * 40 <= 3 * 32 * 72, "alias");
  const bf16_t* proj = (const bf16_t*)(P.ws + OFF_PROJ);
  const bf16_t* lora = (const bf16_t*)(P.ws + OFF_LORA);
  bf16_t* yout = (bf16_t*)(P.ws + OFF_HBUF);
  float* segZ = (float*)(P.ws + OFF_RWSEG);
  const int t = tid >> 3, c0 = (tid & 7) * 8;
  const int hl = lane >> 5, l31 = lane & 31;
  float* sCst = (float*)(smem + SMEM_BYTES - 320 * 4 - 16);
  if (tid < 64) {
    sCst[tid] = P.in[I_MU][h * 64 + tid]; sCst[64 + tid] = P.in[I_MU][512 + h * 64 + tid]; sCst[128 + tid] = P.in[I_MU][1024 + h * 64 + tid];
    sCst[192 + tid] = P.in[I_KK][h * 64 + tid]; sCst[256 + tid] = P.in[I_KA][h * 64 + tid];
  }
  const int cc0 = (seg * RW_NCH) / RW_NSEG, cc1 = ((seg + 1) * RW_NCH) / RW_NSEG;
  RwkvRaw R;
  rwkv_load_raw(proj, lora, b, h, d, cc0, t, c0, R);
  f32x16 Zm[2];
#pragma unroll
  for (int j = 0; j < 2; ++j)
#pragma unroll
    for (int r = 0; r < 16; ++r) Zm[j][r] = 0.f;
  __syncthreads();
  for (int i = tid; i < ZR * 72; i += 256) sZ[i] = 0;
  __syncthreads();
  if (!FULL) {
    if (wave >= 2) {
#pragma unroll
      for (int cb = 0; cb < 2; ++cb)
#pragma unroll
        for (int r = 0; r < 16; ++r) {
          int c = cb * 32 + acc_row(r, lane), vp = wave * 32 + l31;
          if (c == vp - 64) { Zm[cb][r] = 1.f; sZ[vp * 72 + c] = 0x3f80; }
        }
    }
  } else {
    for (int js = 0; js < seg; ++js) {
      const float* Zs = segZ + ((size_t)sid * RW_NSEG + js) * 64 * 128;
      bf16_t* sG = sAt;
      {
        const int c = tid >> 2, c2 = (tid & 3) * 16;
        float gv[16];
        ld8(Zs + c * 128 + 64 + c2, gv); ld8(Zs + c * 128 + 64 + c2 + 8, gv + 8);
        *(u32x4*)(sG + c * 72 + c2) = pack8(gv);
        *(u32x4*)(sG + c * 72 + c2 + 8) = pack8(gv + 8);
      }
      __syncthreads();
      if (wave >= 2) {
        const int cb = wave - 2;
#pragma unroll
        for (int vb = 0; vb < 2; ++vb) {
          f32x16 acc;
#pragma unroll
          for (int r = 0; r < 16; ++r) acc[r] = Zs[(cb * 32 + acc_row(r, lane)) * 128 + vb * 32 + l31];
#pragma unroll
          for (int kk = 0; kk < 4; ++kk) {
            bf16x8 a = *(const bf16x8*)(sG + (cb * 32 + l31) * 72 + kk * 16 + 8 * hl);
            bf16x8 bb = *(const bf16x8*)(sZ + (vb * 32 + l31) * 72 + kk * 16 + 8 * hl);
            acc = mfma32(a, bb, acc);
          }
          Zm[vb] = acc;
        }
      }
      __syncthreads();
      if (wave >= 2) {
        const int cb = wave - 2;
#pragma unroll
        for (int vb = 0; vb < 2; ++vb)
#pragma unroll
          for (int g = 0; g < 4; ++g) {
            u32x2 pk; pk.x = pack2(Zm[vb][4 * g], Zm[vb][4 * g + 1]); pk.y = pack2(Zm[vb][4 * g + 2], Zm[vb][4 * g + 3]);
            *(u32x2*)(sZ + (vb * 32 + l31) * 72 + cb * 32 + 8 * g + 4 * hl) = pk;
          }
      }
      __syncthreads();
    }
  }
  for (int cc = cc0; cc < cc1; ++cc) {
    int tl_ = threadIdx.x; OPAQUE(tl_);
    const int tid = tl_, lane = tl_ & 63, hl = lane >> 5, l31 = lane & 31, t = tl_ >> 3, c0 = (tl_ & 7) * 8;
    const float* muR = sCst + c0; const float* muK = sCst + 64 + c0; const float* muV = sCst + 128 + c0;
    const float* kkw = sCst + 192 + c0; const float* kaw = sCst + 256 + c0;
    float lw8[8], lp8[8];
    {
      float lwf[8];
      unpack8(R.lw, lwf);
#pragma unroll
      for (int j = 0; j < 8; ++j) { lw8[j] = lwf[j]; lp8[j] = lw8[j]; }
#pragma unroll
      for (int off = 8; off < 64; off <<= 1) {
#pragma unroll
        for (int j = 0; j < 8; ++j) {
#ifdef CPU_EMU
          float o = emu_shfl_up(lp8[j], off);
#else
          float o = __shfl_up(lp8[j], off, 64);
#endif
          if (lane >= off) lp8[j] += o;
        }
      }
      if (lane >= 56) {
#pragma unroll
        for (int j = 0; j < 8; ++j) sLP[wave * 64 + c0 + j] = lp8[j];
      }
      if ((tid & 7) == 0) sRow[t] = R.row;
    }
    __syncthreads();
    {
#pragma unroll
      for (int j = 0; j < 8; ++j) {
        float offs = 0.f;
        for (int w2 = 0; w2 < wave; ++w2) offs += sLP[w2 * 64 + c0 + j];
        lp8[j] += offs;
      }
      if (t == 31) {
#pragma unroll
        for (int j = 0; j < 8; ++j) sPT[c0 + j] = fexp(lp8[j]);
      }
    }
    {
      float xs[8], xn[8], kt[8], aa[8], ob[8], ok[8];
      unpack8(R.ks, xs); unpack8(R.kn, xn);
      float ss = 0.f;
#pragma unroll
      for (int j = 0; j < 8; ++j) { kt[j] = xs[j] + muK[j] * (xn[j] - xs[j]); aa[j] = kt[j] * kkw[j]; ss += aa[j] * aa[j]; }
      ss = sum8(ss);
      const float rn = frsq(ss + 1e-12f);
      float laf[8];
      unpack8(R.la, laf);
#pragma unroll
      for (int j = 0; j < 8; ++j) {
        const float lp = lp8[j];
        const float lpm = lp8[j] - lw8[j];
        const float e = fexp(-lp);
        const float kkn = aa[j] * rn;
        const float asg = laf[j];
        aa[j] = -kkn * fexp(lpm);
        ob[j] = kkn * asg * e;
        ok[j] = kt[j] * (1.f + (asg - 1.f) * kaw[j]) * e;
      }
      *(u32x4*)(sAt + t * 72 + c0) = pack8(aa);
      *(u32x4*)(sBt + t * 72 + c0) = pack8(ob);
      *(u32x4*)(sKt + t * 72 + c0) = pack8(ok);
#pragma unroll
      for (int j = 0; j < 8; ++j) { sBT[(c0 + j) * 40 + (t ^ swz32(c0))] = f2bf(ob[j]); sKT[(c0 + j) * 40 + (t ^ swz32(c0))] = f2bf(ok[j]); }
      unpack8(R.vs, xs); unpack8(R.vn, xn);
#pragma unroll
      for (int j = 0; j < 8; ++j) sVT[(c0 + j) * 40 + (t ^ swz32(c0))] = f2bf(xs[j] + muV[j] * (xn[j] - xs[j]));
      if (FULL) {
        unpack8(R.rs, xs); unpack8(R.rn, xn);
#pragma unroll
        for (int j = 0; j < 8; ++j) xs[j] = (xs[j] + muR[j] * (xn[j] - xs[j])) * fexp(lp8[j]);
        *(u32x4*)(sRt + t * 72 + c0) = pack8(xs);
      }
    }
    if (cc + 1 < cc1) rwkv_load_raw(proj, lora, b, h, d, cc + 1, t, c0, R);
    __syncthreads();
    if (FULL || wave < 2) {
      const bf16_t* Asrc = wave < 2 ? sAt : sRt;
      const bf16_t* Bsrc = (wave & 1) ? sKt : sBt;
      f32x16 acc;
#pragma unroll
      for (int r = 0; r < 16; ++r) acc[r] = 0.f;
#pragma unroll
      for (int kk = 0; kk < 4; ++kk) {
        bf16x8 a = *(const bf16x8*)(Asrc + l31 * 72 + kk * 16 + 8 * hl);
        bf16x8 bb = *(const bf16x8*)(Bsrc + l31 * 72 + kk * 16 + 8 * hl);
        acc = mfma32(bb, a, acc);
      }
      bf16_t* dst = wave == 1 ? sLak : (wave == 2 ? sLrb : sLrk);
      {
        const int tt = l31;
        const int lim = wave < 2 ? tt : tt + 1;
#pragma unroll
        for (int g = 0; g < 4; ++g) {
          const int j0 = 8 * g + 4 * hl;
          const float v0 = j0 < lim ? acc[4 * g] : 0.f, v1 = j0 + 1 < lim ? acc[4 * g + 1] : 0.f;
          const float v2 = j0 + 2 < lim ? acc[4 * g + 2] : 0.f, v3 = j0 + 3 < lim ? acc[4 * g + 3] : 0.f;
          if (wave == 0) { f32x4 o = {v0, v1, v2, v3}; *(f32x4*)(sLab + tt * 36 + j0) = o; }
          else { u32x2 pk; pk.x = pack2(v0, v1); pk.y = pack2(v2, v3); *(u32x2*)(dst + tt * 40 + j0) = pk; }
        }
      }
    }
    __syncthreads();
    auto rhs_block = [&](int vb) {
      f32x16 acc;
#pragma unroll
      for (int r = 0; r < 16; ++r) acc[r] = 0.f;
#pragma unroll
      for (int kk = 0; kk < 4; ++kk) {
        bf16x8 a = *(const bf16x8*)(sAt + l31 * 72 + kk * 16 + 8 * hl);
        bf16x8 bb = *(const bf16x8*)(sZ + (vb * 32 + l31) * 72 + kk * 16 + 8 * hl);
        acc = mfma32(a, bb, acc);
      }
      if (vb < 2) {
#pragma unroll
        for (int kk = 0; kk < 2; ++kk) {
          bf16x8 a = *(const bf16x8*)(sLak + l31 * 40 + kk * 16 + 8 * hl);
          bf16x8 bb = *(const bf16x8*)(sVT + (vb * 32 + l31) * 40 + ((kk * 16 + 8 * hl) ^ swz32(l31)));
          acc = mfma32(a, bb, acc);
        }
      }
#pragma unroll
      for (int g = 0; g < 4; ++g) {
        u32x2 pk; pk.x = pack2(acc[4 * g], acc[4 * g + 1]); pk.y = pack2(acc[4 * g + 2], acc[4 * g + 3]);
        *(u32x2*)(sRT + (vb * 32 + l31) * 40 + 8 * g + 4 * hl) = pk;
      }
    };
    if (wave == 0) {
      if (tid < 32) {
        const int q = tid >> 4, c = tid & 15;
        const float* Lq = sLab + (q * 16) * 36 + q * 16;
        float x[16];
        x[0] = (c == 0) ? 1.f : 0.f;
#define INV_GROUP_(I0, I1)                                                                           \
        {                                                                                            \
          f32x4 Lr[12];                                                                              \
          { int n = 0;                                                                               \
            _Pragma("unroll") for (int i = I0; i <= I1; ++i)                                         \
              _Pragma("unroll") for (int j4 = 0; j4 < i; j4 += 4) Lr[n++] = *(const f32x4*)(Lq + i * 36 + j4); }  \
          SCHED_FENCE_();                                                                            \
          { int n = 0;                                                                               \
            _Pragma("unroll") for (int i = I0; i <= I1; ++i) {                                       \
              float s0 = (i == c) ? 1.f : 0.f, s1 = 0.f;                                             \
              _Pragma("unroll") for (int j4 = 0; j4 < i; j4 += 4) {                                  \
                const f32x4 l4 = Lr[n++];                                                            \
                s0 += l4.x * x[j4];                                                                  \
                if (j4 + 1 < i) s1 += l4.y * x[j4 + 1];                                              \
                if (j4 + 2 < i) s0 += l4.z * x[j4 + 2];                                              \
                if (j4 + 3 < i) s1 += l4.w * x[j4 + 3];                                              \
              }                                                                                      \
              x[i] = s0 + s1;                                                                        \
            } }                                                                                      \
          SCHED_FENCE_();                                                                            \
        }
#ifdef CPU_EMU
#define SCHED_FENCE_() ((void)0)
#else
#define SCHED_FENCE_() __builtin_amdgcn_sched_barrier(0)
#endif
        INV_GROUP_(1, 8)
        INV_GROUP_(9, 12)
        INV_GROUP_(13, 15)
#undef INV_GROUP_
#undef SCHED_FENCE_
#pragma unroll
        for (int i = 0; i < 16; ++i) sD[q * 256 + i * 16 + c] = x[i];
      }
    } else if (FULL) {
      if (wave >= 2) rhs_block(wave - 2);
    } else {
      if (wave == 1) { rhs_block(0); rhs_block(1); }
      else rhs_block(wave);
    }
    __syncthreads();
    {
      const int i = tid >> 4, c = tid & 15;
      float sacc = 0.f;
#pragma unroll
      for (int j4 = 0; j4 < 16; j4 += 4) {
        const f32x4 l4 = *(const f32x4*)(sLab + (16 + i) * 36 + j4);
        sacc += l4.x * sD[j4 * 16 + c] + l4.y * sD[(j4 + 1) * 16 + c] + l4.z * sD[(j4 + 2) * 16 + c] + l4.w * sD[(j4 + 3) * 16 + c];
      }
      sD[512 + i * 16 + c] = sacc;
    }
    __syncthreads();
    {
      const int i = tid >> 4, c = tid & 15;
      float sacc = 0.f;
#pragma unroll
      for (int j4 = 0; j4 < 16; j4 += 4) {
        const f32x4 d4 = *(const f32x4*)(sD + 256 + i * 16 + j4);
        sacc += d4.x * sD[512 + j4 * 16 + c] + d4.y * sD[512 + (j4 + 1) * 16 + c] + d4.z * sD[512 + (j4 + 2) * 16 + c] + d4.w * sD[512 + (j4 + 3) * 16 + c];
      }
      sM[(16 + i) * 40 + c] = f2bf(sacc);
      sM[i * 40 + c] = f2bf(sD[i * 16 + c]);
      sM[(16 + i) * 40 + 16 + c] = f2bf(sD[256 + i * 16 + c]);
      sM[i * 40 + 16 + c] = 0;
    }
    __syncthreads();
    if (wave < NVB) {
      const int vb = wave;
      f32x16 acc;
#pragma unroll
      for (int r = 0; r < 16; ++r) acc[r] = 0.f;
#pragma unroll
      for (int kk = 0; kk < 2; ++kk) {
        bf16x8 a = *(const bf16x8*)(sM + l31 * 40 + kk * 16 + 8 * hl);
        bf16x8 bb = *(const bf16x8*)(sRT + (vb * 32 + l31) * 40 + kk * 16 + 8 * hl);
        acc = mfma32(a, bb, acc);
      }
#pragma unroll
      for (int g = 0; g < 4; ++g) {
        u32x2 pk; pk.x = pack2(acc[4 * g], acc[4 * g + 1]); pk.y = pack2(acc[4 * g + 2], acc[4 * g + 3]);
        *(u32x2*)(sSAT + (vb * 32 + l31) * 40 + 8 * g + 4 * hl) = pk;
      }
    }
    __syncthreads();
    if (FULL) {
      if (wave < 2) {
        const int vb = wave;
        f32x16 acc;
#pragma unroll
        for (int r = 0; r < 16; ++r) acc[r] = 0.f;
#pragma unroll
        for (int kk = 0; kk < 4; ++kk) {
          bf16x8 a = *(const bf16x8*)(sZ + (vb * 32 + l31) * 72 + kk * 16 + 8 * hl);
          bf16x8 bb = *(const bf16x8*)(sRt + l31 * 72 + kk * 16 + 8 * hl);
          acc = mfma32(a, bb, acc);
        }
#pragma unroll
        for (int kk = 0; kk < 2; ++kk) {
          bf16x8 a = *(const bf16x8*)(sSAT + (vb * 32 + l31) * 40 + kk * 16 + 8 * hl);
          bf16x8 bb = *(const bf16x8*)(sLrb + l31 * 40 + kk * 16 + 8 * hl);
          acc = mfma32(a, bb, acc);
        }
#pragma unroll
        for (int kk = 0; kk < 2; ++kk) {
          bf16x8 a = *(const bf16x8*)(sVT + (vb * 32 + l31) * 40 + ((kk * 16 + 8 * hl) ^ swz32(l31)));
          bf16x8 bb = *(const bf16x8*)(sLrk + l31 * 40 + kk * 16 + 8 * hl);
          acc = mfma32(a, bb, acc);
        }
        {
          const size_t obase = (size_t)sRow[l31] * 1024 + d * 512 + h * 64 + vb * 32;
#pragma unroll
          for (int g = 0; g < 4; ++g) {
            u32x2 pk; pk.x = pack2(acc[4 * g], acc[4 * g + 1]); pk.y = pack2(acc[4 * g + 2], acc[4 * g + 3]);
            *(u32x2*)(yout + obase + 8 * g + 4 * hl) = pk;
          }
        }
      } else {
        const int cb = wave - 2;
#pragma unroll
        for (int vb = 0; vb < 2; ++vb) {
          f32x16 acc;
#pragma unroll
          for (int r = 0; r < 16; ++r) acc[r] = 0.f;
#pragma unroll
          for (int kk = 0; kk < 2; ++kk) {
            bf16x8 a = *(const bf16x8*)(sBT + (cb * 32 + l31) * 40 + ((kk * 16 + 8 * hl) ^ swz32(l31)));
            bf16x8 bb = *(const bf16x8*)(sSAT + (vb * 32 + l31) * 40 + kk * 16 + 8 * hl);
            acc = mfma32(a, bb, acc);
          }
#pragma unroll
          for (int kk = 0; kk < 2; ++kk) {
            bf16x8 a = *(const bf16x8*)(sKT + (cb * 32 + l31) * 40 + ((kk * 16 + 8 * hl) ^ swz32(l31)));
            bf16x8 bb = *(const bf16x8*)(sVT + (vb * 32 + l31) * 40 + ((kk * 16 + 8 * hl) ^ swz32(l31)));
            acc = mfma32(a, bb, acc);
          }
#pragma unroll
          for (int r = 0; r < 16; ++r) Zm[vb][r] = sPT[cb * 32 + acc_row(r, lane)] * (Zm[vb][r] + acc[r]);
        }
      }
      __syncthreads();
      if (wave >= 2) {
        const int cb = wave - 2;
#pragma unroll
        for (int vb = 0; vb < 2; ++vb)
#pragma unroll
          for (int g = 0; g < 4; ++g) {
            u32x2 pk; pk.x = pack2(Zm[vb][4 * g], Zm[vb][4 * g + 1]); pk.y = pack2(Zm[vb][4 * g + 2], Zm[vb][4 * g + 3]);
            *(u32x2*)(sZ + (vb * 32 + l31) * 72 + cb * 32 + 8 * g + 4 * hl) = pk;
          }
      }
    } else {
      const int vb = wave;
#pragma unroll
      for (int cb = 0; cb < 2; ++cb) {
        f32x16 acc;
#pragma unroll
        for (int r = 0; r < 16; ++r) acc[r] = 0.f;
#pragma unroll
        for (int kk = 0; kk < 2; ++kk) {
          bf16x8 a = *(const bf16x8*)(sBT + (cb * 32 + l31) * 40 + ((kk * 16 + 8 * hl) ^ swz32(l31)));
          bf16x8 bb = *(const bf16x8*)(sSAT + (vb * 32 + l31) * 40 + kk * 16 + 8 * hl);
          acc = mfma32(a, bb, acc);
        }
        if (vb < 2) {
#pragma unroll
          for (int kk = 0; kk < 2; ++kk) {
            bf16x8 a = *(const bf16x8*)(sKT + (cb * 32 + l31) * 40 + ((kk * 16 + 8 * hl) ^ swz32(l31)));
            bf16x8 bb = *(const bf16x8*)(sVT + (vb * 32 + l31) * 40 + ((kk * 16 + 8 * hl) ^ swz32(l31)));
            acc = mfma32(a, bb, acc);
          }
        }
#pragma unroll
        for (int r = 0; r < 16; ++r) Zm[cb][r] = sPT[cb * 32 + acc_row(r, lane)] * (Zm[cb][r] + acc[r]);
      }
#pragma unroll
      for (int cb = 0; cb < 2; ++cb)
#pragma unroll
        for (int g = 0; g < 4; ++g) {
          u32x2 pk; pk.x = pack2(Zm[cb][4 * g], Zm[cb][4 * g + 1]); pk.y = pack2(Zm[cb][4 * g + 2], Zm[cb][4 * g + 3]);
          *(u32x2*)(sZ + (vb * 32 + l31) * 72 + cb * 32 + 8 * g + 4 * hl) = pk;
        }
    }
  }
  if (!FULL) {
    float* Zs = segZ + ((size_t)sid * RW_NSEG + seg) * 64 * 128;
#pragma unroll
    for (int cb = 0; cb < 2; ++cb)
#pragma unroll
      for (int r = 0; r < 16; ++r) Zs[(cb * 32 + acc_row(r, lane)) * 128 + wave * 32 + l31] = Zm[cb][r];
  }
}

constexpr int LRU_NCH = (CTXL + SEQ) / 64;
constexpr size_t OFF_ACUM0 = OFF_PU;
static_assert((size_t)NLAT * 512 * 2 <= (size_t)2 * NEXP * 1024, "acum0");

struct LruRaw { u32x4 x[2][4]; };
DEV void lru_load_raw(const Params& P, int sid, int cc, LruRaw& R) {
  constexpr int NC_CTX = CTXL / 64;
  const int tid = threadIdx.x;
  const int d = sid & 1, blk = (sid >> 1) & 7, b = sid >> 4;
  const bf16_t* proj = (const bf16_t*)(P.ws + OFF_PROJ);
  const int sgi = cc >= NC_CTX;
  const int row0 = sgi ? NCTX + b * SEQ : b * CTXL;
  const int len = sgi ? SEQ : CTXL;
  const int cl = (sgi ? cc - NC_CTX : cc) * 64;
  const int lch = blk * 64 + (tid & 7) * 8;
  const u32x4 z4 = {0u, 0u, 0u, 0u};
#pragma unroll
  for (int i = 0; i < 2; ++i) {
    int c = tid + i * 256, r = c >> 3;
    int p = cl + r, pos = d ? len - 1 - p : p;
#pragma unroll
    for (int tap = 0; tap < 4; ++tap) {
      int pp = pos + tap - 2;
      R.x[i][tap] = (pp >= 0 && pp < len) ? *(const u32x4*)(proj + (size_t)(row0 + pp) * ODC + 2304 + lch) : z4;
    }
  }
}

DEV void st_lru_chunk(const Params& P, int sid, int cc, int nsid, int ncc, bool has_next, LruRaw& R, unsigned char* smem) {
  constexpr int NC_CTX = CTXL / 64;
  const int tid = threadIdx.x, lane = tid & 63, wave = tid >> 6;
  const int d = sid & 1, blk = (sid >> 1) & 7, b = sid >> 4;
  float* sXc = (float*)smem;
  float* sAc = sXc + 4096;
  float* sBc = sAc + 4096;
  float* sU = sBc + 4096;
  bf16_t* sAop = (bf16_t*)(sU + 4096);
  float* sQA = (float*)(sAop + 64 * 72);
  float* sQH = sQA + 256;
  int* sRow = (int*)(sQH + 256);
  const bf16_t* proj = (const bf16_t*)(P.ws + OFF_PROJ);
  bf16_t* uout = (bf16_t*)(P.ws + OFF_LORA) + (size_t)d * NTOK * 512;
  bf16_t* aout = (bf16_t*)(P.ws + (d ? OFF_ACUM1 : OFF_ACUM0));
  const bf16_t* lruT = (const bf16_t*)(P.ws + OFF_LRUT) + (size_t)(d * 8 + blk) * 128 * 64;
  float* chunkS = (float*)(P.ws + OFF_LRUCS) + ((size_t)sid * LRU_NCH + cc) * 128;
  const float* cw = P.in[I_LCONVW];
  const float* cb = P.in[I_LCONVB];
  const int tr = (wave >> 1) * 32, nc0 = (wave & 1) * 64;
  const int sgi = cc >= NC_CTX;
  const int row0 = sgi ? NCTX + b * SEQ : b * CTXL;
  const int len = sgi ? SEQ : CTXL;
  const int cl = (sgi ? cc - NC_CTX : cc) * 64;
  __syncthreads();
  if (tid < 64) { int p = cl + tid; sRow[tid] = row0 + (d ? len - 1 - p : p); }
  {
    const int lc8 = (tid & 7) * 8, lch = blk * 64 + lc8;
#pragma unroll
    for (int i = 0; i < 2; ++i) {
      int c = tid + i * 256, r = c >> 3;
      int p = cl + r, pos = d ? len - 1 - p : p;
      float o[8];
      f32x4 c0 = *(const f32x4*)(cb + lch), c1 = *(const f32x4*)(cb + lch + 4);
      o[0] = c0.x; o[1] = c0.y; o[2] = c0.z; o[3] = c0.w; o[4] = c1.x; o[5] = c1.y; o[6] = c1.z; o[7] = c1.w;
#pragma unroll
      for (int tap = 0; tap < 4; ++tap) {
        float x[8];
        unpack8(R.x[i][tap], x);
        f32x4 w0 = *(const f32x4*)(cw + tap * 512 + lch), w1 = *(const f32x4*)(cw + tap * 512 + lch + 4);
        o[0] += w0.x * x[0]; o[1] += w0.y * x[1]; o[2] += w0.z * x[2]; o[3] += w0.w * x[3];
        o[4] += w1.x * x[4]; o[5] += w1.y * x[5]; o[6] += w1.z * x[6]; o[7] += w1.w * x[7];
      }
      { f32x4 o0 = {o[0], o[1], o[2], o[3]}, o1 = {o[4], o[5], o[6], o[7]};
        *(f32x4*)(sXc + r * 64 + lc8) = o0; *(f32x4*)(sXc + r * 64 + lc8 + 4) = o1; }
      *(u32x4*)(sAop + r * 72 + lc8) = pack8(o);
    }
  }
  if (has_next) lru_load_raw(P, nsid, ncc, R);
  __syncthreads();
  {
    f32x16 acc[2];
#pragma unroll
    for (int j = 0; j < 2; ++j)
#pragma unroll
      for (int r = 0; r < 16; ++r) acc[j][r] = 0.f;
#pragma unroll
    for (int kk = 0; kk < 4; ++kk) {
      bf16x8 a = *(const bf16x8*)(sAop + (tr + (lane & 31)) * 72 + kk * 16 + 8 * (lane >> 5));
#pragma unroll
      for (int j = 0; j < 2; ++j) {
        bf16x8 bb = *(const bf16x8*)(lruT + (nc0 + j * 32 + (lane & 31)) * 64 + kk * 16 + 8 * (lane >> 5));
        acc[j] = mfma32(a, bb, acc[j]);
      }
    }
#pragma unroll
    for (int j = 0; j < 2; ++j) {
      const int e = nc0 + j * 32 + (lane & 31);
      const int ch = blk * 64 + (e & 63);
      const float ebias = e < 64 ? P.in[I_BA][d * 512 + ch] : P.in[I_BI][d * 512 + ch];
      const float esp = softplusf_(-P.in[I_LAM][d * 512 + ch]);
#pragma unroll
      for (int r = 0; r < 16; ++r) {
        int t = tr + acc_row(r, lane);
        float g = sigmoidf_(acc[j][r] + ebias);
        if (e < 64) { float a_ = fexp(-8.f * g * esp); sAc[t * 64 + e] = a_; sU[t * 64 + e] = fsqrt(fmaxf(1.f - a_ * a_, 0.f)); }
        else sBc[t * 64 + (e - 64)] = g * sXc[t * 64 + (e - 64)];
      }
    }
  }
  __syncthreads();
  const int c = tid & 63, q = tid >> 6;
  {
    float av[16], hv[16];
#pragma unroll
    for (int i = 0; i < 16; ++i) {
      const int t = q * 16 + i;
      av[i] = sAc[t * 64 + c];
      hv[i] = sU[t * 64 + c] * sBc[t * 64 + c];
    }
    float h = 0.f, ap = 1.f;
#pragma unroll
    for (int i = 0; i < 16; ++i) { h = av[i] * h + hv[i]; ap *= av[i]; hv[i] = h; av[i] = ap; }
    sQA[q * 64 + c] = ap; sQH[q * 64 + c] = h;
    __syncthreads();
    float hin = 0.f, ain = 1.f;
    for (int q2 = 0; q2 < q; ++q2) { hin = sQA[q2 * 64 + c] * hin + sQH[q2 * 64 + c]; ain *= sQA[q2 * 64 + c]; }
#pragma unroll
    for (int i = 0; i < 16; ++i) {
      const int t = q * 16 + i;
      sU[t * 64 + c] = hv[i] + av[i] * hin;
      sAc[t * 64 + c] = av[i] * ain;
    }
    if (q == 3) { chunkS[c] = av[15] * ain; chunkS[64 + c] = hv[15] + av[15] * hin; }
  }
  __syncthreads();
  if (sgi) {
#pragma unroll
    for (int i = 0; i < 2; ++i) {
      int cidx = tid + i * 256, r = cidx >> 3, c8 = (cidx & 7) * 8;
      float u8[8], a8[8];
      ld8(sU + r * 64 + c8, u8); ld8(sAc + r * 64 + c8, a8);
      const int row = sRow[r];
      *(u32x4*)(uout + (size_t)row * 512 + blk * 64 + c8) = pack8(u8);
      *(u32x4*)(aout + (size_t)(row - NCTX) * 512 + blk * 64 + c8) = pack8(a8);
    }
  }
}

DEV void st_lru_carry(const Params& P, int sid, unsigned char* smem) {
  const int tid = threadIdx.x, c = tid & 63, p = tid >> 6;
  constexpr int NQ = (LRU_NCH + 3) / 4, NBATCH = 13;
  const int c0 = p * NQ, c1 = (c0 + NQ < LRU_NCH) ? c0 + NQ : LRU_NCH;
  const float* cs = (const float*)(P.ws + OFF_LRUCS) + (size_t)sid * LRU_NCH * 128;
  float* hs = (float*)(P.ws + OFF_LRUHS) + (size_t)sid * LRU_NCH * 64;
  float* sA = (float*)smem;
  float* sH = sA + 256;
  float A = 1.f, H = 0.f;
  for (int cc0 = c0; cc0 < c1; cc0 += NBATCH) {
    float a[NBATCH], bb[NBATCH];
#pragma unroll
    for (int i = 0; i < NBATCH; ++i) {
      const int cc = cc0 + i < LRU_NCH ? cc0 + i : LRU_NCH - 1;
      a[i] = cs[(size_t)cc * 128 + c]; bb[i] = cs[(size_t)cc * 128 + 64 + c];
    }
#pragma unroll
    for (int i = 0; i < NBATCH; ++i) if (cc0 + i < c1) { H = a[i] * H + bb[i]; A *= a[i]; }
  }
  __syncthreads();
  sA[p * 64 + c] = A; sH[p * 64 + c] = H;
  __syncthreads();
  float h = 0.f;
  for (int p2 = 0; p2 < p; ++p2) h = sA[p2 * 64 + c] * h + sH[p2 * 64 + c];
  for (int cc0 = c0; cc0 < c1; cc0 += NBATCH) {
    float a[NBATCH], bb[NBATCH];
#pragma unroll
    for (int i = 0; i < NBATCH; ++i) {
      const int cc = cc0 + i < LRU_NCH ? cc0 + i : LRU_NCH - 1;
      a[i] = cs[(size_t)cc * 128 + c]; bb[i] = cs[(size_t)cc * 128 + 64 + c];
    }
#pragma unroll
    for (int i = 0; i < NBATCH; ++i) if (cc0 + i < c1) { hs[(size_t)(cc0 + i) * 64 + c] = h; h = a[i] * h + bb[i]; }
  }
}

DEV void st_finish_l1(const Params& P, int row) {
  const int lane = threadIdx.x & 63;
  bf16_t* hb = (bf16_t*)(P.ws + OFF_HBUF) + (size_t)row * 1024;
  const bf16_t* proj = (const bf16_t*)(P.ws + OFF_PROJ);
  const bf16_t* lora = (const bf16_t*)(P.ws + OFF_LORA);
  const float* mu = P.in[I_MU];
  const int ch = lane * 8;
  float y0[8], y1[8];
  unpack8(*(const u32x4*)(hb + ch), y0);
  unpack8(*(const u32x4*)(hb + 512 + ch), y1);
  float sm = 0.f;
#pragma unroll
  for (int j = 0; j < 8; ++j) { y0[j] += y1[j]; sm += y0[j]; }
  sm = sum8(sm);
  const float mean = sm * (1.f / 64.f);
  float sv = 0.f;
#pragma unroll
  for (int j = 0; j < 8; ++j) { float dlt = y0[j] - mean; sv += dlt * dlt; }
  sv = sum8(sv);
  const float rstd = frsq(sv * (1.f / 64.f) + 64e-5f);
  float a0[8], a1[8], g[8], u0[8], u1[8], gb[8];
  unpack8(*(const u32x4*)(lora + ((size_t)2 * NTOK + row) * 512 + ch), a0);
  unpack8(*(const u32x4*)(lora + ((size_t)3 * NTOK + row) * 512 + ch), a1);
  unpack8(*(const u32x4*)(lora + ((size_t)4 * NTOK + row) * 512 + ch), g);
  unpack8(*(const u32x4*)(lora + ((size_t)0 * NTOK + row) * 512 + ch), u0);
  unpack8(*(const u32x4*)(lora + ((size_t)1 * NTOK + row) * 512 + ch), u1);
  if (row >= NCTX) {
    const int bb_ = (row - NCTX) / SEQ, pos = (row - NCTX) % SEQ, blk = ch >> 6;
    float ac[8];
#pragma unroll
    for (int dd = 0; dd < 2; ++dd) {
      const int pidx = dd ? SEQ - 1 - pos : pos;
      const int cc = CTXL / 64 + pidx / 64;
      const int sid = (bb_ * 8 + blk) * 2 + dd;
      const float* hs = (const float*)(P.ws + OFF_LRUHS) + ((size_t)sid * LRU_NCH + cc) * 64 + (ch & 63);
      unpack8(*(const u32x4*)((const bf16_t*)(P.ws + (dd ? OFF_ACUM1 : OFF_ACUM0)) + (size_t)(row - NCTX) * 512 + ch), ac);
      f32x4 h0 = *(const f32x4*)hs, h1 = *(const f32x4*)(hs + 4);
      float* u = dd ? u1 : u0;
      u[0] += ac[0] * h0.x; u[1] += ac[1] * h0.y; u[2] += ac[2] * h0.z; u[3] += ac[3] * h0.w;
      u[4] += ac[4] * h1.x; u[5] += ac[5] * h1.y; u[6] += ac[6] * h1.z; u[7] += ac[7] * h1.w;
    }
  }
  unpack8(*(const u32x4*)(proj + (size_t)row * ODC + 1792 + ch), gb);
  float rv[8], vv[8], kv[8];
  float sdot = 0.f;
  float pka[8], prk[8], plw[8], plb[8];
  ld8(P.in[I_KA] + ch, pka); ld8(P.in[I_RK] + ch, prk); ld8(P.in[I_LNW] + ch, plw); ld8(P.in[I_LNB] + ch, plb);
  mix8(proj, row, ch, mu, rv);
  mix8(proj, row, 512 + ch, mu, kv);
  mix8(proj, row, 1024 + ch, mu, vv);
#pragma unroll
  for (int j = 0; j < 8; ++j) {
    float r = rv[j];
    float k = kv[j];
    float am = 0.5f * (a0[j] + a1[j]);
    float kb = k * (1.f + (am - 1.f) * pka[j]);
    sdot += r * kb * prk[j];
    rv[j] = r;
  }
  sdot = sum8(sdot);
  float f1[8], f2[8];
#pragma unroll
  for (int j = 0; j < 8; ++j) {
    float yn = (y0[j] - mean) * rstd * plw[j] + plb[j];
    yn += sdot * vv[j];
    f1[j] = yn * g[j];
    f2[j] = (u0[j] + u1[j]) * geluf_(gb[j]);
  }
  *(u32x4*)(hb + ch) = pack8(f1);
  *(u32x4*)(hb + 512 + ch) = pack8(f2);
}

DEV unsigned fkey(float f) { unsigned u; __builtin_memcpy(&u, &f, 4); return (u >> 31) ? ~u : (u | 0x80000000u); }
DEV float keyf(unsigned u) { u = (u >> 31) ? (u & 0x7fffffffu) : ~u; float f; __builtin_memcpy(&f, &u, 4); return f; }
DEV void key_insert(unsigned x, unsigned* v) {
#pragma unroll
  for (int j = 0; j < 16; ++j) { unsigned hi = v[j] > x ? v[j] : x; x = v[j] > x ? x : v[j]; v[j] = hi; }
}
DEV void key_cx(unsigned& hi, unsigned& lo) { unsigned a = hi, b = lo; hi = a > b ? a : b; lo = a > b ? b : a; }
DEV void key_sort16(unsigned* v) {
#pragma unroll
  for (int k = 2; k <= 16; k <<= 1)
#pragma unroll
    for (int j = k >> 1; j > 0; j >>= 1)
#pragma unroll
      for (int i = 0; i < 16; ++i) {
        const int l = i ^ j;
        if (l > i) { if ((i & k) == 0) key_cx(v[i], v[l]); else key_cx(v[l], v[i]); }
      }
}
DEV void key_merge16(unsigned* a, const unsigned* b) {
#pragma unroll
  for (int i = 0; i < 16; ++i) a[i] = a[i] > b[15 - i] ? a[i] : b[15 - i];
#pragma unroll
  for (int j = 8; j > 0; j >>= 1)
#pragma unroll
    for (int i = 0; i < 16; ++i) { const int l = i ^ j; if (l > i) key_cx(a[i], a[l]); }
}

DEV void st_peer_topk(const Params& P, int layer, int tile, int h, unsigned char* smem) {
  const int tid = threadIdx.x;
  const bf16_t* q = (const bf16_t*)(P.ws + OFF_Q);
  const bf16_t* keys = (const bf16_t*)(P.ws + OFF_KEYS) + (size_t)(layer * 8 + h) * 2 * 128 * 128;
  float* sS = (float*)smem;
  const int m0 = tile * 128;
  const int tok = tid & 127, half = tid >> 7;
  unsigned kl[2][16];
#pragma unroll
  for (int p = 0; p < 2; ++p) {
    EpiScoreLds epi{sS, m0};
    gemm_tile_128<true>(q + (h * 2 + p) * 128, 2048, NTOK, keys + p * 128 * 128, 128, 128, 128, m0, 0, epi, smem);
    __syncthreads();
    float* row = sS + tok * 129 + half * 64;
#pragma unroll
    for (int g = 0; g < 4; ++g) {
      unsigned grp[16];
#pragma unroll
      for (int j = 0; j < 16; ++j) grp[j] = (fkey(row[g * 16 + j]) & ~127u) | (unsigned)(127 - (half * 64 + g * 16 + j));
      key_sort16(grp);
      if (g == 0) {
#pragma unroll
        for (int j = 0; j < 16; ++j) kl[p][j] = grp[j];
      } else key_merge16(kl[p], grp);
    }
    if (half == 1) {
#pragma unroll
      for (int j = 0; j < 16; ++j) row[j] = __builtin_bit_cast(float, kl[p][j]);
    }
    __syncthreads();
    if (half == 0) {
      unsigned oth[16];
#pragma unroll
      for (int j = 0; j < 16; ++j) oth[j] = __builtin_bit_cast(unsigned, sS[tok * 129 + 64 + j]);
      key_merge16(kl[p], oth);
    }
    __syncthreads();
  }
  if (tid < 128) {
    float sv0[16], sv1[16];
    int* irow = (int*)(sS + tid * 129);
#pragma unroll
    for (int j = 0; j < 16; ++j) {
      sv0[j] = keyf((kl[0][j] & ~127u) | 64u); sv1[j] = keyf((kl[1][j] & ~127u) | 64u);
      irow[j] = 127 - (int)(kl[0][j] & 127u); irow[16 + j] = 127 - (int)(kl[1][j] & 127u);
    }
    unsigned best[16];
#pragma unroll
    for (int j = 0; j < 16; ++j) best[j] = 0u;
#pragma unroll
    for (int i = 0; i < 16; ++i)
#pragma unroll
      for (int j = 0; j < 16; ++j)
        if ((i + 1) * (j + 1) <= 16) key_insert((fkey(sv0[i] + sv1[j]) & ~255u) | (unsigned)(255 - (i * 16 + j)), best);
    float e[16], sum = 0.f;
    const float b0 = keyf((best[0] & ~255u) | 128u);
#pragma unroll
    for (int j = 0; j < 16; ++j) { e[j] = fexp(keyf((best[j] & ~255u) | 128u) - b0); sum += e[j]; }
    const float inv = 1.f / sum;
    int* pidx = (int*)(P.ws + OFF_PIDX) + (size_t)(m0 + tid) * 128 + h * 16;
    float* pg = (float*)(P.ws + OFF_PGATE) + (size_t)(m0 + tid) * 128 + h * 16;
#pragma unroll
    for (int j = 0; j < 16; ++j) {
      const int pos = 255 - (int)(best[j] & 255u);
      pidx[j] = irow[pos >> 4] * 128 + irow[16 + (pos & 15)];
      pg[j] = e[j] * inv;
    }
  }
}

DEV void st_peer_experts(const Params& P, int layer, int row) {
  const int lane = threadIdx.x & 63;
  const bf16_t* xb = (const bf16_t*)(P.ws + OFF_HBUF) + (size_t)row * 1024;
  const unsigned char* U = P.ws + OFF_PU;
  const int* pidx = (const int*)(P.ws + OFF_PIDX) + (size_t)row * 128;
  const float* pg = (const float*)(P.ws + OFF_PGATE) + (size_t)row * 128;
  float x[16], acc[16];
  unpack8(*(const u32x4*)(xb + lane * 16), x);
  unpack8(*(const u32x4*)(xb + lane * 16 + 8), x + 8);
#pragma unroll
  for (int j = 0; j < 16; ++j) acc[j] = 0.f;
  const int b3 = (lane >> 3) & 1;
  const int mypick = (lane >> 3) & 7;
#ifdef CPU_EMU
#define PEER_SID(id) (id)
#else
#define PEER_SID(id) __builtin_amdgcn_readfirstlane(id)
#endif
  const unsigned lo12 = lane * 12, lo8 = PEER_VOFF + lane * 8;
#define PEER_LDU(i, id) do { const unsigned* up_ = (const unsigned*)(U + (size_t)(unsigned)(id) * PEER_ROWB + lo12); \
    uu[i].x = up_[0]; uu[i].y = up_[1]; uu[i].z = up_[2]; } while (0)
#define PEER_LDV(i, id) vv[i] = *(const u32x2*)(U + (size_t)(unsigned)(id) * PEER_ROWB + lo8)
#define PEER_IDS(v0, v1) {PEER_SID((int)v0.x), PEER_SID((int)v0.y), PEER_SID((int)v0.z), PEER_SID((int)v0.w), \
                          PEER_SID((int)v1.x), PEER_SID((int)v1.y), PEER_SID((int)v1.z), PEER_SID((int)v1.w)}
  u32x3 uu[8]; u32x2 vv[8];
  int cid[8];
  {
    const u32x4 p0 = *(const u32x4*)pidx, p1 = *(const u32x4*)(pidx + 4);
    const int id[8] = PEER_IDS(p0, p1);
#pragma unroll
    for (int i = 0; i < 8; ++i) { cid[i] = id[i]; PEER_LDU(i, id[i]); }
  }
  u32x4 n0 = *(const u32x4*)(pidx + 8), n1 = *(const u32x4*)(pidx + 12);
  float gcur = pg[mypick];
  for (int k0 = 0; k0 < 128; k0 += 8) {
#pragma unroll
    for (int i = 0; i < 8; ++i) PEER_LDV(i, cid[i]);
    const int nid[8] = PEER_IDS(n0, n1);
    {
      const int k2 = k0 + 16 < 128 ? k0 + 16 : 120;
      n0 = *(const u32x4*)(pidx + k2); n1 = *(const u32x4*)(pidx + k2 + 4);
    }
    const float gnxt = pg[(k0 + 8 < 128 ? k0 + 8 : 120) + mypick];
    float dsum[8];
#pragma unroll
    for (int i = 0; i < 8; i += 2) {
      float ufa[16], ufb[16];
#ifndef CPU_EMU
      __builtin_amdgcn_sched_barrier(0);
#endif
      unpack2x16_fp6(uu[i], uu[i + 1], ufa, ufb);
      PEER_LDU(i, nid[i]); PEER_LDU(i + 1, nid[i + 1]);
      typedef __attribute__((ext_vector_type(2))) float f32x2v;
      f32x2v da2 = {0.f, 0.f}, db2 = {0.f, 0.f};
#pragma unroll
      for (int j = 0; j < 8; ++j) {
        const f32x2v xx = {x[2 * j], x[2 * j + 1]};
        const f32x2v ua = {ufa[2 * j], ufa[2 * j + 1]}, ub = {ufb[2 * j], ufb[2 * j + 1]};
        da2 = xx * ua + da2; db2 = xx * ub + db2;
      }
      dsum[i] = da2.x + da2.y; dsum[i + 1] = db2.x + db2.y;
    }
    float e4[4], e2[2], g;
#pragma unroll
    for (int i = 0; i < 4; ++i) e4[i] = swap32_sum(dsum[i], dsum[4 + i]);
#pragma unroll
    for (int i = 0; i < 2; ++i) e2[i] = swap16_sum(e4[i], e4[2 + i]);
    {
      float mine = b3 ? e2[1] : e2[0], send = b3 ? e2[0] : e2[1];
      g = mine + dpp_xor<8>(send);
    }
    g = sum8(g);
    const float mycoef = gcur * geluf_(g * (1.f / PEER_USCALE));
#pragma unroll
    for (int i = 0; i < 8; ++i) {
      const float coef = wreadlane(mycoef, i * 8);
      float vf[16];
      unpack8_fp4(vv[i].x, vf); unpack8_fp4(vv[i].y, vf + 8);
#pragma unroll
      for (int j = 0; j < 16; ++j) acc[j] += coef * vf[j];
    }
#pragma unroll
    for (int i = 0; i < 8; ++i) cid[i] = nid[i];
    gcur = gnxt;
  }
#undef PEER_LDU
#undef PEER_LDV
#undef PEER_IDS
#undef PEER_SID
  float* xr = row < NCTX ? (float*)(P.ws + OFF_CTXRES) + (size_t)row * 1024 : P.out + (size_t)(row - NCTX) * 1024;
  const float* g2 = (const float*)(P.ws + OFF_MODV) + ((size_t)layer * 3 + mod_row(row)) * 6144 + 5 * 1024;
  float o[16];
#pragma unroll
  for (int q = 0; q < 4; ++q) {
    const int c = lane * 16 + q * 4;
    f32x4 a = *(const f32x4*)(xr + c), ga = *(const f32x4*)(g2 + c);
    o[q * 4 + 0] = a.x + ga.x * acc[q * 4 + 0] * (1.f / PEER_VSCALE); o[q * 4 + 1] = a.y + ga.y * acc[q * 4 + 1] * (1.f / PEER_VSCALE);
    o[q * 4 + 2] = a.z + ga.z * acc[q * 4 + 2] * (1.f / PEER_VSCALE); o[q * 4 + 3] = a.w + ga.w * acc[q * 4 + 3] * (1.f / PEER_VSCALE);
  }
  float ss = 0.f;
#pragma unroll
  for (int j = 0; j < 16; ++j) ss += o[j] * o[j];
  ss = wave_sum(ss);
  const float rstd = frsq(ss * (1.f / 1024.f) + 1e-6f);
  if (layer == 1) {
    float fn[16]; ld8(P.in[I_FNORM] + lane * 16, fn); ld8(P.in[I_FNORM] + lane * 16 + 8, fn + 8);
#pragma unroll
    for (int j = 0; j < 16; ++j) o[j] *= rstd * fn[j];
  }
#pragma unroll
  for (int q = 0; q < 4; ++q) {
    f32x4 a = {o[q * 4 + 0], o[q * 4 + 1], o[q * 4 + 2], o[q * 4 + 3]};
    *(f32x4*)(xr + lane * 16 + q * 4) = a;
  }
  if (layer == 0) {
    const float* mv = (const float*)(P.ws + OFF_MODV) + ((size_t)1 * 3 + mod_row(row)) * 6144;
    const float* nw = P.in[I_NORM1] + 1024;
    float hh[16];
#pragma unroll
    for (int q = 0; q < 4; ++q) {
      const int c = lane * 16 + q * 4;
      f32x4 w4 = *(const f32x4*)(nw + c), s4 = *(const f32x4*)(mv + 1024 + c), h4 = *(const f32x4*)(mv + c);
      hh[q * 4 + 0] = o[q * 4 + 0] * rstd * w4.x * (1.f + s4.x) + h4.x; hh[q * 4 + 1] = o[q * 4 + 1] * rstd * w4.y * (1.f + s4.y) + h4.y;
      hh[q * 4 + 2] = o[q * 4 + 2] * rstd * w4.z * (1.f + s4.z) + h4.z; hh[q * 4 + 3] = o[q * 4 + 3] * rstd * w4.w * (1.f + s4.w) + h4.w;
    }
    bf16_t* hb = (bf16_t*)(P.ws + OFF_HBUF) + (size_t)row * 1024 + lane * 16;
    *(u32x4*)hb = pack8(hh);
    *(u32x4*)(hb + 8) = pack8(hh + 8);
  }
}


#define FOR_TILES_XCD(MT0, MT1, NT, mt, nt)                                                     \
  for (int _x = blockIdx.x & 7, _mlo = (MT0) + (((MT1) - (MT0)) * _x) / 8,                        \
           _mhi = (MT0) + (((MT1) - (MT0)) * (_x + 1)) / 8, _i = blockIdx.x >> 3,                 \
           _cnt = (_mhi - _mlo) * (NT), mt = 0, nt = 0;                                           \
       _i < _cnt && ((mt = _mlo + _i / (NT)), (nt = _i % (NT)), true); _i += (int)(gridDim.x >> 3))

#ifndef PHASE_LIST
#define PHASE_LIST(X) X(0) X(1) X(2) X(22) X(23) X(3) X(4) X(5) X(6) X(7) X(8) X(9) X(11) X(12) X(13) X(30) X(14) X(15) X(31) X(16) X(17) X(18) X(19) X(20) X(21)
#endif
constexpr int PH_LAST = 21;

template <int ph>
DEV void run_phase(const Params& P, unsigned char* smem) {
  int bid_ = blockIdx.x, wave_ = threadIdx.x >> 6;
  OPAQUE_S(bid_); OPAQUE(wave_);
  const int bid = bid_, nb = gridDim.x;
  const int wave = wave_;
  unsigned char* ws = P.ws;
  constexpr int layer = ((ph >= 10 && ph <= 21) || ph >= 30) ? 1 : 0;
  const float* modv_l = (const float*)(ws + OFF_MODV) + (size_t)layer * 3 * 6144;
  switch (ph) {
    case 0:
      for (int t = NTRANS + bid; t < NPREP; t += nb) st_prep(P, t, smem);
      break;
    case 1: case 10:
      if (ph == 1) for (int t = nb - 1 - bid; t < NTRANS; t += nb) st_prep(P, t, smem);
      for (int t = bid; t < NTOK / 4; t += nb) st_normmod(P, layer, 0, t * 4 + wave);
      break;
    case 2: {
      EpiProjL0T epi{(bf16_t*)(ws + OFF_PROJ), (float*)(ws + OFF_GATES)};
      FOR_TILES_XCD(0, NTOK / 256, 25, mt, nt)
        gemm_tile_128x256<EpiProjL0T, true>((const bf16_t*)(ws + OFF_WEVIN), 1024, EVC, (const bf16_t*)(ws + OFF_HBUF), 1024, NTOK, 1024,
                                            nt * 128, mt * 256, epi, smem);
    } break;
    case 22:
      for (int t = bid; t < NTOK / 4; t += nb) st_xbc_conv(P, t * 4 + wave);
      for (int t = bid; t < NPCONV; t += nb) st_peer_conv(P, 0, t);
      break;
    case 23:
      for (int t = bid; t < 48 * LA_NSEG; t += nb) {
        int sid = t % 48, seg = t / 48;
        if (sid < 16) st_linattn_seg<true, false>(P, sid, seg, smem);
        else st_linattn_seg<false, false>(P, sid - 16, seg, smem);
      }
      break;
    case 3:
      for (int t = bid; t < 48 * LA_NSEG; t += nb) {
        int sid = t % 48, seg = t / 48;
        if (sid < 16) st_linattn_seg<true, true>(P, sid, seg, smem);
        else st_linattn_seg<false, true>(P, sid - 16, seg, smem);
      }
      break;
    case 4:
      for (int t = bid; t < NTOK / 4; t += nb) st_finish_l0(P, t * 4 + wave);
      break;
    case 5: case 17: {
      EpiOutProjT epi{layer == 0 ? P.in[I_X] : P.out, P.in[I_CTX], P.out, (float*)(ws + OFF_CTXRES), modv_l};
      const bf16_t* Wt = (const bf16_t*)(ws + (layer == 0 ? OFF_WEVOUT : OFF_WODOUT));
      FOR_TILES_XCD(layer == 0 ? 0 : NCTX / 256, NTOK / 256, 8, mt, nt)
        gemm_tile_128x256<EpiOutProjT, true>(Wt, 1024, 1024, (const bf16_t*)(ws + OFF_HBUF), 1024, NTOK, 1024, nt * 128, mt * 256, epi, smem);
    } break;
    case 6: case 18: {
      const int r0 = layer == 0 ? 0 : NCTX / 4;
      for (int t = r0 + bid; t < NTOK / 4; t += nb) st_normmod(P, layer, 1, t * 4 + wave);
      if (ph == 18) for (int t = bid; t < NPCONV; t += nb) st_peer_conv(P, 1, t);
    } break;
    case 7: case 19: {
      EpiStoreBfT epi{(bf16_t*)(ws + OFF_Q), 2048};
      const bf16_t* Wt = (const bf16_t*)(ws + OFF_WQ) + (size_t)layer * 2048 * 1024;
      FOR_TILES_XCD(layer == 0 ? 0 : NCTX / 256, NTOK / 256, 16, mt, nt)
        gemm_tile_128x256<EpiStoreBfT, true>(Wt, 1024, 2048, (const bf16_t*)(ws + OFF_HBUF), 1024, NTOK, 1024, nt * 128, mt * 256, epi, smem);
    } break;
    case 8: case 20: {
      const int t0 = layer == 0 ? 0 : CTILE * 8;
      for (int t = t0 + bid; t < NTILE * 8; t += nb) st_peer_topk(P, layer, t / 8, t % 8, smem);
    } break;
    case 9: case 21: {
      const int r0 = layer == 0 ? 0 : NCTX / 4;
      for (int t = r0 + bid; t < NTOK / 4; t += nb) st_peer_experts(P, layer, t * 4 + wave);
    } break;
    case 11: {
      EpiStoreBfT epi{(bf16_t*)(ws + OFF_PROJ), ODC};
      FOR_TILES_XCD(0, NTOK / 256, 22, mt, nt)
        gemm_tile_128x256<EpiStoreBfT, true>((const bf16_t*)(ws + OFF_WODIN), 1024, ODC, (const bf16_t*)(ws + OFF_HBUF), 1024, NTOK, 1024,
                                             nt * 128, mt * 256, epi, smem);
    } break;
    case 12:
      for (int t = bid; t < NTOK / 8; t += nb) st_lora_act(P, t * 8 + wave * 2);
      break;
    case 13:
      for (int t = bid; t < NTILE * 20; t += nb) {
        int job = t / (NTILE * 4), tt = t % (NTILE * 4);
        int mt = tt / 4, nt = tt % 4;
        bf16_t* dst = (bf16_t*)(ws + OFF_LORA) + (size_t)job * NTOK * 512;
        const bf16_t* A = (const bf16_t*)(ws + OFF_HBUF) + (job < 2 ? 0 : (job < 4 ? 64 : 128));
        const bf16_t* Bt = job < 2 ? (const bf16_t*)(ws + OFF_WUP) + (size_t)job * 512 * 64
                         : job < 4 ? (const bf16_t*)(ws + OFF_AUP) + (size_t)(job - 2) * 512 * 64
                                   : (const bf16_t*)(ws + OFF_GUP);
        const float* bias = job < 2 ? P.in[I_W0] + job * 512 : (job < 4 ? P.in[I_A0] + (job - 2) * 512 : nullptr);
        const int K = job < 4 ? 64 : 128;
        EpiStoreBfBiasT epi{dst, 512, bias, job < 2 ? 1 : (job < 4 ? 2 : 0)};
        gemm_tile_128<false, EpiStoreBfBiasT, true>(Bt, K, 512, A, 1024, NTOK, K, nt * 128, mt * 128, epi, smem);
      }
      break;
    case 30:
      for (int t = bid; t < 32 * RW_NSEG; t += nb) st_rwkv_seg<false>(P, t % 32, t / 32, smem);
      break;
    case 14:
      for (int t = bid; t < 32 * RW_NSEG; t += nb) st_rwkv_seg<true>(P, t % 32, t / 32, smem);
      break;
    case 15:
      {
        LruRaw R;
        if (bid < 32 * LRU_NCH) lru_load_raw(P, bid % 32, bid / 32, R);
        for (int t = bid; t < 32 * LRU_NCH; t += nb) {
          const int tn = t + nb;
          st_lru_chunk(P, t % 32, t / 32, tn % 32, tn / 32, tn < 32 * LRU_NCH, R, smem);
        }
      }
      break;
    case 31:
      if (bid < 32) st_lru_carry(P, bid, smem);
      break;
    case 16:
      for (int t = bid; t < NTOK / 4; t += nb) st_finish_l1(P, t * 4 + wave);
      break;
    default: break;
  }
}


#ifndef CPU_EMU
#define XB_TMO      128
#define XB_XCNT(j)  (256  + 64 * (j))
#define XB_XSUB(j)  (1280 + 64 * (j))
#define XB_XGEN(j)  (2304 + 64 * (j))
#define XB_TOP      3328
#define XB_TOPGEN   3392
#define XCD_BAR_WORDS 3456
#define XB_SPIN_CAP (1u << 20)
#define LAS __attribute__((address_space(3)))
__device__ __forceinline__ unsigned xb_ld(unsigned* p)              { return __hip_atomic_load(p, __ATOMIC_RELAXED, __HIP_MEMORY_SCOPE_AGENT); }
__device__ __forceinline__ unsigned xb_add(unsigned* p, unsigned v) { return __hip_atomic_fetch_add(p, v, __ATOMIC_RELAXED, __HIP_MEMORY_SCOPE_AGENT); }
__device__ __forceinline__ unsigned xb_xcc_id() { return (unsigned)__builtin_amdgcn_s_getreg((3 << 11) | 20) & 0xFu; }
#define XB_SPIN(cond, bar) do { unsigned _sp = 0; while (cond) { __builtin_amdgcn_s_sleep(1); \
    if ((++_sp & 255u) == 0u) { if (xb_ld(&(bar)[XB_TMO])) break; if (_sp > XB_SPIN_CAP) { atomicAdd(&(bar)[XB_TMO], 1u); break; } } } } while (0)
struct XcdBarrier { unsigned* bar; unsigned x; volatile LAS unsigned* st; };
__device__ __forceinline__ XcdBarrier xcd_barrier_post(unsigned* bar, volatile LAS unsigned* st) {
  XcdBarrier b; b.bar = bar; b.x = xb_xcc_id(); b.st = st;
  if (threadIdx.x == 0) (void)xb_add(&bar[XB_XCNT(b.x)], 1u);
  return b;
}
__device__ __forceinline__ void xcd_barrier_complete(unsigned* bar, unsigned x, unsigned& nloc, unsigned& nx) {
  const unsigned G = gridDim.x * gridDim.y * gridDim.z;
  unsigned sum, cnt, mine, sp = 0u;
  for (;;) {
    sum = 0u; cnt = 0u; mine = 0u;
#pragma unroll
    for (unsigned j = 0; j < 16; ++j) { const unsigned c = xb_ld(&bar[XB_XCNT(j)]); sum += c; cnt += (c > 0u) ? 1u : 0u; mine = (j == x) ? c : mine; }
    if (sum == G) break;
    __builtin_amdgcn_s_sleep(1);
    if ((++sp & 255u) == 0u) { if (xb_ld(&bar[XB_TMO])) break; if (sp > XB_SPIN_CAP) { atomicAdd(&bar[XB_TMO], 1u); break; } }
  }
  nloc = mine > 0u ? mine : 1u; nx = cnt > 0u ? cnt : 1u;
}
__device__ __forceinline__ void xcd_barrier(const XcdBarrier& b) {
  asm volatile("s_waitcnt vmcnt(0)" ::: "memory");
  __syncthreads();
  if (threadIdx.x == 0) {
    unsigned* bar = b.bar;
    __builtin_amdgcn_s_waitcnt(0);
    unsigned nloc = b.st[0], nx = b.st[1];
    if (nloc == 0u) { xcd_barrier_complete(bar, b.x, nloc, nx); b.st[0] = nloc; b.st[1] = nx; }
    const unsigned old = xb_add(&bar[XB_XSUB(b.x)], 1u);
    const unsigned gen = old / nloc;
    if (old + 1u == (gen + 1u) * nloc) {
      __builtin_amdgcn_fence(__ATOMIC_RELEASE, "agent");
      asm volatile("s_waitcnt vmcnt(0)" ::: "memory");
      const unsigned og = xb_add(&bar[XB_TOP], 1u);
      const unsigned tg = og / nx;
      if (og + 1u == (tg + 1u) * nx) xb_add(&bar[XB_TOPGEN], 1u);
      else XB_SPIN(xb_ld(&bar[XB_TOPGEN]) == tg, bar);
      __builtin_amdgcn_fence(__ATOMIC_ACQUIRE, "agent");
      xb_add(&bar[XB_XGEN(b.x)], 1u);
      asm volatile("s_waitcnt vmcnt(0)" ::: "memory");
    } else {
      XB_SPIN(xb_ld(&bar[XB_XGEN(b.x)]) == gen, bar);
      __builtin_amdgcn_fence(__ATOMIC_ACQUIRE, "agent");
      asm volatile("s_waitcnt vmcnt(0)" ::: "memory");
    }
  }
  __syncthreads();
}
#endif
#ifndef CPU_EMU
#define RUN_PH(n) run_phase<n>(P, smem_raw); if (n != PH_LAST) xcd_barrier(xb);
__global__ void __launch_bounds__(256, 2) mega_kernel(Params P) {
  SMEM_DECL;
  unsigned* bar = (unsigned*)(P.ws + OFF_BAR);
  volatile LAS unsigned* st = (volatile LAS unsigned*)(smem_raw + SMEM_BYTES - 16);
  if (threadIdx.x == 0) { st[0] = 0u; st[1] = 0u; }
  if (P.ws == nullptr) cg::this_grid().sync();
  __syncthreads();
  XcdBarrier xb = xcd_barrier_post(bar, st);
  PHASE_LIST(RUN_PH)
}

extern "C" void kernel_launch(void* const* d_in, const int* in_sizes, int n_in, void* d_out, int out_size, void* d_ws,
                              size_t ws_size, hipStream_t stream) {
  Params P{};
  for (int i = 0; i < N_IN; ++i) P.in[i] = (const float*)d_in[i];
  P.out = (float*)d_out;
  P.ws = (unsigned char*)d_ws;
  if (ws_size < WS_NEEDED) { fprintf(stderr, "workspace too small: %zu < %zu\n", ws_size, (size_t)WS_NEEDED); return; }
  static int grid_blocks = 0;
  if (!grid_blocks) {
    int dev = 0, cus = 0, per_cu = 0;
    hipGetDevice(&dev);
    hipDeviceGetAttribute(&cus, hipDeviceAttributeMultiprocessorCount, dev);
    hipOccupancyMaxActiveBlocksPerMultiprocessor(&per_cu, mega_kernel, 256, 0);
    if (per_cu > 2) per_cu = 2;
    grid_blocks = cus * per_cu;
  }
  (void)hipMemsetAsync((unsigned char*)d_ws + OFF_BAR, 0, 16384, stream);
  void* args[] = {&P};
  hipError_t e = hipLaunchCooperativeKernel((void*)mega_kernel, dim3(grid_blocks), dim3(256), args, 0, stream);
  if (e != hipSuccess) fprintf(stderr, "cooperative launch failed: %s (grid %d)\n", hipGetErrorString(e), grid_blocks);
}
#endif
```

```cpp
#ifdef CPU_EMU
#include "emu.h"
#else
#include <hip/hip_runtime.h>
#include <hip/hip_cooperative_groups.h>
#include <cstdio>
namespace cg = cooperative_groups;
#define DEV __device__ __forceinline__
#define DEVM __device__ __forceinline__
#define OPAQUE(x) asm volatile("" : "+v"(x))
#define OPAQUE_S(x) asm volatile("" : "+s"(x))
#endif

#ifndef SEQ_LEN
#define SEQ_LEN 16384
#endif
#ifndef CTX_LEN
#define CTX_LEN 256
#endif
#ifndef GRID_W_
#define GRID_W_ 64
#endif
#ifndef MULTI_LAUNCH
#define MULTI_LAUNCH 0
#endif

typedef unsigned short bf16_t;
typedef __attribute__((ext_vector_type(8))) short bf16x8;
typedef __attribute__((ext_vector_type(16))) float f32x16;
typedef __attribute__((ext_vector_type(4))) unsigned u32x4;
typedef __attribute__((ext_vector_type(2))) unsigned u32x2;
typedef __attribute__((ext_vector_type(4))) float f32x4;

constexpr int D = 1024, NB = 2, SEQ = SEQ_LEN, CTXL = CTX_LEN, GW = GRID_W_;
constexpr int NCTX = NB * CTXL, NLAT = NB * SEQ, NTOK = NCTX + NLAT;
constexpr int EVC = 3104, ODC = 2816;
constexpr int NEXP = 16384;
constexpr int NTILE = NTOK / 128, CTILE = NCTX / 128;
static_assert(NTOK % 256 == 0 && NCTX % 256 == 0, "tiles");
static_assert(CTXL % 64 == 0 && SEQ % 64 == 0 && SEQ % GW == 0, "chunks");

constexpr size_t al256(size_t x) { return (x + 255) & ~(size_t)255; }
constexpr size_t OFF_MODV = 0;
constexpr size_t OFF_CTXRES = OFF_MODV + al256(2 * 3 * 6144 * 4);
constexpr size_t OFF_GATES = OFF_CTXRES + al256((size_t)NCTX * 1024 * 4);
constexpr size_t OFF_WEVIN = OFF_GATES + al256((size_t)NTOK * 32 * 4);
constexpr size_t OFF_WEVOUT = OFF_WEVIN + al256((size_t)EVC * 1024 * 2);
constexpr size_t OFF_WODIN = OFF_WEVOUT + al256((size_t)1024 * 1024 * 2);
constexpr size_t OFF_WODOUT = OFF_WODIN + al256((size_t)ODC * 1024 * 2);
constexpr size_t OFF_WQ = OFF_WODOUT + al256((size_t)1024 * 1024 * 2);
constexpr size_t OFF_KEYS = OFF_WQ + al256((size_t)2 * 2048 * 1024 * 2);
constexpr size_t OFF_WUP = OFF_KEYS + al256((size_t)2 * 8 * 2 * 128 * 128 * 2);
constexpr size_t OFF_AUP = OFF_WUP + al256((size_t)2 * 512 * 64 * 2);
constexpr size_t OFF_GUP = OFF_AUP + al256((size_t)2 * 512 * 64 * 2);
constexpr size_t OFF_LRUT = OFF_GUP + al256((size_t)512 * 128 * 2);
constexpr size_t OFF_PU = OFF_LRUT + al256((size_t)2 * 8 * 128 * 64 * 2);
constexpr size_t OFF_PV = OFF_PU + al256((size_t)NEXP * 1024);
constexpr size_t OFF_HBUF = OFF_PV + al256((size_t)NEXP * 1024);
constexpr size_t OFF_PR = OFF_HBUF + al256((size_t)NTOK * 1024 * 2);
constexpr size_t PR_BYTES = (size_t)NTOK * 5376 * 2;
constexpr size_t OFF_BAR = OFF_PR + PR_BYTES;
constexpr size_t OFF_ACUM1 = OFF_BAR + 16384;
constexpr size_t OFF_LRUCS = OFF_ACUM1 + (size_t)NLAT * 512 * 2;
constexpr size_t OFF_LRUHS = OFF_LRUCS + (size_t)32 * ((CTXL + SEQ) / 64) * 128 * 4;
constexpr size_t WS_NEEDED = OFF_LRUHS + (size_t)32 * ((CTXL + SEQ) / 64) * 64 * 4;
#ifndef CPU_EMU
static_assert(WS_NEEDED <= (size_t)512 * 1024 * 1024, "workspace too large");
#endif
constexpr size_t OFF_PROJ = OFF_PR;
constexpr size_t OFF_R2L0 = OFF_PR + (size_t)NTOK * EVC * 2;
constexpr size_t OFF_LORA = OFF_PR + (size_t)NTOK * ODC * 2;
constexpr size_t OFF_Q = OFF_PR;
constexpr size_t OFF_PIDX = OFF_PR + (size_t)NTOK * 2048 * 2;
constexpr size_t OFF_PGATE = OFF_PIDX + (size_t)NTOK * 128 * 4;
static_assert(OFF_PGATE + (size_t)NTOK * 128 * 4 <= OFF_PR + PR_BYTES, "picks");

enum {
  I_X = 0, I_C, I_CTX, I_CCTX, I_MODW, I_MODB, I_NORM1, I_NORM2, I_WQ, I_KEYS, I_PU, I_PV,
  I_EVWIN, I_EVWOUT, I_IBIAS, I_FBIAS, I_MNORM, I_SCONVW, I_SCONVB, I_DTBIAS, I_ALOG, I_DSKIP, I_SNORM,
  I_ODWIN, I_ODWOUT, I_MU, I_W0, I_WUP, I_A0, I_AUP, I_GUP, I_KK, I_KA, I_RK, I_LNW, I_LNB,
  I_LCONVW, I_LCONVB, I_LAM, I_WA, I_BA, I_WI, I_BI, I_FNORM, N_IN
};

struct Params {
  const float* in[N_IN];
  float* out;
  unsigned char* ws;
};

constexpr int SMEM_BYTES = 80 * 1024;
#ifdef CPU_EMU
#define SMEM_DECL static thread_local __attribute__((aligned(16))) unsigned char smem_raw[SMEM_BYTES]
#else
#define SMEM_DECL __shared__ __attribute__((aligned(16))) unsigned char smem_raw[SMEM_BYTES]
#endif

DEV float bf2f(bf16_t v) { unsigned u = ((unsigned)v) << 16; float f; __builtin_memcpy(&f, &u, 4); return f; }
#ifdef CPU_EMU
DEV bf16_t f2bf(float f) { unsigned u; __builtin_memcpy(&u, &f, 4); u += 0x7fffu + ((u >> 16) & 1u); return (bf16_t)(u >> 16); }
DEV unsigned pack2(float a, float b) { return (unsigned)f2bf(a) | ((unsigned)f2bf(b) << 16); }
#else
typedef __attribute__((ext_vector_type(2))) float f32x2_t;
typedef __attribute__((ext_vector_type(2))) __bf16 bf16x2_t;
DEV unsigned pack2(float a, float b) { f32x2_t f = {a, b}; return __builtin_bit_cast(unsigned, __builtin_convertvector(f, bf16x2_t)); }
DEV bf16_t f2bf(float f) { return __builtin_bit_cast(unsigned short, (__bf16)f); }
#endif
DEV void unpack8(const u32x4& r, float* o) {
  unsigned w[4] = {r.x, r.y, r.z, r.w};
#pragma unroll
  for (int i = 0; i < 4; ++i) { unsigned lo = w[i] << 16, hi = w[i] & 0xffff0000u; __builtin_memcpy(&o[2 * i], &lo, 4); __builtin_memcpy(&o[2 * i + 1], &hi, 4); }
}
DEV u32x4 pack8(const float* o) { u32x4 r; r.x = pack2(o[0], o[1]); r.y = pack2(o[2], o[3]); r.z = pack2(o[4], o[5]); r.w = pack2(o[6], o[7]); return r; }
#ifdef CPU_EMU
DEV float fexp(float x) { return expf(x); }
DEV float frcp(float x) { return 1.f / x; }
DEV float flog(float x) { return logf(x); }
DEV float frsq(float x) { return 1.f / sqrtf(x); }
DEV float fsqrt(float x) { return sqrtf(x); }
#else
DEV float fexp(float x) { return __expf(x); }
DEV float frcp(float x) { return __builtin_amdgcn_rcpf(x); }
DEV float flog(float x) { return __logf(x); }
DEV float frsq(float x) { return __builtin_amdgcn_rsqf(x); }
DEV float fsqrt(float x) { return __builtin_amdgcn_sqrtf(x); }
#endif
DEV void ld8(const float* __restrict__ p, float* o) { const f32x4 a = *(const f32x4*)p, b = *(const f32x4*)(p + 4); o[0] = a.x; o[1] = a.y; o[2] = a.z; o[3] = a.w; o[4] = b.x; o[5] = b.y; o[6] = b.z; o[7] = b.w; }
DEV float sigmoidf_(float x) { return frcp(1.f + fexp(-x)); }
DEV float siluf_(float x) { return x * frcp(1.f + fexp(-x)); }
DEV float softplusf_(float x) { return fmaxf(x, 0.f) + flog(1.f + fexp(-fabsf(x))); }
DEV float tanhf_(float x) { return 1.f - 2.f * frcp(1.f + fexp(2.f * x)); }
DEV float geluf_(float x) { return 0.5f * x * (1.f + erff(x * 0.70710678118654752f)); }

DEV f32x16 mfma32(bf16x8 a, bf16x8 b, f32x16 c) {
#ifdef CPU_EMU
  return emu_mfma32(a, b, c);
#else
  return __builtin_amdgcn_mfma_f32_32x32x16_bf16(a, b, c, 0, 0, 0);
#endif
}
DEV float wshfl_xor(float v, int m) {
#ifdef CPU_EMU
  return emu_shfl_xor(v, m);
#else
  return __shfl_xor(v, m, 64);
#endif
}
template <int M> DEV float dpp_xor(float v) {
  static_assert(M == 1 || M == 2 || M == 7 || M == 8, "dpp pattern");
#ifdef CPU_EMU
  return emu_shfl_xor(v, M);
#else
  constexpr int ctrl = M == 1 ? 0xB1 : (M == 2 ? 0x4E : (M == 7 ? 0x141 : 0x128));
  return __int_as_float(__builtin_amdgcn_update_dpp(0, __float_as_int(v), ctrl, 0xf, 0xf, false));
#endif
}
DEV float sum8(float v) { v += dpp_xor<1>(v); v += dpp_xor<2>(v); v += dpp_xor<7>(v); return v; }
DEV float sum4(float v) { v += dpp_xor<1>(v); v += dpp_xor<2>(v); return v; }
DEV float sum16(float v) { v = sum8(v); v += dpp_xor<8>(v); return v; }
DEV float swap32_sum(float a, float b) {
#ifdef CPU_EMU
  float ra = emu_shfl_xor(a, 32), rb = emu_shfl_xor(b, 32);
  return ((threadIdx.x >> 5) & 1) ? b + rb : a + ra;
#else
  auto r = __builtin_amdgcn_permlane32_swap(__float_as_uint(a), __float_as_uint(b), false, false);
  return __uint_as_float(r[0]) + __uint_as_float(r[1]);
#endif
}
DEV float swap16_sum(float a, float b) {
#ifdef CPU_EMU
  float ra = emu_shfl_xor(a, 16), rb = emu_shfl_xor(b, 16);
  return ((threadIdx.x >> 4) & 1) ? b + rb : a + ra;
#else
  auto r = __builtin_amdgcn_permlane16_swap(__float_as_uint(a), __float_as_uint(b), false, false);
  return __uint_as_float(r[0]) + __uint_as_float(r[1]);
#endif
}
DEV float wave_sum(float v) {
  v = sum16(v);
  v = swap16_sum(v, v);
  return swap32_sum(v, v);
}
DEV float wave_incl_scan(float v) {
#ifdef CPU_EMU
  const int l = threadIdx.x & 63;
  for (int s = 1; s < 16; s <<= 1) { const bool ok = (l & 15) >= s; float o = emu_readlane(v, ok ? l - s : l); v += ok ? o : 0.f; }
  { const bool ok = ((l >> 4) & 1) != 0; float o = emu_readlane(v, ok ? (l & ~15) - 1 : l); v += ok ? o : 0.f; }
  { const bool ok = l >= 32; float o = emu_readlane(v, ok ? 31 : l); v += ok ? o : 0.f; }
  return v;
#else
#define DPP_ADD_(ctrl, rmask) v += __int_as_float(__builtin_amdgcn_update_dpp(0, __float_as_int(v), ctrl, rmask, 0xf, false))
  DPP_ADD_(0x111, 0xf); DPP_ADD_(0x112, 0xf); DPP_ADD_(0x114, 0xf); DPP_ADD_(0x118, 0xf);
  DPP_ADD_(0x142, 0xa); DPP_ADD_(0x143, 0xc);
#undef DPP_ADD_
  return v;
#endif
}

#ifdef CPU_EMU
static inline unsigned emu_f2fp8(float f) {
  unsigned sgn = f < 0.f ? 0x80u : 0u; float a = fabsf(f);
  if (!(a == a)) return 0x7f;
  if (a >= 448.f) return sgn | 0x7e;
  if (a < 0.0009765625f) return sgn;
  int e; frexpf(a, &e); e -= 1;
  if (e < -6) { int q = (int)nearbyintf(a * 512.f); return sgn | (unsigned)q; }
  float m = a / ldexpf(1.f, e);
  int q = (int)nearbyintf((m - 1.f) * 8.f);
  if (q == 8) { q = 0; e += 1; }
  if (e > 8) return sgn | 0x7e;
  return sgn | (unsigned)((e + 7) << 3) | (unsigned)q;
}
static inline float emu_fp82f(unsigned c) {
  unsigned sgn = c & 0x80, e = (c >> 3) & 15, m = c & 7;
  float v = e == 0 ? ldexpf((float)m, -9) : ldexpf(1.f + m / 8.f, (int)e - 7);
  return sgn ? -v : v;
}
#endif
DEV unsigned pack4_fp8(float a, float b, float c, float d) {
#ifdef CPU_EMU
  return emu_f2fp8(a) | (emu_f2fp8(b) << 8) | (emu_f2fp8(c) << 16) | (emu_f2fp8(d) << 24);
#else
  int w = 0;
  w = __builtin_amdgcn_cvt_pk_fp8_f32(a, b, w, false);
  w = __builtin_amdgcn_cvt_pk_fp8_f32(c, d, w, true);
  return (unsigned)w;
#endif
}
DEV void unpack4_fp8(unsigned w, float* o) {
#ifdef CPU_EMU
  o[0] = emu_fp82f(w & 255); o[1] = emu_fp82f((w >> 8) & 255); o[2] = emu_fp82f((w >> 16) & 255); o[3] = emu_fp82f(w >> 24);
#else
  typedef __attribute__((ext_vector_type(2))) float f32x2_;
  f32x2_ lo = __builtin_amdgcn_cvt_pk_f32_fp8((int)w, false);
  f32x2_ hi = __builtin_amdgcn_cvt_pk_f32_fp8((int)w, true);
  o[0] = lo.x; o[1] = lo.y; o[2] = hi.x; o[3] = hi.y;
#endif
}
DEV void unpack16_fp8(const u32x4& r, float* o) { unpack4_fp8(r.x, o); unpack4_fp8(r.y, o + 4); unpack4_fp8(r.z, o + 8); unpack4_fp8(r.w, o + 12); }
DEV float wreadlane(float v, int srclane) {
#ifdef CPU_EMU
  return emu_readlane(v, srclane);
#else
  int iv; __builtin_memcpy(&iv, &v, 4);
  int r = __builtin_amdgcn_readlane(iv, srclane);
  float f; __builtin_memcpy(&f, &r, 4); return f;
#endif
}
constexpr float PEER_USCALE = 64.f, PEER_VSCALE = 4.f;
#ifdef CPU_EMU
static inline unsigned emu_f2fp4(float f) {
  static const float lv[8] = {0.f, 0.5f, 1.f, 1.5f, 2.f, 3.f, 4.f, 6.f};
  unsigned sgn = f < 0.f ? 8u : 0u; float a = fabsf(f);
  int best = 0; float bd = 1e30f;
  for (int i = 0; i < 8; ++i) { float dd = fabsf(a - lv[i]); if (dd < bd || (dd == bd && (i & 1) == 0)) { bd = dd; best = i; } }
  return sgn | (unsigned)best;
}
static inline float emu_fp42f(unsigned c) {
  static const float lv[8] = {0.f, 0.5f, 1.f, 1.5f, 2.f, 3.f, 4.f, 6.f};
  float v = lv[c & 7]; return (c & 8) ? -v : v;
}
#endif
DEV unsigned pack8_fp4(const float* v) {
#ifdef CPU_EMU
  unsigned w = 0;
  for (int i = 0; i < 8; ++i) w |= emu_f2fp4(v[i]) << (4 * i);
  return w;
#else
  unsigned w = 0;
  w = __builtin_amdgcn_cvt_scalef32_pk_fp4_f32(w, v[0], v[1], 1.0f, 0);
  w = __builtin_amdgcn_cvt_scalef32_pk_fp4_f32(w, v[2], v[3], 1.0f, 1);
  w = __builtin_amdgcn_cvt_scalef32_pk_fp4_f32(w, v[4], v[5], 1.0f, 2);
  w = __builtin_amdgcn_cvt_scalef32_pk_fp4_f32(w, v[6], v[7], 1.0f, 3);
  return w;
#endif
}
DEV void unpack8_fp4(unsigned w, float* o) {
#ifdef CPU_EMU
  for (int i = 0; i < 8; ++i) o[i] = emu_fp42f((w >> (4 * i)) & 15u);
#else
  typedef __attribute__((ext_vector_type(2))) float f32x2_;
  f32x2_ a = __builtin_amdgcn_cvt_scalef32_pk_f32_fp4(w, 1.0f, 0);
  f32x2_ b = __builtin_amdgcn_cvt_scalef32_pk_f32_fp4(w, 1.0f, 1);
  f32x2_ c = __builtin_amdgcn_cvt_scalef32_pk_f32_fp4(w, 1.0f, 2);
  f32x2_ d = __builtin_amdgcn_cvt_scalef32_pk_f32_fp4(w, 1.0f, 3);
  o[0] = a.x; o[1] = a.y; o[2] = b.x; o[3] = b.y; o[4] = c.x; o[5] = c.y; o[6] = d.x; o[7] = d.y;
#endif
}
typedef __attribute__((ext_vector_type(3))) unsigned u32x3;
#ifndef FP6_INTERLEAVED
#define FP6_INTERLEAVED 1
#endif
#ifdef CPU_EMU
static inline unsigned emu_f2fp6(float f) {
  unsigned sgn = f < 0.f ? 32u : 0u; float a = fabsf(f);
  if (a >= 7.5f) return sgn | 31u;
  int e; unsigned code;
  if (a < 1.f) { int q = (int)nearbyintf(a * 8.f); code = (unsigned)q; }
  else { frexpf(a, &e); e -= 1; float m = a / ldexpf(1.f, e); int q = (int)nearbyintf((m - 1.f) * 8.f); if (q == 8) { q = 0; e += 1; } code = (unsigned)(((e + 1) << 3) | q); if (e > 2) code = 31u; }
  return sgn | code;
}
static inline float emu_fp62f(unsigned c) {
  unsigned e = (c >> 3) & 3, m = c & 7;
  float v = e == 0 ? m * 0.125f : ldexpf(1.f + m / 8.f, (int)e - 1);
  return (c & 32) ? -v : v;
}
#endif
DEV u32x3 pack16_fp6(const float* v) {
#ifdef CPU_EMU
  unsigned long long lo = 0; unsigned hi = 0;
  for (int i = 0; i < 16; ++i) {
    unsigned long long c = emu_f2fp6(v[i]); int bit = 6 * i;
    if (bit < 64) { lo |= c << bit; if (bit > 58) hi |= (unsigned)(c >> (64 - bit)); } else hi |= (unsigned)(c << (bit - 64));
  }
  u32x3 r; r.x = (unsigned)lo; r.y = (unsigned)(lo >> 32); r.z = hi; return r;
#else
  typedef __attribute__((ext_vector_type(6))) unsigned u32x6_;
  f32x16 a, b;
#if FP6_INTERLEAVED
#pragma unroll
  for (int i = 0; i < 8; ++i) { a[i] = v[2 * i]; b[i] = v[2 * i + 1]; a[8 + i] = 0.f; b[8 + i] = 0.f; }
#else
#pragma unroll
  for (int i = 0; i < 16; ++i) { a[i] = v[i]; b[i] = 0.f; }
#endif
  u32x6_ w = __builtin_amdgcn_cvt_scalef32_2xpk16_fp6_f32(a, b, 1.0f);
  u32x3 r; r.x = w[0]; r.y = w[1]; r.z = w[2]; return r;
#endif
}
DEV void unpack16_fp6(const u32x3& r, float* o) {
#ifdef CPU_EMU
  unsigned long long lo = (unsigned long long)r.x | ((unsigned long long)r.y << 32); unsigned hi = r.z;
  for (int i = 0; i < 16; ++i) {
    int bit = 6 * i; unsigned c;
    if (bit + 6 <= 64) c = (unsigned)(lo >> bit) & 63u;
    else if (bit >= 64) c = (hi >> (bit - 64)) & 63u;
    else c = ((unsigned)(lo >> bit) | (hi << (64 - bit))) & 63u;
    o[i] = emu_fp62f(c);
  }
#else
  typedef __attribute__((ext_vector_type(6))) unsigned u32x6_;
  typedef __attribute__((ext_vector_type(32))) float f32x32_;
  u32x6_ w; w[0] = r.x; w[1] = r.y; w[2] = r.z; w[3] = 0u; w[4] = 0u; w[5] = 0u;
  f32x32_ f = __builtin_amdgcn_cvt_scalef32_pk32_f32_fp6(w, 1.0f);
#pragma unroll
  for (int i = 0; i < 16; ++i) o[i] = f[i];
#endif
}
DEV void unpack2x16_fp6(const u32x3& ra, const u32x3& rb, float* oa, float* ob) {
#ifdef CPU_EMU
  unpack16_fp6(ra, oa); unpack16_fp6(rb, ob);
#else
  typedef __attribute__((ext_vector_type(6))) unsigned u32x6_;
  typedef __attribute__((ext_vector_type(32))) float f32x32_;
  u32x6_ w; w[0] = ra.x; w[1] = ra.y; w[2] = ra.z; w[3] = rb.x; w[4] = rb.y; w[5] = rb.z;
  f32x32_ f = __builtin_amdgcn_cvt_scalef32_pk32_f32_fp6(w, 1.0f);
#pragma unroll
  for (int i = 0; i < 16; ++i) { oa[i] = f[i]; ob[i] = f[16 + i]; }
#endif
}
constexpr int PEER_ROWB = 1024;
constexpr int PEER_VOFF = 512;


DEV int acc_row(int reg, int lane) { return (reg & 3) + 8 * (reg >> 2) + 4 * (lane >> 5); }

DEV int mod_row(int row) { return row < NCTX ? 2 : (row - NCTX) / SEQ; }

template <bool SYNC_EPI, class Epi, bool VEC4 = false>
DEV void gemm_tile_128(const bf16_t* __restrict__ A, int lda, int M, const bf16_t* __restrict__ Bt, int ldb, int N,
                       int K, int m0, int n0, const Epi& epi, unsigned char* smem) {
  constexpr int LS = 72;
  constexpr int STAGE = 2 * 128 * LS;
  bf16_t* sbase = (bf16_t*)smem;
  const int wave = threadIdx.x >> 6;
  const int wm = (wave >> 1) * 64, wn = (wave & 1) * 64;
  f32x16 acc[2][2];
#pragma unroll
  for (int i = 0; i < 2; ++i)
#pragma unroll
    for (int j = 0; j < 2; ++j)
#pragma unroll
      for (int r = 0; r < 16; ++r) acc[i][j][r] = 0.f;
  u32x4 ra[4], rb[4];
  auto gload = [&](int k0) {
    int tl_ = threadIdx.x; OPAQUE(tl_);
#pragma unroll
    for (int i = 0; i < 4; ++i) {
      int c = tl_ + i * 256, r = c >> 3, cc = (c & 7) * 8;
      int gr = m0 + r, gn = n0 + r;
      gr = gr < M ? gr : M - 1; gn = gn < N ? gn : N - 1;
      ra[i] = *(const u32x4*)(A + (size_t)gr * lda + k0 + cc);
      rb[i] = *(const u32x4*)(Bt + (size_t)gn * ldb + k0 + cc);
    }
  };
  auto lwrite = [&](int buf) {
    int tl_ = threadIdx.x; OPAQUE(tl_);
    bf16_t* sA = sbase + buf * STAGE;
    bf16_t* sB = sA + 128 * LS;
#pragma unroll
    for (int i = 0; i < 4; ++i) {
      int c = tl_ + i * 256, r = c >> 3, cc = (c & 7) * 8;
      *(u32x4*)(sA + r * LS + cc) = ra[i];
      *(u32x4*)(sB + r * LS + cc) = rb[i];
    }
  };
  const int nk = K >> 6;
  gload(0);
  __syncthreads();
  lwrite(0);
  if (nk > 1) gload(64);
  __syncthreads();
  for (int it = 0; it < nk; ++it) {
    int tl_ = threadIdx.x; OPAQUE(tl_);
    const int lane = tl_ & 63;
    const bf16_t* sA = sbase + (it & 1) * STAGE;
    const bf16_t* sB = sA + 128 * LS;
#pragma unroll
    for (int kk = 0; kk < 4; ++kk) {
      bf16x8 a[2], b[2];
      const int ko = kk * 16 + 8 * (lane >> 5);
#pragma unroll
      for (int i = 0; i < 2; ++i) a[i] = *(const bf16x8*)(sA + (wm + i * 32 + (lane & 31)) * LS + ko);
#pragma unroll
      for (int j = 0; j < 2; ++j) b[j] = *(const bf16x8*)(sB + (wn + j * 32 + (lane & 31)) * LS + ko);
#pragma unroll
      for (int i = 0; i < 2; ++i)
#pragma unroll
        for (int j = 0; j < 2; ++j) acc[i][j] = mfma32(a[i], b[j], acc[i][j]);
      if (kk == 1) {
        if (it + 1 < nk) lwrite((it + 1) & 1);
        if (it + 2 < nk) gload((it + 2) * 64);
      }
    }
    __syncthreads();
  }
  {
    int tl_ = threadIdx.x; OPAQUE(tl_);
    const int lane = tl_ & 63;
    if constexpr (VEC4) {
#pragma unroll
      for (int i = 0; i < 2; ++i)
#pragma unroll
        for (int j = 0; j < 2; ++j)
#pragma unroll
          for (int gq = 0; gq < 4; ++gq) {
            int row = m0 + wm + i * 32 + 8 * gq + 4 * (lane >> 5);
            int col = n0 + wn + j * 32 + (lane & 31);
            if (row < M && col < N) epi.store4(row, col, acc[i][j][4 * gq], acc[i][j][4 * gq + 1], acc[i][j][4 * gq + 2], acc[i][j][4 * gq + 3]);
          }
    } else {
#pragma unroll
      for (int i = 0; i < 2; ++i)
#pragma unroll
        for (int j = 0; j < 2; ++j)
#pragma unroll
          for (int r = 0; r < 16; ++r) {
            int row = m0 + wm + i * 32 + acc_row(r, lane);
            int col = n0 + wn + j * 32 + (lane & 31);
            if (row < M && col < N) epi(row, col, acc[i][j][r]);
          }
    }
  }
}

template <class Epi, bool VEC4 = false>
DEV void gemm_tile_128x256(const bf16_t* __restrict__ A, int lda, int M, const bf16_t* __restrict__ Bt, int ldb, int N,
                           int K, int m0, int n0, const Epi& epi, unsigned char* smem) {
  constexpr int LS = 72;
  bf16_t* sA = (bf16_t*)smem;
  bf16_t* sB = sA + 128 * LS;
  const int wave = threadIdx.x >> 6;
  const int wm = (wave >> 1) * 64, wn = (wave & 1) * 128;
  f32x16 acc[2][4];
#pragma unroll
  for (int i = 0; i < 2; ++i)
#pragma unroll
    for (int j = 0; j < 4; ++j)
#pragma unroll
      for (int r = 0; r < 16; ++r) acc[i][j][r] = 0.f;
  u32x4 ra[4], rb[8];
  {
    const int tid = threadIdx.x;
#pragma unroll
    for (int i = 0; i < 4; ++i) {
      int c = tid + i * 256, r = c >> 3, cc = (c & 7) * 8;
      { int gr = m0 + r; gr = gr < M ? gr : M - 1; ra[i] = *(const u32x4*)(A + (size_t)gr * lda + cc); }
    }
#pragma unroll
    for (int i = 0; i < 8; ++i) {
      int c = tid + i * 256, r = c >> 3, cc = (c & 7) * 8;
      { int gn = n0 + r; gn = gn < N ? gn : N - 1; rb[i] = *(const u32x4*)(Bt + (size_t)gn * ldb + cc); }
    }
  }
  for (int k0 = 0; k0 < K; k0 += 64) {
    int tl_ = threadIdx.x; OPAQUE(tl_);
    const int tid = tl_, lane = tl_ & 63;
    __syncthreads();
#pragma unroll
    for (int i = 0; i < 4; ++i) { int c = tid + i * 256, r = c >> 3, cc = (c & 7) * 8; *(u32x4*)(sA + r * LS + cc) = ra[i]; }
#pragma unroll
    for (int i = 0; i < 8; ++i) { int c = tid + i * 256, r = c >> 3, cc = (c & 7) * 8; *(u32x4*)(sB + r * LS + cc) = rb[i]; }
    if (k0 + 64 < K) {
#pragma unroll
      for (int i = 0; i < 4; ++i) {
        int c = tid + i * 256, r = c >> 3, cc = (c & 7) * 8;
        { int gr = m0 + r; gr = gr < M ? gr : M - 1; ra[i] = *(const u32x4*)(A + (size_t)gr * lda + k0 + 64 + cc); }
      }
#pragma unroll
      for (int i = 0; i < 8; ++i) {
        int c = tid + i * 256, r = c >> 3, cc = (c & 7) * 8;
        { int gn = n0 + r; gn = gn < N ? gn : N - 1; rb[i] = *(const u32x4*)(Bt + (size_t)gn * ldb + k0 + 64 + cc); }
      }
    }
    __syncthreads();
#pragma unroll 2
    for (int kk = 0; kk < 4; ++kk) {
      bf16x8 a[2], b[4];
      const int ko = kk * 16 + 8 * (lane >> 5);
#pragma unroll
      for (int i = 0; i < 2; ++i) a[i] = *(const bf16x8*)(sA + (wm + i * 32 + (lane & 31)) * LS + ko);
#pragma unroll
      for (int j = 0; j < 4; ++j) b[j] = *(const bf16x8*)(sB + (wn + j * 32 + (lane & 31)) * LS + ko);
#pragma unroll
      for (int i = 0; i < 2; ++i)
#pragma unroll
        for (int j = 0; j < 4; ++j) acc[i][j] = mfma32(a[i], b[j], acc[i][j]);
    }
  }
  {
    int tl_ = threadIdx.x; OPAQUE(tl_);
    const int lane = tl_ & 63;
    if constexpr (VEC4) {
#pragma unroll
      for (int i = 0; i < 2; ++i)
#pragma unroll
        for (int j = 0; j < 4; ++j)
#pragma unroll
          for (int gq = 0; gq < 4; ++gq) {
            int row = m0 + wm + i * 32 + 8 * gq + 4 * (lane >> 5);
            int col = n0 + wn + j * 32 + (lane & 31);
            if (row < M && col < N) epi.store4(row, col, acc[i][j][4 * gq], acc[i][j][4 * gq + 1], acc[i][j][4 * gq + 2], acc[i][j][4 * gq + 3]);
          }
    } else {
#pragma unroll
      for (int i = 0; i < 2; ++i)
#pragma unroll
        for (int j = 0; j < 4; ++j)
#pragma unroll
          for (int r = 0; r < 16; ++r) {
            int row = m0 + wm + i * 32 + acc_row(r, lane);
            int col = n0 + wn + j * 32 + (lane & 31);
            if (row < M && col < N) epi(row, col, acc[i][j][r]);
          }
    }
  }
}

DEV void transpose_tile(const float* __restrict__ src, int ld_src, bf16_t* __restrict__ dst, int ld_dst, int K, int N,
                        int tk, int tn, unsigned char* smem) {
  float* sT = (float*)smem;
  const int tid = threadIdx.x;
  __syncthreads();
  {
    const int tx = tid & 15, ty = tid >> 4;
#pragma unroll
    for (int p = 0; p < 4; ++p) {
      int k = tk * 64 + ty + p * 16, n = tn * 64 + tx * 4;
      f32x4 v4 = {0.f, 0.f, 0.f, 0.f};
      if (k < K && n < N) v4 = *(const f32x4*)(src + (size_t)k * ld_src + n);
      float* d = sT + (ty + p * 16) * 65 + tx * 4;
      d[0] = v4.x; d[1] = v4.y; d[2] = v4.z; d[3] = v4.w;
    }
  }
  __syncthreads();
  {
    const int n = tid >> 2, kseg = (tid & 3) * 16;
    int gn = tn * 64 + n;
    if (gn < N) {
      float v[16];
#pragma unroll
      for (int j = 0; j < 16; ++j) v[j] = sT[(kseg + j) * 65 + n];
      bf16_t* d = dst + (size_t)gn * ld_dst + tk * 64 + kseg;
      *(u32x4*)d = pack8(v);
      *(u32x4*)(d + 8) = pack8(v + 8);
    }
  }
}

constexpr int TJ0 = 16 * 49, TJ1 = 16 * 16, TJ2 = 16 * 44, TJ3 = 16 * 16, TJ4 = 2 * 16 * 32, TJ5 = 2 * 8, TJ6 = 2 * 8,
              TJ7 = 2 * 8, TJ8 = 32;
constexpr int NTRANS = TJ0 + TJ1 + TJ2 + TJ3 + TJ4 + TJ5 + TJ6 + TJ7 + TJ8;
constexpr int NKEYCV = (2 * 8 * 2 * 128 * 128) / (256 * 8);
constexpr int NMODV = 2 * 96;
constexpr int NPREP = NTRANS + NKEYCV + NMODV;

DEV void st_prep(const Params& P, int item, unsigned char* smem) {
  unsigned char* ws = P.ws;
  if (item < NTRANS) {
    int t = item;
    if (t < TJ0) { transpose_tile(P.in[I_EVWIN], EVC, (bf16_t*)(ws + OFF_WEVIN), 1024, 1024, EVC, t / 49, t % 49, smem); return; }
    t -= TJ0;
    if (t < TJ1) { transpose_tile(P.in[I_EVWOUT], 1024, (bf16_t*)(ws + OFF_WEVOUT), 1024, 1024, 1024, t / 16, t % 16, smem); return; }
    t -= TJ1;
    if (t < TJ2) { transpose_tile(P.in[I_ODWIN], ODC, (bf16_t*)(ws + OFF_WODIN), 1024, 1024, ODC, t / 44, t % 44, smem); return; }
    t -= TJ2;
    if (t < TJ3) { transpose_tile(P.in[I_ODWOUT], 1024, (bf16_t*)(ws + OFF_WODOUT), 1024, 1024, 1024, t / 16, t % 16, smem); return; }
    t -= TJ3;
    if (t < TJ4) {
      int l = t / 512, tt = t % 512;
      transpose_tile(P.in[I_WQ] + (size_t)l * 1024 * 2048, 2048, (bf16_t*)(ws + OFF_WQ) + (size_t)l * 2048 * 1024, 1024, 1024, 2048, tt / 32, tt % 32, smem);
      return;
    }
    t -= TJ4;
    if (t < TJ5) { int d = t / 8; transpose_tile(P.in[I_WUP] + d * 64 * 512, 512, (bf16_t*)(ws + OFF_WUP) + d * 512 * 64, 64, 64, 512, 0, t % 8, smem); return; }
    t -= TJ5;
    if (t < TJ6) { int d = t / 8; transpose_tile(P.in[I_AUP] + d * 64 * 512, 512, (bf16_t*)(ws + OFF_AUP) + d * 512 * 64, 64, 64, 512, 0, t % 8, smem); return; }
    t -= TJ6;
    if (t < TJ7) { transpose_tile(P.in[I_GUP], 512, (bf16_t*)(ws + OFF_GUP), 128, 128, 512, t / 8, t % 8, smem); return; }
    t -= TJ7;
    {
      int which = t & 1, db = t >> 1;
      const float* src = (which ? P.in[I_WI] : P.in[I_WA]) + (size_t)db * 64 * 64;
      transpose_tile(src, 64, (bf16_t*)(ws + OFF_LRUT) + (size_t)db * 128 * 64 + which * 64 * 64, 64, 64, 64, 0, 0, smem);
      return;
    }
  }
  item -= NTRANS;
  if (item < NKEYCV) {
    size_t e = ((size_t)item * 256 + threadIdx.x) * 8;
    const float* s = P.in[I_KEYS] + e;
    f32x4 a = *(const f32x4*)s, b = *(const f32x4*)(s + 4);
    float v[8] = {a.x, a.y, a.z, a.w, b.x, b.y, b.z, b.w};
    *(u32x4*)((bf16_t*)(ws + OFF_KEYS) + e) = pack8(v);
    return;
  }
  item -= NKEYCV;
  {
    const int l = item / 96, cgp = item % 96;
    float* sS = (float*)smem;
    float* sRed = sS + 3 * 1024;
    const int tid = threadIdx.x;
    __syncthreads();
    for (int i = tid; i < 3 * 1024; i += 256) {
      int m = i >> 10, k = i & 1023;
      float c = m < 2 ? P.in[I_C][m * 1024 + k] : P.in[I_CCTX][k];
      sS[i] = siluf_(c);
    }
    __syncthreads();
    const int ks = tid >> 6, col = cgp * 64 + (tid & 63);
    const float* w = P.in[I_MODW] + (size_t)l * 1024 * 6144 + col;
    float a0 = 0.f, a1 = 0.f, a2 = 0.f;
    for (int k = ks * 256; k < ks * 256 + 256; ++k) {
      float wv = w[(size_t)k * 6144];
      a0 += sS[k] * wv; a1 += sS[1024 + k] * wv; a2 += sS[2048 + k] * wv;
    }
    sRed[(ks * 3 + 0) * 64 + (tid & 63)] = a0;
    sRed[(ks * 3 + 1) * 64 + (tid & 63)] = a1;
    sRed[(ks * 3 + 2) * 64 + (tid & 63)] = a2;
    __syncthreads();
    if (tid < 192) {
      int m = tid >> 6, c = tid & 63;
      float s = sRed[(0 * 3 + m) * 64 + c] + sRed[(1 * 3 + m) * 64 + c] + sRed[(2 * 3 + m) * 64 + c] + sRed[(3 * 3 + m) * 64 + c];
      int cc = cgp * 64 + c;
      ((float*)(ws + OFF_MODV))[((size_t)l * 3 + m) * 6144 + cc] = s + P.in[I_MODB][l * 6144 + cc];
    }
  }
}

constexpr int NPCONV = 2 * (NEXP * 1024 / (256 * 16));
DEV void st_peer_conv(const Params& P, int layer, int item) {
  const int half = NPCONV / 2;
  int which = item >= half;
  int it = which ? item - half : item;
  size_t e = ((size_t)it * 256 + threadIdx.x) * 16;
  const float* s = (which ? P.in[I_PV] : P.in[I_PU]) + (size_t)layer * NEXP * 1024 + e;
  const float sc = which ? PEER_VSCALE : PEER_USCALE;
  float v16[16];
#pragma unroll
  for (int q = 0; q < 4; ++q) {
    f32x4 a = *(const f32x4*)(s + 4 * q);
    v16[4 * q] = a.x * sc; v16[4 * q + 1] = a.y * sc; v16[4 * q + 2] = a.z * sc; v16[4 * q + 3] = a.w * sc;
  }
  const size_t ex = e >> 10, col = e & 1023;
  if (which) {
    u32x2 o; o.x = pack8_fp4(v16); o.y = pack8_fp4(v16 + 8);
    *(u32x2*)(P.ws + OFF_PU + ex * PEER_ROWB + PEER_VOFF + (col >> 1)) = o;
  } else {
    u32x2 o; o.x = pack8_fp4(v16); o.y = pack8_fp4(v16 + 8);
    *(u32x2*)(P.ws + OFF_PU + ex * PEER_ROWB + (col >> 1)) = o;
  }
}

DEV void st_normmod(const Params& P, int layer, int which, int row) {
  const int lane = threadIdx.x & 63;
  const float* src;
  if (which == 0 && layer == 0) src = row < NCTX ? P.in[I_CTX] + (size_t)row * 1024 : P.in[I_X] + (size_t)(row - NCTX) * 1024;
  else src = row < NCTX ? (const float*)(P.ws + OFF_CTXRES) + (size_t)row * 1024 : P.out + (size_t)(row - NCTX) * 1024;
  const float* mv = (const float*)(P.ws + OFF_MODV) + ((size_t)layer * 3 + mod_row(row)) * 6144;
  const float* sh = mv + (which ? 3 : 0) * 1024;
  const float* sc = mv + (which ? 4 : 1) * 1024;
  const float* nw = (which ? P.in[I_NORM2] : P.in[I_NORM1]) + layer * 1024;
  f32x4 v[4];
  float ss = 0.f;
#pragma unroll
  for (int i = 0; i < 4; ++i) {
    v[i] = *(const f32x4*)(src + i * 256 + lane * 4);
    ss += v[i].x * v[i].x + v[i].y * v[i].y + v[i].z * v[i].z + v[i].w * v[i].w;
  }
  ss = wave_sum(ss);
  const float rstd = frsq(ss * (1.f / 1024.f) + 1e-6f);
  bf16_t* dst = (bf16_t*)(P.ws + OFF_HBUF) + (size_t)row * 1024;
#pragma unroll
  for (int i = 0; i < 4; ++i) {
    int c = i * 256 + lane * 4;
    f32x4 w4 = *(const f32x4*)(nw + c), s4 = *(const f32x4*)(sc + c), h4 = *(const f32x4*)(sh + c);
    float o0 = v[i].x * rstd * w4.x * (1.f + s4.x) + h4.x;
    float o1 = v[i].y * rstd * w4.y * (1.f + s4.y) + h4.y;
    float o2 = v[i].z * rstd * w4.z * (1.f + s4.z) + h4.z;
    float o3 = v[i].w * rstd * w4.w * (1.f + s4.w) + h4.w;
    u32x2 pk; pk.x = pack2(o0, o1); pk.y = pack2(o2, o3);
    *(u32x2*)(dst + c) = pk;
  }
}

struct EpiProjL0 {
  bf16_t* proj; float* gates;
  DEVM void operator()(int row, int col, float v) const {
    proj[(size_t)row * EVC + col] = f2bf(v);
    if (col >= 1536 && col < 1552) gates[row * 32 + (col - 1536)] = v;
    else if (col >= 3088) gates[row * 32 + 16 + (col - 3088)] = v;
  }
};
struct EpiStoreBf {
  bf16_t* dst; int ld;
  DEVM void operator()(int row, int col, float v) const { dst[(size_t)row * ld + col] = f2bf(v); }
};
struct EpiStoreBfBias {
  bf16_t* dst; int ld; const float* bias;
  DEVM void operator()(int row, int col, float v) const { dst[(size_t)row * ld + col] = f2bf(v + (bias ? bias[col] : 0.f)); }
};
struct EpiProjL0T {
  bf16_t* proj; float* gates;
  DEVM void operator()(int, int, float) const {}
  DEVM void store4(int n, int m, float v0, float v1, float v2, float v3) const {
    u32x2 pk; pk.x = pack2(v0, v1); pk.y = pack2(v2, v3);
    *(u32x2*)(proj + (size_t)m * EVC + n) = pk;
    if (n >= 1536 && n < 1552) { f32x4 g = {v0, v1, v2, v3}; *(f32x4*)(gates + m * 32 + (n - 1536)) = g; }
    else if (n >= 3088) { f32x4 g = {v0, v1, v2, v3}; *(f32x4*)(gates + m * 32 + 16 + (n - 3088)) = g; }
  }
};
struct EpiStoreBfT {
  bf16_t* dst; int ld;
  DEVM void operator()(int, int, float) const {}
  DEVM void store4(int n, int m, float v0, float v1, float v2, float v3) const {
    u32x2 pk; pk.x = pack2(v0, v1); pk.y = pack2(v2, v3);
    *(u32x2*)(dst + (size_t)m * ld + n) = pk;
  }
};
struct EpiOutProjT {
  const float* x_lat; const float* x_ctx; float* o_lat; float* o_ctx; const float* modv;
  DEVM void operator()(int, int, float) const {}
  DEVM void store4(int n, int m, float v0, float v1, float v2, float v3) const {
    const f32x4 g = *(const f32x4*)(modv + mod_row(m) * 6144 + 2 * 1024 + n);
    const float* xs; float* od;
    if (m < NCTX) { xs = x_ctx + (size_t)m * 1024 + n; od = o_ctx + (size_t)m * 1024 + n; }
    else { size_t o = (size_t)(m - NCTX) * 1024 + n; xs = x_lat + o; od = o_lat + o; }
    const f32x4 x = *(const f32x4*)xs;
    f32x4 r = {x.x + g.x * v0, x.y + g.y * v1, x.z + g.z * v2, x.w + g.w * v3};
    *(f32x4*)od = r;
  }
};
struct EpiStoreBfBiasT {
  bf16_t* dst; int ld; const float* bias; int mode;
  DEVM void operator()(int, int, float) const {}
  DEVM void store4(int n, int m, float v0, float v1, float v2, float v3) const {
    if (bias) { v0 += bias[n]; v1 += bias[n + 1]; v2 += bias[n + 2]; v3 += bias[n + 3]; }
    if (mode) {
      const float sc = mode == 1 ? -0.6065306597126334f : 1.f;
      v0 = sc * sigmoidf_(v0); v1 = sc * sigmoidf_(v1); v2 = sc * sigmoidf_(v2); v3 = sc * sigmoidf_(v3);
    }
    u32x2 pk; pk.x = pack2(v0, v1); pk.y = pack2(v2, v3);
    *(u32x2*)(dst + (size_t)m * ld + n) = pk;
  }
};
struct EpiOutProj {
  const float* x_lat; const float* x_ctx; float* o_lat; float* o_ctx; const float* modv;
  DEVM void operator()(int row, int col, float v) const {
    float g = modv[mod_row(row) * 6144 + 2 * 1024 + col];
    if (row < NCTX) o_ctx[(size_t)row * 1024 + col] = x_ctx[(size_t)row * 1024 + col] + g * v;
    else { size_t o = (size_t)(row - NCTX) * 1024 + col; o_lat[o] = x_lat[o] + g * v; }
  }
};
struct EpiScoreLds {
  float* sS; int m0;
  DEVM void operator()(int row, int col, float v) const { sS[(row - m0) * 129 + col] = v; }
};

DEV void st_xbc_conv(const Params& P, int row) {
  const int lane = threadIdx.x & 63;
  const bf16_t* proj = (const bf16_t*)(P.ws + OFF_PROJ);
  bf16_t* xc = (bf16_t*)P.out + (size_t)row * 1024;
  int row0, len, pos;
  if (row < NCTX) { row0 = (row / CTXL) * CTXL; len = CTXL; pos = row - row0; }
  else { int r = row - NCTX; row0 = NCTX + (r / SEQ) * SEQ; len = SEQ; pos = r % SEQ; }
  const float* cw = P.in[I_SCONVW];
  const float* cb = P.in[I_SCONVB];
#pragma unroll
  for (int hh = 0; hh < 2; ++hh) {
    const int ch = hh * 512 + lane * 8;
    float o[8];
#pragma unroll
    for (int j = 0; j < 8; ++j) o[j] = cb[ch + j];
#pragma unroll
    for (int tap = 0; tap < 4; ++tap) {
      int pp = pos + tap - 2;
      if (pp >= 0 && pp < len) {
        float x[8];
        unpack8(*(const u32x4*)(proj + (size_t)(row0 + pp) * EVC + 2064 + ch), x);
        f32x4 w0 = *(const f32x4*)(cw + tap * 1024 + ch), w1 = *(const f32x4*)(cw + tap * 1024 + ch + 4);
        o[0] += w0.x * x[0]; o[1] += w0.y * x[1]; o[2] += w0.z * x[2]; o[3] += w0.w * x[3];
        o[4] += w1.x * x[4]; o[5] += w1.y * x[5]; o[6] += w1.z * x[6]; o[7] += w1.w * x[7];
      }
    }
#pragma unroll
    for (int j = 0; j < 8; ++j) o[j] = siluf_(o[j]);
    *(u32x4*)(xc + ch) = pack8(o);
  }
}

#ifndef LA_NSEG
#define LA_NSEG 10
#endif
constexpr int LA_NCH = (CTXL + SEQ) / 64;
constexpr int LA_CPS = LA_NCH / LA_NSEG;
static_assert(LA_NCH % LA_NSEG == 0, "linattn segments");
#ifdef CPU_EMU
constexpr size_t OFF_LASEG = OFF_PR + PR_BYTES;
#else
constexpr size_t OFF_LASEG = OFF_R2L0 + (size_t)NTOK * 1024 * 2;
#endif
constexpr size_t LASEG_U = (size_t)48 * LA_NSEG * 8192 * 4;
constexpr size_t OFF_LASEG_N = OFF_LASEG + LASEG_U;
constexpr size_t OFF_LASEG_D = OFF_LASEG_N + (size_t)48 * LA_NSEG * 64 * 4;
#ifndef CPU_EMU
static_assert(OFF_LASEG_D + 48 * LA_NSEG * 4 <= OFF_PR + PR_BYTES, "laseg");
#endif

DEV int swz64(int row) { return ((row >> 3) & 7) << 3; }
DEV int swz32(int row) { return ((row >> 3) & 3) << 3; }
struct LaRaw { u32x4 q[2], k[4], x[4]; float g0, g1; };

template <bool MLSTM, bool FULL>
DEV void la_load_raw(const Params& P, int b, int h, int d, int cc, LaRaw& R) {
  constexpr int NC_CTX = CTXL / 64;
  const int tid = threadIdx.x;
  const int seg = cc >= NC_CTX;
  const int row0 = seg ? NCTX + b * SEQ : b * CTXL;
  const int len = seg ? SEQ : CTXL;
  const int cl = (seg ? cc - NC_CTX : cc) * 64;
  const bf16_t* proj = (const bf16_t*)(P.ws + OFF_PROJ);
  const bf16_t* xcv = (const bf16_t*)P.out;
  const float* gates = (const float*)(P.ws + OFF_GATES);
  if (tid < 64) {
    int p = cl + tid, grow = row0 + (d ? len - 1 - p : p);
    if (MLSTM) { R.g0 = gates[grow * 32 + d * 4 + h]; R.g1 = gates[grow * 32 + 8 + d * 4 + h]; }
    else { R.g0 = gates[grow * 32 + 16 + d * 8 + h]; R.g1 = 0.f; }
  }
  if (MLSTM) {
#pragma unroll
    for (int i = 0; i < 2; ++i) {
      int c = tid + i * 256, r = c >> 3, cc8 = (c & 7) * 8;
      int p = cl + r, pos = d ? len - 1 - p : p;
      const bf16_t* rp = proj + (size_t)(row0 + pos) * EVC;
      if (FULL) R.q[i] = *(const u32x4*)(rp + h * 64 + cc8);
      R.k[i] = *(const u32x4*)(rp + 256 + h * 64 + cc8);
    }
#pragma unroll
    for (int i = 0; i < 4; ++i) {
      int c = tid + i * 256, r = c >> 4, cc8 = (c & 15) * 8;
      int p = cl + r, pos = d ? len - 1 - p : p;
      R.x[i] = *(const u32x4*)(proj + (size_t)(row0 + pos) * EVC + 512 + h * 128 + cc8);
    }
  } else {
    const int grp = h >> 2;
#pragma unroll
    for (int i = 0; i < 2; ++i) {
      int c = tid + i * 256, r = c >> 3, cc8 = (c & 7) * 8;
      int p = cl + r, pos = d ? len - 1 - p : p;
      R.x[i] = *(const u32x4*)(xcv + (size_t)(row0 + pos) * 1024 + h * 64 + cc8);
    }
#pragma unroll
    for (int i = 0; i < 4; ++i) {
      int c = tid + i * 256, r = c >> 4, cc8 = (c & 15) * 8;
      int p = cl + r, pos = d ? len - 1 - p : p;
      const bf16_t* rp = xcv + (size_t)(row0 + pos) * 1024;
      R.k[i] = *(const u32x4*)(rp + 512 + grp * 128 + cc8);
      if (FULL) { if (i < 2) R.q[i] = *(const u32x4*)(rp + 768 + grp * 128 + cc8); else R.x[i] = *(const u32x4*)(rp + 768 + grp * 128 + cc8); }
    }
  }
}

template <bool MLSTM, bool FULL>
DEV void st_linattn_seg(const Params& P, int sid, int seg, unsigned char* smem) {
  constexpr int DK = MLSTM ? 64 : 128, DX = MLSTM ? 128 : 64;
  constexpr int QS = DK + 8;
  constexpr int NH = MLSTM ? 4 : 8;
  constexpr int NC_CTX = CTXL / 64;
  const int tid = threadIdx.x, lane = tid & 63, wave = tid >> 6;
  const int d = sid & 1, h = (sid >> 1) % NH, b = (sid >> 1) / NH;
  const int gsid = MLSTM ? sid : 16 + sid;
  bf16_t* sQ = (bf16_t*)smem;
  bf16_t* sK = sQ + 64 * QS;
  bf16_t* sP = sK;
  bf16_t* sKT = sK + 64 * QS;
  bf16_t* sXT = sKT + DK * 72;
  bf16_t* sST = sXT + DX * 72;
  float* sF = (float*)(sST + DX * QS);
  float* sLa = sF;
  float* sG = sF + 64;
  float* sBc = sF + 128;
  float* sDen = sF + 192;
  float* sN = sF + 256;
  int* sRow = (int*)(sF + 384);
  static_assert((64 * QS * 2 + DK * 72 + DX * 72 + DX * QS) * 2 + 448 * 4 <= SMEM_BYTES, "lds");
  bf16_t* outb = MLSTM ? (bf16_t*)(P.ws + OFF_HBUF) : (bf16_t*)(P.ws + OFF_R2L0);
  float* segU = (float*)(P.ws + OFF_LASEG);
  float* segN = (float*)(P.ws + OFF_LASEG_N);
  float* segD = (float*)(P.ws + OFF_LASEG_D);

  f32x16 accS[2];
#pragma unroll
  for (int j = 0; j < 2; ++j)
#pragma unroll
    for (int r = 0; r < 16; ++r) accS[j][r] = 0.f;
  const int sx0 = MLSTM ? wave * 32 : (wave >> 1) * 32;
  const int sk0 = MLSTM ? 0 : (wave & 1) * 64;
  float nreg = 0.f;
  float gb0 = 0.f, gb1 = 0.f, alog_e = 0.f, dskip = 0.f;
  if (MLSTM) { gb0 = P.in[I_IBIAS][d * 4 + h]; gb1 = P.in[I_FBIAS][d * 4 + h]; }
  else { gb0 = P.in[I_DTBIAS][d * 8 + h]; alog_e = fexp(P.in[I_ALOG][d * 8 + h]); dskip = P.in[I_DSKIP][h]; }

  const int cc0 = seg * LA_CPS, cc1 = cc0 + LA_CPS;
  LaRaw R;
  la_load_raw<MLSTM, FULL>(P, b, h, d, cc0, R);
  __syncthreads();
  if (FULL) {
    for (int js = 0; js < seg; ++js) {
      const size_t it = (size_t)gsid * LA_NSEG + js;
      const float a = fexp(segD[it]);
      const float* U = segU + it * 8192;
#pragma unroll
      for (int j = 0; j < 2; ++j)
#pragma unroll
        for (int r = 0; r < 16; ++r) accS[j][r] = a * accS[j][r] + U[(j * 16 + r) * 256 + tid];
      if (MLSTM) nreg = a * nreg + segN[it * 64 + (tid >> 2)];
    }
#pragma unroll
    for (int j = 0; j < 2; ++j)
#pragma unroll
      for (int g = 0; g < 4; ++g) {
        u32x2 pk; pk.x = pack2(accS[j][4 * g], accS[j][4 * g + 1]); pk.y = pack2(accS[j][4 * g + 2], accS[j][4 * g + 3]);
        *(u32x2*)(sST + (sx0 + (lane & 31)) * QS + sk0 + j * 32 + 8 * g + 4 * (lane >> 5)) = pk;
      }
    if (MLSTM && (tid & 3) == 0) sN[tid >> 2] = nreg;
  }
  float lsum = 0.f;

  for (int cc = cc0; cc < cc1; ++cc) {
    int tl_ = threadIdx.x; OPAQUE(tl_);
    const int tid = tl_, lane = tl_ & 63;
    const int sgi = cc >= NC_CTX;
    const int row0 = sgi ? NCTX + b * SEQ : b * CTXL;
    const int len = sgi ? SEQ : CTXL;
    const int cl = (sgi ? cc - NC_CTX : cc) * 64;
    if (tid < 64) {
      int p = cl + tid;
      sRow[tid] = row0 + (d ? len - 1 - p : p);
      float la;
      if (MLSTM) { la = -softplusf_(-(R.g1 + gb1)); sG[tid] = fexp(R.g0 + gb0); }
      else { float dt = softplusf_(R.g0 + gb0); la = -dt * alog_e; sG[tid] = dt; }
      sBc[tid] = wave_incl_scan(la);
    }
    __syncthreads();
    const float blast = sBc[63];
    lsum += blast;
    if (MLSTM) {
#pragma unroll
      for (int i = 0; i < 2; ++i) {
        int c = tid + i * 256, r = c >> 3, cc8 = (c & 7) * 8;
        float kf[8]; unpack8(R.k[i], kf);
        const float wgt = fexp(blast - sBc[r]) * sG[r];
#pragma unroll
        for (int j = 0; j < 8; ++j) sKT[(cc8 + j) * 72 + (r ^ swz64(cc8))] = f2bf(kf[j] * wgt);
        if (FULL) {
          float qf[8]; unpack8(R.q[i], qf);
#pragma unroll
          for (int j = 0; j < 8; ++j) qf[j] *= 0.125f;
          *(u32x4*)(sQ + r * QS + cc8) = pack8(qf);
          *(u32x4*)(sK + r * QS + cc8) = R.k[i];
        }
      }
#pragma unroll
      for (int i = 0; i < 4; ++i) {
        int c = tid + i * 256, r = c >> 4, cc8 = (c & 15) * 8;
        const bf16_t* xs = (const bf16_t*)&R.x[i];
#pragma unroll
        for (int j = 0; j < 8; ++j) sXT[(cc8 + j) * 72 + (r ^ swz64(cc8))] = xs[j];
      }
    } else {
#pragma unroll
      for (int i = 0; i < 2; ++i) {
        int c = tid + i * 256, r = c >> 3, cc8 = (c & 7) * 8;
        const bf16_t* xs = (const bf16_t*)&R.x[i];
#pragma unroll
        for (int j = 0; j < 8; ++j) sXT[(cc8 + j) * 72 + (r ^ swz64(cc8))] = xs[j];
      }
#pragma unroll
      for (int i = 0; i < 4; ++i) {
        int c = tid + i * 256, r = c >> 4, cc8 = (c & 15) * 8;
        float kf[8]; unpack8(R.k[i], kf);
        const float wgt = fexp(blast - sBc[r]) * sG[r];
#pragma unroll
        for (int j = 0; j < 8; ++j) sKT[(cc8 + j) * 72 + (r ^ swz64(cc8))] = f2bf(kf[j] * wgt);
        if (FULL) {
          *(u32x4*)(sK + r * QS + cc8) = R.k[i];
          *(u32x4*)(sQ + r * QS + cc8) = i < 2 ? R.q[i] : R.x[i];
        }
      }
    }
    if (cc + 1 < cc1) la_load_raw<MLSTM, FULL>(P, b, h, d, cc + 1, R);
    __syncthreads();
    if (FULL) {
      const int tr = (wave >> 1) * 32, tc = (wave & 1) * 32;
      f32x16 accP;
#pragma unroll
      for (int r = 0; r < 16; ++r) accP[r] = 0.f;
      if (!(tr == 0 && tc == 32)) {
#pragma unroll
        for (int kk = 0; kk < DK / 16; ++kk) {
          const int ko = kk * 16 + 8 * (lane >> 5);
          bf16x8 a = *(const bf16x8*)(sQ + (tr + (lane & 31)) * QS + ko);
          bf16x8 bb = *(const bf16x8*)(sK + (tc + (lane & 31)) * QS + ko);
          accP = mfma32(bb, a, accP);
        }
      }
      __syncthreads();
      {
        const int t = tr + (lane & 31);
        const float bt = sBc[t];
#pragma unroll
        for (int g = 0; g < 4; ++g) {
          const int s0 = tc + 8 * g + 4 * (lane >> 5);
          const f32x4 b4 = *(const f32x4*)(sBc + s0), g4 = *(const f32x4*)(sG + s0);
          const float v0 = accP[4 * g] * fexp(fminf(bt - b4.x, 0.f)) * g4.x, v1 = accP[4 * g + 1] * fexp(fminf(bt - b4.y, 0.f)) * g4.y;
          const float v2 = accP[4 * g + 2] * fexp(fminf(bt - b4.z, 0.f)) * g4.z, v3 = accP[4 * g + 3] * fexp(fminf(bt - b4.w, 0.f)) * g4.w;
          u32x2 pk;
          pk.x = pack2(s0 <= t ? v0 : 0.f, s0 + 1 <= t ? v1 : 0.f);
          pk.y = pack2(s0 + 2 <= t ? v2 : 0.f, s0 + 3 <= t ? v3 : 0.f);
          *(u32x2*)(sP + t * 72 + s0) = pk;
        }
        {
          const int t = tid >> 2, kq = (tid & 3) * (DK / 4);
          const float et = fexp(sBc[t]);
#pragma unroll
          for (int c8 = 0; c8 < DK / 4; c8 += 8) {
            float qf[8];
            unpack8(*(const u32x4*)(sQ + t * QS + kq + c8), qf);
#pragma unroll
            for (int j = 0; j < 8; ++j) qf[j] *= et;
            *(u32x4*)(sQ + t * QS + kq + c8) = pack8(qf);
          }
        }
      }
      __syncthreads();
      constexpr int NYT = MLSTM ? 2 : 1;
      const int yx0 = MLSTM ? wave * 32 : (wave >> 1) * 32;
      const int yt0 = MLSTM ? 0 : (wave & 1) * 32;
      f32x16 accY[NYT];
#pragma unroll
      for (int j = 0; j < NYT; ++j)
#pragma unroll
        for (int r = 0; r < 16; ++r) accY[j][r] = 0.f;
#pragma unroll
      for (int kk = 0; kk < 4; ++kk) {
        const int ko = kk * 16 + 8 * (lane >> 5);
        bf16x8 a = *(const bf16x8*)(sXT + (yx0 + (lane & 31)) * 72 + (ko ^ swz64(yx0 + (lane & 31))));
#pragma unroll
        for (int j = 0; j < NYT; ++j) {
          bf16x8 bb = *(const bf16x8*)(sP + (yt0 + j * 32 + (lane & 31)) * 72 + ko);
          accY[j] = mfma32(a, bb, accY[j]);
        }
      }
#pragma unroll
      for (int kk = 0; kk < DK / 16; ++kk) {
        const int ko = kk * 16 + 8 * (lane >> 5);
        bf16x8 a = *(const bf16x8*)(sST + (yx0 + (lane & 31)) * QS + ko);
#pragma unroll
        for (int j = 0; j < NYT; ++j) {
          bf16x8 bb = *(const bf16x8*)(sQ + (yt0 + j * 32 + (lane & 31)) * QS + ko);
          accY[j] = mfma32(a, bb, accY[j]);
        }
      }
      if (MLSTM) {
        const int t = tid >> 2, q4 = (tid & 3) * 16;
        float pf[16], qf[16];
        unpack8(*(const u32x4*)(sP + t * 72 + q4), pf); unpack8(*(const u32x4*)(sP + t * 72 + q4 + 8), pf + 8);
        unpack8(*(const u32x4*)(sQ + t * QS + q4), qf); unpack8(*(const u32x4*)(sQ + t * QS + q4 + 8), qf + 8);
        float den = 0.f;
#pragma unroll
        for (int j = 0; j < 16; ++j) den += pf[j] + sN[q4 + j] * qf[j];
        den = sum4(den);
        if ((tid & 3) == 0) sDen[t] = den;
        __syncthreads();
      }
#pragma unroll
      for (int j = 0; j < NYT; ++j) {
        const int t = yt0 + j * 32 + (lane & 31);
        const size_t obase = (size_t)sRow[t] * 1024 + d * 512 + h * DX;
        const float dinv = MLSTM ? frcp(fmaxf(fabsf(sDen[t]), 1.f)) : 1.f;
#pragma unroll
        for (int g = 0; g < 4; ++g) {
          const int x0 = yx0 + 8 * g + 4 * (lane >> 5);
          float v0 = accY[j][4 * g], v1 = accY[j][4 * g + 1], v2 = accY[j][4 * g + 2], v3 = accY[j][4 * g + 3];
          if (MLSTM) { v0 *= dinv; v1 *= dinv; v2 *= dinv; v3 *= dinv; }
          else if (d == 0) {
            const int ts = t ^ swz64(x0);
            v0 += dskip * bf2f(sXT[(x0 + 0) * 72 + ts]); v1 += dskip * bf2f(sXT[(x0 + 1) * 72 + ts]);
            v2 += dskip * bf2f(sXT[(x0 + 2) * 72 + ts]); v3 += dskip * bf2f(sXT[(x0 + 3) * 72 + ts]);
          }
          u32x2 pk; pk.x = pack2(v0, v1); pk.y = pack2(v2, v3);
          *(u32x2*)(outb + obase + x0) = pk;
        }
      }
      __syncthreads();
    }
    {
      const float eb = fexp(blast);
#pragma unroll
      for (int j = 0; j < 2; ++j)
#pragma unroll
        for (int r = 0; r < 16; ++r) accS[j][r] *= eb;
#pragma unroll
      for (int kk = 0; kk < 4; ++kk) {
        const int ko = kk * 16 + 8 * (lane >> 5);
        bf16x8 a = *(const bf16x8*)(sXT + (sx0 + (lane & 31)) * 72 + (ko ^ swz64(sx0 + (lane & 31))));
#pragma unroll
        for (int j = 0; j < 2; ++j) {
          bf16x8 bb = *(const bf16x8*)(sKT + (sk0 + j * 32 + (lane & 31)) * 72 + (ko ^ swz64(sk0 + j * 32 + (lane & 31))));
          accS[j] = mfma32(bb, a, accS[j]);
        }
      }
      if (FULL) {
#pragma unroll
        for (int j = 0; j < 2; ++j)
#pragma unroll
          for (int g = 0; g < 4; ++g) {
            u32x2 pk; pk.x = pack2(accS[j][4 * g], accS[j][4 * g + 1]); pk.y = pack2(accS[j][4 * g + 2], accS[j][4 * g + 3]);
            *(u32x2*)(sST + (sx0 + (lane & 31)) * QS + sk0 + j * 32 + 8 * g + 4 * (lane >> 5)) = pk;
          }
      }
      if (MLSTM) {
        const int k = tid >> 2, q4 = (tid & 3) * 16;
        float kf[16];
        unpack8(*(const u32x4*)(sKT + k * 72 + q4), kf); unpack8(*(const u32x4*)(sKT + k * 72 + q4 + 8), kf + 8);
        float ps = 0.f;
#pragma unroll
        for (int j = 0; j < 16; ++j) ps += kf[j];
        nreg = nreg * eb + sum4(ps);
        if (FULL && (tid & 3) == 0) sN[k] = nreg;
      }
    }
    __syncthreads();
  }
  if (!FULL) {
    const size_t it = (size_t)gsid * LA_NSEG + seg;
    float* U = segU + it * 8192;
#pragma unroll
    for (int j = 0; j < 2; ++j)
#pragma unroll
      for (int r = 0; r < 16; ++r) U[(j * 16 + r) * 256 + tid] = accS[j][r];
    if (MLSTM && (tid & 3) == 0) segN[it * 64 + (tid >> 2)] = nreg;
    if (tid == 0) segD[it] = lsum;
  }
}

DEV void st_finish_l0(const Params& P, int row) {
  const int lane = threadIdx.x & 63;
  bf16_t* hb = (bf16_t*)(P.ws + OFF_HBUF) + (size_t)row * 1024;
  const bf16_t* yb = (const bf16_t*)(P.ws + OFF_R2L0) + (size_t)row * 1024;
  const bf16_t* pr = (const bf16_t*)(P.ws + OFF_PROJ) + (size_t)row * EVC;
  const int ch = lane * 8;
  float h0[8], h1[8], o[8], f1[8];
  unpack8(*(const u32x4*)(hb + ch), h0);
  unpack8(*(const u32x4*)(hb + 512 + ch), h1);
  unpack8(*(const u32x4*)(pr + 1024 + ch), o);
  float ss = 0.f;
#pragma unroll
  for (int j = 0; j < 8; ++j) { h0[j] += h1[j]; ss += h0[j] * h0[j]; }
  ss = sum16(ss);
  float rstd = frsq(ss * (1.f / 128.f) + 1e-6f);
  float pw[8]; ld8(P.in[I_MNORM] + ch, pw);
#pragma unroll
  for (int j = 0; j < 8; ++j) f1[j] = h0[j] * rstd * pw[j] * sigmoidf_(o[j]);
  float y0[8], y1[8], z[8], f2[8];
  unpack8(*(const u32x4*)(yb + ch), y0);
  unpack8(*(const u32x4*)(yb + 512 + ch), y1);
  unpack8(*(const u32x4*)(pr + 1552 + ch), z);
  float s2 = 0.f;
#pragma unroll
  for (int j = 0; j < 8; ++j) { y0[j] = (y0[j] + y1[j]) * siluf_(z[j]); s2 += y0[j] * y0[j]; }
  s2 = wave_sum(s2);
  float rstd2 = frsq(s2 * (1.f / 512.f) + 1e-6f);
  ld8(P.in[I_SNORM] + ch, pw);
#pragma unroll
  for (int j = 0; j < 8; ++j) f2[j] = y0[j] * rstd2 * pw[j];
  *(u32x4*)(hb + ch) = pack8(f1);
  *(u32x4*)(hb + 512 + ch) = pack8(f2);
}

DEV float mixval(const bf16_t* __restrict__ proj, int row, int c, const float* __restrict__ mu) {
  float self = bf2f(proj[(size_t)row * ODC + c]);
  int nrow = -1;
  if (row < NCTX) {
    int pos = row % CTXL;
    if (c < 896) { if (pos > 0) nrow = row - 1; }
    else { if (pos < CTXL - 1) nrow = row + 1; }
  } else {
    int pos = (row - NCTX) % SEQ;
    int gx = pos % GW, gy = pos / GW, q = c / 448;
    if (q == 0) { if (gx > 0) nrow = row - 1; }
    else if (q == 1) { if (gx < GW - 1) nrow = row + 1; }
    else if (q == 2) { if (gy > 0) nrow = row - GW; }
    else { if (gy < SEQ / GW - 1) nrow = row + GW; }
  }
  float nb = nrow >= 0 ? bf2f(proj[(size_t)nrow * ODC + c]) : 0.f;
  return self + mu[c] * (nb - self);
}

DEV int nbr_row(int row, int c) {
  if (row < NCTX) {
    int pos = row % CTXL;
    if (c < 896) return pos > 0 ? row - 1 : -1;
    return pos < CTXL - 1 ? row + 1 : -1;
  }
  int pos = (row - NCTX) % SEQ;
  int gx = pos % GW, gy = pos / GW, q = c / 448;
  if (q == 0) return gx > 0 ? row - 1 : -1;
  if (q == 1) return gx < GW - 1 ? row + 1 : -1;
  if (q == 2) return gy > 0 ? row - GW : -1;
  return gy < SEQ / GW - 1 ? row + GW : -1;
}

DEV void mix8(const bf16_t* __restrict__ proj, int row, int c, const float* __restrict__ mu, float* o) {
  float xs[8], xn[8];
  unpack8(*(const u32x4*)(proj + (size_t)row * ODC + c), xs);
  const int nr = nbr_row(row, c);
  if (nr >= 0) unpack8(*(const u32x4*)(proj + (size_t)nr * ODC + c), xn);
  else {
#pragma unroll
    for (int j = 0; j < 8; ++j) xn[j] = 0.f;
  }
  const f32x4 m0 = *(const f32x4*)(mu + c), m1 = *(const f32x4*)(mu + c + 4);
  const float mm[8] = {m0.x, m0.y, m0.z, m0.w, m1.x, m1.y, m1.z, m1.w};
#pragma unroll
  for (int j = 0; j < 8; ++j) o[j] = xs[j] + mm[j] * (xn[j] - xs[j]);
}

DEV void st_lora_act(const Params& P, int row2) {
  const int lane = threadIdx.x & 63;
  const int row = row2 + (lane >> 5), c = (lane & 31) * 8;
  const bf16_t* proj = (const bf16_t*)(P.ws + OFF_PROJ);
  bf16_t* hb = (bf16_t*)(P.ws + OFF_HBUF) + (size_t)row * 1024;
  float v[8];
  mix8(proj, row, 1536 + c, P.in[I_MU], v);
#pragma unroll
  for (int j = 0; j < 8; ++j) v[j] = c < 64 ? tanhf_(v[j]) : (c < 128 ? v[j] : sigmoidf_(v[j]));
  *(u32x4*)(hb + c) = pack8(v);
}

DEV void st_rwkv_stream(const Params& P, int sid, unsigned char* smem) {
  const int tid = threadIdx.x, lane = tid & 63, wave = tid >> 6;
  const int d = sid & 1, h = (sid >> 1) & 7, b = sid >> 4;
  float* sR = (float*)smem;
  float* sW = sR + 2048;
  float* sKk = sW + 2048;
  float* sV = sKk + 2048;
  float* sA = sV + 2048;
  float* sBb = sA + 2048;
  float* sY = sBb + 2048;
  int* sRow = (int*)(sY + 2048);
  const bf16_t* proj = (const bf16_t*)(P.ws + OFF_PROJ);
  const bf16_t* lora = (const bf16_t*)(P.ws + OFF_LORA);
  bf16_t* yout = (bf16_t*)(P.ws + OFF_HBUF);
  const float* mu = P.in[I_MU];
  const int vrow = tid >> 2, j4 = tid & 3;
  float S[16];
#pragma unroll
  for (int i = 0; i < 16; ++i) S[i] = 0.f;
  const float kkw = P.in[I_KK][h * 64 + lane], kaw = P.in[I_KA][h * 64 + lane];
  for (int seg = 0; seg < 2; ++seg) {
    const int row0 = seg == 0 ? b * CTXL : NCTX + b * SEQ;
    const int len = seg == 0 ? CTXL : SEQ;
    for (int it = 0; it < len / 32; ++it) {
      __syncthreads();
      for (int s = wave; s < 32; s += 4) {
        int p = it * 32 + s, pos = d ? len - 1 - p : p, row = row0 + pos;
        int c = h * 64 + lane;
        float r = mixval(proj, row, c, mu);
        float k = mixval(proj, row, 512 + c, mu);
        float v = mixval(proj, row, 1024 + c, mu);
        float kk = k * kkw;
        float ss = wave_sum(kk * kk);
        kk *= frsq(ss + 1e-12f);
        float lw = bf2f(lora[((size_t)d * NTOK + row) * 512 + c]);
        float la = bf2f(lora[((size_t)(2 + d) * NTOK + row) * 512 + c]);
        float w = fexp(-0.6065306597126334f * sigmoidf_(lw));
        float a = sigmoidf_(la);
        float kt = k * (1.f + (a - 1.f) * kaw);
        sR[s * 64 + lane] = r; sW[s * 64 + lane] = w; sKk[s * 64 + lane] = kt; sV[s * 64 + lane] = v;
        sA[s * 64 + lane] = -kk; sBb[s * 64 + lane] = kk * a;
        if (lane == 0) sRow[s] = row;
      }
      __syncthreads();
      for (int s = 0; s < 32; ++s) {
        const float* pa = sA + s * 64 + j4 * 16;
        const float* pw = sW + s * 64 + j4 * 16;
        const float* pk = sKk + s * 64 + j4 * 16;
        const float* pb = sBb + s * 64 + j4 * 16;
        const float* pr = sR + s * 64 + j4 * 16;
        const float vv = sV[s * 64 + vrow];
        float sa = 0.f;
#pragma unroll
        for (int i = 0; i < 16; ++i) sa += S[i] * pa[i];
        sa = sum4(sa);
        float y = 0.f;
#pragma unroll
        for (int i = 0; i < 16; ++i) { S[i] = S[i] * pw[i] + sa * pb[i] + vv * pk[i]; y += S[i] * pr[i]; }
        y = sum4(y);
        if (j4 == 0) sY[s * 64 + vrow] = y;
      }
      __syncthreads();
      for (int i = tid; i < 2048; i += 256) {
        int s = i >> 6, c = i & 63;
        yout[(size_t)sRow[s] * 1024 + d * 512 + h * 64 + c] = f2bf(sY[i]);
      }
    }
  }
}


struct RwkvRaw { u32x4 rs, rn, ks, kn, vs, vn, lw, la; int row; };

DEV void rwkv_load_raw(const bf16_t* __restrict__ proj, const bf16_t* __restrict__ lora, int b, int h, int d, int cc, int t, int c0,
                       RwkvRaw& R) {
  constexpr int NC_CTX = CTXL / 32;
  const int seg = cc >= NC_CTX;
  const int row0 = seg ? NCTX + b * SEQ : b * CTXL;
  const int len = seg ? SEQ : CTXL;
  const int p = (seg ? cc - NC_CTX : cc) * 32 + t;
  const int row = row0 + (d ? len - 1 - p : p);
  const int col = h * 64 + c0;
  const u32x4 z4 = {0u, 0u, 0u, 0u};
  const bf16_t* rp = proj + (size_t)row * ODC;
  R.row = row;
  R.rs = *(const u32x4*)(rp + col);
  R.ks = *(const u32x4*)(rp + 512 + col);
  R.vs = *(const u32x4*)(rp + 1024 + col);
  int n0 = nbr_row(row, col), n1 = nbr_row(row, 512 + col), n2 = nbr_row(row, 1024 + col);
  R.rn = n0 >= 0 ? *(const u32x4*)(proj + (size_t)n0 * ODC + col) : z4;
  R.kn = n1 >= 0 ? *(const u32x4*)(proj + (size_t)n1 * ODC + 512 + col) : z4;
  R.vn = n2 >= 0 ? *(const u32x4*)(proj + (size_t)n2 * ODC + 1024 + col) : z4;
  R.lw = *(const u32x4*)(lora + ((size_t)d * NTOK + row) * 512 + col);
  R.la = *(const u32x4*)(lora + ((size_t)(2 + d) * NTOK + row) * 512 + col);
}

#ifndef RW_NSEG
#define RW_NSEG 16
#endif
constexpr int RW_NCH = (CTXL + SEQ) / 32;
constexpr size_t OFF_RWSEG = OFF_PU;
static_assert((size_t)32 * RW_NSEG * 64 * 128 * 4 <= (size_t)2 * NEXP * 1024, "rwseg");

template <bool FULL>
DEV void st_rwkv_seg(const Params& P, int sid, int seg, unsigned char* smem) {
  constexpr int NVB = FULL ? 2 : 4;
  constexpr int ZR = FULL ? 64 : 128;
  const int tid = threadIdx.x, lane = tid & 63, wave = tid >> 6;
  const int d = sid & 1, h = (sid >> 1) & 7, b = sid >> 4;
  bf16_t* sAt = (bf16_t*)smem;
  bf16_t* sRt = sAt + 32 * 72;
  bf16_t* sBt = sRt + 32 * 72;
  bf16_t* sKt = sBt + 32 * 72;
  bf16_t* sBT = sKt + 32 * 72;
  bf16_t* sKT = sBT + 64 * 40;
  bf16_t* sVT = sKT + 64 * 40;
  bf16_t* sLak = sVT + 64 * 40;
  bf16_t* sM = sLak + 32 * 40;
  bf16_t* sLrb = sM + 32 * 40;
  bf16_t* sLrk = sLrb + 32 * 40;
  bf16_t* sZ = FULL ? sLrk + 32 * 40 : sLrb;
  bf16_t* after = sZ + ZR * 72;
  bf16_t* sRT = after;
  bf16_t* sSAT = FULL ? after + 64 * 40 : sRt;
  float* sLP = (float*)(FULL ? after + 2 * 64 * 40 : after + 128 * 40);
  float* sLab = sLP + 4 * 64;
  float* sD = sLab + 32 * 36;
  float* sPT = sD + 768;
  int* sRow = (int*)(sPT + 64);
  static_assert((4 * 32 * 72 + 3 * 64 * 40 + 4 * 32 * 40 + 2 * 64 * 40 + 64 * 72) * 2 + (4 * 64 + 32 * 36 + 768 + 64 + 32 + 320) * 4 + 16 <= SMEM_BYTES, "lds full");
  static_assert((4 * 32 * 72 + 3 * 64 * 40 + 2 * 32 * 40 + 128 * 72 + 128 * 40) * 2 + (4 * 64 + 32 * 36 + 768 + 64 + 32 + 320) * 4 + 16 <= SMEM_BYTES, "lds p1");
  static_assert(128 * 40 <= 3 * 32 * 72, "alias");
  const bf16_t* proj = (const bf16_t*)(P.ws + OFF_PROJ);
  const bf16_t* lora = (const bf16_t*)(P.ws + OFF_LORA);
  bf16_t* yout = (bf16_t*)(P.ws + OFF_HBUF);
  float* segZ = (float*)(P.ws + OFF_RWSEG);
  const int t = tid >> 3, c0 = (tid & 7) * 8;
  const int hl = lane >> 5, l31 = lane & 31;
  float* sCst = (float*)(smem + SMEM_BYTES - 320 * 4 - 16);
  if (tid < 64) {
    sCst[tid] = P.in[I_MU][h * 64 + tid]; sCst[64 + tid] = P.in[I_MU][512 + h * 64 + tid]; sCst[128 + tid] = P.in[I_MU][1024 + h * 64 + tid];
    sCst[192 + tid] = P.in[I_KK][h * 64 + tid]; sCst[256 + tid] = P.in[I_KA][h * 64 + tid];
  }
  const int cc0 = (seg * RW_NCH) / RW_NSEG, cc1 = ((seg + 1) * RW_NCH) / RW_NSEG;
  RwkvRaw R;
  rwkv_load_raw(proj, lora, b, h, d, cc0, t, c0, R);
  f32x16 Zm[2];
#pragma unroll
  for (int j = 0; j < 2; ++j)
#pragma unroll
    for (int r = 0; r < 16; ++r) Zm[j][r] = 0.f;
  __syncthreads();
  for (int i = tid; i < ZR * 72; i += 256) sZ[i] = 0;
  __syncthreads();
  if (!FULL) {
    if (wave >= 2) {
#pragma unroll
      for (int cb = 0; cb < 2; ++cb)
#pragma unroll
        for (int r = 0; r < 16; ++r) {
          int c = cb * 32 + acc_row(r, lane), vp = wave * 32 + l31;
          if (c == vp - 64) { Zm[cb][r] = 1.f; sZ[vp * 72 + c] = 0x3f80; }
        }
    }
  } else {
    for (int js = 0; js < seg; ++js) {
      const float* Zs = segZ + ((size_t)sid * RW_NSEG + js) * 64 * 128;
      bf16_t* sG = sAt;
      {
        const int c = tid >> 2, c2 = (tid & 3) * 16;
        float gv[16];
        ld8(Zs + c * 128 + 64 + c2, gv); ld8(Zs + c * 128 + 64 + c2 + 8, gv + 8);
        *(u32x4*)(sG + c * 72 + c2) = pack8(gv);
        *(u32x4*)(sG + c * 72 + c2 + 8) = pack8(gv + 8);
      }
      __syncthreads();
      if (wave >= 2) {
        const int cb = wave - 2;
#pragma unroll
        for (int vb = 0; vb < 2; ++vb) {
          f32x16 acc;
#pragma unroll
          for (int r = 0; r < 16; ++r) acc[r] = Zs[(cb * 32 + acc_row(r, lane)) * 128 + vb * 32 + l31];
#pragma unroll
          for (int kk = 0; kk < 4; ++kk) {
            bf16x8 a = *(const bf16x8*)(sG + (cb * 32 + l31) * 72 + kk * 16 + 8 * hl);
            bf16x8 bb = *(const bf16x8*)(sZ + (vb * 32 + l31) * 72 + kk * 16 + 8 * hl);
            acc = mfma32(a, bb, acc);
          }
          Zm[vb] = acc;
        }
      }
      __syncthreads();
      if (wave >= 2) {
        const int cb = wave - 2;
#pragma unroll
        for (int vb = 0; vb < 2; ++vb)
#pragma unroll
          for (int g = 0; g < 4; ++g) {
            u32x2 pk; pk.x = pack2(Zm[vb][4 * g], Zm[vb][4 * g + 1]); pk.y = pack2(Zm[vb][4 * g + 2], Zm[vb][4 * g + 3]);
            *(u32x2*)(sZ + (vb * 32 + l31) * 72 + cb * 32 + 8 * g + 4 * hl) = pk;
          }
      }
      __syncthreads();
    }
  }
  for (int cc = cc0; cc < cc1; ++cc) {
    int tl_ = threadIdx.x; OPAQUE(tl_);
    const int tid = tl_, lane = tl_ & 63, hl = lane >> 5, l31 = lane & 31, t = tl_ >> 3, c0 = (tl_ & 7) * 8;
    const float* muR = sCst + c0; const float* muK = sCst + 64 + c0; const float* muV = sCst + 128 + c0;
    const float* kkw = sCst + 192 + c0; const float* kaw = sCst + 256 + c0;
    float lw8[8], lp8[8];
    {
      float lwf[8];
      unpack8(R.lw, lwf);
#pragma unroll
      for (int j = 0; j < 8; ++j) { lw8[j] = lwf[j]; lp8[j] = lw8[j]; }
#pragma unroll
      for (int off = 8; off < 64; off <<= 1) {
#pragma unroll
        for (int j = 0; j < 8; ++j) {
#ifdef CPU_EMU
          float o = emu_shfl_up(lp8[j], off);
#else
          float o = __shfl_up(lp8[j], off, 64);
#endif
          if (lane >= off) lp8[j] += o;
        }
      }
      if (lane >= 56) {
#pragma unroll
        for (int j = 0; j < 8; ++j) sLP[wave * 64 + c0 + j] = lp8[j];
      }
      if ((tid & 7) == 0) sRow[t] = R.row;
    }
    __syncthreads();
    {
#pragma unroll
      for (int j = 0; j < 8; ++j) {
        float offs = 0.f;
        for (int w2 = 0; w2 < wave; ++w2) offs += sLP[w2 * 64 + c0 + j];
        lp8[j] += offs;
      }
      if (t == 31) {
#pragma unroll
        for (int j = 0; j < 8; ++j) sPT[c0 + j] = fexp(lp8[j]);
      }
    }
    {
      float xs[8], xn[8], kt[8], aa[8], ob[8], ok[8];
      unpack8(R.ks, xs); unpack8(R.kn, xn);
      float ss = 0.f;
#pragma unroll
      for (int j = 0; j < 8; ++j) { kt[j] = xs[j] + muK[j] * (xn[j] - xs[j]); aa[j] = kt[j] * kkw[j]; ss += aa[j] * aa[j]; }
      ss = sum8(ss);
      const float rn = frsq(ss + 1e-12f);
      float laf[8];
      unpack8(R.la, laf);
#pragma unroll
      for (int j = 0; j < 8; ++j) {
        const float lp = lp8[j];
        const float lpm = lp8[j] - lw8[j];
        const float e = fexp(-lp);
        const float kkn = aa[j] * rn;
        const float asg = laf[j];
        aa[j] = -kkn * fexp(lpm);
        ob[j] = kkn * asg * e;
        ok[j] = kt[j] * (1.f + (asg - 1.f) * kaw[j]) * e;
      }
      *(u32x4*)(sAt + t * 72 + c0) = pack8(aa);
      *(u32x4*)(sBt + t * 72 + c0) = pack8(ob);
      *(u32x4*)(sKt + t * 72 + c0) = pack8(ok);
#pragma unroll
      for (int j = 0; j < 8; ++j) { sBT[(c0 + j) * 40 + (t ^ swz32(c0))] = f2bf(ob[j]); sKT[(c0 + j) * 40 + (t ^ swz32(c0))] = f2bf(ok[j]); }
      unpack8(R.vs, xs); unpack8(R.vn, xn);
#pragma unroll
      for (int j = 0; j < 8; ++j) sVT[(c0 + j) * 40 + (t ^ swz32(c0))] = f2bf(xs[j] + muV[j] * (xn[j] - xs[j]));
      if (FULL) {
        unpack8(R.rs, xs); unpack8(R.rn, xn);
#pragma unroll
        for (int j = 0; j < 8; ++j) xs[j] = (xs[j] + muR[j] * (xn[j] - xs[j])) * fexp(lp8[j]);
        *(u32x4*)(sRt + t * 72 + c0) = pack8(xs);
      }
    }
    if (cc + 1 < cc1) rwkv_load_raw(proj, lora, b, h, d, cc + 1, t, c0, R);
    __syncthreads();
    if (FULL || wave < 2) {
      const bf16_t* Asrc = wave < 2 ? sAt : sRt;
      const bf16_t* Bsrc = (wave & 1) ? sKt : sBt;
      f32x16 acc;
#pragma unroll
      for (int r = 0; r < 16; ++r) acc[r] = 0.f;
#pragma unroll
      for (int kk = 0; kk < 4; ++kk) {
        bf16x8 a = *(const bf16x8*)(Asrc + l31 * 72 + kk * 16 + 8 * hl);
        bf16x8 bb = *(const bf16x8*)(Bsrc + l31 * 72 + kk * 16 + 8 * hl);
        acc = mfma32(bb, a, acc);
      }
      bf16_t* dst = wave == 1 ? sLak : (wave == 2 ? sLrb : sLrk);
      {
        const int tt = l31;
        const int lim = wave < 2 ? tt : tt + 1;
#pragma unroll
        for (int g = 0; g < 4; ++g) {
          const int j0 = 8 * g + 4 * hl;
          const float v0 = j0 < lim ? acc[4 * g] : 0.f, v1 = j0 + 1 < lim ? acc[4 * g + 1] : 0.f;
          const float v2 = j0 + 2 < lim ? acc[4 * g + 2] : 0.f, v3 = j0 + 3 < lim ? acc[4 * g + 3] : 0.f;
          if (wave == 0) { f32x4 o = {v0, v1, v2, v3}; *(f32x4*)(sLab + tt * 36 + j0) = o; }
          else { u32x2 pk; pk.x = pack2(v0, v1); pk.y = pack2(v2, v3); *(u32x2*)(dst + tt * 40 + j0) = pk; }
        }
      }
    }
    __syncthreads();
    auto rhs_block = [&](int vb) {
      f32x16 acc;
#pragma unroll
      for (int r = 0; r < 16; ++r) acc[r] = 0.f;
#pragma unroll
      for (int kk = 0; kk < 4; ++kk) {
        bf16x8 a = *(const bf16x8*)(sAt + l31 * 72 + kk * 16 + 8 * hl);
        bf16x8 bb = *(const bf16x8*)(sZ + (vb * 32 + l31) * 72 + kk * 16 + 8 * hl);
        acc = mfma32(a, bb, acc);
      }
      if (vb < 2) {
#pragma unroll
        for (int kk = 0; kk < 2; ++kk) {
          bf16x8 a = *(const bf16x8*)(sLak + l31 * 40 + kk * 16 + 8 * hl);
          bf16x8 bb = *(const bf16x8*)(sVT + (vb * 32 + l31) * 40 + ((kk * 16 + 8 * hl) ^ swz32(l31)));
          acc = mfma32(a, bb, acc);
        }
      }
#pragma unroll
      for (int g = 0; g < 4; ++g) {
        u32x2 pk; pk.x = pack2(acc[4 * g], acc[4 * g + 1]); pk.y = pack2(acc[4 * g + 2], acc[4 * g + 3]);
        *(u32x2*)(sRT + (vb * 32 + l31) * 40 + 8 * g + 4 * hl) = pk;
      }
    };
    if (wave == 0) {
      if (tid < 32) {
        const int q = tid >> 4, c = tid & 15;
        const float* Lq = sLab + (q * 16) * 36 + q * 16;
        float x[16];
        x[0] = (c == 0) ? 1.f : 0.f;
#define INV_GROUP_(I0, I1)                                                                           \
        {                                                                                            \
          f32x4 Lr[12];                                                                              \
          { int n = 0;                                                                               \
            _Pragma("unroll") for (int i = I0; i <= I1; ++i)                                         \
              _Pragma("unroll") for (int j4 = 0; j4 < i; j4 += 4) Lr[n++] = *(const f32x4*)(Lq + i * 36 + j4); }  \
          SCHED_FENCE_();                                                                            \
          { int n = 0;                                                                               \
            _Pragma("unroll") for (int i = I0; i <= I1; ++i) {                                       \
              float s0 = (i == c) ? 1.f : 0.f, s1 = 0.f;                                             \
              _Pragma("unroll") for (int j4 = 0; j4 < i; j4 += 4) {                                  \
                const f32x4 l4 = Lr[n++];                                                            \
                s0 += l4.x * x[j4];                                                                  \
                if (j4 + 1 < i) s1 += l4.y * x[j4 + 1];                                              \
                if (j4 + 2 < i) s0 += l4.z * x[j4 + 2];                                              \
                if (j4 + 3 < i) s1 += l4.w * x[j4 + 3];                                              \
              }                                                                                      \
              x[i] = s0 + s1;                                                                        \
            } }                                                                                      \
          SCHED_FENCE_();                                                                            \
        }
#ifdef CPU_EMU
#define SCHED_FENCE_() ((void)0)
#else
#define SCHED_FENCE_() __builtin_amdgcn_sched_barrier(0)
#endif
        INV_GROUP_(1, 8)
        INV_GROUP_(9, 12)
        INV_GROUP_(13, 15)
#undef INV_GROUP_
#undef SCHED_FENCE_
#pragma unroll
        for (int i = 0; i < 16; ++i) sD[q * 256 + i * 16 + c] = x[i];
      }
    } else if (FULL) {
      if (wave >= 2) rhs_block(wave - 2);
    } else {
      if (wave == 1) { rhs_block(0); rhs_block(1); }
      else rhs_block(wave);
    }
    __syncthreads();
    {
      const int i = tid >> 4, c = tid & 15;
      float sacc = 0.f;
#pragma unroll
      for (int j4 = 0; j4 < 16; j4 += 4) {
        const f32x4 l4 = *(const f32x4*)(sLab + (16 + i) * 36 + j4);
        sacc += l4.x * sD[j4 * 16 + c] + l4.y * sD[(j4 + 1) * 16 + c] + l4.z * sD[(j4 + 2) * 16 + c] + l4.w * sD[(j4 + 3) * 16 + c];
      }
      sD[512 + i * 16 + c] = sacc;
    }
    __syncthreads();
    {
      const int i = tid >> 4, c = tid & 15;
      float sacc = 0.f;
#pragma unroll
      for (int j4 = 0; j4 < 16; j4 += 4) {
        const f32x4 d4 = *(const f32x4*)(sD + 256 + i * 16 + j4);
        sacc += d4.x * sD[512 + j4 * 16 + c] + d4.y * sD[512 + (j4 + 1) * 16 + c] + d4.z * sD[512 + (j4 + 2) * 16 + c] + d4.w * sD[512 + (j4 + 3) * 16 + c];
      }
      sM[(16 + i) * 40 + c] = f2bf(sacc);
      sM[i * 40 + c] = f2bf(sD[i * 16 + c]);
      sM[(16 + i) * 40 + 16 + c] = f2bf(sD[256 + i * 16 + c]);
      sM[i * 40 + 16 + c] = 0;
    }
    __syncthreads();
    if (wave < NVB) {
      const int vb = wave;
      f32x16 acc;
#pragma unroll
      for (int r = 0; r < 16; ++r) acc[r] = 0.f;
#pragma unroll
      for (int kk = 0; kk < 2; ++kk) {
        bf16x8 a = *(const bf16x8*)(sM + l31 * 40 + kk * 16 + 8 * hl);
        bf16x8 bb = *(const bf16x8*)(sRT + (vb * 32 + l31) * 40 + kk * 16 + 8 * hl);
        acc = mfma32(a, bb, acc);
      }
#pragma unroll
      for (int g = 0; g < 4; ++g) {
        u32x2 pk; pk.x = pack2(acc[4 * g], acc[4 * g + 1]); pk.y = pack2(acc[4 * g + 2], acc[4 * g + 3]);
        *(u32x2*)(sSAT + (vb * 32 + l31) * 40 + 8 * g + 4 * hl) = pk;
      }
    }
    __syncthreads();
    if (FULL) {
      if (wave < 2) {
        const int vb = wave;
        f32x16 acc;
#pragma unroll
        for (int r = 0; r < 16; ++r) acc[r] = 0.f;
#pragma unroll
        for (int kk = 0; kk < 4; ++kk) {
          bf16x8 a = *(const bf16x8*)(sZ + (vb * 32 + l31) * 72 + kk * 16 + 8 * hl);
          bf16x8 bb = *(const bf16x8*)(sRt + l31 * 72 + kk * 16 + 8 * hl);
          acc = mfma32(a, bb, acc);
        }
#pragma unroll
        for (int kk = 0; kk < 2; ++kk) {
          bf16x8 a = *(const bf16x8*)(sSAT + (vb * 32 + l31) * 40 + kk * 16 + 8 * hl);
          bf16x8 bb = *(const bf16x8*)(sLrb + l31 * 40 + kk * 16 + 8 * hl);
          acc = mfma32(a, bb, acc);
        }
#pragma unroll
        for (int kk = 0; kk < 2; ++kk) {
          bf16x8 a = *(const bf16x8*)(sVT + (vb * 32 + l31) * 40 + ((kk * 16 + 8 * hl) ^ swz32(l31)));
          bf16x8 bb = *(const bf16x8*)(sLrk + l31 * 40 + kk * 16 + 8 * hl);
          acc = mfma32(a, bb, acc);
        }
        {
          const size_t obase = (size_t)sRow[l31] * 1024 + d * 512 + h * 64 + vb * 32;
#pragma unroll
          for (int g = 0; g < 4; ++g) {
            u32x2 pk; pk.x = pack2(acc[4 * g], acc[4 * g + 1]); pk.y = pack2(acc[4 * g + 2], acc[4 * g + 3]);
            *(u32x2*)(yout + obase + 8 * g + 4 * hl) = pk;
          }
        }
      } else {
        const int cb = wave - 2;
#pragma unroll
        for (int vb = 0; vb < 2; ++vb) {
          f32x16 acc;
#pragma unroll
          for (int r = 0; r < 16; ++r) acc[r] = 0.f;
#pragma unroll
          for (int kk = 0; kk < 2; ++kk) {
            bf16x8 a = *(const bf16x8*)(sBT + (cb * 32 + l31) * 40 + ((kk * 16 + 8 * hl) ^ swz32(l31)));
            bf16x8 bb = *(const bf16x8*)(sSAT + (vb * 32 + l31) * 40 + kk * 16 + 8 * hl);
            acc = mfma32(a, bb, acc);
          }
#pragma unroll
          for (int kk = 0; kk < 2; ++kk) {
            bf16x8 a = *(const bf16x8*)(sKT + (cb * 32 + l31) * 40 + ((kk * 16 + 8 * hl) ^ swz32(l31)));
            bf16x8 bb = *(const bf16x8*)(sVT + (vb * 32 + l31) * 40 + ((kk * 16 + 8 * hl) ^ swz32(l31)));
            acc = mfma32(a, bb, acc);
          }
#pragma unroll
          for (int r = 0; r < 16; ++r) Zm[vb][r] = sPT[cb * 32 + acc_row(r, lane)] * (Zm[vb][r] + acc[r]);
        }
      }
      __syncthreads();
      if (wave >= 2) {
        const int cb = wave - 2;
#pragma unroll
        for (int vb = 0; vb < 2; ++vb)
#pragma unroll
          for (int g = 0; g < 4; ++g) {
            u32x2 pk; pk.x = pack2(Zm[vb][4 * g], Zm[vb][4 * g + 1]); pk.y = pack2(Zm[vb][4 * g + 2], Zm[vb][4 * g + 3]);
            *(u32x2*)(sZ + (vb * 32 + l31) * 72 + cb * 32 + 8 * g + 4 * hl) = pk;
          }
      }
    } else {
      const int vb = wave;
#pragma unroll
      for (int cb = 0; cb < 2; ++cb) {
        f32x16 acc;
#pragma unroll
        for (int r = 0; r < 16; ++r) acc[r] = 0.f;
#pragma unroll
        for (int kk = 0; kk < 2; ++kk) {
          bf16x8 a = *(const bf16x8*)(sBT + (cb * 32 + l31) * 40 + ((kk * 16 + 8 * hl) ^ swz32(l31)));
          bf16x8 bb = *(const bf16x8*)(sSAT + (vb * 32 + l31) * 40 + kk * 16 + 8 * hl);
          acc = mfma32(a, bb, acc);
        }
        if (vb < 2) {
#pragma unroll
          for (int kk = 0; kk < 2; ++kk) {
            bf16x8 a = *(const bf16x8*)(sKT + (cb * 32 + l31) * 40 + ((kk * 16 + 8 * hl) ^ swz32(l31)));
            bf16x8 bb = *(const bf16x8*)(sVT + (vb * 32 + l31) * 40 + ((kk * 16 + 8 * hl) ^ swz32(l31)));
            acc = mfma32(a, bb, acc);
          }
        }
#pragma unroll
        for (int r = 0; r < 16; ++r) Zm[cb][r] = sPT[cb * 32 + acc_row(r, lane)] * (Zm[cb][r] + acc[r]);
      }
#pragma unroll
      for (int cb = 0; cb < 2; ++cb)
#pragma unroll
        for (int g = 0; g < 4; ++g) {
          u32x2 pk; pk.x = pack2(Zm[cb][4 * g], Zm[cb][4 * g + 1]); pk.y = pack2(Zm[cb][4 * g + 2], Zm[cb][4 * g + 3]);
          *(u32x2*)(sZ + (vb * 32 + l31) * 72 + cb * 32 + 8 * g + 4 * hl) = pk;
        }
    }
  }
  if (!FULL) {
    float* Zs = segZ + ((size_t)sid * RW_NSEG + seg) * 64 * 128;
#pragma unroll
    for (int cb = 0; cb < 2; ++cb)
#pragma unroll
      for (int r = 0; r < 16; ++r) Zs[(cb * 32 + acc_row(r, lane)) * 128 + wave * 32 + l31] = Zm[cb][r];
  }
}

constexpr int LRU_NCH = (CTXL + SEQ) / 64;
constexpr size_t OFF_ACUM0 = OFF_PU;
static_assert((size_t)NLAT * 512 * 2 <= (size_t)2 * NEXP * 1024, "acum0");

struct LruRaw { u32x4 x[2][4]; };
DEV void lru_load_raw(const Params& P, int sid, int cc, LruRaw& R) {
  constexpr int NC_CTX = CTXL / 64;
  const int tid = threadIdx.x;
  const int d = sid & 1, blk = (sid >> 1) & 7, b = sid >> 4;
  const bf16_t* proj = (const bf16_t*)(P.ws + OFF_PROJ);
  const int sgi = cc >= NC_CTX;
  const int row0 = sgi ? NCTX + b * SEQ : b * CTXL;
  const int len = sgi ? SEQ : CTXL;
  const int cl = (sgi ? cc - NC_CTX : cc) * 64;
  const int lch = blk * 64 + (tid & 7) * 8;
  const u32x4 z4 = {0u, 0u, 0u, 0u};
#pragma unroll
  for (int i = 0; i < 2; ++i) {
    int c = tid + i * 256, r = c >> 3;
    int p = cl + r, pos = d ? len - 1 - p : p;
#pragma unroll
    for (int tap = 0; tap < 4; ++tap) {
      int pp = pos + tap - 2;
      R.x[i][tap] = (pp >= 0 && pp < len) ? *(const u32x4*)(proj + (size_t)(row0 + pp) * ODC + 2304 + lch) : z4;
    }
  }
}

DEV void st_lru_chunk(const Params& P, int sid, int cc, int nsid, int ncc, bool has_next, LruRaw& R, unsigned char* smem) {
  constexpr int NC_CTX = CTXL / 64;
  const int tid = threadIdx.x, lane = tid & 63, wave = tid >> 6;
  const int d = sid & 1, blk = (sid >> 1) & 7, b = sid >> 4;
  float* sXc = (float*)smem;
  float* sAc = sXc + 4096;
  float* sBc = sAc + 4096;
  float* sU = sBc + 4096;
  bf16_t* sAop = (bf16_t*)(sU + 4096);
  float* sQA = (float*)(sAop + 64 * 72);
  float* sQH = sQA + 256;
  int* sRow = (int*)(sQH + 256);
  const bf16_t* proj = (const bf16_t*)(P.ws + OFF_PROJ);
  bf16_t* uout = (bf16_t*)(P.ws + OFF_LORA) + (size_t)d * NTOK * 512;
  bf16_t* aout = (bf16_t*)(P.ws + (d ? OFF_ACUM1 : OFF_ACUM0));
  const bf16_t* lruT = (const bf16_t*)(P.ws + OFF_LRUT) + (size_t)(d * 8 + blk) * 128 * 64;
  float* chunkS = (float*)(P.ws + OFF_LRUCS) + ((size_t)sid * LRU_NCH + cc) * 128;
  const float* cw = P.in[I_LCONVW];
  const float* cb = P.in[I_LCONVB];
  const int tr = (wave >> 1) * 32, nc0 = (wave & 1) * 64;
  const int sgi = cc >= NC_CTX;
  const int row0 = sgi ? NCTX + b * SEQ : b * CTXL;
  const int len = sgi ? SEQ : CTXL;
  const int cl = (sgi ? cc - NC_CTX : cc) * 64;
  __syncthreads();
  if (tid < 64) { int p = cl + tid; sRow[tid] = row0 + (d ? len - 1 - p : p); }
  {
    const int lc8 = (tid & 7) * 8, lch = blk * 64 + lc8;
#pragma unroll
    for (int i = 0; i < 2; ++i) {
      int c = tid + i * 256, r = c >> 3;
      int p = cl + r, pos = d ? len - 1 - p : p;
      float o[8];
      f32x4 c0 = *(const f32x4*)(cb + lch), c1 = *(const f32x4*)(cb + lch + 4);
      o[0] = c0.x; o[1] = c0.y; o[2] = c0.z; o[3] = c0.w; o[4] = c1.x; o[5] = c1.y; o[6] = c1.z; o[7] = c1.w;
#pragma unroll
      for (int tap = 0; tap < 4; ++tap) {
        float x[8];
        unpack8(R.x[i][tap], x);
        f32x4 w0 = *(const f32x4*)(cw + tap * 512 + lch), w1 = *(const f32x4*)(cw + tap * 512 + lch + 4);
        o[0] += w0.x * x[0]; o[1] += w0.y * x[1]; o[2] += w0.z * x[2]; o[3] += w0.w * x[3];
        o[4] += w1.x * x[4]; o[5] += w1.y * x[5]; o[6] += w1.z * x[6]; o[7] += w1.w * x[7];
      }
      { f32x4 o0 = {o[0], o[1], o[2], o[3]}, o1 = {o[4], o[5], o[6], o[7]};
        *(f32x4*)(sXc + r * 64 + lc8) = o0; *(f32x4*)(sXc + r * 64 + lc8 + 4) = o1; }
      *(u32x4*)(sAop + r * 72 + lc8) = pack8(o);
    }
  }
  if (has_next) lru_load_raw(P, nsid, ncc, R);
  __syncthreads();
  {
    f32x16 acc[2];
#pragma unroll
    for (int j = 0; j < 2; ++j)
#pragma unroll
      for (int r = 0; r < 16; ++r) acc[j][r] = 0.f;
#pragma unroll
    for (int kk = 0; kk < 4; ++kk) {
      bf16x8 a = *(const bf16x8*)(sAop + (tr + (lane & 31)) * 72 + kk * 16 + 8 * (lane >> 5));
#pragma unroll
      for (int j = 0; j < 2; ++j) {
        bf16x8 bb = *(const bf16x8*)(lruT + (nc0 + j * 32 + (lane & 31)) * 64 + kk * 16 + 8 * (lane >> 5));
        acc[j] = mfma32(a, bb, acc[j]);
      }
    }
#pragma unroll
    for (int j = 0; j < 2; ++j) {
      const int e = nc0 + j * 32 + (lane & 31);
      const int ch = blk * 64 + (e & 63);
      const float ebias = e < 64 ? P.in[I_BA][d * 512 + ch] : P.in[I_BI][d * 512 + ch];
      const float esp = softplusf_(-P.in[I_LAM][d * 512 + ch]);
#pragma unroll
      for (int r = 0; r < 16; ++r) {
        int t = tr + acc_row(r, lane);
        float g = sigmoidf_(acc[j][r] + ebias);
        if (e < 64) { float a_ = fexp(-8.f * g * esp); sAc[t * 64 + e] = a_; sU[t * 64 + e] = fsqrt(fmaxf(1.f - a_ * a_, 0.f)); }
        else sBc[t * 64 + (e - 64)] = g * sXc[t * 64 + (e - 64)];
      }
    }
  }
  __syncthreads();
  const int c = tid & 63, q = tid >> 6;
  {
    float av[16], hv[16];
#pragma unroll
    for (int i = 0; i < 16; ++i) {
      const int t = q * 16 + i;
      av[i] = sAc[t * 64 + c];
      hv[i] = sU[t * 64 + c] * sBc[t * 64 + c];
    }
    float h = 0.f, ap = 1.f;
#pragma unroll
    for (int i = 0; i < 16; ++i) { h = av[i] * h + hv[i]; ap *= av[i]; hv[i] = h; av[i] = ap; }
    sQA[q * 64 + c] = ap; sQH[q * 64 + c] = h;
    __syncthreads();
    float hin = 0.f, ain = 1.f;
    for (int q2 = 0; q2 < q; ++q2) { hin = sQA[q2 * 64 + c] * hin + sQH[q2 * 64 + c]; ain *= sQA[q2 * 64 + c]; }
#pragma unroll
    for (int i = 0; i < 16; ++i) {
      const int t = q * 16 + i;
      sU[t * 64 + c] = hv[i] + av[i] * hin;
      sAc[t * 64 + c] = av[i] * ain;
    }
    if (q == 3) { chunkS[c] = av[15] * ain; chunkS[64 + c] = hv[15] + av[15] * hin; }
  }
  __syncthreads();
  if (sgi) {
#pragma unroll
    for (int i = 0; i < 2; ++i) {
      int cidx = tid + i * 256, r = cidx >> 3, c8 = (cidx & 7) * 8;
      float u8[8], a8[8];
      ld8(sU + r * 64 + c8, u8); ld8(sAc + r * 64 + c8, a8);
      const int row = sRow[r];
      *(u32x4*)(uout + (size_t)row * 512 + blk * 64 + c8) = pack8(u8);
      *(u32x4*)(aout + (size_t)(row - NCTX) * 512 + blk * 64 + c8) = pack8(a8);
    }
  }
}

DEV void st_lru_carry(const Params& P, int sid, unsigned char* smem) {
  const int tid = threadIdx.x, c = tid & 63, p = tid >> 6;
  constexpr int NQ = (LRU_NCH + 3) / 4, NBATCH = 13;
  const int c0 = p * NQ, c1 = (c0 + NQ < LRU_NCH) ? c0 + NQ : LRU_NCH;
  const float* cs = (const float*)(P.ws + OFF_LRUCS) + (size_t)sid * LRU_NCH * 128;
  float* hs = (float*)(P.ws + OFF_LRUHS) + (size_t)sid * LRU_NCH * 64;
  float* sA = (float*)smem;
  float* sH = sA + 256;
  float A = 1.f, H = 0.f;
  for (int cc0 = c0; cc0 < c1; cc0 += NBATCH) {
    float a[NBATCH], bb[NBATCH];
#pragma unroll
    for (int i = 0; i < NBATCH; ++i) {
      const int cc = cc0 + i < LRU_NCH ? cc0 + i : LRU_NCH - 1;
      a[i] = cs[(size_t)cc * 128 + c]; bb[i] = cs[(size_t)cc * 128 + 64 + c];
    }
#pragma unroll
    for (int i = 0; i < NBATCH; ++i) if (cc0 + i < c1) { H = a[i] * H + bb[i]; A *= a[i]; }
  }
  __syncthreads();
  sA[p * 64 + c] = A; sH[p * 64 + c] = H;
  __syncthreads();
  float h = 0.f;
  for (int p2 = 0; p2 < p; ++p2) h = sA[p2 * 64 + c] * h + sH[p2 * 64 + c];
  for (int cc0 = c0; cc0 < c1; cc0 += NBATCH) {
    float a[NBATCH], bb[NBATCH];
#pragma unroll
    for (int i = 0; i < NBATCH; ++i) {
      const int cc = cc0 + i < LRU_NCH ? cc0 + i : LRU_NCH - 1;
      a[i] = cs[(size_t)cc * 128 + c]; bb[i] = cs[(size_t)cc * 128 + 64 + c];
    }
#pragma unroll
    for (int i = 0; i < NBATCH; ++i) if (cc0 + i < c1) { hs[(size_t)(cc0 + i) * 64 + c] = h; h = a[i] * h + bb[i]; }
  }
}

DEV void st_finish_l1(const Params& P, int row) {
  const int lane = threadIdx.x & 63;
  bf16_t* hb = (bf16_t*)(P.ws + OFF_HBUF) + (size_t)row * 1024;
  const bf16_t* proj = (const bf16_t*)(P.ws + OFF_PROJ);
  const bf16_t* lora = (const bf16_t*)(P.ws + OFF_LORA);
  const float* mu = P.in[I_MU];
  const int ch = lane * 8;
  float y0[8], y1[8];
  unpack8(*(const u32x4*)(hb + ch), y0);
  unpack8(*(const u32x4*)(hb + 512 + ch), y1);
  float sm = 0.f;
#pragma unroll
  for (int j = 0; j < 8; ++j) { y0[j] += y1[j]; sm += y0[j]; }
  sm = sum8(sm);
  const float mean = sm * (1.f / 64.f);
  float sv = 0.f;
#pragma unroll
  for (int j = 0; j < 8; ++j) { float dlt = y0[j] - mean; sv += dlt * dlt; }
  sv = sum8(sv);
  const float rstd = frsq(sv * (1.f / 64.f) + 64e-5f);
  float a0[8], a1[8], g[8], u0[8], u1[8], gb[8];
  unpack8(*(const u32x4*)(lora + ((size_t)2 * NTOK + row) * 512 + ch), a0);
  unpack8(*(const u32x4*)(lora + ((size_t)3 * NTOK + row) * 512 + ch), a1);
  unpack8(*(const u32x4*)(lora + ((size_t)4 * NTOK + row) * 512 + ch), g);
  unpack8(*(const u32x4*)(lora + ((size_t)0 * NTOK + row) * 512 + ch), u0);
  unpack8(*(const u32x4*)(lora + ((size_t)1 * NTOK + row) * 512 + ch), u1);
  if (row >= NCTX) {
    const int bb_ = (row - NCTX) / SEQ, pos = (row - NCTX) % SEQ, blk = ch >> 6;
    float ac[8];
#pragma unroll
    for (int dd = 0; dd < 2; ++dd) {
      const int pidx = dd ? SEQ - 1 - pos : pos;
      const int cc = CTXL / 64 + pidx / 64;
      const int sid = (bb_ * 8 + blk) * 2 + dd;
      const float* hs = (const float*)(P.ws + OFF_LRUHS) + ((size_t)sid * LRU_NCH + cc) * 64 + (ch & 63);
      unpack8(*(const u32x4*)((const bf16_t*)(P.ws + (dd ? OFF_ACUM1 : OFF_ACUM0)) + (size_t)(row - NCTX) * 512 + ch), ac);
      f32x4 h0 = *(const f32x4*)hs, h1 = *(const f32x4*)(hs + 4);
      float* u = dd ? u1 : u0;
      u[0] += ac[0] * h0.x; u[1] += ac[1] * h0.y; u[2] += ac[2] * h0.z; u[3] += ac[3] * h0.w;
      u[4] += ac[4] * h1.x; u[5] += ac[5] * h1.y; u[6] += ac[6] * h1.z; u[7] += ac[7] * h1.w;
    }
  }
  unpack8(*(const u32x4*)(proj + (size_t)row * ODC + 1792 + ch), gb);
  float rv[8], vv[8], kv[8];
  float sdot = 0.f;
  float pka[8], prk[8], plw[8], plb[8];
  ld8(P.in[I_KA] + ch, pka); ld8(P.in[I_RK] + ch, prk); ld8(P.in[I_LNW] + ch, plw); ld8(P.in[I_LNB] + ch, plb);
  mix8(proj, row, ch, mu, rv);
  mix8(proj, row, 512 + ch, mu, kv);
  mix8(proj, row, 1024 + ch, mu, vv);
#pragma unroll
  for (int j = 0; j < 8; ++j) {
    float r = rv[j];
    float k = kv[j];
    float am = 0.5f * (a0[j] + a1[j]);
    float kb = k * (1.f + (am - 1.f) * pka[j]);
    sdot += r * kb * prk[j];
    rv[j] = r;
  }
  sdot = sum8(sdot);
  float f1[8], f2[8];
#pragma unroll
  for (int j = 0; j < 8; ++j) {
    float yn = (y0[j] - mean) * rstd * plw[j] + plb[j];
    yn += sdot * vv[j];
    f1[j] = yn * g[j];
    f2[j] = (u0[j] + u1[j]) * geluf_(gb[j]);
  }
  *(u32x4*)(hb + ch) = pack8(f1);
  *(u32x4*)(hb + 512 + ch) = pack8(f2);
}

DEV unsigned fkey(float f) { unsigned u; __builtin_memcpy(&u, &f, 4); return (u >> 31) ? ~u : (u | 0x80000000u); }
DEV float keyf(unsigned u) { u = (u >> 31) ? (u & 0x7fffffffu) : ~u; float f; __builtin_memcpy(&f, &u, 4); return f; }
DEV void key_insert(unsigned x, unsigned* v) {
#pragma unroll
  for (int j = 0; j < 16; ++j) { unsigned hi = v[j] > x ? v[j] : x; x = v[j] > x ? x : v[j]; v[j] = hi; }
}
DEV void key_cx(unsigned& hi, unsigned& lo) { unsigned a = hi, b = lo; hi = a > b ? a : b; lo = a > b ? b : a; }
DEV void key_sort16(unsigned* v) {
#pragma unroll
  for (int k = 2; k <= 16; k <<= 1)
#pragma unroll
    for (int j = k >> 1; j > 0; j >>= 1)
#pragma unroll
      for (int i = 0; i < 16; ++i) {
        const int l = i ^ j;
        if (l > i) { if ((i & k) == 0) key_cx(v[i], v[l]); else key_cx(v[l], v[i]); }
      }
}
DEV void key_merge16(unsigned* a, const unsigned* b) {
#pragma unroll
  for (int i = 0; i < 16; ++i) a[i] = a[i] > b[15 - i] ? a[i] : b[15 - i];
#pragma unroll
  for (int j = 8; j > 0; j >>= 1)
#pragma unroll
    for (int i = 0; i < 16; ++i) { const int l = i ^ j; if (l > i) key_cx(a[i], a[l]); }
}

DEV void st_peer_topk(const Params& P, int layer, int tile, int h, unsigned char* smem) {
  const int tid = threadIdx.x;
  const bf16_t* q = (const bf16_t*)(P.ws + OFF_Q);
  const bf16_t* keys = (const bf16_t*)(P.ws + OFF_KEYS) + (size_t)(layer * 8 + h) * 2 * 128 * 128;
  float* sS = (float*)smem;
  const int m0 = tile * 128;
  const int tok = tid & 127, half = tid >> 7;
  unsigned kl[2][16];
#pragma unroll
  for (int p = 0; p < 2; ++p) {
    EpiScoreLds epi{sS, m0};
    gemm_tile_128<true>(q + (h * 2 + p) * 128, 2048, NTOK, keys + p * 128 * 128, 128, 128, 128, m0, 0, epi, smem);
    __syncthreads();
    float* row = sS + tok * 129 + half * 64;
#pragma unroll
    for (int g = 0; g < 4; ++g) {
      unsigned grp[16];
#pragma unroll
      for (int j = 0; j < 16; ++j) grp[j] = (fkey(row[g * 16 + j]) & ~127u) | (unsigned)(127 - (half * 64 + g * 16 + j));
      key_sort16(grp);
      if (g == 0) {
#pragma unroll
        for (int j = 0; j < 16; ++j) kl[p][j] = grp[j];
      } else key_merge16(kl[p], grp);
    }
    if (half == 1) {
#pragma unroll
      for (int j = 0; j < 16; ++j) row[j] = __builtin_bit_cast(float, kl[p][j]);
    }
    __syncthreads();
    if (half == 0) {
      unsigned oth[16];
#pragma unroll
      for (int j = 0; j < 16; ++j) oth[j] = __builtin_bit_cast(unsigned, sS[tok * 129 + 64 + j]);
      key_merge16(kl[p], oth);
    }
    __syncthreads();
  }
  if (tid < 128) {
    float sv0[16], sv1[16];
    int* irow = (int*)(sS + tid * 129);
#pragma unroll
    for (int j = 0; j < 16; ++j) {
      sv0[j] = keyf((kl[0][j] & ~127u) | 64u); sv1[j] = keyf((kl[1][j] & ~127u) | 64u);
      irow[j] = 127 - (int)(kl[0][j] & 127u); irow[16 + j] = 127 - (int)(kl[1][j] & 127u);
    }
    unsigned best[16];
#pragma unroll
    for (int j = 0; j < 16; ++j) best[j] = 0u;
#pragma unroll
    for (int i = 0; i < 16; ++i)
#pragma unroll
      for (int j = 0; j < 16; ++j)
        if ((i + 1) * (j + 1) <= 16) key_insert((fkey(sv0[i] + sv1[j]) & ~255u) | (unsigned)(255 - (i * 16 + j)), best);
    float e[16], sum = 0.f;
    const float b0 = keyf((best[0] & ~255u) | 128u);
#pragma unroll
    for (int j = 0; j < 16; ++j) { e[j] = fexp(keyf((best[j] & ~255u) | 128u) - b0); sum += e[j]; }
    const float inv = 1.f / sum;
    int* pidx = (int*)(P.ws + OFF_PIDX) + (size_t)(m0 + tid) * 128 + h * 16;
    float* pg = (float*)(P.ws + OFF_PGATE) + (size_t)(m0 + tid) * 128 + h * 16;
#pragma unroll
    for (int j = 0; j < 16; ++j) {
      const int pos = 255 - (int)(best[j] & 255u);
      pidx[j] = irow[pos >> 4] * 128 + irow[16 + (pos & 15)];
      pg[j] = e[j] * inv;
    }
  }
}

DEV void st_peer_experts(const Params& P, int layer, int row) {
  const int lane = threadIdx.x & 63;
  const bf16_t* xb = (const bf16_t*)(P.ws + OFF_HBUF) + (size_t)row * 1024;
  const unsigned char* U = P.ws + OFF_PU;
  const int* pidx = (const int*)(P.ws + OFF_PIDX) + (size_t)row * 128;
  const float* pg = (const float*)(P.ws + OFF_PGATE) + (size_t)row * 128;
  float x[16], acc[16];
  unpack8(*(const u32x4*)(xb + lane * 16), x);
  unpack8(*(const u32x4*)(xb + lane * 16 + 8), x + 8);
#pragma unroll
  for (int j = 0; j < 16; ++j) acc[j] = 0.f;
  const int b3 = (lane >> 3) & 1;
  const int mypick = (lane >> 3) & 7;
#ifdef CPU_EMU
#define PEER_SID(id) (id)
#else
#define PEER_SID(id) __builtin_amdgcn_readfirstlane(id)
#endif
  const unsigned lo12 = lane * 8, lo8 = PEER_VOFF + lane * 8;
#define PEER_LDU(i, id) uu[i] = *(const u32x2*)(U + (size_t)(unsigned)(id) * PEER_ROWB + lo12)
#define PEER_LDV(i, id) vv[i] = *(const u32x2*)(U + (size_t)(unsigned)(id) * PEER_ROWB + lo8)
#define PEER_IDS(v0, v1) {PEER_SID((int)v0.x), PEER_SID((int)v0.y), PEER_SID((int)v0.z), PEER_SID((int)v0.w), \
                          PEER_SID((int)v1.x), PEER_SID((int)v1.y), PEER_SID((int)v1.z), PEER_SID((int)v1.w)}
  u32x2 uu[8]; u32x2 vv[8];
  int cid[8];
  {
    const u32x4 p0 = *(const u32x4*)pidx, p1 = *(const u32x4*)(pidx + 4);
    const int id[8] = PEER_IDS(p0, p1);
#pragma unroll
    for (int i = 0; i < 8; ++i) { cid[i] = id[i]; PEER_LDU(i, id[i]); }
  }
  u32x4 n0 = *(const u32x4*)(pidx + 8), n1 = *(const u32x4*)(pidx + 12);
  float gcur = pg[mypick];
  for (int k0 = 0; k0 < 128; k0 += 8) {
#pragma unroll
    for (int i = 0; i < 8; ++i) PEER_LDV(i, cid[i]);
    const int nid[8] = PEER_IDS(n0, n1);
    {
      const int k2 = k0 + 16 < 128 ? k0 + 16 : 120;
      n0 = *(const u32x4*)(pidx + k2); n1 = *(const u32x4*)(pidx + k2 + 4);
    }
    const float gnxt = pg[(k0 + 8 < 128 ? k0 + 8 : 120) + mypick];
    float dsum[8];
#pragma unroll
    for (int i = 0; i < 8; i += 2) {
      float ufa[16], ufb[16];
#ifndef CPU_EMU
      __builtin_amdgcn_sched_barrier(0);
#endif
      unpack8_fp4(uu[i].x, ufa); unpack8_fp4(uu[i].y, ufa + 8); unpack8_fp4(uu[i + 1].x, ufb); unpack8_fp4(uu[i + 1].y, ufb + 8);
      PEER_LDU(i, nid[i]); PEER_LDU(i + 1, nid[i + 1]);
      typedef __attribute__((ext_vector_type(2))) float f32x2v;
      f32x2v da2 = {0.f, 0.f}, db2 = {0.f, 0.f};
#pragma unroll
      for (int j = 0; j < 8; ++j) {
        const f32x2v xx = {x[2 * j], x[2 * j + 1]};
        const f32x2v ua = {ufa[2 * j], ufa[2 * j + 1]}, ub = {ufb[2 * j], ufb[2 * j + 1]};
        da2 = xx * ua + da2; db2 = xx * ub + db2;
      }
      dsum[i] = da2.x + da2.y; dsum[i + 1] = db2.x + db2.y;
    }
    float e4[4], e2[2], g;
#pragma unroll
    for (int i = 0; i < 4; ++i) e4[i] = swap32_sum(dsum[i], dsum[4 + i]);
#pragma unroll
    for (int i = 0; i < 2; ++i) e2[i] = swap16_sum(e4[i], e4[2 + i]);
    {
      float mine = b3 ? e2[1] : e2[0], send = b3 ? e2[0] : e2[1];
      g = mine + dpp_xor<8>(send);
    }
    g = sum8(g);
    const float mycoef = gcur * geluf_(g * (1.f / PEER_USCALE));
#pragma unroll
    for (int i = 0; i < 8; ++i) {
      const float coef = wreadlane(mycoef, i * 8);
      float vf[16];
      unpack8_fp4(vv[i].x, vf); unpack8_fp4(vv[i].y, vf + 8);
#pragma unroll
      for (int j = 0; j < 16; ++j) acc[j] += coef * vf[j];
    }
#pragma unroll
    for (int i = 0; i < 8; ++i) cid[i] = nid[i];
    gcur = gnxt;
  }
#undef PEER_LDU
#undef PEER_LDV
#undef PEER_IDS
#undef PEER_SID
  float* xr = row < NCTX ? (float*)(P.ws + OFF_CTXRES) + (size_t)row * 1024 : P.out + (size_t)(row - NCTX) * 1024;
  const float* g2 = (const float*)(P.ws + OFF_MODV) + ((size_t)layer * 3 + mod_row(row)) * 6144 + 5 * 1024;
  float o[16];
#pragma unroll
  for (int q = 0; q < 4; ++q) {
    const int c = lane * 16 + q * 4;
    f32x4 a = *(const f32x4*)(xr + c), ga = *(const f32x4*)(g2 + c);
    o[q * 4 + 0] = a.x + ga.x * acc[q * 4 + 0] * (1.f / PEER_VSCALE); o[q * 4 + 1] = a.y + ga.y * acc[q * 4 + 1] * (1.f / PEER_VSCALE);
    o[q * 4 + 2] = a.z + ga.z * acc[q * 4 + 2] * (1.f / PEER_VSCALE); o[q * 4 + 3] = a.w + ga.w * acc[q * 4 + 3] * (1.f / PEER_VSCALE);
  }
  float ss = 0.f;
#pragma unroll
  for (int j = 0; j < 16; ++j) ss += o[j] * o[j];
  ss = wave_sum(ss);
  const float rstd = frsq(ss * (1.f / 1024.f) + 1e-6f);
  if (layer == 1) {
    float fn[16]; ld8(P.in[I_FNORM] + lane * 16, fn); ld8(P.in[I_FNORM] + lane * 16 + 8, fn + 8);
#pragma unroll
    for (int j = 0; j < 16; ++j) o[j] *= rstd * fn[j];
  }
#pragma unroll
  for (int q = 0; q < 4; ++q) {
    f32x4 a = {o[q * 4 + 0], o[q * 4 + 1], o[q * 4 + 2], o[q * 4 + 3]};
    *(f32x4*)(xr + lane * 16 + q * 4) = a;
  }
  if (layer == 0) {
    const float* mv = (const float*)(P.ws + OFF_MODV) + ((size_t)1 * 3 + mod_row(row)) * 6144;
    const float* nw = P.in[I_NORM1] + 1024;
    float hh[16];
#pragma unroll
    for (int q = 0; q < 4; ++q) {
      const int c = lane * 16 + q * 4;
      f32x4 w4 = *(const f32x4*)(nw + c), s4 = *(const f32x4*)(mv + 1024 + c), h4 = *(const f32x4*)(mv + c);
      hh[q * 4 + 0] = o[q * 4 + 0] * rstd * w4.x * (1.f + s4.x) + h4.x; hh[q * 4 + 1] = o[q * 4 + 1] * rstd * w4.y * (1.f + s4.y) + h4.y;
      hh[q * 4 + 2] = o[q * 4 + 2] * rstd * w4.z * (1.f + s4.z) + h4.z; hh[q * 4 + 3] = o[q * 4 + 3] * rstd * w4.w * (1.f + s4.w) + h4.w;
    }
    bf16_t* hb = (bf16_t*)(P.ws + OFF_HBUF) + (size_t)row * 1024 + lane * 16;
    *(u32x4*)hb = pack8(hh);
    *(u32x4*)(hb + 8) = pack8(hh + 8);
  }
}


#define FOR_TILES_XCD(MT0, MT1, NT, mt, nt)                                                     \
  for (int _x = blockIdx.x & 7, _mlo = (MT0) + (((MT1) - (MT0)) * _x) / 8,                        \
           _mhi = (MT0) + (((MT1) - (MT0)) * (_x + 1)) / 8, _i = blockIdx.x >> 3,                 \
           _cnt = (_mhi - _mlo) * (NT), mt = 0, nt = 0;                                           \
       _i < _cnt && ((mt = _mlo + _i / (NT)), (nt = _i % (NT)), true); _i += (int)(gridDim.x >> 3))

#ifndef PHASE_LIST
#define PHASE_LIST(X) X(0) X(1) X(2) X(22) X(23) X(3) X(4) X(5) X(6) X(7) X(8) X(9) X(11) X(12) X(13) X(30) X(14) X(15) X(31) X(16) X(17) X(18) X(19) X(20) X(21)
#endif
constexpr int PH_LAST = 21;

template <int ph>
DEV void run_phase(const Params& P, unsigned char* smem) {
  int bid_ = blockIdx.x, wave_ = threadIdx.x >> 6;
  OPAQUE_S(bid_); OPAQUE(wave_);
  const int bid = bid_, nb = gridDim.x;
  const int wave = wave_;
  unsigned char* ws = P.ws;
  constexpr int layer = ((ph >= 10 && ph <= 21) || ph >= 30) ? 1 : 0;
  const float* modv_l = (const float*)(ws + OFF_MODV) + (size_t)layer * 3 * 6144;
  switch (ph) {
    case 0:
      for (int t = NTRANS + bid; t < NPREP; t += nb) st_prep(P, t, smem);
      break;
    case 1: case 10:
      if (ph == 1) for (int t = nb - 1 - bid; t < NTRANS; t += nb) st_prep(P, t, smem);
      for (int t = bid; t < NTOK / 4; t += nb) st_normmod(P, layer, 0, t * 4 + wave);
      break;
    case 2: {
      EpiProjL0T epi{(bf16_t*)(ws + OFF_PROJ), (float*)(ws + OFF_GATES)};
      FOR_TILES_XCD(0, NTOK / 256, 25, mt, nt)
        gemm_tile_128x256<EpiProjL0T, true>((const bf16_t*)(ws + OFF_WEVIN), 1024, EVC, (const bf16_t*)(ws + OFF_HBUF), 1024, NTOK, 1024,
                                            nt * 128, mt * 256, epi, smem);
    } break;
    case 22:
      for (int t = bid; t < NTOK / 4; t += nb) st_xbc_conv(P, t * 4 + wave);
      for (int t = bid; t < NPCONV; t += nb) st_peer_conv(P, 0, t);
      break;
    case 23:
      for (int t = bid; t < 48 * LA_NSEG; t += nb) {
        int sid = t % 48, seg = t / 48;
        if (sid < 16) st_linattn_seg<true, false>(P, sid, seg, smem);
        else st_linattn_seg<false, false>(P, sid - 16, seg, smem);
      }
      break;
    case 3:
      for (int t = bid; t < 48 * LA_NSEG; t += nb) {
        int sid = t % 48, seg = t / 48;
        if (sid < 16) st_linattn_seg<true, true>(P, sid, seg, smem);
        else st_linattn_seg<false, true>(P, sid - 16, seg, smem);
      }
      break;
    case 4:
      for (int t = bid; t < NTOK / 4; t += nb) st_finish_l0(P, t * 4 + wave);
      break;
    case 5: case 17: {
      EpiOutProjT epi{layer == 0 ? P.in[I_X] : P.out, P.in[I_CTX], P.out, (float*)(ws + OFF_CTXRES), modv_l};
      const bf16_t* Wt = (const bf16_t*)(ws + (layer == 0 ? OFF_WEVOUT : OFF_WODOUT));
      FOR_TILES_XCD(layer == 0 ? 0 : NCTX / 256, NTOK / 256, 8, mt, nt)
        gemm_tile_128x256<EpiOutProjT, true>(Wt, 1024, 1024, (const bf16_t*)(ws + OFF_HBUF), 1024, NTOK, 1024, nt * 128, mt * 256, epi, smem);
    } break;
    case 6: case 18: {
      const int r0 = layer == 0 ? 0 : NCTX / 4;
      for (int t = r0 + bid; t < NTOK / 4; t += nb) st_normmod(P, layer, 1, t * 4 + wave);
      if (ph == 18) for (int t = bid; t < NPCONV; t += nb) st_peer_conv(P, 1, t);
    } break;
    case 7: case 19: {
      EpiStoreBfT epi{(bf16_t*)(ws + OFF_Q), 2048};
      const bf16_t* Wt = (const bf16_t*)(ws + OFF_WQ) + (size_t)layer * 2048 * 1024;
      FOR_TILES_XCD(layer == 0 ? 0 : NCTX / 256, NTOK / 256, 16, mt, nt)
        gemm_tile_128x256<EpiStoreBfT, true>(Wt, 1024, 2048, (const bf16_t*)(ws + OFF_HBUF), 1024, NTOK, 1024, nt * 128, mt * 256, epi, smem);
    } break;
    case 8: case 20: {
      const int t0 = layer == 0 ? 0 : CTILE * 8;
      for (int t = t0 + bid; t < NTILE * 8; t += nb) st_peer_topk(P, layer, t / 8, t % 8, smem);
    } break;
    case 9: case 21: {
      const int r0 = layer == 0 ? 0 : NCTX / 4;
      for (int t = r0 + bid; t < NTOK / 4; t += nb) st_peer_experts(P, layer, t * 4 + wave);
    } break;
    case 11: {
      EpiStoreBfT epi{(bf16_t*)(ws + OFF_PROJ), ODC};
      FOR_TILES_XCD(0, NTOK / 256, 22, mt, nt)
        gemm_tile_128x256<EpiStoreBfT, true>((const bf16_t*)(ws + OFF_WODIN), 1024, ODC, (const bf16_t*)(ws + OFF_HBUF), 1024, NTOK, 1024,
                                             nt * 128, mt * 256, epi, smem);
    } break;
    case 12:
      for (int t = bid; t < NTOK / 8; t += nb) st_lora_act(P, t * 8 + wave * 2);
      break;
    case 13:
      for (int t = bid; t < NTILE * 20; t += nb) {
        int job = t / (NTILE * 4), tt = t % (NTILE * 4);
        int mt = tt / 4, nt = tt % 4;
        bf16_t* dst = (bf16_t*)(ws + OFF_LORA) + (size_t)job * NTOK * 512;
        const bf16_t* A = (const bf16_t*)(ws + OFF_HBUF) + (job < 2 ? 0 : (job < 4 ? 64 : 128));
        const bf16_t* Bt = job < 2 ? (const bf16_t*)(ws + OFF_WUP) + (size_t)job * 512 * 64
                         : job < 4 ? (const bf16_t*)(ws + OFF_AUP) + (size_t)(job - 2) * 512 * 64
                                   : (const bf16_t*)(ws + OFF_GUP);
        const float* bias = job < 2 ? P.in[I_W0] + job * 512 : (job < 4 ? P.in[I_A0] + (job - 2) * 512 : nullptr);
        const int K = job < 4 ? 64 : 128;
        EpiStoreBfBiasT epi{dst, 512, bias, job < 2 ? 1 : (job < 4 ? 2 : 0)};
        gemm_tile_128<false, EpiStoreBfBiasT, true>(Bt, K, 512, A, 1024, NTOK, K, nt * 128, mt * 128, epi, smem);
      }
      break;
    case 30:
      for (int t = bid; t < 32 * RW_NSEG; t += nb) st_rwkv_seg<false>(P, t % 32, t / 32, smem);
      break;
    case 14:
      for (int t = bid; t < 32 * RW_NSEG; t += nb) st_rwkv_seg<true>(P, t % 32, t / 32, smem);
      break;
    case 15:
      {
        LruRaw R;
        if (bid < 32 * LRU_NCH) lru_load_raw(P, bid % 32, bid / 32, R);
        for (int t = bid; t < 32 * LRU_NCH; t += nb) {
          const int tn = t + nb;
          st_lru_chunk(P, t % 32, t / 32, tn % 32, tn / 32, tn < 32 * LRU_NCH, R, smem);
        }
      }
      break;
    case 31:
      if (bid < 32) st_lru_carry(P, bid, smem);
      break;
    case 16:
      for (int t = bid; t < NTOK / 4; t += nb) st_finish_l1(P, t * 4 + wave);
      break;
    default: break;
  }
}


#ifndef CPU_EMU
#define XB_TMO      128
#define XB_XCNT(j)  (256  + 64 * (j))
#define XB_XSUB(j)  (1280 + 64 * (j))
#define XB_XGEN(j)  (2304 + 64 * (j))
#define XB_TOP      3328
#define XB_TOPGEN   3392
#define XCD_BAR_WORDS 3456
#define XB_SPIN_CAP (1u << 20)
#define LAS __attribute__((address_space(3)))
__device__ __forceinline__ unsigned xb_ld(unsigned* p)              { return __hip_atomic_load(p, __ATOMIC_RELAXED, __HIP_MEMORY_SCOPE_AGENT); }
__device__ __forceinline__ unsigned xb_add(unsigned* p, unsigned v) { return __hip_atomic_fetch_add(p, v, __ATOMIC_RELAXED, __HIP_MEMORY_SCOPE_AGENT); }
__device__ __forceinline__ unsigned xb_xcc_id() { return (unsigned)__builtin_amdgcn_s_getreg((3 << 11) | 20) & 0xFu; }
#define XB_SPIN(cond, bar) do { unsigned _sp = 0; while (cond) { __builtin_amdgcn_s_sleep(1); \
    if ((++_sp & 255u) == 0u) { if (xb_ld(&(bar)[XB_TMO])) break; if (_sp > XB_SPIN_CAP) { atomicAdd(&(bar)[XB_TMO], 1u); break; } } } } while (0)
struct XcdBarrier { unsigned* bar; unsigned x; volatile LAS unsigned* st; };
__device__ __forceinline__ XcdBarrier xcd_barrier_post(unsigned* bar, volatile LAS unsigned* st) {
  XcdBarrier b; b.bar = bar; b.x = xb_xcc_id(); b.st = st;
  if (threadIdx.x == 0) (void)xb_add(&bar[XB_XCNT(b.x)], 1u);
  return b;
}
__device__ __forceinline__ void xcd_barrier_complete(unsigned* bar, unsigned x, unsigned& nloc, unsigned& nx) {
  const unsigned G = gridDim.x * gridDim.y * gridDim.z;
  unsigned sum, cnt, mine, sp = 0u;
  for (;;) {
    sum = 0u; cnt = 0u; mine = 0u;
#pragma unroll
    for (unsigned j = 0; j < 16; ++j) { const unsigned c = xb_ld(&bar[XB_XCNT(j)]); sum += c; cnt += (c > 0u) ? 1u : 0u; mine = (j == x) ? c : mine; }
    if (sum == G) break;
    __builtin_amdgcn_s_sleep(1);
    if ((++sp & 255u) == 0u) { if (xb_ld(&bar[XB_TMO])) break; if (sp > XB_SPIN_CAP) { atomicAdd(&bar[XB_TMO], 1u); break; } }
  }
  nloc = mine > 0u ? mine : 1u; nx = cnt > 0u ? cnt : 1u;
}
__device__ __forceinline__ void xcd_barrier(const XcdBarrier& b) {
  asm volatile("s_waitcnt vmcnt(0)" ::: "memory");
  __syncthreads();
  if (threadIdx.x == 0) {
    unsigned* bar = b.bar;
    __builtin_amdgcn_s_waitcnt(0);
    unsigned nloc = b.st[0], nx = b.st[1];
    if (nloc == 0u) { xcd_barrier_complete(bar, b.x, nloc, nx); b.st[0] = nloc; b.st[1] = nx; }
    const unsigned old = xb_add(&bar[XB_XSUB(b.x)], 1u);
    const unsigned gen = old / nloc;
    if (old + 1u == (gen + 1u) * nloc) {
      __builtin_amdgcn_fence(__ATOMIC_RELEASE, "agent");
      asm volatile("s_waitcnt vmcnt(0)" ::: "memory");
      const unsigned og = xb_add(&bar[XB_TOP], 1u);
      const unsigned tg = og / nx;
      if (og + 1u == (tg + 1u) * nx) xb_add(&bar[XB_TOPGEN], 1u);
      else XB_SPIN(xb_ld(&bar[XB_TOPGEN]) == tg, bar);
      __builtin_amdgcn_fence(__ATOMIC_ACQUIRE, "agent");
      xb_add(&bar[XB_XGEN(b.x)], 1u);
      asm volatile("s_waitcnt vmcnt(0)" ::: "memory");
    } else {
      XB_SPIN(xb_ld(&bar[XB_XGEN(b.x)]) == gen, bar);
      __builtin_amdgcn_fence(__ATOMIC_ACQUIRE, "agent");
      asm volatile("s_waitcnt vmcnt(0)" ::: "memory");
    }
  }
  __syncthreads();
}
#endif
#ifndef CPU_EMU
#define RUN_PH(n) run_phase<n>(P, smem_raw); if (n != PH_LAST) xcd_barrier(xb);
__global__ void __launch_bounds__(256, 2) mega_kernel(Params P) {
  SMEM_DECL;
  unsigned* bar = (unsigned*)(P.ws + OFF_BAR);
  volatile LAS unsigned* st = (volatile LAS unsigned*)(smem_raw + SMEM_BYTES - 16);
  if (threadIdx.x == 0) { st[0] = 0u; st[1] = 0u; }
  if (P.ws == nullptr) cg::this_grid().sync();
  __syncthreads();
  XcdBarrier xb = xcd_barrier_post(bar, st);
  PHASE_LIST(RUN_PH)
}

extern "C" void kernel_launch(void* const* d_in, const int* in_sizes, int n_in, void* d_out, int out_size, void* d_ws,
                              size_t ws_size, hipStream_t stream) {
  Params P{};
  for (int i = 0; i < N_IN; ++i) P.in[i] = (const float*)d_in[i];
  P.out = (float*)d_out;
  P.ws = (unsigned char*)d_ws;
  if (ws_size < WS_NEEDED) { fprintf(stderr, "workspace too small: %zu < %zu\n", ws_size, (size_t)WS_NEEDED); return; }
  static int grid_blocks = 0;
  if (!grid_blocks) {
    int dev = 0, cus = 0, per_cu = 0;
    hipGetDevice(&dev);
    hipDeviceGetAttribute(&cus, hipDeviceAttributeMultiprocessorCount, dev);
    hipOccupancyMaxActiveBlocksPerMultiprocessor(&per_cu, mega_kernel, 256, 0);
    if (per_cu > 2) per_cu = 2;
    grid_blocks = cus * per_cu;
  }
  (void)hipMemsetAsync((unsigned char*)d_ws + OFF_BAR, 0, 16384, stream);
  void* args[] = {&P};
  hipError_t e = hipLaunchCooperativeKernel((void*)mega_kernel, dim3(grid_blocks), dim3(256), args, 0, stream);
  if (e != hipSuccess) fprintf(stderr, "cooperative launch failed: %s (grid %d)\n", hipGetErrorString(e), grid_blocks);
}
#endif
```
